# Optimizing an MI355X kernel written in HIP

```python
import jax
import jax.numpy as jnp
from jax import lax
import numpy as np

D_MODEL = 1024
BATCH = 1
SEQ = 16384
DEPTH = 4

GRID_W = 64
CTX_LEN = 256
HEAD_DIM = 64
ROPE_THETA = 10000.0
ROPE_PAIRS_PER_AXIS = HEAD_DIM // 4
NORM_EPS = 1e-6
NEG_INF = -1e30

A_HEADS = 4
A_KV_HEADS = 2
A_WINDOW = 128
A_BLOCK = 128
B_GROUPS = 4
B_GROUP_DIM = 64
C_HEADS = 4
C_WIN_ROWS = 8
C_WIN_COLS = 16
D_HEADS = 4
D_DECAY_LORA = 64
D_AAA_LORA = 64
D_GATE_LORA = 160
D_CONV = 3
D_GN_EPS = 64e-5

A_W = A_HEADS * HEAD_DIM
A_KV_W = A_KV_HEADS * HEAD_DIM
B_W = B_GROUPS * B_GROUP_DIM
C_W = C_HEADS * HEAD_DIM
D_W = D_HEADS * HEAD_DIM
MIX_W = A_W + B_W + C_W + D_W
IN_SIZES = (A_W, A_KV_W, A_KV_W, B_W, C_W, C_W, C_W, 3 * D_W, 2 * D_DECAY_LORA, 2 * D_AAA_LORA, D_GATE_LORA)
IN_W = A_W + 2 * A_KV_W + B_W + 3 * C_W + 3 * D_W + 2 * D_DECAY_LORA + 2 * D_AAA_LORA + D_GATE_LORA

N_EXPERTS = 32
TOP_K = 4
D_EXPERT = D_MODEL
SWIGLU_LIMIT = 7.0
SWIGLU_ALPHA = 1.702
MOE_BLOCK = 128

kernel_name = 'hybrid_parallel_heads_flow_block'


def rms_norm(x, g):
    xf = x.astype(jnp.float32)
    y = xf * lax.rsqrt(jnp.mean(xf * xf, axis=-1, keepdims=True) + NORM_EPS)
    return (y * g.astype(jnp.float32)).astype(x.dtype)


def modulate(h, shift, scale):
    return h * (1 + scale) + shift


def split_heads(t, n):
    return t.reshape(t.shape[:-1] + (n, HEAD_DIM))


def split_in_proj(p):
    idx, s = [], 0
    for n in IN_SIZES[:-1]:
        s += n
        idx.append(s)
    return jnp.split(p, idx, axis=-1)


def axial_rope(n):
    t = jnp.arange(n)
    row = (t // GRID_W).astype(jnp.float32)
    col = (t % GRID_W).astype(jnp.float32)
    inv = ROPE_THETA ** (-jnp.arange(ROPE_PAIRS_PER_AXIS, dtype=jnp.float32) / ROPE_PAIRS_PER_AXIS)
    ang = jnp.concatenate([row[:, None] * inv, col[:, None] * inv], axis=-1)
    return jnp.cos(ang)[None, :, None, :], jnp.sin(ang)[None, :, None, :]


def apply_rope(x, cos, sin):
    xf = x.astype(jnp.float32)
    x1, x2 = jnp.split(xf, 2, axis=-1)
    return jnp.concatenate([x1 * cos - x2 * sin, x2 * cos + x1 * sin], axis=-1).astype(x.dtype)


def window_gqa_latent(q, k, v, kc, vc, sink):
    bsz, n = q.shape[:2]
    nb = n // A_BLOCK
    grp = A_HEADS // A_KV_HEADS
    n_ctx = kc.shape[1]
    scale = HEAD_DIM ** -0.5
    qb = q.reshape(bsz, nb, A_BLOCK, A_KV_HEADS, grp, HEAD_DIM)

    def band(t):
        tp = jnp.pad(t, ((0, 0), (A_BLOCK, A_BLOCK), (0, 0), (0, 0)))
        tp = tp.reshape(bsz, nb + 2, A_BLOCK, A_KV_HEADS, HEAD_DIM)
        return jnp.concatenate([tp[:, :-2], tp[:, 1:-1], tp[:, 2:]], axis=2)

    kb, vb = band(k), band(v)
    s_loc = jnp.einsum('bnqhgd,bnkhd->bhgnqk', qb, kb).astype(jnp.float32) * scale
    s_ctx = jnp.einsum('bnqhgd,bchd->bhgnqc', qb, kc).astype(jnp.float32) * scale
    q_off = jnp.arange(A_BLOCK)
    k_off = jnp.arange(3 * A_BLOCK) - A_BLOCK
    k_pos = (jnp.arange(nb) * A_BLOCK)[:, None, None] + k_off[None, None, :]
    valid = (jnp.abs(k_off[None, :] - q_off[:, None]) <= A_WINDOW)[None] & (k_pos >= 0) & (k_pos < n)
    s_loc = jnp.where(valid, s_loc, NEG_INF)
    s_sink = jnp.broadcast_to(sink.astype(jnp.float32).reshape(1, A_KV_HEADS, grp, 1, 1, 1), s_loc.shape[:-1] + (1,))
    p = jax.nn.softmax(jnp.concatenate([s_loc, s_ctx, s_sink], axis=-1), axis=-1).astype(v.dtype)
    n_loc = 3 * A_BLOCK
    o = (jnp.einsum('bhgnqk,bnkhd->bnqhgd', p[..., :n_loc], vb)
         + jnp.einsum('bhgnqc,bchd->bnqhgd', p[..., n_loc:n_loc + n_ctx], vc))
    return o.reshape(bsz, n, A_W)


def context_attention(q, k, v, sink):
    bsz, n_ctx, n_q = q.shape[:3]
    n_kv = k.shape[2]
    grp = n_q // n_kv
    qg = q.reshape(bsz, n_ctx, n_kv, grp, HEAD_DIM)
    s = jnp.einsum('bqhgd,bkhd->bhgqk', qg, k).astype(jnp.float32) * HEAD_DIM ** -0.5
    if sink is not None:
        s_sink = jnp.broadcast_to(sink.astype(jnp.float32).reshape(1, n_kv, grp, 1, 1), s.shape[:-1] + (1,))
        s = jnp.concatenate([s, s_sink], axis=-1)
    p = jax.nn.softmax(s, axis=-1)[..., :n_ctx].astype(v.dtype)
    o = jnp.einsum('bhgqk,bkhd->bqhgd', p, v)
    return o.reshape(bsz, n_ctx, n_q * HEAD_DIM)


def neighbourhood_latent(q, k, v, kc, vc, rel_bias):
    bsz, n = q.shape[:2]
    rows = n // GRID_W
    kr = min(C_WIN_ROWS, rows)
    scale = HEAD_DIM ** -0.5
    r = jnp.arange(rows)
    key_rows = jnp.clip(r - kr // 2, 0, rows - kr)[:, None] + jnp.arange(kr)[None, :]

    def to_grid(t):
        return t.reshape(bsz, rows, GRID_W, C_HEADS, HEAD_DIM)

    kg = to_grid(k)[:, key_rows].reshape(bsz, rows, kr * GRID_W, C_HEADS, HEAD_DIM)
    vg = to_grid(v)[:, key_rows].reshape(bsz, rows, kr * GRID_W, C_HEADS, HEAD_DIM)
    qg = to_grid(q)
    s_loc = jnp.einsum('brqhd,brkhd->bhrqk', qg, kg).astype(jnp.float32) * scale
    cols = jnp.arange(GRID_W)
    col_start = jnp.clip(cols - C_WIN_COLS // 2, 0, GRID_W - C_WIN_COLS)
    col_ok = (cols[None, :] >= col_start[:, None]) & (cols[None, :] < col_start[:, None] + C_WIN_COLS)
    row_idx = key_rows - r[:, None] + (C_WIN_ROWS - 1)
    col_idx = jnp.clip(cols[None, :] - cols[:, None] + (C_WIN_COLS - 1), 0, 2 * C_WIN_COLS - 2)
    bias = rel_bias[:, row_idx[:, None, :, None], col_idx[None, :, None, :]]
    bias = bias.reshape(C_HEADS, rows, GRID_W, kr * GRID_W).astype(jnp.float32)
    mask = jnp.broadcast_to(col_ok[:, None, :], (GRID_W, kr, GRID_W)).reshape(GRID_W, kr * GRID_W)
    s_loc = jnp.where(mask, s_loc + bias[None], NEG_INF)
    s_ctx = jnp.einsum('brqhd,bchd->bhrqc', qg, kc).astype(jnp.float32) * scale
    p = jax.nn.softmax(jnp.concatenate([s_loc, s_ctx], axis=-1), axis=-1).astype(v.dtype)
    n_loc = kr * GRID_W
    o = (jnp.einsum('bhrqk,brkhd->brqhd', p[..., :n_loc], vg)
         + jnp.einsum('bhrqc,bchd->brqhd', p[..., n_loc:], vc))
    return o.reshape(bsz, n, C_W)


def fourier_mix(u, w_mix):
    bsz, t = u.shape[:2]
    ug = u.reshape(bsz, t, B_GROUPS, B_GROUP_DIM).astype(jnp.float32)
    f = jnp.fft.fft2(ug, axes=(1, 3), norm='ortho').real
    return jnp.einsum('btgc,gce->btge', f.astype(u.dtype), w_mix).reshape(bsz, t, B_W)


def centred_dwconv(u, w):
    k = w.shape[0]
    p = k // 2
    t = u.shape[1]
    up = jnp.pad(u, ((0, 0), (p, p), (0, 0)))
    out = up[:, 0:t] * w[0]
    for i in range(1, k):
        out = out + up[:, i:i + t] * w[i]
    return out


def rwkv_prep(rkv, wl, al, conv_w, w0, w2, a0, a2, k_k, k_a):
    bsz, t = rkv.shape[:2]
    rkv = centred_dwconv(rkv, conv_w)
    r, k, v = jnp.split(rkv.astype(jnp.float32), 3, axis=-1)
    wl = jnp.tanh(wl.reshape(bsz, t, 2, D_DECAY_LORA).astype(jnp.float32))
    al = al.reshape(bsz, t, 2, D_AAA_LORA).astype(jnp.float32)
    w_pre = w0.astype(jnp.float32) + jnp.einsum('btdl,dlc->btdc', wl, w2.astype(jnp.float32))
    decay = jnp.exp(-jnp.exp(-jax.nn.softplus(-w_pre) - 0.5))
    a = jax.nn.sigmoid(a0.astype(jnp.float32) + jnp.einsum('btdl,dlc->btdc', al, a2.astype(jnp.float32)))
    kk = split_heads(k * k_k.astype(jnp.float32), D_HEADS)
    kk = kk * lax.rsqrt(jnp.maximum(jnp.sum(kk * kk, axis=-1, keepdims=True), 1e-24))
    k_dir = k[:, :, None] * (1 + (a - 1) * k_a.astype(jnp.float32))
    a_h = split_heads(a, D_HEADS)
    return (split_heads(r, D_HEADS), split_heads(decay, D_HEADS), split_heads(k_dir, D_HEADS),
            split_heads(v, D_HEADS), kk, kk[:, :, None] * a_h)


def scan_inputs(prep):
    r_h, w_h, k_h, v_h, kk, b_h = prep

    def both(t):
        return jnp.moveaxis(jnp.stack([t, jnp.flip(t, axis=1)], axis=0), 2, 0)

    def per_dir(t):
        return jnp.moveaxis(jnp.stack([t[:, :, 0], jnp.flip(t[:, :, 1], axis=1)], axis=0), 2, 0)

    return (both(r_h), per_dir(w_h), per_dir(k_h), both(v_h), both(-kk), per_dir(b_h))


def wkv_scan(s0, seq, emit):
    def step(s, inp):
        r_t, w_t, k_t, v_t, a_t, b_t = inp
        sa = jnp.einsum('dbhij,dbhj->dbhi', s, a_t)
        s = s * w_t[..., None, :] + sa[..., :, None] * b_t[..., None, :] + v_t[..., :, None] * k_t[..., None, :]
        y = jnp.einsum('dbhij,dbhj->dbhi', s, r_t) if emit else None
        return s, y
    return lax.scan(step, s0, seq)


def rwkv_out(y, prep, gl, g2, r_k, ln_w, ln_b):
    r_h, _, k_h, v_h, _, _ = prep
    y = jnp.moveaxis(y, 0, 2)
    y = y[0] + jnp.flip(y[1], axis=1)
    mu = jnp.mean(y, axis=-1, keepdims=True)
    var = jnp.mean(jnp.square(y - mu), axis=-1, keepdims=True)
    yn = ((y - mu) * lax.rsqrt(var + D_GN_EPS) * split_heads(ln_w.astype(jnp.float32), D_HEADS)
          + split_heads(ln_b.astype(jnp.float32), D_HEADS))
    coef = jnp.sum(r_h[:, :, None] * k_h * r_k.astype(jnp.float32), axis=(2, 4))[..., None]
    g = (jax.nn.sigmoid(gl) @ g2).astype(jnp.float32)
    bsz, t = y.shape[:2]
    return (yn + coef * v_h).reshape(bsz, t, D_W) * g


def rwkv7_bidir(rkv, wl, al, gl, rkv_c, wl_c, al_c, gl_c, conv_w, w0, w2, a0, a2, g2, k_k, k_a, r_k,
                ln_w, ln_b, emit_ctx):
    lat = rwkv_prep(rkv, wl, al, conv_w, w0, w2, a0, a2, k_k, k_a)
    ctxp = rwkv_prep(rkv_c, wl_c, al_c, conv_w, w0, w2, a0, a2, k_k, k_a)
    s0 = jnp.zeros((2, rkv.shape[0], D_HEADS, HEAD_DIM, HEAD_DIM), jnp.float32)
    s_ctx, y_ctx = wkv_scan(s0, scan_inputs(ctxp), emit_ctx)
    _, y_lat = wkv_scan(s_ctx, scan_inputs(lat), True)
    out = rwkv_out(y_lat, lat, gl, g2, r_k, ln_w, ln_b).astype(rkv.dtype)
    out_c = rwkv_out(y_ctx, ctxp, gl_c, g2, r_k, ln_w, ln_b).astype(rkv.dtype) if emit_ctx else None
    return out, out_c


def moe_ffn(h, router_w, router_b, w_gu, b_gu, w_down, b_down):
    shp = h.shape
    xt = h.reshape(-1, shp[-1])
    n_tok = xt.shape[0]
    logits = (xt @ router_w + router_b).astype(jnp.float32)
    top_v, top_e = lax.top_k(logits, TOP_K)
    gates = jax.nn.softmax(top_v, axis=-1)
    m = n_tok * TOP_K
    flat_e = top_e.reshape(-1)
    order = jnp.argsort(flat_e)
    e_sorted = flat_e[order]
    tok_sorted = order // TOP_K
    gate_sorted = gates.reshape(-1)[order]
    sizes = jnp.bincount(flat_e, length=N_EXPERTS)
    padded = (sizes + MOE_BLOCK - 1) // MOE_BLOCK * MOE_BLOCK
    starts = jnp.cumsum(sizes) - sizes
    p_ends = jnp.cumsum(padded)
    p_starts = p_ends - padded
    dest = p_starts[e_sorted] + jnp.arange(m) - starts[e_sorted]
    n_blocks = (m + N_EXPERTS * (MOE_BLOCK - 1) + MOE_BLOCK - 1) // MOE_BLOCK
    xbuf = jnp.zeros((n_blocks * MOE_BLOCK, shp[-1]), xt.dtype).at[dest].set(xt[tok_sorted])
    blk_e = jnp.minimum(jnp.searchsorted(p_ends, jnp.arange(n_blocks) * MOE_BLOCK, side='right'), N_EXPERTS - 1)

    def expert_block(args):
        xb, e = args
        gu = xb @ w_gu[e] + b_gu[e]
        gate, up = gu[:, 0::2], gu[:, 1::2]
        gate = jnp.minimum(gate, SWIGLU_LIMIT)
        up = jnp.clip(up, -SWIGLU_LIMIT, SWIGLU_LIMIT)
        act = gate * jax.nn.sigmoid(gate * SWIGLU_ALPHA) * (up + 1)
        return act @ w_down[e] + b_down[e]

    ybuf = lax.map(expert_block, (xbuf.reshape(n_blocks, MOE_BLOCK, shp[-1]), blk_e)).reshape(-1, shp[-1])
    contrib = ybuf[dest] * gate_sorted[:, None].astype(ybuf.dtype)
    y = jax.ops.segment_sum(contrib, tok_sorted, num_segments=n_tok)
    return y.reshape(shp)


def hybrid_layer(x, xc, mod, mod_c, n1, n2, w_in, w_out, a_sink, b_mix, c_rel_bias, d_conv, d_w0, d_w2, d_a0,
                 d_a2, d_g2, d_k_k, d_k_a, d_r_k, d_ln_w, d_ln_b, router_w, router_b, e_w_gu, e_b_gu, e_w_down,
                 e_b_down, cos, sin, emit_ctx):
    n_ctx = xc.shape[1]
    sh1, sc1, gt1, sh2, sc2, gt2 = [mm[:, None, :] for mm in jnp.split(mod, 6, axis=-1)]
    sh1c, sc1c, gt1c, sh2c, sc2c, gt2c = jnp.split(mod_c, 6)
    h = modulate(rms_norm(x, n1), sh1, sc1)
    hc = modulate(rms_norm(xc, n1), sh1c, sc1c)
    aq, ak, av, bu, cq, ck, cv, drkv, dwl, dal, dgl = split_in_proj(h @ w_in)
    aqc, akc, avc, buc, cqc, ckc, cvc, drkvc, dwlc, dalc, dglc = split_in_proj(hc @ w_in)
    kac, vac = split_heads(akc, A_KV_HEADS), split_heads(avc, A_KV_HEADS)
    kcc, vcc = split_heads(ckc, C_HEADS), split_heads(cvc, C_HEADS)
    o_a = window_gqa_latent(apply_rope(split_heads(aq, A_HEADS), cos, sin),
                            apply_rope(split_heads(ak, A_KV_HEADS), cos, sin),
                            split_heads(av, A_KV_HEADS), kac, vac, a_sink)
    o_b = fourier_mix(bu, b_mix)
    o_c = neighbourhood_latent(split_heads(cq, C_HEADS), split_heads(ck, C_HEADS), split_heads(cv, C_HEADS),
                               kcc, vcc, c_rel_bias)
    o_d, o_dc = rwkv7_bidir(drkv, dwl, dal, dgl, drkvc, dwlc, dalc, dglc, d_conv, d_w0, d_w2, d_a0, d_a2, d_g2,
                            d_k_k, d_k_a, d_r_k, d_ln_w, d_ln_b, emit_ctx)
    x = x + gt1 * (jnp.concatenate([o_a, o_b, o_c, o_d], axis=-1) @ w_out)
    if emit_ctx:
        o_ac = context_attention(split_heads(aqc, A_HEADS), kac, vac, a_sink)
        o_bc = fourier_mix(buc, b_mix)
        o_cc = context_attention(split_heads(cqc, C_HEADS), kcc, vcc, None)
        xc = xc + gt1c * (jnp.concatenate([o_ac, o_bc, o_cc, o_dc], axis=-1) @ w_out)
        hc2 = modulate(rms_norm(xc, n2), sh2c, sc2c)
        h2 = modulate(rms_norm(x, n2), sh2, sc2)
        f = moe_ffn(jnp.concatenate([hc2, h2], axis=1), router_w, router_b, e_w_gu, e_b_gu, e_w_down, e_b_down)
        xc = xc + gt2c * f[:, :n_ctx]
        x = x + gt2 * f[:, n_ctx:]
    else:
        h2 = modulate(rms_norm(x, n2), sh2, sc2)
        x = x + gt2 * moe_ffn(h2, router_w, router_b, e_w_gu, e_b_gu, e_w_down, e_b_down)
    return x, xc


def setup_inputs(seed: int = 0) -> dict:
    key = jax.random.key(seed)
    ks = jax.random.split(key, 32)
    f32 = jnp.float32
    dm = D_MODEL

    def nrm(i, shape, scale):
        return scale * jax.random.normal(ks[i], shape, f32)

    return {
        'x': nrm(0, (BATCH, SEQ, dm), 1.0),
        'c': nrm(1, (BATCH, dm), 1.0),
        'ctx': nrm(2, (BATCH, CTX_LEN, dm), 1.0),
        'c_ctx': nrm(3, (dm,), 1.0),
        'ada_w': nrm(4, (DEPTH, dm, 6 * dm), 0.5 * dm ** -0.5),
        'ada_b': nrm(5, (DEPTH, 6 * dm), 0.02),
        'norm1_g': 1.0 + nrm(6, (DEPTH, dm), 0.02),
        'norm2_g': 1.0 + nrm(7, (DEPTH, dm), 0.02),
        'w_in': nrm(8, (DEPTH, dm, IN_W), dm ** -0.5),
        'w_out': nrm(9, (DEPTH, MIX_W, dm), MIX_W ** -0.5),
        'a_sink': nrm(10, (DEPTH, A_HEADS), 0.5),
        'b_mix': nrm(11, (DEPTH, B_GROUPS, B_GROUP_DIM, B_GROUP_DIM), B_GROUP_DIM ** -0.5),
        'c_rel_bias': nrm(12, (DEPTH, C_HEADS, 2 * C_WIN_ROWS - 1, 2 * C_WIN_COLS - 1), 0.3),
        'd_conv': nrm(13, (DEPTH, D_CONV, 3 * D_W), D_CONV ** -0.5),
        'd_w0': jax.random.uniform(ks[14], (DEPTH, 2, D_W), f32, -5.0, -1.0),
        'd_w2': nrm(15, (DEPTH, 2, D_DECAY_LORA, D_W), 0.1),
        'd_a0': nrm(16, (DEPTH, 2, D_W), 0.2),
        'd_a2': nrm(17, (DEPTH, 2, D_AAA_LORA, D_W), 0.1),
        'd_g2': nrm(18, (DEPTH, D_GATE_LORA, D_W), D_GATE_LORA ** -0.5),
        'd_k_k': 0.85 + nrm(19, (DEPTH, D_W), 0.02),
        'd_k_a': 1.0 + nrm(20, (DEPTH, D_W), 0.02),
        'd_r_k': nrm(21, (DEPTH, D_HEADS, HEAD_DIM), 0.1),
        'd_ln_w': 1.0 + nrm(22, (DEPTH, D_W), 0.02),
        'd_ln_b': nrm(23, (DEPTH, D_W), 0.02),
        'router_w': nrm(24, (DEPTH, dm, N_EXPERTS), dm ** -0.5),
        'router_b': nrm(25, (DEPTH, N_EXPERTS), 0.01),
        'exp_w_gu': nrm(26, (DEPTH, N_EXPERTS, dm, 2 * D_EXPERT), dm ** -0.5),
        'exp_b_gu': nrm(27, (DEPTH, N_EXPERTS, 2 * D_EXPERT), 0.02),
        'exp_w_down': nrm(28, (DEPTH, N_EXPERTS, D_EXPERT, dm), D_EXPERT ** -0.5),
        'exp_b_down': nrm(29, (DEPTH, N_EXPERTS, dm), 0.02),
        'final_norm_g': 1.0 + nrm(30, (dm,), 0.02),
    }


def reference(x, c, ctx, c_ctx, ada_w, ada_b, norm1_g, norm2_g, w_in, w_out, a_sink, b_mix, c_rel_bias, d_conv,
              d_w0, d_w2, d_a0, d_a2, d_g2, d_k_k, d_k_a, d_r_k, d_ln_w, d_ln_b, router_w, router_b, exp_w_gu,
              exp_b_gu, exp_w_down, exp_b_down, final_norm_g):
    cos, sin = axial_rope(x.shape[1])
    silu_c = jax.nn.silu(c)
    silu_cc = jax.nn.silu(c_ctx)
    xc = ctx
    for l in range(DEPTH):
        mod = silu_c @ ada_w[l] + ada_b[l]
        mod_c = silu_cc @ ada_w[l] + ada_b[l]
        x, xc = hybrid_layer(x, xc, mod, mod_c, norm1_g[l], norm2_g[l], w_in[l], w_out[l], a_sink[l], b_mix[l],
                             c_rel_bias[l], d_conv[l], d_w0[l], d_w2[l], d_a0[l], d_a2[l], d_g2[l], d_k_k[l],
                             d_k_a[l], d_r_k[l], d_ln_w[l], d_ln_b[l], router_w[l], router_b[l], exp_w_gu[l],
                             exp_b_gu[l], exp_w_down[l], exp_b_down[l], cos, sin, l < DEPTH - 1)
    return rms_norm(x, final_norm_g)
```

```cpp
#include <hip/hip_runtime.h>
#include <cstdio>
#include <cstdint>

#define LAS __attribute__((address_space(3)))
typedef unsigned short bf16;
typedef float f32x4 __attribute__((ext_vector_type(4)));
typedef float f32x2 __attribute__((ext_vector_type(2)));
typedef short bf16x8 __attribute__((ext_vector_type(8)));
typedef unsigned u32x4 __attribute__((ext_vector_type(4)));
typedef unsigned u32x2 __attribute__((ext_vector_type(2)));

constexpr int DM = 1024, SEQ = 16384, NCTX = 256, ROWS = SEQ + NCTX, DEPTH = 4, GRIDW = 64;
constexpr int INW = 2720, INWP = 2816;
constexpr int C_AQ = 0, C_AK = 256, C_AV = 384, C_BU = 512, C_CQ = 768, C_CK = 1024, C_CV = 1280, C_DR = 1536, C_DK = 1792, C_DV = 2048, C_WL = 2304, C_AL = 2432, C_GL = 2560;
constexpr int NEXP = 32, TOPK = 4;
constexpr int MOE_MAXBLK = 296;
constexpr int MOE_ROWS = MOE_MAXBLK * 256;
constexpr int NWG = 256, NTHR = 512, NWAVES = 8;

constexpr size_t MiB = 1u << 20;
constexpr size_t WS_CTL = 0, CTL_ZERO_BYTES = 1 * MiB;
constexpr size_t WS_MOD = 1 * MiB;
constexpr size_t WS_TW = 2 * MiB;
constexpr size_t WS_MTAB = 3 * MiB;
constexpr size_t WS_XS = 4 * MiB;
constexpr size_t WS_H = 70 * MiB;
constexpr size_t WS_P = 104 * MiB;
constexpr size_t WS_MIX = 194 * MiB;
constexpr size_t WS_FYR = 228 * MiB, WS_FYI = 244 * MiB;
constexpr size_t WS_SC = 260 * MiB;
constexpr size_t WS_YS = 408 * MiB;
constexpr size_t WS_ROUTE = 442 * MiB;
constexpr size_t WS_CNT = 444 * MiB;
constexpr size_t WS_XG = 446 * MiB;
constexpr size_t WS_ACT = 596 * MiB;
constexpr size_t WS_WIN = 746 * MiB;
constexpr size_t WS_WOUT = 768 * MiB;
constexpr size_t WS_WGU = 776 * MiB;
constexpr size_t WS_WDN = 1288 * MiB;
constexpr size_t WS_END = 1544 * MiB;
static_assert(WS_XS + (size_t)ROWS * DM * 4 <= WS_H && WS_H + (size_t)ROWS * DM * 2 <= WS_P && WS_P + (size_t)ROWS * INWP * 2 <= WS_MIX && WS_MIX + (size_t)ROWS * DM * 2 <= WS_FYR, "ws map 1");
static_assert(WS_SC + (size_t)ROWS * 9 * 256 * 4 <= WS_YS && WS_YS + (size_t)2 * ROWS * 256 * 4 <= WS_ROUTE && WS_XG + (size_t)MOE_ROWS * DM * 2 <= WS_ACT && WS_ACT + (size_t)MOE_ROWS * DM * 2 <= WS_WIN, "ws map 2");
static_assert(WS_WIN + (size_t)4 * INWP * DM * 2 <= WS_WOUT && WS_WGU + (size_t)4 * 32 * 2048 * 1024 * 2 <= WS_WDN && WS_WDN + (size_t)4 * 32 * 1024 * 1024 * 2 <= WS_END, "ws map 3");
constexpr int CW_BAR = 4096;

constexpr int RING_BYTES = 131072;
constexpr int MISC_OFF = RING_BYTES;
constexpr int LDS_BYTES = 147456;

__device__ __forceinline__ unsigned f2bf(float f) { unsigned u = __builtin_bit_cast(unsigned, f); return (u + 0x7fffu + ((u >> 16) & 1u)) >> 16; }
__device__ __forceinline__ unsigned pk2(float lo, float hi) { return f2bf(lo) | (f2bf(hi) << 16); }
__device__ __forceinline__ float bf2f(unsigned short b) { return __builtin_bit_cast(float, (unsigned)b << 16); }
__device__ __forceinline__ float bflo(unsigned w) { return __builtin_bit_cast(float, w << 16); }
__device__ __forceinline__ float bfhi(unsigned w) { return __builtin_bit_cast(float, w & 0xffff0000u); }
__device__ __forceinline__ float wave_sum(float v) {
#pragma unroll
    for (int o = 1; o < 64; o <<= 1) v += __shfl_xor(v, o);
    return v;
}
__device__ __forceinline__ float sigmoidf_(float x) { return 1.f / (1.f + __expf(-x)); }
#define LDS_WAIT() asm volatile("s_waitcnt lgkmcnt(0)" ::: "memory")
#define VM_WAIT() asm volatile("s_waitcnt vmcnt(0)" ::: "memory")

namespace pg8 {
#define PG8_LAS __attribute__((address_space(3)))
typedef unsigned short bf16_t;
constexpr int BM = 256, BK = 64, HALF = 128, HTB = HALF * BK * 2, STAGE_BYTES = 8 * HTB, NXCD = 8, WGM = 8;
__host__ __device__ __forceinline__ int lds_byte(int r, int c) { const int st = (r >> 4) * 2 + (c >> 5), rr = r & 15, cc = c & 31, ob = rr * 64 + cc * 2; return st * 1024 + (ob ^ (((ob >> 9) & 1) << 5)); }
__host__ __device__ __forceinline__ void stage_rc(int b, int& R, int& C) { const int st = b / 1024, sb = b % 1024, swz = sb ^ (((sb >> 9) & 1) << 5); R = (st >> 1) * 16 + swz / 64; C = (st & 1) * 32 + (swz % 64) / 2; }
__host__ __device__ __forceinline__ int perm32(int rho) { const int n = rho >> 4, i = rho & 15; return 8 * (i >> 2) + 4 * n + (i & 3); }
struct Unit { int pm, pn, e; };
__device__ __forceinline__ unsigned cvt_pk_bf16(float lo, float hi) { unsigned r; asm volatile("v_cvt_pk_bf16_f32 %0, %1, %2" : "=v"(r) : "v"(lo), "v"(hi)); return r; }

struct StaticOrder {
    const char* A; const char* Bt; size_t tstep;
    int nM, nN, nwg, G, c;
    __device__ void init(const void* A_, const void* Bt_, int M, int N, int K, int G_, int c_) { A = (const char*)A_; Bt = (const char*)Bt_; tstep = (size_t)BM * K * 2; nM = M / BM; nN = N / BM; nwg = nM * nN; G = G_; c = c_; }
    __device__ bool next(int i, Unit& u) const {
        const long L = (long)i * G + c; if (L >= nwg) return false;
        int wgid = (int)L; { const int q = nwg / NXCD, r = nwg % NXCD, xcd = wgid % NXCD, off = wgid / NXCD; wgid = (xcd < r ? xcd * (q + 1) : r * (q + 1) + (xcd - r) * q) + off; }
        const int nig = WGM * nN, gid = wgid / nig, fm = gid * WGM, gsz = (nM - fm) < WGM ? (nM - fm) : WGM;
        u.pm = fm + ((wgid % nig) % gsz); u.pn = (wgid % nig) / gsz; u.e = 0; return true;
    }
    __device__ __forceinline__ const char* pa(const Unit& u) const { return A + (size_t)u.pm * tstep; }
    __device__ __forceinline__ const char* pb(const Unit& u) const { return Bt + (size_t)u.pn * tstep; }
};
struct MoeOrder {
    const char* A; const char* Bt; size_t tstep, estep;
    const LAS unsigned char* blk_e; int nblk, nN, G, c;
    __device__ bool next(int i, Unit& u) const {
        const int L = i * G + c; if (L >= nblk * nN) return false;
        u.pm = L / nN; u.pn = L % nN; u.e = __builtin_amdgcn_readfirstlane((int)blk_e[u.pm]); return true;
    }
    __device__ __forceinline__ const char* pa(const Unit& u) const { return A + (size_t)u.pm * tstep; }
    __device__ __forceinline__ const char* pb(const Unit& u) const { return Bt + (size_t)u.e * estep + (size_t)u.pn * tstep; }
};

struct EpiStoreBf16 {
    static constexpr bool PERM = true;
    bf16_t* O; int ldc; const float* bias; int bias_estride;
    __device__ __forceinline__ void init(f32x4 (&acc)[2][2][4][2], const Unit& u, int wc, int fq) const {
        const int col0 = u.pn * BM + wc * 32 + 8 * fq;
#pragma unroll
        for (int b = 0; b < 2; ++b)
#pragma unroll
            for (int n = 0; n < 2; ++n) { const f32x4 bv = bias ? *(const f32x4*)(bias + (size_t)u.e * bias_estride + col0 + b * HALF + 4 * n) : (f32x4){0.f, 0.f, 0.f, 0.f};
#pragma unroll
                for (int a = 0; a < 2; ++a)
#pragma unroll
                    for (int m = 0; m < 4; ++m) acc[a][b][m][n] = bv; }
    }
    __device__ __forceinline__ void operator()(const f32x4 (&acc)[2][2][4][2], const Unit& u, int wr, int wc, int fr, int fq) const {
        const int row0 = u.pm * BM + wr * 64 + fr, col0 = u.pn * BM + wc * 32 + 8 * fq;
#pragma unroll
        for (int ai = 0; ai < 2; ++ai)
#pragma unroll
            for (int m = 0; m < 4; ++m) { bf16_t* rowp = O + (size_t)(row0 + ai * HALF + m * 16) * ldc + col0;
#pragma unroll
                for (int bj = 0; bj < 2; ++bj) { const f32x4 v0 = acc[ai][bj][m][0], v1 = acc[ai][bj][m][1];
                    u32x4 w; w.x = cvt_pk_bf16(v0[0], v0[1]); w.y = cvt_pk_bf16(v0[2], v0[3]); w.z = cvt_pk_bf16(v1[0], v1[1]); w.w = cvt_pk_bf16(v1[2], v1[3]);
                    *(u32x4*)(rowp + bj * HALF) = w; } }
    }
};
__device__ __forceinline__ float swiglu1(float g, float up) {
    g = fminf(g, 7.0f); up = fminf(fmaxf(up, -7.0f), 7.0f);
    return g * (1.f / (1.f + __expf(-1.702f * g))) * (up + 1.0f);
}
struct EpiSwiglu {
    static constexpr bool PERM = true;
    bf16_t* O; int ldc; const float* bias; int bias_estride;
    __device__ __forceinline__ void init(f32x4 (&acc)[2][2][4][2], const Unit& u, int wc, int fq) const {
        const int col0 = u.pn * BM + wc * 32 + 8 * fq;
#pragma unroll
        for (int b = 0; b < 2; ++b)
#pragma unroll
            for (int n = 0; n < 2; ++n) { const f32x4 bv = bias ? *(const f32x4*)(bias + (size_t)u.e * bias_estride + col0 + b * HALF + 4 * n) : (f32x4){0.f, 0.f, 0.f, 0.f};
#pragma unroll
                for (int a = 0; a < 2; ++a)
#pragma unroll
                    for (int m = 0; m < 4; ++m) acc[a][b][m][n] = bv; }
    }
    __device__ __forceinline__ void operator()(const f32x4 (&acc)[2][2][4][2], const Unit& u, int wr, int wc, int fr, int fq) const {
        const int row0 = u.pm * BM + wr * 64 + fr, col0 = u.pn * BM + wc * 32 + 8 * fq;
#pragma unroll
        for (int ai = 0; ai < 2; ++ai)
#pragma unroll
            for (int m = 0; m < 4; ++m) { bf16_t* rowp = O + (size_t)(row0 + ai * HALF + m * 16) * ldc + (col0 >> 1);
#pragma unroll
                for (int bj = 0; bj < 2; ++bj) { const f32x4 v0 = acc[ai][bj][m][0], v1 = acc[ai][bj][m][1];
                    u32x2 w; w.x = cvt_pk_bf16(swiglu1(v0[0], v0[1]), swiglu1(v0[2], v0[3])); w.y = cvt_pk_bf16(swiglu1(v1[0], v1[1]), swiglu1(v1[2], v1[3]));
                    *(u32x2*)(rowp + bj * (HALF / 2)) = w; } }
    }
};
struct EpiResidual {
    static constexpr bool PERM = false;
    float* X; int ldc; const float* gate_lat; const float* gate_ctx;
    __device__ __forceinline__ void init(f32x4 (&acc)[2][2][4][2], const Unit& u, int wc, int fq) const {
#pragma unroll
        for (int a = 0; a < 2; ++a)
#pragma unroll
            for (int b = 0; b < 2; ++b)
#pragma unroll
                for (int m = 0; m < 4; ++m)
#pragma unroll
                    for (int n = 0; n < 2; ++n) acc[a][b][m][n] = (f32x4){0.f, 0.f, 0.f, 0.f};
    }
    __device__ __forceinline__ void operator()(const f32x4 (&acc)[2][2][4][2], const Unit& u, int wr, int wc, int fr, int fq) const {
        const int row0 = u.pm * BM + wr * 64 + fr, col0 = u.pn * BM + wc * 32 + 4 * fq;
        const float* gp = (u.pm == 0) ? gate_ctx : gate_lat;
        f32x4 gv[2][2];
#pragma unroll
        for (int bj = 0; bj < 2; ++bj)
#pragma unroll
            for (int n = 0; n < 2; ++n) gv[bj][n] = *(const f32x4*)(gp + col0 + bj * HALF + n * 16);
#pragma unroll
        for (int ai = 0; ai < 2; ++ai)
#pragma unroll
            for (int m = 0; m < 4; ++m) { float* rowp = X + (size_t)(row0 + ai * HALF + m * 16) * ldc + col0;
#pragma unroll
                for (int bj = 0; bj < 2; ++bj)
#pragma unroll
                    for (int n = 0; n < 2; ++n) { f32x4* p = (f32x4*)(rowp + bj * HALF + n * 16); *p = *p + gv[bj][n] * acc[ai][bj][m][n]; } }
    }
};
template <class Epi, class Sched, bool ALIGN_EPI = false, bool SP2 = false>
__device__ __forceinline__ void gemm_phase(PG8_LAS unsigned char* lds, const int K, const Sched& S, const Epi& E) {
    const int tid = threadIdx.x, wid = __builtin_amdgcn_readfirstlane(tid >> 6), lane = tid & 63, wr = wid >> 2, wc = wid & 3, fr = lane & 15, fq = lane >> 4;
    const int nt = K / BK;
    unsigned voffA[2], voffB[2];
#pragma unroll
    for (int i = 0; i < 2; ++i) { int R, C; stage_rc(tid * 16 + i * 8192, R, C); const int Rb = Epi::PERM ? ((R & ~31) + perm32(R & 31)) : R;
        voffA[i] = (unsigned)(R * K + C) * 2u; voffB[i] = (unsigned)(Rb * K + C) * 2u; }
    const size_t kstep = (size_t)(BK * 2);
    const size_t hstep = (size_t)HALF * K * 2;
        const unsigned ldsw = (unsigned)wid * 1024u;
    const int aoff = lds_byte(wr * 64 + fr, fq * 8), boff = lds_byte(wc * 32 + fr, fq * 8);
#define PG8_SA(b, h) (((b) * 2 + (h)) * HTB)
#define PG8_SB(b, h) ((4 + (b) * 2 + (h)) * HTB)
#define PG8_STAGE(bufoff, gbase, voff) do { _Pragma("unroll") for (int _i = 0; _i < 2; ++_i) \
        __builtin_amdgcn_global_load_lds((const unsigned*)((const char*)(gbase) + (voff)[_i]), (PG8_LAS unsigned*)(lds + (bufoff) + ldsw + _i * 8192), 16, 0, 0); } while (0)
#define PG8_LDA(dst, b, h) do { _Pragma("unroll") for (int m = 0; m < 4; ++m) _Pragma("unroll") for (int k = 0; k < 2; ++k) dst[m][k] = *(const PG8_LAS bf16x8*)(lds + PG8_SA(b, h) + aoff + m * 2048 + k * 1024); } while (0)
#define PG8_LDB(dst, b, h) do { _Pragma("unroll") for (int n = 0; n < 2; ++n) _Pragma("unroll") for (int k = 0; k < 2; ++k) dst[n][k] = *(const PG8_LAS bf16x8*)(lds + PG8_SB(b, h) + boff + n * 2048 + k * 1024); } while (0)
#define PG8_MMA(ai, bj, At, Bt) do { __builtin_amdgcn_s_setprio(1); _Pragma("unroll") for (int m = 0; m < 4; ++m) _Pragma("unroll") for (int n = 0; n < 2; ++n) _Pragma("unroll") for (int k = 0; k < 2; ++k) \
        acc[ai][bj][m][n] = __builtin_amdgcn_mfma_f32_16x16x32_bf16(Bt[n][k], At[m][k], acc[ai][bj][m][n], 0, 0, 0); __builtin_amdgcn_s_setprio(0); } while (0)
#define PG8_WAIT_V(n) asm volatile("s_waitcnt vmcnt(" #n ")" ::: "memory")
#define PG8_WAIT_L(n) asm volatile("s_waitcnt lgkmcnt(" #n ")" ::: "memory")
#define PG8_BAR __builtin_amdgcn_s_barrier()
#define PG8_SCHED __builtin_amdgcn_sched_barrier(0)
    Unit cur, nxt; int ui = 0;
    if (!S.next(0, cur)) return;
    f32x4 acc[2][2][4][2];
    E.init(acc, cur, wc, fq);
    bf16x8 At[4][2], B0[2][2], B1[2][2];
    const char* cA = S.pa(cur); const char* cB = S.pb(cur);
    if constexpr (SP2) {
        PG8_STAGE(PG8_SB(0, 0), cB, voffB); PG8_STAGE(PG8_SB(0, 1), cB + hstep, voffB); PG8_STAGE(PG8_SA(0, 0), cA, voffA); PG8_STAGE(PG8_SA(0, 1), cA + hstep, voffA);
        if (wr == 1) PG8_BAR;
        PG8_WAIT_V(2); PG8_BAR;
        PG8_STAGE(PG8_SB(1, 0), cB + kstep, voffB); PG8_STAGE(PG8_SA(1, 0), cA + kstep, voffA); PG8_STAGE(PG8_SB(1, 1), cB + hstep + kstep, voffB);
        PG8_WAIT_V(6); PG8_BAR;
    } else {
        PG8_STAGE(PG8_SB(0, 0), cB, voffB); PG8_STAGE(PG8_SA(0, 0), cA, voffA); PG8_STAGE(PG8_SB(0, 1), cB + hstep, voffB); PG8_STAGE(PG8_SA(0, 1), cA + hstep, voffA);
        if (wr == 1) PG8_BAR;
        PG8_WAIT_V(4); PG8_BAR;
        PG8_STAGE(PG8_SB(1, 0), cB + kstep, voffB); PG8_STAGE(PG8_SA(1, 0), cA + kstep, voffA); PG8_STAGE(PG8_SB(1, 1), cB + hstep + kstep, voffB);
        PG8_WAIT_V(6); PG8_BAR;
    }
    for (;;) {
        const bool has_next = S.next(ui + 1, nxt);
        const char* nA = has_next ? S.pa(nxt) : cA; const char* nB = has_next ? S.pb(nxt) : cB;
        for (int t = 0; t < nt; t += 2) {
            const bool last = (t == nt - 2);
            const char* a1 = cA + (size_t)(t + 1) * kstep;
            const char* a2 = last ? nA : cA + (size_t)(t + 2) * kstep; const char* b2 = last ? nB : cB + (size_t)(t + 2) * kstep;
            const char* a3 = a2 + kstep; const char* b3 = b2 + kstep;
            if constexpr (SP2) {
            PG8_LDB(B0, 0, 0); PG8_LDB(B1, 0, 1); PG8_SCHED; PG8_LDA(At, 0, 0); PG8_STAGE(PG8_SA(1, 1), a1 + hstep, voffA);
            PG8_WAIT_V(8); PG8_WAIT_L(0); PG8_BAR; PG8_MMA(0, 0, At, B0); PG8_MMA(0, 1, At, B1); PG8_BAR; PG8_SCHED;
            PG8_LDA(At, 0, 1); PG8_STAGE(PG8_SB(0, 0), b2, voffB); PG8_STAGE(PG8_SB(0, 1), b2 + hstep, voffB); PG8_STAGE(PG8_SA(0, 0), a2, voffA);
            PG8_WAIT_V(8); PG8_WAIT_L(0); PG8_BAR; PG8_MMA(1, 0, At, B0); PG8_MMA(1, 1, At, B1); PG8_BAR; PG8_SCHED;
            PG8_LDB(B0, 1, 0); PG8_LDB(B1, 1, 1); PG8_SCHED; PG8_LDA(At, 1, 0); PG8_STAGE(PG8_SA(0, 1), a2 + hstep, voffA);
            PG8_WAIT_V(8); PG8_WAIT_L(0); PG8_BAR; PG8_MMA(0, 0, At, B0); PG8_MMA(0, 1, At, B1); PG8_BAR; PG8_SCHED;
            PG8_LDA(At, 1, 1); PG8_STAGE(PG8_SB(1, 0), b3, voffB); PG8_STAGE(PG8_SB(1, 1), b3 + hstep, voffB); PG8_STAGE(PG8_SA(1, 0), a3, voffA);
            PG8_WAIT_V(8); PG8_WAIT_L(0); PG8_BAR; PG8_MMA(1, 0, At, B0); PG8_MMA(1, 1, At, B1); PG8_BAR; PG8_SCHED;
            } else {
            PG8_LDB(B0, 0, 0); PG8_SCHED; PG8_LDA(At, 0, 0); PG8_STAGE(PG8_SA(1, 1), a1 + hstep, voffA);
            PG8_WAIT_L(8); PG8_BAR; PG8_WAIT_L(0); PG8_MMA(0, 0, At, B0); PG8_BAR; PG8_SCHED;
            PG8_LDB(B1, 0, 1); PG8_STAGE(PG8_SB(0, 0), b2, voffB);
            PG8_BAR; PG8_WAIT_L(0); PG8_MMA(0, 1, At, B1); PG8_BAR;
            PG8_LDA(At, 0, 1); PG8_STAGE(PG8_SA(0, 0), a2, voffA);
            PG8_BAR; PG8_WAIT_L(0); PG8_MMA(1, 0, At, B0); PG8_BAR; PG8_SCHED;
            PG8_STAGE(PG8_SB(0, 1), b2 + hstep, voffB);
            PG8_WAIT_V(6); PG8_BAR; PG8_MMA(1, 1, At, B1); PG8_BAR;
            PG8_LDB(B0, 1, 0); PG8_SCHED; PG8_LDA(At, 1, 0); PG8_STAGE(PG8_SA(0, 1), a2 + hstep, voffA);
            PG8_WAIT_L(8); PG8_BAR; PG8_WAIT_L(0); PG8_MMA(0, 0, At, B0); PG8_BAR; PG8_SCHED;
            PG8_LDB(B1, 1, 1); PG8_STAGE(PG8_SB(1, 0), b3, voffB);
            PG8_BAR; PG8_WAIT_L(0); PG8_MMA(0, 1, At, B1); PG8_BAR;
            PG8_LDA(At, 1, 1); PG8_STAGE(PG8_SA(1, 0), a3, voffA);
            PG8_BAR; PG8_WAIT_L(0); PG8_MMA(1, 0, At, B0); PG8_BAR; PG8_SCHED;
            PG8_STAGE(PG8_SB(1, 1), b3 + hstep, voffB);
            PG8_WAIT_V(6); PG8_BAR; PG8_MMA(1, 1, At, B1); PG8_BAR;
            }
        }
        if constexpr (ALIGN_EPI) { if (wr == 0) PG8_BAR; }
        E(acc, cur, wr, wc, fr, fq);
        if (!has_next) break;
        E.init(acc, nxt, wc, fq);
        cur = nxt; cA = nA; cB = nB; ++ui;
        if constexpr (ALIGN_EPI) { if (wr == 1) PG8_BAR; }
    }
    PG8_WAIT_V(0);
    if constexpr (!ALIGN_EPI) { if (wr == 0) PG8_BAR; }
    PG8_BAR;
#undef PG8_SA
#undef PG8_SB
#undef PG8_STAGE
#undef PG8_LDA
#undef PG8_LDB
#undef PG8_MMA
#undef PG8_WAIT_V
#undef PG8_WAIT_L
#undef PG8_BAR
#undef PG8_SCHED
}
}

#define XB_TMO      128
#define XB_XCNT(j)  (256  + 64 * (j))
#define XB_XSUB(j)  (1280 + 64 * (j))
#define XB_XGEN(j)  (2304 + 64 * (j))
#define XB_TOP      3328
#define XB_TOPGEN   3392
#define XCD_BAR_WORDS 3456
#define XB_SPIN_CAP (1u << 18)
__device__ __forceinline__ unsigned xb_ld(unsigned* p)              { return __hip_atomic_load(p, __ATOMIC_RELAXED, __HIP_MEMORY_SCOPE_AGENT); }
__device__ __forceinline__ unsigned xb_add(unsigned* p, unsigned v) { return __hip_atomic_fetch_add(p, v, __ATOMIC_RELAXED, __HIP_MEMORY_SCOPE_AGENT); }
__device__ __forceinline__ unsigned xb_xcc_id() { return (unsigned)__builtin_amdgcn_s_getreg((3 << 11) | 20) & 0xFu; }
#define XB_SPIN(cond, bar) do { unsigned _sp = 0; while (cond) { __builtin_amdgcn_s_sleep(1); \
    if ((++_sp & 255u) == 0u) { if (xb_ld(&(bar)[XB_TMO])) break; if (_sp > XB_SPIN_CAP) { atomicAdd(&(bar)[XB_TMO], 1u); break; } } } } while (0)

struct XcdBarrier {
    unsigned* bar; unsigned x;
    volatile LAS unsigned* st;
};

__device__ __forceinline__ XcdBarrier xcd_barrier_post(unsigned* bar, volatile LAS unsigned* st) {
    XcdBarrier b; b.bar = bar; b.x = xb_xcc_id(); b.st = st;
    if (threadIdx.x == 0) (void)xb_add(&bar[XB_XCNT(b.x)], 1u);
    return b;
}
__device__ __forceinline__ void xcd_barrier_complete(unsigned* bar, unsigned x, unsigned& nloc, unsigned& nx) {
    const unsigned G = gridDim.x * gridDim.y * gridDim.z;
    unsigned sum, cnt, mine, sp = 0u;
    for (;;) {
        sum = 0u; cnt = 0u; mine = 0u;
#pragma unroll
        for (unsigned j = 0; j < 16; ++j) { const unsigned c = xb_ld(&bar[XB_XCNT(j)]); sum += c; cnt += (c > 0u) ? 1u : 0u; mine = (j == x) ? c : mine; }
        if (sum == G) break;
        __builtin_amdgcn_s_sleep(1);
        if ((++sp & 255u) == 0u) { if (xb_ld(&bar[XB_TMO])) break; if (sp > XB_SPIN_CAP) { atomicAdd(&bar[XB_TMO], 1u); break; } }
    }
    nloc = mine > 0u ? mine : 1u; nx = cnt > 0u ? cnt : 1u;
}

__device__ __forceinline__ void xcd_barrier(const XcdBarrier& b) {
    asm volatile("s_waitcnt vmcnt(0)" ::: "memory");
    __syncthreads();
    if (threadIdx.x == 0) {
        unsigned* bar = b.bar;
        __builtin_amdgcn_s_waitcnt(0);
        unsigned nloc = b.st[0], nx = b.st[1];
        if (nloc == 0u) { xcd_barrier_complete(bar, b.x, nloc, nx); b.st[0] = nloc; b.st[1] = nx; }
        const unsigned old = xb_add(&bar[XB_XSUB(b.x)], 1u);
        const unsigned gen = old / nloc;
        if (old + 1u == (gen + 1u) * nloc) {
            __builtin_amdgcn_fence(__ATOMIC_RELEASE, "agent");
            asm volatile("s_waitcnt vmcnt(0)" ::: "memory");
            const unsigned og = xb_add(&bar[XB_TOP], 1u);
            const unsigned tg = og / nx;
            if (og + 1u == (tg + 1u) * nx) xb_add(&bar[XB_TOPGEN], 1u);
            else XB_SPIN(xb_ld(&bar[XB_TOPGEN]) == tg, bar);
            __builtin_amdgcn_fence(__ATOMIC_ACQUIRE, "agent");
            xb_add(&bar[XB_XGEN(b.x)], 1u);
            asm volatile("s_waitcnt vmcnt(0)" ::: "memory");
        } else {
            XB_SPIN(xb_ld(&bar[XB_XGEN(b.x)]) == gen, bar);
            __builtin_amdgcn_fence(__ATOMIC_ACQUIRE, "agent");
            asm volatile("s_waitcnt vmcnt(0)" ::: "memory");
        }
    }
    __syncthreads();
}

struct Args {
    const float* in[31];
    float* out; unsigned char* ws;
    int ph_lo, ph_hi, use_bar, pad;
};
enum InIdx { I_X = 0, I_C, I_CTX, I_CCTX, I_ADAW, I_ADAB, I_N1G, I_N2G, I_WIN, I_WOUT, I_ASINK, I_BMIX, I_CREL, I_DCONV, I_DW0, I_DW2, I_DA0, I_DA2, I_DG2, I_DKK, I_DKA, I_DRK, I_DLNW, I_DLNB,
             I_RW, I_RB, I_WGU, I_BGU, I_WDN, I_BDN, I_FNG };
constexpr int NPL = 10;
constexpr int PH_TOTAL = 1 + DEPTH * NPL + 1;

struct Ctx {
    LAS unsigned char* lds;
    int tid, lane, wave, wg, G, gw, NGW;
    unsigned char* ws;
};

__device__ __forceinline__ void transpose_item(const float* W, int K, int N, bf16* WT, LAS float* scr, int item, int lane) {
    const int nblk = N / 32, kb = item / nblk, nb = item % nblk, k0 = 64 * kb, n0 = 32 * nb;
#pragma unroll 8
    for (int i = 0; i < 32; ++i) { const int kk = 2 * i + (lane >> 5); scr[kk * 33 + (lane & 31)] = W[(size_t)(k0 + kk) * N + n0 + (lane & 31)]; }
    LDS_WAIT(); asm volatile("" ::: "memory");
    const int c = lane & 7;
#pragma unroll
    for (int j = 0; j < 4; ++j) { const int n = (lane >> 3) + 8 * j; const LAS float* s = scr + (8 * c) * 33 + n;
        u32x4 o; o.x = pk2(s[0 * 33], s[1 * 33]); o.y = pk2(s[2 * 33], s[3 * 33]); o.z = pk2(s[4 * 33], s[5 * 33]); o.w = pk2(s[6 * 33], s[7 * 33]);
        *(u32x4*)(WT + (size_t)(n0 + n) * K + k0 + 8 * c) = o; }
    LDS_WAIT(); asm volatile("" ::: "memory");
}
__device__ __forceinline__ void phase_prologue(const Ctx& C, const Args& a) {
    LAS float* scr = (LAS float*)(C.lds + C.wave * 16384);
    constexpr int IT_IN = 16 * (INW / 32), IT_OUT = 16 * 32, IT_GU = 16 * 64, IT_DN = 16 * 32;
    constexpr long N_IN = 4L * IT_IN, N_OUT = 4L * IT_OUT, N_GU = 128L * IT_GU, N_DN = 128L * IT_DN, N_ALL = N_IN + N_OUT + N_GU + N_DN;
    for (long it = C.gw; it < N_ALL; it += C.NGW) {
        long r = it;
        if (r < N_IN) { const int l = (int)(r / IT_IN); transpose_item(a.in[I_WIN] + (size_t)l * DM * INW, DM, INW, (bf16*)(C.ws + WS_WIN) + (size_t)l * INWP * DM, scr, (int)(r % IT_IN), C.lane); continue; } r -= N_IN;
        if (r < N_OUT) { const int l = (int)(r / IT_OUT); transpose_item(a.in[I_WOUT] + (size_t)l * DM * DM, DM, DM, (bf16*)(C.ws + WS_WOUT) + (size_t)l * DM * DM, scr, (int)(r % IT_OUT), C.lane); continue; } r -= N_OUT;
        if (r < N_GU) { const int le = (int)(r / IT_GU); transpose_item(a.in[I_WGU] + (size_t)le * DM * 2048, DM, 2048, (bf16*)(C.ws + WS_WGU) + (size_t)le * 2048 * DM, scr, (int)(r % IT_GU), C.lane); continue; } r -= N_GU;
        { const int le = (int)(r / IT_DN); transpose_item(a.in[I_WDN] + (size_t)le * DM * DM, DM, DM, (bf16*)(C.ws + WS_WDN) + (size_t)le * DM * DM, scr, (int)(r % IT_DN), C.lane); }
    }
    { const int gt = C.wg * NTHR + C.tid; constexpr int PADN = (INWP - INW) * DM / 8;
      for (int i = gt; i < 4 * PADN; i += C.G * NTHR) { const int l = i / PADN, r = i % PADN; *((u32x4*)((bf16*)(C.ws + WS_WIN) + ((size_t)l * INWP + INW) * DM) + r) = (u32x4){0u, 0u, 0u, 0u}; } }
    { float* tw = (float*)(C.ws + WS_TW); const int gt = C.wg * NTHR + C.tid;
      for (int i = gt; i < 16384; i += C.G * NTHR) { const float x = (float)i * (1.0f / 8192.0f); tw[i] = cospif(x); tw[16384 + i] = sinpif(x); } }
    { float* mt = (float*)(C.ws + WS_MTAB); const int gt = C.wg * NTHR + C.tid;
      for (int i = gt; i < 4 * 4 * 64 * 64; i += C.G * NTHR) { const int e = i & 63, c = (i >> 6) & 63, g = (i >> 12) & 3, l = i >> 14;
          const float* w = a.in[I_BMIX] + ((size_t)(l * 4 + g) * 64) * 64 + e; float sc = 0.f, ss = 0.f;
          for (int cp = 0; cp < 64; ++cp) { const float x = (float)((c * cp) & 63) * (1.0f / 32.0f); const float wv = w[cp * 64]; sc += cospif(x) * wv; ss += sinpif(x) * wv; }
          mt[((size_t)(l * 2 + 0) * 4 + g) * 4096 + c * 64 + e] = sc; mt[((size_t)(l * 2 + 1) * 4 + g) * 4096 + c * 64 + e] = ss; } }
    { LAS float* red = (LAS float*)(C.lds);
      __syncthreads();
      float* mod = (float*)(C.ws + WS_MOD);
      for (int u = C.wg; u < 4 * 24; u += C.G) { const int l = u / 24, jb = u % 24, j0 = jb * 256 + 4 * C.lane;
          f32x4 s0 = {0.f, 0.f, 0.f, 0.f}, s1 = {0.f, 0.f, 0.f, 0.f};
          const float* w = a.in[I_ADAW] + (size_t)l * DM * 6144 + j0;
          for (int k = C.wave * 128; k < C.wave * 128 + 128; ++k) { const float c0 = a.in[I_C][k], c1 = a.in[I_CCTX][k]; const float a0 = c0 * sigmoidf_(c0), a1 = c1 * sigmoidf_(c1);
              const f32x4 wv = *(const f32x4*)(w + (size_t)k * 6144); s0 += wv * a0; s1 += wv * a1; }
          *(LAS f32x4*)(red + ((C.wave * 2 + 0) * 64 + C.lane) * 4) = s0; *(LAS f32x4*)(red + ((C.wave * 2 + 1) * 64 + C.lane) * 4) = s1;
          __syncthreads();
          if (C.tid < 512) { const int v = C.tid >> 8, j = C.tid & 255; float s = 0.f;
#pragma unroll
              for (int wv = 0; wv < 8; ++wv) s += red[(wv * 2 + v) * 256 + j];
              mod[(size_t)(l * 2 + v) * 6144 + jb * 256 + j] = s + a.in[I_ADAB][(size_t)l * 6144 + jb * 256 + j]; }
          __syncthreads(); } }
}

__device__ __forceinline__ void load_row(const float* p, int lane, f32x4 (&v)[4]) {
#pragma unroll
    for (int j = 0; j < 4; ++j) v[j] = *((const f32x4*)p + lane + 64 * j);
}
__device__ __forceinline__ void moe_combine_row(const Ctx& C, int row, f32x4 (&v)[4], const float* gt2) {
    const int* dest = (const int*)(C.ws + WS_ROUTE) + (size_t)3 * ROWS * 4; const float* gate = (const float*)(C.ws + WS_ROUTE) + (size_t)1 * ROWS * 4;
    const bf16* YB = (const bf16*)(C.ws + WS_XG);
    f32x4 s[4];
#pragma unroll
    for (int j = 0; j < 4; ++j) s[j] = (f32x4){0.f, 0.f, 0.f, 0.f};
#pragma unroll
    for (int k = 0; k < 4; ++k) { const int d = dest[row * 4 + k]; const float g = gate[row * 4 + k]; const u32x2* yp = (const u32x2*)(YB + (size_t)d * DM) + C.lane;
#pragma unroll
        for (int j = 0; j < 4; ++j) { const u32x2 w = yp[64 * j]; s[j] += (f32x4){bflo(w.x), bfhi(w.x), bflo(w.y), bfhi(w.y)} * g; } }
#pragma unroll
    for (int j = 0; j < 4; ++j) v[j] += *((const f32x4*)gt2 + C.lane + 64 * j) * s[j];
}
__device__ __forceinline__ float row_rstd(const f32x4 (&v)[4]) {
    float s = 0.f;
#pragma unroll
    for (int j = 0; j < 4; ++j) s += (v[j].x * v[j].x + v[j].y * v[j].y) + (v[j].z * v[j].z + v[j].w * v[j].w);
    return rsqrtf(wave_sum(s) * (1.f / DM) + 1e-6f);
}
__device__ __forceinline__ void phase_norm1(const Ctx& C, const Args& a, int l) {
    float* XS = (float*)(C.ws + WS_XS); bf16* H = (bf16*)(C.ws + WS_H); const float* mod = (const float*)(C.ws + WS_MOD);
    const float* g1 = a.in[I_N1G] + (size_t)l * DM;
    for (int row = C.gw; row < ROWS; row += C.NGW) {
        const bool isctx = row < NCTX; f32x4 v[4];
        if (l == 0) { load_row(isctx ? a.in[I_CTX] + (size_t)row * DM : a.in[I_X] + (size_t)(row - NCTX) * DM, C.lane, v); }
        else { load_row(XS + (size_t)row * DM, C.lane, v);
               if (!(l == DEPTH && isctx)) moe_combine_row(C, row, v, mod + (size_t)((l - 1) * 2 + (isctx ? 1 : 0)) * 6144 + 5 * DM); }
        if (l == 0 || true) {
#pragma unroll
            for (int j = 0; j < 4; ++j) *((f32x4*)(XS + (size_t)row * DM) + C.lane + 64 * j) = v[j]; }
        const float rstd = row_rstd(v);
        const float* md = mod + (size_t)(l * 2 + (isctx ? 1 : 0)) * 6144;
        u32x2* o = (u32x2*)(H + (size_t)row * DM) + C.lane;
#pragma unroll
        for (int j = 0; j < 4; ++j) { const f32x4 g = *((const f32x4*)g1 + C.lane + 64 * j), sh = *((const f32x4*)md + C.lane + 64 * j), sc = *((const f32x4*)(md + DM) + C.lane + 64 * j);
            const f32x4 y = v[j] * rstd * g * (sc + 1.0f) + sh; u32x2 w; w.x = pk2(y.x, y.y); w.y = pk2(y.z, y.w); o[64 * j] = w; }
    }
}
__device__ __forceinline__ void phase_final(const Ctx& C, const Args& a) {
    const float* XS = (const float*)(C.ws + WS_XS); const float* mod = (const float*)(C.ws + WS_MOD); const float* g = a.in[I_FNG];
    for (int row = NCTX + C.gw; row < ROWS; row += C.NGW) {
        f32x4 v[4]; load_row(XS + (size_t)row * DM, C.lane, v);
        moe_combine_row(C, row, v, mod + (size_t)((DEPTH - 1) * 2 + 0) * 6144 + 5 * DM);
        const float rstd = row_rstd(v);
        float* o = a.out + (size_t)(row - NCTX) * DM;
#pragma unroll
        for (int j = 0; j < 4; ++j) *((f32x4*)o + C.lane + 64 * j) = v[j] * rstd * *((const f32x4*)g + C.lane + 64 * j);
    }
}
__device__ __forceinline__ void phase_norm2(const Ctx& C, const Args& a, int l) {
    const float* XS = (const float*)(C.ws + WS_XS); bf16* H = (bf16*)(C.ws + WS_H); const float* mod = (const float*)(C.ws + WS_MOD);
    const float* g2 = a.in[I_N2G] + (size_t)l * DM; const float* rw = a.in[I_RW] + (size_t)l * DM * NEXP; const float* rb = a.in[I_RB] + (size_t)l * NEXP;
    int* tok_e = (int*)(C.ws + WS_ROUTE); float* gate = (float*)(C.ws + WS_ROUTE) + (size_t)1 * ROWS * 4; int* slot = (int*)(C.ws + WS_ROUTE) + (size_t)2 * ROWS * 4;
    LAS float* hrow = (LAS float*)(C.lds + C.wave * 4096);
    LAS int* hist = (LAS int*)(C.lds + MISC_OFF + 64);
    if (C.tid < NEXP) hist[C.tid] = 0;
    __syncthreads();
    const int row_lo = (l == DEPTH - 1) ? NCTX : 0;
    for (int row = row_lo + C.gw; row < ROWS; row += C.NGW) {
        const bool isctx = row < NCTX; f32x4 v[4]; load_row(XS + (size_t)row * DM, C.lane, v);
        const float rstd = row_rstd(v);
        const float* md = mod + (size_t)(l * 2 + (isctx ? 1 : 0)) * 6144 + 3 * DM;
        u32x2* o = (u32x2*)(H + (size_t)row * DM) + C.lane;
#pragma unroll
        for (int j = 0; j < 4; ++j) { const f32x4 g = *((const f32x4*)g2 + C.lane + 64 * j), sh = *((const f32x4*)md + C.lane + 64 * j), sc = *((const f32x4*)(md + DM) + C.lane + 64 * j);
            const f32x4 y = v[j] * rstd * g * (sc + 1.0f) + sh; u32x2 w; w.x = pk2(y.x, y.y); w.y = pk2(y.z, y.w); o[64 * j] = w;
            *(LAS f32x4*)(hrow + 4 * (C.lane + 64 * j)) = y; }
        LDS_WAIT(); asm volatile("" ::: "memory");
        const int e = C.lane & 31, hf = C.lane >> 5; float s = 0.f;
        const float* rwp = rw + (size_t)(hf * 512) * NEXP + e; const LAS float* hp = hrow + hf * 512;
#pragma unroll 8
        for (int k = 0; k < 512; ++k) s += hp[k] * rwp[(size_t)k * NEXP];
        s += __shfl_xor(s, 32);
        s += rb[e];
        float val = s; int te[4]; float tv[4];
#pragma unroll
        for (int k = 0; k < 4; ++k) { float bv = val; int bi = e;
#pragma unroll
            for (int o2 = 1; o2 < 32; o2 <<= 1) { const float ov = __shfl_xor(bv, o2); const int oi = __shfl_xor(bi, o2); if (ov > bv || (ov == bv && oi < bi)) { bv = ov; bi = oi; } }
            te[k] = bi; tv[k] = bv; if (e == bi) val = -3.0e38f; }
        if (C.lane == 0) { const float m = tv[0]; float p[4], ps = 0.f;
#pragma unroll
            for (int k = 0; k < 4; ++k) { p[k] = __expf(tv[k] - m); ps += p[k]; }
#pragma unroll
            for (int k = 0; k < 4; ++k) { tok_e[row * 4 + k] = te[k]; gate[row * 4 + k] = p[k] / ps; slot[row * 4 + k] = __hip_atomic_fetch_add(&hist[te[k]], 1, __ATOMIC_RELAXED, __HIP_MEMORY_SCOPE_WORKGROUP); } }
        asm volatile("" ::: "memory");
    }
    __syncthreads();
    if (C.tid < NEXP) ((int*)(C.ws + WS_CNT))[C.wg * NEXP + C.tid] = hist[C.tid];
}
__device__ __forceinline__ int moe_tables(const Ctx& C) {
    const int* cnt = (const int*)(C.ws + WS_CNT);
    LAS int* part = (LAS int*)(C.lds);
    LAS int* pstart = (LAS int*)(C.lds + MISC_OFF + 256); LAS int* wgbase = pstart + 40; LAS int* tot = wgbase + 32; LAS int* nblk_s = tot + 32;
    LAS unsigned char* blk_e = (LAS unsigned char*)(C.lds + MISC_OFF + 1024);
    __syncthreads();
    { const int e = C.tid & 31, p = C.tid >> 5; int t = 0, pre = 0;
#pragma unroll 1
      for (int w = p * 16; w < p * 16 + 16; ++w) { const int c = cnt[w * NEXP + e]; t += c; if (w < C.wg) pre += c; }
      part[(p * 32 + e) * 2] = t; part[(p * 32 + e) * 2 + 1] = pre; }
    __syncthreads();
    if (C.tid < NEXP) { int t = 0, pre = 0;
#pragma unroll 1
        for (int p = 0; p < 16; ++p) { t += part[(p * 32 + C.tid) * 2]; pre += part[(p * 32 + C.tid) * 2 + 1]; }
        tot[C.tid] = t; wgbase[C.tid] = pre; }
    __syncthreads();
    if (C.tid == 0) { int b = 0;
#pragma unroll 1
        for (int e = 0; e < NEXP; ++e) { pstart[e] = b * 256; b += (tot[e] + 255) >> 8; }
        pstart[NEXP] = b * 256; nblk_s[0] = b; }
    __syncthreads();
    if (C.tid < NEXP) wgbase[C.tid] += pstart[C.tid];
    if (C.tid < MOE_MAXBLK) { int e = 0;
#pragma unroll 1
        for (int k = 1; k < NEXP; ++k) if (pstart[k] <= C.tid * 256) e = k;
        blk_e[C.tid] = (unsigned char)e; }
    __syncthreads();
    return __builtin_amdgcn_readfirstlane(nblk_s[0]);
}
__device__ __forceinline__ void phase_gather(const Ctx& C, const Args& a, int l) {
    moe_tables(C);
    const LAS int* wgbase = (const LAS int*)(C.lds + MISC_OFF + 256) + 40;
    const int* tok_e = (const int*)(C.ws + WS_ROUTE); const int* slot = (const int*)(C.ws + WS_ROUTE) + (size_t)2 * ROWS * 4; int* dest = (int*)(C.ws + WS_ROUTE) + (size_t)3 * ROWS * 4;
    const bf16* H = (const bf16*)(C.ws + WS_H); bf16* XG = (bf16*)(C.ws + WS_XG);
    const int row_lo = (l == DEPTH - 1) ? NCTX : 0;
    for (int row = row_lo + C.gw; row < ROWS; row += C.NGW) {
        const u32x4* src = (const u32x4*)(H + (size_t)row * DM) + C.lane; const u32x4 v0 = src[0], v1 = src[64];
#pragma unroll
        for (int k = 0; k < 4; ++k) { const int d = wgbase[tok_e[row * 4 + k]] + slot[row * 4 + k]; if (C.lane == 0) dest[row * 4 + k] = d;
            u32x4* dp = (u32x4*)(XG + (size_t)d * DM) + C.lane; dp[0] = v0; dp[64] = v1; }
    }
}

__device__ __forceinline__ void mix1_rope(const Ctx& C) {
    bf16* P = (bf16*)(C.ws + WS_P);
    const long total = (long)SEQ * 192;
    for (long i = (long)C.wg * NTHR + C.tid; i < total; i += (long)C.G * NTHR) {
        const int j = (int)(i & 31), hh = (int)((i >> 5) % 6), t = (int)(i / 192);
        const int col = (hh < 4) ? (C_AQ + hh * 64) : (C_AK + (hh - 4) * 64);
        const float pos = (j < 16) ? (float)(t >> 6) : (float)(t & 63);
        const float inv = __powf(10000.0f, -(float)(j & 15) * (1.0f / 16.0f));
        const float ang = pos * inv * 0.31830988618379067f;
        const float cs = cospif(ang), sn = sinpif(ang);
        bf16* p = P + (size_t)(NCTX + t) * INWP + col;
        const float x1 = bf2f(p[j]), x2 = bf2f(p[j + 32]);
        p[j] = (bf16)f2bf(x1 * cs - x2 * sn); p[j + 32] = (bf16)f2bf(x2 * cs + x1 * sn);
    }
}
__device__ __forceinline__ float conv3(const bf16* P, int row, int col, const float* cw, int cc) {
    const bool first = (row == 0) || (row == NCTX), last = (row == NCTX - 1) || (row == ROWS - 1);
    float s = cw[768 + cc] * bf2f(P[(size_t)row * INWP + col]);
    if (!first) s += cw[cc] * bf2f(P[(size_t)(row - 1) * INWP + col]);
    if (!last) s += cw[2 * 768 + cc] * bf2f(P[(size_t)(row + 1) * INWP + col]);
    return s;
}
__device__ __forceinline__ void mix1_rwkv_prep(const Ctx& C, const Args& a, int l) {
    const bf16* P = (const bf16*)(C.ws + WS_P); float* SC = (float*)(C.ws + WS_SC);
    LAS float* lo = (LAS float*)(C.lds);
    const float* cw = a.in[I_DCONV] + (size_t)l * 3 * 768;
    const float* w0 = a.in[I_DW0] + (size_t)l * 512; const float* w2 = a.in[I_DW2] + (size_t)l * 2 * 64 * 256;
    const float* a0 = a.in[I_DA0] + (size_t)l * 512; const float* a2 = a.in[I_DA2] + (size_t)l * 2 * 64 * 256;
    const float* kkw = a.in[I_DKK] + (size_t)l * 256; const float* kaw = a.in[I_DKA] + (size_t)l * 256;
    const int half = C.tid >> 8, c = C.tid & 255;
    for (int pr = C.wg; pr < ROWS / 2; pr += C.G) {
        const int row = 2 * pr + half;
        __syncthreads();
        { const float x = bf2f(P[(size_t)row * INWP + C_WL + c]); lo[half * 256 + c] = (c < 128) ? tanhf(x) : x; }
        __syncthreads();
        const float r = conv3(P, row, C_DR + c, cw, c), k = conv3(P, row, C_DK + c, cw, 256 + c), v = conv3(P, row, C_DV + c, cw, 512 + c);
        float kk = k * kkw[c]; const float n2 = wave_sum(kk * kk); kk *= rsqrtf(fmaxf(n2, 1e-24f));
        float* sc = SC + (size_t)row * 9 * 256;
        sc[c] = r; sc[256 + c] = v; sc[512 + c] = -kk;
#pragma unroll
        for (int d = 0; d < 2; ++d) {
            float wp = w0[d * 256 + c], ap = a0[d * 256 + c];
            const LAS float* wl = lo + half * 256 + d * 64; const LAS float* al = lo + half * 256 + 128 + d * 64;
            const float* w2p = w2 + (size_t)d * 64 * 256 + c; const float* a2p = a2 + (size_t)d * 64 * 256 + c;
#pragma unroll 8
            for (int i = 0; i < 64; ++i) { wp += wl[i] * w2p[i * 256]; ap += al[i] * a2p[i * 256]; }
            const float nw = -wp, sp = fmaxf(nw, 0.f) + log1pf(__expf(-fabsf(nw)));
            const float dec = __expf(-__expf(-sp - 0.5f));
            const float as = sigmoidf_(ap);
            sc[(3 + 3 * d) * 256 + c] = dec; sc[(4 + 3 * d) * 256 + c] = k * (1.0f + (as - 1.0f) * kaw[c]); sc[(5 + 3 * d) * 256 + c] = kk * as;
        }
    }
    __syncthreads();
}
__device__ __forceinline__ void mix1_fourier1(const Ctx& C) {
    const bf16* P = (const bf16*)(C.ws + WS_P); const float* tw = (const float*)(C.ws + WS_TW);
    float* FYR = (float*)(C.ws + WS_FYR); float* FYI = (float*)(C.ws + WS_FYI);
    LAS float* ct = (LAS float*)(C.lds + 4096); LAS float* st = ct + 128;
    __syncthreads();
    if (C.tid < 128) { ct[C.tid] = tw[128 * C.tid]; st[C.tid] = tw[16384 + 128 * C.tid]; }
    __syncthreads();
    for (int u = C.wg; u < 128 * 128 * 256 / NTHR; u += C.G) {
        const int idx = u * NTHR + C.tid, ch = idx & 255, t2 = (idx >> 8) & 127, k1 = idx >> 15;
        float dr = 0.f, di = 0.f;
        const bf16* up = P + (size_t)(NCTX + t2) * INWP + C_BU + ch;
#pragma unroll 8
        for (int t1 = 0; t1 < 128; ++t1) { const float x = bf2f(up[(size_t)t1 * 128 * INWP]); const int m = (k1 * t1) & 127; dr += x * ct[m]; di -= x * st[m]; }
        const float cp = tw[t2 * k1], sp = tw[16384 + t2 * k1];
        FYR[idx] = dr * cp + di * sp; FYI[idx] = di * cp - dr * sp;
    }
    __syncthreads();
}

__device__ __forceinline__ void attn_key(const float (&q)[64], float& m, float& l, float (&acc)[64], const bf16* kp, const bf16* vp, float bias) {
    float s = 0.f;
#pragma unroll
    for (int c8 = 0; c8 < 8; ++c8) { const u32x4 w = *((const u32x4*)kp + c8);
        s += q[8 * c8 + 0] * bflo(w.x) + q[8 * c8 + 1] * bfhi(w.x) + q[8 * c8 + 2] * bflo(w.y) + q[8 * c8 + 3] * bfhi(w.y) + q[8 * c8 + 4] * bflo(w.z) + q[8 * c8 + 5] * bfhi(w.z) + q[8 * c8 + 6] * bflo(w.w) + q[8 * c8 + 7] * bfhi(w.w); }
    s = s * 0.125f + bias;
    const float mn = fmaxf(m, s), corr = __expf(m - mn), p = __expf(s - mn);
    l = l * corr + p; m = mn;
#pragma unroll
    for (int c8 = 0; c8 < 8; ++c8) { const u32x4 w = *((const u32x4*)vp + c8);
        acc[8 * c8 + 0] = acc[8 * c8 + 0] * corr + p * bflo(w.x); acc[8 * c8 + 1] = acc[8 * c8 + 1] * corr + p * bfhi(w.x);
        acc[8 * c8 + 2] = acc[8 * c8 + 2] * corr + p * bflo(w.y); acc[8 * c8 + 3] = acc[8 * c8 + 3] * corr + p * bfhi(w.y);
        acc[8 * c8 + 4] = acc[8 * c8 + 4] * corr + p * bflo(w.z); acc[8 * c8 + 5] = acc[8 * c8 + 5] * corr + p * bfhi(w.z);
        acc[8 * c8 + 6] = acc[8 * c8 + 6] * corr + p * bflo(w.w); acc[8 * c8 + 7] = acc[8 * c8 + 7] * corr + p * bfhi(w.w); }
}
__device__ __forceinline__ void attn_item(const Ctx& C, const Args& a, int l, int kind, int idx) {
    const bf16* P = (const bf16*)(C.ws + WS_P); bf16* MIX = (bf16*)(C.ws + WS_MIX);
    const bool isA = kind < 2, lat = (kind & 1) == 0;
    const int nq = lat ? SEQ : NCTX; const int h = idx / nq, t = idx % nq;
    const int qrow = lat ? NCTX + t : t;
    const int qcol = (isA ? C_AQ : C_CQ) + h * 64, kcol = isA ? (C_AK + (h >> 1) * 64) : (C_CK + h * 64), vcol = isA ? (C_AV + (h >> 1) * 64) : (C_CV + h * 64);
    float q[64], acc[64]; float m = -1.0e30f, ls = 0.f;
#pragma unroll
    for (int c8 = 0; c8 < 8; ++c8) { const u32x4 w = *((const u32x4*)(P + (size_t)qrow * INWP + qcol) + c8);
        q[8 * c8 + 0] = bflo(w.x); q[8 * c8 + 1] = bfhi(w.x); q[8 * c8 + 2] = bflo(w.y); q[8 * c8 + 3] = bfhi(w.y); q[8 * c8 + 4] = bflo(w.z); q[8 * c8 + 5] = bfhi(w.z); q[8 * c8 + 6] = bflo(w.w); q[8 * c8 + 7] = bfhi(w.w); }
#pragma unroll
    for (int d = 0; d < 64; ++d) acc[d] = 0.f;
    if (lat && isA) {
        const int j0 = t - 128 < 0 ? 0 : t - 128, j1 = t + 128 > SEQ - 1 ? SEQ - 1 : t + 128;
        for (int j = j0; j <= j1; ++j) attn_key(q, m, ls, acc, P + (size_t)(NCTX + j) * INWP + kcol, P + (size_t)(NCTX + j) * INWP + vcol, 0.f);
    }
    if (lat && !isA) {
        const int r = t >> 6, cq = t & 63; int r0 = r - 4; r0 = r0 < 0 ? 0 : (r0 > 248 ? 248 : r0); int c0 = cq - 8; c0 = c0 < 0 ? 0 : (c0 > 48 ? 48 : c0);
        const float* rb = a.in[I_CREL] + ((size_t)l * 4 + h) * 15 * 31;
        for (int kr = r0; kr < r0 + 8; ++kr)
            for (int kc = c0; kc < c0 + 16; ++kc) { int ci = kc - cq + 15; ci = ci < 0 ? 0 : (ci > 30 ? 30 : ci); const int j = kr * 64 + kc;
                attn_key(q, m, ls, acc, P + (size_t)(NCTX + j) * INWP + kcol, P + (size_t)(NCTX + j) * INWP + vcol, rb[(kr - r + 7) * 31 + ci]); }
    }
    for (int j = 0; j < NCTX; ++j) attn_key(q, m, ls, acc, P + (size_t)j * INWP + kcol, P + (size_t)j * INWP + vcol, 0.f);
    if (isA) { const float sk = a.in[I_ASINK][l * 4 + h]; const float mn = fmaxf(m, sk), corr = __expf(m - mn); ls = ls * corr + __expf(sk - mn);
#pragma unroll
        for (int d = 0; d < 64; ++d) acc[d] *= corr; }
    const float inv = 1.0f / ls;
    bf16* o = MIX + (size_t)qrow * DM + (isA ? 0 : 512) + h * 64;
#pragma unroll
    for (int c8 = 0; c8 < 8; ++c8) { u32x4 w; w.x = pk2(acc[8 * c8] * inv, acc[8 * c8 + 1] * inv); w.y = pk2(acc[8 * c8 + 2] * inv, acc[8 * c8 + 3] * inv); w.z = pk2(acc[8 * c8 + 4] * inv, acc[8 * c8 + 5] * inv); w.w = pk2(acc[8 * c8 + 6] * inv, acc[8 * c8 + 7] * inv);
        *((u32x4*)o + c8) = w; }
}
__device__ __forceinline__ void fourier2_unit(const Ctx& C, int l, int u, bool ctx) {
    const bf16* P = (const bf16*)(C.ws + WS_P); const float* tw = (const float*)(C.ws + WS_TW); bf16* MIX = (bf16*)(C.ws + WS_MIX);
    const float* FYR = (const float*)(C.ws + WS_FYR); const float* FYI = (const float*)(C.ws + WS_FYI);
    const float* mt = (const float*)(C.ws + WS_MTAB) + (size_t)l * 2 * 4 * 4096;
    LAS float* xr = (LAS float*)(C.lds + 8192); LAS float* xi = xr + 512;
    const int tl = C.tid >> 8, ch = C.tid & 255, tp = 2 * u + tl;
    float sr = 0.f, si = 0.f;
    if (!ctx) { const int k1 = tp & 127, k2 = tp >> 7; const float* yr = FYR + (size_t)k1 * 128 * 256 + ch; const float* yi = FYI + (size_t)k1 * 128 * 256 + ch;
#pragma unroll 8
        for (int t2 = 0; t2 < 128; ++t2) { const int m = ((t2 * k2) & 127) * 128; const float c = tw[m], s = tw[16384 + m]; const float a = yr[t2 * 256], b = yi[t2 * 256]; sr += a * c + b * s; si += b * c - a * s; } }
    else {
#pragma unroll 8
        for (int t = 0; t < NCTX; ++t) { const int m = ((t * tp) & 255) * 64; const float x = bf2f(P[(size_t)t * INWP + C_BU + ch]); sr += x * tw[m]; si -= x * tw[16384 + m]; } }
    __syncthreads();
    xr[tl * 256 + ch] = sr; xi[tl * 256 + ch] = si;
    __syncthreads();
    const int g = ch >> 6, e = ch & 63; const float* mc = mt + (size_t)(0 * 4 + g) * 4096 + e; const float* ms = mt + (size_t)(1 * 4 + g) * 4096 + e;
    const LAS float* xrp = xr + tl * 256 + g * 64; const LAS float* xip = xi + tl * 256 + g * 64; float o = 0.f;
#pragma unroll 8
    for (int c = 0; c < 64; ++c) o += xrp[c] * mc[c * 64] + xip[c] * ms[c * 64];
    o *= ctx ? (1.0f / 128.0f) : (1.0f / 1024.0f);
    MIX[(size_t)((ctx ? 0 : NCTX) + tp) * DM + 256 + ch] = (bf16)f2bf(o);
}
__device__ __forceinline__ void rwkv_scan_seq(const Ctx& C, int b) {
    const float* SC = (const float*)(C.ws + WS_SC); float* YS = (float*)(C.ws + WS_YS);
    const int d = b >> 2, h = b & 3, il = C.lane & 15, jq = C.lane >> 4, i = (C.wave & 3) * 16 + il;
    LAS float* buf = (LAS float*)(C.lds + 16384);
    float S[16];
#pragma unroll
    for (int m = 0; m < 16; ++m) S[m] = 0.f;
    for (int p0 = 0; p0 < ROWS; p0 += 16) {
        __syncthreads();
#pragma unroll
        for (int t = 0; t < 3; ++t) { const int f = C.tid + 512 * t;
            const int st = f / 96, q = (f % 96) / 16, c4 = f % 16, p = p0 + st;
            const int row = (d == 0) ? p : (p < NCTX ? NCTX - 1 - p : ROWS + NCTX - 1 - p);
            const int qq = (q == 0) ? 2 : (q == 1) ? 3 + 3 * d : (q == 2) ? 4 + 3 * d : (q == 3) ? 5 + 3 * d : (q == 4) ? 0 : 1;
            *(LAS f32x4*)(buf + (st * 6 + q) * 64 + 4 * c4) = *(const f32x4*)(SC + ((size_t)row * 9 + qq) * 256 + h * 64 + 4 * c4); }
        __syncthreads();
        if (C.wave < 4) {
            for (int st = 0; st < 16; ++st) {
                const int p = p0 + st; const int row = (d == 0) ? p : (p < NCTX ? NCTX - 1 - p : ROWS + NCTX - 1 - p);
                const LAS float* sb = buf + st * 6 * 64 + jq * 16;
                f32x4 av[4], wv[4], kv[4], bv[4], rv[4];
#pragma unroll
                for (int m = 0; m < 4; ++m) { av[m] = *(const LAS f32x4*)(sb + 4 * m); wv[m] = *(const LAS f32x4*)(sb + 64 + 4 * m); kv[m] = *(const LAS f32x4*)(sb + 128 + 4 * m);
                    bv[m] = *(const LAS f32x4*)(sb + 192 + 4 * m); rv[m] = *(const LAS f32x4*)(sb + 256 + 4 * m); }
                const float v = buf[st * 6 * 64 + 320 + i];
                float sa = 0.f;
#pragma unroll
                for (int m = 0; m < 16; ++m) sa += S[m] * av[m >> 2][m & 3];
                sa += __shfl_xor(sa, 16); sa += __shfl_xor(sa, 32);
                float y = 0.f;
#pragma unroll
                for (int m = 0; m < 16; ++m) { S[m] = S[m] * wv[m >> 2][m & 3] + sa * bv[m >> 2][m & 3] + v * kv[m >> 2][m & 3]; y += S[m] * rv[m >> 2][m & 3]; }
                y += __shfl_xor(y, 16); y += __shfl_xor(y, 32);
                if (jq == 0) YS[((size_t)d * ROWS + row) * 256 + h * 64 + i] = y;
            }
        }
    }
    __syncthreads();
}
__device__ __forceinline__ void phase_mix2(const Ctx& C, const Args& a, int l) {
    const bool emit_ctx = l < DEPTH - 1;
    if (C.wg < 8) rwkv_scan_seq(C, C.wg);
    const int nA = SEQ * 4 / NTHR, nCtx = emit_ctx ? NCTX * 4 / NTHR : 0, nAtt = 2 * nA + 2 * nCtx;
    const int nF = SEQ / 2, nFc = emit_ctx ? NCTX / 2 : 0;
    for (int u = C.wg; u < nAtt + nF + nFc; u += C.G) {
        if (u < nA) attn_item(C, a, l, 0, u * NTHR + C.tid);
        else if (u < 2 * nA) attn_item(C, a, l, 2, (u - nA) * NTHR + C.tid);
        else if (u < 2 * nA + nCtx) attn_item(C, a, l, 1, (u - 2 * nA) * NTHR + C.tid);
        else if (u < nAtt) attn_item(C, a, l, 3, (u - 2 * nA - nCtx) * NTHR + C.tid);
        else if (u < nAtt + nF) fourier2_unit(C, l, u - nAtt, false);
        else fourier2_unit(C, l, u - nAtt - nF, true);
    }
}
__device__ __forceinline__ void phase_mix3(const Ctx& C, const Args& a, int l) {
    const bf16* P = (const bf16*)(C.ws + WS_P); const float* SC = (const float*)(C.ws + WS_SC); const float* YS = (const float*)(C.ws + WS_YS); bf16* MIX = (bf16*)(C.ws + WS_MIX);
    LAS float* gl = (LAS float*)(C.lds);
    const float* g2 = a.in[I_DG2] + (size_t)l * 160 * 256; const float* rk = a.in[I_DRK] + (size_t)l * 256; const float* lnw = a.in[I_DLNW] + (size_t)l * 256; const float* lnb = a.in[I_DLNB] + (size_t)l * 256;
    const int half = C.tid >> 8, c = C.tid & 255;
    const int row_lo = (l == DEPTH - 1) ? NCTX : 0;
    for (int pr = C.wg + row_lo / 2; pr < ROWS / 2; pr += C.G) {
        const int row = 2 * pr + half;
        __syncthreads();
        if (c < 160) gl[half * 160 + c] = sigmoidf_(bf2f(P[(size_t)row * INWP + C_GL + c]));
        __syncthreads();
        const float* sc = SC + (size_t)row * 9 * 256;
        const float y = YS[(size_t)row * 256 + c] + YS[((size_t)ROWS + row) * 256 + c];
        const float mu = wave_sum(y) * (1.f / 64.f), dy = y - mu, var = wave_sum(dy * dy) * (1.f / 64.f);
        const float yn = dy * rsqrtf(var + 64e-5f) * lnw[c] + lnb[c];
        const float r = sc[c], v = sc[256 + c];
        const float coef = wave_sum(r * (sc[4 * 256 + c] + sc[7 * 256 + c]) * rk[c]);
        float g = 0.f; const float* g2p = g2 + c; const LAS float* glp = gl + half * 160;
#pragma unroll 8
        for (int i = 0; i < 160; ++i) g += glp[i] * g2p[i * 256];
        MIX[(size_t)row * DM + 768 + c] = (bf16)f2bf((yn + coef * v) * g);
    }
    __syncthreads();
}

#ifndef MK_SINGLE
#define MK_SINGLE 0
#endif
template <int ONLYP> __global__ void __launch_bounds__(NTHR, 2) mega(Args a) {
    extern __shared__ __attribute__((aligned(16))) unsigned char lds_raw[];
    Ctx C;
    C.lds = (LAS unsigned char*)lds_raw;
    C.tid = threadIdx.x; C.lane = C.tid & 63; C.wave = __builtin_amdgcn_readfirstlane(C.tid >> 6);
    C.wg = blockIdx.x; C.G = gridDim.x; C.gw = C.wg * NWAVES + C.wave; C.NGW = C.G * NWAVES; C.ws = a.ws;
    if (C.tid < 4) ((LAS unsigned*)(C.lds + MISC_OFF))[C.tid] = 0u;
    __syncthreads();
    XcdBarrier bar; bar.bar = (unsigned*)(a.ws + WS_CTL) + CW_BAR; bar.x = 0; bar.st = (volatile LAS unsigned*)(C.lds + MISC_OFF);
    if (a.use_bar) bar = xcd_barrier_post((unsigned*)(a.ws + WS_CTL) + CW_BAR, (volatile LAS unsigned*)(C.lds + MISC_OFF));
#ifndef PHMASK
#define PHMASK 0xfff
#endif
#define INP(o, k) ((ONLYP < 0 || ONLYP == (o)) && ((PHMASK >> ((o) == 99 ? 11 : (o))) & 1) && a.ph_lo <= (k) && (k) < a.ph_hi)
#define IN(k) (a.ph_lo <= (k) && (k) < a.ph_hi)
#define SEAM(k) do { if (a.use_bar && IN(k) && IN((k) + 1)) xcd_barrier(bar); } while (0)
    if (INP(0, 0)) phase_prologue(C, a);
    SEAM(0);
    for (int l = 0; l < DEPTH; ++l) {
        const int b = 1 + l * NPL;
        const float* mod_lat = (const float*)(a.ws + WS_MOD) + (size_t)(l * 2 + 0) * 6144; const float* mod_ctx = mod_lat + 6144;
        if (INP(1, b + 0)) phase_norm1(C, a, l);
        SEAM(b + 0);
        if (INP(2, b + 1)) {
            pg8::StaticOrder S; S.init(a.ws + WS_H, (const bf16*)(a.ws + WS_WIN) + (size_t)l * INWP * DM, ROWS, INWP, DM, C.G, C.wg);
            pg8::EpiStoreBf16 E{(bf16*)(a.ws + WS_P), INWP, nullptr, 0};
            pg8::gemm_phase<pg8::EpiStoreBf16, pg8::StaticOrder, true, true>(C.lds, DM, S, E);
        }
        SEAM(b + 1);
        if (INP(3, b + 2)) { mix1_rope(C); mix1_rwkv_prep(C, a, l); mix1_fourier1(C); }
        SEAM(b + 2);
        if (INP(4, b + 3)) phase_mix2(C, a, l);
        SEAM(b + 3);
        if (INP(5, b + 4)) phase_mix3(C, a, l);
        SEAM(b + 4);
        if (INP(6, b + 5)) {
            pg8::StaticOrder S; S.init(a.ws + WS_MIX, (const bf16*)(a.ws + WS_WOUT) + (size_t)l * DM * DM, ROWS, DM, DM, C.G, C.wg);
            pg8::EpiResidual E{(float*)(a.ws + WS_XS), DM, mod_lat + 2 * DM, mod_ctx + 2 * DM};
            pg8::gemm_phase<pg8::EpiResidual, pg8::StaticOrder, true, true>(C.lds, DM, S, E);
        }
        SEAM(b + 5);
        if (INP(7, b + 6)) phase_norm2(C, a, l);
        SEAM(b + 6);
        if (INP(8, b + 7)) phase_gather(C, a, l);
        SEAM(b + 7);
        if (INP(9, b + 8)) {
            const int nblk = moe_tables(C);
            pg8::MoeOrder S{(const char*)(a.ws + WS_XG), (const char*)((const bf16*)(a.ws + WS_WGU) + (size_t)l * 32 * 2048 * DM), (size_t)256 * DM * 2, (size_t)2048 * DM * 2,
                            (const LAS unsigned char*)(C.lds + MISC_OFF + 1024), nblk, 8, C.G, C.wg};
            pg8::EpiSwiglu E{(bf16*)(a.ws + WS_ACT), DM, a.in[I_BGU] + (size_t)l * 32 * 2048, 2048};
            pg8::gemm_phase<pg8::EpiSwiglu, pg8::MoeOrder, true, true>(C.lds, DM, S, E);
        }
        SEAM(b + 8);
        if (INP(10, b + 9)) {
            const int nblk = moe_tables(C);
            pg8::MoeOrder S{(const char*)(a.ws + WS_ACT), (const char*)((const bf16*)(a.ws + WS_WDN) + (size_t)l * 32 * DM * DM), (size_t)256 * DM * 2, (size_t)DM * DM * 2,
                            (const LAS unsigned char*)(C.lds + MISC_OFF + 1024), nblk, 4, C.G, C.wg};
            pg8::EpiStoreBf16 E{(bf16*)(a.ws + WS_XG), DM, a.in[I_BDN] + (size_t)l * 32 * DM, DM};
            pg8::gemm_phase<pg8::EpiStoreBf16, pg8::MoeOrder, true, true>(C.lds, DM, S, E);
        }
        SEAM(b + 9);
    }
    if (INP(99, PH_TOTAL - 1)) phase_final(C, a);
#undef IN
#undef INP
#undef SEAM
}

typedef void (*kern_t)(Args);
static kern_t kern_of(int o) {
    switch (o) { case 0: return mega<0>; case 1: return mega<1>; case 2: return mega<2>; case 3: return mega<3>; case 4: return mega<4>; case 5: return mega<5>; case 6: return mega<6>;
                 case 7: return mega<7>; case 8: return mega<8>; case 9: return mega<9>; case 10: return mega<10>; case 99: return mega<99>;
#if MK_SINGLE
                 default: return mega<-1>;
#else
                 default: return mega<0>;
#endif
    }
}
extern "C" void kernel_launch(void* const* d_in, const int* in_sizes, int n_in, void* d_out, int out_size, void* d_ws, size_t ws_size, hipStream_t stream) {
    static int ready = 0;
    if (ready == 0) {
        if (n_in != 31 || out_size != SEQ * DM || ws_size < WS_END) { fprintf(stderr, "kernel_launch: unexpected shapes (n_in %d, out %d, ws %zu)\n", n_in, out_size, ws_size); ready = -1; return; }
        const int ids[13] = {0, 1, 2, 3, 4, 5, 6, 7, 8, 9, 10, 99, -1};
        for (int i = 0; i < (MK_SINGLE ? 13 : 12); ++i) { if (MK_SINGLE && ids[i] != -1) continue;
            if (hipFuncSetAttribute((const void*)kern_of(ids[i]), hipFuncAttributeMaxDynamicSharedMemorySize, LDS_BYTES) != hipSuccess) { fprintf(stderr, "kernel_launch: hipFuncSetAttribute failed (%d)\n", ids[i]); ready = -1; return; } }
        ready = 1;
    }
    if (ready < 0) return;
    (void)hipMemsetAsync((char*)d_ws + WS_CTL, 0, CTL_ZERO_BYTES, stream);
    Args a{};
    for (int i = 0; i < 31; ++i) a.in[i] = (const float*)d_in[i];
    a.out = (float*)d_out; a.ws = (unsigned char*)d_ws; a.pad = 0;
#if MK_SINGLE
    a.ph_lo = 0; a.ph_hi = PH_TOTAL; a.use_bar = 1;
    hipLaunchKernelGGL(kern_of(-1), dim3(NWG), dim3(NTHR), LDS_BYTES, stream, a);
#else
    for (int p = 0; p < PH_TOTAL; ++p) { a.ph_lo = p; a.ph_hi = p + 1; a.use_bar = 0;
        const int o = (p == 0) ? 0 : (p == PH_TOTAL - 1) ? 99 : 1 + (p - 1) % NPL;
        hipLaunchKernelGGL(kern_of(o), dim3(NWG), dim3(NTHR), LDS_BYTES, stream, a); }
#endif
}
```

```cpp
#include <hip/hip_runtime.h>
#include <cstdio>
#include <cstdint>

#define LAS __attribute__((address_space(3)))
typedef unsigned short bf16;
typedef float f32x4 __attribute__((ext_vector_type(4)));
typedef float f32x2 __attribute__((ext_vector_type(2)));
typedef short bf16x8 __attribute__((ext_vector_type(8)));
typedef unsigned u32x4 __attribute__((ext_vector_type(4)));
typedef unsigned u32x2 __attribute__((ext_vector_type(2)));

constexpr int DM = 1024, SEQ = 16384, NCTX = 256, ROWS = SEQ + NCTX, DEPTH = 4, GRIDW = 64;
constexpr int INW = 2720, INWP = 2816;
constexpr int C_AQ = 0, C_AK = 256, C_AV = 384, C_BU = 512, C_CQ = 768, C_CK = 1024, C_CV = 1280, C_DR = 1536, C_DK = 1792, C_DV = 2048, C_WL = 2304, C_AL = 2432, C_GL = 2560;
constexpr int NEXP = 32, TOPK = 4;
constexpr int MOE_MAXBLK = 296;
constexpr int MOE_ROWS = MOE_MAXBLK * 256;
constexpr int NWG = 256, NTHR = 512, NWAVES = 8;

constexpr size_t MiB = 1u << 20;
constexpr size_t WS_CTL = 0, CTL_ZERO_BYTES = 1 * MiB;
constexpr size_t WS_MOD = 1 * MiB;
constexpr size_t WS_TW = 2 * MiB;
constexpr size_t WS_MTAB = 3 * MiB;
constexpr size_t WS_XS = 4 * MiB;
constexpr size_t WS_H = 70 * MiB;
constexpr size_t WS_P = 104 * MiB;
constexpr size_t WS_MIX = 194 * MiB;
constexpr size_t WS_FYR = 228 * MiB, WS_FYI = 244 * MiB;
constexpr size_t WS_SC = 260 * MiB;
constexpr size_t WS_YS = 408 * MiB;
constexpr size_t WS_ROUTE = 442 * MiB;
constexpr size_t WS_CNT = 444 * MiB;
constexpr size_t WS_XG = 446 * MiB;
constexpr size_t WS_ACT = 596 * MiB;
constexpr size_t WS_WIN = 746 * MiB;
constexpr size_t WS_WOUT = 768 * MiB;
constexpr size_t WS_WGU = 776 * MiB;
constexpr size_t WS_WDN = 1288 * MiB;
constexpr size_t WS_END = 1544 * MiB;
static_assert(WS_XS + (size_t)ROWS * DM * 4 <= WS_H && WS_H + (size_t)ROWS * DM * 2 <= WS_P && WS_P + (size_t)ROWS * INWP * 2 <= WS_MIX && WS_MIX + (size_t)ROWS * DM * 2 <= WS_FYR, "ws map 1");
static_assert(WS_SC + (size_t)ROWS * 9 * 256 * 4 <= WS_YS && WS_YS + (size_t)2 * ROWS * 256 * 4 <= WS_ROUTE && WS_XG + (size_t)MOE_ROWS * DM * 2 <= WS_ACT && WS_ACT + (size_t)MOE_ROWS * DM * 2 <= WS_WIN, "ws map 2");
static_assert(WS_WIN + (size_t)4 * INWP * DM * 2 <= WS_WOUT && WS_WGU + (size_t)4 * 32 * 2048 * 1024 * 2 <= WS_WDN && WS_WDN + (size_t)4 * 32 * 1024 * 1024 * 2 <= WS_END, "ws map 3");
constexpr int CW_BAR = 4096;

constexpr int RING_BYTES = 131072;
constexpr int MISC_OFF = RING_BYTES;
constexpr int LDS_BYTES = 147456;

__device__ __forceinline__ unsigned f2bf(float f) { unsigned u = __builtin_bit_cast(unsigned, f); return (u + 0x7fffu + ((u >> 16) & 1u)) >> 16; }
__device__ __forceinline__ unsigned pk2(float lo, float hi) { return f2bf(lo) | (f2bf(hi) << 16); }
__device__ __forceinline__ float bf2f(unsigned short b) { return __builtin_bit_cast(float, (unsigned)b << 16); }
__device__ __forceinline__ float bflo(unsigned w) { return __builtin_bit_cast(float, w << 16); }
__device__ __forceinline__ float bfhi(unsigned w) { return __builtin_bit_cast(float, w & 0xffff0000u); }
__device__ __forceinline__ float wave_sum(float v) {
#pragma unroll
    for (int o = 1; o < 64; o <<= 1) v += __shfl_xor(v, o);
    return v;
}
__device__ __forceinline__ float sigmoidf_(float x) { return 1.f / (1.f + __expf(-x)); }
#define LDS_WAIT() asm volatile("s_waitcnt lgkmcnt(0)" ::: "memory")
#define VM_WAIT() asm volatile("s_waitcnt vmcnt(0)" ::: "memory")

namespace pg8 {
#define PG8_LAS __attribute__((address_space(3)))
typedef unsigned short bf16_t;
constexpr int BM = 256, BK = 64, HALF = 128, HTB = HALF * BK * 2, STAGE_BYTES = 8 * HTB, NXCD = 8, WGM = 8;
__host__ __device__ __forceinline__ int lds_byte(int r, int c) { const int st = (r >> 4) * 2 + (c >> 5), rr = r & 15, cc = c & 31, ob = rr * 64 + cc * 2; return st * 1024 + (ob ^ (((ob >> 9) & 1) << 5)); }
__host__ __device__ __forceinline__ void stage_rc(int b, int& R, int& C) { const int st = b / 1024, sb = b % 1024, swz = sb ^ (((sb >> 9) & 1) << 5); R = (st >> 1) * 16 + swz / 64; C = (st & 1) * 32 + (swz % 64) / 2; }
__host__ __device__ __forceinline__ int perm32(int rho) { const int n = rho >> 4, i = rho & 15; return 8 * (i >> 2) + 4 * n + (i & 3); }
struct Unit { int pm, pn, e; };
__device__ __forceinline__ unsigned cvt_pk_bf16(float lo, float hi) { unsigned r; asm volatile("v_cvt_pk_bf16_f32 %0, %1, %2" : "=v"(r) : "v"(lo), "v"(hi)); return r; }

struct StaticOrder {
    const char* A; const char* Bt; size_t tstep;
    int nM, nN, nwg, G, c;
    __device__ void init(const void* A_, const void* Bt_, int M, int N, int K, int G_, int c_) { A = (const char*)A_; Bt = (const char*)Bt_; tstep = (size_t)BM * K * 2; nM = M / BM; nN = N / BM; nwg = nM * nN; G = G_; c = c_; }
    __device__ bool next(int i, Unit& u) const {
        const long L = (long)i * G + c; if (L >= nwg) return false;
        int wgid = (int)L; { const int q = nwg / NXCD, r = nwg % NXCD, xcd = wgid % NXCD, off = wgid / NXCD; wgid = (xcd < r ? xcd * (q + 1) : r * (q + 1) + (xcd - r) * q) + off; }
        const int nig = WGM * nN, gid = wgid / nig, fm = gid * WGM, gsz = (nM - fm) < WGM ? (nM - fm) : WGM;
        u.pm = fm + ((wgid % nig) % gsz); u.pn = (wgid % nig) / gsz; u.e = 0; return true;
    }
    __device__ __forceinline__ const char* pa(const Unit& u) const { return A + (size_t)u.pm * tstep; }
    __device__ __forceinline__ const char* pb(const Unit& u) const { return Bt + (size_t)u.pn * tstep; }
};
struct MoeOrder {
    const char* A; const char* Bt; size_t tstep, estep;
    const LAS unsigned char* blk_e; int nblk, nN, G, c;
    __device__ bool next(int i, Unit& u) const {
        const int L = i * G + c; if (L >= nblk * nN) return false;
        u.pm = L / nN; u.pn = L % nN; u.e = __builtin_amdgcn_readfirstlane((int)blk_e[u.pm]); return true;
    }
    __device__ __forceinline__ const char* pa(const Unit& u) const { return A + (size_t)u.pm * tstep; }
    __device__ __forceinline__ const char* pb(const Unit& u) const { return Bt + (size_t)u.e * estep + (size_t)u.pn * tstep; }
};

struct EpiStoreBf16 {
    static constexpr bool PERM = true;
    bf16_t* O; int ldc; const float* bias; int bias_estride;
    __device__ __forceinline__ void init(f32x4 (&acc)[2][2][4][2], const Unit& u, int wc, int fq) const {
        const int col0 = u.pn * BM + wc * 32 + 8 * fq;
#pragma unroll
        for (int b = 0; b < 2; ++b)
#pragma unroll
            for (int n = 0; n < 2; ++n) { const f32x4 bv = bias ? *(const f32x4*)(bias + (size_t)u.e * bias_estride + col0 + b * HALF + 4 * n) : (f32x4){0.f, 0.f, 0.f, 0.f};
#pragma unroll
                for (int a = 0; a < 2; ++a)
#pragma unroll
                    for (int m = 0; m < 4; ++m) acc[a][b][m][n] = bv; }
    }
    __device__ __forceinline__ void operator()(const f32x4 (&acc)[2][2][4][2], const Unit& u, int wr, int wc, int fr, int fq) const {
        const int row0 = u.pm * BM + wr * 64 + fr, col0 = u.pn * BM + wc * 32 + 8 * fq;
#pragma unroll
        for (int ai = 0; ai < 2; ++ai)
#pragma unroll
            for (int m = 0; m < 4; ++m) { bf16_t* rowp = O + (size_t)(row0 + ai * HALF + m * 16) * ldc + col0;
#pragma unroll
                for (int bj = 0; bj < 2; ++bj) { const f32x4 v0 = acc[ai][bj][m][0], v1 = acc[ai][bj][m][1];
                    u32x4 w; w.x = cvt_pk_bf16(v0[0], v0[1]); w.y = cvt_pk_bf16(v0[2], v0[3]); w.z = cvt_pk_bf16(v1[0], v1[1]); w.w = cvt_pk_bf16(v1[2], v1[3]);
                    *(u32x4*)(rowp + bj * HALF) = w; } }
    }
};
__device__ __forceinline__ float swiglu1(float g, float up) {
    g = fminf(g, 7.0f); up = fminf(fmaxf(up, -7.0f), 7.0f);
    return g * (1.f / (1.f + __expf(-1.702f * g))) * (up + 1.0f);
}
struct EpiSwiglu {
    static constexpr bool PERM = true;
    bf16_t* O; int ldc; const float* bias; int bias_estride;
    __device__ __forceinline__ void init(f32x4 (&acc)[2][2][4][2], const Unit& u, int wc, int fq) const {
        const int col0 = u.pn * BM + wc * 32 + 8 * fq;
#pragma unroll
        for (int b = 0; b < 2; ++b)
#pragma unroll
            for (int n = 0; n < 2; ++n) { const f32x4 bv = bias ? *(const f32x4*)(bias + (size_t)u.e * bias_estride + col0 + b * HALF + 4 * n) : (f32x4){0.f, 0.f, 0.f, 0.f};
#pragma unroll
                for (int a = 0; a < 2; ++a)
#pragma unroll
                    for (int m = 0; m < 4; ++m) acc[a][b][m][n] = bv; }
    }
    __device__ __forceinline__ void operator()(const f32x4 (&acc)[2][2][4][2], const Unit& u, int wr, int wc, int fr, int fq) const {
        const int row0 = u.pm * BM + wr * 64 + fr, col0 = u.pn * BM + wc * 32 + 8 * fq;
#pragma unroll
        for (int ai = 0; ai < 2; ++ai)
#pragma unroll
            for (int m = 0; m < 4; ++m) { bf16_t* rowp = O + (size_t)(row0 + ai * HALF + m * 16) * ldc + (col0 >> 1);
#pragma unroll
                for (int bj = 0; bj < 2; ++bj) { const f32x4 v0 = acc[ai][bj][m][0], v1 = acc[ai][bj][m][1];
                    u32x2 w; w.x = cvt_pk_bf16(swiglu1(v0[0], v0[1]), swiglu1(v0[2], v0[3])); w.y = cvt_pk_bf16(swiglu1(v1[0], v1[1]), swiglu1(v1[2], v1[3]));
                    *(u32x2*)(rowp + bj * (HALF / 2)) = w; } }
    }
};
struct EpiResidual {
    static constexpr bool PERM = false;
    float* X; int ldc; const float* gate_lat; const float* gate_ctx;
    __device__ __forceinline__ void init(f32x4 (&acc)[2][2][4][2], const Unit& u, int wc, int fq) const {
#pragma unroll
        for (int a = 0; a < 2; ++a)
#pragma unroll
            for (int b = 0; b < 2; ++b)
#pragma unroll
                for (int m = 0; m < 4; ++m)
#pragma unroll
                    for (int n = 0; n < 2; ++n) acc[a][b][m][n] = (f32x4){0.f, 0.f, 0.f, 0.f};
    }
    __device__ __forceinline__ void operator()(const f32x4 (&acc)[2][2][4][2], const Unit& u, int wr, int wc, int fr, int fq) const {
        const int row0 = u.pm * BM + wr * 64 + fr, col0 = u.pn * BM + wc * 32 + 4 * fq;
        const float* gp = (u.pm == 0) ? gate_ctx : gate_lat;
        f32x4 gv[2][2];
#pragma unroll
        for (int bj = 0; bj < 2; ++bj)
#pragma unroll
            for (int n = 0; n < 2; ++n) gv[bj][n] = *(const f32x4*)(gp + col0 + bj * HALF + n * 16);
#pragma unroll
        for (int ai = 0; ai < 2; ++ai)
#pragma unroll
            for (int m = 0; m < 4; ++m) { float* rowp = X + (size_t)(row0 + ai * HALF + m * 16) * ldc + col0;
#pragma unroll
                for (int bj = 0; bj < 2; ++bj)
#pragma unroll
                    for (int n = 0; n < 2; ++n) { f32x4* p = (f32x4*)(rowp + bj * HALF + n * 16); *p = *p + gv[bj][n] * acc[ai][bj][m][n]; }
                asm volatile("" ::: "memory"); }
    }
};
template <class Epi, class Sched, bool ALIGN_EPI = false, bool SP2 = false>
__device__ __forceinline__ void gemm_phase(PG8_LAS unsigned char* lds, const int tid, const int K, const Sched& S, const Epi& E) {
    const int wid = __builtin_amdgcn_readfirstlane(tid >> 6), lane = tid & 63, wr = wid >> 2, wc = wid & 3, fr = lane & 15, fq = lane >> 4;
    const int nt = K / BK;
    unsigned voffA[2], voffB[2];
#pragma unroll
    for (int i = 0; i < 2; ++i) { int R, C; stage_rc(tid * 16 + i * 8192, R, C); const int Rb = Epi::PERM ? ((R & ~31) + perm32(R & 31)) : R;
        voffA[i] = (unsigned)(R * K + C) * 2u; voffB[i] = (unsigned)(Rb * K + C) * 2u; }
    const size_t kstep = (size_t)(BK * 2);
    const size_t hstep = (size_t)HALF * K * 2;
        const unsigned ldsw = (unsigned)wid * 1024u;
    const int aoff = lds_byte(wr * 64 + fr, fq * 8), boff = lds_byte(wc * 32 + fr, fq * 8);
#define PG8_SA(b, h) (((b) * 2 + (h)) * HTB)
#define PG8_SB(b, h) ((4 + (b) * 2 + (h)) * HTB)
#define PG8_STAGE(bufoff, gbase, voff) do { _Pragma("unroll") for (int _i = 0; _i < 2; ++_i) \
        __builtin_amdgcn_global_load_lds((const unsigned*)((const char*)(gbase) + (voff)[_i]), (PG8_LAS unsigned*)(lds + (bufoff) + ldsw + _i * 8192), 16, 0, 0); } while (0)
#define PG8_LDA(dst, b, h) do { _Pragma("unroll") for (int m = 0; m < 4; ++m) _Pragma("unroll") for (int k = 0; k < 2; ++k) dst[m][k] = *(const PG8_LAS bf16x8*)(lds + PG8_SA(b, h) + aoff + m * 2048 + k * 1024); } while (0)
#define PG8_LDB(dst, b, h) do { _Pragma("unroll") for (int n = 0; n < 2; ++n) _Pragma("unroll") for (int k = 0; k < 2; ++k) dst[n][k] = *(const PG8_LAS bf16x8*)(lds + PG8_SB(b, h) + boff + n * 2048 + k * 1024); } while (0)
#define PG8_MMA(ai, bj, At, Bt) do { __builtin_amdgcn_s_setprio(1); _Pragma("unroll") for (int m = 0; m < 4; ++m) _Pragma("unroll") for (int n = 0; n < 2; ++n) _Pragma("unroll") for (int k = 0; k < 2; ++k) \
        acc[ai][bj][m][n] = __builtin_amdgcn_mfma_f32_16x16x32_bf16(Bt[n][k], At[m][k], acc[ai][bj][m][n], 0, 0, 0); __builtin_amdgcn_s_setprio(0); } while (0)
#define PG8_WAIT_V(n) asm volatile("s_waitcnt vmcnt(" #n ")" ::: "memory")
#define PG8_WAIT_L(n) asm volatile("s_waitcnt lgkmcnt(" #n ")" ::: "memory")
#define PG8_BAR __builtin_amdgcn_s_barrier()
#define PG8_SCHED __builtin_amdgcn_sched_barrier(0)
    Unit cur, nxt; int ui = 0;
    if (!S.next(0, cur)) return;
    f32x4 acc[2][2][4][2];
    E.init(acc, cur, wc, fq);
    bf16x8 At[4][2], B0[2][2], B1[2][2];
    const char* cA = S.pa(cur); const char* cB = S.pb(cur);
    if constexpr (SP2) {
        PG8_STAGE(PG8_SB(0, 0), cB, voffB); PG8_STAGE(PG8_SB(0, 1), cB + hstep, voffB); PG8_STAGE(PG8_SA(0, 0), cA, voffA); PG8_STAGE(PG8_SA(0, 1), cA + hstep, voffA);
        if (wr == 1) PG8_BAR;
        PG8_WAIT_V(2); PG8_BAR;
        PG8_STAGE(PG8_SB(1, 0), cB + kstep, voffB); PG8_STAGE(PG8_SA(1, 0), cA + kstep, voffA); PG8_STAGE(PG8_SB(1, 1), cB + hstep + kstep, voffB);
        PG8_WAIT_V(6); PG8_BAR;
    } else {
        PG8_STAGE(PG8_SB(0, 0), cB, voffB); PG8_STAGE(PG8_SA(0, 0), cA, voffA); PG8_STAGE(PG8_SB(0, 1), cB + hstep, voffB); PG8_STAGE(PG8_SA(0, 1), cA + hstep, voffA);
        if (wr == 1) PG8_BAR;
        PG8_WAIT_V(4); PG8_BAR;
        PG8_STAGE(PG8_SB(1, 0), cB + kstep, voffB); PG8_STAGE(PG8_SA(1, 0), cA + kstep, voffA); PG8_STAGE(PG8_SB(1, 1), cB + hstep + kstep, voffB);
        PG8_WAIT_V(6); PG8_BAR;
    }
    for (;;) {
        const bool has_next = S.next(ui + 1, nxt);
        const char* nA = has_next ? S.pa(nxt) : cA; const char* nB = has_next ? S.pb(nxt) : cB;
        for (int t = 0; t < nt; t += 2) {
            const bool last = (t == nt - 2);
            const char* a1 = cA + (size_t)(t + 1) * kstep;
            const char* a2 = last ? nA : cA + (size_t)(t + 2) * kstep; const char* b2 = last ? nB : cB + (size_t)(t + 2) * kstep;
            const char* a3 = a2 + kstep; const char* b3 = b2 + kstep;
            if constexpr (SP2) {
            PG8_LDB(B0, 0, 0); PG8_LDB(B1, 0, 1); PG8_SCHED; PG8_LDA(At, 0, 0); PG8_STAGE(PG8_SA(1, 1), a1 + hstep, voffA);
            PG8_WAIT_V(8); PG8_WAIT_L(0); PG8_BAR; PG8_MMA(0, 0, At, B0); PG8_MMA(0, 1, At, B1); PG8_BAR; PG8_SCHED;
            PG8_LDA(At, 0, 1); PG8_STAGE(PG8_SB(0, 0), b2, voffB); PG8_STAGE(PG8_SB(0, 1), b2 + hstep, voffB); PG8_STAGE(PG8_SA(0, 0), a2, voffA);
            PG8_WAIT_V(8); PG8_WAIT_L(0); PG8_BAR; PG8_MMA(1, 0, At, B0); PG8_MMA(1, 1, At, B1); PG8_BAR; PG8_SCHED;
            PG8_LDB(B0, 1, 0); PG8_LDB(B1, 1, 1); PG8_SCHED; PG8_LDA(At, 1, 0); PG8_STAGE(PG8_SA(0, 1), a2 + hstep, voffA);
            PG8_WAIT_V(8); PG8_WAIT_L(0); PG8_BAR; PG8_MMA(0, 0, At, B0); PG8_MMA(0, 1, At, B1); PG8_BAR; PG8_SCHED;
            PG8_LDA(At, 1, 1); PG8_STAGE(PG8_SB(1, 0), b3, voffB); PG8_STAGE(PG8_SB(1, 1), b3 + hstep, voffB); PG8_STAGE(PG8_SA(1, 0), a3, voffA);
            PG8_WAIT_V(8); PG8_WAIT_L(0); PG8_BAR; PG8_MMA(1, 0, At, B0); PG8_MMA(1, 1, At, B1); PG8_BAR; PG8_SCHED;
            } else {
            PG8_LDB(B0, 0, 0); PG8_SCHED; PG8_LDA(At, 0, 0); PG8_STAGE(PG8_SA(1, 1), a1 + hstep, voffA);
            PG8_WAIT_L(8); PG8_BAR; PG8_WAIT_L(0); PG8_MMA(0, 0, At, B0); PG8_BAR; PG8_SCHED;
            PG8_LDB(B1, 0, 1); PG8_STAGE(PG8_SB(0, 0), b2, voffB);
            PG8_BAR; PG8_WAIT_L(0); PG8_MMA(0, 1, At, B1); PG8_BAR;
            PG8_LDA(At, 0, 1); PG8_STAGE(PG8_SA(0, 0), a2, voffA);
            PG8_BAR; PG8_WAIT_L(0); PG8_MMA(1, 0, At, B0); PG8_BAR; PG8_SCHED;
            PG8_STAGE(PG8_SB(0, 1), b2 + hstep, voffB);
            PG8_WAIT_V(6); PG8_BAR; PG8_MMA(1, 1, At, B1); PG8_BAR;
            PG8_LDB(B0, 1, 0); PG8_SCHED; PG8_LDA(At, 1, 0); PG8_STAGE(PG8_SA(0, 1), a2 + hstep, voffA);
            PG8_WAIT_L(8); PG8_BAR; PG8_WAIT_L(0); PG8_MMA(0, 0, At, B0); PG8_BAR; PG8_SCHED;
            PG8_LDB(B1, 1, 1); PG8_STAGE(PG8_SB(1, 0), b3, voffB);
            PG8_BAR; PG8_WAIT_L(0); PG8_MMA(0, 1, At, B1); PG8_BAR;
            PG8_LDA(At, 1, 1); PG8_STAGE(PG8_SA(1, 0), a3, voffA);
            PG8_BAR; PG8_WAIT_L(0); PG8_MMA(1, 0, At, B0); PG8_BAR; PG8_SCHED;
            PG8_STAGE(PG8_SB(1, 1), b3 + hstep, voffB);
            PG8_WAIT_V(6); PG8_BAR; PG8_MMA(1, 1, At, B1); PG8_BAR;
            }
        }
        if constexpr (ALIGN_EPI) { if (wr == 0) PG8_BAR; }
        E(acc, cur, wr, wc, fr, fq);
        if (!has_next) break;
        E.init(acc, nxt, wc, fq);
        cur = nxt; cA = nA; cB = nB; ++ui;
        if constexpr (ALIGN_EPI) { if (wr == 1) PG8_BAR; }
    }
    PG8_WAIT_V(0);
    if constexpr (!ALIGN_EPI) { if (wr == 0) PG8_BAR; }
    PG8_BAR;
#undef PG8_SA
#undef PG8_SB
#undef PG8_STAGE
#undef PG8_LDA
#undef PG8_LDB
#undef PG8_MMA
#undef PG8_WAIT_V
#undef PG8_WAIT_L
#undef PG8_BAR
#undef PG8_SCHED
}
}

#define XB_TMO      128
#define XB_XCNT(j)  (256  + 64 * (j))
#define XB_XSUB(j)  (1280 + 64 * (j))
#define XB_XGEN(j)  (2304 + 64 * (j))
#define XB_TOP      3328
#define XB_TOPGEN   3392
#define XCD_BAR_WORDS 3456
#define XB_SPIN_CAP (1u << 18)
__device__ __forceinline__ unsigned xb_ld(unsigned* p)              { return __hip_atomic_load(p, __ATOMIC_RELAXED, __HIP_MEMORY_SCOPE_AGENT); }
__device__ __forceinline__ unsigned xb_add(unsigned* p, unsigned v) { return __hip_atomic_fetch_add(p, v, __ATOMIC_RELAXED, __HIP_MEMORY_SCOPE_AGENT); }
__device__ __forceinline__ unsigned xb_xcc_id() { return (unsigned)__builtin_amdgcn_s_getreg((3 << 11) | 20) & 0xFu; }
#define XB_SPIN(cond, bar) do { unsigned _sp = 0; while (cond) { __builtin_amdgcn_s_sleep(1); \
    if ((++_sp & 255u) == 0u) { if (xb_ld(&(bar)[XB_TMO])) break; if (_sp > XB_SPIN_CAP) { atomicAdd(&(bar)[XB_TMO], 1u); break; } } } } while (0)

struct XcdBarrier {
    unsigned* bar; unsigned x;
    volatile LAS unsigned* st;
};

__device__ __forceinline__ XcdBarrier xcd_barrier_post(unsigned* bar, volatile LAS unsigned* st) {
    XcdBarrier b; b.bar = bar; b.x = xb_xcc_id(); b.st = st;
    if (threadIdx.x == 0) (void)xb_add(&bar[XB_XCNT(b.x)], 1u);
    return b;
}
__device__ __forceinline__ void xcd_barrier_complete(unsigned* bar, unsigned x, unsigned& nloc, unsigned& nx) {
    const unsigned G = gridDim.x * gridDim.y * gridDim.z;
    unsigned sum, cnt, mine, sp = 0u;
    for (;;) {
        sum = 0u; cnt = 0u; mine = 0u;
#pragma unroll
        for (unsigned j = 0; j < 16; ++j) { const unsigned c = xb_ld(&bar[XB_XCNT(j)]); sum += c; cnt += (c > 0u) ? 1u : 0u; mine = (j == x) ? c : mine; }
        if (sum == G) break;
        __builtin_amdgcn_s_sleep(1);
        if ((++sp & 255u) == 0u) { if (xb_ld(&bar[XB_TMO])) break; if (sp > XB_SPIN_CAP) { atomicAdd(&bar[XB_TMO], 1u); break; } }
    }
    nloc = mine > 0u ? mine : 1u; nx = cnt > 0u ? cnt : 1u;
}

__device__ __forceinline__ void xcd_barrier(const XcdBarrier& b) {
    asm volatile("s_waitcnt vmcnt(0)" ::: "memory");
    __syncthreads();
    if (threadIdx.x == 0) {
        unsigned* bar = b.bar;
        __builtin_amdgcn_s_waitcnt(0);
        unsigned nloc = b.st[0], nx = b.st[1];
        if (nloc == 0u) { xcd_barrier_complete(bar, b.x, nloc, nx); b.st[0] = nloc; b.st[1] = nx; }
        const unsigned old = xb_add(&bar[XB_XSUB(b.x)], 1u);
        const unsigned gen = old / nloc;
        if (old + 1u == (gen + 1u) * nloc) {
            __builtin_amdgcn_fence(__ATOMIC_RELEASE, "agent");
            asm volatile("s_waitcnt vmcnt(0)" ::: "memory");
            const unsigned og = xb_add(&bar[XB_TOP], 1u);
            const unsigned tg = og / nx;
            if (og + 1u == (tg + 1u) * nx) xb_add(&bar[XB_TOPGEN], 1u);
            else XB_SPIN(xb_ld(&bar[XB_TOPGEN]) == tg, bar);
            __builtin_amdgcn_fence(__ATOMIC_ACQUIRE, "agent");
            xb_add(&bar[XB_XGEN(b.x)], 1u);
            asm volatile("s_waitcnt vmcnt(0)" ::: "memory");
        } else {
            XB_SPIN(xb_ld(&bar[XB_XGEN(b.x)]) == gen, bar);
            __builtin_amdgcn_fence(__ATOMIC_ACQUIRE, "agent");
            asm volatile("s_waitcnt vmcnt(0)" ::: "memory");
        }
    }
    __syncthreads();
}

struct Args {
    const float* in[31];
    float* out; unsigned char* ws;
    int ph_lo, ph_hi, use_bar, pad;
};
enum InIdx { I_X = 0, I_C, I_CTX, I_CCTX, I_ADAW, I_ADAB, I_N1G, I_N2G, I_WIN, I_WOUT, I_ASINK, I_BMIX, I_CREL, I_DCONV, I_DW0, I_DW2, I_DA0, I_DA2, I_DG2, I_DKK, I_DKA, I_DRK, I_DLNW, I_DLNB,
             I_RW, I_RB, I_WGU, I_BGU, I_WDN, I_BDN, I_FNG };
constexpr int NPL = 10;
constexpr int PH_TOTAL = 1 + DEPTH * NPL + 1;

struct DevIn {
    const LAS unsigned* tab;
    __device__ __forceinline__ const float* operator[](int i) const {
        const unsigned lo = __builtin_amdgcn_readfirstlane(((const volatile LAS unsigned*)tab)[2 * i]), hi = __builtin_amdgcn_readfirstlane(((const volatile LAS unsigned*)tab)[2 * i + 1]);
        return (const float*)(((unsigned long long)hi << 32) | lo);
    }
};
struct DArgs { DevIn in; float* out; };
struct Ctx {
    LAS unsigned char* lds;
    int tid, lane, wave, wg, G, gw, NGW;
    unsigned char* ws;
};

__device__ __forceinline__ void transpose_item(const float* W, int K, int N, bf16* WT, LAS float* scr, int item, int lane) {
    const int nblk = N / 32, kb = item / nblk, nb = item % nblk, k0 = 64 * kb, n0 = 32 * nb;
#pragma unroll 8
    for (int i = 0; i < 32; ++i) { const int kk = 2 * i + (lane >> 5); scr[kk * 33 + (lane & 31)] = W[(size_t)(k0 + kk) * N + n0 + (lane & 31)]; }
    LDS_WAIT(); asm volatile("" ::: "memory");
    const int c = lane & 7;
#pragma unroll
    for (int j = 0; j < 4; ++j) { const int n = (lane >> 3) + 8 * j; const LAS float* s = scr + (8 * c) * 33 + n;
        u32x4 o; o.x = pk2(s[0 * 33], s[1 * 33]); o.y = pk2(s[2 * 33], s[3 * 33]); o.z = pk2(s[4 * 33], s[5 * 33]); o.w = pk2(s[6 * 33], s[7 * 33]);
        *(u32x4*)(WT + (size_t)(n0 + n) * K + k0 + 8 * c) = o; }
    LDS_WAIT(); asm volatile("" ::: "memory");
}
__device__ __forceinline__ void phase_prologue(const Ctx& C, const DArgs& a) {
    LAS float* scr = (LAS float*)(C.lds + C.wave * 16384);
    constexpr int IT_IN = 16 * (INW / 32), IT_OUT = 16 * 32, IT_GU = 16 * 64, IT_DN = 16 * 32;
    constexpr long N_IN = 4L * IT_IN, N_OUT = 4L * IT_OUT, N_GU = 128L * IT_GU, N_DN = 128L * IT_DN, N_ALL = N_IN + N_OUT + N_GU + N_DN;
    const float* pwin = a.in[I_WIN]; const float* pwout = a.in[I_WOUT]; const float* pwgu = a.in[I_WGU]; const float* pwdn = a.in[I_WDN];
    for (long it = C.gw; it < N_ALL; it += C.NGW) {
        long r = it;
        if (r < N_IN) { const int l = (int)(r / IT_IN); transpose_item(pwin + (size_t)l * DM * INW, DM, INW, (bf16*)(C.ws + WS_WIN) + (size_t)l * INWP * DM, scr, (int)(r % IT_IN), C.lane); continue; } r -= N_IN;
        if (r < N_OUT) { const int l = (int)(r / IT_OUT); transpose_item(pwout + (size_t)l * DM * DM, DM, DM, (bf16*)(C.ws + WS_WOUT) + (size_t)l * DM * DM, scr, (int)(r % IT_OUT), C.lane); continue; } r -= N_OUT;
        if (r < N_GU) { const int le = (int)(r / IT_GU); transpose_item(pwgu + (size_t)le * DM * 2048, DM, 2048, (bf16*)(C.ws + WS_WGU) + (size_t)le * 2048 * DM, scr, (int)(r % IT_GU), C.lane); continue; } r -= N_GU;
        { const int le = (int)(r / IT_DN); transpose_item(pwdn + (size_t)le * DM * DM, DM, DM, (bf16*)(C.ws + WS_WDN) + (size_t)le * DM * DM, scr, (int)(r % IT_DN), C.lane); }
    }
    { const int gt = C.wg * NTHR + C.tid; constexpr int PADN = (INWP - INW) * DM / 8;
      for (int i = gt; i < 4 * PADN; i += C.G * NTHR) { const int l = i / PADN, r = i % PADN; *((u32x4*)((bf16*)(C.ws + WS_WIN) + ((size_t)l * INWP + INW) * DM) + r) = (u32x4){0u, 0u, 0u, 0u}; } }
    { float* tw = (float*)(C.ws + WS_TW); const int gt = C.wg * NTHR + C.tid;
      for (int i = gt; i < 16384; i += C.G * NTHR) { const float x = (float)i * (1.0f / 8192.0f); tw[i] = cospif(x); tw[16384 + i] = sinpif(x); } }
    { float* mt = (float*)(C.ws + WS_MTAB); const int gt = C.wg * NTHR + C.tid; const float* pbmix = a.in[I_BMIX];
      for (int i = gt; i < 4 * 4 * 64 * 64; i += C.G * NTHR) { const int e = i & 63, c = (i >> 6) & 63, g = (i >> 12) & 3, l = i >> 14;
          const float* w = pbmix + ((size_t)(l * 4 + g) * 64) * 64 + e; float sc = 0.f, ss = 0.f;
          for (int cp = 0; cp < 64; ++cp) { const float x = (float)((c * cp) & 63) * (1.0f / 32.0f); const float wv = w[cp * 64]; sc += cospif(x) * wv; ss += sinpif(x) * wv; }
          mt[((size_t)(l * 2 + 0) * 4 + g) * 4096 + c * 64 + e] = sc; mt[((size_t)(l * 2 + 1) * 4 + g) * 4096 + c * 64 + e] = ss; } }
    { LAS float* red = (LAS float*)(C.lds);
      __syncthreads();
      float* mod = (float*)(C.ws + WS_MOD);
      const float* pc = a.in[I_C]; const float* pcc = a.in[I_CCTX]; const float* padaw = a.in[I_ADAW]; const float* padab = a.in[I_ADAB];
      for (int u = C.wg; u < 4 * 24; u += C.G) { const int l = u / 24, jb = u % 24, j0 = jb * 256 + 4 * C.lane;
          f32x4 s0 = {0.f, 0.f, 0.f, 0.f}, s1 = {0.f, 0.f, 0.f, 0.f};
          const float* w = padaw + (size_t)l * DM * 6144 + j0;
          for (int k = C.wave * 128; k < C.wave * 128 + 128; ++k) { const float c0 = pc[k], c1 = pcc[k]; const float a0 = c0 * sigmoidf_(c0), a1 = c1 * sigmoidf_(c1);
              const f32x4 wv = *(const f32x4*)(w + (size_t)k * 6144); s0 += wv * a0; s1 += wv * a1; }
          *(LAS f32x4*)(red + ((C.wave * 2 + 0) * 64 + C.lane) * 4) = s0; *(LAS f32x4*)(red + ((C.wave * 2 + 1) * 64 + C.lane) * 4) = s1;
          __syncthreads();
          if (C.tid < 512) { const int v = C.tid >> 8, j = C.tid & 255; float s = 0.f;
#pragma unroll
              for (int wv = 0; wv < 8; ++wv) s += red[(wv * 2 + v) * 256 + j];
              mod[(size_t)(l * 2 + v) * 6144 + jb * 256 + j] = s + padab[(size_t)l * 6144 + jb * 256 + j]; }
          __syncthreads(); } }
}

__device__ __forceinline__ void load_row(const float* p, int lane, f32x4 (&v)[4]) {
#pragma unroll
    for (int j = 0; j < 4; ++j) v[j] = *((const f32x4*)p + lane + 64 * j);
}
__device__ __forceinline__ void moe_combine_row(const Ctx& C, int row, f32x4 (&v)[4], const float* gt2) {
    const int* dest = (const int*)(C.ws + WS_ROUTE) + (size_t)3 * ROWS * 4; const float* gate = (const float*)(C.ws + WS_ROUTE) + (size_t)1 * ROWS * 4;
    const bf16* YB = (const bf16*)(C.ws + WS_XG);
    f32x4 s[4];
#pragma unroll
    for (int j = 0; j < 4; ++j) s[j] = (f32x4){0.f, 0.f, 0.f, 0.f};
#pragma unroll
    for (int k = 0; k < 4; ++k) { const int d = dest[row * 4 + k]; const float g = gate[row * 4 + k]; const u32x2* yp = (const u32x2*)(YB + (size_t)d * DM) + C.lane;
#pragma unroll
        for (int j = 0; j < 4; ++j) { const u32x2 w = yp[64 * j]; s[j] += (f32x4){bflo(w.x), bfhi(w.x), bflo(w.y), bfhi(w.y)} * g; } }
#pragma unroll
    for (int j = 0; j < 4; ++j) v[j] += *((const f32x4*)gt2 + C.lane + 64 * j) * s[j];
}
__device__ __forceinline__ float row_rstd(const f32x4 (&v)[4]) {
    float s = 0.f;
#pragma unroll
    for (int j = 0; j < 4; ++j) s += (v[j].x * v[j].x + v[j].y * v[j].y) + (v[j].z * v[j].z + v[j].w * v[j].w);
    return rsqrtf(wave_sum(s) * (1.f / DM) + 1e-6f);
}
__device__ __forceinline__ void phase_norm1(const Ctx& C, const DArgs& a, int l) {
    float* XS = (float*)(C.ws + WS_XS); bf16* H = (bf16*)(C.ws + WS_H); const float* mod = (const float*)(C.ws + WS_MOD);
    const float* g1 = a.in[I_N1G] + (size_t)l * DM;
    const float* pctx = a.in[I_CTX]; const float* px = a.in[I_X];
    for (int row = C.gw; row < ROWS; row += C.NGW) {
        const bool isctx = row < NCTX; f32x4 v[4];
        if (l == 0) { load_row(isctx ? pctx + (size_t)row * DM : px + (size_t)(row - NCTX) * DM, C.lane, v); }
        else { load_row(XS + (size_t)row * DM, C.lane, v);
               if (!(l == DEPTH && isctx)) moe_combine_row(C, row, v, mod + (size_t)((l - 1) * 2 + (isctx ? 1 : 0)) * 6144 + 5 * DM); }
        if (l == 0 || true) {
#pragma unroll
            for (int j = 0; j < 4; ++j) *((f32x4*)(XS + (size_t)row * DM) + C.lane + 64 * j) = v[j]; }
        const float rstd = row_rstd(v);
        const float* md = mod + (size_t)(l * 2 + (isctx ? 1 : 0)) * 6144;
        u32x2* o = (u32x2*)(H + (size_t)row * DM) + C.lane;
#pragma unroll
        for (int j = 0; j < 4; ++j) { const f32x4 g = *((const f32x4*)g1 + C.lane + 64 * j), sh = *((const f32x4*)md + C.lane + 64 * j), sc = *((const f32x4*)(md + DM) + C.lane + 64 * j);
            const f32x4 y = v[j] * rstd * g * (sc + 1.0f) + sh; u32x2 w; w.x = pk2(y.x, y.y); w.y = pk2(y.z, y.w); o[64 * j] = w; }
    }
}
__device__ __forceinline__ void phase_final(const Ctx& C, const DArgs& a) {
    const float* XS = (const float*)(C.ws + WS_XS); const float* mod = (const float*)(C.ws + WS_MOD); const float* g = a.in[I_FNG];
    for (int row = NCTX + C.gw; row < ROWS; row += C.NGW) {
        f32x4 v[4]; load_row(XS + (size_t)row * DM, C.lane, v);
        moe_combine_row(C, row, v, mod + (size_t)((DEPTH - 1) * 2 + 0) * 6144 + 5 * DM);
        const float rstd = row_rstd(v);
        float* o = a.out + (size_t)(row - NCTX) * DM;
#pragma unroll
        for (int j = 0; j < 4; ++j) *((f32x4*)o + C.lane + 64 * j) = v[j] * rstd * *((const f32x4*)g + C.lane + 64 * j);
    }
}
__device__ __forceinline__ void phase_norm2(const Ctx& C, const DArgs& a, int l) {
    const float* XS = (const float*)(C.ws + WS_XS); bf16* H = (bf16*)(C.ws + WS_H); const float* mod = (const float*)(C.ws + WS_MOD);
    const float* g2 = a.in[I_N2G] + (size_t)l * DM; const float* rw = a.in[I_RW] + (size_t)l * DM * NEXP; const float* rb = a.in[I_RB] + (size_t)l * NEXP;
    int* tok_e = (int*)(C.ws + WS_ROUTE); float* gate = (float*)(C.ws + WS_ROUTE) + (size_t)1 * ROWS * 4; int* slot = (int*)(C.ws + WS_ROUTE) + (size_t)2 * ROWS * 4;
    LAS float* hrow = (LAS float*)(C.lds + C.wave * 4096);
    LAS int* hist = (LAS int*)(C.lds + MISC_OFF + 64);
    if (C.tid < NEXP) hist[C.tid] = 0;
    __syncthreads();
    const int row_lo = (l == DEPTH - 1) ? NCTX : 0;
    for (int row = row_lo + C.gw; row < ROWS; row += C.NGW) {
        const bool isctx = row < NCTX; f32x4 v[4]; load_row(XS + (size_t)row * DM, C.lane, v);
        const float rstd = row_rstd(v);
        const float* md = mod + (size_t)(l * 2 + (isctx ? 1 : 0)) * 6144 + 3 * DM;
        u32x2* o = (u32x2*)(H + (size_t)row * DM) + C.lane;
#pragma unroll
        for (int j = 0; j < 4; ++j) { const f32x4 g = *((const f32x4*)g2 + C.lane + 64 * j), sh = *((const f32x4*)md + C.lane + 64 * j), sc = *((const f32x4*)(md + DM) + C.lane + 64 * j);
            const f32x4 y = v[j] * rstd * g * (sc + 1.0f) + sh; u32x2 w; w.x = pk2(y.x, y.y); w.y = pk2(y.z, y.w); o[64 * j] = w;
            *(LAS f32x4*)(hrow + 4 * (C.lane + 64 * j)) = y; }
        LDS_WAIT(); asm volatile("" ::: "memory");
        const int e = C.lane & 31, hf = C.lane >> 5; float s = 0.f;
        const float* rwp = rw + (size_t)(hf * 512) * NEXP + e; const LAS float* hp = hrow + hf * 512;
#pragma unroll 8
        for (int k = 0; k < 512; ++k) s += hp[k] * rwp[(size_t)k * NEXP];
        s += __shfl_xor(s, 32);
        s += rb[e];
        float val = s; int te[4]; float tv[4];
#pragma unroll
        for (int k = 0; k < 4; ++k) { float bv = val; int bi = e;
#pragma unroll
            for (int o2 = 1; o2 < 32; o2 <<= 1) { const float ov = __shfl_xor(bv, o2); const int oi = __shfl_xor(bi, o2); if (ov > bv || (ov == bv && oi < bi)) { bv = ov; bi = oi; } }
            te[k] = bi; tv[k] = bv; if (e == bi) val = -3.0e38f; }
        if (C.lane == 0) { const float m = tv[0]; float p[4], ps = 0.f;
#pragma unroll
            for (int k = 0; k < 4; ++k) { p[k] = __expf(tv[k] - m); ps += p[k]; }
#pragma unroll
            for (int k = 0; k < 4; ++k) { tok_e[row * 4 + k] = te[k]; gate[row * 4 + k] = p[k] / ps; slot[row * 4 + k] = __hip_atomic_fetch_add(&hist[te[k]], 1, __ATOMIC_RELAXED, __HIP_MEMORY_SCOPE_WORKGROUP); } }
        asm volatile("" ::: "memory");
    }
    __syncthreads();
    if (C.tid < NEXP) ((int*)(C.ws + WS_CNT))[C.wg * NEXP + C.tid] = hist[C.tid];
}
__device__ __forceinline__ int moe_tables(const Ctx& C) {
    const int* cnt = (const int*)(C.ws + WS_CNT);
    LAS int* part = (LAS int*)(C.lds);
    LAS int* pstart = (LAS int*)(C.lds + MISC_OFF + 256); LAS int* wgbase = pstart + 40; LAS int* tot = wgbase + 32; LAS int* nblk_s = tot + 32;
    LAS unsigned char* blk_e = (LAS unsigned char*)(C.lds + MISC_OFF + 1024);
    __syncthreads();
    { const int e = C.tid & 31, p = C.tid >> 5; int t = 0, pre = 0;
#pragma unroll 1
      for (int w = p * 16; w < p * 16 + 16; ++w) { const int c = cnt[w * NEXP + e]; t += c; if (w < C.wg) pre += c; }
      part[(p * 32 + e) * 2] = t; part[(p * 32 + e) * 2 + 1] = pre; }
    __syncthreads();
    if (C.tid < NEXP) { int t = 0, pre = 0;
#pragma unroll 1
        for (int p = 0; p < 16; ++p) { t += part[(p * 32 + C.tid) * 2]; pre += part[(p * 32 + C.tid) * 2 + 1]; }
        tot[C.tid] = t; wgbase[C.tid] = pre; }
    __syncthreads();
    if (C.tid == 0) { int b = 0;
#pragma unroll 1
        for (int e = 0; e < NEXP; ++e) { pstart[e] = b * 256; b += (tot[e] + 255) >> 8; }
        pstart[NEXP] = b * 256; nblk_s[0] = b; }
    __syncthreads();
    if (C.tid < NEXP) wgbase[C.tid] += pstart[C.tid];
    if (C.tid < MOE_MAXBLK) { int e = 0;
#pragma unroll 1
        for (int k = 1; k < NEXP; ++k) if (pstart[k] <= C.tid * 256) e = k;
        blk_e[C.tid] = (unsigned char)e; }
    __syncthreads();
    return __builtin_amdgcn_readfirstlane(nblk_s[0]);
}
__device__ __forceinline__ void phase_gather(const Ctx& C, const DArgs& a, int l) {
    moe_tables(C);
    const LAS int* wgbase = (const LAS int*)(C.lds + MISC_OFF + 256) + 40;
    const int* tok_e = (const int*)(C.ws + WS_ROUTE); const int* slot = (const int*)(C.ws + WS_ROUTE) + (size_t)2 * ROWS * 4; int* dest = (int*)(C.ws + WS_ROUTE) + (size_t)3 * ROWS * 4;
    const bf16* H = (const bf16*)(C.ws + WS_H); bf16* XG = (bf16*)(C.ws + WS_XG);
    const int row_lo = (l == DEPTH - 1) ? NCTX : 0;
    for (int row = row_lo + C.gw; row < ROWS; row += C.NGW) {
        const u32x4* src = (const u32x4*)(H + (size_t)row * DM) + C.lane; const u32x4 v0 = src[0], v1 = src[64];
#pragma unroll
        for (int k = 0; k < 4; ++k) { const int d = wgbase[tok_e[row * 4 + k]] + slot[row * 4 + k]; if (C.lane == 0) dest[row * 4 + k] = d;
            u32x4* dp = (u32x4*)(XG + (size_t)d * DM) + C.lane; dp[0] = v0; dp[64] = v1; }
    }
}

__device__ __forceinline__ void mix1_rope(const Ctx& C) {
    bf16* P = (bf16*)(C.ws + WS_P);
    const long total = (long)SEQ * 192;
    for (long i = (long)C.wg * NTHR + C.tid; i < total; i += (long)C.G * NTHR) {
        const int j = (int)(i & 31), hh = (int)((i >> 5) % 6), t = (int)(i / 192);
        const int col = (hh < 4) ? (C_AQ + hh * 64) : (C_AK + (hh - 4) * 64);
        const float pos = (j < 16) ? (float)(t >> 6) : (float)(t & 63);
        const float inv = __powf(10000.0f, -(float)(j & 15) * (1.0f / 16.0f));
        const float ang = pos * inv * 0.31830988618379067f;
        const float cs = cospif(ang), sn = sinpif(ang);
        bf16* p = P + (size_t)(NCTX + t) * INWP + col;
        const float x1 = bf2f(p[j]), x2 = bf2f(p[j + 32]);
        p[j] = (bf16)f2bf(x1 * cs - x2 * sn); p[j + 32] = (bf16)f2bf(x2 * cs + x1 * sn);
    }
}
__device__ __forceinline__ float conv3(const bf16* P, int row, int col, const float* cw, int cc) {
    const bool first = (row == 0) || (row == NCTX), last = (row == NCTX - 1) || (row == ROWS - 1);
    float s = cw[768 + cc] * bf2f(P[(size_t)row * INWP + col]);
    if (!first) s += cw[cc] * bf2f(P[(size_t)(row - 1) * INWP + col]);
    if (!last) s += cw[2 * 768 + cc] * bf2f(P[(size_t)(row + 1) * INWP + col]);
    return s;
}
__device__ __forceinline__ void mix1_rwkv_prep(const Ctx& C, const DArgs& a, int l) {
    const bf16* P = (const bf16*)(C.ws + WS_P); float* SC = (float*)(C.ws + WS_SC);
    LAS float* lo = (LAS float*)(C.lds);
    const float* cw = a.in[I_DCONV] + (size_t)l * 3 * 768;
    const float* w0 = a.in[I_DW0] + (size_t)l * 512; const float* w2 = a.in[I_DW2] + (size_t)l * 2 * 64 * 256;
    const float* a0 = a.in[I_DA0] + (size_t)l * 512; const float* a2 = a.in[I_DA2] + (size_t)l * 2 * 64 * 256;
    const float* kkw = a.in[I_DKK] + (size_t)l * 256; const float* kaw = a.in[I_DKA] + (size_t)l * 256;
    const int half = C.tid >> 8, c = C.tid & 255;
    for (int pr = C.wg; pr < ROWS / 2; pr += C.G) {
        const int row = 2 * pr + half;
        __syncthreads();
        { const float x = bf2f(P[(size_t)row * INWP + C_WL + c]); lo[half * 256 + c] = (c < 128) ? tanhf(x) : x; }
        __syncthreads();
        const float r = conv3(P, row, C_DR + c, cw, c), k = conv3(P, row, C_DK + c, cw, 256 + c), v = conv3(P, row, C_DV + c, cw, 512 + c);
        float kk = k * kkw[c]; const float n2 = wave_sum(kk * kk); kk *= rsqrtf(fmaxf(n2, 1e-24f));
        float* sc = SC + (size_t)row * 9 * 256;
        sc[c] = r; sc[256 + c] = v; sc[512 + c] = -kk;
#pragma unroll
        for (int d = 0; d < 2; ++d) {
            float wp = w0[d * 256 + c], ap = a0[d * 256 + c];
            const LAS float* wl = lo + half * 256 + d * 64; const LAS float* al = lo + half * 256 + 128 + d * 64;
            const float* w2p = w2 + (size_t)d * 64 * 256 + c; const float* a2p = a2 + (size_t)d * 64 * 256 + c;
#pragma unroll 8
            for (int i = 0; i < 64; ++i) { wp += wl[i] * w2p[i * 256]; ap += al[i] * a2p[i * 256]; }
            const float nw = -wp, sp = fmaxf(nw, 0.f) + log1pf(__expf(-fabsf(nw)));
            const float dec = __expf(-__expf(-sp - 0.5f));
            const float as = sigmoidf_(ap);
            sc[(3 + 3 * d) * 256 + c] = dec; sc[(4 + 3 * d) * 256 + c] = k * (1.0f + (as - 1.0f) * kaw[c]); sc[(5 + 3 * d) * 256 + c] = kk * as;
        }
    }
    __syncthreads();
}
__device__ __forceinline__ void mix1_fourier1(const Ctx& C) {
    const bf16* P = (const bf16*)(C.ws + WS_P); const float* tw = (const float*)(C.ws + WS_TW);
    float* FYR = (float*)(C.ws + WS_FYR); float* FYI = (float*)(C.ws + WS_FYI);
    LAS float* ct = (LAS float*)(C.lds + 4096); LAS float* st = ct + 128;
    __syncthreads();
    if (C.tid < 128) { ct[C.tid] = tw[128 * C.tid]; st[C.tid] = tw[16384 + 128 * C.tid]; }
    __syncthreads();
    for (int u = C.wg; u < 128 * 128 * 256 / NTHR; u += C.G) {
        const int idx = u * NTHR + C.tid, ch = idx & 255, t2 = (idx >> 8) & 127, k1 = idx >> 15;
        float dr = 0.f, di = 0.f;
        const bf16* up = P + (size_t)(NCTX + t2) * INWP + C_BU + ch;
#pragma unroll 8
        for (int t1 = 0; t1 < 128; ++t1) { const float x = bf2f(up[(size_t)t1 * 128 * INWP]); const int m = (k1 * t1) & 127; dr += x * ct[m]; di -= x * st[m]; }
        const float cp = tw[t2 * k1], sp = tw[16384 + t2 * k1];
        FYR[idx] = dr * cp + di * sp; FYI[idx] = di * cp - dr * sp;
    }
    __syncthreads();
}

__device__ __forceinline__ void attn_key(const float (&q)[64], float& m, float& l, float (&acc)[64], const bf16* kp, const bf16* vp, float bias) {
    float s = 0.f;
#pragma unroll
    for (int c8 = 0; c8 < 8; ++c8) { const u32x4 w = *((const u32x4*)kp + c8);
        s += q[8 * c8 + 0] * bflo(w.x) + q[8 * c8 + 1] * bfhi(w.x) + q[8 * c8 + 2] * bflo(w.y) + q[8 * c8 + 3] * bfhi(w.y) + q[8 * c8 + 4] * bflo(w.z) + q[8 * c8 + 5] * bfhi(w.z) + q[8 * c8 + 6] * bflo(w.w) + q[8 * c8 + 7] * bfhi(w.w); }
    s = s * 0.125f + bias;
    const float mn = fmaxf(m, s), corr = __expf(m - mn), p = __expf(s - mn);
    l = l * corr + p; m = mn;
#pragma unroll
    for (int c8 = 0; c8 < 8; ++c8) { const u32x4 w = *((const u32x4*)vp + c8);
        acc[8 * c8 + 0] = acc[8 * c8 + 0] * corr + p * bflo(w.x); acc[8 * c8 + 1] = acc[8 * c8 + 1] * corr + p * bfhi(w.x);
        acc[8 * c8 + 2] = acc[8 * c8 + 2] * corr + p * bflo(w.y); acc[8 * c8 + 3] = acc[8 * c8 + 3] * corr + p * bfhi(w.y);
        acc[8 * c8 + 4] = acc[8 * c8 + 4] * corr + p * bflo(w.z); acc[8 * c8 + 5] = acc[8 * c8 + 5] * corr + p * bfhi(w.z);
        acc[8 * c8 + 6] = acc[8 * c8 + 6] * corr + p * bflo(w.w); acc[8 * c8 + 7] = acc[8 * c8 + 7] * corr + p * bfhi(w.w); }
}
__device__ __forceinline__ void attn_item(const Ctx& C, const DArgs& a, int l, int kind, int idx) {
    const bf16* P = (const bf16*)(C.ws + WS_P); bf16* MIX = (bf16*)(C.ws + WS_MIX);
    const bool isA = kind < 2, lat = (kind & 1) == 0;
    const float* asink = a.in[I_ASINK];
    const int nq = lat ? SEQ : NCTX; const int h = idx / nq, t = idx % nq;
    const int qrow = lat ? NCTX + t : t;
    const int qcol = (isA ? C_AQ : C_CQ) + h * 64, kcol = isA ? (C_AK + (h >> 1) * 64) : (C_CK + h * 64), vcol = isA ? (C_AV + (h >> 1) * 64) : (C_CV + h * 64);
    float q[64], acc[64]; float m = -1.0e30f, ls = 0.f;
#pragma unroll
    for (int c8 = 0; c8 < 8; ++c8) { const u32x4 w = *((const u32x4*)(P + (size_t)qrow * INWP + qcol) + c8);
        q[8 * c8 + 0] = bflo(w.x); q[8 * c8 + 1] = bfhi(w.x); q[8 * c8 + 2] = bflo(w.y); q[8 * c8 + 3] = bfhi(w.y); q[8 * c8 + 4] = bflo(w.z); q[8 * c8 + 5] = bfhi(w.z); q[8 * c8 + 6] = bflo(w.w); q[8 * c8 + 7] = bfhi(w.w); }
#pragma unroll
    for (int d = 0; d < 64; ++d) acc[d] = 0.f;
    if (lat && isA) {
        const int j0 = t - 128 < 0 ? 0 : t - 128, j1 = t + 128 > SEQ - 1 ? SEQ - 1 : t + 128;
        for (int j = j0; j <= j1; ++j) attn_key(q, m, ls, acc, P + (size_t)(NCTX + j) * INWP + kcol, P + (size_t)(NCTX + j) * INWP + vcol, 0.f);
    }
    if (lat && !isA) {
        const int r = t >> 6, cq = t & 63; int r0 = r - 4; r0 = r0 < 0 ? 0 : (r0 > 248 ? 248 : r0); int c0 = cq - 8; c0 = c0 < 0 ? 0 : (c0 > 48 ? 48 : c0);
        const float* rb = a.in[I_CREL] + ((size_t)l * 4 + h) * 15 * 31;
        for (int kr = r0; kr < r0 + 8; ++kr)
            for (int kc = c0; kc < c0 + 16; ++kc) { int ci = kc - cq + 15; ci = ci < 0 ? 0 : (ci > 30 ? 30 : ci); const int j = kr * 64 + kc;
                attn_key(q, m, ls, acc, P + (size_t)(NCTX + j) * INWP + kcol, P + (size_t)(NCTX + j) * INWP + vcol, rb[(kr - r + 7) * 31 + ci]); }
    }
    for (int j = 0; j < NCTX; ++j) attn_key(q, m, ls, acc, P + (size_t)j * INWP + kcol, P + (size_t)j * INWP + vcol, 0.f);
    if (isA) { const float sk = asink[l * 4 + h]; const float mn = fmaxf(m, sk), corr = __expf(m - mn); ls = ls * corr + __expf(sk - mn);
#pragma unroll
        for (int d = 0; d < 64; ++d) acc[d] *= corr; }
    const float inv = 1.0f / ls;
    bf16* o = MIX + (size_t)qrow * DM + (isA ? 0 : 512) + h * 64;
#pragma unroll
    for (int c8 = 0; c8 < 8; ++c8) { u32x4 w; w.x = pk2(acc[8 * c8] * inv, acc[8 * c8 + 1] * inv); w.y = pk2(acc[8 * c8 + 2] * inv, acc[8 * c8 + 3] * inv); w.z = pk2(acc[8 * c8 + 4] * inv, acc[8 * c8 + 5] * inv); w.w = pk2(acc[8 * c8 + 6] * inv, acc[8 * c8 + 7] * inv);
        *((u32x4*)o + c8) = w; }
}
__device__ __forceinline__ void fourier2_unit(const Ctx& C, int l, int u, bool ctx) {
    const bf16* P = (const bf16*)(C.ws + WS_P); const float* tw = (const float*)(C.ws + WS_TW); bf16* MIX = (bf16*)(C.ws + WS_MIX);
    const float* FYR = (const float*)(C.ws + WS_FYR); const float* FYI = (const float*)(C.ws + WS_FYI);
    const float* mt = (const float*)(C.ws + WS_MTAB) + (size_t)l * 2 * 4 * 4096;
    LAS float* xr = (LAS float*)(C.lds + 8192); LAS float* xi = xr + 512;
    const int tl = C.tid >> 8, ch = C.tid & 255, tp = 2 * u + tl;
    float sr = 0.f, si = 0.f;
    if (!ctx) { const int k1 = tp & 127, k2 = tp >> 7; const float* yr = FYR + (size_t)k1 * 128 * 256 + ch; const float* yi = FYI + (size_t)k1 * 128 * 256 + ch;
#pragma unroll 8
        for (int t2 = 0; t2 < 128; ++t2) { const int m = ((t2 * k2) & 127) * 128; const float c = tw[m], s = tw[16384 + m]; const float a = yr[t2 * 256], b = yi[t2 * 256]; sr += a * c + b * s; si += b * c - a * s; } }
    else {
#pragma unroll 8
        for (int t = 0; t < NCTX; ++t) { const int m = ((t * tp) & 255) * 64; const float x = bf2f(P[(size_t)t * INWP + C_BU + ch]); sr += x * tw[m]; si -= x * tw[16384 + m]; } }
    __syncthreads();
    xr[tl * 256 + ch] = sr; xi[tl * 256 + ch] = si;
    __syncthreads();
    const int g = ch >> 6, e = ch & 63; const float* mc = mt + (size_t)(0 * 4 + g) * 4096 + e; const float* ms = mt + (size_t)(1 * 4 + g) * 4096 + e;
    const LAS float* xrp = xr + tl * 256 + g * 64; const LAS float* xip = xi + tl * 256 + g * 64; float o = 0.f;
#pragma unroll 8
    for (int c = 0; c < 64; ++c) o += xrp[c] * mc[c * 64] + xip[c] * ms[c * 64];
    o *= ctx ? (1.0f / 128.0f) : (1.0f / 1024.0f);
    MIX[(size_t)((ctx ? 0 : NCTX) + tp) * DM + 256 + ch] = (bf16)f2bf(o);
}
__device__ __forceinline__ void rwkv_scan_seq(const Ctx& C, int b) {
    const float* SC = (const float*)(C.ws + WS_SC); float* YS = (float*)(C.ws + WS_YS);
    const int d = b >> 2, h = b & 3, il = C.lane & 15, jq = C.lane >> 4, i = (C.wave & 3) * 16 + il;
    LAS float* buf = (LAS float*)(C.lds + 16384);
    float S[16];
#pragma unroll
    for (int m = 0; m < 16; ++m) S[m] = 0.f;
    for (int p0 = 0; p0 < ROWS; p0 += 16) {
        __syncthreads();
#pragma unroll
        for (int t = 0; t < 3; ++t) { const int f = C.tid + 512 * t;
            const int st = f / 96, q = (f % 96) / 16, c4 = f % 16, p = p0 + st;
            const int row = (d == 0) ? p : (p < NCTX ? NCTX - 1 - p : ROWS + NCTX - 1 - p);
            const int qq = (q == 0) ? 2 : (q == 1) ? 3 + 3 * d : (q == 2) ? 4 + 3 * d : (q == 3) ? 5 + 3 * d : (q == 4) ? 0 : 1;
            *(LAS f32x4*)(buf + (st * 6 + q) * 64 + 4 * c4) = *(const f32x4*)(SC + ((size_t)row * 9 + qq) * 256 + h * 64 + 4 * c4); }
        __syncthreads();
        if (C.wave < 4) {
            for (int st = 0; st < 16; ++st) {
                const int p = p0 + st; const int row = (d == 0) ? p : (p < NCTX ? NCTX - 1 - p : ROWS + NCTX - 1 - p);
                const LAS float* sb = buf + st * 6 * 64 + jq * 16;
                f32x4 av[4], wv[4], kv[4], bv[4], rv[4];
#pragma unroll
                for (int m = 0; m < 4; ++m) { av[m] = *(const LAS f32x4*)(sb + 4 * m); wv[m] = *(const LAS f32x4*)(sb + 64 + 4 * m); kv[m] = *(const LAS f32x4*)(sb + 128 + 4 * m);
                    bv[m] = *(const LAS f32x4*)(sb + 192 + 4 * m); rv[m] = *(const LAS f32x4*)(sb + 256 + 4 * m); }
                const float v = buf[st * 6 * 64 + 320 + i];
                float sa = 0.f;
#pragma unroll
                for (int m = 0; m < 16; ++m) sa += S[m] * av[m >> 2][m & 3];
                sa += __shfl_xor(sa, 16); sa += __shfl_xor(sa, 32);
                float y = 0.f;
#pragma unroll
                for (int m = 0; m < 16; ++m) { S[m] = S[m] * wv[m >> 2][m & 3] + sa * bv[m >> 2][m & 3] + v * kv[m >> 2][m & 3]; y += S[m] * rv[m >> 2][m & 3]; }
                y += __shfl_xor(y, 16); y += __shfl_xor(y, 32);
                if (jq == 0) YS[((size_t)d * ROWS + row) * 256 + h * 64 + i] = y;
            }
        }
    }
    __syncthreads();
}
__device__ __forceinline__ void phase_mix2(const Ctx& C, const DArgs& a, int l) {
    const bool emit_ctx = l < DEPTH - 1;
    if (C.wg < 8) rwkv_scan_seq(C, C.wg);
    const int nA = SEQ * 4 / NTHR, nCtx = emit_ctx ? NCTX * 4 / NTHR : 0, nAtt = 2 * nA + 2 * nCtx;
    const int nF = SEQ / 2, nFc = emit_ctx ? NCTX / 2 : 0;
    for (int u = C.wg; u < nAtt + nF + nFc; u += C.G) {
        if (u < nA) attn_item(C, a, l, 0, u * NTHR + C.tid);
        else if (u < 2 * nA) attn_item(C, a, l, 2, (u - nA) * NTHR + C.tid);
        else if (u < 2 * nA + nCtx) attn_item(C, a, l, 1, (u - 2 * nA) * NTHR + C.tid);
        else if (u < nAtt) attn_item(C, a, l, 3, (u - 2 * nA - nCtx) * NTHR + C.tid);
        else if (u < nAtt + nF) fourier2_unit(C, l, u - nAtt, false);
        else fourier2_unit(C, l, u - nAtt - nF, true);
    }
}
__device__ __forceinline__ void phase_mix3(const Ctx& C, const DArgs& a, int l) {
    const bf16* P = (const bf16*)(C.ws + WS_P); const float* SC = (const float*)(C.ws + WS_SC); const float* YS = (const float*)(C.ws + WS_YS); bf16* MIX = (bf16*)(C.ws + WS_MIX);
    LAS float* gl = (LAS float*)(C.lds);
    const float* g2 = a.in[I_DG2] + (size_t)l * 160 * 256; const float* rk = a.in[I_DRK] + (size_t)l * 256; const float* lnw = a.in[I_DLNW] + (size_t)l * 256; const float* lnb = a.in[I_DLNB] + (size_t)l * 256;
    const int half = C.tid >> 8, c = C.tid & 255;
    const int row_lo = (l == DEPTH - 1) ? NCTX : 0;
    for (int pr = C.wg + row_lo / 2; pr < ROWS / 2; pr += C.G) {
        const int row = 2 * pr + half;
        __syncthreads();
        if (c < 160) gl[half * 160 + c] = sigmoidf_(bf2f(P[(size_t)row * INWP + C_GL + c]));
        __syncthreads();
        const float* sc = SC + (size_t)row * 9 * 256;
        const float y = YS[(size_t)row * 256 + c] + YS[((size_t)ROWS + row) * 256 + c];
        const float mu = wave_sum(y) * (1.f / 64.f), dy = y - mu, var = wave_sum(dy * dy) * (1.f / 64.f);
        const float yn = dy * rsqrtf(var + 64e-5f) * lnw[c] + lnb[c];
        const float r = sc[c], v = sc[256 + c];
        const float coef = wave_sum(r * (sc[4 * 256 + c] + sc[7 * 256 + c]) * rk[c]);
        float g = 0.f; const float* g2p = g2 + c; const LAS float* glp = gl + half * 160;
#pragma unroll 8
        for (int i = 0; i < 160; ++i) g += glp[i] * g2p[i * 256];
        MIX[(size_t)row * DM + 768 + c] = (bf16)f2bf((yn + coef * v) * g);
    }
    __syncthreads();
}

#ifndef MK_SINGLE
#define MK_SINGLE 1
#endif
template <int ONLYP> __global__ void __launch_bounds__(NTHR, 2) mega(Args a) {
    extern __shared__ __attribute__((aligned(16))) unsigned char lds_raw[];
    Ctx C;
#define MKCTX() do { int t_ = threadIdx.x; asm volatile("" : "+v"(t_)); unsigned char* w_ = a.ws; asm volatile("" : "+s"(w_)); unsigned l_ = 0u; asm volatile("" : "+s"(l_)); \
        C.lds = (LAS unsigned char*)lds_raw + l_; C.tid = t_; C.lane = t_ & 63; C.wave = __builtin_amdgcn_readfirstlane(t_ >> 6); \
        C.wg = blockIdx.x; C.G = gridDim.x; C.gw = C.wg * NWAVES + C.wave; C.NGW = C.G * NWAVES; C.ws = w_; } while (0)
    MKCTX();
    if (C.tid == 0) {
#pragma unroll
        for (int i = 0; i < 31; ++i) ((LAS unsigned long long*)(C.lds + MISC_OFF + 2048))[i] = (unsigned long long)a.in[i]; }
    DArgs da; da.in.tab = (const LAS unsigned*)(C.lds + MISC_OFF + 2048); da.out = a.out;
    if (C.tid < 4) ((LAS unsigned*)(C.lds + MISC_OFF))[C.tid] = 0u;
    __syncthreads();
    XcdBarrier bar; bar.bar = (unsigned*)(C.ws + WS_CTL) + CW_BAR; bar.x = 0; bar.st = (volatile LAS unsigned*)(C.lds + MISC_OFF);
    if (a.use_bar) bar = xcd_barrier_post((unsigned*)(C.ws + WS_CTL) + CW_BAR, (volatile LAS unsigned*)(C.lds + MISC_OFF));
#ifndef PHMASK
#define PHMASK 0xfff
#endif
#define INP(o, k) ((ONLYP < 0 || ONLYP == (o)) && ((PHMASK >> ((o) == 99 ? 11 : (o))) & 1) && a.ph_lo <= (k) && (k) < a.ph_hi)
#define IN(k) (a.ph_lo <= (k) && (k) < a.ph_hi)
#define SEAM(k) do { if (a.use_bar && IN(k) && IN((k) + 1)) xcd_barrier(bar); } while (0)
    if (INP(0, 0)) { MKCTX(); phase_prologue(C, da); }
    SEAM(0);
    for (int l = 0; l < DEPTH; ++l) {
        const int b = 1 + l * NPL;
        const float* mod_lat = (const float*)(C.ws + WS_MOD) + (size_t)(l * 2 + 0) * 6144; const float* mod_ctx = mod_lat + 6144;
        if (INP(1, b + 0)) { MKCTX(); phase_norm1(C, da, l); }
        SEAM(b + 0);
        if (INP(2, b + 1)) { MKCTX();
            pg8::StaticOrder S; S.init(C.ws + WS_H, (const bf16*)(C.ws + WS_WIN) + (size_t)l * INWP * DM, ROWS, INWP, DM, C.G, C.wg);
            pg8::EpiStoreBf16 E{(bf16*)(C.ws + WS_P), INWP, nullptr, 0};
            pg8::gemm_phase<pg8::EpiStoreBf16, pg8::StaticOrder, true, true>(C.lds, C.tid, DM, S, E);
        }
        SEAM(b + 1);
        if (INP(3, b + 2)) { MKCTX(); mix1_rope(C); mix1_rwkv_prep(C, da, l); mix1_fourier1(C); }
        SEAM(b + 2);
        if (INP(4, b + 3)) { MKCTX(); phase_mix2(C, da, l); }
        SEAM(b + 3);
        if (INP(5, b + 4)) { MKCTX(); phase_mix3(C, da, l); }
        SEAM(b + 4);
        if (INP(6, b + 5)) { MKCTX();
            pg8::StaticOrder S; S.init(C.ws + WS_MIX, (const bf16*)(C.ws + WS_WOUT) + (size_t)l * DM * DM, ROWS, DM, DM, C.G, C.wg);
            pg8::EpiResidual E{(float*)(C.ws + WS_XS), DM, mod_lat + 2 * DM, mod_ctx + 2 * DM};
            pg8::gemm_phase<pg8::EpiResidual, pg8::StaticOrder, true, true>(C.lds, C.tid, DM, S, E);
        }
        SEAM(b + 5);
        if (INP(7, b + 6)) { MKCTX(); phase_norm2(C, da, l); }
        SEAM(b + 6);
        if (INP(8, b + 7)) { MKCTX(); phase_gather(C, da, l); }
        SEAM(b + 7);
        if (INP(9, b + 8)) { MKCTX();
            const int nblk = moe_tables(C);
            pg8::MoeOrder S{(const char*)(C.ws + WS_XG), (const char*)((const bf16*)(C.ws + WS_WGU) + (size_t)l * 32 * 2048 * DM), (size_t)256 * DM * 2, (size_t)2048 * DM * 2,
                            (const LAS unsigned char*)(C.lds + MISC_OFF + 1024), nblk, 8, C.G, C.wg};
            pg8::EpiSwiglu E{(bf16*)(C.ws + WS_ACT), DM, da.in[I_BGU] + (size_t)l * 32 * 2048, 2048};
            pg8::gemm_phase<pg8::EpiSwiglu, pg8::MoeOrder, true, true>(C.lds, C.tid, DM, S, E);
        }
        SEAM(b + 8);
        if (INP(10, b + 9)) { MKCTX();
            const int nblk = moe_tables(C);
            pg8::MoeOrder S{(const char*)(C.ws + WS_ACT), (const char*)((const bf16*)(C.ws + WS_WDN) + (size_t)l * 32 * DM * DM), (size_t)256 * DM * 2, (size_t)DM * DM * 2,
                            (const LAS unsigned char*)(C.lds + MISC_OFF + 1024), nblk, 4, C.G, C.wg};
            pg8::EpiStoreBf16 E{(bf16*)(C.ws + WS_XG), DM, da.in[I_BDN] + (size_t)l * 32 * DM, DM};
            pg8::gemm_phase<pg8::EpiStoreBf16, pg8::MoeOrder, true, true>(C.lds, C.tid, DM, S, E);
        }
        SEAM(b + 9);
    }
    if (INP(99, PH_TOTAL - 1)) { MKCTX(); phase_final(C, da); }
#undef IN
#undef INP
#undef SEAM
}

typedef void (*kern_t)(Args);
static kern_t kern_of(int o) {
    switch (o) { case 0: return mega<0>; case 1: return mega<1>; case 2: return mega<2>; case 3: return mega<3>; case 4: return mega<4>; case 5: return mega<5>; case 6: return mega<6>;
                 case 7: return mega<7>; case 8: return mega<8>; case 9: return mega<9>; case 10: return mega<10>; case 99: return mega<99>;
#if MK_SINGLE
                 default: return mega<-1>;
#else
                 default: return mega<0>;
#endif
    }
}
extern "C" void kernel_launch(void* const* d_in, const int* in_sizes, int n_in, void* d_out, int out_size, void* d_ws, size_t ws_size, hipStream_t stream) {
    static int ready = 0;
    if (ready == 0) {
        if (n_in != 31 || out_size != SEQ * DM || ws_size < WS_END) { fprintf(stderr, "kernel_launch: unexpected shapes (n_in %d, out %d, ws %zu)\n", n_in, out_size, ws_size); ready = -1; return; }
        const int ids[13] = {0, 1, 2, 3, 4, 5, 6, 7, 8, 9, 10, 99, -1};
        for (int i = 0; i < (MK_SINGLE ? 13 : 12); ++i) { if (MK_SINGLE && ids[i] != -1) continue;
            if (hipFuncSetAttribute((const void*)kern_of(ids[i]), hipFuncAttributeMaxDynamicSharedMemorySize, LDS_BYTES) != hipSuccess) { fprintf(stderr, "kernel_launch: hipFuncSetAttribute failed (%d)\n", ids[i]); ready = -1; return; } }
        ready = 1;
    }
    if (ready < 0) return;
    (void)hipMemsetAsync((char*)d_ws + WS_CTL, 0, CTL_ZERO_BYTES, stream);
    Args a{};
    for (int i = 0; i < 31; ++i) a.in[i] = (const float*)d_in[i];
    a.out = (float*)d_out; a.ws = (unsigned char*)d_ws; a.pad = 0;
#if MK_SINGLE
    a.ph_lo = 0; a.ph_hi = PH_TOTAL; a.use_bar = 1;
    hipLaunchKernelGGL(kern_of(-1), dim3(NWG), dim3(NTHR), LDS_BYTES, stream, a);
#else
    for (int p = 0; p < PH_TOTAL; ++p) { a.ph_lo = p; a.ph_hi = p + 1; a.use_bar = 0;
        const int o = (p == 0) ? 0 : (p == PH_TOTAL - 1) ? 99 : 1 + (p - 1) % NPL;
        hipLaunchKernelGGL(kern_of(o), dim3(NWG), dim3(NTHR), LDS_BYTES, stream, a); }
#endif
}
```

```cpp
#include <hip/hip_runtime.h>
#include <cstdio>
#include <cstdint>

#define LAS __attribute__((address_space(3)))
typedef unsigned short bf16;
typedef float f32x4 __attribute__((ext_vector_type(4)));
typedef float f32x2 __attribute__((ext_vector_type(2)));
typedef short bf16x8 __attribute__((ext_vector_type(8)));
typedef unsigned u32x4 __attribute__((ext_vector_type(4)));
typedef unsigned u32x2 __attribute__((ext_vector_type(2)));

constexpr int DM = 1024, SEQ = 16384, NCTX = 256, ROWS = SEQ + NCTX, DEPTH = 4, GRIDW = 64;
constexpr int INW = 2720, INWP = 2816;
constexpr int C_AQ = 0, C_AK = 256, C_AV = 384, C_BU = 512, C_CQ = 768, C_CK = 1024, C_CV = 1280, C_DR = 1536, C_DK = 1792, C_DV = 2048, C_WL = 2304, C_AL = 2432, C_GL = 2560;
constexpr int NEXP = 32, TOPK = 4;
constexpr int MOE_MAXBLK = 296;
constexpr int MOE_ROWS = MOE_MAXBLK * 256;
constexpr int NWG = 256, NTHR = 512, NWAVES = 8;
constexpr int VTP = ROWS + 256;

constexpr size_t MiB = 1u << 20;
constexpr size_t WS_CTL = 0, CTL_ZERO_BYTES = 1 * MiB;
constexpr size_t WS_MOD = 1 * MiB;
constexpr size_t WS_TW = 2 * MiB;
constexpr size_t WS_MTAB = 3 * MiB;
constexpr size_t WS_XS = 4 * MiB;
constexpr size_t WS_H = 70 * MiB;
constexpr size_t WS_P = 104 * MiB;
constexpr size_t WS_MIX = 194 * MiB;
constexpr size_t WS_FYR = 228 * MiB, WS_FYI = 244 * MiB;
constexpr size_t WS_VTA = 1544 * MiB, WS_VTC = 1550 * MiB;
constexpr size_t WS_SC = 260 * MiB;
constexpr size_t WS_YS = 408 * MiB;
constexpr size_t WS_ROUTE = 442 * MiB;
constexpr size_t WS_CNT = 444 * MiB;
constexpr size_t WS_XG = 446 * MiB;
constexpr size_t WS_ACT = 596 * MiB;
constexpr size_t WS_WIN = 746 * MiB;
constexpr size_t WS_WOUT = 768 * MiB;
constexpr size_t WS_WGU = 776 * MiB;
constexpr size_t WS_WDN = 1288 * MiB;
constexpr size_t WS_END = 1560 * MiB;
static_assert(WS_XS + (size_t)ROWS * DM * 4 <= WS_H && WS_H + (size_t)ROWS * DM * 2 <= WS_P && WS_P + (size_t)ROWS * INWP * 2 <= WS_MIX && WS_MIX + (size_t)ROWS * DM * 2 <= WS_FYR, "ws map 1");
static_assert(WS_SC + (size_t)ROWS * 9 * 256 * 4 <= WS_YS && WS_YS + (size_t)2 * ROWS * 256 * 4 <= WS_ROUTE && WS_XG + (size_t)MOE_ROWS * DM * 2 <= WS_ACT && WS_ACT + (size_t)MOE_ROWS * DM * 2 <= WS_WIN, "ws map 2");
static_assert(WS_WIN + (size_t)4 * INWP * DM * 2 <= WS_WOUT && WS_WGU + (size_t)4 * 32 * 2048 * 1024 * 2 <= WS_WDN && WS_WDN + (size_t)4 * 32 * 1024 * 1024 * 2 <= WS_END, "ws map 3");
constexpr int CW_BAR = 4096;

constexpr int RING_BYTES = 131072;
constexpr int MISC_OFF = RING_BYTES;
constexpr int LDS_BYTES = 147456;

__device__ __forceinline__ unsigned f2bf(float f) { unsigned u = __builtin_bit_cast(unsigned, f); return (u + 0x7fffu + ((u >> 16) & 1u)) >> 16; }
__device__ __forceinline__ unsigned pk2(float lo, float hi) { return f2bf(lo) | (f2bf(hi) << 16); }
__device__ __forceinline__ float bf2f(unsigned short b) { return __builtin_bit_cast(float, (unsigned)b << 16); }
__device__ __forceinline__ float bflo(unsigned w) { return __builtin_bit_cast(float, w << 16); }
__device__ __forceinline__ float bfhi(unsigned w) { return __builtin_bit_cast(float, w & 0xffff0000u); }
__device__ __forceinline__ float wave_sum(float v) {
#pragma unroll
    for (int o = 1; o < 64; o <<= 1) v += __shfl_xor(v, o);
    return v;
}
__device__ __forceinline__ float sigmoidf_(float x) { return 1.f / (1.f + __expf(-x)); }
#define LDS_WAIT() asm volatile("s_waitcnt lgkmcnt(0)" ::: "memory")
#define VM_WAIT() asm volatile("s_waitcnt vmcnt(0)" ::: "memory")

namespace pg8 {
#define PG8_LAS __attribute__((address_space(3)))
typedef unsigned short bf16_t;
constexpr int BM = 256, BK = 64, HALF = 128, HTB = HALF * BK * 2, STAGE_BYTES = 8 * HTB, NXCD = 8, WGM = 8;
__host__ __device__ __forceinline__ int lds_byte(int r, int c) { const int st = (r >> 4) * 2 + (c >> 5), rr = r & 15, cc = c & 31, ob = rr * 64 + cc * 2; return st * 1024 + (ob ^ (((ob >> 9) & 1) << 5)); }
__host__ __device__ __forceinline__ void stage_rc(int b, int& R, int& C) { const int st = b / 1024, sb = b % 1024, swz = sb ^ (((sb >> 9) & 1) << 5); R = (st >> 1) * 16 + swz / 64; C = (st & 1) * 32 + (swz % 64) / 2; }
__host__ __device__ __forceinline__ int perm32(int rho) { const int n = rho >> 4, i = rho & 15; return 8 * (i >> 2) + 4 * n + (i & 3); }
struct Unit { int pm, pn, e; };
__device__ __forceinline__ unsigned cvt_pk_bf16(float lo, float hi) { unsigned r; asm volatile("v_cvt_pk_bf16_f32 %0, %1, %2" : "=v"(r) : "v"(lo), "v"(hi)); return r; }

struct StaticOrder {
    const char* A; const char* Bt; size_t tstep;
    int nM, nN, nwg, G, c;
    __device__ void init(const void* A_, const void* Bt_, int M, int N, int K, int G_, int c_) { A = (const char*)A_; Bt = (const char*)Bt_; tstep = (size_t)BM * K * 2; nM = M / BM; nN = N / BM; nwg = nM * nN; G = G_; c = c_; }
    __device__ bool next(int i, Unit& u) const {
        const long L = (long)i * G + c; if (L >= nwg) return false;
        int wgid = (int)L; { const int q = nwg / NXCD, r = nwg % NXCD, xcd = wgid % NXCD, off = wgid / NXCD; wgid = (xcd < r ? xcd * (q + 1) : r * (q + 1) + (xcd - r) * q) + off; }
        const int nig = WGM * nN, gid = wgid / nig, fm = gid * WGM, gsz = (nM - fm) < WGM ? (nM - fm) : WGM;
        u.pm = fm + ((wgid % nig) % gsz); u.pn = (wgid % nig) / gsz; u.e = 0; return true;
    }
    __device__ __forceinline__ const char* pa(const Unit& u) const { return A + (size_t)u.pm * tstep; }
    __device__ __forceinline__ const char* pb(const Unit& u) const { return Bt + (size_t)u.pn * tstep; }
};
struct MoeOrder {
    const char* A; const char* Bt; size_t tstep, estep;
    const LAS unsigned char* blk_e; int nblk, nN, G, c;
    __device__ bool next(int i, Unit& u) const {
        const int L = i * G + c; if (L >= nblk * nN) return false;
        u.pm = L / nN; u.pn = L % nN; u.e = __builtin_amdgcn_readfirstlane((int)blk_e[u.pm]); return true;
    }
    __device__ __forceinline__ const char* pa(const Unit& u) const { return A + (size_t)u.pm * tstep; }
    __device__ __forceinline__ const char* pb(const Unit& u) const { return Bt + (size_t)u.e * estep + (size_t)u.pn * tstep; }
};

struct EpiStoreBf16 {
    static constexpr bool PERM = true;
    bf16_t* O; int ldc; const float* bias; int bias_estride;
    __device__ __forceinline__ void init(f32x4 (&acc)[2][2][4][2], const Unit& u, int wc, int fq) const {
        const int col0 = u.pn * BM + wc * 32 + 8 * fq;
#pragma unroll
        for (int b = 0; b < 2; ++b)
#pragma unroll
            for (int n = 0; n < 2; ++n) { const f32x4 bv = bias ? *(const f32x4*)(bias + (size_t)u.e * bias_estride + col0 + b * HALF + 4 * n) : (f32x4){0.f, 0.f, 0.f, 0.f};
#pragma unroll
                for (int a = 0; a < 2; ++a)
#pragma unroll
                    for (int m = 0; m < 4; ++m) acc[a][b][m][n] = bv; }
    }
    __device__ __forceinline__ void operator()(const f32x4 (&acc)[2][2][4][2], const Unit& u, int wr, int wc, int fr, int fq) const {
        const int row0 = u.pm * BM + wr * 64 + fr, col0 = u.pn * BM + wc * 32 + 8 * fq;
#pragma unroll
        for (int ai = 0; ai < 2; ++ai)
#pragma unroll
            for (int m = 0; m < 4; ++m) { bf16_t* rowp = O + (size_t)(row0 + ai * HALF + m * 16) * ldc + col0;
#pragma unroll
                for (int bj = 0; bj < 2; ++bj) { const f32x4 v0 = acc[ai][bj][m][0], v1 = acc[ai][bj][m][1];
                    u32x4 w; w.x = cvt_pk_bf16(v0[0], v0[1]); w.y = cvt_pk_bf16(v0[2], v0[3]); w.z = cvt_pk_bf16(v1[0], v1[1]); w.w = cvt_pk_bf16(v1[2], v1[3]);
                    *(u32x4*)(rowp + bj * HALF) = w; } }
    }
};
__device__ __forceinline__ float swiglu1(float g, float up) {
    g = fminf(g, 7.0f); up = fminf(fmaxf(up, -7.0f), 7.0f);
    return g * (1.f / (1.f + __expf(-1.702f * g))) * (up + 1.0f);
}
struct EpiSwiglu {
    static constexpr bool PERM = true;
    bf16_t* O; int ldc; const float* bias; int bias_estride;
    __device__ __forceinline__ void init(f32x4 (&acc)[2][2][4][2], const Unit& u, int wc, int fq) const {
        const int col0 = u.pn * BM + wc * 32 + 8 * fq;
#pragma unroll
        for (int b = 0; b < 2; ++b)
#pragma unroll
            for (int n = 0; n < 2; ++n) { const f32x4 bv = bias ? *(const f32x4*)(bias + (size_t)u.e * bias_estride + col0 + b * HALF + 4 * n) : (f32x4){0.f, 0.f, 0.f, 0.f};
#pragma unroll
                for (int a = 0; a < 2; ++a)
#pragma unroll
                    for (int m = 0; m < 4; ++m) acc[a][b][m][n] = bv; }
    }
    __device__ __forceinline__ void operator()(const f32x4 (&acc)[2][2][4][2], const Unit& u, int wr, int wc, int fr, int fq) const {
        const int row0 = u.pm * BM + wr * 64 + fr, col0 = u.pn * BM + wc * 32 + 8 * fq;
#pragma unroll
        for (int ai = 0; ai < 2; ++ai)
#pragma unroll
            for (int m = 0; m < 4; ++m) { bf16_t* rowp = O + (size_t)(row0 + ai * HALF + m * 16) * ldc + (col0 >> 1);
#pragma unroll
                for (int bj = 0; bj < 2; ++bj) { const f32x4 v0 = acc[ai][bj][m][0], v1 = acc[ai][bj][m][1];
                    u32x2 w; w.x = cvt_pk_bf16(swiglu1(v0[0], v0[1]), swiglu1(v0[2], v0[3])); w.y = cvt_pk_bf16(swiglu1(v1[0], v1[1]), swiglu1(v1[2], v1[3]));
                    *(u32x2*)(rowp + bj * (HALF / 2)) = w; } }
    }
};
struct EpiResidual {
    static constexpr bool PERM = false;
    float* X; int ldc; const float* gate_lat; const float* gate_ctx;
    __device__ __forceinline__ void init(f32x4 (&acc)[2][2][4][2], const Unit& u, int wc, int fq) const {
#pragma unroll
        for (int a = 0; a < 2; ++a)
#pragma unroll
            for (int b = 0; b < 2; ++b)
#pragma unroll
                for (int m = 0; m < 4; ++m)
#pragma unroll
                    for (int n = 0; n < 2; ++n) acc[a][b][m][n] = (f32x4){0.f, 0.f, 0.f, 0.f};
    }
    __device__ __forceinline__ void operator()(const f32x4 (&acc)[2][2][4][2], const Unit& u, int wr, int wc, int fr, int fq) const {
        const int row0 = u.pm * BM + wr * 64 + fr, col0 = u.pn * BM + wc * 32 + 4 * fq;
        const float* gp = (u.pm == 0) ? gate_ctx : gate_lat;
        f32x4 gv[2][2];
#pragma unroll
        for (int bj = 0; bj < 2; ++bj)
#pragma unroll
            for (int n = 0; n < 2; ++n) gv[bj][n] = *(const f32x4*)(gp + col0 + bj * HALF + n * 16);
#pragma unroll
        for (int ai = 0; ai < 2; ++ai)
#pragma unroll
            for (int m = 0; m < 4; ++m) { float* rowp = X + (size_t)(row0 + ai * HALF + m * 16) * ldc + col0;
#pragma unroll
                for (int bj = 0; bj < 2; ++bj)
#pragma unroll
                    for (int n = 0; n < 2; ++n) { f32x4* p = (f32x4*)(rowp + bj * HALF + n * 16); *p = *p + gv[bj][n] * acc[ai][bj][m][n]; }
                asm volatile("" ::: "memory"); }
    }
};
template <class Epi, class Sched, bool ALIGN_EPI = false, bool SP2 = false>
__device__ __forceinline__ void gemm_phase(PG8_LAS unsigned char* lds, const int tid, const int K, const Sched& S, const Epi& E) {
    const int wid = __builtin_amdgcn_readfirstlane(tid >> 6), lane = tid & 63, wr = wid >> 2, wc = wid & 3, fr = lane & 15, fq = lane >> 4;
    const int nt = K / BK;
    unsigned voffA[2], voffB[2];
#pragma unroll
    for (int i = 0; i < 2; ++i) { int R, C; stage_rc(tid * 16 + i * 8192, R, C); const int Rb = Epi::PERM ? ((R & ~31) + perm32(R & 31)) : R;
        voffA[i] = (unsigned)(R * K + C) * 2u; voffB[i] = (unsigned)(Rb * K + C) * 2u; }
    const size_t kstep = (size_t)(BK * 2);
    const size_t hstep = (size_t)HALF * K * 2;
        const unsigned ldsw = (unsigned)wid * 1024u;
    const int aoff = lds_byte(wr * 64 + fr, fq * 8), boff = lds_byte(wc * 32 + fr, fq * 8);
#define PG8_SA(b, h) (((b) * 2 + (h)) * HTB)
#define PG8_SB(b, h) ((4 + (b) * 2 + (h)) * HTB)
#define PG8_STAGE(bufoff, gbase, voff) do { _Pragma("unroll") for (int _i = 0; _i < 2; ++_i) \
        __builtin_amdgcn_global_load_lds((const unsigned*)((const char*)(gbase) + (voff)[_i]), (PG8_LAS unsigned*)(lds + (bufoff) + ldsw + _i * 8192), 16, 0, 0); } while (0)
#define PG8_LDA(dst, b, h) do { _Pragma("unroll") for (int m = 0; m < 4; ++m) _Pragma("unroll") for (int k = 0; k < 2; ++k) dst[m][k] = *(const PG8_LAS bf16x8*)(lds + PG8_SA(b, h) + aoff + m * 2048 + k * 1024); } while (0)
#define PG8_LDB(dst, b, h) do { _Pragma("unroll") for (int n = 0; n < 2; ++n) _Pragma("unroll") for (int k = 0; k < 2; ++k) dst[n][k] = *(const PG8_LAS bf16x8*)(lds + PG8_SB(b, h) + boff + n * 2048 + k * 1024); } while (0)
#define PG8_MMA(ai, bj, At, Bt) do { __builtin_amdgcn_s_setprio(1); _Pragma("unroll") for (int m = 0; m < 4; ++m) _Pragma("unroll") for (int n = 0; n < 2; ++n) _Pragma("unroll") for (int k = 0; k < 2; ++k) \
        acc[ai][bj][m][n] = __builtin_amdgcn_mfma_f32_16x16x32_bf16(Bt[n][k], At[m][k], acc[ai][bj][m][n], 0, 0, 0); __builtin_amdgcn_s_setprio(0); } while (0)
#define PG8_WAIT_V(n) asm volatile("s_waitcnt vmcnt(" #n ")" ::: "memory")
#define PG8_WAIT_L(n) asm volatile("s_waitcnt lgkmcnt(" #n ")" ::: "memory")
#define PG8_BAR __builtin_amdgcn_s_barrier()
#define PG8_SCHED __builtin_amdgcn_sched_barrier(0)
    Unit cur, nxt; int ui = 0;
    if (!S.next(0, cur)) return;
    f32x4 acc[2][2][4][2];
    E.init(acc, cur, wc, fq);
    bf16x8 At[4][2], B0[2][2], B1[2][2];
    const char* cA = S.pa(cur); const char* cB = S.pb(cur);
    if constexpr (SP2) {
        PG8_STAGE(PG8_SB(0, 0), cB, voffB); PG8_STAGE(PG8_SB(0, 1), cB + hstep, voffB); PG8_STAGE(PG8_SA(0, 0), cA, voffA); PG8_STAGE(PG8_SA(0, 1), cA + hstep, voffA);
        if (wr == 1) PG8_BAR;
        PG8_WAIT_V(2); PG8_BAR;
        PG8_STAGE(PG8_SB(1, 0), cB + kstep, voffB); PG8_STAGE(PG8_SA(1, 0), cA + kstep, voffA); PG8_STAGE(PG8_SB(1, 1), cB + hstep + kstep, voffB);
        PG8_WAIT_V(6); PG8_BAR;
    } else {
        PG8_STAGE(PG8_SB(0, 0), cB, voffB); PG8_STAGE(PG8_SA(0, 0), cA, voffA); PG8_STAGE(PG8_SB(0, 1), cB + hstep, voffB); PG8_STAGE(PG8_SA(0, 1), cA + hstep, voffA);
        if (wr == 1) PG8_BAR;
        PG8_WAIT_V(4); PG8_BAR;
        PG8_STAGE(PG8_SB(1, 0), cB + kstep, voffB); PG8_STAGE(PG8_SA(1, 0), cA + kstep, voffA); PG8_STAGE(PG8_SB(1, 1), cB + hstep + kstep, voffB);
        PG8_WAIT_V(6); PG8_BAR;
    }
    for (;;) {
        const bool has_next = S.next(ui + 1, nxt);
        const char* nA = has_next ? S.pa(nxt) : cA; const char* nB = has_next ? S.pb(nxt) : cB;
        for (int t = 0; t < nt; t += 2) {
            const bool last = (t == nt - 2);
            const char* a1 = cA + (size_t)(t + 1) * kstep;
            const char* a2 = last ? nA : cA + (size_t)(t + 2) * kstep; const char* b2 = last ? nB : cB + (size_t)(t + 2) * kstep;
            const char* a3 = a2 + kstep; const char* b3 = b2 + kstep;
            if constexpr (SP2) {
            PG8_LDB(B0, 0, 0); PG8_LDB(B1, 0, 1); PG8_SCHED; PG8_LDA(At, 0, 0); PG8_STAGE(PG8_SA(1, 1), a1 + hstep, voffA);
            PG8_WAIT_V(8); PG8_WAIT_L(0); PG8_BAR; PG8_MMA(0, 0, At, B0); PG8_MMA(0, 1, At, B1); PG8_BAR; PG8_SCHED;
            PG8_LDA(At, 0, 1); PG8_STAGE(PG8_SB(0, 0), b2, voffB); PG8_STAGE(PG8_SB(0, 1), b2 + hstep, voffB); PG8_STAGE(PG8_SA(0, 0), a2, voffA);
            PG8_WAIT_V(8); PG8_WAIT_L(0); PG8_BAR; PG8_MMA(1, 0, At, B0); PG8_MMA(1, 1, At, B1); PG8_BAR; PG8_SCHED;
            PG8_LDB(B0, 1, 0); PG8_LDB(B1, 1, 1); PG8_SCHED; PG8_LDA(At, 1, 0); PG8_STAGE(PG8_SA(0, 1), a2 + hstep, voffA);
            PG8_WAIT_V(8); PG8_WAIT_L(0); PG8_BAR; PG8_MMA(0, 0, At, B0); PG8_MMA(0, 1, At, B1); PG8_BAR; PG8_SCHED;
            PG8_LDA(At, 1, 1); PG8_STAGE(PG8_SB(1, 0), b3, voffB); PG8_STAGE(PG8_SB(1, 1), b3 + hstep, voffB); PG8_STAGE(PG8_SA(1, 0), a3, voffA);
            PG8_WAIT_V(8); PG8_WAIT_L(0); PG8_BAR; PG8_MMA(1, 0, At, B0); PG8_MMA(1, 1, At, B1); PG8_BAR; PG8_SCHED;
            } else {
            PG8_LDB(B0, 0, 0); PG8_SCHED; PG8_LDA(At, 0, 0); PG8_STAGE(PG8_SA(1, 1), a1 + hstep, voffA);
            PG8_WAIT_L(8); PG8_BAR; PG8_WAIT_L(0); PG8_MMA(0, 0, At, B0); PG8_BAR; PG8_SCHED;
            PG8_LDB(B1, 0, 1); PG8_STAGE(PG8_SB(0, 0), b2, voffB);
            PG8_BAR; PG8_WAIT_L(0); PG8_MMA(0, 1, At, B1); PG8_BAR;
            PG8_LDA(At, 0, 1); PG8_STAGE(PG8_SA(0, 0), a2, voffA);
            PG8_BAR; PG8_WAIT_L(0); PG8_MMA(1, 0, At, B0); PG8_BAR; PG8_SCHED;
            PG8_STAGE(PG8_SB(0, 1), b2 + hstep, voffB);
            PG8_WAIT_V(6); PG8_BAR; PG8_MMA(1, 1, At, B1); PG8_BAR;
            PG8_LDB(B0, 1, 0); PG8_SCHED; PG8_LDA(At, 1, 0); PG8_STAGE(PG8_SA(0, 1), a2 + hstep, voffA);
            PG8_WAIT_L(8); PG8_BAR; PG8_WAIT_L(0); PG8_MMA(0, 0, At, B0); PG8_BAR; PG8_SCHED;
            PG8_LDB(B1, 1, 1); PG8_STAGE(PG8_SB(1, 0), b3, voffB);
            PG8_BAR; PG8_WAIT_L(0); PG8_MMA(0, 1, At, B1); PG8_BAR;
            PG8_LDA(At, 1, 1); PG8_STAGE(PG8_SA(1, 0), a3, voffA);
            PG8_BAR; PG8_WAIT_L(0); PG8_MMA(1, 0, At, B0); PG8_BAR; PG8_SCHED;
            PG8_STAGE(PG8_SB(1, 1), b3 + hstep, voffB);
            PG8_WAIT_V(6); PG8_BAR; PG8_MMA(1, 1, At, B1); PG8_BAR;
            }
        }
        if constexpr (ALIGN_EPI) { if (wr == 0) PG8_BAR; }
        E(acc, cur, wr, wc, fr, fq);
        if (!has_next) break;
        E.init(acc, nxt, wc, fq);
        cur = nxt; cA = nA; cB = nB; ++ui;
        if constexpr (ALIGN_EPI) { if (wr == 1) PG8_BAR; }
    }
    PG8_WAIT_V(0);
    if constexpr (!ALIGN_EPI) { if (wr == 0) PG8_BAR; }
    PG8_BAR;
#undef PG8_SA
#undef PG8_SB
#undef PG8_STAGE
#undef PG8_LDA
#undef PG8_LDB
#undef PG8_MMA
#undef PG8_WAIT_V
#undef PG8_WAIT_L
#undef PG8_BAR
#undef PG8_SCHED
}
}

#define XB_TMO      128
#define XB_XCNT(j)  (256  + 64 * (j))
#define XB_XSUB(j)  (1280 + 64 * (j))
#define XB_XGEN(j)  (2304 + 64 * (j))
#define XB_TOP      3328
#define XB_TOPGEN   3392
#define XCD_BAR_WORDS 3456
#define XB_SPIN_CAP (1u << 18)
__device__ __forceinline__ unsigned xb_ld(unsigned* p)              { return __hip_atomic_load(p, __ATOMIC_RELAXED, __HIP_MEMORY_SCOPE_AGENT); }
__device__ __forceinline__ unsigned xb_add(unsigned* p, unsigned v) { return __hip_atomic_fetch_add(p, v, __ATOMIC_RELAXED, __HIP_MEMORY_SCOPE_AGENT); }
__device__ __forceinline__ unsigned xb_xcc_id() { return (unsigned)__builtin_amdgcn_s_getreg((3 << 11) | 20) & 0xFu; }
#define XB_SPIN(cond, bar) do { unsigned _sp = 0; while (cond) { __builtin_amdgcn_s_sleep(1); \
    if ((++_sp & 255u) == 0u) { if (xb_ld(&(bar)[XB_TMO])) break; if (_sp > XB_SPIN_CAP) { atomicAdd(&(bar)[XB_TMO], 1u); break; } } } } while (0)

struct XcdBarrier {
    unsigned* bar; unsigned x;
    volatile LAS unsigned* st;
};

__device__ __forceinline__ XcdBarrier xcd_barrier_post(unsigned* bar, volatile LAS unsigned* st) {
    XcdBarrier b; b.bar = bar; b.x = xb_xcc_id(); b.st = st;
    if (threadIdx.x == 0) (void)xb_add(&bar[XB_XCNT(b.x)], 1u);
    return b;
}
__device__ __forceinline__ void xcd_barrier_complete(unsigned* bar, unsigned x, unsigned& nloc, unsigned& nx) {
    const unsigned G = gridDim.x * gridDim.y * gridDim.z;
    unsigned sum, cnt, mine, sp = 0u;
    for (;;) {
        sum = 0u; cnt = 0u; mine = 0u;
#pragma unroll
        for (unsigned j = 0; j < 16; ++j) { const unsigned c = xb_ld(&bar[XB_XCNT(j)]); sum += c; cnt += (c > 0u) ? 1u : 0u; mine = (j == x) ? c : mine; }
        if (sum == G) break;
        __builtin_amdgcn_s_sleep(1);
        if ((++sp & 255u) == 0u) { if (xb_ld(&bar[XB_TMO])) break; if (sp > XB_SPIN_CAP) { atomicAdd(&bar[XB_TMO], 1u); break; } }
    }
    nloc = mine > 0u ? mine : 1u; nx = cnt > 0u ? cnt : 1u;
}

__device__ __forceinline__ void xcd_barrier(const XcdBarrier& b) {
    asm volatile("s_waitcnt vmcnt(0)" ::: "memory");
    __syncthreads();
    if (threadIdx.x == 0) {
        unsigned* bar = b.bar;
        __builtin_amdgcn_s_waitcnt(0);
        unsigned nloc = b.st[0], nx = b.st[1];
        if (nloc == 0u) { xcd_barrier_complete(bar, b.x, nloc, nx); b.st[0] = nloc; b.st[1] = nx; }
        const unsigned old = xb_add(&bar[XB_XSUB(b.x)], 1u);
        const unsigned gen = old / nloc;
        if (old + 1u == (gen + 1u) * nloc) {
            __builtin_amdgcn_fence(__ATOMIC_RELEASE, "agent");
            asm volatile("s_waitcnt vmcnt(0)" ::: "memory");
            const unsigned og = xb_add(&bar[XB_TOP], 1u);
            const unsigned tg = og / nx;
            if (og + 1u == (tg + 1u) * nx) xb_add(&bar[XB_TOPGEN], 1u);
            else XB_SPIN(xb_ld(&bar[XB_TOPGEN]) == tg, bar);
            __builtin_amdgcn_fence(__ATOMIC_ACQUIRE, "agent");
            xb_add(&bar[XB_XGEN(b.x)], 1u);
            asm volatile("s_waitcnt vmcnt(0)" ::: "memory");
        } else {
            XB_SPIN(xb_ld(&bar[XB_XGEN(b.x)]) == gen, bar);
            __builtin_amdgcn_fence(__ATOMIC_ACQUIRE, "agent");
            asm volatile("s_waitcnt vmcnt(0)" ::: "memory");
        }
    }
    __syncthreads();
}

struct Args {
    const float* in[31];
    float* out; unsigned char* ws;
    int ph_lo, ph_hi, use_bar, pad;
};
enum InIdx { I_X = 0, I_C, I_CTX, I_CCTX, I_ADAW, I_ADAB, I_N1G, I_N2G, I_WIN, I_WOUT, I_ASINK, I_BMIX, I_CREL, I_DCONV, I_DW0, I_DW2, I_DA0, I_DA2, I_DG2, I_DKK, I_DKA, I_DRK, I_DLNW, I_DLNB,
             I_RW, I_RB, I_WGU, I_BGU, I_WDN, I_BDN, I_FNG };
constexpr int NPL = 10;
constexpr int PH_TOTAL = 1 + DEPTH * NPL + 1;

struct DevIn {
    const LAS unsigned* tab;
    __device__ __forceinline__ const float* operator[](int i) const {
        const unsigned lo = __builtin_amdgcn_readfirstlane(((const volatile LAS unsigned*)tab)[2 * i]), hi = __builtin_amdgcn_readfirstlane(((const volatile LAS unsigned*)tab)[2 * i + 1]);
        return (const float*)(((unsigned long long)hi << 32) | lo);
    }
};
struct DArgs { DevIn in; float* out; };
struct Ctx {
    LAS unsigned char* lds;
    int tid, lane, wave, wg, G, gw, NGW;
    unsigned char* ws;
};

__device__ __forceinline__ void transpose_item(const float* W, int K, int N, bf16* WT, LAS float* scr, int item, int lane) {
    const int nblk = N / 32, kb = item / nblk, nb = item % nblk, k0 = 64 * kb, n0 = 32 * nb;
#pragma unroll 8
    for (int i = 0; i < 32; ++i) { const int kk = 2 * i + (lane >> 5); scr[kk * 33 + (lane & 31)] = W[(size_t)(k0 + kk) * N + n0 + (lane & 31)]; }
    LDS_WAIT(); asm volatile("" ::: "memory");
    const int c = lane & 7;
#pragma unroll
    for (int j = 0; j < 4; ++j) { const int n = (lane >> 3) + 8 * j; const LAS float* s = scr + (8 * c) * 33 + n;
        u32x4 o; o.x = pk2(s[0 * 33], s[1 * 33]); o.y = pk2(s[2 * 33], s[3 * 33]); o.z = pk2(s[4 * 33], s[5 * 33]); o.w = pk2(s[6 * 33], s[7 * 33]);
        *(u32x4*)(WT + (size_t)(n0 + n) * K + k0 + 8 * c) = o; }
    LDS_WAIT(); asm volatile("" ::: "memory");
}
__device__ __forceinline__ void phase_prologue(const Ctx& C, const DArgs& a) {
    LAS float* scr = (LAS float*)(C.lds + C.wave * 16384);
    constexpr int IT_IN = 16 * (INW / 32), IT_OUT = 16 * 32, IT_GU = 16 * 64, IT_DN = 16 * 32;
    constexpr long N_IN = 4L * IT_IN, N_OUT = 4L * IT_OUT, N_GU = 128L * IT_GU, N_DN = 128L * IT_DN, N_ALL = N_IN + N_OUT + N_GU + N_DN;
    const float* pwin = a.in[I_WIN]; const float* pwout = a.in[I_WOUT]; const float* pwgu = a.in[I_WGU]; const float* pwdn = a.in[I_WDN];
    for (long it = C.gw; it < N_ALL; it += C.NGW) {
        long r = it;
        if (r < N_IN) { const int l = (int)(r / IT_IN); transpose_item(pwin + (size_t)l * DM * INW, DM, INW, (bf16*)(C.ws + WS_WIN) + (size_t)l * INWP * DM, scr, (int)(r % IT_IN), C.lane); continue; } r -= N_IN;
        if (r < N_OUT) { const int l = (int)(r / IT_OUT); transpose_item(pwout + (size_t)l * DM * DM, DM, DM, (bf16*)(C.ws + WS_WOUT) + (size_t)l * DM * DM, scr, (int)(r % IT_OUT), C.lane); continue; } r -= N_OUT;
        if (r < N_GU) { const int le = (int)(r / IT_GU); transpose_item(pwgu + (size_t)le * DM * 2048, DM, 2048, (bf16*)(C.ws + WS_WGU) + (size_t)le * 2048 * DM, scr, (int)(r % IT_GU), C.lane); continue; } r -= N_GU;
        { const int le = (int)(r / IT_DN); transpose_item(pwdn + (size_t)le * DM * DM, DM, DM, (bf16*)(C.ws + WS_WDN) + (size_t)le * DM * DM, scr, (int)(r % IT_DN), C.lane); }
    }
    { const int gt = C.wg * NTHR + C.tid; constexpr int PADN = (INWP - INW) * DM / 8;
      for (int i = gt; i < 4 * PADN; i += C.G * NTHR) { const int l = i / PADN, r = i % PADN; *((u32x4*)((bf16*)(C.ws + WS_WIN) + ((size_t)l * INWP + INW) * DM) + r) = (u32x4){0u, 0u, 0u, 0u}; } }
    { float* tw = (float*)(C.ws + WS_TW); const int gt = C.wg * NTHR + C.tid;
      for (int i = gt; i < 16384; i += C.G * NTHR) { const float x = (float)i * (1.0f / 8192.0f); tw[i] = cospif(x); tw[16384 + i] = sinpif(x); } }
    { float* mt = (float*)(C.ws + WS_MTAB); const int gt = C.wg * NTHR + C.tid; const float* pbmix = a.in[I_BMIX];
      for (int i = gt; i < 4 * 4 * 64 * 64; i += C.G * NTHR) { const int e = i & 63, c = (i >> 6) & 63, g = (i >> 12) & 3, l = i >> 14;
          const float* w = pbmix + ((size_t)(l * 4 + g) * 64) * 64 + e; float sc = 0.f, ss = 0.f;
          for (int cp = 0; cp < 64; ++cp) { const float x = (float)((c * cp) & 63) * (1.0f / 32.0f); const float wv = w[cp * 64]; sc += cospif(x) * wv; ss += sinpif(x) * wv; }
          mt[((size_t)(l * 2 + 0) * 4 + g) * 4096 + c * 64 + e] = sc; mt[((size_t)(l * 2 + 1) * 4 + g) * 4096 + c * 64 + e] = ss; } }
    { LAS float* red = (LAS float*)(C.lds);
      __syncthreads();
      float* mod = (float*)(C.ws + WS_MOD);
      const float* pc = a.in[I_C]; const float* pcc = a.in[I_CCTX]; const float* padaw = a.in[I_ADAW]; const float* padab = a.in[I_ADAB];
      for (int u = C.wg; u < 4 * 24; u += C.G) { const int l = u / 24, jb = u % 24, j0 = jb * 256 + 4 * C.lane;
          f32x4 s0 = {0.f, 0.f, 0.f, 0.f}, s1 = {0.f, 0.f, 0.f, 0.f};
          const float* w = padaw + (size_t)l * DM * 6144 + j0;
          for (int k = C.wave * 128; k < C.wave * 128 + 128; ++k) { const float c0 = pc[k], c1 = pcc[k]; const float a0 = c0 * sigmoidf_(c0), a1 = c1 * sigmoidf_(c1);
              const f32x4 wv = *(const f32x4*)(w + (size_t)k * 6144); s0 += wv * a0; s1 += wv * a1; }
          *(LAS f32x4*)(red + ((C.wave * 2 + 0) * 64 + C.lane) * 4) = s0; *(LAS f32x4*)(red + ((C.wave * 2 + 1) * 64 + C.lane) * 4) = s1;
          __syncthreads();
          if (C.tid < 512) { const int v = C.tid >> 8, j = C.tid & 255; float s = 0.f;
#pragma unroll
              for (int wv = 0; wv < 8; ++wv) s += red[(wv * 2 + v) * 256 + j];
              mod[(size_t)(l * 2 + v) * 6144 + jb * 256 + j] = s + padab[(size_t)l * 6144 + jb * 256 + j]; }
          __syncthreads(); } }
}

__device__ __forceinline__ void load_row(const float* p, int lane, f32x4 (&v)[4]) {
#pragma unroll
    for (int j = 0; j < 4; ++j) v[j] = *((const f32x4*)p + lane + 64 * j);
}
__device__ __forceinline__ void moe_combine_row(const Ctx& C, int row, f32x4 (&v)[4], const float* gt2) {
    const int* dest = (const int*)(C.ws + WS_ROUTE) + (size_t)3 * ROWS * 4; const float* gate = (const float*)(C.ws + WS_ROUTE) + (size_t)1 * ROWS * 4;
    const bf16* YB = (const bf16*)(C.ws + WS_XG);
    f32x4 s[4];
#pragma unroll
    for (int j = 0; j < 4; ++j) s[j] = (f32x4){0.f, 0.f, 0.f, 0.f};
#pragma unroll
    for (int k = 0; k < 4; ++k) { const int d = dest[row * 4 + k]; const float g = gate[row * 4 + k]; const u32x2* yp = (const u32x2*)(YB + (size_t)d * DM) + C.lane;
#pragma unroll
        for (int j = 0; j < 4; ++j) { const u32x2 w = yp[64 * j]; s[j] += (f32x4){bflo(w.x), bfhi(w.x), bflo(w.y), bfhi(w.y)} * g; } }
#pragma unroll
    for (int j = 0; j < 4; ++j) v[j] += *((const f32x4*)gt2 + C.lane + 64 * j) * s[j];
}
__device__ __forceinline__ float row_rstd(const f32x4 (&v)[4]) {
    float s = 0.f;
#pragma unroll
    for (int j = 0; j < 4; ++j) s += (v[j].x * v[j].x + v[j].y * v[j].y) + (v[j].z * v[j].z + v[j].w * v[j].w);
    return rsqrtf(wave_sum(s) * (1.f / DM) + 1e-6f);
}
__device__ __forceinline__ void phase_norm1(const Ctx& C, const DArgs& a, int l) {
    float* XS = (float*)(C.ws + WS_XS); bf16* H = (bf16*)(C.ws + WS_H); const float* mod = (const float*)(C.ws + WS_MOD);
    const float* g1 = a.in[I_N1G] + (size_t)l * DM;
    const float* pctx = a.in[I_CTX]; const float* px = a.in[I_X];
    for (int row = C.gw; row < ROWS; row += C.NGW) {
        const bool isctx = row < NCTX; f32x4 v[4];
        if (l == 0) { load_row(isctx ? pctx + (size_t)row * DM : px + (size_t)(row - NCTX) * DM, C.lane, v); }
        else { load_row(XS + (size_t)row * DM, C.lane, v);
               if (!(l == DEPTH && isctx)) moe_combine_row(C, row, v, mod + (size_t)((l - 1) * 2 + (isctx ? 1 : 0)) * 6144 + 5 * DM); }
        if (l == 0 || true) {
#pragma unroll
            for (int j = 0; j < 4; ++j) *((f32x4*)(XS + (size_t)row * DM) + C.lane + 64 * j) = v[j]; }
        const float rstd = row_rstd(v);
        const float* md = mod + (size_t)(l * 2 + (isctx ? 1 : 0)) * 6144;
        u32x2* o = (u32x2*)(H + (size_t)row * DM) + C.lane;
#pragma unroll
        for (int j = 0; j < 4; ++j) { const f32x4 g = *((const f32x4*)g1 + C.lane + 64 * j), sh = *((const f32x4*)md + C.lane + 64 * j), sc = *((const f32x4*)(md + DM) + C.lane + 64 * j);
            const f32x4 y = v[j] * rstd * g * (sc + 1.0f) + sh; u32x2 w; w.x = pk2(y.x, y.y); w.y = pk2(y.z, y.w); o[64 * j] = w; }
    }
}
__device__ __forceinline__ void phase_final(const Ctx& C, const DArgs& a) {
    const float* XS = (const float*)(C.ws + WS_XS); const float* mod = (const float*)(C.ws + WS_MOD); const float* g = a.in[I_FNG];
    for (int row = NCTX + C.gw; row < ROWS; row += C.NGW) {
        f32x4 v[4]; load_row(XS + (size_t)row * DM, C.lane, v);
        moe_combine_row(C, row, v, mod + (size_t)((DEPTH - 1) * 2 + 0) * 6144 + 5 * DM);
        const float rstd = row_rstd(v);
        float* o = a.out + (size_t)(row - NCTX) * DM;
#pragma unroll
        for (int j = 0; j < 4; ++j) *((f32x4*)o + C.lane + 64 * j) = v[j] * rstd * *((const f32x4*)g + C.lane + 64 * j);
    }
}
__device__ __forceinline__ void phase_norm2(const Ctx& C, const DArgs& a, int l) {
    const float* XS = (const float*)(C.ws + WS_XS); bf16* H = (bf16*)(C.ws + WS_H); const float* mod = (const float*)(C.ws + WS_MOD);
    const float* g2 = a.in[I_N2G] + (size_t)l * DM; const float* rw = a.in[I_RW] + (size_t)l * DM * NEXP; const float* rb = a.in[I_RB] + (size_t)l * NEXP;
    int* tok_e = (int*)(C.ws + WS_ROUTE); float* gate = (float*)(C.ws + WS_ROUTE) + (size_t)1 * ROWS * 4; int* slot = (int*)(C.ws + WS_ROUTE) + (size_t)2 * ROWS * 4;
    LAS float* hrow = (LAS float*)(C.lds + C.wave * 4096);
    LAS int* hist = (LAS int*)(C.lds + MISC_OFF + 64);
    if (C.tid < NEXP) hist[C.tid] = 0;
    __syncthreads();
    const int row_lo = (l == DEPTH - 1) ? NCTX : 0;
    for (int row = row_lo + C.gw; row < ROWS; row += C.NGW) {
        const bool isctx = row < NCTX; f32x4 v[4]; load_row(XS + (size_t)row * DM, C.lane, v);
        const float rstd = row_rstd(v);
        const float* md = mod + (size_t)(l * 2 + (isctx ? 1 : 0)) * 6144 + 3 * DM;
        u32x2* o = (u32x2*)(H + (size_t)row * DM) + C.lane;
#pragma unroll
        for (int j = 0; j < 4; ++j) { const f32x4 g = *((const f32x4*)g2 + C.lane + 64 * j), sh = *((const f32x4*)md + C.lane + 64 * j), sc = *((const f32x4*)(md + DM) + C.lane + 64 * j);
            const f32x4 y = v[j] * rstd * g * (sc + 1.0f) + sh; u32x2 w; w.x = pk2(y.x, y.y); w.y = pk2(y.z, y.w); o[64 * j] = w;
            *(LAS f32x4*)(hrow + 4 * (C.lane + 64 * j)) = y; }
        LDS_WAIT(); asm volatile("" ::: "memory");
        const int e = C.lane & 31, hf = C.lane >> 5; float s = 0.f;
        const float* rwp = rw + (size_t)(hf * 512) * NEXP + e; const LAS float* hp = hrow + hf * 512;
#pragma unroll 8
        for (int k = 0; k < 512; ++k) s += hp[k] * rwp[(size_t)k * NEXP];
        s += __shfl_xor(s, 32);
        s += rb[e];
        float val = s; int te[4]; float tv[4];
#pragma unroll
        for (int k = 0; k < 4; ++k) { float bv = val; int bi = e;
#pragma unroll
            for (int o2 = 1; o2 < 32; o2 <<= 1) { const float ov = __shfl_xor(bv, o2); const int oi = __shfl_xor(bi, o2); if (ov > bv || (ov == bv && oi < bi)) { bv = ov; bi = oi; } }
            te[k] = bi; tv[k] = bv; if (e == bi) val = -3.0e38f; }
        if (C.lane == 0) { const float m = tv[0]; float p[4], ps = 0.f;
#pragma unroll
            for (int k = 0; k < 4; ++k) { p[k] = __expf(tv[k] - m); ps += p[k]; }
#pragma unroll
            for (int k = 0; k < 4; ++k) { tok_e[row * 4 + k] = te[k]; gate[row * 4 + k] = p[k] / ps; slot[row * 4 + k] = __hip_atomic_fetch_add(&hist[te[k]], 1, __ATOMIC_RELAXED, __HIP_MEMORY_SCOPE_WORKGROUP); } }
        asm volatile("" ::: "memory");
    }
    __syncthreads();
    if (C.tid < NEXP) ((int*)(C.ws + WS_CNT))[C.wg * NEXP + C.tid] = hist[C.tid];
}
__device__ __forceinline__ int moe_tables(const Ctx& C) {
    const int* cnt = (const int*)(C.ws + WS_CNT);
    LAS int* part = (LAS int*)(C.lds);
    LAS int* pstart = (LAS int*)(C.lds + MISC_OFF + 256); LAS int* wgbase = pstart + 40; LAS int* tot = wgbase + 32; LAS int* nblk_s = tot + 32;
    LAS unsigned char* blk_e = (LAS unsigned char*)(C.lds + MISC_OFF + 1024);
    __syncthreads();
    { const int e = C.tid & 31, p = C.tid >> 5; int t = 0, pre = 0;
#pragma unroll 1
      for (int w = p * 16; w < p * 16 + 16; ++w) { const int c = cnt[w * NEXP + e]; t += c; if (w < C.wg) pre += c; }
      part[(p * 32 + e) * 2] = t; part[(p * 32 + e) * 2 + 1] = pre; }
    __syncthreads();
    if (C.tid < NEXP) { int t = 0, pre = 0;
#pragma unroll 1
        for (int p = 0; p < 16; ++p) { t += part[(p * 32 + C.tid) * 2]; pre += part[(p * 32 + C.tid) * 2 + 1]; }
        tot[C.tid] = t; wgbase[C.tid] = pre; }
    __syncthreads();
    if (C.tid == 0) { int b = 0;
#pragma unroll 1
        for (int e = 0; e < NEXP; ++e) { pstart[e] = b * 256; b += (tot[e] + 255) >> 8; }
        pstart[NEXP] = b * 256; nblk_s[0] = b; }
    __syncthreads();
    if (C.tid < NEXP) wgbase[C.tid] += pstart[C.tid];
    if (C.tid < MOE_MAXBLK) { int e = 0;
#pragma unroll 1
        for (int k = 1; k < NEXP; ++k) if (pstart[k] <= C.tid * 256) e = k;
        blk_e[C.tid] = (unsigned char)e; }
    __syncthreads();
    return __builtin_amdgcn_readfirstlane(nblk_s[0]);
}
__device__ __forceinline__ void phase_gather(const Ctx& C, const DArgs& a, int l) {
    moe_tables(C);
    const LAS int* wgbase = (const LAS int*)(C.lds + MISC_OFF + 256) + 40;
    const int* tok_e = (const int*)(C.ws + WS_ROUTE); const int* slot = (const int*)(C.ws + WS_ROUTE) + (size_t)2 * ROWS * 4; int* dest = (int*)(C.ws + WS_ROUTE) + (size_t)3 * ROWS * 4;
    const bf16* H = (const bf16*)(C.ws + WS_H); bf16* XG = (bf16*)(C.ws + WS_XG);
    const int row_lo = (l == DEPTH - 1) ? NCTX : 0;
    for (int row = row_lo + C.gw; row < ROWS; row += C.NGW) {
        const u32x4* src = (const u32x4*)(H + (size_t)row * DM) + C.lane; const u32x4 v0 = src[0], v1 = src[64];
#pragma unroll
        for (int k = 0; k < 4; ++k) { const int d = wgbase[tok_e[row * 4 + k]] + slot[row * 4 + k]; if (C.lane == 0) dest[row * 4 + k] = d;
            u32x4* dp = (u32x4*)(XG + (size_t)d * DM) + C.lane; dp[0] = v0; dp[64] = v1; }
    }
}

__device__ __forceinline__ void mix1_rope(const Ctx& C) {
    bf16* P = (bf16*)(C.ws + WS_P);
    const long total = (long)SEQ * 192;
    for (long i = (long)C.wg * NTHR + C.tid; i < total; i += (long)C.G * NTHR) {
        const int j = (int)(i & 31), hh = (int)((i >> 5) % 6), t = (int)(i / 192);
        const int col = (hh < 4) ? (C_AQ + hh * 64) : (C_AK + (hh - 4) * 64);
        const float pos = (j < 16) ? (float)(t >> 6) : (float)(t & 63);
        const float inv = __powf(10000.0f, -(float)(j & 15) * (1.0f / 16.0f));
        const float ang = pos * inv * 0.31830988618379067f;
        const float cs = cospif(ang), sn = sinpif(ang);
        bf16* p = P + (size_t)(NCTX + t) * INWP + col;
        const float x1 = bf2f(p[j]), x2 = bf2f(p[j + 32]);
        p[j] = (bf16)f2bf(x1 * cs - x2 * sn); p[j + 32] = (bf16)f2bf(x2 * cs + x1 * sn);
    }
}
__device__ __forceinline__ void mix1_vt(const Ctx& C) {
    const bf16* P = (const bf16*)(C.ws + WS_P);
    LAS unsigned short* scr = (LAS unsigned short*)(C.lds + C.wave * 16384);
    for (int u = C.gw; u < (ROWS / 64) * 6; u += C.NGW) {
        const int hd = u % 6, tb = u / 6; const int vcol = (hd < 2) ? (C_AV + hd * 64) : (C_CV + (hd - 2) * 64);
        bf16* VT = ((hd < 2) ? (bf16*)(C.ws + WS_VTA) + (size_t)hd * 64 * VTP : (bf16*)(C.ws + WS_VTC) + (size_t)(hd - 2) * 64 * VTP);
#pragma unroll
        for (int i = 0; i < 8; ++i) { const int tk = (C.lane >> 3) + 8 * i, ch = C.lane & 7; const u32x4 w = *(const u32x4*)(P + (size_t)(tb * 64 + tk) * INWP + vcol + 8 * ch);
            LAS unsigned* d = (LAS unsigned*)(scr + tk * 66 + 8 * ch); d[0] = w.x; d[1] = w.y; d[2] = w.z; d[3] = w.w; }
        LDS_WAIT(); asm volatile("" ::: "memory");
#pragma unroll
        for (int k8 = 0; k8 < 8; ++k8) { unsigned w[4];
#pragma unroll
            for (int e2 = 0; e2 < 4; ++e2) { const unsigned lo = scr[(8 * k8 + 2 * e2) * 66 + C.lane], hi = scr[(8 * k8 + 2 * e2 + 1) * 66 + C.lane]; w[e2] = lo | (hi << 16); }
            *(u32x4*)(VT + (size_t)C.lane * VTP + tb * 64 + 8 * k8) = (u32x4){w[0], w[1], w[2], w[3]}; }
        LDS_WAIT(); asm volatile("" ::: "memory");
    }
    for (int i = C.wg * NTHR + C.tid; i < 6 * 64 * 32; i += C.G * NTHR) { const int rowi = i >> 5, pc = i & 31; const int hd = rowi >> 6, d = rowi & 63;
        bf16* VT = ((hd < 2) ? (bf16*)(C.ws + WS_VTA) + (size_t)hd * 64 * VTP : (bf16*)(C.ws + WS_VTC) + (size_t)(hd - 2) * 64 * VTP);
        *(u32x4*)(VT + (size_t)d * VTP + ROWS + 8 * pc) = (u32x4){0u, 0u, 0u, 0u}; }
}
__device__ __forceinline__ float conv3(const bf16* P, int row, int col, const float* cw, int cc) {
    const bool first = (row == 0) || (row == NCTX), last = (row == NCTX - 1) || (row == ROWS - 1);
    float s = cw[768 + cc] * bf2f(P[(size_t)row * INWP + col]);
    if (!first) s += cw[cc] * bf2f(P[(size_t)(row - 1) * INWP + col]);
    if (!last) s += cw[2 * 768 + cc] * bf2f(P[(size_t)(row + 1) * INWP + col]);
    return s;
}
__device__ __forceinline__ void mix1_rwkv_prep(const Ctx& C, const DArgs& a, int l) {
    const bf16* P = (const bf16*)(C.ws + WS_P); float* SC = (float*)(C.ws + WS_SC);
    LAS float* lo = (LAS float*)(C.lds);
    const float* cw = a.in[I_DCONV] + (size_t)l * 3 * 768;
    const float* w0 = a.in[I_DW0] + (size_t)l * 512; const float* w2 = a.in[I_DW2] + (size_t)l * 2 * 64 * 256;
    const float* a0 = a.in[I_DA0] + (size_t)l * 512; const float* a2 = a.in[I_DA2] + (size_t)l * 2 * 64 * 256;
    const float* kkw = a.in[I_DKK] + (size_t)l * 256; const float* kaw = a.in[I_DKA] + (size_t)l * 256;
    const int half = C.tid >> 8, c = C.tid & 255;
    for (int pr = C.wg; pr < ROWS / 2; pr += C.G) {
        const int row = 2 * pr + half;
        __syncthreads();
        { const float x = bf2f(P[(size_t)row * INWP + C_WL + c]); lo[half * 256 + c] = (c < 128) ? tanhf(x) : x; }
        __syncthreads();
        const float r = conv3(P, row, C_DR + c, cw, c), k = conv3(P, row, C_DK + c, cw, 256 + c), v = conv3(P, row, C_DV + c, cw, 512 + c);
        float kk = k * kkw[c]; const float n2 = wave_sum(kk * kk); kk *= rsqrtf(fmaxf(n2, 1e-24f));
        float* sc = SC + (size_t)row * 9 * 256;
        sc[c] = r; sc[256 + c] = v; sc[512 + c] = -kk;
#pragma unroll
        for (int d = 0; d < 2; ++d) {
            float wp = w0[d * 256 + c], ap = a0[d * 256 + c];
            const LAS float* wl = lo + half * 256 + d * 64; const LAS float* al = lo + half * 256 + 128 + d * 64;
            const float* w2p = w2 + (size_t)d * 64 * 256 + c; const float* a2p = a2 + (size_t)d * 64 * 256 + c;
#pragma unroll 8
            for (int i = 0; i < 64; ++i) { wp += wl[i] * w2p[i * 256]; ap += al[i] * a2p[i * 256]; }
            const float nw = -wp, sp = fmaxf(nw, 0.f) + log1pf(__expf(-fabsf(nw)));
            const float dec = __expf(-__expf(-sp - 0.5f));
            const float as = sigmoidf_(ap);
            sc[(3 + 3 * d) * 256 + c] = dec; sc[(4 + 3 * d) * 256 + c] = k * (1.0f + (as - 1.0f) * kaw[c]); sc[(5 + 3 * d) * 256 + c] = kk * as;
        }
    }
    __syncthreads();
}
__device__ __forceinline__ void mix1_fourier1(const Ctx& C) {
    const bf16* P = (const bf16*)(C.ws + WS_P); const float* tw = (const float*)(C.ws + WS_TW);
    float* FYR = (float*)(C.ws + WS_FYR); float* FYI = (float*)(C.ws + WS_FYI);
    LAS float* ct = (LAS float*)(C.lds + 4096); LAS float* st = ct + 128;
    __syncthreads();
    if (C.tid < 128) { ct[C.tid] = tw[128 * C.tid]; st[C.tid] = tw[16384 + 128 * C.tid]; }
    __syncthreads();
    for (int u = C.wg; u < 128 * 128 * 256 / NTHR; u += C.G) {
        const int idx = u * NTHR + C.tid, ch = idx & 255, t2 = (idx >> 8) & 127, k1 = idx >> 15;
        float dr = 0.f, di = 0.f;
        const bf16* up = P + (size_t)(NCTX + t2) * INWP + C_BU + ch;
#pragma unroll 8
        for (int t1 = 0; t1 < 128; ++t1) { const float x = bf2f(up[(size_t)t1 * 128 * INWP]); const int m = (k1 * t1) & 127; dr += x * ct[m]; di -= x * st[m]; }
        const float cp = tw[t2 * k1], sp = tw[16384 + t2 * k1];
        FYR[idx] = dr * cp + di * sp; FYI[idx] = di * cp - dr * sp;
    }
    __syncthreads();
}

constexpr float LOG2E = 1.4426950408889634f;
typedef short bf16x4 __attribute__((ext_vector_type(4)));
__device__ __forceinline__ bf16x8 ldg8(const bf16* p) { return *(const bf16x8*)p; }
template <int NH>
__device__ __forceinline__ void attn_block(const bf16* P, const bf16* VT, int krow, int kcol, const bf16x8 (&qf)[NH][2], f32x4 (&o)[NH][4], float (&m)[NH], float (&ls)[NH],
                                           const float (&add)[2][4], int li, int g) {
    bf16x8 kf[2][2];
#pragma unroll
    for (int t = 0; t < 2; ++t)
#pragma unroll
        for (int ks = 0; ks < 2; ++ks) kf[t][ks] = ldg8(P + (size_t)(krow + 16 * t + li) * INWP + kcol + 32 * ks + 8 * g);
    bf16x8 vf[4];
#pragma unroll
    for (int dt = 0; dt < 4; ++dt) { const bf16* vp = VT + (size_t)(dt * 16 + li) * VTP + krow + 4 * g;
        const bf16x4 a = *(const bf16x4*)vp, b = *(const bf16x4*)(vp + 16); vf[dt] = (bf16x8){a[0], a[1], a[2], a[3], b[0], b[1], b[2], b[3]}; }
#pragma unroll
    for (int hh = 0; hh < NH; ++hh) {
        f32x4 st[2];
#pragma unroll
        for (int t = 0; t < 2; ++t) { st[t] = (f32x4){0.f, 0.f, 0.f, 0.f};
#pragma unroll
            for (int ks = 0; ks < 2; ++ks) st[t] = __builtin_amdgcn_mfma_f32_16x16x32_bf16(kf[t][ks], qf[hh][ks], st[t], 0, 0, 0); }
        float s[8]; float bm = -INFINITY;
#pragma unroll
        for (int t = 0; t < 2; ++t)
#pragma unroll
            for (int r = 0; r < 4; ++r) { s[4 * t + r] = (add[t][r] == -INFINITY) ? -INFINITY : st[t][r] * (0.125f * LOG2E) + add[t][r]; bm = fmaxf(bm, s[4 * t + r]); }
        bm = fmaxf(bm, __shfl_xor(bm, 16)); bm = fmaxf(bm, __shfl_xor(bm, 32));
        const float mn = fmaxf(m[hh], bm), corr = __builtin_amdgcn_exp2f(m[hh] - mn); m[hh] = mn;
        float ps = 0.f; float pe[8];
#pragma unroll
        for (int e = 0; e < 8; ++e) { pe[e] = __builtin_amdgcn_exp2f(s[e] - mn); ps += pe[e]; }
        ls[hh] = ls[hh] * corr + ps;
        union { bf16x8 v; unsigned u[4]; } pf;
#pragma unroll
        for (int e2 = 0; e2 < 4; ++e2) pf.u[e2] = pk2(pe[2 * e2], pe[2 * e2 + 1]);
#pragma unroll
        for (int dt = 0; dt < 4; ++dt) { o[hh][dt] = o[hh][dt] * corr; o[hh][dt] = __builtin_amdgcn_mfma_f32_16x16x32_bf16(vf[dt], pf.v, o[hh][dt], 0, 0, 0); }
    }
}
template <int NH>
__device__ __forceinline__ void attn_finish(bf16* MIX, int qrow0, int ocol, f32x4 (&o)[NH][4], float (&m)[NH], float (&ls)[NH], const float* sink2  , int li, int g) {
#pragma unroll
    for (int hh = 0; hh < NH; ++hh) {
        float l = ls[hh]; l += __shfl_xor(l, 16); l += __shfl_xor(l, 32);
        float corr = 1.f;
        if (sink2) { const float sk = sink2[hh]; const float mn = fmaxf(m[hh], sk); corr = __builtin_amdgcn_exp2f(m[hh] - mn); l = l * corr + __builtin_amdgcn_exp2f(sk - mn); }
        const float inv = corr / l;
#pragma unroll
        for (int dt = 0; dt < 4; ++dt) { const f32x4 v = o[hh][dt] * inv; u32x2 w; w.x = pk2(v[0], v[1]); w.y = pk2(v[2], v[3]);
            *(u32x2*)(MIX + (size_t)(qrow0 + li) * DM + ocol + hh * 64 + dt * 16 + 4 * g) = w; }
    }
}
__device__ __forceinline__ void attnA_unit(const Ctx& C, const float* asink_l, int unit, bool lat) {
    const bf16* P = (const bf16*)(C.ws + WS_P); bf16* MIX = (bf16*)(C.ws + WS_MIX);
    const int li = C.lane & 15, g = C.lane >> 4;
    const int nqt = lat ? SEQ / 16 : NCTX / 16, kvh = unit / nqt, qt = unit % nqt, t0 = qt * 16, qrow0 = (lat ? NCTX : 0) + t0;
    const bf16* VT = (const bf16*)(C.ws + WS_VTA) + (size_t)kvh * 64 * VTP; const int kcol = C_AK + kvh * 64;
    bf16x8 qf[2][2];
#pragma unroll
    for (int hh = 0; hh < 2; ++hh)
#pragma unroll
        for (int ks = 0; ks < 2; ++ks) qf[hh][ks] = ldg8(P + (size_t)(qrow0 + li) * INWP + C_AQ + (kvh * 2 + hh) * 64 + 32 * ks + 8 * g);
    f32x4 o[2][4]; float m[2] = {-1.0e30f, -1.0e30f}, ls[2] = {0.f, 0.f};
#pragma unroll
    for (int hh = 0; hh < 2; ++hh)
#pragma unroll
        for (int dt = 0; dt < 4; ++dt) o[hh][dt] = (f32x4){0.f, 0.f, 0.f, 0.f};
    if (lat) {
        const int t = t0 + li;
#pragma unroll 1
        for (int b = 0; b < 9; ++b) { const int j0 = t0 - 128 + 32 * b; float add[2][4];
#pragma unroll
            for (int tt = 0; tt < 2; ++tt)
#pragma unroll
                for (int r = 0; r < 4; ++r) { const int j = j0 + 16 * tt + 4 * g + r; const bool ok = (j >= 0) && (j < SEQ) && (j - t <= 128) && (t - j <= 128); add[tt][r] = ok ? 0.f : -INFINITY; }
            attn_block<2>(P, VT, NCTX + j0, kcol, qf, o, m, ls, add, li, g); }
    }
    { float add[2][4];
#pragma unroll
      for (int tt = 0; tt < 2; ++tt)
#pragma unroll
          for (int r = 0; r < 4; ++r) add[tt][r] = 0.f;
#pragma unroll 1
      for (int b = 0; b < NCTX / 32; ++b) attn_block<2>(P, VT, 32 * b, kcol, qf, o, m, ls, add, li, g); }
    float sk2[2] = {asink_l[kvh * 2] * LOG2E, asink_l[kvh * 2 + 1] * LOG2E};
    attn_finish<2>(MIX, qrow0, kvh * 128, o, m, ls, sk2, li, g);
}
__device__ __forceinline__ void attnC_unit(const Ctx& C, const LAS float* relb, int h, int qt, bool lat) {
    const bf16* P = (const bf16*)(C.ws + WS_P); bf16* MIX = (bf16*)(C.ws + WS_MIX);
    const int li = C.lane & 15, g = C.lane >> 4;
    const int t0 = qt * 16, qrow0 = (lat ? NCTX : 0) + t0;
    const bf16* VT = (const bf16*)(C.ws + WS_VTC) + (size_t)h * 64 * VTP; const int kcol = C_CK + h * 64;
    bf16x8 qf[1][2];
#pragma unroll
    for (int ks = 0; ks < 2; ++ks) qf[0][ks] = ldg8(P + (size_t)(qrow0 + li) * INWP + C_CQ + h * 64 + 32 * ks + 8 * g);
    f32x4 o[1][4]; float m[1] = {-1.0e30f}, ls[1] = {0.f};
#pragma unroll
    for (int dt = 0; dt < 4; ++dt) o[0][dt] = (f32x4){0.f, 0.f, 0.f, 0.f};
    if (lat) {
        const int r = t0 >> 6, cj = (t0 >> 4) & 3, cq = cj * 16 + li; int r0 = r - 4; r0 = r0 < 0 ? 0 : (r0 > 248 ? 248 : r0);
        int c0 = cq - 8; c0 = c0 < 0 ? 0 : (c0 > 48 ? 48 : c0);
        const int cw0 = (cj == 0) ? 0 : (cj == 1) ? 8 : (cj == 2) ? 24 : 32;
#pragma unroll 1
        for (int kr = r0; kr < r0 + 8; ++kr) { float add[2][4]; const LAS float* rbp = relb + (kr - r + 7) * 31;
#pragma unroll
            for (int tt = 0; tt < 2; ++tt)
#pragma unroll
                for (int rr = 0; rr < 4; ++rr) { const int kc = cw0 + 16 * tt + 4 * g + rr; int ci = kc - cq + 15; ci = ci < 0 ? 0 : (ci > 30 ? 30 : ci);
                    const float bv = rbp[ci]; add[tt][rr] = (kc >= c0 && kc < c0 + 16) ? bv : -INFINITY; }
            attn_block<1>(P, VT, NCTX + kr * 64 + cw0, kcol, qf, o, m, ls, add, li, g); }
    }
    { float add[2][4];
#pragma unroll
      for (int tt = 0; tt < 2; ++tt)
#pragma unroll
          for (int r = 0; r < 4; ++r) add[tt][r] = 0.f;
#pragma unroll 1
      for (int b = 0; b < NCTX / 32; ++b) attn_block<1>(P, VT, 32 * b, kcol, qf, o, m, ls, add, li, g); }
    attn_finish<1>(MIX, qrow0, 512 + h * 64, o, m, ls, nullptr, li, g);
}
__device__ __forceinline__ void fourier2_unit(const Ctx& C, int l, int u, bool ctx) {
    const bf16* P = (const bf16*)(C.ws + WS_P); const float* tw = (const float*)(C.ws + WS_TW); bf16* MIX = (bf16*)(C.ws + WS_MIX);
    const float* FYR = (const float*)(C.ws + WS_FYR); const float* FYI = (const float*)(C.ws + WS_FYI);
    const float* mt = (const float*)(C.ws + WS_MTAB) + (size_t)l * 2 * 4 * 4096;
    LAS float* xr = (LAS float*)(C.lds + 8192); LAS float* xi = xr + 512;
    const int tl = C.tid >> 8, ch = C.tid & 255, tp = 2 * u + tl;
    float sr = 0.f, si = 0.f;
    if (!ctx) { const int k1 = tp & 127, k2 = tp >> 7; const float* yr = FYR + (size_t)k1 * 128 * 256 + ch; const float* yi = FYI + (size_t)k1 * 128 * 256 + ch;
#pragma unroll 8
        for (int t2 = 0; t2 < 128; ++t2) { const int m = ((t2 * k2) & 127) * 128; const float c = tw[m], s = tw[16384 + m]; const float a = yr[t2 * 256], b = yi[t2 * 256]; sr += a * c + b * s; si += b * c - a * s; } }
    else {
#pragma unroll 8
        for (int t = 0; t < NCTX; ++t) { const int m = ((t * tp) & 255) * 64; const float x = bf2f(P[(size_t)t * INWP + C_BU + ch]); sr += x * tw[m]; si -= x * tw[16384 + m]; } }
    __syncthreads();
    xr[tl * 256 + ch] = sr; xi[tl * 256 + ch] = si;
    __syncthreads();
    const int g = ch >> 6, e = ch & 63; const float* mc = mt + (size_t)(0 * 4 + g) * 4096 + e; const float* ms = mt + (size_t)(1 * 4 + g) * 4096 + e;
    const LAS float* xrp = xr + tl * 256 + g * 64; const LAS float* xip = xi + tl * 256 + g * 64; float o = 0.f;
#pragma unroll 8
    for (int c = 0; c < 64; ++c) o += xrp[c] * mc[c * 64] + xip[c] * ms[c * 64];
    o *= ctx ? (1.0f / 128.0f) : (1.0f / 1024.0f);
    MIX[(size_t)((ctx ? 0 : NCTX) + tp) * DM + 256 + ch] = (bf16)f2bf(o);
}
__device__ __forceinline__ void rwkv_scan_seq(const Ctx& C, int b) {
    const float* SC = (const float*)(C.ws + WS_SC); float* YS = (float*)(C.ws + WS_YS);
    const int d = b >> 2, h = b & 3, il = C.lane & 15, jq = C.lane >> 4, i = (C.wave & 3) * 16 + il;
    LAS float* buf = (LAS float*)(C.lds + 16384);
    float S[16];
#pragma unroll
    for (int m = 0; m < 16; ++m) S[m] = 0.f;
    for (int p0 = 0; p0 < ROWS; p0 += 16) {
        __syncthreads();
#pragma unroll
        for (int t = 0; t < 3; ++t) { const int f = C.tid + 512 * t;
            const int st = f / 96, q = (f % 96) / 16, c4 = f % 16, p = p0 + st;
            const int row = (d == 0) ? p : (p < NCTX ? NCTX - 1 - p : ROWS + NCTX - 1 - p);
            const int qq = (q == 0) ? 2 : (q == 1) ? 3 + 3 * d : (q == 2) ? 4 + 3 * d : (q == 3) ? 5 + 3 * d : (q == 4) ? 0 : 1;
            *(LAS f32x4*)(buf + (st * 6 + q) * 64 + 4 * c4) = *(const f32x4*)(SC + ((size_t)row * 9 + qq) * 256 + h * 64 + 4 * c4); }
        __syncthreads();
        if (C.wave < 4) {
            for (int st = 0; st < 16; ++st) {
                const int p = p0 + st; const int row = (d == 0) ? p : (p < NCTX ? NCTX - 1 - p : ROWS + NCTX - 1 - p);
                const LAS float* sb = buf + st * 6 * 64 + jq * 16;
                f32x4 av[4], wv[4], kv[4], bv[4], rv[4];
#pragma unroll
                for (int m = 0; m < 4; ++m) { av[m] = *(const LAS f32x4*)(sb + 4 * m); wv[m] = *(const LAS f32x4*)(sb + 64 + 4 * m); kv[m] = *(const LAS f32x4*)(sb + 128 + 4 * m);
                    bv[m] = *(const LAS f32x4*)(sb + 192 + 4 * m); rv[m] = *(const LAS f32x4*)(sb + 256 + 4 * m); }
                const float v = buf[st * 6 * 64 + 320 + i];
                float sa = 0.f;
#pragma unroll
                for (int m = 0; m < 16; ++m) sa += S[m] * av[m >> 2][m & 3];
                sa += __shfl_xor(sa, 16); sa += __shfl_xor(sa, 32);
                float y = 0.f;
#pragma unroll
                for (int m = 0; m < 16; ++m) { S[m] = S[m] * wv[m >> 2][m & 3] + sa * bv[m >> 2][m & 3] + v * kv[m >> 2][m & 3]; y += S[m] * rv[m >> 2][m & 3]; }
                y += __shfl_xor(y, 16); y += __shfl_xor(y, 32);
                if (jq == 0) YS[((size_t)d * ROWS + row) * 256 + h * 64 + i] = y;
            }
        }
    }
    __syncthreads();
}
__device__ __forceinline__ void phase_mix2(const Ctx& C, const DArgs& a, int l) {
    const bool emit_ctx = l < DEPTH - 1;
    if (C.wg < 8) rwkv_scan_seq(C, C.wg);
    { const float* asink_l = a.in[I_ASINK] + l * 4; const float* crel = a.in[I_CREL] + (size_t)l * 4 * 465;
      LAS float* relb = (LAS float*)(C.lds + 65536 + C.wave * 2048);
      const int nA = 2 * (SEQ / 16), nC = 4 * (SEQ / 16), nAc = emit_ctx ? 2 * (NCTX / 16) : 0, nCc = emit_ctx ? 4 * (NCTX / 16) : 0;
      for (int u = C.gw; u < nA + nAc; u += C.NGW) { if (u < nA) attnA_unit(C, asink_l, u, true); else attnA_unit(C, asink_l, u - nA, false); }
      int hcur = -1;
      for (int u = C.gw; u < nC + nCc; u += C.NGW) { const bool lat = u < nC; const int uu = lat ? u : u - nC, nqt = lat ? SEQ / 16 : NCTX / 16, h = uu / nqt, qt = uu % nqt;
          if (h != hcur) { for (int i = C.lane; i < 465; i += 64) relb[i] = crel[h * 465 + i] * LOG2E; hcur = h; LDS_WAIT(); asm volatile("" ::: "memory"); }
          attnC_unit(C, relb, h, qt, lat); } }
    __syncthreads();
    const int nF = SEQ / 2, nFc = emit_ctx ? NCTX / 2 : 0;
    for (int u = C.wg; u < nF + nFc; u += C.G) {
        if (u < nF) fourier2_unit(C, l, u, false);
        else fourier2_unit(C, l, u - nF, true);
    }
}
__device__ __forceinline__ void phase_mix3(const Ctx& C, const DArgs& a, int l) {
    const bf16* P = (const bf16*)(C.ws + WS_P); const float* SC = (const float*)(C.ws + WS_SC); const float* YS = (const float*)(C.ws + WS_YS); bf16* MIX = (bf16*)(C.ws + WS_MIX);
    LAS float* gl = (LAS float*)(C.lds);
    const float* g2 = a.in[I_DG2] + (size_t)l * 160 * 256; const float* rk = a.in[I_DRK] + (size_t)l * 256; const float* lnw = a.in[I_DLNW] + (size_t)l * 256; const float* lnb = a.in[I_DLNB] + (size_t)l * 256;
    const int half = C.tid >> 8, c = C.tid & 255;
    const int row_lo = (l == DEPTH - 1) ? NCTX : 0;
    for (int pr = C.wg + row_lo / 2; pr < ROWS / 2; pr += C.G) {
        const int row = 2 * pr + half;
        __syncthreads();
        if (c < 160) gl[half * 160 + c] = sigmoidf_(bf2f(P[(size_t)row * INWP + C_GL + c]));
        __syncthreads();
        const float* sc = SC + (size_t)row * 9 * 256;
        const float y = YS[(size_t)row * 256 + c] + YS[((size_t)ROWS + row) * 256 + c];
        const float mu = wave_sum(y) * (1.f / 64.f), dy = y - mu, var = wave_sum(dy * dy) * (1.f / 64.f);
        const float yn = dy * rsqrtf(var + 64e-5f) * lnw[c] + lnb[c];
        const float r = sc[c], v = sc[256 + c];
        const float coef = wave_sum(r * (sc[4 * 256 + c] + sc[7 * 256 + c]) * rk[c]);
        float g = 0.f; const float* g2p = g2 + c; const LAS float* glp = gl + half * 160;
#pragma unroll 8
        for (int i = 0; i < 160; ++i) g += glp[i] * g2p[i * 256];
        MIX[(size_t)row * DM + 768 + c] = (bf16)f2bf((yn + coef * v) * g);
    }
    __syncthreads();
}

#ifndef MK_SINGLE
#define MK_SINGLE 1
#endif
template <int ONLYP> __global__ void __launch_bounds__(NTHR, 2) mega(Args a) {
    extern __shared__ __attribute__((aligned(16))) unsigned char lds_raw[];
    Ctx C;
#define MKCTX() do { int t_ = threadIdx.x; asm volatile("" : "+v"(t_)); unsigned char* w_ = a.ws; asm volatile("" : "+s"(w_)); unsigned l_ = 0u; asm volatile("" : "+s"(l_)); \
        C.lds = (LAS unsigned char*)lds_raw + l_; C.tid = t_; C.lane = t_ & 63; C.wave = __builtin_amdgcn_readfirstlane(t_ >> 6); \
        C.wg = blockIdx.x; C.G = gridDim.x; C.gw = C.wg * NWAVES + C.wave; C.NGW = C.G * NWAVES; C.ws = w_; } while (0)
    MKCTX();
    if (C.tid == 0) {
#pragma unroll
        for (int i = 0; i < 31; ++i) ((LAS unsigned long long*)(C.lds + MISC_OFF + 2048))[i] = (unsigned long long)a.in[i]; }
    DArgs da; da.in.tab = (const LAS unsigned*)(C.lds + MISC_OFF + 2048); da.out = a.out;
    if (C.tid < 4) ((LAS unsigned*)(C.lds + MISC_OFF))[C.tid] = 0u;
    __syncthreads();
    XcdBarrier bar; bar.bar = (unsigned*)(C.ws + WS_CTL) + CW_BAR; bar.x = 0; bar.st = (volatile LAS unsigned*)(C.lds + MISC_OFF);
    if (a.use_bar) bar = xcd_barrier_post((unsigned*)(C.ws + WS_CTL) + CW_BAR, (volatile LAS unsigned*)(C.lds + MISC_OFF));
#ifndef PHMASK
#define PHMASK 0xfff
#endif
#define INP(o, k) ((ONLYP < 0 || ONLYP == (o)) && ((PHMASK >> ((o) == 99 ? 11 : (o))) & 1) && a.ph_lo <= (k) && (k) < a.ph_hi)
#define IN(k) (a.ph_lo <= (k) && (k) < a.ph_hi)
#define SEAM(k) do { if (a.use_bar && IN(k) && IN((k) + 1)) xcd_barrier(bar); } while (0)
    if (INP(0, 0)) { MKCTX(); phase_prologue(C, da); }
    SEAM(0);
    for (int l = 0; l < DEPTH; ++l) {
        const int b = 1 + l * NPL;
        const float* mod_lat = (const float*)(C.ws + WS_MOD) + (size_t)(l * 2 + 0) * 6144; const float* mod_ctx = mod_lat + 6144;
        if (INP(1, b + 0)) { MKCTX(); phase_norm1(C, da, l); }
        SEAM(b + 0);
        if (INP(2, b + 1)) { MKCTX();
            pg8::StaticOrder S; S.init(C.ws + WS_H, (const bf16*)(C.ws + WS_WIN) + (size_t)l * INWP * DM, ROWS, INWP, DM, C.G, C.wg);
            pg8::EpiStoreBf16 E{(bf16*)(C.ws + WS_P), INWP, nullptr, 0};
            pg8::gemm_phase<pg8::EpiStoreBf16, pg8::StaticOrder, true, true>(C.lds, C.tid, DM, S, E);
        }
        SEAM(b + 1);
        if (INP(3, b + 2)) { MKCTX(); mix1_rope(C); mix1_vt(C); mix1_rwkv_prep(C, da, l); mix1_fourier1(C); }
        SEAM(b + 2);
        if (INP(4, b + 3)) { MKCTX(); phase_mix2(C, da, l); }
        SEAM(b + 3);
        if (INP(5, b + 4)) { MKCTX(); phase_mix3(C, da, l); }
        SEAM(b + 4);
        if (INP(6, b + 5)) { MKCTX();
            pg8::StaticOrder S; S.init(C.ws + WS_MIX, (const bf16*)(C.ws + WS_WOUT) + (size_t)l * DM * DM, ROWS, DM, DM, C.G, C.wg);
            pg8::EpiResidual E{(float*)(C.ws + WS_XS), DM, mod_lat + 2 * DM, mod_ctx + 2 * DM};
            pg8::gemm_phase<pg8::EpiResidual, pg8::StaticOrder, true, true>(C.lds, C.tid, DM, S, E);
        }
        SEAM(b + 5);
        if (INP(7, b + 6)) { MKCTX(); phase_norm2(C, da, l); }
        SEAM(b + 6);
        if (INP(8, b + 7)) { MKCTX(); phase_gather(C, da, l); }
        SEAM(b + 7);
        if (INP(9, b + 8)) { MKCTX();
            const int nblk = moe_tables(C);
            pg8::MoeOrder S{(const char*)(C.ws + WS_XG), (const char*)((const bf16*)(C.ws + WS_WGU) + (size_t)l * 32 * 2048 * DM), (size_t)256 * DM * 2, (size_t)2048 * DM * 2,
                            (const LAS unsigned char*)(C.lds + MISC_OFF + 1024), nblk, 8, C.G, C.wg};
            pg8::EpiSwiglu E{(bf16*)(C.ws + WS_ACT), DM, da.in[I_BGU] + (size_t)l * 32 * 2048, 2048};
            pg8::gemm_phase<pg8::EpiSwiglu, pg8::MoeOrder, true, true>(C.lds, C.tid, DM, S, E);
        }
        SEAM(b + 8);
        if (INP(10, b + 9)) { MKCTX();
            const int nblk = moe_tables(C);
            pg8::MoeOrder S{(const char*)(C.ws + WS_ACT), (const char*)((const bf16*)(C.ws + WS_WDN) + (size_t)l * 32 * DM * DM), (size_t)256 * DM * 2, (size_t)DM * DM * 2,
                            (const LAS unsigned char*)(C.lds + MISC_OFF + 1024), nblk, 4, C.G, C.wg};
            pg8::EpiStoreBf16 E{(bf16*)(C.ws + WS_XG), DM, da.in[I_BDN] + (size_t)l * 32 * DM, DM};
            pg8::gemm_phase<pg8::EpiStoreBf16, pg8::MoeOrder, true, true>(C.lds, C.tid, DM, S, E);
        }
        SEAM(b + 9);
    }
    if (INP(99, PH_TOTAL - 1)) { MKCTX(); phase_final(C, da); }
#undef IN
#undef INP
#undef SEAM
}

typedef void (*kern_t)(Args);
static kern_t kern_of(int o) {
    switch (o) { case 0: return mega<0>; case 1: return mega<1>; case 2: return mega<2>; case 3: return mega<3>; case 4: return mega<4>; case 5: return mega<5>; case 6: return mega<6>;
                 case 7: return mega<7>; case 8: return mega<8>; case 9: return mega<9>; case 10: return mega<10>; case 99: return mega<99>;
#if MK_SINGLE
                 default: return mega<-1>;
#else
                 default: return mega<0>;
#endif
    }
}
extern "C" void kernel_launch(void* const* d_in, const int* in_sizes, int n_in, void* d_out, int out_size, void* d_ws, size_t ws_size, hipStream_t stream) {
    static int ready = 0;
    if (ready == 0) {
        if (n_in != 31 || out_size != SEQ * DM || ws_size < WS_END) { fprintf(stderr, "kernel_launch: unexpected shapes (n_in %d, out %d, ws %zu)\n", n_in, out_size, ws_size); ready = -1; return; }
        const int ids[13] = {0, 1, 2, 3, 4, 5, 6, 7, 8, 9, 10, 99, -1};
        for (int i = 0; i < (MK_SINGLE ? 13 : 12); ++i) { if (MK_SINGLE && ids[i] != -1) continue;
            if (hipFuncSetAttribute((const void*)kern_of(ids[i]), hipFuncAttributeMaxDynamicSharedMemorySize, LDS_BYTES) != hipSuccess) { fprintf(stderr, "kernel_launch: hipFuncSetAttribute failed (%d)\n", ids[i]); ready = -1; return; } }
        ready = 1;
    }
    if (ready < 0) return;
    (void)hipMemsetAsync((char*)d_ws + WS_CTL, 0, CTL_ZERO_BYTES, stream);
    Args a{};
    for (int i = 0; i < 31; ++i) a.in[i] = (const float*)d_in[i];
    a.out = (float*)d_out; a.ws = (unsigned char*)d_ws; a.pad = 0;
#if MK_SINGLE
    a.ph_lo = 0; a.ph_hi = PH_TOTAL; a.use_bar = 1;
    hipLaunchKernelGGL(kern_of(-1), dim3(NWG), dim3(NTHR), LDS_BYTES, stream, a);
#else
    for (int p = 0; p < PH_TOTAL; ++p) { a.ph_lo = p; a.ph_hi = p + 1; a.use_bar = 0;
        const int o = (p == 0) ? 0 : (p == PH_TOTAL - 1) ? 99 : 1 + (p - 1) % NPL;
        hipLaunchKernelGGL(kern_of(o), dim3(NWG), dim3(NTHR), LDS_BYTES, stream, a); }
#endif
}
```

```cpp
#include <hip/hip_runtime.h>
#include <cstdio>
#include <cstdint>

#define LAS __attribute__((address_space(3)))
typedef unsigned short bf16;
typedef float f32x4 __attribute__((ext_vector_type(4)));
typedef float f32x2 __attribute__((ext_vector_type(2)));
typedef short bf16x8 __attribute__((ext_vector_type(8)));
typedef unsigned u32x4 __attribute__((ext_vector_type(4)));
typedef unsigned u32x2 __attribute__((ext_vector_type(2)));

constexpr int DM = 1024, SEQ = 16384, NCTX = 256, ROWS = SEQ + NCTX, DEPTH = 4, GRIDW = 64;
constexpr int INW = 2720, INWP = 2816;
constexpr int C_AQ = 0, C_AK = 256, C_AV = 384, C_BU = 512, C_CQ = 768, C_CK = 1024, C_CV = 1280, C_DR = 1536, C_DK = 1792, C_DV = 2048, C_WL = 2304, C_AL = 2432, C_GL = 2560;
constexpr int NEXP = 32, TOPK = 4;
constexpr int MOE_MAXBLK = 296;
constexpr int MOE_ROWS = MOE_MAXBLK * 256;
constexpr int NWG = 256, NTHR = 512, NWAVES = 8;
constexpr int VTP = ROWS + 256;

constexpr size_t MiB = 1u << 20;
constexpr size_t WS_CTL = 0, CTL_ZERO_BYTES = 1 * MiB;
constexpr size_t WS_MOD = 1 * MiB;
constexpr size_t WS_TW = 2 * MiB;
constexpr size_t WS_MTAB = 3 * MiB;
constexpr size_t WS_XS = 4 * MiB;
constexpr size_t WS_H = 70 * MiB;
constexpr size_t WS_P = 104 * MiB;
constexpr size_t WS_MIX = 194 * MiB;
constexpr size_t WS_FYR = 228 * MiB, WS_FYI = 244 * MiB;
constexpr size_t WS_VTA = 1544 * MiB, WS_VTC = 1550 * MiB;
constexpr size_t WS_SC = 260 * MiB;
constexpr size_t WS_YS = 408 * MiB;
constexpr size_t WS_ROUTE = 442 * MiB;
constexpr size_t WS_CNT = 444 * MiB;
constexpr size_t WS_XG = 446 * MiB;
constexpr size_t WS_ACT = 596 * MiB;
constexpr size_t WS_WIN = 746 * MiB;
constexpr size_t WS_WOUT = 768 * MiB;
constexpr size_t WS_WGU = 776 * MiB;
constexpr size_t WS_WDN = 1288 * MiB;
constexpr size_t WS_RPP = 1560 * MiB, WS_PSC = 1578 * MiB, WS_LSC = 1580 * MiB, WS_HSC = 1584 * MiB;
constexpr size_t WS_END = 1586 * MiB;
static_assert(WS_XS + (size_t)ROWS * DM * 4 <= WS_H && WS_H + (size_t)ROWS * DM * 2 <= WS_P && WS_P + (size_t)ROWS * INWP * 2 <= WS_MIX && WS_MIX + (size_t)ROWS * DM * 2 <= WS_FYR, "ws map 1");
static_assert(WS_SC + (size_t)ROWS * 9 * 256 * 4 <= WS_YS && WS_YS + (size_t)2 * ROWS * 256 * 4 <= WS_ROUTE && WS_XG + (size_t)MOE_ROWS * DM * 2 <= WS_ACT && WS_ACT + (size_t)MOE_ROWS * DM * 2 <= WS_WIN, "ws map 2");
static_assert(WS_WIN + (size_t)4 * INWP * DM * 2 <= WS_WOUT && WS_WGU + (size_t)4 * 32 * 2048 * 1024 * 2 <= WS_WDN && WS_WDN + (size_t)4 * 32 * 1024 * 1024 * 2 <= WS_END, "ws map 3");
constexpr int CW_BAR = 4096;

constexpr int RING_BYTES = 131072;
constexpr int MISC_OFF = 143360;
constexpr int LDS_BYTES = 147456;

__device__ __forceinline__ unsigned f2bf(float f) { unsigned u = __builtin_bit_cast(unsigned, f); return (u + 0x7fffu + ((u >> 16) & 1u)) >> 16; }
__device__ __forceinline__ unsigned pk2(float lo, float hi) { return f2bf(lo) | (f2bf(hi) << 16); }
__device__ __forceinline__ float bf2f(unsigned short b) { return __builtin_bit_cast(float, (unsigned)b << 16); }
__device__ __forceinline__ float bflo(unsigned w) { return __builtin_bit_cast(float, w << 16); }
__device__ __forceinline__ float bfhi(unsigned w) { return __builtin_bit_cast(float, w & 0xffff0000u); }
__device__ __forceinline__ float shx(float v, int o, int lane) { return __builtin_bit_cast(float, __builtin_amdgcn_ds_bpermute((lane ^ o) << 2, __builtin_bit_cast(int, v))); }
__device__ __forceinline__ int shxi(int v, int o, int lane) { return __builtin_amdgcn_ds_bpermute((lane ^ o) << 2, v); }
__device__ __forceinline__ float wave_sum(float v, int lane) {
#pragma unroll
    for (int o = 1; o < 64; o <<= 1) v += shx(v, o, lane);
    return v;
}
__device__ __forceinline__ float sigmoidf_(float x) { return 1.f / (1.f + __expf(-x)); }
#define LDS_WAIT() asm volatile("s_waitcnt lgkmcnt(0)" ::: "memory")
#define VM_WAIT() asm volatile("s_waitcnt vmcnt(0)" ::: "memory")

namespace pg8 {
#define PG8_LAS __attribute__((address_space(3)))
typedef unsigned short bf16_t;
constexpr int BM = 256, BK = 64, HALF = 128, HTB = HALF * BK * 2, STAGE_BYTES = 8 * HTB, NXCD = 8, WGM = 8;
__host__ __device__ __forceinline__ int lds_byte(int r, int c) { const int st = (r >> 4) * 2 + (c >> 5), rr = r & 15, cc = c & 31, ob = rr * 64 + cc * 2; return st * 1024 + (ob ^ (((ob >> 9) & 1) << 5)); }
__host__ __device__ __forceinline__ void stage_rc(int b, int& R, int& C) { const int st = b / 1024, sb = b % 1024, swz = sb ^ (((sb >> 9) & 1) << 5); R = (st >> 1) * 16 + swz / 64; C = (st & 1) * 32 + (swz % 64) / 2; }
__host__ __device__ __forceinline__ int perm32(int rho) { const int n = rho >> 4, i = rho & 15; return 8 * (i >> 2) + 4 * n + (i & 3); }
struct Unit { int pm, pn, e; };
__device__ __forceinline__ unsigned cvt_pk_bf16(float lo, float hi) { unsigned r; asm volatile("v_cvt_pk_bf16_f32 %0, %1, %2" : "=v"(r) : "v"(lo), "v"(hi)); return r; }

struct StaticOrder {
    const char* A; const char* Bt; size_t tstep;
    int nM, nN, nwg, G, c;
    __device__ void init(const void* A_, const void* Bt_, int M, int N, int K, int G_, int c_) { A = (const char*)A_; Bt = (const char*)Bt_; tstep = (size_t)BM * K * 2; nM = M / BM; nN = N / BM; nwg = nM * nN; G = G_; c = c_; }
    __device__ bool next(int i, Unit& u) const {
        const long L = (long)i * G + c; if (L >= nwg) return false;
        int wgid = (int)L; { const int q = nwg / NXCD, r = nwg % NXCD, xcd = wgid % NXCD, off = wgid / NXCD; wgid = (xcd < r ? xcd * (q + 1) : r * (q + 1) + (xcd - r) * q) + off; }
        const int nig = WGM * nN, gid = wgid / nig, fm = gid * WGM, gsz = (nM - fm) < WGM ? (nM - fm) : WGM;
        u.pm = fm + ((wgid % nig) % gsz); u.pn = (wgid % nig) / gsz; u.e = 0; return true;
    }
    __device__ __forceinline__ const char* pa(const Unit& u) const { return A + (size_t)u.pm * tstep; }
    __device__ __forceinline__ const char* pb(const Unit& u) const { return Bt + (size_t)u.pn * tstep; }
};
struct MoeOrder {
    const char* A; const char* Bt; size_t tstep, estep;
    const LAS unsigned char* blk_e; int nblk, nN, G, c;
    __device__ bool next(int i, Unit& u) const {
        const int L = i * G + c; if (L >= nblk * nN) return false;
        u.pm = L / nN; u.pn = L % nN; u.e = __builtin_amdgcn_readfirstlane((int)blk_e[u.pm]); return true;
    }
    __device__ __forceinline__ const char* pa(const Unit& u) const { return A + (size_t)u.pm * tstep; }
    __device__ __forceinline__ const char* pb(const Unit& u) const { return Bt + (size_t)u.e * estep + (size_t)u.pn * tstep; }
};

struct EpiStoreBf16 {
    static constexpr bool PERM = true;
    bf16_t* O; int ldc; const float* bias; int bias_estride;
    __device__ __forceinline__ void init(f32x4 (&acc)[2][2][4][2], const Unit& u, int wc, int fq) const {
        const int col0 = u.pn * BM + wc * 32 + 8 * fq;
#pragma unroll
        for (int b = 0; b < 2; ++b)
#pragma unroll
            for (int n = 0; n < 2; ++n) { const f32x4 bv = bias ? *(const f32x4*)(bias + (size_t)u.e * bias_estride + col0 + b * HALF + 4 * n) : (f32x4){0.f, 0.f, 0.f, 0.f};
#pragma unroll
                for (int a = 0; a < 2; ++a)
#pragma unroll
                    for (int m = 0; m < 4; ++m) acc[a][b][m][n] = bv; }
    }
    __device__ __forceinline__ void operator()(const f32x4 (&acc)[2][2][4][2], const Unit& u, int wr, int wc, int fr, int fq) const {
        const int row0 = u.pm * BM + wr * 64 + fr, col0 = u.pn * BM + wc * 32 + 8 * fq;
#pragma unroll
        for (int ai = 0; ai < 2; ++ai)
#pragma unroll
            for (int m = 0; m < 4; ++m) { bf16_t* rowp = O + (size_t)(row0 + ai * HALF + m * 16) * ldc + col0;
#pragma unroll
                for (int bj = 0; bj < 2; ++bj) { const f32x4 v0 = acc[ai][bj][m][0], v1 = acc[ai][bj][m][1];
                    u32x4 w; w.x = cvt_pk_bf16(v0[0], v0[1]); w.y = cvt_pk_bf16(v0[2], v0[3]); w.z = cvt_pk_bf16(v1[0], v1[1]); w.w = cvt_pk_bf16(v1[2], v1[3]);
                    *(u32x4*)(rowp + bj * HALF) = w; } }
    }
};
__device__ __forceinline__ float swiglu1(float g, float up) {
    g = fminf(g, 7.0f); up = fminf(fmaxf(up, -7.0f), 7.0f);
    return g * (1.f / (1.f + __expf(-1.702f * g))) * (up + 1.0f);
}
struct EpiSwiglu {
    static constexpr bool PERM = true;
    bf16_t* O; int ldc; const float* bias; int bias_estride;
    __device__ __forceinline__ void init(f32x4 (&acc)[2][2][4][2], const Unit& u, int wc, int fq) const {
        const int col0 = u.pn * BM + wc * 32 + 8 * fq;
#pragma unroll
        for (int b = 0; b < 2; ++b)
#pragma unroll
            for (int n = 0; n < 2; ++n) { const f32x4 bv = bias ? *(const f32x4*)(bias + (size_t)u.e * bias_estride + col0 + b * HALF + 4 * n) : (f32x4){0.f, 0.f, 0.f, 0.f};
#pragma unroll
                for (int a = 0; a < 2; ++a)
#pragma unroll
                    for (int m = 0; m < 4; ++m) acc[a][b][m][n] = bv; }
    }
    __device__ __forceinline__ void operator()(const f32x4 (&acc)[2][2][4][2], const Unit& u, int wr, int wc, int fr, int fq) const {
        const int row0 = u.pm * BM + wr * 64 + fr, col0 = u.pn * BM + wc * 32 + 8 * fq;
#pragma unroll
        for (int ai = 0; ai < 2; ++ai)
#pragma unroll
            for (int m = 0; m < 4; ++m) { bf16_t* rowp = O + (size_t)(row0 + ai * HALF + m * 16) * ldc + (col0 >> 1);
#pragma unroll
                for (int bj = 0; bj < 2; ++bj) { const f32x4 v0 = acc[ai][bj][m][0], v1 = acc[ai][bj][m][1];
                    u32x2 w; w.x = cvt_pk_bf16(swiglu1(v0[0], v0[1]), swiglu1(v0[2], v0[3])); w.y = cvt_pk_bf16(swiglu1(v1[0], v1[1]), swiglu1(v1[2], v1[3]));
                    *(u32x2*)(rowp + bj * (HALF / 2)) = w; } }
    }
};
struct EpiResidual {
    static constexpr bool PERM = false;
    float* X; int ldc; const float* gate_lat; const float* gate_ctx;
    __device__ __forceinline__ void init(f32x4 (&acc)[2][2][4][2], const Unit& u, int wc, int fq) const {
#pragma unroll
        for (int a = 0; a < 2; ++a)
#pragma unroll
            for (int b = 0; b < 2; ++b)
#pragma unroll
                for (int m = 0; m < 4; ++m)
#pragma unroll
                    for (int n = 0; n < 2; ++n) acc[a][b][m][n] = (f32x4){0.f, 0.f, 0.f, 0.f};
    }
    __device__ __forceinline__ void operator()(const f32x4 (&acc)[2][2][4][2], const Unit& u, int wr, int wc, int fr, int fq) const {
        const int row0 = u.pm * BM + wr * 64 + fr, col0 = u.pn * BM + wc * 32 + 4 * fq;
        const float* gp = (u.pm == 0) ? gate_ctx : gate_lat;
        f32x4 gv[2][2];
#pragma unroll
        for (int bj = 0; bj < 2; ++bj)
#pragma unroll
            for (int n = 0; n < 2; ++n) gv[bj][n] = *(const f32x4*)(gp + col0 + bj * HALF + n * 16);
#pragma unroll
        for (int ai = 0; ai < 2; ++ai)
#pragma unroll
            for (int m = 0; m < 4; ++m) { float* rowp = X + (size_t)(row0 + ai * HALF + m * 16) * ldc + col0;
#pragma unroll
                for (int bj = 0; bj < 2; ++bj)
#pragma unroll
                    for (int n = 0; n < 2; ++n) { f32x4* p = (f32x4*)(rowp + bj * HALF + n * 16); *p = *p + gv[bj][n] * acc[ai][bj][m][n]; }
                asm volatile("" ::: "memory"); }
    }
};
template <class Epi, class Sched, bool ALIGN_EPI = false, bool SP2 = false>
__device__ __forceinline__ void gemm_phase(PG8_LAS unsigned char* lds, const int tid, const int K, const Sched& S, const Epi& E) {
    const int wid = __builtin_amdgcn_readfirstlane(tid >> 6), lane = tid & 63, wr = wid >> 2, wc = wid & 3, fr = lane & 15, fq = lane >> 4;
    const int nt = K / BK;
    unsigned voffA[2], voffB[2];
#pragma unroll
    for (int i = 0; i < 2; ++i) { int R, C; stage_rc(tid * 16 + i * 8192, R, C); const int Rb = Epi::PERM ? ((R & ~31) + perm32(R & 31)) : R;
        voffA[i] = (unsigned)(R * K + C) * 2u; voffB[i] = (unsigned)(Rb * K + C) * 2u; }
    const size_t kstep = (size_t)(BK * 2);
    const size_t hstep = (size_t)HALF * K * 2;
        const unsigned ldsw = (unsigned)wid * 1024u;
    const int aoff = lds_byte(wr * 64 + fr, fq * 8), boff = lds_byte(wc * 32 + fr, fq * 8);
#define PG8_SA(b, h) (((b) * 2 + (h)) * HTB)
#define PG8_SB(b, h) ((4 + (b) * 2 + (h)) * HTB)
#define PG8_STAGE(bufoff, gbase, voff) do { _Pragma("unroll") for (int _i = 0; _i < 2; ++_i) \
        __builtin_amdgcn_global_load_lds((const unsigned*)((const char*)(gbase) + (voff)[_i]), (PG8_LAS unsigned*)(lds + (bufoff) + ldsw + _i * 8192), 16, 0, 0); } while (0)
#define PG8_LDA(dst, b, h) do { _Pragma("unroll") for (int m = 0; m < 4; ++m) _Pragma("unroll") for (int k = 0; k < 2; ++k) dst[m][k] = *(const PG8_LAS bf16x8*)(lds + PG8_SA(b, h) + aoff + m * 2048 + k * 1024); } while (0)
#define PG8_LDB(dst, b, h) do { _Pragma("unroll") for (int n = 0; n < 2; ++n) _Pragma("unroll") for (int k = 0; k < 2; ++k) dst[n][k] = *(const PG8_LAS bf16x8*)(lds + PG8_SB(b, h) + boff + n * 2048 + k * 1024); } while (0)
#define PG8_MMA(ai, bj, At, Bt) do { __builtin_amdgcn_s_setprio(1); _Pragma("unroll") for (int m = 0; m < 4; ++m) _Pragma("unroll") for (int n = 0; n < 2; ++n) _Pragma("unroll") for (int k = 0; k < 2; ++k) \
        acc[ai][bj][m][n] = __builtin_amdgcn_mfma_f32_16x16x32_bf16(Bt[n][k], At[m][k], acc[ai][bj][m][n], 0, 0, 0); __builtin_amdgcn_s_setprio(0); } while (0)
#define PG8_WAIT_V(n) asm volatile("s_waitcnt vmcnt(" #n ")" ::: "memory")
#define PG8_WAIT_L(n) asm volatile("s_waitcnt lgkmcnt(" #n ")" ::: "memory")
#define PG8_BAR __builtin_amdgcn_s_barrier()
#define PG8_SCHED __builtin_amdgcn_sched_barrier(0)
    Unit cur, nxt; int ui = 0;
    if (!S.next(0, cur)) return;
    f32x4 acc[2][2][4][2];
    E.init(acc, cur, wc, fq);
    bf16x8 At[4][2], B0[2][2], B1[2][2];
    const char* cA = S.pa(cur); const char* cB = S.pb(cur);
    if constexpr (SP2) {
        PG8_STAGE(PG8_SB(0, 0), cB, voffB); PG8_STAGE(PG8_SB(0, 1), cB + hstep, voffB); PG8_STAGE(PG8_SA(0, 0), cA, voffA); PG8_STAGE(PG8_SA(0, 1), cA + hstep, voffA);
        if (wr == 1) PG8_BAR;
        PG8_WAIT_V(2); PG8_BAR;
        PG8_STAGE(PG8_SB(1, 0), cB + kstep, voffB); PG8_STAGE(PG8_SA(1, 0), cA + kstep, voffA); PG8_STAGE(PG8_SB(1, 1), cB + hstep + kstep, voffB);
        PG8_WAIT_V(6); PG8_BAR;
    } else {
        PG8_STAGE(PG8_SB(0, 0), cB, voffB); PG8_STAGE(PG8_SA(0, 0), cA, voffA); PG8_STAGE(PG8_SB(0, 1), cB + hstep, voffB); PG8_STAGE(PG8_SA(0, 1), cA + hstep, voffA);
        if (wr == 1) PG8_BAR;
        PG8_WAIT_V(4); PG8_BAR;
        PG8_STAGE(PG8_SB(1, 0), cB + kstep, voffB); PG8_STAGE(PG8_SA(1, 0), cA + kstep, voffA); PG8_STAGE(PG8_SB(1, 1), cB + hstep + kstep, voffB);
        PG8_WAIT_V(6); PG8_BAR;
    }
    for (;;) {
        const bool has_next = S.next(ui + 1, nxt);
        const char* nA = has_next ? S.pa(nxt) : cA; const char* nB = has_next ? S.pb(nxt) : cB;
        for (int t = 0; t < nt; t += 2) {
            const bool last = (t == nt - 2);
            const char* a1 = cA + (size_t)(t + 1) * kstep;
            const char* a2 = last ? nA : cA + (size_t)(t + 2) * kstep; const char* b2 = last ? nB : cB + (size_t)(t + 2) * kstep;
            const char* a3 = a2 + kstep; const char* b3 = b2 + kstep;
            if constexpr (SP2) {
            PG8_LDB(B0, 0, 0); PG8_LDB(B1, 0, 1); PG8_SCHED; PG8_LDA(At, 0, 0); PG8_STAGE(PG8_SA(1, 1), a1 + hstep, voffA);
            PG8_WAIT_V(8); PG8_WAIT_L(0); PG8_BAR; PG8_MMA(0, 0, At, B0); PG8_MMA(0, 1, At, B1); PG8_BAR; PG8_SCHED;
            PG8_LDA(At, 0, 1); PG8_STAGE(PG8_SB(0, 0), b2, voffB); PG8_STAGE(PG8_SB(0, 1), b2 + hstep, voffB); PG8_STAGE(PG8_SA(0, 0), a2, voffA);
            PG8_WAIT_V(8); PG8_WAIT_L(0); PG8_BAR; PG8_MMA(1, 0, At, B0); PG8_MMA(1, 1, At, B1); PG8_BAR; PG8_SCHED;
            PG8_LDB(B0, 1, 0); PG8_LDB(B1, 1, 1); PG8_SCHED; PG8_LDA(At, 1, 0); PG8_STAGE(PG8_SA(0, 1), a2 + hstep, voffA);
            PG8_WAIT_V(8); PG8_WAIT_L(0); PG8_BAR; PG8_MMA(0, 0, At, B0); PG8_MMA(0, 1, At, B1); PG8_BAR; PG8_SCHED;
            PG8_LDA(At, 1, 1); PG8_STAGE(PG8_SB(1, 0), b3, voffB); PG8_STAGE(PG8_SB(1, 1), b3 + hstep, voffB); PG8_STAGE(PG8_SA(1, 0), a3, voffA);
            PG8_WAIT_V(8); PG8_WAIT_L(0); PG8_BAR; PG8_MMA(1, 0, At, B0); PG8_MMA(1, 1, At, B1); PG8_BAR; PG8_SCHED;
            } else {
            PG8_LDB(B0, 0, 0); PG8_SCHED; PG8_LDA(At, 0, 0); PG8_STAGE(PG8_SA(1, 1), a1 + hstep, voffA);
            PG8_WAIT_L(8); PG8_BAR; PG8_WAIT_L(0); PG8_MMA(0, 0, At, B0); PG8_BAR; PG8_SCHED;
            PG8_LDB(B1, 0, 1); PG8_STAGE(PG8_SB(0, 0), b2, voffB);
            PG8_BAR; PG8_WAIT_L(0); PG8_MMA(0, 1, At, B1); PG8_BAR;
            PG8_LDA(At, 0, 1); PG8_STAGE(PG8_SA(0, 0), a2, voffA);
            PG8_BAR; PG8_WAIT_L(0); PG8_MMA(1, 0, At, B0); PG8_BAR; PG8_SCHED;
            PG8_STAGE(PG8_SB(0, 1), b2 + hstep, voffB);
            PG8_WAIT_V(6); PG8_BAR; PG8_MMA(1, 1, At, B1); PG8_BAR;
            PG8_LDB(B0, 1, 0); PG8_SCHED; PG8_LDA(At, 1, 0); PG8_STAGE(PG8_SA(0, 1), a2 + hstep, voffA);
            PG8_WAIT_L(8); PG8_BAR; PG8_WAIT_L(0); PG8_MMA(0, 0, At, B0); PG8_BAR; PG8_SCHED;
            PG8_LDB(B1, 1, 1); PG8_STAGE(PG8_SB(1, 0), b3, voffB);
            PG8_BAR; PG8_WAIT_L(0); PG8_MMA(0, 1, At, B1); PG8_BAR;
            PG8_LDA(At, 1, 1); PG8_STAGE(PG8_SA(1, 0), a3, voffA);
            PG8_BAR; PG8_WAIT_L(0); PG8_MMA(1, 0, At, B0); PG8_BAR; PG8_SCHED;
            PG8_STAGE(PG8_SB(1, 1), b3 + hstep, voffB);
            PG8_WAIT_V(6); PG8_BAR; PG8_MMA(1, 1, At, B1); PG8_BAR;
            }
        }
        if constexpr (ALIGN_EPI) { if (wr == 0) PG8_BAR; }
        E(acc, cur, wr, wc, fr, fq);
        if (!has_next) break;
        E.init(acc, nxt, wc, fq);
        cur = nxt; cA = nA; cB = nB; ++ui;
        if constexpr (ALIGN_EPI) { if (wr == 1) PG8_BAR; }
    }
    PG8_WAIT_V(0);
    if constexpr (!ALIGN_EPI) { if (wr == 0) PG8_BAR; }
    PG8_BAR;
#undef PG8_SA
#undef PG8_SB
#undef PG8_STAGE
#undef PG8_LDA
#undef PG8_LDB
#undef PG8_MMA
#undef PG8_WAIT_V
#undef PG8_WAIT_L
#undef PG8_BAR
#undef PG8_SCHED
}
}

#define XB_TMO      128
#define XB_XCNT(j)  (256  + 64 * (j))
#define XB_XSUB(j)  (1280 + 64 * (j))
#define XB_XGEN(j)  (2304 + 64 * (j))
#define XB_TOP      3328
#define XB_TOPGEN   3392
#define XCD_BAR_WORDS 3456
#define XB_SPIN_CAP (1u << 18)
__device__ __forceinline__ unsigned xb_ld(unsigned* p)              { return __hip_atomic_load(p, __ATOMIC_RELAXED, __HIP_MEMORY_SCOPE_AGENT); }
__device__ __forceinline__ unsigned xb_add(unsigned* p, unsigned v) { return __hip_atomic_fetch_add(p, v, __ATOMIC_RELAXED, __HIP_MEMORY_SCOPE_AGENT); }
__device__ __forceinline__ unsigned xb_xcc_id() { return (unsigned)__builtin_amdgcn_s_getreg((3 << 11) | 20) & 0xFu; }
#define XB_SPIN(cond, bar) do { unsigned _sp = 0; while (cond) { __builtin_amdgcn_s_sleep(1); \
    if ((++_sp & 255u) == 0u) { if (xb_ld(&(bar)[XB_TMO])) break; if (_sp > XB_SPIN_CAP) { atomicAdd(&(bar)[XB_TMO], 1u); break; } } } } while (0)

struct XcdBarrier {
    unsigned* bar; unsigned x;
    volatile LAS unsigned* st;
};

__device__ __forceinline__ XcdBarrier xcd_barrier_post(unsigned* bar, volatile LAS unsigned* st) {
    XcdBarrier b; b.bar = bar; b.x = xb_xcc_id(); b.st = st;
    if (threadIdx.x == 0) (void)xb_add(&bar[XB_XCNT(b.x)], 1u);
    return b;
}
__device__ __forceinline__ void xcd_barrier_complete(unsigned* bar, unsigned x, unsigned& nloc, unsigned& nx) {
    const unsigned G = gridDim.x * gridDim.y * gridDim.z;
    unsigned sum, cnt, mine, sp = 0u;
    for (;;) {
        sum = 0u; cnt = 0u; mine = 0u;
#pragma unroll
        for (unsigned j = 0; j < 16; ++j) { const unsigned c = xb_ld(&bar[XB_XCNT(j)]); sum += c; cnt += (c > 0u) ? 1u : 0u; mine = (j == x) ? c : mine; }
        if (sum == G) break;
        __builtin_amdgcn_s_sleep(1);
        if ((++sp & 255u) == 0u) { if (xb_ld(&bar[XB_TMO])) break; if (sp > XB_SPIN_CAP) { atomicAdd(&bar[XB_TMO], 1u); break; } }
    }
    nloc = mine > 0u ? mine : 1u; nx = cnt > 0u ? cnt : 1u;
}

__device__ __forceinline__ void xcd_barrier(const XcdBarrier& b) {
    asm volatile("s_waitcnt vmcnt(0)" ::: "memory");
    __syncthreads();
    if (threadIdx.x == 0) {
        unsigned* bar = b.bar;
        __builtin_amdgcn_s_waitcnt(0);
        unsigned nloc = b.st[0], nx = b.st[1];
        if (nloc == 0u) { xcd_barrier_complete(bar, b.x, nloc, nx); b.st[0] = nloc; b.st[1] = nx; }
        const unsigned old = xb_add(&bar[XB_XSUB(b.x)], 1u);
        const unsigned gen = old / nloc;
        if (old + 1u == (gen + 1u) * nloc) {
            __builtin_amdgcn_fence(__ATOMIC_RELEASE, "agent");
            asm volatile("s_waitcnt vmcnt(0)" ::: "memory");
            const unsigned og = xb_add(&bar[XB_TOP], 1u);
            const unsigned tg = og / nx;
            if (og + 1u == (tg + 1u) * nx) xb_add(&bar[XB_TOPGEN], 1u);
            else XB_SPIN(xb_ld(&bar[XB_TOPGEN]) == tg, bar);
            __builtin_amdgcn_fence(__ATOMIC_ACQUIRE, "agent");
            xb_add(&bar[XB_XGEN(b.x)], 1u);
            asm volatile("s_waitcnt vmcnt(0)" ::: "memory");
        } else {
            XB_SPIN(xb_ld(&bar[XB_XGEN(b.x)]) == gen, bar);
            __builtin_amdgcn_fence(__ATOMIC_ACQUIRE, "agent");
            asm volatile("s_waitcnt vmcnt(0)" ::: "memory");
        }
    }
    __syncthreads();
}

struct Args {
    const float* in[31];
    float* out; unsigned char* ws;
    int ph_lo, ph_hi, use_bar, pad;
};
enum InIdx { I_X = 0, I_C, I_CTX, I_CCTX, I_ADAW, I_ADAB, I_N1G, I_N2G, I_WIN, I_WOUT, I_ASINK, I_BMIX, I_CREL, I_DCONV, I_DW0, I_DW2, I_DA0, I_DA2, I_DG2, I_DKK, I_DKA, I_DRK, I_DLNW, I_DLNB,
             I_RW, I_RB, I_WGU, I_BGU, I_WDN, I_BDN, I_FNG };
constexpr int NPL = 11;
constexpr int PH_TOTAL = 1 + DEPTH * NPL + 1;

struct DevIn {
    const LAS unsigned* tab;
    __device__ __forceinline__ const float* operator[](int i) const {
        const unsigned lo = __builtin_amdgcn_readfirstlane(((const volatile LAS unsigned*)tab)[2 * i]), hi = __builtin_amdgcn_readfirstlane(((const volatile LAS unsigned*)tab)[2 * i + 1]);
        return (const float*)(((unsigned long long)hi << 32) | lo);
    }
};
struct DArgs { DevIn in; float* out; };
struct Ctx {
    LAS unsigned char* lds;
    int tid, lane, wave, wg, G, gw, NGW;
    unsigned char* ws;
};

__device__ __forceinline__ void transpose_item(const float* W, int K, int N, bf16* WT, LAS float* scr, int item, int lane) {
    const int nblk = N / 32, kb = item / nblk, nb = item % nblk, k0 = 64 * kb, n0 = 32 * nb;
#pragma unroll 8
    for (int i = 0; i < 32; ++i) { const int kk = 2 * i + (lane >> 5); scr[kk * 33 + (lane & 31)] = W[(size_t)(k0 + kk) * N + n0 + (lane & 31)]; }
    LDS_WAIT(); asm volatile("" ::: "memory");
    const int c = lane & 7;
#pragma unroll
    for (int j = 0; j < 4; ++j) { const int n = (lane >> 3) + 8 * j; const LAS float* s = scr + (8 * c) * 33 + n;
        u32x4 o; o.x = pk2(s[0 * 33], s[1 * 33]); o.y = pk2(s[2 * 33], s[3 * 33]); o.z = pk2(s[4 * 33], s[5 * 33]); o.w = pk2(s[6 * 33], s[7 * 33]);
        *(u32x4*)(WT + (size_t)(n0 + n) * K + k0 + 8 * c) = o; }
    LDS_WAIT(); asm volatile("" ::: "memory");
}
__device__ __forceinline__ void phase_prologue(const Ctx& C, const DArgs& a) {
    LAS float* scr = (LAS float*)(C.lds + C.wave * 16384);
    constexpr int IT_IN = 16 * (INW / 32), IT_OUT = 16 * 32, IT_GU = 16 * 64, IT_DN = 16 * 32;
    constexpr long N_IN = 4L * IT_IN, N_OUT = 4L * IT_OUT, N_GU = 128L * IT_GU, N_DN = 128L * IT_DN, N_ALL = N_IN + N_OUT + N_GU + N_DN;
    const float* pwin = a.in[I_WIN]; const float* pwout = a.in[I_WOUT]; const float* pwgu = a.in[I_WGU]; const float* pwdn = a.in[I_WDN];
    for (long it = C.gw; it < N_ALL; it += C.NGW) {
        long r = it;
        if (r < N_IN) { const int l = (int)(r / IT_IN); transpose_item(pwin + (size_t)l * DM * INW, DM, INW, (bf16*)(C.ws + WS_WIN) + (size_t)l * INWP * DM, scr, (int)(r % IT_IN), C.lane); continue; } r -= N_IN;
        if (r < N_OUT) { const int l = (int)(r / IT_OUT); transpose_item(pwout + (size_t)l * DM * DM, DM, DM, (bf16*)(C.ws + WS_WOUT) + (size_t)l * DM * DM, scr, (int)(r % IT_OUT), C.lane); continue; } r -= N_OUT;
        if (r < N_GU) { const int le = (int)(r / IT_GU); transpose_item(pwgu + (size_t)le * DM * 2048, DM, 2048, (bf16*)(C.ws + WS_WGU) + (size_t)le * 2048 * DM, scr, (int)(r % IT_GU), C.lane); continue; } r -= N_GU;
        { const int le = (int)(r / IT_DN); transpose_item(pwdn + (size_t)le * DM * DM, DM, DM, (bf16*)(C.ws + WS_WDN) + (size_t)le * DM * DM, scr, (int)(r % IT_DN), C.lane); }
    }
    { const int gt = C.wg * NTHR + C.tid; constexpr int PADN = (INWP - INW) * DM / 8;
      for (int i = gt; i < 4 * PADN; i += C.G * NTHR) { const int l = i / PADN, r = i % PADN; *((u32x4*)((bf16*)(C.ws + WS_WIN) + ((size_t)l * INWP + INW) * DM) + r) = (u32x4){0u, 0u, 0u, 0u}; } }
    { float* tw = (float*)(C.ws + WS_TW); const int gt = C.wg * NTHR + C.tid;
      for (int i = gt; i < 16384; i += C.G * NTHR) { const float x = (float)i * (1.0f / 8192.0f); tw[i] = cospif(x); tw[16384 + i] = sinpif(x); } }
    { float* mt = (float*)(C.ws + WS_MTAB); const int gt = C.wg * NTHR + C.tid; const float* pbmix = a.in[I_BMIX];
      for (int i = gt; i < 4 * 4 * 64 * 64; i += C.G * NTHR) { const int e = i & 63, c = (i >> 6) & 63, g = (i >> 12) & 3, l = i >> 14;
          const float* w = pbmix + ((size_t)(l * 4 + g) * 64) * 64 + e; float sc = 0.f, ss = 0.f;
          for (int cp = 0; cp < 64; ++cp) { const float x = (float)((c * cp) & 63) * (1.0f / 32.0f); const float wv = w[cp * 64]; sc += cospif(x) * wv; ss += sinpif(x) * wv; }
          mt[((size_t)(l * 2 + 0) * 4 + g) * 4096 + c * 64 + e] = sc; mt[((size_t)(l * 2 + 1) * 4 + g) * 4096 + c * 64 + e] = ss; } }
    { LAS float* red = (LAS float*)(C.lds);
      __syncthreads();
      float* mod = (float*)(C.ws + WS_MOD);
      const float* pc = a.in[I_C]; const float* pcc = a.in[I_CCTX]; const float* padaw = a.in[I_ADAW]; const float* padab = a.in[I_ADAB];
      for (int u = C.wg; u < 4 * 24; u += C.G) { const int l = u / 24, jb = u % 24, j0 = jb * 256 + 4 * C.lane;
          f32x4 s0 = {0.f, 0.f, 0.f, 0.f}, s1 = {0.f, 0.f, 0.f, 0.f};
          const float* w = padaw + (size_t)l * DM * 6144 + j0;
          for (int k = C.wave * 128; k < C.wave * 128 + 128; ++k) { const float c0 = pc[k], c1 = pcc[k]; const float a0 = c0 * sigmoidf_(c0), a1 = c1 * sigmoidf_(c1);
              const f32x4 wv = *(const f32x4*)(w + (size_t)k * 6144); s0 += wv * a0; s1 += wv * a1; }
          *(LAS f32x4*)(red + ((C.wave * 2 + 0) * 64 + C.lane) * 4) = s0; *(LAS f32x4*)(red + ((C.wave * 2 + 1) * 64 + C.lane) * 4) = s1;
          __syncthreads();
          if (C.tid < 512) { const int v = C.tid >> 8, j = C.tid & 255; float s = 0.f;
#pragma unroll
              for (int wv = 0; wv < 8; ++wv) s += red[(wv * 2 + v) * 256 + j];
              mod[(size_t)(l * 2 + v) * 6144 + jb * 256 + j] = s + padab[(size_t)l * 6144 + jb * 256 + j]; }
          __syncthreads(); } }
}

__device__ __forceinline__ void load_row(const float* p, int lane, f32x4 (&v)[4]) {
#pragma unroll
    for (int j = 0; j < 4; ++j) v[j] = *((const f32x4*)p + lane + 64 * j);
}
__device__ __forceinline__ void moe_combine_row(const Ctx& C, int row, f32x4 (&v)[4], const float* gt2) {
    const int* dest = (const int*)(C.ws + WS_ROUTE) + (size_t)3 * ROWS * 4; const float* gate = (const float*)(C.ws + WS_ROUTE) + (size_t)1 * ROWS * 4;
    const bf16* YB = (const bf16*)(C.ws + WS_XG);
    f32x4 s[4];
#pragma unroll
    for (int j = 0; j < 4; ++j) s[j] = (f32x4){0.f, 0.f, 0.f, 0.f};
#pragma unroll
    for (int k = 0; k < 4; ++k) { const int d = dest[row * 4 + k]; const float g = gate[row * 4 + k]; const u32x2* yp = (const u32x2*)(YB + (size_t)d * DM) + C.lane;
#pragma unroll
        for (int j = 0; j < 4; ++j) { const u32x2 w = yp[64 * j]; s[j] += (f32x4){bflo(w.x), bfhi(w.x), bflo(w.y), bfhi(w.y)} * g; } }
#pragma unroll
    for (int j = 0; j < 4; ++j) v[j] += *((const f32x4*)gt2 + C.lane + 64 * j) * s[j];
}
__device__ __forceinline__ float row_rstd(const f32x4 (&v)[4], int lane) {
    float s = 0.f;
#pragma unroll
    for (int j = 0; j < 4; ++j) s += (v[j].x * v[j].x + v[j].y * v[j].y) + (v[j].z * v[j].z + v[j].w * v[j].w);
    return rsqrtf(wave_sum(s, lane) * (1.f / DM) + 1e-6f);
}
__device__ __forceinline__ void phase_norm1(const Ctx& C, const DArgs& a, int l) {
    float* XS = (float*)(C.ws + WS_XS); bf16* H = (bf16*)(C.ws + WS_H); const float* mod = (const float*)(C.ws + WS_MOD);
    const float* g1 = a.in[I_N1G] + (size_t)l * DM;
    const float* pctx = a.in[I_CTX]; const float* px = a.in[I_X];
    for (int row = C.gw; row < ROWS; row += C.NGW) {
        const bool isctx = row < NCTX; f32x4 v[4];
        if (l == 0) { load_row(isctx ? pctx + (size_t)row * DM : px + (size_t)(row - NCTX) * DM, C.lane, v); }
        else { load_row(XS + (size_t)row * DM, C.lane, v);
               if (!(l == DEPTH && isctx)) moe_combine_row(C, row, v, mod + (size_t)((l - 1) * 2 + (isctx ? 1 : 0)) * 6144 + 5 * DM); }
        if (l == 0 || true) {
#pragma unroll
            for (int j = 0; j < 4; ++j) *((f32x4*)(XS + (size_t)row * DM) + C.lane + 64 * j) = v[j]; }
        const float rstd = row_rstd(v, C.lane);
        const float* md = mod + (size_t)(l * 2 + (isctx ? 1 : 0)) * 6144;
        u32x2* o = (u32x2*)(H + (size_t)row * DM) + C.lane;
#pragma unroll
        for (int j = 0; j < 4; ++j) { const f32x4 g = *((const f32x4*)g1 + C.lane + 64 * j), sh = *((const f32x4*)md + C.lane + 64 * j), sc = *((const f32x4*)(md + DM) + C.lane + 64 * j);
            const f32x4 y = v[j] * rstd * g * (sc + 1.0f) + sh; u32x2 w; w.x = pk2(y.x, y.y); w.y = pk2(y.z, y.w); o[64 * j] = w; }
    }
}
__device__ __forceinline__ void phase_final(const Ctx& C, const DArgs& a) {
    const float* XS = (const float*)(C.ws + WS_XS); const float* mod = (const float*)(C.ws + WS_MOD); const float* g = a.in[I_FNG];
    for (int row = NCTX + C.gw; row < ROWS; row += C.NGW) {
        f32x4 v[4]; load_row(XS + (size_t)row * DM, C.lane, v);
        moe_combine_row(C, row, v, mod + (size_t)((DEPTH - 1) * 2 + 0) * 6144 + 5 * DM);
        const float rstd = row_rstd(v, C.lane);
        float* o = a.out + (size_t)(row - NCTX) * DM;
#pragma unroll
        for (int j = 0; j < 4; ++j) *((f32x4*)o + C.lane + 64 * j) = v[j] * rstd * *((const f32x4*)g + C.lane + 64 * j);
    }
}
__device__ __forceinline__ void phase_norm2(const Ctx& C, const DArgs& a, int l) {
    const float* XS = (const float*)(C.ws + WS_XS); bf16* H = (bf16*)(C.ws + WS_H); const float* mod = (const float*)(C.ws + WS_MOD);
    const float* g2 = a.in[I_N2G] + (size_t)l * DM; const float* rw = a.in[I_RW] + (size_t)l * DM * NEXP; const float* rb = a.in[I_RB] + (size_t)l * NEXP;
    int* tok_e = (int*)(C.ws + WS_ROUTE); float* gate = (float*)(C.ws + WS_ROUTE) + (size_t)1 * ROWS * 4; int* slot = (int*)(C.ws + WS_ROUTE) + (size_t)2 * ROWS * 4;
    LAS float* hrow = (LAS float*)(C.lds + C.wave * 4096);
    LAS int* hist = (LAS int*)(C.lds + MISC_OFF + 64);
    if (C.tid < NEXP) hist[C.tid] = 0;
    __syncthreads();
    const int row_lo = (l == DEPTH - 1) ? NCTX : 0;
    for (int row = row_lo + C.gw; row < ROWS; row += C.NGW) {
        const bool isctx = row < NCTX; f32x4 v[4]; load_row(XS + (size_t)row * DM, C.lane, v);
        const float rstd = row_rstd(v, C.lane);
        const float* md = mod + (size_t)(l * 2 + (isctx ? 1 : 0)) * 6144 + 3 * DM;
        u32x2* o = (u32x2*)(H + (size_t)row * DM) + C.lane;
#pragma unroll
        for (int j = 0; j < 4; ++j) { const f32x4 g = *((const f32x4*)g2 + C.lane + 64 * j), sh = *((const f32x4*)md + C.lane + 64 * j), sc = *((const f32x4*)(md + DM) + C.lane + 64 * j);
            const f32x4 y = v[j] * rstd * g * (sc + 1.0f) + sh; u32x2 w; w.x = pk2(y.x, y.y); w.y = pk2(y.z, y.w); o[64 * j] = w;
            *(LAS f32x4*)(hrow + 4 * (C.lane + 64 * j)) = y; }
        LDS_WAIT(); asm volatile("" ::: "memory");
        const int e = C.lane & 31, hf = C.lane >> 5; float s = 0.f;
        const float* rwp = rw + (size_t)(hf * 512) * NEXP + e; const LAS float* hp = hrow + hf * 512;
#pragma unroll 8
        for (int k = 0; k < 512; ++k) s += hp[k] * rwp[(size_t)k * NEXP];
        s += shx(s, 32, C.lane);
        s += rb[e];
        float val = s; int te[4]; float tv[4];
#pragma unroll
        for (int k = 0; k < 4; ++k) { float bv = val; int bi = e;
#pragma unroll
            for (int o2 = 1; o2 < 32; o2 <<= 1) { const float ov = shx(bv, o2, C.lane); const int oi = shxi(bi, o2, C.lane); if (ov > bv || (ov == bv && oi < bi)) { bv = ov; bi = oi; } }
            te[k] = bi; tv[k] = bv; if (e == bi) val = -3.0e38f; }
        if (C.lane == 0) { const float m = tv[0]; float p[4], ps = 0.f;
#pragma unroll
            for (int k = 0; k < 4; ++k) { p[k] = __expf(tv[k] - m); ps += p[k]; }
#pragma unroll
            for (int k = 0; k < 4; ++k) { tok_e[row * 4 + k] = te[k]; gate[row * 4 + k] = p[k] / ps; slot[row * 4 + k] = __hip_atomic_fetch_add(&hist[te[k]], 1, __ATOMIC_RELAXED, __HIP_MEMORY_SCOPE_WORKGROUP); } }
        asm volatile("" ::: "memory");
    }
    __syncthreads();
    if (C.tid < NEXP) ((int*)(C.ws + WS_CNT))[C.wg * NEXP + C.tid] = hist[C.tid];
}
__device__ __forceinline__ int moe_tables(const Ctx& C) {
    const int* cnt = (const int*)(C.ws + WS_CNT);
    LAS int* part = (LAS int*)(C.lds);
    LAS int* pstart = (LAS int*)(C.lds + MISC_OFF + 256); LAS int* wgbase = pstart + 40; LAS int* tot = wgbase + 32; LAS int* nblk_s = tot + 32;
    LAS unsigned char* blk_e = (LAS unsigned char*)(C.lds + MISC_OFF + 1024);
    __syncthreads();
    { const int e = C.tid & 31, p = C.tid >> 5; int t = 0, pre = 0;
#pragma unroll 1
      for (int w = p * 16; w < p * 16 + 16; ++w) { const int c = cnt[w * NEXP + e]; t += c; if (w < C.wg) pre += c; }
      part[(p * 32 + e) * 2] = t; part[(p * 32 + e) * 2 + 1] = pre; }
    __syncthreads();
    if (C.tid < NEXP) { int t = 0, pre = 0;
#pragma unroll 1
        for (int p = 0; p < 16; ++p) { t += part[(p * 32 + C.tid) * 2]; pre += part[(p * 32 + C.tid) * 2 + 1]; }
        tot[C.tid] = t; wgbase[C.tid] = pre; }
    __syncthreads();
    if (C.tid == 0) { int b = 0;
#pragma unroll 1
        for (int e = 0; e < NEXP; ++e) { pstart[e] = b * 256; b += (tot[e] + 255) >> 8; }
        pstart[NEXP] = b * 256; nblk_s[0] = b; }
    __syncthreads();
    if (C.tid < NEXP) wgbase[C.tid] += pstart[C.tid];
    if (C.tid < MOE_MAXBLK) { int e = 0;
#pragma unroll 1
        for (int k = 1; k < NEXP; ++k) if (pstart[k] <= C.tid * 256) e = k;
        blk_e[C.tid] = (unsigned char)e; }
    __syncthreads();
    return __builtin_amdgcn_readfirstlane(nblk_s[0]);
}
__device__ __forceinline__ void phase_gather(const Ctx& C, const DArgs& a, int l) {
    moe_tables(C);
    const LAS int* wgbase = (const LAS int*)(C.lds + MISC_OFF + 256) + 40;
    const int* tok_e = (const int*)(C.ws + WS_ROUTE); const int* slot = (const int*)(C.ws + WS_ROUTE) + (size_t)2 * ROWS * 4; int* dest = (int*)(C.ws + WS_ROUTE) + (size_t)3 * ROWS * 4;
    const bf16* H = (const bf16*)(C.ws + WS_H); bf16* XG = (bf16*)(C.ws + WS_XG);
    const int row_lo = (l == DEPTH - 1) ? NCTX : 0;
    for (int row = row_lo + C.gw; row < ROWS; row += C.NGW) {
        const u32x4* src = (const u32x4*)(H + (size_t)row * DM) + C.lane; const u32x4 v0 = src[0], v1 = src[64];
#pragma unroll
        for (int k = 0; k < 4; ++k) { const int d = wgbase[tok_e[row * 4 + k]] + slot[row * 4 + k]; if (C.lane == 0) dest[row * 4 + k] = d;
            u32x4* dp = (u32x4*)(XG + (size_t)d * DM) + C.lane; dp[0] = v0; dp[64] = v1; }
    }
}

__device__ __forceinline__ void mix1_rope(const Ctx& C) {
    bf16* P = (bf16*)(C.ws + WS_P);
    const long total = (long)SEQ * 192;
    for (long i = (long)C.wg * NTHR + C.tid; i < total; i += (long)C.G * NTHR) {
        const int j = (int)(i & 31), hh = (int)((i >> 5) % 6), t = (int)(i / 192);
        const int col = (hh < 4) ? (C_AQ + hh * 64) : (C_AK + (hh - 4) * 64);
        const float pos = (j < 16) ? (float)(t >> 6) : (float)(t & 63);
        const float inv = __powf(10000.0f, -(float)(j & 15) * (1.0f / 16.0f));
        const float ang = pos * inv * 0.31830988618379067f;
        const float cs = cospif(ang), sn = sinpif(ang);
        bf16* p = P + (size_t)(NCTX + t) * INWP + col;
        const float x1 = bf2f(p[j]), x2 = bf2f(p[j + 32]);
        p[j] = (bf16)f2bf(x1 * cs - x2 * sn); p[j + 32] = (bf16)f2bf(x2 * cs + x1 * sn);
    }
}
__device__ __forceinline__ void mix1_vt(const Ctx& C) {
    const bf16* P = (const bf16*)(C.ws + WS_P);
    LAS unsigned short* scr = (LAS unsigned short*)(C.lds + C.wave * 16384);
    for (int u = C.gw; u < (ROWS / 64) * 6; u += C.NGW) {
        const int hd = u % 6, tb = u / 6; const int vcol = (hd < 2) ? (C_AV + hd * 64) : (C_CV + (hd - 2) * 64);
        bf16* VT = ((hd < 2) ? (bf16*)(C.ws + WS_VTA) + (size_t)hd * 64 * VTP : (bf16*)(C.ws + WS_VTC) + (size_t)(hd - 2) * 64 * VTP);
#pragma unroll
        for (int i = 0; i < 8; ++i) { const int tk = (C.lane >> 3) + 8 * i, ch = C.lane & 7; const u32x4 w = *(const u32x4*)(P + (size_t)(tb * 64 + tk) * INWP + vcol + 8 * ch);
            LAS unsigned* d = (LAS unsigned*)(scr + tk * 66 + 8 * ch); d[0] = w.x; d[1] = w.y; d[2] = w.z; d[3] = w.w; }
        LDS_WAIT(); asm volatile("" ::: "memory");
#pragma unroll
        for (int k8 = 0; k8 < 8; ++k8) { unsigned w[4];
#pragma unroll
            for (int e2 = 0; e2 < 4; ++e2) { const unsigned lo = scr[(8 * k8 + 2 * e2) * 66 + C.lane], hi = scr[(8 * k8 + 2 * e2 + 1) * 66 + C.lane]; w[e2] = lo | (hi << 16); }
            *(u32x4*)(VT + (size_t)C.lane * VTP + tb * 64 + 8 * k8) = (u32x4){w[0], w[1], w[2], w[3]}; }
        LDS_WAIT(); asm volatile("" ::: "memory");
    }
    for (int i = C.wg * NTHR + C.tid; i < 6 * 64 * 32; i += C.G * NTHR) { const int rowi = i >> 5, pc = i & 31; const int hd = rowi >> 6, d = rowi & 63;
        bf16* VT = ((hd < 2) ? (bf16*)(C.ws + WS_VTA) + (size_t)hd * 64 * VTP : (bf16*)(C.ws + WS_VTC) + (size_t)(hd - 2) * 64 * VTP);
        *(u32x4*)(VT + (size_t)d * VTP + ROWS + 8 * pc) = (u32x4){0u, 0u, 0u, 0u}; }
}
__device__ __forceinline__ float conv3(const bf16* P, int row, int col, const float* cw, int cc) {
    const bool first = (row == 0) || (row == NCTX), last = (row == NCTX - 1) || (row == ROWS - 1);
    float s = cw[768 + cc] * bf2f(P[(size_t)row * INWP + col]);
    if (!first) s += cw[cc] * bf2f(P[(size_t)(row - 1) * INWP + col]);
    if (!last) s += cw[2 * 768 + cc] * bf2f(P[(size_t)(row + 1) * INWP + col]);
    return s;
}
__device__ __forceinline__ void mix1_rwkv_prep(const Ctx& C, const DArgs& a, int l) {
    const bf16* P = (const bf16*)(C.ws + WS_P); float* SC = (float*)(C.ws + WS_SC);
    LAS float* lo = (LAS float*)(C.lds);
    const float* cw = a.in[I_DCONV] + (size_t)l * 3 * 768;
    const float* w0 = a.in[I_DW0] + (size_t)l * 512; const float* w2 = a.in[I_DW2] + (size_t)l * 2 * 64 * 256;
    const float* a0 = a.in[I_DA0] + (size_t)l * 512; const float* a2 = a.in[I_DA2] + (size_t)l * 2 * 64 * 256;
    const float* kkw = a.in[I_DKK] + (size_t)l * 256; const float* kaw = a.in[I_DKA] + (size_t)l * 256;
    const int half = C.tid >> 8, c = C.tid & 255;
    for (int pr = C.wg; pr < ROWS / 2; pr += C.G) {
        const int row = 2 * pr + half;
        __syncthreads();
        { const float x = bf2f(P[(size_t)row * INWP + C_WL + c]); lo[half * 256 + c] = (c < 128) ? tanhf(x) : x; }
        __syncthreads();
        const float r = conv3(P, row, C_DR + c, cw, c), k = conv3(P, row, C_DK + c, cw, 256 + c), v = conv3(P, row, C_DV + c, cw, 512 + c);
        float kk = k * kkw[c]; const float n2 = wave_sum(kk * kk, C.lane); kk *= rsqrtf(fmaxf(n2, 1e-24f));
        float* sc = SC + (size_t)row * 9 * 256;
        sc[c] = r; sc[256 + c] = v; sc[512 + c] = -kk;
#pragma unroll
        for (int d = 0; d < 2; ++d) {
            float wp = w0[d * 256 + c], ap = a0[d * 256 + c];
            const LAS float* wl = lo + half * 256 + d * 64; const LAS float* al = lo + half * 256 + 128 + d * 64;
            const float* w2p = w2 + (size_t)d * 64 * 256 + c; const float* a2p = a2 + (size_t)d * 64 * 256 + c;
#pragma unroll 8
            for (int i = 0; i < 64; ++i) { wp += wl[i] * w2p[i * 256]; ap += al[i] * a2p[i * 256]; }
            const float nw = -wp, sp = fmaxf(nw, 0.f) + log1pf(__expf(-fabsf(nw)));
            const float dec = -__expf(-sp - 0.5f);
            const float as = sigmoidf_(ap);
            sc[(3 + 3 * d) * 256 + c] = dec; sc[(4 + 3 * d) * 256 + c] = k * (1.0f + (as - 1.0f) * kaw[c]); sc[(5 + 3 * d) * 256 + c] = kk * as;
        }
    }
    __syncthreads();
}
__device__ __forceinline__ void mix1_fourier1(const Ctx& C) {
    const bf16* P = (const bf16*)(C.ws + WS_P); const float* tw = (const float*)(C.ws + WS_TW);
    float* FYR = (float*)(C.ws + WS_FYR); float* FYI = (float*)(C.ws + WS_FYI);
    LAS float* ct = (LAS float*)(C.lds + 4096); LAS float* st = ct + 128;
    __syncthreads();
    if (C.tid < 128) { ct[C.tid] = tw[128 * C.tid]; st[C.tid] = tw[16384 + 128 * C.tid]; }
    __syncthreads();
    for (int u = C.wg; u < 128 * 128 * 256 / NTHR; u += C.G) {
        const int idx = u * NTHR + C.tid, ch = idx & 255, t2 = (idx >> 8) & 127, k1 = idx >> 15;
        float dr = 0.f, di = 0.f;
        const bf16* up = P + (size_t)(NCTX + t2) * INWP + C_BU + ch;
#pragma unroll 8
        for (int t1 = 0; t1 < 128; ++t1) { const float x = bf2f(up[(size_t)t1 * 128 * INWP]); const int m = (k1 * t1) & 127; dr += x * ct[m]; di -= x * st[m]; }
        const float cp = tw[t2 * k1], sp = tw[16384 + t2 * k1];
        FYR[idx] = dr * cp + di * sp; FYI[idx] = di * cp - dr * sp;
    }
    __syncthreads();
}

constexpr float LOG2E = 1.4426950408889634f;
typedef short bf16x4 __attribute__((ext_vector_type(4)));
__device__ __forceinline__ bf16x8 ldg8(const bf16* p) { return *(const bf16x8*)p; }
template <int NH>
__device__ __forceinline__ void attn_block(const bf16* P, const bf16* VT, int krow, int kcol, const bf16x8 (&qf)[NH][2], f32x4 (&o)[NH][4], float (&m)[NH], float (&ls)[NH],
                                           const float (&add)[2][4], int li, int g) {
    bf16x8 kf[2][2];
#pragma unroll
    for (int t = 0; t < 2; ++t)
#pragma unroll
        for (int ks = 0; ks < 2; ++ks) kf[t][ks] = ldg8(P + (size_t)(krow + 16 * t + li) * INWP + kcol + 32 * ks + 8 * g);
    bf16x8 vf[4];
#pragma unroll
    for (int dt = 0; dt < 4; ++dt) { const bf16* vp = VT + (size_t)(dt * 16 + li) * VTP + krow + 4 * g;
        const bf16x4 a = *(const bf16x4*)vp, b = *(const bf16x4*)(vp + 16); vf[dt] = (bf16x8){a[0], a[1], a[2], a[3], b[0], b[1], b[2], b[3]}; }
#pragma unroll
    for (int hh = 0; hh < NH; ++hh) {
        f32x4 st[2];
#pragma unroll
        for (int t = 0; t < 2; ++t) { st[t] = (f32x4){0.f, 0.f, 0.f, 0.f};
#pragma unroll
            for (int ks = 0; ks < 2; ++ks) st[t] = __builtin_amdgcn_mfma_f32_16x16x32_bf16(kf[t][ks], qf[hh][ks], st[t], 0, 0, 0); }
        float s[8]; float bm = -INFINITY;
#pragma unroll
        for (int t = 0; t < 2; ++t)
#pragma unroll
            for (int r = 0; r < 4; ++r) { s[4 * t + r] = (add[t][r] == -INFINITY) ? -INFINITY : st[t][r] * (0.125f * LOG2E) + add[t][r]; bm = fmaxf(bm, s[4 * t + r]); }
        bm = fmaxf(bm, shx(bm, 16, 16 * g + li)); bm = fmaxf(bm, shx(bm, 32, 16 * g + li));
        const float mn = fmaxf(m[hh], bm), corr = __builtin_amdgcn_exp2f(m[hh] - mn); m[hh] = mn;
        float ps = 0.f; float pe[8];
#pragma unroll
        for (int e = 0; e < 8; ++e) { pe[e] = __builtin_amdgcn_exp2f(s[e] - mn); ps += pe[e]; }
        ls[hh] = ls[hh] * corr + ps;
        union { bf16x8 v; unsigned u[4]; } pf;
#pragma unroll
        for (int e2 = 0; e2 < 4; ++e2) pf.u[e2] = pk2(pe[2 * e2], pe[2 * e2 + 1]);
#pragma unroll
        for (int dt = 0; dt < 4; ++dt) { o[hh][dt] = o[hh][dt] * corr; o[hh][dt] = __builtin_amdgcn_mfma_f32_16x16x32_bf16(vf[dt], pf.v, o[hh][dt], 0, 0, 0); }
    }
}
template <int NH>
__device__ __forceinline__ void attn_finish(bf16* MIX, int qrow0, int ocol, f32x4 (&o)[NH][4], float (&m)[NH], float (&ls)[NH], const float* sink2  , int li, int g) {
#pragma unroll
    for (int hh = 0; hh < NH; ++hh) {
        float l = ls[hh]; l += shx(l, 16, 16 * g + li); l += shx(l, 32, 16 * g + li);
        float corr = 1.f;
        if (sink2) { const float sk = sink2[hh]; const float mn = fmaxf(m[hh], sk); corr = __builtin_amdgcn_exp2f(m[hh] - mn); l = l * corr + __builtin_amdgcn_exp2f(sk - mn); }
        const float inv = corr / l;
#pragma unroll
        for (int dt = 0; dt < 4; ++dt) { const f32x4 v = o[hh][dt] * inv; u32x2 w; w.x = pk2(v[0], v[1]); w.y = pk2(v[2], v[3]);
            *(u32x2*)(MIX + (size_t)(qrow0 + li) * DM + ocol + hh * 64 + dt * 16 + 4 * g) = w; }
    }
}
__device__ __forceinline__ void attnA_unit(const Ctx& C, const float* asink_l, int unit, bool lat) {
    const bf16* P = (const bf16*)(C.ws + WS_P); bf16* MIX = (bf16*)(C.ws + WS_MIX);
    const int li = C.lane & 15, g = C.lane >> 4;
    const int nqt = lat ? SEQ / 16 : NCTX / 16, kvh = unit / nqt, qt = unit % nqt, t0 = qt * 16, qrow0 = (lat ? NCTX : 0) + t0;
    const bf16* VT = (const bf16*)(C.ws + WS_VTA) + (size_t)kvh * 64 * VTP; const int kcol = C_AK + kvh * 64;
    bf16x8 qf[2][2];
#pragma unroll
    for (int hh = 0; hh < 2; ++hh)
#pragma unroll
        for (int ks = 0; ks < 2; ++ks) qf[hh][ks] = ldg8(P + (size_t)(qrow0 + li) * INWP + C_AQ + (kvh * 2 + hh) * 64 + 32 * ks + 8 * g);
    f32x4 o[2][4]; float m[2] = {-1.0e30f, -1.0e30f}, ls[2] = {0.f, 0.f};
#pragma unroll
    for (int hh = 0; hh < 2; ++hh)
#pragma unroll
        for (int dt = 0; dt < 4; ++dt) o[hh][dt] = (f32x4){0.f, 0.f, 0.f, 0.f};
    if (lat) {
        const int t = t0 + li;
#pragma unroll 1
        for (int b = 0; b < 9; ++b) { const int j0 = t0 - 128 + 32 * b; float add[2][4];
#pragma unroll
            for (int tt = 0; tt < 2; ++tt)
#pragma unroll
                for (int r = 0; r < 4; ++r) { const int j = j0 + 16 * tt + 4 * g + r; const bool ok = (j >= 0) && (j < SEQ) && (j - t <= 128) && (t - j <= 128); add[tt][r] = ok ? 0.f : -INFINITY; }
            attn_block<2>(P, VT, NCTX + j0, kcol, qf, o, m, ls, add, li, g); }
    }
    { float add[2][4];
#pragma unroll
      for (int tt = 0; tt < 2; ++tt)
#pragma unroll
          for (int r = 0; r < 4; ++r) add[tt][r] = 0.f;
#pragma unroll 1
      for (int b = 0; b < NCTX / 32; ++b) attn_block<2>(P, VT, 32 * b, kcol, qf, o, m, ls, add, li, g); }
    float sk2[2] = {asink_l[kvh * 2] * LOG2E, asink_l[kvh * 2 + 1] * LOG2E};
    attn_finish<2>(MIX, qrow0, kvh * 128, o, m, ls, sk2, li, g);
}
__device__ __forceinline__ void attnC_unit(const Ctx& C, const LAS float* relb, int h, int qt, bool lat) {
    const bf16* P = (const bf16*)(C.ws + WS_P); bf16* MIX = (bf16*)(C.ws + WS_MIX);
    const int li = C.lane & 15, g = C.lane >> 4;
    const int t0 = qt * 16, qrow0 = (lat ? NCTX : 0) + t0;
    const bf16* VT = (const bf16*)(C.ws + WS_VTC) + (size_t)h * 64 * VTP; const int kcol = C_CK + h * 64;
    bf16x8 qf[1][2];
#pragma unroll
    for (int ks = 0; ks < 2; ++ks) qf[0][ks] = ldg8(P + (size_t)(qrow0 + li) * INWP + C_CQ + h * 64 + 32 * ks + 8 * g);
    f32x4 o[1][4]; float m[1] = {-1.0e30f}, ls[1] = {0.f};
#pragma unroll
    for (int dt = 0; dt < 4; ++dt) o[0][dt] = (f32x4){0.f, 0.f, 0.f, 0.f};
    if (lat) {
        const int r = t0 >> 6, cj = (t0 >> 4) & 3, cq = cj * 16 + li; int r0 = r - 4; r0 = r0 < 0 ? 0 : (r0 > 248 ? 248 : r0);
        int c0 = cq - 8; c0 = c0 < 0 ? 0 : (c0 > 48 ? 48 : c0);
        const int cw0 = (cj == 0) ? 0 : (cj == 1) ? 8 : (cj == 2) ? 24 : 32;
#pragma unroll 1
        for (int kr = r0; kr < r0 + 8; ++kr) { float add[2][4]; const LAS float* rbp = relb + (kr - r + 7) * 31;
#pragma unroll
            for (int tt = 0; tt < 2; ++tt)
#pragma unroll
                for (int rr = 0; rr < 4; ++rr) { const int kc = cw0 + 16 * tt + 4 * g + rr; int ci = kc - cq + 15; ci = ci < 0 ? 0 : (ci > 30 ? 30 : ci);
                    const float bv = rbp[ci]; add[tt][rr] = (kc >= c0 && kc < c0 + 16) ? bv : -INFINITY; }
            attn_block<1>(P, VT, NCTX + kr * 64 + cw0, kcol, qf, o, m, ls, add, li, g); }
    }
    { float add[2][4];
#pragma unroll
      for (int tt = 0; tt < 2; ++tt)
#pragma unroll
          for (int r = 0; r < 4; ++r) add[tt][r] = 0.f;
#pragma unroll 1
      for (int b = 0; b < NCTX / 32; ++b) attn_block<1>(P, VT, 32 * b, kcol, qf, o, m, ls, add, li, g); }
    attn_finish<1>(MIX, qrow0, 512 + h * 64, o, m, ls, nullptr, li, g);
}
__device__ __forceinline__ void fourier2_unit(const Ctx& C, int l, int u, bool ctx) {
    const bf16* P = (const bf16*)(C.ws + WS_P); const float* tw = (const float*)(C.ws + WS_TW); bf16* MIX = (bf16*)(C.ws + WS_MIX);
    const float* FYR = (const float*)(C.ws + WS_FYR); const float* FYI = (const float*)(C.ws + WS_FYI);
    const float* mt = (const float*)(C.ws + WS_MTAB) + (size_t)l * 2 * 4 * 4096;
    LAS float* xr = (LAS float*)(C.lds + 8192); LAS float* xi = xr + 512;
    const int tl = C.tid >> 8, ch = C.tid & 255, tp = 2 * u + tl;
    float sr = 0.f, si = 0.f;
    if (!ctx) { const int k1 = tp & 127, k2 = tp >> 7; const float* yr = FYR + (size_t)k1 * 128 * 256 + ch; const float* yi = FYI + (size_t)k1 * 128 * 256 + ch;
#pragma unroll 8
        for (int t2 = 0; t2 < 128; ++t2) { const int m = ((t2 * k2) & 127) * 128; const float c = tw[m], s = tw[16384 + m]; const float a = yr[t2 * 256], b = yi[t2 * 256]; sr += a * c + b * s; si += b * c - a * s; } }
    else {
#pragma unroll 8
        for (int t = 0; t < NCTX; ++t) { const int m = ((t * tp) & 255) * 64; const float x = bf2f(P[(size_t)t * INWP + C_BU + ch]); sr += x * tw[m]; si -= x * tw[16384 + m]; } }
    __syncthreads();
    xr[tl * 256 + ch] = sr; xi[tl * 256 + ch] = si;
    __syncthreads();
    const int g = ch >> 6, e = ch & 63; const float* mc = mt + (size_t)(0 * 4 + g) * 4096 + e; const float* ms = mt + (size_t)(1 * 4 + g) * 4096 + e;
    const LAS float* xrp = xr + tl * 256 + g * 64; const LAS float* xip = xi + tl * 256 + g * 64; float o = 0.f;
#pragma unroll 8
    for (int c = 0; c < 64; ++c) o += xrp[c] * mc[c * 64] + xip[c] * ms[c * 64];
    o *= ctx ? (1.0f / 128.0f) : (1.0f / 1024.0f);
    MIX[(size_t)((ctx ? 0 : NCTX) + tp) * DM + 256 + ch] = (bf16)f2bf(o);
}
__device__ __forceinline__ void rwkv_passB(const Ctx& C, int b);
__device__ __forceinline__ void phase_mix2(const Ctx& C, const DArgs& a, int l) {
    const bool emit_ctx = l < DEPTH - 1;
    if (C.wg < 8) rwkv_passB(C, C.wg);
    { const float* asink_l = a.in[I_ASINK] + l * 4; const float* crel = a.in[I_CREL] + (size_t)l * 4 * 465;
      LAS float* relb = (LAS float*)(C.lds + 65536 + C.wave * 2048);
      const int nA = 2 * (SEQ / 16), nC = 4 * (SEQ / 16), nAc = emit_ctx ? 2 * (NCTX / 16) : 0, nCc = emit_ctx ? 4 * (NCTX / 16) : 0;
      for (int u = C.gw; u < nA + nAc; u += C.NGW) { if (u < nA) attnA_unit(C, asink_l, u, true); else attnA_unit(C, asink_l, u - nA, false); }
      int hcur = -1;
      for (int u = C.gw; u < nC + nCc; u += C.NGW) { const bool lat = u < nC; const int uu = lat ? u : u - nC, nqt = lat ? SEQ / 16 : NCTX / 16, h = uu / nqt, qt = uu % nqt;
          if (h != hcur) { for (int i = C.lane; i < 465; i += 64) relb[i] = crel[h * 465 + i] * LOG2E; hcur = h; LDS_WAIT(); asm volatile("" ::: "memory"); }
          attnC_unit(C, relb, h, qt, lat); } }
    __syncthreads();
    const int nF = SEQ / 2, nFc = emit_ctx ? NCTX / 2 : 0;
    for (int u = C.wg; u < nF + nFc; u += C.G) {
        if (u < nF) fourier2_unit(C, l, u, false);
        else fourier2_unit(C, l, u - nF, true);
    }
}

typedef short s4v __attribute__((ext_vector_type(4)));
constexpr int RW_C = 32, RW_NCH = ROWS / RW_C, RW_SC = 20, RW_NSC = RW_NCH / RW_SC;
constexpr int RW_SLOT = 5120, RW_REGION = 9 * RW_SLOT + 1024;
constexpr int TP = 72, HP = 40;
static_assert(3 * RW_REGION <= MISC_OFF, "RWKV D1 regions below the misc area");
__device__ __forceinline__ f32x4 mfma16(bf16x8 a, bf16x8 b, f32x4 c) { return __builtin_amdgcn_mfma_f32_16x16x32_bf16(a, b, c, 0, 0, 0); }
__device__ __forceinline__ bf16x8 ldA(const LAS unsigned char* base, int pitch, int row0, int k0, int li, int g) { return *(const LAS bf16x8*)(base + ((row0 + li) * pitch + k0 + 8 * g) * 2); }
__device__ __forceinline__ bf16x8 ldT(const LAS unsigned char* base, int pitch, int k0, int n0, int li, int g) {
    const LAS unsigned char* p = base + ((k0 + 8 * g + (li >> 2)) * pitch + n0 + 4 * (li & 3)) * 2;
    const s4v a = __builtin_amdgcn_ds_read_tr16_b64_v4i16((LAS s4v*)p), b = __builtin_amdgcn_ds_read_tr16_b64_v4i16((LAS s4v*)(p + 8 * pitch));
    return (bf16x8){a[0], a[1], a[2], a[3], b[0], b[1], b[2], b[3]};
}
__device__ __forceinline__ bf16x8 ldAperm(const LAS unsigned char* base, int pitch, int row0, int ks, int li, int g) {
    const LAS unsigned char* p = base + ((row0 + li) * pitch + 32 * ks + 4 * g) * 2;
    const s4v a = *(const LAS s4v*)p, b = *(const LAS s4v*)(p + 32);
    return (bf16x8){a[0], a[1], a[2], a[3], b[0], b[1], b[2], b[3]};
}
__device__ __forceinline__ void stT(LAS unsigned char* base, int pitch, int n, int m0, const f32x4 v) {
    u32x2 w; w.x = pk2(v[0], v[1]); w.y = pk2(v[2], v[3]); *(LAS u32x2*)(base + (n * pitch + m0) * 2) = w;
}
__device__ __forceinline__ f32x4 ld4bf(const LAS unsigned char* p) { const u32x2 w = *(const LAS u32x2*)p; return (f32x4){bflo(w.x), bfhi(w.x), bflo(w.y), bfhi(w.y)}; }
__device__ __forceinline__ int rw_rc_of(int d, int c) { return d == 0 ? c : (c < 8 ? 7 - c : 527 - c); }
__device__ __forceinline__ int rw_row_of(int d, int rc, int t) { return 32 * rc + (d == 0 ? t : 31 - t); }

__device__ __forceinline__ void rwkv_d1(const Ctx& C, LAS unsigned char* rb, int d, int h, int rc) {
    int lane_ = C.lane; asm volatile("" : "+v"(lane_));
    const int lane = lane_, li = lane & 15, g = lane >> 4;
    const float* SC = (const float*)(C.ws + WS_SC);
    LAS unsigned char* S0 = rb; LAS unsigned char* S1 = rb + RW_SLOT; LAS unsigned char* S2 = rb + 2 * RW_SLOT; LAS unsigned char* S3 = rb + 3 * RW_SLOT; LAS unsigned char* S4 = rb + 4 * RW_SLOT;
    LAS unsigned char* S5 = rb + 5 * RW_SLOT; LAS unsigned char* S6 = rb + 6 * RW_SLOT; LAS unsigned char* S7 = rb + 7 * RW_SLOT; LAS unsigned char* S8 = rb + 8 * RW_SLOT;
    LAS unsigned char* S6b = S6 + 2560; LAS unsigned char* S7b = S7 + 2560;
    LAS float* gc = (LAS float*)(rb + 9 * RW_SLOT);
    { float cum = 0.f; const int j = lane; const int qw = (3 + 3 * d) * 256;
#pragma unroll 1
      for (int t0 = 0; t0 < 32; t0 += 4) { float rv[4], vv[4], av[4], lw[4], kd[4], bb[4];
#pragma unroll
          for (int u = 0; u < 4; ++u) { const float* sc = SC + (size_t)rw_row_of(d, rc, t0 + u) * 9 * 256 + h * 64 + j;
              rv[u] = sc[0]; vv[u] = sc[256]; av[u] = sc[512]; lw[u] = sc[qw]; kd[u] = sc[qw + 256]; bb[u] = sc[qw + 512]; }
#pragma unroll
          for (int u = 0; u < 4; ++u) { const float cp = cum; cum += lw[u]; const float Gt = __expf(cum), Gm = __expf(cp), iG = __expf(-cum); const int off = ((t0 + u) * TP + j) * 2;
              *(LAS bf16*)(S0 + off) = (bf16)f2bf(av[u] * Gm); *(LAS bf16*)(S1 + off) = (bf16)f2bf(rv[u] * Gt); *(LAS bf16*)(S2 + off) = (bf16)f2bf(bb[u] * iG);
              *(LAS bf16*)(S3 + off) = (bf16)f2bf(kd[u] * iG); *(LAS bf16*)(S4 + off) = (bf16)f2bf(vv[u]); } }
      gc[j] = __expf(cum); }
    const f32x4 z4 = {0.f, 0.f, 0.f, 0.f};
#pragma unroll 1
    for (int ti = 0; ti < 2; ++ti)
#pragma unroll 1
        for (int si = 0; si < 2; ++si) {
            f32x4 n = z4, nt = z4, mk = z4, qb = z4, qk = z4;
#pragma unroll
            for (int ks = 0; ks < 2; ++ks) { const bf16x8 at = ldA(S0, TP, 16 * ti, 32 * ks, li, g), rt = ldA(S1, TP, 16 * ti, 32 * ks, li, g), bs = ldA(S2, TP, 16 * si, 32 * ks, li, g), kss = ldA(S3, TP, 16 * si, 32 * ks, li, g);
                n = mfma16(at, bs, n);
                nt = mfma16(bs, at, nt);
                mk = mfma16(kss, at, mk);
                qb = mfma16(bs, rt, qb);
                qk = mfma16(kss, rt, qk); }
#pragma unroll
            for (int r = 0; r < 4; ++r) { const int trow = 16 * ti + 4 * g + r, scol = 16 * si + li; if (!(scol < trow)) n[r] = 0.f;
                const int srow = 16 * si + 4 * g + r, tcol = 16 * ti + li; if (!(srow < tcol)) { mk[r] = 0.f; nt[r] = 0.f; } if (!(srow <= tcol)) { qb[r] = 0.f; qk[r] = 0.f; } }
            *(LAS f32x4*)(S5 + ((16 * si + li) * 32 + 16 * ti + 4 * g) * 4) = n;
            stT(S6, HP, 16 * ti + li, 16 * si + 4 * g, mk);
            stT(S8, HP, 16 * ti + li, 16 * si + 4 * g, nt);
            stT(S6b, HP, 16 * ti + li, 16 * si + 4 * g, qb);
            stT(S7, HP, 16 * ti + li, 16 * si + 4 * g, qk); }
    { const int rr = lane & 31, bq = rr >> 4, lr = rr & 15; float Tr[16];
#pragma unroll
      for (int s = 15; s >= 0; --s) { float acc = (lr == s) ? 1.f : 0.f;
#pragma unroll
          for (int c4 = 0; c4 < 4; ++c4) { if (4 * c4 + 3 > s) { const f32x4 nv = *(const LAS f32x4*)(S5 + ((16 * bq + s) * 32 + 16 * bq + 4 * c4) * 4);
#pragma unroll
              for (int e = 0; e < 4; ++e) if (4 * c4 + e > s) acc += Tr[4 * c4 + e] * nv[e]; } }
          Tr[s] = acc; }
      if (lane < 32) { u32x4 w0, w1; w0.x = pk2(Tr[0], Tr[1]); w0.y = pk2(Tr[2], Tr[3]); w0.z = pk2(Tr[4], Tr[5]); w0.w = pk2(Tr[6], Tr[7]); w1.x = pk2(Tr[8], Tr[9]); w1.y = pk2(Tr[10], Tr[11]); w1.z = pk2(Tr[12], Tr[13]); w1.w = pk2(Tr[14], Tr[15]);
          const u32x4 zz = {0u, 0u, 0u, 0u}; LAS u32x4* trow = (LAS u32x4*)(S7b + rr * HP * 2);
          trow[0] = bq ? zz : w0; trow[1] = bq ? zz : w1; trow[2] = bq ? w0 : zz; trow[3] = bq ? w1 : zz; }
      f32x4 x = mfma16(ldA(S8, HP, 16, 0, li, g), ldT(S7b, HP, 0, 0, li, g), z4);
      LAS unsigned char* XT = S8 + 2560;
      *(LAS u32x2*)(XT + (li * HP + 4 * g) * 2) = (u32x2){0u, 0u}; stT(XT, HP, li, 16 + 4 * g, x);
      const f32x4 t21 = mfma16(ldA(S7b, HP, 16, 0, li, g), ldA(XT, HP, 0, 0, li, g), z4);
#pragma unroll
      for (int r = 0; r < 4; ++r) *(LAS bf16*)(S7b + ((16 + 4 * g + r) * HP + li) * 2) = (bf16)f2bf(t21[r]); }
#pragma unroll 1
    for (int ti = 0; ti < 2; ++ti) { const bf16x8 tf = ldA(S7b, HP, 16 * ti, 0, li, g), mf = ldA(S6, HP, 16 * ti, 0, li, g);
#pragma unroll
        for (int ji = 0; ji < 4; ++ji) { const f32x4 ap = mfma16(tf, ldT(S0, TP, 0, 16 * ji, li, g), z4); stT(S8, HP, 16 * ji + li, 16 * ti + 4 * g, ap);
            const f32x4 mv = mfma16(mf, ldT(S4, TP, 0, 16 * ji, li, g), z4); stT(S5, HP, 16 * ji + li, 16 * ti + 4 * g, mv); } }
#pragma unroll 1
    for (int ti = 0; ti < 2; ++ti) { const bf16x8 tf = ldA(S7b, HP, 16 * ti, 0, li, g);
#pragma unroll
        for (int vi = 0; vi < 4; ++vi) { const f32x4 ul = mfma16(tf, ldA(S5, HP, 16 * vi, 0, li, g), z4); stT(S0, HP, 16 * vi + li, 16 * ti + 4 * g, ul); } }
#pragma unroll 1
    for (int ti = 0; ti < 2; ++ti) { const bf16x8 qbf = ldA(S6b, HP, 16 * ti, 0, li, g), qkf = ldA(S7, HP, 16 * ti, 0, li, g);
#pragma unroll
        for (int ji = 0; ji < 4; ++ji) { f32x4 rp = mfma16(ldA(S8, HP, 16 * ji, 0, li, g), qbf, z4);
            LAS unsigned char* p = S1 + ((16 * ti + li) * TP + 16 * ji + 4 * g) * 2; rp = rp + ld4bf(p); u32x2 w; w.x = pk2(rp[0], rp[1]); w.y = pk2(rp[2], rp[3]); *(LAS u32x2*)p = w;
            f32x4 yl = mfma16(qbf, ldA(S0, HP, 16 * ji, 0, li, g), z4); yl = mfma16(qkf, ldT(S4, TP, 0, 16 * ji, li, g), yl);
            stT(S5, HP, 16 * ji + li, 16 * ti + 4 * g, yl); } }
#pragma unroll 1
    for (int ji = 0; ji < 4; ++ji) { const bf16x8 bt = ldT(S2, TP, 0, 16 * ji, li, g); const float gj = gc[16 * ji + li];
#pragma unroll
        for (int jp = 0; jp < 4; ++jp) { f32x4 pt = mfma16(ldA(S8, HP, 16 * jp, 0, li, g), bt, z4);
#pragma unroll
            for (int r = 0; r < 4; ++r) pt[r] = pt[r] * gj + ((16 * jp + 4 * g + r == 16 * ji + li) ? gj : 0.f);
            stT(S6, TP, 16 * ji + li, 16 * jp + 4 * g, pt); } }
#pragma unroll 1
    for (int vh = 0; vh < 2; ++vh) { f32x4 lt[4][2];
#pragma unroll
      for (int ji = 0; ji < 4; ++ji) { const bf16x8 ba = ldT(S2, TP, 0, 16 * ji, li, g), ka = ldT(S3, TP, 0, 16 * ji, li, g); const f32x4 gv = *(const LAS f32x4*)(gc + 16 * ji + 4 * g);
#pragma unroll
          for (int v2 = 0; v2 < 2; ++v2) { const int vi = 2 * vh + v2; f32x4 x = mfma16(ba, ldA(S0, HP, 16 * vi, 0, li, g), z4); x = mfma16(ka, ldT(S4, TP, 0, 16 * vi, li, g), x); lt[ji][v2] = x * gv; } }
      asm volatile("s_waitcnt lgkmcnt(0)" ::: "memory");
      LAS unsigned char* dst = vh ? S2 : S8;
#pragma unroll
      for (int ji = 0; ji < 4; ++ji)
#pragma unroll
          for (int v2 = 0; v2 < 2; ++v2) stT(dst, TP, 16 * v2 + li, 16 * ji + 4 * g, lt[ji][v2]); }
}
__device__ __forceinline__ void rwkv_passA_step(const Ctx& C, const LAS unsigned char* rb, f32x4 (&hs)[4], int d, int h, int rc) {
    int lane_ = C.lane; asm volatile("" : "+v"(lane_));
    const int lane = lane_, li = lane & 15, g = lane >> 4; const bool isPhi = C.wave >= 4; const int col = 16 * (C.wave & 3) + li;
    const LAS unsigned char* S1 = rb + RW_SLOT; const LAS unsigned char* S2 = rb + 2 * RW_SLOT; const LAS unsigned char* S5 = rb + 5 * RW_SLOT; const LAS unsigned char* S6 = rb + 6 * RW_SLOT;
    const LAS unsigned char* LTb = (col < 32) ? rb + 8 * RW_SLOT + col * TP * 2 : S2 + (col - 32) * TP * 2;
    union { bf16x8 v; unsigned u[4]; } bf[2];
#pragma unroll
    for (int ks = 0; ks < 2; ++ks) { bf[ks].u[0] = pk2(hs[2 * ks][0], hs[2 * ks][1]); bf[ks].u[1] = pk2(hs[2 * ks][2], hs[2 * ks][3]); bf[ks].u[2] = pk2(hs[2 * ks + 1][0], hs[2 * ks + 1][1]); bf[ks].u[3] = pk2(hs[2 * ks + 1][2], hs[2 * ks + 1][3]); }
#pragma unroll
    for (int ti = 0; ti < 2; ++ti) { f32x4 acc = isPhi ? (f32x4){0.f, 0.f, 0.f, 0.f} : ld4bf(S5 + (col * HP + 16 * ti + 4 * g) * 2);
#pragma unroll
        for (int ks = 0; ks < 2; ++ks) acc = mfma16(ldAperm(S1, TP, 16 * ti, ks, li, g), bf[ks].v, acc);
        if (!isPhi) { float* ys = (float*)(C.ws + WS_YS) + (size_t)d * ROWS * 256 + h * 64 + col;
#pragma unroll
            for (int r = 0; r < 4; ++r) ys[(size_t)rw_row_of(d, rc, 16 * ti + 4 * g + r) * 256] = acc[r]; }
        else { bf16* rp = (bf16*)(C.ws + WS_RPP) + ((size_t)((d * 4 + h) * RW_NCH + rc) * 32) * 64 + col;
#pragma unroll
            for (int r = 0; r < 4; ++r) rp[(16 * ti + 4 * g + r) * 64] = (bf16)f2bf(acc[r]); } }
    f32x4 hn[4];
#pragma unroll
    for (int i = 0; i < 4; ++i) { f32x4 acc = isPhi ? (f32x4){0.f, 0.f, 0.f, 0.f} : ld4bf(LTb + (16 * i + 4 * g) * 2);
#pragma unroll
        for (int ks = 0; ks < 2; ++ks) acc = mfma16(ldAperm(S6, TP, 16 * i, ks, li, g), bf[ks].v, acc);
        hn[i] = acc; }
#pragma unroll
    for (int i = 0; i < 4; ++i) hs[i] = hn[i];
}
__device__ __forceinline__ void phase_rwkv1(const Ctx& C) {
    const int lane = C.lane, li = lane & 15, g = lane >> 4;
    for (int u = C.wg; u < 8 * RW_NSC; u += C.G) {
        const int s = u % RW_NSC, dh = u / RW_NSC, d = dh >> 2, h = dh & 3; const bool isPhi = C.wave >= 4; const int col = 16 * (C.wave & 3) + li;
        f32x4 hs[4];
#pragma unroll
        for (int i = 0; i < 4; ++i)
#pragma unroll
            for (int r = 0; r < 4; ++r) hs[i][r] = (isPhi && (16 * i + 4 * g + r == col)) ? 1.f : 0.f;
#pragma unroll 1
        for (int rnd = 0; rnd < (RW_SC + 2) / 3; ++rnd) {
            __syncthreads();
            { int wv = C.wave; asm volatile("" : "+s"(wv)); if (wv < 3 && 3 * rnd + wv < RW_SC) rwkv_d1(C, C.lds + wv * RW_REGION, d, h, rw_rc_of(d, s * RW_SC + 3 * rnd + wv)); }
            __syncthreads();
#pragma unroll 1
            for (int k = 0; k < 3; ++k) { const int ci = 3 * rnd + k; int ko = k * RW_REGION; asm volatile("" : "+s"(ko)); if (ci < RW_SC) rwkv_passA_step(C, C.lds + ko, hs, d, h, rw_rc_of(d, s * RW_SC + ci)); }
        }
        if (isPhi) { bf16* pf = (bf16*)(C.ws + WS_PSC) + (size_t)(dh * RW_NSC + s) * 4096;
            const int ks = col >> 5, eh = (col >> 4) & 1, gp = (col >> 2) & 3, el = col & 3;
#pragma unroll
            for (int i = 0; i < 4; ++i)
#pragma unroll
                for (int r = 0; r < 4; ++r) pf[((i * 2 + ks) * 64 + gp * 16 + 4 * g + r) * 8 + eh * 4 + el] = (bf16)f2bf(hs[i][r]); }
        else { f32x4* lf = (f32x4*)(C.ws + WS_LSC) + ((size_t)(dh * RW_NSC + s) * 4 + C.wave) * 4 * 64;
#pragma unroll
            for (int i = 0; i < 4; ++i) lf[i * 64 + lane] = hs[i]; }
    }
    __syncthreads();
}
__device__ __forceinline__ void rwkv_passB(const Ctx& C, int b) {
    if (C.wave >= 4) return;
    const int lane = C.lane, li = lane & 15, g = lane >> 4, q = C.wave;
    f32x4 hs[4];
#pragma unroll
    for (int i = 0; i < 4; ++i) hs[i] = (f32x4){0.f, 0.f, 0.f, 0.f};
    const bf16x8* pfb = (const bf16x8*)((const bf16*)(C.ws + WS_PSC) + (size_t)b * RW_NSC * 4096);
    const f32x4* lfb = (const f32x4*)(C.ws + WS_LSC) + ((size_t)b * RW_NSC * 4 + q) * 4 * 64;
    bf16x8 pa[8]; f32x4 la[4];
#pragma unroll
    for (int k = 0; k < 8; ++k) pa[k] = pfb[k * 64 + lane];
#pragma unroll
    for (int i = 0; i < 4; ++i) la[i] = lfb[i * 64 + lane];
#pragma unroll 1
    for (int s = 0; s < RW_NSC; ++s) {
        bf16* hp = (bf16*)(C.ws + WS_HSC) + ((size_t)(b * RW_NSC + s) * 64 + 16 * q + li) * 64;
#pragma unroll
        for (int i = 0; i < 4; ++i) { u32x2 w; w.x = pk2(hs[i][0], hs[i][1]); w.y = pk2(hs[i][2], hs[i][3]); *(u32x2*)(hp + 16 * i + 4 * g) = w; }
        bf16x8 pn[8]; f32x4 ln[4]; const int sn = (s + 1 < RW_NSC) ? s + 1 : s;
#pragma unroll
        for (int k = 0; k < 8; ++k) pn[k] = pfb[(size_t)sn * 512 + k * 64 + lane];
#pragma unroll
        for (int i = 0; i < 4; ++i) ln[i] = lfb[(size_t)sn * 4 * 4 * 64 + i * 64 + lane];
        union { bf16x8 v; unsigned u[4]; } bf[2];
#pragma unroll
        for (int ks = 0; ks < 2; ++ks) { bf[ks].u[0] = pk2(hs[2 * ks][0], hs[2 * ks][1]); bf[ks].u[1] = pk2(hs[2 * ks][2], hs[2 * ks][3]); bf[ks].u[2] = pk2(hs[2 * ks + 1][0], hs[2 * ks + 1][1]); bf[ks].u[3] = pk2(hs[2 * ks + 1][2], hs[2 * ks + 1][3]); }
#pragma unroll
        for (int i = 0; i < 4; ++i) { f32x4 acc = la[i];
#pragma unroll
            for (int ks = 0; ks < 2; ++ks) acc = mfma16(pa[i * 2 + ks], bf[ks].v, acc);
            hs[i] = acc; }
#pragma unroll
        for (int k = 0; k < 8; ++k) pa[k] = pn[k];
#pragma unroll
        for (int i = 0; i < 4; ++i) la[i] = ln[i];
    }
}
__device__ __forceinline__ void phase_mix3(const Ctx& C, const DArgs& a, int l) {
    const bf16* P = (const bf16*)(C.ws + WS_P); const float* SC = (const float*)(C.ws + WS_SC); const float* YS = (const float*)(C.ws + WS_YS); bf16* MIX = (bf16*)(C.ws + WS_MIX);
    LAS float* yt = (LAS float*)(C.lds);
    LAS float* gl = (LAS float*)(C.lds + 65536);
    const float* g2 = a.in[I_DG2] + (size_t)l * 160 * 256; const float* rk = a.in[I_DRK] + (size_t)l * 256; const float* lnw = a.in[I_DLNW] + (size_t)l * 256; const float* lnb = a.in[I_DLNB] + (size_t)l * 256;
    const int lane = C.lane, li = lane & 15, g = lane >> 4, h = C.wave & 3, d = C.wave >> 2;
    const int half = C.tid >> 8, c = C.tid & 255;
    const int rc_lo = (l == DEPTH - 1) ? NCTX / 32 : 0;
    for (int rc = rc_lo + C.wg; rc < RW_NCH; rc += C.G) {
        __syncthreads();
        {
          const int ct = (d == 0) ? rc : (rc < 8 ? 7 - rc : 527 - rc), s = ct / RW_SC;
          const bf16* rp = (const bf16*)(C.ws + WS_RPP) + (size_t)((d * 4 + h) * RW_NCH + rc) * 32 * 64;
          const bf16* hp = (const bf16*)(C.ws + WS_HSC) + (size_t)((d * 4 + h) * RW_NSC + s) * 64 * 64;
          bf16x8 af[2][2];
#pragma unroll
          for (int ti = 0; ti < 2; ++ti)
#pragma unroll
              for (int ks = 0; ks < 2; ++ks) af[ti][ks] = ldg8(rp + (16 * ti + li) * 64 + 32 * ks + 8 * g);
#pragma unroll
          for (int vi = 0; vi < 4; ++vi) { bf16x8 bfr[2];
#pragma unroll
              for (int ks = 0; ks < 2; ++ks) bfr[ks] = ldg8(hp + (16 * vi + li) * 64 + 32 * ks + 8 * g);
#pragma unroll
              for (int ti = 0; ti < 2; ++ti) { f32x4 acc = {0.f, 0.f, 0.f, 0.f};
#pragma unroll
                  for (int ks = 0; ks < 2; ++ks) acc = mfma16(af[ti][ks], bfr[ks], acc);
#pragma unroll
                  for (int r = 0; r < 4; ++r) { const int t = 16 * ti + 4 * g + r, rl = (d == 0) ? t : 31 - t;
                      yt[(d * 32 + rl) * 256 + h * 64 + 16 * vi + li] = acc[r] + YS[((size_t)d * ROWS + 32 * rc + rl) * 256 + h * 64 + 16 * vi + li]; } } } }
        __syncthreads();
#pragma unroll 1
        for (int it = 0; it < 16; ++it) { const int rl = 2 * it + half, row = 32 * rc + rl;
            __syncthreads();
            if (c < 160) gl[half * 160 + c] = sigmoidf_(bf2f(P[(size_t)row * INWP + C_GL + c]));
            __syncthreads();
            const float* sc = SC + (size_t)row * 9 * 256;
            const float y = yt[rl * 256 + c] + yt[(32 + rl) * 256 + c];
            const float mu = wave_sum(y, lane) * (1.f / 64.f), dy = y - mu, var = wave_sum(dy * dy, lane) * (1.f / 64.f);
            const float yn = dy * rsqrtf(var + 64e-5f) * lnw[c] + lnb[c];
            const float r = sc[c], v = sc[256 + c];
            const float coef = wave_sum(r * (sc[4 * 256 + c] + sc[7 * 256 + c]) * rk[c], lane);
            float gg = 0.f; const float* g2p = g2 + c; const LAS float* glp = gl + half * 160;
#pragma unroll 8
            for (int i = 0; i < 160; ++i) gg += glp[i] * g2p[i * 256];
            MIX[(size_t)row * DM + 768 + c] = (bf16)f2bf((yn + coef * v) * gg); }
    }
    __syncthreads();
}

#ifndef MK_SINGLE
#define MK_SINGLE 1
#endif
template <int ONLYP> __global__ void __launch_bounds__(NTHR, 2) mega(Args a) {
    extern __shared__ __attribute__((aligned(16))) unsigned char lds_raw[];
    Ctx C;
#define MKCTX() do { int t_ = threadIdx.x; asm volatile("" : "+v"(t_)); unsigned char* w_ = a.ws; asm volatile("" : "+s"(w_)); unsigned l_ = 0u; asm volatile("" : "+s"(l_)); \
        C.lds = (LAS unsigned char*)lds_raw + l_; C.tid = t_; C.lane = t_ & 63; C.wave = __builtin_amdgcn_readfirstlane(t_ >> 6); \
        C.wg = blockIdx.x; C.G = gridDim.x; C.gw = C.wg * NWAVES + C.wave; C.NGW = C.G * NWAVES; C.ws = w_; } while (0)
    MKCTX();
    if (C.tid == 0) {
#pragma unroll
        for (int i = 0; i < 31; ++i) ((LAS unsigned long long*)(C.lds + MISC_OFF + 2048))[i] = (unsigned long long)a.in[i]; }
    DArgs da; da.in.tab = (const LAS unsigned*)(C.lds + MISC_OFF + 2048); da.out = a.out;
    if (C.tid < 4) ((LAS unsigned*)(C.lds + MISC_OFF))[C.tid] = 0u;
    __syncthreads();
    XcdBarrier bar; bar.bar = (unsigned*)(C.ws + WS_CTL) + CW_BAR; bar.x = 0; bar.st = (volatile LAS unsigned*)(C.lds + MISC_OFF);
    if (a.use_bar) bar = xcd_barrier_post((unsigned*)(C.ws + WS_CTL) + CW_BAR, (volatile LAS unsigned*)(C.lds + MISC_OFF));
#ifndef PHMASK
#define PHMASK 0x1fff
#endif
#define INP(o, k) ((ONLYP < 0 || ONLYP == (o)) && ((PHMASK >> ((o) == 99 ? 12 : (o))) & 1) && a.ph_lo <= (k) && (k) < a.ph_hi)
#define IN(k) (a.ph_lo <= (k) && (k) < a.ph_hi)
#define SEAM(k) do { if (a.use_bar && IN(k) && IN((k) + 1)) xcd_barrier(bar); } while (0)
    if (INP(0, 0)) { MKCTX(); phase_prologue(C, da); }
    SEAM(0);
    for (int l = 0; l < DEPTH; ++l) {
        const int b = 1 + l * NPL;
        const float* mod_lat = (const float*)(C.ws + WS_MOD) + (size_t)(l * 2 + 0) * 6144; const float* mod_ctx = mod_lat + 6144;
        if (INP(1, b + 0)) { MKCTX(); phase_norm1(C, da, l); }
        SEAM(b + 0);
        if (INP(2, b + 1)) { MKCTX();
            pg8::StaticOrder S; S.init(C.ws + WS_H, (const bf16*)(C.ws + WS_WIN) + (size_t)l * INWP * DM, ROWS, INWP, DM, C.G, C.wg);
            pg8::EpiStoreBf16 E{(bf16*)(C.ws + WS_P), INWP, nullptr, 0};
            pg8::gemm_phase<pg8::EpiStoreBf16, pg8::StaticOrder, true, true>(C.lds, C.tid, DM, S, E);
        }
        SEAM(b + 1);
        if (INP(3, b + 2)) { MKCTX(); mix1_rope(C); mix1_vt(C); mix1_rwkv_prep(C, da, l); mix1_fourier1(C); }
        SEAM(b + 2);
        if (INP(11, b + 3)) { MKCTX(); phase_rwkv1(C); }
        SEAM(b + 3);
        if (INP(4, b + 4)) { MKCTX(); phase_mix2(C, da, l); }
        SEAM(b + 4);
        if (INP(5, b + 5)) { MKCTX(); phase_mix3(C, da, l); }
        SEAM(b + 5);
        if (INP(6, b + 6)) { MKCTX();
            pg8::StaticOrder S; S.init(C.ws + WS_MIX, (const bf16*)(C.ws + WS_WOUT) + (size_t)l * DM * DM, ROWS, DM, DM, C.G, C.wg);
            pg8::EpiResidual E{(float*)(C.ws + WS_XS), DM, mod_lat + 2 * DM, mod_ctx + 2 * DM};
            pg8::gemm_phase<pg8::EpiResidual, pg8::StaticOrder, true, true>(C.lds, C.tid, DM, S, E);
        }
        SEAM(b + 6);
        if (INP(7, b + 7)) { MKCTX(); phase_norm2(C, da, l); }
        SEAM(b + 7);
        if (INP(8, b + 8)) { MKCTX(); phase_gather(C, da, l); }
        SEAM(b + 8);
        if (INP(9, b + 9)) { MKCTX();
            const int nblk = moe_tables(C);
            pg8::MoeOrder S{(const char*)(C.ws + WS_XG), (const char*)((const bf16*)(C.ws + WS_WGU) + (size_t)l * 32 * 2048 * DM), (size_t)256 * DM * 2, (size_t)2048 * DM * 2,
                            (const LAS unsigned char*)(C.lds + MISC_OFF + 1024), nblk, 8, C.G, C.wg};
            pg8::EpiSwiglu E{(bf16*)(C.ws + WS_ACT), DM, da.in[I_BGU] + (size_t)l * 32 * 2048, 2048};
            pg8::gemm_phase<pg8::EpiSwiglu, pg8::MoeOrder, true, true>(C.lds, C.tid, DM, S, E);
        }
        SEAM(b + 9);
        if (INP(10, b + 10)) { MKCTX();
            const int nblk = moe_tables(C);
            pg8::MoeOrder S{(const char*)(C.ws + WS_ACT), (const char*)((const bf16*)(C.ws + WS_WDN) + (size_t)l * 32 * DM * DM), (size_t)256 * DM * 2, (size_t)DM * DM * 2,
                            (const LAS unsigned char*)(C.lds + MISC_OFF + 1024), nblk, 4, C.G, C.wg};
            pg8::EpiStoreBf16 E{(bf16*)(C.ws + WS_XG), DM, da.in[I_BDN] + (size_t)l * 32 * DM, DM};
            pg8::gemm_phase<pg8::EpiStoreBf16, pg8::MoeOrder, true, true>(C.lds, C.tid, DM, S, E);
        }
        SEAM(b + 10);
    }
    if (INP(99, PH_TOTAL - 1)) { MKCTX(); phase_final(C, da); }
#undef IN
#undef INP
#undef SEAM
}

typedef void (*kern_t)(Args);
static kern_t kern_of(int o) {
    switch (o) { case 0: return mega<0>; case 1: return mega<1>; case 2: return mega<2>; case 3: return mega<3>; case 4: return mega<4>; case 5: return mega<5>; case 6: return mega<6>;
                 case 7: return mega<7>; case 8: return mega<8>; case 9: return mega<9>; case 10: return mega<10>; case 11: return mega<11>; case 99: return mega<99>;
#if MK_SINGLE
                 default: return mega<-1>;
#else
                 default: return mega<0>;
#endif
    }
}
extern "C" void kernel_launch(void* const* d_in, const int* in_sizes, int n_in, void* d_out, int out_size, void* d_ws, size_t ws_size, hipStream_t stream) {
    static int ready = 0;
    if (ready == 0) {
        if (n_in != 31 || out_size != SEQ * DM || ws_size < WS_END) { fprintf(stderr, "kernel_launch: unexpected shapes (n_in %d, out %d, ws %zu)\n", n_in, out_size, ws_size); ready = -1; return; }
        const int ids[14] = {0, 1, 2, 3, 4, 5, 6, 7, 8, 9, 10, 11, 99, -1};
        for (int i = 0; i < (MK_SINGLE ? 14 : 13); ++i) { if (MK_SINGLE && ids[i] != -1) continue;
            if (hipFuncSetAttribute((const void*)kern_of(ids[i]), hipFuncAttributeMaxDynamicSharedMemorySize, LDS_BYTES) != hipSuccess) { fprintf(stderr, "kernel_launch: hipFuncSetAttribute failed (%d)\n", ids[i]); ready = -1; return; } }
        ready = 1;
    }
    if (ready < 0) return;
    (void)hipMemsetAsync((char*)d_ws + WS_CTL, 0, CTL_ZERO_BYTES, stream);
    Args a{};
    for (int i = 0; i < 31; ++i) a.in[i] = (const float*)d_in[i];
    a.out = (float*)d_out; a.ws = (unsigned char*)d_ws; a.pad = 0;
#if MK_SINGLE
    a.ph_lo = 0; a.ph_hi = PH_TOTAL; a.use_bar = 1;
    hipLaunchKernelGGL(kern_of(-1), dim3(NWG), dim3(NTHR), LDS_BYTES, stream, a);
#else
    for (int p = 0; p < PH_TOTAL; ++p) { a.ph_lo = p; a.ph_hi = p + 1; a.use_bar = 0;
        const int j = (p - 1) % NPL; const int o = (p == 0) ? 0 : (p == PH_TOTAL - 1) ? 99 : (j < 3 ? 1 + j : j == 3 ? 11 : j);
        hipLaunchKernelGGL(kern_of(o), dim3(NWG), dim3(NTHR), LDS_BYTES, stream, a); }
#endif
}
```

```cpp
#include <hip/hip_runtime.h>
#include <cstdio>
#include <cstdint>

#define LAS __attribute__((address_space(3)))
typedef unsigned short bf16;
typedef float f32x4 __attribute__((ext_vector_type(4)));
typedef float f32x2 __attribute__((ext_vector_type(2)));
typedef short bf16x8 __attribute__((ext_vector_type(8)));
typedef unsigned u32x4 __attribute__((ext_vector_type(4)));
typedef unsigned u32x2 __attribute__((ext_vector_type(2)));

constexpr int DM = 1024, SEQ = 16384, NCTX = 256, ROWS = SEQ + NCTX, DEPTH = 4, GRIDW = 64;
constexpr int INW = 2720, INWP = 2816;
constexpr int C_AQ = 0, C_AK = 256, C_AV = 384, C_BU = 512, C_CQ = 768, C_CK = 1024, C_CV = 1280, C_DR = 1536, C_DK = 1792, C_DV = 2048, C_WL = 2304, C_AL = 2432, C_GL = 2560;
constexpr int NEXP = 32, TOPK = 4;
constexpr int MOE_MAXBLK = 296;
constexpr int MOE_ROWS = MOE_MAXBLK * 256;
constexpr int NWG = 256, NTHR = 512, NWAVES = 8;
constexpr int VTP = ROWS + 256;

constexpr size_t MiB = 1u << 20;
constexpr size_t WS_CTL = 0, CTL_ZERO_BYTES = 1 * MiB;
constexpr size_t WS_MOD = 1 * MiB;
constexpr size_t WS_TW = 2 * MiB;
constexpr size_t WS_MTAB = 3 * MiB;
constexpr size_t WS_XS = 4 * MiB;
constexpr size_t WS_H = 70 * MiB;
constexpr size_t WS_P = 104 * MiB;
constexpr size_t WS_MIX = 194 * MiB;
constexpr size_t WS_FYR = 228 * MiB, WS_FYI = 244 * MiB;
constexpr size_t WS_VTA = 1544 * MiB, WS_VTC = 1550 * MiB;
constexpr size_t WS_SC = 260 * MiB;
constexpr size_t WS_YS = 408 * MiB;
constexpr size_t WS_ROUTE = 442 * MiB;
constexpr size_t WS_CNT = 444 * MiB;
constexpr size_t WS_XG = 446 * MiB;
constexpr size_t WS_ACT = 596 * MiB;
constexpr size_t WS_WIN = 746 * MiB;
constexpr size_t WS_WOUT = 768 * MiB;
constexpr size_t WS_WGU = 776 * MiB;
constexpr size_t WS_WDN = 1288 * MiB;
constexpr size_t WS_RPP = 1560 * MiB, WS_PSC = 1578 * MiB, WS_LSC = 1580 * MiB, WS_HSC = 1584 * MiB;
constexpr size_t WS_FTAB = 1586 * MiB;
constexpr size_t WS_G2T = 1588 * MiB, WS_RWT = 1589 * MiB;
constexpr size_t WS_END = 1590 * MiB;
static_assert(WS_XS + (size_t)ROWS * DM * 4 <= WS_H && WS_H + (size_t)ROWS * DM * 2 <= WS_P && WS_P + (size_t)ROWS * INWP * 2 <= WS_MIX && WS_MIX + (size_t)ROWS * DM * 2 <= WS_FYR, "ws map 1");
static_assert(WS_SC + (size_t)ROWS * 9 * 256 * 4 <= WS_YS && WS_YS + (size_t)2 * ROWS * 256 * 4 <= WS_ROUTE && WS_XG + (size_t)MOE_ROWS * DM * 2 <= WS_ACT && WS_ACT + (size_t)MOE_ROWS * DM * 2 <= WS_WIN, "ws map 2");
static_assert(WS_WIN + (size_t)4 * INWP * DM * 2 <= WS_WOUT && WS_WGU + (size_t)4 * 32 * 2048 * 1024 * 2 <= WS_WDN && WS_WDN + (size_t)4 * 32 * 1024 * 1024 * 2 <= WS_END, "ws map 3");
constexpr int CW_BAR = 4096;

constexpr int RING_BYTES = 131072;
constexpr int MISC_OFF = 143360;
constexpr int LDS_BYTES = 147456;

__device__ __forceinline__ unsigned f2bf(float f) { unsigned u = __builtin_bit_cast(unsigned, f); return (u + 0x7fffu + ((u >> 16) & 1u)) >> 16; }
__device__ __forceinline__ unsigned pk2(float lo, float hi) { return f2bf(lo) | (f2bf(hi) << 16); }
__device__ __forceinline__ float bf2f(unsigned short b) { return __builtin_bit_cast(float, (unsigned)b << 16); }
__device__ __forceinline__ float bflo(unsigned w) { return __builtin_bit_cast(float, w << 16); }
__device__ __forceinline__ float bfhi(unsigned w) { return __builtin_bit_cast(float, w & 0xffff0000u); }
__device__ __forceinline__ float shx(float v, int o, int lane) { return __builtin_bit_cast(float, __builtin_amdgcn_ds_bpermute((lane ^ o) << 2, __builtin_bit_cast(int, v))); }
__device__ __forceinline__ int shxi(int v, int o, int lane) { return __builtin_amdgcn_ds_bpermute((lane ^ o) << 2, v); }
__device__ __forceinline__ float wave_sum(float v, int lane) {
#pragma unroll
    for (int o = 1; o < 64; o <<= 1) v += shx(v, o, lane);
    return v;
}
__device__ __forceinline__ float sigmoidf_(float x) { return 1.f / (1.f + __expf(-x)); }
#define LDS_WAIT() asm volatile("s_waitcnt lgkmcnt(0)" ::: "memory")
#define VM_WAIT() asm volatile("s_waitcnt vmcnt(0)" ::: "memory")

namespace pg8 {
#define PG8_LAS __attribute__((address_space(3)))
typedef unsigned short bf16_t;
constexpr int BM = 256, BK = 64, HALF = 128, HTB = HALF * BK * 2, STAGE_BYTES = 8 * HTB, NXCD = 8, WGM = 8;
__host__ __device__ __forceinline__ int lds_byte(int r, int c) { const int st = (r >> 4) * 2 + (c >> 5), rr = r & 15, cc = c & 31, ob = rr * 64 + cc * 2; return st * 1024 + (ob ^ (((ob >> 9) & 1) << 5)); }
__host__ __device__ __forceinline__ void stage_rc(int b, int& R, int& C) { const int st = b / 1024, sb = b % 1024, swz = sb ^ (((sb >> 9) & 1) << 5); R = (st >> 1) * 16 + swz / 64; C = (st & 1) * 32 + (swz % 64) / 2; }
__host__ __device__ __forceinline__ int perm32(int rho) { const int n = rho >> 4, i = rho & 15; return 8 * (i >> 2) + 4 * n + (i & 3); }
struct Unit { int pm, pn, e; };
__device__ __forceinline__ unsigned cvt_pk_bf16(float lo, float hi) { unsigned r; asm volatile("v_cvt_pk_bf16_f32 %0, %1, %2" : "=v"(r) : "v"(lo), "v"(hi)); return r; }

struct StaticOrder {
    const char* A; const char* Bt; size_t tstep;
    int nM, nN, nwg, G, c;
    __device__ void init(const void* A_, const void* Bt_, int M, int N, int K, int G_, int c_) { A = (const char*)A_; Bt = (const char*)Bt_; tstep = (size_t)BM * K * 2; nM = M / BM; nN = N / BM; nwg = nM * nN; G = G_; c = c_; }
    __device__ bool next(int i, Unit& u) const {
        const long L = (long)i * G + c; if (L >= nwg) return false;
        int wgid = (int)L; { const int q = nwg / NXCD, r = nwg % NXCD, xcd = wgid % NXCD, off = wgid / NXCD; wgid = (xcd < r ? xcd * (q + 1) : r * (q + 1) + (xcd - r) * q) + off; }
        const int nig = WGM * nN, gid = wgid / nig, fm = gid * WGM, gsz = (nM - fm) < WGM ? (nM - fm) : WGM;
        u.pm = fm + ((wgid % nig) % gsz); u.pn = (wgid % nig) / gsz; u.e = 0; return true;
    }
    __device__ __forceinline__ const char* pa(const Unit& u) const { return A + (size_t)u.pm * tstep; }
    __device__ __forceinline__ const char* pb(const Unit& u) const { return Bt + (size_t)u.pn * tstep; }
};
struct MoeOrder {
    const char* A; const char* Bt; size_t tstep, estep;
    const LAS unsigned char* blk_e; int nblk, nN, G, c;
    __device__ bool next(int i, Unit& u) const {
        const int L = i * G + c; if (L >= nblk * nN) return false;
        u.pm = L / nN; u.pn = L % nN; u.e = __builtin_amdgcn_readfirstlane((int)blk_e[u.pm]); return true;
    }
    __device__ __forceinline__ const char* pa(const Unit& u) const { return A + (size_t)u.pm * tstep; }
    __device__ __forceinline__ const char* pb(const Unit& u) const { return Bt + (size_t)u.e * estep + (size_t)u.pn * tstep; }
};

struct EpiStoreBf16 {
    static constexpr bool PERM = true;
    bf16_t* O; int ldc; const float* bias; int bias_estride;
    __device__ __forceinline__ void init(f32x4 (&acc)[2][2][4][2], const Unit& u, int wc, int fq) const {
        const int col0 = u.pn * BM + wc * 32 + 8 * fq;
#pragma unroll
        for (int b = 0; b < 2; ++b)
#pragma unroll
            for (int n = 0; n < 2; ++n) { const f32x4 bv = bias ? *(const f32x4*)(bias + (size_t)u.e * bias_estride + col0 + b * HALF + 4 * n) : (f32x4){0.f, 0.f, 0.f, 0.f};
#pragma unroll
                for (int a = 0; a < 2; ++a)
#pragma unroll
                    for (int m = 0; m < 4; ++m) acc[a][b][m][n] = bv; }
    }
    __device__ __forceinline__ void operator()(const f32x4 (&acc)[2][2][4][2], const Unit& u, int wr, int wc, int fr, int fq) const {
        const int row0 = u.pm * BM + wr * 64 + fr, col0 = u.pn * BM + wc * 32 + 8 * fq;
#pragma unroll
        for (int ai = 0; ai < 2; ++ai)
#pragma unroll
            for (int m = 0; m < 4; ++m) { bf16_t* rowp = O + (size_t)(row0 + ai * HALF + m * 16) * ldc + col0;
#pragma unroll
                for (int bj = 0; bj < 2; ++bj) { const f32x4 v0 = acc[ai][bj][m][0], v1 = acc[ai][bj][m][1];
                    u32x4 w; w.x = cvt_pk_bf16(v0[0], v0[1]); w.y = cvt_pk_bf16(v0[2], v0[3]); w.z = cvt_pk_bf16(v1[0], v1[1]); w.w = cvt_pk_bf16(v1[2], v1[3]);
                    *(u32x4*)(rowp + bj * HALF) = w; } }
    }
};
__device__ __forceinline__ float swiglu1(float g, float up) {
    g = fminf(g, 7.0f); up = fminf(fmaxf(up, -7.0f), 7.0f);
    return g * (1.f / (1.f + __expf(-1.702f * g))) * (up + 1.0f);
}
struct EpiSwiglu {
    static constexpr bool PERM = true;
    bf16_t* O; int ldc; const float* bias; int bias_estride;
    __device__ __forceinline__ void init(f32x4 (&acc)[2][2][4][2], const Unit& u, int wc, int fq) const {
        const int col0 = u.pn * BM + wc * 32 + 8 * fq;
#pragma unroll
        for (int b = 0; b < 2; ++b)
#pragma unroll
            for (int n = 0; n < 2; ++n) { const f32x4 bv = bias ? *(const f32x4*)(bias + (size_t)u.e * bias_estride + col0 + b * HALF + 4 * n) : (f32x4){0.f, 0.f, 0.f, 0.f};
#pragma unroll
                for (int a = 0; a < 2; ++a)
#pragma unroll
                    for (int m = 0; m < 4; ++m) acc[a][b][m][n] = bv; }
    }
    __device__ __forceinline__ void operator()(const f32x4 (&acc)[2][2][4][2], const Unit& u, int wr, int wc, int fr, int fq) const {
        const int row0 = u.pm * BM + wr * 64 + fr, col0 = u.pn * BM + wc * 32 + 8 * fq;
#pragma unroll
        for (int ai = 0; ai < 2; ++ai)
#pragma unroll
            for (int m = 0; m < 4; ++m) { bf16_t* rowp = O + (size_t)(row0 + ai * HALF + m * 16) * ldc + (col0 >> 1);
#pragma unroll
                for (int bj = 0; bj < 2; ++bj) { const f32x4 v0 = acc[ai][bj][m][0], v1 = acc[ai][bj][m][1];
                    u32x2 w; w.x = cvt_pk_bf16(swiglu1(v0[0], v0[1]), swiglu1(v0[2], v0[3])); w.y = cvt_pk_bf16(swiglu1(v1[0], v1[1]), swiglu1(v1[2], v1[3]));
                    *(u32x2*)(rowp + bj * (HALF / 2)) = w; } }
    }
};
struct EpiResidual {
    static constexpr bool PERM = false;
    float* X; int ldc; const float* gate_lat; const float* gate_ctx;
    __device__ __forceinline__ void init(f32x4 (&acc)[2][2][4][2], const Unit& u, int wc, int fq) const {
#pragma unroll
        for (int a = 0; a < 2; ++a)
#pragma unroll
            for (int b = 0; b < 2; ++b)
#pragma unroll
                for (int m = 0; m < 4; ++m)
#pragma unroll
                    for (int n = 0; n < 2; ++n) acc[a][b][m][n] = (f32x4){0.f, 0.f, 0.f, 0.f};
    }
    __device__ __forceinline__ void operator()(const f32x4 (&acc)[2][2][4][2], const Unit& u, int wr, int wc, int fr, int fq) const {
        const int row0 = u.pm * BM + wr * 64 + fr, col0 = u.pn * BM + wc * 32 + 4 * fq;
        const float* gp = (u.pm == 0) ? gate_ctx : gate_lat;
        f32x4 gv[2][2];
#pragma unroll
        for (int bj = 0; bj < 2; ++bj)
#pragma unroll
            for (int n = 0; n < 2; ++n) gv[bj][n] = *(const f32x4*)(gp + col0 + bj * HALF + n * 16);
#pragma unroll
        for (int ai = 0; ai < 2; ++ai)
#pragma unroll
            for (int m = 0; m < 4; ++m) { float* rowp = X + (size_t)(row0 + ai * HALF + m * 16) * ldc + col0;
#pragma unroll
                for (int bj = 0; bj < 2; ++bj)
#pragma unroll
                    for (int n = 0; n < 2; ++n) { f32x4* p = (f32x4*)(rowp + bj * HALF + n * 16); *p = *p + gv[bj][n] * acc[ai][bj][m][n]; }
                asm volatile("" ::: "memory"); }
    }
};
template <class Epi, class Sched, bool ALIGN_EPI = false, bool SP2 = false>
__device__ __forceinline__ void gemm_phase(PG8_LAS unsigned char* lds, const int tid, const int K, const Sched& S, const Epi& E) {
    const int wid = __builtin_amdgcn_readfirstlane(tid >> 6), lane = tid & 63, wr = wid >> 2, wc = wid & 3, fr = lane & 15, fq = lane >> 4;
    const int nt = K / BK;
    unsigned voffA[2], voffB[2];
#pragma unroll
    for (int i = 0; i < 2; ++i) { int R, C; stage_rc(tid * 16 + i * 8192, R, C); const int Rb = Epi::PERM ? ((R & ~31) + perm32(R & 31)) : R;
        voffA[i] = (unsigned)(R * K + C) * 2u; voffB[i] = (unsigned)(Rb * K + C) * 2u; }
    const size_t kstep = (size_t)(BK * 2);
    const size_t hstep = (size_t)HALF * K * 2;
        const unsigned ldsw = (unsigned)wid * 1024u;
    const int aoff = lds_byte(wr * 64 + fr, fq * 8), boff = lds_byte(wc * 32 + fr, fq * 8);
#define PG8_SA(b, h) (((b) * 2 + (h)) * HTB)
#define PG8_SB(b, h) ((4 + (b) * 2 + (h)) * HTB)
#define PG8_STAGE(bufoff, gbase, voff) do { _Pragma("unroll") for (int _i = 0; _i < 2; ++_i) \
        __builtin_amdgcn_global_load_lds((const unsigned*)((const char*)(gbase) + (voff)[_i]), (PG8_LAS unsigned*)(lds + (bufoff) + ldsw + _i * 8192), 16, 0, 0); } while (0)
#define PG8_LDA(dst, b, h) do { _Pragma("unroll") for (int m = 0; m < 4; ++m) _Pragma("unroll") for (int k = 0; k < 2; ++k) dst[m][k] = *(const PG8_LAS bf16x8*)(lds + PG8_SA(b, h) + aoff + m * 2048 + k * 1024); } while (0)
#define PG8_LDB(dst, b, h) do { _Pragma("unroll") for (int n = 0; n < 2; ++n) _Pragma("unroll") for (int k = 0; k < 2; ++k) dst[n][k] = *(const PG8_LAS bf16x8*)(lds + PG8_SB(b, h) + boff + n * 2048 + k * 1024); } while (0)
#define PG8_MMA(ai, bj, At, Bt) do { __builtin_amdgcn_s_setprio(1); _Pragma("unroll") for (int m = 0; m < 4; ++m) _Pragma("unroll") for (int n = 0; n < 2; ++n) _Pragma("unroll") for (int k = 0; k < 2; ++k) \
        acc[ai][bj][m][n] = __builtin_amdgcn_mfma_f32_16x16x32_bf16(Bt[n][k], At[m][k], acc[ai][bj][m][n], 0, 0, 0); __builtin_amdgcn_s_setprio(0); } while (0)
#define PG8_WAIT_V(n) asm volatile("s_waitcnt vmcnt(" #n ")" ::: "memory")
#define PG8_WAIT_L(n) asm volatile("s_waitcnt lgkmcnt(" #n ")" ::: "memory")
#define PG8_BAR __builtin_amdgcn_s_barrier()
#define PG8_SCHED __builtin_amdgcn_sched_barrier(0)
    Unit cur, nxt; int ui = 0;
    if (!S.next(0, cur)) return;
    f32x4 acc[2][2][4][2];
    E.init(acc, cur, wc, fq);
    bf16x8 At[4][2], B0[2][2], B1[2][2];
    const char* cA = S.pa(cur); const char* cB = S.pb(cur);
    if constexpr (SP2) {
        PG8_STAGE(PG8_SB(0, 0), cB, voffB); PG8_STAGE(PG8_SB(0, 1), cB + hstep, voffB); PG8_STAGE(PG8_SA(0, 0), cA, voffA); PG8_STAGE(PG8_SA(0, 1), cA + hstep, voffA);
        if (wr == 1) PG8_BAR;
        PG8_WAIT_V(2); PG8_BAR;
        PG8_STAGE(PG8_SB(1, 0), cB + kstep, voffB); PG8_STAGE(PG8_SA(1, 0), cA + kstep, voffA); PG8_STAGE(PG8_SB(1, 1), cB + hstep + kstep, voffB);
        PG8_WAIT_V(6); PG8_BAR;
    } else {
        PG8_STAGE(PG8_SB(0, 0), cB, voffB); PG8_STAGE(PG8_SA(0, 0), cA, voffA); PG8_STAGE(PG8_SB(0, 1), cB + hstep, voffB); PG8_STAGE(PG8_SA(0, 1), cA + hstep, voffA);
        if (wr == 1) PG8_BAR;
        PG8_WAIT_V(4); PG8_BAR;
        PG8_STAGE(PG8_SB(1, 0), cB + kstep, voffB); PG8_STAGE(PG8_SA(1, 0), cA + kstep, voffA); PG8_STAGE(PG8_SB(1, 1), cB + hstep + kstep, voffB);
        PG8_WAIT_V(6); PG8_BAR;
    }
    for (;;) {
        const bool has_next = S.next(ui + 1, nxt);
        const char* nA = has_next ? S.pa(nxt) : cA; const char* nB = has_next ? S.pb(nxt) : cB;
        for (int t = 0; t < nt; t += 2) {
            const bool last = (t == nt - 2);
            const char* a1 = cA + (size_t)(t + 1) * kstep;
            const char* a2 = last ? nA : cA + (size_t)(t + 2) * kstep; const char* b2 = last ? nB : cB + (size_t)(t + 2) * kstep;
            const char* a3 = a2 + kstep; const char* b3 = b2 + kstep;
            if constexpr (SP2) {
            PG8_LDB(B0, 0, 0); PG8_LDB(B1, 0, 1); PG8_SCHED; PG8_LDA(At, 0, 0); PG8_STAGE(PG8_SA(1, 1), a1 + hstep, voffA);
            PG8_WAIT_V(8); PG8_WAIT_L(0); PG8_BAR; PG8_MMA(0, 0, At, B0); PG8_MMA(0, 1, At, B1); PG8_BAR; PG8_SCHED;
            PG8_LDA(At, 0, 1); PG8_STAGE(PG8_SB(0, 0), b2, voffB); PG8_STAGE(PG8_SB(0, 1), b2 + hstep, voffB); PG8_STAGE(PG8_SA(0, 0), a2, voffA);
            PG8_WAIT_V(8); PG8_WAIT_L(0); PG8_BAR; PG8_MMA(1, 0, At, B0); PG8_MMA(1, 1, At, B1); PG8_BAR; PG8_SCHED;
            PG8_LDB(B0, 1, 0); PG8_LDB(B1, 1, 1); PG8_SCHED; PG8_LDA(At, 1, 0); PG8_STAGE(PG8_SA(0, 1), a2 + hstep, voffA);
            PG8_WAIT_V(8); PG8_WAIT_L(0); PG8_BAR; PG8_MMA(0, 0, At, B0); PG8_MMA(0, 1, At, B1); PG8_BAR; PG8_SCHED;
            PG8_LDA(At, 1, 1); PG8_STAGE(PG8_SB(1, 0), b3, voffB); PG8_STAGE(PG8_SB(1, 1), b3 + hstep, voffB); PG8_STAGE(PG8_SA(1, 0), a3, voffA);
            PG8_WAIT_V(8); PG8_WAIT_L(0); PG8_BAR; PG8_MMA(1, 0, At, B0); PG8_MMA(1, 1, At, B1); PG8_BAR; PG8_SCHED;
            } else {
            PG8_LDB(B0, 0, 0); PG8_SCHED; PG8_LDA(At, 0, 0); PG8_STAGE(PG8_SA(1, 1), a1 + hstep, voffA);
            PG8_WAIT_L(8); PG8_BAR; PG8_WAIT_L(0); PG8_MMA(0, 0, At, B0); PG8_BAR; PG8_SCHED;
            PG8_LDB(B1, 0, 1); PG8_STAGE(PG8_SB(0, 0), b2, voffB);
            PG8_BAR; PG8_WAIT_L(0); PG8_MMA(0, 1, At, B1); PG8_BAR;
            PG8_LDA(At, 0, 1); PG8_STAGE(PG8_SA(0, 0), a2, voffA);
            PG8_BAR; PG8_WAIT_L(0); PG8_MMA(1, 0, At, B0); PG8_BAR; PG8_SCHED;
            PG8_STAGE(PG8_SB(0, 1), b2 + hstep, voffB);
            PG8_WAIT_V(6); PG8_BAR; PG8_MMA(1, 1, At, B1); PG8_BAR;
            PG8_LDB(B0, 1, 0); PG8_SCHED; PG8_LDA(At, 1, 0); PG8_STAGE(PG8_SA(0, 1), a2 + hstep, voffA);
            PG8_WAIT_L(8); PG8_BAR; PG8_WAIT_L(0); PG8_MMA(0, 0, At, B0); PG8_BAR; PG8_SCHED;
            PG8_LDB(B1, 1, 1); PG8_STAGE(PG8_SB(1, 0), b3, voffB);
            PG8_BAR; PG8_WAIT_L(0); PG8_MMA(0, 1, At, B1); PG8_BAR;
            PG8_LDA(At, 1, 1); PG8_STAGE(PG8_SA(1, 0), a3, voffA);
            PG8_BAR; PG8_WAIT_L(0); PG8_MMA(1, 0, At, B0); PG8_BAR; PG8_SCHED;
            PG8_STAGE(PG8_SB(1, 1), b3 + hstep, voffB);
            PG8_WAIT_V(6); PG8_BAR; PG8_MMA(1, 1, At, B1); PG8_BAR;
            }
        }
        if constexpr (ALIGN_EPI) { if (wr == 0) PG8_BAR; }
        E(acc, cur, wr, wc, fr, fq);
        if (!has_next) break;
        E.init(acc, nxt, wc, fq);
        cur = nxt; cA = nA; cB = nB; ++ui;
        if constexpr (ALIGN_EPI) { if (wr == 1) PG8_BAR; }
    }
    PG8_WAIT_V(0);
    if constexpr (!ALIGN_EPI) { if (wr == 0) PG8_BAR; }
    PG8_BAR;
#undef PG8_SA
#undef PG8_SB
#undef PG8_STAGE
#undef PG8_LDA
#undef PG8_LDB
#undef PG8_MMA
#undef PG8_WAIT_V
#undef PG8_WAIT_L
#undef PG8_BAR
#undef PG8_SCHED
}
}

#define XB_TMO      128
#define XB_XCNT(j)  (256  + 64 * (j))
#define XB_XSUB(j)  (1280 + 64 * (j))
#define XB_XGEN(j)  (2304 + 64 * (j))
#define XB_TOP      3328
#define XB_TOPGEN   3392
#define XCD_BAR_WORDS 3456
#define XB_SPIN_CAP (1u << 18)
__device__ __forceinline__ unsigned xb_ld(unsigned* p)              { return __hip_atomic_load(p, __ATOMIC_RELAXED, __HIP_MEMORY_SCOPE_AGENT); }
__device__ __forceinline__ unsigned xb_add(unsigned* p, unsigned v) { return __hip_atomic_fetch_add(p, v, __ATOMIC_RELAXED, __HIP_MEMORY_SCOPE_AGENT); }
__device__ __forceinline__ unsigned xb_xcc_id() { return (unsigned)__builtin_amdgcn_s_getreg((3 << 11) | 20) & 0xFu; }
#define XB_SPIN(cond, bar) do { unsigned _sp = 0; while (cond) { __builtin_amdgcn_s_sleep(1); \
    if ((++_sp & 255u) == 0u) { if (xb_ld(&(bar)[XB_TMO])) break; if (_sp > XB_SPIN_CAP) { atomicAdd(&(bar)[XB_TMO], 1u); break; } } } } while (0)

struct XcdBarrier {
    unsigned* bar; unsigned x;
    volatile LAS unsigned* st;
};

__device__ __forceinline__ XcdBarrier xcd_barrier_post(unsigned* bar, volatile LAS unsigned* st) {
    XcdBarrier b; b.bar = bar; b.x = xb_xcc_id(); b.st = st;
    if (threadIdx.x == 0) (void)xb_add(&bar[XB_XCNT(b.x)], 1u);
    return b;
}
__device__ __forceinline__ void xcd_barrier_complete(unsigned* bar, unsigned x, unsigned& nloc, unsigned& nx) {
    const unsigned G = gridDim.x * gridDim.y * gridDim.z;
    unsigned sum, cnt, mine, sp = 0u;
    for (;;) {
        sum = 0u; cnt = 0u; mine = 0u;
#pragma unroll
        for (unsigned j = 0; j < 16; ++j) { const unsigned c = xb_ld(&bar[XB_XCNT(j)]); sum += c; cnt += (c > 0u) ? 1u : 0u; mine = (j == x) ? c : mine; }
        if (sum == G) break;
        __builtin_amdgcn_s_sleep(1);
        if ((++sp & 255u) == 0u) { if (xb_ld(&bar[XB_TMO])) break; if (sp > XB_SPIN_CAP) { atomicAdd(&bar[XB_TMO], 1u); break; } }
    }
    nloc = mine > 0u ? mine : 1u; nx = cnt > 0u ? cnt : 1u;
}

__device__ __forceinline__ void xcd_barrier(const XcdBarrier& b) {
    asm volatile("s_waitcnt vmcnt(0)" ::: "memory");
    __syncthreads();
    if (threadIdx.x == 0) {
        unsigned* bar = b.bar;
        __builtin_amdgcn_s_waitcnt(0);
        unsigned nloc = b.st[0], nx = b.st[1];
        if (nloc == 0u) { xcd_barrier_complete(bar, b.x, nloc, nx); b.st[0] = nloc; b.st[1] = nx; }
        const unsigned old = xb_add(&bar[XB_XSUB(b.x)], 1u);
        const unsigned gen = old / nloc;
        if (old + 1u == (gen + 1u) * nloc) {
            __builtin_amdgcn_fence(__ATOMIC_RELEASE, "agent");
            asm volatile("s_waitcnt vmcnt(0)" ::: "memory");
            const unsigned og = xb_add(&bar[XB_TOP], 1u);
            const unsigned tg = og / nx;
            if (og + 1u == (tg + 1u) * nx) xb_add(&bar[XB_TOPGEN], 1u);
            else XB_SPIN(xb_ld(&bar[XB_TOPGEN]) == tg, bar);
            __builtin_amdgcn_fence(__ATOMIC_ACQUIRE, "agent");
            xb_add(&bar[XB_XGEN(b.x)], 1u);
            asm volatile("s_waitcnt vmcnt(0)" ::: "memory");
        } else {
            XB_SPIN(xb_ld(&bar[XB_XGEN(b.x)]) == gen, bar);
            __builtin_amdgcn_fence(__ATOMIC_ACQUIRE, "agent");
            asm volatile("s_waitcnt vmcnt(0)" ::: "memory");
        }
    }
    __syncthreads();
}

typedef short s4v __attribute__((ext_vector_type(4)));
__device__ __forceinline__ f32x4 mfma16(bf16x8 a, bf16x8 b, f32x4 c) { return __builtin_amdgcn_mfma_f32_16x16x32_bf16(a, b, c, 0, 0, 0); }
__device__ __forceinline__ bf16x8 ldA(const LAS unsigned char* base, int pitch, int row0, int k0, int li, int g) { return *(const LAS bf16x8*)(base + ((row0 + li) * pitch + k0 + 8 * g) * 2); }
__device__ __forceinline__ bf16x8 ldT(const LAS unsigned char* base, int pitch, int k0, int n0, int li, int g) {
    const LAS unsigned char* p = base + ((k0 + 8 * g + (li >> 2)) * pitch + n0 + 4 * (li & 3)) * 2;
    const s4v a = __builtin_amdgcn_ds_read_tr16_b64_v4i16((LAS s4v*)p), b = __builtin_amdgcn_ds_read_tr16_b64_v4i16((LAS s4v*)(p + 8 * pitch));
    return (bf16x8){a[0], a[1], a[2], a[3], b[0], b[1], b[2], b[3]};
}
__device__ __forceinline__ bf16x8 ldAperm(const LAS unsigned char* base, int pitch, int row0, int ks, int li, int g) {
    const LAS unsigned char* p = base + ((row0 + li) * pitch + 32 * ks + 4 * g) * 2;
    const s4v a = *(const LAS s4v*)p, b = *(const LAS s4v*)(p + 32);
    return (bf16x8){a[0], a[1], a[2], a[3], b[0], b[1], b[2], b[3]};
}
__device__ __forceinline__ void stT(LAS unsigned char* base, int pitch, int n, int m0, const f32x4 v) {
    u32x2 w; w.x = pk2(v[0], v[1]); w.y = pk2(v[2], v[3]); *(LAS u32x2*)(base + (n * pitch + m0) * 2) = w;
}
__device__ __forceinline__ f32x4 ld4bf(const LAS unsigned char* p) { const u32x2 w = *(const LAS u32x2*)p; return (f32x4){bflo(w.x), bfhi(w.x), bflo(w.y), bfhi(w.y)}; }

struct Args {
    const float* in[31];
    float* out; unsigned char* ws;
    int ph_lo, ph_hi, use_bar, pad;
};
enum InIdx { I_X = 0, I_C, I_CTX, I_CCTX, I_ADAW, I_ADAB, I_N1G, I_N2G, I_WIN, I_WOUT, I_ASINK, I_BMIX, I_CREL, I_DCONV, I_DW0, I_DW2, I_DA0, I_DA2, I_DG2, I_DKK, I_DKA, I_DRK, I_DLNW, I_DLNB,
             I_RW, I_RB, I_WGU, I_BGU, I_WDN, I_BDN, I_FNG };
constexpr int NPL = 11;
constexpr int PH_TOTAL = 1 + DEPTH * NPL + 1;

struct DevIn {
    const LAS unsigned* tab;
    __device__ __forceinline__ const float* operator[](int i) const {
        const unsigned lo = __builtin_amdgcn_readfirstlane(((const volatile LAS unsigned*)tab)[2 * i]), hi = __builtin_amdgcn_readfirstlane(((const volatile LAS unsigned*)tab)[2 * i + 1]);
        return (const float*)(((unsigned long long)hi << 32) | lo);
    }
};
struct DArgs { DevIn in; float* out; };
struct Ctx {
    LAS unsigned char* lds;
    int tid, lane, wave, wg, G, gw, NGW;
    unsigned char* ws;
};

template <int NW>
__device__ __forceinline__ void transpose_item(const float* W, int K, int N, bf16* WT, int item, int lane) {
    constexpr int NQ = NW / 4, NC = 64 / NQ, PASSES = 8 / NC;
    const int nblk = N / NW, kb = item / nblk, nb = item % nblk, k0 = 64 * kb, n0 = NW * nb, nq = lane % NQ, cq = lane / NQ;
    f32x4 v[PASSES][8];
#pragma unroll
    for (int ps = 0; ps < PASSES; ++ps)
#pragma unroll
        for (int i = 0; i < 8; ++i) v[ps][i] = *(const f32x4*)(W + (size_t)(k0 + 8 * (cq + NC * ps) + i) * N + n0 + 4 * nq);
#pragma unroll
    for (int ps = 0; ps < PASSES; ++ps)
#pragma unroll
        for (int j = 0; j < 4; ++j) { u32x4 o; o.x = pk2(v[ps][0][j], v[ps][1][j]); o.y = pk2(v[ps][2][j], v[ps][3][j]); o.z = pk2(v[ps][4][j], v[ps][5][j]); o.w = pk2(v[ps][6][j], v[ps][7][j]);
            *(u32x4*)(WT + (size_t)(n0 + 4 * nq + j) * K + k0 + 8 * (cq + NC * ps)) = o; }
}
__device__ __forceinline__ void phase_prologue(const Ctx& C, const DArgs& a) {
    constexpr int IT_IN = 16 * (INW / 32), IT_OUT = 16 * 16, IT_GU = 16 * 32, IT_DN = 16 * 16;
    constexpr long N_IN = 4L * IT_IN, N_OUT = 4L * IT_OUT, N_GU = 128L * IT_GU, N_DN = 128L * IT_DN, N_ALL = N_IN + N_OUT + N_GU + N_DN;
    const float* pwin = a.in[I_WIN]; const float* pwout = a.in[I_WOUT]; const float* pwgu = a.in[I_WGU]; const float* pwdn = a.in[I_WDN];
    for (long it = C.gw; it < N_ALL; it += C.NGW) {
        long r = it;
        if (r < N_IN) { const int l = (int)(r / IT_IN); transpose_item<32>(pwin + (size_t)l * DM * INW, DM, INW, (bf16*)(C.ws + WS_WIN) + (size_t)l * INWP * DM, (int)(r % IT_IN), C.lane); continue; } r -= N_IN;
        if (r < N_OUT) { const int l = (int)(r / IT_OUT); transpose_item<64>(pwout + (size_t)l * DM * DM, DM, DM, (bf16*)(C.ws + WS_WOUT) + (size_t)l * DM * DM, (int)(r % IT_OUT), C.lane); continue; } r -= N_OUT;
        if (r < N_GU) { const int le = (int)(r / IT_GU); transpose_item<64>(pwgu + (size_t)le * DM * 2048, DM, 2048, (bf16*)(C.ws + WS_WGU) + (size_t)le * 2048 * DM, (int)(r % IT_GU), C.lane); continue; } r -= N_GU;
        { const int le = (int)(r / IT_DN); transpose_item<64>(pwdn + (size_t)le * DM * DM, DM, DM, (bf16*)(C.ws + WS_WDN) + (size_t)le * DM * DM, (int)(r % IT_DN), C.lane); }
    }
    { const int gt = C.wg * NTHR + C.tid; constexpr int PADN = (INWP - INW) * DM / 8;
      for (int i = gt; i < 4 * PADN; i += C.G * NTHR) { const int l = i / PADN, r = i % PADN; *((u32x4*)((bf16*)(C.ws + WS_WIN) + ((size_t)l * INWP + INW) * DM) + r) = (u32x4){0u, 0u, 0u, 0u}; } }
    { float* tw = (float*)(C.ws + WS_TW); const int gt = C.wg * NTHR + C.tid;
      for (int i = gt; i < 16384; i += C.G * NTHR) { const float x = (float)i * (1.0f / 8192.0f); tw[i] = cospif(x); tw[16384 + i] = sinpif(x); } }
    { float* mt = (float*)(C.ws + WS_MTAB); const int gt = C.wg * NTHR + C.tid; const float* pbmix = a.in[I_BMIX];
      for (int i = gt; i < 4 * 4 * 64 * 64; i += C.G * NTHR) { const int e = i & 63, c = (i >> 6) & 63, g = (i >> 12) & 3, l = i >> 14;
          const float* w = pbmix + ((size_t)(l * 4 + g) * 64) * 64 + e; float sc = 0.f, ss = 0.f;
          for (int cp = 0; cp < 64; ++cp) { const float x = (float)((c * cp) & 63) * (1.0f / 32.0f); const float wv = w[cp * 64]; sc += cospif(x) * wv; ss += sinpif(x) * wv; }
          mt[((size_t)(l * 2 + 0) * 4 + g) * 4096 + c * 64 + e] = sc; mt[((size_t)(l * 2 + 1) * 4 + g) * 4096 + c * 64 + e] = ss; } }
    { bf16* ft = (bf16*)(C.ws + WS_FTAB); const int gt = C.wg * NTHR + C.tid; const float* pbmix = a.in[I_BMIX];
      for (int i = gt; i < 128 * 128; i += C.G * NTHR) { const int k = i >> 7, t = i & 127; const float x = (float)((k * t) & 127) * (1.0f / 64.0f); ft[i] = (bf16)f2bf(cospif(x)); ft[16384 + i] = (bf16)f2bf(sinpif(x)); }
      bf16* mf = ft + 32768;
      for (int i = gt; i < 4 * 4 * 16 * 64 * 8; i += C.G * NTHR) { const int j8 = i & 7, ln = (i >> 3) & 63, fr = (i >> 9) & 15, gq = (i >> 13) & 3, l = i >> 15;
          const int ei = fr >> 2, ks2 = fr & 3, e = 16 * ei + (ln & 15), g = ln >> 4, c = 32 * (ks2 & 1) + 16 * (j8 >> 2) + 4 * g + (j8 & 3), part = ks2 >> 1;
          const float* w = pbmix + ((size_t)(l * 4 + gq) * 64) * 64 + e; float s = 0.f;
          for (int cp = 0; cp < 64; ++cp) { const float x = (float)((c * cp) & 63) * (1.0f / 32.0f); s += (part ? sinpif(x) : cospif(x)) * w[cp * 64]; }
          mf[i] = (bf16)f2bf(s * (1.0f / 1024.0f)); } }
    { const int gt = C.wg * NTHR + C.tid; const float* pg2 = a.in[I_DG2]; const float* prw = a.in[I_RW]; bf16* g2t = (bf16*)(C.ws + WS_G2T); bf16* rwt = (bf16*)(C.ws + WS_RWT);
      for (int i = gt; i < 4 * 256 * 160; i += C.G * NTHR) { const int ii = i % 160, c = (i / 160) & 255, l = i / (160 * 256); g2t[i] = (bf16)f2bf(pg2[((size_t)l * 160 + ii) * 256 + c]); }
      for (int i = gt; i < 4 * 32 * 1024; i += C.G * NTHR) { const int k = i & 1023, e = (i >> 10) & 31, l = i >> 15; rwt[i] = (bf16)f2bf(prw[((size_t)l * 1024 + k) * 32 + e]); } }
    { LAS float* red = (LAS float*)(C.lds);
      __syncthreads();
      float* mod = (float*)(C.ws + WS_MOD);
      const float* pc = a.in[I_C]; const float* pcc = a.in[I_CCTX]; const float* padaw = a.in[I_ADAW]; const float* padab = a.in[I_ADAB];
      for (int u = C.wg; u < 4 * 24; u += C.G) { const int l = u / 24, jb = u % 24, j0 = jb * 256 + 4 * C.lane;
          f32x4 s0 = {0.f, 0.f, 0.f, 0.f}, s1 = {0.f, 0.f, 0.f, 0.f};
          const float* w = padaw + (size_t)l * DM * 6144 + j0;
          for (int k = C.wave * 128; k < C.wave * 128 + 128; ++k) { const float c0 = pc[k], c1 = pcc[k]; const float a0 = c0 * sigmoidf_(c0), a1 = c1 * sigmoidf_(c1);
              const f32x4 wv = *(const f32x4*)(w + (size_t)k * 6144); s0 += wv * a0; s1 += wv * a1; }
          *(LAS f32x4*)(red + ((C.wave * 2 + 0) * 64 + C.lane) * 4) = s0; *(LAS f32x4*)(red + ((C.wave * 2 + 1) * 64 + C.lane) * 4) = s1;
          __syncthreads();
          if (C.tid < 512) { const int v = C.tid >> 8, j = C.tid & 255; float s = 0.f;
#pragma unroll
              for (int wv = 0; wv < 8; ++wv) s += red[(wv * 2 + v) * 256 + j];
              mod[(size_t)(l * 2 + v) * 6144 + jb * 256 + j] = s + padab[(size_t)l * 6144 + jb * 256 + j]; }
          __syncthreads(); } }
}

__device__ __forceinline__ void load_row(const float* p, int lane, f32x4 (&v)[4]) {
#pragma unroll
    for (int j = 0; j < 4; ++j) v[j] = *((const f32x4*)p + lane + 64 * j);
}
__device__ __forceinline__ void moe_combine_row(const Ctx& C, int row, f32x4 (&v)[4], const float* gt2) {
    const int* dest = (const int*)(C.ws + WS_ROUTE) + (size_t)3 * ROWS * 4; const float* gate = (const float*)(C.ws + WS_ROUTE) + (size_t)1 * ROWS * 4;
    const bf16* YB = (const bf16*)(C.ws + WS_XG);
    f32x4 s[4];
#pragma unroll
    for (int j = 0; j < 4; ++j) s[j] = (f32x4){0.f, 0.f, 0.f, 0.f};
#pragma unroll
    for (int k = 0; k < 4; ++k) { const int d = dest[row * 4 + k]; const float g = gate[row * 4 + k]; const u32x2* yp = (const u32x2*)(YB + (size_t)d * DM) + C.lane;
#pragma unroll
        for (int j = 0; j < 4; ++j) { const u32x2 w = yp[64 * j]; s[j] += (f32x4){bflo(w.x), bfhi(w.x), bflo(w.y), bfhi(w.y)} * g; } }
#pragma unroll
    for (int j = 0; j < 4; ++j) v[j] += *((const f32x4*)gt2 + C.lane + 64 * j) * s[j];
}
__device__ __forceinline__ float row_rstd(const f32x4 (&v)[4], int lane) {
    float s = 0.f;
#pragma unroll
    for (int j = 0; j < 4; ++j) s += (v[j].x * v[j].x + v[j].y * v[j].y) + (v[j].z * v[j].z + v[j].w * v[j].w);
    return rsqrtf(wave_sum(s, lane) * (1.f / DM) + 1e-6f);
}
__device__ __forceinline__ void phase_norm1(const Ctx& C, const DArgs& a, int l) {
    float* XS = (float*)(C.ws + WS_XS); bf16* H = (bf16*)(C.ws + WS_H); const float* mod = (const float*)(C.ws + WS_MOD);
    const float* g1 = a.in[I_N1G] + (size_t)l * DM;
    const float* pctx = a.in[I_CTX]; const float* px = a.in[I_X];
    for (int row = C.gw; row < ROWS; row += C.NGW) {
        const bool isctx = row < NCTX; f32x4 v[4];
        if (l == 0) { load_row(isctx ? pctx + (size_t)row * DM : px + (size_t)(row - NCTX) * DM, C.lane, v); }
        else { load_row(XS + (size_t)row * DM, C.lane, v);
               if (!(l == DEPTH && isctx)) moe_combine_row(C, row, v, mod + (size_t)((l - 1) * 2 + (isctx ? 1 : 0)) * 6144 + 5 * DM); }
        if (l == 0 || true) {
#pragma unroll
            for (int j = 0; j < 4; ++j) *((f32x4*)(XS + (size_t)row * DM) + C.lane + 64 * j) = v[j]; }
        const float rstd = row_rstd(v, C.lane);
        const float* md = mod + (size_t)(l * 2 + (isctx ? 1 : 0)) * 6144;
        u32x2* o = (u32x2*)(H + (size_t)row * DM) + C.lane;
#pragma unroll
        for (int j = 0; j < 4; ++j) { const f32x4 g = *((const f32x4*)g1 + C.lane + 64 * j), sh = *((const f32x4*)md + C.lane + 64 * j), sc = *((const f32x4*)(md + DM) + C.lane + 64 * j);
            const f32x4 y = v[j] * rstd * g * (sc + 1.0f) + sh; u32x2 w; w.x = pk2(y.x, y.y); w.y = pk2(y.z, y.w); o[64 * j] = w; }
    }
}
__device__ __forceinline__ void phase_final(const Ctx& C, const DArgs& a) {
    const float* XS = (const float*)(C.ws + WS_XS); const float* mod = (const float*)(C.ws + WS_MOD); const float* g = a.in[I_FNG];
    for (int row = NCTX + C.gw; row < ROWS; row += C.NGW) {
        f32x4 v[4]; load_row(XS + (size_t)row * DM, C.lane, v);
        moe_combine_row(C, row, v, mod + (size_t)((DEPTH - 1) * 2 + 0) * 6144 + 5 * DM);
        const float rstd = row_rstd(v, C.lane);
        float* o = a.out + (size_t)(row - NCTX) * DM;
#pragma unroll
        for (int j = 0; j < 4; ++j) *((f32x4*)o + C.lane + 64 * j) = v[j] * rstd * *((const f32x4*)g + C.lane + 64 * j);
    }
}
__device__ __forceinline__ void phase_norm2(const Ctx& C, const DArgs& a, int l) {
    const float* XS = (const float*)(C.ws + WS_XS); bf16* H = (bf16*)(C.ws + WS_H); const float* mod = (const float*)(C.ws + WS_MOD);
    const float* g2 = a.in[I_N2G] + (size_t)l * DM; const float* rb = a.in[I_RB] + (size_t)l * NEXP; const bf16* rwt = (const bf16*)(C.ws + WS_RWT) + (size_t)l * NEXP * DM;
    int* tok_e = (int*)(C.ws + WS_ROUTE); float* gate = (float*)(C.ws + WS_ROUTE) + (size_t)1 * ROWS * 4; int* slot = (int*)(C.ws + WS_ROUTE) + (size_t)2 * ROWS * 4;
    LAS float* lg = (LAS float*)(C.lds + C.wave * 4096);
    LAS int* hist = (LAS int*)(C.lds + MISC_OFF + 64);
    const int lane = C.lane, li = lane & 15, g = lane >> 4;
    if (C.tid < NEXP) hist[C.tid] = 0;
    __syncthreads();
    const int tile_lo = (l == DEPTH - 1) ? NCTX / 16 : 0;
    for (int tl = tile_lo + C.gw; tl < ROWS / 16; tl += C.NGW) {
#pragma unroll 1
        for (int rr = 0; rr < 16; ++rr) { const int row = 16 * tl + rr; const bool isctx = row < NCTX; f32x4 v[4]; load_row(XS + (size_t)row * DM, lane, v);
            const float rstd = row_rstd(v, lane);
            const float* md = mod + (size_t)(l * 2 + (isctx ? 1 : 0)) * 6144 + 3 * DM;
            u32x2* o = (u32x2*)(H + (size_t)row * DM) + lane;
#pragma unroll
            for (int j = 0; j < 4; ++j) { const f32x4 gg = *((const f32x4*)g2 + lane + 64 * j), sh = *((const f32x4*)md + lane + 64 * j), sc = *((const f32x4*)(md + DM) + lane + 64 * j);
                const f32x4 y = v[j] * rstd * gg * (sc + 1.0f) + sh; u32x2 w; w.x = pk2(y.x, y.y); w.y = pk2(y.z, y.w); o[64 * j] = w; } }
        asm volatile("s_waitcnt vmcnt(0)" ::: "memory");
        f32x4 acc0 = {0.f, 0.f, 0.f, 0.f}, acc1 = {0.f, 0.f, 0.f, 0.f};
        const bf16* ap = H + (size_t)(16 * tl + li) * DM + 8 * g; const bf16* bp0 = rwt + (size_t)li * DM + 8 * g; const bf16* bp1 = bp0 + 16 * DM;
#pragma unroll 4
        for (int ks = 0; ks < 32; ++ks) { const bf16x8 af = *(const bf16x8*)(ap + 32 * ks); acc0 = mfma16(af, *(const bf16x8*)(bp0 + 32 * ks), acc0); acc1 = mfma16(af, *(const bf16x8*)(bp1 + 32 * ks), acc1); }
#pragma unroll
        for (int r = 0; r < 4; ++r) { lg[(4 * g + r) * 33 + li] = acc0[r]; lg[(4 * g + r) * 33 + 16 + li] = acc1[r]; }
        LDS_WAIT(); asm volatile("" ::: "memory");
        const int e = lane & 31; const float rbe = rb[e];
#pragma unroll 1
        for (int rr = 0; rr < 16; ++rr) { const int row = 16 * tl + rr;
            float val = lg[rr * 33 + e] + rbe; int te[4]; float tv[4];
#pragma unroll
            for (int k = 0; k < 4; ++k) { float bv = val; int bi = e;
#pragma unroll
                for (int o2 = 1; o2 < 32; o2 <<= 1) { const float ov = shx(bv, o2, lane); const int oi = shxi(bi, o2, lane); if (ov > bv || (ov == bv && oi < bi)) { bv = ov; bi = oi; } }
                te[k] = bi; tv[k] = bv; if (e == bi) val = -3.0e38f; }
            if (lane == 0) { const float m = tv[0]; float p[4], ps = 0.f;
#pragma unroll
                for (int k = 0; k < 4; ++k) { p[k] = __expf(tv[k] - m); ps += p[k]; }
#pragma unroll
                for (int k = 0; k < 4; ++k) { tok_e[row * 4 + k] = te[k]; gate[row * 4 + k] = p[k] / ps; slot[row * 4 + k] = __hip_atomic_fetch_add(&hist[te[k]], 1, __ATOMIC_RELAXED, __HIP_MEMORY_SCOPE_WORKGROUP); } } }
        asm volatile("" ::: "memory");
    }
    __syncthreads();
    if (C.tid < NEXP) ((int*)(C.ws + WS_CNT))[C.wg * NEXP + C.tid] = hist[C.tid];
}
__device__ __forceinline__ int moe_tables(const Ctx& C) {
    const int* cnt = (const int*)(C.ws + WS_CNT);
    LAS int* part = (LAS int*)(C.lds);
    LAS int* pstart = (LAS int*)(C.lds + MISC_OFF + 256); LAS int* wgbase = pstart + 40; LAS int* tot = wgbase + 32; LAS int* nblk_s = tot + 32;
    LAS unsigned char* blk_e = (LAS unsigned char*)(C.lds + MISC_OFF + 1024);
    __syncthreads();
    { const int e = C.tid & 31, p = C.tid >> 5; int t = 0, pre = 0;
#pragma unroll 1
      for (int w = p * 16; w < p * 16 + 16; ++w) { const int c = cnt[w * NEXP + e]; t += c; if (w < C.wg) pre += c; }
      part[(p * 32 + e) * 2] = t; part[(p * 32 + e) * 2 + 1] = pre; }
    __syncthreads();
    if (C.tid < NEXP) { int t = 0, pre = 0;
#pragma unroll 1
        for (int p = 0; p < 16; ++p) { t += part[(p * 32 + C.tid) * 2]; pre += part[(p * 32 + C.tid) * 2 + 1]; }
        tot[C.tid] = t; wgbase[C.tid] = pre; }
    __syncthreads();
    if (C.tid == 0) { int b = 0;
#pragma unroll 1
        for (int e = 0; e < NEXP; ++e) { pstart[e] = b * 256; b += (tot[e] + 255) >> 8; }
        pstart[NEXP] = b * 256; nblk_s[0] = b; }
    __syncthreads();
    if (C.tid < NEXP) wgbase[C.tid] += pstart[C.tid];
    if (C.tid < MOE_MAXBLK) { int e = 0;
#pragma unroll 1
        for (int k = 1; k < NEXP; ++k) if (pstart[k] <= C.tid * 256) e = k;
        blk_e[C.tid] = (unsigned char)e; }
    __syncthreads();
    return __builtin_amdgcn_readfirstlane(nblk_s[0]);
}
__device__ __forceinline__ void phase_gather(const Ctx& C, const DArgs& a, int l) {
    moe_tables(C);
    const LAS int* wgbase = (const LAS int*)(C.lds + MISC_OFF + 256) + 40;
    const int* tok_e = (const int*)(C.ws + WS_ROUTE); const int* slot = (const int*)(C.ws + WS_ROUTE) + (size_t)2 * ROWS * 4; int* dest = (int*)(C.ws + WS_ROUTE) + (size_t)3 * ROWS * 4;
    const bf16* H = (const bf16*)(C.ws + WS_H); bf16* XG = (bf16*)(C.ws + WS_XG);
    const int tile_lo = (l == DEPTH - 1) ? NCTX / 16 : 0;
    for (int tl = tile_lo + C.gw; tl < ROWS / 16; tl += C.NGW)
    for (int row = 16 * tl; row < 16 * tl + 16; ++row) {
        const u32x4* src = (const u32x4*)(H + (size_t)row * DM) + C.lane; const u32x4 v0 = src[0], v1 = src[64];
#pragma unroll
        for (int k = 0; k < 4; ++k) { const int d = wgbase[tok_e[row * 4 + k]] + slot[row * 4 + k]; if (C.lane == 0) dest[row * 4 + k] = d;
            u32x4* dp = (u32x4*)(XG + (size_t)d * DM) + C.lane; dp[0] = v0; dp[64] = v1; }
    }
}

__device__ __forceinline__ void mix1_rope(const Ctx& C) {
    bf16* P = (bf16*)(C.ws + WS_P);
    const long total = (long)SEQ * 192;
    for (long i = (long)C.wg * NTHR + C.tid; i < total; i += (long)C.G * NTHR) {
        const int j = (int)(i & 31), hh = (int)((i >> 5) % 6), t = (int)(i / 192);
        const int col = (hh < 4) ? (C_AQ + hh * 64) : (C_AK + (hh - 4) * 64);
        const float pos = (j < 16) ? (float)(t >> 6) : (float)(t & 63);
        const float inv = __powf(10000.0f, -(float)(j & 15) * (1.0f / 16.0f));
        const float ang = pos * inv * 0.31830988618379067f;
        const float cs = cospif(ang), sn = sinpif(ang);
        bf16* p = P + (size_t)(NCTX + t) * INWP + col;
        const float x1 = bf2f(p[j]), x2 = bf2f(p[j + 32]);
        p[j] = (bf16)f2bf(x1 * cs - x2 * sn); p[j + 32] = (bf16)f2bf(x2 * cs + x1 * sn);
    }
}
__device__ __forceinline__ void mix1_vt(const Ctx& C) {
    const bf16* P = (const bf16*)(C.ws + WS_P);
    LAS unsigned short* scr = (LAS unsigned short*)(C.lds + C.wave * 16384);
    for (int u = C.gw; u < (ROWS / 64) * 6; u += C.NGW) {
        const int hd = u % 6, tb = u / 6; const int vcol = (hd < 2) ? (C_AV + hd * 64) : (C_CV + (hd - 2) * 64);
        bf16* VT = ((hd < 2) ? (bf16*)(C.ws + WS_VTA) + (size_t)hd * 64 * VTP : (bf16*)(C.ws + WS_VTC) + (size_t)(hd - 2) * 64 * VTP);
#pragma unroll
        for (int i = 0; i < 8; ++i) { const int tk = (C.lane >> 3) + 8 * i, ch = C.lane & 7; const u32x4 w = *(const u32x4*)(P + (size_t)(tb * 64 + tk) * INWP + vcol + 8 * ch);
            LAS unsigned* d = (LAS unsigned*)(scr + tk * 66 + 8 * ch); d[0] = w.x; d[1] = w.y; d[2] = w.z; d[3] = w.w; }
        LDS_WAIT(); asm volatile("" ::: "memory");
#pragma unroll
        for (int k8 = 0; k8 < 8; ++k8) { unsigned w[4];
#pragma unroll
            for (int e2 = 0; e2 < 4; ++e2) { const unsigned lo = scr[(8 * k8 + 2 * e2) * 66 + C.lane], hi = scr[(8 * k8 + 2 * e2 + 1) * 66 + C.lane]; w[e2] = lo | (hi << 16); }
            *(u32x4*)(VT + (size_t)C.lane * VTP + tb * 64 + 8 * k8) = (u32x4){w[0], w[1], w[2], w[3]}; }
        LDS_WAIT(); asm volatile("" ::: "memory");
    }
    for (int i = C.wg * NTHR + C.tid; i < 6 * 64 * 32; i += C.G * NTHR) { const int rowi = i >> 5, pc = i & 31; const int hd = rowi >> 6, d = rowi & 63;
        bf16* VT = ((hd < 2) ? (bf16*)(C.ws + WS_VTA) + (size_t)hd * 64 * VTP : (bf16*)(C.ws + WS_VTC) + (size_t)(hd - 2) * 64 * VTP);
        *(u32x4*)(VT + (size_t)d * VTP + ROWS + 8 * pc) = (u32x4){0u, 0u, 0u, 0u}; }
}
__device__ __forceinline__ float conv3(const bf16* P, int row, int col, const float* cw, int cc) {
    const bool first = (row == 0) || (row == NCTX), last = (row == NCTX - 1) || (row == ROWS - 1);
    float s = cw[768 + cc] * bf2f(P[(size_t)row * INWP + col]);
    if (!first) s += cw[cc] * bf2f(P[(size_t)(row - 1) * INWP + col]);
    if (!last) s += cw[2 * 768 + cc] * bf2f(P[(size_t)(row + 1) * INWP + col]);
    return s;
}
__device__ __forceinline__ void mix1_rwkv_prep(const Ctx& C, const DArgs& a, int l) {
    const bf16* P = (const bf16*)(C.ws + WS_P); float* SC = (float*)(C.ws + WS_SC);
    LAS float* lo = (LAS float*)(C.lds);
    const float* cw = a.in[I_DCONV] + (size_t)l * 3 * 768;
    const float* w0 = a.in[I_DW0] + (size_t)l * 512; const float* w2 = a.in[I_DW2] + (size_t)l * 2 * 64 * 256;
    const float* a0 = a.in[I_DA0] + (size_t)l * 512; const float* a2 = a.in[I_DA2] + (size_t)l * 2 * 64 * 256;
    const float* kkw = a.in[I_DKK] + (size_t)l * 256; const float* kaw = a.in[I_DKA] + (size_t)l * 256;
    const int half = C.tid >> 8, c = C.tid & 255;
    const float kkc = kkw[c], kac = kaw[c];
    for (int grp = C.wg; grp < ROWS / 16; grp += C.G) {
        const int row0 = 16 * grp + 8 * half;
        __syncthreads();
#pragma unroll
        for (int j = 0; j < 8; ++j) { const float x = bf2f(P[(size_t)(row0 + j) * INWP + C_WL + c]); lo[(8 * half + j) * 256 + c] = (c < 128) ? tanhf(x) : x; }
        __syncthreads();
        float kk[8], kv[8];
#pragma unroll
        for (int j = 0; j < 8; ++j) { const int row = row0 + j; const float r = conv3(P, row, C_DR + c, cw, c), k = conv3(P, row, C_DK + c, cw, 256 + c), v = conv3(P, row, C_DV + c, cw, 512 + c);
            float q = k * kkc; const float n2 = wave_sum(q * q, C.lane); q *= rsqrtf(fmaxf(n2, 1e-24f)); kk[j] = q; kv[j] = k;
            float* sc = SC + (size_t)row * 9 * 256; sc[c] = r; sc[256 + c] = v; sc[512 + c] = -q; }
#pragma unroll 1
        for (int d = 0; d < 2; ++d) {
            float wp[8], ap[8]; const float w0c = w0[d * 256 + c], a0c = a0[d * 256 + c];
#pragma unroll
            for (int j = 0; j < 8; ++j) { wp[j] = w0c; ap[j] = a0c; }
            const float* w2p = w2 + (size_t)d * 64 * 256 + c; const float* a2p = a2 + (size_t)d * 64 * 256 + c;
#pragma unroll 2
            for (int i4 = 0; i4 < 16; ++i4) { float wv[4], av[4];
#pragma unroll
                for (int e = 0; e < 4; ++e) { wv[e] = w2p[(4 * i4 + e) * 256]; av[e] = a2p[(4 * i4 + e) * 256]; }
#pragma unroll
                for (int j = 0; j < 8; ++j) { const f32x4 wl = *(const LAS f32x4*)(lo + (8 * half + j) * 256 + d * 64 + 4 * i4), al = *(const LAS f32x4*)(lo + (8 * half + j) * 256 + 128 + d * 64 + 4 * i4);
                    wp[j] += wl[0] * wv[0] + wl[1] * wv[1] + wl[2] * wv[2] + wl[3] * wv[3]; ap[j] += al[0] * av[0] + al[1] * av[1] + al[2] * av[2] + al[3] * av[3]; } }
#pragma unroll
            for (int j = 0; j < 8; ++j) { const float nw = -wp[j], sp = fmaxf(nw, 0.f) + log1pf(__expf(-fabsf(nw)));
                const float lw = -__expf(-sp - 0.5f);
                const float as = sigmoidf_(ap[j]); float* sc = SC + (size_t)(row0 + j) * 9 * 256;
                sc[(3 + 3 * d) * 256 + c] = lw; sc[(4 + 3 * d) * 256 + c] = kv[j] * (1.0f + (as - 1.0f) * kac); sc[(5 + 3 * d) * 256 + c] = kk[j] * as; }
        }
    }
    __syncthreads();
}
constexpr int FP = 136;
constexpr int F_TABC = 0, F_TABS = 128 * FP * 2, F_TILE = 2 * 128 * FP * 2;
__device__ __forceinline__ void fourier_load_tables(const Ctx& C) {
    const bf16* ft = (const bf16*)(C.ws + WS_FTAB);
    for (int i = C.tid; i < 2 * 128 * 16; i += NTHR) { const int tb = i >> 11, r = (i >> 4) & 127, c8 = i & 15;
        *(LAS u32x4*)(C.lds + tb * F_TABS + (r * FP + 8 * c8) * 2) = *(const u32x4*)(ft + tb * 16384 + r * 128 + 8 * c8); }
}
__device__ __forceinline__ void mix1_fourier1(const Ctx& C) {
    const bf16* P = (const bf16*)(C.ws + WS_P); const float* tw = (const float*)(C.ws + WS_TW);
    bf16* FYR = (bf16*)(C.ws + WS_FYR); bf16* FYI = (bf16*)(C.ws + WS_FYI);
    const int lane = C.lane, li = lane & 15, g = lane >> 4, w = C.wave;
    __syncthreads();
    fourier_load_tables(C);
    for (int u = C.wg; u < 256; u += C.G) {
        const int t2 = u >> 1, ch0 = (u & 1) * 128;
        __syncthreads();
        for (int i = C.tid; i < 128 * 16; i += NTHR) { const int t1 = i >> 4, c8 = i & 15;
            *(LAS u32x4*)(C.lds + F_TILE + (t1 * FP + 8 * c8) * 2) = *(const u32x4*)(P + (size_t)(NCTX + 128 * t1 + t2) * INWP + C_BU + ch0 + 8 * c8); }
        __syncthreads();
        bf16x8 af[4];
#pragma unroll
        for (int ks = 0; ks < 4; ++ks) af[ks] = ldT(C.lds + F_TILE, FP, 32 * ks, 16 * w, li, g);
#pragma unroll 1
        for (int ni = 0; ni < 8; ++ni) { f32x4 dc = {0.f, 0.f, 0.f, 0.f}, ds = {0.f, 0.f, 0.f, 0.f};
#pragma unroll
            for (int ks = 0; ks < 4; ++ks) { dc = mfma16(af[ks], ldA(C.lds + F_TABC, FP, 16 * ni, 32 * ks, li, g), dc); ds = mfma16(af[ks], ldA(C.lds + F_TABS, FP, 16 * ni, 32 * ks, li, g), ds); }
            const int k1 = 16 * ni + li; const float cp = tw[t2 * k1], sp = tw[16384 + t2 * k1];
            const f32x4 yr = dc * cp - ds * sp, yi = -(ds * cp) - dc * sp;
            const size_t o = ((size_t)k1 * 128 + t2) * 256 + ch0 + 16 * w + 4 * g;
            u32x2 wr; wr.x = pk2(yr[0], yr[1]); wr.y = pk2(yr[2], yr[3]); *(u32x2*)(FYR + o) = wr;
            u32x2 wi; wi.x = pk2(yi[0], yi[1]); wi.y = pk2(yi[2], yi[3]); *(u32x2*)(FYI + o) = wi; }
    }
    __syncthreads();
}
__device__ __forceinline__ void fourier2_mfma(const Ctx& C, int l) {
    const bf16* FYR = (const bf16*)(C.ws + WS_FYR); const bf16* FYI = (const bf16*)(C.ws + WS_FYI); bf16* MIX = (bf16*)(C.ws + WS_MIX);
    const int lane = C.lane, li = lane & 15, g = lane >> 4, w = C.wave;
    constexpr int YP = 72, F_YR = F_TILE, F_YI = F_TILE + 128 * YP * 2;
    __syncthreads();
    fourier_load_tables(C);
    for (int u = C.wg; u < 512; u += C.G) {
        const int k1 = u >> 2, gq = u & 3;
        __syncthreads();
        for (int i = C.tid; i < 2 * 128 * 8; i += NTHR) { const int im = i >> 10, t2 = (i >> 3) & 127, c8 = i & 7;
            *(LAS u32x4*)(C.lds + (im ? F_YI : F_YR) + (t2 * YP + 8 * c8) * 2) = *(const u32x4*)((im ? FYI : FYR) + ((size_t)k1 * 128 + t2) * 256 + gq * 64 + 8 * c8); }
        __syncthreads();
        bf16x8 bc[4], bs[4];
#pragma unroll
        for (int ks = 0; ks < 4; ++ks) { bc[ks] = ldA(C.lds + F_TABC, FP, 16 * w, 32 * ks, li, g); bs[ks] = ldA(C.lds + F_TABS, FP, 16 * w, 32 * ks, li, g); }
        f32x4 xr[4], xi[4];
#pragma unroll
        for (int ci = 0; ci < 4; ++ci) { xr[ci] = (f32x4){0.f, 0.f, 0.f, 0.f}; f32x4 xs = {0.f, 0.f, 0.f, 0.f}; xi[ci] = xs;
#pragma unroll
            for (int ks = 0; ks < 4; ++ks) { const bf16x8 ar = ldT(C.lds + F_YR, YP, 32 * ks, 16 * ci, li, g), ai = ldT(C.lds + F_YI, YP, 32 * ks, 16 * ci, li, g);
                xr[ci] = mfma16(ar, bc[ks], xr[ci]); xr[ci] = mfma16(ai, bs[ks], xr[ci]);
                xi[ci] = mfma16(ai, bc[ks], xi[ci]); xs = mfma16(ar, bs[ks], xs); }
            xi[ci] = xi[ci] - xs; }
        union { bf16x8 v; unsigned q[4]; } xb[4];
#pragma unroll
        for (int q2 = 0; q2 < 2; ++q2) { xb[q2].q[0] = pk2(xr[2 * q2][0], xr[2 * q2][1]); xb[q2].q[1] = pk2(xr[2 * q2][2], xr[2 * q2][3]); xb[q2].q[2] = pk2(xr[2 * q2 + 1][0], xr[2 * q2 + 1][1]); xb[q2].q[3] = pk2(xr[2 * q2 + 1][2], xr[2 * q2 + 1][3]);
            xb[2 + q2].q[0] = pk2(xi[2 * q2][0], xi[2 * q2][1]); xb[2 + q2].q[1] = pk2(xi[2 * q2][2], xi[2 * q2][3]); xb[2 + q2].q[2] = pk2(xi[2 * q2 + 1][0], xi[2 * q2 + 1][1]); xb[2 + q2].q[3] = pk2(xi[2 * q2 + 1][2], xi[2 * q2 + 1][3]); }
        const bf16x8* mf = (const bf16x8*)((const bf16*)(C.ws + WS_FTAB) + 32768) + (size_t)(l * 4 + gq) * 16 * 64;
#pragma unroll
        for (int ei = 0; ei < 4; ++ei) { f32x4 o = {0.f, 0.f, 0.f, 0.f};
#pragma unroll
            for (int ks2 = 0; ks2 < 4; ++ks2) o = mfma16(mf[(ei * 4 + ks2) * 64 + lane], xb[ks2].v, o);
            const int tp = k1 + 128 * (16 * w + li);
            u32x2 wo; wo.x = pk2(o[0], o[1]); wo.y = pk2(o[2], o[3]); *(u32x2*)(MIX + (size_t)(NCTX + tp) * DM + 256 + gq * 64 + 16 * ei + 4 * g) = wo; }
    }
    __syncthreads();
}

constexpr float LOG2E = 1.4426950408889634f;
typedef short bf16x4 __attribute__((ext_vector_type(4)));
__device__ __forceinline__ bf16x8 ldg8(const bf16* p) { return *(const bf16x8*)p; }
template <int NH>
__device__ __forceinline__ void attn_block(const bf16* P, const bf16* VT, int krow, int kcol, const bf16x8 (&qf)[NH][2], f32x4 (&o)[NH][4], float (&m)[NH], float (&ls)[NH],
                                           const float (&add)[2][4], int li, int g) {
    bf16x8 kf[2][2];
#pragma unroll
    for (int t = 0; t < 2; ++t)
#pragma unroll
        for (int ks = 0; ks < 2; ++ks) kf[t][ks] = ldg8(P + (size_t)(krow + 16 * t + li) * INWP + kcol + 32 * ks + 8 * g);
    bf16x8 vf[4];
#pragma unroll
    for (int dt = 0; dt < 4; ++dt) { const bf16* vp = VT + (size_t)(dt * 16 + li) * VTP + krow + 4 * g;
        const bf16x4 a = *(const bf16x4*)vp, b = *(const bf16x4*)(vp + 16); vf[dt] = (bf16x8){a[0], a[1], a[2], a[3], b[0], b[1], b[2], b[3]}; }
#pragma unroll
    for (int hh = 0; hh < NH; ++hh) {
        f32x4 st[2];
#pragma unroll
        for (int t = 0; t < 2; ++t) { st[t] = (f32x4){0.f, 0.f, 0.f, 0.f};
#pragma unroll
            for (int ks = 0; ks < 2; ++ks) st[t] = __builtin_amdgcn_mfma_f32_16x16x32_bf16(kf[t][ks], qf[hh][ks], st[t], 0, 0, 0); }
        float s[8]; float bm = -INFINITY;
#pragma unroll
        for (int t = 0; t < 2; ++t)
#pragma unroll
            for (int r = 0; r < 4; ++r) { s[4 * t + r] = (add[t][r] == -INFINITY) ? -INFINITY : st[t][r] * (0.125f * LOG2E) + add[t][r]; bm = fmaxf(bm, s[4 * t + r]); }
        bm = fmaxf(bm, shx(bm, 16, 16 * g + li)); bm = fmaxf(bm, shx(bm, 32, 16 * g + li));
        const float mn = fmaxf(m[hh], bm), corr = __builtin_amdgcn_exp2f(m[hh] - mn); m[hh] = mn;
        float ps = 0.f; float pe[8];
#pragma unroll
        for (int e = 0; e < 8; ++e) { pe[e] = __builtin_amdgcn_exp2f(s[e] - mn); ps += pe[e]; }
        ls[hh] = ls[hh] * corr + ps;
        union { bf16x8 v; unsigned u[4]; } pf;
#pragma unroll
        for (int e2 = 0; e2 < 4; ++e2) pf.u[e2] = pk2(pe[2 * e2], pe[2 * e2 + 1]);
#pragma unroll
        for (int dt = 0; dt < 4; ++dt) { o[hh][dt] = o[hh][dt] * corr; o[hh][dt] = __builtin_amdgcn_mfma_f32_16x16x32_bf16(vf[dt], pf.v, o[hh][dt], 0, 0, 0); }
    }
}
template <int NH>
__device__ __forceinline__ void attn_finish(bf16* MIX, int qrow0, int ocol, f32x4 (&o)[NH][4], float (&m)[NH], float (&ls)[NH], const float* sink2  , int li, int g) {
#pragma unroll
    for (int hh = 0; hh < NH; ++hh) {
        float l = ls[hh]; l += shx(l, 16, 16 * g + li); l += shx(l, 32, 16 * g + li);
        float corr = 1.f;
        if (sink2) { const float sk = sink2[hh]; const float mn = fmaxf(m[hh], sk); corr = __builtin_amdgcn_exp2f(m[hh] - mn); l = l * corr + __builtin_amdgcn_exp2f(sk - mn); }
        const float inv = corr / l;
#pragma unroll
        for (int dt = 0; dt < 4; ++dt) { const f32x4 v = o[hh][dt] * inv; u32x2 w; w.x = pk2(v[0], v[1]); w.y = pk2(v[2], v[3]);
            *(u32x2*)(MIX + (size_t)(qrow0 + li) * DM + ocol + hh * 64 + dt * 16 + 4 * g) = w; }
    }
}
__device__ __forceinline__ void attnA_unit(const Ctx& C, const float* asink_l, int unit, bool lat) {
    const bf16* P = (const bf16*)(C.ws + WS_P); bf16* MIX = (bf16*)(C.ws + WS_MIX);
    const int li = C.lane & 15, g = C.lane >> 4;
    const int nqt = lat ? SEQ / 16 : NCTX / 16, kvh = unit / nqt, qt = unit % nqt, t0 = qt * 16, qrow0 = (lat ? NCTX : 0) + t0;
    const bf16* VT = (const bf16*)(C.ws + WS_VTA) + (size_t)kvh * 64 * VTP; const int kcol = C_AK + kvh * 64;
    bf16x8 qf[2][2];
#pragma unroll
    for (int hh = 0; hh < 2; ++hh)
#pragma unroll
        for (int ks = 0; ks < 2; ++ks) qf[hh][ks] = ldg8(P + (size_t)(qrow0 + li) * INWP + C_AQ + (kvh * 2 + hh) * 64 + 32 * ks + 8 * g);
    f32x4 o[2][4]; float m[2] = {-1.0e30f, -1.0e30f}, ls[2] = {0.f, 0.f};
#pragma unroll
    for (int hh = 0; hh < 2; ++hh)
#pragma unroll
        for (int dt = 0; dt < 4; ++dt) o[hh][dt] = (f32x4){0.f, 0.f, 0.f, 0.f};
    if (lat) {
        const int t = t0 + li;
#pragma unroll 1
        for (int b = 0; b < 9; ++b) { const int j0 = t0 - 128 + 32 * b; float add[2][4];
#pragma unroll
            for (int tt = 0; tt < 2; ++tt)
#pragma unroll
                for (int r = 0; r < 4; ++r) { const int j = j0 + 16 * tt + 4 * g + r; const bool ok = (j >= 0) && (j < SEQ) && (j - t <= 128) && (t - j <= 128); add[tt][r] = ok ? 0.f : -INFINITY; }
            attn_block<2>(P, VT, NCTX + j0, kcol, qf, o, m, ls, add, li, g); }
    }
    { float add[2][4];
#pragma unroll
      for (int tt = 0; tt < 2; ++tt)
#pragma unroll
          for (int r = 0; r < 4; ++r) add[tt][r] = 0.f;
#pragma unroll 1
      for (int b = 0; b < NCTX / 32; ++b) attn_block<2>(P, VT, 32 * b, kcol, qf, o, m, ls, add, li, g); }
    float sk2[2] = {asink_l[kvh * 2] * LOG2E, asink_l[kvh * 2 + 1] * LOG2E};
    attn_finish<2>(MIX, qrow0, kvh * 128, o, m, ls, sk2, li, g);
}
__device__ __forceinline__ void attnC_unit(const Ctx& C, const LAS float* relb, int h, int qt, bool lat) {
    const bf16* P = (const bf16*)(C.ws + WS_P); bf16* MIX = (bf16*)(C.ws + WS_MIX);
    const int li = C.lane & 15, g = C.lane >> 4;
    const int t0 = qt * 16, qrow0 = (lat ? NCTX : 0) + t0;
    const bf16* VT = (const bf16*)(C.ws + WS_VTC) + (size_t)h * 64 * VTP; const int kcol = C_CK + h * 64;
    bf16x8 qf[1][2];
#pragma unroll
    for (int ks = 0; ks < 2; ++ks) qf[0][ks] = ldg8(P + (size_t)(qrow0 + li) * INWP + C_CQ + h * 64 + 32 * ks + 8 * g);
    f32x4 o[1][4]; float m[1] = {-1.0e30f}, ls[1] = {0.f};
#pragma unroll
    for (int dt = 0; dt < 4; ++dt) o[0][dt] = (f32x4){0.f, 0.f, 0.f, 0.f};
    if (lat) {
        const int r = t0 >> 6, cj = (t0 >> 4) & 3, cq = cj * 16 + li; int r0 = r - 4; r0 = r0 < 0 ? 0 : (r0 > 248 ? 248 : r0);
        int c0 = cq - 8; c0 = c0 < 0 ? 0 : (c0 > 48 ? 48 : c0);
        const int cw0 = (cj == 0) ? 0 : (cj == 1) ? 8 : (cj == 2) ? 24 : 32;
#pragma unroll 1
        for (int kr = r0; kr < r0 + 8; ++kr) { float add[2][4]; const LAS float* rbp = relb + (kr - r + 7) * 31;
#pragma unroll
            for (int tt = 0; tt < 2; ++tt)
#pragma unroll
                for (int rr = 0; rr < 4; ++rr) { const int kc = cw0 + 16 * tt + 4 * g + rr; int ci = kc - cq + 15; ci = ci < 0 ? 0 : (ci > 30 ? 30 : ci);
                    const float bv = rbp[ci]; add[tt][rr] = (kc >= c0 && kc < c0 + 16) ? bv : -INFINITY; }
            attn_block<1>(P, VT, NCTX + kr * 64 + cw0, kcol, qf, o, m, ls, add, li, g); }
    }
    { float add[2][4];
#pragma unroll
      for (int tt = 0; tt < 2; ++tt)
#pragma unroll
          for (int r = 0; r < 4; ++r) add[tt][r] = 0.f;
#pragma unroll 1
      for (int b = 0; b < NCTX / 32; ++b) attn_block<1>(P, VT, 32 * b, kcol, qf, o, m, ls, add, li, g); }
    attn_finish<1>(MIX, qrow0, 512 + h * 64, o, m, ls, nullptr, li, g);
}
__device__ __forceinline__ void fourier2_unit(const Ctx& C, int l, int u, bool ctx) {
    const bf16* P = (const bf16*)(C.ws + WS_P); const float* tw = (const float*)(C.ws + WS_TW); bf16* MIX = (bf16*)(C.ws + WS_MIX);
    const float* FYR = (const float*)(C.ws + WS_FYR); const float* FYI = (const float*)(C.ws + WS_FYI);
    const float* mt = (const float*)(C.ws + WS_MTAB) + (size_t)l * 2 * 4 * 4096;
    LAS float* xr = (LAS float*)(C.lds + 8192); LAS float* xi = xr + 512;
    const int tl = C.tid >> 8, ch = C.tid & 255, tp = 2 * u + tl;
    float sr = 0.f, si = 0.f;
    if (!ctx) { const int k1 = tp & 127, k2 = tp >> 7; const float* yr = FYR + (size_t)k1 * 128 * 256 + ch; const float* yi = FYI + (size_t)k1 * 128 * 256 + ch;
#pragma unroll 8
        for (int t2 = 0; t2 < 128; ++t2) { const int m = ((t2 * k2) & 127) * 128; const float c = tw[m], s = tw[16384 + m]; const float a = yr[t2 * 256], b = yi[t2 * 256]; sr += a * c + b * s; si += b * c - a * s; } }
    else {
#pragma unroll 8
        for (int t = 0; t < NCTX; ++t) { const int m = ((t * tp) & 255) * 64; const float x = bf2f(P[(size_t)t * INWP + C_BU + ch]); sr += x * tw[m]; si -= x * tw[16384 + m]; } }
    __syncthreads();
    xr[tl * 256 + ch] = sr; xi[tl * 256 + ch] = si;
    __syncthreads();
    const int g = ch >> 6, e = ch & 63; const float* mc = mt + (size_t)(0 * 4 + g) * 4096 + e; const float* ms = mt + (size_t)(1 * 4 + g) * 4096 + e;
    const LAS float* xrp = xr + tl * 256 + g * 64; const LAS float* xip = xi + tl * 256 + g * 64; float o = 0.f;
#pragma unroll 8
    for (int c = 0; c < 64; ++c) o += xrp[c] * mc[c * 64] + xip[c] * ms[c * 64];
    o *= ctx ? (1.0f / 128.0f) : (1.0f / 1024.0f);
    MIX[(size_t)((ctx ? 0 : NCTX) + tp) * DM + 256 + ch] = (bf16)f2bf(o);
}
__device__ __forceinline__ void rwkv_passB(const Ctx& C, int b);
__device__ __forceinline__ void phase_mix2(const Ctx& C, const DArgs& a, int l) {
    const bool emit_ctx = l < DEPTH - 1;
    if (C.wg < 8) rwkv_passB(C, C.wg);
    { const float* asink_l = a.in[I_ASINK] + l * 4; const float* crel = a.in[I_CREL] + (size_t)l * 4 * 465;
      LAS float* relb = (LAS float*)(C.lds + 65536 + C.wave * 2048);
      const int nA = 2 * (SEQ / 16), nC = 4 * (SEQ / 16), nAc = emit_ctx ? 2 * (NCTX / 16) : 0, nCc = emit_ctx ? 4 * (NCTX / 16) : 0;
      for (int u = C.gw; u < nA + nAc; u += C.NGW) { if (u < nA) attnA_unit(C, asink_l, u, true); else attnA_unit(C, asink_l, u - nA, false); }
      int hcur = -1;
      for (int u = C.gw; u < nC + nCc; u += C.NGW) { const bool lat = u < nC; const int uu = lat ? u : u - nC, nqt = lat ? SEQ / 16 : NCTX / 16, h = uu / nqt, qt = uu % nqt;
          if (h != hcur) { for (int i = C.lane; i < 465; i += 64) relb[i] = crel[h * 465 + i] * LOG2E; hcur = h; LDS_WAIT(); asm volatile("" ::: "memory"); }
          attnC_unit(C, relb, h, qt, lat); } }
    __syncthreads();
    fourier2_mfma(C, l);
    if (emit_ctx) for (int u = C.wg; u < NCTX / 2; u += C.G) fourier2_unit(C, l, u, true);
}

constexpr int RW_C = 32, RW_NCH = ROWS / RW_C, RW_SC = 20, RW_NSC = RW_NCH / RW_SC;
constexpr int RW_SLOT = 5120, RW_REGION = 9 * RW_SLOT + 1024;
constexpr int TP = 72, HP = 40;
static_assert(3 * RW_REGION <= MISC_OFF, "RWKV D1 regions below the misc area");
__device__ __forceinline__ int rw_rc_of(int d, int c) { return d == 0 ? c : (c < 8 ? 7 - c : 527 - c); }
__device__ __forceinline__ int rw_row_of(int d, int rc, int t) { return 32 * rc + (d == 0 ? t : 31 - t); }

__device__ __forceinline__ void rwkv_d1(const Ctx& C, LAS unsigned char* rb, int d, int h, int rc) {
    int lane_ = C.lane; asm volatile("" : "+v"(lane_));
    const int lane = lane_, li = lane & 15, g = lane >> 4;
    const float* SC = (const float*)(C.ws + WS_SC);
    LAS unsigned char* S0 = rb; LAS unsigned char* S1 = rb + RW_SLOT; LAS unsigned char* S2 = rb + 2 * RW_SLOT; LAS unsigned char* S3 = rb + 3 * RW_SLOT; LAS unsigned char* S4 = rb + 4 * RW_SLOT;
    LAS unsigned char* S5 = rb + 5 * RW_SLOT; LAS unsigned char* S6 = rb + 6 * RW_SLOT; LAS unsigned char* S7 = rb + 7 * RW_SLOT; LAS unsigned char* S8 = rb + 8 * RW_SLOT;
    LAS unsigned char* S6b = S6 + 2560; LAS unsigned char* S7b = S7 + 2560;
    LAS float* gc = (LAS float*)(rb + 9 * RW_SLOT);
    { float cum = 0.f; const int j = lane; const int qw = (3 + 3 * d) * 256;
#pragma unroll 1
      for (int t0 = 0; t0 < 32; t0 += 4) { float rv[4], vv[4], av[4], lw[4], kd[4], bb[4];
#pragma unroll
          for (int u = 0; u < 4; ++u) { const float* sc = SC + (size_t)rw_row_of(d, rc, t0 + u) * 9 * 256 + h * 64 + j;
              rv[u] = sc[0]; vv[u] = sc[256]; av[u] = sc[512]; lw[u] = sc[qw]; kd[u] = sc[qw + 256]; bb[u] = sc[qw + 512]; }
#pragma unroll
          for (int u = 0; u < 4; ++u) { const float cp = cum; cum += lw[u]; const float Gt = __expf(cum), Gm = __expf(cp), iG = __expf(-cum); const int off = ((t0 + u) * TP + j) * 2;
              *(LAS bf16*)(S0 + off) = (bf16)f2bf(av[u] * Gm); *(LAS bf16*)(S1 + off) = (bf16)f2bf(rv[u] * Gt); *(LAS bf16*)(S2 + off) = (bf16)f2bf(bb[u] * iG);
              *(LAS bf16*)(S3 + off) = (bf16)f2bf(kd[u] * iG); *(LAS bf16*)(S4 + off) = (bf16)f2bf(vv[u]); } }
      gc[j] = __expf(cum); }
    const f32x4 z4 = {0.f, 0.f, 0.f, 0.f};
#pragma unroll 1
    for (int ti = 0; ti < 2; ++ti)
#pragma unroll 1
        for (int si = 0; si < 2; ++si) {
            f32x4 n = z4, nt = z4, mk = z4, qb = z4, qk = z4;
#pragma unroll
            for (int ks = 0; ks < 2; ++ks) { const bf16x8 at = ldA(S0, TP, 16 * ti, 32 * ks, li, g), rt = ldA(S1, TP, 16 * ti, 32 * ks, li, g), bs = ldA(S2, TP, 16 * si, 32 * ks, li, g), kss = ldA(S3, TP, 16 * si, 32 * ks, li, g);
                n = mfma16(at, bs, n);
                nt = mfma16(bs, at, nt);
                mk = mfma16(kss, at, mk);
                qb = mfma16(bs, rt, qb);
                qk = mfma16(kss, rt, qk); }
#pragma unroll
            for (int r = 0; r < 4; ++r) { const int trow = 16 * ti + 4 * g + r, scol = 16 * si + li; if (!(scol < trow)) n[r] = 0.f;
                const int srow = 16 * si + 4 * g + r, tcol = 16 * ti + li; if (!(srow < tcol)) { mk[r] = 0.f; nt[r] = 0.f; } if (!(srow <= tcol)) { qb[r] = 0.f; qk[r] = 0.f; } }
            *(LAS f32x4*)(S5 + ((16 * si + li) * 32 + 16 * ti + 4 * g) * 4) = n;
            stT(S6, HP, 16 * ti + li, 16 * si + 4 * g, mk);
            stT(S8, HP, 16 * ti + li, 16 * si + 4 * g, nt);
            stT(S6b, HP, 16 * ti + li, 16 * si + 4 * g, qb);
            stT(S7, HP, 16 * ti + li, 16 * si + 4 * g, qk); }
    { const int rr = lane & 31, bq = rr >> 4, lr = rr & 15; float Tr[16];
#pragma unroll
      for (int s = 15; s >= 0; --s) { float acc = (lr == s) ? 1.f : 0.f;
#pragma unroll
          for (int c4 = 0; c4 < 4; ++c4) { if (4 * c4 + 3 > s) { const f32x4 nv = *(const LAS f32x4*)(S5 + ((16 * bq + s) * 32 + 16 * bq + 4 * c4) * 4);
#pragma unroll
              for (int e = 0; e < 4; ++e) if (4 * c4 + e > s) acc += Tr[4 * c4 + e] * nv[e]; } }
          Tr[s] = acc; }
      if (lane < 32) { u32x4 w0, w1; w0.x = pk2(Tr[0], Tr[1]); w0.y = pk2(Tr[2], Tr[3]); w0.z = pk2(Tr[4], Tr[5]); w0.w = pk2(Tr[6], Tr[7]); w1.x = pk2(Tr[8], Tr[9]); w1.y = pk2(Tr[10], Tr[11]); w1.z = pk2(Tr[12], Tr[13]); w1.w = pk2(Tr[14], Tr[15]);
          const u32x4 zz = {0u, 0u, 0u, 0u}; LAS u32x4* trow = (LAS u32x4*)(S7b + rr * HP * 2);
          trow[0] = bq ? zz : w0; trow[1] = bq ? zz : w1; trow[2] = bq ? w0 : zz; trow[3] = bq ? w1 : zz; }
      f32x4 x = mfma16(ldA(S8, HP, 16, 0, li, g), ldT(S7b, HP, 0, 0, li, g), z4);
      LAS unsigned char* XT = S8 + 2560;
      *(LAS u32x2*)(XT + (li * HP + 4 * g) * 2) = (u32x2){0u, 0u}; stT(XT, HP, li, 16 + 4 * g, x);
      const f32x4 t21 = mfma16(ldA(S7b, HP, 16, 0, li, g), ldA(XT, HP, 0, 0, li, g), z4);
#pragma unroll
      for (int r = 0; r < 4; ++r) *(LAS bf16*)(S7b + ((16 + 4 * g + r) * HP + li) * 2) = (bf16)f2bf(t21[r]); }
#pragma unroll 1
    for (int ti = 0; ti < 2; ++ti) { const bf16x8 tf = ldA(S7b, HP, 16 * ti, 0, li, g), mf = ldA(S6, HP, 16 * ti, 0, li, g);
#pragma unroll
        for (int ji = 0; ji < 4; ++ji) { const f32x4 ap = mfma16(tf, ldT(S0, TP, 0, 16 * ji, li, g), z4); stT(S8, HP, 16 * ji + li, 16 * ti + 4 * g, ap);
            const f32x4 mv = mfma16(mf, ldT(S4, TP, 0, 16 * ji, li, g), z4); stT(S5, HP, 16 * ji + li, 16 * ti + 4 * g, mv); } }
#pragma unroll 1
    for (int ti = 0; ti < 2; ++ti) { const bf16x8 tf = ldA(S7b, HP, 16 * ti, 0, li, g);
#pragma unroll
        for (int vi = 0; vi < 4; ++vi) { const f32x4 ul = mfma16(tf, ldA(S5, HP, 16 * vi, 0, li, g), z4); stT(S0, HP, 16 * vi + li, 16 * ti + 4 * g, ul); } }
#pragma unroll 1
    for (int ti = 0; ti < 2; ++ti) { const bf16x8 qbf = ldA(S6b, HP, 16 * ti, 0, li, g), qkf = ldA(S7, HP, 16 * ti, 0, li, g);
#pragma unroll
        for (int ji = 0; ji < 4; ++ji) { f32x4 rp = mfma16(ldA(S8, HP, 16 * ji, 0, li, g), qbf, z4);
            LAS unsigned char* p = S1 + ((16 * ti + li) * TP + 16 * ji + 4 * g) * 2; rp = rp + ld4bf(p); u32x2 w; w.x = pk2(rp[0], rp[1]); w.y = pk2(rp[2], rp[3]); *(LAS u32x2*)p = w;
            f32x4 yl = mfma16(qbf, ldA(S0, HP, 16 * ji, 0, li, g), z4); yl = mfma16(qkf, ldT(S4, TP, 0, 16 * ji, li, g), yl);
            stT(S5, HP, 16 * ji + li, 16 * ti + 4 * g, yl); } }
#pragma unroll 1
    for (int ji = 0; ji < 4; ++ji) { const bf16x8 bt = ldT(S2, TP, 0, 16 * ji, li, g); const float gj = gc[16 * ji + li];
#pragma unroll
        for (int jp = 0; jp < 4; ++jp) { f32x4 pt = mfma16(ldA(S8, HP, 16 * jp, 0, li, g), bt, z4);
#pragma unroll
            for (int r = 0; r < 4; ++r) pt[r] = pt[r] * gj + ((16 * jp + 4 * g + r == 16 * ji + li) ? gj : 0.f);
            stT(S6, TP, 16 * ji + li, 16 * jp + 4 * g, pt); } }
#pragma unroll 1
    for (int vh = 0; vh < 2; ++vh) { f32x4 lt[4][2];
#pragma unroll
      for (int ji = 0; ji < 4; ++ji) { const bf16x8 ba = ldT(S2, TP, 0, 16 * ji, li, g), ka = ldT(S3, TP, 0, 16 * ji, li, g); const f32x4 gv = *(const LAS f32x4*)(gc + 16 * ji + 4 * g);
#pragma unroll
          for (int v2 = 0; v2 < 2; ++v2) { const int vi = 2 * vh + v2; f32x4 x = mfma16(ba, ldA(S0, HP, 16 * vi, 0, li, g), z4); x = mfma16(ka, ldT(S4, TP, 0, 16 * vi, li, g), x); lt[ji][v2] = x * gv; } }
      asm volatile("s_waitcnt lgkmcnt(0)" ::: "memory");
      LAS unsigned char* dst = vh ? S2 : S8;
#pragma unroll
      for (int ji = 0; ji < 4; ++ji)
#pragma unroll
          for (int v2 = 0; v2 < 2; ++v2) stT(dst, TP, 16 * v2 + li, 16 * ji + 4 * g, lt[ji][v2]); }
}
__device__ __forceinline__ void rwkv_passA_step(const Ctx& C, const LAS unsigned char* rb, f32x4 (&hs)[4], int d, int h, int rc) {
    int lane_ = C.lane; asm volatile("" : "+v"(lane_));
    const int lane = lane_, li = lane & 15, g = lane >> 4; const bool isPhi = C.wave >= 4; const int col = 16 * (C.wave & 3) + li;
    const LAS unsigned char* S1 = rb + RW_SLOT; const LAS unsigned char* S2 = rb + 2 * RW_SLOT; const LAS unsigned char* S5 = rb + 5 * RW_SLOT; const LAS unsigned char* S6 = rb + 6 * RW_SLOT;
    const LAS unsigned char* LTb = (col < 32) ? rb + 8 * RW_SLOT + col * TP * 2 : S2 + (col - 32) * TP * 2;
    union { bf16x8 v; unsigned u[4]; } bf[2];
#pragma unroll
    for (int ks = 0; ks < 2; ++ks) { bf[ks].u[0] = pk2(hs[2 * ks][0], hs[2 * ks][1]); bf[ks].u[1] = pk2(hs[2 * ks][2], hs[2 * ks][3]); bf[ks].u[2] = pk2(hs[2 * ks + 1][0], hs[2 * ks + 1][1]); bf[ks].u[3] = pk2(hs[2 * ks + 1][2], hs[2 * ks + 1][3]); }
#pragma unroll
    for (int ti = 0; ti < 2; ++ti) { f32x4 acc = isPhi ? (f32x4){0.f, 0.f, 0.f, 0.f} : ld4bf(S5 + (col * HP + 16 * ti + 4 * g) * 2);
#pragma unroll
        for (int ks = 0; ks < 2; ++ks) acc = mfma16(ldAperm(S1, TP, 16 * ti, ks, li, g), bf[ks].v, acc);
        if (!isPhi) { float* ys = (float*)(C.ws + WS_YS) + (size_t)d * ROWS * 256 + h * 64 + col;
#pragma unroll
            for (int r = 0; r < 4; ++r) ys[(size_t)rw_row_of(d, rc, 16 * ti + 4 * g + r) * 256] = acc[r]; }
        else { bf16* rp = (bf16*)(C.ws + WS_RPP) + ((size_t)((d * 4 + h) * RW_NCH + rc) * 32) * 64 + col;
#pragma unroll
            for (int r = 0; r < 4; ++r) rp[(16 * ti + 4 * g + r) * 64] = (bf16)f2bf(acc[r]); } }
    f32x4 hn[4];
#pragma unroll
    for (int i = 0; i < 4; ++i) { f32x4 acc = isPhi ? (f32x4){0.f, 0.f, 0.f, 0.f} : ld4bf(LTb + (16 * i + 4 * g) * 2);
#pragma unroll
        for (int ks = 0; ks < 2; ++ks) acc = mfma16(ldAperm(S6, TP, 16 * i, ks, li, g), bf[ks].v, acc);
        hn[i] = acc; }
#pragma unroll
    for (int i = 0; i < 4; ++i) hs[i] = hn[i];
}
__device__ __forceinline__ void phase_rwkv1(const Ctx& C) {
    const int lane = C.lane, li = lane & 15, g = lane >> 4;
    for (int u = C.wg; u < 8 * RW_NSC; u += C.G) {
        const int s = u % RW_NSC, dh = u / RW_NSC, d = dh >> 2, h = dh & 3; const bool isPhi = C.wave >= 4; const int col = 16 * (C.wave & 3) + li;
        f32x4 hs[4];
#pragma unroll
        for (int i = 0; i < 4; ++i)
#pragma unroll
            for (int r = 0; r < 4; ++r) hs[i][r] = (isPhi && (16 * i + 4 * g + r == col)) ? 1.f : 0.f;
#pragma unroll 1
        for (int rnd = 0; rnd < (RW_SC + 2) / 3; ++rnd) {
            __syncthreads();
            { int wv = C.wave; asm volatile("" : "+s"(wv)); if (wv < 3 && 3 * rnd + wv < RW_SC) rwkv_d1(C, C.lds + wv * RW_REGION, d, h, rw_rc_of(d, s * RW_SC + 3 * rnd + wv)); }
            __syncthreads();
#pragma unroll 1
            for (int k = 0; k < 3; ++k) { const int ci = 3 * rnd + k; int ko = k * RW_REGION; asm volatile("" : "+s"(ko)); if (ci < RW_SC) rwkv_passA_step(C, C.lds + ko, hs, d, h, rw_rc_of(d, s * RW_SC + ci)); }
        }
        if (isPhi) { bf16* pf = (bf16*)(C.ws + WS_PSC) + (size_t)(dh * RW_NSC + s) * 4096;
            const int ks = col >> 5, eh = (col >> 4) & 1, gp = (col >> 2) & 3, el = col & 3;
#pragma unroll
            for (int i = 0; i < 4; ++i)
#pragma unroll
                for (int r = 0; r < 4; ++r) pf[((i * 2 + ks) * 64 + gp * 16 + 4 * g + r) * 8 + eh * 4 + el] = (bf16)f2bf(hs[i][r]); }
        else { f32x4* lf = (f32x4*)(C.ws + WS_LSC) + ((size_t)(dh * RW_NSC + s) * 4 + C.wave) * 4 * 64;
#pragma unroll
            for (int i = 0; i < 4; ++i) lf[i * 64 + lane] = hs[i]; }
    }
    __syncthreads();
}
__device__ __forceinline__ void rwkv_passB(const Ctx& C, int b) {
    if (C.wave >= 4) return;
    const int lane = C.lane, li = lane & 15, g = lane >> 4, q = C.wave;
    f32x4 hs[4];
#pragma unroll
    for (int i = 0; i < 4; ++i) hs[i] = (f32x4){0.f, 0.f, 0.f, 0.f};
    const bf16x8* pfb = (const bf16x8*)((const bf16*)(C.ws + WS_PSC) + (size_t)b * RW_NSC * 4096);
    const f32x4* lfb = (const f32x4*)(C.ws + WS_LSC) + ((size_t)b * RW_NSC * 4 + q) * 4 * 64;
    bf16x8 pa[8]; f32x4 la[4];
#pragma unroll
    for (int k = 0; k < 8; ++k) pa[k] = pfb[k * 64 + lane];
#pragma unroll
    for (int i = 0; i < 4; ++i) la[i] = lfb[i * 64 + lane];
#pragma unroll 1
    for (int s = 0; s < RW_NSC; ++s) {
        bf16* hp = (bf16*)(C.ws + WS_HSC) + ((size_t)(b * RW_NSC + s) * 64 + 16 * q + li) * 64;
#pragma unroll
        for (int i = 0; i < 4; ++i) { u32x2 w; w.x = pk2(hs[i][0], hs[i][1]); w.y = pk2(hs[i][2], hs[i][3]); *(u32x2*)(hp + 16 * i + 4 * g) = w; }
        bf16x8 pn[8]; f32x4 ln[4]; const int sn = (s + 1 < RW_NSC) ? s + 1 : s;
#pragma unroll
        for (int k = 0; k < 8; ++k) pn[k] = pfb[(size_t)sn * 512 + k * 64 + lane];
#pragma unroll
        for (int i = 0; i < 4; ++i) ln[i] = lfb[(size_t)sn * 4 * 4 * 64 + i * 64 + lane];
        union { bf16x8 v; unsigned u[4]; } bf[2];
#pragma unroll
        for (int ks = 0; ks < 2; ++ks) { bf[ks].u[0] = pk2(hs[2 * ks][0], hs[2 * ks][1]); bf[ks].u[1] = pk2(hs[2 * ks][2], hs[2 * ks][3]); bf[ks].u[2] = pk2(hs[2 * ks + 1][0], hs[2 * ks + 1][1]); bf[ks].u[3] = pk2(hs[2 * ks + 1][2], hs[2 * ks + 1][3]); }
#pragma unroll
        for (int i = 0; i < 4; ++i) { f32x4 acc = la[i];
#pragma unroll
            for (int ks = 0; ks < 2; ++ks) acc = mfma16(pa[i * 2 + ks], bf[ks].v, acc);
            hs[i] = acc; }
#pragma unroll
        for (int k = 0; k < 8; ++k) pa[k] = pn[k];
#pragma unroll
        for (int i = 0; i < 4; ++i) la[i] = ln[i];
    }
}
__device__ __forceinline__ void phase_mix3(const Ctx& C, const DArgs& a, int l) {
    const bf16* P = (const bf16*)(C.ws + WS_P); const float* SC = (const float*)(C.ws + WS_SC); const float* YS = (const float*)(C.ws + WS_YS); bf16* MIX = (bf16*)(C.ws + WS_MIX);
    LAS float* yt = (LAS float*)(C.lds);
    constexpr int GSP = 168;
    LAS unsigned char* gsig = C.lds + 65536;
    LAS float* gm = (LAS float*)(C.lds + 81920);
    const bf16* g2t = (const bf16*)(C.ws + WS_G2T) + (size_t)l * 256 * 160;
    const float* rk = a.in[I_DRK] + (size_t)l * 256; const float* lnw = a.in[I_DLNW] + (size_t)l * 256; const float* lnb = a.in[I_DLNB] + (size_t)l * 256;
    const int lane = C.lane, li = lane & 15, g = lane >> 4, h = C.wave & 3, d = C.wave >> 2;
    const int half = C.tid >> 8, c = C.tid & 255;
    const int rc_lo = (l == DEPTH - 1) ? NCTX / 32 : 0;
    for (int rc = rc_lo + C.wg; rc < RW_NCH; rc += C.G) {
        __syncthreads();
        for (int i = C.tid; i < 32 * 160; i += NTHR) { const int t = i / 160, ii = i % 160; *(LAS bf16*)(gsig + (t * GSP + ii) * 2) = (bf16)f2bf(sigmoidf_(bf2f(P[(size_t)(32 * rc + t) * INWP + C_GL + ii]))); }
        {
          const int ct = (d == 0) ? rc : (rc < 8 ? 7 - rc : 527 - rc), s = ct / RW_SC;
          const bf16* rp = (const bf16*)(C.ws + WS_RPP) + (size_t)((d * 4 + h) * RW_NCH + rc) * 32 * 64;
          const bf16* hp = (const bf16*)(C.ws + WS_HSC) + (size_t)((d * 4 + h) * RW_NSC + s) * 64 * 64;
          bf16x8 af[2][2];
#pragma unroll
          for (int ti = 0; ti < 2; ++ti)
#pragma unroll
              for (int ks = 0; ks < 2; ++ks) af[ti][ks] = ldg8(rp + (16 * ti + li) * 64 + 32 * ks + 8 * g);
#pragma unroll
          for (int vi = 0; vi < 4; ++vi) { bf16x8 bfr[2];
#pragma unroll
              for (int ks = 0; ks < 2; ++ks) bfr[ks] = ldg8(hp + (16 * vi + li) * 64 + 32 * ks + 8 * g);
#pragma unroll
              for (int ti = 0; ti < 2; ++ti) { f32x4 acc = {0.f, 0.f, 0.f, 0.f};
#pragma unroll
                  for (int ks = 0; ks < 2; ++ks) acc = mfma16(af[ti][ks], bfr[ks], acc);
#pragma unroll
                  for (int r = 0; r < 4; ++r) { const int t = 16 * ti + 4 * g + r, rl = (d == 0) ? t : 31 - t;
                      yt[(d * 32 + rl) * 256 + h * 64 + 16 * vi + li] = acc[r] + YS[((size_t)d * ROWS + 32 * rc + rl) * 256 + h * 64 + 16 * vi + li]; } } } }
        __syncthreads();
#pragma unroll
        for (int c2 = 0; c2 < 2; ++c2) { const int ci = 2 * C.wave + c2; f32x4 a0 = {0.f, 0.f, 0.f, 0.f}, a1 = {0.f, 0.f, 0.f, 0.f};
#pragma unroll
            for (int ks = 0; ks < 5; ++ks) { const bf16x8 bfr = ldg8(g2t + (size_t)(16 * ci + li) * 160 + 32 * ks + 8 * g);
                a0 = mfma16(ldA(gsig, GSP, 0, 32 * ks, li, g), bfr, a0); a1 = mfma16(ldA(gsig, GSP, 16, 32 * ks, li, g), bfr, a1); }
#pragma unroll
            for (int r = 0; r < 4; ++r) { gm[(4 * g + r) * 256 + 16 * ci + li] = a0[r]; gm[(16 + 4 * g + r) * 256 + 16 * ci + li] = a1[r]; } }
        __syncthreads();
#pragma unroll 1
        for (int it = 0; it < 16; ++it) { const int rl = 2 * it + half, row = 32 * rc + rl;
            const float* sc = SC + (size_t)row * 9 * 256;
            const float y = yt[rl * 256 + c] + yt[(32 + rl) * 256 + c];
            const float mu = wave_sum(y, lane) * (1.f / 64.f), dy = y - mu, var = wave_sum(dy * dy, lane) * (1.f / 64.f);
            const float yn = dy * rsqrtf(var + 64e-5f) * lnw[c] + lnb[c];
            const float r = sc[c], v = sc[256 + c];
            const float coef = wave_sum(r * (sc[4 * 256 + c] + sc[7 * 256 + c]) * rk[c], lane);
            MIX[(size_t)row * DM + 768 + c] = (bf16)f2bf((yn + coef * v) * gm[rl * 256 + c]); }
    }
    __syncthreads();
}

#ifndef MK_SINGLE
#define MK_SINGLE 1
#endif
template <int ONLYP> __global__ void __launch_bounds__(NTHR, 2) mega(Args a) {
    extern __shared__ __attribute__((aligned(16))) unsigned char lds_raw[];
    Ctx C;
#define MKCTX() do { int t_ = threadIdx.x; asm volatile("" : "+v"(t_)); unsigned char* w_ = a.ws; asm volatile("" : "+s"(w_)); unsigned l_ = 0u; asm volatile("" : "+s"(l_)); \
        C.lds = (LAS unsigned char*)lds_raw + l_; C.tid = t_; C.lane = t_ & 63; C.wave = __builtin_amdgcn_readfirstlane(t_ >> 6); \
        C.wg = blockIdx.x; C.G = gridDim.x; C.gw = C.wg * NWAVES + C.wave; C.NGW = C.G * NWAVES; C.ws = w_; } while (0)
    MKCTX();
    if (C.tid == 0) {
#pragma unroll
        for (int i = 0; i < 31; ++i) ((LAS unsigned long long*)(C.lds + MISC_OFF + 2048))[i] = (unsigned long long)a.in[i]; }
    DArgs da; da.in.tab = (const LAS unsigned*)(C.lds + MISC_OFF + 2048); da.out = a.out;
    if (C.tid < 4) ((LAS unsigned*)(C.lds + MISC_OFF))[C.tid] = 0u;
    __syncthreads();
    XcdBarrier bar; bar.bar = (unsigned*)(C.ws + WS_CTL) + CW_BAR; bar.x = 0; bar.st = (volatile LAS unsigned*)(C.lds + MISC_OFF);
    if (a.use_bar) bar = xcd_barrier_post((unsigned*)(C.ws + WS_CTL) + CW_BAR, (volatile LAS unsigned*)(C.lds + MISC_OFF));
#ifndef PHMASK
#define PHMASK 0x1fff
#endif
#define INP(o, k) ((ONLYP < 0 || ONLYP == (o)) && ((PHMASK >> ((o) == 99 ? 12 : (o))) & 1) && a.ph_lo <= (k) && (k) < a.ph_hi)
#ifndef REPMASK
#define REPMASK 0
#endif
#define NREP(o) ((((REPMASK) >> ((o) == 99 ? 12 : (o))) & 1) ? 2 : 1)
#define IN(k) (a.ph_lo <= (k) && (k) < a.ph_hi)
#define SEAM(k) do { if (a.use_bar && IN(k) && IN((k) + 1)) xcd_barrier(bar); } while (0)
    if (INP(0, 0)) for (int rep = 0; rep < NREP(0); ++rep) { MKCTX(); phase_prologue(C, da); }
    SEAM(0);
    for (int l = 0; l < DEPTH; ++l) {
        const int b = 1 + l * NPL;
        const float* mod_lat = (const float*)(C.ws + WS_MOD) + (size_t)(l * 2 + 0) * 6144; const float* mod_ctx = mod_lat + 6144;
        if (INP(1, b + 0)) { MKCTX(); phase_norm1(C, da, l); }
        SEAM(b + 0);
        if (INP(2, b + 1)) for (int rep = 0; rep < NREP(2); ++rep) { MKCTX();
            pg8::StaticOrder S; S.init(C.ws + WS_H, (const bf16*)(C.ws + WS_WIN) + (size_t)l * INWP * DM, ROWS, INWP, DM, C.G, C.wg);
            pg8::EpiStoreBf16 E{(bf16*)(C.ws + WS_P), INWP, nullptr, 0};
            pg8::gemm_phase<pg8::EpiStoreBf16, pg8::StaticOrder, true, true>(C.lds, C.tid, DM, S, E);
        }
        SEAM(b + 1);
        if (INP(3, b + 2)) { MKCTX(); mix1_rope(C); for (int rep = 0; rep < NREP(3); ++rep) { mix1_vt(C); mix1_rwkv_prep(C, da, l); mix1_fourier1(C); } }
        SEAM(b + 2);
        if (INP(11, b + 3)) for (int rep = 0; rep < NREP(11); ++rep) { MKCTX(); phase_rwkv1(C); }
        SEAM(b + 3);
        if (INP(4, b + 4)) for (int rep = 0; rep < NREP(4); ++rep) { MKCTX(); phase_mix2(C, da, l); }
        SEAM(b + 4);
        if (INP(5, b + 5)) for (int rep = 0; rep < NREP(5); ++rep) { MKCTX(); phase_mix3(C, da, l); }
        SEAM(b + 5);
        if (INP(6, b + 6)) { MKCTX();
            pg8::StaticOrder S; S.init(C.ws + WS_MIX, (const bf16*)(C.ws + WS_WOUT) + (size_t)l * DM * DM, ROWS, DM, DM, C.G, C.wg);
            pg8::EpiResidual E{(float*)(C.ws + WS_XS), DM, mod_lat + 2 * DM, mod_ctx + 2 * DM};
            pg8::gemm_phase<pg8::EpiResidual, pg8::StaticOrder, true, true>(C.lds, C.tid, DM, S, E);
        }
        SEAM(b + 6);
        if (INP(7, b + 7)) for (int rep = 0; rep < NREP(7); ++rep) { MKCTX(); phase_norm2(C, da, l); }
        SEAM(b + 7);
        if (INP(8, b + 8)) for (int rep = 0; rep < NREP(8); ++rep) { MKCTX(); phase_gather(C, da, l); }
        SEAM(b + 8);
        if (INP(9, b + 9)) for (int rep = 0; rep < NREP(9); ++rep) { MKCTX();
            const int nblk = moe_tables(C);
            pg8::MoeOrder S{(const char*)(C.ws + WS_XG), (const char*)((const bf16*)(C.ws + WS_WGU) + (size_t)l * 32 * 2048 * DM), (size_t)256 * DM * 2, (size_t)2048 * DM * 2,
                            (const LAS unsigned char*)(C.lds + MISC_OFF + 1024), nblk, 8, C.G, C.wg};
            pg8::EpiSwiglu E{(bf16*)(C.ws + WS_ACT), DM, da.in[I_BGU] + (size_t)l * 32 * 2048, 2048};
            pg8::gemm_phase<pg8::EpiSwiglu, pg8::MoeOrder, true, true>(C.lds, C.tid, DM, S, E);
        }
        SEAM(b + 9);
        if (INP(10, b + 10)) for (int rep = 0; rep < NREP(10); ++rep) { MKCTX();
            const int nblk = moe_tables(C);
            pg8::MoeOrder S{(const char*)(C.ws + WS_ACT), (const char*)((const bf16*)(C.ws + WS_WDN) + (size_t)l * 32 * DM * DM), (size_t)256 * DM * 2, (size_t)DM * DM * 2,
                            (const LAS unsigned char*)(C.lds + MISC_OFF + 1024), nblk, 4, C.G, C.wg};
            pg8::EpiStoreBf16 E{(bf16*)(C.ws + WS_XG), DM, da.in[I_BDN] + (size_t)l * 32 * DM, DM};
            pg8::gemm_phase<pg8::EpiStoreBf16, pg8::MoeOrder, true, true>(C.lds, C.tid, DM, S, E);
        }
        SEAM(b + 10);
    }
    if (INP(99, PH_TOTAL - 1)) { MKCTX(); phase_final(C, da); }
#undef IN
#undef INP
#undef SEAM
}

typedef void (*kern_t)(Args);
static kern_t kern_of(int o) {
    switch (o) { case 0: return mega<0>; case 1: return mega<1>; case 2: return mega<2>; case 3: return mega<3>; case 4: return mega<4>; case 5: return mega<5>; case 6: return mega<6>;
                 case 7: return mega<7>; case 8: return mega<8>; case 9: return mega<9>; case 10: return mega<10>; case 11: return mega<11>; case 99: return mega<99>;
#if MK_SINGLE
                 default: return mega<-1>;
#else
                 default: return mega<0>;
#endif
    }
}
extern "C" void kernel_launch(void* const* d_in, const int* in_sizes, int n_in, void* d_out, int out_size, void* d_ws, size_t ws_size, hipStream_t stream) {
    static int ready = 0;
    if (ready == 0) {
        if (n_in != 31 || out_size != SEQ * DM || ws_size < WS_END) { fprintf(stderr, "kernel_launch: unexpected shapes (n_in %d, out %d, ws %zu)\n", n_in, out_size, ws_size); ready = -1; return; }
        const int ids[14] = {0, 1, 2, 3, 4, 5, 6, 7, 8, 9, 10, 11, 99, -1};
        for (int i = 0; i < (MK_SINGLE ? 14 : 13); ++i) { if (MK_SINGLE && ids[i] != -1) continue;
            if (hipFuncSetAttribute((const void*)kern_of(ids[i]), hipFuncAttributeMaxDynamicSharedMemorySize, LDS_BYTES) != hipSuccess) { fprintf(stderr, "kernel_launch: hipFuncSetAttribute failed (%d)\n", ids[i]); ready = -1; return; } }
        ready = 1;
    }
    if (ready < 0) return;
    (void)hipMemsetAsync((char*)d_ws + WS_CTL, 0, CTL_ZERO_BYTES, stream);
    Args a{};
    for (int i = 0; i < 31; ++i) a.in[i] = (const float*)d_in[i];
    a.out = (float*)d_out; a.ws = (unsigned char*)d_ws; a.pad = 0;
#if MK_SINGLE
    a.ph_lo = 0; a.ph_hi = PH_TOTAL; a.use_bar = 1;
    hipLaunchKernelGGL(kern_of(-1), dim3(NWG), dim3(NTHR), LDS_BYTES, stream, a);
#else
    for (int p = 0; p < PH_TOTAL; ++p) { a.ph_lo = p; a.ph_hi = p + 1; a.use_bar = 0;
        const int j = (p - 1) % NPL; const int o = (p == 0) ? 0 : (p == PH_TOTAL - 1) ? 99 : (j < 3 ? 1 + j : j == 3 ? 11 : j);
        hipLaunchKernelGGL(kern_of(o), dim3(NWG), dim3(NTHR), LDS_BYTES, stream, a); }
#endif
}
```

```cpp
#include <hip/hip_runtime.h>
#include <cstdio>
#include <cstdint>

#define LAS __attribute__((address_space(3)))
typedef unsigned short bf16;
typedef float f32x4 __attribute__((ext_vector_type(4)));
typedef float f32x2 __attribute__((ext_vector_type(2)));
typedef short bf16x8 __attribute__((ext_vector_type(8)));
typedef unsigned u32x4 __attribute__((ext_vector_type(4)));
typedef unsigned u32x2 __attribute__((ext_vector_type(2)));

constexpr int DM = 1024, SEQ = 16384, NCTX = 256, ROWS = SEQ + NCTX, DEPTH = 4, GRIDW = 64;
constexpr int INW = 2720, INWP = 2816;
constexpr int C_AQ = 0, C_AK = 256, C_AV = 384, C_BU = 512, C_CQ = 768, C_CK = 1024, C_CV = 1280, C_DR = 1536, C_DK = 1792, C_DV = 2048, C_WL = 2304, C_AL = 2432, C_GL = 2560;
constexpr int NEXP = 32, TOPK = 4;
constexpr int MOE_MAXBLK = 296;
constexpr int MOE_ROWS = MOE_MAXBLK * 256;
constexpr int NWG = 256, NTHR = 512, NWAVES = 8;
constexpr int VTP = ROWS + 256;

constexpr size_t MiB = 1u << 20;
constexpr size_t WS_CTL = 0, CTL_ZERO_BYTES = 1 * MiB;
constexpr size_t WS_MOD = 1 * MiB;
constexpr size_t WS_TW = 2 * MiB;
constexpr size_t WS_MTAB = 3 * MiB;
constexpr size_t WS_XS = 4 * MiB;
constexpr size_t WS_H = 70 * MiB;
constexpr size_t WS_P = 104 * MiB;
constexpr size_t WS_MIX = 194 * MiB;
constexpr size_t WS_FYR = 228 * MiB, WS_FYI = 244 * MiB;
constexpr size_t WS_VTA = 1544 * MiB, WS_VTC = 1550 * MiB;
constexpr size_t WS_SC = 260 * MiB;
constexpr size_t WS_YS = 408 * MiB;
constexpr size_t WS_ROUTE = 442 * MiB;
constexpr size_t WS_CNT = 444 * MiB;
constexpr size_t WS_XG = 446 * MiB;
constexpr size_t WS_ACT = 596 * MiB;
constexpr size_t WS_WIN = 746 * MiB;
constexpr size_t WS_WOUT = 768 * MiB;
constexpr size_t WS_WGU = 776 * MiB;
constexpr size_t WS_WDN = 1288 * MiB;
constexpr size_t WS_RPP = 1560 * MiB, WS_PSC = 1578 * MiB, WS_LSC = 1580 * MiB, WS_HSC = 1584 * MiB;
constexpr size_t WS_FTAB = 1586 * MiB;
constexpr size_t WS_G2T = 1588 * MiB, WS_RWT = 1589 * MiB;
constexpr size_t WS_LORAT = 1590 * MiB;
constexpr size_t WS_F256 = 1591 * MiB;
constexpr size_t WS_END = 1592 * MiB;
static_assert(WS_XS + (size_t)ROWS * DM * 4 <= WS_H && WS_H + (size_t)ROWS * DM * 2 <= WS_P && WS_P + (size_t)ROWS * INWP * 2 <= WS_MIX && WS_MIX + (size_t)ROWS * DM * 2 <= WS_FYR, "ws map 1");
static_assert(WS_SC + (size_t)ROWS * 9 * 256 * 4 <= WS_YS && WS_YS + (size_t)2 * ROWS * 256 * 4 <= WS_ROUTE && WS_XG + (size_t)MOE_ROWS * DM * 2 <= WS_ACT && WS_ACT + (size_t)MOE_ROWS * DM * 2 <= WS_WIN, "ws map 2");
static_assert(WS_WIN + (size_t)4 * INWP * DM * 2 <= WS_WOUT && WS_WGU + (size_t)4 * 32 * 2048 * 1024 * 2 <= WS_WDN && WS_WDN + (size_t)4 * 32 * 1024 * 1024 * 2 <= WS_END, "ws map 3");
constexpr int CW_BAR = 4096;
constexpr int CW_WQ = 16384;

constexpr int RING_BYTES = 131072;
constexpr int MISC_OFF = 143360;
constexpr int LDS_BYTES = 147456;

__device__ __forceinline__ unsigned f2bf(float f) { unsigned u = __builtin_bit_cast(unsigned, f); return (u + 0x7fffu + ((u >> 16) & 1u)) >> 16; }
__device__ __forceinline__ unsigned pk2(float lo, float hi) { return f2bf(lo) | (f2bf(hi) << 16); }
__device__ __forceinline__ float bf2f(unsigned short b) { return __builtin_bit_cast(float, (unsigned)b << 16); }
__device__ __forceinline__ float bflo(unsigned w) { return __builtin_bit_cast(float, w << 16); }
__device__ __forceinline__ float bfhi(unsigned w) { return __builtin_bit_cast(float, w & 0xffff0000u); }
__device__ __forceinline__ float shx(float v, int o, int lane) { return __builtin_bit_cast(float, __builtin_amdgcn_ds_bpermute((lane ^ o) << 2, __builtin_bit_cast(int, v))); }
__device__ __forceinline__ int shxi(int v, int o, int lane) { return __builtin_amdgcn_ds_bpermute((lane ^ o) << 2, v); }
__device__ __forceinline__ float wave_sum(float v, int lane) {
#pragma unroll
    for (int o = 1; o < 64; o <<= 1) v += shx(v, o, lane);
    return v;
}
__device__ __forceinline__ float sigmoidf_(float x) { return 1.f / (1.f + __expf(-x)); }
#define LDS_WAIT() asm volatile("s_waitcnt lgkmcnt(0)" ::: "memory")
#define VM_WAIT() asm volatile("s_waitcnt vmcnt(0)" ::: "memory")

namespace pg8 {
#define PG8_LAS __attribute__((address_space(3)))
typedef unsigned short bf16_t;
constexpr int BM = 256, BK = 64, HALF = 128, HTB = HALF * BK * 2, STAGE_BYTES = 8 * HTB, NXCD = 8, WGM = 8;
__host__ __device__ __forceinline__ int lds_byte(int r, int c) { const int st = (r >> 4) * 2 + (c >> 5), rr = r & 15, cc = c & 31, ob = rr * 64 + cc * 2; return st * 1024 + (ob ^ (((ob >> 9) & 1) << 5)); }
__host__ __device__ __forceinline__ void stage_rc(int b, int& R, int& C) { const int st = b / 1024, sb = b % 1024, swz = sb ^ (((sb >> 9) & 1) << 5); R = (st >> 1) * 16 + swz / 64; C = (st & 1) * 32 + (swz % 64) / 2; }
__host__ __device__ __forceinline__ int perm32(int rho) { const int n = rho >> 4, i = rho & 15; return 8 * (i >> 2) + 4 * n + (i & 3); }
struct Unit { int pm, pn, e; };
__device__ __forceinline__ unsigned cvt_pk_bf16(float lo, float hi) { unsigned r; asm volatile("v_cvt_pk_bf16_f32 %0, %1, %2" : "=v"(r) : "v"(lo), "v"(hi)); return r; }

struct StaticOrder {
    const char* A; const char* Bt; size_t tstep;
    int nM, nN, nwg, G, c;
    __device__ void init(const void* A_, const void* Bt_, int M, int N, int K, int G_, int c_) { A = (const char*)A_; Bt = (const char*)Bt_; tstep = (size_t)BM * K * 2; nM = M / BM; nN = N / BM; nwg = nM * nN; G = G_; c = c_; }
    __device__ bool next(int i, Unit& u) const {
        const long L = (long)i * G + c; if (L >= nwg) return false;
        int wgid = (int)L; { const int q = nwg / NXCD, r = nwg % NXCD, xcd = wgid % NXCD, off = wgid / NXCD; wgid = (xcd < r ? xcd * (q + 1) : r * (q + 1) + (xcd - r) * q) + off; }
        const int nig = WGM * nN, gid = wgid / nig, fm = gid * WGM, gsz = (nM - fm) < WGM ? (nM - fm) : WGM;
        u.pm = fm + ((wgid % nig) % gsz); u.pn = (wgid % nig) / gsz; u.e = 0; return true;
    }
    __device__ __forceinline__ const char* pa(const Unit& u) const { return A + (size_t)u.pm * tstep; }
    __device__ __forceinline__ const char* pb(const Unit& u) const { return Bt + (size_t)u.pn * tstep; }
};
struct MoeOrder {
    const char* A; const char* Bt; size_t tstep, estep;
    const LAS unsigned char* blk_e; int nblk, nN, G, c;
    __device__ bool next(int i, Unit& u) const {
        const int L = i * G + c; if (L >= nblk * nN) return false;
        u.pm = L / nN; u.pn = L % nN; u.e = __builtin_amdgcn_readfirstlane((int)blk_e[u.pm]); return true;
    }
    __device__ __forceinline__ const char* pa(const Unit& u) const { return A + (size_t)u.pm * tstep; }
    __device__ __forceinline__ const char* pb(const Unit& u) const { return Bt + (size_t)u.e * estep + (size_t)u.pn * tstep; }
};

struct EpiStoreBf16 {
    static constexpr bool PERM = true;
    bf16_t* O; int ldc; const float* bias; int bias_estride;
    __device__ __forceinline__ void init(f32x4 (&acc)[2][2][4][2], const Unit& u, int wc, int fq) const {
        const int col0 = u.pn * BM + wc * 32 + 8 * fq;
#pragma unroll
        for (int b = 0; b < 2; ++b)
#pragma unroll
            for (int n = 0; n < 2; ++n) { const f32x4 bv = bias ? *(const f32x4*)(bias + (size_t)u.e * bias_estride + col0 + b * HALF + 4 * n) : (f32x4){0.f, 0.f, 0.f, 0.f};
#pragma unroll
                for (int a = 0; a < 2; ++a)
#pragma unroll
                    for (int m = 0; m < 4; ++m) acc[a][b][m][n] = bv; }
    }
    __device__ __forceinline__ void operator()(const f32x4 (&acc)[2][2][4][2], const Unit& u, int wr, int wc, int fr, int fq) const {
        const int row0 = u.pm * BM + wr * 64 + fr, col0 = u.pn * BM + wc * 32 + 8 * fq;
#pragma unroll
        for (int ai = 0; ai < 2; ++ai)
#pragma unroll
            for (int m = 0; m < 4; ++m) { bf16_t* rowp = O + (size_t)(row0 + ai * HALF + m * 16) * ldc + col0;
#pragma unroll
                for (int bj = 0; bj < 2; ++bj) { const f32x4 v0 = acc[ai][bj][m][0], v1 = acc[ai][bj][m][1];
                    u32x4 w; w.x = cvt_pk_bf16(v0[0], v0[1]); w.y = cvt_pk_bf16(v0[2], v0[3]); w.z = cvt_pk_bf16(v1[0], v1[1]); w.w = cvt_pk_bf16(v1[2], v1[3]);
                    *(u32x4*)(rowp + bj * HALF) = w; } }
    }
};
__device__ __forceinline__ float swiglu1(float g, float up) {
    g = fminf(g, 7.0f); up = fminf(fmaxf(up, -7.0f), 7.0f);
    return g * (1.f / (1.f + __expf(-1.702f * g))) * (up + 1.0f);
}
struct EpiSwiglu {
    static constexpr bool PERM = true;
    bf16_t* O; int ldc; const float* bias; int bias_estride;
    __device__ __forceinline__ void init(f32x4 (&acc)[2][2][4][2], const Unit& u, int wc, int fq) const {
        const int col0 = u.pn * BM + wc * 32 + 8 * fq;
#pragma unroll
        for (int b = 0; b < 2; ++b)
#pragma unroll
            for (int n = 0; n < 2; ++n) { const f32x4 bv = bias ? *(const f32x4*)(bias + (size_t)u.e * bias_estride + col0 + b * HALF + 4 * n) : (f32x4){0.f, 0.f, 0.f, 0.f};
#pragma unroll
                for (int a = 0; a < 2; ++a)
#pragma unroll
                    for (int m = 0; m < 4; ++m) acc[a][b][m][n] = bv; }
    }
    __device__ __forceinline__ void operator()(const f32x4 (&acc)[2][2][4][2], const Unit& u, int wr, int wc, int fr, int fq) const {
        const int row0 = u.pm * BM + wr * 64 + fr, col0 = u.pn * BM + wc * 32 + 8 * fq;
#pragma unroll
        for (int ai = 0; ai < 2; ++ai)
#pragma unroll
            for (int m = 0; m < 4; ++m) { bf16_t* rowp = O + (size_t)(row0 + ai * HALF + m * 16) * ldc + (col0 >> 1);
#pragma unroll
                for (int bj = 0; bj < 2; ++bj) { const f32x4 v0 = acc[ai][bj][m][0], v1 = acc[ai][bj][m][1];
                    u32x2 w; w.x = cvt_pk_bf16(swiglu1(v0[0], v0[1]), swiglu1(v0[2], v0[3])); w.y = cvt_pk_bf16(swiglu1(v1[0], v1[1]), swiglu1(v1[2], v1[3]));
                    *(u32x2*)(rowp + bj * (HALF / 2)) = w; } }
    }
};
struct EpiResidual {
    static constexpr bool PERM = false;
    float* X; int ldc; const float* gate_lat; const float* gate_ctx;
    __device__ __forceinline__ void init(f32x4 (&acc)[2][2][4][2], const Unit& u, int wc, int fq) const {
#pragma unroll
        for (int a = 0; a < 2; ++a)
#pragma unroll
            for (int b = 0; b < 2; ++b)
#pragma unroll
                for (int m = 0; m < 4; ++m)
#pragma unroll
                    for (int n = 0; n < 2; ++n) acc[a][b][m][n] = (f32x4){0.f, 0.f, 0.f, 0.f};
    }
    __device__ __forceinline__ void operator()(const f32x4 (&acc)[2][2][4][2], const Unit& u, int wr, int wc, int fr, int fq) const {
        const int row0 = u.pm * BM + wr * 64 + fr, col0 = u.pn * BM + wc * 32 + 4 * fq;
        const float* gp = (u.pm == 0) ? gate_ctx : gate_lat;
        f32x4 gv[2][2];
#pragma unroll
        for (int bj = 0; bj < 2; ++bj)
#pragma unroll
            for (int n = 0; n < 2; ++n) gv[bj][n] = *(const f32x4*)(gp + col0 + bj * HALF + n * 16);
#pragma unroll
        for (int ai = 0; ai < 2; ++ai)
#pragma unroll
            for (int m = 0; m < 4; ++m) { float* rowp = X + (size_t)(row0 + ai * HALF + m * 16) * ldc + col0;
#pragma unroll
                for (int bj = 0; bj < 2; ++bj)
#pragma unroll
                    for (int n = 0; n < 2; ++n) { f32x4* p = (f32x4*)(rowp + bj * HALF + n * 16); *p = *p + gv[bj][n] * acc[ai][bj][m][n]; }
                asm volatile("" ::: "memory"); }
    }
};
template <class Epi, class Sched, bool ALIGN_EPI = false, bool SP2 = false>
__device__ __forceinline__ void gemm_phase(PG8_LAS unsigned char* lds, const int tid, const int K, const Sched& S, const Epi& E) {
    const int wid = __builtin_amdgcn_readfirstlane(tid >> 6), lane = tid & 63, wr = wid >> 2, wc = wid & 3, fr = lane & 15, fq = lane >> 4;
    const int nt = K / BK;
    unsigned voffA[2], voffB[2];
#pragma unroll
    for (int i = 0; i < 2; ++i) { int R, C; stage_rc(tid * 16 + i * 8192, R, C); const int Rb = Epi::PERM ? ((R & ~31) + perm32(R & 31)) : R;
        voffA[i] = (unsigned)(R * K + C) * 2u; voffB[i] = (unsigned)(Rb * K + C) * 2u; }
    const size_t kstep = (size_t)(BK * 2);
    const size_t hstep = (size_t)HALF * K * 2;
        const unsigned ldsw = (unsigned)wid * 1024u;
    const int aoff = lds_byte(wr * 64 + fr, fq * 8), boff = lds_byte(wc * 32 + fr, fq * 8);
#define PG8_SA(b, h) (((b) * 2 + (h)) * HTB)
#define PG8_SB(b, h) ((4 + (b) * 2 + (h)) * HTB)
#define PG8_STAGE(bufoff, gbase, voff) do { _Pragma("unroll") for (int _i = 0; _i < 2; ++_i) \
        __builtin_amdgcn_global_load_lds((const unsigned*)((const char*)(gbase) + (voff)[_i]), (PG8_LAS unsigned*)(lds + (bufoff) + ldsw + _i * 8192), 16, 0, 0); } while (0)
#define PG8_LDA(dst, b, h) do { _Pragma("unroll") for (int m = 0; m < 4; ++m) _Pragma("unroll") for (int k = 0; k < 2; ++k) dst[m][k] = *(const PG8_LAS bf16x8*)(lds + PG8_SA(b, h) + aoff + m * 2048 + k * 1024); } while (0)
#define PG8_LDB(dst, b, h) do { _Pragma("unroll") for (int n = 0; n < 2; ++n) _Pragma("unroll") for (int k = 0; k < 2; ++k) dst[n][k] = *(const PG8_LAS bf16x8*)(lds + PG8_SB(b, h) + boff + n * 2048 + k * 1024); } while (0)
#define PG8_MMA(ai, bj, At, Bt) do { __builtin_amdgcn_s_setprio(1); _Pragma("unroll") for (int m = 0; m < 4; ++m) _Pragma("unroll") for (int n = 0; n < 2; ++n) _Pragma("unroll") for (int k = 0; k < 2; ++k) \
        acc[ai][bj][m][n] = __builtin_amdgcn_mfma_f32_16x16x32_bf16(Bt[n][k], At[m][k], acc[ai][bj][m][n], 0, 0, 0); __builtin_amdgcn_s_setprio(0); } while (0)
#define PG8_WAIT_V(n) asm volatile("s_waitcnt vmcnt(" #n ")" ::: "memory")
#define PG8_WAIT_L(n) asm volatile("s_waitcnt lgkmcnt(" #n ")" ::: "memory")
#define PG8_BAR __builtin_amdgcn_s_barrier()
#define PG8_SCHED __builtin_amdgcn_sched_barrier(0)
    Unit cur, nxt; int ui = 0;
    if (!S.next(0, cur)) return;
    f32x4 acc[2][2][4][2];
    E.init(acc, cur, wc, fq);
    bf16x8 At[4][2], B0[2][2], B1[2][2];
    const char* cA = S.pa(cur); const char* cB = S.pb(cur);
    if constexpr (SP2) {
        PG8_STAGE(PG8_SB(0, 0), cB, voffB); PG8_STAGE(PG8_SB(0, 1), cB + hstep, voffB); PG8_STAGE(PG8_SA(0, 0), cA, voffA); PG8_STAGE(PG8_SA(0, 1), cA + hstep, voffA);
        if (wr == 1) PG8_BAR;
        PG8_WAIT_V(2); PG8_BAR;
        PG8_STAGE(PG8_SB(1, 0), cB + kstep, voffB); PG8_STAGE(PG8_SA(1, 0), cA + kstep, voffA); PG8_STAGE(PG8_SB(1, 1), cB + hstep + kstep, voffB);
        PG8_WAIT_V(6); PG8_BAR;
    } else {
        PG8_STAGE(PG8_SB(0, 0), cB, voffB); PG8_STAGE(PG8_SA(0, 0), cA, voffA); PG8_STAGE(PG8_SB(0, 1), cB + hstep, voffB); PG8_STAGE(PG8_SA(0, 1), cA + hstep, voffA);
        if (wr == 1) PG8_BAR;
        PG8_WAIT_V(4); PG8_BAR;
        PG8_STAGE(PG8_SB(1, 0), cB + kstep, voffB); PG8_STAGE(PG8_SA(1, 0), cA + kstep, voffA); PG8_STAGE(PG8_SB(1, 1), cB + hstep + kstep, voffB);
        PG8_WAIT_V(6); PG8_BAR;
    }
    for (;;) {
        const bool has_next = S.next(ui + 1, nxt);
        const char* nA = has_next ? S.pa(nxt) : cA; const char* nB = has_next ? S.pb(nxt) : cB;
        for (int t = 0; t < nt; t += 2) {
            const bool last = (t == nt - 2);
            const char* a1 = cA + (size_t)(t + 1) * kstep;
            const char* a2 = last ? nA : cA + (size_t)(t + 2) * kstep; const char* b2 = last ? nB : cB + (size_t)(t + 2) * kstep;
            const char* a3 = a2 + kstep; const char* b3 = b2 + kstep;
            if constexpr (SP2) {
            PG8_LDB(B0, 0, 0); PG8_LDB(B1, 0, 1); PG8_SCHED; PG8_LDA(At, 0, 0); PG8_STAGE(PG8_SA(1, 1), a1 + hstep, voffA);
            PG8_WAIT_V(8); PG8_WAIT_L(0); PG8_BAR; PG8_MMA(0, 0, At, B0); PG8_MMA(0, 1, At, B1); PG8_BAR; PG8_SCHED;
            PG8_LDA(At, 0, 1); PG8_STAGE(PG8_SB(0, 0), b2, voffB); PG8_STAGE(PG8_SB(0, 1), b2 + hstep, voffB); PG8_STAGE(PG8_SA(0, 0), a2, voffA);
            PG8_WAIT_V(8); PG8_WAIT_L(0); PG8_BAR; PG8_MMA(1, 0, At, B0); PG8_MMA(1, 1, At, B1); PG8_BAR; PG8_SCHED;
            PG8_LDB(B0, 1, 0); PG8_LDB(B1, 1, 1); PG8_SCHED; PG8_LDA(At, 1, 0); PG8_STAGE(PG8_SA(0, 1), a2 + hstep, voffA);
            PG8_WAIT_V(8); PG8_WAIT_L(0); PG8_BAR; PG8_MMA(0, 0, At, B0); PG8_MMA(0, 1, At, B1); PG8_BAR; PG8_SCHED;
            PG8_LDA(At, 1, 1); PG8_STAGE(PG8_SB(1, 0), b3, voffB); PG8_STAGE(PG8_SB(1, 1), b3 + hstep, voffB); PG8_STAGE(PG8_SA(1, 0), a3, voffA);
            PG8_WAIT_V(8); PG8_WAIT_L(0); PG8_BAR; PG8_MMA(1, 0, At, B0); PG8_MMA(1, 1, At, B1); PG8_BAR; PG8_SCHED;
            } else {
            PG8_LDB(B0, 0, 0); PG8_SCHED; PG8_LDA(At, 0, 0); PG8_STAGE(PG8_SA(1, 1), a1 + hstep, voffA);
            PG8_WAIT_L(8); PG8_BAR; PG8_WAIT_L(0); PG8_MMA(0, 0, At, B0); PG8_BAR; PG8_SCHED;
            PG8_LDB(B1, 0, 1); PG8_STAGE(PG8_SB(0, 0), b2, voffB);
            PG8_BAR; PG8_WAIT_L(0); PG8_MMA(0, 1, At, B1); PG8_BAR;
            PG8_LDA(At, 0, 1); PG8_STAGE(PG8_SA(0, 0), a2, voffA);
            PG8_BAR; PG8_WAIT_L(0); PG8_MMA(1, 0, At, B0); PG8_BAR; PG8_SCHED;
            PG8_STAGE(PG8_SB(0, 1), b2 + hstep, voffB);
            PG8_WAIT_V(6); PG8_BAR; PG8_MMA(1, 1, At, B1); PG8_BAR;
            PG8_LDB(B0, 1, 0); PG8_SCHED; PG8_LDA(At, 1, 0); PG8_STAGE(PG8_SA(0, 1), a2 + hstep, voffA);
            PG8_WAIT_L(8); PG8_BAR; PG8_WAIT_L(0); PG8_MMA(0, 0, At, B0); PG8_BAR; PG8_SCHED;
            PG8_LDB(B1, 1, 1); PG8_STAGE(PG8_SB(1, 0), b3, voffB);
            PG8_BAR; PG8_WAIT_L(0); PG8_MMA(0, 1, At, B1); PG8_BAR;
            PG8_LDA(At, 1, 1); PG8_STAGE(PG8_SA(1, 0), a3, voffA);
            PG8_BAR; PG8_WAIT_L(0); PG8_MMA(1, 0, At, B0); PG8_BAR; PG8_SCHED;
            PG8_STAGE(PG8_SB(1, 1), b3 + hstep, voffB);
            PG8_WAIT_V(6); PG8_BAR; PG8_MMA(1, 1, At, B1); PG8_BAR;
            }
        }
        if constexpr (ALIGN_EPI) { if (wr == 0) PG8_BAR; }
        E(acc, cur, wr, wc, fr, fq);
        if (!has_next) break;
        E.init(acc, nxt, wc, fq);
        cur = nxt; cA = nA; cB = nB; ++ui;
        if constexpr (ALIGN_EPI) { if (wr == 1) PG8_BAR; }
    }
    PG8_WAIT_V(0);
    if constexpr (!ALIGN_EPI) { if (wr == 0) PG8_BAR; }
    PG8_BAR;
#undef PG8_SA
#undef PG8_SB
#undef PG8_STAGE
#undef PG8_LDA
#undef PG8_LDB
#undef PG8_MMA
#undef PG8_WAIT_V
#undef PG8_WAIT_L
#undef PG8_BAR
#undef PG8_SCHED
}
}

#define XB_TMO      128
#define XB_XCNT(j)  (256  + 64 * (j))
#define XB_XSUB(j)  (1280 + 64 * (j))
#define XB_XGEN(j)  (2304 + 64 * (j))
#define XB_TOP      3328
#define XB_TOPGEN   3392
#define XCD_BAR_WORDS 3456
#define XB_SPIN_CAP (1u << 18)
__device__ __forceinline__ unsigned xb_ld(unsigned* p)              { return __hip_atomic_load(p, __ATOMIC_RELAXED, __HIP_MEMORY_SCOPE_AGENT); }
__device__ __forceinline__ unsigned xb_add(unsigned* p, unsigned v) { return __hip_atomic_fetch_add(p, v, __ATOMIC_RELAXED, __HIP_MEMORY_SCOPE_AGENT); }
__device__ __forceinline__ unsigned xb_xcc_id() { return (unsigned)__builtin_amdgcn_s_getreg((3 << 11) | 20) & 0xFu; }
#define XB_SPIN(cond, bar) do { unsigned _sp = 0; while (cond) { __builtin_amdgcn_s_sleep(1); \
    if ((++_sp & 255u) == 0u) { if (xb_ld(&(bar)[XB_TMO])) break; if (_sp > XB_SPIN_CAP) { atomicAdd(&(bar)[XB_TMO], 1u); break; } } } } while (0)

struct XcdBarrier {
    unsigned* bar; unsigned x;
    volatile LAS unsigned* st;
};

__device__ __forceinline__ XcdBarrier xcd_barrier_post(unsigned* bar, volatile LAS unsigned* st) {
    XcdBarrier b; b.bar = bar; b.x = xb_xcc_id(); b.st = st;
    if (threadIdx.x == 0) (void)xb_add(&bar[XB_XCNT(b.x)], 1u);
    return b;
}
__device__ __forceinline__ void xcd_barrier_complete(unsigned* bar, unsigned x, unsigned& nloc, unsigned& nx) {
    const unsigned G = gridDim.x * gridDim.y * gridDim.z;
    unsigned sum, cnt, mine, sp = 0u;
    for (;;) {
        sum = 0u; cnt = 0u; mine = 0u;
#pragma unroll
        for (unsigned j = 0; j < 16; ++j) { const unsigned c = xb_ld(&bar[XB_XCNT(j)]); sum += c; cnt += (c > 0u) ? 1u : 0u; mine = (j == x) ? c : mine; }
        if (sum == G) break;
        __builtin_amdgcn_s_sleep(1);
        if ((++sp & 255u) == 0u) { if (xb_ld(&bar[XB_TMO])) break; if (sp > XB_SPIN_CAP) { atomicAdd(&bar[XB_TMO], 1u); break; } }
    }
    nloc = mine > 0u ? mine : 1u; nx = cnt > 0u ? cnt : 1u;
}

__device__ __forceinline__ void xcd_barrier(const XcdBarrier& b) {
    asm volatile("s_waitcnt vmcnt(0)" ::: "memory");
    __syncthreads();
    if (threadIdx.x == 0) {
        unsigned* bar = b.bar;
        __builtin_amdgcn_s_waitcnt(0);
        unsigned nloc = b.st[0], nx = b.st[1];
        if (nloc == 0u) { xcd_barrier_complete(bar, b.x, nloc, nx); b.st[0] = nloc; b.st[1] = nx; }
        const unsigned old = xb_add(&bar[XB_XSUB(b.x)], 1u);
        const unsigned gen = old / nloc;
        if (old + 1u == (gen + 1u) * nloc) {
            __builtin_amdgcn_fence(__ATOMIC_RELEASE, "agent");
            asm volatile("s_waitcnt vmcnt(0)" ::: "memory");
            const unsigned og = xb_add(&bar[XB_TOP], 1u);
            const unsigned tg = og / nx;
            if (og + 1u == (tg + 1u) * nx) xb_add(&bar[XB_TOPGEN], 1u);
            else XB_SPIN(xb_ld(&bar[XB_TOPGEN]) == tg, bar);
            __builtin_amdgcn_fence(__ATOMIC_ACQUIRE, "agent");
            xb_add(&bar[XB_XGEN(b.x)], 1u);
            asm volatile("s_waitcnt vmcnt(0)" ::: "memory");
        } else {
            XB_SPIN(xb_ld(&bar[XB_XGEN(b.x)]) == gen, bar);
            __builtin_amdgcn_fence(__ATOMIC_ACQUIRE, "agent");
            asm volatile("s_waitcnt vmcnt(0)" ::: "memory");
        }
    }
    __syncthreads();
}

typedef short s4v __attribute__((ext_vector_type(4)));
__device__ __forceinline__ bf16x8 ldg8(const bf16* p) { return *(const bf16x8*)p; }
__device__ __forceinline__ f32x4 mfma16(bf16x8 a, bf16x8 b, f32x4 c) { return __builtin_amdgcn_mfma_f32_16x16x32_bf16(a, b, c, 0, 0, 0); }
__device__ __forceinline__ bf16x8 ldA(const LAS unsigned char* base, int pitch, int row0, int k0, int li, int g) { return *(const LAS bf16x8*)(base + ((row0 + li) * pitch + k0 + 8 * g) * 2); }
__device__ __forceinline__ bf16x8 ldT(const LAS unsigned char* base, int pitch, int k0, int n0, int li, int g) {
    const LAS unsigned char* p = base + ((k0 + 8 * g + (li >> 2)) * pitch + n0 + 4 * (li & 3)) * 2;
    const s4v a = __builtin_amdgcn_ds_read_tr16_b64_v4i16((LAS s4v*)p), b = __builtin_amdgcn_ds_read_tr16_b64_v4i16((LAS s4v*)(p + 8 * pitch));
    return (bf16x8){a[0], a[1], a[2], a[3], b[0], b[1], b[2], b[3]};
}
__device__ __forceinline__ bf16x8 ldAperm(const LAS unsigned char* base, int pitch, int row0, int ks, int li, int g) {
    const LAS unsigned char* p = base + ((row0 + li) * pitch + 32 * ks + 4 * g) * 2;
    const s4v a = *(const LAS s4v*)p, b = *(const LAS s4v*)(p + 32);
    return (bf16x8){a[0], a[1], a[2], a[3], b[0], b[1], b[2], b[3]};
}
__device__ __forceinline__ void stT(LAS unsigned char* base, int pitch, int n, int m0, const f32x4 v) {
    u32x2 w; w.x = pk2(v[0], v[1]); w.y = pk2(v[2], v[3]); *(LAS u32x2*)(base + (n * pitch + m0) * 2) = w;
}
__device__ __forceinline__ f32x4 ld4bf(const LAS unsigned char* p) { const u32x2 w = *(const LAS u32x2*)p; return (f32x4){bflo(w.x), bfhi(w.x), bflo(w.y), bfhi(w.y)}; }

struct Args {
    const float* in[31];
    float* out; unsigned char* ws;
    int ph_lo, ph_hi, use_bar, pad;
};
enum InIdx { I_X = 0, I_C, I_CTX, I_CCTX, I_ADAW, I_ADAB, I_N1G, I_N2G, I_WIN, I_WOUT, I_ASINK, I_BMIX, I_CREL, I_DCONV, I_DW0, I_DW2, I_DA0, I_DA2, I_DG2, I_DKK, I_DKA, I_DRK, I_DLNW, I_DLNB,
             I_RW, I_RB, I_WGU, I_BGU, I_WDN, I_BDN, I_FNG };
constexpr int NPL = 11;
constexpr int PH_TOTAL = 1 + DEPTH * NPL + 1;

struct DevIn {
    const LAS unsigned* tab;
    __device__ __forceinline__ const float* operator[](int i) const {
        const unsigned lo = __builtin_amdgcn_readfirstlane(((const volatile LAS unsigned*)tab)[2 * i]), hi = __builtin_amdgcn_readfirstlane(((const volatile LAS unsigned*)tab)[2 * i + 1]);
        return (const float*)(((unsigned long long)hi << 32) | lo);
    }
};
struct DArgs { DevIn in; float* out; };
struct Ctx {
    LAS unsigned char* lds;
    int tid, lane, wave, wg, G, gw, NGW;
    unsigned char* ws;
};

template <int NW>
__device__ __forceinline__ void transpose_item(const float* W, int K, int N, bf16* WT, int item, int lane) {
    constexpr int NQ = NW / 4, NC = 64 / NQ, PASSES = 8 / NC;
    const int nblk = N / NW, kb = item / nblk, nb = item % nblk, k0 = 64 * kb, n0 = NW * nb, nq = lane % NQ, cq = lane / NQ;
    f32x4 v[PASSES][8];
#pragma unroll
    for (int ps = 0; ps < PASSES; ++ps)
#pragma unroll
        for (int i = 0; i < 8; ++i) v[ps][i] = *(const f32x4*)(W + (size_t)(k0 + 8 * (cq + NC * ps) + i) * N + n0 + 4 * nq);
#pragma unroll
    for (int ps = 0; ps < PASSES; ++ps)
#pragma unroll
        for (int j = 0; j < 4; ++j) { u32x4 o; o.x = pk2(v[ps][0][j], v[ps][1][j]); o.y = pk2(v[ps][2][j], v[ps][3][j]); o.z = pk2(v[ps][4][j], v[ps][5][j]); o.w = pk2(v[ps][6][j], v[ps][7][j]);
            *(u32x4*)(WT + (size_t)(n0 + 4 * nq + j) * K + k0 + 8 * (cq + NC * ps)) = o; }
}
__device__ __forceinline__ void phase_prologue(const Ctx& C, const DArgs& a) {
    constexpr int IT_IN = 16 * (INW / 32), IT_OUT = 16 * 16, IT_GU = 16 * 32, IT_DN = 16 * 16;
    constexpr long N_IN = 4L * IT_IN, N_OUT = 4L * IT_OUT, N_GU = 128L * IT_GU, N_DN = 128L * IT_DN, N_ALL = N_IN + N_OUT + N_GU + N_DN;
    const float* pwin = a.in[I_WIN]; const float* pwout = a.in[I_WOUT]; const float* pwgu = a.in[I_WGU]; const float* pwdn = a.in[I_WDN];
    for (long it = C.gw; it < N_ALL; it += C.NGW) {
        long r = it;
        if (r < N_IN) { const int l = (int)(r / IT_IN); transpose_item<32>(pwin + (size_t)l * DM * INW, DM, INW, (bf16*)(C.ws + WS_WIN) + (size_t)l * INWP * DM, (int)(r % IT_IN), C.lane); continue; } r -= N_IN;
        if (r < N_OUT) { const int l = (int)(r / IT_OUT); transpose_item<64>(pwout + (size_t)l * DM * DM, DM, DM, (bf16*)(C.ws + WS_WOUT) + (size_t)l * DM * DM, (int)(r % IT_OUT), C.lane); continue; } r -= N_OUT;
        if (r < N_GU) { const int le = (int)(r / IT_GU); transpose_item<64>(pwgu + (size_t)le * DM * 2048, DM, 2048, (bf16*)(C.ws + WS_WGU) + (size_t)le * 2048 * DM, (int)(r % IT_GU), C.lane); continue; } r -= N_GU;
        { const int le = (int)(r / IT_DN); transpose_item<64>(pwdn + (size_t)le * DM * DM, DM, DM, (bf16*)(C.ws + WS_WDN) + (size_t)le * DM * DM, (int)(r % IT_DN), C.lane); }
    }
    { const int gt = C.wg * NTHR + C.tid; constexpr int PADN = (INWP - INW) * DM / 8;
      for (int i = gt; i < 4 * PADN; i += C.G * NTHR) { const int l = i / PADN, r = i % PADN; *((u32x4*)((bf16*)(C.ws + WS_WIN) + ((size_t)l * INWP + INW) * DM) + r) = (u32x4){0u, 0u, 0u, 0u}; } }
    { float* tw = (float*)(C.ws + WS_TW); const int gt = C.wg * NTHR + C.tid;
      for (int i = gt; i < 16384; i += C.G * NTHR) { const float x = (float)i * (1.0f / 8192.0f); tw[i] = cospif(x); tw[16384 + i] = sinpif(x); } }
    { float* mt = (float*)(C.ws + WS_MTAB); const int gt = C.wg * NTHR + C.tid; const float* pbmix = a.in[I_BMIX];
      for (int i = gt; i < 4 * 4 * 64 * 64; i += C.G * NTHR) { const int e = i & 63, c = (i >> 6) & 63, g = (i >> 12) & 3, l = i >> 14;
          const float* w = pbmix + ((size_t)(l * 4 + g) * 64) * 64 + e; float sc = 0.f, ss = 0.f;
          for (int cp = 0; cp < 64; ++cp) { const float x = (float)((c * cp) & 63) * (1.0f / 32.0f); const float wv = w[cp * 64]; sc += cospif(x) * wv; ss += sinpif(x) * wv; }
          mt[((size_t)(l * 2 + 0) * 4 + g) * 4096 + c * 64 + e] = sc; mt[((size_t)(l * 2 + 1) * 4 + g) * 4096 + c * 64 + e] = ss; } }
    { bf16* ft = (bf16*)(C.ws + WS_FTAB); const int gt = C.wg * NTHR + C.tid; const float* pbmix = a.in[I_BMIX];
      for (int i = gt; i < 128 * 128; i += C.G * NTHR) { const int k = i >> 7, t = i & 127; const float x = (float)((k * t) & 127) * (1.0f / 64.0f); ft[i] = (bf16)f2bf(cospif(x)); ft[16384 + i] = (bf16)f2bf(sinpif(x)); }
      bf16* mf = ft + 32768;
      for (int i = gt; i < 4 * 4 * 16 * 64 * 8; i += C.G * NTHR) { const int j8 = i & 7, ln = (i >> 3) & 63, fr = (i >> 9) & 15, gq = (i >> 13) & 3, l = i >> 15;
          const int ei = fr >> 2, ks2 = fr & 3, e = 16 * ei + (ln & 15), g = ln >> 4, c = 32 * (ks2 & 1) + 16 * (j8 >> 2) + 4 * g + (j8 & 3), part = ks2 >> 1;
          const float* w = pbmix + ((size_t)(l * 4 + gq) * 64) * 64 + e; float s = 0.f;
          for (int cp = 0; cp < 64; ++cp) { const float x = (float)((c * cp) & 63) * (1.0f / 32.0f); s += (part ? sinpif(x) : cospif(x)) * w[cp * 64]; }
          mf[i] = (bf16)f2bf(s * (1.0f / 1024.0f)); } }
    { const int gt = C.wg * NTHR + C.tid; const float* pg2 = a.in[I_DG2]; const float* prw = a.in[I_RW]; bf16* g2t = (bf16*)(C.ws + WS_G2T); bf16* rwt = (bf16*)(C.ws + WS_RWT);
      for (int i = gt; i < 4 * 256 * 160; i += C.G * NTHR) { const int ii = i % 160, c = (i / 160) & 255, l = i / (160 * 256); g2t[i] = (bf16)f2bf(pg2[((size_t)l * 160 + ii) * 256 + c]); }
      for (int i = gt; i < 4 * 32 * 1024; i += C.G * NTHR) { const int k = i & 1023, e = (i >> 10) & 31, l = i >> 15; rwt[i] = (bf16)f2bf(prw[((size_t)l * 1024 + k) * 32 + e]); } }
    { const int gt = C.wg * NTHR + C.tid; const float* pw2 = a.in[I_DW2]; const float* pa2 = a.in[I_DA2]; bf16* lt = (bf16*)(C.ws + WS_LORAT);
      for (int i = gt; i < 4 * 4 * 256 * 64; i += C.G * NTHR) { const int ii = i & 63, c = (i >> 6) & 255, q = (i >> 14) & 3, l = i >> 16;
          const float* src = (q < 2) ? pw2 : pa2; lt[i] = (bf16)f2bf(src[(((size_t)l * 2 + (q & 1)) * 64 + ii) * 256 + c]); } }
    { bf16* f2 = (bf16*)(C.ws + WS_F256); const int gt = C.wg * NTHR + C.tid;
      for (int i = gt; i < 256 * 256; i += C.G * NTHR) { const int k = i >> 8, t = i & 255; const float x = (float)((k * t) & 255) * (1.0f / 128.0f); f2[i] = (bf16)f2bf(cospif(x)); f2[65536 + i] = (bf16)f2bf(sinpif(x)); } }
    { LAS float* red = (LAS float*)(C.lds);
      __syncthreads();
      float* mod = (float*)(C.ws + WS_MOD);
      const float* pc = a.in[I_C]; const float* pcc = a.in[I_CCTX]; const float* padaw = a.in[I_ADAW]; const float* padab = a.in[I_ADAB];
      for (int u = C.wg; u < 4 * 24; u += C.G) { const int l = u / 24, jb = u % 24, j0 = jb * 256 + 4 * C.lane;
          f32x4 s0 = {0.f, 0.f, 0.f, 0.f}, s1 = {0.f, 0.f, 0.f, 0.f};
          const float* w = padaw + (size_t)l * DM * 6144 + j0;
          for (int k = C.wave * 128; k < C.wave * 128 + 128; ++k) { const float c0 = pc[k], c1 = pcc[k]; const float a0 = c0 * sigmoidf_(c0), a1 = c1 * sigmoidf_(c1);
              const f32x4 wv = *(const f32x4*)(w + (size_t)k * 6144); s0 += wv * a0; s1 += wv * a1; }
          *(LAS f32x4*)(red + ((C.wave * 2 + 0) * 64 + C.lane) * 4) = s0; *(LAS f32x4*)(red + ((C.wave * 2 + 1) * 64 + C.lane) * 4) = s1;
          __syncthreads();
          if (C.tid < 512) { const int v = C.tid >> 8, j = C.tid & 255; float s = 0.f;
#pragma unroll
              for (int wv = 0; wv < 8; ++wv) s += red[(wv * 2 + v) * 256 + j];
              mod[(size_t)(l * 2 + v) * 6144 + jb * 256 + j] = s + padab[(size_t)l * 6144 + jb * 256 + j]; }
          __syncthreads(); } }
}

__device__ __forceinline__ void load_row(const float* p, int lane, f32x4 (&v)[4]) {
#pragma unroll
    for (int j = 0; j < 4; ++j) v[j] = *((const f32x4*)p + lane + 64 * j);
}
__device__ __forceinline__ void moe_combine_row(const Ctx& C, int row, f32x4 (&v)[4], const float* gt2) {
    const int* dest = (const int*)(C.ws + WS_ROUTE) + (size_t)3 * ROWS * 4; const float* gate = (const float*)(C.ws + WS_ROUTE) + (size_t)1 * ROWS * 4;
    const bf16* YB = (const bf16*)(C.ws + WS_XG);
    f32x4 s[4];
#pragma unroll
    for (int j = 0; j < 4; ++j) s[j] = (f32x4){0.f, 0.f, 0.f, 0.f};
#pragma unroll
    for (int k = 0; k < 4; ++k) { const int d = dest[row * 4 + k]; const float g = gate[row * 4 + k]; const u32x2* yp = (const u32x2*)(YB + (size_t)d * DM) + C.lane;
#pragma unroll
        for (int j = 0; j < 4; ++j) { const u32x2 w = yp[64 * j]; s[j] += (f32x4){bflo(w.x), bfhi(w.x), bflo(w.y), bfhi(w.y)} * g; } }
#pragma unroll
    for (int j = 0; j < 4; ++j) v[j] += *((const f32x4*)gt2 + C.lane + 64 * j) * s[j];
}
__device__ __forceinline__ float row_rstd(const f32x4 (&v)[4], int lane) {
    float s = 0.f;
#pragma unroll
    for (int j = 0; j < 4; ++j) s += (v[j].x * v[j].x + v[j].y * v[j].y) + (v[j].z * v[j].z + v[j].w * v[j].w);
    return rsqrtf(wave_sum(s, lane) * (1.f / DM) + 1e-6f);
}
__device__ __forceinline__ void phase_norm1(const Ctx& C, const DArgs& a, int l) {
    float* XS = (float*)(C.ws + WS_XS); bf16* H = (bf16*)(C.ws + WS_H); const float* mod = (const float*)(C.ws + WS_MOD);
    const float* g1 = a.in[I_N1G] + (size_t)l * DM;
    const float* pctx = a.in[I_CTX]; const float* px = a.in[I_X];
    for (int row = C.gw; row < ROWS; row += C.NGW) {
        const bool isctx = row < NCTX; f32x4 v[4];
        if (l == 0) { load_row(isctx ? pctx + (size_t)row * DM : px + (size_t)(row - NCTX) * DM, C.lane, v); }
        else { load_row(XS + (size_t)row * DM, C.lane, v);
               if (!(l == DEPTH && isctx)) moe_combine_row(C, row, v, mod + (size_t)((l - 1) * 2 + (isctx ? 1 : 0)) * 6144 + 5 * DM); }
        if (l == 0 || true) {
#pragma unroll
            for (int j = 0; j < 4; ++j) *((f32x4*)(XS + (size_t)row * DM) + C.lane + 64 * j) = v[j]; }
        const float rstd = row_rstd(v, C.lane);
        const float* md = mod + (size_t)(l * 2 + (isctx ? 1 : 0)) * 6144;
        u32x2* o = (u32x2*)(H + (size_t)row * DM) + C.lane;
#pragma unroll
        for (int j = 0; j < 4; ++j) { const f32x4 g = *((const f32x4*)g1 + C.lane + 64 * j), sh = *((const f32x4*)md + C.lane + 64 * j), sc = *((const f32x4*)(md + DM) + C.lane + 64 * j);
            const f32x4 y = v[j] * rstd * g * (sc + 1.0f) + sh; u32x2 w; w.x = pk2(y.x, y.y); w.y = pk2(y.z, y.w); o[64 * j] = w; }
    }
}
__device__ __forceinline__ void phase_final(const Ctx& C, const DArgs& a) {
    const float* XS = (const float*)(C.ws + WS_XS); const float* mod = (const float*)(C.ws + WS_MOD); const float* g = a.in[I_FNG];
    for (int row = NCTX + C.gw; row < ROWS; row += C.NGW) {
        f32x4 v[4]; load_row(XS + (size_t)row * DM, C.lane, v);
        moe_combine_row(C, row, v, mod + (size_t)((DEPTH - 1) * 2 + 0) * 6144 + 5 * DM);
        const float rstd = row_rstd(v, C.lane);
        float* o = a.out + (size_t)(row - NCTX) * DM;
#pragma unroll
        for (int j = 0; j < 4; ++j) *((f32x4*)o + C.lane + 64 * j) = v[j] * rstd * *((const f32x4*)g + C.lane + 64 * j);
    }
}
constexpr int NR2 = 9;
__device__ __forceinline__ void phase_norm2(const Ctx& C, const DArgs& a, int l) {
    const float* XS = (const float*)(C.ws + WS_XS); bf16* H = (bf16*)(C.ws + WS_H); const float* mod = (const float*)(C.ws + WS_MOD);
    const float* g2 = a.in[I_N2G] + (size_t)l * DM; const float* rb = a.in[I_RB] + (size_t)l * NEXP; const bf16* rwt = (const bf16*)(C.ws + WS_RWT) + (size_t)l * NEXP * DM;
    int* tok_e = (int*)(C.ws + WS_ROUTE); float* gate = (float*)(C.ws + WS_ROUTE) + (size_t)1 * ROWS * 4; int* slot = (int*)(C.ws + WS_ROUTE) + (size_t)2 * ROWS * 4;
    LAS float* lg = (LAS float*)(C.lds + C.wave * 4096);
    LAS int* hist = (LAS int*)(C.lds + MISC_OFF + 64);
    const int lane = C.lane, li = lane & 15, g = lane >> 4;
    if (C.tid < NEXP) hist[C.tid] = 0;
    __syncthreads();
    const int row_base = (l == DEPTH - 1) ? NCTX : 0, ntile = (ROWS - row_base + NR2 - 1) / NR2;
    for (int tl = C.gw; tl < ntile; tl += C.NGW) {
        const int trow0 = row_base + NR2 * tl, nrow = (ROWS - trow0 < NR2) ? ROWS - trow0 : NR2;
#pragma unroll 1
        for (int rr = 0; rr < nrow; ++rr) { const int row = trow0 + rr; const bool isctx = row < NCTX; f32x4 v[4]; load_row(XS + (size_t)row * DM, lane, v);
            const float rstd = row_rstd(v, lane);
            const float* md = mod + (size_t)(l * 2 + (isctx ? 1 : 0)) * 6144 + 3 * DM;
            u32x2* o = (u32x2*)(H + (size_t)row * DM) + lane;
#pragma unroll
            for (int j = 0; j < 4; ++j) { const f32x4 gg = *((const f32x4*)g2 + lane + 64 * j), sh = *((const f32x4*)md + lane + 64 * j), sc = *((const f32x4*)(md + DM) + lane + 64 * j);
                const f32x4 y = v[j] * rstd * gg * (sc + 1.0f) + sh; u32x2 w; w.x = pk2(y.x, y.y); w.y = pk2(y.z, y.w); o[64 * j] = w; } }
        asm volatile("s_waitcnt vmcnt(0)" ::: "memory");
        f32x4 acc0 = {0.f, 0.f, 0.f, 0.f}, acc1 = {0.f, 0.f, 0.f, 0.f};
        const int arow = (trow0 + li < ROWS) ? trow0 + li : ROWS - 1;
        const bf16* ap = H + (size_t)arow * DM + 8 * g; const bf16* bp0 = rwt + (size_t)li * DM + 8 * g; const bf16* bp1 = bp0 + 16 * DM;
#pragma unroll 4
        for (int ks = 0; ks < 32; ++ks) { const bf16x8 af = *(const bf16x8*)(ap + 32 * ks); acc0 = mfma16(af, *(const bf16x8*)(bp0 + 32 * ks), acc0); acc1 = mfma16(af, *(const bf16x8*)(bp1 + 32 * ks), acc1); }
#pragma unroll
        for (int r = 0; r < 4; ++r) { lg[(4 * g + r) * 33 + li] = acc0[r]; lg[(4 * g + r) * 33 + 16 + li] = acc1[r]; }
        LDS_WAIT(); asm volatile("" ::: "memory");
        const int e = lane & 31; const float rbe = rb[e];
#pragma unroll 1
        for (int rr = 0; rr < nrow; ++rr) { const int row = trow0 + rr;
            float val = lg[rr * 33 + e] + rbe; int te[4]; float tv[4];
#pragma unroll
            for (int k = 0; k < 4; ++k) { float bv = val; int bi = e;
#pragma unroll
                for (int o2 = 1; o2 < 32; o2 <<= 1) { const float ov = shx(bv, o2, lane); const int oi = shxi(bi, o2, lane); if (ov > bv || (ov == bv && oi < bi)) { bv = ov; bi = oi; } }
                te[k] = bi; tv[k] = bv; if (e == bi) val = -3.0e38f; }
            if (lane == 0) { const float m = tv[0]; float p[4], ps = 0.f;
#pragma unroll
                for (int k = 0; k < 4; ++k) { p[k] = __expf(tv[k] - m); ps += p[k]; }
#pragma unroll
                for (int k = 0; k < 4; ++k) { tok_e[row * 4 + k] = te[k]; gate[row * 4 + k] = p[k] / ps; slot[row * 4 + k] = __hip_atomic_fetch_add(&hist[te[k]], 1, __ATOMIC_RELAXED, __HIP_MEMORY_SCOPE_WORKGROUP); } } }
        asm volatile("" ::: "memory");
    }
    __syncthreads();
    if (C.tid < NEXP) ((int*)(C.ws + WS_CNT))[C.wg * NEXP + C.tid] = hist[C.tid];
}
__device__ __forceinline__ int moe_tables(const Ctx& C) {
    const int* cnt = (const int*)(C.ws + WS_CNT);
    LAS int* part = (LAS int*)(C.lds);
    LAS int* pstart = (LAS int*)(C.lds + MISC_OFF + 256); LAS int* wgbase = pstart + 40; LAS int* tot = wgbase + 32; LAS int* nblk_s = tot + 32;
    LAS unsigned char* blk_e = (LAS unsigned char*)(C.lds + MISC_OFF + 1024);
    __syncthreads();
    { const int e = C.tid & 31, p = C.tid >> 5; int t = 0, pre = 0;
#pragma unroll 1
      for (int w = p * 16; w < p * 16 + 16; ++w) { const int c = cnt[w * NEXP + e]; t += c; if (w < C.wg) pre += c; }
      part[(p * 32 + e) * 2] = t; part[(p * 32 + e) * 2 + 1] = pre; }
    __syncthreads();
    if (C.tid < NEXP) { int t = 0, pre = 0;
#pragma unroll 1
        for (int p = 0; p < 16; ++p) { t += part[(p * 32 + C.tid) * 2]; pre += part[(p * 32 + C.tid) * 2 + 1]; }
        tot[C.tid] = t; wgbase[C.tid] = pre; }
    __syncthreads();
    if (C.tid == 0) { int b = 0;
#pragma unroll 1
        for (int e = 0; e < NEXP; ++e) { pstart[e] = b * 256; b += (tot[e] + 255) >> 8; }
        pstart[NEXP] = b * 256; nblk_s[0] = b; }
    __syncthreads();
    if (C.tid < NEXP) wgbase[C.tid] += pstart[C.tid];
    if (C.tid < MOE_MAXBLK) { int e = 0;
#pragma unroll 1
        for (int k = 1; k < NEXP; ++k) if (pstart[k] <= C.tid * 256) e = k;
        blk_e[C.tid] = (unsigned char)e; }
    __syncthreads();
    return __builtin_amdgcn_readfirstlane(nblk_s[0]);
}
__device__ __forceinline__ void phase_gather(const Ctx& C, const DArgs& a, int l) {
    moe_tables(C);
    const LAS int* wgbase = (const LAS int*)(C.lds + MISC_OFF + 256) + 40;
    const int* tok_e = (const int*)(C.ws + WS_ROUTE); const int* slot = (const int*)(C.ws + WS_ROUTE) + (size_t)2 * ROWS * 4; int* dest = (int*)(C.ws + WS_ROUTE) + (size_t)3 * ROWS * 4;
    const bf16* H = (const bf16*)(C.ws + WS_H); bf16* XG = (bf16*)(C.ws + WS_XG);
    const int row_base = (l == DEPTH - 1) ? NCTX : 0, ntile = (ROWS - row_base + NR2 - 1) / NR2;
    for (int tl = C.gw; tl < ntile; tl += C.NGW)
    for (int row = row_base + NR2 * tl; row < row_base + NR2 * tl + NR2 && row < ROWS; ++row) {
        const u32x4* src = (const u32x4*)(H + (size_t)row * DM) + C.lane; const u32x4 v0 = src[0], v1 = src[64];
#pragma unroll
        for (int k = 0; k < 4; ++k) { const int d = wgbase[tok_e[row * 4 + k]] + slot[row * 4 + k]; if (C.lane == 0) dest[row * 4 + k] = d;
            u32x4* dp = (u32x4*)(XG + (size_t)d * DM) + C.lane; dp[0] = v0; dp[64] = v1; }
    }
}

__device__ __forceinline__ void mix1_rope(const Ctx& C) {
    bf16* P = (bf16*)(C.ws + WS_P);
    const long total = (long)SEQ * 192;
    for (long i = (long)C.wg * NTHR + C.tid; i < total; i += (long)C.G * NTHR) {
        const int j = (int)(i & 31), hh = (int)((i >> 5) % 6), t = (int)(i / 192);
        const int col = (hh < 4) ? (C_AQ + hh * 64) : (C_AK + (hh - 4) * 64);
        const float pos = (j < 16) ? (float)(t >> 6) : (float)(t & 63);
        const float inv = __powf(10000.0f, -(float)(j & 15) * (1.0f / 16.0f));
        const float ang = pos * inv * 0.31830988618379067f;
        const float cs = cospif(ang), sn = sinpif(ang);
        bf16* p = P + (size_t)(NCTX + t) * INWP + col;
        const float x1 = bf2f(p[j]), x2 = bf2f(p[j + 32]);
        p[j] = (bf16)f2bf(x1 * cs - x2 * sn); p[j + 32] = (bf16)f2bf(x2 * cs + x1 * sn);
    }
}
__device__ __forceinline__ void mix1_vt(const Ctx& C) {
    const bf16* P = (const bf16*)(C.ws + WS_P);
    LAS unsigned short* scr = (LAS unsigned short*)(C.lds + C.wave * 16384);
    for (int u = C.gw; u < (ROWS / 64) * 6; u += C.NGW) {
        const int hd = u % 6, tb = u / 6; const int vcol = (hd < 2) ? (C_AV + hd * 64) : (C_CV + (hd - 2) * 64);
        bf16* VT = ((hd < 2) ? (bf16*)(C.ws + WS_VTA) + (size_t)hd * 64 * VTP : (bf16*)(C.ws + WS_VTC) + (size_t)(hd - 2) * 64 * VTP);
#pragma unroll
        for (int i = 0; i < 8; ++i) { const int tk = (C.lane >> 3) + 8 * i, ch = C.lane & 7; const u32x4 w = *(const u32x4*)(P + (size_t)(tb * 64 + tk) * INWP + vcol + 8 * ch);
            LAS unsigned* d = (LAS unsigned*)(scr + tk * 66 + 8 * ch); d[0] = w.x; d[1] = w.y; d[2] = w.z; d[3] = w.w; }
        LDS_WAIT(); asm volatile("" ::: "memory");
#pragma unroll
        for (int k8 = 0; k8 < 8; ++k8) { unsigned w[4];
#pragma unroll
            for (int e2 = 0; e2 < 4; ++e2) { const unsigned lo = scr[(8 * k8 + 2 * e2) * 66 + C.lane], hi = scr[(8 * k8 + 2 * e2 + 1) * 66 + C.lane]; w[e2] = lo | (hi << 16); }
            *(u32x4*)(VT + (size_t)C.lane * VTP + tb * 64 + 8 * k8) = (u32x4){w[0], w[1], w[2], w[3]}; }
        LDS_WAIT(); asm volatile("" ::: "memory");
    }
    for (int i = C.wg * NTHR + C.tid; i < 6 * 64 * 32; i += C.G * NTHR) { const int rowi = i >> 5, pc = i & 31; const int hd = rowi >> 6, d = rowi & 63;
        bf16* VT = ((hd < 2) ? (bf16*)(C.ws + WS_VTA) + (size_t)hd * 64 * VTP : (bf16*)(C.ws + WS_VTC) + (size_t)(hd - 2) * 64 * VTP);
        *(u32x4*)(VT + (size_t)d * VTP + ROWS + 8 * pc) = (u32x4){0u, 0u, 0u, 0u}; }
}
__device__ __forceinline__ float conv3(const bf16* P, int row, int col, const float* cw, int cc) {
    const bool first = (row == 0) || (row == NCTX), last = (row == NCTX - 1) || (row == ROWS - 1);
    float s = cw[768 + cc] * bf2f(P[(size_t)row * INWP + col]);
    if (!first) s += cw[cc] * bf2f(P[(size_t)(row - 1) * INWP + col]);
    if (!last) s += cw[2 * 768 + cc] * bf2f(P[(size_t)(row + 1) * INWP + col]);
    return s;
}
__device__ __forceinline__ void mix1_rwkv_prep(const Ctx& C, const DArgs& a, int l) {
    const bf16* P = (const bf16*)(C.ws + WS_P); float* SC = (float*)(C.ws + WS_SC);
    constexpr int LBP = 264;
    LAS unsigned char* lob = C.lds;
    LAS float* pre = (LAS float*)(C.lds + 16384);
    const bf16* lorat = (const bf16*)(C.ws + WS_LORAT) + (size_t)l * 4 * 256 * 64;
    const float* cw = a.in[I_DCONV] + (size_t)l * 3 * 768;
    const float* w0 = a.in[I_DW0] + (size_t)l * 512; const float* a0 = a.in[I_DA0] + (size_t)l * 512;
    const float* kkw = a.in[I_DKK] + (size_t)l * 256; const float* kaw = a.in[I_DKA] + (size_t)l * 256;
    const int half = C.tid >> 8, c = C.tid & 255, lane = C.lane, li = lane & 15, g = lane >> 4;
    const float kkc = kkw[c], kac = kaw[c];
    for (int grp = C.wg; grp < ROWS / 13; grp += C.G) {
        const int row0 = 13 * grp + 7 * half, nj = 7 - half;
        __syncthreads();
#pragma unroll
        for (int j = 0; j < 7; ++j) if (j < nj) { const float x = bf2f(P[(size_t)(row0 + j) * INWP + C_WL + c]); *(LAS bf16*)(lob + ((7 * half + j) * LBP + c) * 2) = (bf16)f2bf((c < 128) ? tanhf(x) : x); }
        __syncthreads();
#pragma unroll
        for (int q = 0; q < 4; ++q) { const bf16x8 a0f = ldA(lob, LBP, 0, 64 * q, li, g), a1f = ldA(lob, LBP, 0, 64 * q + 32, li, g);
#pragma unroll
            for (int c2 = 0; c2 < 2; ++c2) { const int ci = 2 * C.wave + c2; const bf16* bp = lorat + ((size_t)q * 256 + 16 * ci + li) * 64 + 8 * g;
                f32x4 acc = {0.f, 0.f, 0.f, 0.f}; acc = mfma16(a0f, ldg8(bp), acc); acc = mfma16(a1f, ldg8(bp + 32), acc);
#pragma unroll
                for (int r = 0; r < 4; ++r) pre[(q * 16 + 4 * g + r) * 256 + 16 * ci + li] = acc[r]; } }
        __syncthreads();
#pragma unroll 1
        for (int j = 0; j < nj; ++j) { const int row = row0 + j, rl = 7 * half + j; const float r = conv3(P, row, C_DR + c, cw, c), k = conv3(P, row, C_DK + c, cw, 256 + c), v = conv3(P, row, C_DV + c, cw, 512 + c);
            float kk = k * kkc; const float n2 = wave_sum(kk * kk, lane); kk *= rsqrtf(fmaxf(n2, 1e-24f));
            float* sc = SC + (size_t)row * 9 * 256; sc[c] = r; sc[256 + c] = v; sc[512 + c] = -kk;
#pragma unroll
            for (int d = 0; d < 2; ++d) { const float wp = w0[d * 256 + c] + pre[(d * 16 + rl) * 256 + c], ap = a0[d * 256 + c] + pre[((2 + d) * 16 + rl) * 256 + c];
                const float nw = -wp, sp = fmaxf(nw, 0.f) + log1pf(__expf(-fabsf(nw)));
                const float lw = -__expf(-sp - 0.5f);
                const float as = sigmoidf_(ap);
                sc[(3 + 3 * d) * 256 + c] = lw; sc[(4 + 3 * d) * 256 + c] = k * (1.0f + (as - 1.0f) * kac); sc[(5 + 3 * d) * 256 + c] = kk * as; } }
    }
    __syncthreads();
}
constexpr int FP = 136;
constexpr int F_TABC = 0, F_TABS = 128 * FP * 2, F_TILE = 2 * 128 * FP * 2;
__device__ __forceinline__ void fourier_load_tables(const Ctx& C) {
    const bf16* ft = (const bf16*)(C.ws + WS_FTAB);
    for (int i = C.tid; i < 2 * 128 * 16; i += NTHR) { const int tb = i >> 11, r = (i >> 4) & 127, c8 = i & 15;
        *(LAS u32x4*)(C.lds + tb * F_TABS + (r * FP + 8 * c8) * 2) = *(const u32x4*)(ft + tb * 16384 + r * 128 + 8 * c8); }
}
__device__ __forceinline__ void mix1_fourier1(const Ctx& C) {
    const bf16* P = (const bf16*)(C.ws + WS_P); const float* tw = (const float*)(C.ws + WS_TW);
    bf16* FYR = (bf16*)(C.ws + WS_FYR); bf16* FYI = (bf16*)(C.ws + WS_FYI);
    const int lane = C.lane, li = lane & 15, g = lane >> 4, w = C.wave;
    __syncthreads();
    fourier_load_tables(C);
    for (int u = C.wg; u < 256; u += C.G) {
        const int t2 = u >> 1, ch0 = (u & 1) * 128;
        __syncthreads();
        for (int i = C.tid; i < 128 * 16; i += NTHR) { const int t1 = i >> 4, c8 = i & 15;
            *(LAS u32x4*)(C.lds + F_TILE + (t1 * FP + 8 * c8) * 2) = *(const u32x4*)(P + (size_t)(NCTX + 128 * t1 + t2) * INWP + C_BU + ch0 + 8 * c8); }
        __syncthreads();
        bf16x8 af[4];
#pragma unroll
        for (int ks = 0; ks < 4; ++ks) af[ks] = ldT(C.lds + F_TILE, FP, 32 * ks, 16 * w, li, g);
#pragma unroll 1
        for (int ni = 0; ni < 8; ++ni) { f32x4 dc = {0.f, 0.f, 0.f, 0.f}, ds = {0.f, 0.f, 0.f, 0.f};
#pragma unroll
            for (int ks = 0; ks < 4; ++ks) { dc = mfma16(af[ks], ldA(C.lds + F_TABC, FP, 16 * ni, 32 * ks, li, g), dc); ds = mfma16(af[ks], ldA(C.lds + F_TABS, FP, 16 * ni, 32 * ks, li, g), ds); }
            const int k1 = 16 * ni + li; const float cp = tw[t2 * k1], sp = tw[16384 + t2 * k1];
            const f32x4 yr = dc * cp - ds * sp, yi = -(ds * cp) - dc * sp;
            const size_t o = ((size_t)k1 * 128 + t2) * 256 + ch0 + 16 * w + 4 * g;
            u32x2 wr; wr.x = pk2(yr[0], yr[1]); wr.y = pk2(yr[2], yr[3]); *(u32x2*)(FYR + o) = wr;
            u32x2 wi; wi.x = pk2(yi[0], yi[1]); wi.y = pk2(yi[2], yi[3]); *(u32x2*)(FYI + o) = wi; }
    }
    __syncthreads();
}
__device__ __forceinline__ void fourier2_mfma(const Ctx& C, int l, int wg0) {
    const bf16* FYR = (const bf16*)(C.ws + WS_FYR); const bf16* FYI = (const bf16*)(C.ws + WS_FYI); bf16* MIX = (bf16*)(C.ws + WS_MIX);
    const int lane = C.lane, li = lane & 15, g = lane >> 4, w = C.wave;
    constexpr int YP = 72, F_YR = F_TILE, F_YI = F_TILE + 128 * YP * 2;
    __syncthreads();
    fourier_load_tables(C);
    for (int u = C.wg - wg0; u < 512; u += C.G - wg0) {
        const int k1 = u >> 2, gq = u & 3;
        __syncthreads();
        for (int i = C.tid; i < 2 * 128 * 8; i += NTHR) { const int im = i >> 10, t2 = (i >> 3) & 127, c8 = i & 7;
            *(LAS u32x4*)(C.lds + (im ? F_YI : F_YR) + (t2 * YP + 8 * c8) * 2) = *(const u32x4*)((im ? FYI : FYR) + ((size_t)k1 * 128 + t2) * 256 + gq * 64 + 8 * c8); }
        __syncthreads();
        bf16x8 bc[4], bs[4];
#pragma unroll
        for (int ks = 0; ks < 4; ++ks) { bc[ks] = ldA(C.lds + F_TABC, FP, 16 * w, 32 * ks, li, g); bs[ks] = ldA(C.lds + F_TABS, FP, 16 * w, 32 * ks, li, g); }
        f32x4 xr[4], xi[4];
#pragma unroll
        for (int ci = 0; ci < 4; ++ci) { xr[ci] = (f32x4){0.f, 0.f, 0.f, 0.f}; f32x4 xs = {0.f, 0.f, 0.f, 0.f}; xi[ci] = xs;
#pragma unroll
            for (int ks = 0; ks < 4; ++ks) { const bf16x8 ar = ldT(C.lds + F_YR, YP, 32 * ks, 16 * ci, li, g), ai = ldT(C.lds + F_YI, YP, 32 * ks, 16 * ci, li, g);
                xr[ci] = mfma16(ar, bc[ks], xr[ci]); xr[ci] = mfma16(ai, bs[ks], xr[ci]);
                xi[ci] = mfma16(ai, bc[ks], xi[ci]); xs = mfma16(ar, bs[ks], xs); }
            xi[ci] = xi[ci] - xs; }
        union { bf16x8 v; unsigned q[4]; } xb[4];
#pragma unroll
        for (int q2 = 0; q2 < 2; ++q2) { xb[q2].q[0] = pk2(xr[2 * q2][0], xr[2 * q2][1]); xb[q2].q[1] = pk2(xr[2 * q2][2], xr[2 * q2][3]); xb[q2].q[2] = pk2(xr[2 * q2 + 1][0], xr[2 * q2 + 1][1]); xb[q2].q[3] = pk2(xr[2 * q2 + 1][2], xr[2 * q2 + 1][3]);
            xb[2 + q2].q[0] = pk2(xi[2 * q2][0], xi[2 * q2][1]); xb[2 + q2].q[1] = pk2(xi[2 * q2][2], xi[2 * q2][3]); xb[2 + q2].q[2] = pk2(xi[2 * q2 + 1][0], xi[2 * q2 + 1][1]); xb[2 + q2].q[3] = pk2(xi[2 * q2 + 1][2], xi[2 * q2 + 1][3]); }
        const bf16x8* mf = (const bf16x8*)((const bf16*)(C.ws + WS_FTAB) + 32768) + (size_t)(l * 4 + gq) * 16 * 64;
#pragma unroll
        for (int ei = 0; ei < 4; ++ei) { f32x4 o = {0.f, 0.f, 0.f, 0.f};
#pragma unroll
            for (int ks2 = 0; ks2 < 4; ++ks2) o = mfma16(mf[(ei * 4 + ks2) * 64 + lane], xb[ks2].v, o);
            const int tp = k1 + 128 * (16 * w + li);
            u32x2 wo; wo.x = pk2(o[0], o[1]); wo.y = pk2(o[2], o[3]); *(u32x2*)(MIX + (size_t)(NCTX + tp) * DM + 256 + gq * 64 + 16 * ei + 4 * g) = wo; }
    }
    __syncthreads();
}

constexpr float LOG2E = 1.4426950408889634f;
typedef short bf16x4 __attribute__((ext_vector_type(4)));
__device__ __forceinline__ void attn_load(const bf16* P, const bf16* VT, int krow, int kcol, int li, int g, bf16x8 (&kf)[2][2], bf16x8 (&vf)[4]) {
#pragma unroll
    for (int t = 0; t < 2; ++t)
#pragma unroll
        for (int ks = 0; ks < 2; ++ks) kf[t][ks] = ldg8(P + (size_t)(krow + 16 * t + li) * INWP + kcol + 32 * ks + 8 * g);
#pragma unroll
    for (int dt = 0; dt < 4; ++dt) { const bf16* vp = VT + (size_t)(dt * 16 + li) * VTP + krow + 4 * g;
        const bf16x4 a = *(const bf16x4*)vp, b = *(const bf16x4*)(vp + 16); vf[dt] = (bf16x8){a[0], a[1], a[2], a[3], b[0], b[1], b[2], b[3]}; }
}
template <int NH>
__device__ __forceinline__ void attn_compute(const bf16x8 (&kf)[2][2], const bf16x8 (&vf)[4], const bf16x8 (&qf)[NH][2], f32x4 (&o)[NH][4], float (&m)[NH], float (&ls)[NH],
                                             const float (&add)[2][4], int li, int g) {
#pragma unroll
    for (int hh = 0; hh < NH; ++hh) {
        f32x4 st[2];
#pragma unroll
        for (int t = 0; t < 2; ++t) { st[t] = (f32x4){0.f, 0.f, 0.f, 0.f};
#pragma unroll
            for (int ks = 0; ks < 2; ++ks) st[t] = __builtin_amdgcn_mfma_f32_16x16x32_bf16(kf[t][ks], qf[hh][ks], st[t], 0, 0, 0); }
        float s[8]; float bm = -INFINITY;
#pragma unroll
        for (int t = 0; t < 2; ++t)
#pragma unroll
            for (int r = 0; r < 4; ++r) { s[4 * t + r] = (add[t][r] == -INFINITY) ? -INFINITY : st[t][r] * (0.125f * LOG2E) + add[t][r]; bm = fmaxf(bm, s[4 * t + r]); }
        bm = fmaxf(bm, shx(bm, 16, 16 * g + li)); bm = fmaxf(bm, shx(bm, 32, 16 * g + li));
        const float mn = fmaxf(m[hh], bm), corr = __builtin_amdgcn_exp2f(m[hh] - mn); m[hh] = mn;
        float ps = 0.f; float pe[8];
#pragma unroll
        for (int e = 0; e < 8; ++e) { pe[e] = __builtin_amdgcn_exp2f(s[e] - mn); ps += pe[e]; }
        ls[hh] = ls[hh] * corr + ps;
        union { bf16x8 v; unsigned u[4]; } pf;
#pragma unroll
        for (int e2 = 0; e2 < 4; ++e2) pf.u[e2] = pk2(pe[2 * e2], pe[2 * e2 + 1]);
#pragma unroll
        for (int dt = 0; dt < 4; ++dt) { o[hh][dt] = o[hh][dt] * corr; o[hh][dt] = __builtin_amdgcn_mfma_f32_16x16x32_bf16(vf[dt], pf.v, o[hh][dt], 0, 0, 0); }
    }
}
template <int NH>
__device__ __forceinline__ void attn_finish(bf16* MIX, int qrow0, int ocol, f32x4 (&o)[NH][4], float (&m)[NH], float (&ls)[NH], const float* sink2  , int li, int g) {
#pragma unroll
    for (int hh = 0; hh < NH; ++hh) {
        float l = ls[hh]; l += shx(l, 16, 16 * g + li); l += shx(l, 32, 16 * g + li);
        float corr = 1.f;
        if (sink2) { const float sk = sink2[hh]; const float mn = fmaxf(m[hh], sk); corr = __builtin_amdgcn_exp2f(m[hh] - mn); l = l * corr + __builtin_amdgcn_exp2f(sk - mn); }
        const float inv = corr / l;
#pragma unroll
        for (int dt = 0; dt < 4; ++dt) { const f32x4 v = o[hh][dt] * inv; u32x2 w; w.x = pk2(v[0], v[1]); w.y = pk2(v[2], v[3]);
            *(u32x2*)(MIX + (size_t)(qrow0 + li) * DM + ocol + hh * 64 + dt * 16 + 4 * g) = w; }
    }
}
__device__ __forceinline__ void attnA_unit(const Ctx& C, const float* asink_l, int unit, bool lat) {
    const bf16* P = (const bf16*)(C.ws + WS_P); bf16* MIX = (bf16*)(C.ws + WS_MIX);
    const int li = C.lane & 15, g = C.lane >> 4;
    const int nqt = lat ? SEQ / 16 : NCTX / 16, kvh = unit / nqt, qt = unit % nqt, t0 = qt * 16, qrow0 = (lat ? NCTX : 0) + t0, t = t0 + li;
    const bf16* VT = (const bf16*)(C.ws + WS_VTA) + (size_t)kvh * 64 * VTP; const int kcol = C_AK + kvh * 64;
    bf16x8 qf[2][2];
#pragma unroll
    for (int hh = 0; hh < 2; ++hh)
#pragma unroll
        for (int ks = 0; ks < 2; ++ks) qf[hh][ks] = ldg8(P + (size_t)(qrow0 + li) * INWP + C_AQ + (kvh * 2 + hh) * 64 + 32 * ks + 8 * g);
    f32x4 o[2][4]; float m[2] = {-1.0e30f, -1.0e30f}, ls[2] = {0.f, 0.f};
#pragma unroll
    for (int hh = 0; hh < 2; ++hh)
#pragma unroll
        for (int dt = 0; dt < 4; ++dt) o[hh][dt] = (f32x4){0.f, 0.f, 0.f, 0.f};
    const int b_lo = lat ? 0 : 9;
#define A_KROW(bb) ((bb) < 9 ? NCTX + t0 - 128 + 32 * (bb) : 32 * ((bb) - 9))
#define A_MASK(bb, add) do { _Pragma("unroll") for (int tt = 0; tt < 2; ++tt) _Pragma("unroll") for (int r = 0; r < 4; ++r) { const int j = t0 - 128 + 32 * (bb) + 16 * tt + 4 * g + r; \
        const bool ok = ((bb) >= 9) || ((j >= 0) && (j < SEQ) && (j - t <= 128) && (t - j <= 128)); add[tt][r] = ok ? 0.f : -INFINITY; } } while (0)
    bf16x8 kfa[2][2], vfa[4], kfb[2][2], vfb[4];
    attn_load(P, VT, A_KROW(b_lo), kcol, li, g, kfa, vfa);
#pragma unroll 1
    for (int bb = b_lo; bb < 17; bb += 2) { float add[2][4];
        if (bb + 1 < 17) attn_load(P, VT, A_KROW(bb + 1), kcol, li, g, kfb, vfb);
        A_MASK(bb, add); attn_compute<2>(kfa, vfa, qf, o, m, ls, add, li, g);
        if (bb + 1 < 17) { if (bb + 2 < 17) attn_load(P, VT, A_KROW(bb + 2), kcol, li, g, kfa, vfa);
            A_MASK(bb + 1, add); attn_compute<2>(kfb, vfb, qf, o, m, ls, add, li, g); } }
#undef A_KROW
#undef A_MASK
    float sk2[2] = {asink_l[kvh * 2] * LOG2E, asink_l[kvh * 2 + 1] * LOG2E};
    attn_finish<2>(MIX, qrow0, kvh * 128, o, m, ls, sk2, li, g);
}
__device__ __forceinline__ void attnC_unit(const Ctx& C, const LAS float* relb, int h, int qt, bool lat) {
    const bf16* P = (const bf16*)(C.ws + WS_P); bf16* MIX = (bf16*)(C.ws + WS_MIX);
    const int li = C.lane & 15, g = C.lane >> 4;
    const int t0 = qt * 16, qrow0 = (lat ? NCTX : 0) + t0;
    const bf16* VT = (const bf16*)(C.ws + WS_VTC) + (size_t)h * 64 * VTP; const int kcol = C_CK + h * 64;
    bf16x8 qf[1][2];
#pragma unroll
    for (int ks = 0; ks < 2; ++ks) qf[0][ks] = ldg8(P + (size_t)(qrow0 + li) * INWP + C_CQ + h * 64 + 32 * ks + 8 * g);
    f32x4 o[1][4]; float m[1] = {-1.0e30f}, ls[1] = {0.f};
#pragma unroll
    for (int dt = 0; dt < 4; ++dt) o[0][dt] = (f32x4){0.f, 0.f, 0.f, 0.f};
    const int r = t0 >> 6, cj = (t0 >> 4) & 3, cq = cj * 16 + li; int r0 = r - 4; r0 = r0 < 0 ? 0 : (r0 > 248 ? 248 : r0);
    int c0 = cq - 8; c0 = c0 < 0 ? 0 : (c0 > 48 ? 48 : c0);
    const int cw0 = (cj == 0) ? 0 : (cj == 1) ? 8 : (cj == 2) ? 24 : 32;
    const int b_lo = lat ? 0 : 8;
#define C_KROW(bb) ((bb) < 8 ? NCTX + (r0 + (bb)) * 64 + cw0 : 32 * ((bb) - 8))
#define C_MASK(bb, add) do { const LAS float* rbp = relb + (((bb) < 8 ? r0 + (bb) - r + 7 : 0)) * 31; _Pragma("unroll") for (int tt = 0; tt < 2; ++tt) _Pragma("unroll") for (int rr = 0; rr < 4; ++rr) { \
        const int kc = cw0 + 16 * tt + 4 * g + rr; int ci = kc - cq + 15; ci = ci < 0 ? 0 : (ci > 30 ? 30 : ci); const float bv = rbp[ci]; \
        add[tt][rr] = ((bb) >= 8) ? 0.f : ((kc >= c0 && kc < c0 + 16) ? bv : -INFINITY); } } while (0)
    bf16x8 kfa[2][2], vfa[4], kfb[2][2], vfb[4];
    attn_load(P, VT, C_KROW(b_lo), kcol, li, g, kfa, vfa);
#pragma unroll 1
    for (int bb = b_lo; bb < 16; bb += 2) { float add[2][4];
        attn_load(P, VT, C_KROW(bb + 1), kcol, li, g, kfb, vfb);
        C_MASK(bb, add); attn_compute<1>(kfa, vfa, qf, o, m, ls, add, li, g);
        if (bb + 2 < 16) attn_load(P, VT, C_KROW(bb + 2), kcol, li, g, kfa, vfa);
        C_MASK(bb + 1, add); attn_compute<1>(kfb, vfb, qf, o, m, ls, add, li, g); }
#undef C_KROW
#undef C_MASK
    attn_finish<1>(MIX, qrow0, 512 + h * 64, o, m, ls, nullptr, li, g);
}
__device__ __forceinline__ void fourier_ctx_mfma(const Ctx& C, int l, int wg0) {
    const bf16* P = (const bf16*)(C.ws + WS_P); bf16* MIX = (bf16*)(C.ws + WS_MIX); const bf16* f2 = (const bf16*)(C.ws + WS_F256);
    const int lane = C.lane, li = lane & 15, g = lane >> 4, w = C.wave;
    constexpr int UP = 72;
    for (int u = C.wg - wg0; u < 8; u += C.G - wg0) {
        const int tb = u >> 2, gq = u & 3;
        __syncthreads();
        for (int i = C.tid; i < 256 * 8; i += NTHR) { const int t = i >> 3, c8 = i & 7; *(LAS u32x4*)(C.lds + (t * UP + 8 * c8) * 2) = *(const u32x4*)(P + (size_t)t * INWP + C_BU + gq * 64 + 8 * c8); }
        __syncthreads();
        const int tp0 = 128 * tb + 16 * w;
        f32x4 xr[4], xi[4];
#pragma unroll
        for (int ci = 0; ci < 4; ++ci) { xr[ci] = (f32x4){0.f, 0.f, 0.f, 0.f}; xi[ci] = (f32x4){0.f, 0.f, 0.f, 0.f}; }
#pragma unroll 2
        for (int ks = 0; ks < 8; ++ks) { const bf16x8 bc = ldg8(f2 + (size_t)(tp0 + li) * 256 + 32 * ks + 8 * g), bs = ldg8(f2 + 65536 + (size_t)(tp0 + li) * 256 + 32 * ks + 8 * g);
#pragma unroll
            for (int ci = 0; ci < 4; ++ci) { const bf16x8 au = ldT(C.lds, UP, 32 * ks, 16 * ci, li, g); xr[ci] = mfma16(au, bc, xr[ci]); xi[ci] = mfma16(au, bs, xi[ci]); } }
        union { bf16x8 v; unsigned q[4]; } xb[4];
#pragma unroll
        for (int q2 = 0; q2 < 2; ++q2) { xb[q2].q[0] = pk2(xr[2 * q2][0], xr[2 * q2][1]); xb[q2].q[1] = pk2(xr[2 * q2][2], xr[2 * q2][3]); xb[q2].q[2] = pk2(xr[2 * q2 + 1][0], xr[2 * q2 + 1][1]); xb[q2].q[3] = pk2(xr[2 * q2 + 1][2], xr[2 * q2 + 1][3]);
            xb[2 + q2].q[0] = pk2(-xi[2 * q2][0], -xi[2 * q2][1]); xb[2 + q2].q[1] = pk2(-xi[2 * q2][2], -xi[2 * q2][3]); xb[2 + q2].q[2] = pk2(-xi[2 * q2 + 1][0], -xi[2 * q2 + 1][1]); xb[2 + q2].q[3] = pk2(-xi[2 * q2 + 1][2], -xi[2 * q2 + 1][3]); }
        const bf16x8* mf = (const bf16x8*)((const bf16*)(C.ws + WS_FTAB) + 32768) + (size_t)(l * 4 + gq) * 16 * 64;
#pragma unroll
        for (int ei = 0; ei < 4; ++ei) { f32x4 o = {0.f, 0.f, 0.f, 0.f};
#pragma unroll
            for (int ks2 = 0; ks2 < 4; ++ks2) o = mfma16(mf[(ei * 4 + ks2) * 64 + lane], xb[ks2].v, o);
            o = o * 8.0f;
            u32x2 wo; wo.x = pk2(o[0], o[1]); wo.y = pk2(o[2], o[3]); *(u32x2*)(MIX + (size_t)(tp0 + li) * DM + 256 + gq * 64 + 16 * ei + 4 * g) = wo; }
    }
    __syncthreads();
}
__device__ __forceinline__ void fourier2_unit(const Ctx& C, int l, int u, bool ctx) {
    const bf16* P = (const bf16*)(C.ws + WS_P); const float* tw = (const float*)(C.ws + WS_TW); bf16* MIX = (bf16*)(C.ws + WS_MIX);
    const float* FYR = (const float*)(C.ws + WS_FYR); const float* FYI = (const float*)(C.ws + WS_FYI);
    const float* mt = (const float*)(C.ws + WS_MTAB) + (size_t)l * 2 * 4 * 4096;
    LAS float* xr = (LAS float*)(C.lds + 8192); LAS float* xi = xr + 512;
    const int tl = C.tid >> 8, ch = C.tid & 255, tp = 2 * u + tl;
    float sr = 0.f, si = 0.f;
    if (!ctx) { const int k1 = tp & 127, k2 = tp >> 7; const float* yr = FYR + (size_t)k1 * 128 * 256 + ch; const float* yi = FYI + (size_t)k1 * 128 * 256 + ch;
#pragma unroll 8
        for (int t2 = 0; t2 < 128; ++t2) { const int m = ((t2 * k2) & 127) * 128; const float c = tw[m], s = tw[16384 + m]; const float a = yr[t2 * 256], b = yi[t2 * 256]; sr += a * c + b * s; si += b * c - a * s; } }
    else {
#pragma unroll 8
        for (int t = 0; t < NCTX; ++t) { const int m = ((t * tp) & 255) * 64; const float x = bf2f(P[(size_t)t * INWP + C_BU + ch]); sr += x * tw[m]; si -= x * tw[16384 + m]; } }
    __syncthreads();
    xr[tl * 256 + ch] = sr; xi[tl * 256 + ch] = si;
    __syncthreads();
    const int g = ch >> 6, e = ch & 63; const float* mc = mt + (size_t)(0 * 4 + g) * 4096 + e; const float* ms = mt + (size_t)(1 * 4 + g) * 4096 + e;
    const LAS float* xrp = xr + tl * 256 + g * 64; const LAS float* xip = xi + tl * 256 + g * 64; float o = 0.f;
#pragma unroll 8
    for (int c = 0; c < 64; ++c) o += xrp[c] * mc[c * 64] + xip[c] * ms[c * 64];
    o *= ctx ? (1.0f / 128.0f) : (1.0f / 1024.0f);
    MIX[(size_t)((ctx ? 0 : NCTX) + tp) * DM + 256 + ch] = (bf16)f2bf(o);
}
__device__ __forceinline__ void rwkv_passB(const Ctx& C, int b);
__device__ __forceinline__ void phase_mix2(const Ctx& C, const DArgs& a, int l) {
    const bool emit_ctx = l < DEPTH - 1;
#ifndef REPMASK
#define REPMASK 0
#endif
#define NREP2(o) ((((REPMASK) >> (o)) & 1) ? 2 : 1)
    if (C.wg < 8) { for (int r2 = 0; r2 < NREP2(16); ++r2) rwkv_passB(C, C.wg); }
    else if (emit_ctx) fourier_ctx_mfma(C, l, 8);
    { const float* asink_l = a.in[I_ASINK] + l * 4; const float* crel = a.in[I_CREL] + (size_t)l * 4 * 465;
      LAS float* relb = (LAS float*)(C.lds + 110592 + C.wave * 2048);
      unsigned* qhead = (unsigned*)(C.ws + WS_CTL) + CW_WQ + 64 * l;
      const int nA = 2 * (SEQ / 16), nC = 4 * (SEQ / 16), nAc = emit_ctx ? 2 * (NCTX / 16) : 0, nCc = emit_ctx ? 4 * (NCTX / 16) : 0, nAll = nA + nAc + nC + nCc;
      int hcur = -1;
      for (;;) { unsigned uq = 0; if (C.lane == 0) uq = __hip_atomic_fetch_add(qhead, 1u, __ATOMIC_RELAXED, __HIP_MEMORY_SCOPE_AGENT);
          const int u = __builtin_amdgcn_readfirstlane((int)uq); if (u >= nAll) break;
          if (u < nA) attnA_unit(C, asink_l, u, true);
          else if (u < nA + nAc) attnA_unit(C, asink_l, u - nA, false);
          else { const int uc = u - nA - nAc; const bool lat = uc < nC; const int uu = lat ? uc : uc - nC, nqt = lat ? SEQ / 16 : NCTX / 16, h = uu / nqt, qt = uu % nqt;
              if (h != hcur) { for (int i = C.lane; i < 465; i += 64) relb[i] = crel[h * 465 + i] * LOG2E; hcur = h; LDS_WAIT(); asm volatile("" ::: "memory"); }
              attnC_unit(C, relb, h, qt, lat); } } }
    __syncthreads();
    if (C.wg >= 8) for (int r2 = 0; r2 < NREP2(19); ++r2) fourier2_mfma(C, l, 8);
}

constexpr int RW_C = 32, RW_NCH = ROWS / RW_C, RW_SC = 20, RW_NSC = RW_NCH / RW_SC;
constexpr int RW_SLOT = 5120, RW_REGION = 9 * RW_SLOT + 1024;
constexpr int TP = 72, HP = 40;
static_assert(3 * RW_REGION <= MISC_OFF, "RWKV D1 regions below the misc area");
__device__ __forceinline__ int rw_rc_of(int d, int c) { return d == 0 ? c : (c < 8 ? 7 - c : 527 - c); }
__device__ __forceinline__ int rw_row_of(int d, int rc, int t) { return 32 * rc + (d == 0 ? t : 31 - t); }

__device__ __forceinline__ void rwkv_d1(const Ctx& C, LAS unsigned char* rb, int d, int h, int rc) {
    int lane_ = C.lane; asm volatile("" : "+v"(lane_));
    const int lane = lane_, li = lane & 15, g = lane >> 4;
    const float* SC = (const float*)(C.ws + WS_SC);
    LAS unsigned char* S0 = rb; LAS unsigned char* S1 = rb + RW_SLOT; LAS unsigned char* S2 = rb + 2 * RW_SLOT; LAS unsigned char* S3 = rb + 3 * RW_SLOT; LAS unsigned char* S4 = rb + 4 * RW_SLOT;
    LAS unsigned char* S5 = rb + 5 * RW_SLOT; LAS unsigned char* S6 = rb + 6 * RW_SLOT; LAS unsigned char* S7 = rb + 7 * RW_SLOT; LAS unsigned char* S8 = rb + 8 * RW_SLOT;
    LAS unsigned char* S6b = S6 + 2560; LAS unsigned char* S7b = S7 + 2560;
    LAS float* gc = (LAS float*)(rb + 9 * RW_SLOT);
    { float cum = 0.f; const int j = lane; const int qw = (3 + 3 * d) * 256;
#pragma unroll 1
      for (int t0 = 0; t0 < 32; t0 += 4) { float rv[4], vv[4], av[4], lw[4], kd[4], bb[4];
#pragma unroll
          for (int u = 0; u < 4; ++u) { const float* sc = SC + (size_t)rw_row_of(d, rc, t0 + u) * 9 * 256 + h * 64 + j;
              rv[u] = sc[0]; vv[u] = sc[256]; av[u] = sc[512]; lw[u] = sc[qw]; kd[u] = sc[qw + 256]; bb[u] = sc[qw + 512]; }
#pragma unroll
          for (int u = 0; u < 4; ++u) { const float cp = cum; cum += lw[u]; const float Gt = __expf(cum), Gm = __expf(cp), iG = __expf(-cum); const int off = ((t0 + u) * TP + j) * 2;
              *(LAS bf16*)(S0 + off) = (bf16)f2bf(av[u] * Gm); *(LAS bf16*)(S1 + off) = (bf16)f2bf(rv[u] * Gt); *(LAS bf16*)(S2 + off) = (bf16)f2bf(bb[u] * iG);
              *(LAS bf16*)(S3 + off) = (bf16)f2bf(kd[u] * iG); *(LAS bf16*)(S4 + off) = (bf16)f2bf(vv[u]); } }
      gc[j] = __expf(cum); }
    const f32x4 z4 = {0.f, 0.f, 0.f, 0.f};
#pragma unroll 1
    for (int ti = 0; ti < 2; ++ti)
#pragma unroll 1
        for (int si = 0; si < 2; ++si) {
            f32x4 n = z4, nt = z4, mk = z4, qb = z4, qk = z4;
#pragma unroll
            for (int ks = 0; ks < 2; ++ks) { const bf16x8 at = ldA(S0, TP, 16 * ti, 32 * ks, li, g), rt = ldA(S1, TP, 16 * ti, 32 * ks, li, g), bs = ldA(S2, TP, 16 * si, 32 * ks, li, g), kss = ldA(S3, TP, 16 * si, 32 * ks, li, g);
                n = mfma16(at, bs, n);
                nt = mfma16(bs, at, nt);
                mk = mfma16(kss, at, mk);
                qb = mfma16(bs, rt, qb);
                qk = mfma16(kss, rt, qk); }
#pragma unroll
            for (int r = 0; r < 4; ++r) { const int trow = 16 * ti + 4 * g + r, scol = 16 * si + li; if (!(scol < trow)) n[r] = 0.f;
                const int srow = 16 * si + 4 * g + r, tcol = 16 * ti + li; if (!(srow < tcol)) { mk[r] = 0.f; nt[r] = 0.f; } if (!(srow <= tcol)) { qb[r] = 0.f; qk[r] = 0.f; } }
            *(LAS f32x4*)(S5 + ((16 * si + li) * 32 + 16 * ti + 4 * g) * 4) = n;
            stT(S6, HP, 16 * ti + li, 16 * si + 4 * g, mk);
            stT(S8, HP, 16 * ti + li, 16 * si + 4 * g, nt);
            stT(S6b, HP, 16 * ti + li, 16 * si + 4 * g, qb);
            stT(S7, HP, 16 * ti + li, 16 * si + 4 * g, qk); }
    { const int rr = lane & 31, bq = rr >> 4, lr = rr & 15; float Tr[16];
#pragma unroll
      for (int s = 15; s >= 0; --s) { float acc = (lr == s) ? 1.f : 0.f;
#pragma unroll
          for (int c4 = 0; c4 < 4; ++c4) { if (4 * c4 + 3 > s) { const f32x4 nv = *(const LAS f32x4*)(S5 + ((16 * bq + s) * 32 + 16 * bq + 4 * c4) * 4);
#pragma unroll
              for (int e = 0; e < 4; ++e) if (4 * c4 + e > s) acc += Tr[4 * c4 + e] * nv[e]; } }
          Tr[s] = acc; }
      if (lane < 32) { u32x4 w0, w1; w0.x = pk2(Tr[0], Tr[1]); w0.y = pk2(Tr[2], Tr[3]); w0.z = pk2(Tr[4], Tr[5]); w0.w = pk2(Tr[6], Tr[7]); w1.x = pk2(Tr[8], Tr[9]); w1.y = pk2(Tr[10], Tr[11]); w1.z = pk2(Tr[12], Tr[13]); w1.w = pk2(Tr[14], Tr[15]);
          const u32x4 zz = {0u, 0u, 0u, 0u}; LAS u32x4* trow = (LAS u32x4*)(S7b + rr * HP * 2);
          trow[0] = bq ? zz : w0; trow[1] = bq ? zz : w1; trow[2] = bq ? w0 : zz; trow[3] = bq ? w1 : zz; }
      f32x4 x = mfma16(ldA(S8, HP, 16, 0, li, g), ldT(S7b, HP, 0, 0, li, g), z4);
      LAS unsigned char* XT = S8 + 2560;
      *(LAS u32x2*)(XT + (li * HP + 4 * g) * 2) = (u32x2){0u, 0u}; stT(XT, HP, li, 16 + 4 * g, x);
      const f32x4 t21 = mfma16(ldA(S7b, HP, 16, 0, li, g), ldA(XT, HP, 0, 0, li, g), z4);
#pragma unroll
      for (int r = 0; r < 4; ++r) *(LAS bf16*)(S7b + ((16 + 4 * g + r) * HP + li) * 2) = (bf16)f2bf(t21[r]); }
#pragma unroll 1
    for (int ti = 0; ti < 2; ++ti) { const bf16x8 tf = ldA(S7b, HP, 16 * ti, 0, li, g), mf = ldA(S6, HP, 16 * ti, 0, li, g);
#pragma unroll
        for (int ji = 0; ji < 4; ++ji) { const f32x4 ap = mfma16(tf, ldT(S0, TP, 0, 16 * ji, li, g), z4); stT(S8, HP, 16 * ji + li, 16 * ti + 4 * g, ap);
            const f32x4 mv = mfma16(mf, ldT(S4, TP, 0, 16 * ji, li, g), z4); stT(S5, HP, 16 * ji + li, 16 * ti + 4 * g, mv); } }
#pragma unroll 1
    for (int ti = 0; ti < 2; ++ti) { const bf16x8 tf = ldA(S7b, HP, 16 * ti, 0, li, g);
#pragma unroll
        for (int vi = 0; vi < 4; ++vi) { const f32x4 ul = mfma16(tf, ldA(S5, HP, 16 * vi, 0, li, g), z4); stT(S0, HP, 16 * vi + li, 16 * ti + 4 * g, ul); } }
#pragma unroll 1
    for (int ti = 0; ti < 2; ++ti) { const bf16x8 qbf = ldA(S6b, HP, 16 * ti, 0, li, g), qkf = ldA(S7, HP, 16 * ti, 0, li, g);
#pragma unroll
        for (int ji = 0; ji < 4; ++ji) { f32x4 rp = mfma16(ldA(S8, HP, 16 * ji, 0, li, g), qbf, z4);
            LAS unsigned char* p = S1 + ((16 * ti + li) * TP + 16 * ji + 4 * g) * 2; rp = rp + ld4bf(p); u32x2 w; w.x = pk2(rp[0], rp[1]); w.y = pk2(rp[2], rp[3]); *(LAS u32x2*)p = w;
            f32x4 yl = mfma16(qbf, ldA(S0, HP, 16 * ji, 0, li, g), z4); yl = mfma16(qkf, ldT(S4, TP, 0, 16 * ji, li, g), yl);
            stT(S5, HP, 16 * ji + li, 16 * ti + 4 * g, yl); } }
#pragma unroll 1
    for (int ji = 0; ji < 4; ++ji) { const bf16x8 bt = ldT(S2, TP, 0, 16 * ji, li, g); const float gj = gc[16 * ji + li];
#pragma unroll
        for (int jp = 0; jp < 4; ++jp) { f32x4 pt = mfma16(ldA(S8, HP, 16 * jp, 0, li, g), bt, z4);
#pragma unroll
            for (int r = 0; r < 4; ++r) pt[r] = pt[r] * gj + ((16 * jp + 4 * g + r == 16 * ji + li) ? gj : 0.f);
            stT(S6, TP, 16 * ji + li, 16 * jp + 4 * g, pt); } }
#pragma unroll 1
    for (int vh = 0; vh < 2; ++vh) { f32x4 lt[4][2];
#pragma unroll
      for (int ji = 0; ji < 4; ++ji) { const bf16x8 ba = ldT(S2, TP, 0, 16 * ji, li, g), ka = ldT(S3, TP, 0, 16 * ji, li, g); const f32x4 gv = *(const LAS f32x4*)(gc + 16 * ji + 4 * g);
#pragma unroll
          for (int v2 = 0; v2 < 2; ++v2) { const int vi = 2 * vh + v2; f32x4 x = mfma16(ba, ldA(S0, HP, 16 * vi, 0, li, g), z4); x = mfma16(ka, ldT(S4, TP, 0, 16 * vi, li, g), x); lt[ji][v2] = x * gv; } }
      asm volatile("s_waitcnt lgkmcnt(0)" ::: "memory");
      LAS unsigned char* dst = vh ? S2 : S8;
#pragma unroll
      for (int ji = 0; ji < 4; ++ji)
#pragma unroll
          for (int v2 = 0; v2 < 2; ++v2) stT(dst, TP, 16 * v2 + li, 16 * ji + 4 * g, lt[ji][v2]); }
}
__device__ __forceinline__ void rwkv_passA_step(const Ctx& C, const LAS unsigned char* rb, f32x4 (&hs)[4], int d, int h, int rc) {
    int lane_ = C.lane; asm volatile("" : "+v"(lane_));
    const int lane = lane_, li = lane & 15, g = lane >> 4; const bool isPhi = C.wave >= 4; const int col = 16 * (C.wave & 3) + li;
    const LAS unsigned char* S1 = rb + RW_SLOT; const LAS unsigned char* S2 = rb + 2 * RW_SLOT; const LAS unsigned char* S5 = rb + 5 * RW_SLOT; const LAS unsigned char* S6 = rb + 6 * RW_SLOT;
    const LAS unsigned char* LTb = (col < 32) ? rb + 8 * RW_SLOT + col * TP * 2 : S2 + (col - 32) * TP * 2;
    union { bf16x8 v; unsigned u[4]; } bf[2];
#pragma unroll
    for (int ks = 0; ks < 2; ++ks) { bf[ks].u[0] = pk2(hs[2 * ks][0], hs[2 * ks][1]); bf[ks].u[1] = pk2(hs[2 * ks][2], hs[2 * ks][3]); bf[ks].u[2] = pk2(hs[2 * ks + 1][0], hs[2 * ks + 1][1]); bf[ks].u[3] = pk2(hs[2 * ks + 1][2], hs[2 * ks + 1][3]); }
#pragma unroll
    for (int ti = 0; ti < 2; ++ti) { f32x4 acc = isPhi ? (f32x4){0.f, 0.f, 0.f, 0.f} : ld4bf(S5 + (col * HP + 16 * ti + 4 * g) * 2);
#pragma unroll
        for (int ks = 0; ks < 2; ++ks) acc = mfma16(ldAperm(S1, TP, 16 * ti, ks, li, g), bf[ks].v, acc);
        if (!isPhi) { float* ys = (float*)(C.ws + WS_YS) + (size_t)d * ROWS * 256 + h * 64 + col;
#pragma unroll
            for (int r = 0; r < 4; ++r) ys[(size_t)rw_row_of(d, rc, 16 * ti + 4 * g + r) * 256] = acc[r]; }
        else { bf16* rp = (bf16*)(C.ws + WS_RPP) + ((size_t)((d * 4 + h) * RW_NCH + rc) * 32) * 64 + col;
#pragma unroll
            for (int r = 0; r < 4; ++r) rp[(16 * ti + 4 * g + r) * 64] = (bf16)f2bf(acc[r]); } }
    f32x4 hn[4];
#pragma unroll
    for (int i = 0; i < 4; ++i) { f32x4 acc = isPhi ? (f32x4){0.f, 0.f, 0.f, 0.f} : ld4bf(LTb + (16 * i + 4 * g) * 2);
#pragma unroll
        for (int ks = 0; ks < 2; ++ks) acc = mfma16(ldAperm(S6, TP, 16 * i, ks, li, g), bf[ks].v, acc);
        hn[i] = acc; }
#pragma unroll
    for (int i = 0; i < 4; ++i) hs[i] = hn[i];
}
__device__ __forceinline__ void phase_rwkv1(const Ctx& C) {
    const int lane = C.lane, li = lane & 15, g = lane >> 4;
    for (int u = C.wg; u < 8 * RW_NSC; u += C.G) {
        const int s = u % RW_NSC, dh = u / RW_NSC, d = dh >> 2, h = dh & 3; const bool isPhi = C.wave >= 4; const int col = 16 * (C.wave & 3) + li;
        f32x4 hs[4];
#pragma unroll
        for (int i = 0; i < 4; ++i)
#pragma unroll
            for (int r = 0; r < 4; ++r) hs[i][r] = (isPhi && (16 * i + 4 * g + r == col)) ? 1.f : 0.f;
#pragma unroll 1
        for (int rnd = 0; rnd < (RW_SC + 2) / 3; ++rnd) {
            __syncthreads();
            { int wv = C.wave; asm volatile("" : "+s"(wv)); if (wv < 3 && 3 * rnd + wv < RW_SC) rwkv_d1(C, C.lds + wv * RW_REGION, d, h, rw_rc_of(d, s * RW_SC + 3 * rnd + wv)); }
            __syncthreads();
#pragma unroll 1
            for (int k = 0; k < 3; ++k) { const int ci = 3 * rnd + k; int ko = k * RW_REGION; asm volatile("" : "+s"(ko)); if (ci < RW_SC) rwkv_passA_step(C, C.lds + ko, hs, d, h, rw_rc_of(d, s * RW_SC + ci)); }
        }
        if (isPhi) { bf16* pf = (bf16*)(C.ws + WS_PSC) + (size_t)(dh * RW_NSC + s) * 4096;
            const int ks = col >> 5, eh = (col >> 4) & 1, gp = (col >> 2) & 3, el = col & 3;
#pragma unroll
            for (int i = 0; i < 4; ++i)
#pragma unroll
                for (int r = 0; r < 4; ++r) pf[((i * 2 + ks) * 64 + gp * 16 + 4 * g + r) * 8 + eh * 4 + el] = (bf16)f2bf(hs[i][r]); }
        else { f32x4* lf = (f32x4*)(C.ws + WS_LSC) + ((size_t)(dh * RW_NSC + s) * 4 + C.wave) * 4 * 64;
#pragma unroll
            for (int i = 0; i < 4; ++i) lf[i * 64 + lane] = hs[i]; }
    }
    __syncthreads();
}
__device__ __forceinline__ void rwkv_passB(const Ctx& C, int b) {
    if (C.wave >= 4) return;
    const int lane = C.lane, li = lane & 15, g = lane >> 4, q = C.wave;
    f32x4 hs[4];
#pragma unroll
    for (int i = 0; i < 4; ++i) hs[i] = (f32x4){0.f, 0.f, 0.f, 0.f};
    const bf16x8* pfb = (const bf16x8*)((const bf16*)(C.ws + WS_PSC) + (size_t)b * RW_NSC * 4096);
    const f32x4* lfb = (const f32x4*)(C.ws + WS_LSC) + ((size_t)b * RW_NSC * 4 + q) * 4 * 64;
    bf16x8 pa[8]; f32x4 la[4];
#pragma unroll
    for (int k = 0; k < 8; ++k) pa[k] = pfb[k * 64 + lane];
#pragma unroll
    for (int i = 0; i < 4; ++i) la[i] = lfb[i * 64 + lane];
#pragma unroll 1
    for (int s = 0; s < RW_NSC; ++s) {
        bf16* hp = (bf16*)(C.ws + WS_HSC) + ((size_t)(b * RW_NSC + s) * 64 + 16 * q + li) * 64;
#pragma unroll
        for (int i = 0; i < 4; ++i) { u32x2 w; w.x = pk2(hs[i][0], hs[i][1]); w.y = pk2(hs[i][2], hs[i][3]); *(u32x2*)(hp + 16 * i + 4 * g) = w; }
        bf16x8 pn[8]; f32x4 ln[4]; const int sn = (s + 1 < RW_NSC) ? s + 1 : s;
#pragma unroll
        for (int k = 0; k < 8; ++k) pn[k] = pfb[(size_t)sn * 512 + k * 64 + lane];
#pragma unroll
        for (int i = 0; i < 4; ++i) ln[i] = lfb[(size_t)sn * 4 * 4 * 64 + i * 64 + lane];
        union { bf16x8 v; unsigned u[4]; } bf[2];
#pragma unroll
        for (int ks = 0; ks < 2; ++ks) { bf[ks].u[0] = pk2(hs[2 * ks][0], hs[2 * ks][1]); bf[ks].u[1] = pk2(hs[2 * ks][2], hs[2 * ks][3]); bf[ks].u[2] = pk2(hs[2 * ks + 1][0], hs[2 * ks + 1][1]); bf[ks].u[3] = pk2(hs[2 * ks + 1][2], hs[2 * ks + 1][3]); }
#pragma unroll
        for (int i = 0; i < 4; ++i) { f32x4 acc = la[i];
#pragma unroll
            for (int ks = 0; ks < 2; ++ks) acc = mfma16(pa[i * 2 + ks], bf[ks].v, acc);
            hs[i] = acc; }
#pragma unroll
        for (int k = 0; k < 8; ++k) pa[k] = pn[k];
#pragma unroll
        for (int i = 0; i < 4; ++i) la[i] = ln[i];
    }
}
__device__ __forceinline__ void phase_mix3(const Ctx& C, const DArgs& a, int l) {
    const bf16* P = (const bf16*)(C.ws + WS_P); const float* SC = (const float*)(C.ws + WS_SC); const float* YS = (const float*)(C.ws + WS_YS); bf16* MIX = (bf16*)(C.ws + WS_MIX);
    LAS float* yt = (LAS float*)(C.lds);
    constexpr int GSP = 168;
    LAS unsigned char* gsig = C.lds + 32768;
    LAS float* gm = (LAS float*)(C.lds + 40960);
    const bf16* g2t = (const bf16*)(C.ws + WS_G2T) + (size_t)l * 256 * 160;
    const float* rk = a.in[I_DRK] + (size_t)l * 256; const float* lnw = a.in[I_DLNW] + (size_t)l * 256; const float* lnb = a.in[I_DLNB] + (size_t)l * 256;
    const int lane = C.lane, li = lane & 15, g = lane >> 4, h = C.wave & 3, d = C.wave >> 2;
    const int half = C.tid >> 8, c = C.tid & 255;
    const int u_lo = (l == DEPTH - 1) ? NCTX / 16 : 0;
    for (int u = u_lo + C.wg; u < ROWS / 16; u += C.G) {
        const int rc = u >> 1, th = u & 1, rowb = 16 * u;
        __syncthreads();
        for (int i = C.tid; i < 16 * 160; i += NTHR) { const int t = i / 160, ii = i % 160; *(LAS bf16*)(gsig + (t * GSP + ii) * 2) = (bf16)f2bf(sigmoidf_(bf2f(P[(size_t)(rowb + t) * INWP + C_GL + ii]))); }
        {
          const int ct = (d == 0) ? rc : (rc < 8 ? 7 - rc : 527 - rc), s = ct / RW_SC, ti = (d == 0) ? th : 1 - th;
          const bf16* rp = (const bf16*)(C.ws + WS_RPP) + (size_t)((d * 4 + h) * RW_NCH + rc) * 32 * 64;
          const bf16* hp = (const bf16*)(C.ws + WS_HSC) + (size_t)((d * 4 + h) * RW_NSC + s) * 64 * 64;
          bf16x8 af[2];
#pragma unroll
          for (int ks = 0; ks < 2; ++ks) af[ks] = ldg8(rp + (16 * ti + li) * 64 + 32 * ks + 8 * g);
#pragma unroll
          for (int vi = 0; vi < 4; ++vi) { f32x4 acc = {0.f, 0.f, 0.f, 0.f};
#pragma unroll
              for (int ks = 0; ks < 2; ++ks) acc = mfma16(af[ks], ldg8(hp + (16 * vi + li) * 64 + 32 * ks + 8 * g), acc);
#pragma unroll
              for (int r = 0; r < 4; ++r) { const int t = 16 * ti + 4 * g + r, rl = ((d == 0) ? t : 31 - t) - 16 * th;
                  yt[(d * 16 + rl) * 256 + h * 64 + 16 * vi + li] = acc[r] + YS[((size_t)d * ROWS + rowb + rl) * 256 + h * 64 + 16 * vi + li]; } } }
        __syncthreads();
#pragma unroll
        for (int c2 = 0; c2 < 2; ++c2) { const int ci = 2 * C.wave + c2; f32x4 a0 = {0.f, 0.f, 0.f, 0.f};
#pragma unroll
            for (int ks = 0; ks < 5; ++ks) a0 = mfma16(ldA(gsig, GSP, 0, 32 * ks, li, g), ldg8(g2t + (size_t)(16 * ci + li) * 160 + 32 * ks + 8 * g), a0);
#pragma unroll
            for (int r = 0; r < 4; ++r) gm[(4 * g + r) * 256 + 16 * ci + li] = a0[r]; }
        __syncthreads();
#pragma unroll 1
        for (int it = 0; it < 8; ++it) { const int rl = 2 * it + half, row = rowb + rl;
            const float* sc = SC + (size_t)row * 9 * 256;
            const float y = yt[rl * 256 + c] + yt[(16 + rl) * 256 + c];
            const float mu = wave_sum(y, lane) * (1.f / 64.f), dy = y - mu, var = wave_sum(dy * dy, lane) * (1.f / 64.f);
            const float yn = dy * rsqrtf(var + 64e-5f) * lnw[c] + lnb[c];
            const float r = sc[c], v = sc[256 + c];
            const float coef = wave_sum(r * (sc[4 * 256 + c] + sc[7 * 256 + c]) * rk[c], lane);
            MIX[(size_t)row * DM + 768 + c] = (bf16)f2bf((yn + coef * v) * gm[rl * 256 + c]); }
    }
    __syncthreads();
}
__device__ __forceinline__ void outproj_ctx(const Ctx& C, int l, const float* gate) {
    const bf16* A = (const bf16*)(C.ws + WS_MIX); const bf16* B = (const bf16*)(C.ws + WS_WOUT) + (size_t)l * DM * DM; float* XS = (float*)(C.ws + WS_XS);
    const int lane = C.lane, li = lane & 15, g = lane >> 4;
    for (int u = C.gw; u < (NCTX / 16) * (DM / 16); u += C.NGW) { const int rt = u >> 6, ct = u & 63;
        const bf16* ap = A + (size_t)(16 * rt + li) * DM + 8 * g; const bf16* bp = B + (size_t)(16 * ct + li) * DM + 8 * g;
        f32x4 acc0 = {0.f, 0.f, 0.f, 0.f}, acc1 = {0.f, 0.f, 0.f, 0.f};
#pragma unroll 4
        for (int ks = 0; ks < 32; ks += 2) { acc0 = mfma16(ldg8(ap + 32 * ks), ldg8(bp + 32 * ks), acc0); acc1 = mfma16(ldg8(ap + 32 * ks + 32), ldg8(bp + 32 * ks + 32), acc1); }
        const float gv = gate[16 * ct + li];
#pragma unroll
        for (int r = 0; r < 4; ++r) { float* p = XS + (size_t)(16 * rt + 4 * g + r) * DM + 16 * ct + li; *p = *p + gv * (acc0[r] + acc1[r]); } }
}

#ifndef MK_SINGLE
#define MK_SINGLE 1
#endif
template <int ONLYP> __global__ void __launch_bounds__(NTHR, 2) mega(Args a) {
    extern __shared__ __attribute__((aligned(16))) unsigned char lds_raw[];
    Ctx C;
#define MKCTX() do { int t_ = threadIdx.x; asm volatile("" : "+v"(t_)); unsigned char* w_ = a.ws; asm volatile("" : "+s"(w_)); unsigned l_ = 0u; asm volatile("" : "+s"(l_)); \
        C.lds = (LAS unsigned char*)lds_raw + l_; C.tid = t_; C.lane = t_ & 63; C.wave = __builtin_amdgcn_readfirstlane(t_ >> 6); \
        C.wg = blockIdx.x; C.G = gridDim.x; C.gw = C.wg * NWAVES + C.wave; C.NGW = C.G * NWAVES; C.ws = w_; } while (0)
    MKCTX();
    if (C.tid == 0) {
#pragma unroll
        for (int i = 0; i < 31; ++i) ((LAS unsigned long long*)(C.lds + MISC_OFF + 2048))[i] = (unsigned long long)a.in[i]; }
    DArgs da; da.in.tab = (const LAS unsigned*)(C.lds + MISC_OFF + 2048); da.out = a.out;
    if (C.tid < 4) ((LAS unsigned*)(C.lds + MISC_OFF))[C.tid] = 0u;
    __syncthreads();
    XcdBarrier bar; bar.bar = (unsigned*)(C.ws + WS_CTL) + CW_BAR; bar.x = 0; bar.st = (volatile LAS unsigned*)(C.lds + MISC_OFF);
    if (a.use_bar) bar = xcd_barrier_post((unsigned*)(C.ws + WS_CTL) + CW_BAR, (volatile LAS unsigned*)(C.lds + MISC_OFF));
#ifndef PHMASK
#define PHMASK 0x1fff
#endif
#define INP(o, k) ((ONLYP < 0 || ONLYP == (o)) && ((PHMASK >> ((o) == 99 ? 12 : (o))) & 1) && a.ph_lo <= (k) && (k) < a.ph_hi)
#ifndef REPMASK
#define REPMASK 0
#endif
#define NREP(o) ((((REPMASK) >> ((o) == 99 ? 12 : (o))) & 1) ? 2 : 1)
#define IN(k) (a.ph_lo <= (k) && (k) < a.ph_hi)
#define SEAM(k) do { if (a.use_bar && IN(k) && IN((k) + 1)) xcd_barrier(bar); } while (0)
    if (INP(0, 0)) for (int rep = 0; rep < NREP(0); ++rep) { MKCTX(); phase_prologue(C, da); }
    SEAM(0);
    for (int l = 0; l < DEPTH; ++l) {
        const int b = 1 + l * NPL;
        const float* mod_lat = (const float*)(C.ws + WS_MOD) + (size_t)(l * 2 + 0) * 6144; const float* mod_ctx = mod_lat + 6144;
        if (INP(1, b + 0)) { MKCTX(); phase_norm1(C, da, l); }
        SEAM(b + 0);
        if (INP(2, b + 1)) for (int rep = 0; rep < NREP(2); ++rep) { MKCTX();
            pg8::StaticOrder S; S.init(C.ws + WS_H, (const bf16*)(C.ws + WS_WIN) + (size_t)l * INWP * DM, ROWS, INWP, DM, C.G, C.wg);
            pg8::EpiStoreBf16 E{(bf16*)(C.ws + WS_P), INWP, nullptr, 0};
            pg8::gemm_phase<pg8::EpiStoreBf16, pg8::StaticOrder, true, true>(C.lds, C.tid, DM, S, E);
        }
        SEAM(b + 1);
        if (INP(3, b + 2)) { MKCTX(); mix1_rope(C); for (int rep = 0; rep < NREP(3); ++rep) { for (int r2 = 0; r2 < NREP(13); ++r2) mix1_vt(C); for (int r2 = 0; r2 < NREP(14); ++r2) mix1_rwkv_prep(C, da, l); for (int r2 = 0; r2 < NREP(15); ++r2) mix1_fourier1(C); } }
        SEAM(b + 2);
        if (INP(11, b + 3)) for (int rep = 0; rep < NREP(11); ++rep) { MKCTX(); phase_rwkv1(C); }
        SEAM(b + 3);
        if (INP(4, b + 4)) for (int rep = 0; rep < NREP(4); ++rep) { MKCTX(); phase_mix2(C, da, l); }
        SEAM(b + 4);
        if (INP(5, b + 5)) for (int rep = 0; rep < NREP(5); ++rep) { MKCTX(); phase_mix3(C, da, l); }
        SEAM(b + 5);
        if (INP(6, b + 6)) { MKCTX();
            if (l < DEPTH - 1) outproj_ctx(C, l, mod_ctx + 2 * DM);
            pg8::StaticOrder S; S.init(C.ws + WS_MIX + (size_t)NCTX * DM * 2, (const bf16*)(C.ws + WS_WOUT) + (size_t)l * DM * DM, SEQ, DM, DM, C.G, C.wg);
            pg8::EpiResidual E{(float*)(C.ws + WS_XS) + (size_t)NCTX * DM, DM, mod_lat + 2 * DM, mod_lat + 2 * DM};
            pg8::gemm_phase<pg8::EpiResidual, pg8::StaticOrder, true, true>(C.lds, C.tid, DM, S, E);
        }
        SEAM(b + 6);
        if (INP(7, b + 7)) for (int rep = 0; rep < NREP(7); ++rep) { MKCTX(); phase_norm2(C, da, l); }
        SEAM(b + 7);
        if (INP(8, b + 8)) for (int rep = 0; rep < NREP(8); ++rep) { MKCTX(); phase_gather(C, da, l); }
        SEAM(b + 8);
        if (INP(9, b + 9)) for (int rep = 0; rep < NREP(9); ++rep) { MKCTX();
            const int nblk = moe_tables(C);
            pg8::MoeOrder S{(const char*)(C.ws + WS_XG), (const char*)((const bf16*)(C.ws + WS_WGU) + (size_t)l * 32 * 2048 * DM), (size_t)256 * DM * 2, (size_t)2048 * DM * 2,
                            (const LAS unsigned char*)(C.lds + MISC_OFF + 1024), nblk, 8, C.G, C.wg};
            pg8::EpiSwiglu E{(bf16*)(C.ws + WS_ACT), DM, da.in[I_BGU] + (size_t)l * 32 * 2048, 2048};
            pg8::gemm_phase<pg8::EpiSwiglu, pg8::MoeOrder, true, true>(C.lds, C.tid, DM, S, E);
        }
        SEAM(b + 9);
        if (INP(10, b + 10)) for (int rep = 0; rep < NREP(10); ++rep) { MKCTX();
            const int nblk = moe_tables(C);
            pg8::MoeOrder S{(const char*)(C.ws + WS_ACT), (const char*)((const bf16*)(C.ws + WS_WDN) + (size_t)l * 32 * DM * DM), (size_t)256 * DM * 2, (size_t)DM * DM * 2,
                            (const LAS unsigned char*)(C.lds + MISC_OFF + 1024), nblk, 4, C.G, C.wg};
            pg8::EpiStoreBf16 E{(bf16*)(C.ws + WS_XG), DM, da.in[I_BDN] + (size_t)l * 32 * DM, DM};
            pg8::gemm_phase<pg8::EpiStoreBf16, pg8::MoeOrder, true, true>(C.lds, C.tid, DM, S, E);
        }
        SEAM(b + 10);
    }
    if (INP(99, PH_TOTAL - 1)) { MKCTX(); phase_final(C, da); }
#undef IN
#undef INP
#undef SEAM
}

typedef void (*kern_t)(Args);
static kern_t kern_of(int o) {
    switch (o) { case 0: return mega<0>; case 1: return mega<1>; case 2: return mega<2>; case 3: return mega<3>; case 4: return mega<4>; case 5: return mega<5>; case 6: return mega<6>;
                 case 7: return mega<7>; case 8: return mega<8>; case 9: return mega<9>; case 10: return mega<10>; case 11: return mega<11>; case 99: return mega<99>;
#if MK_SINGLE
                 default: return mega<-1>;
#else
                 default: return mega<0>;
#endif
    }
}
extern "C" void kernel_launch(void* const* d_in, const int* in_sizes, int n_in, void* d_out, int out_size, void* d_ws, size_t ws_size, hipStream_t stream) {
    static int ready = 0;
    if (ready == 0) {
        if (n_in != 31 || out_size != SEQ * DM || ws_size < WS_END) { fprintf(stderr, "kernel_launch: unexpected shapes (n_in %d, out %d, ws %zu)\n", n_in, out_size, ws_size); ready = -1; return; }
        const int ids[14] = {0, 1, 2, 3, 4, 5, 6, 7, 8, 9, 10, 11, 99, -1};
        for (int i = 0; i < (MK_SINGLE ? 14 : 13); ++i) { if (MK_SINGLE && ids[i] != -1) continue;
            if (hipFuncSetAttribute((const void*)kern_of(ids[i]), hipFuncAttributeMaxDynamicSharedMemorySize, LDS_BYTES) != hipSuccess) { fprintf(stderr, "kernel_launch: hipFuncSetAttribute failed (%d)\n", ids[i]); ready = -1; return; } }
        ready = 1;
    }
    if (ready < 0) return;
    (void)hipMemsetAsync((char*)d_ws + WS_CTL, 0, CTL_ZERO_BYTES, stream);
    Args a{};
    for (int i = 0; i < 31; ++i) a.in[i] = (const float*)d_in[i];
    a.out = (float*)d_out; a.ws = (unsigned char*)d_ws; a.pad = 0;
#if MK_SINGLE
    a.ph_lo = 0; a.ph_hi = PH_TOTAL; a.use_bar = 1;
    hipLaunchKernelGGL(kern_of(-1), dim3(NWG), dim3(NTHR), LDS_BYTES, stream, a);
#else
    for (int p = 0; p < PH_TOTAL; ++p) { a.ph_lo = p; a.ph_hi = p + 1; a.use_bar = 0;
        const int j = (p - 1) % NPL; const int o = (p == 0) ? 0 : (p == PH_TOTAL - 1) ? 99 : (j < 3 ? 1 + j : j == 3 ? 11 : j);
        hipLaunchKernelGGL(kern_of(o), dim3(NWG), dim3(NTHR), LDS_BYTES, stream, a); }
#endif
}
```

```cpp
#include <hip/hip_runtime.h>
#include <cstdio>
#include <cstdint>

#define LAS __attribute__((address_space(3)))
typedef unsigned short bf16;
typedef float f32x4 __attribute__((ext_vector_type(4)));
typedef float f32x2 __attribute__((ext_vector_type(2)));
typedef short bf16x8 __attribute__((ext_vector_type(8)));
typedef unsigned u32x4 __attribute__((ext_vector_type(4)));
typedef unsigned u32x2 __attribute__((ext_vector_type(2)));

constexpr int DM = 1024, SEQ = 16384, NCTX = 256, ROWS = SEQ + NCTX, DEPTH = 4, GRIDW = 64;
constexpr int INW = 2720, INWP = 2816;
constexpr int C_AQ = 0, C_AK = 256, C_AV = 384, C_BU = 512, C_CQ = 768, C_CK = 1024, C_CV = 1280, C_DR = 1536, C_DK = 1792, C_DV = 2048, C_WL = 2304, C_AL = 2432, C_GL = 2560;
constexpr int NEXP = 32, TOPK = 4;
constexpr int MOE_MAXBLK = 296;
constexpr int MOE_ROWS = MOE_MAXBLK * 256;
constexpr int NWG = 256, NTHR = 512, NWAVES = 8;
constexpr int VTP = ROWS + 256;

constexpr size_t MiB = 1u << 20;
constexpr size_t WS_CTL = 0, CTL_ZERO_BYTES = 1 * MiB;
constexpr size_t WS_MOD = 1 * MiB;
constexpr size_t WS_TW = 2 * MiB;
constexpr size_t WS_MTAB = 3 * MiB;
constexpr size_t WS_XS = 4 * MiB;
constexpr size_t WS_H = 70 * MiB;
constexpr size_t WS_P = 104 * MiB;
constexpr size_t WS_MIX = 194 * MiB;
constexpr size_t WS_FYR = 228 * MiB, WS_FYI = 244 * MiB;
constexpr size_t WS_VTA = 1544 * MiB, WS_VTC = 1550 * MiB;
constexpr size_t WS_SC = 260 * MiB;
constexpr size_t WS_YS = 408 * MiB;
constexpr size_t WS_ROUTE = 442 * MiB;
constexpr size_t WS_CNT = 444 * MiB;
constexpr size_t WS_XG = 446 * MiB;
constexpr size_t WS_ACT = 596 * MiB;
constexpr size_t WS_XG8 = WS_ACT, WS_ACT8 = WS_ACT + 75 * MiB;
constexpr size_t WS_WIN = 746 * MiB;
constexpr size_t WS_WOUT = 768 * MiB;
constexpr size_t WS_WGU = 776 * MiB;
constexpr size_t WS_WDN = 1288 * MiB;
constexpr size_t WS_RPP = 1560 * MiB, WS_PSC = 1578 * MiB, WS_LSC = 1580 * MiB, WS_HSC = 1584 * MiB;
constexpr size_t WS_FTAB = 1586 * MiB;
constexpr size_t WS_G2T = 1588 * MiB, WS_RWT = 1589 * MiB;
constexpr size_t WS_LORAT = 1590 * MiB;
constexpr size_t WS_F256 = 1591 * MiB;
constexpr size_t WS_END = 1592 * MiB;
static_assert(WS_XS + (size_t)ROWS * DM * 4 <= WS_H && WS_H + (size_t)ROWS * DM * 2 <= WS_P && WS_P + (size_t)ROWS * INWP * 2 <= WS_MIX && WS_MIX + (size_t)ROWS * DM * 2 <= WS_FYR, "ws map 1");
static_assert(WS_SC + (size_t)ROWS * 9 * 256 * 4 <= WS_YS && WS_YS + (size_t)2 * ROWS * 256 * 4 <= WS_ROUTE && WS_XG + (size_t)MOE_ROWS * DM * 2 <= WS_ACT && WS_ACT + (size_t)MOE_ROWS * DM * 2 <= WS_WIN, "ws map 2");
static_assert(WS_WIN + (size_t)4 * INWP * DM * 2 <= WS_WOUT && WS_WGU + (size_t)4 * 32 * 2048 * 1024 * 2 <= WS_WDN && WS_WDN + (size_t)4 * 32 * 1024 * 1024 * 2 <= WS_END, "ws map 3");
constexpr int CW_BAR = 4096;
constexpr int CW_WQ = 16384;

constexpr int RING_BYTES = 131072;
constexpr int MISC_OFF = 143360;
constexpr int LDS_BYTES = 147456;

__device__ __forceinline__ unsigned f2bf(float f) { unsigned u = __builtin_bit_cast(unsigned, f); return (u + 0x7fffu + ((u >> 16) & 1u)) >> 16; }
__device__ __forceinline__ unsigned pk2(float lo, float hi) { return f2bf(lo) | (f2bf(hi) << 16); }
__device__ __forceinline__ float bf2f(unsigned short b) { return __builtin_bit_cast(float, (unsigned)b << 16); }
__device__ __forceinline__ float bflo(unsigned w) { return __builtin_bit_cast(float, w << 16); }
__device__ __forceinline__ float bfhi(unsigned w) { return __builtin_bit_cast(float, w & 0xffff0000u); }
__device__ __forceinline__ float shx(float v, int o, int lane) { return __builtin_bit_cast(float, __builtin_amdgcn_ds_bpermute((lane ^ o) << 2, __builtin_bit_cast(int, v))); }
__device__ __forceinline__ int shxi(int v, int o, int lane) { return __builtin_amdgcn_ds_bpermute((lane ^ o) << 2, v); }
__device__ __forceinline__ float wave_sum(float v, int lane) {
#pragma unroll
    for (int o = 1; o < 64; o <<= 1) v += shx(v, o, lane);
    return v;
}
__device__ __forceinline__ float sigmoidf_(float x) { return 1.f / (1.f + __expf(-x)); }
#define LDS_WAIT() asm volatile("s_waitcnt lgkmcnt(0)" ::: "memory")
#define VM_WAIT() asm volatile("s_waitcnt vmcnt(0)" ::: "memory")

namespace pg8 {
#define PG8_LAS __attribute__((address_space(3)))
typedef unsigned short bf16_t;
constexpr int BM = 256, BK = 64, HALF = 128, HTB = HALF * BK * 2, STAGE_BYTES = 8 * HTB, NXCD = 8, WGM = 8;
__host__ __device__ __forceinline__ int lds_byte(int r, int c) { const int st = (r >> 4) * 2 + (c >> 5), rr = r & 15, cc = c & 31, ob = rr * 64 + cc * 2; return st * 1024 + (ob ^ (((ob >> 9) & 1) << 5)); }
__host__ __device__ __forceinline__ void stage_rc(int b, int& R, int& C) { const int st = b / 1024, sb = b % 1024, swz = sb ^ (((sb >> 9) & 1) << 5); R = (st >> 1) * 16 + swz / 64; C = (st & 1) * 32 + (swz % 64) / 2; }
__host__ __device__ __forceinline__ int perm32(int rho) { const int n = rho >> 4, i = rho & 15; return 8 * (i >> 2) + 4 * n + (i & 3); }
struct Unit { int pm, pn, e; };
typedef int v8i __attribute__((ext_vector_type(8))); typedef int v4i __attribute__((ext_vector_type(4)));
__device__ __forceinline__ v8i cat8(bf16x8 a, bf16x8 b) { const v4i x = __builtin_bit_cast(v4i, a), y = __builtin_bit_cast(v4i, b); return __builtin_shufflevector(x, y, 0, 1, 2, 3, 4, 5, 6, 7); }
__device__ __forceinline__ unsigned cvt_pk_bf16(float lo, float hi) { unsigned r; asm volatile("v_cvt_pk_bf16_f32 %0, %1, %2" : "=v"(r) : "v"(lo), "v"(hi)); return r; }

struct StaticOrder {
    unsigned A, Bt, tstep;
    int nM, nN, nwg, G, c;
    __device__ void init(size_t A_, size_t Bt_, int M, int N, int K, int G_, int c_) { A = (unsigned)A_; Bt = (unsigned)Bt_; tstep = (unsigned)(BM * K * 2); nM = M / BM; nN = N / BM; nwg = nM * nN; G = G_; c = c_; }
    __device__ bool next(int i, Unit& u) const {
        const long L = (long)i * G + c; if (L >= nwg) return false;
        int wgid = (int)L; { const int q = nwg / NXCD, r = nwg % NXCD, xcd = wgid % NXCD, off = wgid / NXCD; wgid = (xcd < r ? xcd * (q + 1) : r * (q + 1) + (xcd - r) * q) + off; }
        const int nig = WGM * nN, gid = wgid / nig, fm = gid * WGM, gsz = (nM - fm) < WGM ? (nM - fm) : WGM;
        u.pm = fm + ((wgid % nig) % gsz); u.pn = (wgid % nig) / gsz; u.e = 0; return true;
    }
    __device__ __forceinline__ unsigned pa(const Unit& u) const { return A + (unsigned)u.pm * tstep; }
    __device__ __forceinline__ unsigned pb(const Unit& u) const { return Bt + (unsigned)u.pn * tstep; }
};
struct MoeOrder {
    unsigned A, Bt, tstep, estep;
    const LAS unsigned char* blk_e; int nblk, nN, G, c;
    __device__ bool next(int i, Unit& u) const {
        const int L = i * G + c; if (L >= nblk * nN) return false;
        u.pm = L / nN; u.pn = L % nN; u.e = __builtin_amdgcn_readfirstlane((int)blk_e[u.pm]); return true;
    }
    __device__ __forceinline__ unsigned pa(const Unit& u) const { return A + (unsigned)u.pm * tstep; }
    __device__ __forceinline__ unsigned pb(const Unit& u) const { return Bt + (unsigned)u.e * estep + (unsigned)u.pn * tstep; }
};

struct EpiStoreBf16 {
    static constexpr bool PERM = true;
    bf16_t* O; int ldc; const float* bias; int bias_estride; float bias_scale, acc_scale;
    __device__ __forceinline__ void init(f32x4 (&acc)[2][2][4][2], const Unit& u, int wc, int fq) const {
        const int col0 = u.pn * BM + wc * 32 + 8 * fq;
#pragma unroll
        for (int b = 0; b < 2; ++b)
#pragma unroll
            for (int n = 0; n < 2; ++n) { const f32x4 bv = bias ? *(const f32x4*)(bias + (size_t)u.e * bias_estride + col0 + b * HALF + 4 * n) * bias_scale : (f32x4){0.f, 0.f, 0.f, 0.f};
#pragma unroll
                for (int a = 0; a < 2; ++a)
#pragma unroll
                    for (int m = 0; m < 4; ++m) { f32x4 t = bv; asm volatile("" : "+v"(t)); acc[a][b][m][n] = t; } }
    }
    __device__ __forceinline__ void operator()(const f32x4 (&acc)[2][2][4][2], const Unit& u, int wr, int wc, int fr, int fq) const {
        const int row0 = u.pm * BM + wr * 64 + fr, col0 = u.pn * BM + wc * 32 + 8 * fq;
#pragma unroll
        for (int ai = 0; ai < 2; ++ai)
#pragma unroll
            for (int m = 0; m < 4; ++m) { bf16_t* rowp = O + (size_t)(row0 + ai * HALF + m * 16) * ldc + col0;
#pragma unroll
                for (int bj = 0; bj < 2; ++bj) { const f32x4 v0 = acc[ai][bj][m][0] * acc_scale, v1 = acc[ai][bj][m][1] * acc_scale;
                    u32x4 w; w.x = cvt_pk_bf16(v0[0], v0[1]); w.y = cvt_pk_bf16(v0[2], v0[3]); w.z = cvt_pk_bf16(v1[0], v1[1]); w.w = cvt_pk_bf16(v1[2], v1[3]);
                    *(u32x4*)(rowp + bj * HALF) = w; }
                asm volatile("" ::: "memory"); }
    }
};
__device__ __forceinline__ float swiglu1(float g, float up) {
    g = fminf(g, 7.0f); up = fminf(fmaxf(up, -7.0f), 7.0f);
    return g * (1.f / (1.f + __expf(-1.702f * g))) * (up + 1.0f);
}
constexpr float X8_S = 8.0f, W8_S = 256.0f, ACT_S = 4.0f;
struct EpiSwiglu {
    static constexpr bool PERM = true;
    bf16_t* O; int ldc; const float* bias; int bias_estride; float bias_scale, acc_scale;
    __device__ __forceinline__ void init(f32x4 (&acc)[2][2][4][2], const Unit& u, int wc, int fq) const {
        const int col0 = u.pn * BM + wc * 32 + 8 * fq;
#pragma unroll
        for (int b = 0; b < 2; ++b)
#pragma unroll
            for (int n = 0; n < 2; ++n) { const f32x4 bv = bias ? *(const f32x4*)(bias + (size_t)u.e * bias_estride + col0 + b * HALF + 4 * n) * bias_scale : (f32x4){0.f, 0.f, 0.f, 0.f};
#pragma unroll
                for (int a = 0; a < 2; ++a)
#pragma unroll
                    for (int m = 0; m < 4; ++m) { f32x4 t = bv; asm volatile("" : "+v"(t)); acc[a][b][m][n] = t; } }
    }
    __device__ __forceinline__ void operator()(const f32x4 (&acc)[2][2][4][2], const Unit& u, int wr, int wc, int fr, int fq) const {
        const int row0 = u.pm * BM + wr * 64 + fr, col0 = u.pn * BM + wc * 32 + 8 * fq;
#pragma unroll
        for (int ai = 0; ai < 2; ++ai)
#pragma unroll
            for (int m = 0; m < 4; ++m) { unsigned char* rowp = (unsigned char*)O + (size_t)(row0 + ai * HALF + m * 16) * ldc + (col0 >> 1);
#pragma unroll
                for (int bj = 0; bj < 2; ++bj) { const f32x4 v0 = acc[ai][bj][m][0] * acc_scale, v1 = acc[ai][bj][m][1] * acc_scale;
                    unsigned w = 0; w = __builtin_amdgcn_cvt_pk_fp8_f32(swiglu1(v0[0], v0[1]) * ACT_S, swiglu1(v0[2], v0[3]) * ACT_S, w, false); w = __builtin_amdgcn_cvt_pk_fp8_f32(swiglu1(v1[0], v1[1]) * ACT_S, swiglu1(v1[2], v1[3]) * ACT_S, w, true);
                    *(unsigned*)(rowp + bj * (HALF / 2)) = w; }
                asm volatile("" ::: "memory"); }
    }
};
struct EpiResidual {
    static constexpr bool PERM = false;
    float* X; int ldc; const float* gate_lat; const float* gate_ctx;
    __device__ __forceinline__ void init(f32x4 (&acc)[2][2][4][2], const Unit& u, int wc, int fq) const {
#pragma unroll
        for (int a = 0; a < 2; ++a)
#pragma unroll
            for (int b = 0; b < 2; ++b)
#pragma unroll
                for (int m = 0; m < 4; ++m)
#pragma unroll
                    for (int n = 0; n < 2; ++n) acc[a][b][m][n] = (f32x4){0.f, 0.f, 0.f, 0.f};
    }
    __device__ __forceinline__ void operator()(const f32x4 (&acc)[2][2][4][2], const Unit& u, int wr, int wc, int fr, int fq) const {
        const int row0 = u.pm * BM + wr * 64 + fr, col0 = u.pn * BM + wc * 32 + 4 * fq;
        const float* gp = (u.pm == 0) ? gate_ctx : gate_lat;
        f32x4 gv[2][2];
#pragma unroll
        for (int bj = 0; bj < 2; ++bj)
#pragma unroll
            for (int n = 0; n < 2; ++n) gv[bj][n] = *(const f32x4*)(gp + col0 + bj * HALF + n * 16);
#pragma unroll
        for (int ai = 0; ai < 2; ++ai)
#pragma unroll
            for (int m = 0; m < 4; ++m) { float* rowp = X + (size_t)(row0 + ai * HALF + m * 16) * ldc + col0;
#pragma unroll
                for (int bj = 0; bj < 2; ++bj)
#pragma unroll
                    for (int n = 0; n < 2; ++n) { f32x4* p = (f32x4*)(rowp + bj * HALF + n * 16); *p = *p + gv[bj][n] * acc[ai][bj][m][n]; }
                asm volatile("" ::: "memory"); }
    }
};
template <class Epi, class Sched, bool ALIGN_EPI = false, bool SP2 = false, int ES = 2>
__device__ __forceinline__ void gemm_phase(PG8_LAS unsigned char* lds, const int tid, const int K, const Sched& S, const Epi& E, const void* wsbase) {
    const __amdgpu_buffer_rsrc_t rsrc = __builtin_amdgcn_make_buffer_rsrc((void*)wsbase, 0, 0x7fffffff, 0x00020000);
    const int wid = __builtin_amdgcn_readfirstlane(tid >> 6), lane = tid & 63, wr = wid >> 2, wc = wid & 3, fr = lane & 15, fq = lane >> 4;
    const int nt = (K * ES) / 128;
    unsigned voffA[2], voffB[2];
#pragma unroll
    for (int i = 0; i < 2; ++i) { int R, C; stage_rc(tid * 16 + i * 8192, R, C); const int Rb = Epi::PERM ? ((R & ~31) + perm32(R & 31)) : R;
        voffA[i] = (unsigned)(R * K * ES + C * 2); voffB[i] = (unsigned)(Rb * K * ES + C * 2); }
    const unsigned kstep = (unsigned)(BK * 2);
    const unsigned hstep = (unsigned)(HALF * K * ES);
        const unsigned ldsw = (unsigned)wid * 1024u;
    const int aoff = lds_byte(wr * 64 + fr, ES == 2 ? fq * 8 : fq * 16), boff = lds_byte(wc * 32 + fr, ES == 2 ? fq * 8 : fq * 16); constexpr int KOFF = (ES == 2) ? 1024 : 16;
#define PG8_SA(b, h) (((b) * 2 + (h)) * HTB)
#define PG8_SB(b, h) ((4 + (b) * 2 + (h)) * HTB)
#define PG8_STAGE(bufoff, gbase, voff) do { _Pragma("unroll") for (int _i = 0; _i < 2; ++_i) \
        __builtin_amdgcn_raw_ptr_buffer_load_lds(rsrc, (PG8_LAS unsigned*)(lds + (bufoff) + ldsw + _i * 8192), 16, (voff)[_i], (gbase), 0, 0); } while (0)
#define PG8_LDA(dst, b, h) do { _Pragma("unroll") for (int m = 0; m < 4; ++m) _Pragma("unroll") for (int k = 0; k < 2; ++k) dst[m][k] = *(const PG8_LAS bf16x8*)(lds + PG8_SA(b, h) + aoff + m * 2048 + k * KOFF); } while (0)
#define PG8_LDA8(dst, b, h) do { _Pragma("unroll") for (int m = 0; m < 4; ++m) { const PG8_LAS v4i* p_ = (const PG8_LAS v4i*)(lds + PG8_SA(b, h) + aoff + m * 2048); const v4i x_ = p_[0], y_ = p_[1]; dst[m] = __builtin_shufflevector(x_, y_, 0, 1, 2, 3, 4, 5, 6, 7); } } while (0)
#define PG8_LDB(dst, b, h) do { _Pragma("unroll") for (int n = 0; n < 2; ++n) _Pragma("unroll") for (int k = 0; k < 2; ++k) dst[n][k] = *(const PG8_LAS bf16x8*)(lds + PG8_SB(b, h) + boff + n * 2048 + k * KOFF); } while (0)
#define PG8_LDB8(dst, b, h) do { _Pragma("unroll") for (int n = 0; n < 2; ++n) { const PG8_LAS v4i* p_ = (const PG8_LAS v4i*)(lds + PG8_SB(b, h) + boff + n * 2048); const v4i x_ = p_[0], y_ = p_[1]; dst[n] = __builtin_shufflevector(x_, y_, 0, 1, 2, 3, 4, 5, 6, 7); } } while (0)
#define PG8_MMA(ai, bj, At, Bt) do { __builtin_amdgcn_s_setprio(1); _Pragma("unroll") for (int m = 0; m < 4; ++m) _Pragma("unroll") for (int n = 0; n < 2; ++n) { \
        if constexpr (ES == 2) { _Pragma("unroll") for (int k = 0; k < 2; ++k) acc[ai][bj][m][n] = __builtin_amdgcn_mfma_f32_16x16x32_bf16(Bt[n][k], At[m][k], acc[ai][bj][m][n], 0, 0, 0); } \
        else asm volatile("v_mfma_f32_16x16x128_f8f6f4 %0, %1, %2, %0" : "+v"(acc[ai][bj][m][n]) : "v"(Bt##8[n]), "v"(At##8[m])); } \
        __builtin_amdgcn_s_setprio(0); } while (0)
#define PG8_LDAX(b, h) do { if constexpr (ES == 2) PG8_LDA(At, b, h); else PG8_LDA8(At8, b, h); } while (0)
#define PG8_LDBX(B, b, h) do { if constexpr (ES == 2) PG8_LDB(B, b, h); else PG8_LDB8(B##8, b, h); } while (0)
#define PG8_WAIT_V(n) asm volatile("s_waitcnt vmcnt(" #n ")" ::: "memory")
#define PG8_WAIT_L(n) asm volatile("s_waitcnt lgkmcnt(" #n ")" ::: "memory")
#define PG8_BAR __builtin_amdgcn_s_barrier()
#define PG8_SCHED __builtin_amdgcn_sched_barrier(0)
    Unit cur, nxt; int ui = 0;
    if (!S.next(0, cur)) return;
    f32x4 acc[2][2][4][2];
    E.init(acc, cur, wc, fq);
    bf16x8 At[4][2], B0[2][2], B1[2][2]; v8i At8[4], B08[2], B18[2];
    unsigned cA = S.pa(cur), cB = S.pb(cur);
    if constexpr (SP2) {
        PG8_STAGE(PG8_SB(0, 0), cB, voffB); PG8_STAGE(PG8_SB(0, 1), cB + hstep, voffB); PG8_STAGE(PG8_SA(0, 0), cA, voffA); PG8_STAGE(PG8_SA(0, 1), cA + hstep, voffA);
        if (wr == 1) PG8_BAR;
        PG8_WAIT_V(2); PG8_BAR;
        PG8_STAGE(PG8_SB(1, 0), cB + kstep, voffB); PG8_STAGE(PG8_SA(1, 0), cA + kstep, voffA); PG8_STAGE(PG8_SB(1, 1), cB + hstep + kstep, voffB);
        PG8_WAIT_V(6); PG8_BAR;
    } else {
        PG8_STAGE(PG8_SB(0, 0), cB, voffB); PG8_STAGE(PG8_SA(0, 0), cA, voffA); PG8_STAGE(PG8_SB(0, 1), cB + hstep, voffB); PG8_STAGE(PG8_SA(0, 1), cA + hstep, voffA);
        if (wr == 1) PG8_BAR;
        PG8_WAIT_V(4); PG8_BAR;
        PG8_STAGE(PG8_SB(1, 0), cB + kstep, voffB); PG8_STAGE(PG8_SA(1, 0), cA + kstep, voffA); PG8_STAGE(PG8_SB(1, 1), cB + hstep + kstep, voffB);
        PG8_WAIT_V(6); PG8_BAR;
    }
    for (;;) {
        const bool has_next = S.next(ui + 1, nxt);
        const unsigned nA = has_next ? S.pa(nxt) : cA, nB = has_next ? S.pb(nxt) : cB;
        for (int t = 0; t < nt; t += 2) {
            const bool last = (t == nt - 2);
            const unsigned a1 = cA + (unsigned)(t + 1) * kstep;
            const unsigned a2 = last ? nA : cA + (unsigned)(t + 2) * kstep, b2 = last ? nB : cB + (unsigned)(t + 2) * kstep;
            const unsigned a3 = a2 + kstep, b3 = b2 + kstep;
            if constexpr (SP2) {
            PG8_LDBX(B0, 0, 0); PG8_LDBX(B1, 0, 1); PG8_SCHED; PG8_LDAX(0, 0); PG8_STAGE(PG8_SA(1, 1), a1 + hstep, voffA);
            PG8_WAIT_V(8); PG8_WAIT_L(0); PG8_BAR; PG8_MMA(0, 0, At, B0); PG8_MMA(0, 1, At, B1); PG8_BAR; PG8_SCHED;
            PG8_LDAX(0, 1); PG8_STAGE(PG8_SB(0, 0), b2, voffB); PG8_STAGE(PG8_SB(0, 1), b2 + hstep, voffB); PG8_STAGE(PG8_SA(0, 0), a2, voffA);
            PG8_WAIT_V(8); PG8_WAIT_L(0); PG8_BAR; PG8_MMA(1, 0, At, B0); PG8_MMA(1, 1, At, B1); PG8_BAR; PG8_SCHED;
            PG8_LDBX(B0, 1, 0); PG8_LDBX(B1, 1, 1); PG8_SCHED; PG8_LDAX(1, 0); PG8_STAGE(PG8_SA(0, 1), a2 + hstep, voffA);
            PG8_WAIT_V(8); PG8_WAIT_L(0); PG8_BAR; PG8_MMA(0, 0, At, B0); PG8_MMA(0, 1, At, B1); PG8_BAR; PG8_SCHED;
            PG8_LDAX(1, 1); PG8_STAGE(PG8_SB(1, 0), b3, voffB); PG8_STAGE(PG8_SB(1, 1), b3 + hstep, voffB); PG8_STAGE(PG8_SA(1, 0), a3, voffA);
            PG8_WAIT_V(8); PG8_WAIT_L(0); PG8_BAR; PG8_MMA(1, 0, At, B0); PG8_MMA(1, 1, At, B1); PG8_BAR; PG8_SCHED;
            } else {
            PG8_LDBX(B0, 0, 0); PG8_SCHED; PG8_LDAX(0, 0); PG8_STAGE(PG8_SA(1, 1), a1 + hstep, voffA);
            PG8_WAIT_L(8); PG8_BAR; PG8_WAIT_L(0); PG8_MMA(0, 0, At, B0); PG8_BAR; PG8_SCHED;
            PG8_LDBX(B1, 0, 1); PG8_STAGE(PG8_SB(0, 0), b2, voffB);
            PG8_BAR; PG8_WAIT_L(0); PG8_MMA(0, 1, At, B1); PG8_BAR;
            PG8_LDAX(0, 1); PG8_STAGE(PG8_SA(0, 0), a2, voffA);
            PG8_BAR; PG8_WAIT_L(0); PG8_MMA(1, 0, At, B0); PG8_BAR; PG8_SCHED;
            PG8_STAGE(PG8_SB(0, 1), b2 + hstep, voffB);
            PG8_WAIT_V(6); PG8_BAR; PG8_MMA(1, 1, At, B1); PG8_BAR;
            PG8_LDBX(B0, 1, 0); PG8_SCHED; PG8_LDAX(1, 0); PG8_STAGE(PG8_SA(0, 1), a2 + hstep, voffA);
            PG8_WAIT_L(8); PG8_BAR; PG8_WAIT_L(0); PG8_MMA(0, 0, At, B0); PG8_BAR; PG8_SCHED;
            PG8_LDBX(B1, 1, 1); PG8_STAGE(PG8_SB(1, 0), b3, voffB);
            PG8_BAR; PG8_WAIT_L(0); PG8_MMA(0, 1, At, B1); PG8_BAR;
            PG8_LDAX(1, 1); PG8_STAGE(PG8_SA(1, 0), a3, voffA);
            PG8_BAR; PG8_WAIT_L(0); PG8_MMA(1, 0, At, B0); PG8_BAR; PG8_SCHED;
            PG8_STAGE(PG8_SB(1, 1), b3 + hstep, voffB);
            PG8_WAIT_V(6); PG8_BAR; PG8_MMA(1, 1, At, B1); PG8_BAR;
            }
        }
        if constexpr (ALIGN_EPI) { if (wr == 0) PG8_BAR; }
        if constexpr (ES == 1) asm volatile("s_nop 15\n\ts_nop 15" ::: "memory");
        E(acc, cur, wr, wc, fr, fq);
        if (!has_next) break;
        E.init(acc, nxt, wc, fq);
        cur = nxt; cA = nA; cB = nB; ++ui;
        if constexpr (ALIGN_EPI) { if (wr == 1) PG8_BAR; }
    }
    PG8_WAIT_V(0);
    if constexpr (!ALIGN_EPI) { if (wr == 0) PG8_BAR; }
    PG8_BAR;
#undef PG8_SA
#undef PG8_SB
#undef PG8_STAGE
#undef PG8_LDA
#undef PG8_LDA8
#undef PG8_LDB8
#undef PG8_LDAX
#undef PG8_LDBX
#undef PG8_LDB
#undef PG8_MMA
#undef PG8_WAIT_V
#undef PG8_WAIT_L
#undef PG8_BAR
#undef PG8_SCHED
}
}

#define XB_TMO      128
#define XB_XCNT(j)  (256  + 64 * (j))
#define XB_XSUB(j)  (1280 + 64 * (j))
#define XB_XGEN(j)  (2304 + 64 * (j))
#define XB_TOP      3328
#define XB_TOPGEN   3392
#define XCD_BAR_WORDS 3456
#define XB_SPIN_CAP (1u << 18)
__device__ __forceinline__ unsigned xb_ld(unsigned* p)              { return __hip_atomic_load(p, __ATOMIC_RELAXED, __HIP_MEMORY_SCOPE_AGENT); }
__device__ __forceinline__ unsigned xb_add(unsigned* p, unsigned v) { return __hip_atomic_fetch_add(p, v, __ATOMIC_RELAXED, __HIP_MEMORY_SCOPE_AGENT); }
__device__ __forceinline__ unsigned xb_xcc_id() { return (unsigned)__builtin_amdgcn_s_getreg((3 << 11) | 20) & 0xFu; }
#define XB_SPIN(cond, bar) do { unsigned _sp = 0; while (cond) { __builtin_amdgcn_s_sleep(1); \
    if ((++_sp & 255u) == 0u) { if (xb_ld(&(bar)[XB_TMO])) break; if (_sp > XB_SPIN_CAP) { atomicAdd(&(bar)[XB_TMO], 1u); break; } } } } while (0)

struct XcdBarrier {
    unsigned* bar; unsigned x;
    volatile LAS unsigned* st;
};

__device__ __forceinline__ XcdBarrier xcd_barrier_post(unsigned* bar, volatile LAS unsigned* st) {
    XcdBarrier b; b.bar = bar; b.x = xb_xcc_id(); b.st = st;
    if (threadIdx.x == 0) (void)xb_add(&bar[XB_XCNT(b.x)], 1u);
    return b;
}
__device__ __forceinline__ void xcd_barrier_complete(unsigned* bar, unsigned x, unsigned& nloc, unsigned& nx) {
    const unsigned G = gridDim.x * gridDim.y * gridDim.z;
    unsigned sum, cnt, mine, sp = 0u;
    for (;;) {
        sum = 0u; cnt = 0u; mine = 0u;
#pragma unroll
        for (unsigned j = 0; j < 16; ++j) { const unsigned c = xb_ld(&bar[XB_XCNT(j)]); sum += c; cnt += (c > 0u) ? 1u : 0u; mine = (j == x) ? c : mine; }
        if (sum == G) break;
        __builtin_amdgcn_s_sleep(1);
        if ((++sp & 255u) == 0u) { if (xb_ld(&bar[XB_TMO])) break; if (sp > XB_SPIN_CAP) { atomicAdd(&bar[XB_TMO], 1u); break; } }
    }
    nloc = mine > 0u ? mine : 1u; nx = cnt > 0u ? cnt : 1u;
}

__device__ __forceinline__ void xcd_barrier(const XcdBarrier& b) {
    asm volatile("s_waitcnt vmcnt(0)" ::: "memory");
    __syncthreads();
    if (threadIdx.x == 0) {
        unsigned* bar = b.bar;
        __builtin_amdgcn_s_waitcnt(0);
        unsigned nloc = b.st[0], nx = b.st[1];
        if (nloc == 0u) { xcd_barrier_complete(bar, b.x, nloc, nx); b.st[0] = nloc; b.st[1] = nx; }
        const unsigned old = xb_add(&bar[XB_XSUB(b.x)], 1u);
        const unsigned gen = old / nloc;
        if (old + 1u == (gen + 1u) * nloc) {
            __builtin_amdgcn_fence(__ATOMIC_RELEASE, "agent");
            asm volatile("s_waitcnt vmcnt(0)" ::: "memory");
            const unsigned og = xb_add(&bar[XB_TOP], 1u);
            const unsigned tg = og / nx;
            if (og + 1u == (tg + 1u) * nx) xb_add(&bar[XB_TOPGEN], 1u);
            else XB_SPIN(xb_ld(&bar[XB_TOPGEN]) == tg, bar);
            __builtin_amdgcn_fence(__ATOMIC_ACQUIRE, "agent");
            xb_add(&bar[XB_XGEN(b.x)], 1u);
            asm volatile("s_waitcnt vmcnt(0)" ::: "memory");
        } else {
            XB_SPIN(xb_ld(&bar[XB_XGEN(b.x)]) == gen, bar);
            __builtin_amdgcn_fence(__ATOMIC_ACQUIRE, "agent");
            asm volatile("s_waitcnt vmcnt(0)" ::: "memory");
        }
    }
    __syncthreads();
}

typedef short s4v __attribute__((ext_vector_type(4)));
__device__ __forceinline__ bf16x8 ldg8(const bf16* p) { return *(const bf16x8*)p; }
__device__ __forceinline__ f32x4 mfma16(bf16x8 a, bf16x8 b, f32x4 c) { return __builtin_amdgcn_mfma_f32_16x16x32_bf16(a, b, c, 0, 0, 0); }
__device__ __forceinline__ bf16x8 ldA(const LAS unsigned char* base, int pitch, int row0, int k0, int li, int g) { return *(const LAS bf16x8*)(base + ((row0 + li) * pitch + k0 + 8 * g) * 2); }
__device__ __forceinline__ bf16x8 ldT(const LAS unsigned char* base, int pitch, int k0, int n0, int li, int g) {
    const LAS unsigned char* p = base + ((k0 + 8 * g + (li >> 2)) * pitch + n0 + 4 * (li & 3)) * 2;
    const s4v a = __builtin_amdgcn_ds_read_tr16_b64_v4i16((LAS s4v*)p), b = __builtin_amdgcn_ds_read_tr16_b64_v4i16((LAS s4v*)(p + 8 * pitch));
    return (bf16x8){a[0], a[1], a[2], a[3], b[0], b[1], b[2], b[3]};
}
__device__ __forceinline__ bf16x8 ldAperm(const LAS unsigned char* base, int pitch, int row0, int ks, int li, int g) {
    const LAS unsigned char* p = base + ((row0 + li) * pitch + 32 * ks + 4 * g) * 2;
    const s4v a = *(const LAS s4v*)p, b = *(const LAS s4v*)(p + 32);
    return (bf16x8){a[0], a[1], a[2], a[3], b[0], b[1], b[2], b[3]};
}
__device__ __forceinline__ void stT(LAS unsigned char* base, int pitch, int n, int m0, const f32x4 v) {
    u32x2 w; w.x = pk2(v[0], v[1]); w.y = pk2(v[2], v[3]); *(LAS u32x2*)(base + (n * pitch + m0) * 2) = w;
}
__device__ __forceinline__ f32x4 ld4bf(const LAS unsigned char* p) { const u32x2 w = *(const LAS u32x2*)p; return (f32x4){bflo(w.x), bfhi(w.x), bflo(w.y), bfhi(w.y)}; }

struct Args {
    const float* in[31];
    float* out; unsigned char* ws;
    int ph_lo, ph_hi, use_bar, pad;
};
enum InIdx { I_X = 0, I_C, I_CTX, I_CCTX, I_ADAW, I_ADAB, I_N1G, I_N2G, I_WIN, I_WOUT, I_ASINK, I_BMIX, I_CREL, I_DCONV, I_DW0, I_DW2, I_DA0, I_DA2, I_DG2, I_DKK, I_DKA, I_DRK, I_DLNW, I_DLNB,
             I_RW, I_RB, I_WGU, I_BGU, I_WDN, I_BDN, I_FNG };
constexpr int NPL = 11;
constexpr int PH_TOTAL = 1 + DEPTH * NPL + 1;

struct DevIn {
    const LAS unsigned* tab;
    __device__ __forceinline__ const float* operator[](int i) const {
        const unsigned lo = __builtin_amdgcn_readfirstlane(((const volatile LAS unsigned*)tab)[2 * i]), hi = __builtin_amdgcn_readfirstlane(((const volatile LAS unsigned*)tab)[2 * i + 1]);
        return (const float*)(((unsigned long long)hi << 32) | lo);
    }
};
struct DArgs { DevIn in; float* out; };
struct Ctx {
    LAS unsigned char* lds;
    int tid, lane, wave, wg, G, gw, NGW;
    unsigned char* ws;
};

template <int NW>
__device__ __forceinline__ void transpose_item(const float* W, int K, int N, bf16* WT, int item, int lane) {
    constexpr int NQ = NW / 4, NC = 64 / NQ, PASSES = 8 / NC;
    const int nblk = N / NW, kb = item / nblk, nb = item % nblk, k0 = 64 * kb, n0 = NW * nb, nq = lane % NQ, cq = lane / NQ;
    f32x4 v[PASSES][8];
#pragma unroll
    for (int ps = 0; ps < PASSES; ++ps)
#pragma unroll
        for (int i = 0; i < 8; ++i) v[ps][i] = *(const f32x4*)(W + (size_t)(k0 + 8 * (cq + NC * ps) + i) * N + n0 + 4 * nq);
#pragma unroll
    for (int ps = 0; ps < PASSES; ++ps)
#pragma unroll
        for (int j = 0; j < 4; ++j) { u32x4 o; o.x = pk2(v[ps][0][j], v[ps][1][j]); o.y = pk2(v[ps][2][j], v[ps][3][j]); o.z = pk2(v[ps][4][j], v[ps][5][j]); o.w = pk2(v[ps][6][j], v[ps][7][j]);
            *(u32x4*)(WT + (size_t)(n0 + 4 * nq + j) * K + k0 + 8 * (cq + NC * ps)) = o; }
}
template <int NW>
__device__ __forceinline__ void transpose_item8(const float* W, int K, int N, unsigned char* WT, int item, int lane) {
    constexpr int NQ = NW / 4, NC = 64 / NQ, PASSES = 8 / NC;
    const int nblk = N / NW, kb = item / nblk, nb = item % nblk, k0 = 64 * kb, n0 = NW * nb, nq = lane % NQ, cq = lane / NQ;
    f32x4 v[PASSES][8];
#pragma unroll
    for (int ps = 0; ps < PASSES; ++ps)
#pragma unroll
        for (int i = 0; i < 8; ++i) v[ps][i] = *(const f32x4*)(W + (size_t)(k0 + 8 * (cq + NC * ps) + i) * N + n0 + 4 * nq) * pg8::W8_S;
#pragma unroll
    for (int ps = 0; ps < PASSES; ++ps)
#pragma unroll
        for (int j = 0; j < 4; ++j) { unsigned w0 = 0, w1 = 0;
            w0 = __builtin_amdgcn_cvt_pk_fp8_f32(v[ps][0][j], v[ps][1][j], w0, false); w0 = __builtin_amdgcn_cvt_pk_fp8_f32(v[ps][2][j], v[ps][3][j], w0, true);
            w1 = __builtin_amdgcn_cvt_pk_fp8_f32(v[ps][4][j], v[ps][5][j], w1, false); w1 = __builtin_amdgcn_cvt_pk_fp8_f32(v[ps][6][j], v[ps][7][j], w1, true);
            *(u32x2*)(WT + (size_t)(n0 + 4 * nq + j) * K + k0 + 8 * (cq + NC * ps)) = (u32x2){w0, w1}; }
}
__device__ __forceinline__ void phase_prologue(const Ctx& C, const DArgs& a) {
    constexpr int IT_IN = 16 * (INW / 32), IT_OUT = 16 * 16, IT_GU = 16 * 32, IT_DN = 16 * 16;
    constexpr long N_IN = 4L * IT_IN, N_OUT = 4L * IT_OUT, N_GU = 128L * IT_GU, N_DN = 128L * IT_DN, N_ALL = N_IN + N_OUT + N_GU + N_DN;
    const float* pwin = a.in[I_WIN]; const float* pwout = a.in[I_WOUT]; const float* pwgu = a.in[I_WGU]; const float* pwdn = a.in[I_WDN];
    for (long it = C.gw; it < N_ALL; it += C.NGW) {
        long r = it;
        if (r < N_IN) { const int l = (int)(r / IT_IN); transpose_item<32>(pwin + (size_t)l * DM * INW, DM, INW, (bf16*)(C.ws + WS_WIN) + (size_t)l * INWP * DM, (int)(r % IT_IN), C.lane); continue; } r -= N_IN;
        if (r < N_OUT) { const int l = (int)(r / IT_OUT); transpose_item<64>(pwout + (size_t)l * DM * DM, DM, DM, (bf16*)(C.ws + WS_WOUT) + (size_t)l * DM * DM, (int)(r % IT_OUT), C.lane); continue; } r -= N_OUT;
        if (r < N_GU) { const int le = (int)(r / IT_GU); transpose_item8<64>(pwgu + (size_t)le * DM * 2048, DM, 2048, C.ws + WS_WGU + (size_t)le * 2048 * DM, (int)(r % IT_GU), C.lane); continue; } r -= N_GU;
        { const int le = (int)(r / IT_DN); transpose_item8<64>(pwdn + (size_t)le * DM * DM, DM, DM, C.ws + WS_WDN + (size_t)le * DM * DM, (int)(r % IT_DN), C.lane); }
    }
    { const int gt = C.wg * NTHR + C.tid; constexpr int PADN = (INWP - INW) * DM / 8;
      for (int i = gt; i < 4 * PADN; i += C.G * NTHR) { const int l = i / PADN, r = i % PADN; *((u32x4*)((bf16*)(C.ws + WS_WIN) + ((size_t)l * INWP + INW) * DM) + r) = (u32x4){0u, 0u, 0u, 0u}; } }
    { float* tw = (float*)(C.ws + WS_TW); const int gt = C.wg * NTHR + C.tid;
      for (int i = gt; i < 16384; i += C.G * NTHR) { const float x = (float)i * (1.0f / 8192.0f); tw[i] = cospif(x); tw[16384 + i] = sinpif(x); } }
    { float* mt = (float*)(C.ws + WS_MTAB); const int gt = C.wg * NTHR + C.tid; const float* pbmix = a.in[I_BMIX];
      for (int i = gt; i < 4 * 4 * 64 * 64; i += C.G * NTHR) { const int e = i & 63, c = (i >> 6) & 63, g = (i >> 12) & 3, l = i >> 14;
          const float* w = pbmix + ((size_t)(l * 4 + g) * 64) * 64 + e; float sc = 0.f, ss = 0.f;
          for (int cp = 0; cp < 64; ++cp) { const float x = (float)((c * cp) & 63) * (1.0f / 32.0f); const float wv = w[cp * 64]; sc += cospif(x) * wv; ss += sinpif(x) * wv; }
          mt[((size_t)(l * 2 + 0) * 4 + g) * 4096 + c * 64 + e] = sc; mt[((size_t)(l * 2 + 1) * 4 + g) * 4096 + c * 64 + e] = ss; } }
    { bf16* ft = (bf16*)(C.ws + WS_FTAB); const int gt = C.wg * NTHR + C.tid; const float* pbmix = a.in[I_BMIX];
      for (int i = gt; i < 128 * 128; i += C.G * NTHR) { const int k = i >> 7, t = i & 127; const float x = (float)((k * t) & 127) * (1.0f / 64.0f); ft[i] = (bf16)f2bf(cospif(x)); ft[16384 + i] = (bf16)f2bf(sinpif(x)); }
      bf16* mf = ft + 32768;
      for (int i = gt; i < 4 * 4 * 16 * 64 * 8; i += C.G * NTHR) { const int j8 = i & 7, ln = (i >> 3) & 63, fr = (i >> 9) & 15, gq = (i >> 13) & 3, l = i >> 15;
          const int ei = fr >> 2, ks2 = fr & 3, e = 16 * ei + (ln & 15), g = ln >> 4, c = 32 * (ks2 & 1) + 16 * (j8 >> 2) + 4 * g + (j8 & 3), part = ks2 >> 1;
          const float* w = pbmix + ((size_t)(l * 4 + gq) * 64) * 64 + e; float s = 0.f;
          for (int cp = 0; cp < 64; ++cp) { const float x = (float)((c * cp) & 63) * (1.0f / 32.0f); s += (part ? sinpif(x) : cospif(x)) * w[cp * 64]; }
          mf[i] = (bf16)f2bf(s * (1.0f / 1024.0f)); } }
    { const int gt = C.wg * NTHR + C.tid; const float* pg2 = a.in[I_DG2]; const float* prw = a.in[I_RW]; bf16* g2t = (bf16*)(C.ws + WS_G2T); bf16* rwt = (bf16*)(C.ws + WS_RWT);
      for (int i = gt; i < 4 * 256 * 160; i += C.G * NTHR) { const int ii = i % 160, c = (i / 160) & 255, l = i / (160 * 256); g2t[i] = (bf16)f2bf(pg2[((size_t)l * 160 + ii) * 256 + c]); }
      for (int i = gt; i < 4 * 32 * 1024; i += C.G * NTHR) { const int k = i & 1023, e = (i >> 10) & 31, l = i >> 15; rwt[i] = (bf16)f2bf(prw[((size_t)l * 1024 + k) * 32 + e]); } }
    { const int gt = C.wg * NTHR + C.tid; const float* pw2 = a.in[I_DW2]; const float* pa2 = a.in[I_DA2]; bf16* lt = (bf16*)(C.ws + WS_LORAT);
      for (int i = gt; i < 4 * 4 * 256 * 64; i += C.G * NTHR) { const int ii = i & 63, c = (i >> 6) & 255, q = (i >> 14) & 3, l = i >> 16;
          const float* src = (q < 2) ? pw2 : pa2; lt[i] = (bf16)f2bf(src[(((size_t)l * 2 + (q & 1)) * 64 + ii) * 256 + c]); } }
    { bf16* f2 = (bf16*)(C.ws + WS_F256); const int gt = C.wg * NTHR + C.tid;
      for (int i = gt; i < 256 * 256; i += C.G * NTHR) { const int k = i >> 8, t = i & 255; const float x = (float)((k * t) & 255) * (1.0f / 128.0f); f2[i] = (bf16)f2bf(cospif(x)); f2[65536 + i] = (bf16)f2bf(sinpif(x)); } }
    { LAS float* red = (LAS float*)(C.lds);
      __syncthreads();
      float* mod = (float*)(C.ws + WS_MOD);
      const float* pc = a.in[I_C]; const float* pcc = a.in[I_CCTX]; const float* padaw = a.in[I_ADAW]; const float* padab = a.in[I_ADAB];
      for (int u = C.wg; u < 4 * 24; u += C.G) { const int l = u / 24, jb = u % 24, j0 = jb * 256 + 4 * C.lane;
          f32x4 s0 = {0.f, 0.f, 0.f, 0.f}, s1 = {0.f, 0.f, 0.f, 0.f};
          const float* w = padaw + (size_t)l * DM * 6144 + j0;
          for (int k = C.wave * 128; k < C.wave * 128 + 128; ++k) { const float c0 = pc[k], c1 = pcc[k]; const float a0 = c0 * sigmoidf_(c0), a1 = c1 * sigmoidf_(c1);
              const f32x4 wv = *(const f32x4*)(w + (size_t)k * 6144); s0 += wv * a0; s1 += wv * a1; }
          *(LAS f32x4*)(red + ((C.wave * 2 + 0) * 64 + C.lane) * 4) = s0; *(LAS f32x4*)(red + ((C.wave * 2 + 1) * 64 + C.lane) * 4) = s1;
          __syncthreads();
          if (C.tid < 512) { const int v = C.tid >> 8, j = C.tid & 255; float s = 0.f;
#pragma unroll
              for (int wv = 0; wv < 8; ++wv) s += red[(wv * 2 + v) * 256 + j];
              mod[(size_t)(l * 2 + v) * 6144 + jb * 256 + j] = s + padab[(size_t)l * 6144 + jb * 256 + j]; }
          __syncthreads(); } }
}

__device__ __forceinline__ void load_row(const float* p, int lane, f32x4 (&v)[4]) {
#pragma unroll
    for (int j = 0; j < 4; ++j) v[j] = *((const f32x4*)p + lane + 64 * j);
}
__device__ __forceinline__ void moe_combine_row(const Ctx& C, int row, f32x4 (&v)[4], const float* gt2) {
    const int* dest = (const int*)(C.ws + WS_ROUTE) + (size_t)3 * ROWS * 4; const float* gate = (const float*)(C.ws + WS_ROUTE) + (size_t)1 * ROWS * 4;
    const bf16* YB = (const bf16*)(C.ws + WS_XG);
    f32x4 s[4];
#pragma unroll
    for (int j = 0; j < 4; ++j) s[j] = (f32x4){0.f, 0.f, 0.f, 0.f};
#pragma unroll
    for (int k = 0; k < 4; ++k) { const int d = dest[row * 4 + k]; const float g = gate[row * 4 + k]; const u32x2* yp = (const u32x2*)(YB + (size_t)d * DM) + C.lane;
#pragma unroll
        for (int j = 0; j < 4; ++j) { const u32x2 w = yp[64 * j]; s[j] += (f32x4){bflo(w.x), bfhi(w.x), bflo(w.y), bfhi(w.y)} * g; } }
#pragma unroll
    for (int j = 0; j < 4; ++j) v[j] += *((const f32x4*)gt2 + C.lane + 64 * j) * s[j];
}
__device__ __forceinline__ float row_rstd(const f32x4 (&v)[4], int lane) {
    float s = 0.f;
#pragma unroll
    for (int j = 0; j < 4; ++j) s += (v[j].x * v[j].x + v[j].y * v[j].y) + (v[j].z * v[j].z + v[j].w * v[j].w);
    return rsqrtf(wave_sum(s, lane) * (1.f / DM) + 1e-6f);
}
__device__ __forceinline__ void phase_norm1(const Ctx& C, const DArgs& a, int l) {
    float* XS = (float*)(C.ws + WS_XS); bf16* H = (bf16*)(C.ws + WS_H); const float* mod = (const float*)(C.ws + WS_MOD);
    const float* g1 = a.in[I_N1G] + (size_t)l * DM;
    const float* pctx = a.in[I_CTX]; const float* px = a.in[I_X];
    for (int row = C.gw; row < ROWS; row += C.NGW) {
        const bool isctx = row < NCTX; f32x4 v[4];
        if (l == 0) { load_row(isctx ? pctx + (size_t)row * DM : px + (size_t)(row - NCTX) * DM, C.lane, v); }
        else { load_row(XS + (size_t)row * DM, C.lane, v);
               if (!(l == DEPTH && isctx)) moe_combine_row(C, row, v, mod + (size_t)((l - 1) * 2 + (isctx ? 1 : 0)) * 6144 + 5 * DM); }
        if (l == 0 || true) {
#pragma unroll
            for (int j = 0; j < 4; ++j) *((f32x4*)(XS + (size_t)row * DM) + C.lane + 64 * j) = v[j]; }
        const float rstd = row_rstd(v, C.lane);
        const float* md = mod + (size_t)(l * 2 + (isctx ? 1 : 0)) * 6144;
        u32x2* o = (u32x2*)(H + (size_t)row * DM) + C.lane;
#pragma unroll
        for (int j = 0; j < 4; ++j) { const f32x4 g = *((const f32x4*)g1 + C.lane + 64 * j), sh = *((const f32x4*)md + C.lane + 64 * j), sc = *((const f32x4*)(md + DM) + C.lane + 64 * j);
            const f32x4 y = v[j] * rstd * g * (sc + 1.0f) + sh; u32x2 w; w.x = pk2(y.x, y.y); w.y = pk2(y.z, y.w); o[64 * j] = w; }
    }
}
__device__ __forceinline__ void phase_final(const Ctx& C, const DArgs& a) {
    const float* XS = (const float*)(C.ws + WS_XS); const float* mod = (const float*)(C.ws + WS_MOD); const float* g = a.in[I_FNG];
    for (int row = NCTX + C.gw; row < ROWS; row += C.NGW) {
        f32x4 v[4]; load_row(XS + (size_t)row * DM, C.lane, v);
        moe_combine_row(C, row, v, mod + (size_t)((DEPTH - 1) * 2 + 0) * 6144 + 5 * DM);
        const float rstd = row_rstd(v, C.lane);
        float* o = a.out + (size_t)(row - NCTX) * DM;
#pragma unroll
        for (int j = 0; j < 4; ++j) *((f32x4*)o + C.lane + 64 * j) = v[j] * rstd * *((const f32x4*)g + C.lane + 64 * j);
    }
}
constexpr int NR2 = 9;
__device__ __forceinline__ void phase_norm2(const Ctx& C, const DArgs& a, int l) {
    const float* XS = (const float*)(C.ws + WS_XS); bf16* H = (bf16*)(C.ws + WS_H); const float* mod = (const float*)(C.ws + WS_MOD);
    const float* g2 = a.in[I_N2G] + (size_t)l * DM; const float* rb = a.in[I_RB] + (size_t)l * NEXP; const bf16* rwt = (const bf16*)(C.ws + WS_RWT) + (size_t)l * NEXP * DM;
    int* tok_e = (int*)(C.ws + WS_ROUTE); float* gate = (float*)(C.ws + WS_ROUTE) + (size_t)1 * ROWS * 4; int* slot = (int*)(C.ws + WS_ROUTE) + (size_t)2 * ROWS * 4;
    LAS float* lg = (LAS float*)(C.lds + C.wave * 4096);
    LAS int* hist = (LAS int*)(C.lds + MISC_OFF + 64);
    const int lane = C.lane, li = lane & 15, g = lane >> 4;
    if (C.tid < NEXP) hist[C.tid] = 0;
    __syncthreads();
    const int row_base = (l == DEPTH - 1) ? NCTX : 0, ntile = (ROWS - row_base + NR2 - 1) / NR2;
    for (int tl = C.gw; tl < ntile; tl += C.NGW) {
        const int trow0 = row_base + NR2 * tl, nrow = (ROWS - trow0 < NR2) ? ROWS - trow0 : NR2;
#pragma unroll 1
        for (int rr = 0; rr < nrow; ++rr) { const int row = trow0 + rr; const bool isctx = row < NCTX; f32x4 v[4]; load_row(XS + (size_t)row * DM, lane, v);
            const float rstd = row_rstd(v, lane);
            const float* md = mod + (size_t)(l * 2 + (isctx ? 1 : 0)) * 6144 + 3 * DM;
            u32x2* o = (u32x2*)(H + (size_t)row * DM) + lane;
#pragma unroll
            for (int j = 0; j < 4; ++j) { const f32x4 gg = *((const f32x4*)g2 + lane + 64 * j), sh = *((const f32x4*)md + lane + 64 * j), sc = *((const f32x4*)(md + DM) + lane + 64 * j);
                const f32x4 y = v[j] * rstd * gg * (sc + 1.0f) + sh; u32x2 w; w.x = pk2(y.x, y.y); w.y = pk2(y.z, y.w); o[64 * j] = w; } }
        asm volatile("s_waitcnt vmcnt(0)" ::: "memory");
        f32x4 acc0 = {0.f, 0.f, 0.f, 0.f}, acc1 = {0.f, 0.f, 0.f, 0.f};
        const int arow = (trow0 + li < ROWS) ? trow0 + li : ROWS - 1;
        const bf16* ap = H + (size_t)arow * DM + 8 * g; const bf16* bp0 = rwt + (size_t)li * DM + 8 * g; const bf16* bp1 = bp0 + 16 * DM;
#pragma unroll 4
        for (int ks = 0; ks < 32; ++ks) { const bf16x8 af = *(const bf16x8*)(ap + 32 * ks); acc0 = mfma16(af, *(const bf16x8*)(bp0 + 32 * ks), acc0); acc1 = mfma16(af, *(const bf16x8*)(bp1 + 32 * ks), acc1); }
#pragma unroll
        for (int r = 0; r < 4; ++r) { lg[(4 * g + r) * 33 + li] = acc0[r]; lg[(4 * g + r) * 33 + 16 + li] = acc1[r]; }
        LDS_WAIT(); asm volatile("" ::: "memory");
        const int e = lane & 31; const float rbe = rb[e];
#pragma unroll 1
        for (int rr = 0; rr < nrow; ++rr) { const int row = trow0 + rr;
            float val = lg[rr * 33 + e] + rbe; int te[4]; float tv[4];
#pragma unroll
            for (int k = 0; k < 4; ++k) { float bv = val; int bi = e;
#pragma unroll
                for (int o2 = 1; o2 < 32; o2 <<= 1) { const float ov = shx(bv, o2, lane); const int oi = shxi(bi, o2, lane); if (ov > bv || (ov == bv && oi < bi)) { bv = ov; bi = oi; } }
                te[k] = bi; tv[k] = bv; if (e == bi) val = -3.0e38f; }
            if (lane == 0) { const float m = tv[0]; float p[4], ps = 0.f;
#pragma unroll
                for (int k = 0; k < 4; ++k) { p[k] = __expf(tv[k] - m); ps += p[k]; }
#pragma unroll
                for (int k = 0; k < 4; ++k) { tok_e[row * 4 + k] = te[k]; gate[row * 4 + k] = p[k] / ps; slot[row * 4 + k] = __hip_atomic_fetch_add(&hist[te[k]], 1, __ATOMIC_RELAXED, __HIP_MEMORY_SCOPE_WORKGROUP); } } }
        asm volatile("" ::: "memory");
    }
    __syncthreads();
    if (C.tid < NEXP) ((int*)(C.ws + WS_CNT))[C.wg * NEXP + C.tid] = hist[C.tid];
}
__device__ __forceinline__ int moe_tables(const Ctx& C) {
    const int* cnt = (const int*)(C.ws + WS_CNT);
    LAS int* part = (LAS int*)(C.lds);
    LAS int* pstart = (LAS int*)(C.lds + MISC_OFF + 256); LAS int* wgbase = pstart + 40; LAS int* tot = wgbase + 32; LAS int* nblk_s = tot + 32;
    LAS unsigned char* blk_e = (LAS unsigned char*)(C.lds + MISC_OFF + 1024);
    __syncthreads();
    { const int e = C.tid & 31, p = C.tid >> 5; int t = 0, pre = 0;
#pragma unroll 1
      for (int w = p * 16; w < p * 16 + 16; ++w) { const int c = cnt[w * NEXP + e]; t += c; if (w < C.wg) pre += c; }
      part[(p * 32 + e) * 2] = t; part[(p * 32 + e) * 2 + 1] = pre; }
    __syncthreads();
    if (C.tid < NEXP) { int t = 0, pre = 0;
#pragma unroll 1
        for (int p = 0; p < 16; ++p) { t += part[(p * 32 + C.tid) * 2]; pre += part[(p * 32 + C.tid) * 2 + 1]; }
        tot[C.tid] = t; wgbase[C.tid] = pre; }
    __syncthreads();
    if (C.tid == 0) { int b = 0;
#pragma unroll 1
        for (int e = 0; e < NEXP; ++e) { pstart[e] = b * 256; b += (tot[e] + 255) >> 8; }
        pstart[NEXP] = b * 256; nblk_s[0] = b; }
    __syncthreads();
    if (C.tid < NEXP) wgbase[C.tid] += pstart[C.tid];
    if (C.tid < MOE_MAXBLK) { int e = 0;
#pragma unroll 1
        for (int k = 1; k < NEXP; ++k) if (pstart[k] <= C.tid * 256) e = k;
        blk_e[C.tid] = (unsigned char)e; }
    __syncthreads();
    return __builtin_amdgcn_readfirstlane(nblk_s[0]);
}
__device__ __forceinline__ void phase_gather(const Ctx& C, const DArgs& a, int l) {
    moe_tables(C);
    const LAS int* wgbase = (const LAS int*)(C.lds + MISC_OFF + 256) + 40;
    const int* tok_e = (const int*)(C.ws + WS_ROUTE); const int* slot = (const int*)(C.ws + WS_ROUTE) + (size_t)2 * ROWS * 4; int* dest = (int*)(C.ws + WS_ROUTE) + (size_t)3 * ROWS * 4;
    const bf16* H = (const bf16*)(C.ws + WS_H); unsigned char* XG = C.ws + WS_XG8;
    const int row_base = (l == DEPTH - 1) ? NCTX : 0, ntile = (ROWS - row_base + NR2 - 1) / NR2;
    for (int tl = C.gw; tl < ntile; tl += C.NGW)
    for (int row = row_base + NR2 * tl; row < row_base + NR2 * tl + NR2 && row < ROWS; ++row) {
        const u32x4* src = (const u32x4*)(H + (size_t)row * DM) + C.lane; const u32x4 v0 = src[0], v1 = src[64];
        u32x2 q0, q1;
        { unsigned w = 0; w = __builtin_amdgcn_cvt_pk_fp8_f32(bflo(v0.x) * pg8::X8_S, bfhi(v0.x) * pg8::X8_S, w, false); w = __builtin_amdgcn_cvt_pk_fp8_f32(bflo(v0.y) * pg8::X8_S, bfhi(v0.y) * pg8::X8_S, w, true); q0.x = w;
          w = 0; w = __builtin_amdgcn_cvt_pk_fp8_f32(bflo(v0.z) * pg8::X8_S, bfhi(v0.z) * pg8::X8_S, w, false); w = __builtin_amdgcn_cvt_pk_fp8_f32(bflo(v0.w) * pg8::X8_S, bfhi(v0.w) * pg8::X8_S, w, true); q0.y = w;
          w = 0; w = __builtin_amdgcn_cvt_pk_fp8_f32(bflo(v1.x) * pg8::X8_S, bfhi(v1.x) * pg8::X8_S, w, false); w = __builtin_amdgcn_cvt_pk_fp8_f32(bflo(v1.y) * pg8::X8_S, bfhi(v1.y) * pg8::X8_S, w, true); q1.x = w;
          w = 0; w = __builtin_amdgcn_cvt_pk_fp8_f32(bflo(v1.z) * pg8::X8_S, bfhi(v1.z) * pg8::X8_S, w, false); w = __builtin_amdgcn_cvt_pk_fp8_f32(bflo(v1.w) * pg8::X8_S, bfhi(v1.w) * pg8::X8_S, w, true); q1.y = w; }
#pragma unroll
        for (int k = 0; k < 4; ++k) { const int d = wgbase[tok_e[row * 4 + k]] + slot[row * 4 + k]; if (C.lane == 0) dest[row * 4 + k] = d;
            u32x2* dp = (u32x2*)(XG + (size_t)d * DM) + C.lane; dp[0] = q0; dp[64] = q1; }
    }
}

__device__ __forceinline__ void mix1_rope(const Ctx& C) {
    bf16* P = (bf16*)(C.ws + WS_P);
    const long total = (long)SEQ * 192;
    for (long i = (long)C.wg * NTHR + C.tid; i < total; i += (long)C.G * NTHR) {
        const int j = (int)(i & 31), hh = (int)((i >> 5) % 6), t = (int)(i / 192);
        const int col = (hh < 4) ? (C_AQ + hh * 64) : (C_AK + (hh - 4) * 64);
        const float pos = (j < 16) ? (float)(t >> 6) : (float)(t & 63);
        const float inv = __powf(10000.0f, -(float)(j & 15) * (1.0f / 16.0f));
        const float ang = pos * inv * 0.31830988618379067f;
        const float cs = cospif(ang), sn = sinpif(ang);
        bf16* p = P + (size_t)(NCTX + t) * INWP + col;
        const float x1 = bf2f(p[j]), x2 = bf2f(p[j + 32]);
        p[j] = (bf16)f2bf(x1 * cs - x2 * sn); p[j + 32] = (bf16)f2bf(x2 * cs + x1 * sn);
    }
}
__device__ __forceinline__ void mix1_vt(const Ctx& C) {
    const bf16* P = (const bf16*)(C.ws + WS_P);
    LAS unsigned short* scr = (LAS unsigned short*)(C.lds + C.wave * 16384);
    for (int u = C.gw; u < (ROWS / 64) * 6; u += C.NGW) {
        const int hd = u % 6, tb = u / 6; const int vcol = (hd < 2) ? (C_AV + hd * 64) : (C_CV + (hd - 2) * 64);
        bf16* VT = ((hd < 2) ? (bf16*)(C.ws + WS_VTA) + (size_t)hd * 64 * VTP : (bf16*)(C.ws + WS_VTC) + (size_t)(hd - 2) * 64 * VTP);
#pragma unroll
        for (int i = 0; i < 8; ++i) { const int tk = (C.lane >> 3) + 8 * i, ch = C.lane & 7; const u32x4 w = *(const u32x4*)(P + (size_t)(tb * 64 + tk) * INWP + vcol + 8 * ch);
            LAS unsigned* d = (LAS unsigned*)(scr + tk * 66 + 8 * ch); d[0] = w.x; d[1] = w.y; d[2] = w.z; d[3] = w.w; }
        LDS_WAIT(); asm volatile("" ::: "memory");
#pragma unroll
        for (int k8 = 0; k8 < 8; ++k8) { unsigned w[4];
#pragma unroll
            for (int e2 = 0; e2 < 4; ++e2) { const unsigned lo = scr[(8 * k8 + 2 * e2) * 66 + C.lane], hi = scr[(8 * k8 + 2 * e2 + 1) * 66 + C.lane]; w[e2] = lo | (hi << 16); }
            *(u32x4*)(VT + (size_t)C.lane * VTP + tb * 64 + 8 * k8) = (u32x4){w[0], w[1], w[2], w[3]}; }
        LDS_WAIT(); asm volatile("" ::: "memory");
    }
    for (int i = C.wg * NTHR + C.tid; i < 6 * 64 * 32; i += C.G * NTHR) { const int rowi = i >> 5, pc = i & 31; const int hd = rowi >> 6, d = rowi & 63;
        bf16* VT = ((hd < 2) ? (bf16*)(C.ws + WS_VTA) + (size_t)hd * 64 * VTP : (bf16*)(C.ws + WS_VTC) + (size_t)(hd - 2) * 64 * VTP);
        *(u32x4*)(VT + (size_t)d * VTP + ROWS + 8 * pc) = (u32x4){0u, 0u, 0u, 0u}; }
}
__device__ __forceinline__ float conv3(const bf16* P, int row, int col, const float* cw, int cc) {
    const bool first = (row == 0) || (row == NCTX), last = (row == NCTX - 1) || (row == ROWS - 1);
    float s = cw[768 + cc] * bf2f(P[(size_t)row * INWP + col]);
    if (!first) s += cw[cc] * bf2f(P[(size_t)(row - 1) * INWP + col]);
    if (!last) s += cw[2 * 768 + cc] * bf2f(P[(size_t)(row + 1) * INWP + col]);
    return s;
}
__device__ __forceinline__ void mix1_rwkv_prep(const Ctx& C, const DArgs& a, int l) {
    const bf16* P = (const bf16*)(C.ws + WS_P); float* SC = (float*)(C.ws + WS_SC);
    constexpr int LBP = 264;
    LAS unsigned char* lob = C.lds;
    LAS float* pre = (LAS float*)(C.lds + 16384);
    const bf16* lorat = (const bf16*)(C.ws + WS_LORAT) + (size_t)l * 4 * 256 * 64;
    const float* cw = a.in[I_DCONV] + (size_t)l * 3 * 768;
    const float* w0 = a.in[I_DW0] + (size_t)l * 512; const float* a0 = a.in[I_DA0] + (size_t)l * 512;
    const float* kkw = a.in[I_DKK] + (size_t)l * 256; const float* kaw = a.in[I_DKA] + (size_t)l * 256;
    const int half = C.tid >> 8, c = C.tid & 255, lane = C.lane, li = lane & 15, g = lane >> 4;
    const float kkc = kkw[c], kac = kaw[c];
    for (int grp = C.wg; grp < ROWS / 13; grp += C.G) {
        const int row0 = 13 * grp + 7 * half, nj = 7 - half;
        __syncthreads();
#pragma unroll
        for (int j = 0; j < 7; ++j) if (j < nj) { const float x = bf2f(P[(size_t)(row0 + j) * INWP + C_WL + c]); *(LAS bf16*)(lob + ((7 * half + j) * LBP + c) * 2) = (bf16)f2bf((c < 128) ? tanhf(x) : x); }
        __syncthreads();
#pragma unroll
        for (int q = 0; q < 4; ++q) { const bf16x8 a0f = ldA(lob, LBP, 0, 64 * q, li, g), a1f = ldA(lob, LBP, 0, 64 * q + 32, li, g);
#pragma unroll
            for (int c2 = 0; c2 < 2; ++c2) { const int ci = 2 * C.wave + c2; const bf16* bp = lorat + ((size_t)q * 256 + 16 * ci + li) * 64 + 8 * g;
                f32x4 acc = {0.f, 0.f, 0.f, 0.f}; acc = mfma16(a0f, ldg8(bp), acc); acc = mfma16(a1f, ldg8(bp + 32), acc);
#pragma unroll
                for (int r = 0; r < 4; ++r) pre[(q * 16 + 4 * g + r) * 256 + 16 * ci + li] = acc[r]; } }
        __syncthreads();
#pragma unroll 1
        for (int j = 0; j < nj; ++j) { const int row = row0 + j, rl = 7 * half + j; const float r = conv3(P, row, C_DR + c, cw, c), k = conv3(P, row, C_DK + c, cw, 256 + c), v = conv3(P, row, C_DV + c, cw, 512 + c);
            float kk = k * kkc; const float n2 = wave_sum(kk * kk, lane); kk *= rsqrtf(fmaxf(n2, 1e-24f));
            float* sc = SC + (size_t)row * 9 * 256; sc[c] = r; sc[256 + c] = v; sc[512 + c] = -kk;
#pragma unroll
            for (int d = 0; d < 2; ++d) { const float wp = w0[d * 256 + c] + pre[(d * 16 + rl) * 256 + c], ap = a0[d * 256 + c] + pre[((2 + d) * 16 + rl) * 256 + c];
                const float nw = -wp, sp = fmaxf(nw, 0.f) + log1pf(__expf(-fabsf(nw)));
                const float lw = -__expf(-sp - 0.5f);
                const float as = sigmoidf_(ap);
                sc[(3 + 3 * d) * 256 + c] = lw; sc[(4 + 3 * d) * 256 + c] = k * (1.0f + (as - 1.0f) * kac); sc[(5 + 3 * d) * 256 + c] = kk * as; } }
    }
    __syncthreads();
}
constexpr int FP = 136;
constexpr int F_TABC = 0, F_TABS = 128 * FP * 2, F_TILE = 2 * 128 * FP * 2;
__device__ __forceinline__ void fourier_load_tables(const Ctx& C) {
    const bf16* ft = (const bf16*)(C.ws + WS_FTAB);
    for (int i = C.tid; i < 2 * 128 * 16; i += NTHR) { const int tb = i >> 11, r = (i >> 4) & 127, c8 = i & 15;
        *(LAS u32x4*)(C.lds + tb * F_TABS + (r * FP + 8 * c8) * 2) = *(const u32x4*)(ft + tb * 16384 + r * 128 + 8 * c8); }
}
__device__ __forceinline__ void mix1_fourier1(const Ctx& C) {
    const bf16* P = (const bf16*)(C.ws + WS_P); const float* tw = (const float*)(C.ws + WS_TW);
    bf16* FYR = (bf16*)(C.ws + WS_FYR); bf16* FYI = (bf16*)(C.ws + WS_FYI);
    const int lane = C.lane, li = lane & 15, g = lane >> 4, w = C.wave;
    __syncthreads();
    fourier_load_tables(C);
    for (int u = C.wg; u < 256; u += C.G) {
        const int t2 = u >> 1, ch0 = (u & 1) * 128;
        __syncthreads();
        for (int i = C.tid; i < 128 * 16; i += NTHR) { const int t1 = i >> 4, c8 = i & 15;
            *(LAS u32x4*)(C.lds + F_TILE + (t1 * FP + 8 * c8) * 2) = *(const u32x4*)(P + (size_t)(NCTX + 128 * t1 + t2) * INWP + C_BU + ch0 + 8 * c8); }
        __syncthreads();
        bf16x8 af[4];
#pragma unroll
        for (int ks = 0; ks < 4; ++ks) af[ks] = ldT(C.lds + F_TILE, FP, 32 * ks, 16 * w, li, g);
#pragma unroll 1
        for (int ni = 0; ni < 8; ++ni) { f32x4 dc = {0.f, 0.f, 0.f, 0.f}, ds = {0.f, 0.f, 0.f, 0.f};
#pragma unroll
            for (int ks = 0; ks < 4; ++ks) { dc = mfma16(af[ks], ldA(C.lds + F_TABC, FP, 16 * ni, 32 * ks, li, g), dc); ds = mfma16(af[ks], ldA(C.lds + F_TABS, FP, 16 * ni, 32 * ks, li, g), ds); }
            const int k1 = 16 * ni + li; const float cp = tw[t2 * k1], sp = tw[16384 + t2 * k1];
            const f32x4 yr = dc * cp - ds * sp, yi = -(ds * cp) - dc * sp;
            const size_t o = ((size_t)k1 * 128 + t2) * 256 + ch0 + 16 * w + 4 * g;
            u32x2 wr; wr.x = pk2(yr[0], yr[1]); wr.y = pk2(yr[2], yr[3]); *(u32x2*)(FYR + o) = wr;
            u32x2 wi; wi.x = pk2(yi[0], yi[1]); wi.y = pk2(yi[2], yi[3]); *(u32x2*)(FYI + o) = wi; }
    }
    __syncthreads();
}
__device__ __forceinline__ void fourier2_mfma(const Ctx& C, int l, int wg0) {
    const bf16* FYR = (const bf16*)(C.ws + WS_FYR); const bf16* FYI = (const bf16*)(C.ws + WS_FYI); bf16* MIX = (bf16*)(C.ws + WS_MIX);
    const int lane = C.lane, li = lane & 15, g = lane >> 4, w = C.wave;
    constexpr int YP = 72, F_YR = F_TILE, F_YI = F_TILE + 128 * YP * 2;
    __syncthreads();
    fourier_load_tables(C);
    for (int u = C.wg - wg0; u < 512; u += C.G - wg0) {
        const int k1 = u >> 2, gq = u & 3;
        __syncthreads();
        for (int i = C.tid; i < 2 * 128 * 8; i += NTHR) { const int im = i >> 10, t2 = (i >> 3) & 127, c8 = i & 7;
            *(LAS u32x4*)(C.lds + (im ? F_YI : F_YR) + (t2 * YP + 8 * c8) * 2) = *(const u32x4*)((im ? FYI : FYR) + ((size_t)k1 * 128 + t2) * 256 + gq * 64 + 8 * c8); }
        __syncthreads();
        bf16x8 bc[4], bs[4];
#pragma unroll
        for (int ks = 0; ks < 4; ++ks) { bc[ks] = ldA(C.lds + F_TABC, FP, 16 * w, 32 * ks, li, g); bs[ks] = ldA(C.lds + F_TABS, FP, 16 * w, 32 * ks, li, g); }
        f32x4 xr[4], xi[4];
#pragma unroll
        for (int ci = 0; ci < 4; ++ci) { xr[ci] = (f32x4){0.f, 0.f, 0.f, 0.f}; f32x4 xs = {0.f, 0.f, 0.f, 0.f}; xi[ci] = xs;
#pragma unroll
            for (int ks = 0; ks < 4; ++ks) { const bf16x8 ar = ldT(C.lds + F_YR, YP, 32 * ks, 16 * ci, li, g), ai = ldT(C.lds + F_YI, YP, 32 * ks, 16 * ci, li, g);
                xr[ci] = mfma16(ar, bc[ks], xr[ci]); xr[ci] = mfma16(ai, bs[ks], xr[ci]);
                xi[ci] = mfma16(ai, bc[ks], xi[ci]); xs = mfma16(ar, bs[ks], xs); }
            xi[ci] = xi[ci] - xs; }
        union { bf16x8 v; unsigned q[4]; } xb[4];
#pragma unroll
        for (int q2 = 0; q2 < 2; ++q2) { xb[q2].q[0] = pk2(xr[2 * q2][0], xr[2 * q2][1]); xb[q2].q[1] = pk2(xr[2 * q2][2], xr[2 * q2][3]); xb[q2].q[2] = pk2(xr[2 * q2 + 1][0], xr[2 * q2 + 1][1]); xb[q2].q[3] = pk2(xr[2 * q2 + 1][2], xr[2 * q2 + 1][3]);
            xb[2 + q2].q[0] = pk2(xi[2 * q2][0], xi[2 * q2][1]); xb[2 + q2].q[1] = pk2(xi[2 * q2][2], xi[2 * q2][3]); xb[2 + q2].q[2] = pk2(xi[2 * q2 + 1][0], xi[2 * q2 + 1][1]); xb[2 + q2].q[3] = pk2(xi[2 * q2 + 1][2], xi[2 * q2 + 1][3]); }
        const bf16x8* mf = (const bf16x8*)((const bf16*)(C.ws + WS_FTAB) + 32768) + (size_t)(l * 4 + gq) * 16 * 64;
#pragma unroll
        for (int ei = 0; ei < 4; ++ei) { f32x4 o = {0.f, 0.f, 0.f, 0.f};
#pragma unroll
            for (int ks2 = 0; ks2 < 4; ++ks2) o = mfma16(mf[(ei * 4 + ks2) * 64 + lane], xb[ks2].v, o);
            const int tp = k1 + 128 * (16 * w + li);
            u32x2 wo; wo.x = pk2(o[0], o[1]); wo.y = pk2(o[2], o[3]); *(u32x2*)(MIX + (size_t)(NCTX + tp) * DM + 256 + gq * 64 + 16 * ei + 4 * g) = wo; }
    }
    __syncthreads();
}

constexpr float LOG2E = 1.4426950408889634f;
typedef short bf16x4 __attribute__((ext_vector_type(4)));
__device__ __forceinline__ void attn_load(const bf16* P, const bf16* VT, int krow, int kcol, int li, int g, bf16x8 (&kf)[2][2], bf16x8 (&vf)[4]) {
#pragma unroll
    for (int t = 0; t < 2; ++t)
#pragma unroll
        for (int ks = 0; ks < 2; ++ks) kf[t][ks] = ldg8(P + (size_t)(krow + 16 * t + li) * INWP + kcol + 32 * ks + 8 * g);
#pragma unroll
    for (int dt = 0; dt < 4; ++dt) { const bf16* vp = VT + (size_t)(dt * 16 + li) * VTP + krow + 4 * g;
        const bf16x4 a = *(const bf16x4*)vp, b = *(const bf16x4*)(vp + 16); vf[dt] = (bf16x8){a[0], a[1], a[2], a[3], b[0], b[1], b[2], b[3]}; }
}
template <int NH>
__device__ __forceinline__ void attn_compute(const bf16x8 (&kf)[2][2], const bf16x8 (&vf)[4], const bf16x8 (&qf)[NH][2], f32x4 (&o)[NH][4], float (&m)[NH], float (&ls)[NH],
                                             const float (&add)[2][4], int li, int g) {
#pragma unroll
    for (int hh = 0; hh < NH; ++hh) {
        f32x4 st[2];
#pragma unroll
        for (int t = 0; t < 2; ++t) { st[t] = (f32x4){0.f, 0.f, 0.f, 0.f};
#pragma unroll
            for (int ks = 0; ks < 2; ++ks) st[t] = __builtin_amdgcn_mfma_f32_16x16x32_bf16(kf[t][ks], qf[hh][ks], st[t], 0, 0, 0); }
        float s[8]; float bm = -INFINITY;
#pragma unroll
        for (int t = 0; t < 2; ++t)
#pragma unroll
            for (int r = 0; r < 4; ++r) { s[4 * t + r] = (add[t][r] == -INFINITY) ? -INFINITY : st[t][r] * (0.125f * LOG2E) + add[t][r]; bm = fmaxf(bm, s[4 * t + r]); }
        bm = fmaxf(bm, shx(bm, 16, 16 * g + li)); bm = fmaxf(bm, shx(bm, 32, 16 * g + li));
        const float mn = fmaxf(m[hh], bm), corr = __builtin_amdgcn_exp2f(m[hh] - mn); m[hh] = mn;
        float ps = 0.f; float pe[8];
#pragma unroll
        for (int e = 0; e < 8; ++e) { pe[e] = __builtin_amdgcn_exp2f(s[e] - mn); ps += pe[e]; }
        ls[hh] = ls[hh] * corr + ps;
        union { bf16x8 v; unsigned u[4]; } pf;
#pragma unroll
        for (int e2 = 0; e2 < 4; ++e2) pf.u[e2] = pk2(pe[2 * e2], pe[2 * e2 + 1]);
#pragma unroll
        for (int dt = 0; dt < 4; ++dt) { o[hh][dt] = o[hh][dt] * corr; o[hh][dt] = __builtin_amdgcn_mfma_f32_16x16x32_bf16(vf[dt], pf.v, o[hh][dt], 0, 0, 0); }
    }
}
template <int NH>
__device__ __forceinline__ void attn_finish(bf16* MIX, int qrow0, int ocol, f32x4 (&o)[NH][4], float (&m)[NH], float (&ls)[NH], const float* sink2  , int li, int g) {
#pragma unroll
    for (int hh = 0; hh < NH; ++hh) {
        float l = ls[hh]; l += shx(l, 16, 16 * g + li); l += shx(l, 32, 16 * g + li);
        float corr = 1.f;
        if (sink2) { const float sk = sink2[hh]; const float mn = fmaxf(m[hh], sk); corr = __builtin_amdgcn_exp2f(m[hh] - mn); l = l * corr + __builtin_amdgcn_exp2f(sk - mn); }
        const float inv = corr / l;
#pragma unroll
        for (int dt = 0; dt < 4; ++dt) { const f32x4 v = o[hh][dt] * inv; u32x2 w; w.x = pk2(v[0], v[1]); w.y = pk2(v[2], v[3]);
            *(u32x2*)(MIX + (size_t)(qrow0 + li) * DM + ocol + hh * 64 + dt * 16 + 4 * g) = w; }
    }
}
__device__ __forceinline__ void attnA_unit(const Ctx& C, const float* asink_l, int unit, bool lat) {
    const bf16* P = (const bf16*)(C.ws + WS_P); bf16* MIX = (bf16*)(C.ws + WS_MIX);
    const int li = C.lane & 15, g = C.lane >> 4;
    const int nqt = lat ? SEQ / 16 : NCTX / 16, kvh = unit / nqt, qt = unit % nqt, t0 = qt * 16, qrow0 = (lat ? NCTX : 0) + t0, t = t0 + li;
    const bf16* VT = (const bf16*)(C.ws + WS_VTA) + (size_t)kvh * 64 * VTP; const int kcol = C_AK + kvh * 64;
    bf16x8 qf[2][2];
#pragma unroll
    for (int hh = 0; hh < 2; ++hh)
#pragma unroll
        for (int ks = 0; ks < 2; ++ks) qf[hh][ks] = ldg8(P + (size_t)(qrow0 + li) * INWP + C_AQ + (kvh * 2 + hh) * 64 + 32 * ks + 8 * g);
    f32x4 o[2][4]; float m[2] = {-1.0e30f, -1.0e30f}, ls[2] = {0.f, 0.f};
#pragma unroll
    for (int hh = 0; hh < 2; ++hh)
#pragma unroll
        for (int dt = 0; dt < 4; ++dt) o[hh][dt] = (f32x4){0.f, 0.f, 0.f, 0.f};
    const int b_lo = lat ? 0 : 9;
#define A_KROW(bb) ((bb) < 9 ? NCTX + t0 - 128 + 32 * (bb) : 32 * ((bb) - 9))
#define A_MASK(bb, add) do { _Pragma("unroll") for (int tt = 0; tt < 2; ++tt) _Pragma("unroll") for (int r = 0; r < 4; ++r) { const int j = t0 - 128 + 32 * (bb) + 16 * tt + 4 * g + r; \
        const bool ok = ((bb) >= 9) || ((j >= 0) && (j < SEQ) && (j - t <= 128) && (t - j <= 128)); add[tt][r] = ok ? 0.f : -INFINITY; } } while (0)
    bf16x8 kfa[2][2], vfa[4], kfb[2][2], vfb[4];
    attn_load(P, VT, A_KROW(b_lo), kcol, li, g, kfa, vfa);
#pragma unroll 1
    for (int bb = b_lo; bb < 17; bb += 2) { float add[2][4];
        if (bb + 1 < 17) attn_load(P, VT, A_KROW(bb + 1), kcol, li, g, kfb, vfb);
        A_MASK(bb, add); attn_compute<2>(kfa, vfa, qf, o, m, ls, add, li, g);
        if (bb + 1 < 17) { if (bb + 2 < 17) attn_load(P, VT, A_KROW(bb + 2), kcol, li, g, kfa, vfa);
            A_MASK(bb + 1, add); attn_compute<2>(kfb, vfb, qf, o, m, ls, add, li, g); } }
#undef A_KROW
#undef A_MASK
    float sk2[2] = {asink_l[kvh * 2] * LOG2E, asink_l[kvh * 2 + 1] * LOG2E};
    attn_finish<2>(MIX, qrow0, kvh * 128, o, m, ls, sk2, li, g);
}
__device__ __forceinline__ void attnC_unit(const Ctx& C, const LAS float* relb, int h, int qt, bool lat) {
    const bf16* P = (const bf16*)(C.ws + WS_P); bf16* MIX = (bf16*)(C.ws + WS_MIX);
    const int li = C.lane & 15, g = C.lane >> 4;
    const int t0 = qt * 16, qrow0 = (lat ? NCTX : 0) + t0;
    const bf16* VT = (const bf16*)(C.ws + WS_VTC) + (size_t)h * 64 * VTP; const int kcol = C_CK + h * 64;
    bf16x8 qf[1][2];
#pragma unroll
    for (int ks = 0; ks < 2; ++ks) qf[0][ks] = ldg8(P + (size_t)(qrow0 + li) * INWP + C_CQ + h * 64 + 32 * ks + 8 * g);
    f32x4 o[1][4]; float m[1] = {-1.0e30f}, ls[1] = {0.f};
#pragma unroll
    for (int dt = 0; dt < 4; ++dt) o[0][dt] = (f32x4){0.f, 0.f, 0.f, 0.f};
    const int r = t0 >> 6, cj = (t0 >> 4) & 3, cq = cj * 16 + li; int r0 = r - 4; r0 = r0 < 0 ? 0 : (r0 > 248 ? 248 : r0);
    int c0 = cq - 8; c0 = c0 < 0 ? 0 : (c0 > 48 ? 48 : c0);
    const int cw0 = (cj == 0) ? 0 : (cj == 1) ? 8 : (cj == 2) ? 24 : 32;
    const int b_lo = lat ? 0 : 8;
#define C_KROW(bb) ((bb) < 8 ? NCTX + (r0 + (bb)) * 64 + cw0 : 32 * ((bb) - 8))
#define C_MASK(bb, add) do { const LAS float* rbp = relb + (((bb) < 8 ? r0 + (bb) - r + 7 : 0)) * 31; _Pragma("unroll") for (int tt = 0; tt < 2; ++tt) _Pragma("unroll") for (int rr = 0; rr < 4; ++rr) { \
        const int kc = cw0 + 16 * tt + 4 * g + rr; int ci = kc - cq + 15; ci = ci < 0 ? 0 : (ci > 30 ? 30 : ci); const float bv = rbp[ci]; \
        add[tt][rr] = ((bb) >= 8) ? 0.f : ((kc >= c0 && kc < c0 + 16) ? bv : -INFINITY); } } while (0)
    bf16x8 kfa[2][2], vfa[4], kfb[2][2], vfb[4];
    attn_load(P, VT, C_KROW(b_lo), kcol, li, g, kfa, vfa);
#pragma unroll 1
    for (int bb = b_lo; bb < 16; bb += 2) { float add[2][4];
        attn_load(P, VT, C_KROW(bb + 1), kcol, li, g, kfb, vfb);
        C_MASK(bb, add); attn_compute<1>(kfa, vfa, qf, o, m, ls, add, li, g);
        if (bb + 2 < 16) attn_load(P, VT, C_KROW(bb + 2), kcol, li, g, kfa, vfa);
        C_MASK(bb + 1, add); attn_compute<1>(kfb, vfb, qf, o, m, ls, add, li, g); }
#undef C_KROW
#undef C_MASK
    attn_finish<1>(MIX, qrow0, 512 + h * 64, o, m, ls, nullptr, li, g);
}
__device__ __forceinline__ void fourier_ctx_mfma(const Ctx& C, int l, int wg0) {
    const bf16* P = (const bf16*)(C.ws + WS_P); bf16* MIX = (bf16*)(C.ws + WS_MIX); const bf16* f2 = (const bf16*)(C.ws + WS_F256);
    const int lane = C.lane, li = lane & 15, g = lane >> 4, w = C.wave;
    constexpr int UP = 72;
    for (int u = C.wg - wg0; u < 8; u += C.G - wg0) {
        const int tb = u >> 2, gq = u & 3;
        __syncthreads();
        for (int i = C.tid; i < 256 * 8; i += NTHR) { const int t = i >> 3, c8 = i & 7; *(LAS u32x4*)(C.lds + (t * UP + 8 * c8) * 2) = *(const u32x4*)(P + (size_t)t * INWP + C_BU + gq * 64 + 8 * c8); }
        __syncthreads();
        const int tp0 = 128 * tb + 16 * w;
        f32x4 xr[4], xi[4];
#pragma unroll
        for (int ci = 0; ci < 4; ++ci) { xr[ci] = (f32x4){0.f, 0.f, 0.f, 0.f}; xi[ci] = (f32x4){0.f, 0.f, 0.f, 0.f}; }
#pragma unroll 2
        for (int ks = 0; ks < 8; ++ks) { const bf16x8 bc = ldg8(f2 + (size_t)(tp0 + li) * 256 + 32 * ks + 8 * g), bs = ldg8(f2 + 65536 + (size_t)(tp0 + li) * 256 + 32 * ks + 8 * g);
#pragma unroll
            for (int ci = 0; ci < 4; ++ci) { const bf16x8 au = ldT(C.lds, UP, 32 * ks, 16 * ci, li, g); xr[ci] = mfma16(au, bc, xr[ci]); xi[ci] = mfma16(au, bs, xi[ci]); } }
        union { bf16x8 v; unsigned q[4]; } xb[4];
#pragma unroll
        for (int q2 = 0; q2 < 2; ++q2) { xb[q2].q[0] = pk2(xr[2 * q2][0], xr[2 * q2][1]); xb[q2].q[1] = pk2(xr[2 * q2][2], xr[2 * q2][3]); xb[q2].q[2] = pk2(xr[2 * q2 + 1][0], xr[2 * q2 + 1][1]); xb[q2].q[3] = pk2(xr[2 * q2 + 1][2], xr[2 * q2 + 1][3]);
            xb[2 + q2].q[0] = pk2(-xi[2 * q2][0], -xi[2 * q2][1]); xb[2 + q2].q[1] = pk2(-xi[2 * q2][2], -xi[2 * q2][3]); xb[2 + q2].q[2] = pk2(-xi[2 * q2 + 1][0], -xi[2 * q2 + 1][1]); xb[2 + q2].q[3] = pk2(-xi[2 * q2 + 1][2], -xi[2 * q2 + 1][3]); }
        const bf16x8* mf = (const bf16x8*)((const bf16*)(C.ws + WS_FTAB) + 32768) + (size_t)(l * 4 + gq) * 16 * 64;
#pragma unroll
        for (int ei = 0; ei < 4; ++ei) { f32x4 o = {0.f, 0.f, 0.f, 0.f};
#pragma unroll
            for (int ks2 = 0; ks2 < 4; ++ks2) o = mfma16(mf[(ei * 4 + ks2) * 64 + lane], xb[ks2].v, o);
            o = o * 8.0f;
            u32x2 wo; wo.x = pk2(o[0], o[1]); wo.y = pk2(o[2], o[3]); *(u32x2*)(MIX + (size_t)(tp0 + li) * DM + 256 + gq * 64 + 16 * ei + 4 * g) = wo; }
    }
    __syncthreads();
}
__device__ __forceinline__ void fourier2_unit(const Ctx& C, int l, int u, bool ctx) {
    const bf16* P = (const bf16*)(C.ws + WS_P); const float* tw = (const float*)(C.ws + WS_TW); bf16* MIX = (bf16*)(C.ws + WS_MIX);
    const float* FYR = (const float*)(C.ws + WS_FYR); const float* FYI = (const float*)(C.ws + WS_FYI);
    const float* mt = (const float*)(C.ws + WS_MTAB) + (size_t)l * 2 * 4 * 4096;
    LAS float* xr = (LAS float*)(C.lds + 8192); LAS float* xi = xr + 512;
    const int tl = C.tid >> 8, ch = C.tid & 255, tp = 2 * u + tl;
    float sr = 0.f, si = 0.f;
    if (!ctx) { const int k1 = tp & 127, k2 = tp >> 7; const float* yr = FYR + (size_t)k1 * 128 * 256 + ch; const float* yi = FYI + (size_t)k1 * 128 * 256 + ch;
#pragma unroll 8
        for (int t2 = 0; t2 < 128; ++t2) { const int m = ((t2 * k2) & 127) * 128; const float c = tw[m], s = tw[16384 + m]; const float a = yr[t2 * 256], b = yi[t2 * 256]; sr += a * c + b * s; si += b * c - a * s; } }
    else {
#pragma unroll 8
        for (int t = 0; t < NCTX; ++t) { const int m = ((t * tp) & 255) * 64; const float x = bf2f(P[(size_t)t * INWP + C_BU + ch]); sr += x * tw[m]; si -= x * tw[16384 + m]; } }
    __syncthreads();
    xr[tl * 256 + ch] = sr; xi[tl * 256 + ch] = si;
    __syncthreads();
    const int g = ch >> 6, e = ch & 63; const float* mc = mt + (size_t)(0 * 4 + g) * 4096 + e; const float* ms = mt + (size_t)(1 * 4 + g) * 4096 + e;
    const LAS float* xrp = xr + tl * 256 + g * 64; const LAS float* xip = xi + tl * 256 + g * 64; float o = 0.f;
#pragma unroll 8
    for (int c = 0; c < 64; ++c) o += xrp[c] * mc[c * 64] + xip[c] * ms[c * 64];
    o *= ctx ? (1.0f / 128.0f) : (1.0f / 1024.0f);
    MIX[(size_t)((ctx ? 0 : NCTX) + tp) * DM + 256 + ch] = (bf16)f2bf(o);
}
__device__ __forceinline__ void rwkv_passB(const Ctx& C, int b);
__device__ __forceinline__ void phase_mix2(const Ctx& C, const DArgs& a, int l) {
    const bool emit_ctx = l < DEPTH - 1;
#ifndef REPMASK
#define REPMASK 0
#endif
#define NREP2(o) ((((REPMASK) >> (o)) & 1) ? 2 : 1)
    if (C.wg < 8) { for (int r2 = 0; r2 < NREP2(16); ++r2) rwkv_passB(C, C.wg); }
    else if (emit_ctx) fourier_ctx_mfma(C, l, 8);
    { const float* asink_l = a.in[I_ASINK] + l * 4; const float* crel = a.in[I_CREL] + (size_t)l * 4 * 465;
      LAS float* relb = (LAS float*)(C.lds + 110592 + C.wave * 2048);
      unsigned* qhead = (unsigned*)(C.ws + WS_CTL) + CW_WQ + 64 * l;
      const int nA = 2 * (SEQ / 16), nC = 4 * (SEQ / 16), nAc = emit_ctx ? 2 * (NCTX / 16) : 0, nCc = emit_ctx ? 4 * (NCTX / 16) : 0, nAll = nA + nAc + nC + nCc;
      int hcur = -1;
      for (;;) { unsigned uq = 0; if (C.lane == 0) uq = __hip_atomic_fetch_add(qhead, 1u, __ATOMIC_RELAXED, __HIP_MEMORY_SCOPE_AGENT);
          const int u = __builtin_amdgcn_readfirstlane((int)uq); if (u >= nAll) break;
          if (u < nA) attnA_unit(C, asink_l, u, true);
          else if (u < nA + nAc) attnA_unit(C, asink_l, u - nA, false);
          else { const int uc = u - nA - nAc; const bool lat = uc < nC; const int uu = lat ? uc : uc - nC, nqt = lat ? SEQ / 16 : NCTX / 16, h = uu / nqt, qt = uu % nqt;
              if (h != hcur) { for (int i = C.lane; i < 465; i += 64) relb[i] = crel[h * 465 + i] * LOG2E; hcur = h; LDS_WAIT(); asm volatile("" ::: "memory"); }
              attnC_unit(C, relb, h, qt, lat); } } }
    __syncthreads();
    if (C.wg >= 8) for (int r2 = 0; r2 < NREP2(19); ++r2) fourier2_mfma(C, l, 8);
}

constexpr int RW_C = 32, RW_NCH = ROWS / RW_C, RW_SC = 20, RW_NSC = RW_NCH / RW_SC;
constexpr int RW_SLOT = 5120, RW_REGION = 9 * RW_SLOT + 1024;
constexpr int TP = 72, HP = 40;
static_assert(3 * RW_REGION <= MISC_OFF, "RWKV D1 regions below the misc area");
__device__ __forceinline__ int rw_rc_of(int d, int c) { return d == 0 ? c : (c < 8 ? 7 - c : 527 - c); }
__device__ __forceinline__ int rw_row_of(int d, int rc, int t) { return 32 * rc + (d == 0 ? t : 31 - t); }

__device__ __forceinline__ void rwkv_d1(const Ctx& C, LAS unsigned char* rb, int d, int h, int rc) {
    int lane_ = C.lane; asm volatile("" : "+v"(lane_));
    const int lane = lane_, li = lane & 15, g = lane >> 4;
    const float* SC = (const float*)(C.ws + WS_SC);
    LAS unsigned char* S0 = rb; LAS unsigned char* S1 = rb + RW_SLOT; LAS unsigned char* S2 = rb + 2 * RW_SLOT; LAS unsigned char* S3 = rb + 3 * RW_SLOT; LAS unsigned char* S4 = rb + 4 * RW_SLOT;
    LAS unsigned char* S5 = rb + 5 * RW_SLOT; LAS unsigned char* S6 = rb + 6 * RW_SLOT; LAS unsigned char* S7 = rb + 7 * RW_SLOT; LAS unsigned char* S8 = rb + 8 * RW_SLOT;
    LAS unsigned char* S6b = S6 + 2560; LAS unsigned char* S7b = S7 + 2560;
    LAS float* gc = (LAS float*)(rb + 9 * RW_SLOT);
    { float cum = 0.f; const int j = lane; const int qw = (3 + 3 * d) * 256;
#pragma unroll 1
      for (int t0 = 0; t0 < 32; t0 += 4) { float rv[4], vv[4], av[4], lw[4], kd[4], bb[4];
#pragma unroll
          for (int u = 0; u < 4; ++u) { const float* sc = SC + (size_t)rw_row_of(d, rc, t0 + u) * 9 * 256 + h * 64 + j;
              rv[u] = sc[0]; vv[u] = sc[256]; av[u] = sc[512]; lw[u] = sc[qw]; kd[u] = sc[qw + 256]; bb[u] = sc[qw + 512]; }
#pragma unroll
          for (int u = 0; u < 4; ++u) { const float cp = cum; cum += lw[u]; const float Gt = __expf(cum), Gm = __expf(cp), iG = __expf(-cum); const int off = ((t0 + u) * TP + j) * 2;
              *(LAS bf16*)(S0 + off) = (bf16)f2bf(av[u] * Gm); *(LAS bf16*)(S1 + off) = (bf16)f2bf(rv[u] * Gt); *(LAS bf16*)(S2 + off) = (bf16)f2bf(bb[u] * iG);
              *(LAS bf16*)(S3 + off) = (bf16)f2bf(kd[u] * iG); *(LAS bf16*)(S4 + off) = (bf16)f2bf(vv[u]); } }
      gc[j] = __expf(cum); }
    const f32x4 z4 = {0.f, 0.f, 0.f, 0.f};
#pragma unroll 1
    for (int ti = 0; ti < 2; ++ti)
#pragma unroll 1
        for (int si = 0; si < 2; ++si) {
            f32x4 n = z4, nt = z4, mk = z4, qb = z4, qk = z4;
#pragma unroll
            for (int ks = 0; ks < 2; ++ks) { const bf16x8 at = ldA(S0, TP, 16 * ti, 32 * ks, li, g), rt = ldA(S1, TP, 16 * ti, 32 * ks, li, g), bs = ldA(S2, TP, 16 * si, 32 * ks, li, g), kss = ldA(S3, TP, 16 * si, 32 * ks, li, g);
                n = mfma16(at, bs, n);
                nt = mfma16(bs, at, nt);
                mk = mfma16(kss, at, mk);
                qb = mfma16(bs, rt, qb);
                qk = mfma16(kss, rt, qk); }
#pragma unroll
            for (int r = 0; r < 4; ++r) { const int trow = 16 * ti + 4 * g + r, scol = 16 * si + li; if (!(scol < trow)) n[r] = 0.f;
                const int srow = 16 * si + 4 * g + r, tcol = 16 * ti + li; if (!(srow < tcol)) { mk[r] = 0.f; nt[r] = 0.f; } if (!(srow <= tcol)) { qb[r] = 0.f; qk[r] = 0.f; } }
            *(LAS f32x4*)(S5 + ((16 * si + li) * 32 + 16 * ti + 4 * g) * 4) = n;
            stT(S6, HP, 16 * ti + li, 16 * si + 4 * g, mk);
            stT(S8, HP, 16 * ti + li, 16 * si + 4 * g, nt);
            stT(S6b, HP, 16 * ti + li, 16 * si + 4 * g, qb);
            stT(S7, HP, 16 * ti + li, 16 * si + 4 * g, qk); }
    { const int rr = lane & 31, bq = rr >> 4, lr = rr & 15; float Tr[16];
#pragma unroll
      for (int s = 15; s >= 0; --s) { float acc = (lr == s) ? 1.f : 0.f;
#pragma unroll
          for (int c4 = 0; c4 < 4; ++c4) { if (4 * c4 + 3 > s) { const f32x4 nv = *(const LAS f32x4*)(S5 + ((16 * bq + s) * 32 + 16 * bq + 4 * c4) * 4);
#pragma unroll
              for (int e = 0; e < 4; ++e) if (4 * c4 + e > s) acc += Tr[4 * c4 + e] * nv[e]; } }
          Tr[s] = acc; }
      if (lane < 32) { u32x4 w0, w1; w0.x = pk2(Tr[0], Tr[1]); w0.y = pk2(Tr[2], Tr[3]); w0.z = pk2(Tr[4], Tr[5]); w0.w = pk2(Tr[6], Tr[7]); w1.x = pk2(Tr[8], Tr[9]); w1.y = pk2(Tr[10], Tr[11]); w1.z = pk2(Tr[12], Tr[13]); w1.w = pk2(Tr[14], Tr[15]);
          const u32x4 zz = {0u, 0u, 0u, 0u}; LAS u32x4* trow = (LAS u32x4*)(S7b + rr * HP * 2);
          trow[0] = bq ? zz : w0; trow[1] = bq ? zz : w1; trow[2] = bq ? w0 : zz; trow[3] = bq ? w1 : zz; }
      f32x4 x = mfma16(ldA(S8, HP, 16, 0, li, g), ldT(S7b, HP, 0, 0, li, g), z4);
      LAS unsigned char* XT = S8 + 2560;
      *(LAS u32x2*)(XT + (li * HP + 4 * g) * 2) = (u32x2){0u, 0u}; stT(XT, HP, li, 16 + 4 * g, x);
      const f32x4 t21 = mfma16(ldA(S7b, HP, 16, 0, li, g), ldA(XT, HP, 0, 0, li, g), z4);
#pragma unroll
      for (int r = 0; r < 4; ++r) *(LAS bf16*)(S7b + ((16 + 4 * g + r) * HP + li) * 2) = (bf16)f2bf(t21[r]); }
#pragma unroll 1
    for (int ti = 0; ti < 2; ++ti) { const bf16x8 tf = ldA(S7b, HP, 16 * ti, 0, li, g), mf = ldA(S6, HP, 16 * ti, 0, li, g);
#pragma unroll
        for (int ji = 0; ji < 4; ++ji) { const f32x4 ap = mfma16(tf, ldT(S0, TP, 0, 16 * ji, li, g), z4); stT(S8, HP, 16 * ji + li, 16 * ti + 4 * g, ap);
            const f32x4 mv = mfma16(mf, ldT(S4, TP, 0, 16 * ji, li, g), z4); stT(S5, HP, 16 * ji + li, 16 * ti + 4 * g, mv); } }
#pragma unroll 1
    for (int ti = 0; ti < 2; ++ti) { const bf16x8 tf = ldA(S7b, HP, 16 * ti, 0, li, g);
#pragma unroll
        for (int vi = 0; vi < 4; ++vi) { const f32x4 ul = mfma16(tf, ldA(S5, HP, 16 * vi, 0, li, g), z4); stT(S0, HP, 16 * vi + li, 16 * ti + 4 * g, ul); } }
#pragma unroll 1
    for (int ti = 0; ti < 2; ++ti) { const bf16x8 qbf = ldA(S6b, HP, 16 * ti, 0, li, g), qkf = ldA(S7, HP, 16 * ti, 0, li, g);
#pragma unroll
        for (int ji = 0; ji < 4; ++ji) { f32x4 rp = mfma16(ldA(S8, HP, 16 * ji, 0, li, g), qbf, z4);
            LAS unsigned char* p = S1 + ((16 * ti + li) * TP + 16 * ji + 4 * g) * 2; rp = rp + ld4bf(p); u32x2 w; w.x = pk2(rp[0], rp[1]); w.y = pk2(rp[2], rp[3]); *(LAS u32x2*)p = w;
            f32x4 yl = mfma16(qbf, ldA(S0, HP, 16 * ji, 0, li, g), z4); yl = mfma16(qkf, ldT(S4, TP, 0, 16 * ji, li, g), yl);
            stT(S5, HP, 16 * ji + li, 16 * ti + 4 * g, yl); } }
#pragma unroll 1
    for (int ji = 0; ji < 4; ++ji) { const bf16x8 bt = ldT(S2, TP, 0, 16 * ji, li, g); const float gj = gc[16 * ji + li];
#pragma unroll
        for (int jp = 0; jp < 4; ++jp) { f32x4 pt = mfma16(ldA(S8, HP, 16 * jp, 0, li, g), bt, z4);
#pragma unroll
            for (int r = 0; r < 4; ++r) pt[r] = pt[r] * gj + ((16 * jp + 4 * g + r == 16 * ji + li) ? gj : 0.f);
            stT(S6, TP, 16 * ji + li, 16 * jp + 4 * g, pt); } }
#pragma unroll 1
    for (int vh = 0; vh < 2; ++vh) { f32x4 lt[4][2];
#pragma unroll
      for (int ji = 0; ji < 4; ++ji) { const bf16x8 ba = ldT(S2, TP, 0, 16 * ji, li, g), ka = ldT(S3, TP, 0, 16 * ji, li, g); const f32x4 gv = *(const LAS f32x4*)(gc + 16 * ji + 4 * g);
#pragma unroll
          for (int v2 = 0; v2 < 2; ++v2) { const int vi = 2 * vh + v2; f32x4 x = mfma16(ba, ldA(S0, HP, 16 * vi, 0, li, g), z4); x = mfma16(ka, ldT(S4, TP, 0, 16 * vi, li, g), x); lt[ji][v2] = x * gv; } }
      asm volatile("s_waitcnt lgkmcnt(0)" ::: "memory");
      LAS unsigned char* dst = vh ? S2 : S8;
#pragma unroll
      for (int ji = 0; ji < 4; ++ji)
#pragma unroll
          for (int v2 = 0; v2 < 2; ++v2) stT(dst, TP, 16 * v2 + li, 16 * ji + 4 * g, lt[ji][v2]); }
}
__device__ __forceinline__ void rwkv_passA_step(const Ctx& C, const LAS unsigned char* rb, f32x4 (&hs)[4], int d, int h, int rc) {
    int lane_ = C.lane; asm volatile("" : "+v"(lane_));
    const int lane = lane_, li = lane & 15, g = lane >> 4; const bool isPhi = C.wave >= 4; const int col = 16 * (C.wave & 3) + li;
    const LAS unsigned char* S1 = rb + RW_SLOT; const LAS unsigned char* S2 = rb + 2 * RW_SLOT; const LAS unsigned char* S5 = rb + 5 * RW_SLOT; const LAS unsigned char* S6 = rb + 6 * RW_SLOT;
    const LAS unsigned char* LTb = (col < 32) ? rb + 8 * RW_SLOT + col * TP * 2 : S2 + (col - 32) * TP * 2;
    union { bf16x8 v; unsigned u[4]; } bf[2];
#pragma unroll
    for (int ks = 0; ks < 2; ++ks) { bf[ks].u[0] = pk2(hs[2 * ks][0], hs[2 * ks][1]); bf[ks].u[1] = pk2(hs[2 * ks][2], hs[2 * ks][3]); bf[ks].u[2] = pk2(hs[2 * ks + 1][0], hs[2 * ks + 1][1]); bf[ks].u[3] = pk2(hs[2 * ks + 1][2], hs[2 * ks + 1][3]); }
#pragma unroll
    for (int ti = 0; ti < 2; ++ti) { f32x4 acc = isPhi ? (f32x4){0.f, 0.f, 0.f, 0.f} : ld4bf(S5 + (col * HP + 16 * ti + 4 * g) * 2);
#pragma unroll
        for (int ks = 0; ks < 2; ++ks) acc = mfma16(ldAperm(S1, TP, 16 * ti, ks, li, g), bf[ks].v, acc);
        if (!isPhi) { float* ys = (float*)(C.ws + WS_YS) + (size_t)d * ROWS * 256 + h * 64 + col;
#pragma unroll
            for (int r = 0; r < 4; ++r) ys[(size_t)rw_row_of(d, rc, 16 * ti + 4 * g + r) * 256] = acc[r]; }
        else { bf16* rp = (bf16*)(C.ws + WS_RPP) + ((size_t)((d * 4 + h) * RW_NCH + rc) * 32) * 64 + col;
#pragma unroll
            for (int r = 0; r < 4; ++r) rp[(16 * ti + 4 * g + r) * 64] = (bf16)f2bf(acc[r]); } }
    f32x4 hn[4];
#pragma unroll
    for (int i = 0; i < 4; ++i) { f32x4 acc = isPhi ? (f32x4){0.f, 0.f, 0.f, 0.f} : ld4bf(LTb + (16 * i + 4 * g) * 2);
#pragma unroll
        for (int ks = 0; ks < 2; ++ks) acc = mfma16(ldAperm(S6, TP, 16 * i, ks, li, g), bf[ks].v, acc);
        hn[i] = acc; }
#pragma unroll
    for (int i = 0; i < 4; ++i) hs[i] = hn[i];
}
__device__ __forceinline__ void phase_rwkv1(const Ctx& C) {
    const int lane = C.lane, li = lane & 15, g = lane >> 4;
    for (int u = C.wg; u < 8 * RW_NSC; u += C.G) {
        const int s = u % RW_NSC, dh = u / RW_NSC, d = dh >> 2, h = dh & 3; const bool isPhi = C.wave >= 4; const int col = 16 * (C.wave & 3) + li;
        f32x4 hs[4];
#pragma unroll
        for (int i = 0; i < 4; ++i)
#pragma unroll
            for (int r = 0; r < 4; ++r) hs[i][r] = (isPhi && (16 * i + 4 * g + r == col)) ? 1.f : 0.f;
#pragma unroll 1
        for (int rnd = 0; rnd < (RW_SC + 2) / 3; ++rnd) {
            __syncthreads();
            { int wv = C.wave; asm volatile("" : "+s"(wv)); if (wv < 3 && 3 * rnd + wv < RW_SC) rwkv_d1(C, C.lds + wv * RW_REGION, d, h, rw_rc_of(d, s * RW_SC + 3 * rnd + wv)); }
            __syncthreads();
#pragma unroll 1
            for (int k = 0; k < 3; ++k) { const int ci = 3 * rnd + k; int ko = k * RW_REGION; asm volatile("" : "+s"(ko)); if (ci < RW_SC) rwkv_passA_step(C, C.lds + ko, hs, d, h, rw_rc_of(d, s * RW_SC + ci)); }
        }
        if (isPhi) { bf16* pf = (bf16*)(C.ws + WS_PSC) + (size_t)(dh * RW_NSC + s) * 4096;
            const int ks = col >> 5, eh = (col >> 4) & 1, gp = (col >> 2) & 3, el = col & 3;
#pragma unroll
            for (int i = 0; i < 4; ++i)
#pragma unroll
                for (int r = 0; r < 4; ++r) pf[((i * 2 + ks) * 64 + gp * 16 + 4 * g + r) * 8 + eh * 4 + el] = (bf16)f2bf(hs[i][r]); }
        else { f32x4* lf = (f32x4*)(C.ws + WS_LSC) + ((size_t)(dh * RW_NSC + s) * 4 + C.wave) * 4 * 64;
#pragma unroll
            for (int i = 0; i < 4; ++i) lf[i * 64 + lane] = hs[i]; }
    }
    __syncthreads();
}
__device__ __forceinline__ void rwkv_passB(const Ctx& C, int b) {
    if (C.wave >= 4) return;
    const int lane = C.lane, li = lane & 15, g = lane >> 4, q = C.wave;
    f32x4 hs[4];
#pragma unroll
    for (int i = 0; i < 4; ++i) hs[i] = (f32x4){0.f, 0.f, 0.f, 0.f};
    const bf16x8* pfb = (const bf16x8*)((const bf16*)(C.ws + WS_PSC) + (size_t)b * RW_NSC * 4096);
    const f32x4* lfb = (const f32x4*)(C.ws + WS_LSC) + ((size_t)b * RW_NSC * 4 + q) * 4 * 64;
    bf16x8 pa[8]; f32x4 la[4];
#pragma unroll
    for (int k = 0; k < 8; ++k) pa[k] = pfb[k * 64 + lane];
#pragma unroll
    for (int i = 0; i < 4; ++i) la[i] = lfb[i * 64 + lane];
#pragma unroll 1
    for (int s = 0; s < RW_NSC; ++s) {
        bf16* hp = (bf16*)(C.ws + WS_HSC) + ((size_t)(b * RW_NSC + s) * 64 + 16 * q + li) * 64;
#pragma unroll
        for (int i = 0; i < 4; ++i) { u32x2 w; w.x = pk2(hs[i][0], hs[i][1]); w.y = pk2(hs[i][2], hs[i][3]); *(u32x2*)(hp + 16 * i + 4 * g) = w; }
        bf16x8 pn[8]; f32x4 ln[4]; const int sn = (s + 1 < RW_NSC) ? s + 1 : s;
#pragma unroll
        for (int k = 0; k < 8; ++k) pn[k] = pfb[(size_t)sn * 512 + k * 64 + lane];
#pragma unroll
        for (int i = 0; i < 4; ++i) ln[i] = lfb[(size_t)sn * 4 * 4 * 64 + i * 64 + lane];
        union { bf16x8 v; unsigned u[4]; } bf[2];
#pragma unroll
        for (int ks = 0; ks < 2; ++ks) { bf[ks].u[0] = pk2(hs[2 * ks][0], hs[2 * ks][1]); bf[ks].u[1] = pk2(hs[2 * ks][2], hs[2 * ks][3]); bf[ks].u[2] = pk2(hs[2 * ks + 1][0], hs[2 * ks + 1][1]); bf[ks].u[3] = pk2(hs[2 * ks + 1][2], hs[2 * ks + 1][3]); }
#pragma unroll
        for (int i = 0; i < 4; ++i) { f32x4 acc = la[i];
#pragma unroll
            for (int ks = 0; ks < 2; ++ks) acc = mfma16(pa[i * 2 + ks], bf[ks].v, acc);
            hs[i] = acc; }
#pragma unroll
        for (int k = 0; k < 8; ++k) pa[k] = pn[k];
#pragma unroll
        for (int i = 0; i < 4; ++i) la[i] = ln[i];
    }
}
__device__ __forceinline__ void phase_mix3(const Ctx& C, const DArgs& a, int l) {
    const bf16* P = (const bf16*)(C.ws + WS_P); const float* SC = (const float*)(C.ws + WS_SC); const float* YS = (const float*)(C.ws + WS_YS); bf16* MIX = (bf16*)(C.ws + WS_MIX);
    LAS float* yt = (LAS float*)(C.lds);
    constexpr int GSP = 168;
    LAS unsigned char* gsig = C.lds + 32768;
    LAS float* gm = (LAS float*)(C.lds + 40960);
    const bf16* g2t = (const bf16*)(C.ws + WS_G2T) + (size_t)l * 256 * 160;
    const float* rk = a.in[I_DRK] + (size_t)l * 256; const float* lnw = a.in[I_DLNW] + (size_t)l * 256; const float* lnb = a.in[I_DLNB] + (size_t)l * 256;
    const int lane = C.lane, li = lane & 15, g = lane >> 4, h = C.wave & 3, d = C.wave >> 2;
    const int half = C.tid >> 8, c = C.tid & 255;
    const int u_lo = (l == DEPTH - 1) ? NCTX / 16 : 0;
    for (int u = u_lo + C.wg; u < ROWS / 16; u += C.G) {
        const int rc = u >> 1, th = u & 1, rowb = 16 * u;
        __syncthreads();
        for (int i = C.tid; i < 16 * 160; i += NTHR) { const int t = i / 160, ii = i % 160; *(LAS bf16*)(gsig + (t * GSP + ii) * 2) = (bf16)f2bf(sigmoidf_(bf2f(P[(size_t)(rowb + t) * INWP + C_GL + ii]))); }
        {
          const int ct = (d == 0) ? rc : (rc < 8 ? 7 - rc : 527 - rc), s = ct / RW_SC, ti = (d == 0) ? th : 1 - th;
          const bf16* rp = (const bf16*)(C.ws + WS_RPP) + (size_t)((d * 4 + h) * RW_NCH + rc) * 32 * 64;
          const bf16* hp = (const bf16*)(C.ws + WS_HSC) + (size_t)((d * 4 + h) * RW_NSC + s) * 64 * 64;
          bf16x8 af[2];
#pragma unroll
          for (int ks = 0; ks < 2; ++ks) af[ks] = ldg8(rp + (16 * ti + li) * 64 + 32 * ks + 8 * g);
#pragma unroll
          for (int vi = 0; vi < 4; ++vi) { f32x4 acc = {0.f, 0.f, 0.f, 0.f};
#pragma unroll
              for (int ks = 0; ks < 2; ++ks) acc = mfma16(af[ks], ldg8(hp + (16 * vi + li) * 64 + 32 * ks + 8 * g), acc);
#pragma unroll
              for (int r = 0; r < 4; ++r) { const int t = 16 * ti + 4 * g + r, rl = ((d == 0) ? t : 31 - t) - 16 * th;
                  yt[(d * 16 + rl) * 256 + h * 64 + 16 * vi + li] = acc[r] + YS[((size_t)d * ROWS + rowb + rl) * 256 + h * 64 + 16 * vi + li]; } } }
        __syncthreads();
#pragma unroll
        for (int c2 = 0; c2 < 2; ++c2) { const int ci = 2 * C.wave + c2; f32x4 a0 = {0.f, 0.f, 0.f, 0.f};
#pragma unroll
            for (int ks = 0; ks < 5; ++ks) a0 = mfma16(ldA(gsig, GSP, 0, 32 * ks, li, g), ldg8(g2t + (size_t)(16 * ci + li) * 160 + 32 * ks + 8 * g), a0);
#pragma unroll
            for (int r = 0; r < 4; ++r) gm[(4 * g + r) * 256 + 16 * ci + li] = a0[r]; }
        __syncthreads();
#pragma unroll 1
        for (int it = 0; it < 8; ++it) { const int rl = 2 * it + half, row = rowb + rl;
            const float* sc = SC + (size_t)row * 9 * 256;
            const float y = yt[rl * 256 + c] + yt[(16 + rl) * 256 + c];
            const float mu = wave_sum(y, lane) * (1.f / 64.f), dy = y - mu, var = wave_sum(dy * dy, lane) * (1.f / 64.f);
            const float yn = dy * rsqrtf(var + 64e-5f) * lnw[c] + lnb[c];
            const float r = sc[c], v = sc[256 + c];
            const float coef = wave_sum(r * (sc[4 * 256 + c] + sc[7 * 256 + c]) * rk[c], lane);
            MIX[(size_t)row * DM + 768 + c] = (bf16)f2bf((yn + coef * v) * gm[rl * 256 + c]); }
    }
    __syncthreads();
}
__device__ __forceinline__ void outproj_ctx(const Ctx& C, int l, const float* gate) {
    const bf16* A = (const bf16*)(C.ws + WS_MIX); const bf16* B = (const bf16*)(C.ws + WS_WOUT) + (size_t)l * DM * DM; float* XS = (float*)(C.ws + WS_XS);
    const int lane = C.lane, li = lane & 15, g = lane >> 4;
    for (int u = C.gw; u < (NCTX / 16) * (DM / 16); u += C.NGW) { const int rt = u >> 6, ct = u & 63;
        const bf16* ap = A + (size_t)(16 * rt + li) * DM + 8 * g; const bf16* bp = B + (size_t)(16 * ct + li) * DM + 8 * g;
        f32x4 acc0 = {0.f, 0.f, 0.f, 0.f}, acc1 = {0.f, 0.f, 0.f, 0.f};
#pragma unroll 4
        for (int ks = 0; ks < 32; ks += 2) { acc0 = mfma16(ldg8(ap + 32 * ks), ldg8(bp + 32 * ks), acc0); acc1 = mfma16(ldg8(ap + 32 * ks + 32), ldg8(bp + 32 * ks + 32), acc1); }
        const float gv = gate[16 * ct + li];
#pragma unroll
        for (int r = 0; r < 4; ++r) { float* p = XS + (size_t)(16 * rt + 4 * g + r) * DM + 16 * ct + li; *p = *p + gv * (acc0[r] + acc1[r]); } }
}

#ifndef MK_SINGLE
#define MK_SINGLE 1
#endif
template <int ONLYP> __global__ void __launch_bounds__(NTHR, 2) mega(Args a) {
    extern __shared__ __attribute__((aligned(16))) unsigned char lds_raw[];
    Ctx C;
#define MKCTX() do { int t_ = threadIdx.x; asm volatile("" : "+v"(t_)); unsigned char* w_ = a.ws; asm volatile("" : "+s"(w_)); unsigned l_ = 0u; asm volatile("" : "+s"(l_)); \
        C.lds = (LAS unsigned char*)lds_raw + l_; C.tid = t_; C.lane = t_ & 63; C.wave = __builtin_amdgcn_readfirstlane(t_ >> 6); \
        C.wg = blockIdx.x; C.G = gridDim.x; C.gw = C.wg * NWAVES + C.wave; C.NGW = C.G * NWAVES; C.ws = w_; } while (0)
    MKCTX();
    if (C.tid == 0) {
#pragma unroll
        for (int i = 0; i < 31; ++i) ((LAS unsigned long long*)(C.lds + MISC_OFF + 2048))[i] = (unsigned long long)a.in[i]; }
    DArgs da; da.in.tab = (const LAS unsigned*)(C.lds + MISC_OFF + 2048); da.out = a.out;
    if (C.tid < 4) ((LAS unsigned*)(C.lds + MISC_OFF))[C.tid] = 0u;
    __syncthreads();
    XcdBarrier bar; bar.bar = (unsigned*)(C.ws + WS_CTL) + CW_BAR; bar.x = 0; bar.st = (volatile LAS unsigned*)(C.lds + MISC_OFF);
    if (a.use_bar) bar = xcd_barrier_post((unsigned*)(C.ws + WS_CTL) + CW_BAR, (volatile LAS unsigned*)(C.lds + MISC_OFF));
#ifndef PHMASK
#define PHMASK 0x1fff
#endif
#define INP(o, k) ((ONLYP < 0 || ONLYP == (o)) && ((PHMASK >> ((o) == 99 ? 12 : (o))) & 1) && a.ph_lo <= (k) && (k) < a.ph_hi)
#ifndef REPMASK
#define REPMASK 0
#endif
#define NREP(o) ((((REPMASK) >> ((o) == 99 ? 12 : (o))) & 1) ? 2 : 1)
#define IN(k) (a.ph_lo <= (k) && (k) < a.ph_hi)
#define SEAM(k) do { if (a.use_bar && IN(k) && IN((k) + 1)) xcd_barrier(bar); } while (0)
    if (INP(0, 0)) for (int rep = 0; rep < NREP(0); ++rep) { MKCTX(); phase_prologue(C, da); }
    SEAM(0);
    for (int l = 0; l < DEPTH; ++l) {
        const int b = 1 + l * NPL;
        const float* mod_lat = (const float*)(C.ws + WS_MOD) + (size_t)(l * 2 + 0) * 6144; const float* mod_ctx = mod_lat + 6144;
        if (INP(1, b + 0)) { MKCTX(); phase_norm1(C, da, l); }
        SEAM(b + 0);
        if (INP(2, b + 1)) for (int rep = 0; rep < NREP(2); ++rep) { MKCTX();
            pg8::StaticOrder S; S.init(WS_H, WS_WIN + (size_t)l * INWP * DM * 2, ROWS, INWP, DM, C.G, C.wg);
            pg8::EpiStoreBf16 E{(bf16*)(C.ws + WS_P), INWP, nullptr, 0, 1.0f, 1.0f};
            pg8::gemm_phase<pg8::EpiStoreBf16, pg8::StaticOrder, true, true>(C.lds, C.tid, DM, S, E, C.ws);
        }
        SEAM(b + 1);
        if (INP(3, b + 2)) { MKCTX(); mix1_rope(C); for (int rep = 0; rep < NREP(3); ++rep) { for (int r2 = 0; r2 < NREP(13); ++r2) mix1_vt(C); for (int r2 = 0; r2 < NREP(14); ++r2) mix1_rwkv_prep(C, da, l); for (int r2 = 0; r2 < NREP(15); ++r2) mix1_fourier1(C); } }
        SEAM(b + 2);
        if (INP(11, b + 3)) for (int rep = 0; rep < NREP(11); ++rep) { MKCTX(); phase_rwkv1(C); }
        SEAM(b + 3);
        if (INP(4, b + 4)) for (int rep = 0; rep < NREP(4); ++rep) { MKCTX(); phase_mix2(C, da, l); }
        SEAM(b + 4);
        if (INP(5, b + 5)) for (int rep = 0; rep < NREP(5); ++rep) { MKCTX(); phase_mix3(C, da, l); }
        SEAM(b + 5);
        if (INP(6, b + 6)) { MKCTX();
            if (l < DEPTH - 1) outproj_ctx(C, l, mod_ctx + 2 * DM);
            pg8::StaticOrder S; S.init(WS_MIX + (size_t)NCTX * DM * 2, WS_WOUT + (size_t)l * DM * DM * 2, SEQ, DM, DM, C.G, C.wg);
            pg8::EpiResidual E{(float*)(C.ws + WS_XS) + (size_t)NCTX * DM, DM, mod_lat + 2 * DM, mod_lat + 2 * DM};
            pg8::gemm_phase<pg8::EpiResidual, pg8::StaticOrder, true, true>(C.lds, C.tid, DM, S, E, C.ws);
        }
        SEAM(b + 6);
        if (INP(7, b + 7)) for (int rep = 0; rep < NREP(7); ++rep) { MKCTX(); phase_norm2(C, da, l); }
        SEAM(b + 7);
        if (INP(8, b + 8)) for (int rep = 0; rep < NREP(8); ++rep) { MKCTX(); phase_gather(C, da, l); }
        SEAM(b + 8);
        if (INP(9, b + 9)) for (int rep = 0; rep < NREP(9); ++rep) { MKCTX();
            const int nblk = moe_tables(C);
            pg8::MoeOrder S{(unsigned)WS_XG8, (unsigned)(WS_WGU + (size_t)l * 32 * 2048 * DM), 256u * DM, 2048u * DM,
                            (const LAS unsigned char*)(C.lds + MISC_OFF + 1024), nblk, 8, C.G, C.wg};
            pg8::EpiSwiglu E{(bf16*)(C.ws + WS_ACT8), DM, da.in[I_BGU] + (size_t)l * 32 * 2048, 2048, pg8::X8_S * pg8::W8_S, 1.0f / (pg8::X8_S * pg8::W8_S)};
            pg8::gemm_phase<pg8::EpiSwiglu, pg8::MoeOrder, true, true, 1>(C.lds, C.tid, DM, S, E, C.ws);
        }
        SEAM(b + 9);
        if (INP(10, b + 10)) for (int rep = 0; rep < NREP(10); ++rep) { MKCTX();
            const int nblk = moe_tables(C);
            pg8::MoeOrder S{(unsigned)WS_ACT8, (unsigned)(WS_WDN + (size_t)l * 32 * DM * DM), 256u * DM, (unsigned)(DM * DM),
                            (const LAS unsigned char*)(C.lds + MISC_OFF + 1024), nblk, 4, C.G, C.wg};
            pg8::EpiStoreBf16 E{(bf16*)(C.ws + WS_XG), DM, da.in[I_BDN] + (size_t)l * 32 * DM, DM, pg8::ACT_S * pg8::W8_S, 1.0f / (pg8::ACT_S * pg8::W8_S)};
            pg8::gemm_phase<pg8::EpiStoreBf16, pg8::MoeOrder, true, true, 1>(C.lds, C.tid, DM, S, E, C.ws);
        }
        SEAM(b + 10);
    }
    if (INP(99, PH_TOTAL - 1)) { MKCTX(); phase_final(C, da); }
#undef IN
#undef INP
#undef SEAM
}

typedef void (*kern_t)(Args);
static kern_t kern_of(int o) {
    switch (o) { case 0: return mega<0>; case 1: return mega<1>; case 2: return mega<2>; case 3: return mega<3>; case 4: return mega<4>; case 5: return mega<5>; case 6: return mega<6>;
                 case 7: return mega<7>; case 8: return mega<8>; case 9: return mega<9>; case 10: return mega<10>; case 11: return mega<11>; case 99: return mega<99>;
#if MK_SINGLE
                 default: return mega<-1>;
#else
                 default: return mega<0>;
#endif
    }
}
extern "C" void kernel_launch(void* const* d_in, const int* in_sizes, int n_in, void* d_out, int out_size, void* d_ws, size_t ws_size, hipStream_t stream) {
    static int ready = 0;
    if (ready == 0) {
        if (n_in != 31 || out_size != SEQ * DM || ws_size < WS_END) { fprintf(stderr, "kernel_launch: unexpected shapes (n_in %d, out %d, ws %zu)\n", n_in, out_size, ws_size); ready = -1; return; }
        const int ids[14] = {0, 1, 2, 3, 4, 5, 6, 7, 8, 9, 10, 11, 99, -1};
        for (int i = 0; i < (MK_SINGLE ? 14 : 13); ++i) { if (MK_SINGLE && ids[i] != -1) continue;
            if (hipFuncSetAttribute((const void*)kern_of(ids[i]), hipFuncAttributeMaxDynamicSharedMemorySize, LDS_BYTES) != hipSuccess) { fprintf(stderr, "kernel_launch: hipFuncSetAttribute failed (%d)\n", ids[i]); ready = -1; return; } }
        ready = 1;
    }
    if (ready < 0) return;
    (void)hipMemsetAsync((char*)d_ws + WS_CTL, 0, CTL_ZERO_BYTES, stream);
    Args a{};
    for (int i = 0; i < 31; ++i) a.in[i] = (const float*)d_in[i];
    a.out = (float*)d_out; a.ws = (unsigned char*)d_ws; a.pad = 0;
#if MK_SINGLE
    a.ph_lo = 0; a.ph_hi = PH_TOTAL; a.use_bar = 1;
    hipLaunchKernelGGL(kern_of(-1), dim3(NWG), dim3(NTHR), LDS_BYTES, stream, a);
#else
    for (int p = 0; p < PH_TOTAL; ++p) { a.ph_lo = p; a.ph_hi = p + 1; a.use_bar = 0;
        const int j = (p - 1) % NPL; const int o = (p == 0) ? 0 : (p == PH_TOTAL - 1) ? 99 : (j < 3 ? 1 + j : j == 3 ? 11 : j);
        hipLaunchKernelGGL(kern_of(o), dim3(NWG), dim3(NTHR), LDS_BYTES, stream, a); }
#endif
}
```

```cpp
#include <hip/hip_runtime.h>
#include <cstdio>
#include <cstdint>

#define LAS __attribute__((address_space(3)))
typedef unsigned short bf16;
typedef float f32x4 __attribute__((ext_vector_type(4)));
typedef float f32x2 __attribute__((ext_vector_type(2)));
typedef short bf16x8 __attribute__((ext_vector_type(8)));
typedef unsigned u32x4 __attribute__((ext_vector_type(4)));
typedef unsigned u32x2 __attribute__((ext_vector_type(2)));

constexpr int DM = 1024, SEQ = 16384, NCTX = 256, ROWS = SEQ + NCTX, DEPTH = 4, GRIDW = 64;
constexpr int INW = 2720, INWP = 2816;
constexpr int C_AQ = 0, C_AK = 256, C_AV = 384, C_BU = 512, C_CQ = 768, C_CK = 1024, C_CV = 1280, C_DR = 1536, C_DK = 1792, C_DV = 2048, C_WL = 2304, C_AL = 2432, C_GL = 2560;
constexpr int NEXP = 32, TOPK = 4;
constexpr int MOE_MAXBLK = 296;
constexpr int MOE_ROWS = MOE_MAXBLK * 256;
constexpr int NWG = 256, NTHR = 512, NWAVES = 8;
constexpr int VTP = ROWS + 256;

constexpr size_t MiB = 1u << 20;
constexpr size_t WS_CTL = 0, CTL_ZERO_BYTES = 1 * MiB;
constexpr size_t WS_MOD = 1 * MiB;
constexpr size_t WS_TW = 2 * MiB;
constexpr size_t WS_MTAB = 3 * MiB;
constexpr size_t WS_XS = 4 * MiB;
constexpr size_t WS_H = 70 * MiB;
constexpr size_t WS_P = 104 * MiB;
constexpr size_t WS_MIX = 194 * MiB;
constexpr size_t WS_FYR = 228 * MiB, WS_FYI = 244 * MiB;
constexpr size_t WS_VTA = 1544 * MiB, WS_VTC = 1550 * MiB;
constexpr size_t WS_SC = 260 * MiB;
constexpr size_t WS_YS = 408 * MiB;
constexpr size_t WS_ROUTE = 442 * MiB;
constexpr size_t WS_CNT = 444 * MiB;
constexpr size_t WS_XG = 446 * MiB;
constexpr size_t WS_ACT = 596 * MiB;
constexpr size_t WS_XG8 = WS_ACT, WS_ACT8 = WS_ACT + 75 * MiB;
constexpr size_t WS_WIN = 746 * MiB;
constexpr size_t WS_WOUT = 768 * MiB;
constexpr size_t WS_WGU = 776 * MiB;
constexpr size_t WS_WDN = 1288 * MiB;
constexpr size_t WS_RPP = 1560 * MiB, WS_PSC = 1578 * MiB, WS_LSC = 1580 * MiB, WS_HSC = 1584 * MiB;
constexpr size_t WS_FTAB = 1586 * MiB;
constexpr size_t WS_G2T = 1588 * MiB, WS_RWT = 1589 * MiB;
constexpr size_t WS_LORAT = 1590 * MiB;
constexpr size_t WS_F256 = 1591 * MiB;

constexpr size_t WS_END = 1592 * MiB;
static_assert(WS_XS + (size_t)ROWS * DM * 4 <= WS_H && WS_H + (size_t)ROWS * DM * 2 <= WS_P && WS_P + (size_t)ROWS * INWP * 2 <= WS_MIX && WS_MIX + (size_t)ROWS * DM * 2 <= WS_FYR, "ws map 1");
static_assert(WS_SC + (size_t)ROWS * 9 * 256 * 4 <= WS_YS && WS_YS + (size_t)2 * ROWS * 256 * 4 <= WS_ROUTE && WS_XG + (size_t)MOE_ROWS * DM * 2 <= WS_ACT && WS_ACT + (size_t)MOE_ROWS * DM * 2 <= WS_WIN, "ws map 2");
static_assert(WS_WIN + (size_t)4 * INWP * DM * 2 <= WS_WOUT && WS_WGU + (size_t)4 * 32 * 2048 * 1024 * 2 <= WS_WDN && WS_WDN + (size_t)4 * 32 * 1024 * 1024 * 2 <= WS_END, "ws map 3");
constexpr int CW_BAR = 4096;
constexpr int CW_WQ = 16384;

constexpr int RING_BYTES = 131072;
constexpr int MISC_OFF = 143360;
constexpr int LDS_BYTES = 147456;

__device__ __forceinline__ unsigned f2bf(float f) { unsigned u = __builtin_bit_cast(unsigned, f); return (u + 0x7fffu + ((u >> 16) & 1u)) >> 16; }
__device__ __forceinline__ unsigned pk2(float lo, float hi) { return f2bf(lo) | (f2bf(hi) << 16); }
__device__ __forceinline__ float bf2f(unsigned short b) { return __builtin_bit_cast(float, (unsigned)b << 16); }
__device__ __forceinline__ float bflo(unsigned w) { return __builtin_bit_cast(float, w << 16); }
__device__ __forceinline__ float bfhi(unsigned w) { return __builtin_bit_cast(float, w & 0xffff0000u); }
__device__ __forceinline__ float shx(float v, int o, int lane) { return __builtin_bit_cast(float, __builtin_amdgcn_ds_bpermute((lane ^ o) << 2, __builtin_bit_cast(int, v))); }
__device__ __forceinline__ int shxi(int v, int o, int lane) { return __builtin_amdgcn_ds_bpermute((lane ^ o) << 2, v); }
__device__ __forceinline__ float dpp_ror(float v, int ctrl_unused);
#define DPP_ROR_ADD(v, n) v += __builtin_bit_cast(float, __builtin_amdgcn_update_dpp(0, __builtin_bit_cast(int, v), 0x120 + (n), 0xf, 0xf, false))
__device__ __forceinline__ float wave_sum(float v, int lane) {
    DPP_ROR_ADD(v, 8); DPP_ROR_ADD(v, 4); DPP_ROR_ADD(v, 2); DPP_ROR_ADD(v, 1);
    v += shx(v, 16, lane); v += shx(v, 32, lane);
    return v;
}
__device__ __forceinline__ float sigmoidf_(float x) { return 1.f / (1.f + __expf(-x)); }
#define LDS_WAIT() asm volatile("s_waitcnt lgkmcnt(0)" ::: "memory")
#define VM_WAIT() asm volatile("s_waitcnt vmcnt(0)" ::: "memory")

namespace pg8 {
#define PG8_LAS __attribute__((address_space(3)))
typedef unsigned short bf16_t;
constexpr int BM = 256, BK = 64, HALF = 128, HTB = HALF * BK * 2, STAGE_BYTES = 8 * HTB, NXCD = 8, WGM = 8;
__host__ __device__ __forceinline__ int lds_byte(int r, int c) { const int st = (r >> 4) * 2 + (c >> 5), rr = r & 15, cc = c & 31, ob = rr * 64 + cc * 2; return st * 1024 + (ob ^ (((ob >> 9) & 1) << 5)); }
__host__ __device__ __forceinline__ void stage_rc(int b, int& R, int& C) { const int st = b / 1024, sb = b % 1024, swz = sb ^ (((sb >> 9) & 1) << 5); R = (st >> 1) * 16 + swz / 64; C = (st & 1) * 32 + (swz % 64) / 2; }
__host__ __device__ __forceinline__ int perm32(int rho) { const int n = rho >> 4, i = rho & 15; return 8 * (i >> 2) + 4 * n + (i & 3); }
struct Unit { int pm, pn, e; };
typedef int v8i __attribute__((ext_vector_type(8))); typedef int v4i __attribute__((ext_vector_type(4)));
__device__ __forceinline__ v8i cat8(bf16x8 a, bf16x8 b) { const v4i x = __builtin_bit_cast(v4i, a), y = __builtin_bit_cast(v4i, b); return __builtin_shufflevector(x, y, 0, 1, 2, 3, 4, 5, 6, 7); }
__device__ __forceinline__ unsigned cvt_pk_bf16(float lo, float hi) { unsigned r; asm volatile("v_cvt_pk_bf16_f32 %0, %1, %2" : "=v"(r) : "v"(lo), "v"(hi)); return r; }

struct StaticOrder {
    unsigned A, Bt, tstep;
    int nM, nN, nwg, G, c;
    __device__ void init(size_t A_, size_t Bt_, int M, int N, int K, int G_, int c_) { A = (unsigned)A_; Bt = (unsigned)Bt_; tstep = (unsigned)(BM * K * 2); nM = M / BM; nN = N / BM; nwg = nM * nN; G = G_; c = c_; }
    __device__ bool next(int i, Unit& u) const {
        const long L = (long)i * G + c; if (L >= nwg) return false;
        int wgid = (int)L; { const int q = nwg / NXCD, r = nwg % NXCD, xcd = wgid % NXCD, off = wgid / NXCD; wgid = (xcd < r ? xcd * (q + 1) : r * (q + 1) + (xcd - r) * q) + off; }
        const int nig = WGM * nN, gid = wgid / nig, fm = gid * WGM, gsz = (nM - fm) < WGM ? (nM - fm) : WGM;
        u.pm = fm + ((wgid % nig) % gsz); u.pn = (wgid % nig) / gsz; u.e = 0; return true;
    }
    __device__ __forceinline__ unsigned pa(const Unit& u) const { return A + (unsigned)u.pm * tstep; }
    __device__ __forceinline__ unsigned pb(const Unit& u) const { return Bt + (unsigned)u.pn * tstep; }
};
struct MoeOrder {
    unsigned A, Bt, tstep, estep;
    const LAS unsigned char* blk_e; int nblk, nN, G, c;
    __device__ bool next(int i, Unit& u) const {
        const int L = i * G + c; if (L >= nblk * nN) return false;
        u.pm = L / nN; u.pn = L % nN; u.e = __builtin_amdgcn_readfirstlane((int)blk_e[u.pm]); return true;
    }
    __device__ __forceinline__ unsigned pa(const Unit& u) const { return A + (unsigned)u.pm * tstep; }
    __device__ __forceinline__ unsigned pb(const Unit& u) const { return Bt + (unsigned)u.e * estep + (unsigned)u.pn * tstep; }
};

struct EpiStoreBf16 {
    static constexpr bool PERM = true;
    bf16_t* O; int ldc; const float* bias; int bias_estride; float bias_scale, acc_scale;
    __device__ __forceinline__ void init(f32x4 (&acc)[2][2][4][2], const Unit& u, int wc, int fq) const {
        const int col0 = u.pn * BM + wc * 32 + 8 * fq;
#pragma unroll
        for (int b = 0; b < 2; ++b)
#pragma unroll
            for (int n = 0; n < 2; ++n) { const f32x4 bv = bias ? *(const f32x4*)(bias + (size_t)u.e * bias_estride + col0 + b * HALF + 4 * n) * bias_scale : (f32x4){0.f, 0.f, 0.f, 0.f};
#pragma unroll
                for (int a = 0; a < 2; ++a)
#pragma unroll
                    for (int m = 0; m < 4; ++m) { f32x4 t = bv; asm volatile("" : "+v"(t)); acc[a][b][m][n] = t; } }
    }
    __device__ __forceinline__ void operator()(const f32x4 (&acc)[2][2][4][2], const Unit& u, int wr, int wc, int fr, int fq) const {
        const int row0 = u.pm * BM + wr * 64 + fr, col0 = u.pn * BM + wc * 32 + 8 * fq;
#pragma unroll
        for (int ai = 0; ai < 2; ++ai)
#pragma unroll
            for (int m = 0; m < 4; ++m) { bf16_t* rowp = O + (size_t)(row0 + ai * HALF + m * 16) * ldc + col0;
#pragma unroll
                for (int bj = 0; bj < 2; ++bj) { const f32x4 v0 = acc[ai][bj][m][0] * acc_scale, v1 = acc[ai][bj][m][1] * acc_scale;
                    u32x4 w; w.x = cvt_pk_bf16(v0[0], v0[1]); w.y = cvt_pk_bf16(v0[2], v0[3]); w.z = cvt_pk_bf16(v1[0], v1[1]); w.w = cvt_pk_bf16(v1[2], v1[3]);
                    *(u32x4*)(rowp + bj * HALF) = w; }
                asm volatile("" ::: "memory"); }
    }
};
__device__ __forceinline__ float swiglu1(float g, float up) {
    g = fminf(g, 7.0f); up = fminf(fmaxf(up, -7.0f), 7.0f);
    return g * (1.f / (1.f + __expf(-1.702f * g))) * (up + 1.0f);
}
constexpr float X8_S = 8.0f, W8_S = 256.0f, ACT_S = 4.0f;
struct EpiSwiglu {
    static constexpr bool PERM = true;
    bf16_t* O; int ldc; const float* bias; int bias_estride; float bias_scale, acc_scale;
    __device__ __forceinline__ void init(f32x4 (&acc)[2][2][4][2], const Unit& u, int wc, int fq) const {
        const int col0 = u.pn * BM + wc * 32 + 8 * fq;
#pragma unroll
        for (int b = 0; b < 2; ++b)
#pragma unroll
            for (int n = 0; n < 2; ++n) { const f32x4 bv = bias ? *(const f32x4*)(bias + (size_t)u.e * bias_estride + col0 + b * HALF + 4 * n) * bias_scale : (f32x4){0.f, 0.f, 0.f, 0.f};
#pragma unroll
                for (int a = 0; a < 2; ++a)
#pragma unroll
                    for (int m = 0; m < 4; ++m) { f32x4 t = bv; asm volatile("" : "+v"(t)); acc[a][b][m][n] = t; } }
    }
    __device__ __forceinline__ void operator()(const f32x4 (&acc)[2][2][4][2], const Unit& u, int wr, int wc, int fr, int fq) const {
        const int row0 = u.pm * BM + wr * 64 + fr, col0 = u.pn * BM + wc * 32 + 8 * fq;
#pragma unroll
        for (int ai = 0; ai < 2; ++ai)
#pragma unroll
            for (int m = 0; m < 4; ++m) { unsigned char* rowp = (unsigned char*)O + (size_t)(row0 + ai * HALF + m * 16) * ldc + (col0 >> 1);
#pragma unroll
                for (int bj = 0; bj < 2; ++bj) { const f32x4 v0 = acc[ai][bj][m][0] * acc_scale, v1 = acc[ai][bj][m][1] * acc_scale;
                    unsigned w = 0; w = __builtin_amdgcn_cvt_pk_fp8_f32(swiglu1(v0[0], v0[1]) * ACT_S, swiglu1(v0[2], v0[3]) * ACT_S, w, false); w = __builtin_amdgcn_cvt_pk_fp8_f32(swiglu1(v1[0], v1[1]) * ACT_S, swiglu1(v1[2], v1[3]) * ACT_S, w, true);
                    *(unsigned*)(rowp + bj * (HALF / 2)) = w; }
                asm volatile("" ::: "memory"); }
    }
};
struct EpiResidual {
    static constexpr bool PERM = false;
    float* X; int ldc; const float* gate_lat; const float* gate_ctx;
    __device__ __forceinline__ void init(f32x4 (&acc)[2][2][4][2], const Unit& u, int wc, int fq) const {
#pragma unroll
        for (int a = 0; a < 2; ++a)
#pragma unroll
            for (int b = 0; b < 2; ++b)
#pragma unroll
                for (int m = 0; m < 4; ++m)
#pragma unroll
                    for (int n = 0; n < 2; ++n) acc[a][b][m][n] = (f32x4){0.f, 0.f, 0.f, 0.f};
    }
    __device__ __forceinline__ void operator()(const f32x4 (&acc)[2][2][4][2], const Unit& u, int wr, int wc, int fr, int fq) const {
        const int row0 = u.pm * BM + wr * 64 + fr, col0 = u.pn * BM + wc * 32 + 4 * fq;
        const float* gp = (u.pm == 0) ? gate_ctx : gate_lat;
        f32x4 gv[2][2];
#pragma unroll
        for (int bj = 0; bj < 2; ++bj)
#pragma unroll
            for (int n = 0; n < 2; ++n) gv[bj][n] = *(const f32x4*)(gp + col0 + bj * HALF + n * 16);
#pragma unroll
        for (int ai = 0; ai < 2; ++ai)
#pragma unroll
            for (int m = 0; m < 4; ++m) { float* rowp = X + (size_t)(row0 + ai * HALF + m * 16) * ldc + col0;
#pragma unroll
                for (int bj = 0; bj < 2; ++bj)
#pragma unroll
                    for (int n = 0; n < 2; ++n) { f32x4* p = (f32x4*)(rowp + bj * HALF + n * 16); *p = *p + gv[bj][n] * acc[ai][bj][m][n]; }
                asm volatile("" ::: "memory"); }
    }
};
template <class Epi, class Sched, bool ALIGN_EPI = false, bool SP2 = false, int ES = 2>
__device__ __forceinline__ void gemm_phase(PG8_LAS unsigned char* lds, const int tid, const int K, const Sched& S, const Epi& E, const void* wsbase) {
    const __amdgpu_buffer_rsrc_t rsrc = __builtin_amdgcn_make_buffer_rsrc((void*)wsbase, 0, 0x7fffffff, 0x00020000);
    const int wid = __builtin_amdgcn_readfirstlane(tid >> 6), lane = tid & 63, wr = wid >> 2, wc = wid & 3, fr = lane & 15, fq = lane >> 4;
    const int nt = (K * ES) / 128;
    unsigned voffA[2], voffB[2];
#pragma unroll
    for (int i = 0; i < 2; ++i) { int R, C; stage_rc(tid * 16 + i * 8192, R, C); const int Rb = Epi::PERM ? ((R & ~31) + perm32(R & 31)) : R;
        voffA[i] = (unsigned)(R * K * ES + C * 2); voffB[i] = (unsigned)(Rb * K * ES + C * 2); }
    const unsigned kstep = (unsigned)(BK * 2);
    const unsigned hstep = (unsigned)(HALF * K * ES);
        const unsigned ldsw = (unsigned)wid * 1024u;
    const int aoff = lds_byte(wr * 64 + fr, ES == 2 ? fq * 8 : fq * 16), boff = lds_byte(wc * 32 + fr, ES == 2 ? fq * 8 : fq * 16); constexpr int KOFF = (ES == 2) ? 1024 : 16;
#define PG8_SA(b, h) (((b) * 2 + (h)) * HTB)
#define PG8_SB(b, h) ((4 + (b) * 2 + (h)) * HTB)
#define PG8_STAGE(bufoff, gbase, voff) do { _Pragma("unroll") for (int _i = 0; _i < 2; ++_i) \
        __builtin_amdgcn_raw_ptr_buffer_load_lds(rsrc, (PG8_LAS unsigned*)(lds + (bufoff) + ldsw + _i * 8192), 16, (voff)[_i], (gbase), 0, 0); } while (0)
#define PG8_LDA(dst, b, h) do { _Pragma("unroll") for (int m = 0; m < 4; ++m) _Pragma("unroll") for (int k = 0; k < 2; ++k) dst[m][k] = *(const PG8_LAS bf16x8*)(lds + PG8_SA(b, h) + aoff + m * 2048 + k * KOFF); } while (0)
#define PG8_LDA8(dst, b, h) do { _Pragma("unroll") for (int m = 0; m < 4; ++m) { const PG8_LAS v4i* p_ = (const PG8_LAS v4i*)(lds + PG8_SA(b, h) + aoff + m * 2048); const v4i x_ = p_[0], y_ = p_[1]; dst[m] = __builtin_shufflevector(x_, y_, 0, 1, 2, 3, 4, 5, 6, 7); } } while (0)
#define PG8_LDB(dst, b, h) do { _Pragma("unroll") for (int n = 0; n < 2; ++n) _Pragma("unroll") for (int k = 0; k < 2; ++k) dst[n][k] = *(const PG8_LAS bf16x8*)(lds + PG8_SB(b, h) + boff + n * 2048 + k * KOFF); } while (0)
#define PG8_LDB8(dst, b, h) do { _Pragma("unroll") for (int n = 0; n < 2; ++n) { const PG8_LAS v4i* p_ = (const PG8_LAS v4i*)(lds + PG8_SB(b, h) + boff + n * 2048); const v4i x_ = p_[0], y_ = p_[1]; dst[n] = __builtin_shufflevector(x_, y_, 0, 1, 2, 3, 4, 5, 6, 7); } } while (0)
#define PG8_MMA(ai, bj, At, Bt) do { __builtin_amdgcn_s_setprio(1); _Pragma("unroll") for (int m = 0; m < 4; ++m) _Pragma("unroll") for (int n = 0; n < 2; ++n) { \
        if constexpr (ES == 2) { _Pragma("unroll") for (int k = 0; k < 2; ++k) acc[ai][bj][m][n] = __builtin_amdgcn_mfma_f32_16x16x32_bf16(Bt[n][k], At[m][k], acc[ai][bj][m][n], 0, 0, 0); } \
        else asm volatile("v_mfma_f32_16x16x128_f8f6f4 %0, %1, %2, %0" : "+v"(acc[ai][bj][m][n]) : "v"(Bt##8[n]), "v"(At##8[m])); } \
        __builtin_amdgcn_s_setprio(0); } while (0)
#define PG8_LDAX(b, h) do { if constexpr (ES == 2) PG8_LDA(At, b, h); else PG8_LDA8(At8, b, h); } while (0)
#define PG8_LDBX(B, b, h) do { if constexpr (ES == 2) PG8_LDB(B, b, h); else PG8_LDB8(B##8, b, h); } while (0)
#define PG8_WAIT_V(n) asm volatile("s_waitcnt vmcnt(" #n ")" ::: "memory")
#define PG8_WAIT_L(n) asm volatile("s_waitcnt lgkmcnt(" #n ")" ::: "memory")
#define PG8_BAR __builtin_amdgcn_s_barrier()
#define PG8_SCHED __builtin_amdgcn_sched_barrier(0)
    Unit cur, nxt; int ui = 0;
    if (!S.next(0, cur)) return;
    f32x4 acc[2][2][4][2];
    E.init(acc, cur, wc, fq);
    bf16x8 At[4][2], B0[2][2], B1[2][2]; v8i At8[4], B08[2], B18[2];
    unsigned cA = S.pa(cur), cB = S.pb(cur);
    if constexpr (SP2) {
        PG8_STAGE(PG8_SB(0, 0), cB, voffB); PG8_STAGE(PG8_SB(0, 1), cB + hstep, voffB); PG8_STAGE(PG8_SA(0, 0), cA, voffA); PG8_STAGE(PG8_SA(0, 1), cA + hstep, voffA);
        if (wr == 1) PG8_BAR;
        PG8_WAIT_V(2); PG8_BAR;
        PG8_STAGE(PG8_SB(1, 0), cB + kstep, voffB); PG8_STAGE(PG8_SA(1, 0), cA + kstep, voffA); PG8_STAGE(PG8_SB(1, 1), cB + hstep + kstep, voffB);
        PG8_WAIT_V(6); PG8_BAR;
    } else {
        PG8_STAGE(PG8_SB(0, 0), cB, voffB); PG8_STAGE(PG8_SA(0, 0), cA, voffA); PG8_STAGE(PG8_SB(0, 1), cB + hstep, voffB); PG8_STAGE(PG8_SA(0, 1), cA + hstep, voffA);
        if (wr == 1) PG8_BAR;
        PG8_WAIT_V(4); PG8_BAR;
        PG8_STAGE(PG8_SB(1, 0), cB + kstep, voffB); PG8_STAGE(PG8_SA(1, 0), cA + kstep, voffA); PG8_STAGE(PG8_SB(1, 1), cB + hstep + kstep, voffB);
        PG8_WAIT_V(6); PG8_BAR;
    }
    for (;;) {
        const bool has_next = S.next(ui + 1, nxt);
        const unsigned nA = has_next ? S.pa(nxt) : cA, nB = has_next ? S.pb(nxt) : cB;
        for (int t = 0; t < nt; t += 2) {
            const bool last = (t == nt - 2);
            const unsigned a1 = cA + (unsigned)(t + 1) * kstep;
            const unsigned a2 = last ? nA : cA + (unsigned)(t + 2) * kstep, b2 = last ? nB : cB + (unsigned)(t + 2) * kstep;
            const unsigned a3 = a2 + kstep, b3 = b2 + kstep;
            if constexpr (SP2) {
            PG8_LDBX(B0, 0, 0); PG8_LDBX(B1, 0, 1); PG8_SCHED; PG8_LDAX(0, 0); PG8_STAGE(PG8_SA(1, 1), a1 + hstep, voffA);
            PG8_WAIT_V(8); PG8_WAIT_L(0); PG8_BAR; PG8_MMA(0, 0, At, B0); PG8_MMA(0, 1, At, B1); PG8_BAR; PG8_SCHED;
            PG8_LDAX(0, 1); PG8_STAGE(PG8_SB(0, 0), b2, voffB); PG8_STAGE(PG8_SB(0, 1), b2 + hstep, voffB); PG8_STAGE(PG8_SA(0, 0), a2, voffA);
            PG8_WAIT_V(8); PG8_WAIT_L(0); PG8_BAR; PG8_MMA(1, 0, At, B0); PG8_MMA(1, 1, At, B1); PG8_BAR; PG8_SCHED;
            PG8_LDBX(B0, 1, 0); PG8_LDBX(B1, 1, 1); PG8_SCHED; PG8_LDAX(1, 0); PG8_STAGE(PG8_SA(0, 1), a2 + hstep, voffA);
            PG8_WAIT_V(8); PG8_WAIT_L(0); PG8_BAR; PG8_MMA(0, 0, At, B0); PG8_MMA(0, 1, At, B1); PG8_BAR; PG8_SCHED;
            PG8_LDAX(1, 1); PG8_STAGE(PG8_SB(1, 0), b3, voffB); PG8_STAGE(PG8_SB(1, 1), b3 + hstep, voffB); PG8_STAGE(PG8_SA(1, 0), a3, voffA);
            PG8_WAIT_V(8); PG8_WAIT_L(0); PG8_BAR; PG8_MMA(1, 0, At, B0); PG8_MMA(1, 1, At, B1); PG8_BAR; PG8_SCHED;
            } else {
            PG8_LDBX(B0, 0, 0); PG8_SCHED; PG8_LDAX(0, 0); PG8_STAGE(PG8_SA(1, 1), a1 + hstep, voffA);
            PG8_WAIT_L(8); PG8_BAR; PG8_WAIT_L(0); PG8_MMA(0, 0, At, B0); PG8_BAR; PG8_SCHED;
            PG8_LDBX(B1, 0, 1); PG8_STAGE(PG8_SB(0, 0), b2, voffB);
            PG8_BAR; PG8_WAIT_L(0); PG8_MMA(0, 1, At, B1); PG8_BAR;
            PG8_LDAX(0, 1); PG8_STAGE(PG8_SA(0, 0), a2, voffA);
            PG8_BAR; PG8_WAIT_L(0); PG8_MMA(1, 0, At, B0); PG8_BAR; PG8_SCHED;
            PG8_STAGE(PG8_SB(0, 1), b2 + hstep, voffB);
            PG8_WAIT_V(6); PG8_BAR; PG8_MMA(1, 1, At, B1); PG8_BAR;
            PG8_LDBX(B0, 1, 0); PG8_SCHED; PG8_LDAX(1, 0); PG8_STAGE(PG8_SA(0, 1), a2 + hstep, voffA);
            PG8_WAIT_L(8); PG8_BAR; PG8_WAIT_L(0); PG8_MMA(0, 0, At, B0); PG8_BAR; PG8_SCHED;
            PG8_LDBX(B1, 1, 1); PG8_STAGE(PG8_SB(1, 0), b3, voffB);
            PG8_BAR; PG8_WAIT_L(0); PG8_MMA(0, 1, At, B1); PG8_BAR;
            PG8_LDAX(1, 1); PG8_STAGE(PG8_SA(1, 0), a3, voffA);
            PG8_BAR; PG8_WAIT_L(0); PG8_MMA(1, 0, At, B0); PG8_BAR; PG8_SCHED;
            PG8_STAGE(PG8_SB(1, 1), b3 + hstep, voffB);
            PG8_WAIT_V(6); PG8_BAR; PG8_MMA(1, 1, At, B1); PG8_BAR;
            }
        }
        if constexpr (ALIGN_EPI) { if (wr == 0) PG8_BAR; }
        if constexpr (ES == 1) asm volatile("s_nop 15\n\ts_nop 15" ::: "memory");
        E(acc, cur, wr, wc, fr, fq);
        if (!has_next) break;
        E.init(acc, nxt, wc, fq);
        cur = nxt; cA = nA; cB = nB; ++ui;
        if constexpr (ALIGN_EPI) { if (wr == 1) PG8_BAR; }
    }
    PG8_WAIT_V(0);
    if constexpr (!ALIGN_EPI) { if (wr == 0) PG8_BAR; }
    PG8_BAR;
#undef PG8_SA
#undef PG8_SB
#undef PG8_STAGE
#undef PG8_LDA
#undef PG8_LDA8
#undef PG8_LDB8
#undef PG8_LDAX
#undef PG8_LDBX
#undef PG8_LDB
#undef PG8_MMA
#undef PG8_WAIT_V
#undef PG8_WAIT_L
#undef PG8_BAR
#undef PG8_SCHED
}
}

#define XB_TMO      128
#define XB_XCNT(j)  (256  + 64 * (j))
#define XB_XSUB(j)  (1280 + 64 * (j))
#define XB_XGEN(j)  (2304 + 64 * (j))
#define XB_TOP      3328
#define XB_TOPGEN   3392
#define XCD_BAR_WORDS 3456
#define XB_SPIN_CAP (1u << 18)
__device__ __forceinline__ unsigned xb_ld(unsigned* p)              { return __hip_atomic_load(p, __ATOMIC_RELAXED, __HIP_MEMORY_SCOPE_AGENT); }
__device__ __forceinline__ unsigned xb_add(unsigned* p, unsigned v) { return __hip_atomic_fetch_add(p, v, __ATOMIC_RELAXED, __HIP_MEMORY_SCOPE_AGENT); }
__device__ __forceinline__ unsigned xb_xcc_id() { return (unsigned)__builtin_amdgcn_s_getreg((3 << 11) | 20) & 0xFu; }
#define XB_SPIN(cond, bar) do { unsigned _sp = 0; while (cond) { __builtin_amdgcn_s_sleep(1); \
    if ((++_sp & 255u) == 0u) { if (xb_ld(&(bar)[XB_TMO])) break; if (_sp > XB_SPIN_CAP) { atomicAdd(&(bar)[XB_TMO], 1u); break; } } } } while (0)

struct XcdBarrier {
    unsigned* bar; unsigned x;
    volatile LAS unsigned* st;
};

__device__ __forceinline__ XcdBarrier xcd_barrier_post(unsigned* bar, volatile LAS unsigned* st) {
    XcdBarrier b; b.bar = bar; b.x = xb_xcc_id(); b.st = st;
    if (threadIdx.x == 0) (void)xb_add(&bar[XB_XCNT(b.x)], 1u);
    return b;
}
__device__ __forceinline__ void xcd_barrier_complete(unsigned* bar, unsigned x, unsigned& nloc, unsigned& nx) {
    const unsigned G = gridDim.x * gridDim.y * gridDim.z;
    unsigned sum, cnt, mine, sp = 0u;
    for (;;) {
        sum = 0u; cnt = 0u; mine = 0u;
#pragma unroll
        for (unsigned j = 0; j < 16; ++j) { const unsigned c = xb_ld(&bar[XB_XCNT(j)]); sum += c; cnt += (c > 0u) ? 1u : 0u; mine = (j == x) ? c : mine; }
        if (sum == G) break;
        __builtin_amdgcn_s_sleep(1);
        if ((++sp & 255u) == 0u) { if (xb_ld(&bar[XB_TMO])) break; if (sp > XB_SPIN_CAP) { atomicAdd(&bar[XB_TMO], 1u); break; } }
    }
    nloc = mine > 0u ? mine : 1u; nx = cnt > 0u ? cnt : 1u;
}

__device__ __forceinline__ void xcd_barrier(const XcdBarrier& b) {
    asm volatile("s_waitcnt vmcnt(0)" ::: "memory");
    __syncthreads();
    if (threadIdx.x == 0) {
        unsigned* bar = b.bar;
        __builtin_amdgcn_s_waitcnt(0);
        unsigned nloc = b.st[0], nx = b.st[1];
        if (nloc == 0u) { xcd_barrier_complete(bar, b.x, nloc, nx); b.st[0] = nloc; b.st[1] = nx; }
        const unsigned old = xb_add(&bar[XB_XSUB(b.x)], 1u);
        const unsigned gen = old / nloc;
        if (old + 1u == (gen + 1u) * nloc) {
            __builtin_amdgcn_fence(__ATOMIC_RELEASE, "agent");
            asm volatile("s_waitcnt vmcnt(0)" ::: "memory");
            const unsigned og = xb_add(&bar[XB_TOP], 1u);
            const unsigned tg = og / nx;
            if (og + 1u == (tg + 1u) * nx) xb_add(&bar[XB_TOPGEN], 1u);
            else XB_SPIN(xb_ld(&bar[XB_TOPGEN]) == tg, bar);
            __builtin_amdgcn_fence(__ATOMIC_ACQUIRE, "agent");
            xb_add(&bar[XB_XGEN(b.x)], 1u);
            asm volatile("s_waitcnt vmcnt(0)" ::: "memory");
        } else {
            XB_SPIN(xb_ld(&bar[XB_XGEN(b.x)]) == gen, bar);
            __builtin_amdgcn_fence(__ATOMIC_ACQUIRE, "agent");
            asm volatile("s_waitcnt vmcnt(0)" ::: "memory");
        }
    }
    __syncthreads();
}

typedef short s4v __attribute__((ext_vector_type(4)));
__device__ __forceinline__ bf16x8 ldg8(const bf16* p) { return *(const bf16x8*)p; }
__device__ __forceinline__ f32x4 mfma16(bf16x8 a, bf16x8 b, f32x4 c) { return __builtin_amdgcn_mfma_f32_16x16x32_bf16(a, b, c, 0, 0, 0); }
__device__ __forceinline__ bf16x8 ldA(const LAS unsigned char* base, int pitch, int row0, int k0, int li, int g) { return *(const LAS bf16x8*)(base + ((row0 + li) * pitch + k0 + 8 * g) * 2); }
__device__ __forceinline__ bf16x8 ldT(const LAS unsigned char* base, int pitch, int k0, int n0, int li, int g) {
    const LAS unsigned char* p = base + ((k0 + 8 * g + (li >> 2)) * pitch + n0 + 4 * (li & 3)) * 2;
    const s4v a = __builtin_amdgcn_ds_read_tr16_b64_v4i16((LAS s4v*)p), b = __builtin_amdgcn_ds_read_tr16_b64_v4i16((LAS s4v*)(p + 8 * pitch));
    return (bf16x8){a[0], a[1], a[2], a[3], b[0], b[1], b[2], b[3]};
}
__device__ __forceinline__ bf16x8 ldAperm(const LAS unsigned char* base, int pitch, int row0, int ks, int li, int g) {
    const LAS unsigned char* p = base + ((row0 + li) * pitch + 32 * ks + 4 * g) * 2;
    const s4v a = *(const LAS s4v*)p, b = *(const LAS s4v*)(p + 32);
    return (bf16x8){a[0], a[1], a[2], a[3], b[0], b[1], b[2], b[3]};
}
__device__ __forceinline__ void stT(LAS unsigned char* base, int pitch, int n, int m0, const f32x4 v) {
    u32x2 w; w.x = pk2(v[0], v[1]); w.y = pk2(v[2], v[3]); *(LAS u32x2*)(base + (n * pitch + m0) * 2) = w;
}
__device__ __forceinline__ f32x4 ld4bf(const LAS unsigned char* p) { const u32x2 w = *(const LAS u32x2*)p; return (f32x4){bflo(w.x), bfhi(w.x), bflo(w.y), bfhi(w.y)}; }

struct Args {
    const float* in[31];
    float* out; unsigned char* ws;
    int ph_lo, ph_hi, use_bar, pad;
};
enum InIdx { I_X = 0, I_C, I_CTX, I_CCTX, I_ADAW, I_ADAB, I_N1G, I_N2G, I_WIN, I_WOUT, I_ASINK, I_BMIX, I_CREL, I_DCONV, I_DW0, I_DW2, I_DA0, I_DA2, I_DG2, I_DKK, I_DKA, I_DRK, I_DLNW, I_DLNB,
             I_RW, I_RB, I_WGU, I_BGU, I_WDN, I_BDN, I_FNG };
constexpr int NPL = 11;
constexpr int PH_TOTAL = 1 + DEPTH * NPL + 1;

struct DevIn {
    const LAS unsigned* tab;
    __device__ __forceinline__ const float* operator[](int i) const {
        const unsigned lo = __builtin_amdgcn_readfirstlane(((const volatile LAS unsigned*)tab)[2 * i]), hi = __builtin_amdgcn_readfirstlane(((const volatile LAS unsigned*)tab)[2 * i + 1]);
        return (const float*)(((unsigned long long)hi << 32) | lo);
    }
};
struct DArgs { DevIn in; float* out; };
struct Ctx {
    LAS unsigned char* lds;
    int tid, lane, wave, wg, G, gw, NGW;
    unsigned char* ws;
};

template <int NW>
__device__ __forceinline__ void transpose_item(const float* W, int K, int N, bf16* WT, int item, int lane) {
    constexpr int NQ = NW / 4, NC = 64 / NQ, PASSES = 8 / NC;
    const int nblk = N / NW, kb = item / nblk, nb = item % nblk, k0 = 64 * kb, n0 = NW * nb, nq = lane % NQ, cq = lane / NQ;
    f32x4 v[PASSES][8];
#pragma unroll
    for (int ps = 0; ps < PASSES; ++ps)
#pragma unroll
        for (int i = 0; i < 8; ++i) v[ps][i] = *(const f32x4*)(W + (size_t)(k0 + 8 * (cq + NC * ps) + i) * N + n0 + 4 * nq);
#pragma unroll
    for (int ps = 0; ps < PASSES; ++ps)
#pragma unroll
        for (int j = 0; j < 4; ++j) { u32x4 o; o.x = pk2(v[ps][0][j], v[ps][1][j]); o.y = pk2(v[ps][2][j], v[ps][3][j]); o.z = pk2(v[ps][4][j], v[ps][5][j]); o.w = pk2(v[ps][6][j], v[ps][7][j]);
            *(u32x4*)(WT + (size_t)(n0 + 4 * nq + j) * K + k0 + 8 * (cq + NC * ps)) = o; }
}
template <int NW>
__device__ __forceinline__ void transpose_item8(const float* W, int K, int N, unsigned char* WT, int item, int lane) {
    constexpr int NQ = NW / 4, NC = 64 / NQ, PASSES = 8 / NC;
    const int nblk = N / NW, kb = item / nblk, nb = item % nblk, k0 = 64 * kb, n0 = NW * nb, nq = lane % NQ, cq = lane / NQ;
    f32x4 v[PASSES][8];
#pragma unroll
    for (int ps = 0; ps < PASSES; ++ps)
#pragma unroll
        for (int i = 0; i < 8; ++i) v[ps][i] = *(const f32x4*)(W + (size_t)(k0 + 8 * (cq + NC * ps) + i) * N + n0 + 4 * nq) * pg8::W8_S;
#pragma unroll
    for (int ps = 0; ps < PASSES; ++ps)
#pragma unroll
        for (int j = 0; j < 4; ++j) { unsigned w0 = 0, w1 = 0;
            w0 = __builtin_amdgcn_cvt_pk_fp8_f32(v[ps][0][j], v[ps][1][j], w0, false); w0 = __builtin_amdgcn_cvt_pk_fp8_f32(v[ps][2][j], v[ps][3][j], w0, true);
            w1 = __builtin_amdgcn_cvt_pk_fp8_f32(v[ps][4][j], v[ps][5][j], w1, false); w1 = __builtin_amdgcn_cvt_pk_fp8_f32(v[ps][6][j], v[ps][7][j], w1, true);
            *(u32x2*)(WT + (size_t)(n0 + 4 * nq + j) * K + k0 + 8 * (cq + NC * ps)) = (u32x2){w0, w1}; }
}
constexpr int CV_IT_GU = 16 * 32, CV_IT_DN = 16 * 16, CV_N_GU = 32 * CV_IT_GU, CV_N_DN = 32 * CV_IT_DN, CV_ITEMS = CV_N_GU + CV_N_DN, CV_CHUNK = 8, CV_NCHUNK = CV_ITEMS / CV_CHUNK;
__device__ __forceinline__ void convert_moe_items(const Ctx& C, const DArgs& a, int l, int it0, int it1) {
    const float* pwgu = a.in[I_WGU] + (size_t)l * 32 * DM * 2048; const float* pwdn = a.in[I_WDN] + (size_t)l * 32 * DM * DM;
    unsigned char* ogu = C.ws + WS_WGU + (size_t)l * 32 * 2048 * DM; unsigned char* odn = C.ws + WS_WDN + (size_t)l * 32 * DM * DM;
#pragma unroll 1
    for (int it = it0; it < it1; ++it) {
        if (it < CV_N_GU) { const int e = it / CV_IT_GU; transpose_item8<64>(pwgu + (size_t)e * DM * 2048, DM, 2048, ogu + (size_t)e * 2048 * DM, it % CV_IT_GU, C.lane); }
        else { const int r = it - CV_N_GU, e = r / CV_IT_DN; transpose_item8<64>(pwdn + (size_t)e * DM * DM, DM, DM, odn + (size_t)e * DM * DM, r % CV_IT_DN, C.lane); }
    }
}
__device__ __forceinline__ void phase_prologue(const Ctx& C, const DArgs& a) {
    constexpr int IT_IN = 16 * (INW / 32), IT_OUT = 16 * 16;
    constexpr int N_IN = 4 * IT_IN, N_OUT = 4 * IT_OUT;
    const float* pwin = a.in[I_WIN]; const float* pwout = a.in[I_WOUT];
    for (int it = C.gw; it < N_IN + N_OUT; it += C.NGW) {
        if (it < N_IN) { const int l = it / IT_IN; transpose_item<32>(pwin + (size_t)l * DM * INW, DM, INW, (bf16*)(C.ws + WS_WIN) + (size_t)l * INWP * DM, it % IT_IN, C.lane); }
        else { const int r = it - N_IN, l = r / IT_OUT; transpose_item<64>(pwout + (size_t)l * DM * DM, DM, DM, (bf16*)(C.ws + WS_WOUT) + (size_t)l * DM * DM, r % IT_OUT, C.lane); }
    }
    for (int ch = C.gw; ch < CV_NCHUNK; ch += C.NGW) convert_moe_items(C, a, 0, ch * CV_CHUNK, ch * CV_CHUNK + CV_CHUNK);
    { const int gt = C.wg * NTHR + C.tid; constexpr int PADN = (INWP - INW) * DM / 8;
      for (int i = gt; i < 4 * PADN; i += C.G * NTHR) { const int l = i / PADN, r = i % PADN; *((u32x4*)((bf16*)(C.ws + WS_WIN) + ((size_t)l * INWP + INW) * DM) + r) = (u32x4){0u, 0u, 0u, 0u}; } }
    { float* tw = (float*)(C.ws + WS_TW); const int gt = C.wg * NTHR + C.tid;
      for (int i = gt; i < 16384; i += C.G * NTHR) { const float x = (float)i * (1.0f / 8192.0f); tw[i] = cospif(x); tw[16384 + i] = sinpif(x); } }
    { float* mt = (float*)(C.ws + WS_MTAB); const int gt = C.wg * NTHR + C.tid; const float* pbmix = a.in[I_BMIX];
      for (int i = gt; i < 4 * 4 * 64 * 64; i += C.G * NTHR) { const int e = i & 63, c = (i >> 6) & 63, g = (i >> 12) & 3, l = i >> 14;
          const float* w = pbmix + ((size_t)(l * 4 + g) * 64) * 64 + e; float sc = 0.f, ss = 0.f;
          for (int cp = 0; cp < 64; ++cp) { const float x = (float)((c * cp) & 63) * (1.0f / 32.0f); const float wv = w[cp * 64]; sc += cospif(x) * wv; ss += sinpif(x) * wv; }
          mt[((size_t)(l * 2 + 0) * 4 + g) * 4096 + c * 64 + e] = sc; mt[((size_t)(l * 2 + 1) * 4 + g) * 4096 + c * 64 + e] = ss; } }
    { bf16* ft = (bf16*)(C.ws + WS_FTAB); const int gt = C.wg * NTHR + C.tid; const float* pbmix = a.in[I_BMIX];
      for (int i = gt; i < 128 * 128; i += C.G * NTHR) { const int k = i >> 7, t = i & 127; const float x = (float)((k * t) & 127) * (1.0f / 64.0f); ft[i] = (bf16)f2bf(cospif(x)); ft[16384 + i] = (bf16)f2bf(sinpif(x)); }
      bf16* mf = ft + 32768;
      for (int i = gt; i < 4 * 4 * 16 * 64 * 8; i += C.G * NTHR) { const int j8 = i & 7, ln = (i >> 3) & 63, fr = (i >> 9) & 15, gq = (i >> 13) & 3, l = i >> 15;
          const int ei = fr >> 2, ks2 = fr & 3, e = 16 * ei + (ln & 15), g = ln >> 4, c = 32 * (ks2 & 1) + 16 * (j8 >> 2) + 4 * g + (j8 & 3), part = ks2 >> 1;
          const float* w = pbmix + ((size_t)(l * 4 + gq) * 64) * 64 + e; float s = 0.f;
          for (int cp = 0; cp < 64; ++cp) { const float x = (float)((c * cp) & 63) * (1.0f / 32.0f); s += (part ? sinpif(x) : cospif(x)) * w[cp * 64]; }
          mf[i] = (bf16)f2bf(s * (1.0f / 1024.0f)); } }
    { const int gt = C.wg * NTHR + C.tid; const float* pg2 = a.in[I_DG2]; const float* prw = a.in[I_RW]; bf16* g2t = (bf16*)(C.ws + WS_G2T); bf16* rwt = (bf16*)(C.ws + WS_RWT);
      for (int i = gt; i < 4 * 256 * 160; i += C.G * NTHR) { const int ii = i % 160, c = (i / 160) & 255, l = i / (160 * 256); g2t[i] = (bf16)f2bf(pg2[((size_t)l * 160 + ii) * 256 + c]); }
      for (int i = gt; i < 4 * 32 * 1024; i += C.G * NTHR) { const int k = i & 1023, e = (i >> 10) & 31, l = i >> 15; rwt[i] = (bf16)f2bf(prw[((size_t)l * 1024 + k) * 32 + e]); } }
    { const int gt = C.wg * NTHR + C.tid; const float* pw2 = a.in[I_DW2]; const float* pa2 = a.in[I_DA2]; bf16* lt = (bf16*)(C.ws + WS_LORAT);
      for (int i = gt; i < 4 * 4 * 256 * 64; i += C.G * NTHR) { const int ii = i & 63, c = (i >> 6) & 255, q = (i >> 14) & 3, l = i >> 16;
          const float* src = (q < 2) ? pw2 : pa2; lt[i] = (bf16)f2bf(src[(((size_t)l * 2 + (q & 1)) * 64 + ii) * 256 + c]); } }
    { bf16* f2 = (bf16*)(C.ws + WS_F256); const int gt = C.wg * NTHR + C.tid;
      for (int i = gt; i < 256 * 256; i += C.G * NTHR) { const int k = i >> 8, t = i & 255; const float x = (float)((k * t) & 255) * (1.0f / 128.0f); f2[i] = (bf16)f2bf(cospif(x)); f2[65536 + i] = (bf16)f2bf(sinpif(x)); } }
    { LAS float* red = (LAS float*)(C.lds);
      __syncthreads();
      float* mod = (float*)(C.ws + WS_MOD);
      const float* pc = a.in[I_C]; const float* pcc = a.in[I_CCTX]; const float* padaw = a.in[I_ADAW]; const float* padab = a.in[I_ADAB];
      for (int u = C.wg; u < 4 * 24; u += C.G) { const int l = u / 24, jb = u % 24, j0 = jb * 256 + 4 * C.lane;
          f32x4 s0 = {0.f, 0.f, 0.f, 0.f}, s1 = {0.f, 0.f, 0.f, 0.f};
          const float* w = padaw + (size_t)l * DM * 6144 + j0;
          for (int k = C.wave * 128; k < C.wave * 128 + 128; ++k) { const float c0 = pc[k], c1 = pcc[k]; const float a0 = c0 * sigmoidf_(c0), a1 = c1 * sigmoidf_(c1);
              const f32x4 wv = *(const f32x4*)(w + (size_t)k * 6144); s0 += wv * a0; s1 += wv * a1; }
          *(LAS f32x4*)(red + ((C.wave * 2 + 0) * 64 + C.lane) * 4) = s0; *(LAS f32x4*)(red + ((C.wave * 2 + 1) * 64 + C.lane) * 4) = s1;
          __syncthreads();
          if (C.tid < 512) { const int v = C.tid >> 8, j = C.tid & 255; float s = 0.f;
#pragma unroll
              for (int wv = 0; wv < 8; ++wv) s += red[(wv * 2 + v) * 256 + j];
              mod[(size_t)(l * 2 + v) * 6144 + jb * 256 + j] = s + padab[(size_t)l * 6144 + jb * 256 + j]; }
          __syncthreads(); } }
}

__device__ __forceinline__ void load_row(const float* p, int lane, f32x4 (&v)[4]) {
#pragma unroll
    for (int j = 0; j < 4; ++j) v[j] = *((const f32x4*)p + lane + 64 * j);
}
__device__ __forceinline__ void moe_combine_row(const Ctx& C, int row, f32x4 (&v)[4], const float* gt2) {
    const int* dest = (const int*)(C.ws + WS_ROUTE) + (size_t)3 * ROWS * 4; const float* gate = (const float*)(C.ws + WS_ROUTE) + (size_t)1 * ROWS * 4;
    const bf16* YB = (const bf16*)(C.ws + WS_XG);
    f32x4 s[4];
#pragma unroll
    for (int j = 0; j < 4; ++j) s[j] = (f32x4){0.f, 0.f, 0.f, 0.f};
#pragma unroll
    for (int k = 0; k < 4; ++k) { const int d = dest[row * 4 + k]; const float g = gate[row * 4 + k]; const u32x2* yp = (const u32x2*)(YB + (size_t)d * DM) + C.lane;
#pragma unroll
        for (int j = 0; j < 4; ++j) { const u32x2 w = yp[64 * j]; s[j] += (f32x4){bflo(w.x), bfhi(w.x), bflo(w.y), bfhi(w.y)} * g; } }
#pragma unroll
    for (int j = 0; j < 4; ++j) v[j] += *((const f32x4*)gt2 + C.lane + 64 * j) * s[j];
}
__device__ __forceinline__ float row_rstd(const f32x4 (&v)[4], int lane) {
    float s = 0.f;
#pragma unroll
    for (int j = 0; j < 4; ++j) s += (v[j].x * v[j].x + v[j].y * v[j].y) + (v[j].z * v[j].z + v[j].w * v[j].w);
    return rsqrtf(wave_sum(s, lane) * (1.f / DM) + 1e-6f);
}
__device__ __forceinline__ void phase_norm1(const Ctx& C, const DArgs& a, int l) {
    float* XS = (float*)(C.ws + WS_XS); bf16* H = (bf16*)(C.ws + WS_H); const float* mod = (const float*)(C.ws + WS_MOD);
    const float* g1 = a.in[I_N1G] + (size_t)l * DM;
    const float* pctx = a.in[I_CTX]; const float* px = a.in[I_X];
    for (int row = C.gw; row < ROWS; row += C.NGW) {
        const bool isctx = row < NCTX; f32x4 v[4];
        if (l == 0) { load_row(isctx ? pctx + (size_t)row * DM : px + (size_t)(row - NCTX) * DM, C.lane, v); }
        else { load_row(XS + (size_t)row * DM, C.lane, v);
               if (!(l == DEPTH && isctx)) moe_combine_row(C, row, v, mod + (size_t)((l - 1) * 2 + (isctx ? 1 : 0)) * 6144 + 5 * DM); }
        if (l == 0 || true) {
#pragma unroll
            for (int j = 0; j < 4; ++j) *((f32x4*)(XS + (size_t)row * DM) + C.lane + 64 * j) = v[j]; }
        const float rstd = row_rstd(v, C.lane);
        const float* md = mod + (size_t)(l * 2 + (isctx ? 1 : 0)) * 6144;
        u32x2* o = (u32x2*)(H + (size_t)row * DM) + C.lane;
#pragma unroll
        for (int j = 0; j < 4; ++j) { const f32x4 g = *((const f32x4*)g1 + C.lane + 64 * j), sh = *((const f32x4*)md + C.lane + 64 * j), sc = *((const f32x4*)(md + DM) + C.lane + 64 * j);
            const f32x4 y = v[j] * rstd * g * (sc + 1.0f) + sh; u32x2 w; w.x = pk2(y.x, y.y); w.y = pk2(y.z, y.w); o[64 * j] = w; }
    }
}
__device__ __forceinline__ void phase_final(const Ctx& C, const DArgs& a) {
    const float* XS = (const float*)(C.ws + WS_XS); const float* mod = (const float*)(C.ws + WS_MOD); const float* g = a.in[I_FNG];
    for (int row = NCTX + C.gw; row < ROWS; row += C.NGW) {
        f32x4 v[4]; load_row(XS + (size_t)row * DM, C.lane, v);
        moe_combine_row(C, row, v, mod + (size_t)((DEPTH - 1) * 2 + 0) * 6144 + 5 * DM);
        const float rstd = row_rstd(v, C.lane);
        float* o = a.out + (size_t)(row - NCTX) * DM;
#pragma unroll
        for (int j = 0; j < 4; ++j) *((f32x4*)o + C.lane + 64 * j) = v[j] * rstd * *((const f32x4*)g + C.lane + 64 * j);
    }
}
constexpr int NR2 = 9;
__device__ __forceinline__ void phase_norm2(const Ctx& C, const DArgs& a, int l) {
    const float* XS = (const float*)(C.ws + WS_XS); bf16* H = (bf16*)(C.ws + WS_H); const float* mod = (const float*)(C.ws + WS_MOD);
    const float* g2 = a.in[I_N2G] + (size_t)l * DM; const float* rb = a.in[I_RB] + (size_t)l * NEXP; const bf16* rwt = (const bf16*)(C.ws + WS_RWT) + (size_t)l * NEXP * DM;
    int* tok_e = (int*)(C.ws + WS_ROUTE); float* gate = (float*)(C.ws + WS_ROUTE) + (size_t)1 * ROWS * 4; int* slot = (int*)(C.ws + WS_ROUTE) + (size_t)2 * ROWS * 4;
    LAS float* lg = (LAS float*)(C.lds + C.wave * 4096);
    LAS int* hist = (LAS int*)(C.lds + MISC_OFF + 64);
    const int lane = C.lane, li = lane & 15, g = lane >> 4;
    if (C.tid < NEXP) hist[C.tid] = 0;
    __syncthreads();
    const int row_base = (l == DEPTH - 1) ? NCTX : 0, ntile = (ROWS - row_base + NR2 - 1) / NR2;
    for (int tl = C.gw; tl < ntile; tl += C.NGW) {
        const int trow0 = row_base + NR2 * tl, nrow = (ROWS - trow0 < NR2) ? ROWS - trow0 : NR2;
#pragma unroll 1
        for (int rr = 0; rr < nrow; ++rr) { const int row = trow0 + rr; const bool isctx = row < NCTX; f32x4 v[4]; load_row(XS + (size_t)row * DM, lane, v);
            const float rstd = row_rstd(v, lane);
            const float* md = mod + (size_t)(l * 2 + (isctx ? 1 : 0)) * 6144 + 3 * DM;
            u32x2* o = (u32x2*)(H + (size_t)row * DM) + lane;
#pragma unroll
            for (int j = 0; j < 4; ++j) { const f32x4 gg = *((const f32x4*)g2 + lane + 64 * j), sh = *((const f32x4*)md + lane + 64 * j), sc = *((const f32x4*)(md + DM) + lane + 64 * j);
                const f32x4 y = v[j] * rstd * gg * (sc + 1.0f) + sh; u32x2 w; w.x = pk2(y.x, y.y); w.y = pk2(y.z, y.w); o[64 * j] = w; } }
        asm volatile("s_waitcnt vmcnt(0)" ::: "memory");
        f32x4 acc0 = {0.f, 0.f, 0.f, 0.f}, acc1 = {0.f, 0.f, 0.f, 0.f};
        const int arow = (trow0 + li < ROWS) ? trow0 + li : ROWS - 1;
        const bf16* ap = H + (size_t)arow * DM + 8 * g; const bf16* bp0 = rwt + (size_t)li * DM + 8 * g; const bf16* bp1 = bp0 + 16 * DM;
#pragma unroll 4
        for (int ks = 0; ks < 32; ++ks) { const bf16x8 af = *(const bf16x8*)(ap + 32 * ks); acc0 = mfma16(af, *(const bf16x8*)(bp0 + 32 * ks), acc0); acc1 = mfma16(af, *(const bf16x8*)(bp1 + 32 * ks), acc1); }
#pragma unroll
        for (int r = 0; r < 4; ++r) { lg[(4 * g + r) * 33 + li] = acc0[r]; lg[(4 * g + r) * 33 + 16 + li] = acc1[r]; }
        LDS_WAIT(); asm volatile("" ::: "memory");
        const int e = lane & 31; const float rbe = rb[e];
#pragma unroll 1
        for (int rr = 0; rr < nrow; ++rr) { const int row = trow0 + rr;
            float val = lg[rr * 33 + e] + rbe; int te[4]; float tv[4];
#pragma unroll
            for (int k = 0; k < 4; ++k) { float bv = val; int bi = e;
#define AMAX_ROR(n) { const float ov = __builtin_bit_cast(float, __builtin_amdgcn_update_dpp(0, __builtin_bit_cast(int, bv), 0x120 + (n), 0xf, 0xf, false)); const int oi = __builtin_amdgcn_update_dpp(0, bi, 0x120 + (n), 0xf, 0xf, false); \
                    if (ov > bv || (ov == bv && oi < bi)) { bv = ov; bi = oi; } }
                AMAX_ROR(8) AMAX_ROR(4) AMAX_ROR(2) AMAX_ROR(1)
#undef AMAX_ROR
                { const float ov = shx(bv, 16, lane); const int oi = shxi(bi, 16, lane); if (ov > bv || (ov == bv && oi < bi)) { bv = ov; bi = oi; } }
                te[k] = bi; tv[k] = bv; if (e == bi) val = -3.0e38f; }
            if (lane == 0) { const float m = tv[0]; float p[4], ps = 0.f;
#pragma unroll
                for (int k = 0; k < 4; ++k) { p[k] = __expf(tv[k] - m); ps += p[k]; }
#pragma unroll
                for (int k = 0; k < 4; ++k) { tok_e[row * 4 + k] = te[k]; gate[row * 4 + k] = p[k] / ps; slot[row * 4 + k] = __hip_atomic_fetch_add(&hist[te[k]], 1, __ATOMIC_RELAXED, __HIP_MEMORY_SCOPE_WORKGROUP); } } }
        asm volatile("" ::: "memory");
    }
    __syncthreads();
    if (C.tid < NEXP) ((int*)(C.ws + WS_CNT))[C.wg * NEXP + C.tid] = hist[C.tid];
}
__device__ __forceinline__ int moe_tables(const Ctx& C) {
    const int* cnt = (const int*)(C.ws + WS_CNT);
    LAS int* part = (LAS int*)(C.lds);
    LAS int* pstart = (LAS int*)(C.lds + MISC_OFF + 256); LAS int* wgbase = pstart + 40; LAS int* tot = wgbase + 32; LAS int* nblk_s = tot + 32;
    LAS unsigned char* blk_e = (LAS unsigned char*)(C.lds + MISC_OFF + 1024);
    __syncthreads();
    { const int e = C.tid & 31, p = C.tid >> 5; int t = 0, pre = 0;
#pragma unroll 1
      for (int w = p * 16; w < p * 16 + 16; ++w) { const int c = cnt[w * NEXP + e]; t += c; if (w < C.wg) pre += c; }
      part[(p * 32 + e) * 2] = t; part[(p * 32 + e) * 2 + 1] = pre; }
    __syncthreads();
    if (C.tid < NEXP) { int t = 0, pre = 0;
#pragma unroll 1
        for (int p = 0; p < 16; ++p) { t += part[(p * 32 + C.tid) * 2]; pre += part[(p * 32 + C.tid) * 2 + 1]; }
        tot[C.tid] = t; wgbase[C.tid] = pre; }
    __syncthreads();
    if (C.tid == 0) { int b = 0;
#pragma unroll 1
        for (int e = 0; e < NEXP; ++e) { pstart[e] = b * 256; b += (tot[e] + 255) >> 8; }
        pstart[NEXP] = b * 256; nblk_s[0] = b; }
    __syncthreads();
    if (C.tid < NEXP) wgbase[C.tid] += pstart[C.tid];
    if (C.tid < MOE_MAXBLK) { int e = 0;
#pragma unroll 1
        for (int k = 1; k < NEXP; ++k) if (pstart[k] <= C.tid * 256) e = k;
        blk_e[C.tid] = (unsigned char)e; }
    __syncthreads();
    return __builtin_amdgcn_readfirstlane(nblk_s[0]);
}
__device__ __forceinline__ void phase_gather(const Ctx& C, const DArgs& a, int l) {
    moe_tables(C);
    const LAS int* wgbase = (const LAS int*)(C.lds + MISC_OFF + 256) + 40;
    const int* tok_e = (const int*)(C.ws + WS_ROUTE); const int* slot = (const int*)(C.ws + WS_ROUTE) + (size_t)2 * ROWS * 4; int* dest = (int*)(C.ws + WS_ROUTE) + (size_t)3 * ROWS * 4;
    const bf16* H = (const bf16*)(C.ws + WS_H); unsigned char* XG = C.ws + WS_XG8;
    const int row_base = (l == DEPTH - 1) ? NCTX : 0, ntile = (ROWS - row_base + NR2 - 1) / NR2;
    for (int tl = C.gw; tl < ntile; tl += C.NGW)
    for (int row = row_base + NR2 * tl; row < row_base + NR2 * tl + NR2 && row < ROWS; ++row) {
        const u32x4* src = (const u32x4*)(H + (size_t)row * DM) + C.lane; const u32x4 v0 = src[0], v1 = src[64];
        u32x2 q0, q1;
        { unsigned w = 0; w = __builtin_amdgcn_cvt_pk_fp8_f32(bflo(v0.x) * pg8::X8_S, bfhi(v0.x) * pg8::X8_S, w, false); w = __builtin_amdgcn_cvt_pk_fp8_f32(bflo(v0.y) * pg8::X8_S, bfhi(v0.y) * pg8::X8_S, w, true); q0.x = w;
          w = 0; w = __builtin_amdgcn_cvt_pk_fp8_f32(bflo(v0.z) * pg8::X8_S, bfhi(v0.z) * pg8::X8_S, w, false); w = __builtin_amdgcn_cvt_pk_fp8_f32(bflo(v0.w) * pg8::X8_S, bfhi(v0.w) * pg8::X8_S, w, true); q0.y = w;
          w = 0; w = __builtin_amdgcn_cvt_pk_fp8_f32(bflo(v1.x) * pg8::X8_S, bfhi(v1.x) * pg8::X8_S, w, false); w = __builtin_amdgcn_cvt_pk_fp8_f32(bflo(v1.y) * pg8::X8_S, bfhi(v1.y) * pg8::X8_S, w, true); q1.x = w;
          w = 0; w = __builtin_amdgcn_cvt_pk_fp8_f32(bflo(v1.z) * pg8::X8_S, bfhi(v1.z) * pg8::X8_S, w, false); w = __builtin_amdgcn_cvt_pk_fp8_f32(bflo(v1.w) * pg8::X8_S, bfhi(v1.w) * pg8::X8_S, w, true); q1.y = w; }
#pragma unroll
        for (int k = 0; k < 4; ++k) { const int d = wgbase[tok_e[row * 4 + k]] + slot[row * 4 + k]; if (C.lane == 0) dest[row * 4 + k] = d;
            u32x2* dp = (u32x2*)(XG + (size_t)d * DM) + C.lane; dp[0] = q0; dp[64] = q1; }
    }
}

__device__ __forceinline__ void mix1_rope(const Ctx& C) {
    bf16* P = (bf16*)(C.ws + WS_P);
    const long total = (long)SEQ * 192;
    for (long i = (long)C.wg * NTHR + C.tid; i < total; i += (long)C.G * NTHR) {
        const int j = (int)(i & 31), hh = (int)((i >> 5) % 6), t = (int)(i / 192);
        const int col = (hh < 4) ? (C_AQ + hh * 64) : (C_AK + (hh - 4) * 64);
        const float pos = (j < 16) ? (float)(t >> 6) : (float)(t & 63);
        const float inv = __powf(10000.0f, -(float)(j & 15) * (1.0f / 16.0f));
        const float ang = pos * inv * 0.31830988618379067f;
        const float cs = cospif(ang), sn = sinpif(ang);
        bf16* p = P + (size_t)(NCTX + t) * INWP + col;
        const float x1 = bf2f(p[j]), x2 = bf2f(p[j + 32]);
        p[j] = (bf16)f2bf(x1 * cs - x2 * sn); p[j + 32] = (bf16)f2bf(x2 * cs + x1 * sn);
    }
}
__device__ __forceinline__ void mix1_vt(const Ctx& C) {
    const bf16* P = (const bf16*)(C.ws + WS_P);
    LAS unsigned short* scr = (LAS unsigned short*)(C.lds + C.wave * 16384);
    for (int u = C.gw; u < (ROWS / 64) * 6; u += C.NGW) {
        const int hd = u % 6, tb = u / 6; const int vcol = (hd < 2) ? (C_AV + hd * 64) : (C_CV + (hd - 2) * 64);
        bf16* VT = ((hd < 2) ? (bf16*)(C.ws + WS_VTA) + (size_t)hd * 64 * VTP : (bf16*)(C.ws + WS_VTC) + (size_t)(hd - 2) * 64 * VTP);
#pragma unroll
        for (int i = 0; i < 8; ++i) { const int tk = (C.lane >> 3) + 8 * i, ch = C.lane & 7; const u32x4 w = *(const u32x4*)(P + (size_t)(tb * 64 + tk) * INWP + vcol + 8 * ch);
            LAS unsigned* d = (LAS unsigned*)(scr + tk * 66 + 8 * ch); d[0] = w.x; d[1] = w.y; d[2] = w.z; d[3] = w.w; }
        LDS_WAIT(); asm volatile("" ::: "memory");
#pragma unroll
        for (int k8 = 0; k8 < 8; ++k8) { unsigned w[4];
#pragma unroll
            for (int e2 = 0; e2 < 4; ++e2) { const unsigned lo = scr[(8 * k8 + 2 * e2) * 66 + C.lane], hi = scr[(8 * k8 + 2 * e2 + 1) * 66 + C.lane]; w[e2] = lo | (hi << 16); }
            *(u32x4*)(VT + (size_t)C.lane * VTP + tb * 64 + 8 * k8) = (u32x4){w[0], w[1], w[2], w[3]}; }
        LDS_WAIT(); asm volatile("" ::: "memory");
    }
    for (int i = C.wg * NTHR + C.tid; i < 6 * 64 * 32; i += C.G * NTHR) { const int rowi = i >> 5, pc = i & 31; const int hd = rowi >> 6, d = rowi & 63;
        bf16* VT = ((hd < 2) ? (bf16*)(C.ws + WS_VTA) + (size_t)hd * 64 * VTP : (bf16*)(C.ws + WS_VTC) + (size_t)(hd - 2) * 64 * VTP);
        *(u32x4*)(VT + (size_t)d * VTP + ROWS + 8 * pc) = (u32x4){0u, 0u, 0u, 0u}; }
}
__device__ __forceinline__ float conv3(const bf16* P, int row, int col, const float* cw, int cc) {
    const bool first = (row == 0) || (row == NCTX), last = (row == NCTX - 1) || (row == ROWS - 1);
    float s = cw[768 + cc] * bf2f(P[(size_t)row * INWP + col]);
    if (!first) s += cw[cc] * bf2f(P[(size_t)(row - 1) * INWP + col]);
    if (!last) s += cw[2 * 768 + cc] * bf2f(P[(size_t)(row + 1) * INWP + col]);
    return s;
}
__device__ __forceinline__ void mix1_rwkv_prep(const Ctx& C, const DArgs& a, int l) {
    const bf16* P = (const bf16*)(C.ws + WS_P); float* SC = (float*)(C.ws + WS_SC);
    constexpr int LBP = 264;
    LAS unsigned char* lob = C.lds;
    LAS float* pre = (LAS float*)(C.lds + 16384);
    const bf16* lorat = (const bf16*)(C.ws + WS_LORAT) + (size_t)l * 4 * 256 * 64;
    const float* cw = a.in[I_DCONV] + (size_t)l * 3 * 768;
    const float* w0 = a.in[I_DW0] + (size_t)l * 512; const float* a0 = a.in[I_DA0] + (size_t)l * 512;
    const float* kkw = a.in[I_DKK] + (size_t)l * 256; const float* kaw = a.in[I_DKA] + (size_t)l * 256;
    const int half = C.tid >> 8, c = C.tid & 255, lane = C.lane, li = lane & 15, g = lane >> 4;
    const float kkc = kkw[c], kac = kaw[c];
    for (int grp = C.wg; grp < ROWS / 13; grp += C.G) {
        const int row0 = 13 * grp + 7 * half, nj = 7 - half;
        __syncthreads();
#pragma unroll
        for (int j = 0; j < 7; ++j) if (j < nj) { const float x = bf2f(P[(size_t)(row0 + j) * INWP + C_WL + c]); *(LAS bf16*)(lob + ((7 * half + j) * LBP + c) * 2) = (bf16)f2bf((c < 128) ? tanhf(x) : x); }
        __syncthreads();
#pragma unroll
        for (int q = 0; q < 4; ++q) { const bf16x8 a0f = ldA(lob, LBP, 0, 64 * q, li, g), a1f = ldA(lob, LBP, 0, 64 * q + 32, li, g);
#pragma unroll
            for (int c2 = 0; c2 < 2; ++c2) { const int ci = 2 * C.wave + c2; const bf16* bp = lorat + ((size_t)q * 256 + 16 * ci + li) * 64 + 8 * g;
                f32x4 acc = {0.f, 0.f, 0.f, 0.f}; acc = mfma16(a0f, ldg8(bp), acc); acc = mfma16(a1f, ldg8(bp + 32), acc);
#pragma unroll
                for (int r = 0; r < 4; ++r) pre[(q * 16 + 4 * g + r) * 256 + 16 * ci + li] = acc[r]; } }
        __syncthreads();
#pragma unroll
        for (int j = 0; j < 7; ++j) if (j < nj) { const int row = row0 + j, rl = 7 * half + j; const float r = conv3(P, row, C_DR + c, cw, c), k = conv3(P, row, C_DK + c, cw, 256 + c), v = conv3(P, row, C_DV + c, cw, 512 + c);
            float kk = k * kkc; const float n2 = wave_sum(kk * kk, lane); kk *= rsqrtf(fmaxf(n2, 1e-24f));
            float* sc = SC + (size_t)row * 9 * 256; sc[c] = r; sc[256 + c] = v; sc[512 + c] = -kk;
#pragma unroll
            for (int d = 0; d < 2; ++d) { const float wp = w0[d * 256 + c] + pre[(d * 16 + rl) * 256 + c], ap = a0[d * 256 + c] + pre[((2 + d) * 16 + rl) * 256 + c];
                const float nw = -wp, sp = fmaxf(nw, 0.f) + log1pf(__expf(-fabsf(nw)));
                const float lw = -__expf(-sp - 0.5f);
                const float as = sigmoidf_(ap);
                sc[(3 + 3 * d) * 256 + c] = lw; sc[(4 + 3 * d) * 256 + c] = k * (1.0f + (as - 1.0f) * kac); sc[(5 + 3 * d) * 256 + c] = kk * as; } }
    }
    __syncthreads();
}
constexpr int FP = 136;
constexpr int F_TABC = 0, F_TABS = 128 * FP * 2, F_TILE = 2 * 128 * FP * 2;
__device__ __forceinline__ void fourier_load_tables(const Ctx& C) {
    const bf16* ft = (const bf16*)(C.ws + WS_FTAB);
    for (int i = C.tid; i < 2 * 128 * 16; i += NTHR) { const int tb = i >> 11, r = (i >> 4) & 127, c8 = i & 15;
        *(LAS u32x4*)(C.lds + tb * F_TABS + (r * FP + 8 * c8) * 2) = *(const u32x4*)(ft + tb * 16384 + r * 128 + 8 * c8); }
}
__device__ __forceinline__ void mix1_fourier1(const Ctx& C) {
    const bf16* P = (const bf16*)(C.ws + WS_P); const float* tw = (const float*)(C.ws + WS_TW);
    bf16* FYR = (bf16*)(C.ws + WS_FYR); bf16* FYI = (bf16*)(C.ws + WS_FYI);
    const int lane = C.lane, li = lane & 15, g = lane >> 4, w = C.wave;
    __syncthreads();
    fourier_load_tables(C);
    for (int u = C.wg; u < 256; u += C.G) {
        const int t2 = u >> 1, ch0 = (u & 1) * 128;
        __syncthreads();
        for (int i = C.tid; i < 128 * 16; i += NTHR) { const int t1 = i >> 4, c8 = i & 15;
            *(LAS u32x4*)(C.lds + F_TILE + (t1 * FP + 8 * c8) * 2) = *(const u32x4*)(P + (size_t)(NCTX + 128 * t1 + t2) * INWP + C_BU + ch0 + 8 * c8); }
        __syncthreads();
        bf16x8 af[4];
#pragma unroll
        for (int ks = 0; ks < 4; ++ks) af[ks] = ldT(C.lds + F_TILE, FP, 32 * ks, 16 * w, li, g);
#pragma unroll 1
        for (int ni = 0; ni < 8; ++ni) { f32x4 dc = {0.f, 0.f, 0.f, 0.f}, ds = {0.f, 0.f, 0.f, 0.f};
#pragma unroll
            for (int ks = 0; ks < 4; ++ks) { dc = mfma16(af[ks], ldA(C.lds + F_TABC, FP, 16 * ni, 32 * ks, li, g), dc); ds = mfma16(af[ks], ldA(C.lds + F_TABS, FP, 16 * ni, 32 * ks, li, g), ds); }
            const int k1 = 16 * ni + li; const float cp = tw[t2 * k1], sp = tw[16384 + t2 * k1];
            const f32x4 yr = dc * cp - ds * sp, yi = -(ds * cp) - dc * sp;
            const size_t o = ((size_t)k1 * 128 + t2) * 256 + ch0 + 16 * w + 4 * g;
            u32x2 wr; wr.x = pk2(yr[0], yr[1]); wr.y = pk2(yr[2], yr[3]); *(u32x2*)(FYR + o) = wr;
            u32x2 wi; wi.x = pk2(yi[0], yi[1]); wi.y = pk2(yi[2], yi[3]); *(u32x2*)(FYI + o) = wi; }
    }
    __syncthreads();
}
__device__ __forceinline__ void fourier2_mfma(const Ctx& C, int l, int wg0) {
    const bf16* FYR = (const bf16*)(C.ws + WS_FYR); const bf16* FYI = (const bf16*)(C.ws + WS_FYI); bf16* MIX = (bf16*)(C.ws + WS_MIX);
    const int lane = C.lane, li = lane & 15, g = lane >> 4, w = C.wave;
    constexpr int YP = 72, F_YR = F_TILE, F_YI = F_TILE + 128 * YP * 2;
    __syncthreads();
    fourier_load_tables(C);
    for (int u = C.wg - wg0; u < 512; u += C.G - wg0) {
        const int k1 = u >> 2, gq = u & 3;
        __syncthreads();
        for (int i = C.tid; i < 2 * 128 * 8; i += NTHR) { const int im = i >> 10, t2 = (i >> 3) & 127, c8 = i & 7;
            *(LAS u32x4*)(C.lds + (im ? F_YI : F_YR) + (t2 * YP + 8 * c8) * 2) = *(const u32x4*)((im ? FYI : FYR) + ((size_t)k1 * 128 + t2) * 256 + gq * 64 + 8 * c8); }
        __syncthreads();
        bf16x8 bc[4], bs[4];
#pragma unroll
        for (int ks = 0; ks < 4; ++ks) { bc[ks] = ldA(C.lds + F_TABC, FP, 16 * w, 32 * ks, li, g); bs[ks] = ldA(C.lds + F_TABS, FP, 16 * w, 32 * ks, li, g); }
        f32x4 xr[4], xi[4];
#pragma unroll
        for (int ci = 0; ci < 4; ++ci) { xr[ci] = (f32x4){0.f, 0.f, 0.f, 0.f}; f32x4 xs = {0.f, 0.f, 0.f, 0.f}; xi[ci] = xs;
#pragma unroll
            for (int ks = 0; ks < 4; ++ks) { const bf16x8 ar = ldT(C.lds + F_YR, YP, 32 * ks, 16 * ci, li, g), ai = ldT(C.lds + F_YI, YP, 32 * ks, 16 * ci, li, g);
                xr[ci] = mfma16(ar, bc[ks], xr[ci]); xr[ci] = mfma16(ai, bs[ks], xr[ci]);
                xi[ci] = mfma16(ai, bc[ks], xi[ci]); xs = mfma16(ar, bs[ks], xs); }
            xi[ci] = xi[ci] - xs; }
        union { bf16x8 v; unsigned q[4]; } xb[4];
#pragma unroll
        for (int q2 = 0; q2 < 2; ++q2) { xb[q2].q[0] = pk2(xr[2 * q2][0], xr[2 * q2][1]); xb[q2].q[1] = pk2(xr[2 * q2][2], xr[2 * q2][3]); xb[q2].q[2] = pk2(xr[2 * q2 + 1][0], xr[2 * q2 + 1][1]); xb[q2].q[3] = pk2(xr[2 * q2 + 1][2], xr[2 * q2 + 1][3]);
            xb[2 + q2].q[0] = pk2(xi[2 * q2][0], xi[2 * q2][1]); xb[2 + q2].q[1] = pk2(xi[2 * q2][2], xi[2 * q2][3]); xb[2 + q2].q[2] = pk2(xi[2 * q2 + 1][0], xi[2 * q2 + 1][1]); xb[2 + q2].q[3] = pk2(xi[2 * q2 + 1][2], xi[2 * q2 + 1][3]); }
        const bf16x8* mf = (const bf16x8*)((const bf16*)(C.ws + WS_FTAB) + 32768) + (size_t)(l * 4 + gq) * 16 * 64;
#pragma unroll
        for (int ei = 0; ei < 4; ++ei) { f32x4 o = {0.f, 0.f, 0.f, 0.f};
#pragma unroll
            for (int ks2 = 0; ks2 < 4; ++ks2) o = mfma16(mf[(ei * 4 + ks2) * 64 + lane], xb[ks2].v, o);
            const int tp = k1 + 128 * (16 * w + li);
            u32x2 wo; wo.x = pk2(o[0], o[1]); wo.y = pk2(o[2], o[3]); *(u32x2*)(MIX + (size_t)(NCTX + tp) * DM + 256 + gq * 64 + 16 * ei + 4 * g) = wo; }
    }
    __syncthreads();
}

constexpr float LOG2E = 1.4426950408889634f;
typedef short bf16x4 __attribute__((ext_vector_type(4)));
__device__ __forceinline__ void attn_load(const bf16* P, const bf16* VT, int krow, int kcol, int li, int g, bf16x8 (&kf)[2][2], bf16x8 (&vf)[4]) {
#pragma unroll
    for (int t = 0; t < 2; ++t)
#pragma unroll
        for (int ks = 0; ks < 2; ++ks) kf[t][ks] = ldg8(P + (size_t)(krow + 16 * t + li) * INWP + kcol + 32 * ks + 8 * g);
#pragma unroll
    for (int dt = 0; dt < 4; ++dt) { const bf16* vp = VT + (size_t)(dt * 16 + li) * VTP + krow + 4 * g;
        const bf16x4 a = *(const bf16x4*)vp, b = *(const bf16x4*)(vp + 16); vf[dt] = (bf16x8){a[0], a[1], a[2], a[3], b[0], b[1], b[2], b[3]}; }
}
template <int NS, int NT>
__device__ __forceinline__ void attn_compute(const bf16x8 (&kf)[2][2], const bf16x8 (&vf)[4], const bf16x8 (&qf)[NS][2], f32x4 (&o)[NS][4], float (&m)[NS], float (&ls)[NS],
                                             const float (&add)[NT][2][4], int li, int g) {
#pragma unroll
    for (int hh = 0; hh < NS; ++hh) {
        f32x4 st[2];
#pragma unroll
        for (int t = 0; t < 2; ++t) { st[t] = (f32x4){0.f, 0.f, 0.f, 0.f};
#pragma unroll
            for (int ks = 0; ks < 2; ++ks) st[t] = __builtin_amdgcn_mfma_f32_16x16x32_bf16(kf[t][ks], qf[hh][ks], st[t], 0, 0, 0); }
        float s[8]; float bm = -INFINITY;
#pragma unroll
        for (int t = 0; t < 2; ++t)
#pragma unroll
            for (int r = 0; r < 4; ++r) { const float ad = add[hh / (NS / NT)][t][r]; s[4 * t + r] = (ad == -INFINITY) ? -INFINITY : st[t][r] * (0.125f * LOG2E) + ad; bm = fmaxf(bm, s[4 * t + r]); }
        bm = fmaxf(bm, shx(bm, 16, 16 * g + li)); bm = fmaxf(bm, shx(bm, 32, 16 * g + li));
        const float mn = fmaxf(m[hh], bm), corr = __builtin_amdgcn_exp2f(m[hh] - mn); m[hh] = mn;
        float ps = 0.f; float pe[8];
#pragma unroll
        for (int e = 0; e < 8; ++e) { pe[e] = __builtin_amdgcn_exp2f(s[e] - mn); ps += pe[e]; }
        ls[hh] = ls[hh] * corr + ps;
        union { bf16x8 v; unsigned u[4]; } pf;
#pragma unroll
        for (int e2 = 0; e2 < 4; ++e2) pf.u[e2] = pk2(pe[2 * e2], pe[2 * e2 + 1]);
#pragma unroll
        for (int dt = 0; dt < 4; ++dt) { o[hh][dt] = o[hh][dt] * corr; o[hh][dt] = __builtin_amdgcn_mfma_f32_16x16x32_bf16(vf[dt], pf.v, o[hh][dt], 0, 0, 0); }
    }
}
__device__ __forceinline__ void attn_finish1(bf16* MIX, int qrow0, int ocol, f32x4 (&o)[4], float m, float ls, bool has_sink, float sink2, int li, int g) {
    float l = ls; l += shx(l, 16, 16 * g + li); l += shx(l, 32, 16 * g + li);
    float corr = 1.f;
    if (has_sink) { const float mn = fmaxf(m, sink2); corr = __builtin_amdgcn_exp2f(m - mn); l = l * corr + __builtin_amdgcn_exp2f(sink2 - mn); }
    const float inv = corr / l;
#pragma unroll
    for (int dt = 0; dt < 4; ++dt) { const f32x4 v = o[dt] * inv; u32x2 w; w.x = pk2(v[0], v[1]); w.y = pk2(v[2], v[3]);
        *(u32x2*)(MIX + (size_t)(qrow0 + li) * DM + ocol + dt * 16 + 4 * g) = w; }
}
__device__ __forceinline__ void attnA_unit(const Ctx& C, const float* asink_l, int unit, bool lat) {
    const bf16* P = (const bf16*)(C.ws + WS_P); bf16* MIX = (bf16*)(C.ws + WS_MIX);
    const int li = C.lane & 15, g = C.lane >> 4;
    const int nqp = lat ? SEQ / 32 : NCTX / 32, kvh = unit / nqp, qp = unit % nqp, t0 = qp * 32, qrow0 = (lat ? NCTX : 0) + t0;
    const bf16* VT = (const bf16*)(C.ws + WS_VTA) + (size_t)kvh * 64 * VTP; const int kcol = C_AK + kvh * 64;
    bf16x8 qf[4][2];
#pragma unroll
    for (int s = 0; s < 4; ++s)
#pragma unroll
        for (int ks = 0; ks < 2; ++ks) qf[s][ks] = ldg8(P + (size_t)(qrow0 + 16 * (s >> 1) + li) * INWP + C_AQ + (kvh * 2 + (s & 1)) * 64 + 32 * ks + 8 * g);
    f32x4 o[4][4]; float m[4], ls[4];
#pragma unroll
    for (int s = 0; s < 4; ++s) { m[s] = -1.0e30f; ls[s] = 0.f;
#pragma unroll
        for (int dt = 0; dt < 4; ++dt) o[s][dt] = (f32x4){0.f, 0.f, 0.f, 0.f}; }
    const int b_lo = lat ? 0 : 9;
#pragma unroll 1
    for (int bb = b_lo; bb < 17; ++bb) { float add[2][2][4]; bf16x8 kf[2][2], vf[4];
        const int krow = (bb < 9) ? NCTX + t0 - 128 + 32 * bb : 32 * (bb - 9);
        attn_load(P, VT, krow, kcol, li, g, kf, vf);
#pragma unroll
        for (int tl = 0; tl < 2; ++tl)
#pragma unroll
            for (int tt = 0; tt < 2; ++tt)
#pragma unroll
                for (int r = 0; r < 4; ++r) { const int j = t0 - 128 + 32 * bb + 16 * tt + 4 * g + r, t = t0 + 16 * tl + li;
                    const bool ok = (bb >= 9) || ((j >= 0) && (j < SEQ) && (j - t <= 128) && (t - j <= 128)); add[tl][tt][r] = ok ? 0.f : -INFINITY; }
        attn_compute<4, 2>(kf, vf, qf, o, m, ls, add, li, g); }
#pragma unroll
    for (int s = 0; s < 4; ++s) attn_finish1(MIX, qrow0 + 16 * (s >> 1), (kvh * 2 + (s & 1)) * 64, o[s], m[s], ls[s], true, asink_l[kvh * 2 + (s & 1)] * LOG2E, li, g);
}
__device__ __forceinline__ void attnC_unit(const Ctx& C, const LAS float* relb, int h, int up, bool lat) {
    const bf16* P = (const bf16*)(C.ws + WS_P); bf16* MIX = (bf16*)(C.ws + WS_MIX);
    const int li = C.lane & 15, g = C.lane >> 4;
    const int rp = up >> 2, cj = up & 3;
    const int t0a = lat ? (2 * rp) * 64 + 16 * cj : 32 * up, tstep = lat ? 64 : 16, qbase = lat ? NCTX : 0;
    const bf16* VT = (const bf16*)(C.ws + WS_VTC) + (size_t)h * 64 * VTP; const int kcol = C_CK + h * 64;
    bf16x8 qf[2][2];
#pragma unroll
    for (int s = 0; s < 2; ++s)
#pragma unroll
        for (int ks = 0; ks < 2; ++ks) qf[s][ks] = ldg8(P + (size_t)(qbase + t0a + tstep * s + li) * INWP + C_CQ + h * 64 + 32 * ks + 8 * g);
    f32x4 o[2][4]; float m[2] = {-1.0e30f, -1.0e30f}, ls[2] = {0.f, 0.f};
#pragma unroll
    for (int s = 0; s < 2; ++s)
#pragma unroll
        for (int dt = 0; dt < 4; ++dt) o[s][dt] = (f32x4){0.f, 0.f, 0.f, 0.f};
    const int r = 2 * rp, cq = cj * 16 + li;
    int r0a = r - 4; r0a = r0a < 0 ? 0 : (r0a > 248 ? 248 : r0a); int r0b = r - 3; r0b = r0b < 0 ? 0 : (r0b > 248 ? 248 : r0b);
    int c0 = cq - 8; c0 = c0 < 0 ? 0 : (c0 > 48 ? 48 : c0);
    const int cw0 = (cj == 0) ? 0 : (cj == 1) ? 8 : (cj == 2) ? 24 : 32;
    const int b_lo = lat ? 0 : 9;
#pragma unroll 1
    for (int bb = b_lo; bb < 17; ++bb) { float add[2][2][4]; bf16x8 kf[2][2], vf[4];
        const int kr = r0a + bb;
        if (bb < 9 && kr >= r0b + 8) continue;
        const int krow = (bb < 9) ? NCTX + kr * 64 + cw0 : 32 * (bb - 9);
        attn_load(P, VT, krow, kcol, li, g, kf, vf);
#pragma unroll
        for (int tl = 0; tl < 2; ++tl) { const int r0t = tl ? r0b : r0a, rt = r + tl; const bool rowok = (bb >= 9) || (kr >= r0t && kr < r0t + 8);
            int bi = kr - rt + 7; bi = bi < 0 ? 0 : (bi > 14 ? 14 : bi); const LAS float* rbp = relb + bi * 31;
#pragma unroll
            for (int tt = 0; tt < 2; ++tt)
#pragma unroll
                for (int rr = 0; rr < 4; ++rr) { const int kc = cw0 + 16 * tt + 4 * g + rr; int ci = kc - cq + 15; ci = ci < 0 ? 0 : (ci > 30 ? 30 : ci); const float bv = rbp[ci];
                    add[tl][tt][rr] = (bb >= 9) ? 0.f : ((rowok && kc >= c0 && kc < c0 + 16) ? bv : -INFINITY); } }
        attn_compute<2, 2>(kf, vf, qf, o, m, ls, add, li, g); }
#pragma unroll
    for (int s = 0; s < 2; ++s) attn_finish1(MIX, qbase + t0a + tstep * s, 512 + h * 64, o[s], m[s], ls[s], false, 0.f, li, g);
}
__device__ __forceinline__ void fourier_ctx_mfma(const Ctx& C, int l, int wg0) {
    const bf16* P = (const bf16*)(C.ws + WS_P); bf16* MIX = (bf16*)(C.ws + WS_MIX); const bf16* f2 = (const bf16*)(C.ws + WS_F256);
    const int lane = C.lane, li = lane & 15, g = lane >> 4, w = C.wave;
    constexpr int UP = 72;
    for (int u = C.wg - wg0; u < 8; u += C.G - wg0) {
        const int tb = u >> 2, gq = u & 3;
        __syncthreads();
        for (int i = C.tid; i < 256 * 8; i += NTHR) { const int t = i >> 3, c8 = i & 7; *(LAS u32x4*)(C.lds + (t * UP + 8 * c8) * 2) = *(const u32x4*)(P + (size_t)t * INWP + C_BU + gq * 64 + 8 * c8); }
        __syncthreads();
        const int tp0 = 128 * tb + 16 * w;
        f32x4 xr[4], xi[4];
#pragma unroll
        for (int ci = 0; ci < 4; ++ci) { xr[ci] = (f32x4){0.f, 0.f, 0.f, 0.f}; xi[ci] = (f32x4){0.f, 0.f, 0.f, 0.f}; }
#pragma unroll 2
        for (int ks = 0; ks < 8; ++ks) { const bf16x8 bc = ldg8(f2 + (size_t)(tp0 + li) * 256 + 32 * ks + 8 * g), bs = ldg8(f2 + 65536 + (size_t)(tp0 + li) * 256 + 32 * ks + 8 * g);
#pragma unroll
            for (int ci = 0; ci < 4; ++ci) { const bf16x8 au = ldT(C.lds, UP, 32 * ks, 16 * ci, li, g); xr[ci] = mfma16(au, bc, xr[ci]); xi[ci] = mfma16(au, bs, xi[ci]); } }
        union { bf16x8 v; unsigned q[4]; } xb[4];
#pragma unroll
        for (int q2 = 0; q2 < 2; ++q2) { xb[q2].q[0] = pk2(xr[2 * q2][0], xr[2 * q2][1]); xb[q2].q[1] = pk2(xr[2 * q2][2], xr[2 * q2][3]); xb[q2].q[2] = pk2(xr[2 * q2 + 1][0], xr[2 * q2 + 1][1]); xb[q2].q[3] = pk2(xr[2 * q2 + 1][2], xr[2 * q2 + 1][3]);
            xb[2 + q2].q[0] = pk2(-xi[2 * q2][0], -xi[2 * q2][1]); xb[2 + q2].q[1] = pk2(-xi[2 * q2][2], -xi[2 * q2][3]); xb[2 + q2].q[2] = pk2(-xi[2 * q2 + 1][0], -xi[2 * q2 + 1][1]); xb[2 + q2].q[3] = pk2(-xi[2 * q2 + 1][2], -xi[2 * q2 + 1][3]); }
        const bf16x8* mf = (const bf16x8*)((const bf16*)(C.ws + WS_FTAB) + 32768) + (size_t)(l * 4 + gq) * 16 * 64;
#pragma unroll
        for (int ei = 0; ei < 4; ++ei) { f32x4 o = {0.f, 0.f, 0.f, 0.f};
#pragma unroll
            for (int ks2 = 0; ks2 < 4; ++ks2) o = mfma16(mf[(ei * 4 + ks2) * 64 + lane], xb[ks2].v, o);
            o = o * 8.0f;
            u32x2 wo; wo.x = pk2(o[0], o[1]); wo.y = pk2(o[2], o[3]); *(u32x2*)(MIX + (size_t)(tp0 + li) * DM + 256 + gq * 64 + 16 * ei + 4 * g) = wo; }
    }
    __syncthreads();
}
__device__ __forceinline__ void fourier2_unit(const Ctx& C, int l, int u, bool ctx) {
    const bf16* P = (const bf16*)(C.ws + WS_P); const float* tw = (const float*)(C.ws + WS_TW); bf16* MIX = (bf16*)(C.ws + WS_MIX);
    const float* FYR = (const float*)(C.ws + WS_FYR); const float* FYI = (const float*)(C.ws + WS_FYI);
    const float* mt = (const float*)(C.ws + WS_MTAB) + (size_t)l * 2 * 4 * 4096;
    LAS float* xr = (LAS float*)(C.lds + 8192); LAS float* xi = xr + 512;
    const int tl = C.tid >> 8, ch = C.tid & 255, tp = 2 * u + tl;
    float sr = 0.f, si = 0.f;
    if (!ctx) { const int k1 = tp & 127, k2 = tp >> 7; const float* yr = FYR + (size_t)k1 * 128 * 256 + ch; const float* yi = FYI + (size_t)k1 * 128 * 256 + ch;
#pragma unroll 8
        for (int t2 = 0; t2 < 128; ++t2) { const int m = ((t2 * k2) & 127) * 128; const float c = tw[m], s = tw[16384 + m]; const float a = yr[t2 * 256], b = yi[t2 * 256]; sr += a * c + b * s; si += b * c - a * s; } }
    else {
#pragma unroll 8
        for (int t = 0; t < NCTX; ++t) { const int m = ((t * tp) & 255) * 64; const float x = bf2f(P[(size_t)t * INWP + C_BU + ch]); sr += x * tw[m]; si -= x * tw[16384 + m]; } }
    __syncthreads();
    xr[tl * 256 + ch] = sr; xi[tl * 256 + ch] = si;
    __syncthreads();
    const int g = ch >> 6, e = ch & 63; const float* mc = mt + (size_t)(0 * 4 + g) * 4096 + e; const float* ms = mt + (size_t)(1 * 4 + g) * 4096 + e;
    const LAS float* xrp = xr + tl * 256 + g * 64; const LAS float* xip = xi + tl * 256 + g * 64; float o = 0.f;
#pragma unroll 8
    for (int c = 0; c < 64; ++c) o += xrp[c] * mc[c * 64] + xip[c] * ms[c * 64];
    o *= ctx ? (1.0f / 128.0f) : (1.0f / 1024.0f);
    MIX[(size_t)((ctx ? 0 : NCTX) + tp) * DM + 256 + ch] = (bf16)f2bf(o);
}
__device__ __forceinline__ void rwkv_passB(const Ctx& C, int b);
__device__ __forceinline__ void phase_mix2(const Ctx& C, const DArgs& a, int l) {
    const bool emit_ctx = l < DEPTH - 1;
#ifndef REPMASK
#define REPMASK 0
#endif
#define NREP2(o) ((((REPMASK) >> (o)) & 1) ? 2 : 1)
    if (C.wg < 8) { for (int r2 = 0; r2 < NREP2(16); ++r2) rwkv_passB(C, C.wg); }
    else if (emit_ctx) fourier_ctx_mfma(C, l, 8);
    { const float* asink_l = a.in[I_ASINK] + l * 4; const float* crel = a.in[I_CREL] + (size_t)l * 4 * 465;
      LAS float* relb = (LAS float*)(C.lds + 110592 + C.wave * 2048);
      for (int r2 = 0; r2 < NREP2(17); ++r2) {
      unsigned* qhead = (unsigned*)(C.ws + WS_CTL) + CW_WQ + 64 * l + 16 * r2;
      const int nA = 2 * (SEQ / 32), nC = 4 * (SEQ / 32), nAc = emit_ctx ? 2 * (NCTX / 32) : 0, nCc = emit_ctx ? 4 * (NCTX / 32) : 0, nAll = nA + nAc + nC + nCc;
      int hcur = -1;
      const int nCv = emit_ctx ? CV_NCHUNK : 0;
      for (;;) { unsigned uq = 0; if (C.lane == 0) uq = __hip_atomic_fetch_add(qhead, 1u, __ATOMIC_RELAXED, __HIP_MEMORY_SCOPE_AGENT);
          const int uraw = __builtin_amdgcn_readfirstlane((int)uq); if (uraw >= nAll + nCv) break;
          int u;
          if (uraw < 2 * nCv) { if (uraw & 1) { const int ch = uraw >> 1; convert_moe_items(C, a, l + 1, ch * CV_CHUNK, ch * CV_CHUNK + CV_CHUNK); continue; } u = uraw >> 1; }
          else u = uraw - nCv;
          if (u < nA) attnA_unit(C, asink_l, u, true);
          else if (u < nA + nAc) attnA_unit(C, asink_l, u - nA, false);
          else { const int uc = u - nA - nAc; const bool lat = uc < nC; const int uu = lat ? uc : uc - nC, nqt = lat ? SEQ / 32 : NCTX / 32, h = uu / nqt, qt = uu % nqt;
              if (h != hcur) { for (int i = C.lane; i < 465; i += 64) relb[i] = crel[h * 465 + i] * LOG2E; hcur = h; LDS_WAIT(); asm volatile("" ::: "memory"); }
              attnC_unit(C, relb, h, qt, lat); } } } }
    __syncthreads();
    for (int r2 = 0; r2 < NREP2(19); ++r2) fourier2_mfma(C, l, 0);
}

constexpr int RW_C = 32, RW_NCH = ROWS / RW_C, RW_SC = 20, RW_NSC = RW_NCH / RW_SC;
constexpr int RW_SLOT = 5120, RW_REGION = 9 * RW_SLOT + 1024;
constexpr int TP = 72, HP = 40;
static_assert(3 * RW_REGION <= MISC_OFF, "RWKV D1 regions below the misc area");
__device__ __forceinline__ int rw_rc_of(int d, int c) { return d == 0 ? c : (c < 8 ? 7 - c : 527 - c); }
__device__ __forceinline__ int rw_row_of(int d, int rc, int t) { return 32 * rc + (d == 0 ? t : 31 - t); }

__device__ __forceinline__ void rwkv_d1(const Ctx& C, LAS unsigned char* rb, int d, int h, int rc) {
    int lane_ = C.lane; asm volatile("" : "+v"(lane_));
    const int lane = lane_, li = lane & 15, g = lane >> 4;
    const float* SC = (const float*)(C.ws + WS_SC);
    LAS unsigned char* S0 = rb; LAS unsigned char* S1 = rb + RW_SLOT; LAS unsigned char* S2 = rb + 2 * RW_SLOT; LAS unsigned char* S3 = rb + 3 * RW_SLOT; LAS unsigned char* S4 = rb + 4 * RW_SLOT;
    LAS unsigned char* S5 = rb + 5 * RW_SLOT; LAS unsigned char* S6 = rb + 6 * RW_SLOT; LAS unsigned char* S7 = rb + 7 * RW_SLOT; LAS unsigned char* S8 = rb + 8 * RW_SLOT;
    LAS unsigned char* S6b = S6 + 2560; LAS unsigned char* S7b = S7 + 2560;
    LAS float* gc = (LAS float*)(rb + 9 * RW_SLOT);
    { float cum = 0.f; const int j = lane; const int qw = (3 + 3 * d) * 256;
#pragma unroll 1
      for (int t0 = 0; t0 < 32; t0 += 4) { float rv[4], vv[4], av[4], lw[4], kd[4], bb[4];
#pragma unroll
          for (int u = 0; u < 4; ++u) { const float* sc = SC + (size_t)rw_row_of(d, rc, t0 + u) * 9 * 256 + h * 64 + j;
              rv[u] = sc[0]; vv[u] = sc[256]; av[u] = sc[512]; lw[u] = sc[qw]; kd[u] = sc[qw + 256]; bb[u] = sc[qw + 512]; }
#pragma unroll
          for (int u = 0; u < 4; ++u) { const float cp = cum; cum += lw[u]; const float Gt = __expf(cum), Gm = __expf(cp), iG = __expf(-cum); const int off = ((t0 + u) * TP + j) * 2;
              *(LAS bf16*)(S0 + off) = (bf16)f2bf(av[u] * Gm); *(LAS bf16*)(S1 + off) = (bf16)f2bf(rv[u] * Gt); *(LAS bf16*)(S2 + off) = (bf16)f2bf(bb[u] * iG);
              *(LAS bf16*)(S3 + off) = (bf16)f2bf(kd[u] * iG); *(LAS bf16*)(S4 + off) = (bf16)f2bf(vv[u]); } }
      gc[j] = __expf(cum); }
    const f32x4 z4 = {0.f, 0.f, 0.f, 0.f};
#pragma unroll 1
    for (int ti = 0; ti < 2; ++ti)
#pragma unroll 1
        for (int si = 0; si < 2; ++si) {
            f32x4 n = z4, nt = z4, mk = z4, qb = z4, qk = z4;
#pragma unroll
            for (int ks = 0; ks < 2; ++ks) { const bf16x8 at = ldA(S0, TP, 16 * ti, 32 * ks, li, g), rt = ldA(S1, TP, 16 * ti, 32 * ks, li, g), bs = ldA(S2, TP, 16 * si, 32 * ks, li, g), kss = ldA(S3, TP, 16 * si, 32 * ks, li, g);
                n = mfma16(at, bs, n);
                nt = mfma16(bs, at, nt);
                mk = mfma16(kss, at, mk);
                qb = mfma16(bs, rt, qb);
                qk = mfma16(kss, rt, qk); }
#pragma unroll
            for (int r = 0; r < 4; ++r) { const int trow = 16 * ti + 4 * g + r, scol = 16 * si + li; if (!(scol < trow)) n[r] = 0.f;
                const int srow = 16 * si + 4 * g + r, tcol = 16 * ti + li; if (!(srow < tcol)) { mk[r] = 0.f; nt[r] = 0.f; } if (!(srow <= tcol)) { qb[r] = 0.f; qk[r] = 0.f; } }
            *(LAS f32x4*)(S5 + ((16 * si + li) * 32 + 16 * ti + 4 * g) * 4) = n;
            stT(S6, HP, 16 * ti + li, 16 * si + 4 * g, mk);
            stT(S8, HP, 16 * ti + li, 16 * si + 4 * g, nt);
            stT(S6b, HP, 16 * ti + li, 16 * si + 4 * g, qb);
            stT(S7, HP, 16 * ti + li, 16 * si + 4 * g, qk); }
    { const int rr = lane & 31, bq = rr >> 4, lr = rr & 15; float Tr[16];
#pragma unroll
      for (int s = 15; s >= 0; --s) { float acc = (lr == s) ? 1.f : 0.f;
#pragma unroll
          for (int c4 = 0; c4 < 4; ++c4) { if (4 * c4 + 3 > s) { const f32x4 nv = *(const LAS f32x4*)(S5 + ((16 * bq + s) * 32 + 16 * bq + 4 * c4) * 4);
#pragma unroll
              for (int e = 0; e < 4; ++e) if (4 * c4 + e > s) acc += Tr[4 * c4 + e] * nv[e]; } }
          Tr[s] = acc; }
      if (lane < 32) { u32x4 w0, w1; w0.x = pk2(Tr[0], Tr[1]); w0.y = pk2(Tr[2], Tr[3]); w0.z = pk2(Tr[4], Tr[5]); w0.w = pk2(Tr[6], Tr[7]); w1.x = pk2(Tr[8], Tr[9]); w1.y = pk2(Tr[10], Tr[11]); w1.z = pk2(Tr[12], Tr[13]); w1.w = pk2(Tr[14], Tr[15]);
          const u32x4 zz = {0u, 0u, 0u, 0u}; LAS u32x4* trow = (LAS u32x4*)(S7b + rr * HP * 2);
          trow[0] = bq ? zz : w0; trow[1] = bq ? zz : w1; trow[2] = bq ? w0 : zz; trow[3] = bq ? w1 : zz; }
      f32x4 x = mfma16(ldA(S8, HP, 16, 0, li, g), ldT(S7b, HP, 0, 0, li, g), z4);
      LAS unsigned char* XT = S8 + 2560;
      *(LAS u32x2*)(XT + (li * HP + 4 * g) * 2) = (u32x2){0u, 0u}; stT(XT, HP, li, 16 + 4 * g, x);
      const f32x4 t21 = mfma16(ldA(S7b, HP, 16, 0, li, g), ldA(XT, HP, 0, 0, li, g), z4);
#pragma unroll
      for (int r = 0; r < 4; ++r) *(LAS bf16*)(S7b + ((16 + 4 * g + r) * HP + li) * 2) = (bf16)f2bf(t21[r]); }
#pragma unroll 1
    for (int ti = 0; ti < 2; ++ti) { const bf16x8 tf = ldA(S7b, HP, 16 * ti, 0, li, g), mf = ldA(S6, HP, 16 * ti, 0, li, g);
#pragma unroll
        for (int ji = 0; ji < 4; ++ji) { const f32x4 ap = mfma16(tf, ldT(S0, TP, 0, 16 * ji, li, g), z4); stT(S8, HP, 16 * ji + li, 16 * ti + 4 * g, ap);
            const f32x4 mv = mfma16(mf, ldT(S4, TP, 0, 16 * ji, li, g), z4); stT(S5, HP, 16 * ji + li, 16 * ti + 4 * g, mv); } }
#pragma unroll 1
    for (int ti = 0; ti < 2; ++ti) { const bf16x8 tf = ldA(S7b, HP, 16 * ti, 0, li, g);
#pragma unroll
        for (int vi = 0; vi < 4; ++vi) { const f32x4 ul = mfma16(tf, ldA(S5, HP, 16 * vi, 0, li, g), z4); stT(S0, HP, 16 * vi + li, 16 * ti + 4 * g, ul); } }
#pragma unroll 1
    for (int ti = 0; ti < 2; ++ti) { const bf16x8 qbf = ldA(S6b, HP, 16 * ti, 0, li, g), qkf = ldA(S7, HP, 16 * ti, 0, li, g);
#pragma unroll
        for (int ji = 0; ji < 4; ++ji) { f32x4 rp = mfma16(ldA(S8, HP, 16 * ji, 0, li, g), qbf, z4);
            LAS unsigned char* p = S1 + ((16 * ti + li) * TP + 16 * ji + 4 * g) * 2; rp = rp + ld4bf(p); u32x2 w; w.x = pk2(rp[0], rp[1]); w.y = pk2(rp[2], rp[3]); *(LAS u32x2*)p = w;
            f32x4 yl = mfma16(qbf, ldA(S0, HP, 16 * ji, 0, li, g), z4); yl = mfma16(qkf, ldT(S4, TP, 0, 16 * ji, li, g), yl);
            stT(S5, HP, 16 * ji + li, 16 * ti + 4 * g, yl); } }
#pragma unroll 1
    for (int ji = 0; ji < 4; ++ji) { const bf16x8 bt = ldT(S2, TP, 0, 16 * ji, li, g); const float gj = gc[16 * ji + li];
#pragma unroll
        for (int jp = 0; jp < 4; ++jp) { f32x4 pt = mfma16(ldA(S8, HP, 16 * jp, 0, li, g), bt, z4);
#pragma unroll
            for (int r = 0; r < 4; ++r) pt[r] = pt[r] * gj + ((16 * jp + 4 * g + r == 16 * ji + li) ? gj : 0.f);
            stT(S6, TP, 16 * ji + li, 16 * jp + 4 * g, pt); } }
#pragma unroll 1
    for (int vh = 0; vh < 2; ++vh) { f32x4 lt[4][2];
#pragma unroll
      for (int ji = 0; ji < 4; ++ji) { const bf16x8 ba = ldT(S2, TP, 0, 16 * ji, li, g), ka = ldT(S3, TP, 0, 16 * ji, li, g); const f32x4 gv = *(const LAS f32x4*)(gc + 16 * ji + 4 * g);
#pragma unroll
          for (int v2 = 0; v2 < 2; ++v2) { const int vi = 2 * vh + v2; f32x4 x = mfma16(ba, ldA(S0, HP, 16 * vi, 0, li, g), z4); x = mfma16(ka, ldT(S4, TP, 0, 16 * vi, li, g), x); lt[ji][v2] = x * gv; } }
      asm volatile("s_waitcnt lgkmcnt(0)" ::: "memory");
      LAS unsigned char* dst = vh ? S2 : S8;
#pragma unroll
      for (int ji = 0; ji < 4; ++ji)
#pragma unroll
          for (int v2 = 0; v2 < 2; ++v2) stT(dst, TP, 16 * v2 + li, 16 * ji + 4 * g, lt[ji][v2]); }
}
__device__ __forceinline__ void rwkv_passA_step(const Ctx& C, const LAS unsigned char* rb, f32x4 (&hs)[4], int d, int h, int rc) {
    int lane_ = C.lane; asm volatile("" : "+v"(lane_));
    const int lane = lane_, li = lane & 15, g = lane >> 4; const bool isPhi = C.wave >= 4; const int col = 16 * (C.wave & 3) + li;
    const LAS unsigned char* S1 = rb + RW_SLOT; const LAS unsigned char* S2 = rb + 2 * RW_SLOT; const LAS unsigned char* S5 = rb + 5 * RW_SLOT; const LAS unsigned char* S6 = rb + 6 * RW_SLOT;
    const LAS unsigned char* LTb = (col < 32) ? rb + 8 * RW_SLOT + col * TP * 2 : S2 + (col - 32) * TP * 2;
    union { bf16x8 v; unsigned u[4]; } bf[2];
#pragma unroll
    for (int ks = 0; ks < 2; ++ks) { bf[ks].u[0] = pk2(hs[2 * ks][0], hs[2 * ks][1]); bf[ks].u[1] = pk2(hs[2 * ks][2], hs[2 * ks][3]); bf[ks].u[2] = pk2(hs[2 * ks + 1][0], hs[2 * ks + 1][1]); bf[ks].u[3] = pk2(hs[2 * ks + 1][2], hs[2 * ks + 1][3]); }
#pragma unroll
    for (int ti = 0; ti < 2; ++ti) { f32x4 acc = isPhi ? (f32x4){0.f, 0.f, 0.f, 0.f} : ld4bf(S5 + (col * HP + 16 * ti + 4 * g) * 2);
#pragma unroll
        for (int ks = 0; ks < 2; ++ks) acc = mfma16(ldAperm(S1, TP, 16 * ti, ks, li, g), bf[ks].v, acc);
        if (!isPhi) { float* ys = (float*)(C.ws + WS_YS) + (size_t)d * ROWS * 256 + h * 64 + col;
#pragma unroll
            for (int r = 0; r < 4; ++r) ys[(size_t)rw_row_of(d, rc, 16 * ti + 4 * g + r) * 256] = acc[r]; }
        else { bf16* rp = (bf16*)(C.ws + WS_RPP) + ((size_t)((d * 4 + h) * RW_NCH + rc) * 32) * 64 + col;
#pragma unroll
            for (int r = 0; r < 4; ++r) rp[(16 * ti + 4 * g + r) * 64] = (bf16)f2bf(acc[r]); } }
    f32x4 hn[4];
#pragma unroll
    for (int i = 0; i < 4; ++i) { f32x4 acc = isPhi ? (f32x4){0.f, 0.f, 0.f, 0.f} : ld4bf(LTb + (16 * i + 4 * g) * 2);
#pragma unroll
        for (int ks = 0; ks < 2; ++ks) acc = mfma16(ldAperm(S6, TP, 16 * i, ks, li, g), bf[ks].v, acc);
        hn[i] = acc; }
#pragma unroll
    for (int i = 0; i < 4; ++i) hs[i] = hn[i];
}
__device__ __forceinline__ void phase_rwkv1(const Ctx& C) {
    const int lane = C.lane, li = lane & 15, g = lane >> 4;
    for (int u = C.wg; u < 8 * RW_NSC; u += C.G) {
        const int s = u % RW_NSC, dh = u / RW_NSC, d = dh >> 2, h = dh & 3; const bool isPhi = C.wave >= 4; const int col = 16 * (C.wave & 3) + li;
        f32x4 hs[4];
#pragma unroll
        for (int i = 0; i < 4; ++i)
#pragma unroll
            for (int r = 0; r < 4; ++r) hs[i][r] = (isPhi && (16 * i + 4 * g + r == col)) ? 1.f : 0.f;
#pragma unroll 1
        for (int rnd = 0; rnd < (RW_SC + 2) / 3; ++rnd) {
            __syncthreads();
            { int wv = C.wave; asm volatile("" : "+s"(wv)); if (wv < 3 && 3 * rnd + wv < RW_SC) rwkv_d1(C, C.lds + wv * RW_REGION, d, h, rw_rc_of(d, s * RW_SC + 3 * rnd + wv)); }
            __syncthreads();
#pragma unroll 1
            for (int k = 0; k < 3; ++k) { const int ci = 3 * rnd + k; int ko = k * RW_REGION; asm volatile("" : "+s"(ko)); if (ci < RW_SC) rwkv_passA_step(C, C.lds + ko, hs, d, h, rw_rc_of(d, s * RW_SC + ci)); }
        }
        if (isPhi) { bf16* pf = (bf16*)(C.ws + WS_PSC) + (size_t)(dh * RW_NSC + s) * 4096;
            const int ks = col >> 5, eh = (col >> 4) & 1, gp = (col >> 2) & 3, el = col & 3;
#pragma unroll
            for (int i = 0; i < 4; ++i)
#pragma unroll
                for (int r = 0; r < 4; ++r) pf[((i * 2 + ks) * 64 + gp * 16 + 4 * g + r) * 8 + eh * 4 + el] = (bf16)f2bf(hs[i][r]); }
        else { f32x4* lf = (f32x4*)(C.ws + WS_LSC) + ((size_t)(dh * RW_NSC + s) * 4 + C.wave) * 4 * 64;
#pragma unroll
            for (int i = 0; i < 4; ++i) lf[i * 64 + lane] = hs[i]; }
    }
    __syncthreads();
}
__device__ __forceinline__ void rwkv_passB(const Ctx& C, int b) {
    if (C.wave >= 4) return;
    const int lane = C.lane, li = lane & 15, g = lane >> 4, q = C.wave;
    f32x4 hs[4];
#pragma unroll
    for (int i = 0; i < 4; ++i) hs[i] = (f32x4){0.f, 0.f, 0.f, 0.f};
    const bf16x8* pfb = (const bf16x8*)((const bf16*)(C.ws + WS_PSC) + (size_t)b * RW_NSC * 4096);
    const f32x4* lfb = (const f32x4*)(C.ws + WS_LSC) + ((size_t)b * RW_NSC * 4 + q) * 4 * 64;
    bf16x8 pa[8]; f32x4 la[4];
#pragma unroll
    for (int k = 0; k < 8; ++k) pa[k] = pfb[k * 64 + lane];
#pragma unroll
    for (int i = 0; i < 4; ++i) la[i] = lfb[i * 64 + lane];
#pragma unroll 1
    for (int s = 0; s < RW_NSC; ++s) {
        bf16* hp = (bf16*)(C.ws + WS_HSC) + ((size_t)(b * RW_NSC + s) * 64 + 16 * q + li) * 64;
#pragma unroll
        for (int i = 0; i < 4; ++i) { u32x2 w; w.x = pk2(hs[i][0], hs[i][1]); w.y = pk2(hs[i][2], hs[i][3]); *(u32x2*)(hp + 16 * i + 4 * g) = w; }
        bf16x8 pn[8]; f32x4 ln[4]; const int sn = (s + 1 < RW_NSC) ? s + 1 : s;
#pragma unroll
        for (int k = 0; k < 8; ++k) pn[k] = pfb[(size_t)sn * 512 + k * 64 + lane];
#pragma unroll
        for (int i = 0; i < 4; ++i) ln[i] = lfb[(size_t)sn * 4 * 4 * 64 + i * 64 + lane];
        union { bf16x8 v; unsigned u[4]; } bf[2];
#pragma unroll
        for (int ks = 0; ks < 2; ++ks) { bf[ks].u[0] = pk2(hs[2 * ks][0], hs[2 * ks][1]); bf[ks].u[1] = pk2(hs[2 * ks][2], hs[2 * ks][3]); bf[ks].u[2] = pk2(hs[2 * ks + 1][0], hs[2 * ks + 1][1]); bf[ks].u[3] = pk2(hs[2 * ks + 1][2], hs[2 * ks + 1][3]); }
#pragma unroll
        for (int i = 0; i < 4; ++i) { f32x4 acc = la[i];
#pragma unroll
            for (int ks = 0; ks < 2; ++ks) acc = mfma16(pa[i * 2 + ks], bf[ks].v, acc);
            hs[i] = acc; }
#pragma unroll
        for (int k = 0; k < 8; ++k) pa[k] = pn[k];
#pragma unroll
        for (int i = 0; i < 4; ++i) la[i] = ln[i];
    }
}
__device__ __forceinline__ void phase_mix3(const Ctx& C, const DArgs& a, int l) {
    const bf16* P = (const bf16*)(C.ws + WS_P); const float* SC = (const float*)(C.ws + WS_SC); const float* YS = (const float*)(C.ws + WS_YS); bf16* MIX = (bf16*)(C.ws + WS_MIX);
    LAS float* yt = (LAS float*)(C.lds);
    constexpr int GSP = 168;
    LAS unsigned char* gsig = C.lds + 32768;
    LAS float* gm = (LAS float*)(C.lds + 40960);
    const bf16* g2t = (const bf16*)(C.ws + WS_G2T) + (size_t)l * 256 * 160;
    const float* rk = a.in[I_DRK] + (size_t)l * 256; const float* lnw = a.in[I_DLNW] + (size_t)l * 256; const float* lnb = a.in[I_DLNB] + (size_t)l * 256;
    const int lane = C.lane, li = lane & 15, g = lane >> 4, h = C.wave & 3, d = C.wave >> 2;
    const int half = C.tid >> 8, c = C.tid & 255;
    const int u_lo = (l == DEPTH - 1) ? NCTX / 16 : 0;
    for (int u = u_lo + C.wg; u < ROWS / 16; u += C.G) {
        const int rc = u >> 1, th = u & 1, rowb = 16 * u;
        __syncthreads();
        for (int i = C.tid; i < 16 * 160; i += NTHR) { const int t = i / 160, ii = i % 160; *(LAS bf16*)(gsig + (t * GSP + ii) * 2) = (bf16)f2bf(sigmoidf_(bf2f(P[(size_t)(rowb + t) * INWP + C_GL + ii]))); }
        {
          const int ct = (d == 0) ? rc : (rc < 8 ? 7 - rc : 527 - rc), s = ct / RW_SC, ti = (d == 0) ? th : 1 - th;
          const bf16* rp = (const bf16*)(C.ws + WS_RPP) + (size_t)((d * 4 + h) * RW_NCH + rc) * 32 * 64;
          const bf16* hp = (const bf16*)(C.ws + WS_HSC) + (size_t)((d * 4 + h) * RW_NSC + s) * 64 * 64;
          bf16x8 af[2];
#pragma unroll
          for (int ks = 0; ks < 2; ++ks) af[ks] = ldg8(rp + (16 * ti + li) * 64 + 32 * ks + 8 * g);
#pragma unroll
          for (int vi = 0; vi < 4; ++vi) { f32x4 acc = {0.f, 0.f, 0.f, 0.f};
#pragma unroll
              for (int ks = 0; ks < 2; ++ks) acc = mfma16(af[ks], ldg8(hp + (16 * vi + li) * 64 + 32 * ks + 8 * g), acc);
#pragma unroll
              for (int r = 0; r < 4; ++r) { const int t = 16 * ti + 4 * g + r, rl = ((d == 0) ? t : 31 - t) - 16 * th;
                  yt[(d * 16 + rl) * 256 + h * 64 + 16 * vi + li] = acc[r] + YS[((size_t)d * ROWS + rowb + rl) * 256 + h * 64 + 16 * vi + li]; } } }
        __syncthreads();
#pragma unroll
        for (int c2 = 0; c2 < 2; ++c2) { const int ci = 2 * C.wave + c2; f32x4 a0 = {0.f, 0.f, 0.f, 0.f};
#pragma unroll
            for (int ks = 0; ks < 5; ++ks) a0 = mfma16(ldA(gsig, GSP, 0, 32 * ks, li, g), ldg8(g2t + (size_t)(16 * ci + li) * 160 + 32 * ks + 8 * g), a0);
#pragma unroll
            for (int r = 0; r < 4; ++r) gm[(4 * g + r) * 256 + 16 * ci + li] = a0[r]; }
        __syncthreads();
#pragma unroll 1
        for (int it = 0; it < 8; ++it) { const int rl = 2 * it + half, row = rowb + rl;
            const float* sc = SC + (size_t)row * 9 * 256;
            const float y = yt[rl * 256 + c] + yt[(16 + rl) * 256 + c];
            const float mu = wave_sum(y, lane) * (1.f / 64.f), dy = y - mu, var = wave_sum(dy * dy, lane) * (1.f / 64.f);
            const float yn = dy * rsqrtf(var + 64e-5f) * lnw[c] + lnb[c];
            const float r = sc[c], v = sc[256 + c];
            const float coef = wave_sum(r * (sc[4 * 256 + c] + sc[7 * 256 + c]) * rk[c], lane);
            MIX[(size_t)row * DM + 768 + c] = (bf16)f2bf((yn + coef * v) * gm[rl * 256 + c]); }
    }
    __syncthreads();
}
__device__ __forceinline__ void outproj_ctx(const Ctx& C, int l, const float* gate) {
    const bf16* A = (const bf16*)(C.ws + WS_MIX); const bf16* B = (const bf16*)(C.ws + WS_WOUT) + (size_t)l * DM * DM; float* XS = (float*)(C.ws + WS_XS);
    const int lane = C.lane, li = lane & 15, g = lane >> 4;
    for (int u = C.gw; u < (NCTX / 16) * (DM / 16); u += C.NGW) { const int rt = u >> 6, ct = u & 63;
        const bf16* ap = A + (size_t)(16 * rt + li) * DM + 8 * g; const bf16* bp = B + (size_t)(16 * ct + li) * DM + 8 * g;
        f32x4 acc0 = {0.f, 0.f, 0.f, 0.f}, acc1 = {0.f, 0.f, 0.f, 0.f};
#pragma unroll 4
        for (int ks = 0; ks < 32; ks += 2) { acc0 = mfma16(ldg8(ap + 32 * ks), ldg8(bp + 32 * ks), acc0); acc1 = mfma16(ldg8(ap + 32 * ks + 32), ldg8(bp + 32 * ks + 32), acc1); }
        const float gv = gate[16 * ct + li];
#pragma unroll
        for (int r = 0; r < 4; ++r) { float* p = XS + (size_t)(16 * rt + 4 * g + r) * DM + 16 * ct + li; *p = *p + gv * (acc0[r] + acc1[r]); } }
}

#ifndef MK_SINGLE
#define MK_SINGLE 1
#endif
template <int ONLYP> __global__ void __launch_bounds__(NTHR, 2) mega(Args a) {
    extern __shared__ __attribute__((aligned(16))) unsigned char lds_raw[];
    Ctx C;
#define MKCTX() do { int t_ = threadIdx.x; asm volatile("" : "+v"(t_)); unsigned char* w_ = a.ws; asm volatile("" : "+s"(w_)); unsigned l_ = 0u; asm volatile("" : "+s"(l_)); \
        C.lds = (LAS unsigned char*)lds_raw + l_; C.tid = t_; C.lane = t_ & 63; C.wave = __builtin_amdgcn_readfirstlane(t_ >> 6); \
        C.wg = blockIdx.x; C.G = gridDim.x; C.gw = C.wg * NWAVES + C.wave; C.NGW = C.G * NWAVES; C.ws = w_; } while (0)
    MKCTX();
    if (C.tid == 0) {
#pragma unroll
        for (int i = 0; i < 31; ++i) ((LAS unsigned long long*)(C.lds + MISC_OFF + 2048))[i] = (unsigned long long)a.in[i]; }
    DArgs da; da.in.tab = (const LAS unsigned*)(C.lds + MISC_OFF + 2048); da.out = a.out;
    if (C.tid < 4) ((LAS unsigned*)(C.lds + MISC_OFF))[C.tid] = 0u;
    __syncthreads();
    XcdBarrier bar; bar.bar = (unsigned*)(C.ws + WS_CTL) + CW_BAR; bar.x = 0; bar.st = (volatile LAS unsigned*)(C.lds + MISC_OFF);
    if (a.use_bar) bar = xcd_barrier_post((unsigned*)(C.ws + WS_CTL) + CW_BAR, (volatile LAS unsigned*)(C.lds + MISC_OFF));
#ifndef PHMASK
#define PHMASK 0x1fff
#endif
#define INP(o, k) ((ONLYP < 0 || ONLYP == (o)) && ((PHMASK >> ((o) == 99 ? 12 : (o))) & 1) && a.ph_lo <= (k) && (k) < a.ph_hi)
#ifndef REPMASK
#define REPMASK 0
#endif
#define NREP(o) ((((REPMASK) >> ((o) == 99 ? 12 : (o))) & 1) ? 2 : 1)
#define IN(k) (a.ph_lo <= (k) && (k) < a.ph_hi)
#define SEAM(k) do { if (a.use_bar && IN(k) && IN((k) + 1)) xcd_barrier(bar); } while (0)
    if (INP(0, 0)) for (int rep = 0; rep < NREP(0); ++rep) { MKCTX(); phase_prologue(C, da); }
    SEAM(0);
    for (int l = 0; l < DEPTH; ++l) {
        const int b = 1 + l * NPL;
        const float* mod_lat = (const float*)(C.ws + WS_MOD) + (size_t)(l * 2 + 0) * 6144; const float* mod_ctx = mod_lat + 6144;
        if (INP(1, b + 0)) { MKCTX(); phase_norm1(C, da, l); }
        SEAM(b + 0);
        if (INP(2, b + 1)) for (int rep = 0; rep < NREP(2); ++rep) { MKCTX();
            pg8::StaticOrder S; S.init(WS_H, WS_WIN + (size_t)l * INWP * DM * 2, ROWS, INWP, DM, C.G, C.wg);
            pg8::EpiStoreBf16 E{(bf16*)(C.ws + WS_P), INWP, nullptr, 0, 1.0f, 1.0f};
            pg8::gemm_phase<pg8::EpiStoreBf16, pg8::StaticOrder, true, true>(C.lds, C.tid, DM, S, E, C.ws);
        }
        SEAM(b + 1);
        if (INP(3, b + 2)) { MKCTX(); mix1_rope(C); for (int rep = 0; rep < NREP(3); ++rep) { for (int r2 = 0; r2 < NREP(13); ++r2) mix1_vt(C); for (int r2 = 0; r2 < NREP(14); ++r2) mix1_rwkv_prep(C, da, l); for (int r2 = 0; r2 < NREP(15); ++r2) mix1_fourier1(C); } }
        SEAM(b + 2);
        if (INP(11, b + 3)) for (int rep = 0; rep < NREP(11); ++rep) { MKCTX(); phase_rwkv1(C); }
        SEAM(b + 3);
        if (INP(4, b + 4)) for (int rep = 0; rep < NREP(4); ++rep) { MKCTX(); phase_mix2(C, da, l); }
        SEAM(b + 4);
        if (INP(5, b + 5)) for (int rep = 0; rep < NREP(5); ++rep) { MKCTX(); phase_mix3(C, da, l); }
        SEAM(b + 5);
        if (INP(6, b + 6)) { MKCTX();
            if (l < DEPTH - 1) outproj_ctx(C, l, mod_ctx + 2 * DM);
            pg8::StaticOrder S; S.init(WS_MIX + (size_t)NCTX * DM * 2, WS_WOUT + (size_t)l * DM * DM * 2, SEQ, DM, DM, C.G, C.wg);
            pg8::EpiResidual E{(float*)(C.ws + WS_XS) + (size_t)NCTX * DM, DM, mod_lat + 2 * DM, mod_lat + 2 * DM};
            pg8::gemm_phase<pg8::EpiResidual, pg8::StaticOrder, true, true>(C.lds, C.tid, DM, S, E, C.ws);
        }
        SEAM(b + 6);
        if (INP(7, b + 7)) for (int rep = 0; rep < NREP(7); ++rep) { MKCTX(); phase_norm2(C, da, l); }
        SEAM(b + 7);
        if (INP(8, b + 8)) for (int rep = 0; rep < NREP(8); ++rep) { MKCTX(); phase_gather(C, da, l); }
        SEAM(b + 8);
        if (INP(9, b + 9)) for (int rep = 0; rep < NREP(9); ++rep) { MKCTX();
            const int nblk = moe_tables(C);
            pg8::MoeOrder S{(unsigned)WS_XG8, (unsigned)(WS_WGU + (size_t)l * 32 * 2048 * DM), 256u * DM, 2048u * DM,
                            (const LAS unsigned char*)(C.lds + MISC_OFF + 1024), nblk, 8, C.G, C.wg};
            pg8::EpiSwiglu E{(bf16*)(C.ws + WS_ACT8), DM, da.in[I_BGU] + (size_t)l * 32 * 2048, 2048, pg8::X8_S * pg8::W8_S, 1.0f / (pg8::X8_S * pg8::W8_S)};
            pg8::gemm_phase<pg8::EpiSwiglu, pg8::MoeOrder, true, true, 1>(C.lds, C.tid, DM, S, E, C.ws);
        }
        SEAM(b + 9);
        if (INP(10, b + 10)) for (int rep = 0; rep < NREP(10); ++rep) { MKCTX();
            const int nblk = moe_tables(C);
            pg8::MoeOrder S{(unsigned)WS_ACT8, (unsigned)(WS_WDN + (size_t)l * 32 * DM * DM), 256u * DM, (unsigned)(DM * DM),
                            (const LAS unsigned char*)(C.lds + MISC_OFF + 1024), nblk, 4, C.G, C.wg};
            pg8::EpiStoreBf16 E{(bf16*)(C.ws + WS_XG), DM, da.in[I_BDN] + (size_t)l * 32 * DM, DM, pg8::ACT_S * pg8::W8_S, 1.0f / (pg8::ACT_S * pg8::W8_S)};
            pg8::gemm_phase<pg8::EpiStoreBf16, pg8::MoeOrder, true, true, 1>(C.lds, C.tid, DM, S, E, C.ws);
        }
        SEAM(b + 10);
    }
    if (INP(99, PH_TOTAL - 1)) { MKCTX(); phase_final(C, da); }
#undef IN
#undef INP
#undef SEAM
}

typedef void (*kern_t)(Args);
static kern_t kern_of(int o) {
    switch (o) { case 0: return mega<0>; case 1: return mega<1>; case 2: return mega<2>; case 3: return mega<3>; case 4: return mega<4>; case 5: return mega<5>; case 6: return mega<6>;
                 case 7: return mega<7>; case 8: return mega<8>; case 9: return mega<9>; case 10: return mega<10>; case 11: return mega<11>; case 99: return mega<99>;
#if MK_SINGLE
                 default: return mega<-1>;
#else
                 default: return mega<0>;
#endif
    }
}
extern "C" void kernel_launch(void* const* d_in, const int* in_sizes, int n_in, void* d_out, int out_size, void* d_ws, size_t ws_size, hipStream_t stream) {
    static int ready = 0;
    if (ready == 0) {
        if (n_in != 31 || out_size != SEQ * DM || ws_size < WS_END) { fprintf(stderr, "kernel_launch: unexpected shapes (n_in %d, out %d, ws %zu)\n", n_in, out_size, ws_size); ready = -1; return; }
        const int ids[14] = {0, 1, 2, 3, 4, 5, 6, 7, 8, 9, 10, 11, 99, -1};
        for (int i = 0; i < (MK_SINGLE ? 14 : 13); ++i) { if (MK_SINGLE && ids[i] != -1) continue;
            if (hipFuncSetAttribute((const void*)kern_of(ids[i]), hipFuncAttributeMaxDynamicSharedMemorySize, LDS_BYTES) != hipSuccess) { fprintf(stderr, "kernel_launch: hipFuncSetAttribute failed (%d)\n", ids[i]); ready = -1; return; } }
        ready = 1;
    }
    if (ready < 0) return;
    (void)hipMemsetAsync((char*)d_ws + WS_CTL, 0, CTL_ZERO_BYTES, stream);
    Args a{};
    for (int i = 0; i < 31; ++i) a.in[i] = (const float*)d_in[i];
    a.out = (float*)d_out; a.ws = (unsigned char*)d_ws; a.pad = 0;
#if MK_SINGLE
    a.ph_lo = 0; a.ph_hi = PH_TOTAL; a.use_bar = 1;
    hipLaunchKernelGGL(kern_of(-1), dim3(NWG), dim3(NTHR), LDS_BYTES, stream, a);
#else
    for (int p = 0; p < PH_TOTAL; ++p) { a.ph_lo = p; a.ph_hi = p + 1; a.use_bar = 0;
        const int j = (p - 1) % NPL; const int o = (p == 0) ? 0 : (p == PH_TOTAL - 1) ? 99 : (j < 3 ? 1 + j : j == 3 ? 11 : j);
        hipLaunchKernelGGL(kern_of(o), dim3(NWG), dim3(NTHR), LDS_BYTES, stream, a); }
#endif
}
```

```cpp
#include <hip/hip_runtime.h>
#include <cstdio>
#include <cstdint>

#define LAS __attribute__((address_space(3)))
typedef unsigned short bf16;
typedef float f32x4 __attribute__((ext_vector_type(4)));
typedef float f32x2 __attribute__((ext_vector_type(2)));
typedef short bf16x8 __attribute__((ext_vector_type(8)));
typedef unsigned u32x4 __attribute__((ext_vector_type(4)));
typedef unsigned u32x2 __attribute__((ext_vector_type(2)));

constexpr int DM = 1024, SEQ = 16384, NCTX = 256, ROWS = SEQ + NCTX, DEPTH = 4, GRIDW = 64;
constexpr int INW = 2720, INWP = 2816;
constexpr int C_AQ = 0, C_AK = 256, C_AV = 384, C_BU = 512, C_CQ = 768, C_CK = 1024, C_CV = 1280, C_DR = 1536, C_DK = 1792, C_DV = 2048, C_WL = 2304, C_AL = 2432, C_GL = 2560;
constexpr int NEXP = 32, TOPK = 4;
constexpr int MOE_MAXBLK = 296;
constexpr int MOE_ROWS = MOE_MAXBLK * 256;
constexpr int NWG = 256, NTHR = 512, NWAVES = 8;
constexpr int VTP = ROWS + 256;

constexpr size_t MiB = 1u << 20;
constexpr size_t WS_CTL = 0, CTL_ZERO_BYTES = 1 * MiB;
constexpr size_t WS_MOD = 1 * MiB;
constexpr size_t WS_TW = 2 * MiB;
constexpr size_t WS_MTAB = 3 * MiB;
constexpr size_t WS_XS = 4 * MiB;
constexpr size_t WS_H = 70 * MiB;
constexpr size_t WS_P = 104 * MiB;
constexpr size_t WS_MIX = 194 * MiB;
constexpr size_t WS_FYR = 228 * MiB, WS_FYI = 244 * MiB;
constexpr size_t WS_VTA = 1544 * MiB, WS_VTC = 1550 * MiB;
constexpr size_t WS_SC = 260 * MiB;
constexpr size_t WS_YS = 408 * MiB;
constexpr size_t WS_ROUTE = 442 * MiB;
constexpr size_t WS_CNT = 444 * MiB;
constexpr size_t WS_XG = 446 * MiB;
constexpr size_t WS_ACT = 596 * MiB;
constexpr size_t WS_XG8 = WS_ACT, WS_ACT8 = WS_ACT + 75 * MiB;
constexpr size_t WS_WIN = 746 * MiB;
constexpr size_t WS_WOUT = 768 * MiB;
constexpr size_t WS_WGU = 776 * MiB;
constexpr size_t WS_WDN = 1288 * MiB;
constexpr size_t WS_RPP = 1560 * MiB, WS_PSC = 1578 * MiB, WS_LSC = 1580 * MiB, WS_HSC = 1584 * MiB;
constexpr size_t WS_FTAB = 1586 * MiB;
constexpr size_t WS_G2T = 1588 * MiB, WS_RWT = 1589 * MiB;
constexpr size_t WS_LORAT = 1590 * MiB;
constexpr size_t WS_F256 = 1591 * MiB;

constexpr size_t WS_END = 1592 * MiB;
static_assert(WS_XS + (size_t)ROWS * DM * 4 <= WS_H && WS_H + (size_t)ROWS * DM * 2 <= WS_P && WS_P + (size_t)ROWS * INWP * 2 <= WS_MIX && WS_MIX + (size_t)ROWS * DM * 2 <= WS_FYR, "ws map 1");
static_assert(WS_SC + (size_t)ROWS * 9 * 256 * 4 <= WS_YS && WS_YS + (size_t)2 * ROWS * 256 * 4 <= WS_ROUTE && WS_XG + (size_t)MOE_ROWS * DM * 2 <= WS_ACT && WS_ACT + (size_t)MOE_ROWS * DM * 2 <= WS_WIN, "ws map 2");
static_assert(WS_WIN + (size_t)4 * INWP * DM * 2 <= WS_WOUT && WS_WGU + (size_t)4 * 32 * 2048 * 1024 * 2 <= WS_WDN && WS_WDN + (size_t)4 * 32 * 1024 * 1024 * 2 <= WS_END, "ws map 3");
constexpr int CW_BAR = 4096;
constexpr int CW_WQ = 16384;

constexpr int RING_BYTES = 131072;
constexpr int MISC_OFF = 143360;
constexpr int LDS_BYTES = 147456;

__device__ __forceinline__ unsigned f2bf(float f) { unsigned u = __builtin_bit_cast(unsigned, f); return (u + 0x7fffu + ((u >> 16) & 1u)) >> 16; }
__device__ __forceinline__ unsigned pk2(float lo, float hi) { return f2bf(lo) | (f2bf(hi) << 16); }
__device__ __forceinline__ float bf2f(unsigned short b) { return __builtin_bit_cast(float, (unsigned)b << 16); }
__device__ __forceinline__ float bflo(unsigned w) { return __builtin_bit_cast(float, w << 16); }
__device__ __forceinline__ float bfhi(unsigned w) { return __builtin_bit_cast(float, w & 0xffff0000u); }
__device__ __forceinline__ float shx(float v, int o, int lane) { return __builtin_bit_cast(float, __builtin_amdgcn_ds_bpermute((lane ^ o) << 2, __builtin_bit_cast(int, v))); }
__device__ __forceinline__ int shxi(int v, int o, int lane) { return __builtin_amdgcn_ds_bpermute((lane ^ o) << 2, v); }
__device__ __forceinline__ float dpp_ror(float v, int ctrl_unused);
#define DPP_ROR_ADD(v, n) v += __builtin_bit_cast(float, __builtin_amdgcn_update_dpp(0, __builtin_bit_cast(int, v), 0x120 + (n), 0xf, 0xf, false))
__device__ __forceinline__ float wave_sum(float v, int lane) {
    DPP_ROR_ADD(v, 8); DPP_ROR_ADD(v, 4); DPP_ROR_ADD(v, 2); DPP_ROR_ADD(v, 1);
    v += shx(v, 16, lane); v += shx(v, 32, lane);
    return v;
}
__device__ __forceinline__ float sigmoidf_(float x) { return 1.f / (1.f + __expf(-x)); }
#define LDS_WAIT() asm volatile("s_waitcnt lgkmcnt(0)" ::: "memory")
#define VM_WAIT() asm volatile("s_waitcnt vmcnt(0)" ::: "memory")

namespace pg8 {
#define PG8_LAS __attribute__((address_space(3)))
typedef unsigned short bf16_t;
constexpr int BM = 256, BK = 64, HALF = 128, HTB = HALF * BK * 2, STAGE_BYTES = 8 * HTB, NXCD = 8, WGM = 8;
__host__ __device__ __forceinline__ int lds_byte(int r, int c) { const int st = (r >> 4) * 2 + (c >> 5), rr = r & 15, cc = c & 31, ob = rr * 64 + cc * 2; return st * 1024 + (ob ^ (((ob >> 9) & 1) << 5)); }
__host__ __device__ __forceinline__ void stage_rc(int b, int& R, int& C) { const int st = b / 1024, sb = b % 1024, swz = sb ^ (((sb >> 9) & 1) << 5); R = (st >> 1) * 16 + swz / 64; C = (st & 1) * 32 + (swz % 64) / 2; }
__host__ __device__ __forceinline__ int perm32(int rho) { const int n = rho >> 4, i = rho & 15; return 8 * (i >> 2) + 4 * n + (i & 3); }
struct Unit { int pm, pn, e; };
typedef int v8i __attribute__((ext_vector_type(8))); typedef int v4i __attribute__((ext_vector_type(4)));
__device__ __forceinline__ v8i cat8(bf16x8 a, bf16x8 b) { const v4i x = __builtin_bit_cast(v4i, a), y = __builtin_bit_cast(v4i, b); return __builtin_shufflevector(x, y, 0, 1, 2, 3, 4, 5, 6, 7); }
__device__ __forceinline__ unsigned cvt_pk_bf16(float lo, float hi) { unsigned r; asm volatile("v_cvt_pk_bf16_f32 %0, %1, %2" : "=v"(r) : "v"(lo), "v"(hi)); return r; }

struct StaticOrder {
    unsigned A, Bt, tstep;
    int nM, nN, nwg, G, c;
    __device__ void init(size_t A_, size_t Bt_, int M, int N, int K, int G_, int c_) { A = (unsigned)A_; Bt = (unsigned)Bt_; tstep = (unsigned)(BM * K * 2); nM = M / BM; nN = N / BM; nwg = nM * nN; G = G_; c = c_; }
    __device__ bool next(int i, Unit& u) const {
        const long L = (long)i * G + c; if (L >= nwg) return false;
        int wgid = (int)L; { const int q = nwg / NXCD, r = nwg % NXCD, xcd = wgid % NXCD, off = wgid / NXCD; wgid = (xcd < r ? xcd * (q + 1) : r * (q + 1) + (xcd - r) * q) + off; }
        const int nig = WGM * nN, gid = wgid / nig, fm = gid * WGM, gsz = (nM - fm) < WGM ? (nM - fm) : WGM;
        u.pm = fm + ((wgid % nig) % gsz); u.pn = (wgid % nig) / gsz; u.e = 0; return true;
    }
    __device__ __forceinline__ unsigned pa(const Unit& u) const { return A + (unsigned)u.pm * tstep; }
    __device__ __forceinline__ unsigned pb(const Unit& u) const { return Bt + (unsigned)u.pn * tstep; }
};
struct MoeOrder {
    unsigned A, Bt, tstep, estep;
    const LAS unsigned char* blk_e; int nblk, nN, G, c;
    __device__ bool next(int i, Unit& u) const {
        const int L = i * G + c; if (L >= nblk * nN) return false;
        u.pm = L / nN; u.pn = L % nN; u.e = __builtin_amdgcn_readfirstlane((int)blk_e[u.pm]); return true;
    }
    __device__ __forceinline__ unsigned pa(const Unit& u) const { return A + (unsigned)u.pm * tstep; }
    __device__ __forceinline__ unsigned pb(const Unit& u) const { return Bt + (unsigned)u.e * estep + (unsigned)u.pn * tstep; }
};

struct EpiStoreBf16 {
    static constexpr bool PERM = true;
    bf16_t* O; int ldc; const float* bias; int bias_estride; float bias_scale, acc_scale;
    __device__ __forceinline__ void init(f32x4 (&acc)[2][2][4][2], const Unit& u, int wc, int fq) const {
        const int col0 = u.pn * BM + wc * 32 + 8 * fq;
#pragma unroll
        for (int b = 0; b < 2; ++b)
#pragma unroll
            for (int n = 0; n < 2; ++n) { const f32x4 bv = bias ? *(const f32x4*)(bias + (size_t)u.e * bias_estride + col0 + b * HALF + 4 * n) * bias_scale : (f32x4){0.f, 0.f, 0.f, 0.f};
#pragma unroll
                for (int a = 0; a < 2; ++a)
#pragma unroll
                    for (int m = 0; m < 4; ++m) { f32x4 t = bv; asm volatile("" : "+v"(t)); acc[a][b][m][n] = t; } }
    }
    __device__ __forceinline__ void operator()(const f32x4 (&acc)[2][2][4][2], const Unit& u, int wr, int wc, int fr, int fq) const {
        const int row0 = u.pm * BM + wr * 64 + fr, col0 = u.pn * BM + wc * 32 + 8 * fq;
#pragma unroll
        for (int ai = 0; ai < 2; ++ai)
#pragma unroll
            for (int m = 0; m < 4; ++m) { bf16_t* rowp = O + (size_t)(row0 + ai * HALF + m * 16) * ldc + col0;
#pragma unroll
                for (int bj = 0; bj < 2; ++bj) { const f32x4 v0 = acc[ai][bj][m][0] * acc_scale, v1 = acc[ai][bj][m][1] * acc_scale;
                    u32x4 w; w.x = cvt_pk_bf16(v0[0], v0[1]); w.y = cvt_pk_bf16(v0[2], v0[3]); w.z = cvt_pk_bf16(v1[0], v1[1]); w.w = cvt_pk_bf16(v1[2], v1[3]);
                    *(u32x4*)(rowp + bj * HALF) = w; }
                asm volatile("" ::: "memory"); }
    }
};
__device__ __forceinline__ float swiglu1(float g, float up) {
    g = fminf(g, 7.0f); up = fminf(fmaxf(up, -7.0f), 7.0f);
    return g * (1.f / (1.f + __expf(-1.702f * g))) * (up + 1.0f);
}
constexpr float X8_S = 8.0f, W8_S = 256.0f, ACT_S = 4.0f;
struct EpiSwiglu {
    static constexpr bool PERM = true;
    bf16_t* O; int ldc; const float* bias; int bias_estride; float bias_scale, acc_scale;
    __device__ __forceinline__ void init(f32x4 (&acc)[2][2][4][2], const Unit& u, int wc, int fq) const {
        const int col0 = u.pn * BM + wc * 32 + 8 * fq;
#pragma unroll
        for (int b = 0; b < 2; ++b)
#pragma unroll
            for (int n = 0; n < 2; ++n) { const f32x4 bv = bias ? *(const f32x4*)(bias + (size_t)u.e * bias_estride + col0 + b * HALF + 4 * n) * bias_scale : (f32x4){0.f, 0.f, 0.f, 0.f};
#pragma unroll
                for (int a = 0; a < 2; ++a)
#pragma unroll
                    for (int m = 0; m < 4; ++m) { f32x4 t = bv; asm volatile("" : "+v"(t)); acc[a][b][m][n] = t; } }
    }
    __device__ __forceinline__ void operator()(const f32x4 (&acc)[2][2][4][2], const Unit& u, int wr, int wc, int fr, int fq) const {
        const int row0 = u.pm * BM + wr * 64 + fr, col0 = u.pn * BM + wc * 32 + 8 * fq;
#pragma unroll
        for (int ai = 0; ai < 2; ++ai)
#pragma unroll
            for (int m = 0; m < 4; ++m) { unsigned char* rowp = (unsigned char*)O + (size_t)(row0 + ai * HALF + m * 16) * ldc + (col0 >> 1);
#pragma unroll
                for (int bj = 0; bj < 2; ++bj) { const f32x4 v0 = acc[ai][bj][m][0] * acc_scale, v1 = acc[ai][bj][m][1] * acc_scale;
                    unsigned w = 0; w = __builtin_amdgcn_cvt_pk_fp8_f32(swiglu1(v0[0], v0[1]) * ACT_S, swiglu1(v0[2], v0[3]) * ACT_S, w, false); w = __builtin_amdgcn_cvt_pk_fp8_f32(swiglu1(v1[0], v1[1]) * ACT_S, swiglu1(v1[2], v1[3]) * ACT_S, w, true);
                    *(unsigned*)(rowp + bj * (HALF / 2)) = w; }
                asm volatile("" ::: "memory"); }
    }
};
struct EpiResidual {
    static constexpr bool PERM = false;
    float* X; int ldc; const float* gate_lat; const float* gate_ctx;
    __device__ __forceinline__ void init(f32x4 (&acc)[2][2][4][2], const Unit& u, int wc, int fq) const {
#pragma unroll
        for (int a = 0; a < 2; ++a)
#pragma unroll
            for (int b = 0; b < 2; ++b)
#pragma unroll
                for (int m = 0; m < 4; ++m)
#pragma unroll
                    for (int n = 0; n < 2; ++n) acc[a][b][m][n] = (f32x4){0.f, 0.f, 0.f, 0.f};
    }
    __device__ __forceinline__ void operator()(const f32x4 (&acc)[2][2][4][2], const Unit& u, int wr, int wc, int fr, int fq) const {
        const int row0 = u.pm * BM + wr * 64 + fr, col0 = u.pn * BM + wc * 32 + 4 * fq;
        const float* gp = (u.pm == 0) ? gate_ctx : gate_lat;
        f32x4 gv[2][2];
#pragma unroll
        for (int bj = 0; bj < 2; ++bj)
#pragma unroll
            for (int n = 0; n < 2; ++n) gv[bj][n] = *(const f32x4*)(gp + col0 + bj * HALF + n * 16);
#pragma unroll
        for (int ai = 0; ai < 2; ++ai)
#pragma unroll
            for (int m = 0; m < 4; ++m) { float* rowp = X + (size_t)(row0 + ai * HALF + m * 16) * ldc + col0;
#pragma unroll
                for (int bj = 0; bj < 2; ++bj)
#pragma unroll
                    for (int n = 0; n < 2; ++n) { f32x4* p = (f32x4*)(rowp + bj * HALF + n * 16); *p = *p + gv[bj][n] * acc[ai][bj][m][n]; }
                asm volatile("" ::: "memory"); }
    }
};
template <class Epi, class Sched, bool ALIGN_EPI = false, bool SP2 = false, int ES = 2>
__device__ __forceinline__ void gemm_phase(PG8_LAS unsigned char* lds, const int tid, const int K, const Sched& S, const Epi& E, const void* wsbase) {
    const __amdgpu_buffer_rsrc_t rsrc = __builtin_amdgcn_make_buffer_rsrc((void*)wsbase, 0, 0x7fffffff, 0x00020000);
    const int wid = __builtin_amdgcn_readfirstlane(tid >> 6), lane = tid & 63, wr = wid >> 2, wc = wid & 3, fr = lane & 15, fq = lane >> 4;
    const int nt = (K * ES) / 128;
    unsigned voffA[2], voffB[2];
#pragma unroll
    for (int i = 0; i < 2; ++i) { int R, C; stage_rc(tid * 16 + i * 8192, R, C); const int Rb = Epi::PERM ? ((R & ~31) + perm32(R & 31)) : R;
        voffA[i] = (unsigned)(R * K * ES + C * 2); voffB[i] = (unsigned)(Rb * K * ES + C * 2); }
    const unsigned kstep = (unsigned)(BK * 2);
    const unsigned hstep = (unsigned)(HALF * K * ES);
        const unsigned ldsw = (unsigned)wid * 1024u;
    const int aoff = lds_byte(wr * 64 + fr, ES == 2 ? fq * 8 : fq * 16), boff = lds_byte(wc * 32 + fr, ES == 2 ? fq * 8 : fq * 16); constexpr int KOFF = (ES == 2) ? 1024 : 16;
#define PG8_SA(b, h) (((b) * 2 + (h)) * HTB)
#define PG8_SB(b, h) ((4 + (b) * 2 + (h)) * HTB)
#define PG8_STAGE(bufoff, gbase, voff) do { _Pragma("unroll") for (int _i = 0; _i < 2; ++_i) \
        __builtin_amdgcn_raw_ptr_buffer_load_lds(rsrc, (PG8_LAS unsigned*)(lds + (bufoff) + ldsw + _i * 8192), 16, (voff)[_i], (gbase), 0, 0); } while (0)
#define PG8_LDA(dst, b, h) do { _Pragma("unroll") for (int m = 0; m < 4; ++m) _Pragma("unroll") for (int k = 0; k < 2; ++k) dst[m][k] = *(const PG8_LAS bf16x8*)(lds + PG8_SA(b, h) + aoff + m * 2048 + k * KOFF); } while (0)
#define PG8_LDA8(dst, b, h) do { _Pragma("unroll") for (int m = 0; m < 4; ++m) { const PG8_LAS v4i* p_ = (const PG8_LAS v4i*)(lds + PG8_SA(b, h) + aoff + m * 2048); const v4i x_ = p_[0], y_ = p_[1]; dst[m] = __builtin_shufflevector(x_, y_, 0, 1, 2, 3, 4, 5, 6, 7); } } while (0)
#define PG8_LDB(dst, b, h) do { _Pragma("unroll") for (int n = 0; n < 2; ++n) _Pragma("unroll") for (int k = 0; k < 2; ++k) dst[n][k] = *(const PG8_LAS bf16x8*)(lds + PG8_SB(b, h) + boff + n * 2048 + k * KOFF); } while (0)
#define PG8_LDB8(dst, b, h) do { _Pragma("unroll") for (int n = 0; n < 2; ++n) { const PG8_LAS v4i* p_ = (const PG8_LAS v4i*)(lds + PG8_SB(b, h) + boff + n * 2048); const v4i x_ = p_[0], y_ = p_[1]; dst[n] = __builtin_shufflevector(x_, y_, 0, 1, 2, 3, 4, 5, 6, 7); } } while (0)
#define PG8_MMA(ai, bj, At, Bt) do { __builtin_amdgcn_s_setprio(1); _Pragma("unroll") for (int m = 0; m < 4; ++m) _Pragma("unroll") for (int n = 0; n < 2; ++n) { \
        if constexpr (ES == 2) { _Pragma("unroll") for (int k = 0; k < 2; ++k) acc[ai][bj][m][n] = __builtin_amdgcn_mfma_f32_16x16x32_bf16(Bt[n][k], At[m][k], acc[ai][bj][m][n], 0, 0, 0); } \
        else asm volatile("v_mfma_f32_16x16x128_f8f6f4 %0, %1, %2, %0" : "+v"(acc[ai][bj][m][n]) : "v"(Bt##8[n]), "v"(At##8[m])); } \
        __builtin_amdgcn_s_setprio(0); } while (0)
#define PG8_LDAX(b, h) do { if constexpr (ES == 2) PG8_LDA(At, b, h); else PG8_LDA8(At8, b, h); } while (0)
#define PG8_LDBX(B, b, h) do { if constexpr (ES == 2) PG8_LDB(B, b, h); else PG8_LDB8(B##8, b, h); } while (0)
#define PG8_WAIT_V(n) asm volatile("s_waitcnt vmcnt(" #n ")" ::: "memory")
#define PG8_WAIT_L(n) asm volatile("s_waitcnt lgkmcnt(" #n ")" ::: "memory")
#define PG8_BAR __builtin_amdgcn_s_barrier()
#define PG8_SCHED __builtin_amdgcn_sched_barrier(0)
    Unit cur, nxt; int ui = 0;
    if (!S.next(0, cur)) return;
    f32x4 acc[2][2][4][2];
    E.init(acc, cur, wc, fq);
    bf16x8 At[4][2], B0[2][2], B1[2][2]; v8i At8[4], B08[2], B18[2];
    unsigned cA = S.pa(cur), cB = S.pb(cur);
    if constexpr (SP2) {
        PG8_STAGE(PG8_SB(0, 0), cB, voffB); PG8_STAGE(PG8_SB(0, 1), cB + hstep, voffB); PG8_STAGE(PG8_SA(0, 0), cA, voffA); PG8_STAGE(PG8_SA(0, 1), cA + hstep, voffA);
        if (wr == 1) PG8_BAR;
        PG8_WAIT_V(2); PG8_BAR;
        PG8_STAGE(PG8_SB(1, 0), cB + kstep, voffB); PG8_STAGE(PG8_SA(1, 0), cA + kstep, voffA); PG8_STAGE(PG8_SB(1, 1), cB + hstep + kstep, voffB);
        PG8_WAIT_V(6); PG8_BAR;
    } else {
        PG8_STAGE(PG8_SB(0, 0), cB, voffB); PG8_STAGE(PG8_SA(0, 0), cA, voffA); PG8_STAGE(PG8_SB(0, 1), cB + hstep, voffB); PG8_STAGE(PG8_SA(0, 1), cA + hstep, voffA);
        if (wr == 1) PG8_BAR;
        PG8_WAIT_V(4); PG8_BAR;
        PG8_STAGE(PG8_SB(1, 0), cB + kstep, voffB); PG8_STAGE(PG8_SA(1, 0), cA + kstep, voffA); PG8_STAGE(PG8_SB(1, 1), cB + hstep + kstep, voffB);
        PG8_WAIT_V(6); PG8_BAR;
    }
    for (;;) {
        const bool has_next = S.next(ui + 1, nxt);
        const unsigned nA = has_next ? S.pa(nxt) : cA, nB = has_next ? S.pb(nxt) : cB;
        for (int t = 0; t < nt; t += 2) {
            const bool last = (t == nt - 2);
            const unsigned a1 = cA + (unsigned)(t + 1) * kstep;
            const unsigned a2 = last ? nA : cA + (unsigned)(t + 2) * kstep, b2 = last ? nB : cB + (unsigned)(t + 2) * kstep;
            const unsigned a3 = a2 + kstep, b3 = b2 + kstep;
            if constexpr (SP2) {
            PG8_LDBX(B0, 0, 0); PG8_LDBX(B1, 0, 1); PG8_SCHED; PG8_LDAX(0, 0); PG8_STAGE(PG8_SA(1, 1), a1 + hstep, voffA);
            PG8_WAIT_V(8); PG8_WAIT_L(0); PG8_BAR; PG8_MMA(0, 0, At, B0); PG8_MMA(0, 1, At, B1); PG8_BAR; PG8_SCHED;
            PG8_LDAX(0, 1); PG8_STAGE(PG8_SB(0, 0), b2, voffB); PG8_STAGE(PG8_SB(0, 1), b2 + hstep, voffB); PG8_STAGE(PG8_SA(0, 0), a2, voffA);
            PG8_WAIT_V(8); PG8_WAIT_L(0); PG8_BAR; PG8_MMA(1, 0, At, B0); PG8_MMA(1, 1, At, B1); PG8_BAR; PG8_SCHED;
            PG8_LDBX(B0, 1, 0); PG8_LDBX(B1, 1, 1); PG8_SCHED; PG8_LDAX(1, 0); PG8_STAGE(PG8_SA(0, 1), a2 + hstep, voffA);
            PG8_WAIT_V(8); PG8_WAIT_L(0); PG8_BAR; PG8_MMA(0, 0, At, B0); PG8_MMA(0, 1, At, B1); PG8_BAR; PG8_SCHED;
            PG8_LDAX(1, 1); PG8_STAGE(PG8_SB(1, 0), b3, voffB); PG8_STAGE(PG8_SB(1, 1), b3 + hstep, voffB); PG8_STAGE(PG8_SA(1, 0), a3, voffA);
            PG8_WAIT_V(8); PG8_WAIT_L(0); PG8_BAR; PG8_MMA(1, 0, At, B0); PG8_MMA(1, 1, At, B1); PG8_BAR; PG8_SCHED;
            } else {
            PG8_LDBX(B0, 0, 0); PG8_SCHED; PG8_LDAX(0, 0); PG8_STAGE(PG8_SA(1, 1), a1 + hstep, voffA);
            PG8_WAIT_L(8); PG8_BAR; PG8_WAIT_L(0); PG8_MMA(0, 0, At, B0); PG8_BAR; PG8_SCHED;
            PG8_LDBX(B1, 0, 1); PG8_STAGE(PG8_SB(0, 0), b2, voffB);
            PG8_BAR; PG8_WAIT_L(0); PG8_MMA(0, 1, At, B1); PG8_BAR;
            PG8_LDAX(0, 1); PG8_STAGE(PG8_SA(0, 0), a2, voffA);
            PG8_BAR; PG8_WAIT_L(0); PG8_MMA(1, 0, At, B0); PG8_BAR; PG8_SCHED;
            PG8_STAGE(PG8_SB(0, 1), b2 + hstep, voffB);
            PG8_WAIT_V(6); PG8_BAR; PG8_MMA(1, 1, At, B1); PG8_BAR;
            PG8_LDBX(B0, 1, 0); PG8_SCHED; PG8_LDAX(1, 0); PG8_STAGE(PG8_SA(0, 1), a2 + hstep, voffA);
            PG8_WAIT_L(8); PG8_BAR; PG8_WAIT_L(0); PG8_MMA(0, 0, At, B0); PG8_BAR; PG8_SCHED;
            PG8_LDBX(B1, 1, 1); PG8_STAGE(PG8_SB(1, 0), b3, voffB);
            PG8_BAR; PG8_WAIT_L(0); PG8_MMA(0, 1, At, B1); PG8_BAR;
            PG8_LDAX(1, 1); PG8_STAGE(PG8_SA(1, 0), a3, voffA);
            PG8_BAR; PG8_WAIT_L(0); PG8_MMA(1, 0, At, B0); PG8_BAR; PG8_SCHED;
            PG8_STAGE(PG8_SB(1, 1), b3 + hstep, voffB);
            PG8_WAIT_V(6); PG8_BAR; PG8_MMA(1, 1, At, B1); PG8_BAR;
            }
        }
        if constexpr (ALIGN_EPI) { if (wr == 0) PG8_BAR; }
        if constexpr (ES == 1) asm volatile("s_nop 15\n\ts_nop 15" ::: "memory");
        E(acc, cur, wr, wc, fr, fq);
        if (!has_next) break;
        E.init(acc, nxt, wc, fq);
        cur = nxt; cA = nA; cB = nB; ++ui;
        if constexpr (ALIGN_EPI) { if (wr == 1) PG8_BAR; }
    }
    PG8_WAIT_V(0);
    if constexpr (!ALIGN_EPI) { if (wr == 0) PG8_BAR; }
    PG8_BAR;
#undef PG8_SA
#undef PG8_SB
#undef PG8_STAGE
#undef PG8_LDA
#undef PG8_LDA8
#undef PG8_LDB8
#undef PG8_LDAX
#undef PG8_LDBX
#undef PG8_LDB
#undef PG8_MMA
#undef PG8_WAIT_V
#undef PG8_WAIT_L
#undef PG8_BAR
#undef PG8_SCHED
}
}

#define XB_TMO      128
#define XB_XCNT(j)  (256  + 64 * (j))
#define XB_XSUB(j)  (1280 + 64 * (j))
#define XB_XGEN(j)  (2304 + 64 * (j))
#define XB_TOP      3328
#define XB_TOPGEN   3392
#define XCD_BAR_WORDS 3456
#define XB_SPIN_CAP (1u << 18)
__device__ __forceinline__ unsigned xb_ld(unsigned* p)              { return __hip_atomic_load(p, __ATOMIC_RELAXED, __HIP_MEMORY_SCOPE_AGENT); }
__device__ __forceinline__ unsigned xb_add(unsigned* p, unsigned v) { return __hip_atomic_fetch_add(p, v, __ATOMIC_RELAXED, __HIP_MEMORY_SCOPE_AGENT); }
__device__ __forceinline__ unsigned xb_xcc_id() { return (unsigned)__builtin_amdgcn_s_getreg((3 << 11) | 20) & 0xFu; }
#define XB_SPIN(cond, bar) do { unsigned _sp = 0; while (cond) { __builtin_amdgcn_s_sleep(1); \
    if ((++_sp & 255u) == 0u) { if (xb_ld(&(bar)[XB_TMO])) break; if (_sp > XB_SPIN_CAP) { atomicAdd(&(bar)[XB_TMO], 1u); break; } } } } while (0)

struct XcdBarrier {
    unsigned* bar; unsigned x;
    volatile LAS unsigned* st;
};

__device__ __forceinline__ XcdBarrier xcd_barrier_post(unsigned* bar, volatile LAS unsigned* st) {
    XcdBarrier b; b.bar = bar; b.x = xb_xcc_id(); b.st = st;
    if (threadIdx.x == 0) (void)xb_add(&bar[XB_XCNT(b.x)], 1u);
    return b;
}
__device__ __forceinline__ void xcd_barrier_complete(unsigned* bar, unsigned x, unsigned& nloc, unsigned& nx) {
    const unsigned G = gridDim.x * gridDim.y * gridDim.z;
    unsigned sum, cnt, mine, sp = 0u;
    for (;;) {
        sum = 0u; cnt = 0u; mine = 0u;
#pragma unroll
        for (unsigned j = 0; j < 16; ++j) { const unsigned c = xb_ld(&bar[XB_XCNT(j)]); sum += c; cnt += (c > 0u) ? 1u : 0u; mine = (j == x) ? c : mine; }
        if (sum == G) break;
        __builtin_amdgcn_s_sleep(1);
        if ((++sp & 255u) == 0u) { if (xb_ld(&bar[XB_TMO])) break; if (sp > XB_SPIN_CAP) { atomicAdd(&bar[XB_TMO], 1u); break; } }
    }
    nloc = mine > 0u ? mine : 1u; nx = cnt > 0u ? cnt : 1u;
}

__device__ __forceinline__ void xcd_barrier(const XcdBarrier& b) {
    asm volatile("s_waitcnt vmcnt(0)" ::: "memory");
    __syncthreads();
    if (threadIdx.x == 0) {
        unsigned* bar = b.bar;
        __builtin_amdgcn_s_waitcnt(0);
        unsigned nloc = b.st[0], nx = b.st[1];
        if (nloc == 0u) { xcd_barrier_complete(bar, b.x, nloc, nx); b.st[0] = nloc; b.st[1] = nx; }
        const unsigned old = xb_add(&bar[XB_XSUB(b.x)], 1u);
        const unsigned gen = old / nloc;
        if (old + 1u == (gen + 1u) * nloc) {
            __builtin_amdgcn_fence(__ATOMIC_RELEASE, "agent");
            asm volatile("s_waitcnt vmcnt(0)" ::: "memory");
            const unsigned og = xb_add(&bar[XB_TOP], 1u);
            const unsigned tg = og / nx;
            if (og + 1u == (tg + 1u) * nx) xb_add(&bar[XB_TOPGEN], 1u);
            else XB_SPIN(xb_ld(&bar[XB_TOPGEN]) == tg, bar);
            __builtin_amdgcn_fence(__ATOMIC_ACQUIRE, "agent");
            xb_add(&bar[XB_XGEN(b.x)], 1u);
            asm volatile("s_waitcnt vmcnt(0)" ::: "memory");
        } else {
            XB_SPIN(xb_ld(&bar[XB_XGEN(b.x)]) == gen, bar);
            __builtin_amdgcn_fence(__ATOMIC_ACQUIRE, "agent");
            asm volatile("s_waitcnt vmcnt(0)" ::: "memory");
        }
    }
    __syncthreads();
}

typedef short s4v __attribute__((ext_vector_type(4)));
__device__ __forceinline__ bf16x8 ldg8(const bf16* p) { return *(const bf16x8*)p; }
__device__ __forceinline__ f32x4 mfma16(bf16x8 a, bf16x8 b, f32x4 c) { return __builtin_amdgcn_mfma_f32_16x16x32_bf16(a, b, c, 0, 0, 0); }
__device__ __forceinline__ bf16x8 ldA(const LAS unsigned char* base, int pitch, int row0, int k0, int li, int g) { return *(const LAS bf16x8*)(base + ((row0 + li) * pitch + k0 + 8 * g) * 2); }
__device__ __forceinline__ bf16x8 ldT(const LAS unsigned char* base, int pitch, int k0, int n0, int li, int g) {
    const LAS unsigned char* p = base + ((k0 + 8 * g + (li >> 2)) * pitch + n0 + 4 * (li & 3)) * 2;
    const s4v a = __builtin_amdgcn_ds_read_tr16_b64_v4i16((LAS s4v*)p), b = __builtin_amdgcn_ds_read_tr16_b64_v4i16((LAS s4v*)(p + 8 * pitch));
    return (bf16x8){a[0], a[1], a[2], a[3], b[0], b[1], b[2], b[3]};
}
__device__ __forceinline__ bf16x8 ldAperm(const LAS unsigned char* base, int pitch, int row0, int ks, int li, int g) {
    const LAS unsigned char* p = base + ((row0 + li) * pitch + 32 * ks + 4 * g) * 2;
    const s4v a = *(const LAS s4v*)p, b = *(const LAS s4v*)(p + 32);
    return (bf16x8){a[0], a[1], a[2], a[3], b[0], b[1], b[2], b[3]};
}
__device__ __forceinline__ void stT(LAS unsigned char* base, int pitch, int n, int m0, const f32x4 v) {
    u32x2 w; w.x = pk2(v[0], v[1]); w.y = pk2(v[2], v[3]); *(LAS u32x2*)(base + (n * pitch + m0) * 2) = w;
}
__device__ __forceinline__ f32x4 ld4bf(const LAS unsigned char* p) { const u32x2 w = *(const LAS u32x2*)p; return (f32x4){bflo(w.x), bfhi(w.x), bflo(w.y), bfhi(w.y)}; }

struct Args {
    const float* in[31];
    float* out; unsigned char* ws;
    int ph_lo, ph_hi, use_bar, pad;
};
enum InIdx { I_X = 0, I_C, I_CTX, I_CCTX, I_ADAW, I_ADAB, I_N1G, I_N2G, I_WIN, I_WOUT, I_ASINK, I_BMIX, I_CREL, I_DCONV, I_DW0, I_DW2, I_DA0, I_DA2, I_DG2, I_DKK, I_DKA, I_DRK, I_DLNW, I_DLNB,
             I_RW, I_RB, I_WGU, I_BGU, I_WDN, I_BDN, I_FNG };
constexpr int NPL = 11;
constexpr int PH_TOTAL = 1 + DEPTH * NPL + 1;

struct DevIn {
    const LAS unsigned* tab;
    __device__ __forceinline__ const float* operator[](int i) const {
        const unsigned lo = __builtin_amdgcn_readfirstlane(((const volatile LAS unsigned*)tab)[2 * i]), hi = __builtin_amdgcn_readfirstlane(((const volatile LAS unsigned*)tab)[2 * i + 1]);
        return (const float*)(((unsigned long long)hi << 32) | lo);
    }
};
struct DArgs { DevIn in; float* out; };
struct Ctx {
    LAS unsigned char* lds;
    int tid, lane, wave, wg, G, gw, NGW;
    unsigned char* ws;
};

template <int NW>
__device__ __forceinline__ void transpose_item(const float* W, int K, int N, bf16* WT, int item, int lane) {
    constexpr int NQ = NW / 4, NC = 64 / NQ, PASSES = 8 / NC;
    const int nblk = N / NW, kb = item / nblk, nb = item % nblk, k0 = 64 * kb, n0 = NW * nb, nq = lane % NQ, cq = lane / NQ;
    f32x4 v[PASSES][8];
#pragma unroll
    for (int ps = 0; ps < PASSES; ++ps)
#pragma unroll
        for (int i = 0; i < 8; ++i) v[ps][i] = *(const f32x4*)(W + (size_t)(k0 + 8 * (cq + NC * ps) + i) * N + n0 + 4 * nq);
#pragma unroll
    for (int ps = 0; ps < PASSES; ++ps)
#pragma unroll
        for (int j = 0; j < 4; ++j) { u32x4 o; o.x = pk2(v[ps][0][j], v[ps][1][j]); o.y = pk2(v[ps][2][j], v[ps][3][j]); o.z = pk2(v[ps][4][j], v[ps][5][j]); o.w = pk2(v[ps][6][j], v[ps][7][j]);
            *(u32x4*)(WT + (size_t)(n0 + 4 * nq + j) * K + k0 + 8 * (cq + NC * ps)) = o; }
}
template <int NW>
__device__ __forceinline__ void transpose_item8(const float* W, int K, int N, unsigned char* WT, int item, int lane) {
    constexpr int NQ = NW / 4, NC = 64 / NQ, PASSES = 8 / NC;
    const int nblk = N / NW, kb = item / nblk, nb = item % nblk, k0 = 64 * kb, n0 = NW * nb, nq = lane % NQ, cq = lane / NQ;
    f32x4 v[PASSES][8];
#pragma unroll
    for (int ps = 0; ps < PASSES; ++ps)
#pragma unroll
        for (int i = 0; i < 8; ++i) v[ps][i] = *(const f32x4*)(W + (size_t)(k0 + 8 * (cq + NC * ps) + i) * N + n0 + 4 * nq) * pg8::W8_S;
#pragma unroll
    for (int ps = 0; ps < PASSES; ++ps)
#pragma unroll
        for (int j = 0; j < 4; ++j) { unsigned w0 = 0, w1 = 0;
            w0 = __builtin_amdgcn_cvt_pk_fp8_f32(v[ps][0][j], v[ps][1][j], w0, false); w0 = __builtin_amdgcn_cvt_pk_fp8_f32(v[ps][2][j], v[ps][3][j], w0, true);
            w1 = __builtin_amdgcn_cvt_pk_fp8_f32(v[ps][4][j], v[ps][5][j], w1, false); w1 = __builtin_amdgcn_cvt_pk_fp8_f32(v[ps][6][j], v[ps][7][j], w1, true);
            *(u32x2*)(WT + (size_t)(n0 + 4 * nq + j) * K + k0 + 8 * (cq + NC * ps)) = (u32x2){w0, w1}; }
}
constexpr int CV_IT_GU = 16 * 64, CV_IT_DN = 16 * 32, CV_N_GU = 32 * CV_IT_GU, CV_N_DN = 32 * CV_IT_DN, CV_ITEMS = CV_N_GU + CV_N_DN, CV_CHUNK = 16, CV_NCHUNK = CV_ITEMS / CV_CHUNK;
__device__ __forceinline__ void convert_moe_items(const Ctx& C, const DArgs& a, int l, int it0, int it1) {
    const float* pwgu = a.in[I_WGU] + (size_t)l * 32 * DM * 2048; const float* pwdn = a.in[I_WDN] + (size_t)l * 32 * DM * DM;
    unsigned char* ogu = C.ws + WS_WGU + (size_t)l * 32 * 2048 * DM; unsigned char* odn = C.ws + WS_WDN + (size_t)l * 32 * DM * DM;
#pragma unroll 1
    for (int it = it0; it < it1; ++it) {
        if (it < CV_N_GU) { const int e = it / CV_IT_GU; transpose_item8<32>(pwgu + (size_t)e * DM * 2048, DM, 2048, ogu + (size_t)e * 2048 * DM, it % CV_IT_GU, C.lane); }
        else { const int r = it - CV_N_GU, e = r / CV_IT_DN; transpose_item8<32>(pwdn + (size_t)e * DM * DM, DM, DM, odn + (size_t)e * DM * DM, r % CV_IT_DN, C.lane); }
    }
}
__device__ __forceinline__ void phase_prologue(const Ctx& C, const DArgs& a) {
    constexpr int IT_IN = 16 * (INW / 32), IT_OUT = 16 * 16;
    constexpr int N_IN = 4 * IT_IN, N_OUT = 4 * IT_OUT;
    const float* pwin = a.in[I_WIN]; const float* pwout = a.in[I_WOUT];
    for (int it = C.gw; it < N_IN + N_OUT; it += C.NGW) {
        if (it < N_IN) { const int l = it / IT_IN; transpose_item<32>(pwin + (size_t)l * DM * INW, DM, INW, (bf16*)(C.ws + WS_WIN) + (size_t)l * INWP * DM, it % IT_IN, C.lane); }
        else { const int r = it - N_IN, l = r / IT_OUT; transpose_item<64>(pwout + (size_t)l * DM * DM, DM, DM, (bf16*)(C.ws + WS_WOUT) + (size_t)l * DM * DM, r % IT_OUT, C.lane); }
    }
    for (int ch = C.gw; ch < CV_NCHUNK; ch += C.NGW) convert_moe_items(C, a, 0, ch * CV_CHUNK, ch * CV_CHUNK + CV_CHUNK);
    { const int gt = C.wg * NTHR + C.tid; constexpr int PADN = (INWP - INW) * DM / 8;
      for (int i = gt; i < 4 * PADN; i += C.G * NTHR) { const int l = i / PADN, r = i % PADN; *((u32x4*)((bf16*)(C.ws + WS_WIN) + ((size_t)l * INWP + INW) * DM) + r) = (u32x4){0u, 0u, 0u, 0u}; } }
    { float* tw = (float*)(C.ws + WS_TW); const int gt = C.wg * NTHR + C.tid;
      for (int i = gt; i < 16384; i += C.G * NTHR) { const float x = (float)i * (1.0f / 8192.0f); tw[i] = cospif(x); tw[16384 + i] = sinpif(x); } }
    { float* mt = (float*)(C.ws + WS_MTAB); const int gt = C.wg * NTHR + C.tid; const float* pbmix = a.in[I_BMIX];
      for (int i = gt; i < 4 * 4 * 64 * 64; i += C.G * NTHR) { const int e = i & 63, c = (i >> 6) & 63, g = (i >> 12) & 3, l = i >> 14;
          const float* w = pbmix + ((size_t)(l * 4 + g) * 64) * 64 + e; float sc = 0.f, ss = 0.f;
          for (int cp = 0; cp < 64; ++cp) { const float x = (float)((c * cp) & 63) * (1.0f / 32.0f); const float wv = w[cp * 64]; sc += cospif(x) * wv; ss += sinpif(x) * wv; }
          mt[((size_t)(l * 2 + 0) * 4 + g) * 4096 + c * 64 + e] = sc; mt[((size_t)(l * 2 + 1) * 4 + g) * 4096 + c * 64 + e] = ss; } }
    { bf16* ft = (bf16*)(C.ws + WS_FTAB); const int gt = C.wg * NTHR + C.tid; const float* pbmix = a.in[I_BMIX];
      for (int i = gt; i < 128 * 128; i += C.G * NTHR) { const int k = i >> 7, t = i & 127; const float x = (float)((k * t) & 127) * (1.0f / 64.0f); ft[i] = (bf16)f2bf(cospif(x)); ft[16384 + i] = (bf16)f2bf(sinpif(x)); }
      bf16* mf = ft + 32768;
      for (int i = gt; i < 4 * 4 * 16 * 64 * 8; i += C.G * NTHR) { const int j8 = i & 7, ln = (i >> 3) & 63, fr = (i >> 9) & 15, gq = (i >> 13) & 3, l = i >> 15;
          const int ei = fr >> 2, ks2 = fr & 3, e = 16 * ei + (ln & 15), g = ln >> 4, c = 32 * (ks2 & 1) + 16 * (j8 >> 2) + 4 * g + (j8 & 3), part = ks2 >> 1;
          const float* w = pbmix + ((size_t)(l * 4 + gq) * 64) * 64 + e; float s = 0.f;
          for (int cp = 0; cp < 64; ++cp) { const float x = (float)((c * cp) & 63) * (1.0f / 32.0f); s += (part ? sinpif(x) : cospif(x)) * w[cp * 64]; }
          mf[i] = (bf16)f2bf(s * (1.0f / 1024.0f)); } }
    { const int gt = C.wg * NTHR + C.tid; const float* pg2 = a.in[I_DG2]; const float* prw = a.in[I_RW]; bf16* g2t = (bf16*)(C.ws + WS_G2T); bf16* rwt = (bf16*)(C.ws + WS_RWT);
      for (int i = gt; i < 4 * 256 * 160; i += C.G * NTHR) { const int ii = i % 160, c = (i / 160) & 255, l = i / (160 * 256); g2t[i] = (bf16)f2bf(pg2[((size_t)l * 160 + ii) * 256 + c]); }
      for (int i = gt; i < 4 * 32 * 1024; i += C.G * NTHR) { const int k = i & 1023, e = (i >> 10) & 31, l = i >> 15; rwt[i] = (bf16)f2bf(prw[((size_t)l * 1024 + k) * 32 + e]); } }
    { const int gt = C.wg * NTHR + C.tid; const float* pw2 = a.in[I_DW2]; const float* pa2 = a.in[I_DA2]; bf16* lt = (bf16*)(C.ws + WS_LORAT);
      for (int i = gt; i < 4 * 4 * 256 * 64; i += C.G * NTHR) { const int ii = i & 63, c = (i >> 6) & 255, q = (i >> 14) & 3, l = i >> 16;
          const float* src = (q < 2) ? pw2 : pa2; lt[i] = (bf16)f2bf(src[(((size_t)l * 2 + (q & 1)) * 64 + ii) * 256 + c]); } }
    { bf16* f2 = (bf16*)(C.ws + WS_F256); const int gt = C.wg * NTHR + C.tid;
      for (int i = gt; i < 256 * 256; i += C.G * NTHR) { const int k = i >> 8, t = i & 255; const float x = (float)((k * t) & 255) * (1.0f / 128.0f); f2[i] = (bf16)f2bf(cospif(x)); f2[65536 + i] = (bf16)f2bf(sinpif(x)); } }
    { LAS float* sl = (LAS float*)(C.lds);
      LAS float* red = (LAS float*)(C.lds + 8192);
      __syncthreads();
      const float* pc = a.in[I_C]; const float* pcc = a.in[I_CCTX]; const float* padaw = a.in[I_ADAW]; const float* padab = a.in[I_ADAB];
      for (int i = C.tid; i < 2048; i += NTHR) { const float x = (i < 1024) ? pc[i] : pcc[i - 1024]; sl[i] = x * sigmoidf_(x); }
      __syncthreads();
      float* mod = (float*)(C.ws + WS_MOD);
      for (int u = C.wg; u < 4 * 96; u += C.G) { const int l = u / 96, jb = u % 96, j0 = jb * 64 + C.lane;
          float s0 = 0.f, s1 = 0.f; const float* w = padaw + (size_t)l * DM * 6144 + j0; const int k0 = C.wave * 128;
#pragma unroll 16
          for (int k = 0; k < 128; ++k) { const float wv = w[(size_t)(k0 + k) * 6144]; s0 += wv * sl[k0 + k]; s1 += wv * sl[1024 + k0 + k]; }
          red[(C.wave * 2 + 0) * 64 + C.lane] = s0; red[(C.wave * 2 + 1) * 64 + C.lane] = s1;
          __syncthreads();
          if (C.tid < 128) { const int v = C.tid >> 6, j = C.tid & 63; float s = 0.f;
#pragma unroll
              for (int wv = 0; wv < 8; ++wv) s += red[(wv * 2 + v) * 64 + j];
              mod[(size_t)(l * 2 + v) * 6144 + jb * 64 + j] = s + padab[(size_t)l * 6144 + jb * 64 + j]; }
          __syncthreads(); } }
}

__device__ __forceinline__ void load_row(const float* p, int lane, f32x4 (&v)[4]) {
#pragma unroll
    for (int j = 0; j < 4; ++j) v[j] = *((const f32x4*)p + lane + 64 * j);
}
__device__ __forceinline__ void moe_combine_row(const Ctx& C, int row, f32x4 (&v)[4], const float* gt2) {
    const int* dest = (const int*)(C.ws + WS_ROUTE) + (size_t)3 * ROWS * 4; const float* gate = (const float*)(C.ws + WS_ROUTE) + (size_t)1 * ROWS * 4;
    const bf16* YB = (const bf16*)(C.ws + WS_XG);
    f32x4 s[4];
#pragma unroll
    for (int j = 0; j < 4; ++j) s[j] = (f32x4){0.f, 0.f, 0.f, 0.f};
#pragma unroll
    for (int k = 0; k < 4; ++k) { const int d = dest[row * 4 + k]; const float g = gate[row * 4 + k]; const u32x2* yp = (const u32x2*)(YB + (size_t)d * DM) + C.lane;
#pragma unroll
        for (int j = 0; j < 4; ++j) { const u32x2 w = yp[64 * j]; s[j] += (f32x4){bflo(w.x), bfhi(w.x), bflo(w.y), bfhi(w.y)} * g; } }
#pragma unroll
    for (int j = 0; j < 4; ++j) v[j] += *((const f32x4*)gt2 + C.lane + 64 * j) * s[j];
}
__device__ __forceinline__ float row_rstd(const f32x4 (&v)[4], int lane) {
    float s = 0.f;
#pragma unroll
    for (int j = 0; j < 4; ++j) s += (v[j].x * v[j].x + v[j].y * v[j].y) + (v[j].z * v[j].z + v[j].w * v[j].w);
    return rsqrtf(wave_sum(s, lane) * (1.f / DM) + 1e-6f);
}
__device__ __forceinline__ void phase_norm1(const Ctx& C, const DArgs& a, int l) {
    float* XS = (float*)(C.ws + WS_XS); bf16* H = (bf16*)(C.ws + WS_H); const float* mod = (const float*)(C.ws + WS_MOD);
    const float* g1 = a.in[I_N1G] + (size_t)l * DM;
    const float* pctx = a.in[I_CTX]; const float* px = a.in[I_X];
    for (int row = C.gw; row < ROWS; row += C.NGW) {
        const bool isctx = row < NCTX; f32x4 v[4];
        if (l == 0) { load_row(isctx ? pctx + (size_t)row * DM : px + (size_t)(row - NCTX) * DM, C.lane, v); }
        else { load_row(XS + (size_t)row * DM, C.lane, v);
               if (!(l == DEPTH && isctx)) moe_combine_row(C, row, v, mod + (size_t)((l - 1) * 2 + (isctx ? 1 : 0)) * 6144 + 5 * DM); }
        if (l == 0 || true) {
#pragma unroll
            for (int j = 0; j < 4; ++j) *((f32x4*)(XS + (size_t)row * DM) + C.lane + 64 * j) = v[j]; }
        const float rstd = row_rstd(v, C.lane);
        const float* md = mod + (size_t)(l * 2 + (isctx ? 1 : 0)) * 6144;
        u32x2* o = (u32x2*)(H + (size_t)row * DM) + C.lane;
#pragma unroll
        for (int j = 0; j < 4; ++j) { const f32x4 g = *((const f32x4*)g1 + C.lane + 64 * j), sh = *((const f32x4*)md + C.lane + 64 * j), sc = *((const f32x4*)(md + DM) + C.lane + 64 * j);
            const f32x4 y = v[j] * rstd * g * (sc + 1.0f) + sh; u32x2 w; w.x = pk2(y.x, y.y); w.y = pk2(y.z, y.w); o[64 * j] = w; }
    }
}
__device__ __forceinline__ void phase_final(const Ctx& C, const DArgs& a) {
    const float* XS = (const float*)(C.ws + WS_XS); const float* mod = (const float*)(C.ws + WS_MOD); const float* g = a.in[I_FNG];
    for (int row = NCTX + C.gw; row < ROWS; row += C.NGW) {
        f32x4 v[4]; load_row(XS + (size_t)row * DM, C.lane, v);
        moe_combine_row(C, row, v, mod + (size_t)((DEPTH - 1) * 2 + 0) * 6144 + 5 * DM);
        const float rstd = row_rstd(v, C.lane);
        float* o = a.out + (size_t)(row - NCTX) * DM;
#pragma unroll
        for (int j = 0; j < 4; ++j) *((f32x4*)o + C.lane + 64 * j) = v[j] * rstd * *((const f32x4*)g + C.lane + 64 * j);
    }
}
constexpr int NR2 = 9;
__device__ __forceinline__ void phase_norm2(const Ctx& C, const DArgs& a, int l) {
    const float* XS = (const float*)(C.ws + WS_XS); bf16* H = (bf16*)(C.ws + WS_H); const float* mod = (const float*)(C.ws + WS_MOD);
    const float* g2 = a.in[I_N2G] + (size_t)l * DM; const float* rb = a.in[I_RB] + (size_t)l * NEXP; const bf16* rwt = (const bf16*)(C.ws + WS_RWT) + (size_t)l * NEXP * DM;
    int* tok_e = (int*)(C.ws + WS_ROUTE); float* gate = (float*)(C.ws + WS_ROUTE) + (size_t)1 * ROWS * 4; int* slot = (int*)(C.ws + WS_ROUTE) + (size_t)2 * ROWS * 4;
    LAS float* lg = (LAS float*)(C.lds + C.wave * 4096);
    LAS int* hist = (LAS int*)(C.lds + MISC_OFF + 64);
    const int lane = C.lane, li = lane & 15, g = lane >> 4;
    if (C.tid < NEXP) hist[C.tid] = 0;
    __syncthreads();
    const int row_base = (l == DEPTH - 1) ? NCTX : 0, ntile = (ROWS - row_base + NR2 - 1) / NR2;
    for (int tl = C.gw; tl < ntile; tl += C.NGW) {
        const int trow0 = row_base + NR2 * tl, nrow = (ROWS - trow0 < NR2) ? ROWS - trow0 : NR2;
#pragma unroll 1
        for (int rr = 0; rr < nrow; ++rr) { const int row = trow0 + rr; const bool isctx = row < NCTX; f32x4 v[4]; load_row(XS + (size_t)row * DM, lane, v);
            const float rstd = row_rstd(v, lane);
            const float* md = mod + (size_t)(l * 2 + (isctx ? 1 : 0)) * 6144 + 3 * DM;
            u32x2* o = (u32x2*)(H + (size_t)row * DM) + lane;
#pragma unroll
            for (int j = 0; j < 4; ++j) { const f32x4 gg = *((const f32x4*)g2 + lane + 64 * j), sh = *((const f32x4*)md + lane + 64 * j), sc = *((const f32x4*)(md + DM) + lane + 64 * j);
                const f32x4 y = v[j] * rstd * gg * (sc + 1.0f) + sh; u32x2 w; w.x = pk2(y.x, y.y); w.y = pk2(y.z, y.w); o[64 * j] = w; } }
        asm volatile("s_waitcnt vmcnt(0)" ::: "memory");
        f32x4 acc0 = {0.f, 0.f, 0.f, 0.f}, acc1 = {0.f, 0.f, 0.f, 0.f};
        const int arow = (trow0 + li < ROWS) ? trow0 + li : ROWS - 1;
        const bf16* ap = H + (size_t)arow * DM + 8 * g; const bf16* bp0 = rwt + (size_t)li * DM + 8 * g; const bf16* bp1 = bp0 + 16 * DM;
#pragma unroll 4
        for (int ks = 0; ks < 32; ++ks) { const bf16x8 af = *(const bf16x8*)(ap + 32 * ks); acc0 = mfma16(af, *(const bf16x8*)(bp0 + 32 * ks), acc0); acc1 = mfma16(af, *(const bf16x8*)(bp1 + 32 * ks), acc1); }
#pragma unroll
        for (int r = 0; r < 4; ++r) { lg[(4 * g + r) * 33 + li] = acc0[r]; lg[(4 * g + r) * 33 + 16 + li] = acc1[r]; }
        LDS_WAIT(); asm volatile("" ::: "memory");
        const int e = lane & 31; const float rbe = rb[e];
#pragma unroll 1
        for (int rr = 0; rr < nrow; ++rr) { const int row = trow0 + rr;
            float val = lg[rr * 33 + e] + rbe; int te[4]; float tv[4];
#pragma unroll
            for (int k = 0; k < 4; ++k) { float bv = val; int bi = e;
#define AMAX_ROR(n) { const float ov = __builtin_bit_cast(float, __builtin_amdgcn_update_dpp(0, __builtin_bit_cast(int, bv), 0x120 + (n), 0xf, 0xf, false)); const int oi = __builtin_amdgcn_update_dpp(0, bi, 0x120 + (n), 0xf, 0xf, false); \
                    if (ov > bv || (ov == bv && oi < bi)) { bv = ov; bi = oi; } }
                AMAX_ROR(8) AMAX_ROR(4) AMAX_ROR(2) AMAX_ROR(1)
#undef AMAX_ROR
                { const float ov = shx(bv, 16, lane); const int oi = shxi(bi, 16, lane); if (ov > bv || (ov == bv && oi < bi)) { bv = ov; bi = oi; } }
                te[k] = bi; tv[k] = bv; if (e == bi) val = -3.0e38f; }
            if (lane == 0) { const float m = tv[0]; float p[4], ps = 0.f;
#pragma unroll
                for (int k = 0; k < 4; ++k) { p[k] = __expf(tv[k] - m); ps += p[k]; }
#pragma unroll
                for (int k = 0; k < 4; ++k) { tok_e[row * 4 + k] = te[k]; gate[row * 4 + k] = p[k] / ps; slot[row * 4 + k] = __hip_atomic_fetch_add(&hist[te[k]], 1, __ATOMIC_RELAXED, __HIP_MEMORY_SCOPE_WORKGROUP); } } }
        asm volatile("" ::: "memory");
    }
    __syncthreads();
    if (C.tid < NEXP) ((int*)(C.ws + WS_CNT))[C.wg * NEXP + C.tid] = hist[C.tid];
}
__device__ __forceinline__ int moe_tables(const Ctx& C) {
    const int* cnt = (const int*)(C.ws + WS_CNT);
    LAS int* part = (LAS int*)(C.lds);
    LAS int* pstart = (LAS int*)(C.lds + MISC_OFF + 256); LAS int* wgbase = pstart + 40; LAS int* tot = wgbase + 32; LAS int* nblk_s = tot + 32;
    LAS unsigned char* blk_e = (LAS unsigned char*)(C.lds + MISC_OFF + 1024);
    __syncthreads();
    { const int e = C.tid & 31, p = C.tid >> 5; int t = 0, pre = 0;
#pragma unroll 1
      for (int w = p * 16; w < p * 16 + 16; ++w) { const int c = cnt[w * NEXP + e]; t += c; if (w < C.wg) pre += c; }
      part[(p * 32 + e) * 2] = t; part[(p * 32 + e) * 2 + 1] = pre; }
    __syncthreads();
    if (C.tid < NEXP) { int t = 0, pre = 0;
#pragma unroll 1
        for (int p = 0; p < 16; ++p) { t += part[(p * 32 + C.tid) * 2]; pre += part[(p * 32 + C.tid) * 2 + 1]; }
        tot[C.tid] = t; wgbase[C.tid] = pre; }
    __syncthreads();
    if (C.tid == 0) { int b = 0;
#pragma unroll 1
        for (int e = 0; e < NEXP; ++e) { pstart[e] = b * 256; b += (tot[e] + 255) >> 8; }
        pstart[NEXP] = b * 256; nblk_s[0] = b; }
    __syncthreads();
    if (C.tid < NEXP) wgbase[C.tid] += pstart[C.tid];
    if (C.tid < MOE_MAXBLK) { int e = 0;
#pragma unroll 1
        for (int k = 1; k < NEXP; ++k) if (pstart[k] <= C.tid * 256) e = k;
        blk_e[C.tid] = (unsigned char)e; }
    __syncthreads();
    return __builtin_amdgcn_readfirstlane(nblk_s[0]);
}
__device__ __forceinline__ void phase_gather(const Ctx& C, const DArgs& a, int l) {
    moe_tables(C);
    const LAS int* wgbase = (const LAS int*)(C.lds + MISC_OFF + 256) + 40;
    const int* tok_e = (const int*)(C.ws + WS_ROUTE); const int* slot = (const int*)(C.ws + WS_ROUTE) + (size_t)2 * ROWS * 4; int* dest = (int*)(C.ws + WS_ROUTE) + (size_t)3 * ROWS * 4;
    const bf16* H = (const bf16*)(C.ws + WS_H); unsigned char* XG = C.ws + WS_XG8;
    const int row_base = (l == DEPTH - 1) ? NCTX : 0, ntile = (ROWS - row_base + NR2 - 1) / NR2;
    for (int tl = C.gw; tl < ntile; tl += C.NGW)
    for (int row = row_base + NR2 * tl; row < row_base + NR2 * tl + NR2 && row < ROWS; ++row) {
        const u32x4* src = (const u32x4*)(H + (size_t)row * DM) + C.lane; const u32x4 v0 = src[0], v1 = src[64];
        u32x2 q0, q1;
        { unsigned w = 0; w = __builtin_amdgcn_cvt_pk_fp8_f32(bflo(v0.x) * pg8::X8_S, bfhi(v0.x) * pg8::X8_S, w, false); w = __builtin_amdgcn_cvt_pk_fp8_f32(bflo(v0.y) * pg8::X8_S, bfhi(v0.y) * pg8::X8_S, w, true); q0.x = w;
          w = 0; w = __builtin_amdgcn_cvt_pk_fp8_f32(bflo(v0.z) * pg8::X8_S, bfhi(v0.z) * pg8::X8_S, w, false); w = __builtin_amdgcn_cvt_pk_fp8_f32(bflo(v0.w) * pg8::X8_S, bfhi(v0.w) * pg8::X8_S, w, true); q0.y = w;
          w = 0; w = __builtin_amdgcn_cvt_pk_fp8_f32(bflo(v1.x) * pg8::X8_S, bfhi(v1.x) * pg8::X8_S, w, false); w = __builtin_amdgcn_cvt_pk_fp8_f32(bflo(v1.y) * pg8::X8_S, bfhi(v1.y) * pg8::X8_S, w, true); q1.x = w;
          w = 0; w = __builtin_amdgcn_cvt_pk_fp8_f32(bflo(v1.z) * pg8::X8_S, bfhi(v1.z) * pg8::X8_S, w, false); w = __builtin_amdgcn_cvt_pk_fp8_f32(bflo(v1.w) * pg8::X8_S, bfhi(v1.w) * pg8::X8_S, w, true); q1.y = w; }
#pragma unroll
        for (int k = 0; k < 4; ++k) { const int d = wgbase[tok_e[row * 4 + k]] + slot[row * 4 + k]; if (C.lane == 0) dest[row * 4 + k] = d;
            u32x2* dp = (u32x2*)(XG + (size_t)d * DM) + C.lane; dp[0] = q0; dp[64] = q1; }
    }
}

__device__ __forceinline__ void mix1_rope(const Ctx& C) {
    bf16* P = (bf16*)(C.ws + WS_P);
    const long total = (long)SEQ * 192;
    for (long i = (long)C.wg * NTHR + C.tid; i < total; i += (long)C.G * NTHR) {
        const int j = (int)(i & 31), hh = (int)((i >> 5) % 6), t = (int)(i / 192);
        const int col = (hh < 4) ? (C_AQ + hh * 64) : (C_AK + (hh - 4) * 64);
        const float pos = (j < 16) ? (float)(t >> 6) : (float)(t & 63);
        const float inv = __powf(10000.0f, -(float)(j & 15) * (1.0f / 16.0f));
        const float ang = pos * inv * 0.31830988618379067f;
        const float cs = cospif(ang), sn = sinpif(ang);
        bf16* p = P + (size_t)(NCTX + t) * INWP + col;
        const float x1 = bf2f(p[j]), x2 = bf2f(p[j + 32]);
        p[j] = (bf16)f2bf(x1 * cs - x2 * sn); p[j + 32] = (bf16)f2bf(x2 * cs + x1 * sn);
    }
}
__device__ __forceinline__ void mix1_vt(const Ctx& C) {
    const bf16* P = (const bf16*)(C.ws + WS_P);
    LAS unsigned short* scr = (LAS unsigned short*)(C.lds + C.wave * 16384);
    for (int u = C.gw; u < (ROWS / 64) * 6; u += C.NGW) {
        const int hd = u % 6, tb = u / 6; const int vcol = (hd < 2) ? (C_AV + hd * 64) : (C_CV + (hd - 2) * 64);
        bf16* VT = ((hd < 2) ? (bf16*)(C.ws + WS_VTA) + (size_t)hd * 64 * VTP : (bf16*)(C.ws + WS_VTC) + (size_t)(hd - 2) * 64 * VTP);
#pragma unroll
        for (int i = 0; i < 8; ++i) { const int tk = (C.lane >> 3) + 8 * i, ch = C.lane & 7; const u32x4 w = *(const u32x4*)(P + (size_t)(tb * 64 + tk) * INWP + vcol + 8 * ch);
            LAS unsigned* d = (LAS unsigned*)(scr + tk * 66 + 8 * ch); d[0] = w.x; d[1] = w.y; d[2] = w.z; d[3] = w.w; }
        LDS_WAIT(); asm volatile("" ::: "memory");
#pragma unroll
        for (int k8 = 0; k8 < 8; ++k8) { unsigned w[4];
#pragma unroll
            for (int e2 = 0; e2 < 4; ++e2) { const unsigned lo = scr[(8 * k8 + 2 * e2) * 66 + C.lane], hi = scr[(8 * k8 + 2 * e2 + 1) * 66 + C.lane]; w[e2] = lo | (hi << 16); }
            *(u32x4*)(VT + (size_t)C.lane * VTP + tb * 64 + 8 * k8) = (u32x4){w[0], w[1], w[2], w[3]}; }
        LDS_WAIT(); asm volatile("" ::: "memory");
    }
    for (int i = C.wg * NTHR + C.tid; i < 6 * 64 * 32; i += C.G * NTHR) { const int rowi = i >> 5, pc = i & 31; const int hd = rowi >> 6, d = rowi & 63;
        bf16* VT = ((hd < 2) ? (bf16*)(C.ws + WS_VTA) + (size_t)hd * 64 * VTP : (bf16*)(C.ws + WS_VTC) + (size_t)(hd - 2) * 64 * VTP);
        *(u32x4*)(VT + (size_t)d * VTP + ROWS + 8 * pc) = (u32x4){0u, 0u, 0u, 0u}; }
}
__device__ __forceinline__ float conv3(const bf16* P, int row, int col, const float* cw, int cc) {
    const bool first = (row == 0) || (row == NCTX), last = (row == NCTX - 1) || (row == ROWS - 1);
    float s = cw[768 + cc] * bf2f(P[(size_t)row * INWP + col]);
    if (!first) s += cw[cc] * bf2f(P[(size_t)(row - 1) * INWP + col]);
    if (!last) s += cw[2 * 768 + cc] * bf2f(P[(size_t)(row + 1) * INWP + col]);
    return s;
}
__device__ __forceinline__ void mix1_rwkv_prep(const Ctx& C, const DArgs& a, int l) {
    const bf16* P = (const bf16*)(C.ws + WS_P); float* SC = (float*)(C.ws + WS_SC);
    constexpr int LBP = 264;
    LAS unsigned char* lob = C.lds;
    LAS float* pre = (LAS float*)(C.lds + 16384);
    const bf16* lorat = (const bf16*)(C.ws + WS_LORAT) + (size_t)l * 4 * 256 * 64;
    const float* cw = a.in[I_DCONV] + (size_t)l * 3 * 768;
    const float* w0 = a.in[I_DW0] + (size_t)l * 512; const float* a0 = a.in[I_DA0] + (size_t)l * 512;
    const float* kkw = a.in[I_DKK] + (size_t)l * 256; const float* kaw = a.in[I_DKA] + (size_t)l * 256;
    const int half = C.tid >> 8, c = C.tid & 255, lane = C.lane, li = lane & 15, g = lane >> 4;
    const float kkc = kkw[c], kac = kaw[c];
    for (int grp = C.wg; grp < ROWS / 13; grp += C.G) {
        const int row0 = 13 * grp + 7 * half, nj = 7 - half;
        __syncthreads();
#pragma unroll
        for (int j = 0; j < 7; ++j) if (j < nj) { const float x = bf2f(P[(size_t)(row0 + j) * INWP + C_WL + c]); *(LAS bf16*)(lob + ((7 * half + j) * LBP + c) * 2) = (bf16)f2bf((c < 128) ? tanhf(x) : x); }
        __syncthreads();
#pragma unroll
        for (int q = 0; q < 4; ++q) { const bf16x8 a0f = ldA(lob, LBP, 0, 64 * q, li, g), a1f = ldA(lob, LBP, 0, 64 * q + 32, li, g);
#pragma unroll
            for (int c2 = 0; c2 < 2; ++c2) { const int ci = 2 * C.wave + c2; const bf16* bp = lorat + ((size_t)q * 256 + 16 * ci + li) * 64 + 8 * g;
                f32x4 acc = {0.f, 0.f, 0.f, 0.f}; acc = mfma16(a0f, ldg8(bp), acc); acc = mfma16(a1f, ldg8(bp + 32), acc);
#pragma unroll
                for (int r = 0; r < 4; ++r) pre[(q * 16 + 4 * g + r) * 256 + 16 * ci + li] = acc[r]; } }
        __syncthreads();
#pragma unroll
        for (int j = 0; j < 7; ++j) if (j < nj) { const int row = row0 + j, rl = 7 * half + j; const float r = conv3(P, row, C_DR + c, cw, c), k = conv3(P, row, C_DK + c, cw, 256 + c), v = conv3(P, row, C_DV + c, cw, 512 + c);
            float kk = k * kkc; const float n2 = wave_sum(kk * kk, lane); kk *= rsqrtf(fmaxf(n2, 1e-24f));
            float* sc = SC + (size_t)row * 9 * 256; sc[c] = r; sc[256 + c] = v; sc[512 + c] = -kk;
#pragma unroll
            for (int d = 0; d < 2; ++d) { const float wp = w0[d * 256 + c] + pre[(d * 16 + rl) * 256 + c], ap = a0[d * 256 + c] + pre[((2 + d) * 16 + rl) * 256 + c];
                const float nw = -wp, sp = fmaxf(nw, 0.f) + log1pf(__expf(-fabsf(nw)));
                const float lw = -__expf(-sp - 0.5f);
                const float as = sigmoidf_(ap);
                sc[(3 + 3 * d) * 256 + c] = lw; sc[(4 + 3 * d) * 256 + c] = k * (1.0f + (as - 1.0f) * kac); sc[(5 + 3 * d) * 256 + c] = kk * as; } }
    }
    __syncthreads();
}
constexpr int FP = 136;
constexpr int F_TABC = 0, F_TABS = 128 * FP * 2, F_TILE = 2 * 128 * FP * 2;
__device__ __forceinline__ void fourier_load_tables(const Ctx& C) {
    const bf16* ft = (const bf16*)(C.ws + WS_FTAB);
    for (int i = C.tid; i < 2 * 128 * 16; i += NTHR) { const int tb = i >> 11, r = (i >> 4) & 127, c8 = i & 15;
        *(LAS u32x4*)(C.lds + tb * F_TABS + (r * FP + 8 * c8) * 2) = *(const u32x4*)(ft + tb * 16384 + r * 128 + 8 * c8); }
}
__device__ __forceinline__ void mix1_fourier1(const Ctx& C) {
    const bf16* P = (const bf16*)(C.ws + WS_P); const float* tw = (const float*)(C.ws + WS_TW);
    bf16* FYR = (bf16*)(C.ws + WS_FYR); bf16* FYI = (bf16*)(C.ws + WS_FYI);
    const int lane = C.lane, li = lane & 15, g = lane >> 4, w = C.wave;
    __syncthreads();
    fourier_load_tables(C);
    for (int u = C.wg; u < 256; u += C.G) {
        const int t2 = u >> 1, ch0 = (u & 1) * 128;
        __syncthreads();
        for (int i = C.tid; i < 128 * 16; i += NTHR) { const int t1 = i >> 4, c8 = i & 15;
            *(LAS u32x4*)(C.lds + F_TILE + (t1 * FP + 8 * c8) * 2) = *(const u32x4*)(P + (size_t)(NCTX + 128 * t1 + t2) * INWP + C_BU + ch0 + 8 * c8); }
        __syncthreads();
        bf16x8 af[4];
#pragma unroll
        for (int ks = 0; ks < 4; ++ks) af[ks] = ldT(C.lds + F_TILE, FP, 32 * ks, 16 * w, li, g);
#pragma unroll 1
        for (int ni = 0; ni < 8; ++ni) { f32x4 dc = {0.f, 0.f, 0.f, 0.f}, ds = {0.f, 0.f, 0.f, 0.f};
#pragma unroll
            for (int ks = 0; ks < 4; ++ks) { dc = mfma16(af[ks], ldA(C.lds + F_TABC, FP, 16 * ni, 32 * ks, li, g), dc); ds = mfma16(af[ks], ldA(C.lds + F_TABS, FP, 16 * ni, 32 * ks, li, g), ds); }
            const int k1 = 16 * ni + li; const float cp = tw[t2 * k1], sp = tw[16384 + t2 * k1];
            const f32x4 yr = dc * cp - ds * sp, yi = -(ds * cp) - dc * sp;
            const size_t o = ((size_t)k1 * 128 + t2) * 256 + ch0 + 16 * w + 4 * g;
            u32x2 wr; wr.x = pk2(yr[0], yr[1]); wr.y = pk2(yr[2], yr[3]); *(u32x2*)(FYR + o) = wr;
            u32x2 wi; wi.x = pk2(yi[0], yi[1]); wi.y = pk2(yi[2], yi[3]); *(u32x2*)(FYI + o) = wi; }
    }
    __syncthreads();
}
__device__ __forceinline__ void fourier2_mfma(const Ctx& C, int l, int wg0) {
    const bf16* FYR = (const bf16*)(C.ws + WS_FYR); const bf16* FYI = (const bf16*)(C.ws + WS_FYI); bf16* MIX = (bf16*)(C.ws + WS_MIX);
    const int lane = C.lane, li = lane & 15, g = lane >> 4, w = C.wave;
    constexpr int YP = 72, F_YR = F_TILE, F_YI = F_TILE + 128 * YP * 2;
    __syncthreads();
    fourier_load_tables(C);
    for (int u = C.wg - wg0; u < 512; u += C.G - wg0) {
        const int k1 = u >> 2, gq = u & 3;
        __syncthreads();
        for (int i = C.tid; i < 2 * 128 * 8; i += NTHR) { const int im = i >> 10, t2 = (i >> 3) & 127, c8 = i & 7;
            *(LAS u32x4*)(C.lds + (im ? F_YI : F_YR) + (t2 * YP + 8 * c8) * 2) = *(const u32x4*)((im ? FYI : FYR) + ((size_t)k1 * 128 + t2) * 256 + gq * 64 + 8 * c8); }
        __syncthreads();
        bf16x8 bc[4], bs[4];
#pragma unroll
        for (int ks = 0; ks < 4; ++ks) { bc[ks] = ldA(C.lds + F_TABC, FP, 16 * w, 32 * ks, li, g); bs[ks] = ldA(C.lds + F_TABS, FP, 16 * w, 32 * ks, li, g); }
        f32x4 xr[4], xi[4];
#pragma unroll
        for (int ci = 0; ci < 4; ++ci) { xr[ci] = (f32x4){0.f, 0.f, 0.f, 0.f}; f32x4 xs = {0.f, 0.f, 0.f, 0.f}; xi[ci] = xs;
#pragma unroll
            for (int ks = 0; ks < 4; ++ks) { const bf16x8 ar = ldT(C.lds + F_YR, YP, 32 * ks, 16 * ci, li, g), ai = ldT(C.lds + F_YI, YP, 32 * ks, 16 * ci, li, g);
                xr[ci] = mfma16(ar, bc[ks], xr[ci]); xr[ci] = mfma16(ai, bs[ks], xr[ci]);
                xi[ci] = mfma16(ai, bc[ks], xi[ci]); xs = mfma16(ar, bs[ks], xs); }
            xi[ci] = xi[ci] - xs; }
        union { bf16x8 v; unsigned q[4]; } xb[4];
#pragma unroll
        for (int q2 = 0; q2 < 2; ++q2) { xb[q2].q[0] = pk2(xr[2 * q2][0], xr[2 * q2][1]); xb[q2].q[1] = pk2(xr[2 * q2][2], xr[2 * q2][3]); xb[q2].q[2] = pk2(xr[2 * q2 + 1][0], xr[2 * q2 + 1][1]); xb[q2].q[3] = pk2(xr[2 * q2 + 1][2], xr[2 * q2 + 1][3]);
            xb[2 + q2].q[0] = pk2(xi[2 * q2][0], xi[2 * q2][1]); xb[2 + q2].q[1] = pk2(xi[2 * q2][2], xi[2 * q2][3]); xb[2 + q2].q[2] = pk2(xi[2 * q2 + 1][0], xi[2 * q2 + 1][1]); xb[2 + q2].q[3] = pk2(xi[2 * q2 + 1][2], xi[2 * q2 + 1][3]); }
        const bf16x8* mf = (const bf16x8*)((const bf16*)(C.ws + WS_FTAB) + 32768) + (size_t)(l * 4 + gq) * 16 * 64;
#pragma unroll
        for (int ei = 0; ei < 4; ++ei) { f32x4 o = {0.f, 0.f, 0.f, 0.f};
#pragma unroll
            for (int ks2 = 0; ks2 < 4; ++ks2) o = mfma16(mf[(ei * 4 + ks2) * 64 + lane], xb[ks2].v, o);
            const int tp = k1 + 128 * (16 * w + li);
            u32x2 wo; wo.x = pk2(o[0], o[1]); wo.y = pk2(o[2], o[3]); *(u32x2*)(MIX + (size_t)(NCTX + tp) * DM + 256 + gq * 64 + 16 * ei + 4 * g) = wo; }
    }
    __syncthreads();
}

constexpr float LOG2E = 1.4426950408889634f;
typedef short bf16x4 __attribute__((ext_vector_type(4)));
__device__ __forceinline__ void attn_load(const bf16* P, const bf16* VT, int krow, int kcol, int li, int g, bf16x8 (&kf)[2][2], bf16x8 (&vf)[4]) {
#pragma unroll
    for (int t = 0; t < 2; ++t)
#pragma unroll
        for (int ks = 0; ks < 2; ++ks) kf[t][ks] = ldg8(P + (size_t)(krow + 16 * t + li) * INWP + kcol + 32 * ks + 8 * g);
#pragma unroll
    for (int dt = 0; dt < 4; ++dt) { const bf16* vp = VT + (size_t)(dt * 16 + li) * VTP + krow + 4 * g;
        const bf16x4 a = *(const bf16x4*)vp, b = *(const bf16x4*)(vp + 16); vf[dt] = (bf16x8){a[0], a[1], a[2], a[3], b[0], b[1], b[2], b[3]}; }
}
template <int NS, int NT>
__device__ __forceinline__ void attn_compute(const bf16x8 (&kf)[2][2], const bf16x8 (&vf)[4], const bf16x8 (&qf)[NS][2], f32x4 (&o)[NS][4], float (&m)[NS], float (&ls)[NS],
                                             const float (&add)[NT][2][4], int li, int g) {
#pragma unroll
    for (int hh = 0; hh < NS; ++hh) {
        f32x4 st[2];
#pragma unroll
        for (int t = 0; t < 2; ++t) { st[t] = (f32x4){0.f, 0.f, 0.f, 0.f};
#pragma unroll
            for (int ks = 0; ks < 2; ++ks) st[t] = __builtin_amdgcn_mfma_f32_16x16x32_bf16(kf[t][ks], qf[hh][ks], st[t], 0, 0, 0); }
        float s[8]; float bm = -INFINITY;
#pragma unroll
        for (int t = 0; t < 2; ++t)
#pragma unroll
            for (int r = 0; r < 4; ++r) { const float ad = add[hh / (NS / NT)][t][r]; s[4 * t + r] = (ad == -INFINITY) ? -INFINITY : st[t][r] * (0.125f * LOG2E) + ad; bm = fmaxf(bm, s[4 * t + r]); }
        bm = fmaxf(bm, shx(bm, 16, 16 * g + li)); bm = fmaxf(bm, shx(bm, 32, 16 * g + li));
        const float mn = fmaxf(m[hh], bm), corr = __builtin_amdgcn_exp2f(m[hh] - mn); m[hh] = mn;
        float ps = 0.f; float pe[8];
#pragma unroll
        for (int e = 0; e < 8; ++e) { pe[e] = __builtin_amdgcn_exp2f(s[e] - mn); ps += pe[e]; }
        ls[hh] = ls[hh] * corr + ps;
        union { bf16x8 v; unsigned u[4]; } pf;
#pragma unroll
        for (int e2 = 0; e2 < 4; ++e2) pf.u[e2] = pk2(pe[2 * e2], pe[2 * e2 + 1]);
#pragma unroll
        for (int dt = 0; dt < 4; ++dt) { o[hh][dt] = o[hh][dt] * corr; o[hh][dt] = __builtin_amdgcn_mfma_f32_16x16x32_bf16(vf[dt], pf.v, o[hh][dt], 0, 0, 0); }
    }
}
__device__ __forceinline__ void attn_finish1(bf16* MIX, int qrow0, int ocol, f32x4 (&o)[4], float m, float ls, bool has_sink, float sink2, int li, int g) {
    float l = ls; l += shx(l, 16, 16 * g + li); l += shx(l, 32, 16 * g + li);
    float corr = 1.f;
    if (has_sink) { const float mn = fmaxf(m, sink2); corr = __builtin_amdgcn_exp2f(m - mn); l = l * corr + __builtin_amdgcn_exp2f(sink2 - mn); }
    const float inv = corr / l;
#pragma unroll
    for (int dt = 0; dt < 4; ++dt) { const f32x4 v = o[dt] * inv; u32x2 w; w.x = pk2(v[0], v[1]); w.y = pk2(v[2], v[3]);
        *(u32x2*)(MIX + (size_t)(qrow0 + li) * DM + ocol + dt * 16 + 4 * g) = w; }
}
__device__ __forceinline__ void attnA_unit(const Ctx& C, const float* asink_l, int unit, bool lat) {
    const bf16* P = (const bf16*)(C.ws + WS_P); bf16* MIX = (bf16*)(C.ws + WS_MIX);
    const int li = C.lane & 15, g = C.lane >> 4;
    const int nqp = lat ? SEQ / 32 : NCTX / 32, kvh = unit / nqp, qp = unit % nqp, t0 = qp * 32, qrow0 = (lat ? NCTX : 0) + t0;
    const bf16* VT = (const bf16*)(C.ws + WS_VTA) + (size_t)kvh * 64 * VTP; const int kcol = C_AK + kvh * 64;
    bf16x8 qf[4][2];
#pragma unroll
    for (int s = 0; s < 4; ++s)
#pragma unroll
        for (int ks = 0; ks < 2; ++ks) qf[s][ks] = ldg8(P + (size_t)(qrow0 + 16 * (s >> 1) + li) * INWP + C_AQ + (kvh * 2 + (s & 1)) * 64 + 32 * ks + 8 * g);
    f32x4 o[4][4]; float m[4], ls[4];
#pragma unroll
    for (int s = 0; s < 4; ++s) { m[s] = -1.0e30f; ls[s] = 0.f;
#pragma unroll
        for (int dt = 0; dt < 4; ++dt) o[s][dt] = (f32x4){0.f, 0.f, 0.f, 0.f}; }
    const int b_lo = lat ? 0 : 9;
#pragma unroll 1
    for (int bb = b_lo; bb < 17; ++bb) { float add[2][2][4]; bf16x8 kf[2][2], vf[4];
        const int krow = (bb < 9) ? NCTX + t0 - 128 + 32 * bb : 32 * (bb - 9);
        attn_load(P, VT, krow, kcol, li, g, kf, vf);
#pragma unroll
        for (int tl = 0; tl < 2; ++tl)
#pragma unroll
            for (int tt = 0; tt < 2; ++tt)
#pragma unroll
                for (int r = 0; r < 4; ++r) { const int j = t0 - 128 + 32 * bb + 16 * tt + 4 * g + r, t = t0 + 16 * tl + li;
                    const bool ok = (bb >= 9) || ((j >= 0) && (j < SEQ) && (j - t <= 128) && (t - j <= 128)); add[tl][tt][r] = ok ? 0.f : -INFINITY; }
        attn_compute<4, 2>(kf, vf, qf, o, m, ls, add, li, g); }
#pragma unroll
    for (int s = 0; s < 4; ++s) attn_finish1(MIX, qrow0 + 16 * (s >> 1), (kvh * 2 + (s & 1)) * 64, o[s], m[s], ls[s], true, asink_l[kvh * 2 + (s & 1)] * LOG2E, li, g);
}
__device__ __forceinline__ void attnC_unit(const Ctx& C, const LAS float* relb, int h, int up, bool lat) {
    const bf16* P = (const bf16*)(C.ws + WS_P); bf16* MIX = (bf16*)(C.ws + WS_MIX);
    const int li = C.lane & 15, g = C.lane >> 4;
    const int rp = up >> 2, cj = up & 3;
    const int t0a = lat ? (2 * rp) * 64 + 16 * cj : 32 * up, tstep = lat ? 64 : 16, qbase = lat ? NCTX : 0;
    const bf16* VT = (const bf16*)(C.ws + WS_VTC) + (size_t)h * 64 * VTP; const int kcol = C_CK + h * 64;
    bf16x8 qf[2][2];
#pragma unroll
    for (int s = 0; s < 2; ++s)
#pragma unroll
        for (int ks = 0; ks < 2; ++ks) qf[s][ks] = ldg8(P + (size_t)(qbase + t0a + tstep * s + li) * INWP + C_CQ + h * 64 + 32 * ks + 8 * g);
    f32x4 o[2][4]; float m[2] = {-1.0e30f, -1.0e30f}, ls[2] = {0.f, 0.f};
#pragma unroll
    for (int s = 0; s < 2; ++s)
#pragma unroll
        for (int dt = 0; dt < 4; ++dt) o[s][dt] = (f32x4){0.f, 0.f, 0.f, 0.f};
    const int r = 2 * rp, cq = cj * 16 + li;
    int r0a = r - 4; r0a = r0a < 0 ? 0 : (r0a > 248 ? 248 : r0a); int r0b = r - 3; r0b = r0b < 0 ? 0 : (r0b > 248 ? 248 : r0b);
    int c0 = cq - 8; c0 = c0 < 0 ? 0 : (c0 > 48 ? 48 : c0);
    const int cw0 = (cj == 0) ? 0 : (cj == 1) ? 8 : (cj == 2) ? 24 : 32;
    const int b_lo = lat ? 0 : 9;
#pragma unroll 1
    for (int bb = b_lo; bb < 17; ++bb) { float add[2][2][4]; bf16x8 kf[2][2], vf[4];
        const int kr = r0a + bb;
        if (bb < 9 && kr >= r0b + 8) continue;
        const int krow = (bb < 9) ? NCTX + kr * 64 + cw0 : 32 * (bb - 9);
        attn_load(P, VT, krow, kcol, li, g, kf, vf);
#pragma unroll
        for (int tl = 0; tl < 2; ++tl) { const int r0t = tl ? r0b : r0a, rt = r + tl; const bool rowok = (bb >= 9) || (kr >= r0t && kr < r0t + 8);
            int bi = kr - rt + 7; bi = bi < 0 ? 0 : (bi > 14 ? 14 : bi); const LAS float* rbp = relb + bi * 31;
#pragma unroll
            for (int tt = 0; tt < 2; ++tt)
#pragma unroll
                for (int rr = 0; rr < 4; ++rr) { const int kc = cw0 + 16 * tt + 4 * g + rr; int ci = kc - cq + 15; ci = ci < 0 ? 0 : (ci > 30 ? 30 : ci); const float bv = rbp[ci];
                    add[tl][tt][rr] = (bb >= 9) ? 0.f : ((rowok && kc >= c0 && kc < c0 + 16) ? bv : -INFINITY); } }
        attn_compute<2, 2>(kf, vf, qf, o, m, ls, add, li, g); }
#pragma unroll
    for (int s = 0; s < 2; ++s) attn_finish1(MIX, qbase + t0a + tstep * s, 512 + h * 64, o[s], m[s], ls[s], false, 0.f, li, g);
}
__device__ __forceinline__ void fourier_ctx_mfma(const Ctx& C, int l, int wg0) {
    const bf16* P = (const bf16*)(C.ws + WS_P); bf16* MIX = (bf16*)(C.ws + WS_MIX); const bf16* f2 = (const bf16*)(C.ws + WS_F256);
    const int lane = C.lane, li = lane & 15, g = lane >> 4, w = C.wave;
    constexpr int UP = 72;
    for (int u = C.wg - wg0; u < 8; u += C.G - wg0) {
        const int tb = u >> 2, gq = u & 3;
        __syncthreads();
        for (int i = C.tid; i < 256 * 8; i += NTHR) { const int t = i >> 3, c8 = i & 7; *(LAS u32x4*)(C.lds + (t * UP + 8 * c8) * 2) = *(const u32x4*)(P + (size_t)t * INWP + C_BU + gq * 64 + 8 * c8); }
        __syncthreads();
        const int tp0 = 128 * tb + 16 * w;
        f32x4 xr[4], xi[4];
#pragma unroll
        for (int ci = 0; ci < 4; ++ci) { xr[ci] = (f32x4){0.f, 0.f, 0.f, 0.f}; xi[ci] = (f32x4){0.f, 0.f, 0.f, 0.f}; }
#pragma unroll 2
        for (int ks = 0; ks < 8; ++ks) { const bf16x8 bc = ldg8(f2 + (size_t)(tp0 + li) * 256 + 32 * ks + 8 * g), bs = ldg8(f2 + 65536 + (size_t)(tp0 + li) * 256 + 32 * ks + 8 * g);
#pragma unroll
            for (int ci = 0; ci < 4; ++ci) { const bf16x8 au = ldT(C.lds, UP, 32 * ks, 16 * ci, li, g); xr[ci] = mfma16(au, bc, xr[ci]); xi[ci] = mfma16(au, bs, xi[ci]); } }
        union { bf16x8 v; unsigned q[4]; } xb[4];
#pragma unroll
        for (int q2 = 0; q2 < 2; ++q2) { xb[q2].q[0] = pk2(xr[2 * q2][0], xr[2 * q2][1]); xb[q2].q[1] = pk2(xr[2 * q2][2], xr[2 * q2][3]); xb[q2].q[2] = pk2(xr[2 * q2 + 1][0], xr[2 * q2 + 1][1]); xb[q2].q[3] = pk2(xr[2 * q2 + 1][2], xr[2 * q2 + 1][3]);
            xb[2 + q2].q[0] = pk2(-xi[2 * q2][0], -xi[2 * q2][1]); xb[2 + q2].q[1] = pk2(-xi[2 * q2][2], -xi[2 * q2][3]); xb[2 + q2].q[2] = pk2(-xi[2 * q2 + 1][0], -xi[2 * q2 + 1][1]); xb[2 + q2].q[3] = pk2(-xi[2 * q2 + 1][2], -xi[2 * q2 + 1][3]); }
        const bf16x8* mf = (const bf16x8*)((const bf16*)(C.ws + WS_FTAB) + 32768) + (size_t)(l * 4 + gq) * 16 * 64;
#pragma unroll
        for (int ei = 0; ei < 4; ++ei) { f32x4 o = {0.f, 0.f, 0.f, 0.f};
#pragma unroll
            for (int ks2 = 0; ks2 < 4; ++ks2) o = mfma16(mf[(ei * 4 + ks2) * 64 + lane], xb[ks2].v, o);
            o = o * 8.0f;
            u32x2 wo; wo.x = pk2(o[0], o[1]); wo.y = pk2(o[2], o[3]); *(u32x2*)(MIX + (size_t)(tp0 + li) * DM + 256 + gq * 64 + 16 * ei + 4 * g) = wo; }
    }
    __syncthreads();
}
__device__ __forceinline__ void fourier2_unit(const Ctx& C, int l, int u, bool ctx) {
    const bf16* P = (const bf16*)(C.ws + WS_P); const float* tw = (const float*)(C.ws + WS_TW); bf16* MIX = (bf16*)(C.ws + WS_MIX);
    const float* FYR = (const float*)(C.ws + WS_FYR); const float* FYI = (const float*)(C.ws + WS_FYI);
    const float* mt = (const float*)(C.ws + WS_MTAB) + (size_t)l * 2 * 4 * 4096;
    LAS float* xr = (LAS float*)(C.lds + 8192); LAS float* xi = xr + 512;
    const int tl = C.tid >> 8, ch = C.tid & 255, tp = 2 * u + tl;
    float sr = 0.f, si = 0.f;
    if (!ctx) { const int k1 = tp & 127, k2 = tp >> 7; const float* yr = FYR + (size_t)k1 * 128 * 256 + ch; const float* yi = FYI + (size_t)k1 * 128 * 256 + ch;
#pragma unroll 8
        for (int t2 = 0; t2 < 128; ++t2) { const int m = ((t2 * k2) & 127) * 128; const float c = tw[m], s = tw[16384 + m]; const float a = yr[t2 * 256], b = yi[t2 * 256]; sr += a * c + b * s; si += b * c - a * s; } }
    else {
#pragma unroll 8
        for (int t = 0; t < NCTX; ++t) { const int m = ((t * tp) & 255) * 64; const float x = bf2f(P[(size_t)t * INWP + C_BU + ch]); sr += x * tw[m]; si -= x * tw[16384 + m]; } }
    __syncthreads();
    xr[tl * 256 + ch] = sr; xi[tl * 256 + ch] = si;
    __syncthreads();
    const int g = ch >> 6, e = ch & 63; const float* mc = mt + (size_t)(0 * 4 + g) * 4096 + e; const float* ms = mt + (size_t)(1 * 4 + g) * 4096 + e;
    const LAS float* xrp = xr + tl * 256 + g * 64; const LAS float* xip = xi + tl * 256 + g * 64; float o = 0.f;
#pragma unroll 8
    for (int c = 0; c < 64; ++c) o += xrp[c] * mc[c * 64] + xip[c] * ms[c * 64];
    o *= ctx ? (1.0f / 128.0f) : (1.0f / 1024.0f);
    MIX[(size_t)((ctx ? 0 : NCTX) + tp) * DM + 256 + ch] = (bf16)f2bf(o);
}
__device__ __forceinline__ void rwkv_passB(const Ctx& C, int b);
__device__ __forceinline__ void phase_mix2(const Ctx& C, const DArgs& a, int l) {
    const bool emit_ctx = l < DEPTH - 1;
#ifndef REPMASK
#define REPMASK 0
#endif
#define NREP2(o) ((((REPMASK) >> (o)) & 1) ? 2 : 1)
    if (C.wg < 8) { for (int r2 = 0; r2 < NREP2(16); ++r2) rwkv_passB(C, C.wg); }
    else if (emit_ctx) fourier_ctx_mfma(C, l, 8);
    { const float* asink_l = a.in[I_ASINK] + l * 4; const float* crel = a.in[I_CREL] + (size_t)l * 4 * 465;
      LAS float* relb = (LAS float*)(C.lds + 110592 + C.wave * 2048);
      for (int r2 = 0; r2 < NREP2(17); ++r2) {
      unsigned* qhead = (unsigned*)(C.ws + WS_CTL) + CW_WQ + 64 * l + 16 * r2;
      const int nA = 2 * (SEQ / 32), nC = 4 * (SEQ / 32), nAc = emit_ctx ? 2 * (NCTX / 32) : 0, nCc = emit_ctx ? 4 * (NCTX / 32) : 0, nAll = nA + nAc + nC + nCc;
      int hcur = -1;
      const int nCv = emit_ctx ? CV_NCHUNK : 0;
      for (;;) { unsigned uq = 0; if (C.lane == 0) uq = __hip_atomic_fetch_add(qhead, 1u, __ATOMIC_RELAXED, __HIP_MEMORY_SCOPE_AGENT);
          const int uraw = __builtin_amdgcn_readfirstlane((int)uq); if (uraw >= nAll + nCv) break;
          int u;
          if (uraw < 2 * nCv) { if (uraw & 1) { const int ch = uraw >> 1; convert_moe_items(C, a, l + 1, ch * CV_CHUNK, ch * CV_CHUNK + CV_CHUNK); continue; } u = uraw >> 1; }
          else u = uraw - nCv;
          if (u < nA) attnA_unit(C, asink_l, u, true);
          else if (u < nA + nAc) attnA_unit(C, asink_l, u - nA, false);
          else { const int uc = u - nA - nAc; const bool lat = uc < nC; const int uu = lat ? uc : uc - nC, nqt = lat ? SEQ / 32 : NCTX / 32, h = uu / nqt, qt = uu % nqt;
              if (h != hcur) { for (int i = C.lane; i < 465; i += 64) relb[i] = crel[h * 465 + i] * LOG2E; hcur = h; LDS_WAIT(); asm volatile("" ::: "memory"); }
              attnC_unit(C, relb, h, qt, lat); } } } }
    __syncthreads();
    for (int r2 = 0; r2 < NREP2(19); ++r2) fourier2_mfma(C, l, 0);
}

constexpr int RW_C = 32, RW_NCH = ROWS / RW_C, RW_SC = 20, RW_NSC = RW_NCH / RW_SC;
constexpr int RW_SLOT = 5120, RW_REGION = 9 * RW_SLOT + 1024;
constexpr int TP = 72, HP = 40;
static_assert(3 * RW_REGION <= MISC_OFF, "RWKV D1 regions below the misc area");
__device__ __forceinline__ int rw_rc_of(int d, int c) { return d == 0 ? c : (c < 8 ? 7 - c : 527 - c); }
__device__ __forceinline__ int rw_row_of(int d, int rc, int t) { return 32 * rc + (d == 0 ? t : 31 - t); }

__device__ __forceinline__ void rwkv_d1(const Ctx& C, LAS unsigned char* rb, int d, int h, int rc) {
    int lane_ = C.lane; asm volatile("" : "+v"(lane_));
    const int lane = lane_, li = lane & 15, g = lane >> 4;
    const float* SC = (const float*)(C.ws + WS_SC);
    LAS unsigned char* S0 = rb; LAS unsigned char* S1 = rb + RW_SLOT; LAS unsigned char* S2 = rb + 2 * RW_SLOT; LAS unsigned char* S3 = rb + 3 * RW_SLOT; LAS unsigned char* S4 = rb + 4 * RW_SLOT;
    LAS unsigned char* S5 = rb + 5 * RW_SLOT; LAS unsigned char* S6 = rb + 6 * RW_SLOT; LAS unsigned char* S7 = rb + 7 * RW_SLOT; LAS unsigned char* S8 = rb + 8 * RW_SLOT;
    LAS unsigned char* S6b = S6 + 2560; LAS unsigned char* S7b = S7 + 2560;
    LAS float* gc = (LAS float*)(rb + 9 * RW_SLOT);
    { float cum = 0.f; const int j = lane; const int qw = (3 + 3 * d) * 256;
#pragma unroll 1
      for (int t0 = 0; t0 < 32; t0 += 4) { float rv[4], vv[4], av[4], lw[4], kd[4], bb[4];
#pragma unroll
          for (int u = 0; u < 4; ++u) { const float* sc = SC + (size_t)rw_row_of(d, rc, t0 + u) * 9 * 256 + h * 64 + j;
              rv[u] = sc[0]; vv[u] = sc[256]; av[u] = sc[512]; lw[u] = sc[qw]; kd[u] = sc[qw + 256]; bb[u] = sc[qw + 512]; }
#pragma unroll
          for (int u = 0; u < 4; ++u) { const float cp = cum; cum += lw[u]; const float Gt = __expf(cum), Gm = __expf(cp), iG = __expf(-cum); const int off = ((t0 + u) * TP + j) * 2;
              *(LAS bf16*)(S0 + off) = (bf16)f2bf(av[u] * Gm); *(LAS bf16*)(S1 + off) = (bf16)f2bf(rv[u] * Gt); *(LAS bf16*)(S2 + off) = (bf16)f2bf(bb[u] * iG);
              *(LAS bf16*)(S3 + off) = (bf16)f2bf(kd[u] * iG); *(LAS bf16*)(S4 + off) = (bf16)f2bf(vv[u]); } }
      gc[j] = __expf(cum); }
    const f32x4 z4 = {0.f, 0.f, 0.f, 0.f};
#pragma unroll 1
    for (int ti = 0; ti < 2; ++ti)
#pragma unroll 1
        for (int si = 0; si < 2; ++si) {
            f32x4 n = z4, nt = z4, mk = z4, qb = z4, qk = z4;
#pragma unroll
            for (int ks = 0; ks < 2; ++ks) { const bf16x8 at = ldA(S0, TP, 16 * ti, 32 * ks, li, g), rt = ldA(S1, TP, 16 * ti, 32 * ks, li, g), bs = ldA(S2, TP, 16 * si, 32 * ks, li, g), kss = ldA(S3, TP, 16 * si, 32 * ks, li, g);
                n = mfma16(at, bs, n);
                nt = mfma16(bs, at, nt);
                mk = mfma16(kss, at, mk);
                qb = mfma16(bs, rt, qb);
                qk = mfma16(kss, rt, qk); }
#pragma unroll
            for (int r = 0; r < 4; ++r) { const int trow = 16 * ti + 4 * g + r, scol = 16 * si + li; if (!(scol < trow)) n[r] = 0.f;
                const int srow = 16 * si + 4 * g + r, tcol = 16 * ti + li; if (!(srow < tcol)) { mk[r] = 0.f; nt[r] = 0.f; } if (!(srow <= tcol)) { qb[r] = 0.f; qk[r] = 0.f; } }
            *(LAS f32x4*)(S5 + ((16 * si + li) * 32 + 16 * ti + 4 * g) * 4) = n;
            stT(S6, HP, 16 * ti + li, 16 * si + 4 * g, mk);
            stT(S8, HP, 16 * ti + li, 16 * si + 4 * g, nt);
            stT(S6b, HP, 16 * ti + li, 16 * si + 4 * g, qb);
            stT(S7, HP, 16 * ti + li, 16 * si + 4 * g, qk); }
    { const int rr = lane & 31, bq = rr >> 4, lr = rr & 15; float Tr[16];
#pragma unroll
      for (int s = 15; s >= 0; --s) { float acc = (lr == s) ? 1.f : 0.f;
#pragma unroll
          for (int c4 = 0; c4 < 4; ++c4) { if (4 * c4 + 3 > s) { const f32x4 nv = *(const LAS f32x4*)(S5 + ((16 * bq + s) * 32 + 16 * bq + 4 * c4) * 4);
#pragma unroll
              for (int e = 0; e < 4; ++e) if (4 * c4 + e > s) acc += Tr[4 * c4 + e] * nv[e]; } }
          Tr[s] = acc; }
      if (lane < 32) { u32x4 w0, w1; w0.x = pk2(Tr[0], Tr[1]); w0.y = pk2(Tr[2], Tr[3]); w0.z = pk2(Tr[4], Tr[5]); w0.w = pk2(Tr[6], Tr[7]); w1.x = pk2(Tr[8], Tr[9]); w1.y = pk2(Tr[10], Tr[11]); w1.z = pk2(Tr[12], Tr[13]); w1.w = pk2(Tr[14], Tr[15]);
          const u32x4 zz = {0u, 0u, 0u, 0u}; LAS u32x4* trow = (LAS u32x4*)(S7b + rr * HP * 2);
          trow[0] = bq ? zz : w0; trow[1] = bq ? zz : w1; trow[2] = bq ? w0 : zz; trow[3] = bq ? w1 : zz; }
      f32x4 x = mfma16(ldA(S8, HP, 16, 0, li, g), ldT(S7b, HP, 0, 0, li, g), z4);
      LAS unsigned char* XT = S8 + 2560;
      *(LAS u32x2*)(XT + (li * HP + 4 * g) * 2) = (u32x2){0u, 0u}; stT(XT, HP, li, 16 + 4 * g, x);
      const f32x4 t21 = mfma16(ldA(S7b, HP, 16, 0, li, g), ldA(XT, HP, 0, 0, li, g), z4);
#pragma unroll
      for (int r = 0; r < 4; ++r) *(LAS bf16*)(S7b + ((16 + 4 * g + r) * HP + li) * 2) = (bf16)f2bf(t21[r]); }
#pragma unroll 1
    for (int ti = 0; ti < 2; ++ti) { const bf16x8 tf = ldA(S7b, HP, 16 * ti, 0, li, g), mf = ldA(S6, HP, 16 * ti, 0, li, g);
#pragma unroll
        for (int ji = 0; ji < 4; ++ji) { const f32x4 ap = mfma16(tf, ldT(S0, TP, 0, 16 * ji, li, g), z4); stT(S8, HP, 16 * ji + li, 16 * ti + 4 * g, ap);
            const f32x4 mv = mfma16(mf, ldT(S4, TP, 0, 16 * ji, li, g), z4); stT(S5, HP, 16 * ji + li, 16 * ti + 4 * g, mv); } }
#pragma unroll 1
    for (int ti = 0; ti < 2; ++ti) { const bf16x8 tf = ldA(S7b, HP, 16 * ti, 0, li, g);
#pragma unroll
        for (int vi = 0; vi < 4; ++vi) { const f32x4 ul = mfma16(tf, ldA(S5, HP, 16 * vi, 0, li, g), z4); stT(S0, HP, 16 * vi + li, 16 * ti + 4 * g, ul); } }
#pragma unroll 1
    for (int ti = 0; ti < 2; ++ti) { const bf16x8 qbf = ldA(S6b, HP, 16 * ti, 0, li, g), qkf = ldA(S7, HP, 16 * ti, 0, li, g);
#pragma unroll
        for (int ji = 0; ji < 4; ++ji) { f32x4 rp = mfma16(ldA(S8, HP, 16 * ji, 0, li, g), qbf, z4);
            LAS unsigned char* p = S1 + ((16 * ti + li) * TP + 16 * ji + 4 * g) * 2; rp = rp + ld4bf(p); u32x2 w; w.x = pk2(rp[0], rp[1]); w.y = pk2(rp[2], rp[3]); *(LAS u32x2*)p = w;
            f32x4 yl = mfma16(qbf, ldA(S0, HP, 16 * ji, 0, li, g), z4); yl = mfma16(qkf, ldT(S4, TP, 0, 16 * ji, li, g), yl);
            stT(S5, HP, 16 * ji + li, 16 * ti + 4 * g, yl); } }
#pragma unroll 1
    for (int ji = 0; ji < 4; ++ji) { const bf16x8 bt = ldT(S2, TP, 0, 16 * ji, li, g); const float gj = gc[16 * ji + li];
#pragma unroll
        for (int jp = 0; jp < 4; ++jp) { f32x4 pt = mfma16(ldA(S8, HP, 16 * jp, 0, li, g), bt, z4);
#pragma unroll
            for (int r = 0; r < 4; ++r) pt[r] = pt[r] * gj + ((16 * jp + 4 * g + r == 16 * ji + li) ? gj : 0.f);
            stT(S6, TP, 16 * ji + li, 16 * jp + 4 * g, pt); } }
#pragma unroll 1
    for (int vh = 0; vh < 2; ++vh) { f32x4 lt[4][2];
#pragma unroll
      for (int ji = 0; ji < 4; ++ji) { const bf16x8 ba = ldT(S2, TP, 0, 16 * ji, li, g), ka = ldT(S3, TP, 0, 16 * ji, li, g); const f32x4 gv = *(const LAS f32x4*)(gc + 16 * ji + 4 * g);
#pragma unroll
          for (int v2 = 0; v2 < 2; ++v2) { const int vi = 2 * vh + v2; f32x4 x = mfma16(ba, ldA(S0, HP, 16 * vi, 0, li, g), z4); x = mfma16(ka, ldT(S4, TP, 0, 16 * vi, li, g), x); lt[ji][v2] = x * gv; } }
      asm volatile("s_waitcnt lgkmcnt(0)" ::: "memory");
      LAS unsigned char* dst = vh ? S2 : S8;
#pragma unroll
      for (int ji = 0; ji < 4; ++ji)
#pragma unroll
          for (int v2 = 0; v2 < 2; ++v2) stT(dst, TP, 16 * v2 + li, 16 * ji + 4 * g, lt[ji][v2]); }
}
__device__ __forceinline__ void rwkv_passA_step(const Ctx& C, const LAS unsigned char* rb, f32x4 (&hs)[4], int d, int h, int rc) {
    int lane_ = C.lane; asm volatile("" : "+v"(lane_));
    const int lane = lane_, li = lane & 15, g = lane >> 4; const bool isPhi = C.wave >= 4; const int col = 16 * (C.wave & 3) + li;
    const LAS unsigned char* S1 = rb + RW_SLOT; const LAS unsigned char* S2 = rb + 2 * RW_SLOT; const LAS unsigned char* S5 = rb + 5 * RW_SLOT; const LAS unsigned char* S6 = rb + 6 * RW_SLOT;
    const LAS unsigned char* LTb = (col < 32) ? rb + 8 * RW_SLOT + col * TP * 2 : S2 + (col - 32) * TP * 2;
    union { bf16x8 v; unsigned u[4]; } bf[2];
#pragma unroll
    for (int ks = 0; ks < 2; ++ks) { bf[ks].u[0] = pk2(hs[2 * ks][0], hs[2 * ks][1]); bf[ks].u[1] = pk2(hs[2 * ks][2], hs[2 * ks][3]); bf[ks].u[2] = pk2(hs[2 * ks + 1][0], hs[2 * ks + 1][1]); bf[ks].u[3] = pk2(hs[2 * ks + 1][2], hs[2 * ks + 1][3]); }
#pragma unroll
    for (int ti = 0; ti < 2; ++ti) { f32x4 acc = isPhi ? (f32x4){0.f, 0.f, 0.f, 0.f} : ld4bf(S5 + (col * HP + 16 * ti + 4 * g) * 2);
#pragma unroll
        for (int ks = 0; ks < 2; ++ks) acc = mfma16(ldAperm(S1, TP, 16 * ti, ks, li, g), bf[ks].v, acc);
        if (!isPhi) { float* ys = (float*)(C.ws + WS_YS) + (size_t)d * ROWS * 256 + h * 64 + col;
#pragma unroll
            for (int r = 0; r < 4; ++r) ys[(size_t)rw_row_of(d, rc, 16 * ti + 4 * g + r) * 256] = acc[r]; }
        else { bf16* rp = (bf16*)(C.ws + WS_RPP) + ((size_t)((d * 4 + h) * RW_NCH + rc) * 32) * 64 + col;
#pragma unroll
            for (int r = 0; r < 4; ++r) rp[(16 * ti + 4 * g + r) * 64] = (bf16)f2bf(acc[r]); } }
    f32x4 hn[4];
#pragma unroll
    for (int i = 0; i < 4; ++i) { f32x4 acc = isPhi ? (f32x4){0.f, 0.f, 0.f, 0.f} : ld4bf(LTb + (16 * i + 4 * g) * 2);
#pragma unroll
        for (int ks = 0; ks < 2; ++ks) acc = mfma16(ldAperm(S6, TP, 16 * i, ks, li, g), bf[ks].v, acc);
        hn[i] = acc; }
#pragma unroll
    for (int i = 0; i < 4; ++i) hs[i] = hn[i];
}
__device__ __forceinline__ void phase_rwkv1(const Ctx& C) {
    const int lane = C.lane, li = lane & 15, g = lane >> 4;
    for (int u = C.wg; u < 8 * RW_NSC; u += C.G) {
        const int s = u % RW_NSC, dh = u / RW_NSC, d = dh >> 2, h = dh & 3; const bool isPhi = C.wave >= 4; const int col = 16 * (C.wave & 3) + li;
        f32x4 hs[4];
#pragma unroll
        for (int i = 0; i < 4; ++i)
#pragma unroll
            for (int r = 0; r < 4; ++r) hs[i][r] = (isPhi && (16 * i + 4 * g + r == col)) ? 1.f : 0.f;
#pragma unroll 1
        for (int rnd = 0; rnd < (RW_SC + 2) / 3; ++rnd) {
            __syncthreads();
            { int wv = C.wave; asm volatile("" : "+s"(wv)); if (wv < 3 && 3 * rnd + wv < RW_SC) rwkv_d1(C, C.lds + wv * RW_REGION, d, h, rw_rc_of(d, s * RW_SC + 3 * rnd + wv)); }
            __syncthreads();
#pragma unroll 1
            for (int k = 0; k < 3; ++k) { const int ci = 3 * rnd + k; int ko = k * RW_REGION; asm volatile("" : "+s"(ko)); if (ci < RW_SC) rwkv_passA_step(C, C.lds + ko, hs, d, h, rw_rc_of(d, s * RW_SC + ci)); }
        }
        if (isPhi) { bf16* pf = (bf16*)(C.ws + WS_PSC) + (size_t)(dh * RW_NSC + s) * 4096;
            const int ks = col >> 5, eh = (col >> 4) & 1, gp = (col >> 2) & 3, el = col & 3;
#pragma unroll
            for (int i = 0; i < 4; ++i)
#pragma unroll
                for (int r = 0; r < 4; ++r) pf[((i * 2 + ks) * 64 + gp * 16 + 4 * g + r) * 8 + eh * 4 + el] = (bf16)f2bf(hs[i][r]); }
        else { f32x4* lf = (f32x4*)(C.ws + WS_LSC) + ((size_t)(dh * RW_NSC + s) * 4 + C.wave) * 4 * 64;
#pragma unroll
            for (int i = 0; i < 4; ++i) lf[i * 64 + lane] = hs[i]; }
    }
    __syncthreads();
}
__device__ __forceinline__ void rwkv_passB(const Ctx& C, int b) {
    if (C.wave >= 4) return;
    const int lane = C.lane, li = lane & 15, g = lane >> 4, q = C.wave;
    f32x4 hs[4];
#pragma unroll
    for (int i = 0; i < 4; ++i) hs[i] = (f32x4){0.f, 0.f, 0.f, 0.f};
    const bf16x8* pfb = (const bf16x8*)((const bf16*)(C.ws + WS_PSC) + (size_t)b * RW_NSC * 4096);
    const f32x4* lfb = (const f32x4*)(C.ws + WS_LSC) + ((size_t)b * RW_NSC * 4 + q) * 4 * 64;
    bf16x8 pa[8]; f32x4 la[4];
#pragma unroll
    for (int k = 0; k < 8; ++k) pa[k] = pfb[k * 64 + lane];
#pragma unroll
    for (int i = 0; i < 4; ++i) la[i] = lfb[i * 64 + lane];
#pragma unroll 1
    for (int s = 0; s < RW_NSC; ++s) {
        bf16* hp = (bf16*)(C.ws + WS_HSC) + ((size_t)(b * RW_NSC + s) * 64 + 16 * q + li) * 64;
#pragma unroll
        for (int i = 0; i < 4; ++i) { u32x2 w; w.x = pk2(hs[i][0], hs[i][1]); w.y = pk2(hs[i][2], hs[i][3]); *(u32x2*)(hp + 16 * i + 4 * g) = w; }
        bf16x8 pn[8]; f32x4 ln[4]; const int sn = (s + 1 < RW_NSC) ? s + 1 : s;
#pragma unroll
        for (int k = 0; k < 8; ++k) pn[k] = pfb[(size_t)sn * 512 + k * 64 + lane];
#pragma unroll
        for (int i = 0; i < 4; ++i) ln[i] = lfb[(size_t)sn * 4 * 4 * 64 + i * 64 + lane];
        union { bf16x8 v; unsigned u[4]; } bf[2];
#pragma unroll
        for (int ks = 0; ks < 2; ++ks) { bf[ks].u[0] = pk2(hs[2 * ks][0], hs[2 * ks][1]); bf[ks].u[1] = pk2(hs[2 * ks][2], hs[2 * ks][3]); bf[ks].u[2] = pk2(hs[2 * ks + 1][0], hs[2 * ks + 1][1]); bf[ks].u[3] = pk2(hs[2 * ks + 1][2], hs[2 * ks + 1][3]); }
#pragma unroll
        for (int i = 0; i < 4; ++i) { f32x4 acc = la[i];
#pragma unroll
            for (int ks = 0; ks < 2; ++ks) acc = mfma16(pa[i * 2 + ks], bf[ks].v, acc);
            hs[i] = acc; }
#pragma unroll
        for (int k = 0; k < 8; ++k) pa[k] = pn[k];
#pragma unroll
        for (int i = 0; i < 4; ++i) la[i] = ln[i];
    }
}
__device__ __forceinline__ void phase_mix3(const Ctx& C, const DArgs& a, int l) {
    const bf16* P = (const bf16*)(C.ws + WS_P); const float* SC = (const float*)(C.ws + WS_SC); const float* YS = (const float*)(C.ws + WS_YS); bf16* MIX = (bf16*)(C.ws + WS_MIX);
    LAS float* yt = (LAS float*)(C.lds);
    constexpr int GSP = 168;
    LAS unsigned char* gsig = C.lds + 32768;
    LAS float* gm = (LAS float*)(C.lds + 40960);
    const bf16* g2t = (const bf16*)(C.ws + WS_G2T) + (size_t)l * 256 * 160;
    const float* rk = a.in[I_DRK] + (size_t)l * 256; const float* lnw = a.in[I_DLNW] + (size_t)l * 256; const float* lnb = a.in[I_DLNB] + (size_t)l * 256;
    const int lane = C.lane, li = lane & 15, g = lane >> 4, h = C.wave & 3, d = C.wave >> 2;
    const int half = C.tid >> 8, c = C.tid & 255;
    const int u_lo = (l == DEPTH - 1) ? NCTX / 16 : 0;
    for (int u = u_lo + C.wg; u < ROWS / 16; u += C.G) {
        const int rc = u >> 1, th = u & 1, rowb = 16 * u;
        __syncthreads();
        for (int i = C.tid; i < 16 * 160; i += NTHR) { const int t = i / 160, ii = i % 160; *(LAS bf16*)(gsig + (t * GSP + ii) * 2) = (bf16)f2bf(sigmoidf_(bf2f(P[(size_t)(rowb + t) * INWP + C_GL + ii]))); }
        {
          const int ct = (d == 0) ? rc : (rc < 8 ? 7 - rc : 527 - rc), s = ct / RW_SC, ti = (d == 0) ? th : 1 - th;
          const bf16* rp = (const bf16*)(C.ws + WS_RPP) + (size_t)((d * 4 + h) * RW_NCH + rc) * 32 * 64;
          const bf16* hp = (const bf16*)(C.ws + WS_HSC) + (size_t)((d * 4 + h) * RW_NSC + s) * 64 * 64;
          bf16x8 af[2];
#pragma unroll
          for (int ks = 0; ks < 2; ++ks) af[ks] = ldg8(rp + (16 * ti + li) * 64 + 32 * ks + 8 * g);
#pragma unroll
          for (int vi = 0; vi < 4; ++vi) { f32x4 acc = {0.f, 0.f, 0.f, 0.f};
#pragma unroll
              for (int ks = 0; ks < 2; ++ks) acc = mfma16(af[ks], ldg8(hp + (16 * vi + li) * 64 + 32 * ks + 8 * g), acc);
#pragma unroll
              for (int r = 0; r < 4; ++r) { const int t = 16 * ti + 4 * g + r, rl = ((d == 0) ? t : 31 - t) - 16 * th;
                  yt[(d * 16 + rl) * 256 + h * 64 + 16 * vi + li] = acc[r] + YS[((size_t)d * ROWS + rowb + rl) * 256 + h * 64 + 16 * vi + li]; } } }
        __syncthreads();
#pragma unroll
        for (int c2 = 0; c2 < 2; ++c2) { const int ci = 2 * C.wave + c2; f32x4 a0 = {0.f, 0.f, 0.f, 0.f};
#pragma unroll
            for (int ks = 0; ks < 5; ++ks) a0 = mfma16(ldA(gsig, GSP, 0, 32 * ks, li, g), ldg8(g2t + (size_t)(16 * ci + li) * 160 + 32 * ks + 8 * g), a0);
#pragma unroll
            for (int r = 0; r < 4; ++r) gm[(4 * g + r) * 256 + 16 * ci + li] = a0[r]; }
        __syncthreads();
#pragma unroll 1
        for (int it = 0; it < 8; ++it) { const int rl = 2 * it + half, row = rowb + rl;
            const float* sc = SC + (size_t)row * 9 * 256;
            const float y = yt[rl * 256 + c] + yt[(16 + rl) * 256 + c];
            const float mu = wave_sum(y, lane) * (1.f / 64.f), dy = y - mu, var = wave_sum(dy * dy, lane) * (1.f / 64.f);
            const float yn = dy * rsqrtf(var + 64e-5f) * lnw[c] + lnb[c];
            const float r = sc[c], v = sc[256 + c];
            const float coef = wave_sum(r * (sc[4 * 256 + c] + sc[7 * 256 + c]) * rk[c], lane);
            MIX[(size_t)row * DM + 768 + c] = (bf16)f2bf((yn + coef * v) * gm[rl * 256 + c]); }
    }
    __syncthreads();
}
__device__ __forceinline__ void outproj_ctx(const Ctx& C, int l, const float* gate) {
    const bf16* A = (const bf16*)(C.ws + WS_MIX); const bf16* B = (const bf16*)(C.ws + WS_WOUT) + (size_t)l * DM * DM; float* XS = (float*)(C.ws + WS_XS);
    const int lane = C.lane, li = lane & 15, g = lane >> 4;
    for (int u = C.gw; u < (NCTX / 16) * (DM / 16); u += C.NGW) { const int rt = u >> 6, ct = u & 63;
        const bf16* ap = A + (size_t)(16 * rt + li) * DM + 8 * g; const bf16* bp = B + (size_t)(16 * ct + li) * DM + 8 * g;
        f32x4 acc0 = {0.f, 0.f, 0.f, 0.f}, acc1 = {0.f, 0.f, 0.f, 0.f};
#pragma unroll 4
        for (int ks = 0; ks < 32; ks += 2) { acc0 = mfma16(ldg8(ap + 32 * ks), ldg8(bp + 32 * ks), acc0); acc1 = mfma16(ldg8(ap + 32 * ks + 32), ldg8(bp + 32 * ks + 32), acc1); }
        const float gv = gate[16 * ct + li];
#pragma unroll
        for (int r = 0; r < 4; ++r) { float* p = XS + (size_t)(16 * rt + 4 * g + r) * DM + 16 * ct + li; *p = *p + gv * (acc0[r] + acc1[r]); } }
}

#ifndef MK_SINGLE
#define MK_SINGLE 1
#endif
template <int ONLYP> __global__ void __launch_bounds__(NTHR, 2) mega(Args a) {
    extern __shared__ __attribute__((aligned(16))) unsigned char lds_raw[];
    Ctx C;
#define MKCTX() do { int t_ = threadIdx.x; asm volatile("" : "+v"(t_)); unsigned char* w_ = a.ws; asm volatile("" : "+s"(w_)); unsigned l_ = 0u; asm volatile("" : "+s"(l_)); \
        C.lds = (LAS unsigned char*)lds_raw + l_; C.tid = t_; C.lane = t_ & 63; C.wave = __builtin_amdgcn_readfirstlane(t_ >> 6); \
        C.wg = blockIdx.x; C.G = gridDim.x; C.gw = C.wg * NWAVES + C.wave; C.NGW = C.G * NWAVES; C.ws = w_; } while (0)
    MKCTX();
    if (C.tid == 0) {
#pragma unroll
        for (int i = 0; i < 31; ++i) ((LAS unsigned long long*)(C.lds + MISC_OFF + 2048))[i] = (unsigned long long)a.in[i]; }
    DArgs da; da.in.tab = (const LAS unsigned*)(C.lds + MISC_OFF + 2048); da.out = a.out;
    if (C.tid < 4) ((LAS unsigned*)(C.lds + MISC_OFF))[C.tid] = 0u;
    __syncthreads();
    XcdBarrier bar; bar.bar = (unsigned*)(C.ws + WS_CTL) + CW_BAR; bar.x = 0; bar.st = (volatile LAS unsigned*)(C.lds + MISC_OFF);
    if (a.use_bar) bar = xcd_barrier_post((unsigned*)(C.ws + WS_CTL) + CW_BAR, (volatile LAS unsigned*)(C.lds + MISC_OFF));
#ifndef PHMASK
#define PHMASK 0x1fff
#endif
#define INP(o, k) ((ONLYP < 0 || ONLYP == (o)) && ((PHMASK >> ((o) == 99 ? 12 : (o))) & 1) && a.ph_lo <= (k) && (k) < a.ph_hi)
#ifndef REPMASK
#define REPMASK 0
#endif
#define NREP(o) ((((REPMASK) >> ((o) == 99 ? 12 : (o))) & 1) ? 2 : 1)
#define IN(k) (a.ph_lo <= (k) && (k) < a.ph_hi)
#define SEAM(k) do { if (a.use_bar && IN(k) && IN((k) + 1)) { xcd_barrier(bar); if ((REPMASK >> 20) & 1) xcd_barrier(bar); } } while (0)
    if (INP(0, 0)) for (int rep = 0; rep < NREP(0); ++rep) { MKCTX(); phase_prologue(C, da); }
    SEAM(0);
    for (int l = 0; l < DEPTH; ++l) {
        const int b = 1 + l * NPL;
        const float* mod_lat = (const float*)(C.ws + WS_MOD) + (size_t)(l * 2 + 0) * 6144; const float* mod_ctx = mod_lat + 6144;
        if (INP(1, b + 0)) { MKCTX(); phase_norm1(C, da, l); }
        SEAM(b + 0);
        if (INP(2, b + 1)) for (int rep = 0; rep < NREP(2); ++rep) { MKCTX();
            pg8::StaticOrder S; S.init(WS_H, WS_WIN + (size_t)l * INWP * DM * 2, ROWS, INWP, DM, C.G, C.wg);
            pg8::EpiStoreBf16 E{(bf16*)(C.ws + WS_P), INWP, nullptr, 0, 1.0f, 1.0f};
            pg8::gemm_phase<pg8::EpiStoreBf16, pg8::StaticOrder, true, true>(C.lds, C.tid, DM, S, E, C.ws);
        }
        SEAM(b + 1);
        if (INP(3, b + 2)) { MKCTX(); for (int rep = 0; rep < NREP(3); ++rep) { mix1_rwkv_prep(C, da, l); mix1_fourier1(C); } }
        SEAM(b + 2);
        if (INP(11, b + 3)) for (int rep = 0; rep < NREP(11); ++rep) { MKCTX(); phase_rwkv1(C);
            if (C.wg >= 8 * RW_NSC) {
                Ctx C2 = C; C2.wg = C.wg - 8 * RW_NSC; C2.G = C.G - 8 * RW_NSC; C2.gw = C2.wg * NWAVES + C.wave; C2.NGW = C2.G * NWAVES;
                mix1_rope(C2); mix1_vt(C2); } }
        SEAM(b + 3);
        if (INP(4, b + 4)) for (int rep = 0; rep < NREP(4); ++rep) { MKCTX(); phase_mix2(C, da, l); }
        SEAM(b + 4);
        if (INP(5, b + 5)) for (int rep = 0; rep < NREP(5); ++rep) { MKCTX(); phase_mix3(C, da, l); }
        SEAM(b + 5);
        if (INP(6, b + 6)) { MKCTX();
            if (l < DEPTH - 1) outproj_ctx(C, l, mod_ctx + 2 * DM);
            pg8::StaticOrder S; S.init(WS_MIX + (size_t)NCTX * DM * 2, WS_WOUT + (size_t)l * DM * DM * 2, SEQ, DM, DM, C.G, C.wg);
            pg8::EpiResidual E{(float*)(C.ws + WS_XS) + (size_t)NCTX * DM, DM, mod_lat + 2 * DM, mod_lat + 2 * DM};
            pg8::gemm_phase<pg8::EpiResidual, pg8::StaticOrder, true, true>(C.lds, C.tid, DM, S, E, C.ws);
        }
        SEAM(b + 6);
        if (INP(7, b + 7)) for (int rep = 0; rep < NREP(7); ++rep) { MKCTX(); phase_norm2(C, da, l); }
        SEAM(b + 7);
        if (INP(8, b + 8)) for (int rep = 0; rep < NREP(8); ++rep) { MKCTX(); phase_gather(C, da, l); }
        SEAM(b + 8);
        if (INP(9, b + 9)) for (int rep = 0; rep < NREP(9); ++rep) { MKCTX();
            const int nblk = moe_tables(C);
            pg8::MoeOrder S{(unsigned)WS_XG8, (unsigned)(WS_WGU + (size_t)l * 32 * 2048 * DM), 256u * DM, 2048u * DM,
                            (const LAS unsigned char*)(C.lds + MISC_OFF + 1024), nblk, 8, C.G, C.wg};
            pg8::EpiSwiglu E{(bf16*)(C.ws + WS_ACT8), DM, da.in[I_BGU] + (size_t)l * 32 * 2048, 2048, pg8::X8_S * pg8::W8_S, 1.0f / (pg8::X8_S * pg8::W8_S)};
            pg8::gemm_phase<pg8::EpiSwiglu, pg8::MoeOrder, true, true, 1>(C.lds, C.tid, DM, S, E, C.ws);
        }
        SEAM(b + 9);
        if (INP(10, b + 10)) for (int rep = 0; rep < NREP(10); ++rep) { MKCTX();
            const int nblk = moe_tables(C);
            pg8::MoeOrder S{(unsigned)WS_ACT8, (unsigned)(WS_WDN + (size_t)l * 32 * DM * DM), 256u * DM, (unsigned)(DM * DM),
                            (const LAS unsigned char*)(C.lds + MISC_OFF + 1024), nblk, 4, C.G, C.wg};
            pg8::EpiStoreBf16 E{(bf16*)(C.ws + WS_XG), DM, da.in[I_BDN] + (size_t)l * 32 * DM, DM, pg8::ACT_S * pg8::W8_S, 1.0f / (pg8::ACT_S * pg8::W8_S)};
            pg8::gemm_phase<pg8::EpiStoreBf16, pg8::MoeOrder, true, true, 1>(C.lds, C.tid, DM, S, E, C.ws);
        }
        SEAM(b + 10);
    }
    if (INP(99, PH_TOTAL - 1)) for (int rep = 0; rep < NREP(99); ++rep) { MKCTX(); phase_final(C, da); }
#undef IN
#undef INP
#undef SEAM
}

typedef void (*kern_t)(Args);
static kern_t kern_of(int o) {
    switch (o) { case 0: return mega<0>; case 1: return mega<1>; case 2: return mega<2>; case 3: return mega<3>; case 4: return mega<4>; case 5: return mega<5>; case 6: return mega<6>;
                 case 7: return mega<7>; case 8: return mega<8>; case 9: return mega<9>; case 10: return mega<10>; case 11: return mega<11>; case 99: return mega<99>;
#if MK_SINGLE
                 default: return mega<-1>;
#else
                 default: return mega<0>;
#endif
    }
}
extern "C" void kernel_launch(void* const* d_in, const int* in_sizes, int n_in, void* d_out, int out_size, void* d_ws, size_t ws_size, hipStream_t stream) {
    static int ready = 0;
    if (ready == 0) {
        if (n_in != 31 || out_size != SEQ * DM || ws_size < WS_END) { fprintf(stderr, "kernel_launch: unexpected shapes (n_in %d, out %d, ws %zu)\n", n_in, out_size, ws_size); ready = -1; return; }
        const int ids[14] = {0, 1, 2, 3, 4, 5, 6, 7, 8, 9, 10, 11, 99, -1};
        for (int i = 0; i < (MK_SINGLE ? 14 : 13); ++i) { if (MK_SINGLE && ids[i] != -1) continue;
            if (hipFuncSetAttribute((const void*)kern_of(ids[i]), hipFuncAttributeMaxDynamicSharedMemorySize, LDS_BYTES) != hipSuccess) { fprintf(stderr, "kernel_launch: hipFuncSetAttribute failed (%d)\n", ids[i]); ready = -1; return; } }
        ready = 1;
    }
    if (ready < 0) return;
    (void)hipMemsetAsync((char*)d_ws + WS_CTL, 0, CTL_ZERO_BYTES, stream);
    Args a{};
    for (int i = 0; i < 31; ++i) a.in[i] = (const float*)d_in[i];
    a.out = (float*)d_out; a.ws = (unsigned char*)d_ws; a.pad = 0;
#if MK_SINGLE
    a.ph_lo = 0; a.ph_hi = PH_TOTAL; a.use_bar = 1;
    hipLaunchKernelGGL(kern_of(-1), dim3(NWG), dim3(NTHR), LDS_BYTES, stream, a);
#else
    for (int p = 0; p < PH_TOTAL; ++p) { a.ph_lo = p; a.ph_hi = p + 1; a.use_bar = 0;
        const int j = (p - 1) % NPL; const int o = (p == 0) ? 0 : (p == PH_TOTAL - 1) ? 99 : (j < 3 ? 1 + j : j == 3 ? 11 : j);
        hipLaunchKernelGGL(kern_of(o), dim3(NWG), dim3(NTHR), LDS_BYTES, stream, a); }
#endif
}
```

```cpp
#include <hip/hip_runtime.h>
#include <cstdio>
#include <cstdint>

#define LAS __attribute__((address_space(3)))
typedef unsigned short bf16;
typedef float f32x4 __attribute__((ext_vector_type(4)));
typedef float f32x2 __attribute__((ext_vector_type(2)));
typedef short bf16x8 __attribute__((ext_vector_type(8)));
typedef unsigned u32x4 __attribute__((ext_vector_type(4)));
typedef unsigned u32x2 __attribute__((ext_vector_type(2)));

constexpr int DM = 1024, SEQ = 16384, NCTX = 256, ROWS = SEQ + NCTX, DEPTH = 4, GRIDW = 64;
constexpr int INW = 2720, INWP = 2816;
constexpr int C_AQ = 0, C_AK = 256, C_AV = 384, C_BU = 512, C_CQ = 768, C_CK = 1024, C_CV = 1280, C_DR = 1536, C_DK = 1792, C_DV = 2048, C_WL = 2304, C_AL = 2432, C_GL = 2560;
constexpr int NEXP = 32, TOPK = 4;
constexpr int MOE_MAXBLK = 296;
constexpr int MOE_ROWS = MOE_MAXBLK * 256;
constexpr int NWG = 256, NTHR = 512, NWAVES = 8;
constexpr int VTP = ROWS + 256;

constexpr size_t MiB = 1u << 20;
constexpr size_t WS_CTL = 0, CTL_ZERO_BYTES = 1 * MiB;
constexpr size_t WS_MOD = 1 * MiB;
constexpr size_t WS_TW = 2 * MiB;
constexpr size_t WS_MTAB = 3 * MiB;
constexpr size_t WS_XS = 4 * MiB;
constexpr size_t WS_H = 70 * MiB;
constexpr size_t WS_P = 104 * MiB;
constexpr size_t WS_MIX = 194 * MiB;
constexpr size_t WS_FYR = 228 * MiB, WS_FYI = 244 * MiB;
constexpr size_t WS_VTA = 1544 * MiB, WS_VTC = 1550 * MiB;
constexpr size_t WS_SC = 260 * MiB;
constexpr size_t WS_YS = 408 * MiB;
constexpr size_t WS_ROUTE = 442 * MiB;
constexpr size_t WS_CNT = 444 * MiB;
constexpr size_t WS_XG = 446 * MiB;
constexpr size_t WS_ACT = 596 * MiB;
constexpr size_t WS_XG8 = WS_ACT, WS_ACT8 = WS_ACT + 75 * MiB;
constexpr size_t WS_WIN = 746 * MiB;
constexpr size_t WS_WOUT = 768 * MiB;
constexpr size_t WS_WGU = 776 * MiB;
constexpr size_t WS_WDN = 1288 * MiB;
constexpr size_t WS_RPP = 1560 * MiB, WS_PSC = 1578 * MiB, WS_LSC = 1580 * MiB, WS_HSC = 1584 * MiB;
constexpr size_t WS_FTAB = 1586 * MiB;
constexpr size_t WS_G2T = 1588 * MiB, WS_RWT = 1589 * MiB;
constexpr size_t WS_LORAT = 1590 * MiB;
constexpr size_t WS_F256 = 1591 * MiB;

constexpr size_t WS_END = 1592 * MiB;
static_assert(WS_XS + (size_t)ROWS * DM * 4 <= WS_H && WS_H + (size_t)ROWS * DM * 2 <= WS_P && WS_P + (size_t)ROWS * INWP * 2 <= WS_MIX && WS_MIX + (size_t)ROWS * DM * 2 <= WS_FYR, "ws map 1");
static_assert(WS_SC + (size_t)ROWS * 9 * 256 * 4 <= WS_YS && WS_YS + (size_t)2 * ROWS * 256 * 4 <= WS_ROUTE && WS_XG + (size_t)MOE_ROWS * DM * 2 <= WS_ACT && WS_ACT + (size_t)MOE_ROWS * DM * 2 <= WS_WIN, "ws map 2");
static_assert(WS_WIN + (size_t)4 * INWP * DM * 2 <= WS_WOUT && WS_WGU + (size_t)4 * 32 * 2048 * 1024 * 2 <= WS_WDN && WS_WDN + (size_t)4 * 32 * 1024 * 1024 * 2 <= WS_END, "ws map 3");
constexpr int CW_BAR = 4096;
constexpr int CW_WQ = 16384;

constexpr int RING_BYTES = 131072;
constexpr int MISC_OFF = 143360;
constexpr int LDS_BYTES = 147456;

__device__ __forceinline__ unsigned f2bf(float f) { unsigned u = __builtin_bit_cast(unsigned, f); return (u + 0x7fffu + ((u >> 16) & 1u)) >> 16; }
__device__ __forceinline__ unsigned pk2(float lo, float hi) { return f2bf(lo) | (f2bf(hi) << 16); }
__device__ __forceinline__ float bf2f(unsigned short b) { return __builtin_bit_cast(float, (unsigned)b << 16); }
__device__ __forceinline__ float bflo(unsigned w) { return __builtin_bit_cast(float, w << 16); }
__device__ __forceinline__ float bfhi(unsigned w) { return __builtin_bit_cast(float, w & 0xffff0000u); }
__device__ __forceinline__ float shx(float v, int o, int lane) { return __builtin_bit_cast(float, __builtin_amdgcn_ds_bpermute((lane ^ o) << 2, __builtin_bit_cast(int, v))); }
__device__ __forceinline__ int shxi(int v, int o, int lane) { return __builtin_amdgcn_ds_bpermute((lane ^ o) << 2, v); }
__device__ __forceinline__ float dpp_ror(float v, int ctrl_unused);
#define DPP_ROR_ADD(v, n) v += __builtin_bit_cast(float, __builtin_amdgcn_update_dpp(0, __builtin_bit_cast(int, v), 0x120 + (n), 0xf, 0xf, false))
__device__ __forceinline__ float wave_sum(float v, int lane) {
    DPP_ROR_ADD(v, 8); DPP_ROR_ADD(v, 4); DPP_ROR_ADD(v, 2); DPP_ROR_ADD(v, 1);
    v += shx(v, 16, lane); v += shx(v, 32, lane);
    return v;
}
__device__ __forceinline__ float sigmoidf_(float x) { return 1.f / (1.f + __expf(-x)); }
#define LDS_WAIT() asm volatile("s_waitcnt lgkmcnt(0)" ::: "memory")
#define VM_WAIT() asm volatile("s_waitcnt vmcnt(0)" ::: "memory")

namespace pg8 {
#define PG8_LAS __attribute__((address_space(3)))
typedef unsigned short bf16_t;
constexpr int BM = 256, BK = 64, HALF = 128, HTB = HALF * BK * 2, STAGE_BYTES = 8 * HTB, NXCD = 8, WGM = 8;
__host__ __device__ __forceinline__ int lds_byte(int r, int c) { const int st = (r >> 4) * 2 + (c >> 5), rr = r & 15, cc = c & 31, ob = rr * 64 + cc * 2; return st * 1024 + (ob ^ (((ob >> 9) & 1) << 5)); }
__host__ __device__ __forceinline__ void stage_rc(int b, int& R, int& C) { const int st = b / 1024, sb = b % 1024, swz = sb ^ (((sb >> 9) & 1) << 5); R = (st >> 1) * 16 + swz / 64; C = (st & 1) * 32 + (swz % 64) / 2; }
__host__ __device__ __forceinline__ int perm32(int rho) { const int n = rho >> 4, i = rho & 15; return 8 * (i >> 2) + 4 * n + (i & 3); }
struct Unit { int pm, pn, e; };
typedef int v8i __attribute__((ext_vector_type(8))); typedef int v4i __attribute__((ext_vector_type(4)));
__device__ __forceinline__ v8i cat8(bf16x8 a, bf16x8 b) { const v4i x = __builtin_bit_cast(v4i, a), y = __builtin_bit_cast(v4i, b); return __builtin_shufflevector(x, y, 0, 1, 2, 3, 4, 5, 6, 7); }
__device__ __forceinline__ unsigned cvt_pk_bf16(float lo, float hi) { unsigned r; asm volatile("v_cvt_pk_bf16_f32 %0, %1, %2" : "=v"(r) : "v"(lo), "v"(hi)); return r; }

struct StaticOrder {
    unsigned A, Bt, tstep;
    int nM, nN, nwg, G, c;
    __device__ void init(size_t A_, size_t Bt_, int M, int N, int K, int G_, int c_) { A = (unsigned)A_; Bt = (unsigned)Bt_; tstep = (unsigned)(BM * K * 2); nM = M / BM; nN = N / BM; nwg = nM * nN; G = G_; c = c_; }
    __device__ bool next(int i, Unit& u) const {
        const long L = (long)i * G + c; if (L >= nwg) return false;
        int wgid = (int)L; { const int q = nwg / NXCD, r = nwg % NXCD, xcd = wgid % NXCD, off = wgid / NXCD; wgid = (xcd < r ? xcd * (q + 1) : r * (q + 1) + (xcd - r) * q) + off; }
        const int nig = WGM * nN, gid = wgid / nig, fm = gid * WGM, gsz = (nM - fm) < WGM ? (nM - fm) : WGM;
        u.pm = fm + ((wgid % nig) % gsz); u.pn = (wgid % nig) / gsz; u.e = 0; return true;
    }
    __device__ __forceinline__ unsigned pa(const Unit& u) const { return A + (unsigned)u.pm * tstep; }
    __device__ __forceinline__ unsigned pb(const Unit& u) const { return Bt + (unsigned)u.pn * tstep; }
};
struct MoeOrder {
    unsigned A, Bt, tstep, estep;
    const LAS unsigned char* blk_e; int nblk, nN, G, c;
    __device__ bool next(int i, Unit& u) const {
        const int L = i * G + c; if (L >= nblk * nN) return false;
        u.pm = L / nN; u.pn = L % nN; u.e = __builtin_amdgcn_readfirstlane((int)blk_e[u.pm]); return true;
    }
    __device__ __forceinline__ unsigned pa(const Unit& u) const { return A + (unsigned)u.pm * tstep; }
    __device__ __forceinline__ unsigned pb(const Unit& u) const { return Bt + (unsigned)u.e * estep + (unsigned)u.pn * tstep; }
};

struct EpiStoreBf16 {
    static constexpr bool PERM = true;
    bf16_t* O; int ldc; const float* bias; int bias_estride; float bias_scale, acc_scale;
    __device__ __forceinline__ void init(f32x4 (&acc)[2][2][4][2], const Unit& u, int wc, int fq) const {
        const int col0 = u.pn * BM + wc * 32 + 8 * fq;
#pragma unroll
        for (int b = 0; b < 2; ++b)
#pragma unroll
            for (int n = 0; n < 2; ++n) { const f32x4 bv = bias ? *(const f32x4*)(bias + (size_t)u.e * bias_estride + col0 + b * HALF + 4 * n) * bias_scale : (f32x4){0.f, 0.f, 0.f, 0.f};
#pragma unroll
                for (int a = 0; a < 2; ++a)
#pragma unroll
                    for (int m = 0; m < 4; ++m) { f32x4 t = bv; asm volatile("" : "+v"(t)); acc[a][b][m][n] = t; } }
    }
    __device__ __forceinline__ void operator()(const f32x4 (&acc)[2][2][4][2], const Unit& u, int wr, int wc, int fr, int fq) const {
        const int row0 = u.pm * BM + wr * 64 + fr, col0 = u.pn * BM + wc * 32 + 8 * fq;
#pragma unroll
        for (int ai = 0; ai < 2; ++ai)
#pragma unroll
            for (int m = 0; m < 4; ++m) { bf16_t* rowp = O + (size_t)(row0 + ai * HALF + m * 16) * ldc + col0;
#pragma unroll
                for (int bj = 0; bj < 2; ++bj) { const f32x4 v0 = acc[ai][bj][m][0] * acc_scale, v1 = acc[ai][bj][m][1] * acc_scale;
                    u32x4 w; w.x = cvt_pk_bf16(v0[0], v0[1]); w.y = cvt_pk_bf16(v0[2], v0[3]); w.z = cvt_pk_bf16(v1[0], v1[1]); w.w = cvt_pk_bf16(v1[2], v1[3]);
                    *(u32x4*)(rowp + bj * HALF) = w; }
                asm volatile("" ::: "memory"); }
    }
};
__device__ __forceinline__ float swiglu1(float g, float up) {
    g = fminf(g, 7.0f); up = fminf(fmaxf(up, -7.0f), 7.0f);
    return g * (1.f / (1.f + __expf(-1.702f * g))) * (up + 1.0f);
}
constexpr float X8_S = 8.0f, W8_S = 256.0f, ACT_S = 4.0f;
struct EpiSwiglu {
    static constexpr bool PERM = true;
    bf16_t* O; int ldc; const float* bias; int bias_estride; float bias_scale, acc_scale;
    __device__ __forceinline__ void init(f32x4 (&acc)[2][2][4][2], const Unit& u, int wc, int fq) const {
        const int col0 = u.pn * BM + wc * 32 + 8 * fq;
#pragma unroll
        for (int b = 0; b < 2; ++b)
#pragma unroll
            for (int n = 0; n < 2; ++n) { const f32x4 bv = bias ? *(const f32x4*)(bias + (size_t)u.e * bias_estride + col0 + b * HALF + 4 * n) * bias_scale : (f32x4){0.f, 0.f, 0.f, 0.f};
#pragma unroll
                for (int a = 0; a < 2; ++a)
#pragma unroll
                    for (int m = 0; m < 4; ++m) { f32x4 t = bv; asm volatile("" : "+v"(t)); acc[a][b][m][n] = t; } }
    }
    __device__ __forceinline__ void operator()(const f32x4 (&acc)[2][2][4][2], const Unit& u, int wr, int wc, int fr, int fq) const {
        const int row0 = u.pm * BM + wr * 64 + fr, col0 = u.pn * BM + wc * 32 + 8 * fq;
#pragma unroll
        for (int ai = 0; ai < 2; ++ai)
#pragma unroll
            for (int m = 0; m < 4; ++m) { unsigned char* rowp = (unsigned char*)O + (size_t)(row0 + ai * HALF + m * 16) * ldc + (col0 >> 1);
#pragma unroll
                for (int bj = 0; bj < 2; ++bj) { const f32x4 v0 = acc[ai][bj][m][0] * acc_scale, v1 = acc[ai][bj][m][1] * acc_scale;
                    unsigned w = 0; w = __builtin_amdgcn_cvt_pk_fp8_f32(swiglu1(v0[0], v0[1]) * ACT_S, swiglu1(v0[2], v0[3]) * ACT_S, w, false); w = __builtin_amdgcn_cvt_pk_fp8_f32(swiglu1(v1[0], v1[1]) * ACT_S, swiglu1(v1[2], v1[3]) * ACT_S, w, true);
                    *(unsigned*)(rowp + bj * (HALF / 2)) = w; }
                asm volatile("" ::: "memory"); }
    }
};
struct EpiResidual {
    static constexpr bool PERM = false;
    float* X; int ldc; const float* gate_lat; const float* gate_ctx;
    __device__ __forceinline__ void init(f32x4 (&acc)[2][2][4][2], const Unit& u, int wc, int fq) const {
#pragma unroll
        for (int a = 0; a < 2; ++a)
#pragma unroll
            for (int b = 0; b < 2; ++b)
#pragma unroll
                for (int m = 0; m < 4; ++m)
#pragma unroll
                    for (int n = 0; n < 2; ++n) acc[a][b][m][n] = (f32x4){0.f, 0.f, 0.f, 0.f};
    }
    __device__ __forceinline__ void operator()(const f32x4 (&acc)[2][2][4][2], const Unit& u, int wr, int wc, int fr, int fq) const {
        const int row0 = u.pm * BM + wr * 64 + fr, col0 = u.pn * BM + wc * 32 + 4 * fq;
        const float* gp = (u.pm == 0) ? gate_ctx : gate_lat;
        f32x4 gv[2][2];
#pragma unroll
        for (int bj = 0; bj < 2; ++bj)
#pragma unroll
            for (int n = 0; n < 2; ++n) gv[bj][n] = *(const f32x4*)(gp + col0 + bj * HALF + n * 16);
#pragma unroll
        for (int ai = 0; ai < 2; ++ai)
#pragma unroll
            for (int m = 0; m < 4; ++m) { float* rowp = X + (size_t)(row0 + ai * HALF + m * 16) * ldc + col0;
#pragma unroll
                for (int bj = 0; bj < 2; ++bj)
#pragma unroll
                    for (int n = 0; n < 2; ++n) { f32x4* p = (f32x4*)(rowp + bj * HALF + n * 16); *p = *p + gv[bj][n] * acc[ai][bj][m][n]; }
                asm volatile("" ::: "memory"); }
    }
};
template <class Epi, class Sched, bool ALIGN_EPI = false, bool SP2 = false, int ES = 2>
__device__ __forceinline__ void gemm_phase(PG8_LAS unsigned char* lds, const int tid, const int K, const Sched& S, const Epi& E, const void* wsbase) {
    const __amdgpu_buffer_rsrc_t rsrc = __builtin_amdgcn_make_buffer_rsrc((void*)wsbase, 0, 0x7fffffff, 0x00020000);
    const int wid = __builtin_amdgcn_readfirstlane(tid >> 6), lane = tid & 63, wr = wid >> 2, wc = wid & 3, fr = lane & 15, fq = lane >> 4;
    const int nt = (K * ES) / 128;
    unsigned voffA[2], voffB[2];
#pragma unroll
    for (int i = 0; i < 2; ++i) { int R, C; stage_rc(tid * 16 + i * 8192, R, C); const int Rb = Epi::PERM ? ((R & ~31) + perm32(R & 31)) : R;
        voffA[i] = (unsigned)(R * K * ES + C * 2); voffB[i] = (unsigned)(Rb * K * ES + C * 2); }
    const unsigned kstep = (unsigned)(BK * 2);
    const unsigned hstep = (unsigned)(HALF * K * ES);
        const unsigned ldsw = (unsigned)wid * 1024u;
    const int aoff = lds_byte(wr * 64 + fr, ES == 2 ? fq * 8 : fq * 16), boff = lds_byte(wc * 32 + fr, ES == 2 ? fq * 8 : fq * 16); constexpr int KOFF = (ES == 2) ? 1024 : 16;
#define PG8_SA(b, h) (((b) * 2 + (h)) * HTB)
#define PG8_SB(b, h) ((4 + (b) * 2 + (h)) * HTB)
#define PG8_STAGE(bufoff, gbase, voff) do { _Pragma("unroll") for (int _i = 0; _i < 2; ++_i) \
        __builtin_amdgcn_raw_ptr_buffer_load_lds(rsrc, (PG8_LAS unsigned*)(lds + (bufoff) + ldsw + _i * 8192), 16, (voff)[_i], (gbase), 0, 0); } while (0)
#define PG8_LDA(dst, b, h) do { _Pragma("unroll") for (int m = 0; m < 4; ++m) _Pragma("unroll") for (int k = 0; k < 2; ++k) dst[m][k] = *(const PG8_LAS bf16x8*)(lds + PG8_SA(b, h) + aoff + m * 2048 + k * KOFF); } while (0)
#define PG8_LDA8(dst, b, h) do { _Pragma("unroll") for (int m = 0; m < 4; ++m) { const PG8_LAS v4i* p_ = (const PG8_LAS v4i*)(lds + PG8_SA(b, h) + aoff + m * 2048); const v4i x_ = p_[0], y_ = p_[1]; dst[m] = __builtin_shufflevector(x_, y_, 0, 1, 2, 3, 4, 5, 6, 7); } } while (0)
#define PG8_LDB(dst, b, h) do { _Pragma("unroll") for (int n = 0; n < 2; ++n) _Pragma("unroll") for (int k = 0; k < 2; ++k) dst[n][k] = *(const PG8_LAS bf16x8*)(lds + PG8_SB(b, h) + boff + n * 2048 + k * KOFF); } while (0)
#define PG8_LDB8(dst, b, h) do { _Pragma("unroll") for (int n = 0; n < 2; ++n) { const PG8_LAS v4i* p_ = (const PG8_LAS v4i*)(lds + PG8_SB(b, h) + boff + n * 2048); const v4i x_ = p_[0], y_ = p_[1]; dst[n] = __builtin_shufflevector(x_, y_, 0, 1, 2, 3, 4, 5, 6, 7); } } while (0)
#define PG8_MMA(ai, bj, At, Bt) do { __builtin_amdgcn_s_setprio(1); _Pragma("unroll") for (int m = 0; m < 4; ++m) _Pragma("unroll") for (int n = 0; n < 2; ++n) { \
        if constexpr (ES == 2) { _Pragma("unroll") for (int k = 0; k < 2; ++k) acc[ai][bj][m][n] = __builtin_amdgcn_mfma_f32_16x16x32_bf16(Bt[n][k], At[m][k], acc[ai][bj][m][n], 0, 0, 0); } \
        else asm volatile("v_mfma_f32_16x16x128_f8f6f4 %0, %1, %2, %0" : "+v"(acc[ai][bj][m][n]) : "v"(Bt##8[n]), "v"(At##8[m])); } \
        __builtin_amdgcn_s_setprio(0); } while (0)
#define PG8_LDAX(b, h) do { if constexpr (ES == 2) PG8_LDA(At, b, h); else PG8_LDA8(At8, b, h); } while (0)
#define PG8_LDBX(B, b, h) do { if constexpr (ES == 2) PG8_LDB(B, b, h); else PG8_LDB8(B##8, b, h); } while (0)
#define PG8_WAIT_V(n) asm volatile("s_waitcnt vmcnt(" #n ")" ::: "memory")
#define PG8_WAIT_L(n) asm volatile("s_waitcnt lgkmcnt(" #n ")" ::: "memory")
#define PG8_BAR __builtin_amdgcn_s_barrier()
#define PG8_SCHED __builtin_amdgcn_sched_barrier(0)
    Unit cur, nxt; int ui = 0;
    if (!S.next(0, cur)) return;
    f32x4 acc[2][2][4][2];
    E.init(acc, cur, wc, fq);
    bf16x8 At[4][2], B0[2][2], B1[2][2]; v8i At8[4], B08[2], B18[2];
    unsigned cA = S.pa(cur), cB = S.pb(cur);
    if constexpr (SP2) {
        PG8_STAGE(PG8_SB(0, 0), cB, voffB); PG8_STAGE(PG8_SB(0, 1), cB + hstep, voffB); PG8_STAGE(PG8_SA(0, 0), cA, voffA); PG8_STAGE(PG8_SA(0, 1), cA + hstep, voffA);
        if (wr == 1) PG8_BAR;
        PG8_WAIT_V(2); PG8_BAR;
        PG8_STAGE(PG8_SB(1, 0), cB + kstep, voffB); PG8_STAGE(PG8_SA(1, 0), cA + kstep, voffA); PG8_STAGE(PG8_SB(1, 1), cB + hstep + kstep, voffB);
        PG8_WAIT_V(6); PG8_BAR;
    } else {
        PG8_STAGE(PG8_SB(0, 0), cB, voffB); PG8_STAGE(PG8_SA(0, 0), cA, voffA); PG8_STAGE(PG8_SB(0, 1), cB + hstep, voffB); PG8_STAGE(PG8_SA(0, 1), cA + hstep, voffA);
        if (wr == 1) PG8_BAR;
        PG8_WAIT_V(4); PG8_BAR;
        PG8_STAGE(PG8_SB(1, 0), cB + kstep, voffB); PG8_STAGE(PG8_SA(1, 0), cA + kstep, voffA); PG8_STAGE(PG8_SB(1, 1), cB + hstep + kstep, voffB);
        PG8_WAIT_V(6); PG8_BAR;
    }
    for (;;) {
        const bool has_next = S.next(ui + 1, nxt);
        const unsigned nA = has_next ? S.pa(nxt) : cA, nB = has_next ? S.pb(nxt) : cB;
        for (int t = 0; t < nt; t += 2) {
            const bool last = (t == nt - 2);
            const unsigned a1 = cA + (unsigned)(t + 1) * kstep;
            const unsigned a2 = last ? nA : cA + (unsigned)(t + 2) * kstep, b2 = last ? nB : cB + (unsigned)(t + 2) * kstep;
            const unsigned a3 = a2 + kstep, b3 = b2 + kstep;
            if constexpr (SP2) {
            PG8_LDBX(B0, 0, 0); PG8_LDBX(B1, 0, 1); PG8_SCHED; PG8_LDAX(0, 0); PG8_STAGE(PG8_SA(1, 1), a1 + hstep, voffA);
            PG8_WAIT_V(8); PG8_WAIT_L(0); PG8_BAR; PG8_MMA(0, 0, At, B0); PG8_MMA(0, 1, At, B1); PG8_BAR; PG8_SCHED;
            PG8_LDAX(0, 1); PG8_STAGE(PG8_SB(0, 0), b2, voffB); PG8_STAGE(PG8_SB(0, 1), b2 + hstep, voffB); PG8_STAGE(PG8_SA(0, 0), a2, voffA);
            PG8_WAIT_V(8); PG8_WAIT_L(0); PG8_BAR; PG8_MMA(1, 0, At, B0); PG8_MMA(1, 1, At, B1); PG8_BAR; PG8_SCHED;
            PG8_LDBX(B0, 1, 0); PG8_LDBX(B1, 1, 1); PG8_SCHED; PG8_LDAX(1, 0); PG8_STAGE(PG8_SA(0, 1), a2 + hstep, voffA);
            PG8_WAIT_V(8); PG8_WAIT_L(0); PG8_BAR; PG8_MMA(0, 0, At, B0); PG8_MMA(0, 1, At, B1); PG8_BAR; PG8_SCHED;
            PG8_LDAX(1, 1); PG8_STAGE(PG8_SB(1, 0), b3, voffB); PG8_STAGE(PG8_SB(1, 1), b3 + hstep, voffB); PG8_STAGE(PG8_SA(1, 0), a3, voffA);
            PG8_WAIT_V(8); PG8_WAIT_L(0); PG8_BAR; PG8_MMA(1, 0, At, B0); PG8_MMA(1, 1, At, B1); PG8_BAR; PG8_SCHED;
            } else {
            PG8_LDBX(B0, 0, 0); PG8_SCHED; PG8_LDAX(0, 0); PG8_STAGE(PG8_SA(1, 1), a1 + hstep, voffA);
            PG8_WAIT_L(8); PG8_BAR; PG8_WAIT_L(0); PG8_MMA(0, 0, At, B0); PG8_BAR; PG8_SCHED;
            PG8_LDBX(B1, 0, 1); PG8_STAGE(PG8_SB(0, 0), b2, voffB);
            PG8_BAR; PG8_WAIT_L(0); PG8_MMA(0, 1, At, B1); PG8_BAR;
            PG8_LDAX(0, 1); PG8_STAGE(PG8_SA(0, 0), a2, voffA);
            PG8_BAR; PG8_WAIT_L(0); PG8_MMA(1, 0, At, B0); PG8_BAR; PG8_SCHED;
            PG8_STAGE(PG8_SB(0, 1), b2 + hstep, voffB);
            PG8_WAIT_V(6); PG8_BAR; PG8_MMA(1, 1, At, B1); PG8_BAR;
            PG8_LDBX(B0, 1, 0); PG8_SCHED; PG8_LDAX(1, 0); PG8_STAGE(PG8_SA(0, 1), a2 + hstep, voffA);
            PG8_WAIT_L(8); PG8_BAR; PG8_WAIT_L(0); PG8_MMA(0, 0, At, B0); PG8_BAR; PG8_SCHED;
            PG8_LDBX(B1, 1, 1); PG8_STAGE(PG8_SB(1, 0), b3, voffB);
            PG8_BAR; PG8_WAIT_L(0); PG8_MMA(0, 1, At, B1); PG8_BAR;
            PG8_LDAX(1, 1); PG8_STAGE(PG8_SA(1, 0), a3, voffA);
            PG8_BAR; PG8_WAIT_L(0); PG8_MMA(1, 0, At, B0); PG8_BAR; PG8_SCHED;
            PG8_STAGE(PG8_SB(1, 1), b3 + hstep, voffB);
            PG8_WAIT_V(6); PG8_BAR; PG8_MMA(1, 1, At, B1); PG8_BAR;
            }
        }
        if constexpr (ALIGN_EPI) { if (wr == 0) PG8_BAR; }
        if constexpr (ES == 1) asm volatile("s_nop 15\n\ts_nop 15" ::: "memory");
        E(acc, cur, wr, wc, fr, fq);
        if (!has_next) break;
        E.init(acc, nxt, wc, fq);
        cur = nxt; cA = nA; cB = nB; ++ui;
        if constexpr (ALIGN_EPI) { if (wr == 1) PG8_BAR; }
    }
    PG8_WAIT_V(0);
    if constexpr (!ALIGN_EPI) { if (wr == 0) PG8_BAR; }
    PG8_BAR;
#undef PG8_SA
#undef PG8_SB
#undef PG8_STAGE
#undef PG8_LDA
#undef PG8_LDA8
#undef PG8_LDB8
#undef PG8_LDAX
#undef PG8_LDBX
#undef PG8_LDB
#undef PG8_MMA
#undef PG8_WAIT_V
#undef PG8_WAIT_L
#undef PG8_BAR
#undef PG8_SCHED
}
}

#define XB_TMO      128
#define XB_XCNT(j)  (256  + 64 * (j))
#define XB_XSUB(j)  (1280 + 64 * (j))
#define XB_XGEN(j)  (2304 + 64 * (j))
#define XB_TOP      3328
#define XB_TOPGEN   3392
#define XCD_BAR_WORDS 3456
#define XB_SPIN_CAP (1u << 18)
__device__ __forceinline__ unsigned xb_ld(unsigned* p)              { return __hip_atomic_load(p, __ATOMIC_RELAXED, __HIP_MEMORY_SCOPE_AGENT); }
__device__ __forceinline__ unsigned xb_add(unsigned* p, unsigned v) { return __hip_atomic_fetch_add(p, v, __ATOMIC_RELAXED, __HIP_MEMORY_SCOPE_AGENT); }
__device__ __forceinline__ unsigned xb_xcc_id() { return (unsigned)__builtin_amdgcn_s_getreg((3 << 11) | 20) & 0xFu; }
#define XB_SPIN(cond, bar) do { unsigned _sp = 0; while (cond) { __builtin_amdgcn_s_sleep(1); \
    if ((++_sp & 255u) == 0u) { if (xb_ld(&(bar)[XB_TMO])) break; if (_sp > XB_SPIN_CAP) { atomicAdd(&(bar)[XB_TMO], 1u); break; } } } } while (0)

struct XcdBarrier {
    unsigned* bar; unsigned x;
    volatile LAS unsigned* st;
};

__device__ __forceinline__ XcdBarrier xcd_barrier_post(unsigned* bar, volatile LAS unsigned* st) {
    XcdBarrier b; b.bar = bar; b.x = xb_xcc_id(); b.st = st;
    if (threadIdx.x == 0) (void)xb_add(&bar[XB_XCNT(b.x)], 1u);
    return b;
}
__device__ __forceinline__ void xcd_barrier_complete(unsigned* bar, unsigned x, unsigned& nloc, unsigned& nx) {
    const unsigned G = gridDim.x * gridDim.y * gridDim.z;
    unsigned sum, cnt, mine, sp = 0u;
    for (;;) {
        sum = 0u; cnt = 0u; mine = 0u;
#pragma unroll
        for (unsigned j = 0; j < 16; ++j) { const unsigned c = xb_ld(&bar[XB_XCNT(j)]); sum += c; cnt += (c > 0u) ? 1u : 0u; mine = (j == x) ? c : mine; }
        if (sum == G) break;
        __builtin_amdgcn_s_sleep(1);
        if ((++sp & 255u) == 0u) { if (xb_ld(&bar[XB_TMO])) break; if (sp > XB_SPIN_CAP) { atomicAdd(&bar[XB_TMO], 1u); break; } }
    }
    nloc = mine > 0u ? mine : 1u; nx = cnt > 0u ? cnt : 1u;
}

__device__ __forceinline__ void xcd_barrier(const XcdBarrier& b) {
    asm volatile("s_waitcnt vmcnt(0)" ::: "memory");
    __syncthreads();
    if (threadIdx.x == 0) {
        unsigned* bar = b.bar;
        __builtin_amdgcn_s_waitcnt(0);
        unsigned nloc = b.st[0], nx = b.st[1];
        if (nloc == 0u) { xcd_barrier_complete(bar, b.x, nloc, nx); b.st[0] = nloc; b.st[1] = nx; }
        const unsigned old = xb_add(&bar[XB_XSUB(b.x)], 1u);
        const unsigned gen = old / nloc;
        if (old + 1u == (gen + 1u) * nloc) {
            __builtin_amdgcn_fence(__ATOMIC_RELEASE, "agent");
            asm volatile("s_waitcnt vmcnt(0)" ::: "memory");
            const unsigned og = xb_add(&bar[XB_TOP], 1u);
            const unsigned tg = og / nx;
            if (og + 1u == (tg + 1u) * nx) xb_add(&bar[XB_TOPGEN], 1u);
            else XB_SPIN(xb_ld(&bar[XB_TOPGEN]) == tg, bar);
            __builtin_amdgcn_fence(__ATOMIC_ACQUIRE, "agent");
            xb_add(&bar[XB_XGEN(b.x)], 1u);
            asm volatile("s_waitcnt vmcnt(0)" ::: "memory");
        } else {
            XB_SPIN(xb_ld(&bar[XB_XGEN(b.x)]) == gen, bar);
            __builtin_amdgcn_fence(__ATOMIC_ACQUIRE, "agent");
            asm volatile("s_waitcnt vmcnt(0)" ::: "memory");
        }
    }
    __syncthreads();
}

typedef short s4v __attribute__((ext_vector_type(4)));
__device__ __forceinline__ bf16x8 ldg8(const bf16* p) { return *(const bf16x8*)p; }
__device__ __forceinline__ f32x4 mfma16(bf16x8 a, bf16x8 b, f32x4 c) { return __builtin_amdgcn_mfma_f32_16x16x32_bf16(a, b, c, 0, 0, 0); }
__device__ __forceinline__ bf16x8 ldA(const LAS unsigned char* base, int pitch, int row0, int k0, int li, int g) { return *(const LAS bf16x8*)(base + ((row0 + li) * pitch + k0 + 8 * g) * 2); }
__device__ __forceinline__ bf16x8 ldT(const LAS unsigned char* base, int pitch, int k0, int n0, int li, int g) {
    const LAS unsigned char* p = base + ((k0 + 8 * g + (li >> 2)) * pitch + n0 + 4 * (li & 3)) * 2;
    const s4v a = __builtin_amdgcn_ds_read_tr16_b64_v4i16((LAS s4v*)p), b = __builtin_amdgcn_ds_read_tr16_b64_v4i16((LAS s4v*)(p + 8 * pitch));
    return (bf16x8){a[0], a[1], a[2], a[3], b[0], b[1], b[2], b[3]};
}
__device__ __forceinline__ bf16x8 ldAperm(const LAS unsigned char* base, int pitch, int row0, int ks, int li, int g) {
    const LAS unsigned char* p = base + ((row0 + li) * pitch + 32 * ks + 4 * g) * 2;
    const s4v a = *(const LAS s4v*)p, b = *(const LAS s4v*)(p + 32);
    return (bf16x8){a[0], a[1], a[2], a[3], b[0], b[1], b[2], b[3]};
}
__device__ __forceinline__ void stT(LAS unsigned char* base, int pitch, int n, int m0, const f32x4 v) {
    u32x2 w; w.x = pk2(v[0], v[1]); w.y = pk2(v[2], v[3]); *(LAS u32x2*)(base + (n * pitch + m0) * 2) = w;
}
__device__ __forceinline__ f32x4 ld4bf(const LAS unsigned char* p) { const u32x2 w = *(const LAS u32x2*)p; return (f32x4){bflo(w.x), bfhi(w.x), bflo(w.y), bfhi(w.y)}; }

struct Args {
    const float* in[31];
    float* out; unsigned char* ws;
    int ph_lo, ph_hi, use_bar, pad;
};
enum InIdx { I_X = 0, I_C, I_CTX, I_CCTX, I_ADAW, I_ADAB, I_N1G, I_N2G, I_WIN, I_WOUT, I_ASINK, I_BMIX, I_CREL, I_DCONV, I_DW0, I_DW2, I_DA0, I_DA2, I_DG2, I_DKK, I_DKA, I_DRK, I_DLNW, I_DLNB,
             I_RW, I_RB, I_WGU, I_BGU, I_WDN, I_BDN, I_FNG };
constexpr int NPL = 11;
constexpr int PH_TOTAL = 1 + DEPTH * NPL + 1;

struct DevIn {
    const LAS unsigned* tab;
    __device__ __forceinline__ const float* operator[](int i) const {
        const unsigned lo = __builtin_amdgcn_readfirstlane(((const volatile LAS unsigned*)tab)[2 * i]), hi = __builtin_amdgcn_readfirstlane(((const volatile LAS unsigned*)tab)[2 * i + 1]);
        return (const float*)(((unsigned long long)hi << 32) | lo);
    }
};
struct DArgs { DevIn in; float* out; };
struct Ctx {
    LAS unsigned char* lds;
    int tid, lane, wave, wg, G, gw, NGW;
    unsigned char* ws;
};

template <int NW>
__device__ __forceinline__ void transpose_item(const float* W, int K, int N, bf16* WT, int item, int lane) {
    constexpr int NQ = NW / 4, NC = 64 / NQ, PASSES = 8 / NC;
    const int nblk = N / NW, kb = item / nblk, nb = item % nblk, k0 = 64 * kb, n0 = NW * nb, nq = lane % NQ, cq = lane / NQ;
    f32x4 v[PASSES][8];
#pragma unroll
    for (int ps = 0; ps < PASSES; ++ps)
#pragma unroll
        for (int i = 0; i < 8; ++i) v[ps][i] = *(const f32x4*)(W + (size_t)(k0 + 8 * (cq + NC * ps) + i) * N + n0 + 4 * nq);
#pragma unroll
    for (int ps = 0; ps < PASSES; ++ps)
#pragma unroll
        for (int j = 0; j < 4; ++j) { u32x4 o; o.x = pk2(v[ps][0][j], v[ps][1][j]); o.y = pk2(v[ps][2][j], v[ps][3][j]); o.z = pk2(v[ps][4][j], v[ps][5][j]); o.w = pk2(v[ps][6][j], v[ps][7][j]);
            *(u32x4*)(WT + (size_t)(n0 + 4 * nq + j) * K + k0 + 8 * (cq + NC * ps)) = o; }
}
template <int NW>
__device__ __forceinline__ void transpose_item8(const float* W, int K, int N, unsigned char* WT, int item, int lane) {
    constexpr int NQ = NW / 4, NC = 64 / NQ, PASSES = 8 / NC;
    const int nblk = N / NW, kb = item / nblk, nb = item % nblk, k0 = 64 * kb, n0 = NW * nb, nq = lane % NQ, cq = lane / NQ;
    f32x4 v[PASSES][8];
#pragma unroll
    for (int ps = 0; ps < PASSES; ++ps)
#pragma unroll
        for (int i = 0; i < 8; ++i) v[ps][i] = *(const f32x4*)(W + (size_t)(k0 + 8 * (cq + NC * ps) + i) * N + n0 + 4 * nq) * pg8::W8_S;
#pragma unroll
    for (int ps = 0; ps < PASSES; ++ps)
#pragma unroll
        for (int j = 0; j < 4; ++j) { unsigned w0 = 0, w1 = 0;
            w0 = __builtin_amdgcn_cvt_pk_fp8_f32(v[ps][0][j], v[ps][1][j], w0, false); w0 = __builtin_amdgcn_cvt_pk_fp8_f32(v[ps][2][j], v[ps][3][j], w0, true);
            w1 = __builtin_amdgcn_cvt_pk_fp8_f32(v[ps][4][j], v[ps][5][j], w1, false); w1 = __builtin_amdgcn_cvt_pk_fp8_f32(v[ps][6][j], v[ps][7][j], w1, true);
            *(u32x2*)(WT + (size_t)(n0 + 4 * nq + j) * K + k0 + 8 * (cq + NC * ps)) = (u32x2){w0, w1}; }
}
constexpr int CV_IT_GU = 16 * 64, CV_IT_DN = 16 * 32, CV_N_GU = 32 * CV_IT_GU, CV_N_DN = 32 * CV_IT_DN, CV_ITEMS = CV_N_GU + CV_N_DN, CV_CHUNK = 16, CV_NCHUNK = CV_ITEMS / CV_CHUNK;
__device__ __forceinline__ void convert_moe_items(const Ctx& C, const DArgs& a, int l, int it0, int it1) {
    const float* pwgu = a.in[I_WGU] + (size_t)l * 32 * DM * 2048; const float* pwdn = a.in[I_WDN] + (size_t)l * 32 * DM * DM;
    unsigned char* ogu = C.ws + WS_WGU + (size_t)l * 32 * 2048 * DM; unsigned char* odn = C.ws + WS_WDN + (size_t)l * 32 * DM * DM;
#pragma unroll 1
    for (int it = it0; it < it1; ++it) {
        if (it < CV_N_GU) { const int e = it / CV_IT_GU; transpose_item8<32>(pwgu + (size_t)e * DM * 2048, DM, 2048, ogu + (size_t)e * 2048 * DM, it % CV_IT_GU, C.lane); }
        else { const int r = it - CV_N_GU, e = r / CV_IT_DN; transpose_item8<32>(pwdn + (size_t)e * DM * DM, DM, DM, odn + (size_t)e * DM * DM, r % CV_IT_DN, C.lane); }
    }
}
__device__ __forceinline__ void phase_prologue(const Ctx& C, const DArgs& a) {
    constexpr int IT_IN = 16 * (INW / 32), IT_OUT = 16 * 16;
    constexpr int N_IN = 4 * IT_IN, N_OUT = 4 * IT_OUT;
    const float* pwin = a.in[I_WIN]; const float* pwout = a.in[I_WOUT];
    for (int it = C.gw; it < N_IN + N_OUT; it += C.NGW) {
        if (it < N_IN) { const int l = it / IT_IN; transpose_item<32>(pwin + (size_t)l * DM * INW, DM, INW, (bf16*)(C.ws + WS_WIN) + (size_t)l * INWP * DM, it % IT_IN, C.lane); }
        else { const int r = it - N_IN, l = r / IT_OUT; transpose_item<64>(pwout + (size_t)l * DM * DM, DM, DM, (bf16*)(C.ws + WS_WOUT) + (size_t)l * DM * DM, r % IT_OUT, C.lane); }
    }
    for (int ch = C.gw; ch < CV_NCHUNK; ch += C.NGW) convert_moe_items(C, a, 0, ch * CV_CHUNK, ch * CV_CHUNK + CV_CHUNK);
    { const int gt = C.wg * NTHR + C.tid; constexpr int PADN = (INWP - INW) * DM / 8;
      for (int i = gt; i < 4 * PADN; i += C.G * NTHR) { const int l = i / PADN, r = i % PADN; *((u32x4*)((bf16*)(C.ws + WS_WIN) + ((size_t)l * INWP + INW) * DM) + r) = (u32x4){0u, 0u, 0u, 0u}; } }
    { float* tw = (float*)(C.ws + WS_TW); const int gt = C.wg * NTHR + C.tid;
      for (int i = gt; i < 16384; i += C.G * NTHR) { const float x = (float)i * (1.0f / 8192.0f); tw[i] = cospif(x); tw[16384 + i] = sinpif(x); } }
    { float* mt = (float*)(C.ws + WS_MTAB); const int gt = C.wg * NTHR + C.tid; const float* pbmix = a.in[I_BMIX];
      for (int i = gt; i < 4 * 4 * 64 * 64; i += C.G * NTHR) { const int e = i & 63, c = (i >> 6) & 63, g = (i >> 12) & 3, l = i >> 14;
          const float* w = pbmix + ((size_t)(l * 4 + g) * 64) * 64 + e; float sc = 0.f, ss = 0.f;
          for (int cp = 0; cp < 64; ++cp) { const float x = (float)((c * cp) & 63) * (1.0f / 32.0f); const float wv = w[cp * 64]; sc += cospif(x) * wv; ss += sinpif(x) * wv; }
          mt[((size_t)(l * 2 + 0) * 4 + g) * 4096 + c * 64 + e] = sc; mt[((size_t)(l * 2 + 1) * 4 + g) * 4096 + c * 64 + e] = ss; } }
    { bf16* ft = (bf16*)(C.ws + WS_FTAB); const int gt = C.wg * NTHR + C.tid; const float* pbmix = a.in[I_BMIX];
      for (int i = gt; i < 128 * 128; i += C.G * NTHR) { const int k = i >> 7, t = i & 127; const float x = (float)((k * t) & 127) * (1.0f / 64.0f); ft[i] = (bf16)f2bf(cospif(x)); ft[16384 + i] = (bf16)f2bf(sinpif(x)); }
      bf16* mf = ft + 32768;
      for (int i = gt; i < 4 * 4 * 16 * 64 * 8; i += C.G * NTHR) { const int j8 = i & 7, ln = (i >> 3) & 63, fr = (i >> 9) & 15, gq = (i >> 13) & 3, l = i >> 15;
          const int ei = fr >> 2, ks2 = fr & 3, e = 16 * ei + (ln & 15), g = ln >> 4, c = 32 * (ks2 & 1) + 16 * (j8 >> 2) + 4 * g + (j8 & 3), part = ks2 >> 1;
          const float* w = pbmix + ((size_t)(l * 4 + gq) * 64) * 64 + e; float s = 0.f;
          for (int cp = 0; cp < 64; ++cp) { const float x = (float)((c * cp) & 63) * (1.0f / 32.0f); s += (part ? sinpif(x) : cospif(x)) * w[cp * 64]; }
          mf[i] = (bf16)f2bf(s * (1.0f / 1024.0f)); } }
    { const int gt = C.wg * NTHR + C.tid; const float* pg2 = a.in[I_DG2]; const float* prw = a.in[I_RW]; bf16* g2t = (bf16*)(C.ws + WS_G2T); bf16* rwt = (bf16*)(C.ws + WS_RWT);
      for (int i = gt; i < 4 * 256 * 160; i += C.G * NTHR) { const int ii = i % 160, c = (i / 160) & 255, l = i / (160 * 256); g2t[i] = (bf16)f2bf(pg2[((size_t)l * 160 + ii) * 256 + c]); }
      for (int i = gt; i < 4 * 32 * 1024; i += C.G * NTHR) { const int k = i & 1023, e = (i >> 10) & 31, l = i >> 15; rwt[i] = (bf16)f2bf(prw[((size_t)l * 1024 + k) * 32 + e]); } }
    { const int gt = C.wg * NTHR + C.tid; const float* pw2 = a.in[I_DW2]; const float* pa2 = a.in[I_DA2]; bf16* lt = (bf16*)(C.ws + WS_LORAT);
      for (int i = gt; i < 4 * 4 * 256 * 64; i += C.G * NTHR) { const int ii = i & 63, c = (i >> 6) & 255, q = (i >> 14) & 3, l = i >> 16;
          const float* src = (q < 2) ? pw2 : pa2; lt[i] = (bf16)f2bf(src[(((size_t)l * 2 + (q & 1)) * 64 + ii) * 256 + c]); } }
    { bf16* f2 = (bf16*)(C.ws + WS_F256); const int gt = C.wg * NTHR + C.tid;
      for (int i = gt; i < 256 * 256; i += C.G * NTHR) { const int k = i >> 8, t = i & 255; const float x = (float)((k * t) & 255) * (1.0f / 128.0f); f2[i] = (bf16)f2bf(cospif(x)); f2[65536 + i] = (bf16)f2bf(sinpif(x)); } }
    { LAS float* sl = (LAS float*)(C.lds);
      LAS float* red = (LAS float*)(C.lds + 8192);
      __syncthreads();
      const float* pc = a.in[I_C]; const float* pcc = a.in[I_CCTX]; const float* padaw = a.in[I_ADAW]; const float* padab = a.in[I_ADAB];
      for (int i = C.tid; i < 2048; i += NTHR) { const float x = (i < 1024) ? pc[i] : pcc[i - 1024]; sl[i] = x * sigmoidf_(x); }
      __syncthreads();
      float* mod = (float*)(C.ws + WS_MOD);
      for (int u = C.wg; u < 4 * 96; u += C.G) { const int l = u / 96, jb = u % 96, j0 = jb * 64 + C.lane;
          float s0 = 0.f, s1 = 0.f; const float* w = padaw + (size_t)l * DM * 6144 + j0; const int k0 = C.wave * 128;
#pragma unroll 16
          for (int k = 0; k < 128; ++k) { const float wv = w[(size_t)(k0 + k) * 6144]; s0 += wv * sl[k0 + k]; s1 += wv * sl[1024 + k0 + k]; }
          red[(C.wave * 2 + 0) * 64 + C.lane] = s0; red[(C.wave * 2 + 1) * 64 + C.lane] = s1;
          __syncthreads();
          if (C.tid < 128) { const int v = C.tid >> 6, j = C.tid & 63; float s = 0.f;
#pragma unroll
              for (int wv = 0; wv < 8; ++wv) s += red[(wv * 2 + v) * 64 + j];
              mod[(size_t)(l * 2 + v) * 6144 + jb * 64 + j] = s + padab[(size_t)l * 6144 + jb * 64 + j]; }
          __syncthreads(); } }
}

__device__ __forceinline__ void load_row(const float* p, int lane, f32x4 (&v)[4]) {
#pragma unroll
    for (int j = 0; j < 4; ++j) v[j] = *((const f32x4*)p + lane + 64 * j);
}
__device__ __forceinline__ void moe_combine_row(const Ctx& C, int row, f32x4 (&v)[4], const float* gt2) {
    const int* dest = (const int*)(C.ws + WS_ROUTE) + (size_t)3 * ROWS * 4; const float* gate = (const float*)(C.ws + WS_ROUTE) + (size_t)1 * ROWS * 4;
    const bf16* YB = (const bf16*)(C.ws + WS_XG);
    f32x4 s[4];
#pragma unroll
    for (int j = 0; j < 4; ++j) s[j] = (f32x4){0.f, 0.f, 0.f, 0.f};
#pragma unroll
    for (int k = 0; k < 4; ++k) { const int d = dest[row * 4 + k]; const float g = gate[row * 4 + k]; const u32x2* yp = (const u32x2*)(YB + (size_t)d * DM) + C.lane;
#pragma unroll
        for (int j = 0; j < 4; ++j) { const u32x2 w = yp[64 * j]; s[j] += (f32x4){bflo(w.x), bfhi(w.x), bflo(w.y), bfhi(w.y)} * g; } }
#pragma unroll
    for (int j = 0; j < 4; ++j) v[j] += *((const f32x4*)gt2 + C.lane + 64 * j) * s[j];
}
__device__ __forceinline__ float row_rstd(const f32x4 (&v)[4], int lane) {
    float s = 0.f;
#pragma unroll
    for (int j = 0; j < 4; ++j) s += (v[j].x * v[j].x + v[j].y * v[j].y) + (v[j].z * v[j].z + v[j].w * v[j].w);
    return rsqrtf(wave_sum(s, lane) * (1.f / DM) + 1e-6f);
}
__device__ __forceinline__ void norm1_fetch(const Ctx& C, const float* src_row, int row, bool combine, const float* gt2, f32x4 (&v)[4]) {
    load_row(src_row, C.lane, v);
    if (combine) moe_combine_row(C, row, v, gt2);
}
__device__ __forceinline__ void phase_norm1(const Ctx& C, const DArgs& a, int l) {
    float* XS = (float*)(C.ws + WS_XS); bf16* H = (bf16*)(C.ws + WS_H); const float* mod = (const float*)(C.ws + WS_MOD);
    const float* g1 = a.in[I_N1G] + (size_t)l * DM;
    const float* pctx = a.in[I_CTX]; const float* px = a.in[I_X];
    for (int row0 = C.gw; row0 < ROWS; row0 += 2 * C.NGW) {
        f32x4 v[2][4]; const int rows[2] = {row0, row0 + C.NGW};
#pragma unroll
        for (int q = 0; q < 2; ++q) if (rows[q] < ROWS) { const int row = rows[q]; const bool isctx = row < NCTX;
            const float* src = (l == 0) ? (isctx ? pctx + (size_t)row * DM : px + (size_t)(row - NCTX) * DM) : XS + (size_t)row * DM;
            norm1_fetch(C, src, row, l > 0, mod + (size_t)((l > 0 ? l - 1 : 0) * 2 + (isctx ? 1 : 0)) * 6144 + 5 * DM, v[q]); }
#pragma unroll
        for (int q = 0; q < 2; ++q) if (rows[q] < ROWS) { const int row = rows[q]; const bool isctx = row < NCTX;
#pragma unroll
            for (int j = 0; j < 4; ++j) *((f32x4*)(XS + (size_t)row * DM) + C.lane + 64 * j) = v[q][j];
            const float rstd = row_rstd(v[q], C.lane);
            const float* md = mod + (size_t)(l * 2 + (isctx ? 1 : 0)) * 6144;
            u32x2* o = (u32x2*)(H + (size_t)row * DM) + C.lane;
#pragma unroll
            for (int j = 0; j < 4; ++j) { const f32x4 g = *((const f32x4*)g1 + C.lane + 64 * j), sh = *((const f32x4*)md + C.lane + 64 * j), sc = *((const f32x4*)(md + DM) + C.lane + 64 * j);
                const f32x4 y = v[q][j] * rstd * g * (sc + 1.0f) + sh; u32x2 w; w.x = pk2(y.x, y.y); w.y = pk2(y.z, y.w); o[64 * j] = w; } }
    }
}
__device__ __forceinline__ void phase_final(const Ctx& C, const DArgs& a) {
    const float* XS = (const float*)(C.ws + WS_XS); const float* mod = (const float*)(C.ws + WS_MOD); const float* g = a.in[I_FNG];
    const float* gt2 = mod + (size_t)((DEPTH - 1) * 2 + 0) * 6144 + 5 * DM;
    for (int row0 = NCTX + C.gw; row0 < ROWS; row0 += 2 * C.NGW) {
        f32x4 v[2][4]; const int rows[2] = {row0, row0 + C.NGW};
#pragma unroll
        for (int q = 0; q < 2; ++q) if (rows[q] < ROWS) norm1_fetch(C, XS + (size_t)rows[q] * DM, rows[q], true, gt2, v[q]);
#pragma unroll
        for (int q = 0; q < 2; ++q) if (rows[q] < ROWS) { const float rstd = row_rstd(v[q], C.lane); float* o = a.out + (size_t)(rows[q] - NCTX) * DM;
#pragma unroll
            for (int j = 0; j < 4; ++j) *((f32x4*)o + C.lane + 64 * j) = v[q][j] * rstd * *((const f32x4*)g + C.lane + 64 * j); }
    }
}
constexpr int NR2 = 9;
__device__ __forceinline__ void phase_norm2(const Ctx& C, const DArgs& a, int l) {
    const float* XS = (const float*)(C.ws + WS_XS); bf16* H = (bf16*)(C.ws + WS_H); const float* mod = (const float*)(C.ws + WS_MOD);
    const float* g2 = a.in[I_N2G] + (size_t)l * DM; const float* rb = a.in[I_RB] + (size_t)l * NEXP; const bf16* rwt = (const bf16*)(C.ws + WS_RWT) + (size_t)l * NEXP * DM;
    int* tok_e = (int*)(C.ws + WS_ROUTE); float* gate = (float*)(C.ws + WS_ROUTE) + (size_t)1 * ROWS * 4; int* slot = (int*)(C.ws + WS_ROUTE) + (size_t)2 * ROWS * 4;
    LAS float* lg = (LAS float*)(C.lds + C.wave * 4096);
    LAS int* hist = (LAS int*)(C.lds + MISC_OFF + 64);
    const int lane = C.lane, li = lane & 15, g = lane >> 4;
    if (C.tid < NEXP) hist[C.tid] = 0;
    __syncthreads();
    const int row_base = (l == DEPTH - 1) ? NCTX : 0, ntile = (ROWS - row_base + NR2 - 1) / NR2;
    for (int tl = C.gw; tl < ntile; tl += C.NGW) {
        const int trow0 = row_base + NR2 * tl, nrow = (ROWS - trow0 < NR2) ? ROWS - trow0 : NR2;
#pragma unroll 1
        for (int rr = 0; rr < nrow; ++rr) { const int row = trow0 + rr; const bool isctx = row < NCTX; f32x4 v[4]; load_row(XS + (size_t)row * DM, lane, v);
            const float rstd = row_rstd(v, lane);
            const float* md = mod + (size_t)(l * 2 + (isctx ? 1 : 0)) * 6144 + 3 * DM;
            u32x2* o = (u32x2*)(H + (size_t)row * DM) + lane;
#pragma unroll
            for (int j = 0; j < 4; ++j) { const f32x4 gg = *((const f32x4*)g2 + lane + 64 * j), sh = *((const f32x4*)md + lane + 64 * j), sc = *((const f32x4*)(md + DM) + lane + 64 * j);
                const f32x4 y = v[j] * rstd * gg * (sc + 1.0f) + sh; u32x2 w; w.x = pk2(y.x, y.y); w.y = pk2(y.z, y.w); o[64 * j] = w; } }
        asm volatile("s_waitcnt vmcnt(0)" ::: "memory");
        f32x4 acc0 = {0.f, 0.f, 0.f, 0.f}, acc1 = {0.f, 0.f, 0.f, 0.f};
        const int arow = (trow0 + li < ROWS) ? trow0 + li : ROWS - 1;
        const bf16* ap = H + (size_t)arow * DM + 8 * g; const bf16* bp0 = rwt + (size_t)li * DM + 8 * g; const bf16* bp1 = bp0 + 16 * DM;
#pragma unroll 4
        for (int ks = 0; ks < 32; ++ks) { const bf16x8 af = *(const bf16x8*)(ap + 32 * ks); acc0 = mfma16(af, *(const bf16x8*)(bp0 + 32 * ks), acc0); acc1 = mfma16(af, *(const bf16x8*)(bp1 + 32 * ks), acc1); }
#pragma unroll
        for (int r = 0; r < 4; ++r) { lg[(4 * g + r) * 33 + li] = acc0[r]; lg[(4 * g + r) * 33 + 16 + li] = acc1[r]; }
        LDS_WAIT(); asm volatile("" ::: "memory");
        const int e = lane & 31; const float rbe = rb[e];
#pragma unroll 1
        for (int rr = 0; rr < nrow; ++rr) { const int row = trow0 + rr;
            float val = lg[rr * 33 + e] + rbe; int te[4]; float tv[4];
#pragma unroll
            for (int k = 0; k < 4; ++k) { float bv = val; int bi = e;
#define AMAX_ROR(n) { const float ov = __builtin_bit_cast(float, __builtin_amdgcn_update_dpp(0, __builtin_bit_cast(int, bv), 0x120 + (n), 0xf, 0xf, false)); const int oi = __builtin_amdgcn_update_dpp(0, bi, 0x120 + (n), 0xf, 0xf, false); \
                    if (ov > bv || (ov == bv && oi < bi)) { bv = ov; bi = oi; } }
                AMAX_ROR(8) AMAX_ROR(4) AMAX_ROR(2) AMAX_ROR(1)
#undef AMAX_ROR
                { const float ov = shx(bv, 16, lane); const int oi = shxi(bi, 16, lane); if (ov > bv || (ov == bv && oi < bi)) { bv = ov; bi = oi; } }
                te[k] = bi; tv[k] = bv; if (e == bi) val = -3.0e38f; }
            if (lane == 0) { const float m = tv[0]; float p[4], ps = 0.f;
#pragma unroll
                for (int k = 0; k < 4; ++k) { p[k] = __expf(tv[k] - m); ps += p[k]; }
#pragma unroll
                for (int k = 0; k < 4; ++k) { tok_e[row * 4 + k] = te[k]; gate[row * 4 + k] = p[k] / ps; slot[row * 4 + k] = __hip_atomic_fetch_add(&hist[te[k]], 1, __ATOMIC_RELAXED, __HIP_MEMORY_SCOPE_WORKGROUP); } } }
        asm volatile("" ::: "memory");
    }
    __syncthreads();
    if (C.tid < NEXP) ((int*)(C.ws + WS_CNT))[C.wg * NEXP + C.tid] = hist[C.tid];
}
__device__ __forceinline__ int moe_tables(const Ctx& C) {
    const int* cnt = (const int*)(C.ws + WS_CNT);
    LAS int* part = (LAS int*)(C.lds);
    LAS int* pstart = (LAS int*)(C.lds + MISC_OFF + 256); LAS int* wgbase = pstart + 40; LAS int* tot = wgbase + 32; LAS int* nblk_s = tot + 32;
    LAS unsigned char* blk_e = (LAS unsigned char*)(C.lds + MISC_OFF + 1024);
    __syncthreads();
    { const int e = C.tid & 31, p = C.tid >> 5; int t = 0, pre = 0;
#pragma unroll 1
      for (int w = p * 16; w < p * 16 + 16; ++w) { const int c = cnt[w * NEXP + e]; t += c; if (w < C.wg) pre += c; }
      part[(p * 32 + e) * 2] = t; part[(p * 32 + e) * 2 + 1] = pre; }
    __syncthreads();
    if (C.tid < NEXP) { int t = 0, pre = 0;
#pragma unroll 1
        for (int p = 0; p < 16; ++p) { t += part[(p * 32 + C.tid) * 2]; pre += part[(p * 32 + C.tid) * 2 + 1]; }
        tot[C.tid] = t; wgbase[C.tid] = pre; }
    __syncthreads();
    if (C.tid == 0) { int b = 0;
#pragma unroll 1
        for (int e = 0; e < NEXP; ++e) { pstart[e] = b * 256; b += (tot[e] + 255) >> 8; }
        pstart[NEXP] = b * 256; nblk_s[0] = b; }
    __syncthreads();
    if (C.tid < NEXP) wgbase[C.tid] += pstart[C.tid];
    if (C.tid < MOE_MAXBLK) { int e = 0;
#pragma unroll 1
        for (int k = 1; k < NEXP; ++k) if (pstart[k] <= C.tid * 256) e = k;
        blk_e[C.tid] = (unsigned char)e; }
    __syncthreads();
    return __builtin_amdgcn_readfirstlane(nblk_s[0]);
}
__device__ __forceinline__ void phase_gather(const Ctx& C, const DArgs& a, int l) {
    moe_tables(C);
    const LAS int* wgbase = (const LAS int*)(C.lds + MISC_OFF + 256) + 40;
    const int* tok_e = (const int*)(C.ws + WS_ROUTE); const int* slot = (const int*)(C.ws + WS_ROUTE) + (size_t)2 * ROWS * 4; int* dest = (int*)(C.ws + WS_ROUTE) + (size_t)3 * ROWS * 4;
    const bf16* H = (const bf16*)(C.ws + WS_H); unsigned char* XG = C.ws + WS_XG8;
    const int row_base = (l == DEPTH - 1) ? NCTX : 0, ntile = (ROWS - row_base + NR2 - 1) / NR2;
    for (int tl = C.gw; tl < ntile; tl += C.NGW)
    for (int row = row_base + NR2 * tl; row < row_base + NR2 * tl + NR2 && row < ROWS; ++row) {
        const u32x4* src = (const u32x4*)(H + (size_t)row * DM) + C.lane; const u32x4 v0 = src[0], v1 = src[64];
        u32x2 q0, q1;
        { unsigned w = 0; w = __builtin_amdgcn_cvt_pk_fp8_f32(bflo(v0.x) * pg8::X8_S, bfhi(v0.x) * pg8::X8_S, w, false); w = __builtin_amdgcn_cvt_pk_fp8_f32(bflo(v0.y) * pg8::X8_S, bfhi(v0.y) * pg8::X8_S, w, true); q0.x = w;
          w = 0; w = __builtin_amdgcn_cvt_pk_fp8_f32(bflo(v0.z) * pg8::X8_S, bfhi(v0.z) * pg8::X8_S, w, false); w = __builtin_amdgcn_cvt_pk_fp8_f32(bflo(v0.w) * pg8::X8_S, bfhi(v0.w) * pg8::X8_S, w, true); q0.y = w;
          w = 0; w = __builtin_amdgcn_cvt_pk_fp8_f32(bflo(v1.x) * pg8::X8_S, bfhi(v1.x) * pg8::X8_S, w, false); w = __builtin_amdgcn_cvt_pk_fp8_f32(bflo(v1.y) * pg8::X8_S, bfhi(v1.y) * pg8::X8_S, w, true); q1.x = w;
          w = 0; w = __builtin_amdgcn_cvt_pk_fp8_f32(bflo(v1.z) * pg8::X8_S, bfhi(v1.z) * pg8::X8_S, w, false); w = __builtin_amdgcn_cvt_pk_fp8_f32(bflo(v1.w) * pg8::X8_S, bfhi(v1.w) * pg8::X8_S, w, true); q1.y = w; }
#pragma unroll
        for (int k = 0; k < 4; ++k) { const int d = wgbase[tok_e[row * 4 + k]] + slot[row * 4 + k]; if (C.lane == 0) dest[row * 4 + k] = d;
            u32x2* dp = (u32x2*)(XG + (size_t)d * DM) + C.lane; dp[0] = q0; dp[64] = q1; }
    }
}

__device__ __forceinline__ void mix1_rope(const Ctx& C) {
    bf16* P = (bf16*)(C.ws + WS_P);
    const long total = (long)SEQ * 192;
    for (long i = (long)C.wg * NTHR + C.tid; i < total; i += (long)C.G * NTHR) {
        const int j = (int)(i & 31), hh = (int)((i >> 5) % 6), t = (int)(i / 192);
        const int col = (hh < 4) ? (C_AQ + hh * 64) : (C_AK + (hh - 4) * 64);
        const float pos = (j < 16) ? (float)(t >> 6) : (float)(t & 63);
        const float inv = __powf(10000.0f, -(float)(j & 15) * (1.0f / 16.0f));
        const float ang = pos * inv * 0.31830988618379067f;
        const float cs = cospif(ang), sn = sinpif(ang);
        bf16* p = P + (size_t)(NCTX + t) * INWP + col;
        const float x1 = bf2f(p[j]), x2 = bf2f(p[j + 32]);
        p[j] = (bf16)f2bf(x1 * cs - x2 * sn); p[j + 32] = (bf16)f2bf(x2 * cs + x1 * sn);
    }
}
__device__ __forceinline__ void mix1_vt(const Ctx& C) {
    const bf16* P = (const bf16*)(C.ws + WS_P);
    LAS unsigned short* scr = (LAS unsigned short*)(C.lds + C.wave * 16384);
    for (int u = C.gw; u < (ROWS / 64) * 6; u += C.NGW) {
        const int hd = u % 6, tb = u / 6; const int vcol = (hd < 2) ? (C_AV + hd * 64) : (C_CV + (hd - 2) * 64);
        bf16* VT = ((hd < 2) ? (bf16*)(C.ws + WS_VTA) + (size_t)hd * 64 * VTP : (bf16*)(C.ws + WS_VTC) + (size_t)(hd - 2) * 64 * VTP);
#pragma unroll
        for (int i = 0; i < 8; ++i) { const int tk = (C.lane >> 3) + 8 * i, ch = C.lane & 7; const u32x4 w = *(const u32x4*)(P + (size_t)(tb * 64 + tk) * INWP + vcol + 8 * ch);
            LAS unsigned* d = (LAS unsigned*)(scr + tk * 66 + 8 * ch); d[0] = w.x; d[1] = w.y; d[2] = w.z; d[3] = w.w; }
        LDS_WAIT(); asm volatile("" ::: "memory");
#pragma unroll
        for (int k8 = 0; k8 < 8; ++k8) { unsigned w[4];
#pragma unroll
            for (int e2 = 0; e2 < 4; ++e2) { const unsigned lo = scr[(8 * k8 + 2 * e2) * 66 + C.lane], hi = scr[(8 * k8 + 2 * e2 + 1) * 66 + C.lane]; w[e2] = lo | (hi << 16); }
            *(u32x4*)(VT + (size_t)C.lane * VTP + tb * 64 + 8 * k8) = (u32x4){w[0], w[1], w[2], w[3]}; }
        LDS_WAIT(); asm volatile("" ::: "memory");
    }
    for (int i = C.wg * NTHR + C.tid; i < 6 * 64 * 32; i += C.G * NTHR) { const int rowi = i >> 5, pc = i & 31; const int hd = rowi >> 6, d = rowi & 63;
        bf16* VT = ((hd < 2) ? (bf16*)(C.ws + WS_VTA) + (size_t)hd * 64 * VTP : (bf16*)(C.ws + WS_VTC) + (size_t)(hd - 2) * 64 * VTP);
        *(u32x4*)(VT + (size_t)d * VTP + ROWS + 8 * pc) = (u32x4){0u, 0u, 0u, 0u}; }
}
__device__ __forceinline__ float conv3(const bf16* P, int row, int col, const float* cw, int cc) {
    const bool first = (row == 0) || (row == NCTX), last = (row == NCTX - 1) || (row == ROWS - 1);
    float s = cw[768 + cc] * bf2f(P[(size_t)row * INWP + col]);
    if (!first) s += cw[cc] * bf2f(P[(size_t)(row - 1) * INWP + col]);
    if (!last) s += cw[2 * 768 + cc] * bf2f(P[(size_t)(row + 1) * INWP + col]);
    return s;
}
__device__ __forceinline__ void mix1_rwkv_prep(const Ctx& C, const DArgs& a, int l) {
    const bf16* P = (const bf16*)(C.ws + WS_P); float* SC = (float*)(C.ws + WS_SC);
    constexpr int LBP = 264;
    LAS unsigned char* lob = C.lds;
    LAS float* pre = (LAS float*)(C.lds + 16384);
    const bf16* lorat = (const bf16*)(C.ws + WS_LORAT) + (size_t)l * 4 * 256 * 64;
    const float* cw = a.in[I_DCONV] + (size_t)l * 3 * 768;
    const float* w0 = a.in[I_DW0] + (size_t)l * 512; const float* a0 = a.in[I_DA0] + (size_t)l * 512;
    const float* kkw = a.in[I_DKK] + (size_t)l * 256; const float* kaw = a.in[I_DKA] + (size_t)l * 256;
    const int half = C.tid >> 8, c = C.tid & 255, lane = C.lane, li = lane & 15, g = lane >> 4;
    const float kkc = kkw[c], kac = kaw[c];
    for (int grp = C.wg; grp < ROWS / 13; grp += C.G) {
        const int row0 = 13 * grp + 7 * half, nj = 7 - half;
        __syncthreads();
#pragma unroll
        for (int j = 0; j < 7; ++j) if (j < nj) { const float x = bf2f(P[(size_t)(row0 + j) * INWP + C_WL + c]); *(LAS bf16*)(lob + ((7 * half + j) * LBP + c) * 2) = (bf16)f2bf((c < 128) ? tanhf(x) : x); }
        __syncthreads();
#pragma unroll
        for (int q = 0; q < 4; ++q) { const bf16x8 a0f = ldA(lob, LBP, 0, 64 * q, li, g), a1f = ldA(lob, LBP, 0, 64 * q + 32, li, g);
#pragma unroll
            for (int c2 = 0; c2 < 2; ++c2) { const int ci = 2 * C.wave + c2; const bf16* bp = lorat + ((size_t)q * 256 + 16 * ci + li) * 64 + 8 * g;
                f32x4 acc = {0.f, 0.f, 0.f, 0.f}; acc = mfma16(a0f, ldg8(bp), acc); acc = mfma16(a1f, ldg8(bp + 32), acc);
#pragma unroll
                for (int r = 0; r < 4; ++r) pre[(q * 16 + 4 * g + r) * 256 + 16 * ci + li] = acc[r]; } }
        __syncthreads();
        float xr[9], xk[9], xv[9];
#pragma unroll
        for (int q = 0; q < 9; ++q) { const int rw = row0 - 1 + q; const bool in = (rw >= 0) && (rw < ROWS) && (q <= nj + 1);
            const bf16* pp = P + (size_t)(in ? rw : row0) * INWP; xr[q] = in ? bf2f(pp[C_DR + c]) : 0.f; xk[q] = in ? bf2f(pp[C_DK + c]) : 0.f; xv[q] = in ? bf2f(pp[C_DV + c]) : 0.f; }
        const float cr0 = cw[c], cr1 = cw[768 + c], cr2 = cw[1536 + c], ck0 = cw[256 + c], ck1 = cw[768 + 256 + c], ck2 = cw[1536 + 256 + c], cv0 = cw[512 + c], cv1 = cw[768 + 512 + c], cv2 = cw[1536 + 512 + c];
#pragma unroll
        for (int j = 0; j < 7; ++j) if (j < nj) { const int row = row0 + j, rl = 7 * half + j;
            const bool first = (row == 0) || (row == NCTX), last = (row == NCTX - 1) || (row == ROWS - 1);
            const float m0 = first ? 0.f : 1.f, m2 = last ? 0.f : 1.f;
            const float r = cr1 * xr[j + 1] + m0 * cr0 * xr[j] + m2 * cr2 * xr[j + 2], k = ck1 * xk[j + 1] + m0 * ck0 * xk[j] + m2 * ck2 * xk[j + 2], v = cv1 * xv[j + 1] + m0 * cv0 * xv[j] + m2 * cv2 * xv[j + 2];
            float kk = k * kkc; const float n2 = wave_sum(kk * kk, lane); kk *= rsqrtf(fmaxf(n2, 1e-24f));
            float* sc = SC + (size_t)row * 9 * 256; sc[c] = r; sc[256 + c] = v; sc[512 + c] = -kk;
#pragma unroll
            for (int d = 0; d < 2; ++d) { const float wp = w0[d * 256 + c] + pre[(d * 16 + rl) * 256 + c], ap = a0[d * 256 + c] + pre[((2 + d) * 16 + rl) * 256 + c];
                const float nw = -wp, sp = fmaxf(nw, 0.f) + log1pf(__expf(-fabsf(nw)));
                const float lw = -__expf(-sp - 0.5f);
                const float as = sigmoidf_(ap);
                sc[(3 + 3 * d) * 256 + c] = lw; sc[(4 + 3 * d) * 256 + c] = k * (1.0f + (as - 1.0f) * kac); sc[(5 + 3 * d) * 256 + c] = kk * as; } }
    }
    __syncthreads();
}
constexpr int FP = 136;
constexpr int F_TABC = 0, F_TABS = 128 * FP * 2, F_TILE = 2 * 128 * FP * 2;
__device__ __forceinline__ void fourier_load_tables(const Ctx& C) {
    const bf16* ft = (const bf16*)(C.ws + WS_FTAB);
    for (int i = C.tid; i < 2 * 128 * 16; i += NTHR) { const int tb = i >> 11, r = (i >> 4) & 127, c8 = i & 15;
        *(LAS u32x4*)(C.lds + tb * F_TABS + (r * FP + 8 * c8) * 2) = *(const u32x4*)(ft + tb * 16384 + r * 128 + 8 * c8); }
}
__device__ __forceinline__ void mix1_fourier1(const Ctx& C) {
    const bf16* P = (const bf16*)(C.ws + WS_P); const float* tw = (const float*)(C.ws + WS_TW);
    bf16* FYR = (bf16*)(C.ws + WS_FYR); bf16* FYI = (bf16*)(C.ws + WS_FYI);
    const int lane = C.lane, li = lane & 15, g = lane >> 4, w = C.wave;
    __syncthreads();
    fourier_load_tables(C);
    for (int u = C.wg; u < 256; u += C.G) {
        const int t2 = u >> 1, ch0 = (u & 1) * 128;
        __syncthreads();
        for (int i = C.tid; i < 128 * 16; i += NTHR) { const int t1 = i >> 4, c8 = i & 15;
            *(LAS u32x4*)(C.lds + F_TILE + (t1 * FP + 8 * c8) * 2) = *(const u32x4*)(P + (size_t)(NCTX + 128 * t1 + t2) * INWP + C_BU + ch0 + 8 * c8); }
        __syncthreads();
        bf16x8 af[4];
#pragma unroll
        for (int ks = 0; ks < 4; ++ks) af[ks] = ldT(C.lds + F_TILE, FP, 32 * ks, 16 * w, li, g);
#pragma unroll 1
        for (int ni = 0; ni < 8; ++ni) { f32x4 dc = {0.f, 0.f, 0.f, 0.f}, ds = {0.f, 0.f, 0.f, 0.f};
#pragma unroll
            for (int ks = 0; ks < 4; ++ks) { dc = mfma16(af[ks], ldA(C.lds + F_TABC, FP, 16 * ni, 32 * ks, li, g), dc); ds = mfma16(af[ks], ldA(C.lds + F_TABS, FP, 16 * ni, 32 * ks, li, g), ds); }
            const int k1 = 16 * ni + li; const float cp = tw[t2 * k1], sp = tw[16384 + t2 * k1];
            const f32x4 yr = dc * cp - ds * sp, yi = -(ds * cp) - dc * sp;
            const size_t o = ((size_t)k1 * 128 + t2) * 256 + ch0 + 16 * w + 4 * g;
            u32x2 wr; wr.x = pk2(yr[0], yr[1]); wr.y = pk2(yr[2], yr[3]); *(u32x2*)(FYR + o) = wr;
            u32x2 wi; wi.x = pk2(yi[0], yi[1]); wi.y = pk2(yi[2], yi[3]); *(u32x2*)(FYI + o) = wi; }
    }
    __syncthreads();
}
__device__ __forceinline__ void fourier2_mfma(const Ctx& C, int l, int wg0) {
    const bf16* FYR = (const bf16*)(C.ws + WS_FYR); const bf16* FYI = (const bf16*)(C.ws + WS_FYI); bf16* MIX = (bf16*)(C.ws + WS_MIX);
    const int lane = C.lane, li = lane & 15, g = lane >> 4, w = C.wave;
    constexpr int YP = 72, F_YR = F_TILE, F_YI = F_TILE + 128 * YP * 2;
    __syncthreads();
    fourier_load_tables(C);
    for (int u = C.wg - wg0; u < 512; u += C.G - wg0) {
        const int k1 = u >> 2, gq = u & 3;
        __syncthreads();
        for (int i = C.tid; i < 2 * 128 * 8; i += NTHR) { const int im = i >> 10, t2 = (i >> 3) & 127, c8 = i & 7;
            *(LAS u32x4*)(C.lds + (im ? F_YI : F_YR) + (t2 * YP + 8 * c8) * 2) = *(const u32x4*)((im ? FYI : FYR) + ((size_t)k1 * 128 + t2) * 256 + gq * 64 + 8 * c8); }
        __syncthreads();
        bf16x8 bc[4], bs[4];
#pragma unroll
        for (int ks = 0; ks < 4; ++ks) { bc[ks] = ldA(C.lds + F_TABC, FP, 16 * w, 32 * ks, li, g); bs[ks] = ldA(C.lds + F_TABS, FP, 16 * w, 32 * ks, li, g); }
        f32x4 xr[4], xi[4];
#pragma unroll
        for (int ci = 0; ci < 4; ++ci) { xr[ci] = (f32x4){0.f, 0.f, 0.f, 0.f}; f32x4 xs = {0.f, 0.f, 0.f, 0.f}; xi[ci] = xs;
#pragma unroll
            for (int ks = 0; ks < 4; ++ks) { const bf16x8 ar = ldT(C.lds + F_YR, YP, 32 * ks, 16 * ci, li, g), ai = ldT(C.lds + F_YI, YP, 32 * ks, 16 * ci, li, g);
                xr[ci] = mfma16(ar, bc[ks], xr[ci]); xr[ci] = mfma16(ai, bs[ks], xr[ci]);
                xi[ci] = mfma16(ai, bc[ks], xi[ci]); xs = mfma16(ar, bs[ks], xs); }
            xi[ci] = xi[ci] - xs; }
        union { bf16x8 v; unsigned q[4]; } xb[4];
#pragma unroll
        for (int q2 = 0; q2 < 2; ++q2) { xb[q2].q[0] = pk2(xr[2 * q2][0], xr[2 * q2][1]); xb[q2].q[1] = pk2(xr[2 * q2][2], xr[2 * q2][3]); xb[q2].q[2] = pk2(xr[2 * q2 + 1][0], xr[2 * q2 + 1][1]); xb[q2].q[3] = pk2(xr[2 * q2 + 1][2], xr[2 * q2 + 1][3]);
            xb[2 + q2].q[0] = pk2(xi[2 * q2][0], xi[2 * q2][1]); xb[2 + q2].q[1] = pk2(xi[2 * q2][2], xi[2 * q2][3]); xb[2 + q2].q[2] = pk2(xi[2 * q2 + 1][0], xi[2 * q2 + 1][1]); xb[2 + q2].q[3] = pk2(xi[2 * q2 + 1][2], xi[2 * q2 + 1][3]); }
        const bf16x8* mf = (const bf16x8*)((const bf16*)(C.ws + WS_FTAB) + 32768) + (size_t)(l * 4 + gq) * 16 * 64;
#pragma unroll
        for (int ei = 0; ei < 4; ++ei) { f32x4 o = {0.f, 0.f, 0.f, 0.f};
#pragma unroll
            for (int ks2 = 0; ks2 < 4; ++ks2) o = mfma16(mf[(ei * 4 + ks2) * 64 + lane], xb[ks2].v, o);
            const int tp = k1 + 128 * (16 * w + li);
            u32x2 wo; wo.x = pk2(o[0], o[1]); wo.y = pk2(o[2], o[3]); *(u32x2*)(MIX + (size_t)(NCTX + tp) * DM + 256 + gq * 64 + 16 * ei + 4 * g) = wo; }
    }
    __syncthreads();
}

constexpr float LOG2E = 1.4426950408889634f;
typedef short bf16x4 __attribute__((ext_vector_type(4)));
__device__ __forceinline__ void attn_load(const bf16* P, const bf16* VT, int krow, int kcol, int li, int g, bf16x8 (&kf)[2][2], bf16x8 (&vf)[4]) {
#pragma unroll
    for (int t = 0; t < 2; ++t)
#pragma unroll
        for (int ks = 0; ks < 2; ++ks) kf[t][ks] = ldg8(P + (size_t)(krow + 16 * t + li) * INWP + kcol + 32 * ks + 8 * g);
#pragma unroll
    for (int dt = 0; dt < 4; ++dt) { const bf16* vp = VT + (size_t)(dt * 16 + li) * VTP + krow + 4 * g;
        const bf16x4 a = *(const bf16x4*)vp, b = *(const bf16x4*)(vp + 16); vf[dt] = (bf16x8){a[0], a[1], a[2], a[3], b[0], b[1], b[2], b[3]}; }
}
template <int NS, int NT>
__device__ __forceinline__ void attn_compute(const bf16x8 (&kf)[2][2], const bf16x8 (&vf)[4], const bf16x8 (&qf)[NS][2], f32x4 (&o)[NS][4], float (&m)[NS], float (&ls)[NS],
                                             const float (&add)[NT][2][4], int li, int g) {
#pragma unroll
    for (int hh = 0; hh < NS; ++hh) {
        f32x4 st[2];
#pragma unroll
        for (int t = 0; t < 2; ++t) { st[t] = (f32x4){0.f, 0.f, 0.f, 0.f};
#pragma unroll
            for (int ks = 0; ks < 2; ++ks) st[t] = __builtin_amdgcn_mfma_f32_16x16x32_bf16(kf[t][ks], qf[hh][ks], st[t], 0, 0, 0); }
        float s[8]; float bm = -INFINITY;
#pragma unroll
        for (int t = 0; t < 2; ++t)
#pragma unroll
            for (int r = 0; r < 4; ++r) { const float ad = add[hh / (NS / NT)][t][r]; s[4 * t + r] = (ad == -INFINITY) ? -INFINITY : st[t][r] * (0.125f * LOG2E) + ad; bm = fmaxf(bm, s[4 * t + r]); }
        bm = fmaxf(bm, shx(bm, 16, 16 * g + li)); bm = fmaxf(bm, shx(bm, 32, 16 * g + li));
        const float mn = fmaxf(m[hh], bm), corr = __builtin_amdgcn_exp2f(m[hh] - mn); m[hh] = mn;
        float ps = 0.f; float pe[8];
#pragma unroll
        for (int e = 0; e < 8; ++e) { pe[e] = __builtin_amdgcn_exp2f(s[e] - mn); ps += pe[e]; }
        ls[hh] = ls[hh] * corr + ps;
        union { bf16x8 v; unsigned u[4]; } pf;
#pragma unroll
        for (int e2 = 0; e2 < 4; ++e2) pf.u[e2] = pk2(pe[2 * e2], pe[2 * e2 + 1]);
#pragma unroll
        for (int dt = 0; dt < 4; ++dt) { o[hh][dt] = o[hh][dt] * corr; o[hh][dt] = __builtin_amdgcn_mfma_f32_16x16x32_bf16(vf[dt], pf.v, o[hh][dt], 0, 0, 0); }
    }
}
__device__ __forceinline__ void attn_finish1(bf16* MIX, int qrow0, int ocol, f32x4 (&o)[4], float m, float ls, bool has_sink, float sink2, int li, int g) {
    float l = ls; l += shx(l, 16, 16 * g + li); l += shx(l, 32, 16 * g + li);
    float corr = 1.f;
    if (has_sink) { const float mn = fmaxf(m, sink2); corr = __builtin_amdgcn_exp2f(m - mn); l = l * corr + __builtin_amdgcn_exp2f(sink2 - mn); }
    const float inv = corr / l;
#pragma unroll
    for (int dt = 0; dt < 4; ++dt) { const f32x4 v = o[dt] * inv; u32x2 w; w.x = pk2(v[0], v[1]); w.y = pk2(v[2], v[3]);
        *(u32x2*)(MIX + (size_t)(qrow0 + li) * DM + ocol + dt * 16 + 4 * g) = w; }
}
__device__ __forceinline__ void attnA_unit(const Ctx& C, const float* asink_l, int unit, bool lat) {
    const bf16* P = (const bf16*)(C.ws + WS_P); bf16* MIX = (bf16*)(C.ws + WS_MIX);
    const int li = C.lane & 15, g = C.lane >> 4;
    const int nqp = lat ? SEQ / 32 : NCTX / 32, kvh = unit / nqp, qp = unit % nqp, t0 = qp * 32, qrow0 = (lat ? NCTX : 0) + t0;
    const bf16* VT = (const bf16*)(C.ws + WS_VTA) + (size_t)kvh * 64 * VTP; const int kcol = C_AK + kvh * 64;
    bf16x8 qf[4][2];
#pragma unroll
    for (int s = 0; s < 4; ++s)
#pragma unroll
        for (int ks = 0; ks < 2; ++ks) qf[s][ks] = ldg8(P + (size_t)(qrow0 + 16 * (s >> 1) + li) * INWP + C_AQ + (kvh * 2 + (s & 1)) * 64 + 32 * ks + 8 * g);
    f32x4 o[4][4]; float m[4], ls[4];
#pragma unroll
    for (int s = 0; s < 4; ++s) { m[s] = -1.0e30f; ls[s] = 0.f;
#pragma unroll
        for (int dt = 0; dt < 4; ++dt) o[s][dt] = (f32x4){0.f, 0.f, 0.f, 0.f}; }
    const int b_lo = lat ? 0 : 9;
#pragma unroll 1
    for (int bb = b_lo; bb < 17; ++bb) { float add[2][2][4]; bf16x8 kf[2][2], vf[4];
        const int krow = (bb < 9) ? NCTX + t0 - 128 + 32 * bb : 32 * (bb - 9);
        attn_load(P, VT, krow, kcol, li, g, kf, vf);
#pragma unroll
        for (int tl = 0; tl < 2; ++tl)
#pragma unroll
            for (int tt = 0; tt < 2; ++tt)
#pragma unroll
                for (int r = 0; r < 4; ++r) { const int j = t0 - 128 + 32 * bb + 16 * tt + 4 * g + r, t = t0 + 16 * tl + li;
                    const bool ok = (bb >= 9) || ((j >= 0) && (j < SEQ) && (j - t <= 128) && (t - j <= 128)); add[tl][tt][r] = ok ? 0.f : -INFINITY; }
        attn_compute<4, 2>(kf, vf, qf, o, m, ls, add, li, g); }
#pragma unroll
    for (int s = 0; s < 4; ++s) attn_finish1(MIX, qrow0 + 16 * (s >> 1), (kvh * 2 + (s & 1)) * 64, o[s], m[s], ls[s], true, asink_l[kvh * 2 + (s & 1)] * LOG2E, li, g);
}
__device__ __forceinline__ void attnC_unit(const Ctx& C, const LAS float* relb, int h, int up, bool lat) {
    const bf16* P = (const bf16*)(C.ws + WS_P); bf16* MIX = (bf16*)(C.ws + WS_MIX);
    const int li = C.lane & 15, g = C.lane >> 4;
    const int rp = up >> 2, cj = up & 3;
    const int t0a = lat ? (2 * rp) * 64 + 16 * cj : 32 * up, tstep = lat ? 64 : 16, qbase = lat ? NCTX : 0;
    const bf16* VT = (const bf16*)(C.ws + WS_VTC) + (size_t)h * 64 * VTP; const int kcol = C_CK + h * 64;
    bf16x8 qf[2][2];
#pragma unroll
    for (int s = 0; s < 2; ++s)
#pragma unroll
        for (int ks = 0; ks < 2; ++ks) qf[s][ks] = ldg8(P + (size_t)(qbase + t0a + tstep * s + li) * INWP + C_CQ + h * 64 + 32 * ks + 8 * g);
    f32x4 o[2][4]; float m[2] = {-1.0e30f, -1.0e30f}, ls[2] = {0.f, 0.f};
#pragma unroll
    for (int s = 0; s < 2; ++s)
#pragma unroll
        for (int dt = 0; dt < 4; ++dt) o[s][dt] = (f32x4){0.f, 0.f, 0.f, 0.f};
    const int r = 2 * rp, cq = cj * 16 + li;
    int r0a = r - 4; r0a = r0a < 0 ? 0 : (r0a > 248 ? 248 : r0a); int r0b = r - 3; r0b = r0b < 0 ? 0 : (r0b > 248 ? 248 : r0b);
    int c0 = cq - 8; c0 = c0 < 0 ? 0 : (c0 > 48 ? 48 : c0);
    const int cw0 = (cj == 0) ? 0 : (cj == 1) ? 8 : (cj == 2) ? 24 : 32;
    const int b_lo = lat ? 0 : 9;
#pragma unroll 1
    for (int bb = b_lo; bb < 17; ++bb) { float add[2][2][4]; bf16x8 kf[2][2], vf[4];
        const int kr = r0a + bb;
        if (bb < 9 && kr >= r0b + 8) continue;
        const int krow = (bb < 9) ? NCTX + kr * 64 + cw0 : 32 * (bb - 9);
        attn_load(P, VT, krow, kcol, li, g, kf, vf);
#pragma unroll
        for (int tl = 0; tl < 2; ++tl) { const int r0t = tl ? r0b : r0a, rt = r + tl; const bool rowok = (bb >= 9) || (kr >= r0t && kr < r0t + 8);
            int bi = kr - rt + 7; bi = bi < 0 ? 0 : (bi > 14 ? 14 : bi); const LAS float* rbp = relb + bi * 31;
#pragma unroll
            for (int tt = 0; tt < 2; ++tt)
#pragma unroll
                for (int rr = 0; rr < 4; ++rr) { const int kc = cw0 + 16 * tt + 4 * g + rr; int ci = kc - cq + 15; ci = ci < 0 ? 0 : (ci > 30 ? 30 : ci); const float bv = rbp[ci];
                    add[tl][tt][rr] = (bb >= 9) ? 0.f : ((rowok && kc >= c0 && kc < c0 + 16) ? bv : -INFINITY); } }
        attn_compute<2, 2>(kf, vf, qf, o, m, ls, add, li, g); }
#pragma unroll
    for (int s = 0; s < 2; ++s) attn_finish1(MIX, qbase + t0a + tstep * s, 512 + h * 64, o[s], m[s], ls[s], false, 0.f, li, g);
}
__device__ __forceinline__ void fourier_ctx_mfma(const Ctx& C, int l, int wg0) {
    const bf16* P = (const bf16*)(C.ws + WS_P); bf16* MIX = (bf16*)(C.ws + WS_MIX); const bf16* f2 = (const bf16*)(C.ws + WS_F256);
    const int lane = C.lane, li = lane & 15, g = lane >> 4, w = C.wave;
    constexpr int UP = 72;
    for (int u = C.wg - wg0; u < 8; u += C.G - wg0) {
        const int tb = u >> 2, gq = u & 3;
        __syncthreads();
        for (int i = C.tid; i < 256 * 8; i += NTHR) { const int t = i >> 3, c8 = i & 7; *(LAS u32x4*)(C.lds + (t * UP + 8 * c8) * 2) = *(const u32x4*)(P + (size_t)t * INWP + C_BU + gq * 64 + 8 * c8); }
        __syncthreads();
        const int tp0 = 128 * tb + 16 * w;
        f32x4 xr[4], xi[4];
#pragma unroll
        for (int ci = 0; ci < 4; ++ci) { xr[ci] = (f32x4){0.f, 0.f, 0.f, 0.f}; xi[ci] = (f32x4){0.f, 0.f, 0.f, 0.f}; }
#pragma unroll 2
        for (int ks = 0; ks < 8; ++ks) { const bf16x8 bc = ldg8(f2 + (size_t)(tp0 + li) * 256 + 32 * ks + 8 * g), bs = ldg8(f2 + 65536 + (size_t)(tp0 + li) * 256 + 32 * ks + 8 * g);
#pragma unroll
            for (int ci = 0; ci < 4; ++ci) { const bf16x8 au = ldT(C.lds, UP, 32 * ks, 16 * ci, li, g); xr[ci] = mfma16(au, bc, xr[ci]); xi[ci] = mfma16(au, bs, xi[ci]); } }
        union { bf16x8 v; unsigned q[4]; } xb[4];
#pragma unroll
        for (int q2 = 0; q2 < 2; ++q2) { xb[q2].q[0] = pk2(xr[2 * q2][0], xr[2 * q2][1]); xb[q2].q[1] = pk2(xr[2 * q2][2], xr[2 * q2][3]); xb[q2].q[2] = pk2(xr[2 * q2 + 1][0], xr[2 * q2 + 1][1]); xb[q2].q[3] = pk2(xr[2 * q2 + 1][2], xr[2 * q2 + 1][3]);
            xb[2 + q2].q[0] = pk2(-xi[2 * q2][0], -xi[2 * q2][1]); xb[2 + q2].q[1] = pk2(-xi[2 * q2][2], -xi[2 * q2][3]); xb[2 + q2].q[2] = pk2(-xi[2 * q2 + 1][0], -xi[2 * q2 + 1][1]); xb[2 + q2].q[3] = pk2(-xi[2 * q2 + 1][2], -xi[2 * q2 + 1][3]); }
        const bf16x8* mf = (const bf16x8*)((const bf16*)(C.ws + WS_FTAB) + 32768) + (size_t)(l * 4 + gq) * 16 * 64;
#pragma unroll
        for (int ei = 0; ei < 4; ++ei) { f32x4 o = {0.f, 0.f, 0.f, 0.f};
#pragma unroll
            for (int ks2 = 0; ks2 < 4; ++ks2) o = mfma16(mf[(ei * 4 + ks2) * 64 + lane], xb[ks2].v, o);
            o = o * 8.0f;
            u32x2 wo; wo.x = pk2(o[0], o[1]); wo.y = pk2(o[2], o[3]); *(u32x2*)(MIX + (size_t)(tp0 + li) * DM + 256 + gq * 64 + 16 * ei + 4 * g) = wo; }
    }
    __syncthreads();
}
__device__ __forceinline__ void fourier2_unit(const Ctx& C, int l, int u, bool ctx) {
    const bf16* P = (const bf16*)(C.ws + WS_P); const float* tw = (const float*)(C.ws + WS_TW); bf16* MIX = (bf16*)(C.ws + WS_MIX);
    const float* FYR = (const float*)(C.ws + WS_FYR); const float* FYI = (const float*)(C.ws + WS_FYI);
    const float* mt = (const float*)(C.ws + WS_MTAB) + (size_t)l * 2 * 4 * 4096;
    LAS float* xr = (LAS float*)(C.lds + 8192); LAS float* xi = xr + 512;
    const int tl = C.tid >> 8, ch = C.tid & 255, tp = 2 * u + tl;
    float sr = 0.f, si = 0.f;
    if (!ctx) { const int k1 = tp & 127, k2 = tp >> 7; const float* yr = FYR + (size_t)k1 * 128 * 256 + ch; const float* yi = FYI + (size_t)k1 * 128 * 256 + ch;
#pragma unroll 8
        for (int t2 = 0; t2 < 128; ++t2) { const int m = ((t2 * k2) & 127) * 128; const float c = tw[m], s = tw[16384 + m]; const float a = yr[t2 * 256], b = yi[t2 * 256]; sr += a * c + b * s; si += b * c - a * s; } }
    else {
#pragma unroll 8
        for (int t = 0; t < NCTX; ++t) { const int m = ((t * tp) & 255) * 64; const float x = bf2f(P[(size_t)t * INWP + C_BU + ch]); sr += x * tw[m]; si -= x * tw[16384 + m]; } }
    __syncthreads();
    xr[tl * 256 + ch] = sr; xi[tl * 256 + ch] = si;
    __syncthreads();
    const int g = ch >> 6, e = ch & 63; const float* mc = mt + (size_t)(0 * 4 + g) * 4096 + e; const float* ms = mt + (size_t)(1 * 4 + g) * 4096 + e;
    const LAS float* xrp = xr + tl * 256 + g * 64; const LAS float* xip = xi + tl * 256 + g * 64; float o = 0.f;
#pragma unroll 8
    for (int c = 0; c < 64; ++c) o += xrp[c] * mc[c * 64] + xip[c] * ms[c * 64];
    o *= ctx ? (1.0f / 128.0f) : (1.0f / 1024.0f);
    MIX[(size_t)((ctx ? 0 : NCTX) + tp) * DM + 256 + ch] = (bf16)f2bf(o);
}
__device__ __forceinline__ void rwkv_passB(const Ctx& C, int b);
__device__ __forceinline__ void phase_mix2(const Ctx& C, const DArgs& a, int l) {
    const bool emit_ctx = l < DEPTH - 1;
#ifndef REPMASK
#define REPMASK 0
#endif
#define NREP2(o) ((((REPMASK) >> (o)) & 1) ? 2 : 1)
    if (C.wg < 8) { for (int r2 = 0; r2 < NREP2(16); ++r2) rwkv_passB(C, C.wg); }
    else if (emit_ctx) fourier_ctx_mfma(C, l, 8);
    { const float* asink_l = a.in[I_ASINK] + l * 4; const float* crel = a.in[I_CREL] + (size_t)l * 4 * 465;
      LAS float* relb = (LAS float*)(C.lds + 110592 + C.wave * 2048);
      for (int r2 = 0; r2 < NREP2(17); ++r2) {
      unsigned* qhead = (unsigned*)(C.ws + WS_CTL) + CW_WQ + 64 * l + 16 * r2;
      const int nA = 2 * (SEQ / 32), nC = 4 * (SEQ / 32), nAc = emit_ctx ? 2 * (NCTX / 32) : 0, nCc = emit_ctx ? 4 * (NCTX / 32) : 0, nAll = nA + nAc + nC + nCc;
      int hcur = -1;
      const int nCv = emit_ctx ? CV_NCHUNK : 0;
      for (;;) { unsigned uq = 0; if (C.lane == 0) uq = __hip_atomic_fetch_add(qhead, 1u, __ATOMIC_RELAXED, __HIP_MEMORY_SCOPE_AGENT);
          const int uraw = __builtin_amdgcn_readfirstlane((int)uq); if (uraw >= nAll + nCv) break;
          int u;
          if (uraw < 2 * nCv) { if (uraw & 1) { const int ch = uraw >> 1; convert_moe_items(C, a, l + 1, ch * CV_CHUNK, ch * CV_CHUNK + CV_CHUNK); continue; } u = uraw >> 1; }
          else u = uraw - nCv;
          if (u < nA) attnA_unit(C, asink_l, u, true);
          else if (u < nA + nAc) attnA_unit(C, asink_l, u - nA, false);
          else { const int uc = u - nA - nAc; const bool lat = uc < nC; const int uu = lat ? uc : uc - nC, nqt = lat ? SEQ / 32 : NCTX / 32, h = uu / nqt, qt = uu % nqt;
              if (h != hcur) { for (int i = C.lane; i < 465; i += 64) relb[i] = crel[h * 465 + i] * LOG2E; hcur = h; LDS_WAIT(); asm volatile("" ::: "memory"); }
              attnC_unit(C, relb, h, qt, lat); } } } }
    __syncthreads();
    for (int r2 = 0; r2 < NREP2(19); ++r2) fourier2_mfma(C, l, 0);
}

constexpr int RW_C = 32, RW_NCH = ROWS / RW_C, RW_SC = 20, RW_NSC = RW_NCH / RW_SC;
constexpr int RW_SLOT = 5120, RW_REGION = 9 * RW_SLOT + 1024;
constexpr int TP = 72, HP = 40;
static_assert(3 * RW_REGION <= MISC_OFF, "RWKV D1 regions below the misc area");
__device__ __forceinline__ int rw_rc_of(int d, int c) { return d == 0 ? c : (c < 8 ? 7 - c : 527 - c); }
__device__ __forceinline__ int rw_row_of(int d, int rc, int t) { return 32 * rc + (d == 0 ? t : 31 - t); }

__device__ __forceinline__ void rwkv_d1(const Ctx& C, LAS unsigned char* rb, int d, int h, int rc) {
    int lane_ = C.lane; asm volatile("" : "+v"(lane_));
    const int lane = lane_, li = lane & 15, g = lane >> 4;
    const float* SC = (const float*)(C.ws + WS_SC);
    LAS unsigned char* S0 = rb; LAS unsigned char* S1 = rb + RW_SLOT; LAS unsigned char* S2 = rb + 2 * RW_SLOT; LAS unsigned char* S3 = rb + 3 * RW_SLOT; LAS unsigned char* S4 = rb + 4 * RW_SLOT;
    LAS unsigned char* S5 = rb + 5 * RW_SLOT; LAS unsigned char* S6 = rb + 6 * RW_SLOT; LAS unsigned char* S7 = rb + 7 * RW_SLOT; LAS unsigned char* S8 = rb + 8 * RW_SLOT;
    LAS unsigned char* S6b = S6 + 2560; LAS unsigned char* S7b = S7 + 2560;
    LAS float* gc = (LAS float*)(rb + 9 * RW_SLOT);
    { float cum = 0.f; const int j = lane; const int qw = (3 + 3 * d) * 256;
#pragma unroll 1
      for (int t0 = 0; t0 < 32; t0 += 4) { float rv[4], vv[4], av[4], lw[4], kd[4], bb[4];
#pragma unroll
          for (int u = 0; u < 4; ++u) { const float* sc = SC + (size_t)rw_row_of(d, rc, t0 + u) * 9 * 256 + h * 64 + j;
              rv[u] = sc[0]; vv[u] = sc[256]; av[u] = sc[512]; lw[u] = sc[qw]; kd[u] = sc[qw + 256]; bb[u] = sc[qw + 512]; }
#pragma unroll
          for (int u = 0; u < 4; ++u) { const float cp = cum; cum += lw[u]; const float Gt = __expf(cum), Gm = __expf(cp), iG = __expf(-cum); const int off = ((t0 + u) * TP + j) * 2;
              *(LAS bf16*)(S0 + off) = (bf16)f2bf(av[u] * Gm); *(LAS bf16*)(S1 + off) = (bf16)f2bf(rv[u] * Gt); *(LAS bf16*)(S2 + off) = (bf16)f2bf(bb[u] * iG);
              *(LAS bf16*)(S3 + off) = (bf16)f2bf(kd[u] * iG); *(LAS bf16*)(S4 + off) = (bf16)f2bf(vv[u]); } }
      gc[j] = __expf(cum); }
    const f32x4 z4 = {0.f, 0.f, 0.f, 0.f};
#pragma unroll 1
    for (int ti = 0; ti < 2; ++ti)
#pragma unroll 1
        for (int si = 0; si < 2; ++si) {
            f32x4 n = z4, nt = z4, mk = z4, qb = z4, qk = z4;
#pragma unroll
            for (int ks = 0; ks < 2; ++ks) { const bf16x8 at = ldA(S0, TP, 16 * ti, 32 * ks, li, g), rt = ldA(S1, TP, 16 * ti, 32 * ks, li, g), bs = ldA(S2, TP, 16 * si, 32 * ks, li, g), kss = ldA(S3, TP, 16 * si, 32 * ks, li, g);
                n = mfma16(at, bs, n);
                nt = mfma16(bs, at, nt);
                mk = mfma16(kss, at, mk);
                qb = mfma16(bs, rt, qb);
                qk = mfma16(kss, rt, qk); }
#pragma unroll
            for (int r = 0; r < 4; ++r) { const int trow = 16 * ti + 4 * g + r, scol = 16 * si + li; if (!(scol < trow)) n[r] = 0.f;
                const int srow = 16 * si + 4 * g + r, tcol = 16 * ti + li; if (!(srow < tcol)) { mk[r] = 0.f; nt[r] = 0.f; } if (!(srow <= tcol)) { qb[r] = 0.f; qk[r] = 0.f; } }
            *(LAS f32x4*)(S5 + ((16 * si + li) * 32 + 16 * ti + 4 * g) * 4) = n;
            stT(S6, HP, 16 * ti + li, 16 * si + 4 * g, mk);
            stT(S8, HP, 16 * ti + li, 16 * si + 4 * g, nt);
            stT(S6b, HP, 16 * ti + li, 16 * si + 4 * g, qb);
            stT(S7, HP, 16 * ti + li, 16 * si + 4 * g, qk); }
    { const int rr = lane & 31, bq = rr >> 4, lr = rr & 15; float Tr[16];
#pragma unroll
      for (int s = 15; s >= 0; --s) { float acc = (lr == s) ? 1.f : 0.f;
#pragma unroll
          for (int c4 = 0; c4 < 4; ++c4) { if (4 * c4 + 3 > s) { const f32x4 nv = *(const LAS f32x4*)(S5 + ((16 * bq + s) * 32 + 16 * bq + 4 * c4) * 4);
#pragma unroll
              for (int e = 0; e < 4; ++e) if (4 * c4 + e > s) acc += Tr[4 * c4 + e] * nv[e]; } }
          Tr[s] = acc; }
      if (lane < 32) { u32x4 w0, w1; w0.x = pk2(Tr[0], Tr[1]); w0.y = pk2(Tr[2], Tr[3]); w0.z = pk2(Tr[4], Tr[5]); w0.w = pk2(Tr[6], Tr[7]); w1.x = pk2(Tr[8], Tr[9]); w1.y = pk2(Tr[10], Tr[11]); w1.z = pk2(Tr[12], Tr[13]); w1.w = pk2(Tr[14], Tr[15]);
          const u32x4 zz = {0u, 0u, 0u, 0u}; LAS u32x4* trow = (LAS u32x4*)(S7b + rr * HP * 2);
          trow[0] = bq ? zz : w0; trow[1] = bq ? zz : w1; trow[2] = bq ? w0 : zz; trow[3] = bq ? w1 : zz; }
      f32x4 x = mfma16(ldA(S8, HP, 16, 0, li, g), ldT(S7b, HP, 0, 0, li, g), z4);
      LAS unsigned char* XT = S8 + 2560;
      *(LAS u32x2*)(XT + (li * HP + 4 * g) * 2) = (u32x2){0u, 0u}; stT(XT, HP, li, 16 + 4 * g, x);
      const f32x4 t21 = mfma16(ldA(S7b, HP, 16, 0, li, g), ldA(XT, HP, 0, 0, li, g), z4);
#pragma unroll
      for (int r = 0; r < 4; ++r) *(LAS bf16*)(S7b + ((16 + 4 * g + r) * HP + li) * 2) = (bf16)f2bf(t21[r]); }
#pragma unroll 1
    for (int ti = 0; ti < 2; ++ti) { const bf16x8 tf = ldA(S7b, HP, 16 * ti, 0, li, g), mf = ldA(S6, HP, 16 * ti, 0, li, g);
#pragma unroll
        for (int ji = 0; ji < 4; ++ji) { const f32x4 ap = mfma16(tf, ldT(S0, TP, 0, 16 * ji, li, g), z4); stT(S8, HP, 16 * ji + li, 16 * ti + 4 * g, ap);
            const f32x4 mv = mfma16(mf, ldT(S4, TP, 0, 16 * ji, li, g), z4); stT(S5, HP, 16 * ji + li, 16 * ti + 4 * g, mv); } }
#pragma unroll 1
    for (int ti = 0; ti < 2; ++ti) { const bf16x8 tf = ldA(S7b, HP, 16 * ti, 0, li, g);
#pragma unroll
        for (int vi = 0; vi < 4; ++vi) { const f32x4 ul = mfma16(tf, ldA(S5, HP, 16 * vi, 0, li, g), z4); stT(S0, HP, 16 * vi + li, 16 * ti + 4 * g, ul); } }
#pragma unroll 1
    for (int ti = 0; ti < 2; ++ti) { const bf16x8 qbf = ldA(S6b, HP, 16 * ti, 0, li, g), qkf = ldA(S7, HP, 16 * ti, 0, li, g);
#pragma unroll
        for (int ji = 0; ji < 4; ++ji) { f32x4 rp = mfma16(ldA(S8, HP, 16 * ji, 0, li, g), qbf, z4);
            LAS unsigned char* p = S1 + ((16 * ti + li) * TP + 16 * ji + 4 * g) * 2; rp = rp + ld4bf(p); u32x2 w; w.x = pk2(rp[0], rp[1]); w.y = pk2(rp[2], rp[3]); *(LAS u32x2*)p = w;
            f32x4 yl = mfma16(qbf, ldA(S0, HP, 16 * ji, 0, li, g), z4); yl = mfma16(qkf, ldT(S4, TP, 0, 16 * ji, li, g), yl);
            stT(S5, HP, 16 * ji + li, 16 * ti + 4 * g, yl); } }
#pragma unroll 1
    for (int ji = 0; ji < 4; ++ji) { const bf16x8 bt = ldT(S2, TP, 0, 16 * ji, li, g); const float gj = gc[16 * ji + li];
#pragma unroll
        for (int jp = 0; jp < 4; ++jp) { f32x4 pt = mfma16(ldA(S8, HP, 16 * jp, 0, li, g), bt, z4);
#pragma unroll
            for (int r = 0; r < 4; ++r) pt[r] = pt[r] * gj + ((16 * jp + 4 * g + r == 16 * ji + li) ? gj : 0.f);
            stT(S6, TP, 16 * ji + li, 16 * jp + 4 * g, pt); } }
#pragma unroll 1
    for (int vh = 0; vh < 2; ++vh) { f32x4 lt[4][2];
#pragma unroll
      for (int ji = 0; ji < 4; ++ji) { const bf16x8 ba = ldT(S2, TP, 0, 16 * ji, li, g), ka = ldT(S3, TP, 0, 16 * ji, li, g); const f32x4 gv = *(const LAS f32x4*)(gc + 16 * ji + 4 * g);
#pragma unroll
          for (int v2 = 0; v2 < 2; ++v2) { const int vi = 2 * vh + v2; f32x4 x = mfma16(ba, ldA(S0, HP, 16 * vi, 0, li, g), z4); x = mfma16(ka, ldT(S4, TP, 0, 16 * vi, li, g), x); lt[ji][v2] = x * gv; } }
      asm volatile("s_waitcnt lgkmcnt(0)" ::: "memory");
      LAS unsigned char* dst = vh ? S2 : S8;
#pragma unroll
      for (int ji = 0; ji < 4; ++ji)
#pragma unroll
          for (int v2 = 0; v2 < 2; ++v2) stT(dst, TP, 16 * v2 + li, 16 * ji + 4 * g, lt[ji][v2]); }
}
__device__ __forceinline__ void rwkv_passA_step(const Ctx& C, const LAS unsigned char* rb, f32x4 (&hs)[4], int d, int h, int rc) {
    int lane_ = C.lane; asm volatile("" : "+v"(lane_));
    const int lane = lane_, li = lane & 15, g = lane >> 4; const bool isPhi = C.wave >= 4; const int col = 16 * (C.wave & 3) + li;
    const LAS unsigned char* S1 = rb + RW_SLOT; const LAS unsigned char* S2 = rb + 2 * RW_SLOT; const LAS unsigned char* S5 = rb + 5 * RW_SLOT; const LAS unsigned char* S6 = rb + 6 * RW_SLOT;
    const LAS unsigned char* LTb = (col < 32) ? rb + 8 * RW_SLOT + col * TP * 2 : S2 + (col - 32) * TP * 2;
    union { bf16x8 v; unsigned u[4]; } bf[2];
#pragma unroll
    for (int ks = 0; ks < 2; ++ks) { bf[ks].u[0] = pk2(hs[2 * ks][0], hs[2 * ks][1]); bf[ks].u[1] = pk2(hs[2 * ks][2], hs[2 * ks][3]); bf[ks].u[2] = pk2(hs[2 * ks + 1][0], hs[2 * ks + 1][1]); bf[ks].u[3] = pk2(hs[2 * ks + 1][2], hs[2 * ks + 1][3]); }
#pragma unroll
    for (int ti = 0; ti < 2; ++ti) { f32x4 acc = isPhi ? (f32x4){0.f, 0.f, 0.f, 0.f} : ld4bf(S5 + (col * HP + 16 * ti + 4 * g) * 2);
#pragma unroll
        for (int ks = 0; ks < 2; ++ks) acc = mfma16(ldAperm(S1, TP, 16 * ti, ks, li, g), bf[ks].v, acc);
        if (!isPhi) { float* ys = (float*)(C.ws + WS_YS) + (size_t)d * ROWS * 256 + h * 64 + col;
#pragma unroll
            for (int r = 0; r < 4; ++r) ys[(size_t)rw_row_of(d, rc, 16 * ti + 4 * g + r) * 256] = acc[r]; }
        else { bf16* rp = (bf16*)(C.ws + WS_RPP) + ((size_t)((d * 4 + h) * RW_NCH + rc) * 32) * 64 + col;
#pragma unroll
            for (int r = 0; r < 4; ++r) rp[(16 * ti + 4 * g + r) * 64] = (bf16)f2bf(acc[r]); } }
    f32x4 hn[4];
#pragma unroll
    for (int i = 0; i < 4; ++i) { f32x4 acc = isPhi ? (f32x4){0.f, 0.f, 0.f, 0.f} : ld4bf(LTb + (16 * i + 4 * g) * 2);
#pragma unroll
        for (int ks = 0; ks < 2; ++ks) acc = mfma16(ldAperm(S6, TP, 16 * i, ks, li, g), bf[ks].v, acc);
        hn[i] = acc; }
#pragma unroll
    for (int i = 0; i < 4; ++i) hs[i] = hn[i];
}
__device__ __forceinline__ void phase_rwkv1(const Ctx& C) {
    const int lane = C.lane, li = lane & 15, g = lane >> 4;
    for (int u = C.wg; u < 8 * RW_NSC; u += C.G) {
        const int s = u % RW_NSC, dh = u / RW_NSC, d = dh >> 2, h = dh & 3; const bool isPhi = C.wave >= 4; const int col = 16 * (C.wave & 3) + li;
        f32x4 hs[4];
#pragma unroll
        for (int i = 0; i < 4; ++i)
#pragma unroll
            for (int r = 0; r < 4; ++r) hs[i][r] = (isPhi && (16 * i + 4 * g + r == col)) ? 1.f : 0.f;
#pragma unroll 1
        for (int rnd = 0; rnd < (RW_SC + 2) / 3; ++rnd) {
            __syncthreads();
            { int wv = C.wave; asm volatile("" : "+s"(wv)); if (wv < 3 && 3 * rnd + wv < RW_SC) rwkv_d1(C, C.lds + wv * RW_REGION, d, h, rw_rc_of(d, s * RW_SC + 3 * rnd + wv)); }
            __syncthreads();
#pragma unroll 1
            for (int k = 0; k < 3; ++k) { const int ci = 3 * rnd + k; int ko = k * RW_REGION; asm volatile("" : "+s"(ko)); if (ci < RW_SC) rwkv_passA_step(C, C.lds + ko, hs, d, h, rw_rc_of(d, s * RW_SC + ci)); }
        }
        if (isPhi) { bf16* pf = (bf16*)(C.ws + WS_PSC) + (size_t)(dh * RW_NSC + s) * 4096;
            const int ks = col >> 5, eh = (col >> 4) & 1, gp = (col >> 2) & 3, el = col & 3;
#pragma unroll
            for (int i = 0; i < 4; ++i)
#pragma unroll
                for (int r = 0; r < 4; ++r) pf[((i * 2 + ks) * 64 + gp * 16 + 4 * g + r) * 8 + eh * 4 + el] = (bf16)f2bf(hs[i][r]); }
        else { f32x4* lf = (f32x4*)(C.ws + WS_LSC) + ((size_t)(dh * RW_NSC + s) * 4 + C.wave) * 4 * 64;
#pragma unroll
            for (int i = 0; i < 4; ++i) lf[i * 64 + lane] = hs[i]; }
    }
    __syncthreads();
}
__device__ __forceinline__ void rwkv_passB(const Ctx& C, int b) {
    if (C.wave >= 4) return;
    const int lane = C.lane, li = lane & 15, g = lane >> 4, q = C.wave;
    f32x4 hs[4];
#pragma unroll
    for (int i = 0; i < 4; ++i) hs[i] = (f32x4){0.f, 0.f, 0.f, 0.f};
    const bf16x8* pfb = (const bf16x8*)((const bf16*)(C.ws + WS_PSC) + (size_t)b * RW_NSC * 4096);
    const f32x4* lfb = (const f32x4*)(C.ws + WS_LSC) + ((size_t)b * RW_NSC * 4 + q) * 4 * 64;
    bf16x8 pa[8]; f32x4 la[4];
#pragma unroll
    for (int k = 0; k < 8; ++k) pa[k] = pfb[k * 64 + lane];
#pragma unroll
    for (int i = 0; i < 4; ++i) la[i] = lfb[i * 64 + lane];
#pragma unroll 1
    for (int s = 0; s < RW_NSC; ++s) {
        bf16* hp = (bf16*)(C.ws + WS_HSC) + ((size_t)(b * RW_NSC + s) * 64 + 16 * q + li) * 64;
#pragma unroll
        for (int i = 0; i < 4; ++i) { u32x2 w; w.x = pk2(hs[i][0], hs[i][1]); w.y = pk2(hs[i][2], hs[i][3]); *(u32x2*)(hp + 16 * i + 4 * g) = w; }
        bf16x8 pn[8]; f32x4 ln[4]; const int sn = (s + 1 < RW_NSC) ? s + 1 : s;
#pragma unroll
        for (int k = 0; k < 8; ++k) pn[k] = pfb[(size_t)sn * 512 + k * 64 + lane];
#pragma unroll
        for (int i = 0; i < 4; ++i) ln[i] = lfb[(size_t)sn * 4 * 4 * 64 + i * 64 + lane];
        union { bf16x8 v; unsigned u[4]; } bf[2];
#pragma unroll
        for (int ks = 0; ks < 2; ++ks) { bf[ks].u[0] = pk2(hs[2 * ks][0], hs[2 * ks][1]); bf[ks].u[1] = pk2(hs[2 * ks][2], hs[2 * ks][3]); bf[ks].u[2] = pk2(hs[2 * ks + 1][0], hs[2 * ks + 1][1]); bf[ks].u[3] = pk2(hs[2 * ks + 1][2], hs[2 * ks + 1][3]); }
#pragma unroll
        for (int i = 0; i < 4; ++i) { f32x4 acc = la[i];
#pragma unroll
            for (int ks = 0; ks < 2; ++ks) acc = mfma16(pa[i * 2 + ks], bf[ks].v, acc);
            hs[i] = acc; }
#pragma unroll
        for (int k = 0; k < 8; ++k) pa[k] = pn[k];
#pragma unroll
        for (int i = 0; i < 4; ++i) la[i] = ln[i];
    }
}
__device__ __forceinline__ void phase_mix3(const Ctx& C, const DArgs& a, int l) {
    const bf16* P = (const bf16*)(C.ws + WS_P); const float* SC = (const float*)(C.ws + WS_SC); const float* YS = (const float*)(C.ws + WS_YS); bf16* MIX = (bf16*)(C.ws + WS_MIX);
    LAS float* yt = (LAS float*)(C.lds);
    constexpr int GSP = 168;
    LAS unsigned char* gsig = C.lds + 32768;
    LAS float* gm = (LAS float*)(C.lds + 40960);
    const bf16* g2t = (const bf16*)(C.ws + WS_G2T) + (size_t)l * 256 * 160;
    const float* rk = a.in[I_DRK] + (size_t)l * 256; const float* lnw = a.in[I_DLNW] + (size_t)l * 256; const float* lnb = a.in[I_DLNB] + (size_t)l * 256;
    const int lane = C.lane, li = lane & 15, g = lane >> 4, h = C.wave & 3, d = C.wave >> 2;
    const int half = C.tid >> 8, c = C.tid & 255;
    const int u_lo = (l == DEPTH - 1) ? NCTX / 16 : 0;
    for (int u = u_lo + C.wg; u < ROWS / 16; u += C.G) {
        const int rc = u >> 1, th = u & 1, rowb = 16 * u;
        __syncthreads();
        for (int i = C.tid; i < 16 * 160; i += NTHR) { const int t = i / 160, ii = i % 160; *(LAS bf16*)(gsig + (t * GSP + ii) * 2) = (bf16)f2bf(sigmoidf_(bf2f(P[(size_t)(rowb + t) * INWP + C_GL + ii]))); }
        {
          const int ct = (d == 0) ? rc : (rc < 8 ? 7 - rc : 527 - rc), s = ct / RW_SC, ti = (d == 0) ? th : 1 - th;
          const bf16* rp = (const bf16*)(C.ws + WS_RPP) + (size_t)((d * 4 + h) * RW_NCH + rc) * 32 * 64;
          const bf16* hp = (const bf16*)(C.ws + WS_HSC) + (size_t)((d * 4 + h) * RW_NSC + s) * 64 * 64;
          bf16x8 af[2];
#pragma unroll
          for (int ks = 0; ks < 2; ++ks) af[ks] = ldg8(rp + (16 * ti + li) * 64 + 32 * ks + 8 * g);
#pragma unroll
          for (int vi = 0; vi < 4; ++vi) { f32x4 acc = {0.f, 0.f, 0.f, 0.f};
#pragma unroll
              for (int ks = 0; ks < 2; ++ks) acc = mfma16(af[ks], ldg8(hp + (16 * vi + li) * 64 + 32 * ks + 8 * g), acc);
#pragma unroll
              for (int r = 0; r < 4; ++r) { const int t = 16 * ti + 4 * g + r, rl = ((d == 0) ? t : 31 - t) - 16 * th;
                  yt[(d * 16 + rl) * 256 + h * 64 + 16 * vi + li] = acc[r] + YS[((size_t)d * ROWS + rowb + rl) * 256 + h * 64 + 16 * vi + li]; } } }
        __syncthreads();
#pragma unroll
        for (int c2 = 0; c2 < 2; ++c2) { const int ci = 2 * C.wave + c2; f32x4 a0 = {0.f, 0.f, 0.f, 0.f};
#pragma unroll
            for (int ks = 0; ks < 5; ++ks) a0 = mfma16(ldA(gsig, GSP, 0, 32 * ks, li, g), ldg8(g2t + (size_t)(16 * ci + li) * 160 + 32 * ks + 8 * g), a0);
#pragma unroll
            for (int r = 0; r < 4; ++r) gm[(4 * g + r) * 256 + 16 * ci + li] = a0[r]; }
        __syncthreads();
#pragma unroll 1
        for (int it = 0; it < 8; ++it) { const int rl = 2 * it + half, row = rowb + rl;
            const float* sc = SC + (size_t)row * 9 * 256;
            const float y = yt[rl * 256 + c] + yt[(16 + rl) * 256 + c];
            const float mu = wave_sum(y, lane) * (1.f / 64.f), dy = y - mu, var = wave_sum(dy * dy, lane) * (1.f / 64.f);
            const float yn = dy * rsqrtf(var + 64e-5f) * lnw[c] + lnb[c];
            const float r = sc[c], v = sc[256 + c];
            const float coef = wave_sum(r * (sc[4 * 256 + c] + sc[7 * 256 + c]) * rk[c], lane);
            MIX[(size_t)row * DM + 768 + c] = (bf16)f2bf((yn + coef * v) * gm[rl * 256 + c]); }
    }
    __syncthreads();
}
__device__ __forceinline__ void outproj_ctx(const Ctx& C, int l, const float* gate) {
    const bf16* A = (const bf16*)(C.ws + WS_MIX); const bf16* B = (const bf16*)(C.ws + WS_WOUT) + (size_t)l * DM * DM; float* XS = (float*)(C.ws + WS_XS);
    const int lane = C.lane, li = lane & 15, g = lane >> 4;
    for (int u = C.gw; u < (NCTX / 16) * (DM / 16); u += C.NGW) { const int rt = u >> 6, ct = u & 63;
        const bf16* ap = A + (size_t)(16 * rt + li) * DM + 8 * g; const bf16* bp = B + (size_t)(16 * ct + li) * DM + 8 * g;
        f32x4 acc0 = {0.f, 0.f, 0.f, 0.f}, acc1 = {0.f, 0.f, 0.f, 0.f};
#pragma unroll 4
        for (int ks = 0; ks < 32; ks += 2) { acc0 = mfma16(ldg8(ap + 32 * ks), ldg8(bp + 32 * ks), acc0); acc1 = mfma16(ldg8(ap + 32 * ks + 32), ldg8(bp + 32 * ks + 32), acc1); }
        const float gv = gate[16 * ct + li];
#pragma unroll
        for (int r = 0; r < 4; ++r) { float* p = XS + (size_t)(16 * rt + 4 * g + r) * DM + 16 * ct + li; *p = *p + gv * (acc0[r] + acc1[r]); } }
}

#ifndef MK_SINGLE
#define MK_SINGLE 1
#endif
template <int ONLYP> __global__ void __launch_bounds__(NTHR, 2) mega(Args a) {
    extern __shared__ __attribute__((aligned(16))) unsigned char lds_raw[];
    Ctx C;
#define MKCTX() do { int t_ = threadIdx.x; asm volatile("" : "+v"(t_)); unsigned char* w_ = a.ws; asm volatile("" : "+s"(w_)); unsigned l_ = 0u; asm volatile("" : "+s"(l_)); \
        C.lds = (LAS unsigned char*)lds_raw + l_; C.tid = t_; C.lane = t_ & 63; C.wave = __builtin_amdgcn_readfirstlane(t_ >> 6); \
        C.wg = blockIdx.x; C.G = gridDim.x; C.gw = C.wg * NWAVES + C.wave; C.NGW = C.G * NWAVES; C.ws = w_; } while (0)
    MKCTX();
    if (C.tid == 0) {
#pragma unroll
        for (int i = 0; i < 31; ++i) ((LAS unsigned long long*)(C.lds + MISC_OFF + 2048))[i] = (unsigned long long)a.in[i]; }
    DArgs da; da.in.tab = (const LAS unsigned*)(C.lds + MISC_OFF + 2048); da.out = a.out;
    if (C.tid < 4) ((LAS unsigned*)(C.lds + MISC_OFF))[C.tid] = 0u;
    __syncthreads();
    XcdBarrier bar; bar.bar = (unsigned*)(C.ws + WS_CTL) + CW_BAR; bar.x = 0; bar.st = (volatile LAS unsigned*)(C.lds + MISC_OFF);
    if (a.use_bar) bar = xcd_barrier_post((unsigned*)(C.ws + WS_CTL) + CW_BAR, (volatile LAS unsigned*)(C.lds + MISC_OFF));
#ifndef PHMASK
#define PHMASK 0x1fff
#endif
#define INP(o, k) ((ONLYP < 0 || ONLYP == (o)) && ((PHMASK >> ((o) == 99 ? 12 : (o))) & 1) && a.ph_lo <= (k) && (k) < a.ph_hi)
#ifndef REPMASK
#define REPMASK 0
#endif
#define NREP(o) ((((REPMASK) >> ((o) == 99 ? 12 : (o))) & 1) ? 2 : 1)
#define IN(k) (a.ph_lo <= (k) && (k) < a.ph_hi)
#define SEAM(k) do { if (a.use_bar && IN(k) && IN((k) + 1)) { xcd_barrier(bar); if ((REPMASK >> 20) & 1) xcd_barrier(bar); } } while (0)
    if (INP(0, 0)) for (int rep = 0; rep < NREP(0); ++rep) { MKCTX(); phase_prologue(C, da); }
    SEAM(0);
    for (int l = 0; l < DEPTH; ++l) {
        const int b = 1 + l * NPL;
        const float* mod_lat = (const float*)(C.ws + WS_MOD) + (size_t)(l * 2 + 0) * 6144; const float* mod_ctx = mod_lat + 6144;
        if (INP(1, b + 0)) { MKCTX(); phase_norm1(C, da, l); }
        SEAM(b + 0);
        if (INP(2, b + 1)) for (int rep = 0; rep < NREP(2); ++rep) { MKCTX();
            pg8::StaticOrder S; S.init(WS_H, WS_WIN + (size_t)l * INWP * DM * 2, ROWS, INWP, DM, C.G, C.wg);
            pg8::EpiStoreBf16 E{(bf16*)(C.ws + WS_P), INWP, nullptr, 0, 1.0f, 1.0f};
            pg8::gemm_phase<pg8::EpiStoreBf16, pg8::StaticOrder, true, true>(C.lds, C.tid, DM, S, E, C.ws);
        }
        SEAM(b + 1);
        if (INP(3, b + 2)) { MKCTX(); for (int rep = 0; rep < NREP(3); ++rep) { mix1_rwkv_prep(C, da, l); mix1_fourier1(C); } }
        SEAM(b + 2);
        if (INP(11, b + 3)) for (int rep = 0; rep < NREP(11); ++rep) { MKCTX(); phase_rwkv1(C);
            if (C.wg >= 8 * RW_NSC) {
                Ctx C2 = C; C2.wg = C.wg - 8 * RW_NSC; C2.G = C.G - 8 * RW_NSC; C2.gw = C2.wg * NWAVES + C.wave; C2.NGW = C2.G * NWAVES;
                mix1_rope(C2); mix1_vt(C2); } }
        SEAM(b + 3);
        if (INP(4, b + 4)) for (int rep = 0; rep < NREP(4); ++rep) { MKCTX(); phase_mix2(C, da, l); }
        SEAM(b + 4);
        if (INP(5, b + 5)) for (int rep = 0; rep < NREP(5); ++rep) { MKCTX(); phase_mix3(C, da, l); }
        SEAM(b + 5);
        if (INP(6, b + 6)) { MKCTX();
            if (l < DEPTH - 1) outproj_ctx(C, l, mod_ctx + 2 * DM);
            pg8::StaticOrder S; S.init(WS_MIX + (size_t)NCTX * DM * 2, WS_WOUT + (size_t)l * DM * DM * 2, SEQ, DM, DM, C.G, C.wg);
            pg8::EpiResidual E{(float*)(C.ws + WS_XS) + (size_t)NCTX * DM, DM, mod_lat + 2 * DM, mod_lat + 2 * DM};
            pg8::gemm_phase<pg8::EpiResidual, pg8::StaticOrder, true, true>(C.lds, C.tid, DM, S, E, C.ws);
        }
        SEAM(b + 6);
        if (INP(7, b + 7)) for (int rep = 0; rep < NREP(7); ++rep) { MKCTX(); phase_norm2(C, da, l); }
        SEAM(b + 7);
        if (INP(8, b + 8)) for (int rep = 0; rep < NREP(8); ++rep) { MKCTX(); phase_gather(C, da, l); }
        SEAM(b + 8);
        if (INP(9, b + 9)) for (int rep = 0; rep < NREP(9); ++rep) { MKCTX();
            const int nblk = moe_tables(C);
            pg8::MoeOrder S{(unsigned)WS_XG8, (unsigned)(WS_WGU + (size_t)l * 32 * 2048 * DM), 256u * DM, 2048u * DM,
                            (const LAS unsigned char*)(C.lds + MISC_OFF + 1024), nblk, 8, C.G, C.wg};
            pg8::EpiSwiglu E{(bf16*)(C.ws + WS_ACT8), DM, da.in[I_BGU] + (size_t)l * 32 * 2048, 2048, pg8::X8_S * pg8::W8_S, 1.0f / (pg8::X8_S * pg8::W8_S)};
            pg8::gemm_phase<pg8::EpiSwiglu, pg8::MoeOrder, true, true, 1>(C.lds, C.tid, DM, S, E, C.ws);
        }
        SEAM(b + 9);
        if (INP(10, b + 10)) for (int rep = 0; rep < NREP(10); ++rep) { MKCTX();
            const int nblk = moe_tables(C);
            pg8::MoeOrder S{(unsigned)WS_ACT8, (unsigned)(WS_WDN + (size_t)l * 32 * DM * DM), 256u * DM, (unsigned)(DM * DM),
                            (const LAS unsigned char*)(C.lds + MISC_OFF + 1024), nblk, 4, C.G, C.wg};
            pg8::EpiStoreBf16 E{(bf16*)(C.ws + WS_XG), DM, da.in[I_BDN] + (size_t)l * 32 * DM, DM, pg8::ACT_S * pg8::W8_S, 1.0f / (pg8::ACT_S * pg8::W8_S)};
            pg8::gemm_phase<pg8::EpiStoreBf16, pg8::MoeOrder, true, true, 1>(C.lds, C.tid, DM, S, E, C.ws);
        }
        SEAM(b + 10);
    }
    if (INP(99, PH_TOTAL - 1)) for (int rep = 0; rep < NREP(99); ++rep) { MKCTX(); phase_final(C, da); }
#undef IN
#undef INP
#undef SEAM
}

typedef void (*kern_t)(Args);
static kern_t kern_of(int o) {
    switch (o) { case 0: return mega<0>; case 1: return mega<1>; case 2: return mega<2>; case 3: return mega<3>; case 4: return mega<4>; case 5: return mega<5>; case 6: return mega<6>;
                 case 7: return mega<7>; case 8: return mega<8>; case 9: return mega<9>; case 10: return mega<10>; case 11: return mega<11>; case 99: return mega<99>;
#if MK_SINGLE
                 default: return mega<-1>;
#else
                 default: return mega<0>;
#endif
    }
}
extern "C" void kernel_launch(void* const* d_in, const int* in_sizes, int n_in, void* d_out, int out_size, void* d_ws, size_t ws_size, hipStream_t stream) {
    static int ready = 0;
    if (ready == 0) {
        if (n_in != 31 || out_size != SEQ * DM || ws_size < WS_END) { fprintf(stderr, "kernel_launch: unexpected shapes (n_in %d, out %d, ws %zu)\n", n_in, out_size, ws_size); ready = -1; return; }
        const int ids[14] = {0, 1, 2, 3, 4, 5, 6, 7, 8, 9, 10, 11, 99, -1};
        for (int i = 0; i < (MK_SINGLE ? 14 : 13); ++i) { if (MK_SINGLE && ids[i] != -1) continue;
            if (hipFuncSetAttribute((const void*)kern_of(ids[i]), hipFuncAttributeMaxDynamicSharedMemorySize, LDS_BYTES) != hipSuccess) { fprintf(stderr, "kernel_launch: hipFuncSetAttribute failed (%d)\n", ids[i]); ready = -1; return; } }
        ready = 1;
    }
    if (ready < 0) return;
    (void)hipMemsetAsync((char*)d_ws + WS_CTL, 0, CTL_ZERO_BYTES, stream);
    Args a{};
    for (int i = 0; i < 31; ++i) a.in[i] = (const float*)d_in[i];
    a.out = (float*)d_out; a.ws = (unsigned char*)d_ws; a.pad = 0;
#if MK_SINGLE
    a.ph_lo = 0; a.ph_hi = PH_TOTAL; a.use_bar = 1;
    hipLaunchKernelGGL(kern_of(-1), dim3(NWG), dim3(NTHR), LDS_BYTES, stream, a);
#else
    for (int p = 0; p < PH_TOTAL; ++p) { a.ph_lo = p; a.ph_hi = p + 1; a.use_bar = 0;
        const int j = (p - 1) % NPL; const int o = (p == 0) ? 0 : (p == PH_TOTAL - 1) ? 99 : (j < 3 ? 1 + j : j == 3 ? 11 : j);
        hipLaunchKernelGGL(kern_of(o), dim3(NWG), dim3(NTHR), LDS_BYTES, stream, a); }
#endif
}
```

```cpp
#include <hip/hip_runtime.h>
#include <cstdio>
#include <cstdint>

#define LAS __attribute__((address_space(3)))
typedef unsigned short bf16;
typedef float f32x4 __attribute__((ext_vector_type(4)));
typedef float f32x2 __attribute__((ext_vector_type(2)));
typedef short bf16x8 __attribute__((ext_vector_type(8)));
typedef unsigned u32x4 __attribute__((ext_vector_type(4)));
typedef unsigned u32x2 __attribute__((ext_vector_type(2)));

constexpr int DM = 1024, SEQ = 16384, NCTX = 256, ROWS = SEQ + NCTX, DEPTH = 4, GRIDW = 64;
constexpr int INW = 2720, INWP = 2816;
constexpr int C_AQ = 0, C_AK = 256, C_AV = 384, C_BU = 512, C_CQ = 768, C_CK = 1024, C_CV = 1280, C_DR = 1536, C_DK = 1792, C_DV = 2048, C_WL = 2304, C_AL = 2432, C_GL = 2560;
constexpr int NEXP = 32, TOPK = 4;
constexpr int MOE_MAXBLK = 296;
constexpr int MOE_ROWS = MOE_MAXBLK * 256;
constexpr int NWG = 256, NTHR = 512, NWAVES = 8;
constexpr int VTP = ROWS + 256;

constexpr size_t MiB = 1u << 20;
constexpr size_t WS_CTL = 0, CTL_ZERO_BYTES = 1 * MiB;
constexpr size_t WS_MOD = 1 * MiB;
constexpr size_t WS_TW = 2 * MiB;
constexpr size_t WS_MTAB = 3 * MiB;
constexpr size_t WS_XS = 4 * MiB;
constexpr size_t WS_H = 70 * MiB;
constexpr size_t WS_P = 104 * MiB;
constexpr size_t WS_MIX = 194 * MiB;
constexpr size_t WS_FYR = 228 * MiB, WS_FYI = 244 * MiB;
constexpr size_t WS_VTA = 1544 * MiB, WS_VTC = 1550 * MiB;
constexpr size_t WS_SC = 260 * MiB;
constexpr size_t WS_YS = 408 * MiB;
constexpr size_t WS_ROUTE = 442 * MiB;
constexpr size_t WS_CNT = 444 * MiB;
constexpr size_t WS_XG = 446 * MiB;
constexpr size_t WS_ACT = 596 * MiB;
constexpr size_t WS_XG8 = WS_ACT, WS_ACT8 = WS_ACT + 75 * MiB;
constexpr size_t WS_WIN = 746 * MiB;
constexpr size_t WS_WOUT = 768 * MiB;
constexpr size_t WS_WGU = 776 * MiB;
constexpr size_t WS_WDN = 1288 * MiB;
constexpr size_t WS_RPP = 1560 * MiB, WS_PSC = 1578 * MiB, WS_LSC = 1580 * MiB, WS_HSC = 1584 * MiB;
constexpr size_t WS_FTAB = 1586 * MiB;
constexpr size_t WS_G2T = 1588 * MiB, WS_RWT = 1589 * MiB;
constexpr size_t WS_LORAT = 1590 * MiB;
constexpr size_t WS_F256 = 1591 * MiB;

constexpr size_t WS_END = 1592 * MiB;
static_assert(WS_XS + (size_t)ROWS * DM * 4 <= WS_H && WS_H + (size_t)ROWS * DM * 2 <= WS_P && WS_P + (size_t)ROWS * INWP * 2 <= WS_MIX && WS_MIX + (size_t)ROWS * DM * 2 <= WS_FYR, "ws map 1");
static_assert(WS_SC + (size_t)ROWS * 9 * 256 * 4 <= WS_YS && WS_YS + (size_t)2 * ROWS * 256 * 4 <= WS_ROUTE && WS_XG + (size_t)MOE_ROWS * DM * 2 <= WS_ACT && WS_ACT + (size_t)MOE_ROWS * DM * 2 <= WS_WIN, "ws map 2");
static_assert(WS_WIN + (size_t)4 * INWP * DM * 2 <= WS_WOUT && WS_WGU + (size_t)4 * 32 * 2048 * 1024 * 2 <= WS_WDN && WS_WDN + (size_t)4 * 32 * 1024 * 1024 * 2 <= WS_END, "ws map 3");
constexpr int CW_BAR = 4096;
constexpr int CW_WQ = 16384;

constexpr int RING_BYTES = 131072;
constexpr int MISC_OFF = 143360;
constexpr int LDS_BYTES = 147456;

__device__ __forceinline__ unsigned f2bf(float f) { unsigned u = __builtin_bit_cast(unsigned, f); return (u + 0x7fffu + ((u >> 16) & 1u)) >> 16; }
__device__ __forceinline__ unsigned pk2(float lo, float hi) { return f2bf(lo) | (f2bf(hi) << 16); }
__device__ __forceinline__ float bf2f(unsigned short b) { return __builtin_bit_cast(float, (unsigned)b << 16); }
__device__ __forceinline__ float bflo(unsigned w) { return __builtin_bit_cast(float, w << 16); }
__device__ __forceinline__ float bfhi(unsigned w) { return __builtin_bit_cast(float, w & 0xffff0000u); }
__device__ __forceinline__ float shx(float v, int o, int lane) { return __builtin_bit_cast(float, __builtin_amdgcn_ds_bpermute((lane ^ o) << 2, __builtin_bit_cast(int, v))); }
__device__ __forceinline__ int shxi(int v, int o, int lane) { return __builtin_amdgcn_ds_bpermute((lane ^ o) << 2, v); }
__device__ __forceinline__ float dpp_ror(float v, int ctrl_unused);
#define DPP_ROR_ADD(v, n) v += __builtin_bit_cast(float, __builtin_amdgcn_update_dpp(0, __builtin_bit_cast(int, v), 0x120 + (n), 0xf, 0xf, false))
__device__ __forceinline__ float wave_sum(float v, int lane) {
    DPP_ROR_ADD(v, 8); DPP_ROR_ADD(v, 4); DPP_ROR_ADD(v, 2); DPP_ROR_ADD(v, 1);
    v += shx(v, 16, lane); v += shx(v, 32, lane);
    return v;
}
__device__ __forceinline__ float sigmoidf_(float x) { return 1.f / (1.f + __expf(-x)); }
#define LDS_WAIT() asm volatile("s_waitcnt lgkmcnt(0)" ::: "memory")
#define VM_WAIT() asm volatile("s_waitcnt vmcnt(0)" ::: "memory")

namespace pg8 {
#define PG8_LAS __attribute__((address_space(3)))
typedef unsigned short bf16_t;
constexpr int BM = 256, BK = 64, HALF = 128, HTB = HALF * BK * 2, STAGE_BYTES = 8 * HTB, NXCD = 8, WGM = 8;
__host__ __device__ __forceinline__ int lds_byte(int r, int c) { const int st = (r >> 4) * 2 + (c >> 5), rr = r & 15, cc = c & 31, ob = rr * 64 + cc * 2; return st * 1024 + (ob ^ (((ob >> 9) & 1) << 5)); }
__host__ __device__ __forceinline__ void stage_rc(int b, int& R, int& C) { const int st = b / 1024, sb = b % 1024, swz = sb ^ (((sb >> 9) & 1) << 5); R = (st >> 1) * 16 + swz / 64; C = (st & 1) * 32 + (swz % 64) / 2; }
__host__ __device__ __forceinline__ int perm32(int rho) { const int n = rho >> 4, i = rho & 15; return 8 * (i >> 2) + 4 * n + (i & 3); }
struct Unit { int pm, pn, e; };
typedef int v8i __attribute__((ext_vector_type(8))); typedef int v4i __attribute__((ext_vector_type(4)));
__device__ __forceinline__ v8i cat8(bf16x8 a, bf16x8 b) { const v4i x = __builtin_bit_cast(v4i, a), y = __builtin_bit_cast(v4i, b); return __builtin_shufflevector(x, y, 0, 1, 2, 3, 4, 5, 6, 7); }
__device__ __forceinline__ unsigned cvt_pk_bf16(float lo, float hi) { unsigned r; asm volatile("v_cvt_pk_bf16_f32 %0, %1, %2" : "=v"(r) : "v"(lo), "v"(hi)); return r; }

struct StaticOrder {
    unsigned A, Bt, tstep;
    int nM, nN, nwg, G, c;
    __device__ void init(size_t A_, size_t Bt_, int M, int N, int K, int G_, int c_) { A = (unsigned)A_; Bt = (unsigned)Bt_; tstep = (unsigned)(BM * K * 2); nM = M / BM; nN = N / BM; nwg = nM * nN; G = G_; c = c_; }
    __device__ bool next(int i, Unit& u) const {
        const long L = (long)i * G + c; if (L >= nwg) return false;
        int wgid = (int)L; { const int q = nwg / NXCD, r = nwg % NXCD, xcd = wgid % NXCD, off = wgid / NXCD; wgid = (xcd < r ? xcd * (q + 1) : r * (q + 1) + (xcd - r) * q) + off; }
        const int nig = WGM * nN, gid = wgid / nig, fm = gid * WGM, gsz = (nM - fm) < WGM ? (nM - fm) : WGM;
        u.pm = fm + ((wgid % nig) % gsz); u.pn = (wgid % nig) / gsz; u.e = 0; return true;
    }
    __device__ __forceinline__ unsigned pa(const Unit& u) const { return A + (unsigned)u.pm * tstep; }
    __device__ __forceinline__ unsigned pb(const Unit& u) const { return Bt + (unsigned)u.pn * tstep; }
};
struct MoeOrder {
    unsigned A, Bt, tstep, estep;
    const LAS unsigned char* blk_e; int nblk, nN, G, c;
    __device__ bool next(int i, Unit& u) const {
        const int L = i * G + c; if (L >= nblk * nN) return false;
        u.pm = L / nN; u.pn = L % nN; u.e = __builtin_amdgcn_readfirstlane((int)blk_e[u.pm]); return true;
    }
    __device__ __forceinline__ unsigned pa(const Unit& u) const { return A + (unsigned)u.pm * tstep; }
    __device__ __forceinline__ unsigned pb(const Unit& u) const { return Bt + (unsigned)u.e * estep + (unsigned)u.pn * tstep; }
};

struct EpiStoreBf16 {
    static constexpr bool PERM = true;
    bf16_t* O; int ldc; const float* bias; int bias_estride; float bias_scale, acc_scale;
    __device__ __forceinline__ void init(f32x4 (&acc)[2][2][4][2], const Unit& u, int wc, int fq) const {
        const int col0 = u.pn * BM + wc * 32 + 8 * fq;
#pragma unroll
        for (int b = 0; b < 2; ++b)
#pragma unroll
            for (int n = 0; n < 2; ++n) { const f32x4 bv = bias ? *(const f32x4*)(bias + (size_t)u.e * bias_estride + col0 + b * HALF + 4 * n) * bias_scale : (f32x4){0.f, 0.f, 0.f, 0.f};
#pragma unroll
                for (int a = 0; a < 2; ++a)
#pragma unroll
                    for (int m = 0; m < 4; ++m) { f32x4 t = bv; asm volatile("" : "+v"(t)); acc[a][b][m][n] = t; } }
    }
    __device__ __forceinline__ void operator()(const f32x4 (&acc)[2][2][4][2], const Unit& u, int wr, int wc, int fr, int fq) const {
        const int row0 = u.pm * BM + wr * 64 + fr, col0 = u.pn * BM + wc * 32 + 8 * fq;
#pragma unroll
        for (int ai = 0; ai < 2; ++ai)
#pragma unroll
            for (int m = 0; m < 4; ++m) { bf16_t* rowp = O + (size_t)(row0 + ai * HALF + m * 16) * ldc + col0;
#pragma unroll
                for (int bj = 0; bj < 2; ++bj) { const f32x4 v0 = acc[ai][bj][m][0] * acc_scale, v1 = acc[ai][bj][m][1] * acc_scale;
                    u32x4 w; w.x = cvt_pk_bf16(v0[0], v0[1]); w.y = cvt_pk_bf16(v0[2], v0[3]); w.z = cvt_pk_bf16(v1[0], v1[1]); w.w = cvt_pk_bf16(v1[2], v1[3]);
                    *(u32x4*)(rowp + bj * HALF) = w; }
                asm volatile("" ::: "memory"); }
    }
};
__device__ __forceinline__ float swiglu1(float g, float up) {
    g = fminf(g, 7.0f); up = fminf(fmaxf(up, -7.0f), 7.0f);
    return g * (1.f / (1.f + __expf(-1.702f * g))) * (up + 1.0f);
}
constexpr float X8_S = 8.0f, W8_S = 256.0f, ACT_S = 4.0f;
struct EpiSwiglu {
    static constexpr bool PERM = true;
    bf16_t* O; int ldc; const float* bias; int bias_estride; float bias_scale, acc_scale;
    __device__ __forceinline__ void init(f32x4 (&acc)[2][2][4][2], const Unit& u, int wc, int fq) const {
        const int col0 = u.pn * BM + wc * 32 + 8 * fq;
#pragma unroll
        for (int b = 0; b < 2; ++b)
#pragma unroll
            for (int n = 0; n < 2; ++n) { const f32x4 bv = bias ? *(const f32x4*)(bias + (size_t)u.e * bias_estride + col0 + b * HALF + 4 * n) * bias_scale : (f32x4){0.f, 0.f, 0.f, 0.f};
#pragma unroll
                for (int a = 0; a < 2; ++a)
#pragma unroll
                    for (int m = 0; m < 4; ++m) { f32x4 t = bv; asm volatile("" : "+v"(t)); acc[a][b][m][n] = t; } }
    }
    __device__ __forceinline__ void operator()(const f32x4 (&acc)[2][2][4][2], const Unit& u, int wr, int wc, int fr, int fq) const {
        const int row0 = u.pm * BM + wr * 64 + fr, col0 = u.pn * BM + wc * 32 + 8 * fq;
#pragma unroll
        for (int ai = 0; ai < 2; ++ai)
#pragma unroll
            for (int m = 0; m < 4; ++m) { unsigned char* rowp = (unsigned char*)O + (size_t)(row0 + ai * HALF + m * 16) * ldc + (col0 >> 1);
#pragma unroll
                for (int bj = 0; bj < 2; ++bj) { const f32x4 v0 = acc[ai][bj][m][0] * acc_scale, v1 = acc[ai][bj][m][1] * acc_scale;
                    unsigned w = 0; w = __builtin_amdgcn_cvt_pk_fp8_f32(swiglu1(v0[0], v0[1]) * ACT_S, swiglu1(v0[2], v0[3]) * ACT_S, w, false); w = __builtin_amdgcn_cvt_pk_fp8_f32(swiglu1(v1[0], v1[1]) * ACT_S, swiglu1(v1[2], v1[3]) * ACT_S, w, true);
                    *(unsigned*)(rowp + bj * (HALF / 2)) = w; }
                asm volatile("" ::: "memory"); }
    }
};
struct EpiResidual {
    static constexpr bool PERM = false;
    float* X; int ldc; const float* gate_lat; const float* gate_ctx;
    __device__ __forceinline__ void init(f32x4 (&acc)[2][2][4][2], const Unit& u, int wc, int fq) const {
#pragma unroll
        for (int a = 0; a < 2; ++a)
#pragma unroll
            for (int b = 0; b < 2; ++b)
#pragma unroll
                for (int m = 0; m < 4; ++m)
#pragma unroll
                    for (int n = 0; n < 2; ++n) acc[a][b][m][n] = (f32x4){0.f, 0.f, 0.f, 0.f};
    }
    __device__ __forceinline__ void operator()(const f32x4 (&acc)[2][2][4][2], const Unit& u, int wr, int wc, int fr, int fq) const {
        const int row0 = u.pm * BM + wr * 64 + fr, col0 = u.pn * BM + wc * 32 + 4 * fq;
        const float* gp = (u.pm == 0) ? gate_ctx : gate_lat;
        f32x4 gv[2][2];
#pragma unroll
        for (int bj = 0; bj < 2; ++bj)
#pragma unroll
            for (int n = 0; n < 2; ++n) gv[bj][n] = *(const f32x4*)(gp + col0 + bj * HALF + n * 16);
#pragma unroll
        for (int ai = 0; ai < 2; ++ai)
#pragma unroll
            for (int m = 0; m < 4; ++m) { float* rowp = X + (size_t)(row0 + ai * HALF + m * 16) * ldc + col0;
#pragma unroll
                for (int bj = 0; bj < 2; ++bj)
#pragma unroll
                    for (int n = 0; n < 2; ++n) { f32x4* p = (f32x4*)(rowp + bj * HALF + n * 16); *p = *p + gv[bj][n] * acc[ai][bj][m][n]; }
                asm volatile("" ::: "memory"); }
    }
};
template <class Epi, class Sched, bool ALIGN_EPI = false, bool SP2 = false, int ES = 2>
__device__ __forceinline__ void gemm_phase(PG8_LAS unsigned char* lds, const int tid, const int K, const Sched& S, const Epi& E, const void* wsbase) {
    const __amdgpu_buffer_rsrc_t rsrc = __builtin_amdgcn_make_buffer_rsrc((void*)wsbase, 0, 0x7fffffff, 0x00020000);
    const int wid = __builtin_amdgcn_readfirstlane(tid >> 6), lane = tid & 63, wr = wid >> 2, wc = wid & 3, fr = lane & 15, fq = lane >> 4;
    const int nt = (K * ES) / 128;
    unsigned voffA[2], voffB[2];
#pragma unroll
    for (int i = 0; i < 2; ++i) { int R, C; stage_rc(tid * 16 + i * 8192, R, C); const int Rb = Epi::PERM ? ((R & ~31) + perm32(R & 31)) : R;
        voffA[i] = (unsigned)(R * K * ES + C * 2); voffB[i] = (unsigned)(Rb * K * ES + C * 2); }
    const unsigned kstep = (unsigned)(BK * 2);
    const unsigned hstep = (unsigned)(HALF * K * ES);
        const unsigned ldsw = (unsigned)wid * 1024u;
    const int aoff = lds_byte(wr * 64 + fr, ES == 2 ? fq * 8 : fq * 16), boff = lds_byte(wc * 32 + fr, ES == 2 ? fq * 8 : fq * 16); constexpr int KOFF = (ES == 2) ? 1024 : 16;
#define PG8_SA(b, h) (((b) * 2 + (h)) * HTB)
#define PG8_SB(b, h) ((4 + (b) * 2 + (h)) * HTB)
#define PG8_STAGE(bufoff, gbase, voff) do { _Pragma("unroll") for (int _i = 0; _i < 2; ++_i) \
        __builtin_amdgcn_raw_ptr_buffer_load_lds(rsrc, (PG8_LAS unsigned*)(lds + (bufoff) + ldsw + _i * 8192), 16, (voff)[_i], (gbase), 0, 0); } while (0)
#define PG8_LDA(dst, b, h) do { _Pragma("unroll") for (int m = 0; m < 4; ++m) _Pragma("unroll") for (int k = 0; k < 2; ++k) dst[m][k] = *(const PG8_LAS bf16x8*)(lds + PG8_SA(b, h) + aoff + m * 2048 + k * KOFF); } while (0)
#define PG8_LDA8(dst, b, h) do { _Pragma("unroll") for (int m = 0; m < 4; ++m) { const PG8_LAS v4i* p_ = (const PG8_LAS v4i*)(lds + PG8_SA(b, h) + aoff + m * 2048); const v4i x_ = p_[0], y_ = p_[1]; dst[m] = __builtin_shufflevector(x_, y_, 0, 1, 2, 3, 4, 5, 6, 7); } } while (0)
#define PG8_LDB(dst, b, h) do { _Pragma("unroll") for (int n = 0; n < 2; ++n) _Pragma("unroll") for (int k = 0; k < 2; ++k) dst[n][k] = *(const PG8_LAS bf16x8*)(lds + PG8_SB(b, h) + boff + n * 2048 + k * KOFF); } while (0)
#define PG8_LDB8(dst, b, h) do { _Pragma("unroll") for (int n = 0; n < 2; ++n) { const PG8_LAS v4i* p_ = (const PG8_LAS v4i*)(lds + PG8_SB(b, h) + boff + n * 2048); const v4i x_ = p_[0], y_ = p_[1]; dst[n] = __builtin_shufflevector(x_, y_, 0, 1, 2, 3, 4, 5, 6, 7); } } while (0)
#define PG8_MMA(ai, bj, At, Bt) do { __builtin_amdgcn_s_setprio(1); _Pragma("unroll") for (int m = 0; m < 4; ++m) _Pragma("unroll") for (int n = 0; n < 2; ++n) { \
        if constexpr (ES == 2) { _Pragma("unroll") for (int k = 0; k < 2; ++k) acc[ai][bj][m][n] = __builtin_amdgcn_mfma_f32_16x16x32_bf16(Bt[n][k], At[m][k], acc[ai][bj][m][n], 0, 0, 0); } \
        else asm volatile("v_mfma_f32_16x16x128_f8f6f4 %0, %1, %2, %0" : "+v"(acc[ai][bj][m][n]) : "v"(Bt##8[n]), "v"(At##8[m])); } \
        __builtin_amdgcn_s_setprio(0); } while (0)
#define PG8_LDAX(b, h) do { if constexpr (ES == 2) PG8_LDA(At, b, h); else PG8_LDA8(At8, b, h); } while (0)
#define PG8_LDBX(B, b, h) do { if constexpr (ES == 2) PG8_LDB(B, b, h); else PG8_LDB8(B##8, b, h); } while (0)
#define PG8_WAIT_V(n) asm volatile("s_waitcnt vmcnt(" #n ")" ::: "memory")
#define PG8_WAIT_L(n) asm volatile("s_waitcnt lgkmcnt(" #n ")" ::: "memory")
#define PG8_BAR __builtin_amdgcn_s_barrier()
#define PG8_SCHED __builtin_amdgcn_sched_barrier(0)
    Unit cur, nxt; int ui = 0;
    if (!S.next(0, cur)) return;
    f32x4 acc[2][2][4][2];
    E.init(acc, cur, wc, fq);
    bf16x8 At[4][2], B0[2][2], B1[2][2]; v8i At8[4], B08[2], B18[2];
    unsigned cA = S.pa(cur), cB = S.pb(cur);
    if constexpr (SP2) {
        PG8_STAGE(PG8_SB(0, 0), cB, voffB); PG8_STAGE(PG8_SB(0, 1), cB + hstep, voffB); PG8_STAGE(PG8_SA(0, 0), cA, voffA); PG8_STAGE(PG8_SA(0, 1), cA + hstep, voffA);
        if (wr == 1) PG8_BAR;
        PG8_WAIT_V(2); PG8_BAR;
        PG8_STAGE(PG8_SB(1, 0), cB + kstep, voffB); PG8_STAGE(PG8_SA(1, 0), cA + kstep, voffA); PG8_STAGE(PG8_SB(1, 1), cB + hstep + kstep, voffB);
        PG8_WAIT_V(6); PG8_BAR;
    } else {
        PG8_STAGE(PG8_SB(0, 0), cB, voffB); PG8_STAGE(PG8_SA(0, 0), cA, voffA); PG8_STAGE(PG8_SB(0, 1), cB + hstep, voffB); PG8_STAGE(PG8_SA(0, 1), cA + hstep, voffA);
        if (wr == 1) PG8_BAR;
        PG8_WAIT_V(4); PG8_BAR;
        PG8_STAGE(PG8_SB(1, 0), cB + kstep, voffB); PG8_STAGE(PG8_SA(1, 0), cA + kstep, voffA); PG8_STAGE(PG8_SB(1, 1), cB + hstep + kstep, voffB);
        PG8_WAIT_V(6); PG8_BAR;
    }
    for (;;) {
        const bool has_next = S.next(ui + 1, nxt);
        const unsigned nA = has_next ? S.pa(nxt) : cA, nB = has_next ? S.pb(nxt) : cB;
        for (int t = 0; t < nt; t += 2) {
            const bool last = (t == nt - 2);
            const unsigned a1 = cA + (unsigned)(t + 1) * kstep;
            const unsigned a2 = last ? nA : cA + (unsigned)(t + 2) * kstep, b2 = last ? nB : cB + (unsigned)(t + 2) * kstep;
            const unsigned a3 = a2 + kstep, b3 = b2 + kstep;
            if constexpr (SP2) {
            PG8_LDBX(B0, 0, 0); PG8_LDBX(B1, 0, 1); PG8_SCHED; PG8_LDAX(0, 0); PG8_STAGE(PG8_SA(1, 1), a1 + hstep, voffA);
            PG8_WAIT_V(8); PG8_WAIT_L(0); PG8_BAR; PG8_MMA(0, 0, At, B0); PG8_MMA(0, 1, At, B1); PG8_BAR; PG8_SCHED;
            PG8_LDAX(0, 1); PG8_STAGE(PG8_SB(0, 0), b2, voffB); PG8_STAGE(PG8_SB(0, 1), b2 + hstep, voffB); PG8_STAGE(PG8_SA(0, 0), a2, voffA);
            PG8_WAIT_V(8); PG8_WAIT_L(0); PG8_BAR; PG8_MMA(1, 0, At, B0); PG8_MMA(1, 1, At, B1); PG8_BAR; PG8_SCHED;
            PG8_LDBX(B0, 1, 0); PG8_LDBX(B1, 1, 1); PG8_SCHED; PG8_LDAX(1, 0); PG8_STAGE(PG8_SA(0, 1), a2 + hstep, voffA);
            PG8_WAIT_V(8); PG8_WAIT_L(0); PG8_BAR; PG8_MMA(0, 0, At, B0); PG8_MMA(0, 1, At, B1); PG8_BAR; PG8_SCHED;
            PG8_LDAX(1, 1); PG8_STAGE(PG8_SB(1, 0), b3, voffB); PG8_STAGE(PG8_SB(1, 1), b3 + hstep, voffB); PG8_STAGE(PG8_SA(1, 0), a3, voffA);
            PG8_WAIT_V(8); PG8_WAIT_L(0); PG8_BAR; PG8_MMA(1, 0, At, B0); PG8_MMA(1, 1, At, B1); PG8_BAR; PG8_SCHED;
            } else {
            PG8_LDBX(B0, 0, 0); PG8_SCHED; PG8_LDAX(0, 0); PG8_STAGE(PG8_SA(1, 1), a1 + hstep, voffA);
            PG8_WAIT_L(8); PG8_BAR; PG8_WAIT_L(0); PG8_MMA(0, 0, At, B0); PG8_BAR; PG8_SCHED;
            PG8_LDBX(B1, 0, 1); PG8_STAGE(PG8_SB(0, 0), b2, voffB);
            PG8_BAR; PG8_WAIT_L(0); PG8_MMA(0, 1, At, B1); PG8_BAR;
            PG8_LDAX(0, 1); PG8_STAGE(PG8_SA(0, 0), a2, voffA);
            PG8_BAR; PG8_WAIT_L(0); PG8_MMA(1, 0, At, B0); PG8_BAR; PG8_SCHED;
            PG8_STAGE(PG8_SB(0, 1), b2 + hstep, voffB);
            PG8_WAIT_V(6); PG8_BAR; PG8_MMA(1, 1, At, B1); PG8_BAR;
            PG8_LDBX(B0, 1, 0); PG8_SCHED; PG8_LDAX(1, 0); PG8_STAGE(PG8_SA(0, 1), a2 + hstep, voffA);
            PG8_WAIT_L(8); PG8_BAR; PG8_WAIT_L(0); PG8_MMA(0, 0, At, B0); PG8_BAR; PG8_SCHED;
            PG8_LDBX(B1, 1, 1); PG8_STAGE(PG8_SB(1, 0), b3, voffB);
            PG8_BAR; PG8_WAIT_L(0); PG8_MMA(0, 1, At, B1); PG8_BAR;
            PG8_LDAX(1, 1); PG8_STAGE(PG8_SA(1, 0), a3, voffA);
            PG8_BAR; PG8_WAIT_L(0); PG8_MMA(1, 0, At, B0); PG8_BAR; PG8_SCHED;
            PG8_STAGE(PG8_SB(1, 1), b3 + hstep, voffB);
            PG8_WAIT_V(6); PG8_BAR; PG8_MMA(1, 1, At, B1); PG8_BAR;
            }
        }
        if constexpr (ALIGN_EPI) { if (wr == 0) PG8_BAR; }
        if constexpr (ES == 1) asm volatile("s_nop 15\n\ts_nop 15" ::: "memory");
        E(acc, cur, wr, wc, fr, fq);
        if (!has_next) break;
        E.init(acc, nxt, wc, fq);
        cur = nxt; cA = nA; cB = nB; ++ui;
        if constexpr (ALIGN_EPI) { if (wr == 1) PG8_BAR; }
    }
    PG8_WAIT_V(0);
    if constexpr (!ALIGN_EPI) { if (wr == 0) PG8_BAR; }
    PG8_BAR;
#undef PG8_SA
#undef PG8_SB
#undef PG8_STAGE
#undef PG8_LDA
#undef PG8_LDA8
#undef PG8_LDB8
#undef PG8_LDAX
#undef PG8_LDBX
#undef PG8_LDB
#undef PG8_MMA
#undef PG8_WAIT_V
#undef PG8_WAIT_L
#undef PG8_BAR
#undef PG8_SCHED
}
}

#define XB_TMO      128
#define XB_XCNT(j)  (256  + 64 * (j))
#define XB_XSUB(j)  (1280 + 64 * (j))
#define XB_XGEN(j)  (2304 + 64 * (j))
#define XB_TOP      3328
#define XB_TOPGEN   3392
#define XCD_BAR_WORDS 3456
#define XB_SPIN_CAP (1u << 18)
__device__ __forceinline__ unsigned xb_ld(unsigned* p)              { return __hip_atomic_load(p, __ATOMIC_RELAXED, __HIP_MEMORY_SCOPE_AGENT); }
__device__ __forceinline__ unsigned xb_add(unsigned* p, unsigned v) { return __hip_atomic_fetch_add(p, v, __ATOMIC_RELAXED, __HIP_MEMORY_SCOPE_AGENT); }
__device__ __forceinline__ unsigned xb_xcc_id() { return (unsigned)__builtin_amdgcn_s_getreg((3 << 11) | 20) & 0xFu; }
#define XB_SPIN(cond, bar) do { unsigned _sp = 0; while (cond) { __builtin_amdgcn_s_sleep(1); \
    if ((++_sp & 255u) == 0u) { if (xb_ld(&(bar)[XB_TMO])) break; if (_sp > XB_SPIN_CAP) { atomicAdd(&(bar)[XB_TMO], 1u); break; } } } } while (0)

struct XcdBarrier {
    unsigned* bar; unsigned x;
    volatile LAS unsigned* st;
};

__device__ __forceinline__ XcdBarrier xcd_barrier_post(unsigned* bar, volatile LAS unsigned* st) {
    XcdBarrier b; b.bar = bar; b.x = xb_xcc_id(); b.st = st;
    if (threadIdx.x == 0) (void)xb_add(&bar[XB_XCNT(b.x)], 1u);
    return b;
}
__device__ __forceinline__ void xcd_barrier_complete(unsigned* bar, unsigned x, unsigned& nloc, unsigned& nx) {
    const unsigned G = gridDim.x * gridDim.y * gridDim.z;
    unsigned sum, cnt, mine, sp = 0u;
    for (;;) {
        sum = 0u; cnt = 0u; mine = 0u;
#pragma unroll
        for (unsigned j = 0; j < 16; ++j) { const unsigned c = xb_ld(&bar[XB_XCNT(j)]); sum += c; cnt += (c > 0u) ? 1u : 0u; mine = (j == x) ? c : mine; }
        if (sum == G) break;
        __builtin_amdgcn_s_sleep(1);
        if ((++sp & 255u) == 0u) { if (xb_ld(&bar[XB_TMO])) break; if (sp > XB_SPIN_CAP) { atomicAdd(&bar[XB_TMO], 1u); break; } }
    }
    nloc = mine > 0u ? mine : 1u; nx = cnt > 0u ? cnt : 1u;
}

__device__ __forceinline__ void xcd_barrier(const XcdBarrier& b) {
    asm volatile("s_waitcnt vmcnt(0)" ::: "memory");
    __syncthreads();
    if (threadIdx.x == 0) {
        unsigned* bar = b.bar;
        __builtin_amdgcn_s_waitcnt(0);
        unsigned nloc = b.st[0], nx = b.st[1];
        if (nloc == 0u) { xcd_barrier_complete(bar, b.x, nloc, nx); b.st[0] = nloc; b.st[1] = nx; }
        const unsigned old = xb_add(&bar[XB_XSUB(b.x)], 1u);
        const unsigned gen = old / nloc;
        if (old + 1u == (gen + 1u) * nloc) {
            __builtin_amdgcn_fence(__ATOMIC_RELEASE, "agent");
            asm volatile("s_waitcnt vmcnt(0)" ::: "memory");
            const unsigned og = xb_add(&bar[XB_TOP], 1u);
            const unsigned tg = og / nx;
            if (og + 1u == (tg + 1u) * nx) xb_add(&bar[XB_TOPGEN], 1u);
            else XB_SPIN(xb_ld(&bar[XB_TOPGEN]) == tg, bar);
            __builtin_amdgcn_fence(__ATOMIC_ACQUIRE, "agent");
            xb_add(&bar[XB_XGEN(b.x)], 1u);
            asm volatile("s_waitcnt vmcnt(0)" ::: "memory");
        } else {
            XB_SPIN(xb_ld(&bar[XB_XGEN(b.x)]) == gen, bar);
            __builtin_amdgcn_fence(__ATOMIC_ACQUIRE, "agent");
            asm volatile("s_waitcnt vmcnt(0)" ::: "memory");
        }
    }
    __syncthreads();
}

typedef short s4v __attribute__((ext_vector_type(4)));
__device__ __forceinline__ bf16x8 ldg8(const bf16* p) { return *(const bf16x8*)p; }
__device__ __forceinline__ f32x4 mfma16(bf16x8 a, bf16x8 b, f32x4 c) { return __builtin_amdgcn_mfma_f32_16x16x32_bf16(a, b, c, 0, 0, 0); }
__device__ __forceinline__ bf16x8 ldA(const LAS unsigned char* base, int pitch, int row0, int k0, int li, int g) { return *(const LAS bf16x8*)(base + ((row0 + li) * pitch + k0 + 8 * g) * 2); }
__device__ __forceinline__ bf16x8 ldT(const LAS unsigned char* base, int pitch, int k0, int n0, int li, int g) {
    const LAS unsigned char* p = base + ((k0 + 8 * g + (li >> 2)) * pitch + n0 + 4 * (li & 3)) * 2;
    const s4v a = __builtin_amdgcn_ds_read_tr16_b64_v4i16((LAS s4v*)p), b = __builtin_amdgcn_ds_read_tr16_b64_v4i16((LAS s4v*)(p + 8 * pitch));
    return (bf16x8){a[0], a[1], a[2], a[3], b[0], b[1], b[2], b[3]};
}
__device__ __forceinline__ bf16x8 ldAperm(const LAS unsigned char* base, int pitch, int row0, int ks, int li, int g) {
    const LAS unsigned char* p = base + ((row0 + li) * pitch + 32 * ks + 4 * g) * 2;
    const s4v a = *(const LAS s4v*)p, b = *(const LAS s4v*)(p + 32);
    return (bf16x8){a[0], a[1], a[2], a[3], b[0], b[1], b[2], b[3]};
}
__device__ __forceinline__ void stT(LAS unsigned char* base, int pitch, int n, int m0, const f32x4 v) {
    u32x2 w; w.x = pk2(v[0], v[1]); w.y = pk2(v[2], v[3]); *(LAS u32x2*)(base + (n * pitch + m0) * 2) = w;
}
__device__ __forceinline__ f32x4 ld4bf(const LAS unsigned char* p) { const u32x2 w = *(const LAS u32x2*)p; return (f32x4){bflo(w.x), bfhi(w.x), bflo(w.y), bfhi(w.y)}; }

struct Args {
    const float* in[31];
    float* out; unsigned char* ws;
    int ph_lo, ph_hi, use_bar, pad;
};
enum InIdx { I_X = 0, I_C, I_CTX, I_CCTX, I_ADAW, I_ADAB, I_N1G, I_N2G, I_WIN, I_WOUT, I_ASINK, I_BMIX, I_CREL, I_DCONV, I_DW0, I_DW2, I_DA0, I_DA2, I_DG2, I_DKK, I_DKA, I_DRK, I_DLNW, I_DLNB,
             I_RW, I_RB, I_WGU, I_BGU, I_WDN, I_BDN, I_FNG };
constexpr int NPL = 11;
constexpr int PH_TOTAL = 1 + DEPTH * NPL + 1;

struct DevIn {
    const LAS unsigned* tab;
    __device__ __forceinline__ const float* operator[](int i) const {
        const unsigned lo = __builtin_amdgcn_readfirstlane(((const volatile LAS unsigned*)tab)[2 * i]), hi = __builtin_amdgcn_readfirstlane(((const volatile LAS unsigned*)tab)[2 * i + 1]);
        return (const float*)(((unsigned long long)hi << 32) | lo);
    }
};
struct DArgs { DevIn in; float* out; };
struct Ctx {
    LAS unsigned char* lds;
    int tid, lane, wave, wg, G, gw, NGW;
    unsigned char* ws;
};

template <int NW>
__device__ __forceinline__ void transpose_item(const float* W, int K, int N, bf16* WT, int item, int lane) {
    constexpr int NQ = NW / 4, NC = 64 / NQ, PASSES = 8 / NC;
    const int nblk = N / NW, kb = item / nblk, nb = item % nblk, k0 = 64 * kb, n0 = NW * nb, nq = lane % NQ, cq = lane / NQ;
    f32x4 v[PASSES][8];
#pragma unroll
    for (int ps = 0; ps < PASSES; ++ps)
#pragma unroll
        for (int i = 0; i < 8; ++i) v[ps][i] = *(const f32x4*)(W + (size_t)(k0 + 8 * (cq + NC * ps) + i) * N + n0 + 4 * nq);
#pragma unroll
    for (int ps = 0; ps < PASSES; ++ps)
#pragma unroll
        for (int j = 0; j < 4; ++j) { u32x4 o; o.x = pk2(v[ps][0][j], v[ps][1][j]); o.y = pk2(v[ps][2][j], v[ps][3][j]); o.z = pk2(v[ps][4][j], v[ps][5][j]); o.w = pk2(v[ps][6][j], v[ps][7][j]);
            *(u32x4*)(WT + (size_t)(n0 + 4 * nq + j) * K + k0 + 8 * (cq + NC * ps)) = o; }
}
template <int NW>
__device__ __forceinline__ void transpose_item8(const float* W, int K, int N, unsigned char* WT, int item, int lane) {
    constexpr int NQ = NW / 4, NC = 64 / NQ, PASSES = 8 / NC;
    const int nblk = N / NW, kb = item / nblk, nb = item % nblk, k0 = 64 * kb, n0 = NW * nb, nq = lane % NQ, cq = lane / NQ;
    f32x4 v[PASSES][8];
#pragma unroll
    for (int ps = 0; ps < PASSES; ++ps)
#pragma unroll
        for (int i = 0; i < 8; ++i) v[ps][i] = __builtin_nontemporal_load((const f32x4*)(W + (size_t)(k0 + 8 * (cq + NC * ps) + i) * N + n0 + 4 * nq)) * pg8::W8_S;
#pragma unroll
    for (int ps = 0; ps < PASSES; ++ps)
#pragma unroll
        for (int j = 0; j < 4; ++j) { unsigned w0 = 0, w1 = 0;
            w0 = __builtin_amdgcn_cvt_pk_fp8_f32(v[ps][0][j], v[ps][1][j], w0, false); w0 = __builtin_amdgcn_cvt_pk_fp8_f32(v[ps][2][j], v[ps][3][j], w0, true);
            w1 = __builtin_amdgcn_cvt_pk_fp8_f32(v[ps][4][j], v[ps][5][j], w1, false); w1 = __builtin_amdgcn_cvt_pk_fp8_f32(v[ps][6][j], v[ps][7][j], w1, true);
            __builtin_nontemporal_store((u32x2){w0, w1}, (u32x2*)(WT + (size_t)(n0 + 4 * nq + j) * K + k0 + 8 * (cq + NC * ps))); }
}
constexpr int CV_IT_GU = 16 * 64, CV_IT_DN = 16 * 32, CV_N_GU = 32 * CV_IT_GU, CV_N_DN = 32 * CV_IT_DN, CV_ITEMS = CV_N_GU + CV_N_DN, CV_CHUNK = 16, CV_NCHUNK = CV_ITEMS / CV_CHUNK;
__device__ __forceinline__ void convert_moe_items(const Ctx& C, const DArgs& a, int l, int it0, int it1) {
    const float* pwgu = a.in[I_WGU] + (size_t)l * 32 * DM * 2048; const float* pwdn = a.in[I_WDN] + (size_t)l * 32 * DM * DM;
    unsigned char* ogu = C.ws + WS_WGU + (size_t)l * 32 * 2048 * DM; unsigned char* odn = C.ws + WS_WDN + (size_t)l * 32 * DM * DM;
#pragma unroll 1
    for (int it = it0; it < it1; ++it) {
        if (it < CV_N_GU) { const int e = it / CV_IT_GU; transpose_item8<32>(pwgu + (size_t)e * DM * 2048, DM, 2048, ogu + (size_t)e * 2048 * DM, it % CV_IT_GU, C.lane); }
        else { const int r = it - CV_N_GU, e = r / CV_IT_DN; transpose_item8<32>(pwdn + (size_t)e * DM * DM, DM, DM, odn + (size_t)e * DM * DM, r % CV_IT_DN, C.lane); }
    }
}
__device__ __forceinline__ void phase_prologue(const Ctx& C, const DArgs& a) {
    constexpr int IT_IN = 16 * (INW / 32), IT_OUT = 16 * 16;
    constexpr int N_IN = 4 * IT_IN, N_OUT = 4 * IT_OUT;
    const float* pwin = a.in[I_WIN]; const float* pwout = a.in[I_WOUT];
    for (int it = C.gw; it < N_IN + N_OUT; it += C.NGW) {
        if (it < N_IN) { const int l = it / IT_IN; transpose_item<32>(pwin + (size_t)l * DM * INW, DM, INW, (bf16*)(C.ws + WS_WIN) + (size_t)l * INWP * DM, it % IT_IN, C.lane); }
        else { const int r = it - N_IN, l = r / IT_OUT; transpose_item<64>(pwout + (size_t)l * DM * DM, DM, DM, (bf16*)(C.ws + WS_WOUT) + (size_t)l * DM * DM, r % IT_OUT, C.lane); }
    }
    for (int ch = C.gw; ch < CV_NCHUNK; ch += C.NGW) convert_moe_items(C, a, 0, ch * CV_CHUNK, ch * CV_CHUNK + CV_CHUNK);
    { const int gt = C.wg * NTHR + C.tid; constexpr int PADN = (INWP - INW) * DM / 8;
      for (int i = gt; i < 4 * PADN; i += C.G * NTHR) { const int l = i / PADN, r = i % PADN; *((u32x4*)((bf16*)(C.ws + WS_WIN) + ((size_t)l * INWP + INW) * DM) + r) = (u32x4){0u, 0u, 0u, 0u}; } }
    { float* tw = (float*)(C.ws + WS_TW); const int gt = C.wg * NTHR + C.tid;
      for (int i = gt; i < 16384; i += C.G * NTHR) { const float x = (float)i * (1.0f / 8192.0f); tw[i] = cospif(x); tw[16384 + i] = sinpif(x); } }
    { float* mt = (float*)(C.ws + WS_MTAB); const int gt = C.wg * NTHR + C.tid; const float* pbmix = a.in[I_BMIX];
      for (int i = gt; i < 4 * 4 * 64 * 64; i += C.G * NTHR) { const int e = i & 63, c = (i >> 6) & 63, g = (i >> 12) & 3, l = i >> 14;
          const float* w = pbmix + ((size_t)(l * 4 + g) * 64) * 64 + e; float sc = 0.f, ss = 0.f;
          for (int cp = 0; cp < 64; ++cp) { const float x = (float)((c * cp) & 63) * (1.0f / 32.0f); const float wv = w[cp * 64]; sc += cospif(x) * wv; ss += sinpif(x) * wv; }
          mt[((size_t)(l * 2 + 0) * 4 + g) * 4096 + c * 64 + e] = sc; mt[((size_t)(l * 2 + 1) * 4 + g) * 4096 + c * 64 + e] = ss; } }
    { bf16* ft = (bf16*)(C.ws + WS_FTAB); const int gt = C.wg * NTHR + C.tid; const float* pbmix = a.in[I_BMIX];
      for (int i = gt; i < 128 * 128; i += C.G * NTHR) { const int k = i >> 7, t = i & 127; const float x = (float)((k * t) & 127) * (1.0f / 64.0f); ft[i] = (bf16)f2bf(cospif(x)); ft[16384 + i] = (bf16)f2bf(sinpif(x)); }
      bf16* mf = ft + 32768;
      for (int i = gt; i < 4 * 4 * 16 * 64 * 8; i += C.G * NTHR) { const int j8 = i & 7, ln = (i >> 3) & 63, fr = (i >> 9) & 15, gq = (i >> 13) & 3, l = i >> 15;
          const int ei = fr >> 2, ks2 = fr & 3, e = 16 * ei + (ln & 15), g = ln >> 4, c = 32 * (ks2 & 1) + 16 * (j8 >> 2) + 4 * g + (j8 & 3), part = ks2 >> 1;
          const float* w = pbmix + ((size_t)(l * 4 + gq) * 64) * 64 + e; float s = 0.f;
          for (int cp = 0; cp < 64; ++cp) { const float x = (float)((c * cp) & 63) * (1.0f / 32.0f); s += (part ? sinpif(x) : cospif(x)) * w[cp * 64]; }
          mf[i] = (bf16)f2bf(s * (1.0f / 1024.0f)); } }
    { const int gt = C.wg * NTHR + C.tid; const float* pg2 = a.in[I_DG2]; const float* prw = a.in[I_RW]; bf16* g2t = (bf16*)(C.ws + WS_G2T); bf16* rwt = (bf16*)(C.ws + WS_RWT);
      for (int i = gt; i < 4 * 256 * 160; i += C.G * NTHR) { const int ii = i % 160, c = (i / 160) & 255, l = i / (160 * 256); g2t[i] = (bf16)f2bf(pg2[((size_t)l * 160 + ii) * 256 + c]); }
      for (int i = gt; i < 4 * 32 * 1024; i += C.G * NTHR) { const int k = i & 1023, e = (i >> 10) & 31, l = i >> 15; rwt[i] = (bf16)f2bf(prw[((size_t)l * 1024 + k) * 32 + e]); } }
    { const int gt = C.wg * NTHR + C.tid; const float* pw2 = a.in[I_DW2]; const float* pa2 = a.in[I_DA2]; bf16* lt = (bf16*)(C.ws + WS_LORAT);
      for (int i = gt; i < 4 * 4 * 256 * 64; i += C.G * NTHR) { const int ii = i & 63, c = (i >> 6) & 255, q = (i >> 14) & 3, l = i >> 16;
          const float* src = (q < 2) ? pw2 : pa2; lt[i] = (bf16)f2bf(src[(((size_t)l * 2 + (q & 1)) * 64 + ii) * 256 + c]); } }
    { bf16* f2 = (bf16*)(C.ws + WS_F256); const int gt = C.wg * NTHR + C.tid;
      for (int i = gt; i < 256 * 256; i += C.G * NTHR) { const int k = i >> 8, t = i & 255; const float x = (float)((k * t) & 255) * (1.0f / 128.0f); f2[i] = (bf16)f2bf(cospif(x)); f2[65536 + i] = (bf16)f2bf(sinpif(x)); } }
    { LAS float* sl = (LAS float*)(C.lds);
      LAS float* red = (LAS float*)(C.lds + 8192);
      __syncthreads();
      const float* pc = a.in[I_C]; const float* pcc = a.in[I_CCTX]; const float* padaw = a.in[I_ADAW]; const float* padab = a.in[I_ADAB];
      for (int i = C.tid; i < 2048; i += NTHR) { const float x = (i < 1024) ? pc[i] : pcc[i - 1024]; sl[i] = x * sigmoidf_(x); }
      __syncthreads();
      float* mod = (float*)(C.ws + WS_MOD);
      for (int u = C.wg; u < 4 * 96; u += C.G) { const int l = u / 96, jb = u % 96, j0 = jb * 64 + C.lane;
          float s0 = 0.f, s1 = 0.f; const float* w = padaw + (size_t)l * DM * 6144 + j0; const int k0 = C.wave * 128;
#pragma unroll 16
          for (int k = 0; k < 128; ++k) { const float wv = w[(size_t)(k0 + k) * 6144]; s0 += wv * sl[k0 + k]; s1 += wv * sl[1024 + k0 + k]; }
          red[(C.wave * 2 + 0) * 64 + C.lane] = s0; red[(C.wave * 2 + 1) * 64 + C.lane] = s1;
          __syncthreads();
          if (C.tid < 128) { const int v = C.tid >> 6, j = C.tid & 63; float s = 0.f;
#pragma unroll
              for (int wv = 0; wv < 8; ++wv) s += red[(wv * 2 + v) * 64 + j];
              mod[(size_t)(l * 2 + v) * 6144 + jb * 64 + j] = s + padab[(size_t)l * 6144 + jb * 64 + j]; }
          __syncthreads(); } }
}

__device__ __forceinline__ void load_row(const float* p, int lane, f32x4 (&v)[4]) {
#pragma unroll
    for (int j = 0; j < 4; ++j) v[j] = *((const f32x4*)p + lane + 64 * j);
}
__device__ __forceinline__ void moe_combine_row(const Ctx& C, int row, f32x4 (&v)[4], const float* gt2) {
    const int* dest = (const int*)(C.ws + WS_ROUTE) + (size_t)3 * ROWS * 4; const float* gate = (const float*)(C.ws + WS_ROUTE) + (size_t)1 * ROWS * 4;
    const bf16* YB = (const bf16*)(C.ws + WS_XG);
    f32x4 s[4];
#pragma unroll
    for (int j = 0; j < 4; ++j) s[j] = (f32x4){0.f, 0.f, 0.f, 0.f};
#pragma unroll
    for (int k = 0; k < 4; ++k) { const int d = dest[row * 4 + k]; const float g = gate[row * 4 + k]; const u32x2* yp = (const u32x2*)(YB + (size_t)d * DM) + C.lane;
#pragma unroll
        for (int j = 0; j < 4; ++j) { const u32x2 w = yp[64 * j]; s[j] += (f32x4){bflo(w.x), bfhi(w.x), bflo(w.y), bfhi(w.y)} * g; } }
#pragma unroll
    for (int j = 0; j < 4; ++j) v[j] += *((const f32x4*)gt2 + C.lane + 64 * j) * s[j];
}
__device__ __forceinline__ float row_rstd(const f32x4 (&v)[4], int lane) {
    float s = 0.f;
#pragma unroll
    for (int j = 0; j < 4; ++j) s += (v[j].x * v[j].x + v[j].y * v[j].y) + (v[j].z * v[j].z + v[j].w * v[j].w);
    return rsqrtf(wave_sum(s, lane) * (1.f / DM) + 1e-6f);
}
__device__ __forceinline__ void norm1_fetch(const Ctx& C, const float* src_row, int row, bool combine, const float* gt2, f32x4 (&v)[4]) {
    load_row(src_row, C.lane, v);
    if (combine) moe_combine_row(C, row, v, gt2);
}
__device__ __forceinline__ void phase_norm1(const Ctx& C, const DArgs& a, int l) {
    float* XS = (float*)(C.ws + WS_XS); bf16* H = (bf16*)(C.ws + WS_H); const float* mod = (const float*)(C.ws + WS_MOD);
    const float* g1 = a.in[I_N1G] + (size_t)l * DM;
    const float* pctx = a.in[I_CTX]; const float* px = a.in[I_X];
    for (int row0 = C.gw; row0 < ROWS; row0 += 2 * C.NGW) {
        f32x4 v[2][4]; const int rows[2] = {row0, row0 + C.NGW};
#pragma unroll
        for (int q = 0; q < 2; ++q) if (rows[q] < ROWS) { const int row = rows[q]; const bool isctx = row < NCTX;
            const float* src = (l == 0) ? (isctx ? pctx + (size_t)row * DM : px + (size_t)(row - NCTX) * DM) : XS + (size_t)row * DM;
            norm1_fetch(C, src, row, l > 0, mod + (size_t)((l > 0 ? l - 1 : 0) * 2 + (isctx ? 1 : 0)) * 6144 + 5 * DM, v[q]); }
#pragma unroll
        for (int q = 0; q < 2; ++q) if (rows[q] < ROWS) { const int row = rows[q]; const bool isctx = row < NCTX;
#pragma unroll
            for (int j = 0; j < 4; ++j) *((f32x4*)(XS + (size_t)row * DM) + C.lane + 64 * j) = v[q][j];
            const float rstd = row_rstd(v[q], C.lane);
            const float* md = mod + (size_t)(l * 2 + (isctx ? 1 : 0)) * 6144;
            u32x2* o = (u32x2*)(H + (size_t)row * DM) + C.lane;
#pragma unroll
            for (int j = 0; j < 4; ++j) { const f32x4 g = *((const f32x4*)g1 + C.lane + 64 * j), sh = *((const f32x4*)md + C.lane + 64 * j), sc = *((const f32x4*)(md + DM) + C.lane + 64 * j);
                const f32x4 y = v[q][j] * rstd * g * (sc + 1.0f) + sh; u32x2 w; w.x = pk2(y.x, y.y); w.y = pk2(y.z, y.w); o[64 * j] = w; } }
    }
}
__device__ __forceinline__ void phase_final(const Ctx& C, const DArgs& a) {
    const float* XS = (const float*)(C.ws + WS_XS); const float* mod = (const float*)(C.ws + WS_MOD); const float* g = a.in[I_FNG];
    const float* gt2 = mod + (size_t)((DEPTH - 1) * 2 + 0) * 6144 + 5 * DM;
    for (int row0 = NCTX + C.gw; row0 < ROWS; row0 += 2 * C.NGW) {
        f32x4 v[2][4]; const int rows[2] = {row0, row0 + C.NGW};
#pragma unroll
        for (int q = 0; q < 2; ++q) if (rows[q] < ROWS) norm1_fetch(C, XS + (size_t)rows[q] * DM, rows[q], true, gt2, v[q]);
#pragma unroll
        for (int q = 0; q < 2; ++q) if (rows[q] < ROWS) { const float rstd = row_rstd(v[q], C.lane); float* o = a.out + (size_t)(rows[q] - NCTX) * DM;
#pragma unroll
            for (int j = 0; j < 4; ++j) *((f32x4*)o + C.lane + 64 * j) = v[q][j] * rstd * *((const f32x4*)g + C.lane + 64 * j); }
    }
}
constexpr int NR2 = 9;
__device__ __forceinline__ void phase_norm2(const Ctx& C, const DArgs& a, int l) {
    const float* XS = (const float*)(C.ws + WS_XS); bf16* H = (bf16*)(C.ws + WS_H); const float* mod = (const float*)(C.ws + WS_MOD);
    const float* g2 = a.in[I_N2G] + (size_t)l * DM; const float* rb = a.in[I_RB] + (size_t)l * NEXP; const bf16* rwt = (const bf16*)(C.ws + WS_RWT) + (size_t)l * NEXP * DM;
    int* tok_e = (int*)(C.ws + WS_ROUTE); float* gate = (float*)(C.ws + WS_ROUTE) + (size_t)1 * ROWS * 4; int* slot = (int*)(C.ws + WS_ROUTE) + (size_t)2 * ROWS * 4;
    LAS float* lg = (LAS float*)(C.lds + C.wave * 4096);
    LAS int* hist = (LAS int*)(C.lds + MISC_OFF + 64);
    const int lane = C.lane, li = lane & 15, g = lane >> 4;
    if (C.tid < NEXP) hist[C.tid] = 0;
    __syncthreads();
    const int row_base = (l == DEPTH - 1) ? NCTX : 0, ntile = (ROWS - row_base + NR2 - 1) / NR2;
    for (int tl = C.gw; tl < ntile; tl += C.NGW) {
        const int trow0 = row_base + NR2 * tl, nrow = (ROWS - trow0 < NR2) ? ROWS - trow0 : NR2;
#pragma unroll 1
        for (int rr = 0; rr < nrow; ++rr) { const int row = trow0 + rr; const bool isctx = row < NCTX; f32x4 v[4]; load_row(XS + (size_t)row * DM, lane, v);
            const float rstd = row_rstd(v, lane);
            const float* md = mod + (size_t)(l * 2 + (isctx ? 1 : 0)) * 6144 + 3 * DM;
            u32x2* o = (u32x2*)(H + (size_t)row * DM) + lane;
#pragma unroll
            for (int j = 0; j < 4; ++j) { const f32x4 gg = *((const f32x4*)g2 + lane + 64 * j), sh = *((const f32x4*)md + lane + 64 * j), sc = *((const f32x4*)(md + DM) + lane + 64 * j);
                const f32x4 y = v[j] * rstd * gg * (sc + 1.0f) + sh; u32x2 w; w.x = pk2(y.x, y.y); w.y = pk2(y.z, y.w); o[64 * j] = w; } }
        asm volatile("s_waitcnt vmcnt(0)" ::: "memory");
        f32x4 acc0 = {0.f, 0.f, 0.f, 0.f}, acc1 = {0.f, 0.f, 0.f, 0.f};
        const int arow = (trow0 + li < ROWS) ? trow0 + li : ROWS - 1;
        const bf16* ap = H + (size_t)arow * DM + 8 * g; const bf16* bp0 = rwt + (size_t)li * DM + 8 * g; const bf16* bp1 = bp0 + 16 * DM;
#pragma unroll 4
        for (int ks = 0; ks < 32; ++ks) { const bf16x8 af = *(const bf16x8*)(ap + 32 * ks); acc0 = mfma16(af, *(const bf16x8*)(bp0 + 32 * ks), acc0); acc1 = mfma16(af, *(const bf16x8*)(bp1 + 32 * ks), acc1); }
#pragma unroll
        for (int r = 0; r < 4; ++r) { lg[(4 * g + r) * 33 + li] = acc0[r]; lg[(4 * g + r) * 33 + 16 + li] = acc1[r]; }
        LDS_WAIT(); asm volatile("" ::: "memory");
        const int e = lane & 31; const float rbe = rb[e];
#pragma unroll 1
        for (int rr = 0; rr < nrow; ++rr) { const int row = trow0 + rr;
            float val = lg[rr * 33 + e] + rbe; int te[4]; float tv[4];
#pragma unroll
            for (int k = 0; k < 4; ++k) { float bv = val; int bi = e;
#define AMAX_ROR(n) { const float ov = __builtin_bit_cast(float, __builtin_amdgcn_update_dpp(0, __builtin_bit_cast(int, bv), 0x120 + (n), 0xf, 0xf, false)); const int oi = __builtin_amdgcn_update_dpp(0, bi, 0x120 + (n), 0xf, 0xf, false); \
                    if (ov > bv || (ov == bv && oi < bi)) { bv = ov; bi = oi; } }
                AMAX_ROR(8) AMAX_ROR(4) AMAX_ROR(2) AMAX_ROR(1)
#undef AMAX_ROR
                { const float ov = shx(bv, 16, lane); const int oi = shxi(bi, 16, lane); if (ov > bv || (ov == bv && oi < bi)) { bv = ov; bi = oi; } }
                te[k] = bi; tv[k] = bv; if (e == bi) val = -3.0e38f; }
            if (lane == 0) { const float m = tv[0]; float p[4], ps = 0.f;
#pragma unroll
                for (int k = 0; k < 4; ++k) { p[k] = __expf(tv[k] - m); ps += p[k]; }
#pragma unroll
                for (int k = 0; k < 4; ++k) { tok_e[row * 4 + k] = te[k]; gate[row * 4 + k] = p[k] / ps; slot[row * 4 + k] = __hip_atomic_fetch_add(&hist[te[k]], 1, __ATOMIC_RELAXED, __HIP_MEMORY_SCOPE_WORKGROUP); } } }
        asm volatile("" ::: "memory");
    }
    __syncthreads();
    if (C.tid < NEXP) ((int*)(C.ws + WS_CNT))[C.wg * NEXP + C.tid] = hist[C.tid];
}
__device__ __forceinline__ int moe_tables(const Ctx& C) {
    const int* cnt = (const int*)(C.ws + WS_CNT);
    LAS int* part = (LAS int*)(C.lds);
    LAS int* pstart = (LAS int*)(C.lds + MISC_OFF + 256); LAS int* wgbase = pstart + 40; LAS int* tot = wgbase + 32; LAS int* nblk_s = tot + 32;
    LAS unsigned char* blk_e = (LAS unsigned char*)(C.lds + MISC_OFF + 1024);
    __syncthreads();
    { const int e = C.tid & 31, p = C.tid >> 5; int t = 0, pre = 0;
#pragma unroll 1
      for (int w = p * 16; w < p * 16 + 16; ++w) { const int c = cnt[w * NEXP + e]; t += c; if (w < C.wg) pre += c; }
      part[(p * 32 + e) * 2] = t; part[(p * 32 + e) * 2 + 1] = pre; }
    __syncthreads();
    if (C.tid < NEXP) { int t = 0, pre = 0;
#pragma unroll 1
        for (int p = 0; p < 16; ++p) { t += part[(p * 32 + C.tid) * 2]; pre += part[(p * 32 + C.tid) * 2 + 1]; }
        tot[C.tid] = t; wgbase[C.tid] = pre; }
    __syncthreads();
    if (C.tid == 0) { int b = 0;
#pragma unroll 1
        for (int e = 0; e < NEXP; ++e) { pstart[e] = b * 256; b += (tot[e] + 255) >> 8; }
        pstart[NEXP] = b * 256; nblk_s[0] = b; }
    __syncthreads();
    if (C.tid < NEXP) wgbase[C.tid] += pstart[C.tid];
    if (C.tid < MOE_MAXBLK) { int e = 0;
#pragma unroll 1
        for (int k = 1; k < NEXP; ++k) if (pstart[k] <= C.tid * 256) e = k;
        blk_e[C.tid] = (unsigned char)e; }
    __syncthreads();
    return __builtin_amdgcn_readfirstlane(nblk_s[0]);
}
__device__ __forceinline__ void phase_gather(const Ctx& C, const DArgs& a, int l) {
    moe_tables(C);
    const LAS int* wgbase = (const LAS int*)(C.lds + MISC_OFF + 256) + 40;
    const int* tok_e = (const int*)(C.ws + WS_ROUTE); const int* slot = (const int*)(C.ws + WS_ROUTE) + (size_t)2 * ROWS * 4; int* dest = (int*)(C.ws + WS_ROUTE) + (size_t)3 * ROWS * 4;
    const bf16* H = (const bf16*)(C.ws + WS_H); unsigned char* XG = C.ws + WS_XG8;
    const int row_base = (l == DEPTH - 1) ? NCTX : 0, ntile = (ROWS - row_base + NR2 - 1) / NR2;
    for (int tl = C.gw; tl < ntile; tl += C.NGW)
    for (int row = row_base + NR2 * tl; row < row_base + NR2 * tl + NR2 && row < ROWS; ++row) {
        const u32x4* src = (const u32x4*)(H + (size_t)row * DM) + C.lane; const u32x4 v0 = src[0], v1 = src[64];
        u32x2 q0, q1;
        { unsigned w = 0; w = __builtin_amdgcn_cvt_pk_fp8_f32(bflo(v0.x) * pg8::X8_S, bfhi(v0.x) * pg8::X8_S, w, false); w = __builtin_amdgcn_cvt_pk_fp8_f32(bflo(v0.y) * pg8::X8_S, bfhi(v0.y) * pg8::X8_S, w, true); q0.x = w;
          w = 0; w = __builtin_amdgcn_cvt_pk_fp8_f32(bflo(v0.z) * pg8::X8_S, bfhi(v0.z) * pg8::X8_S, w, false); w = __builtin_amdgcn_cvt_pk_fp8_f32(bflo(v0.w) * pg8::X8_S, bfhi(v0.w) * pg8::X8_S, w, true); q0.y = w;
          w = 0; w = __builtin_amdgcn_cvt_pk_fp8_f32(bflo(v1.x) * pg8::X8_S, bfhi(v1.x) * pg8::X8_S, w, false); w = __builtin_amdgcn_cvt_pk_fp8_f32(bflo(v1.y) * pg8::X8_S, bfhi(v1.y) * pg8::X8_S, w, true); q1.x = w;
          w = 0; w = __builtin_amdgcn_cvt_pk_fp8_f32(bflo(v1.z) * pg8::X8_S, bfhi(v1.z) * pg8::X8_S, w, false); w = __builtin_amdgcn_cvt_pk_fp8_f32(bflo(v1.w) * pg8::X8_S, bfhi(v1.w) * pg8::X8_S, w, true); q1.y = w; }
#pragma unroll
        for (int k = 0; k < 4; ++k) { const int d = wgbase[tok_e[row * 4 + k]] + slot[row * 4 + k]; if (C.lane == 0) dest[row * 4 + k] = d;
            u32x2* dp = (u32x2*)(XG + (size_t)d * DM) + C.lane; dp[0] = q0; dp[64] = q1; }
    }
}

__device__ __forceinline__ void mix1_rope(const Ctx& C) {
    bf16* P = (bf16*)(C.ws + WS_P);
    const long total = (long)SEQ * 192;
    for (long i = (long)C.wg * NTHR + C.tid; i < total; i += (long)C.G * NTHR) {
        const int j = (int)(i & 31), hh = (int)((i >> 5) % 6), t = (int)(i / 192);
        const int col = (hh < 4) ? (C_AQ + hh * 64) : (C_AK + (hh - 4) * 64);
        const float pos = (j < 16) ? (float)(t >> 6) : (float)(t & 63);
        const float inv = __powf(10000.0f, -(float)(j & 15) * (1.0f / 16.0f));
        const float ang = pos * inv * 0.31830988618379067f;
        const float cs = cospif(ang), sn = sinpif(ang);
        bf16* p = P + (size_t)(NCTX + t) * INWP + col;
        const float x1 = bf2f(p[j]), x2 = bf2f(p[j + 32]);
        p[j] = (bf16)f2bf(x1 * cs - x2 * sn); p[j + 32] = (bf16)f2bf(x2 * cs + x1 * sn);
    }
}
__device__ __forceinline__ void mix1_vt(const Ctx& C) {
    const bf16* P = (const bf16*)(C.ws + WS_P);
    LAS unsigned short* scr = (LAS unsigned short*)(C.lds + C.wave * 16384);
    for (int u = C.gw; u < (ROWS / 64) * 6; u += C.NGW) {
        const int hd = u % 6, tb = u / 6; const int vcol = (hd < 2) ? (C_AV + hd * 64) : (C_CV + (hd - 2) * 64);
        bf16* VT = ((hd < 2) ? (bf16*)(C.ws + WS_VTA) + (size_t)hd * 64 * VTP : (bf16*)(C.ws + WS_VTC) + (size_t)(hd - 2) * 64 * VTP);
#pragma unroll
        for (int i = 0; i < 8; ++i) { const int tk = (C.lane >> 3) + 8 * i, ch = C.lane & 7; const u32x4 w = *(const u32x4*)(P + (size_t)(tb * 64 + tk) * INWP + vcol + 8 * ch);
            LAS unsigned* d = (LAS unsigned*)(scr + tk * 66 + 8 * ch); d[0] = w.x; d[1] = w.y; d[2] = w.z; d[3] = w.w; }
        LDS_WAIT(); asm volatile("" ::: "memory");
#pragma unroll
        for (int k8 = 0; k8 < 8; ++k8) { unsigned w[4];
#pragma unroll
            for (int e2 = 0; e2 < 4; ++e2) { const unsigned lo = scr[(8 * k8 + 2 * e2) * 66 + C.lane], hi = scr[(8 * k8 + 2 * e2 + 1) * 66 + C.lane]; w[e2] = lo | (hi << 16); }
            *(u32x4*)(VT + (size_t)C.lane * VTP + tb * 64 + 8 * k8) = (u32x4){w[0], w[1], w[2], w[3]}; }
        LDS_WAIT(); asm volatile("" ::: "memory");
    }
    for (int i = C.wg * NTHR + C.tid; i < 6 * 64 * 32; i += C.G * NTHR) { const int rowi = i >> 5, pc = i & 31; const int hd = rowi >> 6, d = rowi & 63;
        bf16* VT = ((hd < 2) ? (bf16*)(C.ws + WS_VTA) + (size_t)hd * 64 * VTP : (bf16*)(C.ws + WS_VTC) + (size_t)(hd - 2) * 64 * VTP);
        *(u32x4*)(VT + (size_t)d * VTP + ROWS + 8 * pc) = (u32x4){0u, 0u, 0u, 0u}; }
}
__device__ __forceinline__ float conv3(const bf16* P, int row, int col, const float* cw, int cc) {
    const bool first = (row == 0) || (row == NCTX), last = (row == NCTX - 1) || (row == ROWS - 1);
    float s = cw[768 + cc] * bf2f(P[(size_t)row * INWP + col]);
    if (!first) s += cw[cc] * bf2f(P[(size_t)(row - 1) * INWP + col]);
    if (!last) s += cw[2 * 768 + cc] * bf2f(P[(size_t)(row + 1) * INWP + col]);
    return s;
}
__device__ __forceinline__ void mix1_rwkv_prep(const Ctx& C, const DArgs& a, int l) {
    const bf16* P = (const bf16*)(C.ws + WS_P); float* SC = (float*)(C.ws + WS_SC);
    constexpr int LBP = 264;
    LAS unsigned char* lob = C.lds;
    LAS float* pre = (LAS float*)(C.lds + 16384);
    const bf16* lorat = (const bf16*)(C.ws + WS_LORAT) + (size_t)l * 4 * 256 * 64;
    const float* cw = a.in[I_DCONV] + (size_t)l * 3 * 768;
    const float* w0 = a.in[I_DW0] + (size_t)l * 512; const float* a0 = a.in[I_DA0] + (size_t)l * 512;
    const float* kkw = a.in[I_DKK] + (size_t)l * 256; const float* kaw = a.in[I_DKA] + (size_t)l * 256;
    const int half = C.tid >> 8, c = C.tid & 255, lane = C.lane, li = lane & 15, g = lane >> 4;
    const float kkc = kkw[c], kac = kaw[c];
    for (int grp = C.wg; grp < ROWS / 13; grp += C.G) {
        const int row0 = 13 * grp + 7 * half, nj = 7 - half;
        __syncthreads();
#pragma unroll
        for (int j = 0; j < 7; ++j) if (j < nj) { const float x = bf2f(P[(size_t)(row0 + j) * INWP + C_WL + c]); *(LAS bf16*)(lob + ((7 * half + j) * LBP + c) * 2) = (bf16)f2bf((c < 128) ? tanhf(x) : x); }
        __syncthreads();
#pragma unroll
        for (int q = 0; q < 4; ++q) { const bf16x8 a0f = ldA(lob, LBP, 0, 64 * q, li, g), a1f = ldA(lob, LBP, 0, 64 * q + 32, li, g);
#pragma unroll
            for (int c2 = 0; c2 < 2; ++c2) { const int ci = 2 * C.wave + c2; const bf16* bp = lorat + ((size_t)q * 256 + 16 * ci + li) * 64 + 8 * g;
                f32x4 acc = {0.f, 0.f, 0.f, 0.f}; acc = mfma16(a0f, ldg8(bp), acc); acc = mfma16(a1f, ldg8(bp + 32), acc);
#pragma unroll
                for (int r = 0; r < 4; ++r) pre[(q * 16 + 4 * g + r) * 256 + 16 * ci + li] = acc[r]; } }
        __syncthreads();
        float xr[9], xk[9], xv[9];
#pragma unroll
        for (int q = 0; q < 9; ++q) { const int rw = row0 - 1 + q; const bool in = (rw >= 0) && (rw < ROWS) && (q <= nj + 1);
            const bf16* pp = P + (size_t)(in ? rw : row0) * INWP; xr[q] = in ? bf2f(pp[C_DR + c]) : 0.f; xk[q] = in ? bf2f(pp[C_DK + c]) : 0.f; xv[q] = in ? bf2f(pp[C_DV + c]) : 0.f; }
        const float cr0 = cw[c], cr1 = cw[768 + c], cr2 = cw[1536 + c], ck0 = cw[256 + c], ck1 = cw[768 + 256 + c], ck2 = cw[1536 + 256 + c], cv0 = cw[512 + c], cv1 = cw[768 + 512 + c], cv2 = cw[1536 + 512 + c];
#pragma unroll
        for (int j = 0; j < 7; ++j) if (j < nj) { const int row = row0 + j, rl = 7 * half + j;
            const bool first = (row == 0) || (row == NCTX), last = (row == NCTX - 1) || (row == ROWS - 1);
            const float m0 = first ? 0.f : 1.f, m2 = last ? 0.f : 1.f;
            const float r = cr1 * xr[j + 1] + m0 * cr0 * xr[j] + m2 * cr2 * xr[j + 2], k = ck1 * xk[j + 1] + m0 * ck0 * xk[j] + m2 * ck2 * xk[j + 2], v = cv1 * xv[j + 1] + m0 * cv0 * xv[j] + m2 * cv2 * xv[j + 2];
            float kk = k * kkc; const float n2 = wave_sum(kk * kk, lane); kk *= rsqrtf(fmaxf(n2, 1e-24f));
            float* sc = SC + (size_t)row * 9 * 256; sc[c] = r; sc[256 + c] = v; sc[512 + c] = -kk;
#pragma unroll
            for (int d = 0; d < 2; ++d) { const float wp = w0[d * 256 + c] + pre[(d * 16 + rl) * 256 + c], ap = a0[d * 256 + c] + pre[((2 + d) * 16 + rl) * 256 + c];
                const float nw = -wp, sp = fmaxf(nw, 0.f) + log1pf(__expf(-fabsf(nw)));
                const float lw = -__expf(-sp - 0.5f);
                const float as = sigmoidf_(ap);
                sc[(3 + 3 * d) * 256 + c] = lw; sc[(4 + 3 * d) * 256 + c] = k * (1.0f + (as - 1.0f) * kac); sc[(5 + 3 * d) * 256 + c] = kk * as; } }
    }
    __syncthreads();
}
constexpr int FP = 136;
constexpr int F_TABC = 0, F_TABS = 128 * FP * 2, F_TILE = 2 * 128 * FP * 2;
__device__ __forceinline__ void fourier_load_tables(const Ctx& C) {
    const bf16* ft = (const bf16*)(C.ws + WS_FTAB);
    for (int i = C.tid; i < 2 * 128 * 16; i += NTHR) { const int tb = i >> 11, r = (i >> 4) & 127, c8 = i & 15;
        *(LAS u32x4*)(C.lds + tb * F_TABS + (r * FP + 8 * c8) * 2) = *(const u32x4*)(ft + tb * 16384 + r * 128 + 8 * c8); }
}
__device__ __forceinline__ void mix1_fourier1(const Ctx& C) {
    const bf16* P = (const bf16*)(C.ws + WS_P); const float* tw = (const float*)(C.ws + WS_TW);
    bf16* FYR = (bf16*)(C.ws + WS_FYR); bf16* FYI = (bf16*)(C.ws + WS_FYI);
    const int lane = C.lane, li = lane & 15, g = lane >> 4, w = C.wave;
    __syncthreads();
    fourier_load_tables(C);
    for (int u = C.wg; u < 256; u += C.G) {
        const int t2 = u >> 1, ch0 = (u & 1) * 128;
        __syncthreads();
        for (int i = C.tid; i < 128 * 16; i += NTHR) { const int t1 = i >> 4, c8 = i & 15;
            *(LAS u32x4*)(C.lds + F_TILE + (t1 * FP + 8 * c8) * 2) = *(const u32x4*)(P + (size_t)(NCTX + 128 * t1 + t2) * INWP + C_BU + ch0 + 8 * c8); }
        __syncthreads();
        bf16x8 af[4];
#pragma unroll
        for (int ks = 0; ks < 4; ++ks) af[ks] = ldT(C.lds + F_TILE, FP, 32 * ks, 16 * w, li, g);
#pragma unroll 1
        for (int ni = 0; ni < 8; ++ni) { f32x4 dc = {0.f, 0.f, 0.f, 0.f}, ds = {0.f, 0.f, 0.f, 0.f};
#pragma unroll
            for (int ks = 0; ks < 4; ++ks) { dc = mfma16(af[ks], ldA(C.lds + F_TABC, FP, 16 * ni, 32 * ks, li, g), dc); ds = mfma16(af[ks], ldA(C.lds + F_TABS, FP, 16 * ni, 32 * ks, li, g), ds); }
            const int k1 = 16 * ni + li; const float cp = tw[t2 * k1], sp = tw[16384 + t2 * k1];
            const f32x4 yr = dc * cp - ds * sp, yi = -(ds * cp) - dc * sp;
            const size_t o = ((size_t)k1 * 128 + t2) * 256 + ch0 + 16 * w + 4 * g;
            u32x2 wr; wr.x = pk2(yr[0], yr[1]); wr.y = pk2(yr[2], yr[3]); *(u32x2*)(FYR + o) = wr;
            u32x2 wi; wi.x = pk2(yi[0], yi[1]); wi.y = pk2(yi[2], yi[3]); *(u32x2*)(FYI + o) = wi; }
    }
    __syncthreads();
}
__device__ __forceinline__ void fourier2_mfma(const Ctx& C, int l, int wg0) {
    const bf16* FYR = (const bf16*)(C.ws + WS_FYR); const bf16* FYI = (const bf16*)(C.ws + WS_FYI); bf16* MIX = (bf16*)(C.ws + WS_MIX);
    const int lane = C.lane, li = lane & 15, g = lane >> 4, w = C.wave;
    constexpr int YP = 72, F_YR = F_TILE, F_YI = F_TILE + 128 * YP * 2;
    __syncthreads();
    fourier_load_tables(C);
    for (int u = C.wg - wg0; u < 512; u += C.G - wg0) {
        const int k1 = u >> 2, gq = u & 3;
        __syncthreads();
        for (int i = C.tid; i < 2 * 128 * 8; i += NTHR) { const int im = i >> 10, t2 = (i >> 3) & 127, c8 = i & 7;
            *(LAS u32x4*)(C.lds + (im ? F_YI : F_YR) + (t2 * YP + 8 * c8) * 2) = *(const u32x4*)((im ? FYI : FYR) + ((size_t)k1 * 128 + t2) * 256 + gq * 64 + 8 * c8); }
        __syncthreads();
        bf16x8 bc[4], bs[4];
#pragma unroll
        for (int ks = 0; ks < 4; ++ks) { bc[ks] = ldA(C.lds + F_TABC, FP, 16 * w, 32 * ks, li, g); bs[ks] = ldA(C.lds + F_TABS, FP, 16 * w, 32 * ks, li, g); }
        f32x4 xr[4], xi[4];
#pragma unroll
        for (int ci = 0; ci < 4; ++ci) { xr[ci] = (f32x4){0.f, 0.f, 0.f, 0.f}; f32x4 xs = {0.f, 0.f, 0.f, 0.f}; xi[ci] = xs;
#pragma unroll
            for (int ks = 0; ks < 4; ++ks) { const bf16x8 ar = ldT(C.lds + F_YR, YP, 32 * ks, 16 * ci, li, g), ai = ldT(C.lds + F_YI, YP, 32 * ks, 16 * ci, li, g);
                xr[ci] = mfma16(ar, bc[ks], xr[ci]); xr[ci] = mfma16(ai, bs[ks], xr[ci]);
                xi[ci] = mfma16(ai, bc[ks], xi[ci]); xs = mfma16(ar, bs[ks], xs); }
            xi[ci] = xi[ci] - xs; }
        union { bf16x8 v; unsigned q[4]; } xb[4];
#pragma unroll
        for (int q2 = 0; q2 < 2; ++q2) { xb[q2].q[0] = pk2(xr[2 * q2][0], xr[2 * q2][1]); xb[q2].q[1] = pk2(xr[2 * q2][2], xr[2 * q2][3]); xb[q2].q[2] = pk2(xr[2 * q2 + 1][0], xr[2 * q2 + 1][1]); xb[q2].q[3] = pk2(xr[2 * q2 + 1][2], xr[2 * q2 + 1][3]);
            xb[2 + q2].q[0] = pk2(xi[2 * q2][0], xi[2 * q2][1]); xb[2 + q2].q[1] = pk2(xi[2 * q2][2], xi[2 * q2][3]); xb[2 + q2].q[2] = pk2(xi[2 * q2 + 1][0], xi[2 * q2 + 1][1]); xb[2 + q2].q[3] = pk2(xi[2 * q2 + 1][2], xi[2 * q2 + 1][3]); }
        const bf16x8* mf = (const bf16x8*)((const bf16*)(C.ws + WS_FTAB) + 32768) + (size_t)(l * 4 + gq) * 16 * 64;
#pragma unroll
        for (int ei = 0; ei < 4; ++ei) { f32x4 o = {0.f, 0.f, 0.f, 0.f};
#pragma unroll
            for (int ks2 = 0; ks2 < 4; ++ks2) o = mfma16(mf[(ei * 4 + ks2) * 64 + lane], xb[ks2].v, o);
            const int tp = k1 + 128 * (16 * w + li);
            u32x2 wo; wo.x = pk2(o[0], o[1]); wo.y = pk2(o[2], o[3]); *(u32x2*)(MIX + (size_t)(NCTX + tp) * DM + 256 + gq * 64 + 16 * ei + 4 * g) = wo; }
    }
    __syncthreads();
}

constexpr float LOG2E = 1.4426950408889634f;
typedef short bf16x4 __attribute__((ext_vector_type(4)));
__device__ __forceinline__ void attn_load(const bf16* P, const bf16* VT, int krow, int kcol, int li, int g, bf16x8 (&kf)[2][2], bf16x8 (&vf)[4]) {
#pragma unroll
    for (int t = 0; t < 2; ++t)
#pragma unroll
        for (int ks = 0; ks < 2; ++ks) kf[t][ks] = ldg8(P + (size_t)(krow + 16 * t + li) * INWP + kcol + 32 * ks + 8 * g);
#pragma unroll
    for (int dt = 0; dt < 4; ++dt) { const bf16* vp = VT + (size_t)(dt * 16 + li) * VTP + krow + 4 * g;
        const bf16x4 a = *(const bf16x4*)vp, b = *(const bf16x4*)(vp + 16); vf[dt] = (bf16x8){a[0], a[1], a[2], a[3], b[0], b[1], b[2], b[3]}; }
}
template <int NS, int NT>
__device__ __forceinline__ void attn_compute(const bf16x8 (&kf)[2][2], const bf16x8 (&vf)[4], const bf16x8 (&qf)[NS][2], f32x4 (&o)[NS][4], float (&m)[NS], float (&ls)[NS],
                                             const float (&add)[NT][2][4], int li, int g) {
#pragma unroll
    for (int hh = 0; hh < NS; ++hh) {
        f32x4 st[2];
#pragma unroll
        for (int t = 0; t < 2; ++t) { st[t] = (f32x4){0.f, 0.f, 0.f, 0.f};
#pragma unroll
            for (int ks = 0; ks < 2; ++ks) st[t] = __builtin_amdgcn_mfma_f32_16x16x32_bf16(kf[t][ks], qf[hh][ks], st[t], 0, 0, 0); }
        float s[8]; float bm = -INFINITY;
#pragma unroll
        for (int t = 0; t < 2; ++t)
#pragma unroll
            for (int r = 0; r < 4; ++r) { const float ad = add[hh / (NS / NT)][t][r]; s[4 * t + r] = (ad == -INFINITY) ? -INFINITY : st[t][r] * (0.125f * LOG2E) + ad; bm = fmaxf(bm, s[4 * t + r]); }
        bm = fmaxf(bm, shx(bm, 16, 16 * g + li)); bm = fmaxf(bm, shx(bm, 32, 16 * g + li));
        const float mn = fmaxf(m[hh], bm), corr = __builtin_amdgcn_exp2f(m[hh] - mn); m[hh] = mn;
        float ps = 0.f; float pe[8];
#pragma unroll
        for (int e = 0; e < 8; ++e) { pe[e] = __builtin_amdgcn_exp2f(s[e] - mn); ps += pe[e]; }
        ls[hh] = ls[hh] * corr + ps;
        union { bf16x8 v; unsigned u[4]; } pf;
#pragma unroll
        for (int e2 = 0; e2 < 4; ++e2) pf.u[e2] = pk2(pe[2 * e2], pe[2 * e2 + 1]);
#pragma unroll
        for (int dt = 0; dt < 4; ++dt) { o[hh][dt] = o[hh][dt] * corr; o[hh][dt] = __builtin_amdgcn_mfma_f32_16x16x32_bf16(vf[dt], pf.v, o[hh][dt], 0, 0, 0); }
    }
}
__device__ __forceinline__ void attn_finish1(bf16* MIX, int qrow0, int ocol, f32x4 (&o)[4], float m, float ls, bool has_sink, float sink2, int li, int g) {
    float l = ls; l += shx(l, 16, 16 * g + li); l += shx(l, 32, 16 * g + li);
    float corr = 1.f;
    if (has_sink) { const float mn = fmaxf(m, sink2); corr = __builtin_amdgcn_exp2f(m - mn); l = l * corr + __builtin_amdgcn_exp2f(sink2 - mn); }
    const float inv = corr / l;
#pragma unroll
    for (int dt = 0; dt < 4; ++dt) { const f32x4 v = o[dt] * inv; u32x2 w; w.x = pk2(v[0], v[1]); w.y = pk2(v[2], v[3]);
        *(u32x2*)(MIX + (size_t)(qrow0 + li) * DM + ocol + dt * 16 + 4 * g) = w; }
}
__device__ __forceinline__ void attnA_unit(const Ctx& C, const float* asink_l, int unit, bool lat) {
    const bf16* P = (const bf16*)(C.ws + WS_P); bf16* MIX = (bf16*)(C.ws + WS_MIX);
    const int li = C.lane & 15, g = C.lane >> 4;
    const int nqp = lat ? SEQ / 32 : NCTX / 32, kvh = unit / nqp, qp = unit % nqp, t0 = qp * 32, qrow0 = (lat ? NCTX : 0) + t0;
    const bf16* VT = (const bf16*)(C.ws + WS_VTA) + (size_t)kvh * 64 * VTP; const int kcol = C_AK + kvh * 64;
    bf16x8 qf[4][2];
#pragma unroll
    for (int s = 0; s < 4; ++s)
#pragma unroll
        for (int ks = 0; ks < 2; ++ks) qf[s][ks] = ldg8(P + (size_t)(qrow0 + 16 * (s >> 1) + li) * INWP + C_AQ + (kvh * 2 + (s & 1)) * 64 + 32 * ks + 8 * g);
    f32x4 o[4][4]; float m[4], ls[4];
#pragma unroll
    for (int s = 0; s < 4; ++s) { m[s] = -1.0e30f; ls[s] = 0.f;
#pragma unroll
        for (int dt = 0; dt < 4; ++dt) o[s][dt] = (f32x4){0.f, 0.f, 0.f, 0.f}; }
    const int b_lo = lat ? 0 : 9;
#pragma unroll 1
    for (int bb = b_lo; bb < 17; ++bb) { float add[2][2][4]; bf16x8 kf[2][2], vf[4];
        const int krow = (bb < 9) ? NCTX + t0 - 128 + 32 * bb : 32 * (bb - 9);
        attn_load(P, VT, krow, kcol, li, g, kf, vf);
#pragma unroll
        for (int tl = 0; tl < 2; ++tl)
#pragma unroll
            for (int tt = 0; tt < 2; ++tt)
#pragma unroll
                for (int r = 0; r < 4; ++r) { const int j = t0 - 128 + 32 * bb + 16 * tt + 4 * g + r, t = t0 + 16 * tl + li;
                    const bool ok = (bb >= 9) || ((j >= 0) && (j < SEQ) && (j - t <= 128) && (t - j <= 128)); add[tl][tt][r] = ok ? 0.f : -INFINITY; }
        attn_compute<4, 2>(kf, vf, qf, o, m, ls, add, li, g); }
#pragma unroll
    for (int s = 0; s < 4; ++s) attn_finish1(MIX, qrow0 + 16 * (s >> 1), (kvh * 2 + (s & 1)) * 64, o[s], m[s], ls[s], true, asink_l[kvh * 2 + (s & 1)] * LOG2E, li, g);
}
__device__ __forceinline__ void attnC_unit(const Ctx& C, const LAS float* relb, int h, int up, bool lat) {
    const bf16* P = (const bf16*)(C.ws + WS_P); bf16* MIX = (bf16*)(C.ws + WS_MIX);
    const int li = C.lane & 15, g = C.lane >> 4;
    const int rp = up >> 2, cj = up & 3;
    const int t0a = lat ? (2 * rp) * 64 + 16 * cj : 32 * up, tstep = lat ? 64 : 16, qbase = lat ? NCTX : 0;
    const bf16* VT = (const bf16*)(C.ws + WS_VTC) + (size_t)h * 64 * VTP; const int kcol = C_CK + h * 64;
    bf16x8 qf[2][2];
#pragma unroll
    for (int s = 0; s < 2; ++s)
#pragma unroll
        for (int ks = 0; ks < 2; ++ks) qf[s][ks] = ldg8(P + (size_t)(qbase + t0a + tstep * s + li) * INWP + C_CQ + h * 64 + 32 * ks + 8 * g);
    f32x4 o[2][4]; float m[2] = {-1.0e30f, -1.0e30f}, ls[2] = {0.f, 0.f};
#pragma unroll
    for (int s = 0; s < 2; ++s)
#pragma unroll
        for (int dt = 0; dt < 4; ++dt) o[s][dt] = (f32x4){0.f, 0.f, 0.f, 0.f};
    const int r = 2 * rp, cq = cj * 16 + li;
    int r0a = r - 4; r0a = r0a < 0 ? 0 : (r0a > 248 ? 248 : r0a); int r0b = r - 3; r0b = r0b < 0 ? 0 : (r0b > 248 ? 248 : r0b);
    int c0 = cq - 8; c0 = c0 < 0 ? 0 : (c0 > 48 ? 48 : c0);
    const int cw0 = (cj == 0) ? 0 : (cj == 1) ? 8 : (cj == 2) ? 24 : 32;
    const int b_lo = lat ? 0 : 9;
#pragma unroll 1
    for (int bb = b_lo; bb < 17; ++bb) { float add[2][2][4]; bf16x8 kf[2][2], vf[4];
        const int kr = r0a + bb;
        if (bb < 9 && kr >= r0b + 8) continue;
        const int krow = (bb < 9) ? NCTX + kr * 64 + cw0 : 32 * (bb - 9);
        attn_load(P, VT, krow, kcol, li, g, kf, vf);
#pragma unroll
        for (int tl = 0; tl < 2; ++tl) { const int r0t = tl ? r0b : r0a, rt = r + tl; const bool rowok = (bb >= 9) || (kr >= r0t && kr < r0t + 8);
            int bi = kr - rt + 7; bi = bi < 0 ? 0 : (bi > 14 ? 14 : bi); const LAS float* rbp = relb + bi * 31;
#pragma unroll
            for (int tt = 0; tt < 2; ++tt)
#pragma unroll
                for (int rr = 0; rr < 4; ++rr) { const int kc = cw0 + 16 * tt + 4 * g + rr; int ci = kc - cq + 15; ci = ci < 0 ? 0 : (ci > 30 ? 30 : ci); const float bv = rbp[ci];
                    add[tl][tt][rr] = (bb >= 9) ? 0.f : ((rowok && kc >= c0 && kc < c0 + 16) ? bv : -INFINITY); } }
        attn_compute<2, 2>(kf, vf, qf, o, m, ls, add, li, g); }
#pragma unroll
    for (int s = 0; s < 2; ++s) attn_finish1(MIX, qbase + t0a + tstep * s, 512 + h * 64, o[s], m[s], ls[s], false, 0.f, li, g);
}
__device__ __forceinline__ void fourier_ctx_mfma(const Ctx& C, int l, int wg0) {
    const bf16* P = (const bf16*)(C.ws + WS_P); bf16* MIX = (bf16*)(C.ws + WS_MIX); const bf16* f2 = (const bf16*)(C.ws + WS_F256);
    const int lane = C.lane, li = lane & 15, g = lane >> 4, w = C.wave;
    constexpr int UP = 72;
    for (int u = C.wg - wg0; u < 8; u += C.G - wg0) {
        const int tb = u >> 2, gq = u & 3;
        __syncthreads();
        for (int i = C.tid; i < 256 * 8; i += NTHR) { const int t = i >> 3, c8 = i & 7; *(LAS u32x4*)(C.lds + (t * UP + 8 * c8) * 2) = *(const u32x4*)(P + (size_t)t * INWP + C_BU + gq * 64 + 8 * c8); }
        __syncthreads();
        const int tp0 = 128 * tb + 16 * w;
        f32x4 xr[4], xi[4];
#pragma unroll
        for (int ci = 0; ci < 4; ++ci) { xr[ci] = (f32x4){0.f, 0.f, 0.f, 0.f}; xi[ci] = (f32x4){0.f, 0.f, 0.f, 0.f}; }
#pragma unroll 2
        for (int ks = 0; ks < 8; ++ks) { const bf16x8 bc = ldg8(f2 + (size_t)(tp0 + li) * 256 + 32 * ks + 8 * g), bs = ldg8(f2 + 65536 + (size_t)(tp0 + li) * 256 + 32 * ks + 8 * g);
#pragma unroll
            for (int ci = 0; ci < 4; ++ci) { const bf16x8 au = ldT(C.lds, UP, 32 * ks, 16 * ci, li, g); xr[ci] = mfma16(au, bc, xr[ci]); xi[ci] = mfma16(au, bs, xi[ci]); } }
        union { bf16x8 v; unsigned q[4]; } xb[4];
#pragma unroll
        for (int q2 = 0; q2 < 2; ++q2) { xb[q2].q[0] = pk2(xr[2 * q2][0], xr[2 * q2][1]); xb[q2].q[1] = pk2(xr[2 * q2][2], xr[2 * q2][3]); xb[q2].q[2] = pk2(xr[2 * q2 + 1][0], xr[2 * q2 + 1][1]); xb[q2].q[3] = pk2(xr[2 * q2 + 1][2], xr[2 * q2 + 1][3]);
            xb[2 + q2].q[0] = pk2(-xi[2 * q2][0], -xi[2 * q2][1]); xb[2 + q2].q[1] = pk2(-xi[2 * q2][2], -xi[2 * q2][3]); xb[2 + q2].q[2] = pk2(-xi[2 * q2 + 1][0], -xi[2 * q2 + 1][1]); xb[2 + q2].q[3] = pk2(-xi[2 * q2 + 1][2], -xi[2 * q2 + 1][3]); }
        const bf16x8* mf = (const bf16x8*)((const bf16*)(C.ws + WS_FTAB) + 32768) + (size_t)(l * 4 + gq) * 16 * 64;
#pragma unroll
        for (int ei = 0; ei < 4; ++ei) { f32x4 o = {0.f, 0.f, 0.f, 0.f};
#pragma unroll
            for (int ks2 = 0; ks2 < 4; ++ks2) o = mfma16(mf[(ei * 4 + ks2) * 64 + lane], xb[ks2].v, o);
            o = o * 8.0f;
            u32x2 wo; wo.x = pk2(o[0], o[1]); wo.y = pk2(o[2], o[3]); *(u32x2*)(MIX + (size_t)(tp0 + li) * DM + 256 + gq * 64 + 16 * ei + 4 * g) = wo; }
    }
    __syncthreads();
}
__device__ __forceinline__ void fourier2_unit(const Ctx& C, int l, int u, bool ctx) {
    const bf16* P = (const bf16*)(C.ws + WS_P); const float* tw = (const float*)(C.ws + WS_TW); bf16* MIX = (bf16*)(C.ws + WS_MIX);
    const float* FYR = (const float*)(C.ws + WS_FYR); const float* FYI = (const float*)(C.ws + WS_FYI);
    const float* mt = (const float*)(C.ws + WS_MTAB) + (size_t)l * 2 * 4 * 4096;
    LAS float* xr = (LAS float*)(C.lds + 8192); LAS float* xi = xr + 512;
    const int tl = C.tid >> 8, ch = C.tid & 255, tp = 2 * u + tl;
    float sr = 0.f, si = 0.f;
    if (!ctx) { const int k1 = tp & 127, k2 = tp >> 7; const float* yr = FYR + (size_t)k1 * 128 * 256 + ch; const float* yi = FYI + (size_t)k1 * 128 * 256 + ch;
#pragma unroll 8
        for (int t2 = 0; t2 < 128; ++t2) { const int m = ((t2 * k2) & 127) * 128; const float c = tw[m], s = tw[16384 + m]; const float a = yr[t2 * 256], b = yi[t2 * 256]; sr += a * c + b * s; si += b * c - a * s; } }
    else {
#pragma unroll 8
        for (int t = 0; t < NCTX; ++t) { const int m = ((t * tp) & 255) * 64; const float x = bf2f(P[(size_t)t * INWP + C_BU + ch]); sr += x * tw[m]; si -= x * tw[16384 + m]; } }
    __syncthreads();
    xr[tl * 256 + ch] = sr; xi[tl * 256 + ch] = si;
    __syncthreads();
    const int g = ch >> 6, e = ch & 63; const float* mc = mt + (size_t)(0 * 4 + g) * 4096 + e; const float* ms = mt + (size_t)(1 * 4 + g) * 4096 + e;
    const LAS float* xrp = xr + tl * 256 + g * 64; const LAS float* xip = xi + tl * 256 + g * 64; float o = 0.f;
#pragma unroll 8
    for (int c = 0; c < 64; ++c) o += xrp[c] * mc[c * 64] + xip[c] * ms[c * 64];
    o *= ctx ? (1.0f / 128.0f) : (1.0f / 1024.0f);
    MIX[(size_t)((ctx ? 0 : NCTX) + tp) * DM + 256 + ch] = (bf16)f2bf(o);
}
__device__ __forceinline__ void rwkv_passB(const Ctx& C, int b);
__device__ __forceinline__ void phase_mix2(const Ctx& C, const DArgs& a, int l) {
    const bool emit_ctx = l < DEPTH - 1;
#ifndef REPMASK
#define REPMASK 0
#endif
#define NREP2(o) ((((REPMASK) >> (o)) & 1) ? 2 : 1)
    if (C.wg < 8) { for (int r2 = 0; r2 < NREP2(16); ++r2) rwkv_passB(C, C.wg); }
    else if (emit_ctx) fourier_ctx_mfma(C, l, 8);
    { const float* asink_l = a.in[I_ASINK] + l * 4; const float* crel = a.in[I_CREL] + (size_t)l * 4 * 465;
      LAS float* relb = (LAS float*)(C.lds + 110592 + C.wave * 2048);
      for (int r2 = 0; r2 < NREP2(17); ++r2) {
      unsigned* qhead = (unsigned*)(C.ws + WS_CTL) + CW_WQ + 64 * l + 16 * r2;
      const int nA = 2 * (SEQ / 32), nC = 4 * (SEQ / 32), nAc = emit_ctx ? 2 * (NCTX / 32) : 0, nCc = emit_ctx ? 4 * (NCTX / 32) : 0, nAll = nA + nAc + nC + nCc;
      int hcur = -1;
      const int nCv = emit_ctx ? CV_NCHUNK : 0;
      for (;;) { unsigned uq = 0; if (C.lane == 0) uq = __hip_atomic_fetch_add(qhead, 1u, __ATOMIC_RELAXED, __HIP_MEMORY_SCOPE_AGENT);
          const int uraw = __builtin_amdgcn_readfirstlane((int)uq); if (uraw >= nAll + nCv) break;
          int u;
          if (uraw < 2 * nCv) { if (uraw & 1) { const int ch = uraw >> 1; convert_moe_items(C, a, l + 1, ch * CV_CHUNK, ch * CV_CHUNK + CV_CHUNK); continue; } u = uraw >> 1; }
          else u = uraw - nCv;
          if (u < nA) attnA_unit(C, asink_l, u, true);
          else if (u < nA + nAc) attnA_unit(C, asink_l, u - nA, false);
          else { const int uc = u - nA - nAc; const bool lat = uc < nC; const int uu = lat ? uc : uc - nC, nqt = lat ? SEQ / 32 : NCTX / 32, h = uu / nqt, qt = uu % nqt;
              if (h != hcur) { for (int i = C.lane; i < 465; i += 64) relb[i] = crel[h * 465 + i] * LOG2E; hcur = h; LDS_WAIT(); asm volatile("" ::: "memory"); }
              attnC_unit(C, relb, h, qt, lat); } } } }
    __syncthreads();
    for (int r2 = 0; r2 < NREP2(19); ++r2) fourier2_mfma(C, l, 0);
}

constexpr int RW_C = 32, RW_NCH = ROWS / RW_C, RW_SC = 20, RW_NSC = RW_NCH / RW_SC;
constexpr int RW_SLOT = 5120, RW_REGION = 9 * RW_SLOT + 1024;
constexpr int TP = 72, HP = 40;
static_assert(3 * RW_REGION <= MISC_OFF, "RWKV D1 regions below the misc area");
__device__ __forceinline__ int rw_rc_of(int d, int c) { return d == 0 ? c : (c < 8 ? 7 - c : 527 - c); }
__device__ __forceinline__ int rw_row_of(int d, int rc, int t) { return 32 * rc + (d == 0 ? t : 31 - t); }

__device__ __forceinline__ void rwkv_d1(const Ctx& C, LAS unsigned char* rb, int d, int h, int rc) {
    int lane_ = C.lane; asm volatile("" : "+v"(lane_));
    const int lane = lane_, li = lane & 15, g = lane >> 4;
    const float* SC = (const float*)(C.ws + WS_SC);
    LAS unsigned char* S0 = rb; LAS unsigned char* S1 = rb + RW_SLOT; LAS unsigned char* S2 = rb + 2 * RW_SLOT; LAS unsigned char* S3 = rb + 3 * RW_SLOT; LAS unsigned char* S4 = rb + 4 * RW_SLOT;
    LAS unsigned char* S5 = rb + 5 * RW_SLOT; LAS unsigned char* S6 = rb + 6 * RW_SLOT; LAS unsigned char* S7 = rb + 7 * RW_SLOT; LAS unsigned char* S8 = rb + 8 * RW_SLOT;
    LAS unsigned char* S6b = S6 + 2560; LAS unsigned char* S7b = S7 + 2560;
    LAS float* gc = (LAS float*)(rb + 9 * RW_SLOT);
    { float cum = 0.f; const int j = lane; const int qw = (3 + 3 * d) * 256;
#pragma unroll 1
      for (int t0 = 0; t0 < 32; t0 += 4) { float rv[4], vv[4], av[4], lw[4], kd[4], bb[4];
#pragma unroll
          for (int u = 0; u < 4; ++u) { const float* sc = SC + (size_t)rw_row_of(d, rc, t0 + u) * 9 * 256 + h * 64 + j;
              rv[u] = sc[0]; vv[u] = sc[256]; av[u] = sc[512]; lw[u] = sc[qw]; kd[u] = sc[qw + 256]; bb[u] = sc[qw + 512]; }
#pragma unroll
          for (int u = 0; u < 4; ++u) { const float cp = cum; cum += lw[u]; const float Gt = __expf(cum), Gm = __expf(cp), iG = __expf(-cum); const int off = ((t0 + u) * TP + j) * 2;
              *(LAS bf16*)(S0 + off) = (bf16)f2bf(av[u] * Gm); *(LAS bf16*)(S1 + off) = (bf16)f2bf(rv[u] * Gt); *(LAS bf16*)(S2 + off) = (bf16)f2bf(bb[u] * iG);
              *(LAS bf16*)(S3 + off) = (bf16)f2bf(kd[u] * iG); *(LAS bf16*)(S4 + off) = (bf16)f2bf(vv[u]); } }
      gc[j] = __expf(cum); }
    const f32x4 z4 = {0.f, 0.f, 0.f, 0.f};
#pragma unroll 1
    for (int ti = 0; ti < 2; ++ti)
#pragma unroll 1
        for (int si = 0; si < 2; ++si) {
            f32x4 n = z4, nt = z4, mk = z4, qb = z4, qk = z4;
#pragma unroll
            for (int ks = 0; ks < 2; ++ks) { const bf16x8 at = ldA(S0, TP, 16 * ti, 32 * ks, li, g), rt = ldA(S1, TP, 16 * ti, 32 * ks, li, g), bs = ldA(S2, TP, 16 * si, 32 * ks, li, g), kss = ldA(S3, TP, 16 * si, 32 * ks, li, g);
                n = mfma16(at, bs, n);
                nt = mfma16(bs, at, nt);
                mk = mfma16(kss, at, mk);
                qb = mfma16(bs, rt, qb);
                qk = mfma16(kss, rt, qk); }
#pragma unroll
            for (int r = 0; r < 4; ++r) { const int trow = 16 * ti + 4 * g + r, scol = 16 * si + li; if (!(scol < trow)) n[r] = 0.f;
                const int srow = 16 * si + 4 * g + r, tcol = 16 * ti + li; if (!(srow < tcol)) { mk[r] = 0.f; nt[r] = 0.f; } if (!(srow <= tcol)) { qb[r] = 0.f; qk[r] = 0.f; } }
            *(LAS f32x4*)(S5 + ((16 * si + li) * 32 + 16 * ti + 4 * g) * 4) = n;
            stT(S6, HP, 16 * ti + li, 16 * si + 4 * g, mk);
            stT(S8, HP, 16 * ti + li, 16 * si + 4 * g, nt);
            stT(S6b, HP, 16 * ti + li, 16 * si + 4 * g, qb);
            stT(S7, HP, 16 * ti + li, 16 * si + 4 * g, qk); }
    { const int rr = lane & 31, bq = rr >> 4, lr = rr & 15; float Tr[16];
#pragma unroll
      for (int s = 15; s >= 0; --s) { float acc = (lr == s) ? 1.f : 0.f;
#pragma unroll
          for (int c4 = 0; c4 < 4; ++c4) { if (4 * c4 + 3 > s) { const f32x4 nv = *(const LAS f32x4*)(S5 + ((16 * bq + s) * 32 + 16 * bq + 4 * c4) * 4);
#pragma unroll
              for (int e = 0; e < 4; ++e) if (4 * c4 + e > s) acc += Tr[4 * c4 + e] * nv[e]; } }
          Tr[s] = acc; }
      if (lane < 32) { u32x4 w0, w1; w0.x = pk2(Tr[0], Tr[1]); w0.y = pk2(Tr[2], Tr[3]); w0.z = pk2(Tr[4], Tr[5]); w0.w = pk2(Tr[6], Tr[7]); w1.x = pk2(Tr[8], Tr[9]); w1.y = pk2(Tr[10], Tr[11]); w1.z = pk2(Tr[12], Tr[13]); w1.w = pk2(Tr[14], Tr[15]);
          const u32x4 zz = {0u, 0u, 0u, 0u}; LAS u32x4* trow = (LAS u32x4*)(S7b + rr * HP * 2);
          trow[0] = bq ? zz : w0; trow[1] = bq ? zz : w1; trow[2] = bq ? w0 : zz; trow[3] = bq ? w1 : zz; }
      f32x4 x = mfma16(ldA(S8, HP, 16, 0, li, g), ldT(S7b, HP, 0, 0, li, g), z4);
      LAS unsigned char* XT = S8 + 2560;
      *(LAS u32x2*)(XT + (li * HP + 4 * g) * 2) = (u32x2){0u, 0u}; stT(XT, HP, li, 16 + 4 * g, x);
      const f32x4 t21 = mfma16(ldA(S7b, HP, 16, 0, li, g), ldA(XT, HP, 0, 0, li, g), z4);
#pragma unroll
      for (int r = 0; r < 4; ++r) *(LAS bf16*)(S7b + ((16 + 4 * g + r) * HP + li) * 2) = (bf16)f2bf(t21[r]); }
#pragma unroll 1
    for (int ti = 0; ti < 2; ++ti) { const bf16x8 tf = ldA(S7b, HP, 16 * ti, 0, li, g), mf = ldA(S6, HP, 16 * ti, 0, li, g);
#pragma unroll
        for (int ji = 0; ji < 4; ++ji) { const f32x4 ap = mfma16(tf, ldT(S0, TP, 0, 16 * ji, li, g), z4); stT(S8, HP, 16 * ji + li, 16 * ti + 4 * g, ap);
            const f32x4 mv = mfma16(mf, ldT(S4, TP, 0, 16 * ji, li, g), z4); stT(S5, HP, 16 * ji + li, 16 * ti + 4 * g, mv); } }
#pragma unroll 1
    for (int ti = 0; ti < 2; ++ti) { const bf16x8 tf = ldA(S7b, HP, 16 * ti, 0, li, g);
#pragma unroll
        for (int vi = 0; vi < 4; ++vi) { const f32x4 ul = mfma16(tf, ldA(S5, HP, 16 * vi, 0, li, g), z4); stT(S0, HP, 16 * vi + li, 16 * ti + 4 * g, ul); } }
#pragma unroll 1
    for (int ti = 0; ti < 2; ++ti) { const bf16x8 qbf = ldA(S6b, HP, 16 * ti, 0, li, g), qkf = ldA(S7, HP, 16 * ti, 0, li, g);
#pragma unroll
        for (int ji = 0; ji < 4; ++ji) { f32x4 rp = mfma16(ldA(S8, HP, 16 * ji, 0, li, g), qbf, z4);
            LAS unsigned char* p = S1 + ((16 * ti + li) * TP + 16 * ji + 4 * g) * 2; rp = rp + ld4bf(p); u32x2 w; w.x = pk2(rp[0], rp[1]); w.y = pk2(rp[2], rp[3]); *(LAS u32x2*)p = w;
            f32x4 yl = mfma16(qbf, ldA(S0, HP, 16 * ji, 0, li, g), z4); yl = mfma16(qkf, ldT(S4, TP, 0, 16 * ji, li, g), yl);
            stT(S5, HP, 16 * ji + li, 16 * ti + 4 * g, yl); } }
#pragma unroll 1
    for (int ji = 0; ji < 4; ++ji) { const bf16x8 bt = ldT(S2, TP, 0, 16 * ji, li, g); const float gj = gc[16 * ji + li];
#pragma unroll
        for (int jp = 0; jp < 4; ++jp) { f32x4 pt = mfma16(ldA(S8, HP, 16 * jp, 0, li, g), bt, z4);
#pragma unroll
            for (int r = 0; r < 4; ++r) pt[r] = pt[r] * gj + ((16 * jp + 4 * g + r == 16 * ji + li) ? gj : 0.f);
            stT(S6, TP, 16 * ji + li, 16 * jp + 4 * g, pt); } }
#pragma unroll 1
    for (int vh = 0; vh < 2; ++vh) { f32x4 lt[4][2];
#pragma unroll
      for (int ji = 0; ji < 4; ++ji) { const bf16x8 ba = ldT(S2, TP, 0, 16 * ji, li, g), ka = ldT(S3, TP, 0, 16 * ji, li, g); const f32x4 gv = *(const LAS f32x4*)(gc + 16 * ji + 4 * g);
#pragma unroll
          for (int v2 = 0; v2 < 2; ++v2) { const int vi = 2 * vh + v2; f32x4 x = mfma16(ba, ldA(S0, HP, 16 * vi, 0, li, g), z4); x = mfma16(ka, ldT(S4, TP, 0, 16 * vi, li, g), x); lt[ji][v2] = x * gv; } }
      asm volatile("s_waitcnt lgkmcnt(0)" ::: "memory");
      LAS unsigned char* dst = vh ? S2 : S8;
#pragma unroll
      for (int ji = 0; ji < 4; ++ji)
#pragma unroll
          for (int v2 = 0; v2 < 2; ++v2) stT(dst, TP, 16 * v2 + li, 16 * ji + 4 * g, lt[ji][v2]); }
}
__device__ __forceinline__ void rwkv_passA_step(const Ctx& C, const LAS unsigned char* rb, f32x4 (&hs)[4], int d, int h, int rc) {
    int lane_ = C.lane; asm volatile("" : "+v"(lane_));
    const int lane = lane_, li = lane & 15, g = lane >> 4; const bool isPhi = C.wave >= 4; const int col = 16 * (C.wave & 3) + li;
    const LAS unsigned char* S1 = rb + RW_SLOT; const LAS unsigned char* S2 = rb + 2 * RW_SLOT; const LAS unsigned char* S5 = rb + 5 * RW_SLOT; const LAS unsigned char* S6 = rb + 6 * RW_SLOT;
    const LAS unsigned char* LTb = (col < 32) ? rb + 8 * RW_SLOT + col * TP * 2 : S2 + (col - 32) * TP * 2;
    union { bf16x8 v; unsigned u[4]; } bf[2];
#pragma unroll
    for (int ks = 0; ks < 2; ++ks) { bf[ks].u[0] = pk2(hs[2 * ks][0], hs[2 * ks][1]); bf[ks].u[1] = pk2(hs[2 * ks][2], hs[2 * ks][3]); bf[ks].u[2] = pk2(hs[2 * ks + 1][0], hs[2 * ks + 1][1]); bf[ks].u[3] = pk2(hs[2 * ks + 1][2], hs[2 * ks + 1][3]); }
#pragma unroll
    for (int ti = 0; ti < 2; ++ti) { f32x4 acc = isPhi ? (f32x4){0.f, 0.f, 0.f, 0.f} : ld4bf(S5 + (col * HP + 16 * ti + 4 * g) * 2);
#pragma unroll
        for (int ks = 0; ks < 2; ++ks) acc = mfma16(ldAperm(S1, TP, 16 * ti, ks, li, g), bf[ks].v, acc);
        if (!isPhi) { float* ys = (float*)(C.ws + WS_YS) + (size_t)d * ROWS * 256 + h * 64 + col;
#pragma unroll
            for (int r = 0; r < 4; ++r) ys[(size_t)rw_row_of(d, rc, 16 * ti + 4 * g + r) * 256] = acc[r]; }
        else { bf16* rp = (bf16*)(C.ws + WS_RPP) + ((size_t)((d * 4 + h) * RW_NCH + rc) * 32) * 64 + col;
#pragma unroll
            for (int r = 0; r < 4; ++r) rp[(16 * ti + 4 * g + r) * 64] = (bf16)f2bf(acc[r]); } }
    f32x4 hn[4];
#pragma unroll
    for (int i = 0; i < 4; ++i) { f32x4 acc = isPhi ? (f32x4){0.f, 0.f, 0.f, 0.f} : ld4bf(LTb + (16 * i + 4 * g) * 2);
#pragma unroll
        for (int ks = 0; ks < 2; ++ks) acc = mfma16(ldAperm(S6, TP, 16 * i, ks, li, g), bf[ks].v, acc);
        hn[i] = acc; }
#pragma unroll
    for (int i = 0; i < 4; ++i) hs[i] = hn[i];
}
__device__ __forceinline__ void phase_rwkv1(const Ctx& C) {
    const int lane = C.lane, li = lane & 15, g = lane >> 4;
    for (int u = C.wg; u < 8 * RW_NSC; u += C.G) {
        const int s = u % RW_NSC, dh = u / RW_NSC, d = dh >> 2, h = dh & 3; const bool isPhi = C.wave >= 4; const int col = 16 * (C.wave & 3) + li;
        f32x4 hs[4];
#pragma unroll
        for (int i = 0; i < 4; ++i)
#pragma unroll
            for (int r = 0; r < 4; ++r) hs[i][r] = (isPhi && (16 * i + 4 * g + r == col)) ? 1.f : 0.f;
#pragma unroll 1
        for (int rnd = 0; rnd < (RW_SC + 2) / 3; ++rnd) {
            __syncthreads();
            { int wv = C.wave; asm volatile("" : "+s"(wv)); if (wv < 3 && 3 * rnd + wv < RW_SC) rwkv_d1(C, C.lds + wv * RW_REGION, d, h, rw_rc_of(d, s * RW_SC + 3 * rnd + wv)); }
            __syncthreads();
#pragma unroll 1
            for (int k = 0; k < 3; ++k) { const int ci = 3 * rnd + k; int ko = k * RW_REGION; asm volatile("" : "+s"(ko)); if (ci < RW_SC) rwkv_passA_step(C, C.lds + ko, hs, d, h, rw_rc_of(d, s * RW_SC + ci)); }
        }
        if (isPhi) { bf16* pf = (bf16*)(C.ws + WS_PSC) + (size_t)(dh * RW_NSC + s) * 4096;
            const int ks = col >> 5, eh = (col >> 4) & 1, gp = (col >> 2) & 3, el = col & 3;
#pragma unroll
            for (int i = 0; i < 4; ++i)
#pragma unroll
                for (int r = 0; r < 4; ++r) pf[((i * 2 + ks) * 64 + gp * 16 + 4 * g + r) * 8 + eh * 4 + el] = (bf16)f2bf(hs[i][r]); }
        else { f32x4* lf = (f32x4*)(C.ws + WS_LSC) + ((size_t)(dh * RW_NSC + s) * 4 + C.wave) * 4 * 64;
#pragma unroll
            for (int i = 0; i < 4; ++i) lf[i * 64 + lane] = hs[i]; }
    }
    __syncthreads();
}
__device__ __forceinline__ void rwkv_passB(const Ctx& C, int b) {
    if (C.wave >= 4) return;
    const int lane = C.lane, li = lane & 15, g = lane >> 4, q = C.wave;
    f32x4 hs[4];
#pragma unroll
    for (int i = 0; i < 4; ++i) hs[i] = (f32x4){0.f, 0.f, 0.f, 0.f};
    const bf16x8* pfb = (const bf16x8*)((const bf16*)(C.ws + WS_PSC) + (size_t)b * RW_NSC * 4096);
    const f32x4* lfb = (const f32x4*)(C.ws + WS_LSC) + ((size_t)b * RW_NSC * 4 + q) * 4 * 64;
    bf16x8 pa[8]; f32x4 la[4];
#pragma unroll
    for (int k = 0; k < 8; ++k) pa[k] = pfb[k * 64 + lane];
#pragma unroll
    for (int i = 0; i < 4; ++i) la[i] = lfb[i * 64 + lane];
#pragma unroll 1
    for (int s = 0; s < RW_NSC; ++s) {
        bf16* hp = (bf16*)(C.ws + WS_HSC) + ((size_t)(b * RW_NSC + s) * 64 + 16 * q + li) * 64;
#pragma unroll
        for (int i = 0; i < 4; ++i) { u32x2 w; w.x = pk2(hs[i][0], hs[i][1]); w.y = pk2(hs[i][2], hs[i][3]); *(u32x2*)(hp + 16 * i + 4 * g) = w; }
        bf16x8 pn[8]; f32x4 ln[4]; const int sn = (s + 1 < RW_NSC) ? s + 1 : s;
#pragma unroll
        for (int k = 0; k < 8; ++k) pn[k] = pfb[(size_t)sn * 512 + k * 64 + lane];
#pragma unroll
        for (int i = 0; i < 4; ++i) ln[i] = lfb[(size_t)sn * 4 * 4 * 64 + i * 64 + lane];
        union { bf16x8 v; unsigned u[4]; } bf[2];
#pragma unroll
        for (int ks = 0; ks < 2; ++ks) { bf[ks].u[0] = pk2(hs[2 * ks][0], hs[2 * ks][1]); bf[ks].u[1] = pk2(hs[2 * ks][2], hs[2 * ks][3]); bf[ks].u[2] = pk2(hs[2 * ks + 1][0], hs[2 * ks + 1][1]); bf[ks].u[3] = pk2(hs[2 * ks + 1][2], hs[2 * ks + 1][3]); }
#pragma unroll
        for (int i = 0; i < 4; ++i) { f32x4 acc = la[i];
#pragma unroll
            for (int ks = 0; ks < 2; ++ks) acc = mfma16(pa[i * 2 + ks], bf[ks].v, acc);
            hs[i] = acc; }
#pragma unroll
        for (int k = 0; k < 8; ++k) pa[k] = pn[k];
#pragma unroll
        for (int i = 0; i < 4; ++i) la[i] = ln[i];
    }
}
__device__ __forceinline__ void phase_mix3(const Ctx& C, const DArgs& a, int l) {
    const bf16* P = (const bf16*)(C.ws + WS_P); const float* SC = (const float*)(C.ws + WS_SC); const float* YS = (const float*)(C.ws + WS_YS); bf16* MIX = (bf16*)(C.ws + WS_MIX);
    LAS float* yt = (LAS float*)(C.lds);
    constexpr int GSP = 168;
    LAS unsigned char* gsig = C.lds + 32768;
    LAS float* gm = (LAS float*)(C.lds + 40960);
    const bf16* g2t = (const bf16*)(C.ws + WS_G2T) + (size_t)l * 256 * 160;
    const float* rk = a.in[I_DRK] + (size_t)l * 256; const float* lnw = a.in[I_DLNW] + (size_t)l * 256; const float* lnb = a.in[I_DLNB] + (size_t)l * 256;
    const int lane = C.lane, li = lane & 15, g = lane >> 4, h = C.wave & 3, d = C.wave >> 2;
    const int half = C.tid >> 8, c = C.tid & 255;
    const int u_lo = (l == DEPTH - 1) ? NCTX / 16 : 0;
    for (int u = u_lo + C.wg; u < ROWS / 16; u += C.G) {
        const int rc = u >> 1, th = u & 1, rowb = 16 * u;
        __syncthreads();
        for (int i = C.tid; i < 16 * 160; i += NTHR) { const int t = i / 160, ii = i % 160; *(LAS bf16*)(gsig + (t * GSP + ii) * 2) = (bf16)f2bf(sigmoidf_(bf2f(P[(size_t)(rowb + t) * INWP + C_GL + ii]))); }
        {
          const int ct = (d == 0) ? rc : (rc < 8 ? 7 - rc : 527 - rc), s = ct / RW_SC, ti = (d == 0) ? th : 1 - th;
          const bf16* rp = (const bf16*)(C.ws + WS_RPP) + (size_t)((d * 4 + h) * RW_NCH + rc) * 32 * 64;
          const bf16* hp = (const bf16*)(C.ws + WS_HSC) + (size_t)((d * 4 + h) * RW_NSC + s) * 64 * 64;
          bf16x8 af[2];
#pragma unroll
          for (int ks = 0; ks < 2; ++ks) af[ks] = ldg8(rp + (16 * ti + li) * 64 + 32 * ks + 8 * g);
#pragma unroll
          for (int vi = 0; vi < 4; ++vi) { f32x4 acc = {0.f, 0.f, 0.f, 0.f};
#pragma unroll
              for (int ks = 0; ks < 2; ++ks) acc = mfma16(af[ks], ldg8(hp + (16 * vi + li) * 64 + 32 * ks + 8 * g), acc);
#pragma unroll
              for (int r = 0; r < 4; ++r) { const int t = 16 * ti + 4 * g + r, rl = ((d == 0) ? t : 31 - t) - 16 * th;
                  yt[(d * 16 + rl) * 256 + h * 64 + 16 * vi + li] = acc[r] + YS[((size_t)d * ROWS + rowb + rl) * 256 + h * 64 + 16 * vi + li]; } } }
        __syncthreads();
#pragma unroll
        for (int c2 = 0; c2 < 2; ++c2) { const int ci = 2 * C.wave + c2; f32x4 a0 = {0.f, 0.f, 0.f, 0.f};
#pragma unroll
            for (int ks = 0; ks < 5; ++ks) a0 = mfma16(ldA(gsig, GSP, 0, 32 * ks, li, g), ldg8(g2t + (size_t)(16 * ci + li) * 160 + 32 * ks + 8 * g), a0);
#pragma unroll
            for (int r = 0; r < 4; ++r) gm[(4 * g + r) * 256 + 16 * ci + li] = a0[r]; }
        __syncthreads();
#pragma unroll 1
        for (int it = 0; it < 8; ++it) { const int rl = 2 * it + half, row = rowb + rl;
            const float* sc = SC + (size_t)row * 9 * 256;
            const float y = yt[rl * 256 + c] + yt[(16 + rl) * 256 + c];
            const float mu = wave_sum(y, lane) * (1.f / 64.f), dy = y - mu, var = wave_sum(dy * dy, lane) * (1.f / 64.f);
            const float yn = dy * rsqrtf(var + 64e-5f) * lnw[c] + lnb[c];
            const float r = sc[c], v = sc[256 + c];
            const float coef = wave_sum(r * (sc[4 * 256 + c] + sc[7 * 256 + c]) * rk[c], lane);
            MIX[(size_t)row * DM + 768 + c] = (bf16)f2bf((yn + coef * v) * gm[rl * 256 + c]); }
    }
    __syncthreads();
}
__device__ __forceinline__ void outproj_ctx(const Ctx& C, int l, const float* gate) {
    const bf16* A = (const bf16*)(C.ws + WS_MIX); const bf16* B = (const bf16*)(C.ws + WS_WOUT) + (size_t)l * DM * DM; float* XS = (float*)(C.ws + WS_XS);
    const int lane = C.lane, li = lane & 15, g = lane >> 4;
    for (int u = C.gw; u < (NCTX / 16) * (DM / 16); u += C.NGW) { const int rt = u >> 6, ct = u & 63;
        const bf16* ap = A + (size_t)(16 * rt + li) * DM + 8 * g; const bf16* bp = B + (size_t)(16 * ct + li) * DM + 8 * g;
        f32x4 acc0 = {0.f, 0.f, 0.f, 0.f}, acc1 = {0.f, 0.f, 0.f, 0.f};
#pragma unroll 4
        for (int ks = 0; ks < 32; ks += 2) { acc0 = mfma16(ldg8(ap + 32 * ks), ldg8(bp + 32 * ks), acc0); acc1 = mfma16(ldg8(ap + 32 * ks + 32), ldg8(bp + 32 * ks + 32), acc1); }
        const float gv = gate[16 * ct + li];
#pragma unroll
        for (int r = 0; r < 4; ++r) { float* p = XS + (size_t)(16 * rt + 4 * g + r) * DM + 16 * ct + li; *p = *p + gv * (acc0[r] + acc1[r]); } }
}

#ifndef MK_SINGLE
#define MK_SINGLE 1
#endif
template <int ONLYP> __global__ void __launch_bounds__(NTHR, 2) mega(Args a) {
    extern __shared__ __attribute__((aligned(16))) unsigned char lds_raw[];
    Ctx C;
#define MKCTX() do { int t_ = threadIdx.x; asm volatile("" : "+v"(t_)); unsigned char* w_ = a.ws; asm volatile("" : "+s"(w_)); unsigned l_ = 0u; asm volatile("" : "+s"(l_)); \
        C.lds = (LAS unsigned char*)lds_raw + l_; C.tid = t_; C.lane = t_ & 63; C.wave = __builtin_amdgcn_readfirstlane(t_ >> 6); \
        C.wg = blockIdx.x; C.G = gridDim.x; C.gw = C.wg * NWAVES + C.wave; C.NGW = C.G * NWAVES; C.ws = w_; } while (0)
    MKCTX();
    if (C.tid == 0) {
#pragma unroll
        for (int i = 0; i < 31; ++i) ((LAS unsigned long long*)(C.lds + MISC_OFF + 2048))[i] = (unsigned long long)a.in[i]; }
    DArgs da; da.in.tab = (const LAS unsigned*)(C.lds + MISC_OFF + 2048); da.out = a.out;
    if (C.tid < 4) ((LAS unsigned*)(C.lds + MISC_OFF))[C.tid] = 0u;
    __syncthreads();
    XcdBarrier bar; bar.bar = (unsigned*)(C.ws + WS_CTL) + CW_BAR; bar.x = 0; bar.st = (volatile LAS unsigned*)(C.lds + MISC_OFF);
    if (a.use_bar) bar = xcd_barrier_post((unsigned*)(C.ws + WS_CTL) + CW_BAR, (volatile LAS unsigned*)(C.lds + MISC_OFF));
#ifndef PHMASK
#define PHMASK 0x1fff
#endif
#define INP(o, k) ((ONLYP < 0 || ONLYP == (o)) && ((PHMASK >> ((o) == 99 ? 12 : (o))) & 1) && a.ph_lo <= (k) && (k) < a.ph_hi)
#ifndef REPMASK
#define REPMASK 0
#endif
#define NREP(o) ((((REPMASK) >> ((o) == 99 ? 12 : (o))) & 1) ? 2 : 1)
#define IN(k) (a.ph_lo <= (k) && (k) < a.ph_hi)
#define SEAM(k) do { if (a.use_bar && IN(k) && IN((k) + 1)) { xcd_barrier(bar); if ((REPMASK >> 20) & 1) xcd_barrier(bar); } } while (0)
    if (INP(0, 0)) for (int rep = 0; rep < NREP(0); ++rep) { MKCTX(); phase_prologue(C, da); }
    SEAM(0);
    for (int l = 0; l < DEPTH; ++l) {
        const int b = 1 + l * NPL;
        const float* mod_lat = (const float*)(C.ws + WS_MOD) + (size_t)(l * 2 + 0) * 6144; const float* mod_ctx = mod_lat + 6144;
        if (INP(1, b + 0)) { MKCTX(); phase_norm1(C, da, l); }
        SEAM(b + 0);
        if (INP(2, b + 1)) for (int rep = 0; rep < NREP(2); ++rep) { MKCTX();
            pg8::StaticOrder S; S.init(WS_H, WS_WIN + (size_t)l * INWP * DM * 2, ROWS, INWP, DM, C.G, C.wg);
            pg8::EpiStoreBf16 E{(bf16*)(C.ws + WS_P), INWP, nullptr, 0, 1.0f, 1.0f};
            pg8::gemm_phase<pg8::EpiStoreBf16, pg8::StaticOrder, true, true>(C.lds, C.tid, DM, S, E, C.ws);
        }
        SEAM(b + 1);
        if (INP(3, b + 2)) { MKCTX(); for (int rep = 0; rep < NREP(3); ++rep) { mix1_rwkv_prep(C, da, l); mix1_fourier1(C); } }
        SEAM(b + 2);
        if (INP(11, b + 3)) for (int rep = 0; rep < NREP(11); ++rep) { MKCTX(); phase_rwkv1(C);
            if (C.wg >= 8 * RW_NSC) {
                Ctx C2 = C; C2.wg = C.wg - 8 * RW_NSC; C2.G = C.G - 8 * RW_NSC; C2.gw = C2.wg * NWAVES + C.wave; C2.NGW = C2.G * NWAVES;
                mix1_rope(C2); mix1_vt(C2); } }
        SEAM(b + 3);
        if (INP(4, b + 4)) for (int rep = 0; rep < NREP(4); ++rep) { MKCTX(); phase_mix2(C, da, l); }
        SEAM(b + 4);
        if (INP(5, b + 5)) for (int rep = 0; rep < NREP(5); ++rep) { MKCTX(); phase_mix3(C, da, l); }
        SEAM(b + 5);
        if (INP(6, b + 6)) { MKCTX();
            if (l < DEPTH - 1) outproj_ctx(C, l, mod_ctx + 2 * DM);
            pg8::StaticOrder S; S.init(WS_MIX + (size_t)NCTX * DM * 2, WS_WOUT + (size_t)l * DM * DM * 2, SEQ, DM, DM, C.G, C.wg);
            pg8::EpiResidual E{(float*)(C.ws + WS_XS) + (size_t)NCTX * DM, DM, mod_lat + 2 * DM, mod_lat + 2 * DM};
            pg8::gemm_phase<pg8::EpiResidual, pg8::StaticOrder, true, true>(C.lds, C.tid, DM, S, E, C.ws);
        }
        SEAM(b + 6);
        if (INP(7, b + 7)) for (int rep = 0; rep < NREP(7); ++rep) { MKCTX(); phase_norm2(C, da, l); }
        SEAM(b + 7);
        if (INP(8, b + 8)) for (int rep = 0; rep < NREP(8); ++rep) { MKCTX(); phase_gather(C, da, l); }
        SEAM(b + 8);
        if (INP(9, b + 9)) for (int rep = 0; rep < NREP(9); ++rep) { MKCTX();
            const int nblk = moe_tables(C);
            pg8::MoeOrder S{(unsigned)WS_XG8, (unsigned)(WS_WGU + (size_t)l * 32 * 2048 * DM), 256u * DM, 2048u * DM,
                            (const LAS unsigned char*)(C.lds + MISC_OFF + 1024), nblk, 8, C.G, C.wg};
            pg8::EpiSwiglu E{(bf16*)(C.ws + WS_ACT8), DM, da.in[I_BGU] + (size_t)l * 32 * 2048, 2048, pg8::X8_S * pg8::W8_S, 1.0f / (pg8::X8_S * pg8::W8_S)};
            pg8::gemm_phase<pg8::EpiSwiglu, pg8::MoeOrder, true, true, 1>(C.lds, C.tid, DM, S, E, C.ws);
        }
        SEAM(b + 9);
        if (INP(10, b + 10)) for (int rep = 0; rep < NREP(10); ++rep) { MKCTX();
            const int nblk = moe_tables(C);
            pg8::MoeOrder S{(unsigned)WS_ACT8, (unsigned)(WS_WDN + (size_t)l * 32 * DM * DM), 256u * DM, (unsigned)(DM * DM),
                            (const LAS unsigned char*)(C.lds + MISC_OFF + 1024), nblk, 4, C.G, C.wg};
            pg8::EpiStoreBf16 E{(bf16*)(C.ws + WS_XG), DM, da.in[I_BDN] + (size_t)l * 32 * DM, DM, pg8::ACT_S * pg8::W8_S, 1.0f / (pg8::ACT_S * pg8::W8_S)};
            pg8::gemm_phase<pg8::EpiStoreBf16, pg8::MoeOrder, true, true, 1>(C.lds, C.tid, DM, S, E, C.ws);
        }
        SEAM(b + 10);
    }
    if (INP(99, PH_TOTAL - 1)) for (int rep = 0; rep < NREP(99); ++rep) { MKCTX(); phase_final(C, da); }
#undef IN
#undef INP
#undef SEAM
}

typedef void (*kern_t)(Args);
static kern_t kern_of(int o) {
    switch (o) { case 0: return mega<0>; case 1: return mega<1>; case 2: return mega<2>; case 3: return mega<3>; case 4: return mega<4>; case 5: return mega<5>; case 6: return mega<6>;
                 case 7: return mega<7>; case 8: return mega<8>; case 9: return mega<9>; case 10: return mega<10>; case 11: return mega<11>; case 99: return mega<99>;
#if MK_SINGLE
                 default: return mega<-1>;
#else
                 default: return mega<0>;
#endif
    }
}
extern "C" void kernel_launch(void* const* d_in, const int* in_sizes, int n_in, void* d_out, int out_size, void* d_ws, size_t ws_size, hipStream_t stream) {
    static int ready = 0;
    if (ready == 0) {
        if (n_in != 31 || out_size != SEQ * DM || ws_size < WS_END) { fprintf(stderr, "kernel_launch: unexpected shapes (n_in %d, out %d, ws %zu)\n", n_in, out_size, ws_size); ready = -1; return; }
        const int ids[14] = {0, 1, 2, 3, 4, 5, 6, 7, 8, 9, 10, 11, 99, -1};
        for (int i = 0; i < (MK_SINGLE ? 14 : 13); ++i) { if (MK_SINGLE && ids[i] != -1) continue;
            if (hipFuncSetAttribute((const void*)kern_of(ids[i]), hipFuncAttributeMaxDynamicSharedMemorySize, LDS_BYTES) != hipSuccess) { fprintf(stderr, "kernel_launch: hipFuncSetAttribute failed (%d)\n", ids[i]); ready = -1; return; } }
        ready = 1;
    }
    if (ready < 0) return;
    (void)hipMemsetAsync((char*)d_ws + WS_CTL, 0, CTL_ZERO_BYTES, stream);
    Args a{};
    for (int i = 0; i < 31; ++i) a.in[i] = (const float*)d_in[i];
    a.out = (float*)d_out; a.ws = (unsigned char*)d_ws; a.pad = 0;
#if MK_SINGLE
    a.ph_lo = 0; a.ph_hi = PH_TOTAL; a.use_bar = 1;
    hipLaunchKernelGGL(kern_of(-1), dim3(NWG), dim3(NTHR), LDS_BYTES, stream, a);
#else
    for (int p = 0; p < PH_TOTAL; ++p) { a.ph_lo = p; a.ph_hi = p + 1; a.use_bar = 0;
        const int j = (p - 1) % NPL; const int o = (p == 0) ? 0 : (p == PH_TOTAL - 1) ? 99 : (j < 3 ? 1 + j : j == 3 ? 11 : j);
        hipLaunchKernelGGL(kern_of(o), dim3(NWG), dim3(NTHR), LDS_BYTES, stream, a); }
#endif
}
```

```cpp
#include <hip/hip_runtime.h>
#include <cstdio>
#include <cstdint>

#define LAS __attribute__((address_space(3)))
typedef unsigned short bf16;
typedef float f32x4 __attribute__((ext_vector_type(4)));
typedef float f32x2 __attribute__((ext_vector_type(2)));
typedef short bf16x8 __attribute__((ext_vector_type(8)));
typedef unsigned u32x4 __attribute__((ext_vector_type(4)));
typedef unsigned u32x2 __attribute__((ext_vector_type(2)));

constexpr int DM = 1024, SEQ = 16384, NCTX = 256, ROWS = SEQ + NCTX, DEPTH = 4, GRIDW = 64;
constexpr int INW = 2720, INWP = 2816;
constexpr int C_AQ = 0, C_AK = 256, C_AV = 384, C_BU = 512, C_CQ = 768, C_CK = 1024, C_CV = 1280, C_DR = 1536, C_DK = 1792, C_DV = 2048, C_WL = 2304, C_AL = 2432, C_GL = 2560;
constexpr int NEXP = 32, TOPK = 4;
constexpr int MOE_MAXBLK = 296;
constexpr int MOE_ROWS = MOE_MAXBLK * 256;
constexpr int NWG = 256, NTHR = 512, NWAVES = 8;
constexpr int VTP = ROWS + 256;

constexpr size_t MiB = 1u << 20;
constexpr size_t WS_CTL = 0, CTL_ZERO_BYTES = 1 * MiB;
constexpr size_t WS_MOD = 1 * MiB;
constexpr size_t WS_TW = 2 * MiB;
constexpr size_t WS_MTAB = 3 * MiB;
constexpr size_t WS_XS = 4 * MiB;
constexpr size_t WS_H = 70 * MiB;
constexpr size_t WS_P = 104 * MiB;
constexpr size_t WS_MIX = 194 * MiB;
constexpr size_t WS_FYR = 228 * MiB, WS_FYI = 244 * MiB;
constexpr size_t WS_VTA = 1544 * MiB, WS_VTC = 1550 * MiB;
constexpr size_t WS_SC = 260 * MiB;
constexpr size_t WS_YS = 408 * MiB;
constexpr size_t WS_ROUTE = 442 * MiB;
constexpr size_t WS_CNT = 444 * MiB;
constexpr size_t WS_XG = 446 * MiB;
constexpr size_t WS_ACT = 596 * MiB;
constexpr size_t WS_XG8 = WS_ACT, WS_ACT8 = WS_ACT + 75 * MiB;
constexpr size_t WS_WIN = 746 * MiB;
constexpr size_t WS_WOUT = 768 * MiB;
constexpr size_t WS_WGU = 776 * MiB;
constexpr size_t WS_WDN = 1288 * MiB;
constexpr size_t WS_RPP = 1560 * MiB, WS_PSC = 1578 * MiB, WS_LSC = 1580 * MiB, WS_HSC = 1584 * MiB;
constexpr size_t WS_FTAB = 1586 * MiB;
constexpr size_t WS_G2T = 1588 * MiB, WS_RWT = 1589 * MiB;
constexpr size_t WS_LORAT = 1590 * MiB;
constexpr size_t WS_F256 = 1591 * MiB;

constexpr size_t WS_END = 1592 * MiB;
static_assert(WS_XS + (size_t)ROWS * DM * 4 <= WS_H && WS_H + (size_t)ROWS * DM * 2 <= WS_P && WS_P + (size_t)ROWS * INWP * 2 <= WS_MIX && WS_MIX + (size_t)ROWS * DM * 2 <= WS_FYR, "ws map 1");
static_assert(WS_SC + (size_t)ROWS * 9 * 256 * 4 <= WS_YS && WS_YS + (size_t)2 * ROWS * 256 * 4 <= WS_ROUTE && WS_XG + (size_t)MOE_ROWS * DM * 2 <= WS_ACT && WS_ACT + (size_t)MOE_ROWS * DM * 2 <= WS_WIN, "ws map 2");
static_assert(WS_WIN + (size_t)4 * INWP * DM * 2 <= WS_WOUT && WS_WGU + (size_t)4 * 32 * 2048 * 1024 * 2 <= WS_WDN && WS_WDN + (size_t)4 * 32 * 1024 * 1024 * 2 <= WS_END, "ws map 3");
constexpr int CW_BAR = 4096;
constexpr int CW_WQ = 16384;

constexpr int RING_BYTES = 131072;
constexpr int MISC_OFF = 143360;
constexpr int LDS_BYTES = 147456;

__device__ __forceinline__ unsigned f2bf(float f) { unsigned u = __builtin_bit_cast(unsigned, f); return (u + 0x7fffu + ((u >> 16) & 1u)) >> 16; }
__device__ __forceinline__ unsigned pk2(float lo, float hi) { return f2bf(lo) | (f2bf(hi) << 16); }
__device__ __forceinline__ float bf2f(unsigned short b) { return __builtin_bit_cast(float, (unsigned)b << 16); }
__device__ __forceinline__ float bflo(unsigned w) { return __builtin_bit_cast(float, w << 16); }
__device__ __forceinline__ float bfhi(unsigned w) { return __builtin_bit_cast(float, w & 0xffff0000u); }
__device__ __forceinline__ float shx(float v, int o, int lane) { return __builtin_bit_cast(float, __builtin_amdgcn_ds_bpermute((lane ^ o) << 2, __builtin_bit_cast(int, v))); }
__device__ __forceinline__ int shxi(int v, int o, int lane) { return __builtin_amdgcn_ds_bpermute((lane ^ o) << 2, v); }
__device__ __forceinline__ float dpp_ror(float v, int ctrl_unused);
#define DPP_ROR_ADD(v, n) v += __builtin_bit_cast(float, __builtin_amdgcn_update_dpp(0, __builtin_bit_cast(int, v), 0x120 + (n), 0xf, 0xf, false))
__device__ __forceinline__ float wave_sum(float v, int lane) {
    DPP_ROR_ADD(v, 8); DPP_ROR_ADD(v, 4); DPP_ROR_ADD(v, 2); DPP_ROR_ADD(v, 1);
    v += shx(v, 16, lane); v += shx(v, 32, lane);
    return v;
}
__device__ __forceinline__ float sigmoidf_(float x) { return 1.f / (1.f + __expf(-x)); }
#define LDS_WAIT() asm volatile("s_waitcnt lgkmcnt(0)" ::: "memory")
#define VM_WAIT() asm volatile("s_waitcnt vmcnt(0)" ::: "memory")

namespace pg8 {
#define PG8_LAS __attribute__((address_space(3)))
typedef unsigned short bf16_t;
constexpr int BM = 256, BK = 64, HALF = 128, HTB = HALF * BK * 2, STAGE_BYTES = 8 * HTB, NXCD = 8, WGM = 8;
__host__ __device__ __forceinline__ int lds_byte(int r, int c) { const int st = (r >> 4) * 2 + (c >> 5), rr = r & 15, cc = c & 31, ob = rr * 64 + cc * 2; return st * 1024 + (ob ^ (((ob >> 9) & 1) << 5)); }
__host__ __device__ __forceinline__ void stage_rc(int b, int& R, int& C) { const int st = b / 1024, sb = b % 1024, swz = sb ^ (((sb >> 9) & 1) << 5); R = (st >> 1) * 16 + swz / 64; C = (st & 1) * 32 + (swz % 64) / 2; }
__host__ __device__ __forceinline__ int perm32(int rho) { const int n = rho >> 4, i = rho & 15; return 8 * (i >> 2) + 4 * n + (i & 3); }
struct Unit { int pm, pn, e; };
typedef int v8i __attribute__((ext_vector_type(8))); typedef int v4i __attribute__((ext_vector_type(4)));
__device__ __forceinline__ v8i cat8(bf16x8 a, bf16x8 b) { const v4i x = __builtin_bit_cast(v4i, a), y = __builtin_bit_cast(v4i, b); return __builtin_shufflevector(x, y, 0, 1, 2, 3, 4, 5, 6, 7); }
__device__ __forceinline__ unsigned cvt_pk_bf16(float lo, float hi) { unsigned r; asm volatile("v_cvt_pk_bf16_f32 %0, %1, %2" : "=v"(r) : "v"(lo), "v"(hi)); return r; }

struct StaticOrder {
    unsigned A, Bt, tstep;
    int nM, nN, nwg, G, c;
    __device__ void init(size_t A_, size_t Bt_, int M, int N, int K, int G_, int c_) { A = (unsigned)A_; Bt = (unsigned)Bt_; tstep = (unsigned)(BM * K * 2); nM = M / BM; nN = N / BM; nwg = nM * nN; G = G_; c = c_; }
    __device__ bool next(int i, Unit& u) const {
        const long L = (long)i * G + c; if (L >= nwg) return false;
        int wgid = (int)L; { const int q = nwg / NXCD, r = nwg % NXCD, xcd = wgid % NXCD, off = wgid / NXCD; wgid = (xcd < r ? xcd * (q + 1) : r * (q + 1) + (xcd - r) * q) + off; }
        const int nig = WGM * nN, gid = wgid / nig, fm = gid * WGM, gsz = (nM - fm) < WGM ? (nM - fm) : WGM;
        u.pm = fm + ((wgid % nig) % gsz); u.pn = (wgid % nig) / gsz; u.e = 0; return true;
    }
    __device__ __forceinline__ unsigned pa(const Unit& u) const { return A + (unsigned)u.pm * tstep; }
    __device__ __forceinline__ unsigned pb(const Unit& u) const { return Bt + (unsigned)u.pn * tstep; }
};
struct MoeOrder {
    unsigned A, Bt, tstep, estep;
    const LAS unsigned char* blk_e; int nblk, nN, G, c;
    __device__ bool next(int i, Unit& u) const {
        const int L = i * G + c; if (L >= nblk * nN) return false;
        u.pm = L / nN; u.pn = L % nN; u.e = __builtin_amdgcn_readfirstlane((int)blk_e[u.pm]); return true;
    }
    __device__ __forceinline__ unsigned pa(const Unit& u) const { return A + (unsigned)u.pm * tstep; }
    __device__ __forceinline__ unsigned pb(const Unit& u) const { return Bt + (unsigned)u.e * estep + (unsigned)u.pn * tstep; }
};

struct EpiStoreBf16 {
    static constexpr bool PERM = true;
    bf16_t* O; int ldc; const float* bias; int bias_estride; float bias_scale, acc_scale;
    __device__ __forceinline__ void init(f32x4 (&acc)[2][2][4][2], const Unit& u, int wc, int fq) const {
        const int col0 = u.pn * BM + wc * 32 + 8 * fq;
#pragma unroll
        for (int b = 0; b < 2; ++b)
#pragma unroll
            for (int n = 0; n < 2; ++n) { const f32x4 bv = bias ? *(const f32x4*)(bias + (size_t)u.e * bias_estride + col0 + b * HALF + 4 * n) * bias_scale : (f32x4){0.f, 0.f, 0.f, 0.f};
#pragma unroll
                for (int a = 0; a < 2; ++a)
#pragma unroll
                    for (int m = 0; m < 4; ++m) { f32x4 t = bv; asm volatile("" : "+v"(t)); acc[a][b][m][n] = t; } }
    }
    __device__ __forceinline__ void operator()(const f32x4 (&acc)[2][2][4][2], const Unit& u, int wr, int wc, int fr, int fq) const {
        const int row0 = u.pm * BM + wr * 64 + fr, col0 = u.pn * BM + wc * 32 + 8 * fq;
#pragma unroll
        for (int ai = 0; ai < 2; ++ai)
#pragma unroll
            for (int m = 0; m < 4; ++m) { bf16_t* rowp = O + (size_t)(row0 + ai * HALF + m * 16) * ldc + col0;
#pragma unroll
                for (int bj = 0; bj < 2; ++bj) { const f32x4 v0 = acc[ai][bj][m][0] * acc_scale, v1 = acc[ai][bj][m][1] * acc_scale;
                    u32x4 w; w.x = cvt_pk_bf16(v0[0], v0[1]); w.y = cvt_pk_bf16(v0[2], v0[3]); w.z = cvt_pk_bf16(v1[0], v1[1]); w.w = cvt_pk_bf16(v1[2], v1[3]);
                    *(u32x4*)(rowp + bj * HALF) = w; }
                asm volatile("" ::: "memory"); }
    }
};
__device__ __forceinline__ float swiglu1(float g, float up) {
    g = fminf(g, 7.0f); up = fminf(fmaxf(up, -7.0f), 7.0f);
    return g * (1.f / (1.f + __expf(-1.702f * g))) * (up + 1.0f);
}
constexpr float X8_S = 8.0f, W8_S = 256.0f, ACT_S = 4.0f;
struct EpiSwiglu {
    static constexpr bool PERM = true;
    bf16_t* O; int ldc; const float* bias; int bias_estride; float bias_scale, acc_scale;
    __device__ __forceinline__ void init(f32x4 (&acc)[2][2][4][2], const Unit& u, int wc, int fq) const {
        const int col0 = u.pn * BM + wc * 32 + 8 * fq;
#pragma unroll
        for (int b = 0; b < 2; ++b)
#pragma unroll
            for (int n = 0; n < 2; ++n) { const f32x4 bv = bias ? *(const f32x4*)(bias + (size_t)u.e * bias_estride + col0 + b * HALF + 4 * n) * bias_scale : (f32x4){0.f, 0.f, 0.f, 0.f};
#pragma unroll
                for (int a = 0; a < 2; ++a)
#pragma unroll
                    for (int m = 0; m < 4; ++m) { f32x4 t = bv; asm volatile("" : "+v"(t)); acc[a][b][m][n] = t; } }
    }
    __device__ __forceinline__ void operator()(const f32x4 (&acc)[2][2][4][2], const Unit& u, int wr, int wc, int fr, int fq) const {
        const int row0 = u.pm * BM + wr * 64 + fr, col0 = u.pn * BM + wc * 32 + 8 * fq;
#pragma unroll
        for (int ai = 0; ai < 2; ++ai)
#pragma unroll
            for (int m = 0; m < 4; ++m) { unsigned char* rowp = (unsigned char*)O + (size_t)(row0 + ai * HALF + m * 16) * ldc + (col0 >> 1);
#pragma unroll
                for (int bj = 0; bj < 2; ++bj) { const f32x4 v0 = acc[ai][bj][m][0] * acc_scale, v1 = acc[ai][bj][m][1] * acc_scale;
                    unsigned w = 0; w = __builtin_amdgcn_cvt_pk_fp8_f32(swiglu1(v0[0], v0[1]) * ACT_S, swiglu1(v0[2], v0[3]) * ACT_S, w, false); w = __builtin_amdgcn_cvt_pk_fp8_f32(swiglu1(v1[0], v1[1]) * ACT_S, swiglu1(v1[2], v1[3]) * ACT_S, w, true);
                    *(unsigned*)(rowp + bj * (HALF / 2)) = w; }
                asm volatile("" ::: "memory"); }
    }
};
struct EpiResidual {
    static constexpr bool PERM = false;
    float* X; int ldc; const float* gate_lat; const float* gate_ctx;
    __device__ __forceinline__ void init(f32x4 (&acc)[2][2][4][2], const Unit& u, int wc, int fq) const {
#pragma unroll
        for (int a = 0; a < 2; ++a)
#pragma unroll
            for (int b = 0; b < 2; ++b)
#pragma unroll
                for (int m = 0; m < 4; ++m)
#pragma unroll
                    for (int n = 0; n < 2; ++n) acc[a][b][m][n] = (f32x4){0.f, 0.f, 0.f, 0.f};
    }
    __device__ __forceinline__ void operator()(const f32x4 (&acc)[2][2][4][2], const Unit& u, int wr, int wc, int fr, int fq) const {
        const int row0 = u.pm * BM + wr * 64 + fr, col0 = u.pn * BM + wc * 32 + 4 * fq;
        const float* gp = (u.pm == 0) ? gate_ctx : gate_lat;
        f32x4 gv[2][2];
#pragma unroll
        for (int bj = 0; bj < 2; ++bj)
#pragma unroll
            for (int n = 0; n < 2; ++n) gv[bj][n] = *(const f32x4*)(gp + col0 + bj * HALF + n * 16);
#pragma unroll
        for (int ai = 0; ai < 2; ++ai)
#pragma unroll
            for (int m = 0; m < 4; ++m) { float* rowp = X + (size_t)(row0 + ai * HALF + m * 16) * ldc + col0;
#pragma unroll
                for (int bj = 0; bj < 2; ++bj)
#pragma unroll
                    for (int n = 0; n < 2; ++n) { f32x4* p = (f32x4*)(rowp + bj * HALF + n * 16); *p = *p + gv[bj][n] * acc[ai][bj][m][n]; }
                asm volatile("" ::: "memory"); }
    }
};
template <class Epi, class Sched, bool ALIGN_EPI = false, bool SP2 = false, int ES = 2>
__device__ __forceinline__ void gemm_phase(PG8_LAS unsigned char* lds, const int tid, const int K, const Sched& S, const Epi& E, const void* wsbase) {
    const __amdgpu_buffer_rsrc_t rsrc = __builtin_amdgcn_make_buffer_rsrc((void*)wsbase, 0, 0x7fffffff, 0x00020000);
    const int wid = __builtin_amdgcn_readfirstlane(tid >> 6), lane = tid & 63, wr = wid >> 2, wc = wid & 3, fr = lane & 15, fq = lane >> 4;
    const int nt = (K * ES) / 128;
    unsigned voffA[2], voffB[2];
#pragma unroll
    for (int i = 0; i < 2; ++i) { int R, C; stage_rc(tid * 16 + i * 8192, R, C); const int Rb = Epi::PERM ? ((R & ~31) + perm32(R & 31)) : R;
        voffA[i] = (unsigned)(R * K * ES + C * 2); voffB[i] = (unsigned)(Rb * K * ES + C * 2); }
    const unsigned kstep = (unsigned)(BK * 2);
    const unsigned hstep = (unsigned)(HALF * K * ES);
        const unsigned ldsw = (unsigned)wid * 1024u;
    const int aoff = lds_byte(wr * 64 + fr, ES == 2 ? fq * 8 : fq * 16), boff = lds_byte(wc * 32 + fr, ES == 2 ? fq * 8 : fq * 16); constexpr int KOFF = (ES == 2) ? 1024 : 16;
#define PG8_SA(b, h) (((b) * 2 + (h)) * HTB)
#define PG8_SB(b, h) ((4 + (b) * 2 + (h)) * HTB)
#define PG8_STAGE(bufoff, gbase, voff) do { _Pragma("unroll") for (int _i = 0; _i < 2; ++_i) \
        __builtin_amdgcn_raw_ptr_buffer_load_lds(rsrc, (PG8_LAS unsigned*)(lds + (bufoff) + ldsw + _i * 8192), 16, (voff)[_i], (gbase), 0, 0); } while (0)
#define PG8_LDA(dst, b, h) do { _Pragma("unroll") for (int m = 0; m < 4; ++m) _Pragma("unroll") for (int k = 0; k < 2; ++k) dst[m][k] = *(const PG8_LAS bf16x8*)(lds + PG8_SA(b, h) + aoff + m * 2048 + k * KOFF); } while (0)
#define PG8_LDA8(dst, b, h) do { _Pragma("unroll") for (int m = 0; m < 4; ++m) { const PG8_LAS v4i* p_ = (const PG8_LAS v4i*)(lds + PG8_SA(b, h) + aoff + m * 2048); const v4i x_ = p_[0], y_ = p_[1]; dst[m] = __builtin_shufflevector(x_, y_, 0, 1, 2, 3, 4, 5, 6, 7); } } while (0)
#define PG8_LDB(dst, b, h) do { _Pragma("unroll") for (int n = 0; n < 2; ++n) _Pragma("unroll") for (int k = 0; k < 2; ++k) dst[n][k] = *(const PG8_LAS bf16x8*)(lds + PG8_SB(b, h) + boff + n * 2048 + k * KOFF); } while (0)
#define PG8_LDB8(dst, b, h) do { _Pragma("unroll") for (int n = 0; n < 2; ++n) { const PG8_LAS v4i* p_ = (const PG8_LAS v4i*)(lds + PG8_SB(b, h) + boff + n * 2048); const v4i x_ = p_[0], y_ = p_[1]; dst[n] = __builtin_shufflevector(x_, y_, 0, 1, 2, 3, 4, 5, 6, 7); } } while (0)
#define PG8_MMA(ai, bj, At, Bt) do { __builtin_amdgcn_s_setprio(1); _Pragma("unroll") for (int m = 0; m < 4; ++m) _Pragma("unroll") for (int n = 0; n < 2; ++n) { \
        if constexpr (ES == 2) { _Pragma("unroll") for (int k = 0; k < 2; ++k) acc[ai][bj][m][n] = __builtin_amdgcn_mfma_f32_16x16x32_bf16(Bt[n][k], At[m][k], acc[ai][bj][m][n], 0, 0, 0); } \
        else asm volatile("v_mfma_f32_16x16x128_f8f6f4 %0, %1, %2, %0" : "+v"(acc[ai][bj][m][n]) : "v"(Bt##8[n]), "v"(At##8[m])); } \
        __builtin_amdgcn_s_setprio(0); } while (0)
#define PG8_LDAX(b, h) do { if constexpr (ES == 2) PG8_LDA(At, b, h); else PG8_LDA8(At8, b, h); } while (0)
#define PG8_LDBX(B, b, h) do { if constexpr (ES == 2) PG8_LDB(B, b, h); else PG8_LDB8(B##8, b, h); } while (0)
#define PG8_WAIT_V(n) asm volatile("s_waitcnt vmcnt(" #n ")" ::: "memory")
#define PG8_WAIT_L(n) asm volatile("s_waitcnt lgkmcnt(" #n ")" ::: "memory")
#define PG8_BAR __builtin_amdgcn_s_barrier()
#define PG8_SCHED __builtin_amdgcn_sched_barrier(0)
    Unit cur, nxt; int ui = 0;
    if (!S.next(0, cur)) return;
    f32x4 acc[2][2][4][2];
    E.init(acc, cur, wc, fq);
    bf16x8 At[4][2], B0[2][2], B1[2][2]; v8i At8[4], B08[2], B18[2];
    unsigned cA = S.pa(cur), cB = S.pb(cur);
    if constexpr (SP2) {
        PG8_STAGE(PG8_SB(0, 0), cB, voffB); PG8_STAGE(PG8_SB(0, 1), cB + hstep, voffB); PG8_STAGE(PG8_SA(0, 0), cA, voffA); PG8_STAGE(PG8_SA(0, 1), cA + hstep, voffA);
        if (wr == 1) PG8_BAR;
        PG8_WAIT_V(2); PG8_BAR;
        PG8_STAGE(PG8_SB(1, 0), cB + kstep, voffB); PG8_STAGE(PG8_SA(1, 0), cA + kstep, voffA); PG8_STAGE(PG8_SB(1, 1), cB + hstep + kstep, voffB);
        PG8_WAIT_V(6); PG8_BAR;
    } else {
        PG8_STAGE(PG8_SB(0, 0), cB, voffB); PG8_STAGE(PG8_SA(0, 0), cA, voffA); PG8_STAGE(PG8_SB(0, 1), cB + hstep, voffB); PG8_STAGE(PG8_SA(0, 1), cA + hstep, voffA);
        if (wr == 1) PG8_BAR;
        PG8_WAIT_V(4); PG8_BAR;
        PG8_STAGE(PG8_SB(1, 0), cB + kstep, voffB); PG8_STAGE(PG8_SA(1, 0), cA + kstep, voffA); PG8_STAGE(PG8_SB(1, 1), cB + hstep + kstep, voffB);
        PG8_WAIT_V(6); PG8_BAR;
    }
    for (;;) {
        const bool has_next = S.next(ui + 1, nxt);
        const unsigned nA = has_next ? S.pa(nxt) : cA, nB = has_next ? S.pb(nxt) : cB;
        for (int t = 0; t < nt; t += 2) {
            const bool last = (t == nt - 2);
            const unsigned a1 = cA + (unsigned)(t + 1) * kstep;
            const unsigned a2 = last ? nA : cA + (unsigned)(t + 2) * kstep, b2 = last ? nB : cB + (unsigned)(t + 2) * kstep;
            const unsigned a3 = a2 + kstep, b3 = b2 + kstep;
            if constexpr (SP2) {
            PG8_LDBX(B0, 0, 0); PG8_LDBX(B1, 0, 1); PG8_SCHED; PG8_LDAX(0, 0); PG8_STAGE(PG8_SA(1, 1), a1 + hstep, voffA);
            PG8_WAIT_V(8); PG8_WAIT_L(0); PG8_BAR; PG8_MMA(0, 0, At, B0); PG8_MMA(0, 1, At, B1); PG8_BAR; PG8_SCHED;
            PG8_LDAX(0, 1); PG8_STAGE(PG8_SB(0, 0), b2, voffB); PG8_STAGE(PG8_SB(0, 1), b2 + hstep, voffB); PG8_STAGE(PG8_SA(0, 0), a2, voffA);
            PG8_WAIT_V(8); PG8_WAIT_L(0); PG8_BAR; PG8_MMA(1, 0, At, B0); PG8_MMA(1, 1, At, B1); PG8_BAR; PG8_SCHED;
            PG8_LDBX(B0, 1, 0); PG8_LDBX(B1, 1, 1); PG8_SCHED; PG8_LDAX(1, 0); PG8_STAGE(PG8_SA(0, 1), a2 + hstep, voffA);
            PG8_WAIT_V(8); PG8_WAIT_L(0); PG8_BAR; PG8_MMA(0, 0, At, B0); PG8_MMA(0, 1, At, B1); PG8_BAR; PG8_SCHED;
            PG8_LDAX(1, 1); PG8_STAGE(PG8_SB(1, 0), b3, voffB); PG8_STAGE(PG8_SB(1, 1), b3 + hstep, voffB); PG8_STAGE(PG8_SA(1, 0), a3, voffA);
            PG8_WAIT_V(8); PG8_WAIT_L(0); PG8_BAR; PG8_MMA(1, 0, At, B0); PG8_MMA(1, 1, At, B1); PG8_BAR; PG8_SCHED;
            } else {
            PG8_LDBX(B0, 0, 0); PG8_SCHED; PG8_LDAX(0, 0); PG8_STAGE(PG8_SA(1, 1), a1 + hstep, voffA);
            PG8_WAIT_L(8); PG8_BAR; PG8_WAIT_L(0); PG8_MMA(0, 0, At, B0); PG8_BAR; PG8_SCHED;
            PG8_LDBX(B1, 0, 1); PG8_STAGE(PG8_SB(0, 0), b2, voffB);
            PG8_BAR; PG8_WAIT_L(0); PG8_MMA(0, 1, At, B1); PG8_BAR;
            PG8_LDAX(0, 1); PG8_STAGE(PG8_SA(0, 0), a2, voffA);
            PG8_BAR; PG8_WAIT_L(0); PG8_MMA(1, 0, At, B0); PG8_BAR; PG8_SCHED;
            PG8_STAGE(PG8_SB(0, 1), b2 + hstep, voffB);
            PG8_WAIT_V(6); PG8_BAR; PG8_MMA(1, 1, At, B1); PG8_BAR;
            PG8_LDBX(B0, 1, 0); PG8_SCHED; PG8_LDAX(1, 0); PG8_STAGE(PG8_SA(0, 1), a2 + hstep, voffA);
            PG8_WAIT_L(8); PG8_BAR; PG8_WAIT_L(0); PG8_MMA(0, 0, At, B0); PG8_BAR; PG8_SCHED;
            PG8_LDBX(B1, 1, 1); PG8_STAGE(PG8_SB(1, 0), b3, voffB);
            PG8_BAR; PG8_WAIT_L(0); PG8_MMA(0, 1, At, B1); PG8_BAR;
            PG8_LDAX(1, 1); PG8_STAGE(PG8_SA(1, 0), a3, voffA);
            PG8_BAR; PG8_WAIT_L(0); PG8_MMA(1, 0, At, B0); PG8_BAR; PG8_SCHED;
            PG8_STAGE(PG8_SB(1, 1), b3 + hstep, voffB);
            PG8_WAIT_V(6); PG8_BAR; PG8_MMA(1, 1, At, B1); PG8_BAR;
            }
        }
        if constexpr (ALIGN_EPI) { if (wr == 0) PG8_BAR; }
        if constexpr (ES == 1) asm volatile("s_nop 15\n\ts_nop 15" ::: "memory");
        E(acc, cur, wr, wc, fr, fq);
        if (!has_next) break;
        E.init(acc, nxt, wc, fq);
        cur = nxt; cA = nA; cB = nB; ++ui;
        if constexpr (ALIGN_EPI) { if (wr == 1) PG8_BAR; }
    }
    PG8_WAIT_V(0);
    if constexpr (!ALIGN_EPI) { if (wr == 0) PG8_BAR; }
    PG8_BAR;
#undef PG8_SA
#undef PG8_SB
#undef PG8_STAGE
#undef PG8_LDA
#undef PG8_LDA8
#undef PG8_LDB8
#undef PG8_LDAX
#undef PG8_LDBX
#undef PG8_LDB
#undef PG8_MMA
#undef PG8_WAIT_V
#undef PG8_WAIT_L
#undef PG8_BAR
#undef PG8_SCHED
}
}

#define XB_TMO      128
#define XB_XCNT(j)  (256  + 64 * (j))
#define XB_XSUB(j)  (1280 + 64 * (j))
#define XB_XGEN(j)  (2304 + 64 * (j))
#define XB_TOP      3328
#define XB_TOPGEN   3392
#define XCD_BAR_WORDS 3456
#define XB_SPIN_CAP (1u << 18)
__device__ __forceinline__ unsigned xb_ld(unsigned* p)              { return __hip_atomic_load(p, __ATOMIC_RELAXED, __HIP_MEMORY_SCOPE_AGENT); }
__device__ __forceinline__ unsigned xb_add(unsigned* p, unsigned v) { return __hip_atomic_fetch_add(p, v, __ATOMIC_RELAXED, __HIP_MEMORY_SCOPE_AGENT); }
__device__ __forceinline__ unsigned xb_xcc_id() { return (unsigned)__builtin_amdgcn_s_getreg((3 << 11) | 20) & 0xFu; }
#define XB_SPIN(cond, bar) do { unsigned _sp = 0; while (cond) { __builtin_amdgcn_s_sleep(1); \
    if ((++_sp & 255u) == 0u) { if (xb_ld(&(bar)[XB_TMO])) break; if (_sp > XB_SPIN_CAP) { atomicAdd(&(bar)[XB_TMO], 1u); break; } } } } while (0)

struct XcdBarrier {
    unsigned* bar; unsigned x;
    volatile LAS unsigned* st;
};

__device__ __forceinline__ XcdBarrier xcd_barrier_post(unsigned* bar, volatile LAS unsigned* st) {
    XcdBarrier b; b.bar = bar; b.x = xb_xcc_id(); b.st = st;
    if (threadIdx.x == 0) (void)xb_add(&bar[XB_XCNT(b.x)], 1u);
    return b;
}
__device__ __forceinline__ void xcd_barrier_complete(unsigned* bar, unsigned x, unsigned& nloc, unsigned& nx) {
    const unsigned G = gridDim.x * gridDim.y * gridDim.z;
    unsigned sum, cnt, mine, sp = 0u;
    for (;;) {
        sum = 0u; cnt = 0u; mine = 0u;
#pragma unroll
        for (unsigned j = 0; j < 16; ++j) { const unsigned c = xb_ld(&bar[XB_XCNT(j)]); sum += c; cnt += (c > 0u) ? 1u : 0u; mine = (j == x) ? c : mine; }
        if (sum == G) break;
        __builtin_amdgcn_s_sleep(1);
        if ((++sp & 255u) == 0u) { if (xb_ld(&bar[XB_TMO])) break; if (sp > XB_SPIN_CAP) { atomicAdd(&bar[XB_TMO], 1u); break; } }
    }
    nloc = mine > 0u ? mine : 1u; nx = cnt > 0u ? cnt : 1u;
}

__device__ __forceinline__ void xcd_barrier(const XcdBarrier& b) {
    asm volatile("s_waitcnt vmcnt(0)" ::: "memory");
    __syncthreads();
    if (threadIdx.x == 0) {
        unsigned* bar = b.bar;
        __builtin_amdgcn_s_waitcnt(0);
        unsigned nloc = b.st[0], nx = b.st[1];
        if (nloc == 0u) { xcd_barrier_complete(bar, b.x, nloc, nx); b.st[0] = nloc; b.st[1] = nx; }
        const unsigned old = xb_add(&bar[XB_XSUB(b.x)], 1u);
        const unsigned gen = old / nloc;
        if (old + 1u == (gen + 1u) * nloc) {
            __builtin_amdgcn_fence(__ATOMIC_RELEASE, "agent");
            asm volatile("s_waitcnt vmcnt(0)" ::: "memory");
            const unsigned og = xb_add(&bar[XB_TOP], 1u);
            const unsigned tg = og / nx;
            if (og + 1u == (tg + 1u) * nx) xb_add(&bar[XB_TOPGEN], 1u);
            else XB_SPIN(xb_ld(&bar[XB_TOPGEN]) == tg, bar);
            __builtin_amdgcn_fence(__ATOMIC_ACQUIRE, "agent");
            xb_add(&bar[XB_XGEN(b.x)], 1u);
            asm volatile("s_waitcnt vmcnt(0)" ::: "memory");
        } else {
            XB_SPIN(xb_ld(&bar[XB_XGEN(b.x)]) == gen, bar);
            __builtin_amdgcn_fence(__ATOMIC_ACQUIRE, "agent");
            asm volatile("s_waitcnt vmcnt(0)" ::: "memory");
        }
    }
    __syncthreads();
}

typedef short s4v __attribute__((ext_vector_type(4)));
__device__ __forceinline__ bf16x8 ldg8(const bf16* p) { return *(const bf16x8*)p; }
__device__ __forceinline__ f32x4 mfma16(bf16x8 a, bf16x8 b, f32x4 c) { return __builtin_amdgcn_mfma_f32_16x16x32_bf16(a, b, c, 0, 0, 0); }
__device__ __forceinline__ bf16x8 ldA(const LAS unsigned char* base, int pitch, int row0, int k0, int li, int g) { return *(const LAS bf16x8*)(base + ((row0 + li) * pitch + k0 + 8 * g) * 2); }
__device__ __forceinline__ bf16x8 ldT(const LAS unsigned char* base, int pitch, int k0, int n0, int li, int g) {
    const LAS unsigned char* p = base + ((k0 + 8 * g + (li >> 2)) * pitch + n0 + 4 * (li & 3)) * 2;
    const s4v a = __builtin_amdgcn_ds_read_tr16_b64_v4i16((LAS s4v*)p), b = __builtin_amdgcn_ds_read_tr16_b64_v4i16((LAS s4v*)(p + 8 * pitch));
    return (bf16x8){a[0], a[1], a[2], a[3], b[0], b[1], b[2], b[3]};
}
__device__ __forceinline__ bf16x8 ldAperm(const LAS unsigned char* base, int pitch, int row0, int ks, int li, int g) {
    const LAS unsigned char* p = base + ((row0 + li) * pitch + 32 * ks + 4 * g) * 2;
    const s4v a = *(const LAS s4v*)p, b = *(const LAS s4v*)(p + 32);
    return (bf16x8){a[0], a[1], a[2], a[3], b[0], b[1], b[2], b[3]};
}
__device__ __forceinline__ void stT(LAS unsigned char* base, int pitch, int n, int m0, const f32x4 v) {
    u32x2 w; w.x = pk2(v[0], v[1]); w.y = pk2(v[2], v[3]); *(LAS u32x2*)(base + (n * pitch + m0) * 2) = w;
}
__device__ __forceinline__ f32x4 ld4bf(const LAS unsigned char* p) { const u32x2 w = *(const LAS u32x2*)p; return (f32x4){bflo(w.x), bfhi(w.x), bflo(w.y), bfhi(w.y)}; }

struct Args {
    const float* in[31];
    float* out; unsigned char* ws;
    int ph_lo, ph_hi, use_bar, pad;
};
enum InIdx { I_X = 0, I_C, I_CTX, I_CCTX, I_ADAW, I_ADAB, I_N1G, I_N2G, I_WIN, I_WOUT, I_ASINK, I_BMIX, I_CREL, I_DCONV, I_DW0, I_DW2, I_DA0, I_DA2, I_DG2, I_DKK, I_DKA, I_DRK, I_DLNW, I_DLNB,
             I_RW, I_RB, I_WGU, I_BGU, I_WDN, I_BDN, I_FNG };
constexpr int NPL = 11;
constexpr int PH_TOTAL = 1 + DEPTH * NPL + 1;

struct DevIn {
    const LAS unsigned* tab;
    __device__ __forceinline__ const float* operator[](int i) const {
        const unsigned lo = __builtin_amdgcn_readfirstlane(((const volatile LAS unsigned*)tab)[2 * i]), hi = __builtin_amdgcn_readfirstlane(((const volatile LAS unsigned*)tab)[2 * i + 1]);
        return (const float*)(((unsigned long long)hi << 32) | lo);
    }
};
struct DArgs { DevIn in; float* out; };
struct Ctx {
    LAS unsigned char* lds;
    int tid, lane, wave, wg, G, gw, NGW;
    unsigned char* ws;
};

template <int NW>
__device__ __forceinline__ void transpose_item(const float* W, int K, int N, bf16* WT, int item, int lane) {
    constexpr int NQ = NW / 4, NC = 64 / NQ, PASSES = 8 / NC;
    const int nblk = N / NW, kb = item / nblk, nb = item % nblk, k0 = 64 * kb, n0 = NW * nb, nq = lane % NQ, cq = lane / NQ;
    f32x4 v[PASSES][8];
#pragma unroll
    for (int ps = 0; ps < PASSES; ++ps)
#pragma unroll
        for (int i = 0; i < 8; ++i) v[ps][i] = *(const f32x4*)(W + (size_t)(k0 + 8 * (cq + NC * ps) + i) * N + n0 + 4 * nq);
#pragma unroll
    for (int ps = 0; ps < PASSES; ++ps)
#pragma unroll
        for (int j = 0; j < 4; ++j) { u32x4 o; o.x = pk2(v[ps][0][j], v[ps][1][j]); o.y = pk2(v[ps][2][j], v[ps][3][j]); o.z = pk2(v[ps][4][j], v[ps][5][j]); o.w = pk2(v[ps][6][j], v[ps][7][j]);
            *(u32x4*)(WT + (size_t)(n0 + 4 * nq + j) * K + k0 + 8 * (cq + NC * ps)) = o; }
}
template <int NW>
__device__ __forceinline__ void transpose_item8(const float* W, int K, int N, unsigned char* WT, int item, int lane) {
    constexpr int NQ = NW / 4, NC = 64 / NQ, PASSES = 8 / NC;
    const int nblk = N / NW, kb = item / nblk, nb = item % nblk, k0 = 64 * kb, n0 = NW * nb, nq = lane % NQ, cq = lane / NQ;
    f32x4 v[PASSES][8];
#pragma unroll
    for (int ps = 0; ps < PASSES; ++ps)
#pragma unroll
        for (int i = 0; i < 8; ++i) v[ps][i] = __builtin_nontemporal_load((const f32x4*)(W + (size_t)(k0 + 8 * (cq + NC * ps) + i) * N + n0 + 4 * nq)) * pg8::W8_S;
#pragma unroll
    for (int ps = 0; ps < PASSES; ++ps)
#pragma unroll
        for (int j = 0; j < 4; ++j) { unsigned w0 = 0, w1 = 0;
            w0 = __builtin_amdgcn_cvt_pk_fp8_f32(v[ps][0][j], v[ps][1][j], w0, false); w0 = __builtin_amdgcn_cvt_pk_fp8_f32(v[ps][2][j], v[ps][3][j], w0, true);
            w1 = __builtin_amdgcn_cvt_pk_fp8_f32(v[ps][4][j], v[ps][5][j], w1, false); w1 = __builtin_amdgcn_cvt_pk_fp8_f32(v[ps][6][j], v[ps][7][j], w1, true);
            __builtin_nontemporal_store((u32x2){w0, w1}, (u32x2*)(WT + (size_t)(n0 + 4 * nq + j) * K + k0 + 8 * (cq + NC * ps))); }
}
constexpr int CV_IT_GU = 16 * 64, CV_IT_DN = 16 * 32, CV_N_GU = 32 * CV_IT_GU, CV_N_DN = 32 * CV_IT_DN, CV_ITEMS = CV_N_GU + CV_N_DN, CV_CHUNK = 16, CV_NCHUNK = CV_ITEMS / CV_CHUNK;
__device__ __forceinline__ void convert_moe_items(const Ctx& C, const DArgs& a, int l, int it0, int it1) {
    const float* pwgu = a.in[I_WGU] + (size_t)l * 32 * DM * 2048; const float* pwdn = a.in[I_WDN] + (size_t)l * 32 * DM * DM;
    unsigned char* ogu = C.ws + WS_WGU + (size_t)l * 32 * 2048 * DM; unsigned char* odn = C.ws + WS_WDN + (size_t)l * 32 * DM * DM;
#pragma unroll 1
    for (int it = it0; it < it1; ++it) {
        if (it < CV_N_GU) { const int e = it / CV_IT_GU; transpose_item8<32>(pwgu + (size_t)e * DM * 2048, DM, 2048, ogu + (size_t)e * 2048 * DM, it % CV_IT_GU, C.lane); }
        else { const int r = it - CV_N_GU, e = r / CV_IT_DN; transpose_item8<32>(pwdn + (size_t)e * DM * DM, DM, DM, odn + (size_t)e * DM * DM, r % CV_IT_DN, C.lane); }
    }
}
__device__ __forceinline__ void phase_prologue(const Ctx& C, const DArgs& a) {
    constexpr int IT_IN = 16 * (INW / 32), IT_OUT = 16 * 16;
    constexpr int N_IN = 4 * IT_IN, N_OUT = 4 * IT_OUT;
    const float* pwin = a.in[I_WIN]; const float* pwout = a.in[I_WOUT];
    for (int it = C.gw; it < N_IN + N_OUT; it += C.NGW) {
        if (it < N_IN) { const int l = it / IT_IN; transpose_item<32>(pwin + (size_t)l * DM * INW, DM, INW, (bf16*)(C.ws + WS_WIN) + (size_t)l * INWP * DM, it % IT_IN, C.lane); }
        else { const int r = it - N_IN, l = r / IT_OUT; transpose_item<64>(pwout + (size_t)l * DM * DM, DM, DM, (bf16*)(C.ws + WS_WOUT) + (size_t)l * DM * DM, r % IT_OUT, C.lane); }
    }
    for (int ch = C.gw; ch < CV_NCHUNK; ch += C.NGW) convert_moe_items(C, a, 0, ch * CV_CHUNK, ch * CV_CHUNK + CV_CHUNK);
    { const int gt = C.wg * NTHR + C.tid; constexpr int PADN = (INWP - INW) * DM / 8;
      for (int i = gt; i < 4 * PADN; i += C.G * NTHR) { const int l = i / PADN, r = i % PADN; *((u32x4*)((bf16*)(C.ws + WS_WIN) + ((size_t)l * INWP + INW) * DM) + r) = (u32x4){0u, 0u, 0u, 0u}; } }
    { float* tw = (float*)(C.ws + WS_TW); const int gt = C.wg * NTHR + C.tid;
      for (int i = gt; i < 16384; i += C.G * NTHR) { const float x = (float)i * (1.0f / 8192.0f); tw[i] = cospif(x); tw[16384 + i] = sinpif(x); } }
    { float* mt = (float*)(C.ws + WS_MTAB); const int gt = C.wg * NTHR + C.tid; const float* pbmix = a.in[I_BMIX];
      for (int i = gt; i < 4 * 4 * 64 * 64; i += C.G * NTHR) { const int e = i & 63, c = (i >> 6) & 63, g = (i >> 12) & 3, l = i >> 14;
          const float* w = pbmix + ((size_t)(l * 4 + g) * 64) * 64 + e; float sc = 0.f, ss = 0.f;
          for (int cp = 0; cp < 64; ++cp) { const float x = (float)((c * cp) & 63) * (1.0f / 32.0f); const float wv = w[cp * 64]; sc += cospif(x) * wv; ss += sinpif(x) * wv; }
          mt[((size_t)(l * 2 + 0) * 4 + g) * 4096 + c * 64 + e] = sc; mt[((size_t)(l * 2 + 1) * 4 + g) * 4096 + c * 64 + e] = ss; } }
    { bf16* ft = (bf16*)(C.ws + WS_FTAB); const int gt = C.wg * NTHR + C.tid; const float* pbmix = a.in[I_BMIX];
      for (int i = gt; i < 128 * 128; i += C.G * NTHR) { const int k = i >> 7, t = i & 127; const float x = (float)((k * t) & 127) * (1.0f / 64.0f); ft[i] = (bf16)f2bf(cospif(x)); ft[16384 + i] = (bf16)f2bf(sinpif(x)); }
      bf16* mf = ft + 32768;
      for (int i = gt; i < 4 * 4 * 16 * 64 * 8; i += C.G * NTHR) { const int j8 = i & 7, ln = (i >> 3) & 63, fr = (i >> 9) & 15, gq = (i >> 13) & 3, l = i >> 15;
          const int ei = fr >> 2, ks2 = fr & 3, e = 16 * ei + (ln & 15), g = ln >> 4, c = 32 * (ks2 & 1) + 16 * (j8 >> 2) + 4 * g + (j8 & 3), part = ks2 >> 1;
          const float* w = pbmix + ((size_t)(l * 4 + gq) * 64) * 64 + e; float s = 0.f;
          for (int cp = 0; cp < 64; ++cp) { const float x = (float)((c * cp) & 63) * (1.0f / 32.0f); s += (part ? sinpif(x) : cospif(x)) * w[cp * 64]; }
          mf[i] = (bf16)f2bf(s * (1.0f / 1024.0f)); } }
    { const int gt = C.wg * NTHR + C.tid; const float* pg2 = a.in[I_DG2]; const float* prw = a.in[I_RW]; bf16* g2t = (bf16*)(C.ws + WS_G2T); bf16* rwt = (bf16*)(C.ws + WS_RWT);
      for (int i = gt; i < 4 * 256 * 160; i += C.G * NTHR) { const int ii = i % 160, c = (i / 160) & 255, l = i / (160 * 256); g2t[i] = (bf16)f2bf(pg2[((size_t)l * 160 + ii) * 256 + c]); }
      for (int i = gt; i < 4 * 32 * 1024; i += C.G * NTHR) { const int k = i & 1023, e = (i >> 10) & 31, l = i >> 15; rwt[i] = (bf16)f2bf(prw[((size_t)l * 1024 + k) * 32 + e]); } }
    { const int gt = C.wg * NTHR + C.tid; const float* pw2 = a.in[I_DW2]; const float* pa2 = a.in[I_DA2]; bf16* lt = (bf16*)(C.ws + WS_LORAT);
      for (int i = gt; i < 4 * 4 * 256 * 64; i += C.G * NTHR) { const int ii = i & 63, c = (i >> 6) & 255, q = (i >> 14) & 3, l = i >> 16;
          const float* src = (q < 2) ? pw2 : pa2; lt[i] = (bf16)f2bf(src[(((size_t)l * 2 + (q & 1)) * 64 + ii) * 256 + c]); } }
    { bf16* f2 = (bf16*)(C.ws + WS_F256); const int gt = C.wg * NTHR + C.tid;
      for (int i = gt; i < 256 * 256; i += C.G * NTHR) { const int k = i >> 8, t = i & 255; const float x = (float)((k * t) & 255) * (1.0f / 128.0f); f2[i] = (bf16)f2bf(cospif(x)); f2[65536 + i] = (bf16)f2bf(sinpif(x)); } }
    { LAS float* sl = (LAS float*)(C.lds);
      LAS float* red = (LAS float*)(C.lds + 8192);
      __syncthreads();
      const float* pc = a.in[I_C]; const float* pcc = a.in[I_CCTX]; const float* padaw = a.in[I_ADAW]; const float* padab = a.in[I_ADAB];
      for (int i = C.tid; i < 2048; i += NTHR) { const float x = (i < 1024) ? pc[i] : pcc[i - 1024]; sl[i] = x * sigmoidf_(x); }
      __syncthreads();
      float* mod = (float*)(C.ws + WS_MOD);
      for (int u = C.wg; u < 4 * 96; u += C.G) { const int l = u / 96, jb = u % 96, j0 = jb * 64 + C.lane;
          float s0 = 0.f, s1 = 0.f; const float* w = padaw + (size_t)l * DM * 6144 + j0; const int k0 = C.wave * 128;
#pragma unroll 16
          for (int k = 0; k < 128; ++k) { const float wv = w[(size_t)(k0 + k) * 6144]; s0 += wv * sl[k0 + k]; s1 += wv * sl[1024 + k0 + k]; }
          red[(C.wave * 2 + 0) * 64 + C.lane] = s0; red[(C.wave * 2 + 1) * 64 + C.lane] = s1;
          __syncthreads();
          if (C.tid < 128) { const int v = C.tid >> 6, j = C.tid & 63; float s = 0.f;
#pragma unroll
              for (int wv = 0; wv < 8; ++wv) s += red[(wv * 2 + v) * 64 + j];
              mod[(size_t)(l * 2 + v) * 6144 + jb * 64 + j] = s + padab[(size_t)l * 6144 + jb * 64 + j]; }
          __syncthreads(); } }
}

__device__ __forceinline__ void load_row(const float* p, int lane, f32x4 (&v)[4]) {
#pragma unroll
    for (int j = 0; j < 4; ++j) v[j] = *((const f32x4*)p + lane + 64 * j);
}
__device__ __forceinline__ void moe_combine_row(const Ctx& C, int row, f32x4 (&v)[4], const float* gt2) {
    const int* dest = (const int*)(C.ws + WS_ROUTE) + (size_t)3 * ROWS * 4; const float* gate = (const float*)(C.ws + WS_ROUTE) + (size_t)1 * ROWS * 4;
    const bf16* YB = (const bf16*)(C.ws + WS_XG);
    f32x4 s[4];
#pragma unroll
    for (int j = 0; j < 4; ++j) s[j] = (f32x4){0.f, 0.f, 0.f, 0.f};
#pragma unroll
    for (int k = 0; k < 4; ++k) { const int d = dest[row * 4 + k]; const float g = gate[row * 4 + k]; const u32x2* yp = (const u32x2*)(YB + (size_t)d * DM) + C.lane;
#pragma unroll
        for (int j = 0; j < 4; ++j) { const u32x2 w = yp[64 * j]; s[j] += (f32x4){bflo(w.x), bfhi(w.x), bflo(w.y), bfhi(w.y)} * g; } }
#pragma unroll
    for (int j = 0; j < 4; ++j) v[j] += *((const f32x4*)gt2 + C.lane + 64 * j) * s[j];
}
__device__ __forceinline__ float row_rstd(const f32x4 (&v)[4], int lane) {
    float s = 0.f;
#pragma unroll
    for (int j = 0; j < 4; ++j) s += (v[j].x * v[j].x + v[j].y * v[j].y) + (v[j].z * v[j].z + v[j].w * v[j].w);
    return rsqrtf(wave_sum(s, lane) * (1.f / DM) + 1e-6f);
}
__device__ __forceinline__ void norm1_fetch(const Ctx& C, const float* src_row, int row, bool combine, const float* gt2, f32x4 (&v)[4]) {
    load_row(src_row, C.lane, v);
    if (combine) moe_combine_row(C, row, v, gt2);
}
__device__ __forceinline__ void phase_norm1(const Ctx& C, const DArgs& a, int l) {
    float* XS = (float*)(C.ws + WS_XS); bf16* H = (bf16*)(C.ws + WS_H); const float* mod = (const float*)(C.ws + WS_MOD);
    const float* g1 = a.in[I_N1G] + (size_t)l * DM;
    const float* pctx = a.in[I_CTX]; const float* px = a.in[I_X];
    for (int row0 = C.gw; row0 < ROWS; row0 += 2 * C.NGW) {
        f32x4 v[2][4]; const int rows[2] = {row0, row0 + C.NGW};
#pragma unroll
        for (int q = 0; q < 2; ++q) if (rows[q] < ROWS) { const int row = rows[q]; const bool isctx = row < NCTX;
            const float* src = (l == 0) ? (isctx ? pctx + (size_t)row * DM : px + (size_t)(row - NCTX) * DM) : XS + (size_t)row * DM;
            norm1_fetch(C, src, row, l > 0, mod + (size_t)((l > 0 ? l - 1 : 0) * 2 + (isctx ? 1 : 0)) * 6144 + 5 * DM, v[q]); }
#pragma unroll
        for (int q = 0; q < 2; ++q) if (rows[q] < ROWS) { const int row = rows[q]; const bool isctx = row < NCTX;
#pragma unroll
            for (int j = 0; j < 4; ++j) *((f32x4*)(XS + (size_t)row * DM) + C.lane + 64 * j) = v[q][j];
            const float rstd = row_rstd(v[q], C.lane);
            const float* md = mod + (size_t)(l * 2 + (isctx ? 1 : 0)) * 6144;
            u32x2* o = (u32x2*)(H + (size_t)row * DM) + C.lane;
#pragma unroll
            for (int j = 0; j < 4; ++j) { const f32x4 g = *((const f32x4*)g1 + C.lane + 64 * j), sh = *((const f32x4*)md + C.lane + 64 * j), sc = *((const f32x4*)(md + DM) + C.lane + 64 * j);
                const f32x4 y = v[q][j] * rstd * g * (sc + 1.0f) + sh; u32x2 w; w.x = pk2(y.x, y.y); w.y = pk2(y.z, y.w); o[64 * j] = w; } }
    }
}
__device__ __forceinline__ void phase_final(const Ctx& C, const DArgs& a) {
    const float* XS = (const float*)(C.ws + WS_XS); const float* mod = (const float*)(C.ws + WS_MOD); const float* g = a.in[I_FNG];
    const float* gt2 = mod + (size_t)((DEPTH - 1) * 2 + 0) * 6144 + 5 * DM;
    for (int row0 = NCTX + C.gw; row0 < ROWS; row0 += 2 * C.NGW) {
        f32x4 v[2][4]; const int rows[2] = {row0, row0 + C.NGW};
#pragma unroll
        for (int q = 0; q < 2; ++q) if (rows[q] < ROWS) norm1_fetch(C, XS + (size_t)rows[q] * DM, rows[q], true, gt2, v[q]);
#pragma unroll
        for (int q = 0; q < 2; ++q) if (rows[q] < ROWS) { const float rstd = row_rstd(v[q], C.lane); float* o = a.out + (size_t)(rows[q] - NCTX) * DM;
#pragma unroll
            for (int j = 0; j < 4; ++j) *((f32x4*)o + C.lane + 64 * j) = v[q][j] * rstd * *((const f32x4*)g + C.lane + 64 * j); }
    }
}
constexpr int NR2 = 9;
__device__ __forceinline__ void phase_norm2(const Ctx& C, const DArgs& a, int l) {
    const float* XS = (const float*)(C.ws + WS_XS); bf16* H = (bf16*)(C.ws + WS_H); const float* mod = (const float*)(C.ws + WS_MOD);
    const float* g2 = a.in[I_N2G] + (size_t)l * DM; const float* rb = a.in[I_RB] + (size_t)l * NEXP; const bf16* rwt = (const bf16*)(C.ws + WS_RWT) + (size_t)l * NEXP * DM;
    int* tok_e = (int*)(C.ws + WS_ROUTE); float* gate = (float*)(C.ws + WS_ROUTE) + (size_t)1 * ROWS * 4; int* slot = (int*)(C.ws + WS_ROUTE) + (size_t)2 * ROWS * 4;
    LAS float* lg = (LAS float*)(C.lds + C.wave * 4096);
    LAS int* hist = (LAS int*)(C.lds + MISC_OFF + 64);
    const int lane = C.lane, li = lane & 15, g = lane >> 4;
    if (C.tid < NEXP) hist[C.tid] = 0;
    __syncthreads();
    const int row_base = (l == DEPTH - 1) ? NCTX : 0, ntile = (ROWS - row_base + NR2 - 1) / NR2;
    for (int tl = C.gw; tl < ntile; tl += C.NGW) {
        const int trow0 = row_base + NR2 * tl, nrow = (ROWS - trow0 < NR2) ? ROWS - trow0 : NR2;
#pragma unroll 1
        for (int rr = 0; rr < nrow; ++rr) { const int row = trow0 + rr; const bool isctx = row < NCTX; f32x4 v[4]; load_row(XS + (size_t)row * DM, lane, v);
            const float rstd = row_rstd(v, lane);
            const float* md = mod + (size_t)(l * 2 + (isctx ? 1 : 0)) * 6144 + 3 * DM;
            u32x2* o = (u32x2*)(H + (size_t)row * DM) + lane;
#pragma unroll
            for (int j = 0; j < 4; ++j) { const f32x4 gg = *((const f32x4*)g2 + lane + 64 * j), sh = *((const f32x4*)md + lane + 64 * j), sc = *((const f32x4*)(md + DM) + lane + 64 * j);
                const f32x4 y = v[j] * rstd * gg * (sc + 1.0f) + sh; u32x2 w; w.x = pk2(y.x, y.y); w.y = pk2(y.z, y.w); o[64 * j] = w; } }
        asm volatile("s_waitcnt vmcnt(0)" ::: "memory");
        f32x4 acc0 = {0.f, 0.f, 0.f, 0.f}, acc1 = {0.f, 0.f, 0.f, 0.f};
        const int arow = (trow0 + li < ROWS) ? trow0 + li : ROWS - 1;
        const bf16* ap = H + (size_t)arow * DM + 8 * g; const bf16* bp0 = rwt + (size_t)li * DM + 8 * g; const bf16* bp1 = bp0 + 16 * DM;
#pragma unroll 4
        for (int ks = 0; ks < 32; ++ks) { const bf16x8 af = *(const bf16x8*)(ap + 32 * ks); acc0 = mfma16(af, *(const bf16x8*)(bp0 + 32 * ks), acc0); acc1 = mfma16(af, *(const bf16x8*)(bp1 + 32 * ks), acc1); }
#pragma unroll
        for (int r = 0; r < 4; ++r) { lg[(4 * g + r) * 33 + li] = acc0[r]; lg[(4 * g + r) * 33 + 16 + li] = acc1[r]; }
        LDS_WAIT(); asm volatile("" ::: "memory");
        const int e = lane & 31; const float rbe = rb[e];
#pragma unroll 1
        for (int rr = 0; rr < nrow; ++rr) { const int row = trow0 + rr;
            float val = lg[rr * 33 + e] + rbe; int te[4]; float tv[4];
#pragma unroll
            for (int k = 0; k < 4; ++k) { float bv = val; int bi = e;
#define AMAX_ROR(n) { const float ov = __builtin_bit_cast(float, __builtin_amdgcn_update_dpp(0, __builtin_bit_cast(int, bv), 0x120 + (n), 0xf, 0xf, false)); const int oi = __builtin_amdgcn_update_dpp(0, bi, 0x120 + (n), 0xf, 0xf, false); \
                    if (ov > bv || (ov == bv && oi < bi)) { bv = ov; bi = oi; } }
                AMAX_ROR(8) AMAX_ROR(4) AMAX_ROR(2) AMAX_ROR(1)
#undef AMAX_ROR
                { const float ov = shx(bv, 16, lane); const int oi = shxi(bi, 16, lane); if (ov > bv || (ov == bv && oi < bi)) { bv = ov; bi = oi; } }
                te[k] = bi; tv[k] = bv; if (e == bi) val = -3.0e38f; }
            if (lane == 0) { const float m = tv[0]; float p[4], ps = 0.f;
#pragma unroll
                for (int k = 0; k < 4; ++k) { p[k] = __expf(tv[k] - m); ps += p[k]; }
#pragma unroll
                for (int k = 0; k < 4; ++k) { tok_e[row * 4 + k] = te[k]; gate[row * 4 + k] = p[k] / ps; slot[row * 4 + k] = __hip_atomic_fetch_add(&hist[te[k]], 1, __ATOMIC_RELAXED, __HIP_MEMORY_SCOPE_WORKGROUP); } } }
        asm volatile("" ::: "memory");
    }
    __syncthreads();
    if (C.tid < NEXP) ((int*)(C.ws + WS_CNT))[C.wg * NEXP + C.tid] = hist[C.tid];
}
__device__ __forceinline__ int moe_tables(const Ctx& C) {
    const int* cnt = (const int*)(C.ws + WS_CNT);
    LAS int* part = (LAS int*)(C.lds);
    LAS int* pstart = (LAS int*)(C.lds + MISC_OFF + 256); LAS int* wgbase = pstart + 40; LAS int* tot = wgbase + 32; LAS int* nblk_s = tot + 32;
    LAS unsigned char* blk_e = (LAS unsigned char*)(C.lds + MISC_OFF + 1024);
    __syncthreads();
    { const int e = C.tid & 31, p = C.tid >> 5; int t = 0, pre = 0;
#pragma unroll 1
      for (int w = p * 16; w < p * 16 + 16; ++w) { const int c = cnt[w * NEXP + e]; t += c; if (w < C.wg) pre += c; }
      part[(p * 32 + e) * 2] = t; part[(p * 32 + e) * 2 + 1] = pre; }
    __syncthreads();
    if (C.tid < NEXP) { int t = 0, pre = 0;
#pragma unroll 1
        for (int p = 0; p < 16; ++p) { t += part[(p * 32 + C.tid) * 2]; pre += part[(p * 32 + C.tid) * 2 + 1]; }
        tot[C.tid] = t; wgbase[C.tid] = pre; }
    __syncthreads();
    if (C.tid == 0) { int b = 0;
#pragma unroll 1
        for (int e = 0; e < NEXP; ++e) { pstart[e] = b * 256; b += (tot[e] + 255) >> 8; }
        pstart[NEXP] = b * 256; nblk_s[0] = b; }
    __syncthreads();
    if (C.tid < NEXP) wgbase[C.tid] += pstart[C.tid];
    if (C.tid < MOE_MAXBLK) { int e = 0;
#pragma unroll 1
        for (int k = 1; k < NEXP; ++k) if (pstart[k] <= C.tid * 256) e = k;
        blk_e[C.tid] = (unsigned char)e; }
    __syncthreads();
    return __builtin_amdgcn_readfirstlane(nblk_s[0]);
}
__device__ __forceinline__ void phase_gather(const Ctx& C, const DArgs& a, int l) {
    moe_tables(C);
    const LAS int* wgbase = (const LAS int*)(C.lds + MISC_OFF + 256) + 40;
    const int* tok_e = (const int*)(C.ws + WS_ROUTE); const int* slot = (const int*)(C.ws + WS_ROUTE) + (size_t)2 * ROWS * 4; int* dest = (int*)(C.ws + WS_ROUTE) + (size_t)3 * ROWS * 4;
    const bf16* H = (const bf16*)(C.ws + WS_H); unsigned char* XG = C.ws + WS_XG8;
    const int row_base = (l == DEPTH - 1) ? NCTX : 0, ntile = (ROWS - row_base + NR2 - 1) / NR2;
    for (int tl = C.gw; tl < ntile; tl += C.NGW)
    for (int row = row_base + NR2 * tl; row < row_base + NR2 * tl + NR2 && row < ROWS; ++row) {
        const u32x4* src = (const u32x4*)(H + (size_t)row * DM) + C.lane; const u32x4 v0 = src[0], v1 = src[64];
        u32x2 q0, q1;
        { unsigned w = 0; w = __builtin_amdgcn_cvt_pk_fp8_f32(bflo(v0.x) * pg8::X8_S, bfhi(v0.x) * pg8::X8_S, w, false); w = __builtin_amdgcn_cvt_pk_fp8_f32(bflo(v0.y) * pg8::X8_S, bfhi(v0.y) * pg8::X8_S, w, true); q0.x = w;
          w = 0; w = __builtin_amdgcn_cvt_pk_fp8_f32(bflo(v0.z) * pg8::X8_S, bfhi(v0.z) * pg8::X8_S, w, false); w = __builtin_amdgcn_cvt_pk_fp8_f32(bflo(v0.w) * pg8::X8_S, bfhi(v0.w) * pg8::X8_S, w, true); q0.y = w;
          w = 0; w = __builtin_amdgcn_cvt_pk_fp8_f32(bflo(v1.x) * pg8::X8_S, bfhi(v1.x) * pg8::X8_S, w, false); w = __builtin_amdgcn_cvt_pk_fp8_f32(bflo(v1.y) * pg8::X8_S, bfhi(v1.y) * pg8::X8_S, w, true); q1.x = w;
          w = 0; w = __builtin_amdgcn_cvt_pk_fp8_f32(bflo(v1.z) * pg8::X8_S, bfhi(v1.z) * pg8::X8_S, w, false); w = __builtin_amdgcn_cvt_pk_fp8_f32(bflo(v1.w) * pg8::X8_S, bfhi(v1.w) * pg8::X8_S, w, true); q1.y = w; }
#pragma unroll
        for (int k = 0; k < 4; ++k) { const int d = wgbase[tok_e[row * 4 + k]] + slot[row * 4 + k]; if (C.lane == 0) dest[row * 4 + k] = d;
            u32x2* dp = (u32x2*)(XG + (size_t)d * DM) + C.lane; dp[0] = q0; dp[64] = q1; }
    }
}

__device__ __forceinline__ void mix1_rope(const Ctx& C) {
    bf16* P = (bf16*)(C.ws + WS_P);
    const long total = (long)SEQ * 192;
    for (long i = (long)C.wg * NTHR + C.tid; i < total; i += (long)C.G * NTHR) {
        const int j = (int)(i & 31), hh = (int)((i >> 5) % 6), t = (int)(i / 192);
        const int col = (hh < 4) ? (C_AQ + hh * 64) : (C_AK + (hh - 4) * 64);
        const float pos = (j < 16) ? (float)(t >> 6) : (float)(t & 63);
        const float inv = __powf(10000.0f, -(float)(j & 15) * (1.0f / 16.0f));
        const float ang = pos * inv * 0.31830988618379067f;
        const float cs = cospif(ang), sn = sinpif(ang);
        bf16* p = P + (size_t)(NCTX + t) * INWP + col;
        const float x1 = bf2f(p[j]), x2 = bf2f(p[j + 32]);
        p[j] = (bf16)f2bf(x1 * cs - x2 * sn); p[j + 32] = (bf16)f2bf(x2 * cs + x1 * sn);
    }
}
__device__ __forceinline__ void mix1_vt(const Ctx& C) {
    const bf16* P = (const bf16*)(C.ws + WS_P);
    LAS unsigned short* scr = (LAS unsigned short*)(C.lds + C.wave * 16384);
    for (int u = C.gw; u < (ROWS / 64) * 6; u += C.NGW) {
        const int hd = u % 6, tb = u / 6; const int vcol = (hd < 2) ? (C_AV + hd * 64) : (C_CV + (hd - 2) * 64);
        bf16* VT = ((hd < 2) ? (bf16*)(C.ws + WS_VTA) + (size_t)hd * 64 * VTP : (bf16*)(C.ws + WS_VTC) + (size_t)(hd - 2) * 64 * VTP);
#pragma unroll
        for (int i = 0; i < 8; ++i) { const int tk = (C.lane >> 3) + 8 * i, ch = C.lane & 7; const u32x4 w = *(const u32x4*)(P + (size_t)(tb * 64 + tk) * INWP + vcol + 8 * ch);
            LAS unsigned* d = (LAS unsigned*)(scr + tk * 66 + 8 * ch); d[0] = w.x; d[1] = w.y; d[2] = w.z; d[3] = w.w; }
        LDS_WAIT(); asm volatile("" ::: "memory");
#pragma unroll
        for (int k8 = 0; k8 < 8; ++k8) { unsigned w[4];
#pragma unroll
            for (int e2 = 0; e2 < 4; ++e2) { const unsigned lo = scr[(8 * k8 + 2 * e2) * 66 + C.lane], hi = scr[(8 * k8 + 2 * e2 + 1) * 66 + C.lane]; w[e2] = lo | (hi << 16); }
            *(u32x4*)(VT + (size_t)C.lane * VTP + tb * 64 + 8 * k8) = (u32x4){w[0], w[1], w[2], w[3]}; }
        LDS_WAIT(); asm volatile("" ::: "memory");
    }
    for (int i = C.wg * NTHR + C.tid; i < 6 * 64 * 32; i += C.G * NTHR) { const int rowi = i >> 5, pc = i & 31; const int hd = rowi >> 6, d = rowi & 63;
        bf16* VT = ((hd < 2) ? (bf16*)(C.ws + WS_VTA) + (size_t)hd * 64 * VTP : (bf16*)(C.ws + WS_VTC) + (size_t)(hd - 2) * 64 * VTP);
        *(u32x4*)(VT + (size_t)d * VTP + ROWS + 8 * pc) = (u32x4){0u, 0u, 0u, 0u}; }
}
__device__ __forceinline__ float conv3(const bf16* P, int row, int col, const float* cw, int cc) {
    const bool first = (row == 0) || (row == NCTX), last = (row == NCTX - 1) || (row == ROWS - 1);
    float s = cw[768 + cc] * bf2f(P[(size_t)row * INWP + col]);
    if (!first) s += cw[cc] * bf2f(P[(size_t)(row - 1) * INWP + col]);
    if (!last) s += cw[2 * 768 + cc] * bf2f(P[(size_t)(row + 1) * INWP + col]);
    return s;
}
__device__ __forceinline__ void mix1_rwkv_prep(const Ctx& C, const DArgs& a, int l) {
    const bf16* P = (const bf16*)(C.ws + WS_P); float* SC = (float*)(C.ws + WS_SC);
    constexpr int LBP = 264;
    LAS unsigned char* lob = C.lds;
    LAS float* pre = (LAS float*)(C.lds + 16384);
    const bf16* lorat = (const bf16*)(C.ws + WS_LORAT) + (size_t)l * 4 * 256 * 64;
    const float* cw = a.in[I_DCONV] + (size_t)l * 3 * 768;
    const float* w0 = a.in[I_DW0] + (size_t)l * 512; const float* a0 = a.in[I_DA0] + (size_t)l * 512;
    const float* kkw = a.in[I_DKK] + (size_t)l * 256; const float* kaw = a.in[I_DKA] + (size_t)l * 256;
    const int half = C.tid >> 8, c = C.tid & 255, lane = C.lane, li = lane & 15, g = lane >> 4;
    const float kkc = kkw[c], kac = kaw[c];
    for (int grp = C.wg; grp < ROWS / 13; grp += C.G) {
        const int row0 = 13 * grp + 7 * half, nj = 7 - half;
        __syncthreads();
#pragma unroll
        for (int j = 0; j < 7; ++j) if (j < nj) { const float x = bf2f(P[(size_t)(row0 + j) * INWP + C_WL + c]); *(LAS bf16*)(lob + ((7 * half + j) * LBP + c) * 2) = (bf16)f2bf((c < 128) ? tanhf(x) : x); }
        __syncthreads();
#pragma unroll
        for (int q = 0; q < 4; ++q) { const bf16x8 a0f = ldA(lob, LBP, 0, 64 * q, li, g), a1f = ldA(lob, LBP, 0, 64 * q + 32, li, g);
#pragma unroll
            for (int c2 = 0; c2 < 2; ++c2) { const int ci = 2 * C.wave + c2; const bf16* bp = lorat + ((size_t)q * 256 + 16 * ci + li) * 64 + 8 * g;
                f32x4 acc = {0.f, 0.f, 0.f, 0.f}; acc = mfma16(a0f, ldg8(bp), acc); acc = mfma16(a1f, ldg8(bp + 32), acc);
#pragma unroll
                for (int r = 0; r < 4; ++r) pre[(q * 16 + 4 * g + r) * 256 + 16 * ci + li] = acc[r]; } }
        __syncthreads();
        float xr[9], xk[9], xv[9];
#pragma unroll
        for (int q = 0; q < 9; ++q) { const int rw = row0 - 1 + q; const bool in = (rw >= 0) && (rw < ROWS) && (q <= nj + 1);
            const bf16* pp = P + (size_t)(in ? rw : row0) * INWP; xr[q] = in ? bf2f(pp[C_DR + c]) : 0.f; xk[q] = in ? bf2f(pp[C_DK + c]) : 0.f; xv[q] = in ? bf2f(pp[C_DV + c]) : 0.f; }
        const float cr0 = cw[c], cr1 = cw[768 + c], cr2 = cw[1536 + c], ck0 = cw[256 + c], ck1 = cw[768 + 256 + c], ck2 = cw[1536 + 256 + c], cv0 = cw[512 + c], cv1 = cw[768 + 512 + c], cv2 = cw[1536 + 512 + c];
#pragma unroll
        for (int j = 0; j < 7; ++j) if (j < nj) { const int row = row0 + j, rl = 7 * half + j;
            const bool first = (row == 0) || (row == NCTX), last = (row == NCTX - 1) || (row == ROWS - 1);
            const float m0 = first ? 0.f : 1.f, m2 = last ? 0.f : 1.f;
            const float r = cr1 * xr[j + 1] + m0 * cr0 * xr[j] + m2 * cr2 * xr[j + 2], k = ck1 * xk[j + 1] + m0 * ck0 * xk[j] + m2 * ck2 * xk[j + 2], v = cv1 * xv[j + 1] + m0 * cv0 * xv[j] + m2 * cv2 * xv[j + 2];
            float kk = k * kkc; const float n2 = wave_sum(kk * kk, lane); kk *= rsqrtf(fmaxf(n2, 1e-24f));
            float* sc = SC + (size_t)row * 9 * 256; sc[c] = r; sc[256 + c] = v; sc[512 + c] = -kk;
#pragma unroll
            for (int d = 0; d < 2; ++d) { const float wp = w0[d * 256 + c] + pre[(d * 16 + rl) * 256 + c], ap = a0[d * 256 + c] + pre[((2 + d) * 16 + rl) * 256 + c];
                const float nw = -wp, sp = fmaxf(nw, 0.f) + log1pf(__expf(-fabsf(nw)));
                const float lw = -__expf(-sp - 0.5f);
                const float as = sigmoidf_(ap);
                sc[(3 + 3 * d) * 256 + c] = lw; sc[(4 + 3 * d) * 256 + c] = k * (1.0f + (as - 1.0f) * kac); sc[(5 + 3 * d) * 256 + c] = kk * as; } }
    }
    __syncthreads();
}
constexpr int FP = 136;
constexpr int F_TABC = 0, F_TABS = 128 * FP * 2, F_TILE = 2 * 128 * FP * 2;
__device__ __forceinline__ void fourier_load_tables(const Ctx& C) {
    const bf16* ft = (const bf16*)(C.ws + WS_FTAB);
    for (int i = C.tid; i < 2 * 128 * 16; i += NTHR) { const int tb = i >> 11, r = (i >> 4) & 127, c8 = i & 15;
        *(LAS u32x4*)(C.lds + tb * F_TABS + (r * FP + 8 * c8) * 2) = *(const u32x4*)(ft + tb * 16384 + r * 128 + 8 * c8); }
}
__device__ __forceinline__ void mix1_fourier1(const Ctx& C) {
    const bf16* P = (const bf16*)(C.ws + WS_P); const float* tw = (const float*)(C.ws + WS_TW);
    bf16* FYR = (bf16*)(C.ws + WS_FYR); bf16* FYI = (bf16*)(C.ws + WS_FYI);
    const int lane = C.lane, li = lane & 15, g = lane >> 4, w = C.wave;
    __syncthreads();
    fourier_load_tables(C);
    for (int u = C.wg; u < 256; u += C.G) {
        const int t2 = u >> 1, ch0 = (u & 1) * 128;
        __syncthreads();
        for (int i = C.tid; i < 128 * 16; i += NTHR) { const int t1 = i >> 4, c8 = i & 15;
            *(LAS u32x4*)(C.lds + F_TILE + (t1 * FP + 8 * c8) * 2) = *(const u32x4*)(P + (size_t)(NCTX + 128 * t1 + t2) * INWP + C_BU + ch0 + 8 * c8); }
        __syncthreads();
        bf16x8 af[4];
#pragma unroll
        for (int ks = 0; ks < 4; ++ks) af[ks] = ldT(C.lds + F_TILE, FP, 32 * ks, 16 * w, li, g);
#pragma unroll 1
        for (int ni = 0; ni < 8; ++ni) { f32x4 dc = {0.f, 0.f, 0.f, 0.f}, ds = {0.f, 0.f, 0.f, 0.f};
#pragma unroll
            for (int ks = 0; ks < 4; ++ks) { dc = mfma16(af[ks], ldA(C.lds + F_TABC, FP, 16 * ni, 32 * ks, li, g), dc); ds = mfma16(af[ks], ldA(C.lds + F_TABS, FP, 16 * ni, 32 * ks, li, g), ds); }
            const int k1 = 16 * ni + li; const float cp = tw[t2 * k1], sp = tw[16384 + t2 * k1];
            const f32x4 yr = dc * cp - ds * sp, yi = -(ds * cp) - dc * sp;
            const size_t o = ((size_t)k1 * 128 + t2) * 256 + ch0 + 16 * w + 4 * g;
            u32x2 wr; wr.x = pk2(yr[0], yr[1]); wr.y = pk2(yr[2], yr[3]); *(u32x2*)(FYR + o) = wr;
            u32x2 wi; wi.x = pk2(yi[0], yi[1]); wi.y = pk2(yi[2], yi[3]); *(u32x2*)(FYI + o) = wi; }
    }
    __syncthreads();
}
__device__ __forceinline__ void fourier2_mfma(const Ctx& C, int l, int wg0) {
    const bf16* FYR = (const bf16*)(C.ws + WS_FYR); const bf16* FYI = (const bf16*)(C.ws + WS_FYI); bf16* MIX = (bf16*)(C.ws + WS_MIX);
    const int lane = C.lane, li = lane & 15, g = lane >> 4, w = C.wave;
    constexpr int YP = 72, F_YR = F_TILE, F_YI = F_TILE + 128 * YP * 2;
    __syncthreads();
    fourier_load_tables(C);
    for (int u = C.wg - wg0; u < 512; u += C.G - wg0) {
        const int k1 = u >> 2, gq = u & 3;
        __syncthreads();
        for (int i = C.tid; i < 2 * 128 * 8; i += NTHR) { const int im = i >> 10, t2 = (i >> 3) & 127, c8 = i & 7;
            *(LAS u32x4*)(C.lds + (im ? F_YI : F_YR) + (t2 * YP + 8 * c8) * 2) = *(const u32x4*)((im ? FYI : FYR) + ((size_t)k1 * 128 + t2) * 256 + gq * 64 + 8 * c8); }
        __syncthreads();
        bf16x8 bc[4], bs[4];
#pragma unroll
        for (int ks = 0; ks < 4; ++ks) { bc[ks] = ldA(C.lds + F_TABC, FP, 16 * w, 32 * ks, li, g); bs[ks] = ldA(C.lds + F_TABS, FP, 16 * w, 32 * ks, li, g); }
        f32x4 xr[4], xi[4];
#pragma unroll
        for (int ci = 0; ci < 4; ++ci) { xr[ci] = (f32x4){0.f, 0.f, 0.f, 0.f}; f32x4 xs = {0.f, 0.f, 0.f, 0.f}; xi[ci] = xs;
#pragma unroll
            for (int ks = 0; ks < 4; ++ks) { const bf16x8 ar = ldT(C.lds + F_YR, YP, 32 * ks, 16 * ci, li, g), ai = ldT(C.lds + F_YI, YP, 32 * ks, 16 * ci, li, g);
                xr[ci] = mfma16(ar, bc[ks], xr[ci]); xr[ci] = mfma16(ai, bs[ks], xr[ci]);
                xi[ci] = mfma16(ai, bc[ks], xi[ci]); xs = mfma16(ar, bs[ks], xs); }
            xi[ci] = xi[ci] - xs; }
        union { bf16x8 v; unsigned q[4]; } xb[4];
#pragma unroll
        for (int q2 = 0; q2 < 2; ++q2) { xb[q2].q[0] = pk2(xr[2 * q2][0], xr[2 * q2][1]); xb[q2].q[1] = pk2(xr[2 * q2][2], xr[2 * q2][3]); xb[q2].q[2] = pk2(xr[2 * q2 + 1][0], xr[2 * q2 + 1][1]); xb[q2].q[3] = pk2(xr[2 * q2 + 1][2], xr[2 * q2 + 1][3]);
            xb[2 + q2].q[0] = pk2(xi[2 * q2][0], xi[2 * q2][1]); xb[2 + q2].q[1] = pk2(xi[2 * q2][2], xi[2 * q2][3]); xb[2 + q2].q[2] = pk2(xi[2 * q2 + 1][0], xi[2 * q2 + 1][1]); xb[2 + q2].q[3] = pk2(xi[2 * q2 + 1][2], xi[2 * q2 + 1][3]); }
        const bf16x8* mf = (const bf16x8*)((const bf16*)(C.ws + WS_FTAB) + 32768) + (size_t)(l * 4 + gq) * 16 * 64;
#pragma unroll
        for (int ei = 0; ei < 4; ++ei) { f32x4 o = {0.f, 0.f, 0.f, 0.f};
#pragma unroll
            for (int ks2 = 0; ks2 < 4; ++ks2) o = mfma16(mf[(ei * 4 + ks2) * 64 + lane], xb[ks2].v, o);
            const int tp = k1 + 128 * (16 * w + li);
            u32x2 wo; wo.x = pk2(o[0], o[1]); wo.y = pk2(o[2], o[3]); *(u32x2*)(MIX + (size_t)(NCTX + tp) * DM + 256 + gq * 64 + 16 * ei + 4 * g) = wo; }
    }
    __syncthreads();
}

constexpr float LOG2E = 1.4426950408889634f;
typedef short bf16x4 __attribute__((ext_vector_type(4)));
__device__ __forceinline__ void attn_load(const bf16* P, const bf16* VT, int krow, int kcol, int li, int g, bf16x8 (&kf)[2][2], bf16x8 (&vf)[4]) {
#pragma unroll
    for (int t = 0; t < 2; ++t)
#pragma unroll
        for (int ks = 0; ks < 2; ++ks) kf[t][ks] = ldg8(P + (size_t)(krow + 16 * t + li) * INWP + kcol + 32 * ks + 8 * g);
#pragma unroll
    for (int dt = 0; dt < 4; ++dt) { const bf16* vp = VT + (size_t)(dt * 16 + li) * VTP + krow + 4 * g;
        const bf16x4 a = *(const bf16x4*)vp, b = *(const bf16x4*)(vp + 16); vf[dt] = (bf16x8){a[0], a[1], a[2], a[3], b[0], b[1], b[2], b[3]}; }
}
template <int NS, int NT>
__device__ __forceinline__ void attn_compute(const bf16x8 (&kf)[2][2], const bf16x8 (&vf)[4], const bf16x8 (&qf)[NS][2], f32x4 (&o)[NS][4], float (&m)[NS], float (&ls)[NS],
                                             const float (&add)[NT][2][4], int li, int g) {
#pragma unroll
    for (int hh = 0; hh < NS; ++hh) {
        f32x4 st[2];
#pragma unroll
        for (int t = 0; t < 2; ++t) { st[t] = (f32x4){0.f, 0.f, 0.f, 0.f};
#pragma unroll
            for (int ks = 0; ks < 2; ++ks) st[t] = __builtin_amdgcn_mfma_f32_16x16x32_bf16(kf[t][ks], qf[hh][ks], st[t], 0, 0, 0); }
        float s[8]; float bm = -INFINITY;
#pragma unroll
        for (int t = 0; t < 2; ++t)
#pragma unroll
            for (int r = 0; r < 4; ++r) { const float ad = add[hh / (NS / NT)][t][r]; s[4 * t + r] = (ad == -INFINITY) ? -INFINITY : st[t][r] * (0.125f * LOG2E) + ad; bm = fmaxf(bm, s[4 * t + r]); }
        bm = fmaxf(bm, shx(bm, 16, 16 * g + li)); bm = fmaxf(bm, shx(bm, 32, 16 * g + li));
        const float mn = fmaxf(m[hh], bm), corr = __builtin_amdgcn_exp2f(m[hh] - mn); m[hh] = mn;
        float ps = 0.f; float pe[8];
#pragma unroll
        for (int e = 0; e < 8; ++e) { pe[e] = __builtin_amdgcn_exp2f(s[e] - mn); ps += pe[e]; }
        ls[hh] = ls[hh] * corr + ps;
        union { bf16x8 v; unsigned u[4]; } pf;
#pragma unroll
        for (int e2 = 0; e2 < 4; ++e2) pf.u[e2] = pk2(pe[2 * e2], pe[2 * e2 + 1]);
#pragma unroll
        for (int dt = 0; dt < 4; ++dt) { o[hh][dt] = o[hh][dt] * corr; o[hh][dt] = __builtin_amdgcn_mfma_f32_16x16x32_bf16(vf[dt], pf.v, o[hh][dt], 0, 0, 0); }
    }
}
__device__ __forceinline__ void attn_finish1(bf16* MIX, int qrow0, int ocol, f32x4 (&o)[4], float m, float ls, bool has_sink, float sink2, int li, int g) {
    float l = ls; l += shx(l, 16, 16 * g + li); l += shx(l, 32, 16 * g + li);
    float corr = 1.f;
    if (has_sink) { const float mn = fmaxf(m, sink2); corr = __builtin_amdgcn_exp2f(m - mn); l = l * corr + __builtin_amdgcn_exp2f(sink2 - mn); }
    const float inv = corr / l;
#pragma unroll
    for (int dt = 0; dt < 4; ++dt) { const f32x4 v = o[dt] * inv; u32x2 w; w.x = pk2(v[0], v[1]); w.y = pk2(v[2], v[3]);
        *(u32x2*)(MIX + (size_t)(qrow0 + li) * DM + ocol + dt * 16 + 4 * g) = w; }
}
__device__ __forceinline__ void attnA_unit(const Ctx& C, const float* asink_l, int unit, bool lat) {
    const bf16* P = (const bf16*)(C.ws + WS_P); bf16* MIX = (bf16*)(C.ws + WS_MIX);
    const int li = C.lane & 15, g = C.lane >> 4;
    const int nqp = lat ? SEQ / 32 : NCTX / 32, kvh = unit / nqp, qp = unit % nqp, t0 = qp * 32, qrow0 = (lat ? NCTX : 0) + t0;
    const bf16* VT = (const bf16*)(C.ws + WS_VTA) + (size_t)kvh * 64 * VTP; const int kcol = C_AK + kvh * 64;
    bf16x8 qf[4][2];
#pragma unroll
    for (int s = 0; s < 4; ++s)
#pragma unroll
        for (int ks = 0; ks < 2; ++ks) qf[s][ks] = ldg8(P + (size_t)(qrow0 + 16 * (s >> 1) + li) * INWP + C_AQ + (kvh * 2 + (s & 1)) * 64 + 32 * ks + 8 * g);
    f32x4 o[4][4]; float m[4], ls[4];
#pragma unroll
    for (int s = 0; s < 4; ++s) { m[s] = -1.0e30f; ls[s] = 0.f;
#pragma unroll
        for (int dt = 0; dt < 4; ++dt) o[s][dt] = (f32x4){0.f, 0.f, 0.f, 0.f}; }
    const int b_lo = lat ? 0 : 9;
#pragma unroll 1
    for (int bb = b_lo; bb < 17; ++bb) { float add[2][2][4]; bf16x8 kf[2][2], vf[4];
        const int krow = (bb < 9) ? NCTX + t0 - 128 + 32 * bb : 32 * (bb - 9);
        attn_load(P, VT, krow, kcol, li, g, kf, vf);
#pragma unroll
        for (int tl = 0; tl < 2; ++tl)
#pragma unroll
            for (int tt = 0; tt < 2; ++tt)
#pragma unroll
                for (int r = 0; r < 4; ++r) { const int j = t0 - 128 + 32 * bb + 16 * tt + 4 * g + r, t = t0 + 16 * tl + li;
                    const bool ok = (bb >= 9) || ((j >= 0) && (j < SEQ) && (j - t <= 128) && (t - j <= 128)); add[tl][tt][r] = ok ? 0.f : -INFINITY; }
        attn_compute<4, 2>(kf, vf, qf, o, m, ls, add, li, g); }
#pragma unroll
    for (int s = 0; s < 4; ++s) attn_finish1(MIX, qrow0 + 16 * (s >> 1), (kvh * 2 + (s & 1)) * 64, o[s], m[s], ls[s], true, asink_l[kvh * 2 + (s & 1)] * LOG2E, li, g);
}
__device__ __forceinline__ void attnC_unit(const Ctx& C, const LAS float* relb, int h, int up, bool lat) {
    const bf16* P = (const bf16*)(C.ws + WS_P); bf16* MIX = (bf16*)(C.ws + WS_MIX);
    const int li = C.lane & 15, g = C.lane >> 4;
    const int rp = up >> 2, cj = up & 3;
    const int t0a = lat ? (2 * rp) * 64 + 16 * cj : 32 * up, tstep = lat ? 64 : 16, qbase = lat ? NCTX : 0;
    const bf16* VT = (const bf16*)(C.ws + WS_VTC) + (size_t)h * 64 * VTP; const int kcol = C_CK + h * 64;
    bf16x8 qf[2][2];
#pragma unroll
    for (int s = 0; s < 2; ++s)
#pragma unroll
        for (int ks = 0; ks < 2; ++ks) qf[s][ks] = ldg8(P + (size_t)(qbase + t0a + tstep * s + li) * INWP + C_CQ + h * 64 + 32 * ks + 8 * g);
    f32x4 o[2][4]; float m[2] = {-1.0e30f, -1.0e30f}, ls[2] = {0.f, 0.f};
#pragma unroll
    for (int s = 0; s < 2; ++s)
#pragma unroll
        for (int dt = 0; dt < 4; ++dt) o[s][dt] = (f32x4){0.f, 0.f, 0.f, 0.f};
    const int r = 2 * rp, cq = cj * 16 + li;
    int r0a = r - 4; r0a = r0a < 0 ? 0 : (r0a > 248 ? 248 : r0a); int r0b = r - 3; r0b = r0b < 0 ? 0 : (r0b > 248 ? 248 : r0b);
    int c0 = cq - 8; c0 = c0 < 0 ? 0 : (c0 > 48 ? 48 : c0);
    const int cw0 = (cj == 0) ? 0 : (cj == 1) ? 8 : (cj == 2) ? 24 : 32;
    const int b_lo = lat ? 0 : 9;
#pragma unroll 1
    for (int bb = b_lo; bb < 17; ++bb) { float add[2][2][4]; bf16x8 kf[2][2], vf[4];
        const int kr = r0a + bb;
        if (bb < 9 && kr >= r0b + 8) continue;
        const int krow = (bb < 9) ? NCTX + kr * 64 + cw0 : 32 * (bb - 9);
        attn_load(P, VT, krow, kcol, li, g, kf, vf);
#pragma unroll
        for (int tl = 0; tl < 2; ++tl) { const int r0t = tl ? r0b : r0a, rt = r + tl; const bool rowok = (bb >= 9) || (kr >= r0t && kr < r0t + 8);
            int bi = kr - rt + 7; bi = bi < 0 ? 0 : (bi > 14 ? 14 : bi); const LAS float* rbp = relb + bi * 31;
#pragma unroll
            for (int tt = 0; tt < 2; ++tt)
#pragma unroll
                for (int rr = 0; rr < 4; ++rr) { const int kc = cw0 + 16 * tt + 4 * g + rr; int ci = kc - cq + 15; ci = ci < 0 ? 0 : (ci > 30 ? 30 : ci); const float bv = rbp[ci];
                    add[tl][tt][rr] = (bb >= 9) ? 0.f : ((rowok && kc >= c0 && kc < c0 + 16) ? bv : -INFINITY); } }
        attn_compute<2, 2>(kf, vf, qf, o, m, ls, add, li, g); }
#pragma unroll
    for (int s = 0; s < 2; ++s) attn_finish1(MIX, qbase + t0a + tstep * s, 512 + h * 64, o[s], m[s], ls[s], false, 0.f, li, g);
}
__device__ __forceinline__ void fourier_ctx_mfma(const Ctx& C, int l, int wg0) {
    const bf16* P = (const bf16*)(C.ws + WS_P); bf16* MIX = (bf16*)(C.ws + WS_MIX); const bf16* f2 = (const bf16*)(C.ws + WS_F256);
    const int lane = C.lane, li = lane & 15, g = lane >> 4, w = C.wave;
    constexpr int UP = 72;
    for (int u = C.wg - wg0; u < 8; u += C.G - wg0) {
        const int tb = u >> 2, gq = u & 3;
        __syncthreads();
        for (int i = C.tid; i < 256 * 8; i += NTHR) { const int t = i >> 3, c8 = i & 7; *(LAS u32x4*)(C.lds + (t * UP + 8 * c8) * 2) = *(const u32x4*)(P + (size_t)t * INWP + C_BU + gq * 64 + 8 * c8); }
        __syncthreads();
        const int tp0 = 128 * tb + 16 * w;
        f32x4 xr[4], xi[4];
#pragma unroll
        for (int ci = 0; ci < 4; ++ci) { xr[ci] = (f32x4){0.f, 0.f, 0.f, 0.f}; xi[ci] = (f32x4){0.f, 0.f, 0.f, 0.f}; }
#pragma unroll 2
        for (int ks = 0; ks < 8; ++ks) { const bf16x8 bc = ldg8(f2 + (size_t)(tp0 + li) * 256 + 32 * ks + 8 * g), bs = ldg8(f2 + 65536 + (size_t)(tp0 + li) * 256 + 32 * ks + 8 * g);
#pragma unroll
            for (int ci = 0; ci < 4; ++ci) { const bf16x8 au = ldT(C.lds, UP, 32 * ks, 16 * ci, li, g); xr[ci] = mfma16(au, bc, xr[ci]); xi[ci] = mfma16(au, bs, xi[ci]); } }
        union { bf16x8 v; unsigned q[4]; } xb[4];
#pragma unroll
        for (int q2 = 0; q2 < 2; ++q2) { xb[q2].q[0] = pk2(xr[2 * q2][0], xr[2 * q2][1]); xb[q2].q[1] = pk2(xr[2 * q2][2], xr[2 * q2][3]); xb[q2].q[2] = pk2(xr[2 * q2 + 1][0], xr[2 * q2 + 1][1]); xb[q2].q[3] = pk2(xr[2 * q2 + 1][2], xr[2 * q2 + 1][3]);
            xb[2 + q2].q[0] = pk2(-xi[2 * q2][0], -xi[2 * q2][1]); xb[2 + q2].q[1] = pk2(-xi[2 * q2][2], -xi[2 * q2][3]); xb[2 + q2].q[2] = pk2(-xi[2 * q2 + 1][0], -xi[2 * q2 + 1][1]); xb[2 + q2].q[3] = pk2(-xi[2 * q2 + 1][2], -xi[2 * q2 + 1][3]); }
        const bf16x8* mf = (const bf16x8*)((const bf16*)(C.ws + WS_FTAB) + 32768) + (size_t)(l * 4 + gq) * 16 * 64;
#pragma unroll
        for (int ei = 0; ei < 4; ++ei) { f32x4 o = {0.f, 0.f, 0.f, 0.f};
#pragma unroll
            for (int ks2 = 0; ks2 < 4; ++ks2) o = mfma16(mf[(ei * 4 + ks2) * 64 + lane], xb[ks2].v, o);
            o = o * 8.0f;
            u32x2 wo; wo.x = pk2(o[0], o[1]); wo.y = pk2(o[2], o[3]); *(u32x2*)(MIX + (size_t)(tp0 + li) * DM + 256 + gq * 64 + 16 * ei + 4 * g) = wo; }
    }
    __syncthreads();
}
__device__ __forceinline__ void fourier2_unit(const Ctx& C, int l, int u, bool ctx) {
    const bf16* P = (const bf16*)(C.ws + WS_P); const float* tw = (const float*)(C.ws + WS_TW); bf16* MIX = (bf16*)(C.ws + WS_MIX);
    const float* FYR = (const float*)(C.ws + WS_FYR); const float* FYI = (const float*)(C.ws + WS_FYI);
    const float* mt = (const float*)(C.ws + WS_MTAB) + (size_t)l * 2 * 4 * 4096;
    LAS float* xr = (LAS float*)(C.lds + 8192); LAS float* xi = xr + 512;
    const int tl = C.tid >> 8, ch = C.tid & 255, tp = 2 * u + tl;
    float sr = 0.f, si = 0.f;
    if (!ctx) { const int k1 = tp & 127, k2 = tp >> 7; const float* yr = FYR + (size_t)k1 * 128 * 256 + ch; const float* yi = FYI + (size_t)k1 * 128 * 256 + ch;
#pragma unroll 8
        for (int t2 = 0; t2 < 128; ++t2) { const int m = ((t2 * k2) & 127) * 128; const float c = tw[m], s = tw[16384 + m]; const float a = yr[t2 * 256], b = yi[t2 * 256]; sr += a * c + b * s; si += b * c - a * s; } }
    else {
#pragma unroll 8
        for (int t = 0; t < NCTX; ++t) { const int m = ((t * tp) & 255) * 64; const float x = bf2f(P[(size_t)t * INWP + C_BU + ch]); sr += x * tw[m]; si -= x * tw[16384 + m]; } }
    __syncthreads();
    xr[tl * 256 + ch] = sr; xi[tl * 256 + ch] = si;
    __syncthreads();
    const int g = ch >> 6, e = ch & 63; const float* mc = mt + (size_t)(0 * 4 + g) * 4096 + e; const float* ms = mt + (size_t)(1 * 4 + g) * 4096 + e;
    const LAS float* xrp = xr + tl * 256 + g * 64; const LAS float* xip = xi + tl * 256 + g * 64; float o = 0.f;
#pragma unroll 8
    for (int c = 0; c < 64; ++c) o += xrp[c] * mc[c * 64] + xip[c] * ms[c * 64];
    o *= ctx ? (1.0f / 128.0f) : (1.0f / 1024.0f);
    MIX[(size_t)((ctx ? 0 : NCTX) + tp) * DM + 256 + ch] = (bf16)f2bf(o);
}
__device__ __forceinline__ void rwkv_passB(const Ctx& C, int b);
__device__ __forceinline__ void phase_mix2(const Ctx& C, const DArgs& a, int l) {
    const bool emit_ctx = l < DEPTH - 1;
#ifndef REPMASK
#define REPMASK 0
#endif
#define NREP2(o) ((((REPMASK) >> (o)) & 1) ? 2 : 1)
    if (C.wg < 8) { for (int r2 = 0; r2 < NREP2(16); ++r2) rwkv_passB(C, C.wg); }
    else if (emit_ctx) fourier_ctx_mfma(C, l, 8);
    { const float* asink_l = a.in[I_ASINK] + l * 4; const float* crel = a.in[I_CREL] + (size_t)l * 4 * 465;
      LAS float* relb = (LAS float*)(C.lds + 110592 + C.wave * 2048);
      for (int r2 = 0; r2 < NREP2(17); ++r2) {
      unsigned* qhead = (unsigned*)(C.ws + WS_CTL) + CW_WQ + 64 * l + 16 * r2;
      const int nA = 2 * (SEQ / 32), nC = 4 * (SEQ / 32), nAc = emit_ctx ? 2 * (NCTX / 32) : 0, nCc = emit_ctx ? 4 * (NCTX / 32) : 0, nAll = nA + nAc + nC + nCc;
      int hcur = -1;
      const int nCv = emit_ctx ? CV_NCHUNK : 0;
      for (;;) { unsigned uq = 0; if (C.lane == 0) uq = __hip_atomic_fetch_add(qhead, 1u, __ATOMIC_RELAXED, __HIP_MEMORY_SCOPE_AGENT);
          const int uraw = __builtin_amdgcn_readfirstlane((int)uq); if (uraw >= nAll + nCv) break;
          int u;
          if (uraw < 2 * nCv) { if (uraw & 1) { const int ch = uraw >> 1; convert_moe_items(C, a, l + 1, ch * CV_CHUNK, ch * CV_CHUNK + CV_CHUNK); continue; } u = uraw >> 1; }
          else u = uraw - nCv;
          if (u < nA) attnA_unit(C, asink_l, u, true);
          else if (u < nA + nAc) attnA_unit(C, asink_l, u - nA, false);
          else { const int uc = u - nA - nAc; const bool lat = uc < nC; const int uu = lat ? uc : uc - nC, nqt = lat ? SEQ / 32 : NCTX / 32, h = uu / nqt, qt = uu % nqt;
              if (h != hcur) { for (int i = C.lane; i < 465; i += 64) relb[i] = crel[h * 465 + i] * LOG2E; hcur = h; LDS_WAIT(); asm volatile("" ::: "memory"); }
              attnC_unit(C, relb, h, qt, lat); } } } }
    __syncthreads();
    for (int r2 = 0; r2 < NREP2(19); ++r2) fourier2_mfma(C, l, 0);
}

constexpr int RW_C = 32, RW_NCH = ROWS / RW_C, RW_SC = 20, RW_NSC = RW_NCH / RW_SC;
constexpr int RW_SLOT = 5120, RW_REGION = 9 * RW_SLOT + 1024;
constexpr int TP = 72, HP = 40;
static_assert(3 * RW_REGION <= MISC_OFF, "RWKV D1 regions below the misc area");
__device__ __forceinline__ int rw_rc_of(int d, int c) { return d == 0 ? c : (c < 8 ? 7 - c : 527 - c); }
__device__ __forceinline__ int rw_row_of(int d, int rc, int t) { return 32 * rc + (d == 0 ? t : 31 - t); }

__device__ __forceinline__ void rwkv_d1(const Ctx& C, LAS unsigned char* rb, int d, int h, int rc) {
    int lane_ = C.lane; asm volatile("" : "+v"(lane_));
    const int lane = lane_, li = lane & 15, g = lane >> 4;
    const float* SC = (const float*)(C.ws + WS_SC);
    LAS unsigned char* S0 = rb; LAS unsigned char* S1 = rb + RW_SLOT; LAS unsigned char* S2 = rb + 2 * RW_SLOT; LAS unsigned char* S3 = rb + 3 * RW_SLOT; LAS unsigned char* S4 = rb + 4 * RW_SLOT;
    LAS unsigned char* S5 = rb + 5 * RW_SLOT; LAS unsigned char* S6 = rb + 6 * RW_SLOT; LAS unsigned char* S7 = rb + 7 * RW_SLOT; LAS unsigned char* S8 = rb + 8 * RW_SLOT;
    LAS unsigned char* S6b = S6 + 2560; LAS unsigned char* S7b = S7 + 2560;
    LAS float* gc = (LAS float*)(rb + 9 * RW_SLOT);
    { float cum = 0.f; const int j = lane; const int qw = (3 + 3 * d) * 256;
      float rv[2][4], vv[2][4], av[2][4], lw[2][4], kd[2][4], bb[2][4];
#define RW_LD(buf, t0) do { _Pragma("unroll") for (int u = 0; u < 4; ++u) { const float* sc = SC + (size_t)rw_row_of(d, rc, (t0) + u) * 9 * 256 + h * 64 + j; \
          rv[buf][u] = sc[0]; vv[buf][u] = sc[256]; av[buf][u] = sc[512]; lw[buf][u] = sc[qw]; kd[buf][u] = sc[qw + 256]; bb[buf][u] = sc[qw + 512]; } } while (0)
#define RW_CP(buf, t0) do { _Pragma("unroll") for (int u = 0; u < 4; ++u) { const float cp = cum; cum += lw[buf][u]; const float Gt = __expf(cum), Gm = __expf(cp), iG = __expf(-cum); const int off = (((t0) + u) * TP + j) * 2; \
          *(LAS bf16*)(S0 + off) = (bf16)f2bf(av[buf][u] * Gm); *(LAS bf16*)(S1 + off) = (bf16)f2bf(rv[buf][u] * Gt); *(LAS bf16*)(S2 + off) = (bf16)f2bf(bb[buf][u] * iG); \
          *(LAS bf16*)(S3 + off) = (bf16)f2bf(kd[buf][u] * iG); *(LAS bf16*)(S4 + off) = (bf16)f2bf(vv[buf][u]); } } while (0)
      RW_LD(0, 0);
#pragma unroll
      for (int b2 = 0; b2 < 4; ++b2) { RW_LD(1, 8 * b2 + 4); __builtin_amdgcn_sched_barrier(0); RW_CP(0, 8 * b2); if (b2 < 3) RW_LD(0, 8 * b2 + 8); __builtin_amdgcn_sched_barrier(0); RW_CP(1, 8 * b2 + 4); }
#undef RW_LD
#undef RW_CP
      gc[j] = __expf(cum); }
    const f32x4 z4 = {0.f, 0.f, 0.f, 0.f};
#pragma unroll 1
    for (int ti = 0; ti < 2; ++ti)
#pragma unroll 1
        for (int si = 0; si < 2; ++si) {
            f32x4 n = z4, nt = z4, mk = z4, qb = z4, qk = z4;
#pragma unroll
            for (int ks = 0; ks < 2; ++ks) { const bf16x8 at = ldA(S0, TP, 16 * ti, 32 * ks, li, g), rt = ldA(S1, TP, 16 * ti, 32 * ks, li, g), bs = ldA(S2, TP, 16 * si, 32 * ks, li, g), kss = ldA(S3, TP, 16 * si, 32 * ks, li, g);
                n = mfma16(at, bs, n);
                nt = mfma16(bs, at, nt);
                mk = mfma16(kss, at, mk);
                qb = mfma16(bs, rt, qb);
                qk = mfma16(kss, rt, qk); }
#pragma unroll
            for (int r = 0; r < 4; ++r) { const int trow = 16 * ti + 4 * g + r, scol = 16 * si + li; if (!(scol < trow)) n[r] = 0.f;
                const int srow = 16 * si + 4 * g + r, tcol = 16 * ti + li; if (!(srow < tcol)) { mk[r] = 0.f; nt[r] = 0.f; } if (!(srow <= tcol)) { qb[r] = 0.f; qk[r] = 0.f; } }
            *(LAS f32x4*)(S5 + ((16 * si + li) * 32 + 16 * ti + 4 * g) * 4) = n;
            stT(S6, HP, 16 * ti + li, 16 * si + 4 * g, mk);
            stT(S8, HP, 16 * ti + li, 16 * si + 4 * g, nt);
            stT(S6b, HP, 16 * ti + li, 16 * si + 4 * g, qb);
            stT(S7, HP, 16 * ti + li, 16 * si + 4 * g, qk); }
    { const int rr = lane & 31, bq = rr >> 4, lr = rr & 15; float Tr[16];
#pragma unroll
      for (int s = 15; s >= 0; --s) { float acc = (lr == s) ? 1.f : 0.f;
#pragma unroll
          for (int c4 = 0; c4 < 4; ++c4) { if (4 * c4 + 3 > s) { const f32x4 nv = *(const LAS f32x4*)(S5 + ((16 * bq + s) * 32 + 16 * bq + 4 * c4) * 4);
#pragma unroll
              for (int e = 0; e < 4; ++e) if (4 * c4 + e > s) acc += Tr[4 * c4 + e] * nv[e]; } }
          Tr[s] = acc; }
      if (lane < 32) { u32x4 w0, w1; w0.x = pk2(Tr[0], Tr[1]); w0.y = pk2(Tr[2], Tr[3]); w0.z = pk2(Tr[4], Tr[5]); w0.w = pk2(Tr[6], Tr[7]); w1.x = pk2(Tr[8], Tr[9]); w1.y = pk2(Tr[10], Tr[11]); w1.z = pk2(Tr[12], Tr[13]); w1.w = pk2(Tr[14], Tr[15]);
          const u32x4 zz = {0u, 0u, 0u, 0u}; LAS u32x4* trow = (LAS u32x4*)(S7b + rr * HP * 2);
          trow[0] = bq ? zz : w0; trow[1] = bq ? zz : w1; trow[2] = bq ? w0 : zz; trow[3] = bq ? w1 : zz; }
      f32x4 x = mfma16(ldA(S8, HP, 16, 0, li, g), ldT(S7b, HP, 0, 0, li, g), z4);
      LAS unsigned char* XT = S8 + 2560;
      *(LAS u32x2*)(XT + (li * HP + 4 * g) * 2) = (u32x2){0u, 0u}; stT(XT, HP, li, 16 + 4 * g, x);
      const f32x4 t21 = mfma16(ldA(S7b, HP, 16, 0, li, g), ldA(XT, HP, 0, 0, li, g), z4);
#pragma unroll
      for (int r = 0; r < 4; ++r) *(LAS bf16*)(S7b + ((16 + 4 * g + r) * HP + li) * 2) = (bf16)f2bf(t21[r]); }
#pragma unroll 1
    for (int ti = 0; ti < 2; ++ti) { const bf16x8 tf = ldA(S7b, HP, 16 * ti, 0, li, g), mf = ldA(S6, HP, 16 * ti, 0, li, g);
#pragma unroll
        for (int ji = 0; ji < 4; ++ji) { const f32x4 ap = mfma16(tf, ldT(S0, TP, 0, 16 * ji, li, g), z4); stT(S8, HP, 16 * ji + li, 16 * ti + 4 * g, ap);
            const f32x4 mv = mfma16(mf, ldT(S4, TP, 0, 16 * ji, li, g), z4); stT(S5, HP, 16 * ji + li, 16 * ti + 4 * g, mv); } }
#pragma unroll 1
    for (int ti = 0; ti < 2; ++ti) { const bf16x8 tf = ldA(S7b, HP, 16 * ti, 0, li, g);
#pragma unroll
        for (int vi = 0; vi < 4; ++vi) { const f32x4 ul = mfma16(tf, ldA(S5, HP, 16 * vi, 0, li, g), z4); stT(S0, HP, 16 * vi + li, 16 * ti + 4 * g, ul); } }
#pragma unroll 1
    for (int ti = 0; ti < 2; ++ti) { const bf16x8 qbf = ldA(S6b, HP, 16 * ti, 0, li, g), qkf = ldA(S7, HP, 16 * ti, 0, li, g);
#pragma unroll
        for (int ji = 0; ji < 4; ++ji) { f32x4 rp = mfma16(ldA(S8, HP, 16 * ji, 0, li, g), qbf, z4);
            LAS unsigned char* p = S1 + ((16 * ti + li) * TP + 16 * ji + 4 * g) * 2; rp = rp + ld4bf(p); u32x2 w; w.x = pk2(rp[0], rp[1]); w.y = pk2(rp[2], rp[3]); *(LAS u32x2*)p = w;
            f32x4 yl = mfma16(qbf, ldA(S0, HP, 16 * ji, 0, li, g), z4); yl = mfma16(qkf, ldT(S4, TP, 0, 16 * ji, li, g), yl);
            stT(S5, HP, 16 * ji + li, 16 * ti + 4 * g, yl); } }
#pragma unroll 1
    for (int ji = 0; ji < 4; ++ji) { const bf16x8 bt = ldT(S2, TP, 0, 16 * ji, li, g); const float gj = gc[16 * ji + li];
#pragma unroll
        for (int jp = 0; jp < 4; ++jp) { f32x4 pt = mfma16(ldA(S8, HP, 16 * jp, 0, li, g), bt, z4);
#pragma unroll
            for (int r = 0; r < 4; ++r) pt[r] = pt[r] * gj + ((16 * jp + 4 * g + r == 16 * ji + li) ? gj : 0.f);
            stT(S6, TP, 16 * ji + li, 16 * jp + 4 * g, pt); } }
#pragma unroll 1
    for (int vh = 0; vh < 2; ++vh) { f32x4 lt[4][2];
#pragma unroll
      for (int ji = 0; ji < 4; ++ji) { const bf16x8 ba = ldT(S2, TP, 0, 16 * ji, li, g), ka = ldT(S3, TP, 0, 16 * ji, li, g); const f32x4 gv = *(const LAS f32x4*)(gc + 16 * ji + 4 * g);
#pragma unroll
          for (int v2 = 0; v2 < 2; ++v2) { const int vi = 2 * vh + v2; f32x4 x = mfma16(ba, ldA(S0, HP, 16 * vi, 0, li, g), z4); x = mfma16(ka, ldT(S4, TP, 0, 16 * vi, li, g), x); lt[ji][v2] = x * gv; } }
      asm volatile("s_waitcnt lgkmcnt(0)" ::: "memory");
      LAS unsigned char* dst = vh ? S2 : S8;
#pragma unroll
      for (int ji = 0; ji < 4; ++ji)
#pragma unroll
          for (int v2 = 0; v2 < 2; ++v2) stT(dst, TP, 16 * v2 + li, 16 * ji + 4 * g, lt[ji][v2]); }
}
__device__ __forceinline__ void rwkv_passA_step(const Ctx& C, const LAS unsigned char* rb, f32x4 (&hs)[4], int d, int h, int rc) {
    int lane_ = C.lane; asm volatile("" : "+v"(lane_));
    const int lane = lane_, li = lane & 15, g = lane >> 4; const bool isPhi = C.wave >= 4; const int col = 16 * (C.wave & 3) + li;
    const LAS unsigned char* S1 = rb + RW_SLOT; const LAS unsigned char* S2 = rb + 2 * RW_SLOT; const LAS unsigned char* S5 = rb + 5 * RW_SLOT; const LAS unsigned char* S6 = rb + 6 * RW_SLOT;
    const LAS unsigned char* LTb = (col < 32) ? rb + 8 * RW_SLOT + col * TP * 2 : S2 + (col - 32) * TP * 2;
    union { bf16x8 v; unsigned u[4]; } bf[2];
#pragma unroll
    for (int ks = 0; ks < 2; ++ks) { bf[ks].u[0] = pk2(hs[2 * ks][0], hs[2 * ks][1]); bf[ks].u[1] = pk2(hs[2 * ks][2], hs[2 * ks][3]); bf[ks].u[2] = pk2(hs[2 * ks + 1][0], hs[2 * ks + 1][1]); bf[ks].u[3] = pk2(hs[2 * ks + 1][2], hs[2 * ks + 1][3]); }
#pragma unroll
    for (int ti = 0; ti < 2; ++ti) { f32x4 acc = isPhi ? (f32x4){0.f, 0.f, 0.f, 0.f} : ld4bf(S5 + (col * HP + 16 * ti + 4 * g) * 2);
#pragma unroll
        for (int ks = 0; ks < 2; ++ks) acc = mfma16(ldAperm(S1, TP, 16 * ti, ks, li, g), bf[ks].v, acc);
        if (!isPhi) { float* ys = (float*)(C.ws + WS_YS) + (size_t)d * ROWS * 256 + h * 64 + col;
#pragma unroll
            for (int r = 0; r < 4; ++r) ys[(size_t)rw_row_of(d, rc, 16 * ti + 4 * g + r) * 256] = acc[r]; }
        else { bf16* rp = (bf16*)(C.ws + WS_RPP) + ((size_t)((d * 4 + h) * RW_NCH + rc) * 32) * 64 + col;
#pragma unroll
            for (int r = 0; r < 4; ++r) rp[(16 * ti + 4 * g + r) * 64] = (bf16)f2bf(acc[r]); } }
    f32x4 hn[4];
#pragma unroll
    for (int i = 0; i < 4; ++i) { f32x4 acc = isPhi ? (f32x4){0.f, 0.f, 0.f, 0.f} : ld4bf(LTb + (16 * i + 4 * g) * 2);
#pragma unroll
        for (int ks = 0; ks < 2; ++ks) acc = mfma16(ldAperm(S6, TP, 16 * i, ks, li, g), bf[ks].v, acc);
        hn[i] = acc; }
#pragma unroll
    for (int i = 0; i < 4; ++i) hs[i] = hn[i];
}
__device__ __forceinline__ void phase_rwkv1(const Ctx& C) {
    const int lane = C.lane, li = lane & 15, g = lane >> 4;
    for (int u = C.wg; u < 8 * RW_NSC; u += C.G) {
        const int s = u % RW_NSC, dh = u / RW_NSC, d = dh >> 2, h = dh & 3; const bool isPhi = C.wave >= 4; const int col = 16 * (C.wave & 3) + li;
        f32x4 hs[4];
#pragma unroll
        for (int i = 0; i < 4; ++i)
#pragma unroll
            for (int r = 0; r < 4; ++r) hs[i][r] = (isPhi && (16 * i + 4 * g + r == col)) ? 1.f : 0.f;
#pragma unroll 1
        for (int rnd = 0; rnd < (RW_SC + 2) / 3; ++rnd) {
            __syncthreads();
            { int wv = C.wave; asm volatile("" : "+s"(wv)); if (wv < 3 && 3 * rnd + wv < RW_SC) rwkv_d1(C, C.lds + wv * RW_REGION, d, h, rw_rc_of(d, s * RW_SC + 3 * rnd + wv)); }
            __syncthreads();
#pragma unroll 1
            for (int k = 0; k < 3; ++k) { const int ci = 3 * rnd + k; int ko = k * RW_REGION; asm volatile("" : "+s"(ko)); if (ci < RW_SC) rwkv_passA_step(C, C.lds + ko, hs, d, h, rw_rc_of(d, s * RW_SC + ci)); }
        }
        if (isPhi) { bf16* pf = (bf16*)(C.ws + WS_PSC) + (size_t)(dh * RW_NSC + s) * 4096;
            const int ks = col >> 5, eh = (col >> 4) & 1, gp = (col >> 2) & 3, el = col & 3;
#pragma unroll
            for (int i = 0; i < 4; ++i)
#pragma unroll
                for (int r = 0; r < 4; ++r) pf[((i * 2 + ks) * 64 + gp * 16 + 4 * g + r) * 8 + eh * 4 + el] = (bf16)f2bf(hs[i][r]); }
        else { f32x4* lf = (f32x4*)(C.ws + WS_LSC) + ((size_t)(dh * RW_NSC + s) * 4 + C.wave) * 4 * 64;
#pragma unroll
            for (int i = 0; i < 4; ++i) lf[i * 64 + lane] = hs[i]; }
    }
    __syncthreads();
}
__device__ __forceinline__ void rwkv_passB(const Ctx& C, int b) {
    if (C.wave >= 4) return;
    const int lane = C.lane, li = lane & 15, g = lane >> 4, q = C.wave;
    f32x4 hs[4];
#pragma unroll
    for (int i = 0; i < 4; ++i) hs[i] = (f32x4){0.f, 0.f, 0.f, 0.f};
    const bf16x8* pfb = (const bf16x8*)((const bf16*)(C.ws + WS_PSC) + (size_t)b * RW_NSC * 4096);
    const f32x4* lfb = (const f32x4*)(C.ws + WS_LSC) + ((size_t)b * RW_NSC * 4 + q) * 4 * 64;
    bf16x8 pa[8]; f32x4 la[4];
#pragma unroll
    for (int k = 0; k < 8; ++k) pa[k] = pfb[k * 64 + lane];
#pragma unroll
    for (int i = 0; i < 4; ++i) la[i] = lfb[i * 64 + lane];
#pragma unroll 1
    for (int s = 0; s < RW_NSC; ++s) {
        bf16* hp = (bf16*)(C.ws + WS_HSC) + ((size_t)(b * RW_NSC + s) * 64 + 16 * q + li) * 64;
#pragma unroll
        for (int i = 0; i < 4; ++i) { u32x2 w; w.x = pk2(hs[i][0], hs[i][1]); w.y = pk2(hs[i][2], hs[i][3]); *(u32x2*)(hp + 16 * i + 4 * g) = w; }
        bf16x8 pn[8]; f32x4 ln[4]; const int sn = (s + 1 < RW_NSC) ? s + 1 : s;
#pragma unroll
        for (int k = 0; k < 8; ++k) pn[k] = pfb[(size_t)sn * 512 + k * 64 + lane];
#pragma unroll
        for (int i = 0; i < 4; ++i) ln[i] = lfb[(size_t)sn * 4 * 4 * 64 + i * 64 + lane];
        union { bf16x8 v; unsigned u[4]; } bf[2];
#pragma unroll
        for (int ks = 0; ks < 2; ++ks) { bf[ks].u[0] = pk2(hs[2 * ks][0], hs[2 * ks][1]); bf[ks].u[1] = pk2(hs[2 * ks][2], hs[2 * ks][3]); bf[ks].u[2] = pk2(hs[2 * ks + 1][0], hs[2 * ks + 1][1]); bf[ks].u[3] = pk2(hs[2 * ks + 1][2], hs[2 * ks + 1][3]); }
#pragma unroll
        for (int i = 0; i < 4; ++i) { f32x4 acc = la[i];
#pragma unroll
            for (int ks = 0; ks < 2; ++ks) acc = mfma16(pa[i * 2 + ks], bf[ks].v, acc);
            hs[i] = acc; }
#pragma unroll
        for (int k = 0; k < 8; ++k) pa[k] = pn[k];
#pragma unroll
        for (int i = 0; i < 4; ++i) la[i] = ln[i];
    }
}
__device__ __forceinline__ void phase_mix3(const Ctx& C, const DArgs& a, int l) {
    const bf16* P = (const bf16*)(C.ws + WS_P); const float* SC = (const float*)(C.ws + WS_SC); const float* YS = (const float*)(C.ws + WS_YS); bf16* MIX = (bf16*)(C.ws + WS_MIX);
    LAS float* yt = (LAS float*)(C.lds);
    constexpr int GSP = 168;
    LAS unsigned char* gsig = C.lds + 32768;
    LAS float* gm = (LAS float*)(C.lds + 40960);
    const bf16* g2t = (const bf16*)(C.ws + WS_G2T) + (size_t)l * 256 * 160;
    const float* rk = a.in[I_DRK] + (size_t)l * 256; const float* lnw = a.in[I_DLNW] + (size_t)l * 256; const float* lnb = a.in[I_DLNB] + (size_t)l * 256;
    const int lane = C.lane, li = lane & 15, g = lane >> 4, h = C.wave & 3, d = C.wave >> 2;
    const int half = C.tid >> 8, c = C.tid & 255;
    const int u_lo = (l == DEPTH - 1) ? NCTX / 16 : 0;
    for (int u = u_lo + C.wg; u < ROWS / 16; u += C.G) {
        const int rc = u >> 1, th = u & 1, rowb = 16 * u;
        __syncthreads();
        for (int i = C.tid; i < 16 * 160; i += NTHR) { const int t = i / 160, ii = i % 160; *(LAS bf16*)(gsig + (t * GSP + ii) * 2) = (bf16)f2bf(sigmoidf_(bf2f(P[(size_t)(rowb + t) * INWP + C_GL + ii]))); }
        {
          const int ct = (d == 0) ? rc : (rc < 8 ? 7 - rc : 527 - rc), s = ct / RW_SC, ti = (d == 0) ? th : 1 - th;
          const bf16* rp = (const bf16*)(C.ws + WS_RPP) + (size_t)((d * 4 + h) * RW_NCH + rc) * 32 * 64;
          const bf16* hp = (const bf16*)(C.ws + WS_HSC) + (size_t)((d * 4 + h) * RW_NSC + s) * 64 * 64;
          bf16x8 af[2];
#pragma unroll
          for (int ks = 0; ks < 2; ++ks) af[ks] = ldg8(rp + (16 * ti + li) * 64 + 32 * ks + 8 * g);
#pragma unroll
          for (int vi = 0; vi < 4; ++vi) { f32x4 acc = {0.f, 0.f, 0.f, 0.f};
#pragma unroll
              for (int ks = 0; ks < 2; ++ks) acc = mfma16(af[ks], ldg8(hp + (16 * vi + li) * 64 + 32 * ks + 8 * g), acc);
#pragma unroll
              for (int r = 0; r < 4; ++r) { const int t = 16 * ti + 4 * g + r, rl = ((d == 0) ? t : 31 - t) - 16 * th;
                  yt[(d * 16 + rl) * 256 + h * 64 + 16 * vi + li] = acc[r] + YS[((size_t)d * ROWS + rowb + rl) * 256 + h * 64 + 16 * vi + li]; } } }
        __syncthreads();
#pragma unroll
        for (int c2 = 0; c2 < 2; ++c2) { const int ci = 2 * C.wave + c2; f32x4 a0 = {0.f, 0.f, 0.f, 0.f};
#pragma unroll
            for (int ks = 0; ks < 5; ++ks) a0 = mfma16(ldA(gsig, GSP, 0, 32 * ks, li, g), ldg8(g2t + (size_t)(16 * ci + li) * 160 + 32 * ks + 8 * g), a0);
#pragma unroll
            for (int r = 0; r < 4; ++r) gm[(4 * g + r) * 256 + 16 * ci + li] = a0[r]; }
        __syncthreads();
#pragma unroll 1
        for (int it = 0; it < 8; ++it) { const int rl = 2 * it + half, row = rowb + rl;
            const float* sc = SC + (size_t)row * 9 * 256;
            const float y = yt[rl * 256 + c] + yt[(16 + rl) * 256 + c];
            const float mu = wave_sum(y, lane) * (1.f / 64.f), dy = y - mu, var = wave_sum(dy * dy, lane) * (1.f / 64.f);
            const float yn = dy * rsqrtf(var + 64e-5f) * lnw[c] + lnb[c];
            const float r = sc[c], v = sc[256 + c];
            const float coef = wave_sum(r * (sc[4 * 256 + c] + sc[7 * 256 + c]) * rk[c], lane);
            MIX[(size_t)row * DM + 768 + c] = (bf16)f2bf((yn + coef * v) * gm[rl * 256 + c]); }
    }
    __syncthreads();
}
__device__ __forceinline__ void outproj_ctx(const Ctx& C, int l, const float* gate) {
    const bf16* A = (const bf16*)(C.ws + WS_MIX); const bf16* B = (const bf16*)(C.ws + WS_WOUT) + (size_t)l * DM * DM; float* XS = (float*)(C.ws + WS_XS);
    const int lane = C.lane, li = lane & 15, g = lane >> 4;
    for (int u = C.gw; u < (NCTX / 16) * (DM / 16); u += C.NGW) { const int rt = u >> 6, ct = u & 63;
        const bf16* ap = A + (size_t)(16 * rt + li) * DM + 8 * g; const bf16* bp = B + (size_t)(16 * ct + li) * DM + 8 * g;
        f32x4 acc0 = {0.f, 0.f, 0.f, 0.f}, acc1 = {0.f, 0.f, 0.f, 0.f};
#pragma unroll 4
        for (int ks = 0; ks < 32; ks += 2) { acc0 = mfma16(ldg8(ap + 32 * ks), ldg8(bp + 32 * ks), acc0); acc1 = mfma16(ldg8(ap + 32 * ks + 32), ldg8(bp + 32 * ks + 32), acc1); }
        const float gv = gate[16 * ct + li];
#pragma unroll
        for (int r = 0; r < 4; ++r) { float* p = XS + (size_t)(16 * rt + 4 * g + r) * DM + 16 * ct + li; *p = *p + gv * (acc0[r] + acc1[r]); } }
}

#ifndef MK_SINGLE
#define MK_SINGLE 1
#endif
template <int ONLYP> __global__ void __launch_bounds__(NTHR, 2) mega(Args a) {
    extern __shared__ __attribute__((aligned(16))) unsigned char lds_raw[];
    Ctx C;
#define MKCTX() do { int t_ = threadIdx.x; asm volatile("" : "+v"(t_)); unsigned char* w_ = a.ws; asm volatile("" : "+s"(w_)); unsigned l_ = 0u; asm volatile("" : "+s"(l_)); \
        C.lds = (LAS unsigned char*)lds_raw + l_; C.tid = t_; C.lane = t_ & 63; C.wave = __builtin_amdgcn_readfirstlane(t_ >> 6); \
        C.wg = blockIdx.x; C.G = gridDim.x; C.gw = C.wg * NWAVES + C.wave; C.NGW = C.G * NWAVES; C.ws = w_; } while (0)
    MKCTX();
    if (C.tid == 0) {
#pragma unroll
        for (int i = 0; i < 31; ++i) ((LAS unsigned long long*)(C.lds + MISC_OFF + 2048))[i] = (unsigned long long)a.in[i]; }
    DArgs da; da.in.tab = (const LAS unsigned*)(C.lds + MISC_OFF + 2048); da.out = a.out;
    if (C.tid < 4) ((LAS unsigned*)(C.lds + MISC_OFF))[C.tid] = 0u;
    __syncthreads();
    XcdBarrier bar; bar.bar = (unsigned*)(C.ws + WS_CTL) + CW_BAR; bar.x = 0; bar.st = (volatile LAS unsigned*)(C.lds + MISC_OFF);
    if (a.use_bar) bar = xcd_barrier_post((unsigned*)(C.ws + WS_CTL) + CW_BAR, (volatile LAS unsigned*)(C.lds + MISC_OFF));
#ifndef PHMASK
#define PHMASK 0x1fff
#endif
#define INP(o, k) ((ONLYP < 0 || ONLYP == (o)) && ((PHMASK >> ((o) == 99 ? 12 : (o))) & 1) && a.ph_lo <= (k) && (k) < a.ph_hi)
#ifndef REPMASK
#define REPMASK 0
#endif
#define NREP(o) ((((REPMASK) >> ((o) == 99 ? 12 : (o))) & 1) ? 2 : 1)
#define IN(k) (a.ph_lo <= (k) && (k) < a.ph_hi)
#define SEAM(k) do { if (a.use_bar && IN(k) && IN((k) + 1)) { xcd_barrier(bar); if ((REPMASK >> 20) & 1) xcd_barrier(bar); } } while (0)
    if (INP(0, 0)) for (int rep = 0; rep < NREP(0); ++rep) { MKCTX(); phase_prologue(C, da); }
    SEAM(0);
    for (int l = 0; l < DEPTH; ++l) {
        const int b = 1 + l * NPL;
        const float* mod_lat = (const float*)(C.ws + WS_MOD) + (size_t)(l * 2 + 0) * 6144; const float* mod_ctx = mod_lat + 6144;
        if (INP(1, b + 0)) { MKCTX(); phase_norm1(C, da, l); }
        SEAM(b + 0);
        if (INP(2, b + 1)) for (int rep = 0; rep < NREP(2); ++rep) { MKCTX();
            pg8::StaticOrder S; S.init(WS_H, WS_WIN + (size_t)l * INWP * DM * 2, ROWS, INWP, DM, C.G, C.wg);
            pg8::EpiStoreBf16 E{(bf16*)(C.ws + WS_P), INWP, nullptr, 0, 1.0f, 1.0f};
            pg8::gemm_phase<pg8::EpiStoreBf16, pg8::StaticOrder, true, true>(C.lds, C.tid, DM, S, E, C.ws);
        }
        SEAM(b + 1);
        if (INP(3, b + 2)) { MKCTX(); for (int rep = 0; rep < NREP(3); ++rep) { mix1_rwkv_prep(C, da, l); mix1_fourier1(C); } }
        SEAM(b + 2);
        if (INP(11, b + 3)) for (int rep = 0; rep < NREP(11); ++rep) { MKCTX(); phase_rwkv1(C);
            if (C.wg >= 8 * RW_NSC) {
                Ctx C2 = C; C2.wg = C.wg - 8 * RW_NSC; C2.G = C.G - 8 * RW_NSC; C2.gw = C2.wg * NWAVES + C.wave; C2.NGW = C2.G * NWAVES;
                mix1_rope(C2); mix1_vt(C2); } }
        SEAM(b + 3);
        if (INP(4, b + 4)) for (int rep = 0; rep < NREP(4); ++rep) { MKCTX(); phase_mix2(C, da, l); }
        SEAM(b + 4);
        if (INP(5, b + 5)) for (int rep = 0; rep < NREP(5); ++rep) { MKCTX(); phase_mix3(C, da, l); }
        SEAM(b + 5);
        if (INP(6, b + 6)) { MKCTX();
            if (l < DEPTH - 1) outproj_ctx(C, l, mod_ctx + 2 * DM);
            pg8::StaticOrder S; S.init(WS_MIX + (size_t)NCTX * DM * 2, WS_WOUT + (size_t)l * DM * DM * 2, SEQ, DM, DM, C.G, C.wg);
            pg8::EpiResidual E{(float*)(C.ws + WS_XS) + (size_t)NCTX * DM, DM, mod_lat + 2 * DM, mod_lat + 2 * DM};
            pg8::gemm_phase<pg8::EpiResidual, pg8::StaticOrder, true, true>(C.lds, C.tid, DM, S, E, C.ws);
        }
        SEAM(b + 6);
        if (INP(7, b + 7)) for (int rep = 0; rep < NREP(7); ++rep) { MKCTX(); phase_norm2(C, da, l); }
        SEAM(b + 7);
        if (INP(8, b + 8)) for (int rep = 0; rep < NREP(8); ++rep) { MKCTX(); phase_gather(C, da, l); }
        SEAM(b + 8);
        if (INP(9, b + 9)) for (int rep = 0; rep < NREP(9); ++rep) { MKCTX();
            const int nblk = moe_tables(C);
            pg8::MoeOrder S{(unsigned)WS_XG8, (unsigned)(WS_WGU + (size_t)l * 32 * 2048 * DM), 256u * DM, 2048u * DM,
                            (const LAS unsigned char*)(C.lds + MISC_OFF + 1024), nblk, 8, C.G, C.wg};
            pg8::EpiSwiglu E{(bf16*)(C.ws + WS_ACT8), DM, da.in[I_BGU] + (size_t)l * 32 * 2048, 2048, pg8::X8_S * pg8::W8_S, 1.0f / (pg8::X8_S * pg8::W8_S)};
            pg8::gemm_phase<pg8::EpiSwiglu, pg8::MoeOrder, true, true, 1>(C.lds, C.tid, DM, S, E, C.ws);
        }
        SEAM(b + 9);
        if (INP(10, b + 10)) for (int rep = 0; rep < NREP(10); ++rep) { MKCTX();
            const int nblk = moe_tables(C);
            pg8::MoeOrder S{(unsigned)WS_ACT8, (unsigned)(WS_WDN + (size_t)l * 32 * DM * DM), 256u * DM, (unsigned)(DM * DM),
                            (const LAS unsigned char*)(C.lds + MISC_OFF + 1024), nblk, 4, C.G, C.wg};
            pg8::EpiStoreBf16 E{(bf16*)(C.ws + WS_XG), DM, da.in[I_BDN] + (size_t)l * 32 * DM, DM, pg8::ACT_S * pg8::W8_S, 1.0f / (pg8::ACT_S * pg8::W8_S)};
            pg8::gemm_phase<pg8::EpiStoreBf16, pg8::MoeOrder, true, true, 1>(C.lds, C.tid, DM, S, E, C.ws);
        }
        SEAM(b + 10);
    }
    if (INP(99, PH_TOTAL - 1)) for (int rep = 0; rep < NREP(99); ++rep) { MKCTX(); phase_final(C, da); }
#undef IN
#undef INP
#undef SEAM
}

typedef void (*kern_t)(Args);
static kern_t kern_of(int o) {
    switch (o) { case 0: return mega<0>; case 1: return mega<1>; case 2: return mega<2>; case 3: return mega<3>; case 4: return mega<4>; case 5: return mega<5>; case 6: return mega<6>;
                 case 7: return mega<7>; case 8: return mega<8>; case 9: return mega<9>; case 10: return mega<10>; case 11: return mega<11>; case 99: return mega<99>;
#if MK_SINGLE
                 default: return mega<-1>;
#else
                 default: return mega<0>;
#endif
    }
}
extern "C" void kernel_launch(void* const* d_in, const int* in_sizes, int n_in, void* d_out, int out_size, void* d_ws, size_t ws_size, hipStream_t stream) {
    static int ready = 0;
    if (ready == 0) {
        if (n_in != 31 || out_size != SEQ * DM || ws_size < WS_END) { fprintf(stderr, "kernel_launch: unexpected shapes (n_in %d, out %d, ws %zu)\n", n_in, out_size, ws_size); ready = -1; return; }
        const int ids[14] = {0, 1, 2, 3, 4, 5, 6, 7, 8, 9, 10, 11, 99, -1};
        for (int i = 0; i < (MK_SINGLE ? 14 : 13); ++i) { if (MK_SINGLE && ids[i] != -1) continue;
            if (hipFuncSetAttribute((const void*)kern_of(ids[i]), hipFuncAttributeMaxDynamicSharedMemorySize, LDS_BYTES) != hipSuccess) { fprintf(stderr, "kernel_launch: hipFuncSetAttribute failed (%d)\n", ids[i]); ready = -1; return; } }
        ready = 1;
    }
    if (ready < 0) return;
    (void)hipMemsetAsync((char*)d_ws + WS_CTL, 0, CTL_ZERO_BYTES, stream);
    Args a{};
    for (int i = 0; i < 31; ++i) a.in[i] = (const float*)d_in[i];
    a.out = (float*)d_out; a.ws = (unsigned char*)d_ws; a.pad = 0;
#if MK_SINGLE
    a.ph_lo = 0; a.ph_hi = PH_TOTAL; a.use_bar = 1;
    hipLaunchKernelGGL(kern_of(-1), dim3(NWG), dim3(NTHR), LDS_BYTES, stream, a);
#else
    for (int p = 0; p < PH_TOTAL; ++p) { a.ph_lo = p; a.ph_hi = p + 1; a.use_bar = 0;
        const int j = (p - 1) % NPL; const int o = (p == 0) ? 0 : (p == PH_TOTAL - 1) ? 99 : (j < 3 ? 1 + j : j == 3 ? 11 : j);
        hipLaunchKernelGGL(kern_of(o), dim3(NWG), dim3(NTHR), LDS_BYTES, stream, a); }
#endif
}
```

```cpp
#include <hip/hip_runtime.h>
#include <cstdio>
#include <cstdint>

#define LAS __attribute__((address_space(3)))
typedef unsigned short bf16;
typedef float f32x4 __attribute__((ext_vector_type(4)));
typedef float f32x2 __attribute__((ext_vector_type(2)));
typedef short bf16x8 __attribute__((ext_vector_type(8)));
typedef unsigned u32x4 __attribute__((ext_vector_type(4)));
typedef unsigned u32x2 __attribute__((ext_vector_type(2)));

constexpr int DM = 1024, SEQ = 16384, NCTX = 256, ROWS = SEQ + NCTX, DEPTH = 4, GRIDW = 64;
constexpr int INW = 2720, INWP = 2816;
constexpr int C_AQ = 0, C_AK = 256, C_AV = 384, C_BU = 512, C_CQ = 768, C_CK = 1024, C_CV = 1280, C_DR = 1536, C_DK = 1792, C_DV = 2048, C_WL = 2304, C_AL = 2432, C_GL = 2560;
constexpr int NEXP = 32, TOPK = 4;
constexpr int MOE_MAXBLK = 296;
constexpr int MOE_ROWS = MOE_MAXBLK * 256;
constexpr int NWG = 256, NTHR = 512, NWAVES = 8;
constexpr int VTP = ROWS + 256;

constexpr size_t MiB = 1u << 20;
constexpr size_t WS_CTL = 0, CTL_ZERO_BYTES = 1 * MiB;
constexpr size_t WS_MOD = 1 * MiB;
constexpr size_t WS_TW = 2 * MiB;
constexpr size_t WS_MTAB = 3 * MiB;
constexpr size_t WS_XS = 4 * MiB;
constexpr size_t WS_H = 70 * MiB;
constexpr size_t WS_P = 104 * MiB;
constexpr size_t WS_MIX = 194 * MiB;
constexpr size_t WS_FYR = 228 * MiB, WS_FYI = 244 * MiB;
constexpr size_t WS_VTA = 1544 * MiB, WS_VTC = 1550 * MiB;
constexpr size_t WS_SC = 260 * MiB;
constexpr size_t WS_YS = 408 * MiB;
constexpr size_t WS_ROUTE = 442 * MiB;
constexpr size_t WS_CNT = 444 * MiB;
constexpr size_t WS_XG = 446 * MiB;
constexpr size_t WS_ACT = 596 * MiB;
constexpr size_t WS_XG8 = WS_ACT, WS_ACT8 = WS_ACT + 75 * MiB;
constexpr size_t WS_WIN = 746 * MiB;
constexpr size_t WS_WOUT = 768 * MiB;
constexpr size_t WS_WGU = 776 * MiB;
constexpr size_t WS_WDN = 1288 * MiB;
constexpr size_t WS_RPP = 1560 * MiB, WS_PSC = 1578 * MiB, WS_LSC = 1580 * MiB, WS_HSC = 1584 * MiB;
constexpr size_t WS_FTAB = 1586 * MiB;
constexpr size_t WS_G2T = 1588 * MiB, WS_RWT = 1589 * MiB;
constexpr size_t WS_LORAT = 1590 * MiB;
constexpr size_t WS_F256 = 1591 * MiB;

constexpr size_t WS_END = 1592 * MiB;
static_assert(WS_XS + (size_t)ROWS * DM * 4 <= WS_H && WS_H + (size_t)ROWS * DM * 2 <= WS_P && WS_P + (size_t)ROWS * INWP * 2 <= WS_MIX && WS_MIX + (size_t)ROWS * DM * 2 <= WS_FYR, "ws map 1");
static_assert(WS_SC + (size_t)ROWS * 9 * 256 * 4 <= WS_YS && WS_YS + (size_t)2 * ROWS * 256 * 4 <= WS_ROUTE && WS_XG + (size_t)MOE_ROWS * DM * 2 <= WS_ACT && WS_ACT + (size_t)MOE_ROWS * DM * 2 <= WS_WIN, "ws map 2");
static_assert(WS_WIN + (size_t)4 * INWP * DM * 2 <= WS_WOUT && WS_WGU + (size_t)4 * 32 * 2048 * 1024 * 2 <= WS_WDN && WS_WDN + (size_t)4 * 32 * 1024 * 1024 * 2 <= WS_END, "ws map 3");
constexpr int CW_BAR = 4096;
constexpr int CW_WQ = 16384;

constexpr int RING_BYTES = 131072;
constexpr int MISC_OFF = 143360;
constexpr int LDS_BYTES = 147456;

__device__ __forceinline__ unsigned f2bf(float f) { unsigned u = __builtin_bit_cast(unsigned, f); return (u + 0x7fffu + ((u >> 16) & 1u)) >> 16; }
__device__ __forceinline__ unsigned pk2(float lo, float hi) { return f2bf(lo) | (f2bf(hi) << 16); }
__device__ __forceinline__ float bf2f(unsigned short b) { return __builtin_bit_cast(float, (unsigned)b << 16); }
__device__ __forceinline__ float bflo(unsigned w) { return __builtin_bit_cast(float, w << 16); }
__device__ __forceinline__ float bfhi(unsigned w) { return __builtin_bit_cast(float, w & 0xffff0000u); }
__device__ __forceinline__ float shx(float v, int o, int lane) { return __builtin_bit_cast(float, __builtin_amdgcn_ds_bpermute((lane ^ o) << 2, __builtin_bit_cast(int, v))); }
__device__ __forceinline__ int shxi(int v, int o, int lane) { return __builtin_amdgcn_ds_bpermute((lane ^ o) << 2, v); }
__device__ __forceinline__ float dpp_ror(float v, int ctrl_unused);
#define DPP_ROR_ADD(v, n) v += __builtin_bit_cast(float, __builtin_amdgcn_update_dpp(0, __builtin_bit_cast(int, v), 0x120 + (n), 0xf, 0xf, false))
__device__ __forceinline__ float wave_sum(float v, int lane) {
    DPP_ROR_ADD(v, 8); DPP_ROR_ADD(v, 4); DPP_ROR_ADD(v, 2); DPP_ROR_ADD(v, 1);
    v += shx(v, 16, lane); v += shx(v, 32, lane);
    return v;
}
__device__ __forceinline__ float sigmoidf_(float x) { return 1.f / (1.f + __expf(-x)); }
#define LDS_WAIT() asm volatile("s_waitcnt lgkmcnt(0)" ::: "memory")
#define VM_WAIT() asm volatile("s_waitcnt vmcnt(0)" ::: "memory")

namespace pg8 {
#define PG8_LAS __attribute__((address_space(3)))
typedef unsigned short bf16_t;
constexpr int BM = 256, BK = 64, HALF = 128, HTB = HALF * BK * 2, STAGE_BYTES = 8 * HTB, NXCD = 8, WGM = 8;
__host__ __device__ __forceinline__ int lds_byte(int r, int c) { const int st = (r >> 4) * 2 + (c >> 5), rr = r & 15, cc = c & 31, ob = rr * 64 + cc * 2; return st * 1024 + (ob ^ (((ob >> 9) & 1) << 5)); }
__host__ __device__ __forceinline__ void stage_rc(int b, int& R, int& C) { const int st = b / 1024, sb = b % 1024, swz = sb ^ (((sb >> 9) & 1) << 5); R = (st >> 1) * 16 + swz / 64; C = (st & 1) * 32 + (swz % 64) / 2; }
__host__ __device__ __forceinline__ int perm32(int rho) { const int n = rho >> 4, i = rho & 15; return 8 * (i >> 2) + 4 * n + (i & 3); }
struct Unit { int pm, pn, e; };
typedef int v8i __attribute__((ext_vector_type(8))); typedef int v4i __attribute__((ext_vector_type(4)));
__device__ __forceinline__ v8i cat8(bf16x8 a, bf16x8 b) { const v4i x = __builtin_bit_cast(v4i, a), y = __builtin_bit_cast(v4i, b); return __builtin_shufflevector(x, y, 0, 1, 2, 3, 4, 5, 6, 7); }
__device__ __forceinline__ unsigned cvt_pk_bf16(float lo, float hi) { unsigned r; asm volatile("v_cvt_pk_bf16_f32 %0, %1, %2" : "=v"(r) : "v"(lo), "v"(hi)); return r; }

struct StaticOrder {
    unsigned A, Bt, tstep;
    int nM, nN, nwg, G, c;
    __device__ void init(size_t A_, size_t Bt_, int M, int N, int K, int G_, int c_) { A = (unsigned)A_; Bt = (unsigned)Bt_; tstep = (unsigned)(BM * K * 2); nM = M / BM; nN = N / BM; nwg = nM * nN; G = G_; c = c_; }
    __device__ bool next(int i, Unit& u) const {
        const long L = (long)i * G + c; if (L >= nwg) return false;
        int wgid = (int)L; { const int q = nwg / NXCD, r = nwg % NXCD, xcd = wgid % NXCD, off = wgid / NXCD; wgid = (xcd < r ? xcd * (q + 1) : r * (q + 1) + (xcd - r) * q) + off; }
        const int nig = WGM * nN, gid = wgid / nig, fm = gid * WGM, gsz = (nM - fm) < WGM ? (nM - fm) : WGM;
        u.pm = fm + ((wgid % nig) % gsz); u.pn = (wgid % nig) / gsz; u.e = 0; return true;
    }
    __device__ __forceinline__ unsigned pa(const Unit& u) const { return A + (unsigned)u.pm * tstep; }
    __device__ __forceinline__ unsigned pb(const Unit& u) const { return Bt + (unsigned)u.pn * tstep; }
};
struct MoeOrder {
    unsigned A, Bt, tstep, estep;
    const LAS unsigned char* blk_e; int nblk, nN, G, c;
    __device__ bool next(int i, Unit& u) const {
        const int L = i * G + c; if (L >= nblk * nN) return false;
        u.pm = L / nN; u.pn = L % nN; u.e = __builtin_amdgcn_readfirstlane((int)blk_e[u.pm]); return true;
    }
    __device__ __forceinline__ unsigned pa(const Unit& u) const { return A + (unsigned)u.pm * tstep; }
    __device__ __forceinline__ unsigned pb(const Unit& u) const { return Bt + (unsigned)u.e * estep + (unsigned)u.pn * tstep; }
};

struct EpiStoreBf16 {
    static constexpr bool PERM = true;
    bf16_t* O; int ldc; const float* bias; int bias_estride; float bias_scale, acc_scale;
    __device__ __forceinline__ void init(f32x4 (&acc)[2][2][4][2], const Unit& u, int wc, int fq) const {
        const int col0 = u.pn * BM + wc * 32 + 8 * fq;
#pragma unroll
        for (int b = 0; b < 2; ++b)
#pragma unroll
            for (int n = 0; n < 2; ++n) { const f32x4 bv = bias ? *(const f32x4*)(bias + (size_t)u.e * bias_estride + col0 + b * HALF + 4 * n) * bias_scale : (f32x4){0.f, 0.f, 0.f, 0.f};
#pragma unroll
                for (int a = 0; a < 2; ++a)
#pragma unroll
                    for (int m = 0; m < 4; ++m) { f32x4 t = bv; asm volatile("" : "+v"(t)); acc[a][b][m][n] = t; } }
    }
    __device__ __forceinline__ void operator()(const f32x4 (&acc)[2][2][4][2], const Unit& u, int wr, int wc, int fr, int fq) const {
        const int row0 = u.pm * BM + wr * 64 + fr, col0 = u.pn * BM + wc * 32 + 8 * fq;
#pragma unroll
        for (int ai = 0; ai < 2; ++ai)
#pragma unroll
            for (int m = 0; m < 4; ++m) { bf16_t* rowp = O + (size_t)(row0 + ai * HALF + m * 16) * ldc + col0;
#pragma unroll
                for (int bj = 0; bj < 2; ++bj) { const f32x4 v0 = acc[ai][bj][m][0] * acc_scale, v1 = acc[ai][bj][m][1] * acc_scale;
                    u32x4 w; w.x = cvt_pk_bf16(v0[0], v0[1]); w.y = cvt_pk_bf16(v0[2], v0[3]); w.z = cvt_pk_bf16(v1[0], v1[1]); w.w = cvt_pk_bf16(v1[2], v1[3]);
                    *(u32x4*)(rowp + bj * HALF) = w; }
                asm volatile("" ::: "memory"); }
    }
};
__device__ __forceinline__ float swiglu1(float g, float up) {
    g = fminf(g, 7.0f); up = fminf(fmaxf(up, -7.0f), 7.0f);
    return g * (1.f / (1.f + __expf(-1.702f * g))) * (up + 1.0f);
}
constexpr float X8_S = 8.0f, W8_S = 256.0f, ACT_S = 4.0f;
struct EpiSwiglu {
    static constexpr bool PERM = true;
    bf16_t* O; int ldc; const float* bias; int bias_estride; float bias_scale, acc_scale;
    __device__ __forceinline__ void init(f32x4 (&acc)[2][2][4][2], const Unit& u, int wc, int fq) const {
        const int col0 = u.pn * BM + wc * 32 + 8 * fq;
#pragma unroll
        for (int b = 0; b < 2; ++b)
#pragma unroll
            for (int n = 0; n < 2; ++n) { const f32x4 bv = bias ? *(const f32x4*)(bias + (size_t)u.e * bias_estride + col0 + b * HALF + 4 * n) * bias_scale : (f32x4){0.f, 0.f, 0.f, 0.f};
#pragma unroll
                for (int a = 0; a < 2; ++a)
#pragma unroll
                    for (int m = 0; m < 4; ++m) { f32x4 t = bv; asm volatile("" : "+v"(t)); acc[a][b][m][n] = t; } }
    }
    __device__ __forceinline__ void operator()(const f32x4 (&acc)[2][2][4][2], const Unit& u, int wr, int wc, int fr, int fq) const {
        const int row0 = u.pm * BM + wr * 64 + fr, col0 = u.pn * BM + wc * 32 + 8 * fq;
#pragma unroll
        for (int ai = 0; ai < 2; ++ai)
#pragma unroll
            for (int m = 0; m < 4; ++m) { unsigned char* rowp = (unsigned char*)O + (size_t)(row0 + ai * HALF + m * 16) * ldc + (col0 >> 1);
#pragma unroll
                for (int bj = 0; bj < 2; ++bj) { const f32x4 v0 = acc[ai][bj][m][0] * acc_scale, v1 = acc[ai][bj][m][1] * acc_scale;
                    unsigned w = 0; w = __builtin_amdgcn_cvt_pk_fp8_f32(swiglu1(v0[0], v0[1]) * ACT_S, swiglu1(v0[2], v0[3]) * ACT_S, w, false); w = __builtin_amdgcn_cvt_pk_fp8_f32(swiglu1(v1[0], v1[1]) * ACT_S, swiglu1(v1[2], v1[3]) * ACT_S, w, true);
                    *(unsigned*)(rowp + bj * (HALF / 2)) = w; }
                asm volatile("" ::: "memory"); }
    }
};
struct EpiResidual {
    static constexpr bool PERM = false;
    float* X; int ldc; const float* gate_lat; const float* gate_ctx;
    __device__ __forceinline__ void init(f32x4 (&acc)[2][2][4][2], const Unit& u, int wc, int fq) const {
#pragma unroll
        for (int a = 0; a < 2; ++a)
#pragma unroll
            for (int b = 0; b < 2; ++b)
#pragma unroll
                for (int m = 0; m < 4; ++m)
#pragma unroll
                    for (int n = 0; n < 2; ++n) acc[a][b][m][n] = (f32x4){0.f, 0.f, 0.f, 0.f};
    }
    __device__ __forceinline__ void operator()(const f32x4 (&acc)[2][2][4][2], const Unit& u, int wr, int wc, int fr, int fq) const {
        const int row0 = u.pm * BM + wr * 64 + fr, col0 = u.pn * BM + wc * 32 + 4 * fq;
        const float* gp = (u.pm == 0) ? gate_ctx : gate_lat;
        f32x4 gv[2][2];
#pragma unroll
        for (int bj = 0; bj < 2; ++bj)
#pragma unroll
            for (int n = 0; n < 2; ++n) gv[bj][n] = *(const f32x4*)(gp + col0 + bj * HALF + n * 16);
#pragma unroll
        for (int ai = 0; ai < 2; ++ai)
#pragma unroll
            for (int m = 0; m < 4; ++m) { float* rowp = X + (size_t)(row0 + ai * HALF + m * 16) * ldc + col0;
#pragma unroll
                for (int bj = 0; bj < 2; ++bj)
#pragma unroll
                    for (int n = 0; n < 2; ++n) { f32x4* p = (f32x4*)(rowp + bj * HALF + n * 16); *p = *p + gv[bj][n] * acc[ai][bj][m][n]; }
                asm volatile("" ::: "memory"); }
    }
};
template <class Epi, class Sched, bool ALIGN_EPI = false, bool SP2 = false, int ES = 2>
__device__ __forceinline__ void gemm_phase(PG8_LAS unsigned char* lds, const int tid, const int K, const Sched& S, const Epi& E, const void* wsbase) {
    const __amdgpu_buffer_rsrc_t rsrc = __builtin_amdgcn_make_buffer_rsrc((void*)wsbase, 0, 0x7fffffff, 0x00020000);
    const int wid = __builtin_amdgcn_readfirstlane(tid >> 6), lane = tid & 63, wr = wid >> 2, wc = wid & 3, fr = lane & 15, fq = lane >> 4;
    const int nt = (K * ES) / 128;
    unsigned voffA[2], voffB[2];
#pragma unroll
    for (int i = 0; i < 2; ++i) { int R, C; stage_rc(tid * 16 + i * 8192, R, C); const int Rb = Epi::PERM ? ((R & ~31) + perm32(R & 31)) : R;
        voffA[i] = (unsigned)(R * K * ES + C * 2); voffB[i] = (unsigned)(Rb * K * ES + C * 2); }
    const unsigned kstep = (unsigned)(BK * 2);
    const unsigned hstep = (unsigned)(HALF * K * ES);
        const unsigned ldsw = (unsigned)wid * 1024u;
    const int aoff = lds_byte(wr * 64 + fr, ES == 2 ? fq * 8 : fq * 16), boff = lds_byte(wc * 32 + fr, ES == 2 ? fq * 8 : fq * 16); constexpr int KOFF = (ES == 2) ? 1024 : 16;
#define PG8_SA(b, h) (((b) * 2 + (h)) * HTB)
#define PG8_SB(b, h) ((4 + (b) * 2 + (h)) * HTB)
#define PG8_STAGE(bufoff, gbase, voff) do { _Pragma("unroll") for (int _i = 0; _i < 2; ++_i) \
        __builtin_amdgcn_raw_ptr_buffer_load_lds(rsrc, (PG8_LAS unsigned*)(lds + (bufoff) + ldsw + _i * 8192), 16, (voff)[_i], (gbase), 0, 0); } while (0)
#define PG8_LDA(dst, b, h) do { _Pragma("unroll") for (int m = 0; m < 4; ++m) _Pragma("unroll") for (int k = 0; k < 2; ++k) dst[m][k] = *(const PG8_LAS bf16x8*)(lds + PG8_SA(b, h) + aoff + m * 2048 + k * KOFF); } while (0)
#define PG8_LDA8(dst, b, h) do { _Pragma("unroll") for (int m = 0; m < 4; ++m) { const PG8_LAS v4i* p_ = (const PG8_LAS v4i*)(lds + PG8_SA(b, h) + aoff + m * 2048); const v4i x_ = p_[0], y_ = p_[1]; dst[m] = __builtin_shufflevector(x_, y_, 0, 1, 2, 3, 4, 5, 6, 7); } } while (0)
#define PG8_LDB(dst, b, h) do { _Pragma("unroll") for (int n = 0; n < 2; ++n) _Pragma("unroll") for (int k = 0; k < 2; ++k) dst[n][k] = *(const PG8_LAS bf16x8*)(lds + PG8_SB(b, h) + boff + n * 2048 + k * KOFF); } while (0)
#define PG8_LDB8(dst, b, h) do { _Pragma("unroll") for (int n = 0; n < 2; ++n) { const PG8_LAS v4i* p_ = (const PG8_LAS v4i*)(lds + PG8_SB(b, h) + boff + n * 2048); const v4i x_ = p_[0], y_ = p_[1]; dst[n] = __builtin_shufflevector(x_, y_, 0, 1, 2, 3, 4, 5, 6, 7); } } while (0)
#define PG8_MMA(ai, bj, At, Bt) do { __builtin_amdgcn_s_setprio(1); _Pragma("unroll") for (int m = 0; m < 4; ++m) _Pragma("unroll") for (int n = 0; n < 2; ++n) { \
        if constexpr (ES == 2) { _Pragma("unroll") for (int k = 0; k < 2; ++k) acc[ai][bj][m][n] = __builtin_amdgcn_mfma_f32_16x16x32_bf16(Bt[n][k], At[m][k], acc[ai][bj][m][n], 0, 0, 0); } \
        else asm volatile("v_mfma_f32_16x16x128_f8f6f4 %0, %1, %2, %0" : "+v"(acc[ai][bj][m][n]) : "v"(Bt##8[n]), "v"(At##8[m])); } \
        __builtin_amdgcn_s_setprio(0); } while (0)
#define PG8_LDAX(b, h) do { if constexpr (ES == 2) PG8_LDA(At, b, h); else PG8_LDA8(At8, b, h); } while (0)
#define PG8_LDBX(B, b, h) do { if constexpr (ES == 2) PG8_LDB(B, b, h); else PG8_LDB8(B##8, b, h); } while (0)
#define PG8_WAIT_V(n) asm volatile("s_waitcnt vmcnt(" #n ")" ::: "memory")
#define PG8_WAIT_L(n) asm volatile("s_waitcnt lgkmcnt(" #n ")" ::: "memory")
#define PG8_BAR __builtin_amdgcn_s_barrier()
#define PG8_SCHED __builtin_amdgcn_sched_barrier(0)
    Unit cur, nxt; int ui = 0;
    if (!S.next(0, cur)) return;
    f32x4 acc[2][2][4][2];
    E.init(acc, cur, wc, fq);
    bf16x8 At[4][2], B0[2][2], B1[2][2]; v8i At8[4], B08[2], B18[2];
    unsigned cA = S.pa(cur), cB = S.pb(cur);
    if constexpr (SP2) {
        PG8_STAGE(PG8_SB(0, 0), cB, voffB); PG8_STAGE(PG8_SB(0, 1), cB + hstep, voffB); PG8_STAGE(PG8_SA(0, 0), cA, voffA); PG8_STAGE(PG8_SA(0, 1), cA + hstep, voffA);
        if (wr == 1) PG8_BAR;
        PG8_WAIT_V(2); PG8_BAR;
        PG8_STAGE(PG8_SB(1, 0), cB + kstep, voffB); PG8_STAGE(PG8_SA(1, 0), cA + kstep, voffA); PG8_STAGE(PG8_SB(1, 1), cB + hstep + kstep, voffB);
        PG8_WAIT_V(6); PG8_BAR;
    } else {
        PG8_STAGE(PG8_SB(0, 0), cB, voffB); PG8_STAGE(PG8_SA(0, 0), cA, voffA); PG8_STAGE(PG8_SB(0, 1), cB + hstep, voffB); PG8_STAGE(PG8_SA(0, 1), cA + hstep, voffA);
        if (wr == 1) PG8_BAR;
        PG8_WAIT_V(4); PG8_BAR;
        PG8_STAGE(PG8_SB(1, 0), cB + kstep, voffB); PG8_STAGE(PG8_SA(1, 0), cA + kstep, voffA); PG8_STAGE(PG8_SB(1, 1), cB + hstep + kstep, voffB);
        PG8_WAIT_V(6); PG8_BAR;
    }
    for (;;) {
        const bool has_next = S.next(ui + 1, nxt);
        const unsigned nA = has_next ? S.pa(nxt) : cA, nB = has_next ? S.pb(nxt) : cB;
        for (int t = 0; t < nt; t += 2) {
            const bool last = (t == nt - 2);
            const unsigned a1 = cA + (unsigned)(t + 1) * kstep;
            const unsigned a2 = last ? nA : cA + (unsigned)(t + 2) * kstep, b2 = last ? nB : cB + (unsigned)(t + 2) * kstep;
            const unsigned a3 = a2 + kstep, b3 = b2 + kstep;
            if constexpr (SP2) {
            PG8_LDBX(B0, 0, 0); PG8_LDBX(B1, 0, 1); PG8_SCHED; PG8_LDAX(0, 0); PG8_STAGE(PG8_SA(1, 1), a1 + hstep, voffA);
            PG8_WAIT_V(8); PG8_WAIT_L(0); PG8_BAR; PG8_MMA(0, 0, At, B0); PG8_MMA(0, 1, At, B1); PG8_BAR; PG8_SCHED;
            PG8_LDAX(0, 1); PG8_STAGE(PG8_SB(0, 0), b2, voffB); PG8_STAGE(PG8_SB(0, 1), b2 + hstep, voffB); PG8_STAGE(PG8_SA(0, 0), a2, voffA);
            PG8_WAIT_V(8); PG8_WAIT_L(0); PG8_BAR; PG8_MMA(1, 0, At, B0); PG8_MMA(1, 1, At, B1); PG8_BAR; PG8_SCHED;
            PG8_LDBX(B0, 1, 0); PG8_LDBX(B1, 1, 1); PG8_SCHED; PG8_LDAX(1, 0); PG8_STAGE(PG8_SA(0, 1), a2 + hstep, voffA);
            PG8_WAIT_V(8); PG8_WAIT_L(0); PG8_BAR; PG8_MMA(0, 0, At, B0); PG8_MMA(0, 1, At, B1); PG8_BAR; PG8_SCHED;
            PG8_LDAX(1, 1); PG8_STAGE(PG8_SB(1, 0), b3, voffB); PG8_STAGE(PG8_SB(1, 1), b3 + hstep, voffB); PG8_STAGE(PG8_SA(1, 0), a3, voffA);
            PG8_WAIT_V(8); PG8_WAIT_L(0); PG8_BAR; PG8_MMA(1, 0, At, B0); PG8_MMA(1, 1, At, B1); PG8_BAR; PG8_SCHED;
            } else {
            PG8_LDBX(B0, 0, 0); PG8_SCHED; PG8_LDAX(0, 0); PG8_STAGE(PG8_SA(1, 1), a1 + hstep, voffA);
            PG8_WAIT_L(8); PG8_BAR; PG8_WAIT_L(0); PG8_MMA(0, 0, At, B0); PG8_BAR; PG8_SCHED;
            PG8_LDBX(B1, 0, 1); PG8_STAGE(PG8_SB(0, 0), b2, voffB);
            PG8_BAR; PG8_WAIT_L(0); PG8_MMA(0, 1, At, B1); PG8_BAR;
            PG8_LDAX(0, 1); PG8_STAGE(PG8_SA(0, 0), a2, voffA);
            PG8_BAR; PG8_WAIT_L(0); PG8_MMA(1, 0, At, B0); PG8_BAR; PG8_SCHED;
            PG8_STAGE(PG8_SB(0, 1), b2 + hstep, voffB);
            PG8_WAIT_V(6); PG8_BAR; PG8_MMA(1, 1, At, B1); PG8_BAR;
            PG8_LDBX(B0, 1, 0); PG8_SCHED; PG8_LDAX(1, 0); PG8_STAGE(PG8_SA(0, 1), a2 + hstep, voffA);
            PG8_WAIT_L(8); PG8_BAR; PG8_WAIT_L(0); PG8_MMA(0, 0, At, B0); PG8_BAR; PG8_SCHED;
            PG8_LDBX(B1, 1, 1); PG8_STAGE(PG8_SB(1, 0), b3, voffB);
            PG8_BAR; PG8_WAIT_L(0); PG8_MMA(0, 1, At, B1); PG8_BAR;
            PG8_LDAX(1, 1); PG8_STAGE(PG8_SA(1, 0), a3, voffA);
            PG8_BAR; PG8_WAIT_L(0); PG8_MMA(1, 0, At, B0); PG8_BAR; PG8_SCHED;
            PG8_STAGE(PG8_SB(1, 1), b3 + hstep, voffB);
            PG8_WAIT_V(6); PG8_BAR; PG8_MMA(1, 1, At, B1); PG8_BAR;
            }
        }
        if constexpr (ALIGN_EPI) { if (wr == 0) PG8_BAR; }
        if constexpr (ES == 1) asm volatile("s_nop 15\n\ts_nop 15" ::: "memory");
        E(acc, cur, wr, wc, fr, fq);
        if (!has_next) break;
        E.init(acc, nxt, wc, fq);
        cur = nxt; cA = nA; cB = nB; ++ui;
        if constexpr (ALIGN_EPI) { if (wr == 1) PG8_BAR; }
    }
    PG8_WAIT_V(0);
    if constexpr (!ALIGN_EPI) { if (wr == 0) PG8_BAR; }
    PG8_BAR;
#undef PG8_SA
#undef PG8_SB
#undef PG8_STAGE
#undef PG8_LDA
#undef PG8_LDA8
#undef PG8_LDB8
#undef PG8_LDAX
#undef PG8_LDBX
#undef PG8_LDB
#undef PG8_MMA
#undef PG8_WAIT_V
#undef PG8_WAIT_L
#undef PG8_BAR
#undef PG8_SCHED
}
}

#define XB_TMO      128
#define XB_XCNT(j)  (256  + 64 * (j))
#define XB_XSUB(j)  (1280 + 64 * (j))
#define XB_XGEN(j)  (2304 + 64 * (j))
#define XB_TOP      3328
#define XB_TOPGEN   3392
#define XCD_BAR_WORDS 3456
#define XB_SPIN_CAP (1u << 18)
__device__ __forceinline__ unsigned xb_ld(unsigned* p)              { return __hip_atomic_load(p, __ATOMIC_RELAXED, __HIP_MEMORY_SCOPE_AGENT); }
__device__ __forceinline__ unsigned xb_add(unsigned* p, unsigned v) { return __hip_atomic_fetch_add(p, v, __ATOMIC_RELAXED, __HIP_MEMORY_SCOPE_AGENT); }
__device__ __forceinline__ unsigned xb_xcc_id() { return (unsigned)__builtin_amdgcn_s_getreg((3 << 11) | 20) & 0xFu; }
#define XB_SPIN(cond, bar) do { unsigned _sp = 0; while (cond) { __builtin_amdgcn_s_sleep(1); \
    if ((++_sp & 255u) == 0u) { if (xb_ld(&(bar)[XB_TMO])) break; if (_sp > XB_SPIN_CAP) { atomicAdd(&(bar)[XB_TMO], 1u); break; } } } } while (0)

struct XcdBarrier {
    unsigned* bar; unsigned x;
    volatile LAS unsigned* st;
};

__device__ __forceinline__ XcdBarrier xcd_barrier_post(unsigned* bar, volatile LAS unsigned* st) {
    XcdBarrier b; b.bar = bar; b.x = xb_xcc_id(); b.st = st;
    if (threadIdx.x == 0) (void)xb_add(&bar[XB_XCNT(b.x)], 1u);
    return b;
}
__device__ __forceinline__ void xcd_barrier_complete(unsigned* bar, unsigned x, unsigned& nloc, unsigned& nx) {
    const unsigned G = gridDim.x * gridDim.y * gridDim.z;
    unsigned sum, cnt, mine, sp = 0u;
    for (;;) {
        sum = 0u; cnt = 0u; mine = 0u;
#pragma unroll
        for (unsigned j = 0; j < 16; ++j) { const unsigned c = xb_ld(&bar[XB_XCNT(j)]); sum += c; cnt += (c > 0u) ? 1u : 0u; mine = (j == x) ? c : mine; }
        if (sum == G) break;
        __builtin_amdgcn_s_sleep(1);
        if ((++sp & 255u) == 0u) { if (xb_ld(&bar[XB_TMO])) break; if (sp > XB_SPIN_CAP) { atomicAdd(&bar[XB_TMO], 1u); break; } }
    }
    nloc = mine > 0u ? mine : 1u; nx = cnt > 0u ? cnt : 1u;
}

__device__ __forceinline__ void xcd_barrier(const XcdBarrier& b) {
    asm volatile("s_waitcnt vmcnt(0)" ::: "memory");
    __syncthreads();
    if (threadIdx.x == 0) {
        unsigned* bar = b.bar;
        __builtin_amdgcn_s_waitcnt(0);
        unsigned nloc = b.st[0], nx = b.st[1];
        if (nloc == 0u) { xcd_barrier_complete(bar, b.x, nloc, nx); b.st[0] = nloc; b.st[1] = nx; }
        const unsigned old = xb_add(&bar[XB_XSUB(b.x)], 1u);
        const unsigned gen = old / nloc;
        if (old + 1u == (gen + 1u) * nloc) {
            __builtin_amdgcn_fence(__ATOMIC_RELEASE, "agent");
            asm volatile("s_waitcnt vmcnt(0)" ::: "memory");
            const unsigned og = xb_add(&bar[XB_TOP], 1u);
            const unsigned tg = og / nx;
            if (og + 1u == (tg + 1u) * nx) xb_add(&bar[XB_TOPGEN], 1u);
            else XB_SPIN(xb_ld(&bar[XB_TOPGEN]) == tg, bar);
            __builtin_amdgcn_fence(__ATOMIC_ACQUIRE, "agent");
            xb_add(&bar[XB_XGEN(b.x)], 1u);
            asm volatile("s_waitcnt vmcnt(0)" ::: "memory");
        } else {
            XB_SPIN(xb_ld(&bar[XB_XGEN(b.x)]) == gen, bar);
            __builtin_amdgcn_fence(__ATOMIC_ACQUIRE, "agent");
            asm volatile("s_waitcnt vmcnt(0)" ::: "memory");
        }
    }
    __syncthreads();
}

typedef short s4v __attribute__((ext_vector_type(4)));
__device__ __forceinline__ bf16x8 ldg8(const bf16* p) { return *(const bf16x8*)p; }
__device__ __forceinline__ f32x4 mfma16(bf16x8 a, bf16x8 b, f32x4 c) { return __builtin_amdgcn_mfma_f32_16x16x32_bf16(a, b, c, 0, 0, 0); }
__device__ __forceinline__ bf16x8 ldA(const LAS unsigned char* base, int pitch, int row0, int k0, int li, int g) { return *(const LAS bf16x8*)(base + ((row0 + li) * pitch + k0 + 8 * g) * 2); }
__device__ __forceinline__ bf16x8 ldT(const LAS unsigned char* base, int pitch, int k0, int n0, int li, int g) {
    const LAS unsigned char* p = base + ((k0 + 8 * g + (li >> 2)) * pitch + n0 + 4 * (li & 3)) * 2;
    const s4v a = __builtin_amdgcn_ds_read_tr16_b64_v4i16((LAS s4v*)p), b = __builtin_amdgcn_ds_read_tr16_b64_v4i16((LAS s4v*)(p + 8 * pitch));
    return (bf16x8){a[0], a[1], a[2], a[3], b[0], b[1], b[2], b[3]};
}
__device__ __forceinline__ bf16x8 ldAperm(const LAS unsigned char* base, int pitch, int row0, int ks, int li, int g) {
    const LAS unsigned char* p = base + ((row0 + li) * pitch + 32 * ks + 4 * g) * 2;
    const s4v a = *(const LAS s4v*)p, b = *(const LAS s4v*)(p + 32);
    return (bf16x8){a[0], a[1], a[2], a[3], b[0], b[1], b[2], b[3]};
}
__device__ __forceinline__ void stT(LAS unsigned char* base, int pitch, int n, int m0, const f32x4 v) {
    u32x2 w; w.x = pk2(v[0], v[1]); w.y = pk2(v[2], v[3]); *(LAS u32x2*)(base + (n * pitch + m0) * 2) = w;
}
__device__ __forceinline__ f32x4 ld4bf(const LAS unsigned char* p) { const u32x2 w = *(const LAS u32x2*)p; return (f32x4){bflo(w.x), bfhi(w.x), bflo(w.y), bfhi(w.y)}; }

struct Args {
    const float* in[31];
    float* out; unsigned char* ws;
    int ph_lo, ph_hi, use_bar, pad;
};
enum InIdx { I_X = 0, I_C, I_CTX, I_CCTX, I_ADAW, I_ADAB, I_N1G, I_N2G, I_WIN, I_WOUT, I_ASINK, I_BMIX, I_CREL, I_DCONV, I_DW0, I_DW2, I_DA0, I_DA2, I_DG2, I_DKK, I_DKA, I_DRK, I_DLNW, I_DLNB,
             I_RW, I_RB, I_WGU, I_BGU, I_WDN, I_BDN, I_FNG };
constexpr int NPL = 11;
constexpr int PH_TOTAL = 1 + DEPTH * NPL + 1;

struct DevIn {
    const LAS unsigned* tab;
    __device__ __forceinline__ const float* operator[](int i) const {
        const unsigned lo = __builtin_amdgcn_readfirstlane(((const volatile LAS unsigned*)tab)[2 * i]), hi = __builtin_amdgcn_readfirstlane(((const volatile LAS unsigned*)tab)[2 * i + 1]);
        return (const float*)(((unsigned long long)hi << 32) | lo);
    }
};
struct DArgs { DevIn in; float* out; };
struct Ctx {
    LAS unsigned char* lds;
    int tid, lane, wave, wg, G, gw, NGW;
    unsigned char* ws;
};

template <int NW>
__device__ __forceinline__ void transpose_item(const float* W, int K, int N, bf16* WT, int item, int lane) {
    constexpr int NQ = NW / 4, NC = 64 / NQ, PASSES = 8 / NC;
    const int nblk = N / NW, kb = item / nblk, nb = item % nblk, k0 = 64 * kb, n0 = NW * nb, nq = lane % NQ, cq = lane / NQ;
    f32x4 v[PASSES][8];
#pragma unroll
    for (int ps = 0; ps < PASSES; ++ps)
#pragma unroll
        for (int i = 0; i < 8; ++i) v[ps][i] = *(const f32x4*)(W + (size_t)(k0 + 8 * (cq + NC * ps) + i) * N + n0 + 4 * nq);
#pragma unroll
    for (int ps = 0; ps < PASSES; ++ps)
#pragma unroll
        for (int j = 0; j < 4; ++j) { u32x4 o; o.x = pk2(v[ps][0][j], v[ps][1][j]); o.y = pk2(v[ps][2][j], v[ps][3][j]); o.z = pk2(v[ps][4][j], v[ps][5][j]); o.w = pk2(v[ps][6][j], v[ps][7][j]);
            *(u32x4*)(WT + (size_t)(n0 + 4 * nq + j) * K + k0 + 8 * (cq + NC * ps)) = o; }
}
template <int NW>
__device__ __forceinline__ void transpose_item8(const float* W, int K, int N, unsigned char* WT, int item, int lane) {
    constexpr int NQ = NW / 4, NC = 64 / NQ, PASSES = 8 / NC;
    const int nblk = N / NW, kb = item / nblk, nb = item % nblk, k0 = 64 * kb, n0 = NW * nb, nq = lane % NQ, cq = lane / NQ;
    f32x4 v[PASSES][8];
#pragma unroll
    for (int ps = 0; ps < PASSES; ++ps)
#pragma unroll
        for (int i = 0; i < 8; ++i) v[ps][i] = __builtin_nontemporal_load((const f32x4*)(W + (size_t)(k0 + 8 * (cq + NC * ps) + i) * N + n0 + 4 * nq)) * pg8::W8_S;
#pragma unroll
    for (int ps = 0; ps < PASSES; ++ps)
#pragma unroll
        for (int j = 0; j < 4; ++j) { unsigned w0 = 0, w1 = 0;
            w0 = __builtin_amdgcn_cvt_pk_fp8_f32(v[ps][0][j], v[ps][1][j], w0, false); w0 = __builtin_amdgcn_cvt_pk_fp8_f32(v[ps][2][j], v[ps][3][j], w0, true);
            w1 = __builtin_amdgcn_cvt_pk_fp8_f32(v[ps][4][j], v[ps][5][j], w1, false); w1 = __builtin_amdgcn_cvt_pk_fp8_f32(v[ps][6][j], v[ps][7][j], w1, true);
            __builtin_nontemporal_store((u32x2){w0, w1}, (u32x2*)(WT + (size_t)(n0 + 4 * nq + j) * K + k0 + 8 * (cq + NC * ps))); }
}
constexpr int CV_IT_GU = 16 * 64, CV_IT_DN = 16 * 32, CV_N_GU = 32 * CV_IT_GU, CV_N_DN = 32 * CV_IT_DN, CV_ITEMS = CV_N_GU + CV_N_DN, CV_CHUNK = 16, CV_NCHUNK = CV_ITEMS / CV_CHUNK;
__device__ __forceinline__ void convert_moe_items(const Ctx& C, const DArgs& a, int l, int it0, int it1) {
    const float* pwgu = a.in[I_WGU] + (size_t)l * 32 * DM * 2048; const float* pwdn = a.in[I_WDN] + (size_t)l * 32 * DM * DM;
    unsigned char* ogu = C.ws + WS_WGU + (size_t)l * 32 * 2048 * DM; unsigned char* odn = C.ws + WS_WDN + (size_t)l * 32 * DM * DM;
#pragma unroll 1
    for (int it = it0; it < it1; ++it) {
        if (it < CV_N_GU) { const int e = it / CV_IT_GU; transpose_item8<32>(pwgu + (size_t)e * DM * 2048, DM, 2048, ogu + (size_t)e * 2048 * DM, it % CV_IT_GU, C.lane); }
        else { const int r = it - CV_N_GU, e = r / CV_IT_DN; transpose_item8<32>(pwdn + (size_t)e * DM * DM, DM, DM, odn + (size_t)e * DM * DM, r % CV_IT_DN, C.lane); }
    }
}
__device__ __forceinline__ void phase_prologue(const Ctx& C, const DArgs& a) {
    constexpr int IT_IN = 16 * (INW / 32), IT_OUT = 16 * 16;
    constexpr int N_IN = 4 * IT_IN, N_OUT = 4 * IT_OUT;
    const float* pwin = a.in[I_WIN]; const float* pwout = a.in[I_WOUT];
    for (int it = C.gw; it < N_IN + N_OUT; it += C.NGW) {
        if (it < N_IN) { const int l = it / IT_IN; transpose_item<32>(pwin + (size_t)l * DM * INW, DM, INW, (bf16*)(C.ws + WS_WIN) + (size_t)l * INWP * DM, it % IT_IN, C.lane); }
        else { const int r = it - N_IN, l = r / IT_OUT; transpose_item<64>(pwout + (size_t)l * DM * DM, DM, DM, (bf16*)(C.ws + WS_WOUT) + (size_t)l * DM * DM, r % IT_OUT, C.lane); }
    }
    for (int ch = C.gw; ch < CV_NCHUNK; ch += C.NGW) convert_moe_items(C, a, 0, ch * CV_CHUNK, ch * CV_CHUNK + CV_CHUNK);
    { const int gt = C.wg * NTHR + C.tid; constexpr int PADN = (INWP - INW) * DM / 8;
      for (int i = gt; i < 4 * PADN; i += C.G * NTHR) { const int l = i / PADN, r = i % PADN; *((u32x4*)((bf16*)(C.ws + WS_WIN) + ((size_t)l * INWP + INW) * DM) + r) = (u32x4){0u, 0u, 0u, 0u}; } }
    { float* tw = (float*)(C.ws + WS_TW); const int gt = C.wg * NTHR + C.tid;
      for (int i = gt; i < 16384; i += C.G * NTHR) { const float x = (float)i * (1.0f / 8192.0f); tw[i] = cospif(x); tw[16384 + i] = sinpif(x); } }
    { float* mt = (float*)(C.ws + WS_MTAB); const int gt = C.wg * NTHR + C.tid; const float* pbmix = a.in[I_BMIX];
      for (int i = gt; i < 4 * 4 * 64 * 64; i += C.G * NTHR) { const int e = i & 63, c = (i >> 6) & 63, g = (i >> 12) & 3, l = i >> 14;
          const float* w = pbmix + ((size_t)(l * 4 + g) * 64) * 64 + e; float sc = 0.f, ss = 0.f;
          for (int cp = 0; cp < 64; ++cp) { const float x = (float)((c * cp) & 63) * (1.0f / 32.0f); const float wv = w[cp * 64]; sc += cospif(x) * wv; ss += sinpif(x) * wv; }
          mt[((size_t)(l * 2 + 0) * 4 + g) * 4096 + c * 64 + e] = sc; mt[((size_t)(l * 2 + 1) * 4 + g) * 4096 + c * 64 + e] = ss; } }
    { bf16* ft = (bf16*)(C.ws + WS_FTAB); const int gt = C.wg * NTHR + C.tid; const float* pbmix = a.in[I_BMIX];
      for (int i = gt; i < 128 * 128; i += C.G * NTHR) { const int k = i >> 7, t = i & 127; const float x = (float)((k * t) & 127) * (1.0f / 64.0f); ft[i] = (bf16)f2bf(cospif(x)); ft[16384 + i] = (bf16)f2bf(sinpif(x)); }
      bf16* mf = ft + 32768;
      for (int i = gt; i < 4 * 4 * 16 * 64 * 8; i += C.G * NTHR) { const int j8 = i & 7, ln = (i >> 3) & 63, fr = (i >> 9) & 15, gq = (i >> 13) & 3, l = i >> 15;
          const int ei = fr >> 2, ks2 = fr & 3, e = 16 * ei + (ln & 15), g = ln >> 4, c = 32 * (ks2 & 1) + 16 * (j8 >> 2) + 4 * g + (j8 & 3), part = ks2 >> 1;
          const float* w = pbmix + ((size_t)(l * 4 + gq) * 64) * 64 + e; float s = 0.f;
          for (int cp = 0; cp < 64; ++cp) { const float x = (float)((c * cp) & 63) * (1.0f / 32.0f); s += (part ? sinpif(x) : cospif(x)) * w[cp * 64]; }
          mf[i] = (bf16)f2bf(s * (1.0f / 1024.0f)); } }
    { const int gt = C.wg * NTHR + C.tid; const float* pg2 = a.in[I_DG2]; const float* prw = a.in[I_RW]; bf16* g2t = (bf16*)(C.ws + WS_G2T); bf16* rwt = (bf16*)(C.ws + WS_RWT);
      for (int i = gt; i < 4 * 256 * 160; i += C.G * NTHR) { const int ii = i % 160, c = (i / 160) & 255, l = i / (160 * 256); g2t[i] = (bf16)f2bf(pg2[((size_t)l * 160 + ii) * 256 + c]); }
      for (int i = gt; i < 4 * 32 * 1024; i += C.G * NTHR) { const int k = i & 1023, e = (i >> 10) & 31, l = i >> 15; rwt[i] = (bf16)f2bf(prw[((size_t)l * 1024 + k) * 32 + e]); } }
    { const int gt = C.wg * NTHR + C.tid; const float* pw2 = a.in[I_DW2]; const float* pa2 = a.in[I_DA2]; bf16* lt = (bf16*)(C.ws + WS_LORAT);
      for (int i = gt; i < 4 * 4 * 256 * 64; i += C.G * NTHR) { const int ii = i & 63, c = (i >> 6) & 255, q = (i >> 14) & 3, l = i >> 16;
          const float* src = (q < 2) ? pw2 : pa2; lt[i] = (bf16)f2bf(src[(((size_t)l * 2 + (q & 1)) * 64 + ii) * 256 + c]); } }
    { bf16* f2 = (bf16*)(C.ws + WS_F256); const int gt = C.wg * NTHR + C.tid;
      for (int i = gt; i < 256 * 256; i += C.G * NTHR) { const int k = i >> 8, t = i & 255; const float x = (float)((k * t) & 255) * (1.0f / 128.0f); f2[i] = (bf16)f2bf(cospif(x)); f2[65536 + i] = (bf16)f2bf(sinpif(x)); } }
    { LAS float* sl = (LAS float*)(C.lds);
      LAS float* red = (LAS float*)(C.lds + 8192);
      __syncthreads();
      const float* pc = a.in[I_C]; const float* pcc = a.in[I_CCTX]; const float* padaw = a.in[I_ADAW]; const float* padab = a.in[I_ADAB];
      for (int i = C.tid; i < 2048; i += NTHR) { const float x = (i < 1024) ? pc[i] : pcc[i - 1024]; sl[i] = x * sigmoidf_(x); }
      __syncthreads();
      float* mod = (float*)(C.ws + WS_MOD);
      for (int u = C.wg; u < 4 * 96; u += C.G) { const int l = u / 96, jb = u % 96, j0 = jb * 64 + C.lane;
          float s0 = 0.f, s1 = 0.f; const float* w = padaw + (size_t)l * DM * 6144 + j0; const int k0 = C.wave * 128;
#pragma unroll 16
          for (int k = 0; k < 128; ++k) { const float wv = w[(size_t)(k0 + k) * 6144]; s0 += wv * sl[k0 + k]; s1 += wv * sl[1024 + k0 + k]; }
          red[(C.wave * 2 + 0) * 64 + C.lane] = s0; red[(C.wave * 2 + 1) * 64 + C.lane] = s1;
          __syncthreads();
          if (C.tid < 128) { const int v = C.tid >> 6, j = C.tid & 63; float s = 0.f;
#pragma unroll
              for (int wv = 0; wv < 8; ++wv) s += red[(wv * 2 + v) * 64 + j];
              mod[(size_t)(l * 2 + v) * 6144 + jb * 64 + j] = s + padab[(size_t)l * 6144 + jb * 64 + j]; }
          __syncthreads(); } }
}

__device__ __forceinline__ void load_row(const float* p, int lane, f32x4 (&v)[4]) {
#pragma unroll
    for (int j = 0; j < 4; ++j) v[j] = *((const f32x4*)p + lane + 64 * j);
}
__device__ __forceinline__ void moe_combine_row(const Ctx& C, int row, f32x4 (&v)[4], const float* gt2) {
    const int* dest = (const int*)(C.ws + WS_ROUTE) + (size_t)3 * ROWS * 4; const float* gate = (const float*)(C.ws + WS_ROUTE) + (size_t)1 * ROWS * 4;
    const bf16* YB = (const bf16*)(C.ws + WS_XG);
    f32x4 s[4];
#pragma unroll
    for (int j = 0; j < 4; ++j) s[j] = (f32x4){0.f, 0.f, 0.f, 0.f};
#pragma unroll
    for (int k = 0; k < 4; ++k) { const int d = dest[row * 4 + k]; const float g = gate[row * 4 + k]; const u32x2* yp = (const u32x2*)(YB + (size_t)d * DM) + C.lane;
#pragma unroll
        for (int j = 0; j < 4; ++j) { const u32x2 w = yp[64 * j]; s[j] += (f32x4){bflo(w.x), bfhi(w.x), bflo(w.y), bfhi(w.y)} * g; } }
#pragma unroll
    for (int j = 0; j < 4; ++j) v[j] += *((const f32x4*)gt2 + C.lane + 64 * j) * s[j];
}
__device__ __forceinline__ float row_rstd(const f32x4 (&v)[4], int lane) {
    float s = 0.f;
#pragma unroll
    for (int j = 0; j < 4; ++j) s += (v[j].x * v[j].x + v[j].y * v[j].y) + (v[j].z * v[j].z + v[j].w * v[j].w);
    return rsqrtf(wave_sum(s, lane) * (1.f / DM) + 1e-6f);
}
__device__ __forceinline__ void norm1_fetch(const Ctx& C, const float* src_row, int row, bool combine, const float* gt2, f32x4 (&v)[4]) {
    load_row(src_row, C.lane, v);
    if (combine) moe_combine_row(C, row, v, gt2);
}
__device__ __forceinline__ void phase_norm1(const Ctx& C, const DArgs& a, int l) {
    float* XS = (float*)(C.ws + WS_XS); bf16* H = (bf16*)(C.ws + WS_H); const float* mod = (const float*)(C.ws + WS_MOD);
    const float* g1 = a.in[I_N1G] + (size_t)l * DM;
    const float* pctx = a.in[I_CTX]; const float* px = a.in[I_X];
    for (int row0 = C.gw; row0 < ROWS; row0 += 2 * C.NGW) {
        f32x4 v[2][4]; const int rows[2] = {row0, row0 + C.NGW};
#pragma unroll
        for (int q = 0; q < 2; ++q) if (rows[q] < ROWS) { const int row = rows[q]; const bool isctx = row < NCTX;
            const float* src = (l == 0) ? (isctx ? pctx + (size_t)row * DM : px + (size_t)(row - NCTX) * DM) : XS + (size_t)row * DM;
            norm1_fetch(C, src, row, l > 0, mod + (size_t)((l > 0 ? l - 1 : 0) * 2 + (isctx ? 1 : 0)) * 6144 + 5 * DM, v[q]); }
#pragma unroll
        for (int q = 0; q < 2; ++q) if (rows[q] < ROWS) { const int row = rows[q]; const bool isctx = row < NCTX;
#pragma unroll
            for (int j = 0; j < 4; ++j) *((f32x4*)(XS + (size_t)row * DM) + C.lane + 64 * j) = v[q][j];
            const float rstd = row_rstd(v[q], C.lane);
            const float* md = mod + (size_t)(l * 2 + (isctx ? 1 : 0)) * 6144;
            u32x2* o = (u32x2*)(H + (size_t)row * DM) + C.lane;
#pragma unroll
            for (int j = 0; j < 4; ++j) { const f32x4 g = *((const f32x4*)g1 + C.lane + 64 * j), sh = *((const f32x4*)md + C.lane + 64 * j), sc = *((const f32x4*)(md + DM) + C.lane + 64 * j);
                const f32x4 y = v[q][j] * rstd * g * (sc + 1.0f) + sh; u32x2 w; w.x = pk2(y.x, y.y); w.y = pk2(y.z, y.w); o[64 * j] = w; } }
    }
}
__device__ __forceinline__ void phase_final(const Ctx& C, const DArgs& a) {
    const float* XS = (const float*)(C.ws + WS_XS); const float* mod = (const float*)(C.ws + WS_MOD); const float* g = a.in[I_FNG];
    const float* gt2 = mod + (size_t)((DEPTH - 1) * 2 + 0) * 6144 + 5 * DM;
    for (int row0 = NCTX + C.gw; row0 < ROWS; row0 += 2 * C.NGW) {
        f32x4 v[2][4]; const int rows[2] = {row0, row0 + C.NGW};
#pragma unroll
        for (int q = 0; q < 2; ++q) if (rows[q] < ROWS) norm1_fetch(C, XS + (size_t)rows[q] * DM, rows[q], true, gt2, v[q]);
#pragma unroll
        for (int q = 0; q < 2; ++q) if (rows[q] < ROWS) { const float rstd = row_rstd(v[q], C.lane); float* o = a.out + (size_t)(rows[q] - NCTX) * DM;
#pragma unroll
            for (int j = 0; j < 4; ++j) *((f32x4*)o + C.lane + 64 * j) = v[q][j] * rstd * *((const f32x4*)g + C.lane + 64 * j); }
    }
}
constexpr int NR2 = 9;
__device__ __forceinline__ void phase_norm2(const Ctx& C, const DArgs& a, int l) {
    const float* XS = (const float*)(C.ws + WS_XS); bf16* H = (bf16*)(C.ws + WS_H); const float* mod = (const float*)(C.ws + WS_MOD);
    const float* g2 = a.in[I_N2G] + (size_t)l * DM; const float* rb = a.in[I_RB] + (size_t)l * NEXP; const bf16* rwt = (const bf16*)(C.ws + WS_RWT) + (size_t)l * NEXP * DM;
    int* tok_e = (int*)(C.ws + WS_ROUTE); float* gate = (float*)(C.ws + WS_ROUTE) + (size_t)1 * ROWS * 4; int* slot = (int*)(C.ws + WS_ROUTE) + (size_t)2 * ROWS * 4;
    LAS float* lg = (LAS float*)(C.lds + C.wave * 4096);
    LAS int* hist = (LAS int*)(C.lds + MISC_OFF + 64);
    const int lane = C.lane, li = lane & 15, g = lane >> 4;
    if (C.tid < NEXP) hist[C.tid] = 0;
    __syncthreads();
    const int row_base = (l == DEPTH - 1) ? NCTX : 0, ntile = (ROWS - row_base + NR2 - 1) / NR2;
    for (int tl = C.gw; tl < ntile; tl += C.NGW) {
        const int trow0 = row_base + NR2 * tl, nrow = (ROWS - trow0 < NR2) ? ROWS - trow0 : NR2;
#pragma unroll 1
        for (int rr = 0; rr < nrow; ++rr) { const int row = trow0 + rr; const bool isctx = row < NCTX; f32x4 v[4]; load_row(XS + (size_t)row * DM, lane, v);
            const float rstd = row_rstd(v, lane);
            const float* md = mod + (size_t)(l * 2 + (isctx ? 1 : 0)) * 6144 + 3 * DM;
            u32x2* o = (u32x2*)(H + (size_t)row * DM) + lane;
#pragma unroll
            for (int j = 0; j < 4; ++j) { const f32x4 gg = *((const f32x4*)g2 + lane + 64 * j), sh = *((const f32x4*)md + lane + 64 * j), sc = *((const f32x4*)(md + DM) + lane + 64 * j);
                const f32x4 y = v[j] * rstd * gg * (sc + 1.0f) + sh; u32x2 w; w.x = pk2(y.x, y.y); w.y = pk2(y.z, y.w); o[64 * j] = w; } }
        asm volatile("s_waitcnt vmcnt(0)" ::: "memory");
        f32x4 acc0 = {0.f, 0.f, 0.f, 0.f}, acc1 = {0.f, 0.f, 0.f, 0.f};
        const int arow = (trow0 + li < ROWS) ? trow0 + li : ROWS - 1;
        const bf16* ap = H + (size_t)arow * DM + 8 * g; const bf16* bp0 = rwt + (size_t)li * DM + 8 * g; const bf16* bp1 = bp0 + 16 * DM;
#pragma unroll 4
        for (int ks = 0; ks < 32; ++ks) { const bf16x8 af = *(const bf16x8*)(ap + 32 * ks); acc0 = mfma16(af, *(const bf16x8*)(bp0 + 32 * ks), acc0); acc1 = mfma16(af, *(const bf16x8*)(bp1 + 32 * ks), acc1); }
#pragma unroll
        for (int r = 0; r < 4; ++r) { lg[(4 * g + r) * 33 + li] = acc0[r]; lg[(4 * g + r) * 33 + 16 + li] = acc1[r]; }
        LDS_WAIT(); asm volatile("" ::: "memory");
        const int e = lane & 31; const float rbe = rb[e];
#pragma unroll 1
        for (int rr = 0; rr < nrow; ++rr) { const int row = trow0 + rr;
            float val = lg[rr * 33 + e] + rbe; int te[4]; float tv[4];
#pragma unroll
            for (int k = 0; k < 4; ++k) { float bv = val; int bi = e;
#define AMAX_ROR(n) { const float ov = __builtin_bit_cast(float, __builtin_amdgcn_update_dpp(0, __builtin_bit_cast(int, bv), 0x120 + (n), 0xf, 0xf, false)); const int oi = __builtin_amdgcn_update_dpp(0, bi, 0x120 + (n), 0xf, 0xf, false); \
                    if (ov > bv || (ov == bv && oi < bi)) { bv = ov; bi = oi; } }
                AMAX_ROR(8) AMAX_ROR(4) AMAX_ROR(2) AMAX_ROR(1)
#undef AMAX_ROR
                { const float ov = shx(bv, 16, lane); const int oi = shxi(bi, 16, lane); if (ov > bv || (ov == bv && oi < bi)) { bv = ov; bi = oi; } }
                te[k] = bi; tv[k] = bv; if (e == bi) val = -3.0e38f; }
            if (lane == 0) { const float m = tv[0]; float p[4], ps = 0.f;
#pragma unroll
                for (int k = 0; k < 4; ++k) { p[k] = __expf(tv[k] - m); ps += p[k]; }
#pragma unroll
                for (int k = 0; k < 4; ++k) { tok_e[row * 4 + k] = te[k]; gate[row * 4 + k] = p[k] / ps; slot[row * 4 + k] = __hip_atomic_fetch_add(&hist[te[k]], 1, __ATOMIC_RELAXED, __HIP_MEMORY_SCOPE_WORKGROUP); } } }
        asm volatile("" ::: "memory");
    }
    __syncthreads();
    if (C.tid < NEXP) ((int*)(C.ws + WS_CNT))[C.wg * NEXP + C.tid] = hist[C.tid];
}
__device__ __forceinline__ int moe_tables(const Ctx& C) {
    const int* cnt = (const int*)(C.ws + WS_CNT);
    LAS int* part = (LAS int*)(C.lds);
    LAS int* pstart = (LAS int*)(C.lds + MISC_OFF + 256); LAS int* wgbase = pstart + 40; LAS int* tot = wgbase + 32; LAS int* nblk_s = tot + 32;
    LAS unsigned char* blk_e = (LAS unsigned char*)(C.lds + MISC_OFF + 1024);
    __syncthreads();
    { const int e = C.tid & 31, p = C.tid >> 5; int t = 0, pre = 0;
#pragma unroll 1
      for (int w = p * 16; w < p * 16 + 16; ++w) { const int c = cnt[w * NEXP + e]; t += c; if (w < C.wg) pre += c; }
      part[(p * 32 + e) * 2] = t; part[(p * 32 + e) * 2 + 1] = pre; }
    __syncthreads();
    if (C.tid < NEXP) { int t = 0, pre = 0;
#pragma unroll 1
        for (int p = 0; p < 16; ++p) { t += part[(p * 32 + C.tid) * 2]; pre += part[(p * 32 + C.tid) * 2 + 1]; }
        tot[C.tid] = t; wgbase[C.tid] = pre; }
    __syncthreads();
    if (C.tid == 0) { int b = 0;
#pragma unroll 1
        for (int e = 0; e < NEXP; ++e) { pstart[e] = b * 256; b += (tot[e] + 255) >> 8; }
        pstart[NEXP] = b * 256; nblk_s[0] = b; }
    __syncthreads();
    if (C.tid < NEXP) wgbase[C.tid] += pstart[C.tid];
    if (C.tid < MOE_MAXBLK) { int e = 0;
#pragma unroll 1
        for (int k = 1; k < NEXP; ++k) if (pstart[k] <= C.tid * 256) e = k;
        blk_e[C.tid] = (unsigned char)e; }
    __syncthreads();
    return __builtin_amdgcn_readfirstlane(nblk_s[0]);
}
__device__ __forceinline__ void phase_gather(const Ctx& C, const DArgs& a, int l) {
    moe_tables(C);
    const LAS int* wgbase = (const LAS int*)(C.lds + MISC_OFF + 256) + 40;
    const int* tok_e = (const int*)(C.ws + WS_ROUTE); const int* slot = (const int*)(C.ws + WS_ROUTE) + (size_t)2 * ROWS * 4; int* dest = (int*)(C.ws + WS_ROUTE) + (size_t)3 * ROWS * 4;
    const bf16* H = (const bf16*)(C.ws + WS_H); unsigned char* XG = C.ws + WS_XG8;
    const int row_base = (l == DEPTH - 1) ? NCTX : 0, ntile = (ROWS - row_base + NR2 - 1) / NR2;
    for (int tl = C.gw; tl < ntile; tl += C.NGW)
    for (int row = row_base + NR2 * tl; row < row_base + NR2 * tl + NR2 && row < ROWS; ++row) {
        const u32x4* src = (const u32x4*)(H + (size_t)row * DM) + C.lane; const u32x4 v0 = src[0], v1 = src[64];
        u32x2 q0, q1;
        { unsigned w = 0; w = __builtin_amdgcn_cvt_pk_fp8_f32(bflo(v0.x) * pg8::X8_S, bfhi(v0.x) * pg8::X8_S, w, false); w = __builtin_amdgcn_cvt_pk_fp8_f32(bflo(v0.y) * pg8::X8_S, bfhi(v0.y) * pg8::X8_S, w, true); q0.x = w;
          w = 0; w = __builtin_amdgcn_cvt_pk_fp8_f32(bflo(v0.z) * pg8::X8_S, bfhi(v0.z) * pg8::X8_S, w, false); w = __builtin_amdgcn_cvt_pk_fp8_f32(bflo(v0.w) * pg8::X8_S, bfhi(v0.w) * pg8::X8_S, w, true); q0.y = w;
          w = 0; w = __builtin_amdgcn_cvt_pk_fp8_f32(bflo(v1.x) * pg8::X8_S, bfhi(v1.x) * pg8::X8_S, w, false); w = __builtin_amdgcn_cvt_pk_fp8_f32(bflo(v1.y) * pg8::X8_S, bfhi(v1.y) * pg8::X8_S, w, true); q1.x = w;
          w = 0; w = __builtin_amdgcn_cvt_pk_fp8_f32(bflo(v1.z) * pg8::X8_S, bfhi(v1.z) * pg8::X8_S, w, false); w = __builtin_amdgcn_cvt_pk_fp8_f32(bflo(v1.w) * pg8::X8_S, bfhi(v1.w) * pg8::X8_S, w, true); q1.y = w; }
#pragma unroll
        for (int k = 0; k < 4; ++k) { const int d = wgbase[tok_e[row * 4 + k]] + slot[row * 4 + k]; if (C.lane == 0) dest[row * 4 + k] = d;
            u32x2* dp = (u32x2*)(XG + (size_t)d * DM) + C.lane; dp[0] = q0; dp[64] = q1; }
    }
}

__device__ __forceinline__ void mix1_rope(const Ctx& C) {
    bf16* P = (bf16*)(C.ws + WS_P);
    const long total = (long)SEQ * 192;
    for (long i = (long)C.wg * NTHR + C.tid; i < total; i += (long)C.G * NTHR) {
        const int j = (int)(i & 31), hh = (int)((i >> 5) % 6), t = (int)(i / 192);
        const int col = (hh < 4) ? (C_AQ + hh * 64) : (C_AK + (hh - 4) * 64);
        const float pos = (j < 16) ? (float)(t >> 6) : (float)(t & 63);
        const float inv = __powf(10000.0f, -(float)(j & 15) * (1.0f / 16.0f));
        const float ang = pos * inv * 0.31830988618379067f;
        const float cs = cospif(ang), sn = sinpif(ang);
        bf16* p = P + (size_t)(NCTX + t) * INWP + col;
        const float x1 = bf2f(p[j]), x2 = bf2f(p[j + 32]);
        p[j] = (bf16)f2bf(x1 * cs - x2 * sn); p[j + 32] = (bf16)f2bf(x2 * cs + x1 * sn);
    }
}
__device__ __forceinline__ void mix1_vt(const Ctx& C) {
    const bf16* P = (const bf16*)(C.ws + WS_P);
    LAS unsigned short* scr = (LAS unsigned short*)(C.lds + C.wave * 16384);
    for (int u = C.gw; u < (ROWS / 64) * 6; u += C.NGW) {
        const int hd = u % 6, tb = u / 6; const int vcol = (hd < 2) ? (C_AV + hd * 64) : (C_CV + (hd - 2) * 64);
        bf16* VT = ((hd < 2) ? (bf16*)(C.ws + WS_VTA) + (size_t)hd * 64 * VTP : (bf16*)(C.ws + WS_VTC) + (size_t)(hd - 2) * 64 * VTP);
#pragma unroll
        for (int i = 0; i < 8; ++i) { const int tk = (C.lane >> 3) + 8 * i, ch = C.lane & 7; const u32x4 w = *(const u32x4*)(P + (size_t)(tb * 64 + tk) * INWP + vcol + 8 * ch);
            LAS unsigned* d = (LAS unsigned*)(scr + tk * 66 + 8 * ch); d[0] = w.x; d[1] = w.y; d[2] = w.z; d[3] = w.w; }
        LDS_WAIT(); asm volatile("" ::: "memory");
#pragma unroll
        for (int k8 = 0; k8 < 8; ++k8) { unsigned w[4];
#pragma unroll
            for (int e2 = 0; e2 < 4; ++e2) { const unsigned lo = scr[(8 * k8 + 2 * e2) * 66 + C.lane], hi = scr[(8 * k8 + 2 * e2 + 1) * 66 + C.lane]; w[e2] = lo | (hi << 16); }
            *(u32x4*)(VT + (size_t)C.lane * VTP + tb * 64 + 8 * k8) = (u32x4){w[0], w[1], w[2], w[3]}; }
        LDS_WAIT(); asm volatile("" ::: "memory");
    }
    for (int i = C.wg * NTHR + C.tid; i < 6 * 64 * 32; i += C.G * NTHR) { const int rowi = i >> 5, pc = i & 31; const int hd = rowi >> 6, d = rowi & 63;
        bf16* VT = ((hd < 2) ? (bf16*)(C.ws + WS_VTA) + (size_t)hd * 64 * VTP : (bf16*)(C.ws + WS_VTC) + (size_t)(hd - 2) * 64 * VTP);
        *(u32x4*)(VT + (size_t)d * VTP + ROWS + 8 * pc) = (u32x4){0u, 0u, 0u, 0u}; }
}
__device__ __forceinline__ float conv3(const bf16* P, int row, int col, const float* cw, int cc) {
    const bool first = (row == 0) || (row == NCTX), last = (row == NCTX - 1) || (row == ROWS - 1);
    float s = cw[768 + cc] * bf2f(P[(size_t)row * INWP + col]);
    if (!first) s += cw[cc] * bf2f(P[(size_t)(row - 1) * INWP + col]);
    if (!last) s += cw[2 * 768 + cc] * bf2f(P[(size_t)(row + 1) * INWP + col]);
    return s;
}
__device__ __forceinline__ void mix1_rwkv_prep(const Ctx& C, const DArgs& a, int l) {
    const bf16* P = (const bf16*)(C.ws + WS_P); float* SC = (float*)(C.ws + WS_SC);
    constexpr int LBP = 264;
    LAS unsigned char* lob = C.lds;
    LAS float* pre = (LAS float*)(C.lds + 16384);
    const bf16* lorat = (const bf16*)(C.ws + WS_LORAT) + (size_t)l * 4 * 256 * 64;
    const float* cw = a.in[I_DCONV] + (size_t)l * 3 * 768;
    const float* w0 = a.in[I_DW0] + (size_t)l * 512; const float* a0 = a.in[I_DA0] + (size_t)l * 512;
    const float* kkw = a.in[I_DKK] + (size_t)l * 256; const float* kaw = a.in[I_DKA] + (size_t)l * 256;
    const int half = C.tid >> 8, c = C.tid & 255, lane = C.lane, li = lane & 15, g = lane >> 4;
    const float kkc = kkw[c], kac = kaw[c];
    for (int grp = C.wg; grp < ROWS / 13; grp += C.G) {
        const int row0 = 13 * grp + 7 * half, nj = 7 - half;
        __syncthreads();
#pragma unroll
        for (int j = 0; j < 7; ++j) if (j < nj) { const float x = bf2f(P[(size_t)(row0 + j) * INWP + C_WL + c]); *(LAS bf16*)(lob + ((7 * half + j) * LBP + c) * 2) = (bf16)f2bf((c < 128) ? tanhf(x) : x); }
        __syncthreads();
#pragma unroll
        for (int q = 0; q < 4; ++q) { const bf16x8 a0f = ldA(lob, LBP, 0, 64 * q, li, g), a1f = ldA(lob, LBP, 0, 64 * q + 32, li, g);
#pragma unroll
            for (int c2 = 0; c2 < 2; ++c2) { const int ci = 2 * C.wave + c2; const bf16* bp = lorat + ((size_t)q * 256 + 16 * ci + li) * 64 + 8 * g;
                f32x4 acc = {0.f, 0.f, 0.f, 0.f}; acc = mfma16(a0f, ldg8(bp), acc); acc = mfma16(a1f, ldg8(bp + 32), acc);
#pragma unroll
                for (int r = 0; r < 4; ++r) pre[(q * 16 + 4 * g + r) * 256 + 16 * ci + li] = acc[r]; } }
        __syncthreads();
        float xr[9], xk[9], xv[9];
#pragma unroll
        for (int q = 0; q < 9; ++q) { const int rw = row0 - 1 + q; const bool in = (rw >= 0) && (rw < ROWS) && (q <= nj + 1);
            const bf16* pp = P + (size_t)(in ? rw : row0) * INWP; xr[q] = in ? bf2f(pp[C_DR + c]) : 0.f; xk[q] = in ? bf2f(pp[C_DK + c]) : 0.f; xv[q] = in ? bf2f(pp[C_DV + c]) : 0.f; }
        const float cr0 = cw[c], cr1 = cw[768 + c], cr2 = cw[1536 + c], ck0 = cw[256 + c], ck1 = cw[768 + 256 + c], ck2 = cw[1536 + 256 + c], cv0 = cw[512 + c], cv1 = cw[768 + 512 + c], cv2 = cw[1536 + 512 + c];
#pragma unroll
        for (int j = 0; j < 7; ++j) if (j < nj) { const int row = row0 + j, rl = 7 * half + j;
            const bool first = (row == 0) || (row == NCTX), last = (row == NCTX - 1) || (row == ROWS - 1);
            const float m0 = first ? 0.f : 1.f, m2 = last ? 0.f : 1.f;
            const float r = cr1 * xr[j + 1] + m0 * cr0 * xr[j] + m2 * cr2 * xr[j + 2], k = ck1 * xk[j + 1] + m0 * ck0 * xk[j] + m2 * ck2 * xk[j + 2], v = cv1 * xv[j + 1] + m0 * cv0 * xv[j] + m2 * cv2 * xv[j + 2];
            float kk = k * kkc; const float n2 = wave_sum(kk * kk, lane); kk *= rsqrtf(fmaxf(n2, 1e-24f));
            float* sc = SC + (size_t)row * 9 * 256; sc[c] = r; sc[256 + c] = v; sc[512 + c] = -kk;
#pragma unroll
            for (int d = 0; d < 2; ++d) { const float wp = w0[d * 256 + c] + pre[(d * 16 + rl) * 256 + c], ap = a0[d * 256 + c] + pre[((2 + d) * 16 + rl) * 256 + c];
                const float nw = -wp, sp = fmaxf(nw, 0.f) + log1pf(__expf(-fabsf(nw)));
                const float lw = -__expf(-sp - 0.5f);
                const float as = sigmoidf_(ap);
                sc[(3 + 3 * d) * 256 + c] = lw; sc[(4 + 3 * d) * 256 + c] = k * (1.0f + (as - 1.0f) * kac); sc[(5 + 3 * d) * 256 + c] = kk * as; } }
    }
    __syncthreads();
}
constexpr int FP = 136;
constexpr int F_TABC = 0, F_TABS = 128 * FP * 2, F_TILE = 2 * 128 * FP * 2;
__device__ __forceinline__ void fourier_load_tables(const Ctx& C) {
    const bf16* ft = (const bf16*)(C.ws + WS_FTAB);
    for (int i = C.tid; i < 2 * 128 * 16; i += NTHR) { const int tb = i >> 11, r = (i >> 4) & 127, c8 = i & 15;
        *(LAS u32x4*)(C.lds + tb * F_TABS + (r * FP + 8 * c8) * 2) = *(const u32x4*)(ft + tb * 16384 + r * 128 + 8 * c8); }
}
__device__ __forceinline__ void mix1_fourier1(const Ctx& C) {
    const bf16* P = (const bf16*)(C.ws + WS_P); const float* tw = (const float*)(C.ws + WS_TW);
    bf16* FYR = (bf16*)(C.ws + WS_FYR); bf16* FYI = (bf16*)(C.ws + WS_FYI);
    const int lane = C.lane, li = lane & 15, g = lane >> 4, w = C.wave;
    __syncthreads();
    fourier_load_tables(C);
    for (int u = C.wg; u < 256; u += C.G) {
        const int t2 = u >> 1, ch0 = (u & 1) * 128;
        __syncthreads();
        for (int i = C.tid; i < 128 * 16; i += NTHR) { const int t1 = i >> 4, c8 = i & 15;
            *(LAS u32x4*)(C.lds + F_TILE + (t1 * FP + 8 * c8) * 2) = *(const u32x4*)(P + (size_t)(NCTX + 128 * t1 + t2) * INWP + C_BU + ch0 + 8 * c8); }
        __syncthreads();
        bf16x8 af[4];
#pragma unroll
        for (int ks = 0; ks < 4; ++ks) af[ks] = ldT(C.lds + F_TILE, FP, 32 * ks, 16 * w, li, g);
#pragma unroll 1
        for (int ni = 0; ni < 8; ++ni) { f32x4 dc = {0.f, 0.f, 0.f, 0.f}, ds = {0.f, 0.f, 0.f, 0.f};
#pragma unroll
            for (int ks = 0; ks < 4; ++ks) { dc = mfma16(af[ks], ldA(C.lds + F_TABC, FP, 16 * ni, 32 * ks, li, g), dc); ds = mfma16(af[ks], ldA(C.lds + F_TABS, FP, 16 * ni, 32 * ks, li, g), ds); }
            const int k1 = 16 * ni + li; const float cp = tw[t2 * k1], sp = tw[16384 + t2 * k1];
            const f32x4 yr = dc * cp - ds * sp, yi = -(ds * cp) - dc * sp;
            const size_t o = ((size_t)k1 * 128 + t2) * 256 + ch0 + 16 * w + 4 * g;
            u32x2 wr; wr.x = pk2(yr[0], yr[1]); wr.y = pk2(yr[2], yr[3]); *(u32x2*)(FYR + o) = wr;
            u32x2 wi; wi.x = pk2(yi[0], yi[1]); wi.y = pk2(yi[2], yi[3]); *(u32x2*)(FYI + o) = wi; }
    }
    __syncthreads();
}
__device__ __forceinline__ void fourier2_mfma(const Ctx& C, int l, int wg0) {
    const bf16* FYR = (const bf16*)(C.ws + WS_FYR); const bf16* FYI = (const bf16*)(C.ws + WS_FYI); bf16* MIX = (bf16*)(C.ws + WS_MIX);
    const int lane = C.lane, li = lane & 15, g = lane >> 4, w = C.wave;
    constexpr int YP = 72, F_YR = F_TILE, F_YI = F_TILE + 128 * YP * 2;
    __syncthreads();
    fourier_load_tables(C);
    for (int u = C.wg - wg0; u < 512; u += C.G - wg0) {
        const int k1 = u >> 2, gq = u & 3;
        __syncthreads();
        for (int i = C.tid; i < 2 * 128 * 8; i += NTHR) { const int im = i >> 10, t2 = (i >> 3) & 127, c8 = i & 7;
            *(LAS u32x4*)(C.lds + (im ? F_YI : F_YR) + (t2 * YP + 8 * c8) * 2) = *(const u32x4*)((im ? FYI : FYR) + ((size_t)k1 * 128 + t2) * 256 + gq * 64 + 8 * c8); }
        __syncthreads();
        bf16x8 bc[4], bs[4];
#pragma unroll
        for (int ks = 0; ks < 4; ++ks) { bc[ks] = ldA(C.lds + F_TABC, FP, 16 * w, 32 * ks, li, g); bs[ks] = ldA(C.lds + F_TABS, FP, 16 * w, 32 * ks, li, g); }
        f32x4 xr[4], xi[4];
#pragma unroll
        for (int ci = 0; ci < 4; ++ci) { xr[ci] = (f32x4){0.f, 0.f, 0.f, 0.f}; f32x4 xs = {0.f, 0.f, 0.f, 0.f}; xi[ci] = xs;
#pragma unroll
            for (int ks = 0; ks < 4; ++ks) { const bf16x8 ar = ldT(C.lds + F_YR, YP, 32 * ks, 16 * ci, li, g), ai = ldT(C.lds + F_YI, YP, 32 * ks, 16 * ci, li, g);
                xr[ci] = mfma16(ar, bc[ks], xr[ci]); xr[ci] = mfma16(ai, bs[ks], xr[ci]);
                xi[ci] = mfma16(ai, bc[ks], xi[ci]); xs = mfma16(ar, bs[ks], xs); }
            xi[ci] = xi[ci] - xs; }
        union { bf16x8 v; unsigned q[4]; } xb[4];
#pragma unroll
        for (int q2 = 0; q2 < 2; ++q2) { xb[q2].q[0] = pk2(xr[2 * q2][0], xr[2 * q2][1]); xb[q2].q[1] = pk2(xr[2 * q2][2], xr[2 * q2][3]); xb[q2].q[2] = pk2(xr[2 * q2 + 1][0], xr[2 * q2 + 1][1]); xb[q2].q[3] = pk2(xr[2 * q2 + 1][2], xr[2 * q2 + 1][3]);
            xb[2 + q2].q[0] = pk2(xi[2 * q2][0], xi[2 * q2][1]); xb[2 + q2].q[1] = pk2(xi[2 * q2][2], xi[2 * q2][3]); xb[2 + q2].q[2] = pk2(xi[2 * q2 + 1][0], xi[2 * q2 + 1][1]); xb[2 + q2].q[3] = pk2(xi[2 * q2 + 1][2], xi[2 * q2 + 1][3]); }
        const bf16x8* mf = (const bf16x8*)((const bf16*)(C.ws + WS_FTAB) + 32768) + (size_t)(l * 4 + gq) * 16 * 64;
#pragma unroll
        for (int ei = 0; ei < 4; ++ei) { f32x4 o = {0.f, 0.f, 0.f, 0.f};
#pragma unroll
            for (int ks2 = 0; ks2 < 4; ++ks2) o = mfma16(mf[(ei * 4 + ks2) * 64 + lane], xb[ks2].v, o);
            const int tp = k1 + 128 * (16 * w + li);
            u32x2 wo; wo.x = pk2(o[0], o[1]); wo.y = pk2(o[2], o[3]); *(u32x2*)(MIX + (size_t)(NCTX + tp) * DM + 256 + gq * 64 + 16 * ei + 4 * g) = wo; }
    }
    __syncthreads();
}

constexpr float LOG2E = 1.4426950408889634f;
typedef short bf16x4 __attribute__((ext_vector_type(4)));
__device__ __forceinline__ void attn_load(const bf16* P, const bf16* VT, int krow, int kcol, int li, int g, bf16x8 (&kf)[2][2], bf16x8 (&vf)[4]) {
#pragma unroll
    for (int t = 0; t < 2; ++t)
#pragma unroll
        for (int ks = 0; ks < 2; ++ks) kf[t][ks] = ldg8(P + (size_t)(krow + 16 * t + li) * INWP + kcol + 32 * ks + 8 * g);
#pragma unroll
    for (int dt = 0; dt < 4; ++dt) { const bf16* vp = VT + (size_t)(dt * 16 + li) * VTP + krow + 4 * g;
        const bf16x4 a = *(const bf16x4*)vp, b = *(const bf16x4*)(vp + 16); vf[dt] = (bf16x8){a[0], a[1], a[2], a[3], b[0], b[1], b[2], b[3]}; }
}
template <int NS, int NT>
__device__ __forceinline__ void attn_compute(const bf16x8 (&kf)[2][2], const bf16x8 (&vf)[4], const bf16x8 (&qf)[NS][2], f32x4 (&o)[NS][4], float (&m)[NS], float (&ls)[NS],
                                             const float (&add)[NT][2][4], int li, int g) {
#pragma unroll
    for (int hh = 0; hh < NS; ++hh) {
        f32x4 st[2];
#pragma unroll
        for (int t = 0; t < 2; ++t) { st[t] = (f32x4){0.f, 0.f, 0.f, 0.f};
#pragma unroll
            for (int ks = 0; ks < 2; ++ks) st[t] = __builtin_amdgcn_mfma_f32_16x16x32_bf16(kf[t][ks], qf[hh][ks], st[t], 0, 0, 0); }
        float s[8]; float bm = -INFINITY;
#pragma unroll
        for (int t = 0; t < 2; ++t)
#pragma unroll
            for (int r = 0; r < 4; ++r) { const float ad = add[hh / (NS / NT)][t][r]; s[4 * t + r] = (ad == -INFINITY) ? -INFINITY : st[t][r] * (0.125f * LOG2E) + ad; bm = fmaxf(bm, s[4 * t + r]); }
        bm = fmaxf(bm, shx(bm, 16, 16 * g + li)); bm = fmaxf(bm, shx(bm, 32, 16 * g + li));
        const float mn = fmaxf(m[hh], bm), corr = __builtin_amdgcn_exp2f(m[hh] - mn); m[hh] = mn;
        float ps = 0.f; float pe[8];
#pragma unroll
        for (int e = 0; e < 8; ++e) { pe[e] = __builtin_amdgcn_exp2f(s[e] - mn); ps += pe[e]; }
        ls[hh] = ls[hh] * corr + ps;
        union { bf16x8 v; unsigned u[4]; } pf;
#pragma unroll
        for (int e2 = 0; e2 < 4; ++e2) pf.u[e2] = pk2(pe[2 * e2], pe[2 * e2 + 1]);
#pragma unroll
        for (int dt = 0; dt < 4; ++dt) { o[hh][dt] = o[hh][dt] * corr; o[hh][dt] = __builtin_amdgcn_mfma_f32_16x16x32_bf16(vf[dt], pf.v, o[hh][dt], 0, 0, 0); }
    }
}
__device__ __forceinline__ void attn_finish1(bf16* MIX, int qrow0, int ocol, f32x4 (&o)[4], float m, float ls, bool has_sink, float sink2, int li, int g) {
    float l = ls; l += shx(l, 16, 16 * g + li); l += shx(l, 32, 16 * g + li);
    float corr = 1.f;
    if (has_sink) { const float mn = fmaxf(m, sink2); corr = __builtin_amdgcn_exp2f(m - mn); l = l * corr + __builtin_amdgcn_exp2f(sink2 - mn); }
    const float inv = corr / l;
#pragma unroll
    for (int dt = 0; dt < 4; ++dt) { const f32x4 v = o[dt] * inv; u32x2 w; w.x = pk2(v[0], v[1]); w.y = pk2(v[2], v[3]);
        *(u32x2*)(MIX + (size_t)(qrow0 + li) * DM + ocol + dt * 16 + 4 * g) = w; }
}
__device__ __forceinline__ void attnA_unit(const Ctx& C, const float* asink_l, int unit, bool lat) {
    const bf16* P = (const bf16*)(C.ws + WS_P); bf16* MIX = (bf16*)(C.ws + WS_MIX);
    const int li = C.lane & 15, g = C.lane >> 4;
    const int nqp = lat ? SEQ / 32 : NCTX / 32, kvh = unit / nqp, qp = unit % nqp, t0 = qp * 32, qrow0 = (lat ? NCTX : 0) + t0;
    const bf16* VT = (const bf16*)(C.ws + WS_VTA) + (size_t)kvh * 64 * VTP; const int kcol = C_AK + kvh * 64;
    bf16x8 qf[4][2];
#pragma unroll
    for (int s = 0; s < 4; ++s)
#pragma unroll
        for (int ks = 0; ks < 2; ++ks) qf[s][ks] = ldg8(P + (size_t)(qrow0 + 16 * (s >> 1) + li) * INWP + C_AQ + (kvh * 2 + (s & 1)) * 64 + 32 * ks + 8 * g);
    f32x4 o[4][4]; float m[4], ls[4];
#pragma unroll
    for (int s = 0; s < 4; ++s) { m[s] = -1.0e30f; ls[s] = 0.f;
#pragma unroll
        for (int dt = 0; dt < 4; ++dt) o[s][dt] = (f32x4){0.f, 0.f, 0.f, 0.f}; }
    const int b_lo = lat ? 0 : 9;
#pragma unroll 1
    for (int bb = b_lo; bb < 17; ++bb) { float add[2][2][4]; bf16x8 kf[2][2], vf[4];
        const int krow = (bb < 9) ? NCTX + t0 - 128 + 32 * bb : 32 * (bb - 9);
        attn_load(P, VT, krow, kcol, li, g, kf, vf);
#pragma unroll
        for (int tl = 0; tl < 2; ++tl)
#pragma unroll
            for (int tt = 0; tt < 2; ++tt)
#pragma unroll
                for (int r = 0; r < 4; ++r) { const int j = t0 - 128 + 32 * bb + 16 * tt + 4 * g + r, t = t0 + 16 * tl + li;
                    const bool ok = (bb >= 9) || ((j >= 0) && (j < SEQ) && (j - t <= 128) && (t - j <= 128)); add[tl][tt][r] = ok ? 0.f : -INFINITY; }
        attn_compute<4, 2>(kf, vf, qf, o, m, ls, add, li, g); }
#pragma unroll
    for (int s = 0; s < 4; ++s) attn_finish1(MIX, qrow0 + 16 * (s >> 1), (kvh * 2 + (s & 1)) * 64, o[s], m[s], ls[s], true, asink_l[kvh * 2 + (s & 1)] * LOG2E, li, g);
}
__device__ __forceinline__ void attnC_unit(const Ctx& C, const LAS float* relb, int h, int up, bool lat) {
    const bf16* P = (const bf16*)(C.ws + WS_P); bf16* MIX = (bf16*)(C.ws + WS_MIX);
    const int li = C.lane & 15, g = C.lane >> 4;
    const int rp = up >> 2, cj = up & 3;
    const int t0a = lat ? (2 * rp) * 64 + 16 * cj : 32 * up, tstep = lat ? 64 : 16, qbase = lat ? NCTX : 0;
    const bf16* VT = (const bf16*)(C.ws + WS_VTC) + (size_t)h * 64 * VTP; const int kcol = C_CK + h * 64;
    bf16x8 qf[2][2];
#pragma unroll
    for (int s = 0; s < 2; ++s)
#pragma unroll
        for (int ks = 0; ks < 2; ++ks) qf[s][ks] = ldg8(P + (size_t)(qbase + t0a + tstep * s + li) * INWP + C_CQ + h * 64 + 32 * ks + 8 * g);
    f32x4 o[2][4]; float m[2] = {-1.0e30f, -1.0e30f}, ls[2] = {0.f, 0.f};
#pragma unroll
    for (int s = 0; s < 2; ++s)
#pragma unroll
        for (int dt = 0; dt < 4; ++dt) o[s][dt] = (f32x4){0.f, 0.f, 0.f, 0.f};
    const int r = 2 * rp, cq = cj * 16 + li;
    int r0a = r - 4; r0a = r0a < 0 ? 0 : (r0a > 248 ? 248 : r0a); int r0b = r - 3; r0b = r0b < 0 ? 0 : (r0b > 248 ? 248 : r0b);
    int c0 = cq - 8; c0 = c0 < 0 ? 0 : (c0 > 48 ? 48 : c0);
    const int cw0 = (cj == 0) ? 0 : (cj == 1) ? 8 : (cj == 2) ? 24 : 32;
    const int b_lo = lat ? 0 : 9;
#pragma unroll 1
    for (int bb = b_lo; bb < 17; ++bb) { float add[2][2][4]; bf16x8 kf[2][2], vf[4];
        const int kr = r0a + bb;
        if (bb < 9 && kr >= r0b + 8) continue;
        const int krow = (bb < 9) ? NCTX + kr * 64 + cw0 : 32 * (bb - 9);
        attn_load(P, VT, krow, kcol, li, g, kf, vf);
#pragma unroll
        for (int tl = 0; tl < 2; ++tl) { const int r0t = tl ? r0b : r0a, rt = r + tl; const bool rowok = (bb >= 9) || (kr >= r0t && kr < r0t + 8);
            int bi = kr - rt + 7; bi = bi < 0 ? 0 : (bi > 14 ? 14 : bi); const LAS float* rbp = relb + bi * 31;
#pragma unroll
            for (int tt = 0; tt < 2; ++tt)
#pragma unroll
                for (int rr = 0; rr < 4; ++rr) { const int kc = cw0 + 16 * tt + 4 * g + rr; int ci = kc - cq + 15; ci = ci < 0 ? 0 : (ci > 30 ? 30 : ci); const float bv = rbp[ci];
                    add[tl][tt][rr] = (bb >= 9) ? 0.f : ((rowok && kc >= c0 && kc < c0 + 16) ? bv : -INFINITY); } }
        attn_compute<2, 2>(kf, vf, qf, o, m, ls, add, li, g); }
#pragma unroll
    for (int s = 0; s < 2; ++s) attn_finish1(MIX, qbase + t0a + tstep * s, 512 + h * 64, o[s], m[s], ls[s], false, 0.f, li, g);
}
__device__ __forceinline__ void fourier_ctx_mfma(const Ctx& C, int l, int wg0) {
    const bf16* P = (const bf16*)(C.ws + WS_P); bf16* MIX = (bf16*)(C.ws + WS_MIX); const bf16* f2 = (const bf16*)(C.ws + WS_F256);
    const int lane = C.lane, li = lane & 15, g = lane >> 4, w = C.wave;
    constexpr int UP = 72;
    for (int u = C.wg - wg0; u < 8; u += C.G - wg0) {
        const int tb = u >> 2, gq = u & 3;
        __syncthreads();
        for (int i = C.tid; i < 256 * 8; i += NTHR) { const int t = i >> 3, c8 = i & 7; *(LAS u32x4*)(C.lds + (t * UP + 8 * c8) * 2) = *(const u32x4*)(P + (size_t)t * INWP + C_BU + gq * 64 + 8 * c8); }
        __syncthreads();
        const int tp0 = 128 * tb + 16 * w;
        f32x4 xr[4], xi[4];
#pragma unroll
        for (int ci = 0; ci < 4; ++ci) { xr[ci] = (f32x4){0.f, 0.f, 0.f, 0.f}; xi[ci] = (f32x4){0.f, 0.f, 0.f, 0.f}; }
#pragma unroll 2
        for (int ks = 0; ks < 8; ++ks) { const bf16x8 bc = ldg8(f2 + (size_t)(tp0 + li) * 256 + 32 * ks + 8 * g), bs = ldg8(f2 + 65536 + (size_t)(tp0 + li) * 256 + 32 * ks + 8 * g);
#pragma unroll
            for (int ci = 0; ci < 4; ++ci) { const bf16x8 au = ldT(C.lds, UP, 32 * ks, 16 * ci, li, g); xr[ci] = mfma16(au, bc, xr[ci]); xi[ci] = mfma16(au, bs, xi[ci]); } }
        union { bf16x8 v; unsigned q[4]; } xb[4];
#pragma unroll
        for (int q2 = 0; q2 < 2; ++q2) { xb[q2].q[0] = pk2(xr[2 * q2][0], xr[2 * q2][1]); xb[q2].q[1] = pk2(xr[2 * q2][2], xr[2 * q2][3]); xb[q2].q[2] = pk2(xr[2 * q2 + 1][0], xr[2 * q2 + 1][1]); xb[q2].q[3] = pk2(xr[2 * q2 + 1][2], xr[2 * q2 + 1][3]);
            xb[2 + q2].q[0] = pk2(-xi[2 * q2][0], -xi[2 * q2][1]); xb[2 + q2].q[1] = pk2(-xi[2 * q2][2], -xi[2 * q2][3]); xb[2 + q2].q[2] = pk2(-xi[2 * q2 + 1][0], -xi[2 * q2 + 1][1]); xb[2 + q2].q[3] = pk2(-xi[2 * q2 + 1][2], -xi[2 * q2 + 1][3]); }
        const bf16x8* mf = (const bf16x8*)((const bf16*)(C.ws + WS_FTAB) + 32768) + (size_t)(l * 4 + gq) * 16 * 64;
#pragma unroll
        for (int ei = 0; ei < 4; ++ei) { f32x4 o = {0.f, 0.f, 0.f, 0.f};
#pragma unroll
            for (int ks2 = 0; ks2 < 4; ++ks2) o = mfma16(mf[(ei * 4 + ks2) * 64 + lane], xb[ks2].v, o);
            o = o * 8.0f;
            u32x2 wo; wo.x = pk2(o[0], o[1]); wo.y = pk2(o[2], o[3]); *(u32x2*)(MIX + (size_t)(tp0 + li) * DM + 256 + gq * 64 + 16 * ei + 4 * g) = wo; }
    }
    __syncthreads();
}
__device__ __forceinline__ void fourier2_unit(const Ctx& C, int l, int u, bool ctx) {
    const bf16* P = (const bf16*)(C.ws + WS_P); const float* tw = (const float*)(C.ws + WS_TW); bf16* MIX = (bf16*)(C.ws + WS_MIX);
    const float* FYR = (const float*)(C.ws + WS_FYR); const float* FYI = (const float*)(C.ws + WS_FYI);
    const float* mt = (const float*)(C.ws + WS_MTAB) + (size_t)l * 2 * 4 * 4096;
    LAS float* xr = (LAS float*)(C.lds + 8192); LAS float* xi = xr + 512;
    const int tl = C.tid >> 8, ch = C.tid & 255, tp = 2 * u + tl;
    float sr = 0.f, si = 0.f;
    if (!ctx) { const int k1 = tp & 127, k2 = tp >> 7; const float* yr = FYR + (size_t)k1 * 128 * 256 + ch; const float* yi = FYI + (size_t)k1 * 128 * 256 + ch;
#pragma unroll 8
        for (int t2 = 0; t2 < 128; ++t2) { const int m = ((t2 * k2) & 127) * 128; const float c = tw[m], s = tw[16384 + m]; const float a = yr[t2 * 256], b = yi[t2 * 256]; sr += a * c + b * s; si += b * c - a * s; } }
    else {
#pragma unroll 8
        for (int t = 0; t < NCTX; ++t) { const int m = ((t * tp) & 255) * 64; const float x = bf2f(P[(size_t)t * INWP + C_BU + ch]); sr += x * tw[m]; si -= x * tw[16384 + m]; } }
    __syncthreads();
    xr[tl * 256 + ch] = sr; xi[tl * 256 + ch] = si;
    __syncthreads();
    const int g = ch >> 6, e = ch & 63; const float* mc = mt + (size_t)(0 * 4 + g) * 4096 + e; const float* ms = mt + (size_t)(1 * 4 + g) * 4096 + e;
    const LAS float* xrp = xr + tl * 256 + g * 64; const LAS float* xip = xi + tl * 256 + g * 64; float o = 0.f;
#pragma unroll 8
    for (int c = 0; c < 64; ++c) o += xrp[c] * mc[c * 64] + xip[c] * ms[c * 64];
    o *= ctx ? (1.0f / 128.0f) : (1.0f / 1024.0f);
    MIX[(size_t)((ctx ? 0 : NCTX) + tp) * DM + 256 + ch] = (bf16)f2bf(o);
}
__device__ __forceinline__ void rwkv_passB(const Ctx& C, int b);
__device__ __forceinline__ void phase_mix2(const Ctx& C, const DArgs& a, int l) {
    const bool emit_ctx = l < DEPTH - 1;
#ifndef REPMASK
#define REPMASK 0
#endif
#define NREP2(o) ((((REPMASK) >> (o)) & 1) ? 2 : 1)
    if (C.wg < 8) { for (int r2 = 0; r2 < NREP2(16); ++r2) rwkv_passB(C, C.wg); }
    else if (emit_ctx) fourier_ctx_mfma(C, l, 8);
    { const float* asink_l = a.in[I_ASINK] + l * 4; const float* crel = a.in[I_CREL] + (size_t)l * 4 * 465;
      LAS float* relb = (LAS float*)(C.lds + 110592 + C.wave * 2048);
      for (int r2 = 0; r2 < NREP2(17); ++r2) {
      unsigned* qhead = (unsigned*)(C.ws + WS_CTL) + CW_WQ + 64 * l + 16 * r2;
      const int nA = 2 * (SEQ / 32), nC = 4 * (SEQ / 32), nAc = emit_ctx ? 2 * (NCTX / 32) : 0, nCc = emit_ctx ? 4 * (NCTX / 32) : 0, nAll = nA + nAc + nC + nCc;
      int hcur = -1;
      const int nCv = emit_ctx ? CV_NCHUNK : 0;
      for (;;) { unsigned uq = 0; if (C.lane == 0) uq = __hip_atomic_fetch_add(qhead, 1u, __ATOMIC_RELAXED, __HIP_MEMORY_SCOPE_AGENT);
          const int uraw = __builtin_amdgcn_readfirstlane((int)uq); if (uraw >= nAll + nCv) break;
          int u;
          if (uraw < 2 * nCv) { if (uraw & 1) { const int ch = uraw >> 1; convert_moe_items(C, a, l + 1, ch * CV_CHUNK, ch * CV_CHUNK + CV_CHUNK); continue; } u = uraw >> 1; }
          else u = uraw - nCv;
          if (u < nA) attnA_unit(C, asink_l, u, true);
          else if (u < nA + nAc) attnA_unit(C, asink_l, u - nA, false);
          else { const int uc = u - nA - nAc; const bool lat = uc < nC; const int uu = lat ? uc : uc - nC, nqt = lat ? SEQ / 32 : NCTX / 32, h = uu / nqt, qt = uu % nqt;
              if (h != hcur) { for (int i = C.lane; i < 465; i += 64) relb[i] = crel[h * 465 + i] * LOG2E; hcur = h; LDS_WAIT(); asm volatile("" ::: "memory"); }
              attnC_unit(C, relb, h, qt, lat); } } } }
    __syncthreads();
    for (int r2 = 0; r2 < NREP2(19); ++r2) fourier2_mfma(C, l, 0);
}

constexpr int RW_C = 32, RW_NCH = ROWS / RW_C, RW_SC = 20, RW_NSC = RW_NCH / RW_SC;
constexpr int RW_SLOT = 5120, RW_REGION = 9 * RW_SLOT + 1024;
constexpr int TP = 72, HP = 40;
static_assert(3 * RW_REGION <= MISC_OFF, "RWKV D1 regions below the misc area");
__device__ __forceinline__ int rw_rc_of(int d, int c) { return d == 0 ? c : (c < 8 ? 7 - c : 527 - c); }
__device__ __forceinline__ int rw_row_of(int d, int rc, int t) { return 32 * rc + (d == 0 ? t : 31 - t); }

__device__ __forceinline__ void rwkv_d1(const Ctx& C, LAS unsigned char* rb, int d, int h, int rc) {
    int lane_ = C.lane; asm volatile("" : "+v"(lane_));
    const int lane = lane_, li = lane & 15, g = lane >> 4;
    const float* SC = (const float*)(C.ws + WS_SC);
    LAS unsigned char* S0 = rb; LAS unsigned char* S1 = rb + RW_SLOT; LAS unsigned char* S2 = rb + 2 * RW_SLOT; LAS unsigned char* S3 = rb + 3 * RW_SLOT; LAS unsigned char* S4 = rb + 4 * RW_SLOT;
    LAS unsigned char* S5 = rb + 5 * RW_SLOT; LAS unsigned char* S6 = rb + 6 * RW_SLOT; LAS unsigned char* S7 = rb + 7 * RW_SLOT; LAS unsigned char* S8 = rb + 8 * RW_SLOT;
    LAS unsigned char* S6b = S6 + 2560; LAS unsigned char* S7b = S7 + 2560;
    LAS float* gc = (LAS float*)(rb + 9 * RW_SLOT);
    { float cum = 0.f; const int j = lane; const int qw = (3 + 3 * d) * 256;
      float rv[2][4], vv[2][4], av[2][4], lw[2][4], kd[2][4], bb[2][4];
#define RW_LD(buf, t0) do { _Pragma("unroll") for (int u = 0; u < 4; ++u) { const float* sc = SC + (size_t)rw_row_of(d, rc, (t0) + u) * 9 * 256 + h * 64 + j; \
          rv[buf][u] = sc[0]; vv[buf][u] = sc[256]; av[buf][u] = sc[512]; lw[buf][u] = sc[qw]; kd[buf][u] = sc[qw + 256]; bb[buf][u] = sc[qw + 512]; } } while (0)
#define RW_CP(buf, t0) do { _Pragma("unroll") for (int u = 0; u < 4; ++u) { const float cp = cum; cum += lw[buf][u]; const float Gt = __expf(cum), Gm = __expf(cp), iG = __expf(-cum); const int off = (((t0) + u) * TP + j) * 2; \
          *(LAS bf16*)(S0 + off) = (bf16)f2bf(av[buf][u] * Gm); *(LAS bf16*)(S1 + off) = (bf16)f2bf(rv[buf][u] * Gt); *(LAS bf16*)(S2 + off) = (bf16)f2bf(bb[buf][u] * iG); \
          *(LAS bf16*)(S3 + off) = (bf16)f2bf(kd[buf][u] * iG); *(LAS bf16*)(S4 + off) = (bf16)f2bf(vv[buf][u]); } } while (0)
      RW_LD(0, 0);
#pragma unroll
      for (int b2 = 0; b2 < 4; ++b2) { RW_LD(1, 8 * b2 + 4); __builtin_amdgcn_sched_barrier(0); RW_CP(0, 8 * b2); if (b2 < 3) RW_LD(0, 8 * b2 + 8); __builtin_amdgcn_sched_barrier(0); RW_CP(1, 8 * b2 + 4); }
#undef RW_LD
#undef RW_CP
      gc[j] = __expf(cum); }
    const f32x4 z4 = {0.f, 0.f, 0.f, 0.f};
#pragma unroll 1
    for (int ti = 0; ti < 2; ++ti)
#pragma unroll 1
        for (int si = 0; si < 2; ++si) {
            f32x4 n = z4, nt = z4, mk = z4, qb = z4, qk = z4;
#pragma unroll
            for (int ks = 0; ks < 2; ++ks) { const bf16x8 at = ldA(S0, TP, 16 * ti, 32 * ks, li, g), rt = ldA(S1, TP, 16 * ti, 32 * ks, li, g), bs = ldA(S2, TP, 16 * si, 32 * ks, li, g), kss = ldA(S3, TP, 16 * si, 32 * ks, li, g);
                n = mfma16(at, bs, n);
                nt = mfma16(bs, at, nt);
                mk = mfma16(kss, at, mk);
                qb = mfma16(bs, rt, qb);
                qk = mfma16(kss, rt, qk); }
#pragma unroll
            for (int r = 0; r < 4; ++r) { const int trow = 16 * ti + 4 * g + r, scol = 16 * si + li; if (!(scol < trow)) n[r] = 0.f;
                const int srow = 16 * si + 4 * g + r, tcol = 16 * ti + li; if (!(srow < tcol)) { mk[r] = 0.f; nt[r] = 0.f; } if (!(srow <= tcol)) { qb[r] = 0.f; qk[r] = 0.f; } }
            *(LAS f32x4*)(S5 + ((16 * si + li) * 32 + 16 * ti + 4 * g) * 4) = n;
            stT(S6, HP, 16 * ti + li, 16 * si + 4 * g, mk);
            stT(S8, HP, 16 * ti + li, 16 * si + 4 * g, nt);
            stT(S6b, HP, 16 * ti + li, 16 * si + 4 * g, qb);
            stT(S7, HP, 16 * ti + li, 16 * si + 4 * g, qk); }
    { const int rr = lane & 31, bq = rr >> 4, lr = rr & 15; float Tr[16];
#pragma unroll
      for (int s = 15; s >= 0; --s) { float acc = (lr == s) ? 1.f : 0.f;
#pragma unroll
          for (int c4 = 0; c4 < 4; ++c4) { if (4 * c4 + 3 > s) { const f32x4 nv = *(const LAS f32x4*)(S5 + ((16 * bq + s) * 32 + 16 * bq + 4 * c4) * 4);
#pragma unroll
              for (int e = 0; e < 4; ++e) if (4 * c4 + e > s) acc += Tr[4 * c4 + e] * nv[e]; } }
          Tr[s] = acc; }
      if (lane < 32) { u32x4 w0, w1; w0.x = pk2(Tr[0], Tr[1]); w0.y = pk2(Tr[2], Tr[3]); w0.z = pk2(Tr[4], Tr[5]); w0.w = pk2(Tr[6], Tr[7]); w1.x = pk2(Tr[8], Tr[9]); w1.y = pk2(Tr[10], Tr[11]); w1.z = pk2(Tr[12], Tr[13]); w1.w = pk2(Tr[14], Tr[15]);
          const u32x4 zz = {0u, 0u, 0u, 0u}; LAS u32x4* trow = (LAS u32x4*)(S7b + rr * HP * 2);
          trow[0] = bq ? zz : w0; trow[1] = bq ? zz : w1; trow[2] = bq ? w0 : zz; trow[3] = bq ? w1 : zz; }
      f32x4 x = mfma16(ldA(S8, HP, 16, 0, li, g), ldT(S7b, HP, 0, 0, li, g), z4);
      LAS unsigned char* XT = S8 + 2560;
      *(LAS u32x2*)(XT + (li * HP + 4 * g) * 2) = (u32x2){0u, 0u}; stT(XT, HP, li, 16 + 4 * g, x);
      const f32x4 t21 = mfma16(ldA(S7b, HP, 16, 0, li, g), ldA(XT, HP, 0, 0, li, g), z4);
#pragma unroll
      for (int r = 0; r < 4; ++r) *(LAS bf16*)(S7b + ((16 + 4 * g + r) * HP + li) * 2) = (bf16)f2bf(t21[r]); }
#pragma unroll 1
    for (int ti = 0; ti < 2; ++ti) { const bf16x8 tf = ldA(S7b, HP, 16 * ti, 0, li, g), mf = ldA(S6, HP, 16 * ti, 0, li, g);
#pragma unroll
        for (int ji = 0; ji < 4; ++ji) { const f32x4 ap = mfma16(tf, ldT(S0, TP, 0, 16 * ji, li, g), z4); stT(S8, HP, 16 * ji + li, 16 * ti + 4 * g, ap);
            const f32x4 mv = mfma16(mf, ldT(S4, TP, 0, 16 * ji, li, g), z4); stT(S5, HP, 16 * ji + li, 16 * ti + 4 * g, mv); } }
#pragma unroll 1
    for (int ti = 0; ti < 2; ++ti) { const bf16x8 tf = ldA(S7b, HP, 16 * ti, 0, li, g);
#pragma unroll
        for (int vi = 0; vi < 4; ++vi) { const f32x4 ul = mfma16(tf, ldA(S5, HP, 16 * vi, 0, li, g), z4); stT(S0, HP, 16 * vi + li, 16 * ti + 4 * g, ul); } }
#pragma unroll 1
    for (int ti = 0; ti < 2; ++ti) { const bf16x8 qbf = ldA(S6b, HP, 16 * ti, 0, li, g), qkf = ldA(S7, HP, 16 * ti, 0, li, g);
#pragma unroll
        for (int ji = 0; ji < 4; ++ji) { f32x4 rp = mfma16(ldA(S8, HP, 16 * ji, 0, li, g), qbf, z4);
            LAS unsigned char* p = S1 + ((16 * ti + li) * TP + 16 * ji + 4 * g) * 2; rp = rp + ld4bf(p); u32x2 w; w.x = pk2(rp[0], rp[1]); w.y = pk2(rp[2], rp[3]); *(LAS u32x2*)p = w;
            f32x4 yl = mfma16(qbf, ldA(S0, HP, 16 * ji, 0, li, g), z4); yl = mfma16(qkf, ldT(S4, TP, 0, 16 * ji, li, g), yl);
            stT(S5, HP, 16 * ji + li, 16 * ti + 4 * g, yl); } }
#pragma unroll 1
    for (int ji = 0; ji < 4; ++ji) { const bf16x8 bt = ldT(S2, TP, 0, 16 * ji, li, g); const float gj = gc[16 * ji + li];
#pragma unroll
        for (int jp = 0; jp < 4; ++jp) { f32x4 pt = mfma16(ldA(S8, HP, 16 * jp, 0, li, g), bt, z4);
#pragma unroll
            for (int r = 0; r < 4; ++r) pt[r] = pt[r] * gj + ((16 * jp + 4 * g + r == 16 * ji + li) ? gj : 0.f);
            stT(S6, TP, 16 * ji + li, 16 * jp + 4 * g, pt); } }
#pragma unroll 1
    for (int vh = 0; vh < 2; ++vh) { f32x4 lt[4][2];
#pragma unroll
      for (int ji = 0; ji < 4; ++ji) { const bf16x8 ba = ldT(S2, TP, 0, 16 * ji, li, g), ka = ldT(S3, TP, 0, 16 * ji, li, g); const f32x4 gv = *(const LAS f32x4*)(gc + 16 * ji + 4 * g);
#pragma unroll
          for (int v2 = 0; v2 < 2; ++v2) { const int vi = 2 * vh + v2; f32x4 x = mfma16(ba, ldA(S0, HP, 16 * vi, 0, li, g), z4); x = mfma16(ka, ldT(S4, TP, 0, 16 * vi, li, g), x); lt[ji][v2] = x * gv; } }
      asm volatile("s_waitcnt lgkmcnt(0)" ::: "memory");
      LAS unsigned char* dst = vh ? S2 : S8;
#pragma unroll
      for (int ji = 0; ji < 4; ++ji)
#pragma unroll
          for (int v2 = 0; v2 < 2; ++v2) stT(dst, TP, 16 * v2 + li, 16 * ji + 4 * g, lt[ji][v2]); }
}
__device__ __forceinline__ void rwkv_passA_step(const Ctx& C, const LAS unsigned char* rb, f32x4 (&hs)[4], int d, int h, int rc) {
    int lane_ = C.lane; asm volatile("" : "+v"(lane_));
    const int lane = lane_, li = lane & 15, g = lane >> 4; const bool isPhi = C.wave >= 4; const int col = 16 * (C.wave & 3) + li;
    const LAS unsigned char* S1 = rb + RW_SLOT; const LAS unsigned char* S2 = rb + 2 * RW_SLOT; const LAS unsigned char* S5 = rb + 5 * RW_SLOT; const LAS unsigned char* S6 = rb + 6 * RW_SLOT;
    const LAS unsigned char* LTb = (col < 32) ? rb + 8 * RW_SLOT + col * TP * 2 : S2 + (col - 32) * TP * 2;
    union { bf16x8 v; unsigned u[4]; } bf[2];
#pragma unroll
    for (int ks = 0; ks < 2; ++ks) { bf[ks].u[0] = pk2(hs[2 * ks][0], hs[2 * ks][1]); bf[ks].u[1] = pk2(hs[2 * ks][2], hs[2 * ks][3]); bf[ks].u[2] = pk2(hs[2 * ks + 1][0], hs[2 * ks + 1][1]); bf[ks].u[3] = pk2(hs[2 * ks + 1][2], hs[2 * ks + 1][3]); }
#pragma unroll
    for (int ti = 0; ti < 2; ++ti) { f32x4 acc = isPhi ? (f32x4){0.f, 0.f, 0.f, 0.f} : ld4bf(S5 + (col * HP + 16 * ti + 4 * g) * 2);
#pragma unroll
        for (int ks = 0; ks < 2; ++ks) acc = mfma16(ldAperm(S1, TP, 16 * ti, ks, li, g), bf[ks].v, acc);
        if (!isPhi) { float* ys = (float*)(C.ws + WS_YS) + (size_t)d * ROWS * 256 + h * 64 + col;
#pragma unroll
            for (int r = 0; r < 4; ++r) ys[(size_t)rw_row_of(d, rc, 16 * ti + 4 * g + r) * 256] = acc[r]; }
        else { bf16* rp = (bf16*)(C.ws + WS_RPP) + ((size_t)((d * 4 + h) * RW_NCH + rc) * 32) * 64 + col;
#pragma unroll
            for (int r = 0; r < 4; ++r) rp[(16 * ti + 4 * g + r) * 64] = (bf16)f2bf(acc[r]); } }
    f32x4 hn[4];
#pragma unroll
    for (int i = 0; i < 4; ++i) { f32x4 acc = isPhi ? (f32x4){0.f, 0.f, 0.f, 0.f} : ld4bf(LTb + (16 * i + 4 * g) * 2);
#pragma unroll
        for (int ks = 0; ks < 2; ++ks) acc = mfma16(ldAperm(S6, TP, 16 * i, ks, li, g), bf[ks].v, acc);
        hn[i] = acc; }
#pragma unroll
    for (int i = 0; i < 4; ++i) hs[i] = hn[i];
}
__device__ __forceinline__ void phase_rwkv1(const Ctx& C) {
    const int lane = C.lane, li = lane & 15, g = lane >> 4;
    for (int u = C.wg; u < 8 * RW_NSC; u += C.G) {
        const int s = u % RW_NSC, dh = u / RW_NSC, d = dh >> 2, h = dh & 3; const bool isPhi = C.wave >= 4; const int col = 16 * (C.wave & 3) + li;
        f32x4 hs[4];
#pragma unroll
        for (int i = 0; i < 4; ++i)
#pragma unroll
            for (int r = 0; r < 4; ++r) hs[i][r] = (isPhi && (16 * i + 4 * g + r == col)) ? 1.f : 0.f;
#pragma unroll 1
        for (int rnd = 0; rnd < (RW_SC + 2) / 3; ++rnd) {
            __syncthreads();
            { int wv = C.wave; asm volatile("" : "+s"(wv)); if (wv < 3 && 3 * rnd + wv < RW_SC) rwkv_d1(C, C.lds + wv * RW_REGION, d, h, rw_rc_of(d, s * RW_SC + 3 * rnd + wv)); }
            __syncthreads();
#pragma unroll 1
            for (int k = 0; k < 3; ++k) { const int ci = 3 * rnd + k; int ko = k * RW_REGION; asm volatile("" : "+s"(ko)); if (ci < RW_SC) rwkv_passA_step(C, C.lds + ko, hs, d, h, rw_rc_of(d, s * RW_SC + ci)); }
        }
        if (isPhi) { bf16* pf = (bf16*)(C.ws + WS_PSC) + (size_t)(dh * RW_NSC + s) * 4096;
            const int ks = col >> 5, eh = (col >> 4) & 1, gp = (col >> 2) & 3, el = col & 3;
#pragma unroll
            for (int i = 0; i < 4; ++i)
#pragma unroll
                for (int r = 0; r < 4; ++r) pf[((i * 2 + ks) * 64 + gp * 16 + 4 * g + r) * 8 + eh * 4 + el] = (bf16)f2bf(hs[i][r]); }
        else { f32x4* lf = (f32x4*)(C.ws + WS_LSC) + ((size_t)(dh * RW_NSC + s) * 4 + C.wave) * 4 * 64;
#pragma unroll
            for (int i = 0; i < 4; ++i) lf[i * 64 + lane] = hs[i]; }
    }
    __syncthreads();
}
__device__ __forceinline__ void rwkv_passB(const Ctx& C, int b) {
    if (C.wave >= 4) return;
    const int lane = C.lane, li = lane & 15, g = lane >> 4, q = C.wave;
    f32x4 hs[4];
#pragma unroll
    for (int i = 0; i < 4; ++i) hs[i] = (f32x4){0.f, 0.f, 0.f, 0.f};
    const bf16x8* pfb = (const bf16x8*)((const bf16*)(C.ws + WS_PSC) + (size_t)b * RW_NSC * 4096);
    const f32x4* lfb = (const f32x4*)(C.ws + WS_LSC) + ((size_t)b * RW_NSC * 4 + q) * 4 * 64;
    bf16x8 pa[8]; f32x4 la[4];
#pragma unroll
    for (int k = 0; k < 8; ++k) pa[k] = pfb[k * 64 + lane];
#pragma unroll
    for (int i = 0; i < 4; ++i) la[i] = lfb[i * 64 + lane];
#pragma unroll 1
    for (int s = 0; s < RW_NSC; ++s) {
        bf16* hp = (bf16*)(C.ws + WS_HSC) + ((size_t)(b * RW_NSC + s) * 64 + 16 * q + li) * 64;
#pragma unroll
        for (int i = 0; i < 4; ++i) { u32x2 w; w.x = pk2(hs[i][0], hs[i][1]); w.y = pk2(hs[i][2], hs[i][3]); *(u32x2*)(hp + 16 * i + 4 * g) = w; }
        bf16x8 pn[8]; f32x4 ln[4]; const int sn = (s + 1 < RW_NSC) ? s + 1 : s;
#pragma unroll
        for (int k = 0; k < 8; ++k) pn[k] = pfb[(size_t)sn * 512 + k * 64 + lane];
#pragma unroll
        for (int i = 0; i < 4; ++i) ln[i] = lfb[(size_t)sn * 4 * 4 * 64 + i * 64 + lane];
        union { bf16x8 v; unsigned u[4]; } bf[2];
#pragma unroll
        for (int ks = 0; ks < 2; ++ks) { bf[ks].u[0] = pk2(hs[2 * ks][0], hs[2 * ks][1]); bf[ks].u[1] = pk2(hs[2 * ks][2], hs[2 * ks][3]); bf[ks].u[2] = pk2(hs[2 * ks + 1][0], hs[2 * ks + 1][1]); bf[ks].u[3] = pk2(hs[2 * ks + 1][2], hs[2 * ks + 1][3]); }
#pragma unroll
        for (int i = 0; i < 4; ++i) { f32x4 acc = la[i];
#pragma unroll
            for (int ks = 0; ks < 2; ++ks) acc = mfma16(pa[i * 2 + ks], bf[ks].v, acc);
            hs[i] = acc; }
#pragma unroll
        for (int k = 0; k < 8; ++k) pa[k] = pn[k];
#pragma unroll
        for (int i = 0; i < 4; ++i) la[i] = ln[i];
    }
}
__device__ __forceinline__ void phase_mix3(const Ctx& C, const DArgs& a, int l) {
    const bf16* P = (const bf16*)(C.ws + WS_P); const float* SC = (const float*)(C.ws + WS_SC); const float* YS = (const float*)(C.ws + WS_YS); bf16* MIX = (bf16*)(C.ws + WS_MIX);
    LAS float* yt = (LAS float*)(C.lds);
    constexpr int GSP = 168;
    LAS unsigned char* gsig = C.lds + 32768;
    LAS float* gm = (LAS float*)(C.lds + 40960);
    const bf16* g2t = (const bf16*)(C.ws + WS_G2T) + (size_t)l * 256 * 160;
    const float* rk = a.in[I_DRK] + (size_t)l * 256; const float* lnw = a.in[I_DLNW] + (size_t)l * 256; const float* lnb = a.in[I_DLNB] + (size_t)l * 256;
    const int lane = C.lane, li = lane & 15, g = lane >> 4, h = C.wave & 3, d = C.wave >> 2;
    const int half = C.tid >> 8, c = C.tid & 255;
    const int u_lo = (l == DEPTH - 1) ? NCTX / 16 : 0;
    for (int u = u_lo + C.wg; u < ROWS / 16; u += C.G) {
        const int rc = u >> 1, th = u & 1, rowb = 16 * u;
        __syncthreads();
        for (int i = C.tid; i < 16 * 160; i += NTHR) { const int t = i / 160, ii = i % 160; *(LAS bf16*)(gsig + (t * GSP + ii) * 2) = (bf16)f2bf(sigmoidf_(bf2f(P[(size_t)(rowb + t) * INWP + C_GL + ii]))); }
        {
          const int ct = (d == 0) ? rc : (rc < 8 ? 7 - rc : 527 - rc), s = ct / RW_SC, ti = (d == 0) ? th : 1 - th;
          const bf16* rp = (const bf16*)(C.ws + WS_RPP) + (size_t)((d * 4 + h) * RW_NCH + rc) * 32 * 64;
          const bf16* hp = (const bf16*)(C.ws + WS_HSC) + (size_t)((d * 4 + h) * RW_NSC + s) * 64 * 64;
          bf16x8 af[2];
#pragma unroll
          for (int ks = 0; ks < 2; ++ks) af[ks] = ldg8(rp + (16 * ti + li) * 64 + 32 * ks + 8 * g);
#pragma unroll
          for (int vi = 0; vi < 4; ++vi) { f32x4 acc = {0.f, 0.f, 0.f, 0.f};
#pragma unroll
              for (int ks = 0; ks < 2; ++ks) acc = mfma16(af[ks], ldg8(hp + (16 * vi + li) * 64 + 32 * ks + 8 * g), acc);
#pragma unroll
              for (int r = 0; r < 4; ++r) { const int t = 16 * ti + 4 * g + r, rl = ((d == 0) ? t : 31 - t) - 16 * th;
                  yt[(d * 16 + rl) * 256 + h * 64 + 16 * vi + li] = acc[r] + YS[((size_t)d * ROWS + rowb + rl) * 256 + h * 64 + 16 * vi + li]; } } }
        __syncthreads();
#pragma unroll
        for (int c2 = 0; c2 < 2; ++c2) { const int ci = 2 * C.wave + c2; f32x4 a0 = {0.f, 0.f, 0.f, 0.f};
#pragma unroll
            for (int ks = 0; ks < 5; ++ks) a0 = mfma16(ldA(gsig, GSP, 0, 32 * ks, li, g), ldg8(g2t + (size_t)(16 * ci + li) * 160 + 32 * ks + 8 * g), a0);
#pragma unroll
            for (int r = 0; r < 4; ++r) gm[(4 * g + r) * 256 + 16 * ci + li] = a0[r]; }
        __syncthreads();
#pragma unroll 1
        for (int it = 0; it < 8; ++it) { const int rl = 2 * it + half, row = rowb + rl;
            const float* sc = SC + (size_t)row * 9 * 256;
            const float y = yt[rl * 256 + c] + yt[(16 + rl) * 256 + c];
            const float mu = wave_sum(y, lane) * (1.f / 64.f), dy = y - mu, var = wave_sum(dy * dy, lane) * (1.f / 64.f);
            const float yn = dy * rsqrtf(var + 64e-5f) * lnw[c] + lnb[c];
            const float r = sc[c], v = sc[256 + c];
            const float coef = wave_sum(r * (sc[4 * 256 + c] + sc[7 * 256 + c]) * rk[c], lane);
            MIX[(size_t)row * DM + 768 + c] = (bf16)f2bf((yn + coef * v) * gm[rl * 256 + c]); }
    }
    __syncthreads();
}
__device__ __forceinline__ void outproj_ctx(const Ctx& C, int l, const float* gate) {
    const bf16* A = (const bf16*)(C.ws + WS_MIX); const bf16* B = (const bf16*)(C.ws + WS_WOUT) + (size_t)l * DM * DM; float* XS = (float*)(C.ws + WS_XS);
    const int lane = C.lane, li = lane & 15, g = lane >> 4;
    for (int u = C.gw; u < (NCTX / 16) * (DM / 16); u += C.NGW) { const int rt = u >> 6, ct = u & 63;
        const bf16* ap = A + (size_t)(16 * rt + li) * DM + 8 * g; const bf16* bp = B + (size_t)(16 * ct + li) * DM + 8 * g;
        f32x4 acc0 = {0.f, 0.f, 0.f, 0.f}, acc1 = {0.f, 0.f, 0.f, 0.f};
#pragma unroll 4
        for (int ks = 0; ks < 32; ks += 2) { acc0 = mfma16(ldg8(ap + 32 * ks), ldg8(bp + 32 * ks), acc0); acc1 = mfma16(ldg8(ap + 32 * ks + 32), ldg8(bp + 32 * ks + 32), acc1); }
        const float gv = gate[16 * ct + li];
#pragma unroll
        for (int r = 0; r < 4; ++r) { float* p = XS + (size_t)(16 * rt + 4 * g + r) * DM + 16 * ct + li; *p = *p + gv * (acc0[r] + acc1[r]); } }
}

#ifndef MK_SINGLE
#define MK_SINGLE 1
#endif
template <int ONLYP> __global__ void __launch_bounds__(NTHR, 2) mega(Args a) {
    extern __shared__ __attribute__((aligned(16))) unsigned char lds_raw[];
    Ctx C;
#define MKCTX() do { int t_ = threadIdx.x; asm volatile("" : "+v"(t_)); unsigned char* w_ = a.ws; asm volatile("" : "+s"(w_)); unsigned l_ = 0u; asm volatile("" : "+s"(l_)); \
        C.lds = (LAS unsigned char*)lds_raw + l_; C.tid = t_; C.lane = t_ & 63; C.wave = __builtin_amdgcn_readfirstlane(t_ >> 6); \
        C.wg = blockIdx.x; C.G = gridDim.x; C.gw = C.wg * NWAVES + C.wave; C.NGW = C.G * NWAVES; C.ws = w_; } while (0)
    MKCTX();
    if (C.tid == 0) {
#pragma unroll
        for (int i = 0; i < 31; ++i) ((LAS unsigned long long*)(C.lds + MISC_OFF + 2048))[i] = (unsigned long long)a.in[i]; }
    DArgs da; da.in.tab = (const LAS unsigned*)(C.lds + MISC_OFF + 2048); da.out = a.out;
    if (C.tid < 4) ((LAS unsigned*)(C.lds + MISC_OFF))[C.tid] = 0u;
    __syncthreads();
    XcdBarrier bar; bar.bar = (unsigned*)(C.ws + WS_CTL) + CW_BAR; bar.x = 0; bar.st = (volatile LAS unsigned*)(C.lds + MISC_OFF);
    if (a.use_bar) bar = xcd_barrier_post((unsigned*)(C.ws + WS_CTL) + CW_BAR, (volatile LAS unsigned*)(C.lds + MISC_OFF));
#ifndef PHMASK
#define PHMASK 0x1fff
#endif
#define INP(o, k) ((ONLYP < 0 || ONLYP == (o)) && ((PHMASK >> ((o) == 99 ? 12 : (o))) & 1) && a.ph_lo <= (k) && (k) < a.ph_hi)
#ifndef REPMASK
#define REPMASK 0
#endif
#define NREP(o) ((((REPMASK) >> ((o) == 99 ? 12 : (o))) & 1) ? 2 : 1)
#define IN(k) (a.ph_lo <= (k) && (k) < a.ph_hi)
#define SEAM(k) do { if (a.use_bar && IN(k) && IN((k) + 1)) { xcd_barrier(bar); if ((REPMASK >> 20) & 1) xcd_barrier(bar); } } while (0)
    if (INP(0, 0)) for (int rep = 0; rep < NREP(0); ++rep) { MKCTX(); phase_prologue(C, da); }
    SEAM(0);
    for (int l = 0; l < DEPTH; ++l) {
        const int b = 1 + l * NPL;
        const float* mod_lat = (const float*)(C.ws + WS_MOD) + (size_t)(l * 2 + 0) * 6144; const float* mod_ctx = mod_lat + 6144;
        if (INP(1, b + 0)) { MKCTX(); phase_norm1(C, da, l); }
        SEAM(b + 0);
        if (INP(2, b + 1)) for (int rep = 0; rep < NREP(2); ++rep) { MKCTX();
            pg8::StaticOrder S; S.init(WS_H, WS_WIN + (size_t)l * INWP * DM * 2, ROWS, INWP, DM, C.G, C.wg);
            pg8::EpiStoreBf16 E{(bf16*)(C.ws + WS_P), INWP, nullptr, 0, 1.0f, 1.0f};
            pg8::gemm_phase<pg8::EpiStoreBf16, pg8::StaticOrder, true, true>(C.lds, C.tid, DM, S, E, C.ws);
        }
        SEAM(b + 1);
        if (INP(3, b + 2)) { MKCTX(); for (int rep = 0; rep < NREP(3); ++rep) { mix1_rwkv_prep(C, da, l); mix1_fourier1(C); } }
        SEAM(b + 2);
        if (INP(11, b + 3)) for (int rep = 0; rep < NREP(11); ++rep) { MKCTX(); phase_rwkv1(C);
            if (C.wg >= 8 * RW_NSC) {
                Ctx C2 = C; C2.wg = C.wg - 8 * RW_NSC; C2.G = C.G - 8 * RW_NSC; C2.gw = C2.wg * NWAVES + C.wave; C2.NGW = C2.G * NWAVES;
                mix1_rope(C2); mix1_vt(C2); } }
        SEAM(b + 3);
        if (INP(4, b + 4)) for (int rep = 0; rep < NREP(4); ++rep) { MKCTX(); phase_mix2(C, da, l); }
        SEAM(b + 4);
        if (INP(5, b + 5)) for (int rep = 0; rep < NREP(5); ++rep) { MKCTX(); phase_mix3(C, da, l); }
        SEAM(b + 5);
        if (INP(6, b + 6)) { MKCTX();
            if (l < DEPTH - 1) outproj_ctx(C, l, mod_ctx + 2 * DM);
            pg8::StaticOrder S; S.init(WS_MIX + (size_t)NCTX * DM * 2, WS_WOUT + (size_t)l * DM * DM * 2, SEQ, DM, DM, C.G, C.wg);
            pg8::EpiResidual E{(float*)(C.ws + WS_XS) + (size_t)NCTX * DM, DM, mod_lat + 2 * DM, mod_lat + 2 * DM};
            pg8::gemm_phase<pg8::EpiResidual, pg8::StaticOrder, true, true>(C.lds, C.tid, DM, S, E, C.ws);
        }
        SEAM(b + 6);
        if (INP(7, b + 7)) for (int rep = 0; rep < NREP(7); ++rep) { MKCTX(); phase_norm2(C, da, l); }
        SEAM(b + 7);
        if (INP(8, b + 8)) for (int rep = 0; rep < NREP(8); ++rep) { MKCTX(); phase_gather(C, da, l); }
        SEAM(b + 8);
        if (INP(9, b + 9)) for (int rep = 0; rep < NREP(9); ++rep) { MKCTX();
            const int nblk = moe_tables(C);
            pg8::MoeOrder S{(unsigned)WS_XG8, (unsigned)(WS_WGU + (size_t)l * 32 * 2048 * DM), 256u * DM, 2048u * DM,
                            (const LAS unsigned char*)(C.lds + MISC_OFF + 1024), nblk, 8, C.G, C.wg};
            pg8::EpiSwiglu E{(bf16*)(C.ws + WS_ACT8), DM, da.in[I_BGU] + (size_t)l * 32 * 2048, 2048, pg8::X8_S * pg8::W8_S, 1.0f / (pg8::X8_S * pg8::W8_S)};
            pg8::gemm_phase<pg8::EpiSwiglu, pg8::MoeOrder, true, true, 1>(C.lds, C.tid, DM, S, E, C.ws);
        }
        SEAM(b + 9);
        if (INP(10, b + 10)) for (int rep = 0; rep < NREP(10); ++rep) { MKCTX();
            const int nblk = moe_tables(C);
            pg8::MoeOrder S{(unsigned)WS_ACT8, (unsigned)(WS_WDN + (size_t)l * 32 * DM * DM), 256u * DM, (unsigned)(DM * DM),
                            (const LAS unsigned char*)(C.lds + MISC_OFF + 1024), nblk, 4, C.G, C.wg};
            pg8::EpiStoreBf16 E{(bf16*)(C.ws + WS_XG), DM, da.in[I_BDN] + (size_t)l * 32 * DM, DM, pg8::ACT_S * pg8::W8_S, 1.0f / (pg8::ACT_S * pg8::W8_S)};
            pg8::gemm_phase<pg8::EpiStoreBf16, pg8::MoeOrder, true, true, 1>(C.lds, C.tid, DM, S, E, C.ws);
        }
        SEAM(b + 10);
    }
    if (INP(99, PH_TOTAL - 1)) for (int rep = 0; rep < NREP(99); ++rep) { MKCTX(); phase_final(C, da); }
#undef IN
#undef INP
#undef SEAM
}

typedef void (*kern_t)(Args);
static kern_t kern_of(int o) {
#if MK_SINGLE
    (void)o; return mega<-1>;
#else
    switch (o) { case 0: return mega<0>; case 1: return mega<1>; case 2: return mega<2>; case 3: return mega<3>; case 4: return mega<4>; case 5: return mega<5>; case 6: return mega<6>;
                 case 7: return mega<7>; case 8: return mega<8>; case 9: return mega<9>; case 10: return mega<10>; case 11: return mega<11>; case 99: return mega<99>;
                 default: return mega<0>;
    }
#endif
}
extern "C" void kernel_launch(void* const* d_in, const int* in_sizes, int n_in, void* d_out, int out_size, void* d_ws, size_t ws_size, hipStream_t stream) {
    static int ready = 0;
    if (ready == 0) {
        if (n_in != 31 || out_size != SEQ * DM || ws_size < WS_END) { fprintf(stderr, "kernel_launch: unexpected shapes (n_in %d, out %d, ws %zu)\n", n_in, out_size, ws_size); ready = -1; return; }
        const int ids[14] = {0, 1, 2, 3, 4, 5, 6, 7, 8, 9, 10, 11, 99, -1};
        for (int i = 0; i < (MK_SINGLE ? 14 : 13); ++i) { if (MK_SINGLE && ids[i] != -1) continue;
            if (hipFuncSetAttribute((const void*)kern_of(ids[i]), hipFuncAttributeMaxDynamicSharedMemorySize, LDS_BYTES) != hipSuccess) { fprintf(stderr, "kernel_launch: hipFuncSetAttribute failed (%d)\n", ids[i]); ready = -1; return; } }
        ready = 1;
    }
    if (ready < 0) return;
    (void)hipMemsetAsync((char*)d_ws + WS_CTL, 0, CTL_ZERO_BYTES, stream);
    Args a{};
    for (int i = 0; i < 31; ++i) a.in[i] = (const float*)d_in[i];
    a.out = (float*)d_out; a.ws = (unsigned char*)d_ws; a.pad = 0;
#if MK_SINGLE
    a.ph_lo = 0; a.ph_hi = PH_TOTAL; a.use_bar = 1;
    hipLaunchKernelGGL(kern_of(-1), dim3(NWG), dim3(NTHR), LDS_BYTES, stream, a);
#else
    for (int p = 0; p < PH_TOTAL; ++p) { a.ph_lo = p; a.ph_hi = p + 1; a.use_bar = 0;
        const int j = (p - 1) % NPL; const int o = (p == 0) ? 0 : (p == PH_TOTAL - 1) ? 99 : (j < 3 ? 1 + j : j == 3 ? 11 : j);
        hipLaunchKernelGGL(kern_of(o), dim3(NWG), dim3(NTHR), LDS_BYTES, stream, a); }
#endif
}
```

```cpp
#include <hip/hip_runtime.h>
#include <cstdio>
#include <cstdint>

#define LAS __attribute__((address_space(3)))
typedef unsigned short bf16;
typedef float f32x4 __attribute__((ext_vector_type(4)));
typedef float f32x2 __attribute__((ext_vector_type(2)));
typedef short bf16x8 __attribute__((ext_vector_type(8)));
typedef unsigned u32x4 __attribute__((ext_vector_type(4)));
typedef unsigned u32x2 __attribute__((ext_vector_type(2)));

constexpr int DM = 1024, SEQ = 16384, NCTX = 256, ROWS = SEQ + NCTX, DEPTH = 4, GRIDW = 64;
constexpr int INW = 2720, INWP = 2816;
constexpr int C_AQ = 0, C_AK = 256, C_AV = 384, C_BU = 512, C_CQ = 768, C_CK = 1024, C_CV = 1280, C_DR = 1536, C_DK = 1792, C_DV = 2048, C_WL = 2304, C_AL = 2432, C_GL = 2560;
constexpr int NEXP = 32, TOPK = 4;
constexpr int MOE_MAXBLK = 296;
constexpr int MOE_ROWS = MOE_MAXBLK * 256;
constexpr int NWG = 256, NTHR = 512, NWAVES = 8;
constexpr int VTP = ROWS + 256;

constexpr size_t MiB = 1u << 20;
constexpr size_t WS_CTL = 0, CTL_ZERO_BYTES = 1 * MiB;
constexpr size_t WS_MOD = 1 * MiB;
constexpr size_t WS_TW = 2 * MiB;
constexpr size_t WS_MTAB = 3 * MiB;
constexpr size_t WS_XS = 4 * MiB;
constexpr size_t WS_H = 70 * MiB;
constexpr size_t WS_P = 104 * MiB;
constexpr size_t WS_MIX = 194 * MiB;
constexpr size_t WS_FYR = 228 * MiB, WS_FYI = 244 * MiB;
constexpr size_t WS_VTA = 1544 * MiB, WS_VTC = 1550 * MiB;
constexpr size_t WS_SC = 260 * MiB;
constexpr size_t WS_YS = 408 * MiB;
constexpr size_t WS_ROUTE = 442 * MiB;
constexpr size_t WS_CNT = 444 * MiB;
constexpr size_t WS_XG = 446 * MiB;
constexpr size_t WS_ACT = 596 * MiB;
constexpr size_t WS_XG8 = WS_ACT, WS_ACT8 = WS_ACT + 75 * MiB;
constexpr size_t WS_WIN = 746 * MiB;
constexpr size_t WS_WOUT = 768 * MiB;
constexpr size_t WS_WGU = 776 * MiB;
constexpr size_t WS_WDN = 1288 * MiB;
constexpr size_t WS_RPP = 1560 * MiB, WS_PSC = 1578 * MiB, WS_LSC = 1580 * MiB, WS_HSC = 1584 * MiB;
constexpr size_t WS_FTAB = 1586 * MiB;
constexpr size_t WS_G2T = 1588 * MiB, WS_RWT = 1589 * MiB;
constexpr size_t WS_LORAT = 1590 * MiB;
constexpr size_t WS_F256 = 1591 * MiB;

constexpr size_t WS_END = 1592 * MiB;
static_assert(WS_XS + (size_t)ROWS * DM * 4 <= WS_H && WS_H + (size_t)ROWS * DM * 2 <= WS_P && WS_P + (size_t)ROWS * INWP * 2 <= WS_MIX && WS_MIX + (size_t)ROWS * DM * 2 <= WS_FYR, "ws map 1");
static_assert(WS_SC + (size_t)ROWS * 9 * 256 * 4 <= WS_YS && WS_YS + (size_t)2 * ROWS * 256 * 4 <= WS_ROUTE && WS_XG + (size_t)MOE_ROWS * DM * 2 <= WS_ACT && WS_ACT + (size_t)MOE_ROWS * DM * 2 <= WS_WIN, "ws map 2");
static_assert(WS_WIN + (size_t)4 * INWP * DM * 2 <= WS_WOUT && WS_WGU + (size_t)4 * 32 * 2048 * 1024 * 2 <= WS_WDN && WS_WDN + (size_t)4 * 32 * 1024 * 1024 * 2 <= WS_END, "ws map 3");
constexpr int CW_BAR = 4096;
constexpr int CW_WQ = 16384;

constexpr int RING_BYTES = 131072;
constexpr int MISC_OFF = 143360;
constexpr int LDS_BYTES = 147456;

__device__ __forceinline__ unsigned f2bf(float f) { unsigned u = __builtin_bit_cast(unsigned, f); return (u + 0x7fffu + ((u >> 16) & 1u)) >> 16; }
__device__ __forceinline__ unsigned pk2(float lo, float hi) { return f2bf(lo) | (f2bf(hi) << 16); }
__device__ __forceinline__ float bf2f(unsigned short b) { return __builtin_bit_cast(float, (unsigned)b << 16); }
__device__ __forceinline__ float bflo(unsigned w) { return __builtin_bit_cast(float, w << 16); }
__device__ __forceinline__ float bfhi(unsigned w) { return __builtin_bit_cast(float, w & 0xffff0000u); }
__device__ __forceinline__ float shx(float v, int o, int lane) { return __builtin_bit_cast(float, __builtin_amdgcn_ds_bpermute((lane ^ o) << 2, __builtin_bit_cast(int, v))); }
__device__ __forceinline__ int shxi(int v, int o, int lane) { return __builtin_amdgcn_ds_bpermute((lane ^ o) << 2, v); }
__device__ __forceinline__ float dpp_ror(float v, int ctrl_unused);
#define DPP_ROR_ADD(v, n) v += __builtin_bit_cast(float, __builtin_amdgcn_update_dpp(0, __builtin_bit_cast(int, v), 0x120 + (n), 0xf, 0xf, false))
__device__ __forceinline__ float wave_sum(float v, int lane) {
    DPP_ROR_ADD(v, 8); DPP_ROR_ADD(v, 4); DPP_ROR_ADD(v, 2); DPP_ROR_ADD(v, 1);
    v += shx(v, 16, lane); v += shx(v, 32, lane);
    return v;
}
__device__ __forceinline__ float sigmoidf_(float x) { return 1.f / (1.f + __expf(-x)); }
#define LDS_WAIT() asm volatile("s_waitcnt lgkmcnt(0)" ::: "memory")
#define VM_WAIT() asm volatile("s_waitcnt vmcnt(0)" ::: "memory")

namespace pg8 {
#define PG8_LAS __attribute__((address_space(3)))
typedef unsigned short bf16_t;
constexpr int BM = 256, BK = 64, HALF = 128, HTB = HALF * BK * 2, STAGE_BYTES = 8 * HTB, NXCD = 8, WGM = 8;
__host__ __device__ __forceinline__ int lds_byte(int r, int c) { const int st = (r >> 4) * 2 + (c >> 5), rr = r & 15, cc = c & 31, ob = rr * 64 + cc * 2; return st * 1024 + (ob ^ (((ob >> 9) & 1) << 5)); }
__host__ __device__ __forceinline__ void stage_rc(int b, int& R, int& C) { const int st = b / 1024, sb = b % 1024, swz = sb ^ (((sb >> 9) & 1) << 5); R = (st >> 1) * 16 + swz / 64; C = (st & 1) * 32 + (swz % 64) / 2; }
__host__ __device__ __forceinline__ int perm32(int rho) { const int n = rho >> 4, i = rho & 15; return 8 * (i >> 2) + 4 * n + (i & 3); }
struct Unit { int pm, pn, e; };
typedef int v8i __attribute__((ext_vector_type(8))); typedef int v4i __attribute__((ext_vector_type(4)));
__device__ __forceinline__ v8i cat8(bf16x8 a, bf16x8 b) { const v4i x = __builtin_bit_cast(v4i, a), y = __builtin_bit_cast(v4i, b); return __builtin_shufflevector(x, y, 0, 1, 2, 3, 4, 5, 6, 7); }
__device__ __forceinline__ unsigned cvt_pk_bf16(float lo, float hi) { unsigned r; asm volatile("v_cvt_pk_bf16_f32 %0, %1, %2" : "=v"(r) : "v"(lo), "v"(hi)); return r; }

struct StaticOrder {
    unsigned A, Bt, tstep;
    int nM, nN, nwg, G, c;
    __device__ void init(size_t A_, size_t Bt_, int M, int N, int K, int G_, int c_) { A = (unsigned)A_; Bt = (unsigned)Bt_; tstep = (unsigned)(BM * K * 2); nM = M / BM; nN = N / BM; nwg = nM * nN; G = G_; c = c_; }
    __device__ bool next(int i, Unit& u) const {
        const long L = (long)i * G + c; if (L >= nwg) return false;
        int wgid = (int)L; { const int q = nwg / NXCD, r = nwg % NXCD, xcd = wgid % NXCD, off = wgid / NXCD; wgid = (xcd < r ? xcd * (q + 1) : r * (q + 1) + (xcd - r) * q) + off; }
        const int nig = WGM * nN, gid = wgid / nig, fm = gid * WGM, gsz = (nM - fm) < WGM ? (nM - fm) : WGM;
        u.pm = fm + ((wgid % nig) % gsz); u.pn = (wgid % nig) / gsz; u.e = 0; return true;
    }
    __device__ __forceinline__ unsigned pa(const Unit& u) const { return A + (unsigned)u.pm * tstep; }
    __device__ __forceinline__ unsigned pb(const Unit& u) const { return Bt + (unsigned)u.pn * tstep; }
};
struct MoeOrder {
    unsigned A, Bt, tstep, estep;
    const LAS unsigned char* blk_e; int nblk, nN, G, c;
    __device__ bool next(int i, Unit& u) const {
        const int L = i * G + c; if (L >= nblk * nN) return false;
        u.pm = L / nN; u.pn = L % nN; u.e = __builtin_amdgcn_readfirstlane((int)blk_e[u.pm]); return true;
    }
    __device__ __forceinline__ unsigned pa(const Unit& u) const { return A + (unsigned)u.pm * tstep; }
    __device__ __forceinline__ unsigned pb(const Unit& u) const { return Bt + (unsigned)u.e * estep + (unsigned)u.pn * tstep; }
};

struct EpiStoreBf16 {
    static constexpr bool PERM = true;
    bf16_t* O; int ldc; const float* bias; int bias_estride; float bias_scale, acc_scale;
    __device__ __forceinline__ void init(f32x4 (&acc)[2][2][4][2], const Unit& u, int wc, int fq) const {
        const int col0 = u.pn * BM + wc * 32 + 8 * fq;
#pragma unroll
        for (int b = 0; b < 2; ++b)
#pragma unroll
            for (int n = 0; n < 2; ++n) { const f32x4 bv = bias ? *(const f32x4*)(bias + (size_t)u.e * bias_estride + col0 + b * HALF + 4 * n) * bias_scale : (f32x4){0.f, 0.f, 0.f, 0.f};
#pragma unroll
                for (int a = 0; a < 2; ++a)
#pragma unroll
                    for (int m = 0; m < 4; ++m) { f32x4 t = bv; asm volatile("" : "+v"(t)); acc[a][b][m][n] = t; } }
    }
    __device__ __forceinline__ void operator()(const f32x4 (&acc)[2][2][4][2], const Unit& u, int wr, int wc, int fr, int fq) const {
        const int row0 = u.pm * BM + wr * 64 + fr, col0 = u.pn * BM + wc * 32 + 8 * fq;
#pragma unroll
        for (int ai = 0; ai < 2; ++ai)
#pragma unroll
            for (int m = 0; m < 4; ++m) { bf16_t* rowp = O + (size_t)(row0 + ai * HALF + m * 16) * ldc + col0;
#pragma unroll
                for (int bj = 0; bj < 2; ++bj) { const f32x4 v0 = acc[ai][bj][m][0] * acc_scale, v1 = acc[ai][bj][m][1] * acc_scale;
                    u32x4 w; w.x = cvt_pk_bf16(v0[0], v0[1]); w.y = cvt_pk_bf16(v0[2], v0[3]); w.z = cvt_pk_bf16(v1[0], v1[1]); w.w = cvt_pk_bf16(v1[2], v1[3]);
                    *(u32x4*)(rowp + bj * HALF) = w; }
                asm volatile("" ::: "memory"); }
    }
};
__device__ __forceinline__ float swiglu1(float g, float up) {
    g = fminf(g, 7.0f); up = fminf(fmaxf(up, -7.0f), 7.0f);
    return g * (1.f / (1.f + __expf(-1.702f * g))) * (up + 1.0f);
}
constexpr float X8_S = 8.0f, W8_S = 256.0f, ACT_S = 4.0f;
struct EpiSwiglu {
    static constexpr bool PERM = true;
    bf16_t* O; int ldc; const float* bias; int bias_estride; float bias_scale, acc_scale;
    __device__ __forceinline__ void init(f32x4 (&acc)[2][2][4][2], const Unit& u, int wc, int fq) const {
        const int col0 = u.pn * BM + wc * 32 + 8 * fq;
#pragma unroll
        for (int b = 0; b < 2; ++b)
#pragma unroll
            for (int n = 0; n < 2; ++n) { const f32x4 bv = bias ? *(const f32x4*)(bias + (size_t)u.e * bias_estride + col0 + b * HALF + 4 * n) * bias_scale : (f32x4){0.f, 0.f, 0.f, 0.f};
#pragma unroll
                for (int a = 0; a < 2; ++a)
#pragma unroll
                    for (int m = 0; m < 4; ++m) { f32x4 t = bv; asm volatile("" : "+v"(t)); acc[a][b][m][n] = t; } }
    }
    __device__ __forceinline__ void operator()(const f32x4 (&acc)[2][2][4][2], const Unit& u, int wr, int wc, int fr, int fq) const {
        const int row0 = u.pm * BM + wr * 64 + fr, col0 = u.pn * BM + wc * 32 + 8 * fq;
#pragma unroll
        for (int ai = 0; ai < 2; ++ai)
#pragma unroll
            for (int m = 0; m < 4; ++m) { unsigned char* rowp = (unsigned char*)O + (size_t)(row0 + ai * HALF + m * 16) * ldc + (col0 >> 1);
#pragma unroll
                for (int bj = 0; bj < 2; ++bj) { const f32x4 v0 = acc[ai][bj][m][0] * acc_scale, v1 = acc[ai][bj][m][1] * acc_scale;
                    unsigned w = 0; w = __builtin_amdgcn_cvt_pk_fp8_f32(swiglu1(v0[0], v0[1]) * ACT_S, swiglu1(v0[2], v0[3]) * ACT_S, w, false); w = __builtin_amdgcn_cvt_pk_fp8_f32(swiglu1(v1[0], v1[1]) * ACT_S, swiglu1(v1[2], v1[3]) * ACT_S, w, true);
                    *(unsigned*)(rowp + bj * (HALF / 2)) = w; }
                asm volatile("" ::: "memory"); }
    }
};
struct EpiResidual {
    static constexpr bool PERM = false;
    float* X; int ldc; const float* gate_lat; const float* gate_ctx;
    __device__ __forceinline__ void init(f32x4 (&acc)[2][2][4][2], const Unit& u, int wc, int fq) const {
#pragma unroll
        for (int a = 0; a < 2; ++a)
#pragma unroll
            for (int b = 0; b < 2; ++b)
#pragma unroll
                for (int m = 0; m < 4; ++m)
#pragma unroll
                    for (int n = 0; n < 2; ++n) acc[a][b][m][n] = (f32x4){0.f, 0.f, 0.f, 0.f};
    }
    __device__ __forceinline__ void operator()(const f32x4 (&acc)[2][2][4][2], const Unit& u, int wr, int wc, int fr, int fq) const {
        const int row0 = u.pm * BM + wr * 64 + fr, col0 = u.pn * BM + wc * 32 + 4 * fq;
        const float* gp = (u.pm == 0) ? gate_ctx : gate_lat;
        f32x4 gv[2][2];
#pragma unroll
        for (int bj = 0; bj < 2; ++bj)
#pragma unroll
            for (int n = 0; n < 2; ++n) gv[bj][n] = *(const f32x4*)(gp + col0 + bj * HALF + n * 16);
#pragma unroll
        for (int ai = 0; ai < 2; ++ai)
#pragma unroll
            for (int m = 0; m < 4; ++m) { float* rowp = X + (size_t)(row0 + ai * HALF + m * 16) * ldc + col0;
#pragma unroll
                for (int bj = 0; bj < 2; ++bj)
#pragma unroll
                    for (int n = 0; n < 2; ++n) { f32x4* p = (f32x4*)(rowp + bj * HALF + n * 16); *p = *p + gv[bj][n] * acc[ai][bj][m][n]; }
                asm volatile("" ::: "memory"); }
    }
};
template <class Epi, class Sched, bool ALIGN_EPI = false, bool SP2 = false, int ES = 2>
__device__ __forceinline__ void gemm_phase(PG8_LAS unsigned char* lds, const int tid, const int K, const Sched& S, const Epi& E, const void* wsbase) {
    const __amdgpu_buffer_rsrc_t rsrc = __builtin_amdgcn_make_buffer_rsrc((void*)wsbase, 0, 0x7fffffff, 0x00020000);
    const int wid = __builtin_amdgcn_readfirstlane(tid >> 6), lane = tid & 63, wr = wid >> 2, wc = wid & 3, fr = lane & 15, fq = lane >> 4;
    const int nt = (K * ES) / 128;
    unsigned voffA[2], voffB[2];
#pragma unroll
    for (int i = 0; i < 2; ++i) { int R, C; stage_rc(tid * 16 + i * 8192, R, C); const int Rb = Epi::PERM ? ((R & ~31) + perm32(R & 31)) : R;
        voffA[i] = (unsigned)(R * K * ES + C * 2); voffB[i] = (unsigned)(Rb * K * ES + C * 2); }
    const unsigned kstep = (unsigned)(BK * 2);
    const unsigned hstep = (unsigned)(HALF * K * ES);
        const unsigned ldsw = (unsigned)wid * 1024u;
    const int aoff = lds_byte(wr * 64 + fr, ES == 2 ? fq * 8 : fq * 16), boff = lds_byte(wc * 32 + fr, ES == 2 ? fq * 8 : fq * 16); constexpr int KOFF = (ES == 2) ? 1024 : 16;
#define PG8_SA(b, h) (((b) * 2 + (h)) * HTB)
#define PG8_SB(b, h) ((4 + (b) * 2 + (h)) * HTB)
#define PG8_STAGE(bufoff, gbase, voff) do { _Pragma("unroll") for (int _i = 0; _i < 2; ++_i) \
        __builtin_amdgcn_raw_ptr_buffer_load_lds(rsrc, (PG8_LAS unsigned*)(lds + (bufoff) + ldsw + _i * 8192), 16, (voff)[_i], (gbase), 0, 0); } while (0)
#define PG8_LDA(dst, b, h) do { _Pragma("unroll") for (int m = 0; m < 4; ++m) _Pragma("unroll") for (int k = 0; k < 2; ++k) dst[m][k] = *(const PG8_LAS bf16x8*)(lds + PG8_SA(b, h) + aoff + m * 2048 + k * KOFF); } while (0)
#define PG8_LDA8(dst, b, h) do { _Pragma("unroll") for (int m = 0; m < 4; ++m) { const PG8_LAS v4i* p_ = (const PG8_LAS v4i*)(lds + PG8_SA(b, h) + aoff + m * 2048); const v4i x_ = p_[0], y_ = p_[1]; dst[m] = __builtin_shufflevector(x_, y_, 0, 1, 2, 3, 4, 5, 6, 7); } } while (0)
#define PG8_LDB(dst, b, h) do { _Pragma("unroll") for (int n = 0; n < 2; ++n) _Pragma("unroll") for (int k = 0; k < 2; ++k) dst[n][k] = *(const PG8_LAS bf16x8*)(lds + PG8_SB(b, h) + boff + n * 2048 + k * KOFF); } while (0)
#define PG8_LDB8(dst, b, h) do { _Pragma("unroll") for (int n = 0; n < 2; ++n) { const PG8_LAS v4i* p_ = (const PG8_LAS v4i*)(lds + PG8_SB(b, h) + boff + n * 2048); const v4i x_ = p_[0], y_ = p_[1]; dst[n] = __builtin_shufflevector(x_, y_, 0, 1, 2, 3, 4, 5, 6, 7); } } while (0)
#define PG8_MMA(ai, bj, At, Bt) do { __builtin_amdgcn_s_setprio(1); _Pragma("unroll") for (int m = 0; m < 4; ++m) _Pragma("unroll") for (int n = 0; n < 2; ++n) { \
        if constexpr (ES == 2) { _Pragma("unroll") for (int k = 0; k < 2; ++k) acc[ai][bj][m][n] = __builtin_amdgcn_mfma_f32_16x16x32_bf16(Bt[n][k], At[m][k], acc[ai][bj][m][n], 0, 0, 0); } \
        else asm volatile("v_mfma_f32_16x16x128_f8f6f4 %0, %1, %2, %0" : "+v"(acc[ai][bj][m][n]) : "v"(Bt##8[n]), "v"(At##8[m])); } \
        __builtin_amdgcn_s_setprio(0); } while (0)
#define PG8_LDAX(b, h) do { if constexpr (ES == 2) PG8_LDA(At, b, h); else PG8_LDA8(At8, b, h); } while (0)
#define PG8_LDBX(B, b, h) do { if constexpr (ES == 2) PG8_LDB(B, b, h); else PG8_LDB8(B##8, b, h); } while (0)
#define PG8_WAIT_V(n) asm volatile("s_waitcnt vmcnt(" #n ")" ::: "memory")
#define PG8_WAIT_L(n) asm volatile("s_waitcnt lgkmcnt(" #n ")" ::: "memory")
#define PG8_BAR __builtin_amdgcn_s_barrier()
#define PG8_SCHED __builtin_amdgcn_sched_barrier(0)
    Unit cur, nxt; int ui = 0;
    if (!S.next(0, cur)) return;
    f32x4 acc[2][2][4][2];
    E.init(acc, cur, wc, fq);
    bf16x8 At[4][2], B0[2][2], B1[2][2]; v8i At8[4], B08[2], B18[2];
    unsigned cA = S.pa(cur), cB = S.pb(cur);
    if constexpr (SP2) {
        PG8_STAGE(PG8_SB(0, 0), cB, voffB); PG8_STAGE(PG8_SB(0, 1), cB + hstep, voffB); PG8_STAGE(PG8_SA(0, 0), cA, voffA); PG8_STAGE(PG8_SA(0, 1), cA + hstep, voffA);
        if (wr == 1) PG8_BAR;
        PG8_WAIT_V(2); PG8_BAR;
        PG8_STAGE(PG8_SB(1, 0), cB + kstep, voffB); PG8_STAGE(PG8_SA(1, 0), cA + kstep, voffA); PG8_STAGE(PG8_SB(1, 1), cB + hstep + kstep, voffB);
        PG8_WAIT_V(6); PG8_BAR;
    } else {
        PG8_STAGE(PG8_SB(0, 0), cB, voffB); PG8_STAGE(PG8_SA(0, 0), cA, voffA); PG8_STAGE(PG8_SB(0, 1), cB + hstep, voffB); PG8_STAGE(PG8_SA(0, 1), cA + hstep, voffA);
        if (wr == 1) PG8_BAR;
        PG8_WAIT_V(4); PG8_BAR;
        PG8_STAGE(PG8_SB(1, 0), cB + kstep, voffB); PG8_STAGE(PG8_SA(1, 0), cA + kstep, voffA); PG8_STAGE(PG8_SB(1, 1), cB + hstep + kstep, voffB);
        PG8_WAIT_V(6); PG8_BAR;
    }
    for (;;) {
        const bool has_next = S.next(ui + 1, nxt);
        const unsigned nA = has_next ? S.pa(nxt) : cA, nB = has_next ? S.pb(nxt) : cB;
        for (int t = 0; t < nt; t += 2) {
            const bool last = (t == nt - 2);
            const unsigned a1 = cA + (unsigned)(t + 1) * kstep;
            const unsigned a2 = last ? nA : cA + (unsigned)(t + 2) * kstep, b2 = last ? nB : cB + (unsigned)(t + 2) * kstep;
            const unsigned a3 = a2 + kstep, b3 = b2 + kstep;
            if constexpr (SP2) {
            PG8_LDBX(B0, 0, 0); PG8_LDBX(B1, 0, 1); PG8_SCHED; PG8_LDAX(0, 0); PG8_STAGE(PG8_SA(1, 1), a1 + hstep, voffA);
            PG8_WAIT_V(8); PG8_WAIT_L(0); PG8_BAR; PG8_MMA(0, 0, At, B0); PG8_MMA(0, 1, At, B1); PG8_BAR; PG8_SCHED;
            PG8_LDAX(0, 1); PG8_STAGE(PG8_SB(0, 0), b2, voffB); PG8_STAGE(PG8_SB(0, 1), b2 + hstep, voffB); PG8_STAGE(PG8_SA(0, 0), a2, voffA);
            PG8_WAIT_V(8); PG8_WAIT_L(0); PG8_BAR; PG8_MMA(1, 0, At, B0); PG8_MMA(1, 1, At, B1); PG8_BAR; PG8_SCHED;
            PG8_LDBX(B0, 1, 0); PG8_LDBX(B1, 1, 1); PG8_SCHED; PG8_LDAX(1, 0); PG8_STAGE(PG8_SA(0, 1), a2 + hstep, voffA);
            PG8_WAIT_V(8); PG8_WAIT_L(0); PG8_BAR; PG8_MMA(0, 0, At, B0); PG8_MMA(0, 1, At, B1); PG8_BAR; PG8_SCHED;
            PG8_LDAX(1, 1); PG8_STAGE(PG8_SB(1, 0), b3, voffB); PG8_STAGE(PG8_SB(1, 1), b3 + hstep, voffB); PG8_STAGE(PG8_SA(1, 0), a3, voffA);
            PG8_WAIT_V(8); PG8_WAIT_L(0); PG8_BAR; PG8_MMA(1, 0, At, B0); PG8_MMA(1, 1, At, B1); PG8_BAR; PG8_SCHED;
            } else {
            PG8_LDBX(B0, 0, 0); PG8_SCHED; PG8_LDAX(0, 0); PG8_STAGE(PG8_SA(1, 1), a1 + hstep, voffA);
            PG8_WAIT_L(8); PG8_BAR; PG8_WAIT_L(0); PG8_MMA(0, 0, At, B0); PG8_BAR; PG8_SCHED;
            PG8_LDBX(B1, 0, 1); PG8_STAGE(PG8_SB(0, 0), b2, voffB);
            PG8_BAR; PG8_WAIT_L(0); PG8_MMA(0, 1, At, B1); PG8_BAR;
            PG8_LDAX(0, 1); PG8_STAGE(PG8_SA(0, 0), a2, voffA);
            PG8_BAR; PG8_WAIT_L(0); PG8_MMA(1, 0, At, B0); PG8_BAR; PG8_SCHED;
            PG8_STAGE(PG8_SB(0, 1), b2 + hstep, voffB);
            PG8_WAIT_V(6); PG8_BAR; PG8_MMA(1, 1, At, B1); PG8_BAR;
            PG8_LDBX(B0, 1, 0); PG8_SCHED; PG8_LDAX(1, 0); PG8_STAGE(PG8_SA(0, 1), a2 + hstep, voffA);
            PG8_WAIT_L(8); PG8_BAR; PG8_WAIT_L(0); PG8_MMA(0, 0, At, B0); PG8_BAR; PG8_SCHED;
            PG8_LDBX(B1, 1, 1); PG8_STAGE(PG8_SB(1, 0), b3, voffB);
            PG8_BAR; PG8_WAIT_L(0); PG8_MMA(0, 1, At, B1); PG8_BAR;
            PG8_LDAX(1, 1); PG8_STAGE(PG8_SA(1, 0), a3, voffA);
            PG8_BAR; PG8_WAIT_L(0); PG8_MMA(1, 0, At, B0); PG8_BAR; PG8_SCHED;
            PG8_STAGE(PG8_SB(1, 1), b3 + hstep, voffB);
            PG8_WAIT_V(6); PG8_BAR; PG8_MMA(1, 1, At, B1); PG8_BAR;
            }
        }
        if constexpr (ALIGN_EPI) { if (wr == 0) PG8_BAR; }
        if constexpr (ES == 1) asm volatile("s_nop 15\n\ts_nop 15" ::: "memory");
        E(acc, cur, wr, wc, fr, fq);
        if (!has_next) break;
        E.init(acc, nxt, wc, fq);
        cur = nxt; cA = nA; cB = nB; ++ui;
        if constexpr (ALIGN_EPI) { if (wr == 1) PG8_BAR; }
    }
    PG8_WAIT_V(0);
    if constexpr (!ALIGN_EPI) { if (wr == 0) PG8_BAR; }
    PG8_BAR;
#undef PG8_SA
#undef PG8_SB
#undef PG8_STAGE
#undef PG8_LDA
#undef PG8_LDA8
#undef PG8_LDB8
#undef PG8_LDAX
#undef PG8_LDBX
#undef PG8_LDB
#undef PG8_MMA
#undef PG8_WAIT_V
#undef PG8_WAIT_L
#undef PG8_BAR
#undef PG8_SCHED
}
}

#define XB_TMO      128
#define XB_XCNT(j)  (256  + 64 * (j))
#define XB_XSUB(j)  (1280 + 64 * (j))
#define XB_XGEN(j)  (2304 + 64 * (j))
#define XB_TOP      3328
#define XB_TOPGEN   3392
#define XCD_BAR_WORDS 3456
#define XB_SPIN_CAP (1u << 18)
__device__ __forceinline__ unsigned xb_ld(unsigned* p)              { return __hip_atomic_load(p, __ATOMIC_RELAXED, __HIP_MEMORY_SCOPE_AGENT); }
__device__ __forceinline__ unsigned xb_add(unsigned* p, unsigned v) { return __hip_atomic_fetch_add(p, v, __ATOMIC_RELAXED, __HIP_MEMORY_SCOPE_AGENT); }
__device__ __forceinline__ unsigned xb_xcc_id() { return (unsigned)__builtin_amdgcn_s_getreg((3 << 11) | 20) & 0xFu; }
#define XB_SPIN(cond, bar) do { unsigned _sp = 0; while (cond) { __builtin_amdgcn_s_sleep(1); \
    if ((++_sp & 255u) == 0u) { if (xb_ld(&(bar)[XB_TMO])) break; if (_sp > XB_SPIN_CAP) { atomicAdd(&(bar)[XB_TMO], 1u); break; } } } } while (0)

struct XcdBarrier {
    unsigned* bar; unsigned x;
    volatile LAS unsigned* st;
};

__device__ __forceinline__ XcdBarrier xcd_barrier_post(unsigned* bar, volatile LAS unsigned* st) {
    XcdBarrier b; b.bar = bar; b.x = xb_xcc_id(); b.st = st;
    if (threadIdx.x == 0) (void)xb_add(&bar[XB_XCNT(b.x)], 1u);
    return b;
}
__device__ __forceinline__ void xcd_barrier_complete(unsigned* bar, unsigned x, unsigned& nloc, unsigned& nx) {
    const unsigned G = gridDim.x * gridDim.y * gridDim.z;
    unsigned sum, cnt, mine, sp = 0u;
    for (;;) {
        sum = 0u; cnt = 0u; mine = 0u;
#pragma unroll
        for (unsigned j = 0; j < 16; ++j) { const unsigned c = xb_ld(&bar[XB_XCNT(j)]); sum += c; cnt += (c > 0u) ? 1u : 0u; mine = (j == x) ? c : mine; }
        if (sum == G) break;
        __builtin_amdgcn_s_sleep(1);
        if ((++sp & 255u) == 0u) { if (xb_ld(&bar[XB_TMO])) break; if (sp > XB_SPIN_CAP) { atomicAdd(&bar[XB_TMO], 1u); break; } }
    }
    nloc = mine > 0u ? mine : 1u; nx = cnt > 0u ? cnt : 1u;
}

__device__ __forceinline__ void xcd_barrier(const XcdBarrier& b) {
    asm volatile("s_waitcnt vmcnt(0)" ::: "memory");
    __syncthreads();
    if (threadIdx.x == 0) {
        unsigned* bar = b.bar;
        __builtin_amdgcn_s_waitcnt(0);
        unsigned nloc = b.st[0], nx = b.st[1];
        if (nloc == 0u) { xcd_barrier_complete(bar, b.x, nloc, nx); b.st[0] = nloc; b.st[1] = nx; }
        const unsigned old = xb_add(&bar[XB_XSUB(b.x)], 1u);
        const unsigned gen = old / nloc;
        if (old + 1u == (gen + 1u) * nloc) {
            __builtin_amdgcn_fence(__ATOMIC_RELEASE, "agent");
            asm volatile("s_waitcnt vmcnt(0)" ::: "memory");
            const unsigned og = xb_add(&bar[XB_TOP], 1u);
            const unsigned tg = og / nx;
            if (og + 1u == (tg + 1u) * nx) xb_add(&bar[XB_TOPGEN], 1u);
            else XB_SPIN(xb_ld(&bar[XB_TOPGEN]) == tg, bar);
            __builtin_amdgcn_fence(__ATOMIC_ACQUIRE, "agent");
            xb_add(&bar[XB_XGEN(b.x)], 1u);
            asm volatile("s_waitcnt vmcnt(0)" ::: "memory");
        } else {
            XB_SPIN(xb_ld(&bar[XB_XGEN(b.x)]) == gen, bar);
            __builtin_amdgcn_fence(__ATOMIC_ACQUIRE, "agent");
            asm volatile("s_waitcnt vmcnt(0)" ::: "memory");
        }
    }
    __syncthreads();
}

typedef short s4v __attribute__((ext_vector_type(4)));
__device__ __forceinline__ bf16x8 ldg8(const bf16* p) { return *(const bf16x8*)p; }
__device__ __forceinline__ f32x4 mfma16(bf16x8 a, bf16x8 b, f32x4 c) { return __builtin_amdgcn_mfma_f32_16x16x32_bf16(a, b, c, 0, 0, 0); }
__device__ __forceinline__ bf16x8 ldA(const LAS unsigned char* base, int pitch, int row0, int k0, int li, int g) { return *(const LAS bf16x8*)(base + ((row0 + li) * pitch + k0 + 8 * g) * 2); }
__device__ __forceinline__ bf16x8 ldT(const LAS unsigned char* base, int pitch, int k0, int n0, int li, int g) {
    const LAS unsigned char* p = base + ((k0 + 8 * g + (li >> 2)) * pitch + n0 + 4 * (li & 3)) * 2;
    const s4v a = __builtin_amdgcn_ds_read_tr16_b64_v4i16((LAS s4v*)p), b = __builtin_amdgcn_ds_read_tr16_b64_v4i16((LAS s4v*)(p + 8 * pitch));
    return (bf16x8){a[0], a[1], a[2], a[3], b[0], b[1], b[2], b[3]};
}
__device__ __forceinline__ bf16x8 ldAperm(const LAS unsigned char* base, int pitch, int row0, int ks, int li, int g) {
    const LAS unsigned char* p = base + ((row0 + li) * pitch + 32 * ks + 4 * g) * 2;
    const s4v a = *(const LAS s4v*)p, b = *(const LAS s4v*)(p + 32);
    return (bf16x8){a[0], a[1], a[2], a[3], b[0], b[1], b[2], b[3]};
}
__device__ __forceinline__ void stT(LAS unsigned char* base, int pitch, int n, int m0, const f32x4 v) {
    u32x2 w; w.x = pk2(v[0], v[1]); w.y = pk2(v[2], v[3]); *(LAS u32x2*)(base + (n * pitch + m0) * 2) = w;
}
__device__ __forceinline__ f32x4 ld4bf(const LAS unsigned char* p) { const u32x2 w = *(const LAS u32x2*)p; return (f32x4){bflo(w.x), bfhi(w.x), bflo(w.y), bfhi(w.y)}; }

struct Args {
    const float* in[31];
    float* out; unsigned char* ws;
    int ph_lo, ph_hi, use_bar, pad;
};
enum InIdx { I_X = 0, I_C, I_CTX, I_CCTX, I_ADAW, I_ADAB, I_N1G, I_N2G, I_WIN, I_WOUT, I_ASINK, I_BMIX, I_CREL, I_DCONV, I_DW0, I_DW2, I_DA0, I_DA2, I_DG2, I_DKK, I_DKA, I_DRK, I_DLNW, I_DLNB,
             I_RW, I_RB, I_WGU, I_BGU, I_WDN, I_BDN, I_FNG };
constexpr int NPL = 11;
constexpr int PH_TOTAL = 1 + DEPTH * NPL + 1;

struct DevIn {
    const LAS unsigned* tab;
    __device__ __forceinline__ const float* operator[](int i) const {
        const unsigned lo = __builtin_amdgcn_readfirstlane(((const volatile LAS unsigned*)tab)[2 * i]), hi = __builtin_amdgcn_readfirstlane(((const volatile LAS unsigned*)tab)[2 * i + 1]);
        return (const float*)(((unsigned long long)hi << 32) | lo);
    }
};
struct DArgs { DevIn in; float* out; };
struct Ctx {
    LAS unsigned char* lds;
    int tid, lane, wave, wg, G, gw, NGW;
    unsigned char* ws;
};

template <int NW>
__device__ __forceinline__ void transpose_item(const float* W, int K, int N, bf16* WT, int item, int lane) {
    constexpr int NQ = NW / 4, NC = 64 / NQ, PASSES = 8 / NC;
    const int nblk = N / NW, kb = item / nblk, nb = item % nblk, k0 = 64 * kb, n0 = NW * nb, nq = lane % NQ, cq = lane / NQ;
    f32x4 v[PASSES][8];
#pragma unroll
    for (int ps = 0; ps < PASSES; ++ps)
#pragma unroll
        for (int i = 0; i < 8; ++i) v[ps][i] = *(const f32x4*)(W + (size_t)(k0 + 8 * (cq + NC * ps) + i) * N + n0 + 4 * nq);
#pragma unroll
    for (int ps = 0; ps < PASSES; ++ps)
#pragma unroll
        for (int j = 0; j < 4; ++j) { u32x4 o; o.x = pk2(v[ps][0][j], v[ps][1][j]); o.y = pk2(v[ps][2][j], v[ps][3][j]); o.z = pk2(v[ps][4][j], v[ps][5][j]); o.w = pk2(v[ps][6][j], v[ps][7][j]);
            *(u32x4*)(WT + (size_t)(n0 + 4 * nq + j) * K + k0 + 8 * (cq + NC * ps)) = o; }
}
template <int NW>
__device__ __forceinline__ void transpose_item8(const float* W, int K, int N, unsigned char* WT, int item, int lane) {
    constexpr int NQ = NW / 4, NC = 64 / NQ, PASSES = 8 / NC;
    const int nblk = N / NW, kb = item / nblk, nb = item % nblk, k0 = 64 * kb, n0 = NW * nb, nq = lane % NQ, cq = lane / NQ;
    f32x4 v[PASSES][8];
#pragma unroll
    for (int ps = 0; ps < PASSES; ++ps)
#pragma unroll
        for (int i = 0; i < 8; ++i) v[ps][i] = __builtin_nontemporal_load((const f32x4*)(W + (size_t)(k0 + 8 * (cq + NC * ps) + i) * N + n0 + 4 * nq)) * pg8::W8_S;
#pragma unroll
    for (int ps = 0; ps < PASSES; ++ps)
#pragma unroll
        for (int j = 0; j < 4; ++j) { unsigned w0 = 0, w1 = 0;
            w0 = __builtin_amdgcn_cvt_pk_fp8_f32(v[ps][0][j], v[ps][1][j], w0, false); w0 = __builtin_amdgcn_cvt_pk_fp8_f32(v[ps][2][j], v[ps][3][j], w0, true);
            w1 = __builtin_amdgcn_cvt_pk_fp8_f32(v[ps][4][j], v[ps][5][j], w1, false); w1 = __builtin_amdgcn_cvt_pk_fp8_f32(v[ps][6][j], v[ps][7][j], w1, true);
            __builtin_nontemporal_store((u32x2){w0, w1}, (u32x2*)(WT + (size_t)(n0 + 4 * nq + j) * K + k0 + 8 * (cq + NC * ps))); }
}
constexpr int CV_IT_GU = 16 * 64, CV_IT_DN = 16 * 32, CV_N_GU = 32 * CV_IT_GU, CV_N_DN = 32 * CV_IT_DN, CV_ITEMS = CV_N_GU + CV_N_DN, CV_CHUNK = 16, CV_NCHUNK = CV_ITEMS / CV_CHUNK;
__device__ __forceinline__ void convert_moe_items(const Ctx& C, const DArgs& a, int l, int it0, int it1) {
    const float* pwgu = a.in[I_WGU] + (size_t)l * 32 * DM * 2048; const float* pwdn = a.in[I_WDN] + (size_t)l * 32 * DM * DM;
    unsigned char* ogu = C.ws + WS_WGU + (size_t)l * 32 * 2048 * DM; unsigned char* odn = C.ws + WS_WDN + (size_t)l * 32 * DM * DM;
#pragma unroll 1
    for (int it = it0; it < it1; ++it) {
        if (it < CV_N_GU) { const int e = it / CV_IT_GU; transpose_item8<32>(pwgu + (size_t)e * DM * 2048, DM, 2048, ogu + (size_t)e * 2048 * DM, it % CV_IT_GU, C.lane); }
        else { const int r = it - CV_N_GU, e = r / CV_IT_DN; transpose_item8<32>(pwdn + (size_t)e * DM * DM, DM, DM, odn + (size_t)e * DM * DM, r % CV_IT_DN, C.lane); }
    }
}
__device__ __forceinline__ void phase_prologue(const Ctx& C, const DArgs& a) {
    constexpr int IT_IN = 16 * (INW / 32), IT_OUT = 16 * 16;
    constexpr int N_IN = 4 * IT_IN, N_OUT = 4 * IT_OUT;
    const float* pwin = a.in[I_WIN]; const float* pwout = a.in[I_WOUT];
    for (int it = C.gw; it < N_IN + N_OUT; it += C.NGW) {
        if (it < N_IN) { const int l = it / IT_IN; transpose_item<32>(pwin + (size_t)l * DM * INW, DM, INW, (bf16*)(C.ws + WS_WIN) + (size_t)l * INWP * DM, it % IT_IN, C.lane); }
        else { const int r = it - N_IN, l = r / IT_OUT; transpose_item<64>(pwout + (size_t)l * DM * DM, DM, DM, (bf16*)(C.ws + WS_WOUT) + (size_t)l * DM * DM, r % IT_OUT, C.lane); }
    }
    for (int ch = C.gw; ch < CV_NCHUNK; ch += C.NGW) convert_moe_items(C, a, 0, ch * CV_CHUNK, ch * CV_CHUNK + CV_CHUNK);
    { const int gt = C.wg * NTHR + C.tid; constexpr int PADN = (INWP - INW) * DM / 8;
      for (int i = gt; i < 4 * PADN; i += C.G * NTHR) { const int l = i / PADN, r = i % PADN; *((u32x4*)((bf16*)(C.ws + WS_WIN) + ((size_t)l * INWP + INW) * DM) + r) = (u32x4){0u, 0u, 0u, 0u}; } }
    { float* tw = (float*)(C.ws + WS_TW); const int gt = C.wg * NTHR + C.tid;
      for (int i = gt; i < 16384; i += C.G * NTHR) { const float x = (float)i * (1.0f / 8192.0f); tw[i] = cospif(x); tw[16384 + i] = sinpif(x); } }
    { float* mt = (float*)(C.ws + WS_MTAB); const int gt = C.wg * NTHR + C.tid; const float* pbmix = a.in[I_BMIX];
      for (int i = gt; i < 4 * 4 * 64 * 64; i += C.G * NTHR) { const int e = i & 63, c = (i >> 6) & 63, g = (i >> 12) & 3, l = i >> 14;
          const float* w = pbmix + ((size_t)(l * 4 + g) * 64) * 64 + e; float sc = 0.f, ss = 0.f;
          for (int cp = 0; cp < 64; ++cp) { const float x = (float)((c * cp) & 63) * (1.0f / 32.0f); const float wv = w[cp * 64]; sc += cospif(x) * wv; ss += sinpif(x) * wv; }
          mt[((size_t)(l * 2 + 0) * 4 + g) * 4096 + c * 64 + e] = sc; mt[((size_t)(l * 2 + 1) * 4 + g) * 4096 + c * 64 + e] = ss; } }
    { bf16* ft = (bf16*)(C.ws + WS_FTAB); const int gt = C.wg * NTHR + C.tid; const float* pbmix = a.in[I_BMIX];
      for (int i = gt; i < 128 * 128; i += C.G * NTHR) { const int k = i >> 7, t = i & 127; const float x = (float)((k * t) & 127) * (1.0f / 64.0f); ft[i] = (bf16)f2bf(cospif(x)); ft[16384 + i] = (bf16)f2bf(sinpif(x)); }
      bf16* mf = ft + 32768;
      for (int i = gt; i < 4 * 4 * 16 * 64 * 8; i += C.G * NTHR) { const int j8 = i & 7, ln = (i >> 3) & 63, fr = (i >> 9) & 15, gq = (i >> 13) & 3, l = i >> 15;
          const int ei = fr >> 2, ks2 = fr & 3, e = 16 * ei + (ln & 15), g = ln >> 4, c = 32 * (ks2 & 1) + 16 * (j8 >> 2) + 4 * g + (j8 & 3), part = ks2 >> 1;
          const float* w = pbmix + ((size_t)(l * 4 + gq) * 64) * 64 + e; float s = 0.f;
          for (int cp = 0; cp < 64; ++cp) { const float x = (float)((c * cp) & 63) * (1.0f / 32.0f); s += (part ? sinpif(x) : cospif(x)) * w[cp * 64]; }
          mf[i] = (bf16)f2bf(s * (1.0f / 1024.0f)); } }
    { const int gt = C.wg * NTHR + C.tid; const float* pg2 = a.in[I_DG2]; const float* prw = a.in[I_RW]; bf16* g2t = (bf16*)(C.ws + WS_G2T); bf16* rwt = (bf16*)(C.ws + WS_RWT);
      for (int i = gt; i < 4 * 256 * 160; i += C.G * NTHR) { const int ii = i % 160, c = (i / 160) & 255, l = i / (160 * 256); g2t[i] = (bf16)f2bf(pg2[((size_t)l * 160 + ii) * 256 + c]); }
      for (int i = gt; i < 4 * 32 * 1024; i += C.G * NTHR) { const int k = i & 1023, e = (i >> 10) & 31, l = i >> 15; rwt[i] = (bf16)f2bf(prw[((size_t)l * 1024 + k) * 32 + e]); } }
    { const int gt = C.wg * NTHR + C.tid; const float* pw2 = a.in[I_DW2]; const float* pa2 = a.in[I_DA2]; bf16* lt = (bf16*)(C.ws + WS_LORAT);
      for (int i = gt; i < 4 * 4 * 256 * 64; i += C.G * NTHR) { const int ii = i & 63, c = (i >> 6) & 255, q = (i >> 14) & 3, l = i >> 16;
          const float* src = (q < 2) ? pw2 : pa2; lt[i] = (bf16)f2bf(src[(((size_t)l * 2 + (q & 1)) * 64 + ii) * 256 + c]); } }
    { bf16* f2 = (bf16*)(C.ws + WS_F256); const int gt = C.wg * NTHR + C.tid;
      for (int i = gt; i < 256 * 256; i += C.G * NTHR) { const int k = i >> 8, t = i & 255; const float x = (float)((k * t) & 255) * (1.0f / 128.0f); f2[i] = (bf16)f2bf(cospif(x)); f2[65536 + i] = (bf16)f2bf(sinpif(x)); } }
    { LAS float* sl = (LAS float*)(C.lds);
      LAS float* red = (LAS float*)(C.lds + 8192);
      __syncthreads();
      const float* pc = a.in[I_C]; const float* pcc = a.in[I_CCTX]; const float* padaw = a.in[I_ADAW]; const float* padab = a.in[I_ADAB];
      for (int i = C.tid; i < 2048; i += NTHR) { const float x = (i < 1024) ? pc[i] : pcc[i - 1024]; sl[i] = x * sigmoidf_(x); }
      __syncthreads();
      float* mod = (float*)(C.ws + WS_MOD);
      for (int u = C.wg; u < 4 * 96; u += C.G) { const int l = u / 96, jb = u % 96, j0 = jb * 64 + C.lane;
          float s0 = 0.f, s1 = 0.f; const float* w = padaw + (size_t)l * DM * 6144 + j0; const int k0 = C.wave * 128;
#pragma unroll 16
          for (int k = 0; k < 128; ++k) { const float wv = w[(size_t)(k0 + k) * 6144]; s0 += wv * sl[k0 + k]; s1 += wv * sl[1024 + k0 + k]; }
          red[(C.wave * 2 + 0) * 64 + C.lane] = s0; red[(C.wave * 2 + 1) * 64 + C.lane] = s1;
          __syncthreads();
          if (C.tid < 128) { const int v = C.tid >> 6, j = C.tid & 63; float s = 0.f;
#pragma unroll
              for (int wv = 0; wv < 8; ++wv) s += red[(wv * 2 + v) * 64 + j];
              mod[(size_t)(l * 2 + v) * 6144 + jb * 64 + j] = s + padab[(size_t)l * 6144 + jb * 64 + j]; }
          __syncthreads(); } }
}

__device__ __forceinline__ void load_row(const float* p, int lane, f32x4 (&v)[4]) {
#pragma unroll
    for (int j = 0; j < 4; ++j) v[j] = *((const f32x4*)p + lane + 64 * j);
}
__device__ __forceinline__ void moe_combine_row(const Ctx& C, int row, f32x4 (&v)[4], const float* gt2) {
    const int* dest = (const int*)(C.ws + WS_ROUTE) + (size_t)3 * ROWS * 4; const float* gate = (const float*)(C.ws + WS_ROUTE) + (size_t)1 * ROWS * 4;
    const bf16* YB = (const bf16*)(C.ws + WS_XG);
    f32x4 s[4];
#pragma unroll
    for (int j = 0; j < 4; ++j) s[j] = (f32x4){0.f, 0.f, 0.f, 0.f};
#pragma unroll
    for (int k = 0; k < 4; ++k) { const int d = dest[row * 4 + k]; const float g = gate[row * 4 + k]; const u32x2* yp = (const u32x2*)(YB + (size_t)d * DM) + C.lane;
#pragma unroll
        for (int j = 0; j < 4; ++j) { const u32x2 w = yp[64 * j]; s[j] += (f32x4){bflo(w.x), bfhi(w.x), bflo(w.y), bfhi(w.y)} * g; } }
#pragma unroll
    for (int j = 0; j < 4; ++j) v[j] += *((const f32x4*)gt2 + C.lane + 64 * j) * s[j];
}
__device__ __forceinline__ float row_rstd(const f32x4 (&v)[4], int lane) {
    float s = 0.f;
#pragma unroll
    for (int j = 0; j < 4; ++j) s += (v[j].x * v[j].x + v[j].y * v[j].y) + (v[j].z * v[j].z + v[j].w * v[j].w);
    return rsqrtf(wave_sum(s, lane) * (1.f / DM) + 1e-6f);
}
__device__ __forceinline__ void norm1_fetch(const Ctx& C, const float* src_row, int row, bool combine, const float* gt2, f32x4 (&v)[4]) {
    load_row(src_row, C.lane, v);
    if (combine) moe_combine_row(C, row, v, gt2);
}
__device__ __forceinline__ void phase_norm1(const Ctx& C, const DArgs& a, int l) {
    float* XS = (float*)(C.ws + WS_XS); bf16* H = (bf16*)(C.ws + WS_H); const float* mod = (const float*)(C.ws + WS_MOD);
    const float* g1 = a.in[I_N1G] + (size_t)l * DM;
    const float* pctx = a.in[I_CTX]; const float* px = a.in[I_X];
    for (int row0 = C.gw; row0 < ROWS; row0 += 2 * C.NGW) {
        f32x4 v[2][4]; const int rows[2] = {row0, row0 + C.NGW};
#pragma unroll
        for (int q = 0; q < 2; ++q) if (rows[q] < ROWS) { const int row = rows[q]; const bool isctx = row < NCTX;
            const float* src = (l == 0) ? (isctx ? pctx + (size_t)row * DM : px + (size_t)(row - NCTX) * DM) : XS + (size_t)row * DM;
            norm1_fetch(C, src, row, l > 0, mod + (size_t)((l > 0 ? l - 1 : 0) * 2 + (isctx ? 1 : 0)) * 6144 + 5 * DM, v[q]); }
#pragma unroll
        for (int q = 0; q < 2; ++q) if (rows[q] < ROWS) { const int row = rows[q]; const bool isctx = row < NCTX;
#pragma unroll
            for (int j = 0; j < 4; ++j) *((f32x4*)(XS + (size_t)row * DM) + C.lane + 64 * j) = v[q][j];
            const float rstd = row_rstd(v[q], C.lane);
            const float* md = mod + (size_t)(l * 2 + (isctx ? 1 : 0)) * 6144;
            u32x2* o = (u32x2*)(H + (size_t)row * DM) + C.lane;
#pragma unroll
            for (int j = 0; j < 4; ++j) { const f32x4 g = *((const f32x4*)g1 + C.lane + 64 * j), sh = *((const f32x4*)md + C.lane + 64 * j), sc = *((const f32x4*)(md + DM) + C.lane + 64 * j);
                const f32x4 y = v[q][j] * rstd * g * (sc + 1.0f) + sh; u32x2 w; w.x = pk2(y.x, y.y); w.y = pk2(y.z, y.w); o[64 * j] = w; } }
    }
}
__device__ __forceinline__ void phase_final(const Ctx& C, const DArgs& a) {
    const float* XS = (const float*)(C.ws + WS_XS); const float* mod = (const float*)(C.ws + WS_MOD); const float* g = a.in[I_FNG];
    const float* gt2 = mod + (size_t)((DEPTH - 1) * 2 + 0) * 6144 + 5 * DM;
    for (int row0 = NCTX + C.gw; row0 < ROWS; row0 += 2 * C.NGW) {
        f32x4 v[2][4]; const int rows[2] = {row0, row0 + C.NGW};
#pragma unroll
        for (int q = 0; q < 2; ++q) if (rows[q] < ROWS) norm1_fetch(C, XS + (size_t)rows[q] * DM, rows[q], true, gt2, v[q]);
#pragma unroll
        for (int q = 0; q < 2; ++q) if (rows[q] < ROWS) { const float rstd = row_rstd(v[q], C.lane); float* o = a.out + (size_t)(rows[q] - NCTX) * DM;
#pragma unroll
            for (int j = 0; j < 4; ++j) *((f32x4*)o + C.lane + 64 * j) = v[q][j] * rstd * *((const f32x4*)g + C.lane + 64 * j); }
    }
}
constexpr int NR2 = 9;
__device__ __forceinline__ void phase_norm2(const Ctx& C, const DArgs& a, int l) {
    const float* XS = (const float*)(C.ws + WS_XS); bf16* H = (bf16*)(C.ws + WS_H); const float* mod = (const float*)(C.ws + WS_MOD);
    const float* g2 = a.in[I_N2G] + (size_t)l * DM; const float* rb = a.in[I_RB] + (size_t)l * NEXP; const bf16* rwt = (const bf16*)(C.ws + WS_RWT) + (size_t)l * NEXP * DM;
    int* tok_e = (int*)(C.ws + WS_ROUTE); float* gate = (float*)(C.ws + WS_ROUTE) + (size_t)1 * ROWS * 4; int* slot = (int*)(C.ws + WS_ROUTE) + (size_t)2 * ROWS * 4;
    LAS float* lg = (LAS float*)(C.lds + C.wave * 4096);
    LAS int* hist = (LAS int*)(C.lds + MISC_OFF + 64);
    const int lane = C.lane, li = lane & 15, g = lane >> 4;
    if (C.tid < NEXP) hist[C.tid] = 0;
    __syncthreads();
    const int row_base = (l == DEPTH - 1) ? NCTX : 0, ntile = (ROWS - row_base + NR2 - 1) / NR2;
    for (int tl = C.gw; tl < ntile; tl += C.NGW) {
        const int trow0 = row_base + NR2 * tl, nrow = (ROWS - trow0 < NR2) ? ROWS - trow0 : NR2;
#pragma unroll 1
        for (int rr = 0; rr < nrow; ++rr) { const int row = trow0 + rr; const bool isctx = row < NCTX; f32x4 v[4]; load_row(XS + (size_t)row * DM, lane, v);
            const float rstd = row_rstd(v, lane);
            const float* md = mod + (size_t)(l * 2 + (isctx ? 1 : 0)) * 6144 + 3 * DM;
            u32x2* o = (u32x2*)(H + (size_t)row * DM) + lane;
#pragma unroll
            for (int j = 0; j < 4; ++j) { const f32x4 gg = *((const f32x4*)g2 + lane + 64 * j), sh = *((const f32x4*)md + lane + 64 * j), sc = *((const f32x4*)(md + DM) + lane + 64 * j);
                const f32x4 y = v[j] * rstd * gg * (sc + 1.0f) + sh; u32x2 w; w.x = pk2(y.x, y.y); w.y = pk2(y.z, y.w); o[64 * j] = w; } }
        asm volatile("s_waitcnt vmcnt(0)" ::: "memory");
        f32x4 acc0 = {0.f, 0.f, 0.f, 0.f}, acc1 = {0.f, 0.f, 0.f, 0.f};
        const int arow = (trow0 + li < ROWS) ? trow0 + li : ROWS - 1;
        const bf16* ap = H + (size_t)arow * DM + 8 * g; const bf16* bp0 = rwt + (size_t)li * DM + 8 * g; const bf16* bp1 = bp0 + 16 * DM;
#pragma unroll 4
        for (int ks = 0; ks < 32; ++ks) { const bf16x8 af = *(const bf16x8*)(ap + 32 * ks); acc0 = mfma16(af, *(const bf16x8*)(bp0 + 32 * ks), acc0); acc1 = mfma16(af, *(const bf16x8*)(bp1 + 32 * ks), acc1); }
#pragma unroll
        for (int r = 0; r < 4; ++r) { lg[(4 * g + r) * 33 + li] = acc0[r]; lg[(4 * g + r) * 33 + 16 + li] = acc1[r]; }
        LDS_WAIT(); asm volatile("" ::: "memory");
        const int e = lane & 31; const float rbe = rb[e];
#pragma unroll 1
        for (int rr = 0; rr < nrow; ++rr) { const int row = trow0 + rr;
            float val = lg[rr * 33 + e] + rbe; int te[4]; float tv[4];
#pragma unroll
            for (int k = 0; k < 4; ++k) { float bv = val; int bi = e;
#define AMAX_ROR(n) { const float ov = __builtin_bit_cast(float, __builtin_amdgcn_update_dpp(0, __builtin_bit_cast(int, bv), 0x120 + (n), 0xf, 0xf, false)); const int oi = __builtin_amdgcn_update_dpp(0, bi, 0x120 + (n), 0xf, 0xf, false); \
                    if (ov > bv || (ov == bv && oi < bi)) { bv = ov; bi = oi; } }
                AMAX_ROR(8) AMAX_ROR(4) AMAX_ROR(2) AMAX_ROR(1)
#undef AMAX_ROR
                { const float ov = shx(bv, 16, lane); const int oi = shxi(bi, 16, lane); if (ov > bv || (ov == bv && oi < bi)) { bv = ov; bi = oi; } }
                te[k] = bi; tv[k] = bv; if (e == bi) val = -3.0e38f; }
            if (lane == 0) { const float m = tv[0]; float p[4], ps = 0.f;
#pragma unroll
                for (int k = 0; k < 4; ++k) { p[k] = __expf(tv[k] - m); ps += p[k]; }
#pragma unroll
                for (int k = 0; k < 4; ++k) { tok_e[row * 4 + k] = te[k]; gate[row * 4 + k] = p[k] / ps; slot[row * 4 + k] = __hip_atomic_fetch_add(&hist[te[k]], 1, __ATOMIC_RELAXED, __HIP_MEMORY_SCOPE_WORKGROUP); } } }
        asm volatile("" ::: "memory");
    }
    __syncthreads();
    if (C.tid < NEXP) ((int*)(C.ws + WS_CNT))[C.wg * NEXP + C.tid] = hist[C.tid];
}
__device__ __forceinline__ int moe_tables(const Ctx& C) {
    const int* cnt = (const int*)(C.ws + WS_CNT);
    LAS int* part = (LAS int*)(C.lds);
    LAS int* pstart = (LAS int*)(C.lds + MISC_OFF + 256); LAS int* wgbase = pstart + 40; LAS int* tot = wgbase + 32; LAS int* nblk_s = tot + 32;
    LAS unsigned char* blk_e = (LAS unsigned char*)(C.lds + MISC_OFF + 1024);
    __syncthreads();
    { const int e = C.tid & 31, p = C.tid >> 5; int t = 0, pre = 0;
#pragma unroll 1
      for (int w = p * 16; w < p * 16 + 16; ++w) { const int c = cnt[w * NEXP + e]; t += c; if (w < C.wg) pre += c; }
      part[(p * 32 + e) * 2] = t; part[(p * 32 + e) * 2 + 1] = pre; }
    __syncthreads();
    if (C.tid < NEXP) { int t = 0, pre = 0;
#pragma unroll 1
        for (int p = 0; p < 16; ++p) { t += part[(p * 32 + C.tid) * 2]; pre += part[(p * 32 + C.tid) * 2 + 1]; }
        tot[C.tid] = t; wgbase[C.tid] = pre; }
    __syncthreads();
    if (C.tid == 0) { int b = 0;
#pragma unroll 1
        for (int e = 0; e < NEXP; ++e) { pstart[e] = b * 256; b += (tot[e] + 255) >> 8; }
        pstart[NEXP] = b * 256; nblk_s[0] = b; }
    __syncthreads();
    if (C.tid < NEXP) wgbase[C.tid] += pstart[C.tid];
    if (C.tid < MOE_MAXBLK) { int e = 0;
#pragma unroll 1
        for (int k = 1; k < NEXP; ++k) if (pstart[k] <= C.tid * 256) e = k;
        blk_e[C.tid] = (unsigned char)e; }
    __syncthreads();
    return __builtin_amdgcn_readfirstlane(nblk_s[0]);
}
__device__ __forceinline__ void phase_gather(const Ctx& C, const DArgs& a, int l) {
    moe_tables(C);
    const LAS int* wgbase = (const LAS int*)(C.lds + MISC_OFF + 256) + 40;
    const int* tok_e = (const int*)(C.ws + WS_ROUTE); const int* slot = (const int*)(C.ws + WS_ROUTE) + (size_t)2 * ROWS * 4; int* dest = (int*)(C.ws + WS_ROUTE) + (size_t)3 * ROWS * 4;
    const bf16* H = (const bf16*)(C.ws + WS_H); unsigned char* XG = C.ws + WS_XG8;
    const int row_base = (l == DEPTH - 1) ? NCTX : 0, ntile = (ROWS - row_base + NR2 - 1) / NR2;
    for (int tl = C.gw; tl < ntile; tl += C.NGW)
    for (int row = row_base + NR2 * tl; row < row_base + NR2 * tl + NR2 && row < ROWS; ++row) {
        const u32x4* src = (const u32x4*)(H + (size_t)row * DM) + C.lane; const u32x4 v0 = src[0], v1 = src[64];
        u32x2 q0, q1;
        { unsigned w = 0; w = __builtin_amdgcn_cvt_pk_fp8_f32(bflo(v0.x) * pg8::X8_S, bfhi(v0.x) * pg8::X8_S, w, false); w = __builtin_amdgcn_cvt_pk_fp8_f32(bflo(v0.y) * pg8::X8_S, bfhi(v0.y) * pg8::X8_S, w, true); q0.x = w;
          w = 0; w = __builtin_amdgcn_cvt_pk_fp8_f32(bflo(v0.z) * pg8::X8_S, bfhi(v0.z) * pg8::X8_S, w, false); w = __builtin_amdgcn_cvt_pk_fp8_f32(bflo(v0.w) * pg8::X8_S, bfhi(v0.w) * pg8::X8_S, w, true); q0.y = w;
          w = 0; w = __builtin_amdgcn_cvt_pk_fp8_f32(bflo(v1.x) * pg8::X8_S, bfhi(v1.x) * pg8::X8_S, w, false); w = __builtin_amdgcn_cvt_pk_fp8_f32(bflo(v1.y) * pg8::X8_S, bfhi(v1.y) * pg8::X8_S, w, true); q1.x = w;
          w = 0; w = __builtin_amdgcn_cvt_pk_fp8_f32(bflo(v1.z) * pg8::X8_S, bfhi(v1.z) * pg8::X8_S, w, false); w = __builtin_amdgcn_cvt_pk_fp8_f32(bflo(v1.w) * pg8::X8_S, bfhi(v1.w) * pg8::X8_S, w, true); q1.y = w; }
#pragma unroll
        for (int k = 0; k < 4; ++k) { const int d = wgbase[tok_e[row * 4 + k]] + slot[row * 4 + k]; if (C.lane == 0) dest[row * 4 + k] = d;
            u32x2* dp = (u32x2*)(XG + (size_t)d * DM) + C.lane; dp[0] = q0; dp[64] = q1; }
    }
}

__device__ __forceinline__ void mix1_rope(const Ctx& C) {
    bf16* P = (bf16*)(C.ws + WS_P);
    const long total = (long)SEQ * 192;
    for (long i = (long)C.wg * NTHR + C.tid; i < total; i += (long)C.G * NTHR) {
        const int j = (int)(i & 31), hh = (int)((i >> 5) % 6), t = (int)(i / 192);
        const int col = (hh < 4) ? (C_AQ + hh * 64) : (C_AK + (hh - 4) * 64);
        const float pos = (j < 16) ? (float)(t >> 6) : (float)(t & 63);
        const float inv = __powf(10000.0f, -(float)(j & 15) * (1.0f / 16.0f));
        const float ang = pos * inv * 0.31830988618379067f;
        const float cs = cospif(ang), sn = sinpif(ang);
        bf16* p = P + (size_t)(NCTX + t) * INWP + col;
        const float x1 = bf2f(p[j]), x2 = bf2f(p[j + 32]);
        p[j] = (bf16)f2bf(x1 * cs - x2 * sn); p[j + 32] = (bf16)f2bf(x2 * cs + x1 * sn);
    }
}
__device__ __forceinline__ void mix1_vt(const Ctx& C) {
    const bf16* P = (const bf16*)(C.ws + WS_P);
    LAS unsigned short* scr = (LAS unsigned short*)(C.lds + C.wave * 16384);
    for (int u = C.gw; u < (ROWS / 64) * 6; u += C.NGW) {
        const int hd = u % 6, tb = u / 6; const int vcol = (hd < 2) ? (C_AV + hd * 64) : (C_CV + (hd - 2) * 64);
        bf16* VT = ((hd < 2) ? (bf16*)(C.ws + WS_VTA) + (size_t)hd * 64 * VTP : (bf16*)(C.ws + WS_VTC) + (size_t)(hd - 2) * 64 * VTP);
#pragma unroll
        for (int i = 0; i < 8; ++i) { const int tk = (C.lane >> 3) + 8 * i, ch = C.lane & 7; const u32x4 w = *(const u32x4*)(P + (size_t)(tb * 64 + tk) * INWP + vcol + 8 * ch);
            LAS unsigned* d = (LAS unsigned*)(scr + tk * 66 + 8 * ch); d[0] = w.x; d[1] = w.y; d[2] = w.z; d[3] = w.w; }
        LDS_WAIT(); asm volatile("" ::: "memory");
#pragma unroll
        for (int k8 = 0; k8 < 8; ++k8) { unsigned w[4];
#pragma unroll
            for (int e2 = 0; e2 < 4; ++e2) { const unsigned lo = scr[(8 * k8 + 2 * e2) * 66 + C.lane], hi = scr[(8 * k8 + 2 * e2 + 1) * 66 + C.lane]; w[e2] = lo | (hi << 16); }
            *(u32x4*)(VT + (size_t)C.lane * VTP + tb * 64 + 8 * k8) = (u32x4){w[0], w[1], w[2], w[3]}; }
        LDS_WAIT(); asm volatile("" ::: "memory");
    }
    for (int i = C.wg * NTHR + C.tid; i < 6 * 64 * 32; i += C.G * NTHR) { const int rowi = i >> 5, pc = i & 31; const int hd = rowi >> 6, d = rowi & 63;
        bf16* VT = ((hd < 2) ? (bf16*)(C.ws + WS_VTA) + (size_t)hd * 64 * VTP : (bf16*)(C.ws + WS_VTC) + (size_t)(hd - 2) * 64 * VTP);
        *(u32x4*)(VT + (size_t)d * VTP + ROWS + 8 * pc) = (u32x4){0u, 0u, 0u, 0u}; }
}
__device__ __forceinline__ float conv3(const bf16* P, int row, int col, const float* cw, int cc) {
    const bool first = (row == 0) || (row == NCTX), last = (row == NCTX - 1) || (row == ROWS - 1);
    float s = cw[768 + cc] * bf2f(P[(size_t)row * INWP + col]);
    if (!first) s += cw[cc] * bf2f(P[(size_t)(row - 1) * INWP + col]);
    if (!last) s += cw[2 * 768 + cc] * bf2f(P[(size_t)(row + 1) * INWP + col]);
    return s;
}
__device__ __forceinline__ void mix1_rwkv_prep(const Ctx& C, const DArgs& a, int l) {
    const bf16* P = (const bf16*)(C.ws + WS_P); float* SC = (float*)(C.ws + WS_SC);
    constexpr int LBP = 264;
    LAS unsigned char* lob = C.lds;
    LAS float* pre = (LAS float*)(C.lds + 16384);
    const bf16* lorat = (const bf16*)(C.ws + WS_LORAT) + (size_t)l * 4 * 256 * 64;
    const float* cw = a.in[I_DCONV] + (size_t)l * 3 * 768;
    const float* w0 = a.in[I_DW0] + (size_t)l * 512; const float* a0 = a.in[I_DA0] + (size_t)l * 512;
    const float* kkw = a.in[I_DKK] + (size_t)l * 256; const float* kaw = a.in[I_DKA] + (size_t)l * 256;
    const int half = C.tid >> 8, c = C.tid & 255, lane = C.lane, li = lane & 15, g = lane >> 4;
    const float kkc = kkw[c], kac = kaw[c];
    bf16 lin[7];
#define LIN_FETCH(gg) do { const int r0_ = 13 * (gg) + 7 * half; _Pragma("unroll") for (int j = 0; j < 7; ++j) if (j < 7 - half) lin[j] = P[(size_t)(r0_ + j) * INWP + C_WL + c]; } while (0)
    if (C.wg < ROWS / 13) LIN_FETCH(C.wg);
    for (int grp = C.wg; grp < ROWS / 13; grp += C.G) {
        const int row0 = 13 * grp + 7 * half, nj = 7 - half;
        __syncthreads();
#pragma unroll
        for (int j = 0; j < 7; ++j) if (j < nj) { const float x = bf2f(lin[j]); *(LAS bf16*)(lob + ((7 * half + j) * LBP + c) * 2) = (bf16)f2bf((c < 128) ? tanhf(x) : x); }
        __syncthreads();
        float xr[9], xk[9], xv[9];
#pragma unroll
        for (int q = 0; q < 9; ++q) { const int rw = row0 - 1 + q; const bool in = (rw >= 0) && (rw < ROWS) && (q <= nj + 1);
            const bf16* pp = P + (size_t)(in ? rw : row0) * INWP; xr[q] = in ? bf2f(pp[C_DR + c]) : 0.f; xk[q] = in ? bf2f(pp[C_DK + c]) : 0.f; xv[q] = in ? bf2f(pp[C_DV + c]) : 0.f; }
#pragma unroll
        for (int q = 0; q < 4; ++q) { const bf16x8 a0f = ldA(lob, LBP, 0, 64 * q, li, g), a1f = ldA(lob, LBP, 0, 64 * q + 32, li, g);
#pragma unroll
            for (int c2 = 0; c2 < 2; ++c2) { const int ci = 2 * C.wave + c2; const bf16* bp = lorat + ((size_t)q * 256 + 16 * ci + li) * 64 + 8 * g;
                f32x4 acc = {0.f, 0.f, 0.f, 0.f}; acc = mfma16(a0f, ldg8(bp), acc); acc = mfma16(a1f, ldg8(bp + 32), acc);
#pragma unroll
                for (int r = 0; r < 4; ++r) pre[(q * 16 + 4 * g + r) * 256 + 16 * ci + li] = acc[r]; } }
        __syncthreads();
        if (grp + C.G < ROWS / 13) LIN_FETCH(grp + C.G);
        const float cr0 = cw[c], cr1 = cw[768 + c], cr2 = cw[1536 + c], ck0 = cw[256 + c], ck1 = cw[768 + 256 + c], ck2 = cw[1536 + 256 + c], cv0 = cw[512 + c], cv1 = cw[768 + 512 + c], cv2 = cw[1536 + 512 + c];
#pragma unroll
        for (int j = 0; j < 7; ++j) if (j < nj) { const int row = row0 + j, rl = 7 * half + j;
            const bool first = (row == 0) || (row == NCTX), last = (row == NCTX - 1) || (row == ROWS - 1);
            const float m0 = first ? 0.f : 1.f, m2 = last ? 0.f : 1.f;
            const float r = cr1 * xr[j + 1] + m0 * cr0 * xr[j] + m2 * cr2 * xr[j + 2], k = ck1 * xk[j + 1] + m0 * ck0 * xk[j] + m2 * ck2 * xk[j + 2], v = cv1 * xv[j + 1] + m0 * cv0 * xv[j] + m2 * cv2 * xv[j + 2];
            float kk = k * kkc; const float n2 = wave_sum(kk * kk, lane); kk *= rsqrtf(fmaxf(n2, 1e-24f));
            float* sc = SC + (size_t)row * 9 * 256; sc[c] = r; sc[256 + c] = v; sc[512 + c] = -kk;
#pragma unroll
            for (int d = 0; d < 2; ++d) { const float wp = w0[d * 256 + c] + pre[(d * 16 + rl) * 256 + c], ap = a0[d * 256 + c] + pre[((2 + d) * 16 + rl) * 256 + c];
                const float nw = -wp, sp = fmaxf(nw, 0.f) + log1pf(__expf(-fabsf(nw)));
                const float lw = -__expf(-sp - 0.5f);
                const float as = sigmoidf_(ap);
                sc[(3 + 3 * d) * 256 + c] = lw; sc[(4 + 3 * d) * 256 + c] = k * (1.0f + (as - 1.0f) * kac); sc[(5 + 3 * d) * 256 + c] = kk * as; } }
    }
#undef LIN_FETCH
    __syncthreads();
}
constexpr int FP = 136;
constexpr int F_TABC = 0, F_TABS = 128 * FP * 2, F_TILE = 2 * 128 * FP * 2;
__device__ __forceinline__ void fourier_load_tables(const Ctx& C) {
    const bf16* ft = (const bf16*)(C.ws + WS_FTAB);
    for (int i = C.tid; i < 2 * 128 * 16; i += NTHR) { const int tb = i >> 11, r = (i >> 4) & 127, c8 = i & 15;
        *(LAS u32x4*)(C.lds + tb * F_TABS + (r * FP + 8 * c8) * 2) = *(const u32x4*)(ft + tb * 16384 + r * 128 + 8 * c8); }
}
__device__ __forceinline__ void mix1_fourier1(const Ctx& C) {
    const bf16* P = (const bf16*)(C.ws + WS_P); const float* tw = (const float*)(C.ws + WS_TW);
    bf16* FYR = (bf16*)(C.ws + WS_FYR); bf16* FYI = (bf16*)(C.ws + WS_FYI);
    const int lane = C.lane, li = lane & 15, g = lane >> 4, w = C.wave;
    __syncthreads();
    fourier_load_tables(C);
    for (int u = C.wg; u < 256; u += C.G) {
        const int t2 = u >> 1, ch0 = (u & 1) * 128;
        __syncthreads();
        for (int i = C.tid; i < 128 * 16; i += NTHR) { const int t1 = i >> 4, c8 = i & 15;
            *(LAS u32x4*)(C.lds + F_TILE + (t1 * FP + 8 * c8) * 2) = *(const u32x4*)(P + (size_t)(NCTX + 128 * t1 + t2) * INWP + C_BU + ch0 + 8 * c8); }
        __syncthreads();
        bf16x8 af[4];
#pragma unroll
        for (int ks = 0; ks < 4; ++ks) af[ks] = ldT(C.lds + F_TILE, FP, 32 * ks, 16 * w, li, g);
#pragma unroll 1
        for (int ni = 0; ni < 8; ++ni) { f32x4 dc = {0.f, 0.f, 0.f, 0.f}, ds = {0.f, 0.f, 0.f, 0.f};
#pragma unroll
            for (int ks = 0; ks < 4; ++ks) { dc = mfma16(af[ks], ldA(C.lds + F_TABC, FP, 16 * ni, 32 * ks, li, g), dc); ds = mfma16(af[ks], ldA(C.lds + F_TABS, FP, 16 * ni, 32 * ks, li, g), ds); }
            const int k1 = 16 * ni + li; const float cp = tw[t2 * k1], sp = tw[16384 + t2 * k1];
            const f32x4 yr = dc * cp - ds * sp, yi = -(ds * cp) - dc * sp;
            const size_t o = ((size_t)k1 * 128 + t2) * 256 + ch0 + 16 * w + 4 * g;
            u32x2 wr; wr.x = pk2(yr[0], yr[1]); wr.y = pk2(yr[2], yr[3]); *(u32x2*)(FYR + o) = wr;
            u32x2 wi; wi.x = pk2(yi[0], yi[1]); wi.y = pk2(yi[2], yi[3]); *(u32x2*)(FYI + o) = wi; }
    }
    __syncthreads();
}
__device__ __forceinline__ void fourier2_mfma(const Ctx& C, int l, int wg0) {
    const bf16* FYR = (const bf16*)(C.ws + WS_FYR); const bf16* FYI = (const bf16*)(C.ws + WS_FYI); bf16* MIX = (bf16*)(C.ws + WS_MIX);
    const int lane = C.lane, li = lane & 15, g = lane >> 4, w = C.wave;
    constexpr int YP = 72, F_YR = F_TILE, F_YI = F_TILE + 128 * YP * 2;
    __syncthreads();
    fourier_load_tables(C);
    for (int u = C.wg - wg0; u < 512; u += C.G - wg0) {
        const int k1 = u >> 2, gq = u & 3;
        __syncthreads();
        for (int i = C.tid; i < 2 * 128 * 8; i += NTHR) { const int im = i >> 10, t2 = (i >> 3) & 127, c8 = i & 7;
            *(LAS u32x4*)(C.lds + (im ? F_YI : F_YR) + (t2 * YP + 8 * c8) * 2) = *(const u32x4*)((im ? FYI : FYR) + ((size_t)k1 * 128 + t2) * 256 + gq * 64 + 8 * c8); }
        __syncthreads();
        bf16x8 bc[4], bs[4];
#pragma unroll
        for (int ks = 0; ks < 4; ++ks) { bc[ks] = ldA(C.lds + F_TABC, FP, 16 * w, 32 * ks, li, g); bs[ks] = ldA(C.lds + F_TABS, FP, 16 * w, 32 * ks, li, g); }
        f32x4 xr[4], xi[4];
#pragma unroll
        for (int ci = 0; ci < 4; ++ci) { xr[ci] = (f32x4){0.f, 0.f, 0.f, 0.f}; f32x4 xs = {0.f, 0.f, 0.f, 0.f}; xi[ci] = xs;
#pragma unroll
            for (int ks = 0; ks < 4; ++ks) { const bf16x8 ar = ldT(C.lds + F_YR, YP, 32 * ks, 16 * ci, li, g), ai = ldT(C.lds + F_YI, YP, 32 * ks, 16 * ci, li, g);
                xr[ci] = mfma16(ar, bc[ks], xr[ci]); xr[ci] = mfma16(ai, bs[ks], xr[ci]);
                xi[ci] = mfma16(ai, bc[ks], xi[ci]); xs = mfma16(ar, bs[ks], xs); }
            xi[ci] = xi[ci] - xs; }
        union { bf16x8 v; unsigned q[4]; } xb[4];
#pragma unroll
        for (int q2 = 0; q2 < 2; ++q2) { xb[q2].q[0] = pk2(xr[2 * q2][0], xr[2 * q2][1]); xb[q2].q[1] = pk2(xr[2 * q2][2], xr[2 * q2][3]); xb[q2].q[2] = pk2(xr[2 * q2 + 1][0], xr[2 * q2 + 1][1]); xb[q2].q[3] = pk2(xr[2 * q2 + 1][2], xr[2 * q2 + 1][3]);
            xb[2 + q2].q[0] = pk2(xi[2 * q2][0], xi[2 * q2][1]); xb[2 + q2].q[1] = pk2(xi[2 * q2][2], xi[2 * q2][3]); xb[2 + q2].q[2] = pk2(xi[2 * q2 + 1][0], xi[2 * q2 + 1][1]); xb[2 + q2].q[3] = pk2(xi[2 * q2 + 1][2], xi[2 * q2 + 1][3]); }
        const bf16x8* mf = (const bf16x8*)((const bf16*)(C.ws + WS_FTAB) + 32768) + (size_t)(l * 4 + gq) * 16 * 64;
#pragma unroll
        for (int ei = 0; ei < 4; ++ei) { f32x4 o = {0.f, 0.f, 0.f, 0.f};
#pragma unroll
            for (int ks2 = 0; ks2 < 4; ++ks2) o = mfma16(mf[(ei * 4 + ks2) * 64 + lane], xb[ks2].v, o);
            const int tp = k1 + 128 * (16 * w + li);
            u32x2 wo; wo.x = pk2(o[0], o[1]); wo.y = pk2(o[2], o[3]); *(u32x2*)(MIX + (size_t)(NCTX + tp) * DM + 256 + gq * 64 + 16 * ei + 4 * g) = wo; }
    }
    __syncthreads();
}

constexpr float LOG2E = 1.4426950408889634f;
typedef short bf16x4 __attribute__((ext_vector_type(4)));
__device__ __forceinline__ void attn_load(const bf16* P, const bf16* VT, int krow, int kcol, int li, int g, bf16x8 (&kf)[2][2], bf16x8 (&vf)[4]) {
#pragma unroll
    for (int t = 0; t < 2; ++t)
#pragma unroll
        for (int ks = 0; ks < 2; ++ks) kf[t][ks] = ldg8(P + (size_t)(krow + 16 * t + li) * INWP + kcol + 32 * ks + 8 * g);
#pragma unroll
    for (int dt = 0; dt < 4; ++dt) { const bf16* vp = VT + (size_t)(dt * 16 + li) * VTP + krow + 4 * g;
        const bf16x4 a = *(const bf16x4*)vp, b = *(const bf16x4*)(vp + 16); vf[dt] = (bf16x8){a[0], a[1], a[2], a[3], b[0], b[1], b[2], b[3]}; }
}
template <int NS, int NT>
__device__ __forceinline__ void attn_compute(const bf16x8 (&kf)[2][2], const bf16x8 (&vf)[4], const bf16x8 (&qf)[NS][2], f32x4 (&o)[NS][4], float (&m)[NS], float (&ls)[NS],
                                             const float (&add)[NT][2][4], int li, int g) {
#pragma unroll
    for (int hh = 0; hh < NS; ++hh) {
        f32x4 st[2];
#pragma unroll
        for (int t = 0; t < 2; ++t) { st[t] = (f32x4){0.f, 0.f, 0.f, 0.f};
#pragma unroll
            for (int ks = 0; ks < 2; ++ks) st[t] = __builtin_amdgcn_mfma_f32_16x16x32_bf16(kf[t][ks], qf[hh][ks], st[t], 0, 0, 0); }
        float s[8]; float bm = -INFINITY;
#pragma unroll
        for (int t = 0; t < 2; ++t)
#pragma unroll
            for (int r = 0; r < 4; ++r) { const float ad = add[hh / (NS / NT)][t][r]; s[4 * t + r] = (ad == -INFINITY) ? -INFINITY : st[t][r] * (0.125f * LOG2E) + ad; bm = fmaxf(bm, s[4 * t + r]); }
        bm = fmaxf(bm, shx(bm, 16, 16 * g + li)); bm = fmaxf(bm, shx(bm, 32, 16 * g + li));
        const float mn = fmaxf(m[hh], bm), corr = __builtin_amdgcn_exp2f(m[hh] - mn); m[hh] = mn;
        float ps = 0.f; float pe[8];
#pragma unroll
        for (int e = 0; e < 8; ++e) { pe[e] = __builtin_amdgcn_exp2f(s[e] - mn); ps += pe[e]; }
        ls[hh] = ls[hh] * corr + ps;
        union { bf16x8 v; unsigned u[4]; } pf;
#pragma unroll
        for (int e2 = 0; e2 < 4; ++e2) pf.u[e2] = pk2(pe[2 * e2], pe[2 * e2 + 1]);
#pragma unroll
        for (int dt = 0; dt < 4; ++dt) { o[hh][dt] = o[hh][dt] * corr; o[hh][dt] = __builtin_amdgcn_mfma_f32_16x16x32_bf16(vf[dt], pf.v, o[hh][dt], 0, 0, 0); }
    }
}
__device__ __forceinline__ void attn_finish1(bf16* MIX, int qrow0, int ocol, f32x4 (&o)[4], float m, float ls, bool has_sink, float sink2, int li, int g) {
    float l = ls; l += shx(l, 16, 16 * g + li); l += shx(l, 32, 16 * g + li);
    float corr = 1.f;
    if (has_sink) { const float mn = fmaxf(m, sink2); corr = __builtin_amdgcn_exp2f(m - mn); l = l * corr + __builtin_amdgcn_exp2f(sink2 - mn); }
    const float inv = corr / l;
#pragma unroll
    for (int dt = 0; dt < 4; ++dt) { const f32x4 v = o[dt] * inv; u32x2 w; w.x = pk2(v[0], v[1]); w.y = pk2(v[2], v[3]);
        *(u32x2*)(MIX + (size_t)(qrow0 + li) * DM + ocol + dt * 16 + 4 * g) = w; }
}
__device__ __forceinline__ void attnA_unit(const Ctx& C, const float* asink_l, int unit, bool lat) {
    const bf16* P = (const bf16*)(C.ws + WS_P); bf16* MIX = (bf16*)(C.ws + WS_MIX);
    const int li = C.lane & 15, g = C.lane >> 4;
    const int nqp = lat ? SEQ / 32 : NCTX / 32, kvh = unit / nqp, qp = unit % nqp, t0 = qp * 32, qrow0 = (lat ? NCTX : 0) + t0;
    const bf16* VT = (const bf16*)(C.ws + WS_VTA) + (size_t)kvh * 64 * VTP; const int kcol = C_AK + kvh * 64;
    bf16x8 qf[4][2];
#pragma unroll
    for (int s = 0; s < 4; ++s)
#pragma unroll
        for (int ks = 0; ks < 2; ++ks) qf[s][ks] = ldg8(P + (size_t)(qrow0 + 16 * (s >> 1) + li) * INWP + C_AQ + (kvh * 2 + (s & 1)) * 64 + 32 * ks + 8 * g);
    f32x4 o[4][4]; float m[4], ls[4];
#pragma unroll
    for (int s = 0; s < 4; ++s) { m[s] = -1.0e30f; ls[s] = 0.f;
#pragma unroll
        for (int dt = 0; dt < 4; ++dt) o[s][dt] = (f32x4){0.f, 0.f, 0.f, 0.f}; }
    const int b_lo = lat ? 0 : 9;
#pragma unroll 1
    for (int bb = b_lo; bb < 17; ++bb) { float add[2][2][4]; bf16x8 kf[2][2], vf[4];
        const int krow = (bb < 9) ? NCTX + t0 - 128 + 32 * bb : 32 * (bb - 9);
        attn_load(P, VT, krow, kcol, li, g, kf, vf);
#pragma unroll
        for (int tl = 0; tl < 2; ++tl)
#pragma unroll
            for (int tt = 0; tt < 2; ++tt)
#pragma unroll
                for (int r = 0; r < 4; ++r) { const int j = t0 - 128 + 32 * bb + 16 * tt + 4 * g + r, t = t0 + 16 * tl + li;
                    const bool ok = (bb >= 9) || ((j >= 0) && (j < SEQ) && (j - t <= 128) && (t - j <= 128)); add[tl][tt][r] = ok ? 0.f : -INFINITY; }
        attn_compute<4, 2>(kf, vf, qf, o, m, ls, add, li, g); }
#pragma unroll
    for (int s = 0; s < 4; ++s) attn_finish1(MIX, qrow0 + 16 * (s >> 1), (kvh * 2 + (s & 1)) * 64, o[s], m[s], ls[s], true, asink_l[kvh * 2 + (s & 1)] * LOG2E, li, g);
}
__device__ __forceinline__ void attnC_unit(const Ctx& C, const LAS float* relb, int h, int up, bool lat) {
    const bf16* P = (const bf16*)(C.ws + WS_P); bf16* MIX = (bf16*)(C.ws + WS_MIX);
    const int li = C.lane & 15, g = C.lane >> 4;
    const int rp = up >> 2, cj = up & 3;
    const int t0a = lat ? (2 * rp) * 64 + 16 * cj : 32 * up, tstep = lat ? 64 : 16, qbase = lat ? NCTX : 0;
    const bf16* VT = (const bf16*)(C.ws + WS_VTC) + (size_t)h * 64 * VTP; const int kcol = C_CK + h * 64;
    bf16x8 qf[2][2];
#pragma unroll
    for (int s = 0; s < 2; ++s)
#pragma unroll
        for (int ks = 0; ks < 2; ++ks) qf[s][ks] = ldg8(P + (size_t)(qbase + t0a + tstep * s + li) * INWP + C_CQ + h * 64 + 32 * ks + 8 * g);
    f32x4 o[2][4]; float m[2] = {-1.0e30f, -1.0e30f}, ls[2] = {0.f, 0.f};
#pragma unroll
    for (int s = 0; s < 2; ++s)
#pragma unroll
        for (int dt = 0; dt < 4; ++dt) o[s][dt] = (f32x4){0.f, 0.f, 0.f, 0.f};
    const int r = 2 * rp, cq = cj * 16 + li;
    int r0a = r - 4; r0a = r0a < 0 ? 0 : (r0a > 248 ? 248 : r0a); int r0b = r - 3; r0b = r0b < 0 ? 0 : (r0b > 248 ? 248 : r0b);
    int c0 = cq - 8; c0 = c0 < 0 ? 0 : (c0 > 48 ? 48 : c0);
    const int cw0 = (cj == 0) ? 0 : (cj == 1) ? 8 : (cj == 2) ? 24 : 32;
    const int b_lo = lat ? 0 : 9;
#pragma unroll 1
    for (int bb = b_lo; bb < 17; ++bb) { float add[2][2][4]; bf16x8 kf[2][2], vf[4];
        const int kr = r0a + bb;
        if (bb < 9 && kr >= r0b + 8) continue;
        const int krow = (bb < 9) ? NCTX + kr * 64 + cw0 : 32 * (bb - 9);
        attn_load(P, VT, krow, kcol, li, g, kf, vf);
#pragma unroll
        for (int tl = 0; tl < 2; ++tl) { const int r0t = tl ? r0b : r0a, rt = r + tl; const bool rowok = (bb >= 9) || (kr >= r0t && kr < r0t + 8);
            int bi = kr - rt + 7; bi = bi < 0 ? 0 : (bi > 14 ? 14 : bi); const LAS float* rbp = relb + bi * 31;
#pragma unroll
            for (int tt = 0; tt < 2; ++tt)
#pragma unroll
                for (int rr = 0; rr < 4; ++rr) { const int kc = cw0 + 16 * tt + 4 * g + rr; int ci = kc - cq + 15; ci = ci < 0 ? 0 : (ci > 30 ? 30 : ci); const float bv = rbp[ci];
                    add[tl][tt][rr] = (bb >= 9) ? 0.f : ((rowok && kc >= c0 && kc < c0 + 16) ? bv : -INFINITY); } }
        attn_compute<2, 2>(kf, vf, qf, o, m, ls, add, li, g); }
#pragma unroll
    for (int s = 0; s < 2; ++s) attn_finish1(MIX, qbase + t0a + tstep * s, 512 + h * 64, o[s], m[s], ls[s], false, 0.f, li, g);
}
__device__ __forceinline__ void fourier_ctx_mfma(const Ctx& C, int l, int wg0) {
    const bf16* P = (const bf16*)(C.ws + WS_P); bf16* MIX = (bf16*)(C.ws + WS_MIX); const bf16* f2 = (const bf16*)(C.ws + WS_F256);
    const int lane = C.lane, li = lane & 15, g = lane >> 4, w = C.wave;
    constexpr int UP = 72;
    for (int u = C.wg - wg0; u < 8; u += C.G - wg0) {
        const int tb = u >> 2, gq = u & 3;
        __syncthreads();
        for (int i = C.tid; i < 256 * 8; i += NTHR) { const int t = i >> 3, c8 = i & 7; *(LAS u32x4*)(C.lds + (t * UP + 8 * c8) * 2) = *(const u32x4*)(P + (size_t)t * INWP + C_BU + gq * 64 + 8 * c8); }
        __syncthreads();
        const int tp0 = 128 * tb + 16 * w;
        f32x4 xr[4], xi[4];
#pragma unroll
        for (int ci = 0; ci < 4; ++ci) { xr[ci] = (f32x4){0.f, 0.f, 0.f, 0.f}; xi[ci] = (f32x4){0.f, 0.f, 0.f, 0.f}; }
#pragma unroll 2
        for (int ks = 0; ks < 8; ++ks) { const bf16x8 bc = ldg8(f2 + (size_t)(tp0 + li) * 256 + 32 * ks + 8 * g), bs = ldg8(f2 + 65536 + (size_t)(tp0 + li) * 256 + 32 * ks + 8 * g);
#pragma unroll
            for (int ci = 0; ci < 4; ++ci) { const bf16x8 au = ldT(C.lds, UP, 32 * ks, 16 * ci, li, g); xr[ci] = mfma16(au, bc, xr[ci]); xi[ci] = mfma16(au, bs, xi[ci]); } }
        union { bf16x8 v; unsigned q[4]; } xb[4];
#pragma unroll
        for (int q2 = 0; q2 < 2; ++q2) { xb[q2].q[0] = pk2(xr[2 * q2][0], xr[2 * q2][1]); xb[q2].q[1] = pk2(xr[2 * q2][2], xr[2 * q2][3]); xb[q2].q[2] = pk2(xr[2 * q2 + 1][0], xr[2 * q2 + 1][1]); xb[q2].q[3] = pk2(xr[2 * q2 + 1][2], xr[2 * q2 + 1][3]);
            xb[2 + q2].q[0] = pk2(-xi[2 * q2][0], -xi[2 * q2][1]); xb[2 + q2].q[1] = pk2(-xi[2 * q2][2], -xi[2 * q2][3]); xb[2 + q2].q[2] = pk2(-xi[2 * q2 + 1][0], -xi[2 * q2 + 1][1]); xb[2 + q2].q[3] = pk2(-xi[2 * q2 + 1][2], -xi[2 * q2 + 1][3]); }
        const bf16x8* mf = (const bf16x8*)((const bf16*)(C.ws + WS_FTAB) + 32768) + (size_t)(l * 4 + gq) * 16 * 64;
#pragma unroll
        for (int ei = 0; ei < 4; ++ei) { f32x4 o = {0.f, 0.f, 0.f, 0.f};
#pragma unroll
            for (int ks2 = 0; ks2 < 4; ++ks2) o = mfma16(mf[(ei * 4 + ks2) * 64 + lane], xb[ks2].v, o);
            o = o * 8.0f;
            u32x2 wo; wo.x = pk2(o[0], o[1]); wo.y = pk2(o[2], o[3]); *(u32x2*)(MIX + (size_t)(tp0 + li) * DM + 256 + gq * 64 + 16 * ei + 4 * g) = wo; }
    }
    __syncthreads();
}
__device__ __forceinline__ void fourier2_unit(const Ctx& C, int l, int u, bool ctx) {
    const bf16* P = (const bf16*)(C.ws + WS_P); const float* tw = (const float*)(C.ws + WS_TW); bf16* MIX = (bf16*)(C.ws + WS_MIX);
    const float* FYR = (const float*)(C.ws + WS_FYR); const float* FYI = (const float*)(C.ws + WS_FYI);
    const float* mt = (const float*)(C.ws + WS_MTAB) + (size_t)l * 2 * 4 * 4096;
    LAS float* xr = (LAS float*)(C.lds + 8192); LAS float* xi = xr + 512;
    const int tl = C.tid >> 8, ch = C.tid & 255, tp = 2 * u + tl;
    float sr = 0.f, si = 0.f;
    if (!ctx) { const int k1 = tp & 127, k2 = tp >> 7; const float* yr = FYR + (size_t)k1 * 128 * 256 + ch; const float* yi = FYI + (size_t)k1 * 128 * 256 + ch;
#pragma unroll 8
        for (int t2 = 0; t2 < 128; ++t2) { const int m = ((t2 * k2) & 127) * 128; const float c = tw[m], s = tw[16384 + m]; const float a = yr[t2 * 256], b = yi[t2 * 256]; sr += a * c + b * s; si += b * c - a * s; } }
    else {
#pragma unroll 8
        for (int t = 0; t < NCTX; ++t) { const int m = ((t * tp) & 255) * 64; const float x = bf2f(P[(size_t)t * INWP + C_BU + ch]); sr += x * tw[m]; si -= x * tw[16384 + m]; } }
    __syncthreads();
    xr[tl * 256 + ch] = sr; xi[tl * 256 + ch] = si;
    __syncthreads();
    const int g = ch >> 6, e = ch & 63; const float* mc = mt + (size_t)(0 * 4 + g) * 4096 + e; const float* ms = mt + (size_t)(1 * 4 + g) * 4096 + e;
    const LAS float* xrp = xr + tl * 256 + g * 64; const LAS float* xip = xi + tl * 256 + g * 64; float o = 0.f;
#pragma unroll 8
    for (int c = 0; c < 64; ++c) o += xrp[c] * mc[c * 64] + xip[c] * ms[c * 64];
    o *= ctx ? (1.0f / 128.0f) : (1.0f / 1024.0f);
    MIX[(size_t)((ctx ? 0 : NCTX) + tp) * DM + 256 + ch] = (bf16)f2bf(o);
}
__device__ __forceinline__ void rwkv_passB(const Ctx& C, int b);
__device__ __forceinline__ void phase_mix2(const Ctx& C, const DArgs& a, int l) {
    const bool emit_ctx = l < DEPTH - 1;
#ifndef REPMASK
#define REPMASK 0
#endif
#define NREP2(o) ((((REPMASK) >> (o)) & 1) ? 2 : 1)
    if (C.wg < 8) { for (int r2 = 0; r2 < NREP2(16); ++r2) rwkv_passB(C, C.wg); }
    else if (emit_ctx) fourier_ctx_mfma(C, l, 8);
    { const float* asink_l = a.in[I_ASINK] + l * 4; const float* crel = a.in[I_CREL] + (size_t)l * 4 * 465;
      LAS float* relb = (LAS float*)(C.lds + 110592 + C.wave * 2048);
      for (int r2 = 0; r2 < NREP2(17); ++r2) {
      unsigned* qhead = (unsigned*)(C.ws + WS_CTL) + CW_WQ + 64 * l + 16 * r2;
      const int nA = 2 * (SEQ / 32), nC = 4 * (SEQ / 32), nAc = emit_ctx ? 2 * (NCTX / 32) : 0, nCc = emit_ctx ? 4 * (NCTX / 32) : 0, nAll = nA + nAc + nC + nCc;
      int hcur = -1;
      const int nCv = emit_ctx ? CV_NCHUNK : 0;
      for (;;) { unsigned uq = 0; if (C.lane == 0) uq = __hip_atomic_fetch_add(qhead, 1u, __ATOMIC_RELAXED, __HIP_MEMORY_SCOPE_AGENT);
          const int uraw = __builtin_amdgcn_readfirstlane((int)uq); if (uraw >= nAll + nCv) break;
          int u;
          if (uraw < 2 * nCv) { if (uraw & 1) { const int ch = uraw >> 1; convert_moe_items(C, a, l + 1, ch * CV_CHUNK, ch * CV_CHUNK + CV_CHUNK); continue; } u = uraw >> 1; }
          else u = uraw - nCv;
          if (u < nA) attnA_unit(C, asink_l, u, true);
          else if (u < nA + nAc) attnA_unit(C, asink_l, u - nA, false);
          else { const int uc = u - nA - nAc; const bool lat = uc < nC; const int uu = lat ? uc : uc - nC, nqt = lat ? SEQ / 32 : NCTX / 32, h = uu / nqt, qt = uu % nqt;
              if (h != hcur) { for (int i = C.lane; i < 465; i += 64) relb[i] = crel[h * 465 + i] * LOG2E; hcur = h; LDS_WAIT(); asm volatile("" ::: "memory"); }
              attnC_unit(C, relb, h, qt, lat); } } } }
    __syncthreads();
    for (int r2 = 0; r2 < NREP2(19); ++r2) fourier2_mfma(C, l, 0);
}

constexpr int RW_C = 32, RW_NCH = ROWS / RW_C, RW_SC = 20, RW_NSC = RW_NCH / RW_SC;
constexpr int RW_SLOT = 5120, RW_REGION = 9 * RW_SLOT + 1024;
constexpr int TP = 72, HP = 40;
static_assert(3 * RW_REGION <= MISC_OFF, "RWKV D1 regions below the misc area");
__device__ __forceinline__ int rw_rc_of(int d, int c) { return d == 0 ? c : (c < 8 ? 7 - c : 527 - c); }
__device__ __forceinline__ int rw_row_of(int d, int rc, int t) { return 32 * rc + (d == 0 ? t : 31 - t); }

__device__ __forceinline__ void rwkv_d1(const Ctx& C, LAS unsigned char* rb, int d, int h, int rc) {
    int lane_ = C.lane; asm volatile("" : "+v"(lane_));
    const int lane = lane_, li = lane & 15, g = lane >> 4;
    const float* SC = (const float*)(C.ws + WS_SC);
    LAS unsigned char* S0 = rb; LAS unsigned char* S1 = rb + RW_SLOT; LAS unsigned char* S2 = rb + 2 * RW_SLOT; LAS unsigned char* S3 = rb + 3 * RW_SLOT; LAS unsigned char* S4 = rb + 4 * RW_SLOT;
    LAS unsigned char* S5 = rb + 5 * RW_SLOT; LAS unsigned char* S6 = rb + 6 * RW_SLOT; LAS unsigned char* S7 = rb + 7 * RW_SLOT; LAS unsigned char* S8 = rb + 8 * RW_SLOT;
    LAS unsigned char* S6b = S6 + 2560; LAS unsigned char* S7b = S7 + 2560;
    LAS float* gc = (LAS float*)(rb + 9 * RW_SLOT);
    { float cum = 0.f; const int j = lane; const int qw = (3 + 3 * d) * 256;
      float rv[2][4], vv[2][4], av[2][4], lw[2][4], kd[2][4], bb[2][4];
#define RW_LD(buf, t0) do { _Pragma("unroll") for (int u = 0; u < 4; ++u) { const float* sc = SC + (size_t)rw_row_of(d, rc, (t0) + u) * 9 * 256 + h * 64 + j; \
          rv[buf][u] = sc[0]; vv[buf][u] = sc[256]; av[buf][u] = sc[512]; lw[buf][u] = sc[qw]; kd[buf][u] = sc[qw + 256]; bb[buf][u] = sc[qw + 512]; } } while (0)
#define RW_CP(buf, t0) do { _Pragma("unroll") for (int u = 0; u < 4; ++u) { const float cp = cum; cum += lw[buf][u]; const float Gt = __expf(cum), Gm = __expf(cp), iG = __expf(-cum); const int off = (((t0) + u) * TP + j) * 2; \
          *(LAS bf16*)(S0 + off) = (bf16)f2bf(av[buf][u] * Gm); *(LAS bf16*)(S1 + off) = (bf16)f2bf(rv[buf][u] * Gt); *(LAS bf16*)(S2 + off) = (bf16)f2bf(bb[buf][u] * iG); \
          *(LAS bf16*)(S3 + off) = (bf16)f2bf(kd[buf][u] * iG); *(LAS bf16*)(S4 + off) = (bf16)f2bf(vv[buf][u]); } } while (0)
      RW_LD(0, 0);
#pragma unroll
      for (int b2 = 0; b2 < 4; ++b2) { RW_LD(1, 8 * b2 + 4); __builtin_amdgcn_sched_barrier(0); RW_CP(0, 8 * b2); if (b2 < 3) RW_LD(0, 8 * b2 + 8); __builtin_amdgcn_sched_barrier(0); RW_CP(1, 8 * b2 + 4); }
#undef RW_LD
#undef RW_CP
      gc[j] = __expf(cum); }
    const f32x4 z4 = {0.f, 0.f, 0.f, 0.f};
#pragma unroll 1
    for (int ti = 0; ti < 2; ++ti)
#pragma unroll 1
        for (int si = 0; si < 2; ++si) {
            f32x4 n = z4, nt = z4, mk = z4, qb = z4, qk = z4;
#pragma unroll
            for (int ks = 0; ks < 2; ++ks) { const bf16x8 at = ldA(S0, TP, 16 * ti, 32 * ks, li, g), rt = ldA(S1, TP, 16 * ti, 32 * ks, li, g), bs = ldA(S2, TP, 16 * si, 32 * ks, li, g), kss = ldA(S3, TP, 16 * si, 32 * ks, li, g);
                n = mfma16(at, bs, n);
                nt = mfma16(bs, at, nt);
                mk = mfma16(kss, at, mk);
                qb = mfma16(bs, rt, qb);
                qk = mfma16(kss, rt, qk); }
#pragma unroll
            for (int r = 0; r < 4; ++r) { const int trow = 16 * ti + 4 * g + r, scol = 16 * si + li; if (!(scol < trow)) n[r] = 0.f;
                const int srow = 16 * si + 4 * g + r, tcol = 16 * ti + li; if (!(srow < tcol)) { mk[r] = 0.f; nt[r] = 0.f; } if (!(srow <= tcol)) { qb[r] = 0.f; qk[r] = 0.f; } }
            *(LAS f32x4*)(S5 + ((16 * si + li) * 32 + 16 * ti + 4 * g) * 4) = n;
            stT(S6, HP, 16 * ti + li, 16 * si + 4 * g, mk);
            stT(S8, HP, 16 * ti + li, 16 * si + 4 * g, nt);
            stT(S6b, HP, 16 * ti + li, 16 * si + 4 * g, qb);
            stT(S7, HP, 16 * ti + li, 16 * si + 4 * g, qk); }
    { const int rr = lane & 31, bq = rr >> 4, lr = rr & 15; float Tr[16];
#pragma unroll
      for (int s = 15; s >= 0; --s) { float acc = (lr == s) ? 1.f : 0.f;
#pragma unroll
          for (int c4 = 0; c4 < 4; ++c4) { if (4 * c4 + 3 > s) { const f32x4 nv = *(const LAS f32x4*)(S5 + ((16 * bq + s) * 32 + 16 * bq + 4 * c4) * 4);
#pragma unroll
              for (int e = 0; e < 4; ++e) if (4 * c4 + e > s) acc += Tr[4 * c4 + e] * nv[e]; } }
          Tr[s] = acc; }
      if (lane < 32) { u32x4 w0, w1; w0.x = pk2(Tr[0], Tr[1]); w0.y = pk2(Tr[2], Tr[3]); w0.z = pk2(Tr[4], Tr[5]); w0.w = pk2(Tr[6], Tr[7]); w1.x = pk2(Tr[8], Tr[9]); w1.y = pk2(Tr[10], Tr[11]); w1.z = pk2(Tr[12], Tr[13]); w1.w = pk2(Tr[14], Tr[15]);
          const u32x4 zz = {0u, 0u, 0u, 0u}; LAS u32x4* trow = (LAS u32x4*)(S7b + rr * HP * 2);
          trow[0] = bq ? zz : w0; trow[1] = bq ? zz : w1; trow[2] = bq ? w0 : zz; trow[3] = bq ? w1 : zz; }
      f32x4 x = mfma16(ldA(S8, HP, 16, 0, li, g), ldT(S7b, HP, 0, 0, li, g), z4);
      LAS unsigned char* XT = S8 + 2560;
      *(LAS u32x2*)(XT + (li * HP + 4 * g) * 2) = (u32x2){0u, 0u}; stT(XT, HP, li, 16 + 4 * g, x);
      const f32x4 t21 = mfma16(ldA(S7b, HP, 16, 0, li, g), ldA(XT, HP, 0, 0, li, g), z4);
#pragma unroll
      for (int r = 0; r < 4; ++r) *(LAS bf16*)(S7b + ((16 + 4 * g + r) * HP + li) * 2) = (bf16)f2bf(t21[r]); }
#pragma unroll 1
    for (int ti = 0; ti < 2; ++ti) { const bf16x8 tf = ldA(S7b, HP, 16 * ti, 0, li, g), mf = ldA(S6, HP, 16 * ti, 0, li, g);
#pragma unroll
        for (int ji = 0; ji < 4; ++ji) { const f32x4 ap = mfma16(tf, ldT(S0, TP, 0, 16 * ji, li, g), z4); stT(S8, HP, 16 * ji + li, 16 * ti + 4 * g, ap);
            const f32x4 mv = mfma16(mf, ldT(S4, TP, 0, 16 * ji, li, g), z4); stT(S5, HP, 16 * ji + li, 16 * ti + 4 * g, mv); } }
#pragma unroll 1
    for (int ti = 0; ti < 2; ++ti) { const bf16x8 tf = ldA(S7b, HP, 16 * ti, 0, li, g);
#pragma unroll
        for (int vi = 0; vi < 4; ++vi) { const f32x4 ul = mfma16(tf, ldA(S5, HP, 16 * vi, 0, li, g), z4); stT(S0, HP, 16 * vi + li, 16 * ti + 4 * g, ul); } }
#pragma unroll 1
    for (int ti = 0; ti < 2; ++ti) { const bf16x8 qbf = ldA(S6b, HP, 16 * ti, 0, li, g), qkf = ldA(S7, HP, 16 * ti, 0, li, g);
#pragma unroll
        for (int ji = 0; ji < 4; ++ji) { f32x4 rp = mfma16(ldA(S8, HP, 16 * ji, 0, li, g), qbf, z4);
            LAS unsigned char* p = S1 + ((16 * ti + li) * TP + 16 * ji + 4 * g) * 2; rp = rp + ld4bf(p); u32x2 w; w.x = pk2(rp[0], rp[1]); w.y = pk2(rp[2], rp[3]); *(LAS u32x2*)p = w;
            f32x4 yl = mfma16(qbf, ldA(S0, HP, 16 * ji, 0, li, g), z4); yl = mfma16(qkf, ldT(S4, TP, 0, 16 * ji, li, g), yl);
            stT(S5, HP, 16 * ji + li, 16 * ti + 4 * g, yl); } }
#pragma unroll 1
    for (int ji = 0; ji < 4; ++ji) { const bf16x8 bt = ldT(S2, TP, 0, 16 * ji, li, g); const float gj = gc[16 * ji + li];
#pragma unroll
        for (int jp = 0; jp < 4; ++jp) { f32x4 pt = mfma16(ldA(S8, HP, 16 * jp, 0, li, g), bt, z4);
#pragma unroll
            for (int r = 0; r < 4; ++r) pt[r] = pt[r] * gj + ((16 * jp + 4 * g + r == 16 * ji + li) ? gj : 0.f);
            stT(S6, TP, 16 * ji + li, 16 * jp + 4 * g, pt); } }
#pragma unroll 1
    for (int vh = 0; vh < 2; ++vh) { f32x4 lt[4][2];
#pragma unroll
      for (int ji = 0; ji < 4; ++ji) { const bf16x8 ba = ldT(S2, TP, 0, 16 * ji, li, g), ka = ldT(S3, TP, 0, 16 * ji, li, g); const f32x4 gv = *(const LAS f32x4*)(gc + 16 * ji + 4 * g);
#pragma unroll
          for (int v2 = 0; v2 < 2; ++v2) { const int vi = 2 * vh + v2; f32x4 x = mfma16(ba, ldA(S0, HP, 16 * vi, 0, li, g), z4); x = mfma16(ka, ldT(S4, TP, 0, 16 * vi, li, g), x); lt[ji][v2] = x * gv; } }
      asm volatile("s_waitcnt lgkmcnt(0)" ::: "memory");
      LAS unsigned char* dst = vh ? S2 : S8;
#pragma unroll
      for (int ji = 0; ji < 4; ++ji)
#pragma unroll
          for (int v2 = 0; v2 < 2; ++v2) stT(dst, TP, 16 * v2 + li, 16 * ji + 4 * g, lt[ji][v2]); }
}
__device__ __forceinline__ void rwkv_passA_step(const Ctx& C, const LAS unsigned char* rb, f32x4 (&hs)[4], int d, int h, int rc) {
    int lane_ = C.lane; asm volatile("" : "+v"(lane_));
    const int lane = lane_, li = lane & 15, g = lane >> 4; const bool isPhi = C.wave >= 4; const int col = 16 * (C.wave & 3) + li;
    const LAS unsigned char* S1 = rb + RW_SLOT; const LAS unsigned char* S2 = rb + 2 * RW_SLOT; const LAS unsigned char* S5 = rb + 5 * RW_SLOT; const LAS unsigned char* S6 = rb + 6 * RW_SLOT;
    const LAS unsigned char* LTb = (col < 32) ? rb + 8 * RW_SLOT + col * TP * 2 : S2 + (col - 32) * TP * 2;
    union { bf16x8 v; unsigned u[4]; } bf[2];
#pragma unroll
    for (int ks = 0; ks < 2; ++ks) { bf[ks].u[0] = pk2(hs[2 * ks][0], hs[2 * ks][1]); bf[ks].u[1] = pk2(hs[2 * ks][2], hs[2 * ks][3]); bf[ks].u[2] = pk2(hs[2 * ks + 1][0], hs[2 * ks + 1][1]); bf[ks].u[3] = pk2(hs[2 * ks + 1][2], hs[2 * ks + 1][3]); }
#pragma unroll
    for (int ti = 0; ti < 2; ++ti) { f32x4 acc = isPhi ? (f32x4){0.f, 0.f, 0.f, 0.f} : ld4bf(S5 + (col * HP + 16 * ti + 4 * g) * 2);
#pragma unroll
        for (int ks = 0; ks < 2; ++ks) acc = mfma16(ldAperm(S1, TP, 16 * ti, ks, li, g), bf[ks].v, acc);
        if (!isPhi) { float* ys = (float*)(C.ws + WS_YS) + (size_t)d * ROWS * 256 + h * 64 + col;
#pragma unroll
            for (int r = 0; r < 4; ++r) ys[(size_t)rw_row_of(d, rc, 16 * ti + 4 * g + r) * 256] = acc[r]; }
        else { bf16* rp = (bf16*)(C.ws + WS_RPP) + ((size_t)((d * 4 + h) * RW_NCH + rc) * 32) * 64 + col;
#pragma unroll
            for (int r = 0; r < 4; ++r) rp[(16 * ti + 4 * g + r) * 64] = (bf16)f2bf(acc[r]); } }
    f32x4 hn[4];
#pragma unroll
    for (int i = 0; i < 4; ++i) { f32x4 acc = isPhi ? (f32x4){0.f, 0.f, 0.f, 0.f} : ld4bf(LTb + (16 * i + 4 * g) * 2);
#pragma unroll
        for (int ks = 0; ks < 2; ++ks) acc = mfma16(ldAperm(S6, TP, 16 * i, ks, li, g), bf[ks].v, acc);
        hn[i] = acc; }
#pragma unroll
    for (int i = 0; i < 4; ++i) hs[i] = hn[i];
}
__device__ __forceinline__ void phase_rwkv1(const Ctx& C) {
    const int lane = C.lane, li = lane & 15, g = lane >> 4;
    for (int u = C.wg; u < 8 * RW_NSC; u += C.G) {
        const int s = u % RW_NSC, dh = u / RW_NSC, d = dh >> 2, h = dh & 3; const bool isPhi = C.wave >= 4; const int col = 16 * (C.wave & 3) + li;
        f32x4 hs[4];
#pragma unroll
        for (int i = 0; i < 4; ++i)
#pragma unroll
            for (int r = 0; r < 4; ++r) hs[i][r] = (isPhi && (16 * i + 4 * g + r == col)) ? 1.f : 0.f;
#pragma unroll 1
        for (int rnd = 0; rnd < (RW_SC + 2) / 3; ++rnd) {
            __syncthreads();
            { int wv = C.wave; asm volatile("" : "+s"(wv)); if (wv < 3 && 3 * rnd + wv < RW_SC) rwkv_d1(C, C.lds + wv * RW_REGION, d, h, rw_rc_of(d, s * RW_SC + 3 * rnd + wv)); }
            __syncthreads();
#pragma unroll 1
            for (int k = 0; k < 3; ++k) { const int ci = 3 * rnd + k; int ko = k * RW_REGION; asm volatile("" : "+s"(ko)); if (ci < RW_SC) rwkv_passA_step(C, C.lds + ko, hs, d, h, rw_rc_of(d, s * RW_SC + ci)); }
        }
        if (isPhi) { bf16* pf = (bf16*)(C.ws + WS_PSC) + (size_t)(dh * RW_NSC + s) * 4096;
            const int ks = col >> 5, eh = (col >> 4) & 1, gp = (col >> 2) & 3, el = col & 3;
#pragma unroll
            for (int i = 0; i < 4; ++i)
#pragma unroll
                for (int r = 0; r < 4; ++r) pf[((i * 2 + ks) * 64 + gp * 16 + 4 * g + r) * 8 + eh * 4 + el] = (bf16)f2bf(hs[i][r]); }
        else { f32x4* lf = (f32x4*)(C.ws + WS_LSC) + ((size_t)(dh * RW_NSC + s) * 4 + C.wave) * 4 * 64;
#pragma unroll
            for (int i = 0; i < 4; ++i) lf[i * 64 + lane] = hs[i]; }
    }
    __syncthreads();
}
__device__ __forceinline__ void rwkv_passB(const Ctx& C, int b) {
    if (C.wave >= 4) return;
    const int lane = C.lane, li = lane & 15, g = lane >> 4, q = C.wave;
    f32x4 hs[4];
#pragma unroll
    for (int i = 0; i < 4; ++i) hs[i] = (f32x4){0.f, 0.f, 0.f, 0.f};
    const bf16x8* pfb = (const bf16x8*)((const bf16*)(C.ws + WS_PSC) + (size_t)b * RW_NSC * 4096);
    const f32x4* lfb = (const f32x4*)(C.ws + WS_LSC) + ((size_t)b * RW_NSC * 4 + q) * 4 * 64;
    bf16x8 pa[8]; f32x4 la[4];
#pragma unroll
    for (int k = 0; k < 8; ++k) pa[k] = pfb[k * 64 + lane];
#pragma unroll
    for (int i = 0; i < 4; ++i) la[i] = lfb[i * 64 + lane];
#pragma unroll 1
    for (int s = 0; s < RW_NSC; ++s) {
        bf16* hp = (bf16*)(C.ws + WS_HSC) + ((size_t)(b * RW_NSC + s) * 64 + 16 * q + li) * 64;
#pragma unroll
        for (int i = 0; i < 4; ++i) { u32x2 w; w.x = pk2(hs[i][0], hs[i][1]); w.y = pk2(hs[i][2], hs[i][3]); *(u32x2*)(hp + 16 * i + 4 * g) = w; }
        bf16x8 pn[8]; f32x4 ln[4]; const int sn = (s + 1 < RW_NSC) ? s + 1 : s;
#pragma unroll
        for (int k = 0; k < 8; ++k) pn[k] = pfb[(size_t)sn * 512 + k * 64 + lane];
#pragma unroll
        for (int i = 0; i < 4; ++i) ln[i] = lfb[(size_t)sn * 4 * 4 * 64 + i * 64 + lane];
        union { bf16x8 v; unsigned u[4]; } bf[2];
#pragma unroll
        for (int ks = 0; ks < 2; ++ks) { bf[ks].u[0] = pk2(hs[2 * ks][0], hs[2 * ks][1]); bf[ks].u[1] = pk2(hs[2 * ks][2], hs[2 * ks][3]); bf[ks].u[2] = pk2(hs[2 * ks + 1][0], hs[2 * ks + 1][1]); bf[ks].u[3] = pk2(hs[2 * ks + 1][2], hs[2 * ks + 1][3]); }
#pragma unroll
        for (int i = 0; i < 4; ++i) { f32x4 acc = la[i];
#pragma unroll
            for (int ks = 0; ks < 2; ++ks) acc = mfma16(pa[i * 2 + ks], bf[ks].v, acc);
            hs[i] = acc; }
#pragma unroll
        for (int k = 0; k < 8; ++k) pa[k] = pn[k];
#pragma unroll
        for (int i = 0; i < 4; ++i) la[i] = ln[i];
    }
}
__device__ __forceinline__ void phase_mix3(const Ctx& C, const DArgs& a, int l) {
    const bf16* P = (const bf16*)(C.ws + WS_P); const float* SC = (const float*)(C.ws + WS_SC); const float* YS = (const float*)(C.ws + WS_YS); bf16* MIX = (bf16*)(C.ws + WS_MIX);
    LAS float* yt = (LAS float*)(C.lds);
    constexpr int GSP = 168;
    LAS unsigned char* gsig = C.lds + 32768;
    LAS float* gm = (LAS float*)(C.lds + 40960);
    const bf16* g2t = (const bf16*)(C.ws + WS_G2T) + (size_t)l * 256 * 160;
    const float* rk = a.in[I_DRK] + (size_t)l * 256; const float* lnw = a.in[I_DLNW] + (size_t)l * 256; const float* lnb = a.in[I_DLNB] + (size_t)l * 256;
    const int lane = C.lane, li = lane & 15, g = lane >> 4, h = C.wave & 3, d = C.wave >> 2;
    const int half = C.tid >> 8, c = C.tid & 255;
    const int u_lo = (l == DEPTH - 1) ? NCTX / 16 : 0;
    bf16 glv[5];
#define GL_FETCH(uu) do { _Pragma("unroll") for (int k = 0; k < 5; ++k) { const int i = C.tid + NTHR * k, t = i / 160, ii = i % 160; glv[k] = P[(size_t)(16 * (uu) + t) * INWP + C_GL + ii]; } } while (0)
    if (u_lo + C.wg < ROWS / 16) GL_FETCH(u_lo + C.wg);
    for (int u = u_lo + C.wg; u < ROWS / 16; u += C.G) {
        const int rc = u >> 1, th = u & 1, rowb = 16 * u;
        __syncthreads();
#pragma unroll
        for (int k = 0; k < 5; ++k) { const int i = C.tid + NTHR * k, t = i / 160, ii = i % 160; *(LAS bf16*)(gsig + (t * GSP + ii) * 2) = (bf16)f2bf(sigmoidf_(bf2f(glv[k]))); }
        {
          const int ct = (d == 0) ? rc : (rc < 8 ? 7 - rc : 527 - rc), s = ct / RW_SC, ti = (d == 0) ? th : 1 - th;
          const bf16* rp = (const bf16*)(C.ws + WS_RPP) + (size_t)((d * 4 + h) * RW_NCH + rc) * 32 * 64;
          const bf16* hp = (const bf16*)(C.ws + WS_HSC) + (size_t)((d * 4 + h) * RW_NSC + s) * 64 * 64;
          bf16x8 af[2];
#pragma unroll
          for (int ks = 0; ks < 2; ++ks) af[ks] = ldg8(rp + (16 * ti + li) * 64 + 32 * ks + 8 * g);
#pragma unroll
          for (int vi = 0; vi < 4; ++vi) { f32x4 acc = {0.f, 0.f, 0.f, 0.f};
#pragma unroll
              for (int ks = 0; ks < 2; ++ks) acc = mfma16(af[ks], ldg8(hp + (16 * vi + li) * 64 + 32 * ks + 8 * g), acc);
#pragma unroll
              for (int r = 0; r < 4; ++r) { const int t = 16 * ti + 4 * g + r, rl = ((d == 0) ? t : 31 - t) - 16 * th;
                  yt[(d * 16 + rl) * 256 + h * 64 + 16 * vi + li] = acc[r] + YS[((size_t)d * ROWS + rowb + rl) * 256 + h * 64 + 16 * vi + li]; } } }
        __syncthreads();
#pragma unroll
        for (int c2 = 0; c2 < 2; ++c2) { const int ci = 2 * C.wave + c2; f32x4 a0 = {0.f, 0.f, 0.f, 0.f};
#pragma unroll
            for (int ks = 0; ks < 5; ++ks) a0 = mfma16(ldA(gsig, GSP, 0, 32 * ks, li, g), ldg8(g2t + (size_t)(16 * ci + li) * 160 + 32 * ks + 8 * g), a0);
#pragma unroll
            for (int r = 0; r < 4; ++r) gm[(4 * g + r) * 256 + 16 * ci + li] = a0[r]; }
        __syncthreads();
        if (u + C.G < ROWS / 16) GL_FETCH(u + C.G);
#pragma unroll 1
        for (int it = 0; it < 8; ++it) { const int rl = 2 * it + half, row = rowb + rl;
            const float* sc = SC + (size_t)row * 9 * 256;
            const float y = yt[rl * 256 + c] + yt[(16 + rl) * 256 + c];
            const float mu = wave_sum(y, lane) * (1.f / 64.f), dy = y - mu, var = wave_sum(dy * dy, lane) * (1.f / 64.f);
            const float yn = dy * rsqrtf(var + 64e-5f) * lnw[c] + lnb[c];
            const float r = sc[c], v = sc[256 + c];
            const float coef = wave_sum(r * (sc[4 * 256 + c] + sc[7 * 256 + c]) * rk[c], lane);
            MIX[(size_t)row * DM + 768 + c] = (bf16)f2bf((yn + coef * v) * gm[rl * 256 + c]); }
    }
#undef GL_FETCH
    __syncthreads();
}
__device__ __forceinline__ void outproj_ctx(const Ctx& C, int l, const float* gate) {
    const bf16* A = (const bf16*)(C.ws + WS_MIX); const bf16* B = (const bf16*)(C.ws + WS_WOUT) + (size_t)l * DM * DM; float* XS = (float*)(C.ws + WS_XS);
    const int lane = C.lane, li = lane & 15, g = lane >> 4;
    for (int u = C.gw; u < (NCTX / 16) * (DM / 16); u += C.NGW) { const int rt = u >> 6, ct = u & 63;
        const bf16* ap = A + (size_t)(16 * rt + li) * DM + 8 * g; const bf16* bp = B + (size_t)(16 * ct + li) * DM + 8 * g;
        f32x4 acc0 = {0.f, 0.f, 0.f, 0.f}, acc1 = {0.f, 0.f, 0.f, 0.f};
#pragma unroll 4
        for (int ks = 0; ks < 32; ks += 2) { acc0 = mfma16(ldg8(ap + 32 * ks), ldg8(bp + 32 * ks), acc0); acc1 = mfma16(ldg8(ap + 32 * ks + 32), ldg8(bp + 32 * ks + 32), acc1); }
        const float gv = gate[16 * ct + li];
#pragma unroll
        for (int r = 0; r < 4; ++r) { float* p = XS + (size_t)(16 * rt + 4 * g + r) * DM + 16 * ct + li; *p = *p + gv * (acc0[r] + acc1[r]); } }
}

#ifndef MK_SINGLE
#define MK_SINGLE 1
#endif
template <int ONLYP> __global__ void __launch_bounds__(NTHR, 2) mega(Args a) {
    extern __shared__ __attribute__((aligned(16))) unsigned char lds_raw[];
    Ctx C;
#define MKCTX() do { int t_ = threadIdx.x; asm volatile("" : "+v"(t_)); unsigned char* w_ = a.ws; asm volatile("" : "+s"(w_)); unsigned l_ = 0u; asm volatile("" : "+s"(l_)); \
        C.lds = (LAS unsigned char*)lds_raw + l_; C.tid = t_; C.lane = t_ & 63; C.wave = __builtin_amdgcn_readfirstlane(t_ >> 6); \
        C.wg = blockIdx.x; C.G = gridDim.x; C.gw = C.wg * NWAVES + C.wave; C.NGW = C.G * NWAVES; C.ws = w_; } while (0)
    MKCTX();
    if (C.tid == 0) {
#pragma unroll
        for (int i = 0; i < 31; ++i) ((LAS unsigned long long*)(C.lds + MISC_OFF + 2048))[i] = (unsigned long long)a.in[i]; }
    DArgs da; da.in.tab = (const LAS unsigned*)(C.lds + MISC_OFF + 2048); da.out = a.out;
    if (C.tid < 4) ((LAS unsigned*)(C.lds + MISC_OFF))[C.tid] = 0u;
    __syncthreads();
    XcdBarrier bar; bar.bar = (unsigned*)(C.ws + WS_CTL) + CW_BAR; bar.x = 0; bar.st = (volatile LAS unsigned*)(C.lds + MISC_OFF);
    if (a.use_bar) bar = xcd_barrier_post((unsigned*)(C.ws + WS_CTL) + CW_BAR, (volatile LAS unsigned*)(C.lds + MISC_OFF));
#ifndef PHMASK
#define PHMASK 0x1fff
#endif
#define INP(o, k) ((ONLYP < 0 || ONLYP == (o)) && ((PHMASK >> ((o) == 99 ? 12 : (o))) & 1) && a.ph_lo <= (k) && (k) < a.ph_hi)
#ifndef REPMASK
#define REPMASK 0
#endif
#define NREP(o) ((((REPMASK) >> ((o) == 99 ? 12 : (o))) & 1) ? 2 : 1)
#define IN(k) (a.ph_lo <= (k) && (k) < a.ph_hi)
#define SEAM(k) do { if (a.use_bar && IN(k) && IN((k) + 1)) { xcd_barrier(bar); if ((REPMASK >> 20) & 1) xcd_barrier(bar); } } while (0)
    if (INP(0, 0)) for (int rep = 0; rep < NREP(0); ++rep) { MKCTX(); phase_prologue(C, da); }
    SEAM(0);
    for (int l = 0; l < DEPTH; ++l) {
        const int b = 1 + l * NPL;
        const float* mod_lat = (const float*)(C.ws + WS_MOD) + (size_t)(l * 2 + 0) * 6144; const float* mod_ctx = mod_lat + 6144;
        if (INP(1, b + 0)) { MKCTX(); phase_norm1(C, da, l); }
        SEAM(b + 0);
        if (INP(2, b + 1)) for (int rep = 0; rep < NREP(2); ++rep) { MKCTX();
            pg8::StaticOrder S; S.init(WS_H, WS_WIN + (size_t)l * INWP * DM * 2, ROWS, INWP, DM, C.G, C.wg);
            pg8::EpiStoreBf16 E{(bf16*)(C.ws + WS_P), INWP, nullptr, 0, 1.0f, 1.0f};
            pg8::gemm_phase<pg8::EpiStoreBf16, pg8::StaticOrder, true, true>(C.lds, C.tid, DM, S, E, C.ws);
        }
        SEAM(b + 1);
        if (INP(3, b + 2)) { MKCTX(); for (int rep = 0; rep < NREP(3); ++rep) { mix1_rwkv_prep(C, da, l); mix1_fourier1(C); } }
        SEAM(b + 2);
        if (INP(11, b + 3)) for (int rep = 0; rep < NREP(11); ++rep) { MKCTX(); phase_rwkv1(C);
            if (C.wg >= 8 * RW_NSC) {
                Ctx C2 = C; C2.wg = C.wg - 8 * RW_NSC; C2.G = C.G - 8 * RW_NSC; C2.gw = C2.wg * NWAVES + C.wave; C2.NGW = C2.G * NWAVES;
                mix1_rope(C2); mix1_vt(C2); } }
        SEAM(b + 3);
        if (INP(4, b + 4)) for (int rep = 0; rep < NREP(4); ++rep) { MKCTX(); phase_mix2(C, da, l); }
        SEAM(b + 4);
        if (INP(5, b + 5)) for (int rep = 0; rep < NREP(5); ++rep) { MKCTX(); phase_mix3(C, da, l); }
        SEAM(b + 5);
        if (INP(6, b + 6)) { MKCTX();
            if (l < DEPTH - 1) outproj_ctx(C, l, mod_ctx + 2 * DM);
            pg8::StaticOrder S; S.init(WS_MIX + (size_t)NCTX * DM * 2, WS_WOUT + (size_t)l * DM * DM * 2, SEQ, DM, DM, C.G, C.wg);
            pg8::EpiResidual E{(float*)(C.ws + WS_XS) + (size_t)NCTX * DM, DM, mod_lat + 2 * DM, mod_lat + 2 * DM};
            pg8::gemm_phase<pg8::EpiResidual, pg8::StaticOrder, true, true>(C.lds, C.tid, DM, S, E, C.ws);
        }
        SEAM(b + 6);
        if (INP(7, b + 7)) for (int rep = 0; rep < NREP(7); ++rep) { MKCTX(); phase_norm2(C, da, l); }
        SEAM(b + 7);
        if (INP(8, b + 8)) for (int rep = 0; rep < NREP(8); ++rep) { MKCTX(); phase_gather(C, da, l); }
        SEAM(b + 8);
        if (INP(9, b + 9)) for (int rep = 0; rep < NREP(9); ++rep) { MKCTX();
            const int nblk = moe_tables(C);
            pg8::MoeOrder S{(unsigned)WS_XG8, (unsigned)(WS_WGU + (size_t)l * 32 * 2048 * DM), 256u * DM, 2048u * DM,
                            (const LAS unsigned char*)(C.lds + MISC_OFF + 1024), nblk, 8, C.G, C.wg};
            pg8::EpiSwiglu E{(bf16*)(C.ws + WS_ACT8), DM, da.in[I_BGU] + (size_t)l * 32 * 2048, 2048, pg8::X8_S * pg8::W8_S, 1.0f / (pg8::X8_S * pg8::W8_S)};
            pg8::gemm_phase<pg8::EpiSwiglu, pg8::MoeOrder, true, true, 1>(C.lds, C.tid, DM, S, E, C.ws);
        }
        SEAM(b + 9);
        if (INP(10, b + 10)) for (int rep = 0; rep < NREP(10); ++rep) { MKCTX();
            const int nblk = moe_tables(C);
            pg8::MoeOrder S{(unsigned)WS_ACT8, (unsigned)(WS_WDN + (size_t)l * 32 * DM * DM), 256u * DM, (unsigned)(DM * DM),
                            (const LAS unsigned char*)(C.lds + MISC_OFF + 1024), nblk, 4, C.G, C.wg};
            pg8::EpiStoreBf16 E{(bf16*)(C.ws + WS_XG), DM, da.in[I_BDN] + (size_t)l * 32 * DM, DM, pg8::ACT_S * pg8::W8_S, 1.0f / (pg8::ACT_S * pg8::W8_S)};
            pg8::gemm_phase<pg8::EpiStoreBf16, pg8::MoeOrder, true, true, 1>(C.lds, C.tid, DM, S, E, C.ws);
        }
        SEAM(b + 10);
    }
    if (INP(99, PH_TOTAL - 1)) for (int rep = 0; rep < NREP(99); ++rep) { MKCTX(); phase_final(C, da); }
#undef IN
#undef INP
#undef SEAM
}

typedef void (*kern_t)(Args);
static kern_t kern_of(int o) {
#if MK_SINGLE
    (void)o; return mega<-1>;
#else
    switch (o) { case 0: return mega<0>; case 1: return mega<1>; case 2: return mega<2>; case 3: return mega<3>; case 4: return mega<4>; case 5: return mega<5>; case 6: return mega<6>;
                 case 7: return mega<7>; case 8: return mega<8>; case 9: return mega<9>; case 10: return mega<10>; case 11: return mega<11>; case 99: return mega<99>;
                 default: return mega<0>;
    }
#endif
}
extern "C" void kernel_launch(void* const* d_in, const int* in_sizes, int n_in, void* d_out, int out_size, void* d_ws, size_t ws_size, hipStream_t stream) {
    static int ready = 0;
    if (ready == 0) {
        if (n_in != 31 || out_size != SEQ * DM || ws_size < WS_END) { fprintf(stderr, "kernel_launch: unexpected shapes (n_in %d, out %d, ws %zu)\n", n_in, out_size, ws_size); ready = -1; return; }
        const int ids[14] = {0, 1, 2, 3, 4, 5, 6, 7, 8, 9, 10, 11, 99, -1};
        for (int i = 0; i < (MK_SINGLE ? 14 : 13); ++i) { if (MK_SINGLE && ids[i] != -1) continue;
            if (hipFuncSetAttribute((const void*)kern_of(ids[i]), hipFuncAttributeMaxDynamicSharedMemorySize, LDS_BYTES) != hipSuccess) { fprintf(stderr, "kernel_launch: hipFuncSetAttribute failed (%d)\n", ids[i]); ready = -1; return; } }
        ready = 1;
    }
    if (ready < 0) return;
    (void)hipMemsetAsync((char*)d_ws + WS_CTL, 0, CTL_ZERO_BYTES, stream);
    Args a{};
    for (int i = 0; i < 31; ++i) a.in[i] = (const float*)d_in[i];
    a.out = (float*)d_out; a.ws = (unsigned char*)d_ws; a.pad = 0;
#if MK_SINGLE
    a.ph_lo = 0; a.ph_hi = PH_TOTAL; a.use_bar = 1;
    hipLaunchKernelGGL(kern_of(-1), dim3(NWG), dim3(NTHR), LDS_BYTES, stream, a);
#else
    for (int p = 0; p < PH_TOTAL; ++p) { a.ph_lo = p; a.ph_hi = p + 1; a.use_bar = 0;
        const int j = (p - 1) % NPL; const int o = (p == 0) ? 0 : (p == PH_TOTAL - 1) ? 99 : (j < 3 ? 1 + j : j == 3 ? 11 : j);
        hipLaunchKernelGGL(kern_of(o), dim3(NWG), dim3(NTHR), LDS_BYTES, stream, a); }
#endif
}
```

```cpp
#include <hip/hip_runtime.h>
#include <cstdio>
#include <cstdint>

#define LAS __attribute__((address_space(3)))
typedef unsigned short bf16;
typedef float f32x4 __attribute__((ext_vector_type(4)));
typedef float f32x2 __attribute__((ext_vector_type(2)));
typedef short bf16x8 __attribute__((ext_vector_type(8)));
typedef unsigned u32x4 __attribute__((ext_vector_type(4)));
typedef unsigned u32x2 __attribute__((ext_vector_type(2)));

constexpr int DM = 1024, SEQ = 16384, NCTX = 256, ROWS = SEQ + NCTX, DEPTH = 4, GRIDW = 64;
constexpr int INW = 2720, INWP = 2816;
constexpr int C_AQ = 0, C_AK = 256, C_AV = 384, C_BU = 512, C_CQ = 768, C_CK = 1024, C_CV = 1280, C_DR = 1536, C_DK = 1792, C_DV = 2048, C_WL = 2304, C_AL = 2432, C_GL = 2560;
constexpr int NEXP = 32, TOPK = 4;
constexpr int MOE_MAXBLK = 296;
constexpr int MOE_ROWS = MOE_MAXBLK * 256;
constexpr int NWG = 256, NTHR = 512, NWAVES = 8;
constexpr int VTP = ROWS + 256;

constexpr size_t MiB = 1u << 20;
constexpr size_t WS_CTL = 0, CTL_ZERO_BYTES = 1 * MiB;
constexpr size_t WS_MOD = 1 * MiB;
constexpr size_t WS_TW = 2 * MiB;
constexpr size_t WS_MTAB = 3 * MiB;
constexpr size_t WS_XS = 4 * MiB;
constexpr size_t WS_H = 70 * MiB;
constexpr size_t WS_P = 104 * MiB;
constexpr size_t WS_MIX = 194 * MiB;
constexpr size_t WS_FYR = 228 * MiB, WS_FYI = 244 * MiB;
constexpr size_t WS_VTA = 1544 * MiB, WS_VTC = 1550 * MiB;
constexpr size_t WS_SC = 260 * MiB;
constexpr size_t WS_YS = 408 * MiB;
constexpr size_t WS_ROUTE = 442 * MiB;
constexpr size_t WS_CNT = 444 * MiB;
constexpr size_t WS_XG = 446 * MiB;
constexpr size_t WS_ACT = 596 * MiB;
constexpr size_t WS_XG8 = WS_ACT, WS_ACT8 = WS_ACT + 75 * MiB;
constexpr size_t WS_WIN = 746 * MiB;
constexpr size_t WS_WOUT = 768 * MiB;
constexpr size_t WS_WGU = 776 * MiB;
constexpr size_t WS_WDN = 1288 * MiB;
constexpr size_t WS_RPP = 1560 * MiB, WS_PSC = 1578 * MiB, WS_LSC = 1580 * MiB, WS_HSC = 1584 * MiB;
constexpr size_t WS_FTAB = 1586 * MiB;
constexpr size_t WS_G2T = 1588 * MiB, WS_RWT = 1589 * MiB;
constexpr size_t WS_LORAT = 1590 * MiB;
constexpr size_t WS_F256 = 1591 * MiB;

constexpr size_t WS_END = 1592 * MiB;
static_assert(WS_XS + (size_t)ROWS * DM * 4 <= WS_H && WS_H + (size_t)ROWS * DM * 2 <= WS_P && WS_P + (size_t)ROWS * INWP * 2 <= WS_MIX && WS_MIX + (size_t)ROWS * DM * 2 <= WS_FYR, "ws map 1");
static_assert(WS_SC + (size_t)ROWS * 9 * 256 * 4 <= WS_YS && WS_YS + (size_t)2 * ROWS * 256 * 4 <= WS_ROUTE && WS_XG + (size_t)MOE_ROWS * DM * 2 <= WS_ACT && WS_ACT + (size_t)MOE_ROWS * DM * 2 <= WS_WIN, "ws map 2");
static_assert(WS_WIN + (size_t)4 * INWP * DM * 2 <= WS_WOUT && WS_WGU + (size_t)4 * 32 * 2048 * 1024 * 2 <= WS_WDN && WS_WDN + (size_t)4 * 32 * 1024 * 1024 * 2 <= WS_END, "ws map 3");
constexpr int CW_BAR = 4096;
constexpr int CW_WQ = 16384;

constexpr int RING_BYTES = 131072;
constexpr int MISC_OFF = 143360;
constexpr int LDS_BYTES = 147456;

__device__ __forceinline__ unsigned f2bf(float f) { unsigned u = __builtin_bit_cast(unsigned, f); return (u + 0x7fffu + ((u >> 16) & 1u)) >> 16; }
__device__ __forceinline__ unsigned pk2(float lo, float hi) { return f2bf(lo) | (f2bf(hi) << 16); }
__device__ __forceinline__ float bf2f(unsigned short b) { return __builtin_bit_cast(float, (unsigned)b << 16); }
__device__ __forceinline__ float bflo(unsigned w) { return __builtin_bit_cast(float, w << 16); }
__device__ __forceinline__ float bfhi(unsigned w) { return __builtin_bit_cast(float, w & 0xffff0000u); }
__device__ __forceinline__ float shx(float v, int o, int lane) { return __builtin_bit_cast(float, __builtin_amdgcn_ds_bpermute((lane ^ o) << 2, __builtin_bit_cast(int, v))); }
__device__ __forceinline__ int shxi(int v, int o, int lane) { return __builtin_amdgcn_ds_bpermute((lane ^ o) << 2, v); }
__device__ __forceinline__ float dpp_ror(float v, int ctrl_unused);
#define DPP_ROR_ADD(v, n) v += __builtin_bit_cast(float, __builtin_amdgcn_update_dpp(0, __builtin_bit_cast(int, v), 0x120 + (n), 0xf, 0xf, false))
__device__ __forceinline__ float wave_sum(float v, int lane) {
    DPP_ROR_ADD(v, 8); DPP_ROR_ADD(v, 4); DPP_ROR_ADD(v, 2); DPP_ROR_ADD(v, 1);
    v += shx(v, 16, lane); v += shx(v, 32, lane);
    return v;
}
__device__ __forceinline__ float sigmoidf_(float x) { return 1.f / (1.f + __expf(-x)); }
#define LDS_WAIT() asm volatile("s_waitcnt lgkmcnt(0)" ::: "memory")
#define VM_WAIT() asm volatile("s_waitcnt vmcnt(0)" ::: "memory")

namespace pg8 {
#define PG8_LAS __attribute__((address_space(3)))
typedef unsigned short bf16_t;
constexpr int BM = 256, BK = 64, HALF = 128, HTB = HALF * BK * 2, STAGE_BYTES = 8 * HTB, NXCD = 8, WGM = 8;
__host__ __device__ __forceinline__ int lds_byte(int r, int c) { const int st = (r >> 4) * 2 + (c >> 5), rr = r & 15, cc = c & 31, ob = rr * 64 + cc * 2; return st * 1024 + (ob ^ (((ob >> 9) & 1) << 5)); }
__host__ __device__ __forceinline__ void stage_rc(int b, int& R, int& C) { const int st = b / 1024, sb = b % 1024, swz = sb ^ (((sb >> 9) & 1) << 5); R = (st >> 1) * 16 + swz / 64; C = (st & 1) * 32 + (swz % 64) / 2; }
__host__ __device__ __forceinline__ int perm32(int rho) { const int n = rho >> 4, i = rho & 15; return 8 * (i >> 2) + 4 * n + (i & 3); }
struct Unit { int pm, pn, e; };
typedef int v8i __attribute__((ext_vector_type(8))); typedef int v4i __attribute__((ext_vector_type(4)));
__device__ __forceinline__ v8i cat8(bf16x8 a, bf16x8 b) { const v4i x = __builtin_bit_cast(v4i, a), y = __builtin_bit_cast(v4i, b); return __builtin_shufflevector(x, y, 0, 1, 2, 3, 4, 5, 6, 7); }
__device__ __forceinline__ unsigned cvt_pk_bf16(float lo, float hi) { unsigned r; asm volatile("v_cvt_pk_bf16_f32 %0, %1, %2" : "=v"(r) : "v"(lo), "v"(hi)); return r; }

struct StaticOrder {
    unsigned A, Bt, tstep;
    int nM, nN, nwg, G, c;
    __device__ void init(size_t A_, size_t Bt_, int M, int N, int K, int G_, int c_) { A = (unsigned)A_; Bt = (unsigned)Bt_; tstep = (unsigned)(BM * K * 2); nM = M / BM; nN = N / BM; nwg = nM * nN; G = G_; c = c_; }
    __device__ bool next(int i, Unit& u) const {
        const long L = (long)i * G + c; if (L >= nwg) return false;
        int wgid = (int)L; { const int q = nwg / NXCD, r = nwg % NXCD, xcd = wgid % NXCD, off = wgid / NXCD; wgid = (xcd < r ? xcd * (q + 1) : r * (q + 1) + (xcd - r) * q) + off; }
        const int nig = WGM * nN, gid = wgid / nig, fm = gid * WGM, gsz = (nM - fm) < WGM ? (nM - fm) : WGM;
        u.pm = fm + ((wgid % nig) % gsz); u.pn = (wgid % nig) / gsz; u.e = 0; return true;
    }
    __device__ __forceinline__ unsigned pa(const Unit& u) const { return A + (unsigned)u.pm * tstep; }
    __device__ __forceinline__ unsigned pb(const Unit& u) const { return Bt + (unsigned)u.pn * tstep; }
};
struct MoeOrder {
    unsigned A, Bt, tstep, estep;
    const LAS unsigned char* blk_e; int nblk, nN, G, c;
    __device__ bool next(int i, Unit& u) const {
        const int L = i * G + c; if (L >= nblk * nN) return false;
        u.pm = L / nN; u.pn = L % nN; u.e = __builtin_amdgcn_readfirstlane((int)blk_e[u.pm]); return true;
    }
    __device__ __forceinline__ unsigned pa(const Unit& u) const { return A + (unsigned)u.pm * tstep; }
    __device__ __forceinline__ unsigned pb(const Unit& u) const { return Bt + (unsigned)u.e * estep + (unsigned)u.pn * tstep; }
};

struct EpiStoreBf16 {
    static constexpr bool PERM = true;
    bf16_t* O; int ldc; const float* bias; int bias_estride; float bias_scale, acc_scale;
    __device__ __forceinline__ void init(f32x4 (&acc)[2][2][4][2], const Unit& u, int wc, int fq) const {
        const int col0 = u.pn * BM + wc * 32 + 8 * fq;
#pragma unroll
        for (int b = 0; b < 2; ++b)
#pragma unroll
            for (int n = 0; n < 2; ++n) { const f32x4 bv = bias ? *(const f32x4*)(bias + (size_t)u.e * bias_estride + col0 + b * HALF + 4 * n) * bias_scale : (f32x4){0.f, 0.f, 0.f, 0.f};
#pragma unroll
                for (int a = 0; a < 2; ++a)
#pragma unroll
                    for (int m = 0; m < 4; ++m) { f32x4 t = bv; asm volatile("" : "+v"(t)); acc[a][b][m][n] = t; } }
    }
    __device__ __forceinline__ void operator()(const f32x4 (&acc)[2][2][4][2], const Unit& u, int wr, int wc, int fr, int fq) const {
        const int row0 = u.pm * BM + wr * 64 + fr, col0 = u.pn * BM + wc * 32 + 8 * fq;
#pragma unroll
        for (int ai = 0; ai < 2; ++ai)
#pragma unroll
            for (int m = 0; m < 4; ++m) { bf16_t* rowp = O + (size_t)(row0 + ai * HALF + m * 16) * ldc + col0;
#pragma unroll
                for (int bj = 0; bj < 2; ++bj) { const f32x4 v0 = acc[ai][bj][m][0] * acc_scale, v1 = acc[ai][bj][m][1] * acc_scale;
                    u32x4 w; w.x = cvt_pk_bf16(v0[0], v0[1]); w.y = cvt_pk_bf16(v0[2], v0[3]); w.z = cvt_pk_bf16(v1[0], v1[1]); w.w = cvt_pk_bf16(v1[2], v1[3]);
                    *(u32x4*)(rowp + bj * HALF) = w; }
                asm volatile("" ::: "memory"); }
    }
};
__device__ __forceinline__ float swiglu1(float g, float up) {
    g = fminf(g, 7.0f); up = fminf(fmaxf(up, -7.0f), 7.0f);
    return g * (1.f / (1.f + __expf(-1.702f * g))) * (up + 1.0f);
}
constexpr float X8_S = 8.0f, W8_S = 256.0f, ACT_S = 4.0f;
struct EpiSwiglu {
    static constexpr bool PERM = true;
    bf16_t* O; int ldc; const float* bias; int bias_estride; float bias_scale, acc_scale;
    __device__ __forceinline__ void init(f32x4 (&acc)[2][2][4][2], const Unit& u, int wc, int fq) const {
        const int col0 = u.pn * BM + wc * 32 + 8 * fq;
#pragma unroll
        for (int b = 0; b < 2; ++b)
#pragma unroll
            for (int n = 0; n < 2; ++n) { const f32x4 bv = bias ? *(const f32x4*)(bias + (size_t)u.e * bias_estride + col0 + b * HALF + 4 * n) * bias_scale : (f32x4){0.f, 0.f, 0.f, 0.f};
#pragma unroll
                for (int a = 0; a < 2; ++a)
#pragma unroll
                    for (int m = 0; m < 4; ++m) { f32x4 t = bv; asm volatile("" : "+v"(t)); acc[a][b][m][n] = t; } }
    }
    __device__ __forceinline__ void operator()(const f32x4 (&acc)[2][2][4][2], const Unit& u, int wr, int wc, int fr, int fq) const {
        const int row0 = u.pm * BM + wr * 64 + fr, col0 = u.pn * BM + wc * 32 + 8 * fq;
#pragma unroll
        for (int ai = 0; ai < 2; ++ai)
#pragma unroll
            for (int m = 0; m < 4; ++m) { unsigned char* rowp = (unsigned char*)O + (size_t)(row0 + ai * HALF + m * 16) * ldc + (col0 >> 1);
#pragma unroll
                for (int bj = 0; bj < 2; ++bj) { const f32x4 v0 = acc[ai][bj][m][0] * acc_scale, v1 = acc[ai][bj][m][1] * acc_scale;
                    unsigned w = 0; w = __builtin_amdgcn_cvt_pk_fp8_f32(swiglu1(v0[0], v0[1]) * ACT_S, swiglu1(v0[2], v0[3]) * ACT_S, w, false); w = __builtin_amdgcn_cvt_pk_fp8_f32(swiglu1(v1[0], v1[1]) * ACT_S, swiglu1(v1[2], v1[3]) * ACT_S, w, true);
                    *(unsigned*)(rowp + bj * (HALF / 2)) = w; }
                asm volatile("" ::: "memory"); }
    }
};
struct EpiResidual {
    static constexpr bool PERM = false;
    float* X; int ldc; const float* gate_lat; const float* gate_ctx;
    __device__ __forceinline__ void init(f32x4 (&acc)[2][2][4][2], const Unit& u, int wc, int fq) const {
#pragma unroll
        for (int a = 0; a < 2; ++a)
#pragma unroll
            for (int b = 0; b < 2; ++b)
#pragma unroll
                for (int m = 0; m < 4; ++m)
#pragma unroll
                    for (int n = 0; n < 2; ++n) acc[a][b][m][n] = (f32x4){0.f, 0.f, 0.f, 0.f};
    }
    __device__ __forceinline__ void operator()(const f32x4 (&acc)[2][2][4][2], const Unit& u, int wr, int wc, int fr, int fq) const {
        const int row0 = u.pm * BM + wr * 64 + fr, col0 = u.pn * BM + wc * 32 + 4 * fq;
        const float* gp = (u.pm == 0) ? gate_ctx : gate_lat;
        f32x4 gv[2][2];
#pragma unroll
        for (int bj = 0; bj < 2; ++bj)
#pragma unroll
            for (int n = 0; n < 2; ++n) gv[bj][n] = *(const f32x4*)(gp + col0 + bj * HALF + n * 16);
#pragma unroll
        for (int ai = 0; ai < 2; ++ai)
#pragma unroll
            for (int m = 0; m < 4; ++m) { float* rowp = X + (size_t)(row0 + ai * HALF + m * 16) * ldc + col0;
#pragma unroll
                for (int bj = 0; bj < 2; ++bj)
#pragma unroll
                    for (int n = 0; n < 2; ++n) { f32x4* p = (f32x4*)(rowp + bj * HALF + n * 16); *p = *p + gv[bj][n] * acc[ai][bj][m][n]; }
                asm volatile("" ::: "memory"); }
    }
};
template <class Epi, class Sched, bool ALIGN_EPI = false, bool SP2 = false, int ES = 2>
__device__ __forceinline__ void gemm_phase(PG8_LAS unsigned char* lds, const int tid, const int K, const Sched& S, const Epi& E, const void* wsbase) {
    const __amdgpu_buffer_rsrc_t rsrc = __builtin_amdgcn_make_buffer_rsrc((void*)wsbase, 0, 0x7fffffff, 0x00020000);
    const int wid = __builtin_amdgcn_readfirstlane(tid >> 6), lane = tid & 63, wr = wid >> 2, wc = wid & 3, fr = lane & 15, fq = lane >> 4;
    const int nt = (K * ES) / 128;
    unsigned voffA[2], voffB[2];
#pragma unroll
    for (int i = 0; i < 2; ++i) { int R, C; stage_rc(tid * 16 + i * 8192, R, C); const int Rb = Epi::PERM ? ((R & ~31) + perm32(R & 31)) : R;
        voffA[i] = (unsigned)(R * K * ES + C * 2); voffB[i] = (unsigned)(Rb * K * ES + C * 2); }
    const unsigned kstep = (unsigned)(BK * 2);
    const unsigned hstep = (unsigned)(HALF * K * ES);
        const unsigned ldsw = (unsigned)wid * 1024u;
    const int aoff = lds_byte(wr * 64 + fr, ES == 2 ? fq * 8 : fq * 16), boff = lds_byte(wc * 32 + fr, ES == 2 ? fq * 8 : fq * 16); constexpr int KOFF = (ES == 2) ? 1024 : 16;
#define PG8_SA(b, h) (((b) * 2 + (h)) * HTB)
#define PG8_SB(b, h) ((4 + (b) * 2 + (h)) * HTB)
#define PG8_STAGE(bufoff, gbase, voff) do { _Pragma("unroll") for (int _i = 0; _i < 2; ++_i) \
        __builtin_amdgcn_raw_ptr_buffer_load_lds(rsrc, (PG8_LAS unsigned*)(lds + (bufoff) + ldsw + _i * 8192), 16, (voff)[_i], (gbase), 0, 0); } while (0)
#define PG8_LDA(dst, b, h) do { _Pragma("unroll") for (int m = 0; m < 4; ++m) _Pragma("unroll") for (int k = 0; k < 2; ++k) dst[m][k] = *(const PG8_LAS bf16x8*)(lds + PG8_SA(b, h) + aoff + m * 2048 + k * KOFF); } while (0)
#define PG8_LDA8(dst, b, h) do { _Pragma("unroll") for (int m = 0; m < 4; ++m) { const PG8_LAS v4i* p_ = (const PG8_LAS v4i*)(lds + PG8_SA(b, h) + aoff + m * 2048); const v4i x_ = p_[0], y_ = p_[1]; dst[m] = __builtin_shufflevector(x_, y_, 0, 1, 2, 3, 4, 5, 6, 7); } } while (0)
#define PG8_LDB(dst, b, h) do { _Pragma("unroll") for (int n = 0; n < 2; ++n) _Pragma("unroll") for (int k = 0; k < 2; ++k) dst[n][k] = *(const PG8_LAS bf16x8*)(lds + PG8_SB(b, h) + boff + n * 2048 + k * KOFF); } while (0)
#define PG8_LDB8(dst, b, h) do { _Pragma("unroll") for (int n = 0; n < 2; ++n) { const PG8_LAS v4i* p_ = (const PG8_LAS v4i*)(lds + PG8_SB(b, h) + boff + n * 2048); const v4i x_ = p_[0], y_ = p_[1]; dst[n] = __builtin_shufflevector(x_, y_, 0, 1, 2, 3, 4, 5, 6, 7); } } while (0)
#define PG8_MMA(ai, bj, At, Bt) do { __builtin_amdgcn_s_setprio(1); _Pragma("unroll") for (int m = 0; m < 4; ++m) _Pragma("unroll") for (int n = 0; n < 2; ++n) { \
        if constexpr (ES == 2) { _Pragma("unroll") for (int k = 0; k < 2; ++k) acc[ai][bj][m][n] = __builtin_amdgcn_mfma_f32_16x16x32_bf16(Bt[n][k], At[m][k], acc[ai][bj][m][n], 0, 0, 0); } \
        else asm volatile("v_mfma_f32_16x16x128_f8f6f4 %0, %1, %2, %0" : "+v"(acc[ai][bj][m][n]) : "v"(Bt##8[n]), "v"(At##8[m])); } \
        __builtin_amdgcn_s_setprio(0); } while (0)
#define PG8_LDAX(b, h) do { if constexpr (ES == 2) PG8_LDA(At, b, h); else PG8_LDA8(At8, b, h); } while (0)
#define PG8_LDBX(B, b, h) do { if constexpr (ES == 2) PG8_LDB(B, b, h); else PG8_LDB8(B##8, b, h); } while (0)
#define PG8_WAIT_V(n) asm volatile("s_waitcnt vmcnt(" #n ")" ::: "memory")
#define PG8_WAIT_L(n) asm volatile("s_waitcnt lgkmcnt(" #n ")" ::: "memory")
#define PG8_BAR __builtin_amdgcn_s_barrier()
#define PG8_SCHED __builtin_amdgcn_sched_barrier(0)
    Unit cur, nxt; int ui = 0;
    if (!S.next(0, cur)) return;
    f32x4 acc[2][2][4][2];
    E.init(acc, cur, wc, fq);
    bf16x8 At[4][2], B0[2][2], B1[2][2]; v8i At8[4], B08[2], B18[2];
    unsigned cA = S.pa(cur), cB = S.pb(cur);
    if constexpr (SP2) {
        PG8_STAGE(PG8_SB(0, 0), cB, voffB); PG8_STAGE(PG8_SB(0, 1), cB + hstep, voffB); PG8_STAGE(PG8_SA(0, 0), cA, voffA); PG8_STAGE(PG8_SA(0, 1), cA + hstep, voffA);
        if (wr == 1) PG8_BAR;
        PG8_WAIT_V(2); PG8_BAR;
        PG8_STAGE(PG8_SB(1, 0), cB + kstep, voffB); PG8_STAGE(PG8_SA(1, 0), cA + kstep, voffA); PG8_STAGE(PG8_SB(1, 1), cB + hstep + kstep, voffB);
        PG8_WAIT_V(6); PG8_BAR;
    } else {
        PG8_STAGE(PG8_SB(0, 0), cB, voffB); PG8_STAGE(PG8_SA(0, 0), cA, voffA); PG8_STAGE(PG8_SB(0, 1), cB + hstep, voffB); PG8_STAGE(PG8_SA(0, 1), cA + hstep, voffA);
        if (wr == 1) PG8_BAR;
        PG8_WAIT_V(4); PG8_BAR;
        PG8_STAGE(PG8_SB(1, 0), cB + kstep, voffB); PG8_STAGE(PG8_SA(1, 0), cA + kstep, voffA); PG8_STAGE(PG8_SB(1, 1), cB + hstep + kstep, voffB);
        PG8_WAIT_V(6); PG8_BAR;
    }
    for (;;) {
        const bool has_next = S.next(ui + 1, nxt);
        const unsigned nA = has_next ? S.pa(nxt) : cA, nB = has_next ? S.pb(nxt) : cB;
        for (int t = 0; t < nt; t += 2) {
            const bool last = (t == nt - 2);
            const unsigned a1 = cA + (unsigned)(t + 1) * kstep;
            const unsigned a2 = last ? nA : cA + (unsigned)(t + 2) * kstep, b2 = last ? nB : cB + (unsigned)(t + 2) * kstep;
            const unsigned a3 = a2 + kstep, b3 = b2 + kstep;
            if constexpr (SP2) {
            PG8_LDBX(B0, 0, 0); PG8_LDBX(B1, 0, 1); PG8_SCHED; PG8_LDAX(0, 0); PG8_STAGE(PG8_SA(1, 1), a1 + hstep, voffA);
            PG8_WAIT_V(8); PG8_WAIT_L(0); PG8_BAR; PG8_MMA(0, 0, At, B0); PG8_MMA(0, 1, At, B1); PG8_BAR; PG8_SCHED;
            PG8_LDAX(0, 1); PG8_STAGE(PG8_SB(0, 0), b2, voffB); PG8_STAGE(PG8_SB(0, 1), b2 + hstep, voffB); PG8_STAGE(PG8_SA(0, 0), a2, voffA);
            PG8_WAIT_V(8); PG8_WAIT_L(0); PG8_BAR; PG8_MMA(1, 0, At, B0); PG8_MMA(1, 1, At, B1); PG8_BAR; PG8_SCHED;
            PG8_LDBX(B0, 1, 0); PG8_LDBX(B1, 1, 1); PG8_SCHED; PG8_LDAX(1, 0); PG8_STAGE(PG8_SA(0, 1), a2 + hstep, voffA);
            PG8_WAIT_V(8); PG8_WAIT_L(0); PG8_BAR; PG8_MMA(0, 0, At, B0); PG8_MMA(0, 1, At, B1); PG8_BAR; PG8_SCHED;
            PG8_LDAX(1, 1); PG8_STAGE(PG8_SB(1, 0), b3, voffB); PG8_STAGE(PG8_SB(1, 1), b3 + hstep, voffB); PG8_STAGE(PG8_SA(1, 0), a3, voffA);
            PG8_WAIT_V(8); PG8_WAIT_L(0); PG8_BAR; PG8_MMA(1, 0, At, B0); PG8_MMA(1, 1, At, B1); PG8_BAR; PG8_SCHED;
            } else {
            PG8_LDBX(B0, 0, 0); PG8_SCHED; PG8_LDAX(0, 0); PG8_STAGE(PG8_SA(1, 1), a1 + hstep, voffA);
            PG8_WAIT_L(8); PG8_BAR; PG8_WAIT_L(0); PG8_MMA(0, 0, At, B0); PG8_BAR; PG8_SCHED;
            PG8_LDBX(B1, 0, 1); PG8_STAGE(PG8_SB(0, 0), b2, voffB);
            PG8_BAR; PG8_WAIT_L(0); PG8_MMA(0, 1, At, B1); PG8_BAR;
            PG8_LDAX(0, 1); PG8_STAGE(PG8_SA(0, 0), a2, voffA);
            PG8_BAR; PG8_WAIT_L(0); PG8_MMA(1, 0, At, B0); PG8_BAR; PG8_SCHED;
            PG8_STAGE(PG8_SB(0, 1), b2 + hstep, voffB);
            PG8_WAIT_V(6); PG8_BAR; PG8_MMA(1, 1, At, B1); PG8_BAR;
            PG8_LDBX(B0, 1, 0); PG8_SCHED; PG8_LDAX(1, 0); PG8_STAGE(PG8_SA(0, 1), a2 + hstep, voffA);
            PG8_WAIT_L(8); PG8_BAR; PG8_WAIT_L(0); PG8_MMA(0, 0, At, B0); PG8_BAR; PG8_SCHED;
            PG8_LDBX(B1, 1, 1); PG8_STAGE(PG8_SB(1, 0), b3, voffB);
            PG8_BAR; PG8_WAIT_L(0); PG8_MMA(0, 1, At, B1); PG8_BAR;
            PG8_LDAX(1, 1); PG8_STAGE(PG8_SA(1, 0), a3, voffA);
            PG8_BAR; PG8_WAIT_L(0); PG8_MMA(1, 0, At, B0); PG8_BAR; PG8_SCHED;
            PG8_STAGE(PG8_SB(1, 1), b3 + hstep, voffB);
            PG8_WAIT_V(6); PG8_BAR; PG8_MMA(1, 1, At, B1); PG8_BAR;
            }
        }
        if constexpr (ALIGN_EPI) { if (wr == 0) PG8_BAR; }
        if constexpr (ES == 1) asm volatile("s_nop 15\n\ts_nop 15" ::: "memory");
        E(acc, cur, wr, wc, fr, fq);
        if (!has_next) break;
        E.init(acc, nxt, wc, fq);
        cur = nxt; cA = nA; cB = nB; ++ui;
        if constexpr (ALIGN_EPI) { if (wr == 1) PG8_BAR; }
    }
    PG8_WAIT_V(0);
    if constexpr (!ALIGN_EPI) { if (wr == 0) PG8_BAR; }
    PG8_BAR;
#undef PG8_SA
#undef PG8_SB
#undef PG8_STAGE
#undef PG8_LDA
#undef PG8_LDA8
#undef PG8_LDB8
#undef PG8_LDAX
#undef PG8_LDBX
#undef PG8_LDB
#undef PG8_MMA
#undef PG8_WAIT_V
#undef PG8_WAIT_L
#undef PG8_BAR
#undef PG8_SCHED
}
}

#define XB_TMO      128
#define XB_XCNT(j)  (256  + 64 * (j))
#define XB_XSUB(j)  (1280 + 64 * (j))
#define XB_XGEN(j)  (2304 + 64 * (j))
#define XB_TOP      3328
#define XB_TOPGEN   3392
#define XCD_BAR_WORDS 3456
#define XB_SPIN_CAP (1u << 18)
__device__ __forceinline__ unsigned xb_ld(unsigned* p)              { return __hip_atomic_load(p, __ATOMIC_RELAXED, __HIP_MEMORY_SCOPE_AGENT); }
__device__ __forceinline__ unsigned xb_add(unsigned* p, unsigned v) { return __hip_atomic_fetch_add(p, v, __ATOMIC_RELAXED, __HIP_MEMORY_SCOPE_AGENT); }
__device__ __forceinline__ unsigned xb_xcc_id() { return (unsigned)__builtin_amdgcn_s_getreg((3 << 11) | 20) & 0xFu; }
#define XB_SPIN(cond, bar) do { unsigned _sp = 0; while (cond) { __builtin_amdgcn_s_sleep(1); \
    if ((++_sp & 255u) == 0u) { if (xb_ld(&(bar)[XB_TMO])) break; if (_sp > XB_SPIN_CAP) { atomicAdd(&(bar)[XB_TMO], 1u); break; } } } } while (0)

struct XcdBarrier {
    unsigned* bar; unsigned x;
    volatile LAS unsigned* st;
};

__device__ __forceinline__ XcdBarrier xcd_barrier_post(unsigned* bar, volatile LAS unsigned* st) {
    XcdBarrier b; b.bar = bar; b.x = xb_xcc_id(); b.st = st;
    if (threadIdx.x == 0) (void)xb_add(&bar[XB_XCNT(b.x)], 1u);
    return b;
}
__device__ __forceinline__ void xcd_barrier_complete(unsigned* bar, unsigned x, unsigned& nloc, unsigned& nx) {
    const unsigned G = gridDim.x * gridDim.y * gridDim.z;
    unsigned sum, cnt, mine, sp = 0u;
    for (;;) {
        sum = 0u; cnt = 0u; mine = 0u;
#pragma unroll
        for (unsigned j = 0; j < 16; ++j) { const unsigned c = xb_ld(&bar[XB_XCNT(j)]); sum += c; cnt += (c > 0u) ? 1u : 0u; mine = (j == x) ? c : mine; }
        if (sum == G) break;
        __builtin_amdgcn_s_sleep(1);
        if ((++sp & 255u) == 0u) { if (xb_ld(&bar[XB_TMO])) break; if (sp > XB_SPIN_CAP) { atomicAdd(&bar[XB_TMO], 1u); break; } }
    }
    nloc = mine > 0u ? mine : 1u; nx = cnt > 0u ? cnt : 1u;
}

__device__ __forceinline__ void xcd_barrier(const XcdBarrier& b) {
    asm volatile("s_waitcnt vmcnt(0)" ::: "memory");
    __syncthreads();
    if (threadIdx.x == 0) {
        unsigned* bar = b.bar;
        __builtin_amdgcn_s_waitcnt(0);
        unsigned nloc = b.st[0], nx = b.st[1];
        if (nloc == 0u) { xcd_barrier_complete(bar, b.x, nloc, nx); b.st[0] = nloc; b.st[1] = nx; }
        const unsigned old = xb_add(&bar[XB_XSUB(b.x)], 1u);
        const unsigned gen = old / nloc;
        if (old + 1u == (gen + 1u) * nloc) {
            __builtin_amdgcn_fence(__ATOMIC_RELEASE, "agent");
            asm volatile("s_waitcnt vmcnt(0)" ::: "memory");
            const unsigned og = xb_add(&bar[XB_TOP], 1u);
            const unsigned tg = og / nx;
            if (og + 1u == (tg + 1u) * nx) xb_add(&bar[XB_TOPGEN], 1u);
            else XB_SPIN(xb_ld(&bar[XB_TOPGEN]) == tg, bar);
            __builtin_amdgcn_fence(__ATOMIC_ACQUIRE, "agent");
            xb_add(&bar[XB_XGEN(b.x)], 1u);
            asm volatile("s_waitcnt vmcnt(0)" ::: "memory");
        } else {
            XB_SPIN(xb_ld(&bar[XB_XGEN(b.x)]) == gen, bar);
            __builtin_amdgcn_fence(__ATOMIC_ACQUIRE, "agent");
            asm volatile("s_waitcnt vmcnt(0)" ::: "memory");
        }
    }
    __syncthreads();
}

typedef short s4v __attribute__((ext_vector_type(4)));
__device__ __forceinline__ bf16x8 ldg8(const bf16* p) { return *(const bf16x8*)p; }
__device__ __forceinline__ f32x4 mfma16(bf16x8 a, bf16x8 b, f32x4 c) { return __builtin_amdgcn_mfma_f32_16x16x32_bf16(a, b, c, 0, 0, 0); }
__device__ __forceinline__ bf16x8 ldA(const LAS unsigned char* base, int pitch, int row0, int k0, int li, int g) { return *(const LAS bf16x8*)(base + ((row0 + li) * pitch + k0 + 8 * g) * 2); }
__device__ __forceinline__ bf16x8 ldT(const LAS unsigned char* base, int pitch, int k0, int n0, int li, int g) {
    const LAS unsigned char* p = base + ((k0 + 8 * g + (li >> 2)) * pitch + n0 + 4 * (li & 3)) * 2;
    const s4v a = __builtin_amdgcn_ds_read_tr16_b64_v4i16((LAS s4v*)p), b = __builtin_amdgcn_ds_read_tr16_b64_v4i16((LAS s4v*)(p + 8 * pitch));
    return (bf16x8){a[0], a[1], a[2], a[3], b[0], b[1], b[2], b[3]};
}
__device__ __forceinline__ bf16x8 ldAperm(const LAS unsigned char* base, int pitch, int row0, int ks, int li, int g) {
    const LAS unsigned char* p = base + ((row0 + li) * pitch + 32 * ks + 4 * g) * 2;
    const s4v a = *(const LAS s4v*)p, b = *(const LAS s4v*)(p + 32);
    return (bf16x8){a[0], a[1], a[2], a[3], b[0], b[1], b[2], b[3]};
}
__device__ __forceinline__ void stT(LAS unsigned char* base, int pitch, int n, int m0, const f32x4 v) {
    u32x2 w; w.x = pk2(v[0], v[1]); w.y = pk2(v[2], v[3]); *(LAS u32x2*)(base + (n * pitch + m0) * 2) = w;
}
__device__ __forceinline__ f32x4 ld4bf(const LAS unsigned char* p) { const u32x2 w = *(const LAS u32x2*)p; return (f32x4){bflo(w.x), bfhi(w.x), bflo(w.y), bfhi(w.y)}; }

struct Args {
    const float* in[31];
    float* out; unsigned char* ws;
    int ph_lo, ph_hi, use_bar, pad;
};
enum InIdx { I_X = 0, I_C, I_CTX, I_CCTX, I_ADAW, I_ADAB, I_N1G, I_N2G, I_WIN, I_WOUT, I_ASINK, I_BMIX, I_CREL, I_DCONV, I_DW0, I_DW2, I_DA0, I_DA2, I_DG2, I_DKK, I_DKA, I_DRK, I_DLNW, I_DLNB,
             I_RW, I_RB, I_WGU, I_BGU, I_WDN, I_BDN, I_FNG };
constexpr int NPL = 11;
constexpr int PH_TOTAL = 1 + DEPTH * NPL + 1;

struct DevIn {
    const LAS unsigned* tab;
    __device__ __forceinline__ const float* operator[](int i) const {
        const unsigned lo = __builtin_amdgcn_readfirstlane(((const volatile LAS unsigned*)tab)[2 * i]), hi = __builtin_amdgcn_readfirstlane(((const volatile LAS unsigned*)tab)[2 * i + 1]);
        return (const float*)(((unsigned long long)hi << 32) | lo);
    }
};
struct DArgs { DevIn in; float* out; };
struct Ctx {
    LAS unsigned char* lds;
    int tid, lane, wave, wg, G, gw, NGW;
    unsigned char* ws;
};

template <int NW>
__device__ __forceinline__ void transpose_item(const float* W, int K, int N, bf16* WT, int item, int lane) {
    constexpr int NQ = NW / 4, NC = 64 / NQ, PASSES = 8 / NC;
    const int nblk = N / NW, kb = item / nblk, nb = item % nblk, k0 = 64 * kb, n0 = NW * nb, nq = lane % NQ, cq = lane / NQ;
    f32x4 v[PASSES][8];
#pragma unroll
    for (int ps = 0; ps < PASSES; ++ps)
#pragma unroll
        for (int i = 0; i < 8; ++i) v[ps][i] = *(const f32x4*)(W + (size_t)(k0 + 8 * (cq + NC * ps) + i) * N + n0 + 4 * nq);
#pragma unroll
    for (int ps = 0; ps < PASSES; ++ps)
#pragma unroll
        for (int j = 0; j < 4; ++j) { u32x4 o; o.x = pk2(v[ps][0][j], v[ps][1][j]); o.y = pk2(v[ps][2][j], v[ps][3][j]); o.z = pk2(v[ps][4][j], v[ps][5][j]); o.w = pk2(v[ps][6][j], v[ps][7][j]);
            *(u32x4*)(WT + (size_t)(n0 + 4 * nq + j) * K + k0 + 8 * (cq + NC * ps)) = o; }
}
template <int NW>
__device__ __forceinline__ void transpose_item8(const float* W, int K, int N, unsigned char* WT, int item, int lane) {
    constexpr int NQ = NW / 4, NC = 64 / NQ, PASSES = 8 / NC;
    const int nblk = N / NW, kb = item / nblk, nb = item % nblk, k0 = 64 * kb, n0 = NW * nb, nq = lane % NQ, cq = lane / NQ;
    f32x4 v[PASSES][8];
#pragma unroll
    for (int ps = 0; ps < PASSES; ++ps)
#pragma unroll
        for (int i = 0; i < 8; ++i) v[ps][i] = __builtin_nontemporal_load((const f32x4*)(W + (size_t)(k0 + 8 * (cq + NC * ps) + i) * N + n0 + 4 * nq)) * pg8::W8_S;
#pragma unroll
    for (int ps = 0; ps < PASSES; ++ps)
#pragma unroll
        for (int j = 0; j < 4; ++j) { unsigned w0 = 0, w1 = 0;
            w0 = __builtin_amdgcn_cvt_pk_fp8_f32(v[ps][0][j], v[ps][1][j], w0, false); w0 = __builtin_amdgcn_cvt_pk_fp8_f32(v[ps][2][j], v[ps][3][j], w0, true);
            w1 = __builtin_amdgcn_cvt_pk_fp8_f32(v[ps][4][j], v[ps][5][j], w1, false); w1 = __builtin_amdgcn_cvt_pk_fp8_f32(v[ps][6][j], v[ps][7][j], w1, true);
            __builtin_nontemporal_store((u32x2){w0, w1}, (u32x2*)(WT + (size_t)(n0 + 4 * nq + j) * K + k0 + 8 * (cq + NC * ps))); }
}
constexpr int CV_IT_GU = 16 * 64, CV_IT_DN = 16 * 32, CV_N_GU = 32 * CV_IT_GU, CV_N_DN = 32 * CV_IT_DN, CV_ITEMS = CV_N_GU + CV_N_DN, CV_CHUNK = 16, CV_NCHUNK = CV_ITEMS / CV_CHUNK;
__device__ __forceinline__ void convert_moe_items(const Ctx& C, const DArgs& a, int l, int it0, int it1) {
    const float* pwgu = a.in[I_WGU] + (size_t)l * 32 * DM * 2048; const float* pwdn = a.in[I_WDN] + (size_t)l * 32 * DM * DM;
    unsigned char* ogu = C.ws + WS_WGU + (size_t)l * 32 * 2048 * DM; unsigned char* odn = C.ws + WS_WDN + (size_t)l * 32 * DM * DM;
#pragma unroll 1
    for (int it = it0; it < it1; ++it) {
        if (it < CV_N_GU) { const int e = it / CV_IT_GU; transpose_item8<32>(pwgu + (size_t)e * DM * 2048, DM, 2048, ogu + (size_t)e * 2048 * DM, it % CV_IT_GU, C.lane); }
        else { const int r = it - CV_N_GU, e = r / CV_IT_DN; transpose_item8<32>(pwdn + (size_t)e * DM * DM, DM, DM, odn + (size_t)e * DM * DM, r % CV_IT_DN, C.lane); }
    }
}
__device__ __forceinline__ void phase_prologue(const Ctx& C, const DArgs& a) {
    constexpr int IT_IN = 16 * (INW / 32), IT_OUT = 16 * 16;
    constexpr int N_IN = 4 * IT_IN, N_OUT = 4 * IT_OUT;
    const float* pwin = a.in[I_WIN]; const float* pwout = a.in[I_WOUT];
    for (int it = C.gw; it < N_IN + N_OUT; it += C.NGW) {
        if (it < N_IN) { const int l = it / IT_IN; transpose_item<32>(pwin + (size_t)l * DM * INW, DM, INW, (bf16*)(C.ws + WS_WIN) + (size_t)l * INWP * DM, it % IT_IN, C.lane); }
        else { const int r = it - N_IN, l = r / IT_OUT; transpose_item<64>(pwout + (size_t)l * DM * DM, DM, DM, (bf16*)(C.ws + WS_WOUT) + (size_t)l * DM * DM, r % IT_OUT, C.lane); }
    }
    for (int ch = C.gw; ch < CV_NCHUNK; ch += C.NGW) convert_moe_items(C, a, 0, ch * CV_CHUNK, ch * CV_CHUNK + CV_CHUNK);
    { const int gt = C.wg * NTHR + C.tid; constexpr int PADN = (INWP - INW) * DM / 8;
      for (int i = gt; i < 4 * PADN; i += C.G * NTHR) { const int l = i / PADN, r = i % PADN; *((u32x4*)((bf16*)(C.ws + WS_WIN) + ((size_t)l * INWP + INW) * DM) + r) = (u32x4){0u, 0u, 0u, 0u}; } }
    { float* tw = (float*)(C.ws + WS_TW); const int gt = C.wg * NTHR + C.tid;
      for (int i = gt; i < 16384; i += C.G * NTHR) { const float x = (float)i * (1.0f / 8192.0f); tw[i] = cospif(x); tw[16384 + i] = sinpif(x); } }
    { float* mt = (float*)(C.ws + WS_MTAB); const int gt = C.wg * NTHR + C.tid; const float* pbmix = a.in[I_BMIX];
      for (int i = gt; i < 4 * 4 * 64 * 64; i += C.G * NTHR) { const int e = i & 63, c = (i >> 6) & 63, g = (i >> 12) & 3, l = i >> 14;
          const float* w = pbmix + ((size_t)(l * 4 + g) * 64) * 64 + e; float sc = 0.f, ss = 0.f;
          for (int cp = 0; cp < 64; ++cp) { const float x = (float)((c * cp) & 63) * (1.0f / 32.0f); const float wv = w[cp * 64]; sc += cospif(x) * wv; ss += sinpif(x) * wv; }
          mt[((size_t)(l * 2 + 0) * 4 + g) * 4096 + c * 64 + e] = sc; mt[((size_t)(l * 2 + 1) * 4 + g) * 4096 + c * 64 + e] = ss; } }
    { bf16* ft = (bf16*)(C.ws + WS_FTAB); const int gt = C.wg * NTHR + C.tid; const float* pbmix = a.in[I_BMIX];
      for (int i = gt; i < 128 * 128; i += C.G * NTHR) { const int k = i >> 7, t = i & 127; const float x = (float)((k * t) & 127) * (1.0f / 64.0f); ft[i] = (bf16)f2bf(cospif(x)); ft[16384 + i] = (bf16)f2bf(sinpif(x)); }
      bf16* mf = ft + 32768;
      for (int i = gt; i < 4 * 4 * 16 * 64 * 8; i += C.G * NTHR) { const int j8 = i & 7, ln = (i >> 3) & 63, fr = (i >> 9) & 15, gq = (i >> 13) & 3, l = i >> 15;
          const int ei = fr >> 2, ks2 = fr & 3, e = 16 * ei + (ln & 15), g = ln >> 4, c = 32 * (ks2 & 1) + 16 * (j8 >> 2) + 4 * g + (j8 & 3), part = ks2 >> 1;
          const float* w = pbmix + ((size_t)(l * 4 + gq) * 64) * 64 + e; float s = 0.f;
          for (int cp = 0; cp < 64; ++cp) { const float x = (float)((c * cp) & 63) * (1.0f / 32.0f); s += (part ? sinpif(x) : cospif(x)) * w[cp * 64]; }
          mf[i] = (bf16)f2bf(s * (1.0f / 1024.0f)); } }
    { const int gt = C.wg * NTHR + C.tid; const float* pg2 = a.in[I_DG2]; const float* prw = a.in[I_RW]; bf16* g2t = (bf16*)(C.ws + WS_G2T); bf16* rwt = (bf16*)(C.ws + WS_RWT);
      for (int i = gt; i < 4 * 256 * 160; i += C.G * NTHR) { const int ii = i % 160, c = (i / 160) & 255, l = i / (160 * 256); g2t[i] = (bf16)f2bf(pg2[((size_t)l * 160 + ii) * 256 + c]); }
      for (int i = gt; i < 4 * 32 * 1024; i += C.G * NTHR) { const int k = i & 1023, e = (i >> 10) & 31, l = i >> 15; rwt[i] = (bf16)f2bf(prw[((size_t)l * 1024 + k) * 32 + e]); } }
    { const int gt = C.wg * NTHR + C.tid; const float* pw2 = a.in[I_DW2]; const float* pa2 = a.in[I_DA2]; bf16* lt = (bf16*)(C.ws + WS_LORAT);
      for (int i = gt; i < 4 * 4 * 256 * 64; i += C.G * NTHR) { const int ii = i & 63, c = (i >> 6) & 255, q = (i >> 14) & 3, l = i >> 16;
          const float* src = (q < 2) ? pw2 : pa2; lt[i] = (bf16)f2bf(src[(((size_t)l * 2 + (q & 1)) * 64 + ii) * 256 + c]); } }
    { bf16* f2 = (bf16*)(C.ws + WS_F256); const int gt = C.wg * NTHR + C.tid;
      for (int i = gt; i < 256 * 256; i += C.G * NTHR) { const int k = i >> 8, t = i & 255; const float x = (float)((k * t) & 255) * (1.0f / 128.0f); f2[i] = (bf16)f2bf(cospif(x)); f2[65536 + i] = (bf16)f2bf(sinpif(x)); } }
    { LAS float* sl = (LAS float*)(C.lds);
      LAS float* red = (LAS float*)(C.lds + 8192);
      __syncthreads();
      const float* pc = a.in[I_C]; const float* pcc = a.in[I_CCTX]; const float* padaw = a.in[I_ADAW]; const float* padab = a.in[I_ADAB];
      for (int i = C.tid; i < 2048; i += NTHR) { const float x = (i < 1024) ? pc[i] : pcc[i - 1024]; sl[i] = x * sigmoidf_(x); }
      __syncthreads();
      float* mod = (float*)(C.ws + WS_MOD);
      for (int u = C.wg; u < 4 * 96; u += C.G) { const int l = u / 96, jb = u % 96, j0 = jb * 64 + C.lane;
          float s0 = 0.f, s1 = 0.f; const float* w = padaw + (size_t)l * DM * 6144 + j0; const int k0 = C.wave * 128;
#pragma unroll 16
          for (int k = 0; k < 128; ++k) { const float wv = w[(size_t)(k0 + k) * 6144]; s0 += wv * sl[k0 + k]; s1 += wv * sl[1024 + k0 + k]; }
          red[(C.wave * 2 + 0) * 64 + C.lane] = s0; red[(C.wave * 2 + 1) * 64 + C.lane] = s1;
          __syncthreads();
          if (C.tid < 128) { const int v = C.tid >> 6, j = C.tid & 63; float s = 0.f;
#pragma unroll
              for (int wv = 0; wv < 8; ++wv) s += red[(wv * 2 + v) * 64 + j];
              mod[(size_t)(l * 2 + v) * 6144 + jb * 64 + j] = s + padab[(size_t)l * 6144 + jb * 64 + j]; }
          __syncthreads(); } }
}

__device__ __forceinline__ void load_row(const float* p, int lane, f32x4 (&v)[4]) {
#pragma unroll
    for (int j = 0; j < 4; ++j) v[j] = *((const f32x4*)p + lane + 64 * j);
}
__device__ __forceinline__ void moe_combine_row(const Ctx& C, int row, f32x4 (&v)[4], const f32x4 (&gt2q)[4]) {
    const int* dest = (const int*)(C.ws + WS_ROUTE) + (size_t)3 * ROWS * 4; const float* gate = (const float*)(C.ws + WS_ROUTE) + (size_t)1 * ROWS * 4;
    const bf16* YB = (const bf16*)(C.ws + WS_XG);
    f32x4 s[4];
#pragma unroll
    for (int j = 0; j < 4; ++j) s[j] = (f32x4){0.f, 0.f, 0.f, 0.f};
#pragma unroll
    for (int k = 0; k < 4; ++k) { const int d = dest[row * 4 + k]; const float g = gate[row * 4 + k]; const u32x2* yp = (const u32x2*)(YB + (size_t)d * DM) + C.lane;
#pragma unroll
        for (int j = 0; j < 4; ++j) { const u32x2 w = yp[64 * j]; s[j] += (f32x4){bflo(w.x), bfhi(w.x), bflo(w.y), bfhi(w.y)} * g; } }
#pragma unroll
    for (int j = 0; j < 4; ++j) v[j] += gt2q[j] * s[j];
}
__device__ __forceinline__ float row_rstd(const f32x4 (&v)[4], int lane) {
    float s = 0.f;
#pragma unroll
    for (int j = 0; j < 4; ++j) s += (v[j].x * v[j].x + v[j].y * v[j].y) + (v[j].z * v[j].z + v[j].w * v[j].w);
    return rsqrtf(wave_sum(s, lane) * (1.f / DM) + 1e-6f);
}
__device__ __forceinline__ void norm1_fetch(const Ctx& C, const float* src_row, int row, bool combine, const f32x4 (&gt2q)[4], f32x4 (&v)[4]) {
    load_row(src_row, C.lane, v);
    if (combine) moe_combine_row(C, row, v, gt2q);
}
__device__ __forceinline__ void phase_norm1(const Ctx& C, const DArgs& a, int l) {
    float* XS = (float*)(C.ws + WS_XS); bf16* H = (bf16*)(C.ws + WS_H); const float* mod = (const float*)(C.ws + WS_MOD);
    const float* g1 = a.in[I_N1G] + (size_t)l * DM;
    const float* pctx = a.in[I_CTX]; const float* px = a.in[I_X];
    f32x4 gq[4], shq[4], scq[4], gt2q[4];
#pragma unroll
    for (int j = 0; j < 4; ++j) gt2q[j] = *((const f32x4*)(mod + (size_t)((l > 0 ? l - 1 : 0) * 2) * 6144 + 5 * DM) + C.lane + 64 * j);
#pragma unroll
    for (int j = 0; j < 4; ++j) { gq[j] = *((const f32x4*)g1 + C.lane + 64 * j); shq[j] = *((const f32x4*)(mod + (size_t)(l * 2) * 6144) + C.lane + 64 * j); scq[j] = *((const f32x4*)(mod + (size_t)(l * 2) * 6144 + DM) + C.lane + 64 * j) + 1.0f; }
    for (int row0 = C.gw; row0 < ROWS; row0 += 2 * C.NGW) {
        f32x4 v[2][4]; const int rows[2] = {row0, row0 + C.NGW};
#pragma unroll
        for (int q = 0; q < 2; ++q) if (rows[q] < ROWS) { const int row = rows[q]; const bool isctx = row < NCTX;
            const float* src = (l == 0) ? (isctx ? pctx + (size_t)row * DM : px + (size_t)(row - NCTX) * DM) : XS + (size_t)row * DM;
            if (isctx && l > 0) { f32x4 gc4[4];
#pragma unroll
                for (int j = 0; j < 4; ++j) gc4[j] = *((const f32x4*)(mod + (size_t)((l - 1) * 2 + 1) * 6144 + 5 * DM) + C.lane + 64 * j);
                norm1_fetch(C, src, row, true, gc4, v[q]); }
            else norm1_fetch(C, src, row, l > 0, gt2q, v[q]); }
#pragma unroll
        for (int q = 0; q < 2; ++q) if (rows[q] < ROWS) { const int row = rows[q]; const bool isctx = row < NCTX;
#pragma unroll
            for (int j = 0; j < 4; ++j) *((f32x4*)(XS + (size_t)row * DM) + C.lane + 64 * j) = v[q][j];
            const float rstd = row_rstd(v[q], C.lane);
            const float* md = mod + (size_t)(l * 2 + (isctx ? 1 : 0)) * 6144;
            u32x2* o = (u32x2*)(H + (size_t)row * DM) + C.lane;
#pragma unroll
            for (int j = 0; j < 4; ++j) { f32x4 sh = shq[j], sc1 = scq[j]; if (isctx) { sh = *((const f32x4*)md + C.lane + 64 * j); sc1 = *((const f32x4*)(md + DM) + C.lane + 64 * j) + 1.0f; }
                const f32x4 y = v[q][j] * rstd * gq[j] * sc1 + sh; u32x2 w; w.x = pk2(y.x, y.y); w.y = pk2(y.z, y.w); o[64 * j] = w; } }
    }
}
__device__ __forceinline__ void phase_final(const Ctx& C, const DArgs& a) {
    const float* XS = (const float*)(C.ws + WS_XS); const float* mod = (const float*)(C.ws + WS_MOD); const float* g = a.in[I_FNG];
    const float* gt2 = mod + (size_t)((DEPTH - 1) * 2 + 0) * 6144 + 5 * DM;
    f32x4 gq[4], gt2q[4];
#pragma unroll
    for (int j = 0; j < 4; ++j) { gq[j] = *((const f32x4*)g + C.lane + 64 * j); gt2q[j] = *((const f32x4*)gt2 + C.lane + 64 * j); }
    for (int row0 = NCTX + C.gw; row0 < ROWS; row0 += 2 * C.NGW) {
        f32x4 v[2][4]; const int rows[2] = {row0, row0 + C.NGW};
#pragma unroll
        for (int q = 0; q < 2; ++q) if (rows[q] < ROWS) norm1_fetch(C, XS + (size_t)rows[q] * DM, rows[q], true, gt2q, v[q]);
#pragma unroll
        for (int q = 0; q < 2; ++q) if (rows[q] < ROWS) { const float rstd = row_rstd(v[q], C.lane); float* o = a.out + (size_t)(rows[q] - NCTX) * DM;
#pragma unroll
            for (int j = 0; j < 4; ++j) *((f32x4*)o + C.lane + 64 * j) = v[q][j] * rstd * gq[j]; }
    }
}
constexpr int NR2 = 9;
__device__ __forceinline__ void phase_norm2(const Ctx& C, const DArgs& a, int l) {
    const float* XS = (const float*)(C.ws + WS_XS); bf16* H = (bf16*)(C.ws + WS_H); const float* mod = (const float*)(C.ws + WS_MOD);
    const float* g2 = a.in[I_N2G] + (size_t)l * DM; const float* rb = a.in[I_RB] + (size_t)l * NEXP; const bf16* rwt = (const bf16*)(C.ws + WS_RWT) + (size_t)l * NEXP * DM;
    int* tok_e = (int*)(C.ws + WS_ROUTE); float* gate = (float*)(C.ws + WS_ROUTE) + (size_t)1 * ROWS * 4; int* slot = (int*)(C.ws + WS_ROUTE) + (size_t)2 * ROWS * 4;
    LAS float* lg = (LAS float*)(C.lds + C.wave * 4096);
    LAS int* hist = (LAS int*)(C.lds + MISC_OFF + 64);
    const int lane = C.lane, li = lane & 15, g = lane >> 4;
    if (C.tid < NEXP) hist[C.tid] = 0;
    __syncthreads();
    const int row_base = (l == DEPTH - 1) ? NCTX : 0, ntile = (ROWS - row_base + NR2 - 1) / NR2;
    f32x4 gq[4], shq[4], scq[4];
#pragma unroll
    for (int j = 0; j < 4; ++j) { gq[j] = *((const f32x4*)g2 + lane + 64 * j); shq[j] = *((const f32x4*)(mod + (size_t)(l * 2) * 6144 + 3 * DM) + lane + 64 * j); scq[j] = *((const f32x4*)(mod + (size_t)(l * 2) * 6144 + 4 * DM) + lane + 64 * j) + 1.0f; }
    for (int tl = C.gw; tl < ntile; tl += C.NGW) {
        const int trow0 = row_base + NR2 * tl, nrow = (ROWS - trow0 < NR2) ? ROWS - trow0 : NR2;
#pragma unroll 1
        for (int rr = 0; rr < nrow; ++rr) { const int row = trow0 + rr; const bool isctx = row < NCTX; f32x4 v[4]; load_row(XS + (size_t)row * DM, lane, v);
            const float rstd = row_rstd(v, lane);
            const float* md = mod + (size_t)(l * 2 + (isctx ? 1 : 0)) * 6144 + 3 * DM;
            u32x2* o = (u32x2*)(H + (size_t)row * DM) + lane;
#pragma unroll
            for (int j = 0; j < 4; ++j) { f32x4 sh = shq[j], sc1 = scq[j]; if (isctx) { sh = *((const f32x4*)md + lane + 64 * j); sc1 = *((const f32x4*)(md + DM) + lane + 64 * j) + 1.0f; }
                const f32x4 y = v[j] * rstd * gq[j] * sc1 + sh; u32x2 w; w.x = pk2(y.x, y.y); w.y = pk2(y.z, y.w); o[64 * j] = w; } }
        asm volatile("s_waitcnt vmcnt(0)" ::: "memory");
        f32x4 acc0 = {0.f, 0.f, 0.f, 0.f}, acc1 = {0.f, 0.f, 0.f, 0.f};
        const int arow = (trow0 + li < ROWS) ? trow0 + li : ROWS - 1;
        const bf16* ap = H + (size_t)arow * DM + 8 * g; const bf16* bp0 = rwt + (size_t)li * DM + 8 * g; const bf16* bp1 = bp0 + 16 * DM;
#pragma unroll 4
        for (int ks = 0; ks < 32; ++ks) { const bf16x8 af = *(const bf16x8*)(ap + 32 * ks); acc0 = mfma16(af, *(const bf16x8*)(bp0 + 32 * ks), acc0); acc1 = mfma16(af, *(const bf16x8*)(bp1 + 32 * ks), acc1); }
#pragma unroll
        for (int r = 0; r < 4; ++r) { lg[(4 * g + r) * 33 + li] = acc0[r]; lg[(4 * g + r) * 33 + 16 + li] = acc1[r]; }
        LDS_WAIT(); asm volatile("" ::: "memory");
        const int e = lane & 31; const float rbe = rb[e];
#pragma unroll 1
        for (int rr = 0; rr < nrow; ++rr) { const int row = trow0 + rr;
            float val = lg[rr * 33 + e] + rbe; int te[4]; float tv[4];
#pragma unroll
            for (int k = 0; k < 4; ++k) { float bv = val; int bi = e;
#define AMAX_ROR(n) { const float ov = __builtin_bit_cast(float, __builtin_amdgcn_update_dpp(0, __builtin_bit_cast(int, bv), 0x120 + (n), 0xf, 0xf, false)); const int oi = __builtin_amdgcn_update_dpp(0, bi, 0x120 + (n), 0xf, 0xf, false); \
                    if (ov > bv || (ov == bv && oi < bi)) { bv = ov; bi = oi; } }
                AMAX_ROR(8) AMAX_ROR(4) AMAX_ROR(2) AMAX_ROR(1)
#undef AMAX_ROR
                { const float ov = shx(bv, 16, lane); const int oi = shxi(bi, 16, lane); if (ov > bv || (ov == bv && oi < bi)) { bv = ov; bi = oi; } }
                te[k] = bi; tv[k] = bv; if (e == bi) val = -3.0e38f; }
            if (lane == 0) { const float m = tv[0]; float p[4], ps = 0.f;
#pragma unroll
                for (int k = 0; k < 4; ++k) { p[k] = __expf(tv[k] - m); ps += p[k]; }
#pragma unroll
                for (int k = 0; k < 4; ++k) { tok_e[row * 4 + k] = te[k]; gate[row * 4 + k] = p[k] / ps; slot[row * 4 + k] = __hip_atomic_fetch_add(&hist[te[k]], 1, __ATOMIC_RELAXED, __HIP_MEMORY_SCOPE_WORKGROUP); } } }
        asm volatile("" ::: "memory");
    }
    __syncthreads();
    if (C.tid < NEXP) ((int*)(C.ws + WS_CNT))[C.wg * NEXP + C.tid] = hist[C.tid];
}
__device__ __forceinline__ int moe_tables(const Ctx& C) {
    const int* cnt = (const int*)(C.ws + WS_CNT);
    LAS int* part = (LAS int*)(C.lds);
    LAS int* pstart = (LAS int*)(C.lds + MISC_OFF + 256); LAS int* wgbase = pstart + 40; LAS int* tot = wgbase + 32; LAS int* nblk_s = tot + 32;
    LAS unsigned char* blk_e = (LAS unsigned char*)(C.lds + MISC_OFF + 1024);
    __syncthreads();
    { const int e = C.tid & 31, p = C.tid >> 5; int t = 0, pre = 0;
#pragma unroll 1
      for (int w = p * 16; w < p * 16 + 16; ++w) { const int c = cnt[w * NEXP + e]; t += c; if (w < C.wg) pre += c; }
      part[(p * 32 + e) * 2] = t; part[(p * 32 + e) * 2 + 1] = pre; }
    __syncthreads();
    if (C.tid < NEXP) { int t = 0, pre = 0;
#pragma unroll 1
        for (int p = 0; p < 16; ++p) { t += part[(p * 32 + C.tid) * 2]; pre += part[(p * 32 + C.tid) * 2 + 1]; }
        tot[C.tid] = t; wgbase[C.tid] = pre; }
    __syncthreads();
    if (C.tid == 0) { int b = 0;
#pragma unroll 1
        for (int e = 0; e < NEXP; ++e) { pstart[e] = b * 256; b += (tot[e] + 255) >> 8; }
        pstart[NEXP] = b * 256; nblk_s[0] = b; }
    __syncthreads();
    if (C.tid < NEXP) wgbase[C.tid] += pstart[C.tid];
    if (C.tid < MOE_MAXBLK) { int e = 0;
#pragma unroll 1
        for (int k = 1; k < NEXP; ++k) if (pstart[k] <= C.tid * 256) e = k;
        blk_e[C.tid] = (unsigned char)e; }
    __syncthreads();
    return __builtin_amdgcn_readfirstlane(nblk_s[0]);
}
__device__ __forceinline__ void phase_gather(const Ctx& C, const DArgs& a, int l) {
    moe_tables(C);
    const LAS int* wgbase = (const LAS int*)(C.lds + MISC_OFF + 256) + 40;
    const int* tok_e = (const int*)(C.ws + WS_ROUTE); const int* slot = (const int*)(C.ws + WS_ROUTE) + (size_t)2 * ROWS * 4; int* dest = (int*)(C.ws + WS_ROUTE) + (size_t)3 * ROWS * 4;
    const bf16* H = (const bf16*)(C.ws + WS_H); unsigned char* XG = C.ws + WS_XG8;
    const int row_base = (l == DEPTH - 1) ? NCTX : 0, ntile = (ROWS - row_base + NR2 - 1) / NR2;
    for (int tl = C.gw; tl < ntile; tl += C.NGW)
    for (int row = row_base + NR2 * tl; row < row_base + NR2 * tl + NR2 && row < ROWS; ++row) {
        const u32x4* src = (const u32x4*)(H + (size_t)row * DM) + C.lane; const u32x4 v0 = src[0], v1 = src[64];
        u32x2 q0, q1;
        { unsigned w = 0; w = __builtin_amdgcn_cvt_pk_fp8_f32(bflo(v0.x) * pg8::X8_S, bfhi(v0.x) * pg8::X8_S, w, false); w = __builtin_amdgcn_cvt_pk_fp8_f32(bflo(v0.y) * pg8::X8_S, bfhi(v0.y) * pg8::X8_S, w, true); q0.x = w;
          w = 0; w = __builtin_amdgcn_cvt_pk_fp8_f32(bflo(v0.z) * pg8::X8_S, bfhi(v0.z) * pg8::X8_S, w, false); w = __builtin_amdgcn_cvt_pk_fp8_f32(bflo(v0.w) * pg8::X8_S, bfhi(v0.w) * pg8::X8_S, w, true); q0.y = w;
          w = 0; w = __builtin_amdgcn_cvt_pk_fp8_f32(bflo(v1.x) * pg8::X8_S, bfhi(v1.x) * pg8::X8_S, w, false); w = __builtin_amdgcn_cvt_pk_fp8_f32(bflo(v1.y) * pg8::X8_S, bfhi(v1.y) * pg8::X8_S, w, true); q1.x = w;
          w = 0; w = __builtin_amdgcn_cvt_pk_fp8_f32(bflo(v1.z) * pg8::X8_S, bfhi(v1.z) * pg8::X8_S, w, false); w = __builtin_amdgcn_cvt_pk_fp8_f32(bflo(v1.w) * pg8::X8_S, bfhi(v1.w) * pg8::X8_S, w, true); q1.y = w; }
#pragma unroll
        for (int k = 0; k < 4; ++k) { const int d = wgbase[tok_e[row * 4 + k]] + slot[row * 4 + k]; if (C.lane == 0) dest[row * 4 + k] = d;
            u32x2* dp = (u32x2*)(XG + (size_t)d * DM) + C.lane; dp[0] = q0; dp[64] = q1; }
    }
}

__device__ __forceinline__ void mix1_rope(const Ctx& C) {
    bf16* P = (bf16*)(C.ws + WS_P);
    const long total = (long)SEQ * 192;
    for (long i = (long)C.wg * NTHR + C.tid; i < total; i += (long)C.G * NTHR) {
        const int j = (int)(i & 31), hh = (int)((i >> 5) % 6), t = (int)(i / 192);
        const int col = (hh < 4) ? (C_AQ + hh * 64) : (C_AK + (hh - 4) * 64);
        const float pos = (j < 16) ? (float)(t >> 6) : (float)(t & 63);
        const float inv = __powf(10000.0f, -(float)(j & 15) * (1.0f / 16.0f));
        const float ang = pos * inv * 0.31830988618379067f;
        const float cs = cospif(ang), sn = sinpif(ang);
        bf16* p = P + (size_t)(NCTX + t) * INWP + col;
        const float x1 = bf2f(p[j]), x2 = bf2f(p[j + 32]);
        p[j] = (bf16)f2bf(x1 * cs - x2 * sn); p[j + 32] = (bf16)f2bf(x2 * cs + x1 * sn);
    }
}
__device__ __forceinline__ void mix1_vt(const Ctx& C) {
    const bf16* P = (const bf16*)(C.ws + WS_P);
    LAS unsigned short* scr = (LAS unsigned short*)(C.lds + C.wave * 16384);
    for (int u = C.gw; u < (ROWS / 64) * 6; u += C.NGW) {
        const int hd = u % 6, tb = u / 6; const int vcol = (hd < 2) ? (C_AV + hd * 64) : (C_CV + (hd - 2) * 64);
        bf16* VT = ((hd < 2) ? (bf16*)(C.ws + WS_VTA) + (size_t)hd * 64 * VTP : (bf16*)(C.ws + WS_VTC) + (size_t)(hd - 2) * 64 * VTP);
#pragma unroll
        for (int i = 0; i < 8; ++i) { const int tk = (C.lane >> 3) + 8 * i, ch = C.lane & 7; const u32x4 w = *(const u32x4*)(P + (size_t)(tb * 64 + tk) * INWP + vcol + 8 * ch);
            LAS unsigned* d = (LAS unsigned*)(scr + tk * 66 + 8 * ch); d[0] = w.x; d[1] = w.y; d[2] = w.z; d[3] = w.w; }
        LDS_WAIT(); asm volatile("" ::: "memory");
#pragma unroll
        for (int k8 = 0; k8 < 8; ++k8) { unsigned w[4];
#pragma unroll
            for (int e2 = 0; e2 < 4; ++e2) { const unsigned lo = scr[(8 * k8 + 2 * e2) * 66 + C.lane], hi = scr[(8 * k8 + 2 * e2 + 1) * 66 + C.lane]; w[e2] = lo | (hi << 16); }
            *(u32x4*)(VT + (size_t)C.lane * VTP + tb * 64 + 8 * k8) = (u32x4){w[0], w[1], w[2], w[3]}; }
        LDS_WAIT(); asm volatile("" ::: "memory");
    }
    for (int i = C.wg * NTHR + C.tid; i < 6 * 64 * 32; i += C.G * NTHR) { const int rowi = i >> 5, pc = i & 31; const int hd = rowi >> 6, d = rowi & 63;
        bf16* VT = ((hd < 2) ? (bf16*)(C.ws + WS_VTA) + (size_t)hd * 64 * VTP : (bf16*)(C.ws + WS_VTC) + (size_t)(hd - 2) * 64 * VTP);
        *(u32x4*)(VT + (size_t)d * VTP + ROWS + 8 * pc) = (u32x4){0u, 0u, 0u, 0u}; }
}
__device__ __forceinline__ float conv3(const bf16* P, int row, int col, const float* cw, int cc) {
    const bool first = (row == 0) || (row == NCTX), last = (row == NCTX - 1) || (row == ROWS - 1);
    float s = cw[768 + cc] * bf2f(P[(size_t)row * INWP + col]);
    if (!first) s += cw[cc] * bf2f(P[(size_t)(row - 1) * INWP + col]);
    if (!last) s += cw[2 * 768 + cc] * bf2f(P[(size_t)(row + 1) * INWP + col]);
    return s;
}
__device__ __forceinline__ void mix1_rwkv_prep(const Ctx& C, const DArgs& a, int l) {
    const bf16* P = (const bf16*)(C.ws + WS_P); float* SC = (float*)(C.ws + WS_SC);
    constexpr int LBP = 264;
    LAS unsigned char* lob = C.lds;
    LAS float* pre = (LAS float*)(C.lds + 16384);
    const bf16* lorat = (const bf16*)(C.ws + WS_LORAT) + (size_t)l * 4 * 256 * 64;
    const float* cw = a.in[I_DCONV] + (size_t)l * 3 * 768;
    const float* w0 = a.in[I_DW0] + (size_t)l * 512; const float* a0 = a.in[I_DA0] + (size_t)l * 512;
    const float* kkw = a.in[I_DKK] + (size_t)l * 256; const float* kaw = a.in[I_DKA] + (size_t)l * 256;
    const int half = C.tid >> 8, c = C.tid & 255, lane = C.lane, li = lane & 15, g = lane >> 4;
    const float kkc = kkw[c], kac = kaw[c];
    bf16x8 lrf[4][2][2];
#pragma unroll
    for (int q = 0; q < 4; ++q)
#pragma unroll
        for (int c2 = 0; c2 < 2; ++c2) { const bf16* bp = lorat + ((size_t)q * 256 + 16 * (2 * C.wave + c2) + li) * 64 + 8 * g; lrf[q][c2][0] = ldg8(bp); lrf[q][c2][1] = ldg8(bp + 32); }
    const float w0c[2] = {w0[c], w0[256 + c]}, a0c[2] = {a0[c], a0[256 + c]};
    const float cr0 = cw[c], cr1 = cw[768 + c], cr2 = cw[1536 + c], ck0 = cw[256 + c], ck1 = cw[768 + 256 + c], ck2 = cw[1536 + 256 + c], cv0 = cw[512 + c], cv1 = cw[768 + 512 + c], cv2 = cw[1536 + 512 + c];
    bf16 lin[7];
#define LIN_FETCH(gg) do { const int r0_ = 13 * (gg) + 7 * half; _Pragma("unroll") for (int j = 0; j < 7; ++j) if (j < 7 - half) lin[j] = P[(size_t)(r0_ + j) * INWP + C_WL + c]; } while (0)
    if (C.wg < ROWS / 13) LIN_FETCH(C.wg);
    for (int grp = C.wg; grp < ROWS / 13; grp += C.G) {
        const int row0 = 13 * grp + 7 * half, nj = 7 - half;
        __syncthreads();
#pragma unroll
        for (int j = 0; j < 7; ++j) if (j < nj) { const float x = bf2f(lin[j]); *(LAS bf16*)(lob + ((7 * half + j) * LBP + c) * 2) = (bf16)f2bf((c < 128) ? tanhf(x) : x); }
        __syncthreads();
        float xr[9], xk[9], xv[9];
#pragma unroll
        for (int q = 0; q < 9; ++q) { const int rw = row0 - 1 + q; const bool in = (rw >= 0) && (rw < ROWS) && (q <= nj + 1);
            const bf16* pp = P + (size_t)(in ? rw : row0) * INWP; xr[q] = in ? bf2f(pp[C_DR + c]) : 0.f; xk[q] = in ? bf2f(pp[C_DK + c]) : 0.f; xv[q] = in ? bf2f(pp[C_DV + c]) : 0.f; }
#pragma unroll
        for (int q = 0; q < 4; ++q) { const bf16x8 a0f = ldA(lob, LBP, 0, 64 * q, li, g), a1f = ldA(lob, LBP, 0, 64 * q + 32, li, g);
#pragma unroll
            for (int c2 = 0; c2 < 2; ++c2) { const int ci = 2 * C.wave + c2;
                f32x4 acc = {0.f, 0.f, 0.f, 0.f}; acc = mfma16(a0f, lrf[q][c2][0], acc); acc = mfma16(a1f, lrf[q][c2][1], acc);
#pragma unroll
                for (int r = 0; r < 4; ++r) pre[(q * 16 + 4 * g + r) * 256 + 16 * ci + li] = acc[r]; } }
        __syncthreads();
        if (grp + C.G < ROWS / 13) LIN_FETCH(grp + C.G);
#pragma unroll
        for (int j = 0; j < 7; ++j) if (j < nj) { const int row = row0 + j, rl = 7 * half + j;
            const bool first = (row == 0) || (row == NCTX), last = (row == NCTX - 1) || (row == ROWS - 1);
            const float m0 = first ? 0.f : 1.f, m2 = last ? 0.f : 1.f;
            const float r = cr1 * xr[j + 1] + m0 * cr0 * xr[j] + m2 * cr2 * xr[j + 2], k = ck1 * xk[j + 1] + m0 * ck0 * xk[j] + m2 * ck2 * xk[j + 2], v = cv1 * xv[j + 1] + m0 * cv0 * xv[j] + m2 * cv2 * xv[j + 2];
            float kk = k * kkc; const float n2 = wave_sum(kk * kk, lane); kk *= rsqrtf(fmaxf(n2, 1e-24f));
            float* sc = SC + (size_t)row * 9 * 256; sc[c] = r; sc[256 + c] = v; sc[512 + c] = -kk;
#pragma unroll
            for (int d = 0; d < 2; ++d) { const float wp = w0c[d] + pre[(d * 16 + rl) * 256 + c], ap = a0c[d] + pre[((2 + d) * 16 + rl) * 256 + c];
                const float nw = -wp, sp = fmaxf(nw, 0.f) + log1pf(__expf(-fabsf(nw)));
                const float lw = -__expf(-sp - 0.5f);
                const float as = sigmoidf_(ap);
                sc[(3 + 3 * d) * 256 + c] = lw; sc[(4 + 3 * d) * 256 + c] = k * (1.0f + (as - 1.0f) * kac); sc[(5 + 3 * d) * 256 + c] = kk * as; } }
    }
#undef LIN_FETCH
    __syncthreads();
}
constexpr int FP = 136;
constexpr int F_TABC = 0, F_TABS = 128 * FP * 2, F_TILE = 2 * 128 * FP * 2;
__device__ __forceinline__ void fourier_load_tables(const Ctx& C) {
    const bf16* ft = (const bf16*)(C.ws + WS_FTAB);
    for (int i = C.tid; i < 2 * 128 * 16; i += NTHR) { const int tb = i >> 11, r = (i >> 4) & 127, c8 = i & 15;
        *(LAS u32x4*)(C.lds + tb * F_TABS + (r * FP + 8 * c8) * 2) = *(const u32x4*)(ft + tb * 16384 + r * 128 + 8 * c8); }
}
__device__ __forceinline__ void mix1_fourier1(const Ctx& C) {
    const bf16* P = (const bf16*)(C.ws + WS_P); const float* tw = (const float*)(C.ws + WS_TW);
    bf16* FYR = (bf16*)(C.ws + WS_FYR); bf16* FYI = (bf16*)(C.ws + WS_FYI);
    const int lane = C.lane, li = lane & 15, g = lane >> 4, w = C.wave;
    __syncthreads();
    fourier_load_tables(C);
    for (int u = C.wg; u < 256; u += C.G) {
        const int t2 = u >> 1, ch0 = (u & 1) * 128;
        __syncthreads();
        for (int i = C.tid; i < 128 * 16; i += NTHR) { const int t1 = i >> 4, c8 = i & 15;
            *(LAS u32x4*)(C.lds + F_TILE + (t1 * FP + 8 * c8) * 2) = *(const u32x4*)(P + (size_t)(NCTX + 128 * t1 + t2) * INWP + C_BU + ch0 + 8 * c8); }
        __syncthreads();
        bf16x8 af[4];
#pragma unroll
        for (int ks = 0; ks < 4; ++ks) af[ks] = ldT(C.lds + F_TILE, FP, 32 * ks, 16 * w, li, g);
#pragma unroll 1
        for (int ni = 0; ni < 8; ++ni) { f32x4 dc = {0.f, 0.f, 0.f, 0.f}, ds = {0.f, 0.f, 0.f, 0.f};
#pragma unroll
            for (int ks = 0; ks < 4; ++ks) { dc = mfma16(af[ks], ldA(C.lds + F_TABC, FP, 16 * ni, 32 * ks, li, g), dc); ds = mfma16(af[ks], ldA(C.lds + F_TABS, FP, 16 * ni, 32 * ks, li, g), ds); }
            const int k1 = 16 * ni + li; const float cp = tw[t2 * k1], sp = tw[16384 + t2 * k1];
            const f32x4 yr = dc * cp - ds * sp, yi = -(ds * cp) - dc * sp;
            const size_t o = ((size_t)k1 * 128 + t2) * 256 + ch0 + 16 * w + 4 * g;
            u32x2 wr; wr.x = pk2(yr[0], yr[1]); wr.y = pk2(yr[2], yr[3]); *(u32x2*)(FYR + o) = wr;
            u32x2 wi; wi.x = pk2(yi[0], yi[1]); wi.y = pk2(yi[2], yi[3]); *(u32x2*)(FYI + o) = wi; }
    }
    __syncthreads();
}
__device__ __forceinline__ void fourier2_mfma(const Ctx& C, int l, int wg0) {
    const bf16* FYR = (const bf16*)(C.ws + WS_FYR); const bf16* FYI = (const bf16*)(C.ws + WS_FYI); bf16* MIX = (bf16*)(C.ws + WS_MIX);
    const int lane = C.lane, li = lane & 15, g = lane >> 4, w = C.wave;
    constexpr int YP = 72, F_YR = F_TILE, F_YI = F_TILE + 128 * YP * 2;
    __syncthreads();
    fourier_load_tables(C);
    bf16x8 mff[16];
    { const bf16x8* mf = (const bf16x8*)((const bf16*)(C.ws + WS_FTAB) + 32768) + (size_t)(l * 4 + ((C.wg - wg0) & 3)) * 16 * 64;
#pragma unroll
      for (int k = 0; k < 16; ++k) mff[k] = mf[k * 64 + lane]; }
    for (int u = C.wg - wg0; u < 512; u += C.G - wg0) {
        const int k1 = u >> 2, gq = u & 3;
        __syncthreads();
        for (int i = C.tid; i < 2 * 128 * 8; i += NTHR) { const int im = i >> 10, t2 = (i >> 3) & 127, c8 = i & 7;
            *(LAS u32x4*)(C.lds + (im ? F_YI : F_YR) + (t2 * YP + 8 * c8) * 2) = *(const u32x4*)((im ? FYI : FYR) + ((size_t)k1 * 128 + t2) * 256 + gq * 64 + 8 * c8); }
        __syncthreads();
        bf16x8 bc[4], bs[4];
#pragma unroll
        for (int ks = 0; ks < 4; ++ks) { bc[ks] = ldA(C.lds + F_TABC, FP, 16 * w, 32 * ks, li, g); bs[ks] = ldA(C.lds + F_TABS, FP, 16 * w, 32 * ks, li, g); }
        f32x4 xr[4], xi[4];
#pragma unroll
        for (int ci = 0; ci < 4; ++ci) { xr[ci] = (f32x4){0.f, 0.f, 0.f, 0.f}; f32x4 xs = {0.f, 0.f, 0.f, 0.f}; xi[ci] = xs;
#pragma unroll
            for (int ks = 0; ks < 4; ++ks) { const bf16x8 ar = ldT(C.lds + F_YR, YP, 32 * ks, 16 * ci, li, g), ai = ldT(C.lds + F_YI, YP, 32 * ks, 16 * ci, li, g);
                xr[ci] = mfma16(ar, bc[ks], xr[ci]); xr[ci] = mfma16(ai, bs[ks], xr[ci]);
                xi[ci] = mfma16(ai, bc[ks], xi[ci]); xs = mfma16(ar, bs[ks], xs); }
            xi[ci] = xi[ci] - xs; }
        union { bf16x8 v; unsigned q[4]; } xb[4];
#pragma unroll
        for (int q2 = 0; q2 < 2; ++q2) { xb[q2].q[0] = pk2(xr[2 * q2][0], xr[2 * q2][1]); xb[q2].q[1] = pk2(xr[2 * q2][2], xr[2 * q2][3]); xb[q2].q[2] = pk2(xr[2 * q2 + 1][0], xr[2 * q2 + 1][1]); xb[q2].q[3] = pk2(xr[2 * q2 + 1][2], xr[2 * q2 + 1][3]);
            xb[2 + q2].q[0] = pk2(xi[2 * q2][0], xi[2 * q2][1]); xb[2 + q2].q[1] = pk2(xi[2 * q2][2], xi[2 * q2][3]); xb[2 + q2].q[2] = pk2(xi[2 * q2 + 1][0], xi[2 * q2 + 1][1]); xb[2 + q2].q[3] = pk2(xi[2 * q2 + 1][2], xi[2 * q2 + 1][3]); }
#pragma unroll
        for (int ei = 0; ei < 4; ++ei) { f32x4 o = {0.f, 0.f, 0.f, 0.f};
#pragma unroll
            for (int ks2 = 0; ks2 < 4; ++ks2) o = mfma16(mff[ei * 4 + ks2], xb[ks2].v, o);
            const int tp = k1 + 128 * (16 * w + li);
            u32x2 wo; wo.x = pk2(o[0], o[1]); wo.y = pk2(o[2], o[3]); *(u32x2*)(MIX + (size_t)(NCTX + tp) * DM + 256 + gq * 64 + 16 * ei + 4 * g) = wo; }
    }
    __syncthreads();
}

constexpr float LOG2E = 1.4426950408889634f;
typedef short bf16x4 __attribute__((ext_vector_type(4)));
__device__ __forceinline__ void attn_load(const bf16* P, const bf16* VT, int krow, int kcol, int li, int g, bf16x8 (&kf)[2][2], bf16x8 (&vf)[4]) {
#pragma unroll
    for (int t = 0; t < 2; ++t)
#pragma unroll
        for (int ks = 0; ks < 2; ++ks) kf[t][ks] = ldg8(P + (size_t)(krow + 16 * t + li) * INWP + kcol + 32 * ks + 8 * g);
#pragma unroll
    for (int dt = 0; dt < 4; ++dt) { const bf16* vp = VT + (size_t)(dt * 16 + li) * VTP + krow + 4 * g;
        const bf16x4 a = *(const bf16x4*)vp, b = *(const bf16x4*)(vp + 16); vf[dt] = (bf16x8){a[0], a[1], a[2], a[3], b[0], b[1], b[2], b[3]}; }
}
template <int NS, int NT>
__device__ __forceinline__ void attn_compute(const bf16x8 (&kf)[2][2], const bf16x8 (&vf)[4], const bf16x8 (&qf)[NS][2], f32x4 (&o)[NS][4], float (&m)[NS], float (&ls)[NS],
                                             const float (&add)[NT][2][4], int li, int g) {
#pragma unroll
    for (int hh = 0; hh < NS; ++hh) {
        f32x4 st[2];
#pragma unroll
        for (int t = 0; t < 2; ++t) { st[t] = (f32x4){0.f, 0.f, 0.f, 0.f};
#pragma unroll
            for (int ks = 0; ks < 2; ++ks) st[t] = __builtin_amdgcn_mfma_f32_16x16x32_bf16(kf[t][ks], qf[hh][ks], st[t], 0, 0, 0); }
        float s[8]; float bm = -INFINITY;
#pragma unroll
        for (int t = 0; t < 2; ++t)
#pragma unroll
            for (int r = 0; r < 4; ++r) { const float ad = add[hh / (NS / NT)][t][r]; s[4 * t + r] = (ad == -INFINITY) ? -INFINITY : st[t][r] * (0.125f * LOG2E) + ad; bm = fmaxf(bm, s[4 * t + r]); }
        bm = fmaxf(bm, shx(bm, 16, 16 * g + li)); bm = fmaxf(bm, shx(bm, 32, 16 * g + li));
        const float mn = fmaxf(m[hh], bm), corr = __builtin_amdgcn_exp2f(m[hh] - mn); m[hh] = mn;
        float ps = 0.f; float pe[8];
#pragma unroll
        for (int e = 0; e < 8; ++e) { pe[e] = __builtin_amdgcn_exp2f(s[e] - mn); ps += pe[e]; }
        ls[hh] = ls[hh] * corr + ps;
        union { bf16x8 v; unsigned u[4]; } pf;
#pragma unroll
        for (int e2 = 0; e2 < 4; ++e2) pf.u[e2] = pk2(pe[2 * e2], pe[2 * e2 + 1]);
#pragma unroll
        for (int dt = 0; dt < 4; ++dt) { o[hh][dt] = o[hh][dt] * corr; o[hh][dt] = __builtin_amdgcn_mfma_f32_16x16x32_bf16(vf[dt], pf.v, o[hh][dt], 0, 0, 0); }
    }
}
__device__ __forceinline__ void attn_finish1(bf16* MIX, int qrow0, int ocol, f32x4 (&o)[4], float m, float ls, bool has_sink, float sink2, int li, int g) {
    float l = ls; l += shx(l, 16, 16 * g + li); l += shx(l, 32, 16 * g + li);
    float corr = 1.f;
    if (has_sink) { const float mn = fmaxf(m, sink2); corr = __builtin_amdgcn_exp2f(m - mn); l = l * corr + __builtin_amdgcn_exp2f(sink2 - mn); }
    const float inv = corr / l;
#pragma unroll
    for (int dt = 0; dt < 4; ++dt) { const f32x4 v = o[dt] * inv; u32x2 w; w.x = pk2(v[0], v[1]); w.y = pk2(v[2], v[3]);
        *(u32x2*)(MIX + (size_t)(qrow0 + li) * DM + ocol + dt * 16 + 4 * g) = w; }
}
__device__ __forceinline__ void attnA_unit(const Ctx& C, const float* asink_l, int unit, bool lat) {
    const bf16* P = (const bf16*)(C.ws + WS_P); bf16* MIX = (bf16*)(C.ws + WS_MIX);
    const int li = C.lane & 15, g = C.lane >> 4;
    const int nqp = lat ? SEQ / 32 : NCTX / 32, kvh = unit / nqp, qp = unit % nqp, t0 = qp * 32, qrow0 = (lat ? NCTX : 0) + t0;
    const bf16* VT = (const bf16*)(C.ws + WS_VTA) + (size_t)kvh * 64 * VTP; const int kcol = C_AK + kvh * 64;
    bf16x8 qf[4][2];
#pragma unroll
    for (int s = 0; s < 4; ++s)
#pragma unroll
        for (int ks = 0; ks < 2; ++ks) qf[s][ks] = ldg8(P + (size_t)(qrow0 + 16 * (s >> 1) + li) * INWP + C_AQ + (kvh * 2 + (s & 1)) * 64 + 32 * ks + 8 * g);
    f32x4 o[4][4]; float m[4], ls[4];
#pragma unroll
    for (int s = 0; s < 4; ++s) { m[s] = -1.0e30f; ls[s] = 0.f;
#pragma unroll
        for (int dt = 0; dt < 4; ++dt) o[s][dt] = (f32x4){0.f, 0.f, 0.f, 0.f}; }
    const int b_lo = lat ? 0 : 9;
#pragma unroll 1
    for (int bb = b_lo; bb < 17; ++bb) { float add[2][2][4]; bf16x8 kf[2][2], vf[4];
        const int krow = (bb < 9) ? NCTX + t0 - 128 + 32 * bb : 32 * (bb - 9);
        attn_load(P, VT, krow, kcol, li, g, kf, vf);
#pragma unroll
        for (int tl = 0; tl < 2; ++tl)
#pragma unroll
            for (int tt = 0; tt < 2; ++tt)
#pragma unroll
                for (int r = 0; r < 4; ++r) { const int j = t0 - 128 + 32 * bb + 16 * tt + 4 * g + r, t = t0 + 16 * tl + li;
                    const bool ok = (bb >= 9) || ((j >= 0) && (j < SEQ) && (j - t <= 128) && (t - j <= 128)); add[tl][tt][r] = ok ? 0.f : -INFINITY; }
        attn_compute<4, 2>(kf, vf, qf, o, m, ls, add, li, g); }
#pragma unroll
    for (int s = 0; s < 4; ++s) attn_finish1(MIX, qrow0 + 16 * (s >> 1), (kvh * 2 + (s & 1)) * 64, o[s], m[s], ls[s], true, asink_l[kvh * 2 + (s & 1)] * LOG2E, li, g);
}
__device__ __forceinline__ void attnC_unit(const Ctx& C, const LAS float* relb, int h, int up, bool lat) {
    const bf16* P = (const bf16*)(C.ws + WS_P); bf16* MIX = (bf16*)(C.ws + WS_MIX);
    const int li = C.lane & 15, g = C.lane >> 4;
    const int rp = up >> 2, cj = up & 3;
    const int t0a = lat ? (2 * rp) * 64 + 16 * cj : 32 * up, tstep = lat ? 64 : 16, qbase = lat ? NCTX : 0;
    const bf16* VT = (const bf16*)(C.ws + WS_VTC) + (size_t)h * 64 * VTP; const int kcol = C_CK + h * 64;
    bf16x8 qf[2][2];
#pragma unroll
    for (int s = 0; s < 2; ++s)
#pragma unroll
        for (int ks = 0; ks < 2; ++ks) qf[s][ks] = ldg8(P + (size_t)(qbase + t0a + tstep * s + li) * INWP + C_CQ + h * 64 + 32 * ks + 8 * g);
    f32x4 o[2][4]; float m[2] = {-1.0e30f, -1.0e30f}, ls[2] = {0.f, 0.f};
#pragma unroll
    for (int s = 0; s < 2; ++s)
#pragma unroll
        for (int dt = 0; dt < 4; ++dt) o[s][dt] = (f32x4){0.f, 0.f, 0.f, 0.f};
    const int r = 2 * rp, cq = cj * 16 + li;
    int r0a = r - 4; r0a = r0a < 0 ? 0 : (r0a > 248 ? 248 : r0a); int r0b = r - 3; r0b = r0b < 0 ? 0 : (r0b > 248 ? 248 : r0b);
    int c0 = cq - 8; c0 = c0 < 0 ? 0 : (c0 > 48 ? 48 : c0);
    const int cw0 = (cj == 0) ? 0 : (cj == 1) ? 8 : (cj == 2) ? 24 : 32;
    const int b_lo = lat ? 0 : 9;
#pragma unroll 1
    for (int bb = b_lo; bb < 17; ++bb) { float add[2][2][4]; bf16x8 kf[2][2], vf[4];
        const int kr = r0a + bb;
        if (bb < 9 && kr >= r0b + 8) continue;
        const int krow = (bb < 9) ? NCTX + kr * 64 + cw0 : 32 * (bb - 9);
        attn_load(P, VT, krow, kcol, li, g, kf, vf);
#pragma unroll
        for (int tl = 0; tl < 2; ++tl) { const int r0t = tl ? r0b : r0a, rt = r + tl; const bool rowok = (bb >= 9) || (kr >= r0t && kr < r0t + 8);
            int bi = kr - rt + 7; bi = bi < 0 ? 0 : (bi > 14 ? 14 : bi); const LAS float* rbp = relb + bi * 31;
#pragma unroll
            for (int tt = 0; tt < 2; ++tt)
#pragma unroll
                for (int rr = 0; rr < 4; ++rr) { const int kc = cw0 + 16 * tt + 4 * g + rr; int ci = kc - cq + 15; ci = ci < 0 ? 0 : (ci > 30 ? 30 : ci); const float bv = rbp[ci];
                    add[tl][tt][rr] = (bb >= 9) ? 0.f : ((rowok && kc >= c0 && kc < c0 + 16) ? bv : -INFINITY); } }
        attn_compute<2, 2>(kf, vf, qf, o, m, ls, add, li, g); }
#pragma unroll
    for (int s = 0; s < 2; ++s) attn_finish1(MIX, qbase + t0a + tstep * s, 512 + h * 64, o[s], m[s], ls[s], false, 0.f, li, g);
}
__device__ __forceinline__ void fourier_ctx_mfma(const Ctx& C, int l, int wg0) {
    const bf16* P = (const bf16*)(C.ws + WS_P); bf16* MIX = (bf16*)(C.ws + WS_MIX); const bf16* f2 = (const bf16*)(C.ws + WS_F256);
    const int lane = C.lane, li = lane & 15, g = lane >> 4, w = C.wave;
    constexpr int UP = 72;
    for (int u = C.wg - wg0; u < 8; u += C.G - wg0) {
        const int tb = u >> 2, gq = u & 3;
        __syncthreads();
        for (int i = C.tid; i < 256 * 8; i += NTHR) { const int t = i >> 3, c8 = i & 7; *(LAS u32x4*)(C.lds + (t * UP + 8 * c8) * 2) = *(const u32x4*)(P + (size_t)t * INWP + C_BU + gq * 64 + 8 * c8); }
        __syncthreads();
        const int tp0 = 128 * tb + 16 * w;
        f32x4 xr[4], xi[4];
#pragma unroll
        for (int ci = 0; ci < 4; ++ci) { xr[ci] = (f32x4){0.f, 0.f, 0.f, 0.f}; xi[ci] = (f32x4){0.f, 0.f, 0.f, 0.f}; }
#pragma unroll 2
        for (int ks = 0; ks < 8; ++ks) { const bf16x8 bc = ldg8(f2 + (size_t)(tp0 + li) * 256 + 32 * ks + 8 * g), bs = ldg8(f2 + 65536 + (size_t)(tp0 + li) * 256 + 32 * ks + 8 * g);
#pragma unroll
            for (int ci = 0; ci < 4; ++ci) { const bf16x8 au = ldT(C.lds, UP, 32 * ks, 16 * ci, li, g); xr[ci] = mfma16(au, bc, xr[ci]); xi[ci] = mfma16(au, bs, xi[ci]); } }
        union { bf16x8 v; unsigned q[4]; } xb[4];
#pragma unroll
        for (int q2 = 0; q2 < 2; ++q2) { xb[q2].q[0] = pk2(xr[2 * q2][0], xr[2 * q2][1]); xb[q2].q[1] = pk2(xr[2 * q2][2], xr[2 * q2][3]); xb[q2].q[2] = pk2(xr[2 * q2 + 1][0], xr[2 * q2 + 1][1]); xb[q2].q[3] = pk2(xr[2 * q2 + 1][2], xr[2 * q2 + 1][3]);
            xb[2 + q2].q[0] = pk2(-xi[2 * q2][0], -xi[2 * q2][1]); xb[2 + q2].q[1] = pk2(-xi[2 * q2][2], -xi[2 * q2][3]); xb[2 + q2].q[2] = pk2(-xi[2 * q2 + 1][0], -xi[2 * q2 + 1][1]); xb[2 + q2].q[3] = pk2(-xi[2 * q2 + 1][2], -xi[2 * q2 + 1][3]); }
        const bf16x8* mf = (const bf16x8*)((const bf16*)(C.ws + WS_FTAB) + 32768) + (size_t)(l * 4 + gq) * 16 * 64;
#pragma unroll
        for (int ei = 0; ei < 4; ++ei) { f32x4 o = {0.f, 0.f, 0.f, 0.f};
#pragma unroll
            for (int ks2 = 0; ks2 < 4; ++ks2) o = mfma16(mf[(ei * 4 + ks2) * 64 + lane], xb[ks2].v, o);
            o = o * 8.0f;
            u32x2 wo; wo.x = pk2(o[0], o[1]); wo.y = pk2(o[2], o[3]); *(u32x2*)(MIX + (size_t)(tp0 + li) * DM + 256 + gq * 64 + 16 * ei + 4 * g) = wo; }
    }
    __syncthreads();
}
__device__ __forceinline__ void fourier2_unit(const Ctx& C, int l, int u, bool ctx) {
    const bf16* P = (const bf16*)(C.ws + WS_P); const float* tw = (const float*)(C.ws + WS_TW); bf16* MIX = (bf16*)(C.ws + WS_MIX);
    const float* FYR = (const float*)(C.ws + WS_FYR); const float* FYI = (const float*)(C.ws + WS_FYI);
    const float* mt = (const float*)(C.ws + WS_MTAB) + (size_t)l * 2 * 4 * 4096;
    LAS float* xr = (LAS float*)(C.lds + 8192); LAS float* xi = xr + 512;
    const int tl = C.tid >> 8, ch = C.tid & 255, tp = 2 * u + tl;
    float sr = 0.f, si = 0.f;
    if (!ctx) { const int k1 = tp & 127, k2 = tp >> 7; const float* yr = FYR + (size_t)k1 * 128 * 256 + ch; const float* yi = FYI + (size_t)k1 * 128 * 256 + ch;
#pragma unroll 8
        for (int t2 = 0; t2 < 128; ++t2) { const int m = ((t2 * k2) & 127) * 128; const float c = tw[m], s = tw[16384 + m]; const float a = yr[t2 * 256], b = yi[t2 * 256]; sr += a * c + b * s; si += b * c - a * s; } }
    else {
#pragma unroll 8
        for (int t = 0; t < NCTX; ++t) { const int m = ((t * tp) & 255) * 64; const float x = bf2f(P[(size_t)t * INWP + C_BU + ch]); sr += x * tw[m]; si -= x * tw[16384 + m]; } }
    __syncthreads();
    xr[tl * 256 + ch] = sr; xi[tl * 256 + ch] = si;
    __syncthreads();
    const int g = ch >> 6, e = ch & 63; const float* mc = mt + (size_t)(0 * 4 + g) * 4096 + e; const float* ms = mt + (size_t)(1 * 4 + g) * 4096 + e;
    const LAS float* xrp = xr + tl * 256 + g * 64; const LAS float* xip = xi + tl * 256 + g * 64; float o = 0.f;
#pragma unroll 8
    for (int c = 0; c < 64; ++c) o += xrp[c] * mc[c * 64] + xip[c] * ms[c * 64];
    o *= ctx ? (1.0f / 128.0f) : (1.0f / 1024.0f);
    MIX[(size_t)((ctx ? 0 : NCTX) + tp) * DM + 256 + ch] = (bf16)f2bf(o);
}
__device__ __forceinline__ void rwkv_passB(const Ctx& C, int b);
__device__ __forceinline__ void phase_mix2(const Ctx& C, const DArgs& a, int l) {
    const bool emit_ctx = l < DEPTH - 1;
#ifndef REPMASK
#define REPMASK 0
#endif
#define NREP2(o) ((((REPMASK) >> (o)) & 1) ? 2 : 1)
    if (C.wg < 8) { for (int r2 = 0; r2 < NREP2(16); ++r2) rwkv_passB(C, C.wg); }
    else if (emit_ctx) fourier_ctx_mfma(C, l, 8);
    { const float* asink_l = a.in[I_ASINK] + l * 4; const float* crel = a.in[I_CREL] + (size_t)l * 4 * 465;
      LAS float* relb = (LAS float*)(C.lds + 110592 + C.wave * 2048);
      for (int r2 = 0; r2 < NREP2(17); ++r2) {
      unsigned* qhead = (unsigned*)(C.ws + WS_CTL) + CW_WQ + 64 * l + 16 * r2;
      const int nA = 2 * (SEQ / 32), nC = 4 * (SEQ / 32), nAc = emit_ctx ? 2 * (NCTX / 32) : 0, nCc = emit_ctx ? 4 * (NCTX / 32) : 0, nAll = nA + nAc + nC + nCc;
      int hcur = -1;
      const int nCv = emit_ctx ? CV_NCHUNK : 0;
      for (;;) { unsigned uq = 0; if (C.lane == 0) uq = __hip_atomic_fetch_add(qhead, 1u, __ATOMIC_RELAXED, __HIP_MEMORY_SCOPE_AGENT);
          const int uraw = __builtin_amdgcn_readfirstlane((int)uq); if (uraw >= nAll + nCv) break;
          int u;
          if (uraw < 2 * nCv) { if (uraw & 1) { const int ch = uraw >> 1; convert_moe_items(C, a, l + 1, ch * CV_CHUNK, ch * CV_CHUNK + CV_CHUNK); continue; } u = uraw >> 1; }
          else u = uraw - nCv;
          if (u < nA) attnA_unit(C, asink_l, u, true);
          else if (u < nA + nAc) attnA_unit(C, asink_l, u - nA, false);
          else { const int uc = u - nA - nAc; const bool lat = uc < nC; const int uu = lat ? uc : uc - nC, nqt = lat ? SEQ / 32 : NCTX / 32, h = uu / nqt, qt = uu % nqt;
              if (h != hcur) { for (int i = C.lane; i < 465; i += 64) relb[i] = crel[h * 465 + i] * LOG2E; hcur = h; LDS_WAIT(); asm volatile("" ::: "memory"); }
              attnC_unit(C, relb, h, qt, lat); } } } }
    __syncthreads();
    for (int r2 = 0; r2 < NREP2(19); ++r2) fourier2_mfma(C, l, 0);
}

constexpr int RW_C = 32, RW_NCH = ROWS / RW_C, RW_SC = 20, RW_NSC = RW_NCH / RW_SC;
constexpr int RW_SLOT = 5120, RW_REGION = 9 * RW_SLOT + 1024;
constexpr int TP = 72, HP = 40;
static_assert(3 * RW_REGION <= MISC_OFF, "RWKV D1 regions below the misc area");
__device__ __forceinline__ int rw_rc_of(int d, int c) { return d == 0 ? c : (c < 8 ? 7 - c : 527 - c); }
__device__ __forceinline__ int rw_row_of(int d, int rc, int t) { return 32 * rc + (d == 0 ? t : 31 - t); }

__device__ __forceinline__ void rwkv_d1(const Ctx& C, LAS unsigned char* rb, int d, int h, int rc) {
    int lane_ = C.lane; asm volatile("" : "+v"(lane_));
    const int lane = lane_, li = lane & 15, g = lane >> 4;
    const float* SC = (const float*)(C.ws + WS_SC);
    LAS unsigned char* S0 = rb; LAS unsigned char* S1 = rb + RW_SLOT; LAS unsigned char* S2 = rb + 2 * RW_SLOT; LAS unsigned char* S3 = rb + 3 * RW_SLOT; LAS unsigned char* S4 = rb + 4 * RW_SLOT;
    LAS unsigned char* S5 = rb + 5 * RW_SLOT; LAS unsigned char* S6 = rb + 6 * RW_SLOT; LAS unsigned char* S7 = rb + 7 * RW_SLOT; LAS unsigned char* S8 = rb + 8 * RW_SLOT;
    LAS unsigned char* S6b = S6 + 2560; LAS unsigned char* S7b = S7 + 2560;
    LAS float* gc = (LAS float*)(rb + 9 * RW_SLOT);
    { float cum = 0.f; const int j = lane; const int qw = (3 + 3 * d) * 256;
      float rv[2][4], vv[2][4], av[2][4], lw[2][4], kd[2][4], bb[2][4];
#define RW_LD(buf, t0) do { _Pragma("unroll") for (int u = 0; u < 4; ++u) { const float* sc = SC + (size_t)rw_row_of(d, rc, (t0) + u) * 9 * 256 + h * 64 + j; \
          rv[buf][u] = sc[0]; vv[buf][u] = sc[256]; av[buf][u] = sc[512]; lw[buf][u] = sc[qw]; kd[buf][u] = sc[qw + 256]; bb[buf][u] = sc[qw + 512]; } } while (0)
#define RW_CP(buf, t0) do { _Pragma("unroll") for (int u = 0; u < 4; ++u) { const float cp = cum; cum += lw[buf][u]; const float Gt = __expf(cum), Gm = __expf(cp), iG = __expf(-cum); const int off = (((t0) + u) * TP + j) * 2; \
          *(LAS bf16*)(S0 + off) = (bf16)f2bf(av[buf][u] * Gm); *(LAS bf16*)(S1 + off) = (bf16)f2bf(rv[buf][u] * Gt); *(LAS bf16*)(S2 + off) = (bf16)f2bf(bb[buf][u] * iG); \
          *(LAS bf16*)(S3 + off) = (bf16)f2bf(kd[buf][u] * iG); *(LAS bf16*)(S4 + off) = (bf16)f2bf(vv[buf][u]); } } while (0)
      RW_LD(0, 0);
#pragma unroll
      for (int b2 = 0; b2 < 4; ++b2) { RW_LD(1, 8 * b2 + 4); __builtin_amdgcn_sched_barrier(0); RW_CP(0, 8 * b2); if (b2 < 3) RW_LD(0, 8 * b2 + 8); __builtin_amdgcn_sched_barrier(0); RW_CP(1, 8 * b2 + 4); }
#undef RW_LD
#undef RW_CP
      gc[j] = __expf(cum); }
    const f32x4 z4 = {0.f, 0.f, 0.f, 0.f};
#pragma unroll 1
    for (int ti = 0; ti < 2; ++ti)
#pragma unroll 1
        for (int si = 0; si < 2; ++si) {
            f32x4 n = z4, nt = z4, mk = z4, qb = z4, qk = z4;
#pragma unroll
            for (int ks = 0; ks < 2; ++ks) { const bf16x8 at = ldA(S0, TP, 16 * ti, 32 * ks, li, g), rt = ldA(S1, TP, 16 * ti, 32 * ks, li, g), bs = ldA(S2, TP, 16 * si, 32 * ks, li, g), kss = ldA(S3, TP, 16 * si, 32 * ks, li, g);
                n = mfma16(at, bs, n);
                nt = mfma16(bs, at, nt);
                mk = mfma16(kss, at, mk);
                qb = mfma16(bs, rt, qb);
                qk = mfma16(kss, rt, qk); }
#pragma unroll
            for (int r = 0; r < 4; ++r) { const int trow = 16 * ti + 4 * g + r, scol = 16 * si + li; if (!(scol < trow)) n[r] = 0.f;
                const int srow = 16 * si + 4 * g + r, tcol = 16 * ti + li; if (!(srow < tcol)) { mk[r] = 0.f; nt[r] = 0.f; } if (!(srow <= tcol)) { qb[r] = 0.f; qk[r] = 0.f; } }
            *(LAS f32x4*)(S5 + ((16 * si + li) * 32 + 16 * ti + 4 * g) * 4) = n;
            stT(S6, HP, 16 * ti + li, 16 * si + 4 * g, mk);
            stT(S8, HP, 16 * ti + li, 16 * si + 4 * g, nt);
            stT(S6b, HP, 16 * ti + li, 16 * si + 4 * g, qb);
            stT(S7, HP, 16 * ti + li, 16 * si + 4 * g, qk); }
    { const int rr = lane & 31, bq = rr >> 4, lr = rr & 15; float Tr[16];
#pragma unroll
      for (int s = 15; s >= 0; --s) { float acc = (lr == s) ? 1.f : 0.f;
#pragma unroll
          for (int c4 = 0; c4 < 4; ++c4) { if (4 * c4 + 3 > s) { const f32x4 nv = *(const LAS f32x4*)(S5 + ((16 * bq + s) * 32 + 16 * bq + 4 * c4) * 4);
#pragma unroll
              for (int e = 0; e < 4; ++e) if (4 * c4 + e > s) acc += Tr[4 * c4 + e] * nv[e]; } }
          Tr[s] = acc; }
      if (lane < 32) { u32x4 w0, w1; w0.x = pk2(Tr[0], Tr[1]); w0.y = pk2(Tr[2], Tr[3]); w0.z = pk2(Tr[4], Tr[5]); w0.w = pk2(Tr[6], Tr[7]); w1.x = pk2(Tr[8], Tr[9]); w1.y = pk2(Tr[10], Tr[11]); w1.z = pk2(Tr[12], Tr[13]); w1.w = pk2(Tr[14], Tr[15]);
          const u32x4 zz = {0u, 0u, 0u, 0u}; LAS u32x4* trow = (LAS u32x4*)(S7b + rr * HP * 2);
          trow[0] = bq ? zz : w0; trow[1] = bq ? zz : w1; trow[2] = bq ? w0 : zz; trow[3] = bq ? w1 : zz; }
      f32x4 x = mfma16(ldA(S8, HP, 16, 0, li, g), ldT(S7b, HP, 0, 0, li, g), z4);
      LAS unsigned char* XT = S8 + 2560;
      *(LAS u32x2*)(XT + (li * HP + 4 * g) * 2) = (u32x2){0u, 0u}; stT(XT, HP, li, 16 + 4 * g, x);
      const f32x4 t21 = mfma16(ldA(S7b, HP, 16, 0, li, g), ldA(XT, HP, 0, 0, li, g), z4);
#pragma unroll
      for (int r = 0; r < 4; ++r) *(LAS bf16*)(S7b + ((16 + 4 * g + r) * HP + li) * 2) = (bf16)f2bf(t21[r]); }
#pragma unroll 1
    for (int ti = 0; ti < 2; ++ti) { const bf16x8 tf = ldA(S7b, HP, 16 * ti, 0, li, g), mf = ldA(S6, HP, 16 * ti, 0, li, g);
#pragma unroll
        for (int ji = 0; ji < 4; ++ji) { const f32x4 ap = mfma16(tf, ldT(S0, TP, 0, 16 * ji, li, g), z4); stT(S8, HP, 16 * ji + li, 16 * ti + 4 * g, ap);
            const f32x4 mv = mfma16(mf, ldT(S4, TP, 0, 16 * ji, li, g), z4); stT(S5, HP, 16 * ji + li, 16 * ti + 4 * g, mv); } }
#pragma unroll 1
    for (int ti = 0; ti < 2; ++ti) { const bf16x8 tf = ldA(S7b, HP, 16 * ti, 0, li, g);
#pragma unroll
        for (int vi = 0; vi < 4; ++vi) { const f32x4 ul = mfma16(tf, ldA(S5, HP, 16 * vi, 0, li, g), z4); stT(S0, HP, 16 * vi + li, 16 * ti + 4 * g, ul); } }
#pragma unroll 1
    for (int ti = 0; ti < 2; ++ti) { const bf16x8 qbf = ldA(S6b, HP, 16 * ti, 0, li, g), qkf = ldA(S7, HP, 16 * ti, 0, li, g);
#pragma unroll
        for (int ji = 0; ji < 4; ++ji) { f32x4 rp = mfma16(ldA(S8, HP, 16 * ji, 0, li, g), qbf, z4);
            LAS unsigned char* p = S1 + ((16 * ti + li) * TP + 16 * ji + 4 * g) * 2; rp = rp + ld4bf(p); u32x2 w; w.x = pk2(rp[0], rp[1]); w.y = pk2(rp[2], rp[3]); *(LAS u32x2*)p = w;
            f32x4 yl = mfma16(qbf, ldA(S0, HP, 16 * ji, 0, li, g), z4); yl = mfma16(qkf, ldT(S4, TP, 0, 16 * ji, li, g), yl);
            stT(S5, HP, 16 * ji + li, 16 * ti + 4 * g, yl); } }
#pragma unroll 1
    for (int ji = 0; ji < 4; ++ji) { const bf16x8 bt = ldT(S2, TP, 0, 16 * ji, li, g); const float gj = gc[16 * ji + li];
#pragma unroll
        for (int jp = 0; jp < 4; ++jp) { f32x4 pt = mfma16(ldA(S8, HP, 16 * jp, 0, li, g), bt, z4);
#pragma unroll
            for (int r = 0; r < 4; ++r) pt[r] = pt[r] * gj + ((16 * jp + 4 * g + r == 16 * ji + li) ? gj : 0.f);
            stT(S6, TP, 16 * ji + li, 16 * jp + 4 * g, pt); } }
#pragma unroll 1
    for (int vh = 0; vh < 2; ++vh) { f32x4 lt[4][2];
#pragma unroll
      for (int ji = 0; ji < 4; ++ji) { const bf16x8 ba = ldT(S2, TP, 0, 16 * ji, li, g), ka = ldT(S3, TP, 0, 16 * ji, li, g); const f32x4 gv = *(const LAS f32x4*)(gc + 16 * ji + 4 * g);
#pragma unroll
          for (int v2 = 0; v2 < 2; ++v2) { const int vi = 2 * vh + v2; f32x4 x = mfma16(ba, ldA(S0, HP, 16 * vi, 0, li, g), z4); x = mfma16(ka, ldT(S4, TP, 0, 16 * vi, li, g), x); lt[ji][v2] = x * gv; } }
      asm volatile("s_waitcnt lgkmcnt(0)" ::: "memory");
      LAS unsigned char* dst = vh ? S2 : S8;
#pragma unroll
      for (int ji = 0; ji < 4; ++ji)
#pragma unroll
          for (int v2 = 0; v2 < 2; ++v2) stT(dst, TP, 16 * v2 + li, 16 * ji + 4 * g, lt[ji][v2]); }
}
__device__ __forceinline__ void rwkv_passA_step(const Ctx& C, const LAS unsigned char* rb, f32x4 (&hs)[4], int d, int h, int rc) {
    int lane_ = C.lane; asm volatile("" : "+v"(lane_));
    const int lane = lane_, li = lane & 15, g = lane >> 4; const bool isPhi = C.wave >= 4; const int col = 16 * (C.wave & 3) + li;
    const LAS unsigned char* S1 = rb + RW_SLOT; const LAS unsigned char* S2 = rb + 2 * RW_SLOT; const LAS unsigned char* S5 = rb + 5 * RW_SLOT; const LAS unsigned char* S6 = rb + 6 * RW_SLOT;
    const LAS unsigned char* LTb = (col < 32) ? rb + 8 * RW_SLOT + col * TP * 2 : S2 + (col - 32) * TP * 2;
    union { bf16x8 v; unsigned u[4]; } bf[2];
#pragma unroll
    for (int ks = 0; ks < 2; ++ks) { bf[ks].u[0] = pk2(hs[2 * ks][0], hs[2 * ks][1]); bf[ks].u[1] = pk2(hs[2 * ks][2], hs[2 * ks][3]); bf[ks].u[2] = pk2(hs[2 * ks + 1][0], hs[2 * ks + 1][1]); bf[ks].u[3] = pk2(hs[2 * ks + 1][2], hs[2 * ks + 1][3]); }
#pragma unroll
    for (int ti = 0; ti < 2; ++ti) { f32x4 acc = isPhi ? (f32x4){0.f, 0.f, 0.f, 0.f} : ld4bf(S5 + (col * HP + 16 * ti + 4 * g) * 2);
#pragma unroll
        for (int ks = 0; ks < 2; ++ks) acc = mfma16(ldAperm(S1, TP, 16 * ti, ks, li, g), bf[ks].v, acc);
        if (!isPhi) { float* ys = (float*)(C.ws + WS_YS) + (size_t)d * ROWS * 256 + h * 64 + col;
#pragma unroll
            for (int r = 0; r < 4; ++r) ys[(size_t)rw_row_of(d, rc, 16 * ti + 4 * g + r) * 256] = acc[r]; }
        else { bf16* rp = (bf16*)(C.ws + WS_RPP) + ((size_t)((d * 4 + h) * RW_NCH + rc) * 32) * 64 + col;
#pragma unroll
            for (int r = 0; r < 4; ++r) rp[(16 * ti + 4 * g + r) * 64] = (bf16)f2bf(acc[r]); } }
    f32x4 hn[4];
#pragma unroll
    for (int i = 0; i < 4; ++i) { f32x4 acc = isPhi ? (f32x4){0.f, 0.f, 0.f, 0.f} : ld4bf(LTb + (16 * i + 4 * g) * 2);
#pragma unroll
        for (int ks = 0; ks < 2; ++ks) acc = mfma16(ldAperm(S6, TP, 16 * i, ks, li, g), bf[ks].v, acc);
        hn[i] = acc; }
#pragma unroll
    for (int i = 0; i < 4; ++i) hs[i] = hn[i];
}
__device__ __forceinline__ void phase_rwkv1(const Ctx& C) {
    const int lane = C.lane, li = lane & 15, g = lane >> 4;
    for (int u = C.wg; u < 8 * RW_NSC; u += C.G) {
        const int s = u % RW_NSC, dh = u / RW_NSC, d = dh >> 2, h = dh & 3; const bool isPhi = C.wave >= 4; const int col = 16 * (C.wave & 3) + li;
        f32x4 hs[4];
#pragma unroll
        for (int i = 0; i < 4; ++i)
#pragma unroll
            for (int r = 0; r < 4; ++r) hs[i][r] = (isPhi && (16 * i + 4 * g + r == col)) ? 1.f : 0.f;
#pragma unroll 1
        for (int rnd = 0; rnd < (RW_SC + 2) / 3; ++rnd) {
            __syncthreads();
            { int wv = C.wave; asm volatile("" : "+s"(wv)); if (wv < 3 && 3 * rnd + wv < RW_SC) rwkv_d1(C, C.lds + wv * RW_REGION, d, h, rw_rc_of(d, s * RW_SC + 3 * rnd + wv)); }
            __syncthreads();
#pragma unroll 1
            for (int k = 0; k < 3; ++k) { const int ci = 3 * rnd + k; int ko = k * RW_REGION; asm volatile("" : "+s"(ko)); if (ci < RW_SC) rwkv_passA_step(C, C.lds + ko, hs, d, h, rw_rc_of(d, s * RW_SC + ci)); }
        }
        if (isPhi) { bf16* pf = (bf16*)(C.ws + WS_PSC) + (size_t)(dh * RW_NSC + s) * 4096;
            const int ks = col >> 5, eh = (col >> 4) & 1, gp = (col >> 2) & 3, el = col & 3;
#pragma unroll
            for (int i = 0; i < 4; ++i)
#pragma unroll
                for (int r = 0; r < 4; ++r) pf[((i * 2 + ks) * 64 + gp * 16 + 4 * g + r) * 8 + eh * 4 + el] = (bf16)f2bf(hs[i][r]); }
        else { f32x4* lf = (f32x4*)(C.ws + WS_LSC) + ((size_t)(dh * RW_NSC + s) * 4 + C.wave) * 4 * 64;
#pragma unroll
            for (int i = 0; i < 4; ++i) lf[i * 64 + lane] = hs[i]; }
    }
    __syncthreads();
}
__device__ __forceinline__ void rwkv_passB(const Ctx& C, int b) {
    if (C.wave >= 4) return;
    const int lane = C.lane, li = lane & 15, g = lane >> 4, q = C.wave;
    f32x4 hs[4];
#pragma unroll
    for (int i = 0; i < 4; ++i) hs[i] = (f32x4){0.f, 0.f, 0.f, 0.f};
    const bf16x8* pfb = (const bf16x8*)((const bf16*)(C.ws + WS_PSC) + (size_t)b * RW_NSC * 4096);
    const f32x4* lfb = (const f32x4*)(C.ws + WS_LSC) + ((size_t)b * RW_NSC * 4 + q) * 4 * 64;
    bf16x8 pa[8]; f32x4 la[4];
#pragma unroll
    for (int k = 0; k < 8; ++k) pa[k] = pfb[k * 64 + lane];
#pragma unroll
    for (int i = 0; i < 4; ++i) la[i] = lfb[i * 64 + lane];
#pragma unroll 1
    for (int s = 0; s < RW_NSC; ++s) {
        bf16* hp = (bf16*)(C.ws + WS_HSC) + ((size_t)(b * RW_NSC + s) * 64 + 16 * q + li) * 64;
#pragma unroll
        for (int i = 0; i < 4; ++i) { u32x2 w; w.x = pk2(hs[i][0], hs[i][1]); w.y = pk2(hs[i][2], hs[i][3]); *(u32x2*)(hp + 16 * i + 4 * g) = w; }
        bf16x8 pn[8]; f32x4 ln[4]; const int sn = (s + 1 < RW_NSC) ? s + 1 : s;
#pragma unroll
        for (int k = 0; k < 8; ++k) pn[k] = pfb[(size_t)sn * 512 + k * 64 + lane];
#pragma unroll
        for (int i = 0; i < 4; ++i) ln[i] = lfb[(size_t)sn * 4 * 4 * 64 + i * 64 + lane];
        union { bf16x8 v; unsigned u[4]; } bf[2];
#pragma unroll
        for (int ks = 0; ks < 2; ++ks) { bf[ks].u[0] = pk2(hs[2 * ks][0], hs[2 * ks][1]); bf[ks].u[1] = pk2(hs[2 * ks][2], hs[2 * ks][3]); bf[ks].u[2] = pk2(hs[2 * ks + 1][0], hs[2 * ks + 1][1]); bf[ks].u[3] = pk2(hs[2 * ks + 1][2], hs[2 * ks + 1][3]); }
#pragma unroll
        for (int i = 0; i < 4; ++i) { f32x4 acc = la[i];
#pragma unroll
            for (int ks = 0; ks < 2; ++ks) acc = mfma16(pa[i * 2 + ks], bf[ks].v, acc);
            hs[i] = acc; }
#pragma unroll
        for (int k = 0; k < 8; ++k) pa[k] = pn[k];
#pragma unroll
        for (int i = 0; i < 4; ++i) la[i] = ln[i];
    }
}
__device__ __forceinline__ void phase_mix3(const Ctx& C, const DArgs& a, int l) {
    const bf16* P = (const bf16*)(C.ws + WS_P); const float* SC = (const float*)(C.ws + WS_SC); const float* YS = (const float*)(C.ws + WS_YS); bf16* MIX = (bf16*)(C.ws + WS_MIX);
    LAS float* yt = (LAS float*)(C.lds);
    constexpr int GSP = 168;
    LAS unsigned char* gsig = C.lds + 32768;
    LAS float* gm = (LAS float*)(C.lds + 40960);
    const bf16* g2t = (const bf16*)(C.ws + WS_G2T) + (size_t)l * 256 * 160;
    const float* rk = a.in[I_DRK] + (size_t)l * 256; const float* lnw = a.in[I_DLNW] + (size_t)l * 256; const float* lnb = a.in[I_DLNB] + (size_t)l * 256;
    const int lane = C.lane, li = lane & 15, g = lane >> 4, h = C.wave & 3, d = C.wave >> 2;
    const int half = C.tid >> 8, c = C.tid & 255;
    const int u_lo = (l == DEPTH - 1) ? NCTX / 16 : 0;
    bf16 glv[5];
#define GL_FETCH(uu) do { _Pragma("unroll") for (int k = 0; k < 5; ++k) { const int i = C.tid + NTHR * k, t = i / 160, ii = i % 160; glv[k] = P[(size_t)(16 * (uu) + t) * INWP + C_GL + ii]; } } while (0)
    const float lnwc = lnw[c], lnbc = lnb[c], rkc = rk[c];
    bf16x8 g2f[2][5];
#pragma unroll
    for (int c2 = 0; c2 < 2; ++c2)
#pragma unroll
        for (int ks = 0; ks < 5; ++ks) g2f[c2][ks] = ldg8(g2t + (size_t)(16 * (2 * C.wave + c2) + li) * 160 + 32 * ks + 8 * g);
    bf16x8 caf[2], cbf[4][2]; float cys[4][4];
#define CORR_FETCH(uu) do { const int rc_ = (uu) >> 1, th_ = (uu) & 1, ct_ = (d == 0) ? rc_ : (rc_ < 8 ? 7 - rc_ : 527 - rc_), s_ = ct_ / RW_SC, ti_ = (d == 0) ? th_ : 1 - th_; \
        const bf16* rp_ = (const bf16*)(C.ws + WS_RPP) + (size_t)((d * 4 + h) * RW_NCH + rc_) * 32 * 64; const bf16* hp_ = (const bf16*)(C.ws + WS_HSC) + (size_t)((d * 4 + h) * RW_NSC + s_) * 64 * 64; \
        _Pragma("unroll") for (int ks = 0; ks < 2; ++ks) caf[ks] = ldg8(rp_ + (16 * ti_ + li) * 64 + 32 * ks + 8 * g); \
        _Pragma("unroll") for (int vi = 0; vi < 4; ++vi) { _Pragma("unroll") for (int ks = 0; ks < 2; ++ks) cbf[vi][ks] = ldg8(hp_ + (16 * vi + li) * 64 + 32 * ks + 8 * g); \
            _Pragma("unroll") for (int r = 0; r < 4; ++r) { const int t_ = 16 * ti_ + 4 * g + r, rl_ = ((d == 0) ? t_ : 31 - t_) - 16 * th_; cys[vi][r] = YS[((size_t)d * ROWS + 16 * (uu) + rl_) * 256 + h * 64 + 16 * vi + li]; } } } while (0)
    if (u_lo + C.wg < ROWS / 16) { GL_FETCH(u_lo + C.wg); CORR_FETCH(u_lo + C.wg); }
    for (int u = u_lo + C.wg; u < ROWS / 16; u += C.G) {
        const int rc = u >> 1, th = u & 1, rowb = 16 * u;
        __syncthreads();
#pragma unroll
        for (int k = 0; k < 5; ++k) { const int i = C.tid + NTHR * k, t = i / 160, ii = i % 160; *(LAS bf16*)(gsig + (t * GSP + ii) * 2) = (bf16)f2bf(sigmoidf_(bf2f(glv[k]))); }
        {
          const int ti = (d == 0) ? th : 1 - th;
#pragma unroll
          for (int vi = 0; vi < 4; ++vi) { f32x4 acc = {0.f, 0.f, 0.f, 0.f};
#pragma unroll
              for (int ks = 0; ks < 2; ++ks) acc = mfma16(caf[ks], cbf[vi][ks], acc);
#pragma unroll
              for (int r = 0; r < 4; ++r) { const int t = 16 * ti + 4 * g + r, rl = ((d == 0) ? t : 31 - t) - 16 * th;
                  yt[(d * 16 + rl) * 256 + h * 64 + 16 * vi + li] = acc[r] + cys[vi][r]; } } }
        __syncthreads();
#pragma unroll
        for (int c2 = 0; c2 < 2; ++c2) { const int ci = 2 * C.wave + c2; f32x4 a0 = {0.f, 0.f, 0.f, 0.f};
#pragma unroll
            for (int ks = 0; ks < 5; ++ks) a0 = mfma16(ldA(gsig, GSP, 0, 32 * ks, li, g), g2f[c2][ks], a0);
#pragma unroll
            for (int r = 0; r < 4; ++r) gm[(4 * g + r) * 256 + 16 * ci + li] = a0[r]; }
        __syncthreads();
        if (u + C.G < ROWS / 16) { GL_FETCH(u + C.G); CORR_FETCH(u + C.G); }
#pragma unroll 1
        for (int it = 0; it < 8; ++it) { const int rl = 2 * it + half, row = rowb + rl;
            const float* sc = SC + (size_t)row * 9 * 256;
            const float y = yt[rl * 256 + c] + yt[(16 + rl) * 256 + c];
            const float mu = wave_sum(y, lane) * (1.f / 64.f), dy = y - mu, var = wave_sum(dy * dy, lane) * (1.f / 64.f);
            const float yn = dy * rsqrtf(var + 64e-5f) * lnwc + lnbc;
            const float r = sc[c], v = sc[256 + c];
            const float coef = wave_sum(r * (sc[4 * 256 + c] + sc[7 * 256 + c]) * rkc, lane);
            MIX[(size_t)row * DM + 768 + c] = (bf16)f2bf((yn + coef * v) * gm[rl * 256 + c]); }
    }
#undef GL_FETCH
#undef CORR_FETCH
    __syncthreads();
}
__device__ __forceinline__ void outproj_ctx(const Ctx& C, int l, const float* gate) {
    const bf16* A = (const bf16*)(C.ws + WS_MIX); const bf16* B = (const bf16*)(C.ws + WS_WOUT) + (size_t)l * DM * DM; float* XS = (float*)(C.ws + WS_XS);
    const int lane = C.lane, li = lane & 15, g = lane >> 4;
    for (int u = C.gw; u < (NCTX / 16) * (DM / 16); u += C.NGW) { const int rt = u >> 6, ct = u & 63;
        const bf16* ap = A + (size_t)(16 * rt + li) * DM + 8 * g; const bf16* bp = B + (size_t)(16 * ct + li) * DM + 8 * g;
        f32x4 acc0 = {0.f, 0.f, 0.f, 0.f}, acc1 = {0.f, 0.f, 0.f, 0.f};
#pragma unroll 4
        for (int ks = 0; ks < 32; ks += 2) { acc0 = mfma16(ldg8(ap + 32 * ks), ldg8(bp + 32 * ks), acc0); acc1 = mfma16(ldg8(ap + 32 * ks + 32), ldg8(bp + 32 * ks + 32), acc1); }
        const float gv = gate[16 * ct + li];
#pragma unroll
        for (int r = 0; r < 4; ++r) { float* p = XS + (size_t)(16 * rt + 4 * g + r) * DM + 16 * ct + li; *p = *p + gv * (acc0[r] + acc1[r]); } }
}

#ifndef MK_SINGLE
#define MK_SINGLE 1
#endif
template <int ONLYP> __global__ void __launch_bounds__(NTHR, 2) mega(Args a) {
    extern __shared__ __attribute__((aligned(16))) unsigned char lds_raw[];
    Ctx C;
#define MKCTX() do { int t_ = threadIdx.x; asm volatile("" : "+v"(t_)); unsigned char* w_ = a.ws; asm volatile("" : "+s"(w_)); unsigned l_ = 0u; asm volatile("" : "+s"(l_)); \
        C.lds = (LAS unsigned char*)lds_raw + l_; C.tid = t_; C.lane = t_ & 63; C.wave = __builtin_amdgcn_readfirstlane(t_ >> 6); \
        C.wg = blockIdx.x; C.G = gridDim.x; C.gw = C.wg * NWAVES + C.wave; C.NGW = C.G * NWAVES; C.ws = w_; } while (0)
    MKCTX();
    if (C.tid == 0) {
#pragma unroll
        for (int i = 0; i < 31; ++i) ((LAS unsigned long long*)(C.lds + MISC_OFF + 2048))[i] = (unsigned long long)a.in[i]; }
    DArgs da; da.in.tab = (const LAS unsigned*)(C.lds + MISC_OFF + 2048); da.out = a.out;
    if (C.tid < 4) ((LAS unsigned*)(C.lds + MISC_OFF))[C.tid] = 0u;
    __syncthreads();
    XcdBarrier bar; bar.bar = (unsigned*)(C.ws + WS_CTL) + CW_BAR; bar.x = 0; bar.st = (volatile LAS unsigned*)(C.lds + MISC_OFF);
    if (a.use_bar) bar = xcd_barrier_post((unsigned*)(C.ws + WS_CTL) + CW_BAR, (volatile LAS unsigned*)(C.lds + MISC_OFF));
#ifndef PHMASK
#define PHMASK 0x1fff
#endif
#define INP(o, k) ((ONLYP < 0 || ONLYP == (o)) && ((PHMASK >> ((o) == 99 ? 12 : (o))) & 1) && a.ph_lo <= (k) && (k) < a.ph_hi)
#ifndef REPMASK
#define REPMASK 0
#endif
#define NREP(o) ((((REPMASK) >> ((o) == 99 ? 12 : (o))) & 1) ? 2 : 1)
#define IN(k) (a.ph_lo <= (k) && (k) < a.ph_hi)
#define SEAM(k) do { if (a.use_bar && IN(k) && IN((k) + 1)) { xcd_barrier(bar); if ((REPMASK >> 20) & 1) xcd_barrier(bar); } } while (0)
    if (INP(0, 0)) for (int rep = 0; rep < NREP(0); ++rep) { MKCTX(); phase_prologue(C, da); }
    SEAM(0);
    for (int l = 0; l < DEPTH; ++l) {
        const int b = 1 + l * NPL;
        const float* mod_lat = (const float*)(C.ws + WS_MOD) + (size_t)(l * 2 + 0) * 6144; const float* mod_ctx = mod_lat + 6144;
        if (INP(1, b + 0)) { MKCTX(); phase_norm1(C, da, l); }
        SEAM(b + 0);
        if (INP(2, b + 1)) for (int rep = 0; rep < NREP(2); ++rep) { MKCTX();
            pg8::StaticOrder S; S.init(WS_H, WS_WIN + (size_t)l * INWP * DM * 2, ROWS, INWP, DM, C.G, C.wg);
            pg8::EpiStoreBf16 E{(bf16*)(C.ws + WS_P), INWP, nullptr, 0, 1.0f, 1.0f};
            pg8::gemm_phase<pg8::EpiStoreBf16, pg8::StaticOrder, true, true>(C.lds, C.tid, DM, S, E, C.ws);
        }
        SEAM(b + 1);
        if (INP(3, b + 2)) { MKCTX(); for (int rep = 0; rep < NREP(3); ++rep) { mix1_rwkv_prep(C, da, l); mix1_fourier1(C); } }
        SEAM(b + 2);
        if (INP(11, b + 3)) for (int rep = 0; rep < NREP(11); ++rep) { MKCTX(); phase_rwkv1(C);
            if (C.wg >= 8 * RW_NSC) {
                Ctx C2 = C; C2.wg = C.wg - 8 * RW_NSC; C2.G = C.G - 8 * RW_NSC; C2.gw = C2.wg * NWAVES + C.wave; C2.NGW = C2.G * NWAVES;
                mix1_rope(C2); mix1_vt(C2); } }
        SEAM(b + 3);
        if (INP(4, b + 4)) for (int rep = 0; rep < NREP(4); ++rep) { MKCTX(); phase_mix2(C, da, l); }
        SEAM(b + 4);
        if (INP(5, b + 5)) for (int rep = 0; rep < NREP(5); ++rep) { MKCTX(); phase_mix3(C, da, l); }
        SEAM(b + 5);
        if (INP(6, b + 6)) { MKCTX();
            if (l < DEPTH - 1) outproj_ctx(C, l, mod_ctx + 2 * DM);
            pg8::StaticOrder S; S.init(WS_MIX + (size_t)NCTX * DM * 2, WS_WOUT + (size_t)l * DM * DM * 2, SEQ, DM, DM, C.G, C.wg);
            pg8::EpiResidual E{(float*)(C.ws + WS_XS) + (size_t)NCTX * DM, DM, mod_lat + 2 * DM, mod_lat + 2 * DM};
            pg8::gemm_phase<pg8::EpiResidual, pg8::StaticOrder, true, true>(C.lds, C.tid, DM, S, E, C.ws);
        }
        SEAM(b + 6);
        if (INP(7, b + 7)) for (int rep = 0; rep < NREP(7); ++rep) { MKCTX(); phase_norm2(C, da, l); }
        SEAM(b + 7);
        if (INP(8, b + 8)) for (int rep = 0; rep < NREP(8); ++rep) { MKCTX(); phase_gather(C, da, l); }
        SEAM(b + 8);
        if (INP(9, b + 9)) for (int rep = 0; rep < NREP(9); ++rep) { MKCTX();
            const int nblk = moe_tables(C);
            pg8::MoeOrder S{(unsigned)WS_XG8, (unsigned)(WS_WGU + (size_t)l * 32 * 2048 * DM), 256u * DM, 2048u * DM,
                            (const LAS unsigned char*)(C.lds + MISC_OFF + 1024), nblk, 8, C.G, C.wg};
            pg8::EpiSwiglu E{(bf16*)(C.ws + WS_ACT8), DM, da.in[I_BGU] + (size_t)l * 32 * 2048, 2048, pg8::X8_S * pg8::W8_S, 1.0f / (pg8::X8_S * pg8::W8_S)};
            pg8::gemm_phase<pg8::EpiSwiglu, pg8::MoeOrder, true, true, 1>(C.lds, C.tid, DM, S, E, C.ws);
        }
        SEAM(b + 9);
        if (INP(10, b + 10)) for (int rep = 0; rep < NREP(10); ++rep) { MKCTX();
            const int nblk = moe_tables(C);
            pg8::MoeOrder S{(unsigned)WS_ACT8, (unsigned)(WS_WDN + (size_t)l * 32 * DM * DM), 256u * DM, (unsigned)(DM * DM),
                            (const LAS unsigned char*)(C.lds + MISC_OFF + 1024), nblk, 4, C.G, C.wg};
            pg8::EpiStoreBf16 E{(bf16*)(C.ws + WS_XG), DM, da.in[I_BDN] + (size_t)l * 32 * DM, DM, pg8::ACT_S * pg8::W8_S, 1.0f / (pg8::ACT_S * pg8::W8_S)};
            pg8::gemm_phase<pg8::EpiStoreBf16, pg8::MoeOrder, true, true, 1>(C.lds, C.tid, DM, S, E, C.ws);
        }
        SEAM(b + 10);
    }
    if (INP(99, PH_TOTAL - 1)) for (int rep = 0; rep < NREP(99); ++rep) { MKCTX(); phase_final(C, da); }
#undef IN
#undef INP
#undef SEAM
}

typedef void (*kern_t)(Args);
static kern_t kern_of(int o) {
#if MK_SINGLE
    (void)o; return mega<-1>;
#else
    switch (o) { case 0: return mega<0>; case 1: return mega<1>; case 2: return mega<2>; case 3: return mega<3>; case 4: return mega<4>; case 5: return mega<5>; case 6: return mega<6>;
                 case 7: return mega<7>; case 8: return mega<8>; case 9: return mega<9>; case 10: return mega<10>; case 11: return mega<11>; case 99: return mega<99>;
                 default: return mega<0>;
    }
#endif
}
extern "C" void kernel_launch(void* const* d_in, const int* in_sizes, int n_in, void* d_out, int out_size, void* d_ws, size_t ws_size, hipStream_t stream) {
    static int ready = 0;
    if (ready == 0) {
        if (n_in != 31 || out_size != SEQ * DM || ws_size < WS_END) { fprintf(stderr, "kernel_launch: unexpected shapes (n_in %d, out %d, ws %zu)\n", n_in, out_size, ws_size); ready = -1; return; }
        const int ids[14] = {0, 1, 2, 3, 4, 5, 6, 7, 8, 9, 10, 11, 99, -1};
        for (int i = 0; i < (MK_SINGLE ? 14 : 13); ++i) { if (MK_SINGLE && ids[i] != -1) continue;
            if (hipFuncSetAttribute((const void*)kern_of(ids[i]), hipFuncAttributeMaxDynamicSharedMemorySize, LDS_BYTES) != hipSuccess) { fprintf(stderr, "kernel_launch: hipFuncSetAttribute failed (%d)\n", ids[i]); ready = -1; return; } }
        ready = 1;
    }
    if (ready < 0) return;
    (void)hipMemsetAsync((char*)d_ws + WS_CTL, 0, CTL_ZERO_BYTES, stream);
    Args a{};
    for (int i = 0; i < 31; ++i) a.in[i] = (const float*)d_in[i];
    a.out = (float*)d_out; a.ws = (unsigned char*)d_ws; a.pad = 0;
#if MK_SINGLE
    a.ph_lo = 0; a.ph_hi = PH_TOTAL; a.use_bar = 1;
    hipLaunchKernelGGL(kern_of(-1), dim3(NWG), dim3(NTHR), LDS_BYTES, stream, a);
#else
    for (int p = 0; p < PH_TOTAL; ++p) { a.ph_lo = p; a.ph_hi = p + 1; a.use_bar = 0;
        const int j = (p - 1) % NPL; const int o = (p == 0) ? 0 : (p == PH_TOTAL - 1) ? 99 : (j < 3 ? 1 + j : j == 3 ? 11 : j);
        hipLaunchKernelGGL(kern_of(o), dim3(NWG), dim3(NTHR), LDS_BYTES, stream, a); }
#endif
}
```

```cpp
#include <hip/hip_runtime.h>
#include <cstdio>
#include <cstdint>

#define LAS __attribute__((address_space(3)))
typedef unsigned short bf16;
typedef float f32x4 __attribute__((ext_vector_type(4)));
typedef float f32x2 __attribute__((ext_vector_type(2)));
typedef short bf16x8 __attribute__((ext_vector_type(8)));
typedef unsigned u32x4 __attribute__((ext_vector_type(4)));
typedef unsigned u32x2 __attribute__((ext_vector_type(2)));

constexpr int DM = 1024, SEQ = 16384, NCTX = 256, ROWS = SEQ + NCTX, DEPTH = 4, GRIDW = 64;
constexpr int INW = 2720, INWP = 2816;
constexpr int C_AQ = 0, C_AK = 256, C_AV = 384, C_BU = 512, C_CQ = 768, C_CK = 1024, C_CV = 1280, C_DR = 1536, C_DK = 1792, C_DV = 2048, C_WL = 2304, C_AL = 2432, C_GL = 2560;
constexpr int NEXP = 32, TOPK = 4;
constexpr int MOE_MAXBLK = 296;
constexpr int MOE_ROWS = MOE_MAXBLK * 256;
constexpr int NWG = 256, NTHR = 512, NWAVES = 8;
constexpr int VTP = ROWS + 256;

constexpr size_t MiB = 1u << 20;
constexpr size_t WS_CTL = 0, CTL_ZERO_BYTES = 1 * MiB;
constexpr size_t WS_MOD = 1 * MiB;
constexpr size_t WS_TW = 2 * MiB;
constexpr size_t WS_MTAB = 3 * MiB;
constexpr size_t WS_XS = 4 * MiB;
constexpr size_t WS_H = 70 * MiB;
constexpr size_t WS_P = 104 * MiB;
constexpr size_t WS_MIX = 194 * MiB;
constexpr size_t WS_FYR = 228 * MiB, WS_FYI = 244 * MiB;
constexpr size_t WS_VTA = 1544 * MiB, WS_VTC = 1550 * MiB;
constexpr size_t WS_SC = 260 * MiB;
constexpr size_t WS_YS = 408 * MiB;
constexpr size_t WS_ROUTE = 442 * MiB;
constexpr size_t WS_CNT = 444 * MiB;
constexpr size_t WS_XG = 446 * MiB;
constexpr size_t WS_ACT = 596 * MiB;
constexpr size_t WS_XG8 = WS_ACT, WS_ACT8 = WS_ACT + 75 * MiB;
constexpr size_t WS_WIN = 746 * MiB;
constexpr size_t WS_WOUT = 768 * MiB;
constexpr size_t WS_WGU = 776 * MiB;
constexpr size_t WS_WDN = 1288 * MiB;
constexpr size_t WS_RPP = 1560 * MiB, WS_PSC = 1578 * MiB, WS_LSC = 1580 * MiB, WS_HSC = 1584 * MiB;
constexpr size_t WS_FTAB = 1586 * MiB;
constexpr size_t WS_G2T = 1588 * MiB, WS_RWT = 1589 * MiB;
constexpr size_t WS_LORAT = 1590 * MiB;
constexpr size_t WS_F256 = 1591 * MiB;

constexpr size_t WS_END = 1592 * MiB;
static_assert(WS_XS + (size_t)ROWS * DM * 4 <= WS_H && WS_H + (size_t)ROWS * DM * 2 <= WS_P && WS_P + (size_t)ROWS * INWP * 2 <= WS_MIX && WS_MIX + (size_t)ROWS * DM * 2 <= WS_FYR, "ws map 1");
static_assert(WS_SC + (size_t)ROWS * 9 * 256 * 4 <= WS_YS && WS_YS + (size_t)2 * ROWS * 256 * 4 <= WS_ROUTE && WS_XG + (size_t)MOE_ROWS * DM * 2 <= WS_ACT && WS_ACT + (size_t)MOE_ROWS * DM * 2 <= WS_WIN, "ws map 2");
static_assert(WS_WIN + (size_t)4 * INWP * DM * 2 <= WS_WOUT && WS_WGU + (size_t)4 * 32 * 2048 * 1024 * 2 <= WS_WDN && WS_WDN + (size_t)4 * 32 * 1024 * 1024 * 2 <= WS_END, "ws map 3");
constexpr int CW_BAR = 4096;
constexpr int CW_WQ = 16384;

constexpr int RING_BYTES = 131072;
constexpr int MISC_OFF = 143360;
constexpr int LDS_BYTES = 147456;

__device__ __forceinline__ unsigned f2bf(float f) { unsigned u = __builtin_bit_cast(unsigned, f); return (u + 0x7fffu + ((u >> 16) & 1u)) >> 16; }
__device__ __forceinline__ unsigned pk2(float lo, float hi) { return f2bf(lo) | (f2bf(hi) << 16); }
__device__ __forceinline__ float bf2f(unsigned short b) { return __builtin_bit_cast(float, (unsigned)b << 16); }
__device__ __forceinline__ float bflo(unsigned w) { return __builtin_bit_cast(float, w << 16); }
__device__ __forceinline__ float bfhi(unsigned w) { return __builtin_bit_cast(float, w & 0xffff0000u); }
__device__ __forceinline__ float shx(float v, int o, int lane) { return __builtin_bit_cast(float, __builtin_amdgcn_ds_bpermute((lane ^ o) << 2, __builtin_bit_cast(int, v))); }
__device__ __forceinline__ int shxi(int v, int o, int lane) { return __builtin_amdgcn_ds_bpermute((lane ^ o) << 2, v); }
__device__ __forceinline__ float dpp_ror(float v, int ctrl_unused);
#define DPP_ROR_ADD(v, n) v += __builtin_bit_cast(float, __builtin_amdgcn_update_dpp(0, __builtin_bit_cast(int, v), 0x120 + (n), 0xf, 0xf, false))
__device__ __forceinline__ float wave_sum(float v, int lane) {
    DPP_ROR_ADD(v, 8); DPP_ROR_ADD(v, 4); DPP_ROR_ADD(v, 2); DPP_ROR_ADD(v, 1);
    v += shx(v, 16, lane); v += shx(v, 32, lane);
    return v;
}
__device__ __forceinline__ float sigmoidf_(float x) { return 1.f / (1.f + __expf(-x)); }
#define LDS_WAIT() asm volatile("s_waitcnt lgkmcnt(0)" ::: "memory")
#define VM_WAIT() asm volatile("s_waitcnt vmcnt(0)" ::: "memory")

namespace pg8 {
#define PG8_LAS __attribute__((address_space(3)))
typedef unsigned short bf16_t;
constexpr int BM = 256, BK = 64, HALF = 128, HTB = HALF * BK * 2, STAGE_BYTES = 8 * HTB, NXCD = 8, WGM = 8;
__host__ __device__ __forceinline__ int lds_byte(int r, int c) { const int st = (r >> 4) * 2 + (c >> 5), rr = r & 15, cc = c & 31, ob = rr * 64 + cc * 2; return st * 1024 + (ob ^ (((ob >> 9) & 1) << 5)); }
__host__ __device__ __forceinline__ void stage_rc(int b, int& R, int& C) { const int st = b / 1024, sb = b % 1024, swz = sb ^ (((sb >> 9) & 1) << 5); R = (st >> 1) * 16 + swz / 64; C = (st & 1) * 32 + (swz % 64) / 2; }
__host__ __device__ __forceinline__ int perm32(int rho) { const int n = rho >> 4, i = rho & 15; return 8 * (i >> 2) + 4 * n + (i & 3); }
struct Unit { int pm, pn, e; };
typedef int v8i __attribute__((ext_vector_type(8))); typedef int v4i __attribute__((ext_vector_type(4)));
__device__ __forceinline__ v8i cat8(bf16x8 a, bf16x8 b) { const v4i x = __builtin_bit_cast(v4i, a), y = __builtin_bit_cast(v4i, b); return __builtin_shufflevector(x, y, 0, 1, 2, 3, 4, 5, 6, 7); }
__device__ __forceinline__ unsigned cvt_pk_bf16(float lo, float hi) { unsigned r; asm volatile("v_cvt_pk_bf16_f32 %0, %1, %2" : "=v"(r) : "v"(lo), "v"(hi)); return r; }

struct StaticOrder {
    unsigned A, Bt, tstep;
    int nM, nN, nwg, G, c;
    __device__ void init(size_t A_, size_t Bt_, int M, int N, int K, int G_, int c_) { A = (unsigned)A_; Bt = (unsigned)Bt_; tstep = (unsigned)(BM * K * 2); nM = M / BM; nN = N / BM; nwg = nM * nN; G = G_; c = c_; }
    __device__ bool next(int i, Unit& u) const {
        const long L = (long)i * G + c; if (L >= nwg) return false;
        int wgid = (int)L; { const int q = nwg / NXCD, r = nwg % NXCD, xcd = wgid % NXCD, off = wgid / NXCD; wgid = (xcd < r ? xcd * (q + 1) : r * (q + 1) + (xcd - r) * q) + off; }
        const int nig = WGM * nN, gid = wgid / nig, fm = gid * WGM, gsz = (nM - fm) < WGM ? (nM - fm) : WGM;
        u.pm = fm + ((wgid % nig) % gsz); u.pn = (wgid % nig) / gsz; u.e = 0; return true;
    }
    __device__ __forceinline__ unsigned pa(const Unit& u) const { return A + (unsigned)u.pm * tstep; }
    __device__ __forceinline__ unsigned pb(const Unit& u) const { return Bt + (unsigned)u.pn * tstep; }
};
struct MoeOrder {
    unsigned A, Bt, tstep, estep;
    const LAS unsigned char* blk_e; int nblk, nN, G, c;
    __device__ bool next(int i, Unit& u) const {
        const int L = i * G + c; if (L >= nblk * nN) return false;
        u.pm = L / nN; u.pn = L % nN; u.e = __builtin_amdgcn_readfirstlane((int)blk_e[u.pm]); return true;
    }
    __device__ __forceinline__ unsigned pa(const Unit& u) const { return A + (unsigned)u.pm * tstep; }
    __device__ __forceinline__ unsigned pb(const Unit& u) const { return Bt + (unsigned)u.e * estep + (unsigned)u.pn * tstep; }
};

struct EpiStoreBf16 {
    static constexpr bool PERM = true;
    bf16_t* O; int ldc; const float* bias; int bias_estride; float bias_scale, acc_scale;
    __device__ __forceinline__ void init(f32x4 (&acc)[2][2][4][2], const Unit& u, int wc, int fq) const {
        const int col0 = u.pn * BM + wc * 32 + 8 * fq;
#pragma unroll
        for (int b = 0; b < 2; ++b)
#pragma unroll
            for (int n = 0; n < 2; ++n) { const f32x4 bv = bias ? *(const f32x4*)(bias + (size_t)u.e * bias_estride + col0 + b * HALF + 4 * n) * bias_scale : (f32x4){0.f, 0.f, 0.f, 0.f};
#pragma unroll
                for (int a = 0; a < 2; ++a)
#pragma unroll
                    for (int m = 0; m < 4; ++m) { f32x4 t = bv; asm volatile("" : "+v"(t)); acc[a][b][m][n] = t; } }
    }
    __device__ __forceinline__ void operator()(const f32x4 (&acc)[2][2][4][2], const Unit& u, int wr, int wc, int fr, int fq) const {
        const int row0 = u.pm * BM + wr * 64 + fr, col0 = u.pn * BM + wc * 32 + 8 * fq;
#pragma unroll
        for (int ai = 0; ai < 2; ++ai)
#pragma unroll
            for (int m = 0; m < 4; ++m) { bf16_t* rowp = O + (size_t)(row0 + ai * HALF + m * 16) * ldc + col0;
#pragma unroll
                for (int bj = 0; bj < 2; ++bj) { const f32x4 v0 = acc[ai][bj][m][0] * acc_scale, v1 = acc[ai][bj][m][1] * acc_scale;
                    u32x4 w; w.x = cvt_pk_bf16(v0[0], v0[1]); w.y = cvt_pk_bf16(v0[2], v0[3]); w.z = cvt_pk_bf16(v1[0], v1[1]); w.w = cvt_pk_bf16(v1[2], v1[3]);
                    *(u32x4*)(rowp + bj * HALF) = w; }
                asm volatile("" ::: "memory"); }
    }
};
__device__ __forceinline__ float swiglu1(float g, float up) {
    g = fminf(g, 7.0f); up = fminf(fmaxf(up, -7.0f), 7.0f);
    return g * (1.f / (1.f + __expf(-1.702f * g))) * (up + 1.0f);
}
constexpr float X8_S = 8.0f, W8_S = 256.0f, ACT_S = 4.0f;
struct EpiSwiglu {
    static constexpr bool PERM = true;
    bf16_t* O; int ldc; const float* bias; int bias_estride; float bias_scale, acc_scale;
    __device__ __forceinline__ void init(f32x4 (&acc)[2][2][4][2], const Unit& u, int wc, int fq) const {
        const int col0 = u.pn * BM + wc * 32 + 8 * fq;
#pragma unroll
        for (int b = 0; b < 2; ++b)
#pragma unroll
            for (int n = 0; n < 2; ++n) { const f32x4 bv = bias ? *(const f32x4*)(bias + (size_t)u.e * bias_estride + col0 + b * HALF + 4 * n) * bias_scale : (f32x4){0.f, 0.f, 0.f, 0.f};
#pragma unroll
                for (int a = 0; a < 2; ++a)
#pragma unroll
                    for (int m = 0; m < 4; ++m) { f32x4 t = bv; asm volatile("" : "+v"(t)); acc[a][b][m][n] = t; } }
    }
    __device__ __forceinline__ void operator()(const f32x4 (&acc)[2][2][4][2], const Unit& u, int wr, int wc, int fr, int fq) const {
        const int row0 = u.pm * BM + wr * 64 + fr, col0 = u.pn * BM + wc * 32 + 8 * fq;
#pragma unroll
        for (int ai = 0; ai < 2; ++ai)
#pragma unroll
            for (int m = 0; m < 4; ++m) { unsigned char* rowp = (unsigned char*)O + (size_t)(row0 + ai * HALF + m * 16) * ldc + (col0 >> 1);
#pragma unroll
                for (int bj = 0; bj < 2; ++bj) { const f32x4 v0 = acc[ai][bj][m][0] * acc_scale, v1 = acc[ai][bj][m][1] * acc_scale;
                    unsigned w = 0; w = __builtin_amdgcn_cvt_pk_fp8_f32(swiglu1(v0[0], v0[1]) * ACT_S, swiglu1(v0[2], v0[3]) * ACT_S, w, false); w = __builtin_amdgcn_cvt_pk_fp8_f32(swiglu1(v1[0], v1[1]) * ACT_S, swiglu1(v1[2], v1[3]) * ACT_S, w, true);
                    *(unsigned*)(rowp + bj * (HALF / 2)) = w; }
                asm volatile("" ::: "memory"); }
    }
};
struct EpiResidual {
    static constexpr bool PERM = false;
    float* X; int ldc; const float* gate_lat; const float* gate_ctx;
    __device__ __forceinline__ void init(f32x4 (&acc)[2][2][4][2], const Unit& u, int wc, int fq) const {
#pragma unroll
        for (int a = 0; a < 2; ++a)
#pragma unroll
            for (int b = 0; b < 2; ++b)
#pragma unroll
                for (int m = 0; m < 4; ++m)
#pragma unroll
                    for (int n = 0; n < 2; ++n) acc[a][b][m][n] = (f32x4){0.f, 0.f, 0.f, 0.f};
    }
    __device__ __forceinline__ void operator()(const f32x4 (&acc)[2][2][4][2], const Unit& u, int wr, int wc, int fr, int fq) const {
        const int row0 = u.pm * BM + wr * 64 + fr, col0 = u.pn * BM + wc * 32 + 4 * fq;
        const float* gp = (u.pm == 0) ? gate_ctx : gate_lat;
        f32x4 gv[2][2];
#pragma unroll
        for (int bj = 0; bj < 2; ++bj)
#pragma unroll
            for (int n = 0; n < 2; ++n) gv[bj][n] = *(const f32x4*)(gp + col0 + bj * HALF + n * 16);
#pragma unroll
        for (int ai = 0; ai < 2; ++ai)
#pragma unroll
            for (int m = 0; m < 4; ++m) { float* rowp = X + (size_t)(row0 + ai * HALF + m * 16) * ldc + col0;
#pragma unroll
                for (int bj = 0; bj < 2; ++bj)
#pragma unroll
                    for (int n = 0; n < 2; ++n) { f32x4* p = (f32x4*)(rowp + bj * HALF + n * 16); *p = *p + gv[bj][n] * acc[ai][bj][m][n]; }
                asm volatile("" ::: "memory"); }
    }
};
template <class Epi, class Sched, bool ALIGN_EPI = false, bool SP2 = false, int ES = 2>
__device__ __forceinline__ void gemm_phase(PG8_LAS unsigned char* lds, const int tid, const int K, const Sched& S, const Epi& E, const void* wsbase) {
    const __amdgpu_buffer_rsrc_t rsrc = __builtin_amdgcn_make_buffer_rsrc((void*)wsbase, 0, 0x7fffffff, 0x00020000);
    const int wid = __builtin_amdgcn_readfirstlane(tid >> 6), lane = tid & 63, wr = wid >> 2, wc = wid & 3, fr = lane & 15, fq = lane >> 4;
    const int nt = (K * ES) / 128;
    unsigned voffA[2], voffB[2];
#pragma unroll
    for (int i = 0; i < 2; ++i) { int R, C; stage_rc(tid * 16 + i * 8192, R, C); const int Rb = Epi::PERM ? ((R & ~31) + perm32(R & 31)) : R;
        voffA[i] = (unsigned)(R * K * ES + C * 2); voffB[i] = (unsigned)(Rb * K * ES + C * 2); }
    const unsigned kstep = (unsigned)(BK * 2);
    const unsigned hstep = (unsigned)(HALF * K * ES);
        const unsigned ldsw = (unsigned)wid * 1024u;
    const int aoff = lds_byte(wr * 64 + fr, ES == 2 ? fq * 8 : fq * 16), boff = lds_byte(wc * 32 + fr, ES == 2 ? fq * 8 : fq * 16); constexpr int KOFF = (ES == 2) ? 1024 : 16;
#define PG8_SA(b, h) (((b) * 2 + (h)) * HTB)
#define PG8_SB(b, h) ((4 + (b) * 2 + (h)) * HTB)
#define PG8_STAGE(bufoff, gbase, voff) do { _Pragma("unroll") for (int _i = 0; _i < 2; ++_i) \
        __builtin_amdgcn_raw_ptr_buffer_load_lds(rsrc, (PG8_LAS unsigned*)(lds + (bufoff) + ldsw + _i * 8192), 16, (voff)[_i], (gbase), 0, 0); } while (0)
#define PG8_LDA(dst, b, h) do { _Pragma("unroll") for (int m = 0; m < 4; ++m) _Pragma("unroll") for (int k = 0; k < 2; ++k) dst[m][k] = *(const PG8_LAS bf16x8*)(lds + PG8_SA(b, h) + aoff + m * 2048 + k * KOFF); } while (0)
#define PG8_LDA8(dst, b, h) do { _Pragma("unroll") for (int m = 0; m < 4; ++m) { const PG8_LAS v4i* p_ = (const PG8_LAS v4i*)(lds + PG8_SA(b, h) + aoff + m * 2048); const v4i x_ = p_[0], y_ = p_[1]; dst[m] = __builtin_shufflevector(x_, y_, 0, 1, 2, 3, 4, 5, 6, 7); } } while (0)
#define PG8_LDB(dst, b, h) do { _Pragma("unroll") for (int n = 0; n < 2; ++n) _Pragma("unroll") for (int k = 0; k < 2; ++k) dst[n][k] = *(const PG8_LAS bf16x8*)(lds + PG8_SB(b, h) + boff + n * 2048 + k * KOFF); } while (0)
#define PG8_LDB8(dst, b, h) do { _Pragma("unroll") for (int n = 0; n < 2; ++n) { const PG8_LAS v4i* p_ = (const PG8_LAS v4i*)(lds + PG8_SB(b, h) + boff + n * 2048); const v4i x_ = p_[0], y_ = p_[1]; dst[n] = __builtin_shufflevector(x_, y_, 0, 1, 2, 3, 4, 5, 6, 7); } } while (0)
#define PG8_MMA(ai, bj, At, Bt) do { __builtin_amdgcn_s_setprio(1); _Pragma("unroll") for (int m = 0; m < 4; ++m) _Pragma("unroll") for (int n = 0; n < 2; ++n) { \
        if constexpr (ES == 2) { _Pragma("unroll") for (int k = 0; k < 2; ++k) acc[ai][bj][m][n] = __builtin_amdgcn_mfma_f32_16x16x32_bf16(Bt[n][k], At[m][k], acc[ai][bj][m][n], 0, 0, 0); } \
        else asm volatile("v_mfma_f32_16x16x128_f8f6f4 %0, %1, %2, %0" : "+v"(acc[ai][bj][m][n]) : "v"(Bt##8[n]), "v"(At##8[m])); } \
        __builtin_amdgcn_s_setprio(0); } while (0)
#define PG8_LDAX(b, h) do { if constexpr (ES == 2) PG8_LDA(At, b, h); else PG8_LDA8(At8, b, h); } while (0)
#define PG8_LDBX(B, b, h) do { if constexpr (ES == 2) PG8_LDB(B, b, h); else PG8_LDB8(B##8, b, h); } while (0)
#define PG8_WAIT_V(n) asm volatile("s_waitcnt vmcnt(" #n ")" ::: "memory")
#define PG8_WAIT_L(n) asm volatile("s_waitcnt lgkmcnt(" #n ")" ::: "memory")
#define PG8_BAR __builtin_amdgcn_s_barrier()
#define PG8_SCHED __builtin_amdgcn_sched_barrier(0)
    Unit cur, nxt; int ui = 0;
    if (!S.next(0, cur)) return;
    f32x4 acc[2][2][4][2];
    E.init(acc, cur, wc, fq);
    bf16x8 At[4][2], B0[2][2], B1[2][2]; v8i At8[4], B08[2], B18[2];
    unsigned cA = S.pa(cur), cB = S.pb(cur);
    if constexpr (SP2) {
        PG8_STAGE(PG8_SB(0, 0), cB, voffB); PG8_STAGE(PG8_SB(0, 1), cB + hstep, voffB); PG8_STAGE(PG8_SA(0, 0), cA, voffA); PG8_STAGE(PG8_SA(0, 1), cA + hstep, voffA);
        if (wr == 1) PG8_BAR;
        PG8_WAIT_V(2); PG8_BAR;
        PG8_STAGE(PG8_SB(1, 0), cB + kstep, voffB); PG8_STAGE(PG8_SA(1, 0), cA + kstep, voffA); PG8_STAGE(PG8_SB(1, 1), cB + hstep + kstep, voffB);
        PG8_WAIT_V(6); PG8_BAR;
    } else {
        PG8_STAGE(PG8_SB(0, 0), cB, voffB); PG8_STAGE(PG8_SA(0, 0), cA, voffA); PG8_STAGE(PG8_SB(0, 1), cB + hstep, voffB); PG8_STAGE(PG8_SA(0, 1), cA + hstep, voffA);
        if (wr == 1) PG8_BAR;
        PG8_WAIT_V(4); PG8_BAR;
        PG8_STAGE(PG8_SB(1, 0), cB + kstep, voffB); PG8_STAGE(PG8_SA(1, 0), cA + kstep, voffA); PG8_STAGE(PG8_SB(1, 1), cB + hstep + kstep, voffB);
        PG8_WAIT_V(6); PG8_BAR;
    }
    for (;;) {
        const bool has_next = S.next(ui + 1, nxt);
        const unsigned nA = has_next ? S.pa(nxt) : cA, nB = has_next ? S.pb(nxt) : cB;
        for (int t = 0; t < nt; t += 2) {
            const bool last = (t == nt - 2);
            const unsigned a1 = cA + (unsigned)(t + 1) * kstep;
            const unsigned a2 = last ? nA : cA + (unsigned)(t + 2) * kstep, b2 = last ? nB : cB + (unsigned)(t + 2) * kstep;
            const unsigned a3 = a2 + kstep, b3 = b2 + kstep;
            if constexpr (SP2) {
            PG8_LDBX(B0, 0, 0); PG8_LDBX(B1, 0, 1); PG8_SCHED; PG8_LDAX(0, 0); PG8_STAGE(PG8_SA(1, 1), a1 + hstep, voffA);
            PG8_WAIT_V(8); PG8_WAIT_L(0); PG8_BAR; PG8_MMA(0, 0, At, B0); PG8_MMA(0, 1, At, B1); PG8_BAR; PG8_SCHED;
            PG8_LDAX(0, 1); PG8_STAGE(PG8_SB(0, 0), b2, voffB); PG8_STAGE(PG8_SB(0, 1), b2 + hstep, voffB); PG8_STAGE(PG8_SA(0, 0), a2, voffA);
            PG8_WAIT_V(8); PG8_WAIT_L(0); PG8_BAR; PG8_MMA(1, 0, At, B0); PG8_MMA(1, 1, At, B1); PG8_BAR; PG8_SCHED;
            PG8_LDBX(B0, 1, 0); PG8_LDBX(B1, 1, 1); PG8_SCHED; PG8_LDAX(1, 0); PG8_STAGE(PG8_SA(0, 1), a2 + hstep, voffA);
            PG8_WAIT_V(8); PG8_WAIT_L(0); PG8_BAR; PG8_MMA(0, 0, At, B0); PG8_MMA(0, 1, At, B1); PG8_BAR; PG8_SCHED;
            PG8_LDAX(1, 1); PG8_STAGE(PG8_SB(1, 0), b3, voffB); PG8_STAGE(PG8_SB(1, 1), b3 + hstep, voffB); PG8_STAGE(PG8_SA(1, 0), a3, voffA);
            PG8_WAIT_V(8); PG8_WAIT_L(0); PG8_BAR; PG8_MMA(1, 0, At, B0); PG8_MMA(1, 1, At, B1); PG8_BAR; PG8_SCHED;
            } else {
            PG8_LDBX(B0, 0, 0); PG8_SCHED; PG8_LDAX(0, 0); PG8_STAGE(PG8_SA(1, 1), a1 + hstep, voffA);
            PG8_WAIT_L(8); PG8_BAR; PG8_WAIT_L(0); PG8_MMA(0, 0, At, B0); PG8_BAR; PG8_SCHED;
            PG8_LDBX(B1, 0, 1); PG8_STAGE(PG8_SB(0, 0), b2, voffB);
            PG8_BAR; PG8_WAIT_L(0); PG8_MMA(0, 1, At, B1); PG8_BAR;
            PG8_LDAX(0, 1); PG8_STAGE(PG8_SA(0, 0), a2, voffA);
            PG8_BAR; PG8_WAIT_L(0); PG8_MMA(1, 0, At, B0); PG8_BAR; PG8_SCHED;
            PG8_STAGE(PG8_SB(0, 1), b2 + hstep, voffB);
            PG8_WAIT_V(6); PG8_BAR; PG8_MMA(1, 1, At, B1); PG8_BAR;
            PG8_LDBX(B0, 1, 0); PG8_SCHED; PG8_LDAX(1, 0); PG8_STAGE(PG8_SA(0, 1), a2 + hstep, voffA);
            PG8_WAIT_L(8); PG8_BAR; PG8_WAIT_L(0); PG8_MMA(0, 0, At, B0); PG8_BAR; PG8_SCHED;
            PG8_LDBX(B1, 1, 1); PG8_STAGE(PG8_SB(1, 0), b3, voffB);
            PG8_BAR; PG8_WAIT_L(0); PG8_MMA(0, 1, At, B1); PG8_BAR;
            PG8_LDAX(1, 1); PG8_STAGE(PG8_SA(1, 0), a3, voffA);
            PG8_BAR; PG8_WAIT_L(0); PG8_MMA(1, 0, At, B0); PG8_BAR; PG8_SCHED;
            PG8_STAGE(PG8_SB(1, 1), b3 + hstep, voffB);
            PG8_WAIT_V(6); PG8_BAR; PG8_MMA(1, 1, At, B1); PG8_BAR;
            }
        }
        if constexpr (ALIGN_EPI) { if (wr == 0) PG8_BAR; }
        if constexpr (ES == 1) asm volatile("s_nop 15\n\ts_nop 15" ::: "memory");
        E(acc, cur, wr, wc, fr, fq);
        if (!has_next) break;
        E.init(acc, nxt, wc, fq);
        cur = nxt; cA = nA; cB = nB; ++ui;
        if constexpr (ALIGN_EPI) { if (wr == 1) PG8_BAR; }
    }
    PG8_WAIT_V(0);
    if constexpr (!ALIGN_EPI) { if (wr == 0) PG8_BAR; }
    PG8_BAR;
#undef PG8_SA
#undef PG8_SB
#undef PG8_STAGE
#undef PG8_LDA
#undef PG8_LDA8
#undef PG8_LDB8
#undef PG8_LDAX
#undef PG8_LDBX
#undef PG8_LDB
#undef PG8_MMA
#undef PG8_WAIT_V
#undef PG8_WAIT_L
#undef PG8_BAR
#undef PG8_SCHED
}
}

#define XB_TMO      128
#define XB_XCNT(j)  (256  + 64 * (j))
#define XB_XSUB(j)  (1280 + 64 * (j))
#define XB_XGEN(j)  (2304 + 64 * (j))
#define XB_TOP      3328
#define XB_TOPGEN   3392
#define XCD_BAR_WORDS 3456
#define XB_SPIN_CAP (1u << 18)
__device__ __forceinline__ unsigned xb_ld(unsigned* p)              { return __hip_atomic_load(p, __ATOMIC_RELAXED, __HIP_MEMORY_SCOPE_AGENT); }
__device__ __forceinline__ unsigned xb_add(unsigned* p, unsigned v) { return __hip_atomic_fetch_add(p, v, __ATOMIC_RELAXED, __HIP_MEMORY_SCOPE_AGENT); }
__device__ __forceinline__ unsigned xb_xcc_id() { return (unsigned)__builtin_amdgcn_s_getreg((3 << 11) | 20) & 0xFu; }
#define XB_SPIN(cond, bar) do { unsigned _sp = 0; while (cond) { __builtin_amdgcn_s_sleep(1); \
    if ((++_sp & 255u) == 0u) { if (xb_ld(&(bar)[XB_TMO])) break; if (_sp > XB_SPIN_CAP) { atomicAdd(&(bar)[XB_TMO], 1u); break; } } } } while (0)

struct XcdBarrier {
    unsigned* bar; unsigned x;
    volatile LAS unsigned* st;
};

__device__ __forceinline__ XcdBarrier xcd_barrier_post(unsigned* bar, volatile LAS unsigned* st) {
    XcdBarrier b; b.bar = bar; b.x = xb_xcc_id(); b.st = st;
    if (threadIdx.x == 0) (void)xb_add(&bar[XB_XCNT(b.x)], 1u);
    return b;
}
__device__ __forceinline__ void xcd_barrier_complete(unsigned* bar, unsigned x, unsigned& nloc, unsigned& nx) {
    const unsigned G = gridDim.x * gridDim.y * gridDim.z;
    unsigned sum, cnt, mine, sp = 0u;
    for (;;) {
        sum = 0u; cnt = 0u; mine = 0u;
#pragma unroll
        for (unsigned j = 0; j < 16; ++j) { const unsigned c = xb_ld(&bar[XB_XCNT(j)]); sum += c; cnt += (c > 0u) ? 1u : 0u; mine = (j == x) ? c : mine; }
        if (sum == G) break;
        __builtin_amdgcn_s_sleep(1);
        if ((++sp & 255u) == 0u) { if (xb_ld(&bar[XB_TMO])) break; if (sp > XB_SPIN_CAP) { atomicAdd(&bar[XB_TMO], 1u); break; } }
    }
    nloc = mine > 0u ? mine : 1u; nx = cnt > 0u ? cnt : 1u;
}

__device__ __forceinline__ void xcd_barrier(const XcdBarrier& b) {
    asm volatile("s_waitcnt vmcnt(0)" ::: "memory");
    __syncthreads();
    if (threadIdx.x == 0) {
        unsigned* bar = b.bar;
        __builtin_amdgcn_s_waitcnt(0);
        unsigned nloc = b.st[0], nx = b.st[1];
        if (nloc == 0u) { xcd_barrier_complete(bar, b.x, nloc, nx); b.st[0] = nloc; b.st[1] = nx; }
        const unsigned old = xb_add(&bar[XB_XSUB(b.x)], 1u);
        const unsigned gen = old / nloc;
        if (old + 1u == (gen + 1u) * nloc) {
            __builtin_amdgcn_fence(__ATOMIC_RELEASE, "agent");
            asm volatile("s_waitcnt vmcnt(0)" ::: "memory");
            const unsigned og = xb_add(&bar[XB_TOP], 1u);
            const unsigned tg = og / nx;
            if (og + 1u == (tg + 1u) * nx) xb_add(&bar[XB_TOPGEN], 1u);
            else XB_SPIN(xb_ld(&bar[XB_TOPGEN]) == tg, bar);
            __builtin_amdgcn_fence(__ATOMIC_ACQUIRE, "agent");
            xb_add(&bar[XB_XGEN(b.x)], 1u);
            asm volatile("s_waitcnt vmcnt(0)" ::: "memory");
        } else {
            XB_SPIN(xb_ld(&bar[XB_XGEN(b.x)]) == gen, bar);
            __builtin_amdgcn_fence(__ATOMIC_ACQUIRE, "agent");
            asm volatile("s_waitcnt vmcnt(0)" ::: "memory");
        }
    }
    __syncthreads();
}

typedef short s4v __attribute__((ext_vector_type(4)));
__device__ __forceinline__ bf16x8 ldg8(const bf16* p) { return *(const bf16x8*)p; }
__device__ __forceinline__ f32x4 mfma16(bf16x8 a, bf16x8 b, f32x4 c) { return __builtin_amdgcn_mfma_f32_16x16x32_bf16(a, b, c, 0, 0, 0); }
__device__ __forceinline__ bf16x8 ldA(const LAS unsigned char* base, int pitch, int row0, int k0, int li, int g) { return *(const LAS bf16x8*)(base + ((row0 + li) * pitch + k0 + 8 * g) * 2); }
__device__ __forceinline__ bf16x8 ldT(const LAS unsigned char* base, int pitch, int k0, int n0, int li, int g) {
    const LAS unsigned char* p = base + ((k0 + 8 * g + (li >> 2)) * pitch + n0 + 4 * (li & 3)) * 2;
    const s4v a = __builtin_amdgcn_ds_read_tr16_b64_v4i16((LAS s4v*)p), b = __builtin_amdgcn_ds_read_tr16_b64_v4i16((LAS s4v*)(p + 8 * pitch));
    return (bf16x8){a[0], a[1], a[2], a[3], b[0], b[1], b[2], b[3]};
}
__device__ __forceinline__ bf16x8 ldAperm(const LAS unsigned char* base, int pitch, int row0, int ks, int li, int g) {
    const LAS unsigned char* p = base + ((row0 + li) * pitch + 32 * ks + 4 * g) * 2;
    const s4v a = *(const LAS s4v*)p, b = *(const LAS s4v*)(p + 32);
    return (bf16x8){a[0], a[1], a[2], a[3], b[0], b[1], b[2], b[3]};
}
__device__ __forceinline__ void stT(LAS unsigned char* base, int pitch, int n, int m0, const f32x4 v) {
    u32x2 w; w.x = pk2(v[0], v[1]); w.y = pk2(v[2], v[3]); *(LAS u32x2*)(base + (n * pitch + m0) * 2) = w;
}
__device__ __forceinline__ f32x4 ld4bf(const LAS unsigned char* p) { const u32x2 w = *(const LAS u32x2*)p; return (f32x4){bflo(w.x), bfhi(w.x), bflo(w.y), bfhi(w.y)}; }

struct Args {
    const float* in[31];
    float* out; unsigned char* ws;
    int ph_lo, ph_hi, use_bar, pad;
};
enum InIdx { I_X = 0, I_C, I_CTX, I_CCTX, I_ADAW, I_ADAB, I_N1G, I_N2G, I_WIN, I_WOUT, I_ASINK, I_BMIX, I_CREL, I_DCONV, I_DW0, I_DW2, I_DA0, I_DA2, I_DG2, I_DKK, I_DKA, I_DRK, I_DLNW, I_DLNB,
             I_RW, I_RB, I_WGU, I_BGU, I_WDN, I_BDN, I_FNG };
constexpr int NPL = 11;
constexpr int PH_TOTAL = 1 + DEPTH * NPL + 1;

struct DevIn {
    const LAS unsigned* tab;
    __device__ __forceinline__ const float* operator[](int i) const {
        const unsigned lo = __builtin_amdgcn_readfirstlane(((const volatile LAS unsigned*)tab)[2 * i]), hi = __builtin_amdgcn_readfirstlane(((const volatile LAS unsigned*)tab)[2 * i + 1]);
        return (const float*)(((unsigned long long)hi << 32) | lo);
    }
};
struct DArgs { DevIn in; float* out; };
struct Ctx {
    LAS unsigned char* lds;
    int tid, lane, wave, wg, G, gw, NGW;
    unsigned char* ws;
};

template <int NW>
__device__ __forceinline__ void transpose_item(const float* W, int K, int N, bf16* WT, int item, int lane) {
    constexpr int NQ = NW / 4, NC = 64 / NQ, PASSES = 8 / NC;
    const int nblk = N / NW, kb = item / nblk, nb = item % nblk, k0 = 64 * kb, n0 = NW * nb, nq = lane % NQ, cq = lane / NQ;
    f32x4 v[PASSES][8];
#pragma unroll
    for (int ps = 0; ps < PASSES; ++ps)
#pragma unroll
        for (int i = 0; i < 8; ++i) v[ps][i] = *(const f32x4*)(W + (size_t)(k0 + 8 * (cq + NC * ps) + i) * N + n0 + 4 * nq);
#pragma unroll
    for (int ps = 0; ps < PASSES; ++ps)
#pragma unroll
        for (int j = 0; j < 4; ++j) { u32x4 o; o.x = pk2(v[ps][0][j], v[ps][1][j]); o.y = pk2(v[ps][2][j], v[ps][3][j]); o.z = pk2(v[ps][4][j], v[ps][5][j]); o.w = pk2(v[ps][6][j], v[ps][7][j]);
            *(u32x4*)(WT + (size_t)(n0 + 4 * nq + j) * K + k0 + 8 * (cq + NC * ps)) = o; }
}
template <int NW>
__device__ __forceinline__ void transpose_item8(const float* W, int K, int N, unsigned char* WT, int item, int lane) {
    constexpr int NQ = NW / 4, NC = 64 / NQ, PASSES = 8 / NC;
    const int nblk = N / NW, kb = item / nblk, nb = item % nblk, k0 = 64 * kb, n0 = NW * nb, nq = lane % NQ, cq = lane / NQ;
    f32x4 v[PASSES][8];
#pragma unroll
    for (int ps = 0; ps < PASSES; ++ps)
#pragma unroll
        for (int i = 0; i < 8; ++i) v[ps][i] = __builtin_nontemporal_load((const f32x4*)(W + (size_t)(k0 + 8 * (cq + NC * ps) + i) * N + n0 + 4 * nq)) * pg8::W8_S;
#pragma unroll
    for (int ps = 0; ps < PASSES; ++ps)
#pragma unroll
        for (int j = 0; j < 4; ++j) { unsigned w0 = 0, w1 = 0;
            w0 = __builtin_amdgcn_cvt_pk_fp8_f32(v[ps][0][j], v[ps][1][j], w0, false); w0 = __builtin_amdgcn_cvt_pk_fp8_f32(v[ps][2][j], v[ps][3][j], w0, true);
            w1 = __builtin_amdgcn_cvt_pk_fp8_f32(v[ps][4][j], v[ps][5][j], w1, false); w1 = __builtin_amdgcn_cvt_pk_fp8_f32(v[ps][6][j], v[ps][7][j], w1, true);
            __builtin_nontemporal_store((u32x2){w0, w1}, (u32x2*)(WT + (size_t)(n0 + 4 * nq + j) * K + k0 + 8 * (cq + NC * ps))); }
}
constexpr int CV_IT_GU = 16 * 64, CV_IT_DN = 16 * 32, CV_N_GU = 32 * CV_IT_GU, CV_N_DN = 32 * CV_IT_DN, CV_ITEMS = CV_N_GU + CV_N_DN, CV_CHUNK = 16, CV_NCHUNK = CV_ITEMS / CV_CHUNK;
__device__ __forceinline__ void convert_moe_items(const Ctx& C, const DArgs& a, int l, int it0, int it1) {
    const float* pwgu = a.in[I_WGU] + (size_t)l * 32 * DM * 2048; const float* pwdn = a.in[I_WDN] + (size_t)l * 32 * DM * DM;
    unsigned char* ogu = C.ws + WS_WGU + (size_t)l * 32 * 2048 * DM; unsigned char* odn = C.ws + WS_WDN + (size_t)l * 32 * DM * DM;
#pragma unroll 1
    for (int it = it0; it < it1; ++it) {
        if (it < CV_N_GU) { const int e = it / CV_IT_GU; transpose_item8<32>(pwgu + (size_t)e * DM * 2048, DM, 2048, ogu + (size_t)e * 2048 * DM, it % CV_IT_GU, C.lane); }
        else { const int r = it - CV_N_GU, e = r / CV_IT_DN; transpose_item8<32>(pwdn + (size_t)e * DM * DM, DM, DM, odn + (size_t)e * DM * DM, r % CV_IT_DN, C.lane); }
    }
}
__device__ __forceinline__ void phase_prologue(const Ctx& C, const DArgs& a) {
    constexpr int IT_IN = 16 * (INW / 32), IT_OUT = 16 * 16;
    constexpr int N_IN = 4 * IT_IN, N_OUT = 4 * IT_OUT;
    const float* pwin = a.in[I_WIN]; const float* pwout = a.in[I_WOUT];
    for (int it = C.gw; it < N_IN + N_OUT; it += C.NGW) {
        if (it < N_IN) { const int l = it / IT_IN; transpose_item<32>(pwin + (size_t)l * DM * INW, DM, INW, (bf16*)(C.ws + WS_WIN) + (size_t)l * INWP * DM, it % IT_IN, C.lane); }
        else { const int r = it - N_IN, l = r / IT_OUT; transpose_item<64>(pwout + (size_t)l * DM * DM, DM, DM, (bf16*)(C.ws + WS_WOUT) + (size_t)l * DM * DM, r % IT_OUT, C.lane); }
    }
    for (int ch = C.gw; ch < CV_NCHUNK; ch += C.NGW) convert_moe_items(C, a, 0, ch * CV_CHUNK, ch * CV_CHUNK + CV_CHUNK);
    { const int gt = C.wg * NTHR + C.tid; constexpr int PADN = (INWP - INW) * DM / 8;
      for (int i = gt; i < 4 * PADN; i += C.G * NTHR) { const int l = i / PADN, r = i % PADN; *((u32x4*)((bf16*)(C.ws + WS_WIN) + ((size_t)l * INWP + INW) * DM) + r) = (u32x4){0u, 0u, 0u, 0u}; } }
    { float* tw = (float*)(C.ws + WS_TW); const int gt = C.wg * NTHR + C.tid;
      for (int i = gt; i < 16384; i += C.G * NTHR) { const float x = (float)i * (1.0f / 8192.0f); tw[i] = cospif(x); tw[16384 + i] = sinpif(x); } }
    { float* mt = (float*)(C.ws + WS_MTAB); const int gt = C.wg * NTHR + C.tid; const float* pbmix = a.in[I_BMIX];
      for (int i = gt; i < 4 * 4 * 64 * 64; i += C.G * NTHR) { const int e = i & 63, c = (i >> 6) & 63, g = (i >> 12) & 3, l = i >> 14;
          const float* w = pbmix + ((size_t)(l * 4 + g) * 64) * 64 + e; float sc = 0.f, ss = 0.f;
          for (int cp = 0; cp < 64; ++cp) { const float x = (float)((c * cp) & 63) * (1.0f / 32.0f); const float wv = w[cp * 64]; sc += cospif(x) * wv; ss += sinpif(x) * wv; }
          mt[((size_t)(l * 2 + 0) * 4 + g) * 4096 + c * 64 + e] = sc; mt[((size_t)(l * 2 + 1) * 4 + g) * 4096 + c * 64 + e] = ss; } }
    { bf16* ft = (bf16*)(C.ws + WS_FTAB); const int gt = C.wg * NTHR + C.tid; const float* pbmix = a.in[I_BMIX];
      for (int i = gt; i < 128 * 128; i += C.G * NTHR) { const int k = i >> 7, t = i & 127; const float x = (float)((k * t) & 127) * (1.0f / 64.0f); ft[i] = (bf16)f2bf(cospif(x)); ft[16384 + i] = (bf16)f2bf(sinpif(x)); }
      bf16* mf = ft + 32768;
      for (int i = gt; i < 4 * 4 * 16 * 64 * 8; i += C.G * NTHR) { const int j8 = i & 7, ln = (i >> 3) & 63, fr = (i >> 9) & 15, gq = (i >> 13) & 3, l = i >> 15;
          const int ei = fr >> 2, ks2 = fr & 3, e = 16 * ei + (ln & 15), g = ln >> 4, c = 32 * (ks2 & 1) + 16 * (j8 >> 2) + 4 * g + (j8 & 3), part = ks2 >> 1;
          const float* w = pbmix + ((size_t)(l * 4 + gq) * 64) * 64 + e; float s = 0.f;
          for (int cp = 0; cp < 64; ++cp) { const float x = (float)((c * cp) & 63) * (1.0f / 32.0f); s += (part ? sinpif(x) : cospif(x)) * w[cp * 64]; }
          mf[i] = (bf16)f2bf(s * (1.0f / 1024.0f)); } }
    { const int gt = C.wg * NTHR + C.tid; const float* pg2 = a.in[I_DG2]; const float* prw = a.in[I_RW]; bf16* g2t = (bf16*)(C.ws + WS_G2T); bf16* rwt = (bf16*)(C.ws + WS_RWT);
      for (int i = gt; i < 4 * 256 * 160; i += C.G * NTHR) { const int ii = i % 160, c = (i / 160) & 255, l = i / (160 * 256); g2t[i] = (bf16)f2bf(pg2[((size_t)l * 160 + ii) * 256 + c]); }
      for (int i = gt; i < 4 * 32 * 1024; i += C.G * NTHR) { const int k = i & 1023, e = (i >> 10) & 31, l = i >> 15; rwt[i] = (bf16)f2bf(prw[((size_t)l * 1024 + k) * 32 + e]); } }
    { const int gt = C.wg * NTHR + C.tid; const float* pw2 = a.in[I_DW2]; const float* pa2 = a.in[I_DA2]; bf16* lt = (bf16*)(C.ws + WS_LORAT);
      for (int i = gt; i < 4 * 4 * 256 * 64; i += C.G * NTHR) { const int ii = i & 63, c = (i >> 6) & 255, q = (i >> 14) & 3, l = i >> 16;
          const float* src = (q < 2) ? pw2 : pa2; lt[i] = (bf16)f2bf(src[(((size_t)l * 2 + (q & 1)) * 64 + ii) * 256 + c]); } }
    { bf16* f2 = (bf16*)(C.ws + WS_F256); const int gt = C.wg * NTHR + C.tid;
      for (int i = gt; i < 256 * 256; i += C.G * NTHR) { const int k = i >> 8, t = i & 255; const float x = (float)((k * t) & 255) * (1.0f / 128.0f); f2[i] = (bf16)f2bf(cospif(x)); f2[65536 + i] = (bf16)f2bf(sinpif(x)); } }
    { LAS float* sl = (LAS float*)(C.lds);
      LAS float* red = (LAS float*)(C.lds + 8192);
      __syncthreads();
      const float* pc = a.in[I_C]; const float* pcc = a.in[I_CCTX]; const float* padaw = a.in[I_ADAW]; const float* padab = a.in[I_ADAB];
      for (int i = C.tid; i < 2048; i += NTHR) { const float x = (i < 1024) ? pc[i] : pcc[i - 1024]; sl[i] = x * sigmoidf_(x); }
      __syncthreads();
      float* mod = (float*)(C.ws + WS_MOD);
      for (int u = C.wg; u < 4 * 96; u += C.G) { const int l = u / 96, jb = u % 96, j0 = jb * 64 + C.lane;
          float s0 = 0.f, s1 = 0.f; const float* w = padaw + (size_t)l * DM * 6144 + j0; const int k0 = C.wave * 128;
#pragma unroll 16
          for (int k = 0; k < 128; ++k) { const float wv = w[(size_t)(k0 + k) * 6144]; s0 += wv * sl[k0 + k]; s1 += wv * sl[1024 + k0 + k]; }
          red[(C.wave * 2 + 0) * 64 + C.lane] = s0; red[(C.wave * 2 + 1) * 64 + C.lane] = s1;
          __syncthreads();
          if (C.tid < 128) { const int v = C.tid >> 6, j = C.tid & 63; float s = 0.f;
#pragma unroll
              for (int wv = 0; wv < 8; ++wv) s += red[(wv * 2 + v) * 64 + j];
              mod[(size_t)(l * 2 + v) * 6144 + jb * 64 + j] = s + padab[(size_t)l * 6144 + jb * 64 + j]; }
          __syncthreads(); } }
}

__device__ __forceinline__ void load_row(const float* p, int lane, f32x4 (&v)[4]) {
#pragma unroll
    for (int j = 0; j < 4; ++j) v[j] = *((const f32x4*)p + lane + 64 * j);
}
__device__ __forceinline__ void moe_combine_row(const Ctx& C, int row, f32x4 (&v)[4], const f32x4 (&gt2q)[4]) {
    const int* dest = (const int*)(C.ws + WS_ROUTE) + (size_t)3 * ROWS * 4; const float* gate = (const float*)(C.ws + WS_ROUTE) + (size_t)1 * ROWS * 4;
    const bf16* YB = (const bf16*)(C.ws + WS_XG);
    f32x4 s[4];
#pragma unroll
    for (int j = 0; j < 4; ++j) s[j] = (f32x4){0.f, 0.f, 0.f, 0.f};
#pragma unroll
    for (int k = 0; k < 4; ++k) { const int d = dest[row * 4 + k]; const float g = gate[row * 4 + k]; const u32x2* yp = (const u32x2*)(YB + (size_t)d * DM) + C.lane;
#pragma unroll
        for (int j = 0; j < 4; ++j) { const u32x2 w = yp[64 * j]; s[j] += (f32x4){bflo(w.x), bfhi(w.x), bflo(w.y), bfhi(w.y)} * g; } }
#pragma unroll
    for (int j = 0; j < 4; ++j) v[j] += gt2q[j] * s[j];
}
__device__ __forceinline__ float row_rstd(const f32x4 (&v)[4], int lane) {
    float s = 0.f;
#pragma unroll
    for (int j = 0; j < 4; ++j) s += (v[j].x * v[j].x + v[j].y * v[j].y) + (v[j].z * v[j].z + v[j].w * v[j].w);
    return rsqrtf(wave_sum(s, lane) * (1.f / DM) + 1e-6f);
}
__device__ __forceinline__ void norm1_fetch(const Ctx& C, const float* src_row, int row, bool combine, const f32x4 (&gt2q)[4], f32x4 (&v)[4]) {
    load_row(src_row, C.lane, v);
    if (combine) moe_combine_row(C, row, v, gt2q);
}
__device__ __forceinline__ void phase_norm1(const Ctx& C, const DArgs& a, int l) {
    float* XS = (float*)(C.ws + WS_XS); bf16* H = (bf16*)(C.ws + WS_H); const float* mod = (const float*)(C.ws + WS_MOD);
    const float* g1 = a.in[I_N1G] + (size_t)l * DM;
    const float* pctx = a.in[I_CTX]; const float* px = a.in[I_X];
    f32x4 gq[4], shq[4], scq[4], gt2q[4];
#pragma unroll
    for (int j = 0; j < 4; ++j) gt2q[j] = *((const f32x4*)(mod + (size_t)((l > 0 ? l - 1 : 0) * 2) * 6144 + 5 * DM) + C.lane + 64 * j);
#pragma unroll
    for (int j = 0; j < 4; ++j) { gq[j] = *((const f32x4*)g1 + C.lane + 64 * j); shq[j] = *((const f32x4*)(mod + (size_t)(l * 2) * 6144) + C.lane + 64 * j); scq[j] = *((const f32x4*)(mod + (size_t)(l * 2) * 6144 + DM) + C.lane + 64 * j) + 1.0f; }
    for (int row0 = C.gw; row0 < ROWS; row0 += 2 * C.NGW) {
        f32x4 v[2][4]; const int rows[2] = {row0, row0 + C.NGW};
#pragma unroll
        for (int q = 0; q < 2; ++q) if (rows[q] < ROWS) { const int row = rows[q]; const bool isctx = row < NCTX;
            const float* src = (l == 0) ? (isctx ? pctx + (size_t)row * DM : px + (size_t)(row - NCTX) * DM) : XS + (size_t)row * DM;
            if (isctx && l > 0) { f32x4 gc4[4];
#pragma unroll
                for (int j = 0; j < 4; ++j) gc4[j] = *((const f32x4*)(mod + (size_t)((l - 1) * 2 + 1) * 6144 + 5 * DM) + C.lane + 64 * j);
                norm1_fetch(C, src, row, true, gc4, v[q]); }
            else norm1_fetch(C, src, row, l > 0, gt2q, v[q]); }
#pragma unroll
        for (int q = 0; q < 2; ++q) if (rows[q] < ROWS) { const int row = rows[q]; const bool isctx = row < NCTX;
#pragma unroll
            for (int j = 0; j < 4; ++j) *((f32x4*)(XS + (size_t)row * DM) + C.lane + 64 * j) = v[q][j];
            const float rstd = row_rstd(v[q], C.lane);
            const float* md = mod + (size_t)(l * 2 + (isctx ? 1 : 0)) * 6144;
            u32x2* o = (u32x2*)(H + (size_t)row * DM) + C.lane;
#pragma unroll
            for (int j = 0; j < 4; ++j) { f32x4 sh = shq[j], sc1 = scq[j]; if (isctx) { sh = *((const f32x4*)md + C.lane + 64 * j); sc1 = *((const f32x4*)(md + DM) + C.lane + 64 * j) + 1.0f; }
                const f32x4 y = v[q][j] * rstd * gq[j] * sc1 + sh; u32x2 w; w.x = pk2(y.x, y.y); w.y = pk2(y.z, y.w); o[64 * j] = w; } }
    }
}
__device__ __forceinline__ void phase_final(const Ctx& C, const DArgs& a) {
    const float* XS = (const float*)(C.ws + WS_XS); const float* mod = (const float*)(C.ws + WS_MOD); const float* g = a.in[I_FNG];
    const float* gt2 = mod + (size_t)((DEPTH - 1) * 2 + 0) * 6144 + 5 * DM;
    f32x4 gq[4], gt2q[4];
#pragma unroll
    for (int j = 0; j < 4; ++j) { gq[j] = *((const f32x4*)g + C.lane + 64 * j); gt2q[j] = *((const f32x4*)gt2 + C.lane + 64 * j); }
    for (int row0 = NCTX + C.gw; row0 < ROWS; row0 += 2 * C.NGW) {
        f32x4 v[2][4]; const int rows[2] = {row0, row0 + C.NGW};
#pragma unroll
        for (int q = 0; q < 2; ++q) if (rows[q] < ROWS) norm1_fetch(C, XS + (size_t)rows[q] * DM, rows[q], true, gt2q, v[q]);
#pragma unroll
        for (int q = 0; q < 2; ++q) if (rows[q] < ROWS) { const float rstd = row_rstd(v[q], C.lane); float* o = a.out + (size_t)(rows[q] - NCTX) * DM;
#pragma unroll
            for (int j = 0; j < 4; ++j) *((f32x4*)o + C.lane + 64 * j) = v[q][j] * rstd * gq[j]; }
    }
}
constexpr int NR2 = 9;
__device__ __forceinline__ void phase_norm2(const Ctx& C, const DArgs& a, int l) {
    const float* XS = (const float*)(C.ws + WS_XS); bf16* H = (bf16*)(C.ws + WS_H); const float* mod = (const float*)(C.ws + WS_MOD);
    const float* g2 = a.in[I_N2G] + (size_t)l * DM; const float* rb = a.in[I_RB] + (size_t)l * NEXP; const bf16* rwt = (const bf16*)(C.ws + WS_RWT) + (size_t)l * NEXP * DM;
    int* tok_e = (int*)(C.ws + WS_ROUTE); float* gate = (float*)(C.ws + WS_ROUTE) + (size_t)1 * ROWS * 4; int* slot = (int*)(C.ws + WS_ROUTE) + (size_t)2 * ROWS * 4;
    LAS float* lg = (LAS float*)(C.lds + C.wave * 4096);
    LAS int* hist = (LAS int*)(C.lds + MISC_OFF + 64);
    const int lane = C.lane, li = lane & 15, g = lane >> 4;
    if (C.tid < NEXP) hist[C.tid] = 0;
    __syncthreads();
    const int row_base = (l == DEPTH - 1) ? NCTX : 0, ntile = (ROWS - row_base + NR2 - 1) / NR2;
    f32x4 gq[4], shq[4], scq[4];
#pragma unroll
    for (int j = 0; j < 4; ++j) { gq[j] = *((const f32x4*)g2 + lane + 64 * j); shq[j] = *((const f32x4*)(mod + (size_t)(l * 2) * 6144 + 3 * DM) + lane + 64 * j); scq[j] = *((const f32x4*)(mod + (size_t)(l * 2) * 6144 + 4 * DM) + lane + 64 * j) + 1.0f; }
    for (int tl = C.gw; tl < ntile; tl += C.NGW) {
        const int trow0 = row_base + NR2 * tl, nrow = (ROWS - trow0 < NR2) ? ROWS - trow0 : NR2;
#pragma unroll 1
        for (int rr = 0; rr < nrow; ++rr) { const int row = trow0 + rr; const bool isctx = row < NCTX; f32x4 v[4]; load_row(XS + (size_t)row * DM, lane, v);
            const float rstd = row_rstd(v, lane);
            const float* md = mod + (size_t)(l * 2 + (isctx ? 1 : 0)) * 6144 + 3 * DM;
            u32x2* o = (u32x2*)(H + (size_t)row * DM) + lane;
#pragma unroll
            for (int j = 0; j < 4; ++j) { f32x4 sh = shq[j], sc1 = scq[j]; if (isctx) { sh = *((const f32x4*)md + lane + 64 * j); sc1 = *((const f32x4*)(md + DM) + lane + 64 * j) + 1.0f; }
                const f32x4 y = v[j] * rstd * gq[j] * sc1 + sh; u32x2 w; w.x = pk2(y.x, y.y); w.y = pk2(y.z, y.w); o[64 * j] = w; } }
        asm volatile("s_waitcnt vmcnt(0)" ::: "memory");
        f32x4 acc0 = {0.f, 0.f, 0.f, 0.f}, acc1 = {0.f, 0.f, 0.f, 0.f};
        const int arow = (trow0 + li < ROWS) ? trow0 + li : ROWS - 1;
        const bf16* ap = H + (size_t)arow * DM + 8 * g; const bf16* bp0 = rwt + (size_t)li * DM + 8 * g; const bf16* bp1 = bp0 + 16 * DM;
#pragma unroll 4
        for (int ks = 0; ks < 32; ++ks) { const bf16x8 af = *(const bf16x8*)(ap + 32 * ks); acc0 = mfma16(af, *(const bf16x8*)(bp0 + 32 * ks), acc0); acc1 = mfma16(af, *(const bf16x8*)(bp1 + 32 * ks), acc1); }
#pragma unroll
        for (int r = 0; r < 4; ++r) { lg[(4 * g + r) * 33 + li] = acc0[r]; lg[(4 * g + r) * 33 + 16 + li] = acc1[r]; }
        LDS_WAIT(); asm volatile("" ::: "memory");
        const int e = lane & 31; const float rbe = rb[e];
#pragma unroll 1
        for (int rr = 0; rr < nrow; ++rr) { const int row = trow0 + rr;
            float val = lg[rr * 33 + e] + rbe; int te[4]; float tv[4];
#pragma unroll
            for (int k = 0; k < 4; ++k) { float bv = val; int bi = e;
#define AMAX_ROR(n) { const float ov = __builtin_bit_cast(float, __builtin_amdgcn_update_dpp(0, __builtin_bit_cast(int, bv), 0x120 + (n), 0xf, 0xf, false)); const int oi = __builtin_amdgcn_update_dpp(0, bi, 0x120 + (n), 0xf, 0xf, false); \
                    if (ov > bv || (ov == bv && oi < bi)) { bv = ov; bi = oi; } }
                AMAX_ROR(8) AMAX_ROR(4) AMAX_ROR(2) AMAX_ROR(1)
#undef AMAX_ROR
                { const float ov = shx(bv, 16, lane); const int oi = shxi(bi, 16, lane); if (ov > bv || (ov == bv && oi < bi)) { bv = ov; bi = oi; } }
                te[k] = bi; tv[k] = bv; if (e == bi) val = -3.0e38f; }
            if (lane == 0) { const float m = tv[0]; float p[4], ps = 0.f;
#pragma unroll
                for (int k = 0; k < 4; ++k) { p[k] = __expf(tv[k] - m); ps += p[k]; }
#pragma unroll
                for (int k = 0; k < 4; ++k) { tok_e[row * 4 + k] = te[k]; gate[row * 4 + k] = p[k] / ps; slot[row * 4 + k] = __hip_atomic_fetch_add(&hist[te[k]], 1, __ATOMIC_RELAXED, __HIP_MEMORY_SCOPE_WORKGROUP); } } }
        asm volatile("" ::: "memory");
    }
    __syncthreads();
    if (C.tid < NEXP) ((int*)(C.ws + WS_CNT))[C.wg * NEXP + C.tid] = hist[C.tid];
}
__device__ __forceinline__ int moe_tables(const Ctx& C) {
    const int* cnt = (const int*)(C.ws + WS_CNT);
    LAS int* part = (LAS int*)(C.lds);
    LAS int* pstart = (LAS int*)(C.lds + MISC_OFF + 256); LAS int* wgbase = pstart + 40; LAS int* tot = wgbase + 32; LAS int* nblk_s = tot + 32;
    LAS unsigned char* blk_e = (LAS unsigned char*)(C.lds + MISC_OFF + 1024);
    __syncthreads();
    { const int e = C.tid & 31, p = C.tid >> 5; int t = 0, pre = 0;
#pragma unroll 1
      for (int w = p * 16; w < p * 16 + 16; ++w) { const int c = cnt[w * NEXP + e]; t += c; if (w < C.wg) pre += c; }
      part[(p * 32 + e) * 2] = t; part[(p * 32 + e) * 2 + 1] = pre; }
    __syncthreads();
    if (C.tid < NEXP) { int t = 0, pre = 0;
#pragma unroll 1
        for (int p = 0; p < 16; ++p) { t += part[(p * 32 + C.tid) * 2]; pre += part[(p * 32 + C.tid) * 2 + 1]; }
        tot[C.tid] = t; wgbase[C.tid] = pre; }
    __syncthreads();
    if (C.tid == 0) { int b = 0;
#pragma unroll 1
        for (int e = 0; e < NEXP; ++e) { pstart[e] = b * 256; b += (tot[e] + 255) >> 8; }
        pstart[NEXP] = b * 256; nblk_s[0] = b; }
    __syncthreads();
    if (C.tid < NEXP) wgbase[C.tid] += pstart[C.tid];
    if (C.tid < MOE_MAXBLK) { int e = 0;
#pragma unroll 1
        for (int k = 1; k < NEXP; ++k) if (pstart[k] <= C.tid * 256) e = k;
        blk_e[C.tid] = (unsigned char)e; }
    __syncthreads();
    return __builtin_amdgcn_readfirstlane(nblk_s[0]);
}
__device__ __forceinline__ void phase_gather(const Ctx& C, const DArgs& a, int l) {
    moe_tables(C);
    const LAS int* wgbase = (const LAS int*)(C.lds + MISC_OFF + 256) + 40;
    const int* tok_e = (const int*)(C.ws + WS_ROUTE); const int* slot = (const int*)(C.ws + WS_ROUTE) + (size_t)2 * ROWS * 4; int* dest = (int*)(C.ws + WS_ROUTE) + (size_t)3 * ROWS * 4;
    const bf16* H = (const bf16*)(C.ws + WS_H); unsigned char* XG = C.ws + WS_XG8;
    const int row_base = (l == DEPTH - 1) ? NCTX : 0, ntile = (ROWS - row_base + NR2 - 1) / NR2;
    for (int tl = C.gw; tl < ntile; tl += C.NGW)
    for (int row = row_base + NR2 * tl; row < row_base + NR2 * tl + NR2 && row < ROWS; ++row) {
        const u32x4* src = (const u32x4*)(H + (size_t)row * DM) + C.lane; const u32x4 v0 = src[0], v1 = src[64];
        u32x2 q0, q1;
        { unsigned w = 0; w = __builtin_amdgcn_cvt_pk_fp8_f32(bflo(v0.x) * pg8::X8_S, bfhi(v0.x) * pg8::X8_S, w, false); w = __builtin_amdgcn_cvt_pk_fp8_f32(bflo(v0.y) * pg8::X8_S, bfhi(v0.y) * pg8::X8_S, w, true); q0.x = w;
          w = 0; w = __builtin_amdgcn_cvt_pk_fp8_f32(bflo(v0.z) * pg8::X8_S, bfhi(v0.z) * pg8::X8_S, w, false); w = __builtin_amdgcn_cvt_pk_fp8_f32(bflo(v0.w) * pg8::X8_S, bfhi(v0.w) * pg8::X8_S, w, true); q0.y = w;
          w = 0; w = __builtin_amdgcn_cvt_pk_fp8_f32(bflo(v1.x) * pg8::X8_S, bfhi(v1.x) * pg8::X8_S, w, false); w = __builtin_amdgcn_cvt_pk_fp8_f32(bflo(v1.y) * pg8::X8_S, bfhi(v1.y) * pg8::X8_S, w, true); q1.x = w;
          w = 0; w = __builtin_amdgcn_cvt_pk_fp8_f32(bflo(v1.z) * pg8::X8_S, bfhi(v1.z) * pg8::X8_S, w, false); w = __builtin_amdgcn_cvt_pk_fp8_f32(bflo(v1.w) * pg8::X8_S, bfhi(v1.w) * pg8::X8_S, w, true); q1.y = w; }
#pragma unroll
        for (int k = 0; k < 4; ++k) { const int d = wgbase[tok_e[row * 4 + k]] + slot[row * 4 + k]; if (C.lane == 0) dest[row * 4 + k] = d;
            u32x2* dp = (u32x2*)(XG + (size_t)d * DM) + C.lane; dp[0] = q0; dp[64] = q1; }
    }
}

__device__ __forceinline__ void mix1_rope(const Ctx& C) {
    bf16* P = (bf16*)(C.ws + WS_P);
    const long total = (long)SEQ * 192;
    for (long i = (long)C.wg * NTHR + C.tid; i < total; i += (long)C.G * NTHR) {
        const int j = (int)(i & 31), hh = (int)((i >> 5) % 6), t = (int)(i / 192);
        const int col = (hh < 4) ? (C_AQ + hh * 64) : (C_AK + (hh - 4) * 64);
        const float pos = (j < 16) ? (float)(t >> 6) : (float)(t & 63);
        const float inv = __powf(10000.0f, -(float)(j & 15) * (1.0f / 16.0f));
        const float ang = pos * inv * 0.31830988618379067f;
        const float cs = cospif(ang), sn = sinpif(ang);
        bf16* p = P + (size_t)(NCTX + t) * INWP + col;
        const float x1 = bf2f(p[j]), x2 = bf2f(p[j + 32]);
        p[j] = (bf16)f2bf(x1 * cs - x2 * sn); p[j + 32] = (bf16)f2bf(x2 * cs + x1 * sn);
    }
}
__device__ __forceinline__ void mix1_vt(const Ctx& C) {
    const bf16* P = (const bf16*)(C.ws + WS_P);
    LAS unsigned short* scr = (LAS unsigned short*)(C.lds + C.wave * 16384);
    for (int u = C.gw; u < (ROWS / 64) * 6; u += C.NGW) {
        const int hd = u % 6, tb = u / 6; const int vcol = (hd < 2) ? (C_AV + hd * 64) : (C_CV + (hd - 2) * 64);
        bf16* VT = ((hd < 2) ? (bf16*)(C.ws + WS_VTA) + (size_t)hd * 64 * VTP : (bf16*)(C.ws + WS_VTC) + (size_t)(hd - 2) * 64 * VTP);
#pragma unroll
        for (int i = 0; i < 8; ++i) { const int tk = (C.lane >> 3) + 8 * i, ch = C.lane & 7; const u32x4 w = *(const u32x4*)(P + (size_t)(tb * 64 + tk) * INWP + vcol + 8 * ch);
            LAS unsigned* d = (LAS unsigned*)(scr + tk * 66 + 8 * ch); d[0] = w.x; d[1] = w.y; d[2] = w.z; d[3] = w.w; }
        LDS_WAIT(); asm volatile("" ::: "memory");
#pragma unroll
        for (int k8 = 0; k8 < 8; ++k8) { unsigned w[4];
#pragma unroll
            for (int e2 = 0; e2 < 4; ++e2) { const unsigned lo = scr[(8 * k8 + 2 * e2) * 66 + C.lane], hi = scr[(8 * k8 + 2 * e2 + 1) * 66 + C.lane]; w[e2] = lo | (hi << 16); }
            *(u32x4*)(VT + (size_t)C.lane * VTP + tb * 64 + 8 * k8) = (u32x4){w[0], w[1], w[2], w[3]}; }
        LDS_WAIT(); asm volatile("" ::: "memory");
    }
    for (int i = C.wg * NTHR + C.tid; i < 6 * 64 * 32; i += C.G * NTHR) { const int rowi = i >> 5, pc = i & 31; const int hd = rowi >> 6, d = rowi & 63;
        bf16* VT = ((hd < 2) ? (bf16*)(C.ws + WS_VTA) + (size_t)hd * 64 * VTP : (bf16*)(C.ws + WS_VTC) + (size_t)(hd - 2) * 64 * VTP);
        *(u32x4*)(VT + (size_t)d * VTP + ROWS + 8 * pc) = (u32x4){0u, 0u, 0u, 0u}; }
}
__device__ __forceinline__ float conv3(const bf16* P, int row, int col, const float* cw, int cc) {
    const bool first = (row == 0) || (row == NCTX), last = (row == NCTX - 1) || (row == ROWS - 1);
    float s = cw[768 + cc] * bf2f(P[(size_t)row * INWP + col]);
    if (!first) s += cw[cc] * bf2f(P[(size_t)(row - 1) * INWP + col]);
    if (!last) s += cw[2 * 768 + cc] * bf2f(P[(size_t)(row + 1) * INWP + col]);
    return s;
}
__device__ __forceinline__ void mix1_rwkv_prep(const Ctx& C, const DArgs& a, int l) {
    const bf16* P = (const bf16*)(C.ws + WS_P); float* SC = (float*)(C.ws + WS_SC);
    constexpr int LBP = 264;
    LAS unsigned char* lob = C.lds;
    LAS float* pre = (LAS float*)(C.lds + 16384);
    const bf16* lorat = (const bf16*)(C.ws + WS_LORAT) + (size_t)l * 4 * 256 * 64;
    const float* cw = a.in[I_DCONV] + (size_t)l * 3 * 768;
    const float* w0 = a.in[I_DW0] + (size_t)l * 512; const float* a0 = a.in[I_DA0] + (size_t)l * 512;
    const float* kkw = a.in[I_DKK] + (size_t)l * 256; const float* kaw = a.in[I_DKA] + (size_t)l * 256;
    const int half = C.tid >> 8, c = C.tid & 255, lane = C.lane, li = lane & 15, g = lane >> 4;
    const float kkc = kkw[c], kac = kaw[c];
    bf16x8 lrf[4][2][2];
#pragma unroll
    for (int q = 0; q < 4; ++q)
#pragma unroll
        for (int c2 = 0; c2 < 2; ++c2) { const bf16* bp = lorat + ((size_t)q * 256 + 16 * (2 * C.wave + c2) + li) * 64 + 8 * g; lrf[q][c2][0] = ldg8(bp); lrf[q][c2][1] = ldg8(bp + 32); }
    const float w0c[2] = {w0[c], w0[256 + c]}, a0c[2] = {a0[c], a0[256 + c]};
    const float cr0 = cw[c], cr1 = cw[768 + c], cr2 = cw[1536 + c], ck0 = cw[256 + c], ck1 = cw[768 + 256 + c], ck2 = cw[1536 + 256 + c], cv0 = cw[512 + c], cv1 = cw[768 + 512 + c], cv2 = cw[1536 + 512 + c];
    bf16 lin[7];
#define LIN_FETCH(gg) do { const int r0_ = 13 * (gg) + 7 * half; _Pragma("unroll") for (int j = 0; j < 7; ++j) if (j < 7 - half) lin[j] = P[(size_t)(r0_ + j) * INWP + C_WL + c]; } while (0)
    if (C.wg < ROWS / 13) LIN_FETCH(C.wg);
    for (int grp = C.wg; grp < ROWS / 13; grp += C.G) {
        const int row0 = 13 * grp + 7 * half, nj = 7 - half;
        __syncthreads();
#pragma unroll
        for (int j = 0; j < 7; ++j) if (j < nj) { const float x = bf2f(lin[j]); *(LAS bf16*)(lob + ((7 * half + j) * LBP + c) * 2) = (bf16)f2bf((c < 128) ? tanhf(x) : x); }
        __syncthreads();
        float xr[9], xk[9], xv[9];
#pragma unroll
        for (int q = 0; q < 9; ++q) { const int rw = row0 - 1 + q; const bool in = (rw >= 0) && (rw < ROWS) && (q <= nj + 1);
            const bf16* pp = P + (size_t)(in ? rw : row0) * INWP; xr[q] = in ? bf2f(pp[C_DR + c]) : 0.f; xk[q] = in ? bf2f(pp[C_DK + c]) : 0.f; xv[q] = in ? bf2f(pp[C_DV + c]) : 0.f; }
#pragma unroll
        for (int q = 0; q < 4; ++q) { const bf16x8 a0f = ldA(lob, LBP, 0, 64 * q, li, g), a1f = ldA(lob, LBP, 0, 64 * q + 32, li, g);
#pragma unroll
            for (int c2 = 0; c2 < 2; ++c2) { const int ci = 2 * C.wave + c2;
                f32x4 acc = {0.f, 0.f, 0.f, 0.f}; acc = mfma16(a0f, lrf[q][c2][0], acc); acc = mfma16(a1f, lrf[q][c2][1], acc);
#pragma unroll
                for (int r = 0; r < 4; ++r) pre[(q * 16 + 4 * g + r) * 256 + 16 * ci + li] = acc[r]; } }
        __syncthreads();
        if (grp + C.G < ROWS / 13) LIN_FETCH(grp + C.G);
#pragma unroll
        for (int j = 0; j < 7; ++j) if (j < nj) { const int row = row0 + j, rl = 7 * half + j;
            const bool first = (row == 0) || (row == NCTX), last = (row == NCTX - 1) || (row == ROWS - 1);
            const float m0 = first ? 0.f : 1.f, m2 = last ? 0.f : 1.f;
            const float r = cr1 * xr[j + 1] + m0 * cr0 * xr[j] + m2 * cr2 * xr[j + 2], k = ck1 * xk[j + 1] + m0 * ck0 * xk[j] + m2 * ck2 * xk[j + 2], v = cv1 * xv[j + 1] + m0 * cv0 * xv[j] + m2 * cv2 * xv[j + 2];
            float kk = k * kkc; const float n2 = wave_sum(kk * kk, lane); kk *= rsqrtf(fmaxf(n2, 1e-24f));
            float* sc = SC + (size_t)row * 9 * 256; sc[c] = r; sc[256 + c] = v; sc[512 + c] = -kk;
#pragma unroll
            for (int d = 0; d < 2; ++d) { const float wp = w0c[d] + pre[(d * 16 + rl) * 256 + c], ap = a0c[d] + pre[((2 + d) * 16 + rl) * 256 + c];
                const float nw = -wp, sp = fmaxf(nw, 0.f) + log1pf(__expf(-fabsf(nw)));
                const float lw = -__expf(-sp - 0.5f);
                const float as = sigmoidf_(ap);
                sc[(3 + 3 * d) * 256 + c] = lw; sc[(4 + 3 * d) * 256 + c] = k * (1.0f + (as - 1.0f) * kac); sc[(5 + 3 * d) * 256 + c] = kk * as; } }
    }
#undef LIN_FETCH
    __syncthreads();
}
constexpr int FP = 136;
constexpr int F_TABC = 0, F_TABS = 128 * FP * 2, F_TILE = 2 * 128 * FP * 2;
__device__ __forceinline__ void fourier_load_tables(const Ctx& C) {
    const bf16* ft = (const bf16*)(C.ws + WS_FTAB);
    for (int i = C.tid; i < 2 * 128 * 16; i += NTHR) { const int tb = i >> 11, r = (i >> 4) & 127, c8 = i & 15;
        *(LAS u32x4*)(C.lds + tb * F_TABS + (r * FP + 8 * c8) * 2) = *(const u32x4*)(ft + tb * 16384 + r * 128 + 8 * c8); }
}
__device__ __forceinline__ void mix1_fourier1(const Ctx& C) {
    const bf16* P = (const bf16*)(C.ws + WS_P); const float* tw = (const float*)(C.ws + WS_TW);
    bf16* FYR = (bf16*)(C.ws + WS_FYR); bf16* FYI = (bf16*)(C.ws + WS_FYI);
    const int lane = C.lane, li = lane & 15, g = lane >> 4, w = C.wave;
    __syncthreads();
    fourier_load_tables(C);
    for (int u = C.wg; u < 256; u += C.G) {
        const int t2 = u >> 1, ch0 = (u & 1) * 128;
        __syncthreads();
        for (int i = C.tid; i < 128 * 16; i += NTHR) { const int t1 = i >> 4, c8 = i & 15;
            *(LAS u32x4*)(C.lds + F_TILE + (t1 * FP + 8 * c8) * 2) = *(const u32x4*)(P + (size_t)(NCTX + 128 * t1 + t2) * INWP + C_BU + ch0 + 8 * c8); }
        __syncthreads();
        bf16x8 af[4];
#pragma unroll
        for (int ks = 0; ks < 4; ++ks) af[ks] = ldT(C.lds + F_TILE, FP, 32 * ks, 16 * w, li, g);
#pragma unroll 1
        for (int ni = 0; ni < 8; ++ni) { f32x4 dc = {0.f, 0.f, 0.f, 0.f}, ds = {0.f, 0.f, 0.f, 0.f};
#pragma unroll
            for (int ks = 0; ks < 4; ++ks) { dc = mfma16(af[ks], ldA(C.lds + F_TABC, FP, 16 * ni, 32 * ks, li, g), dc); ds = mfma16(af[ks], ldA(C.lds + F_TABS, FP, 16 * ni, 32 * ks, li, g), ds); }
            const int k1 = 16 * ni + li; const float cp = tw[t2 * k1], sp = tw[16384 + t2 * k1];
            const f32x4 yr = dc * cp - ds * sp, yi = -(ds * cp) - dc * sp;
            const size_t o = ((size_t)k1 * 128 + t2) * 256 + ch0 + 16 * w + 4 * g;
            u32x2 wr; wr.x = pk2(yr[0], yr[1]); wr.y = pk2(yr[2], yr[3]); *(u32x2*)(FYR + o) = wr;
            u32x2 wi; wi.x = pk2(yi[0], yi[1]); wi.y = pk2(yi[2], yi[3]); *(u32x2*)(FYI + o) = wi; }
    }
    __syncthreads();
}
__device__ __forceinline__ void fourier2_mfma(const Ctx& C, int l, int wg0) {
    const bf16* FYR = (const bf16*)(C.ws + WS_FYR); const bf16* FYI = (const bf16*)(C.ws + WS_FYI); bf16* MIX = (bf16*)(C.ws + WS_MIX);
    const int lane = C.lane, li = lane & 15, g = lane >> 4, w = C.wave;
    constexpr int YP = 72, F_YR = F_TILE, F_YI = F_TILE + 128 * YP * 2;
    __syncthreads();
    fourier_load_tables(C);
    bf16x8 mff[16];
    { const bf16x8* mf = (const bf16x8*)((const bf16*)(C.ws + WS_FTAB) + 32768) + (size_t)(l * 4 + ((C.wg - wg0) & 3)) * 16 * 64;
#pragma unroll
      for (int k = 0; k < 16; ++k) mff[k] = mf[k * 64 + lane]; }
    for (int u = C.wg - wg0; u < 512; u += C.G - wg0) {
        const int k1 = u >> 2, gq = u & 3;
        __syncthreads();
        for (int i = C.tid; i < 2 * 128 * 8; i += NTHR) { const int im = i >> 10, t2 = (i >> 3) & 127, c8 = i & 7;
            *(LAS u32x4*)(C.lds + (im ? F_YI : F_YR) + (t2 * YP + 8 * c8) * 2) = *(const u32x4*)((im ? FYI : FYR) + ((size_t)k1 * 128 + t2) * 256 + gq * 64 + 8 * c8); }
        __syncthreads();
        bf16x8 bc[4], bs[4];
#pragma unroll
        for (int ks = 0; ks < 4; ++ks) { bc[ks] = ldA(C.lds + F_TABC, FP, 16 * w, 32 * ks, li, g); bs[ks] = ldA(C.lds + F_TABS, FP, 16 * w, 32 * ks, li, g); }
        f32x4 xr[4], xi[4];
#pragma unroll
        for (int ci = 0; ci < 4; ++ci) { xr[ci] = (f32x4){0.f, 0.f, 0.f, 0.f}; f32x4 xs = {0.f, 0.f, 0.f, 0.f}; xi[ci] = xs;
#pragma unroll
            for (int ks = 0; ks < 4; ++ks) { const bf16x8 ar = ldT(C.lds + F_YR, YP, 32 * ks, 16 * ci, li, g), ai = ldT(C.lds + F_YI, YP, 32 * ks, 16 * ci, li, g);
                xr[ci] = mfma16(ar, bc[ks], xr[ci]); xr[ci] = mfma16(ai, bs[ks], xr[ci]);
                xi[ci] = mfma16(ai, bc[ks], xi[ci]); xs = mfma16(ar, bs[ks], xs); }
            xi[ci] = xi[ci] - xs; }
        union { bf16x8 v; unsigned q[4]; } xb[4];
#pragma unroll
        for (int q2 = 0; q2 < 2; ++q2) { xb[q2].q[0] = pk2(xr[2 * q2][0], xr[2 * q2][1]); xb[q2].q[1] = pk2(xr[2 * q2][2], xr[2 * q2][3]); xb[q2].q[2] = pk2(xr[2 * q2 + 1][0], xr[2 * q2 + 1][1]); xb[q2].q[3] = pk2(xr[2 * q2 + 1][2], xr[2 * q2 + 1][3]);
            xb[2 + q2].q[0] = pk2(xi[2 * q2][0], xi[2 * q2][1]); xb[2 + q2].q[1] = pk2(xi[2 * q2][2], xi[2 * q2][3]); xb[2 + q2].q[2] = pk2(xi[2 * q2 + 1][0], xi[2 * q2 + 1][1]); xb[2 + q2].q[3] = pk2(xi[2 * q2 + 1][2], xi[2 * q2 + 1][3]); }
#pragma unroll
        for (int ei = 0; ei < 4; ++ei) { f32x4 o = {0.f, 0.f, 0.f, 0.f};
#pragma unroll
            for (int ks2 = 0; ks2 < 4; ++ks2) o = mfma16(mff[ei * 4 + ks2], xb[ks2].v, o);
            const int tp = k1 + 128 * (16 * w + li);
            u32x2 wo; wo.x = pk2(o[0], o[1]); wo.y = pk2(o[2], o[3]); *(u32x2*)(MIX + (size_t)(NCTX + tp) * DM + 256 + gq * 64 + 16 * ei + 4 * g) = wo; }
    }
    __syncthreads();
}

constexpr float LOG2E = 1.4426950408889634f;
typedef short bf16x4 __attribute__((ext_vector_type(4)));
__device__ __forceinline__ void attn_load(const bf16* P, const bf16* VT, int krow, int kcol, int li, int g, bf16x8 (&kf)[2][2], bf16x8 (&vf)[4]) {
#pragma unroll
    for (int t = 0; t < 2; ++t)
#pragma unroll
        for (int ks = 0; ks < 2; ++ks) kf[t][ks] = ldg8(P + (size_t)(krow + 16 * t + li) * INWP + kcol + 32 * ks + 8 * g);
#pragma unroll
    for (int dt = 0; dt < 4; ++dt) { const bf16* vp = VT + (size_t)(dt * 16 + li) * VTP + krow + 4 * g;
        const bf16x4 a = *(const bf16x4*)vp, b = *(const bf16x4*)(vp + 16); vf[dt] = (bf16x8){a[0], a[1], a[2], a[3], b[0], b[1], b[2], b[3]}; }
}
template <int NS, int NT>
__device__ __forceinline__ void attn_compute(const bf16x8 (&kf)[2][2], const bf16x8 (&vf)[4], const bf16x8 (&qf)[NS][2], f32x4 (&o)[NS][4], float (&m)[NS], float (&ls)[NS],
                                             const float (&add)[NT][2][4], int li, int g) {
#pragma unroll
    for (int hh = 0; hh < NS; ++hh) {
        f32x4 st[2];
#pragma unroll
        for (int t = 0; t < 2; ++t) { st[t] = (f32x4){0.f, 0.f, 0.f, 0.f};
#pragma unroll
            for (int ks = 0; ks < 2; ++ks) st[t] = __builtin_amdgcn_mfma_f32_16x16x32_bf16(kf[t][ks], qf[hh][ks], st[t], 0, 0, 0); }
        float s[8]; float bm = -INFINITY;
#pragma unroll
        for (int t = 0; t < 2; ++t)
#pragma unroll
            for (int r = 0; r < 4; ++r) { const float ad = add[hh / (NS / NT)][t][r]; s[4 * t + r] = (ad == -INFINITY) ? -INFINITY : st[t][r] * (0.125f * LOG2E) + ad; bm = fmaxf(bm, s[4 * t + r]); }
        bm = fmaxf(bm, shx(bm, 16, 16 * g + li)); bm = fmaxf(bm, shx(bm, 32, 16 * g + li));
        const float mn = fmaxf(m[hh], bm), corr = __builtin_amdgcn_exp2f(m[hh] - mn); m[hh] = mn;
        float ps = 0.f; float pe[8];
#pragma unroll
        for (int e = 0; e < 8; ++e) { pe[e] = __builtin_amdgcn_exp2f(s[e] - mn); ps += pe[e]; }
        ls[hh] = ls[hh] * corr + ps;
        union { bf16x8 v; unsigned u[4]; } pf;
#pragma unroll
        for (int e2 = 0; e2 < 4; ++e2) pf.u[e2] = pk2(pe[2 * e2], pe[2 * e2 + 1]);
#pragma unroll
        for (int dt = 0; dt < 4; ++dt) { o[hh][dt] = o[hh][dt] * corr; o[hh][dt] = __builtin_amdgcn_mfma_f32_16x16x32_bf16(vf[dt], pf.v, o[hh][dt], 0, 0, 0); }
    }
}
__device__ __forceinline__ void attn_finish1(bf16* MIX, int qrow0, int ocol, f32x4 (&o)[4], float m, float ls, bool has_sink, float sink2, int li, int g) {
    float l = ls; l += shx(l, 16, 16 * g + li); l += shx(l, 32, 16 * g + li);
    float corr = 1.f;
    if (has_sink) { const float mn = fmaxf(m, sink2); corr = __builtin_amdgcn_exp2f(m - mn); l = l * corr + __builtin_amdgcn_exp2f(sink2 - mn); }
    const float inv = corr / l;
#pragma unroll
    for (int dt = 0; dt < 4; ++dt) { const f32x4 v = o[dt] * inv; u32x2 w; w.x = pk2(v[0], v[1]); w.y = pk2(v[2], v[3]);
        *(u32x2*)(MIX + (size_t)(qrow0 + li) * DM + ocol + dt * 16 + 4 * g) = w; }
}
__device__ __forceinline__ void attnA_unit(const Ctx& C, const float* asink_l, int unit, bool lat) {
    const bf16* P = (const bf16*)(C.ws + WS_P); bf16* MIX = (bf16*)(C.ws + WS_MIX);
    const int li = C.lane & 15, g = C.lane >> 4;
    const int nqp = lat ? SEQ / 32 : NCTX / 32, kvh = unit / nqp, qp = unit % nqp, t0 = qp * 32, qrow0 = (lat ? NCTX : 0) + t0;
    const bf16* VT = (const bf16*)(C.ws + WS_VTA) + (size_t)kvh * 64 * VTP; const int kcol = C_AK + kvh * 64;
    bf16x8 qf[4][2];
#pragma unroll
    for (int s = 0; s < 4; ++s)
#pragma unroll
        for (int ks = 0; ks < 2; ++ks) qf[s][ks] = ldg8(P + (size_t)(qrow0 + 16 * (s >> 1) + li) * INWP + C_AQ + (kvh * 2 + (s & 1)) * 64 + 32 * ks + 8 * g);
    f32x4 o[4][4]; float m[4], ls[4];
#pragma unroll
    for (int s = 0; s < 4; ++s) { m[s] = -1.0e30f; ls[s] = 0.f;
#pragma unroll
        for (int dt = 0; dt < 4; ++dt) o[s][dt] = (f32x4){0.f, 0.f, 0.f, 0.f}; }
    const int b_lo = lat ? 0 : 9;
#pragma unroll 1
    for (int bb = b_lo; bb < 17; ++bb) { float add[2][2][4]; bf16x8 kf[2][2], vf[4];
        const int krow = (bb < 9) ? NCTX + t0 - 128 + 32 * bb : 32 * (bb - 9);
        attn_load(P, VT, krow, kcol, li, g, kf, vf);
#pragma unroll
        for (int tl = 0; tl < 2; ++tl)
#pragma unroll
            for (int tt = 0; tt < 2; ++tt)
#pragma unroll
                for (int r = 0; r < 4; ++r) { const int j = t0 - 128 + 32 * bb + 16 * tt + 4 * g + r, t = t0 + 16 * tl + li;
                    const bool ok = (bb >= 9) || ((j >= 0) && (j < SEQ) && (j - t <= 128) && (t - j <= 128)); add[tl][tt][r] = ok ? 0.f : -INFINITY; }
        attn_compute<4, 2>(kf, vf, qf, o, m, ls, add, li, g); }
#pragma unroll
    for (int s = 0; s < 4; ++s) attn_finish1(MIX, qrow0 + 16 * (s >> 1), (kvh * 2 + (s & 1)) * 64, o[s], m[s], ls[s], true, asink_l[kvh * 2 + (s & 1)] * LOG2E, li, g);
}
__device__ __forceinline__ void attnC_unit(const Ctx& C, const LAS float* relb, int h, int up, bool lat) {
    const bf16* P = (const bf16*)(C.ws + WS_P); bf16* MIX = (bf16*)(C.ws + WS_MIX);
    const int li = C.lane & 15, g = C.lane >> 4;
    const int rp = up >> 2, cj = up & 3;
    const int t0a = lat ? (2 * rp) * 64 + 16 * cj : 32 * up, tstep = lat ? 64 : 16, qbase = lat ? NCTX : 0;
    const bf16* VT = (const bf16*)(C.ws + WS_VTC) + (size_t)h * 64 * VTP; const int kcol = C_CK + h * 64;
    bf16x8 qf[2][2];
#pragma unroll
    for (int s = 0; s < 2; ++s)
#pragma unroll
        for (int ks = 0; ks < 2; ++ks) qf[s][ks] = ldg8(P + (size_t)(qbase + t0a + tstep * s + li) * INWP + C_CQ + h * 64 + 32 * ks + 8 * g);
    f32x4 o[2][4]; float m[2] = {-1.0e30f, -1.0e30f}, ls[2] = {0.f, 0.f};
#pragma unroll
    for (int s = 0; s < 2; ++s)
#pragma unroll
        for (int dt = 0; dt < 4; ++dt) o[s][dt] = (f32x4){0.f, 0.f, 0.f, 0.f};
    const int r = 2 * rp, cq = cj * 16 + li;
    int r0a = r - 4; r0a = r0a < 0 ? 0 : (r0a > 248 ? 248 : r0a); int r0b = r - 3; r0b = r0b < 0 ? 0 : (r0b > 248 ? 248 : r0b);
    int c0 = cq - 8; c0 = c0 < 0 ? 0 : (c0 > 48 ? 48 : c0);
    const int cw0 = (cj == 0) ? 0 : (cj == 1) ? 8 : (cj == 2) ? 24 : 32;
    const int b_lo = lat ? 0 : 9;
#pragma unroll 1
    for (int bb = b_lo; bb < 17; ++bb) { float add[2][2][4]; bf16x8 kf[2][2], vf[4];
        const int kr = r0a + bb;
        if (bb < 9 && kr >= r0b + 8) continue;
        const int krow = (bb < 9) ? NCTX + kr * 64 + cw0 : 32 * (bb - 9);
        attn_load(P, VT, krow, kcol, li, g, kf, vf);
#pragma unroll
        for (int tl = 0; tl < 2; ++tl) { const int r0t = tl ? r0b : r0a, rt = r + tl; const bool rowok = (bb >= 9) || (kr >= r0t && kr < r0t + 8);
            int bi = kr - rt + 7; bi = bi < 0 ? 0 : (bi > 14 ? 14 : bi); const LAS float* rbp = relb + bi * 31;
#pragma unroll
            for (int tt = 0; tt < 2; ++tt)
#pragma unroll
                for (int rr = 0; rr < 4; ++rr) { const int kc = cw0 + 16 * tt + 4 * g + rr; int ci = kc - cq + 15; ci = ci < 0 ? 0 : (ci > 30 ? 30 : ci); const float bv = rbp[ci];
                    add[tl][tt][rr] = (bb >= 9) ? 0.f : ((rowok && kc >= c0 && kc < c0 + 16) ? bv : -INFINITY); } }
        attn_compute<2, 2>(kf, vf, qf, o, m, ls, add, li, g); }
#pragma unroll
    for (int s = 0; s < 2; ++s) attn_finish1(MIX, qbase + t0a + tstep * s, 512 + h * 64, o[s], m[s], ls[s], false, 0.f, li, g);
}
__device__ __forceinline__ void fourier_ctx_mfma(const Ctx& C, int l, int wg0) {
    const bf16* P = (const bf16*)(C.ws + WS_P); bf16* MIX = (bf16*)(C.ws + WS_MIX); const bf16* f2 = (const bf16*)(C.ws + WS_F256);
    const int lane = C.lane, li = lane & 15, g = lane >> 4, w = C.wave;
    constexpr int UP = 72;
    for (int u = C.wg - wg0; u < 8; u += C.G - wg0) {
        const int tb = u >> 2, gq = u & 3;
        __syncthreads();
        for (int i = C.tid; i < 256 * 8; i += NTHR) { const int t = i >> 3, c8 = i & 7; *(LAS u32x4*)(C.lds + (t * UP + 8 * c8) * 2) = *(const u32x4*)(P + (size_t)t * INWP + C_BU + gq * 64 + 8 * c8); }
        __syncthreads();
        const int tp0 = 128 * tb + 16 * w;
        f32x4 xr[4], xi[4];
#pragma unroll
        for (int ci = 0; ci < 4; ++ci) { xr[ci] = (f32x4){0.f, 0.f, 0.f, 0.f}; xi[ci] = (f32x4){0.f, 0.f, 0.f, 0.f}; }
#pragma unroll 2
        for (int ks = 0; ks < 8; ++ks) { const bf16x8 bc = ldg8(f2 + (size_t)(tp0 + li) * 256 + 32 * ks + 8 * g), bs = ldg8(f2 + 65536 + (size_t)(tp0 + li) * 256 + 32 * ks + 8 * g);
#pragma unroll
            for (int ci = 0; ci < 4; ++ci) { const bf16x8 au = ldT(C.lds, UP, 32 * ks, 16 * ci, li, g); xr[ci] = mfma16(au, bc, xr[ci]); xi[ci] = mfma16(au, bs, xi[ci]); } }
        union { bf16x8 v; unsigned q[4]; } xb[4];
#pragma unroll
        for (int q2 = 0; q2 < 2; ++q2) { xb[q2].q[0] = pk2(xr[2 * q2][0], xr[2 * q2][1]); xb[q2].q[1] = pk2(xr[2 * q2][2], xr[2 * q2][3]); xb[q2].q[2] = pk2(xr[2 * q2 + 1][0], xr[2 * q2 + 1][1]); xb[q2].q[3] = pk2(xr[2 * q2 + 1][2], xr[2 * q2 + 1][3]);
            xb[2 + q2].q[0] = pk2(-xi[2 * q2][0], -xi[2 * q2][1]); xb[2 + q2].q[1] = pk2(-xi[2 * q2][2], -xi[2 * q2][3]); xb[2 + q2].q[2] = pk2(-xi[2 * q2 + 1][0], -xi[2 * q2 + 1][1]); xb[2 + q2].q[3] = pk2(-xi[2 * q2 + 1][2], -xi[2 * q2 + 1][3]); }
        const bf16x8* mf = (const bf16x8*)((const bf16*)(C.ws + WS_FTAB) + 32768) + (size_t)(l * 4 + gq) * 16 * 64;
#pragma unroll
        for (int ei = 0; ei < 4; ++ei) { f32x4 o = {0.f, 0.f, 0.f, 0.f};
#pragma unroll
            for (int ks2 = 0; ks2 < 4; ++ks2) o = mfma16(mf[(ei * 4 + ks2) * 64 + lane], xb[ks2].v, o);
            o = o * 8.0f;
            u32x2 wo; wo.x = pk2(o[0], o[1]); wo.y = pk2(o[2], o[3]); *(u32x2*)(MIX + (size_t)(tp0 + li) * DM + 256 + gq * 64 + 16 * ei + 4 * g) = wo; }
    }
    __syncthreads();
}
__device__ __forceinline__ void fourier2_unit(const Ctx& C, int l, int u, bool ctx) {
    const bf16* P = (const bf16*)(C.ws + WS_P); const float* tw = (const float*)(C.ws + WS_TW); bf16* MIX = (bf16*)(C.ws + WS_MIX);
    const float* FYR = (const float*)(C.ws + WS_FYR); const float* FYI = (const float*)(C.ws + WS_FYI);
    const float* mt = (const float*)(C.ws + WS_MTAB) + (size_t)l * 2 * 4 * 4096;
    LAS float* xr = (LAS float*)(C.lds + 8192); LAS float* xi = xr + 512;
    const int tl = C.tid >> 8, ch = C.tid & 255, tp = 2 * u + tl;
    float sr = 0.f, si = 0.f;
    if (!ctx) { const int k1 = tp & 127, k2 = tp >> 7; const float* yr = FYR + (size_t)k1 * 128 * 256 + ch; const float* yi = FYI + (size_t)k1 * 128 * 256 + ch;
#pragma unroll 8
        for (int t2 = 0; t2 < 128; ++t2) { const int m = ((t2 * k2) & 127) * 128; const float c = tw[m], s = tw[16384 + m]; const float a = yr[t2 * 256], b = yi[t2 * 256]; sr += a * c + b * s; si += b * c - a * s; } }
    else {
#pragma unroll 8
        for (int t = 0; t < NCTX; ++t) { const int m = ((t * tp) & 255) * 64; const float x = bf2f(P[(size_t)t * INWP + C_BU + ch]); sr += x * tw[m]; si -= x * tw[16384 + m]; } }
    __syncthreads();
    xr[tl * 256 + ch] = sr; xi[tl * 256 + ch] = si;
    __syncthreads();
    const int g = ch >> 6, e = ch & 63; const float* mc = mt + (size_t)(0 * 4 + g) * 4096 + e; const float* ms = mt + (size_t)(1 * 4 + g) * 4096 + e;
    const LAS float* xrp = xr + tl * 256 + g * 64; const LAS float* xip = xi + tl * 256 + g * 64; float o = 0.f;
#pragma unroll 8
    for (int c = 0; c < 64; ++c) o += xrp[c] * mc[c * 64] + xip[c] * ms[c * 64];
    o *= ctx ? (1.0f / 128.0f) : (1.0f / 1024.0f);
    MIX[(size_t)((ctx ? 0 : NCTX) + tp) * DM + 256 + ch] = (bf16)f2bf(o);
}
__device__ __forceinline__ void rwkv_passB(const Ctx& C, int b);
__device__ __forceinline__ void phase_mix2(const Ctx& C, const DArgs& a, int l) {
    const bool emit_ctx = l < DEPTH - 1;
#ifndef REPMASK
#define REPMASK 0
#endif
#define NREP2(o) ((((REPMASK) >> (o)) & 1) ? 2 : 1)
    if (C.wg < 8) { for (int r2 = 0; r2 < NREP2(16); ++r2) rwkv_passB(C, C.wg); }
    else if (emit_ctx) fourier_ctx_mfma(C, l, 8);
    { const float* asink_l = a.in[I_ASINK] + l * 4; const float* crel = a.in[I_CREL] + (size_t)l * 4 * 465;
      LAS float* relb = (LAS float*)(C.lds + 110592 + C.wave * 2048);
      for (int r2 = 0; r2 < NREP2(17); ++r2) {
      unsigned* qhead = (unsigned*)(C.ws + WS_CTL) + CW_WQ + 64 * l + 16 * r2;
      const int nA = 2 * (SEQ / 32), nC = 4 * (SEQ / 32), nAc = emit_ctx ? 2 * (NCTX / 32) : 0, nCc = emit_ctx ? 4 * (NCTX / 32) : 0, nAll = nA + nAc + nC + nCc;
      int hcur = -1;
      const int nCv = emit_ctx ? CV_NCHUNK : 0;
      for (;;) { unsigned uq = 0; if (C.lane == 0) uq = __hip_atomic_fetch_add(qhead, 1u, __ATOMIC_RELAXED, __HIP_MEMORY_SCOPE_AGENT);
          const int uraw = __builtin_amdgcn_readfirstlane((int)uq); if (uraw >= nAll + nCv) break;
          int u;
          if (uraw < 2 * nCv) { if (uraw & 1) { const int ch = uraw >> 1; convert_moe_items(C, a, l + 1, ch * CV_CHUNK, ch * CV_CHUNK + CV_CHUNK); continue; } u = uraw >> 1; }
          else u = uraw - nCv;
          if (u < nA) attnA_unit(C, asink_l, u, true);
          else if (u < nA + nAc) attnA_unit(C, asink_l, u - nA, false);
          else { const int uc = u - nA - nAc; const bool lat = uc < nC; const int uu = lat ? uc : uc - nC, nqt = lat ? SEQ / 32 : NCTX / 32, h = uu / nqt, qt = uu % nqt;
              if (h != hcur) { for (int i = C.lane; i < 465; i += 64) relb[i] = crel[h * 465 + i] * LOG2E; hcur = h; LDS_WAIT(); asm volatile("" ::: "memory"); }
              attnC_unit(C, relb, h, qt, lat); } } } }
    __syncthreads();
    for (int r2 = 0; r2 < NREP2(19); ++r2) fourier2_mfma(C, l, 0);
}

constexpr int RW_C = 32, RW_NCH = ROWS / RW_C, RW_SC = 20, RW_NSC = RW_NCH / RW_SC;
constexpr int RW_SLOT = 5120, RW_REGION = 9 * RW_SLOT + 1024;
constexpr int TP = 72, HP = 40;
static_assert(3 * RW_REGION <= MISC_OFF, "RWKV D1 regions below the misc area");
__device__ __forceinline__ int rw_rc_of(int d, int c) { return d == 0 ? c : (c < 8 ? 7 - c : 527 - c); }
__device__ __forceinline__ int rw_row_of(int d, int rc, int t) { return 32 * rc + (d == 0 ? t : 31 - t); }

__device__ __forceinline__ void rwkv_d1(const Ctx& C, LAS unsigned char* rb, int d, int h, int rc) {
    int lane_ = C.lane; asm volatile("" : "+v"(lane_));
    const int lane = lane_, li = lane & 15, g = lane >> 4;
    const float* SC = (const float*)(C.ws + WS_SC);
    LAS unsigned char* S0 = rb; LAS unsigned char* S1 = rb + RW_SLOT; LAS unsigned char* S2 = rb + 2 * RW_SLOT; LAS unsigned char* S3 = rb + 3 * RW_SLOT; LAS unsigned char* S4 = rb + 4 * RW_SLOT;
    LAS unsigned char* S5 = rb + 5 * RW_SLOT; LAS unsigned char* S6 = rb + 6 * RW_SLOT; LAS unsigned char* S7 = rb + 7 * RW_SLOT; LAS unsigned char* S8 = rb + 8 * RW_SLOT;
    LAS unsigned char* S6b = S6 + 2560; LAS unsigned char* S7b = S7 + 2560;
    LAS float* gc = (LAS float*)(rb + 9 * RW_SLOT);
    { float cum = 0.f; const int j = lane; const int qw = (3 + 3 * d) * 256;
      float rv[2][4], vv[2][4], av[2][4], lw[2][4], kd[2][4], bb[2][4];
#define RW_LD(buf, t0) do { _Pragma("unroll") for (int u = 0; u < 4; ++u) { const float* sc = SC + (size_t)rw_row_of(d, rc, (t0) + u) * 9 * 256 + h * 64 + j; \
          rv[buf][u] = sc[0]; vv[buf][u] = sc[256]; av[buf][u] = sc[512]; lw[buf][u] = sc[qw]; kd[buf][u] = sc[qw + 256]; bb[buf][u] = sc[qw + 512]; } } while (0)
#define RW_CP(buf, t0) do { _Pragma("unroll") for (int u = 0; u < 4; ++u) { const float cp = cum; cum += lw[buf][u]; const float Gt = __expf(cum), Gm = __expf(cp), iG = __expf(-cum); const int off = (((t0) + u) * TP + j) * 2; \
          *(LAS bf16*)(S0 + off) = (bf16)f2bf(av[buf][u] * Gm); *(LAS bf16*)(S1 + off) = (bf16)f2bf(rv[buf][u] * Gt); *(LAS bf16*)(S2 + off) = (bf16)f2bf(bb[buf][u] * iG); \
          *(LAS bf16*)(S3 + off) = (bf16)f2bf(kd[buf][u] * iG); *(LAS bf16*)(S4 + off) = (bf16)f2bf(vv[buf][u]); } } while (0)
      RW_LD(0, 0);
#pragma unroll
      for (int b2 = 0; b2 < 4; ++b2) { RW_LD(1, 8 * b2 + 4); __builtin_amdgcn_sched_barrier(0); RW_CP(0, 8 * b2); if (b2 < 3) RW_LD(0, 8 * b2 + 8); __builtin_amdgcn_sched_barrier(0); RW_CP(1, 8 * b2 + 4); }
#undef RW_LD
#undef RW_CP
      gc[j] = __expf(cum); }
    const f32x4 z4 = {0.f, 0.f, 0.f, 0.f};
#pragma unroll 1
    for (int ti = 0; ti < 2; ++ti)
#pragma unroll
        for (int si = 0; si < 2; ++si) {
            f32x4 n = z4, nt = z4, mk = z4, qb = z4, qk = z4;
#pragma unroll
            for (int ks = 0; ks < 2; ++ks) { const bf16x8 at = ldA(S0, TP, 16 * ti, 32 * ks, li, g), rt = ldA(S1, TP, 16 * ti, 32 * ks, li, g), bs = ldA(S2, TP, 16 * si, 32 * ks, li, g), kss = ldA(S3, TP, 16 * si, 32 * ks, li, g);
                n = mfma16(at, bs, n);
                nt = mfma16(bs, at, nt);
                mk = mfma16(kss, at, mk);
                qb = mfma16(bs, rt, qb);
                qk = mfma16(kss, rt, qk); }
#pragma unroll
            for (int r = 0; r < 4; ++r) { const int trow = 16 * ti + 4 * g + r, scol = 16 * si + li; if (!(scol < trow)) n[r] = 0.f;
                const int srow = 16 * si + 4 * g + r, tcol = 16 * ti + li; if (!(srow < tcol)) { mk[r] = 0.f; nt[r] = 0.f; } if (!(srow <= tcol)) { qb[r] = 0.f; qk[r] = 0.f; } }
            *(LAS f32x4*)(S5 + ((16 * si + li) * 32 + 16 * ti + 4 * g) * 4) = n;
            stT(S6, HP, 16 * ti + li, 16 * si + 4 * g, mk);
            stT(S8, HP, 16 * ti + li, 16 * si + 4 * g, nt);
            stT(S6b, HP, 16 * ti + li, 16 * si + 4 * g, qb);
            stT(S7, HP, 16 * ti + li, 16 * si + 4 * g, qk); }
    { const int rr = lane & 31, bq = rr >> 4, lr = rr & 15; float Tr[16];
#pragma unroll
      for (int s = 15; s >= 0; --s) { float acc = (lr == s) ? 1.f : 0.f;
#pragma unroll
          for (int c4 = 0; c4 < 4; ++c4) { if (4 * c4 + 3 > s) { const f32x4 nv = *(const LAS f32x4*)(S5 + ((16 * bq + s) * 32 + 16 * bq + 4 * c4) * 4);
#pragma unroll
              for (int e = 0; e < 4; ++e) if (4 * c4 + e > s) acc += Tr[4 * c4 + e] * nv[e]; } }
          Tr[s] = acc; }
      if (lane < 32) { u32x4 w0, w1; w0.x = pk2(Tr[0], Tr[1]); w0.y = pk2(Tr[2], Tr[3]); w0.z = pk2(Tr[4], Tr[5]); w0.w = pk2(Tr[6], Tr[7]); w1.x = pk2(Tr[8], Tr[9]); w1.y = pk2(Tr[10], Tr[11]); w1.z = pk2(Tr[12], Tr[13]); w1.w = pk2(Tr[14], Tr[15]);
          const u32x4 zz = {0u, 0u, 0u, 0u}; LAS u32x4* trow = (LAS u32x4*)(S7b + rr * HP * 2);
          trow[0] = bq ? zz : w0; trow[1] = bq ? zz : w1; trow[2] = bq ? w0 : zz; trow[3] = bq ? w1 : zz; }
      f32x4 x = mfma16(ldA(S8, HP, 16, 0, li, g), ldT(S7b, HP, 0, 0, li, g), z4);
      LAS unsigned char* XT = S8 + 2560;
      *(LAS u32x2*)(XT + (li * HP + 4 * g) * 2) = (u32x2){0u, 0u}; stT(XT, HP, li, 16 + 4 * g, x);
      const f32x4 t21 = mfma16(ldA(S7b, HP, 16, 0, li, g), ldA(XT, HP, 0, 0, li, g), z4);
#pragma unroll
      for (int r = 0; r < 4; ++r) *(LAS bf16*)(S7b + ((16 + 4 * g + r) * HP + li) * 2) = (bf16)f2bf(t21[r]); }
#pragma unroll
    for (int ti = 0; ti < 2; ++ti) { const bf16x8 tf = ldA(S7b, HP, 16 * ti, 0, li, g), mf = ldA(S6, HP, 16 * ti, 0, li, g);
#pragma unroll
        for (int ji = 0; ji < 4; ++ji) { const f32x4 ap = mfma16(tf, ldT(S0, TP, 0, 16 * ji, li, g), z4); stT(S8, HP, 16 * ji + li, 16 * ti + 4 * g, ap);
            const f32x4 mv = mfma16(mf, ldT(S4, TP, 0, 16 * ji, li, g), z4); stT(S5, HP, 16 * ji + li, 16 * ti + 4 * g, mv); } }
#pragma unroll
    for (int ti = 0; ti < 2; ++ti) { const bf16x8 tf = ldA(S7b, HP, 16 * ti, 0, li, g);
#pragma unroll
        for (int vi = 0; vi < 4; ++vi) { const f32x4 ul = mfma16(tf, ldA(S5, HP, 16 * vi, 0, li, g), z4); stT(S0, HP, 16 * vi + li, 16 * ti + 4 * g, ul); } }
#pragma unroll
    for (int ti = 0; ti < 2; ++ti) { const bf16x8 qbf = ldA(S6b, HP, 16 * ti, 0, li, g), qkf = ldA(S7, HP, 16 * ti, 0, li, g);
#pragma unroll
        for (int ji = 0; ji < 4; ++ji) { f32x4 rp = mfma16(ldA(S8, HP, 16 * ji, 0, li, g), qbf, z4);
            LAS unsigned char* p = S1 + ((16 * ti + li) * TP + 16 * ji + 4 * g) * 2; rp = rp + ld4bf(p); u32x2 w; w.x = pk2(rp[0], rp[1]); w.y = pk2(rp[2], rp[3]); *(LAS u32x2*)p = w;
            f32x4 yl = mfma16(qbf, ldA(S0, HP, 16 * ji, 0, li, g), z4); yl = mfma16(qkf, ldT(S4, TP, 0, 16 * ji, li, g), yl);
            stT(S5, HP, 16 * ji + li, 16 * ti + 4 * g, yl); } }
#pragma unroll 2
    for (int ji = 0; ji < 4; ++ji) { const bf16x8 bt = ldT(S2, TP, 0, 16 * ji, li, g); const float gj = gc[16 * ji + li];
#pragma unroll
        for (int jp = 0; jp < 4; ++jp) { f32x4 pt = mfma16(ldA(S8, HP, 16 * jp, 0, li, g), bt, z4);
#pragma unroll
            for (int r = 0; r < 4; ++r) pt[r] = pt[r] * gj + ((16 * jp + 4 * g + r == 16 * ji + li) ? gj : 0.f);
            stT(S6, TP, 16 * ji + li, 16 * jp + 4 * g, pt); } }
#pragma unroll 1
    for (int vh = 0; vh < 2; ++vh) { f32x4 lt[4][2];
#pragma unroll
      for (int ji = 0; ji < 4; ++ji) { const bf16x8 ba = ldT(S2, TP, 0, 16 * ji, li, g), ka = ldT(S3, TP, 0, 16 * ji, li, g); const f32x4 gv = *(const LAS f32x4*)(gc + 16 * ji + 4 * g);
#pragma unroll
          for (int v2 = 0; v2 < 2; ++v2) { const int vi = 2 * vh + v2; f32x4 x = mfma16(ba, ldA(S0, HP, 16 * vi, 0, li, g), z4); x = mfma16(ka, ldT(S4, TP, 0, 16 * vi, li, g), x); lt[ji][v2] = x * gv; } }
      asm volatile("s_waitcnt lgkmcnt(0)" ::: "memory");
      LAS unsigned char* dst = vh ? S2 : S8;
#pragma unroll
      for (int ji = 0; ji < 4; ++ji)
#pragma unroll
          for (int v2 = 0; v2 < 2; ++v2) stT(dst, TP, 16 * v2 + li, 16 * ji + 4 * g, lt[ji][v2]); }
}
__device__ __forceinline__ void rwkv_passA_step(const Ctx& C, const LAS unsigned char* rb, f32x4 (&hs)[4], int d, int h, int rc) {
    int lane_ = C.lane; asm volatile("" : "+v"(lane_));
    const int lane = lane_, li = lane & 15, g = lane >> 4; const bool isPhi = C.wave >= 4; const int col = 16 * (C.wave & 3) + li;
    const LAS unsigned char* S1 = rb + RW_SLOT; const LAS unsigned char* S2 = rb + 2 * RW_SLOT; const LAS unsigned char* S5 = rb + 5 * RW_SLOT; const LAS unsigned char* S6 = rb + 6 * RW_SLOT;
    const LAS unsigned char* LTb = (col < 32) ? rb + 8 * RW_SLOT + col * TP * 2 : S2 + (col - 32) * TP * 2;
    union { bf16x8 v; unsigned u[4]; } bf[2];
#pragma unroll
    for (int ks = 0; ks < 2; ++ks) { bf[ks].u[0] = pk2(hs[2 * ks][0], hs[2 * ks][1]); bf[ks].u[1] = pk2(hs[2 * ks][2], hs[2 * ks][3]); bf[ks].u[2] = pk2(hs[2 * ks + 1][0], hs[2 * ks + 1][1]); bf[ks].u[3] = pk2(hs[2 * ks + 1][2], hs[2 * ks + 1][3]); }
#pragma unroll
    for (int ti = 0; ti < 2; ++ti) { f32x4 acc = isPhi ? (f32x4){0.f, 0.f, 0.f, 0.f} : ld4bf(S5 + (col * HP + 16 * ti + 4 * g) * 2);
#pragma unroll
        for (int ks = 0; ks < 2; ++ks) acc = mfma16(ldAperm(S1, TP, 16 * ti, ks, li, g), bf[ks].v, acc);
        if (!isPhi) { float* ys = (float*)(C.ws + WS_YS) + (size_t)d * ROWS * 256 + h * 64 + col;
#pragma unroll
            for (int r = 0; r < 4; ++r) ys[(size_t)rw_row_of(d, rc, 16 * ti + 4 * g + r) * 256] = acc[r]; }
        else { bf16* rp = (bf16*)(C.ws + WS_RPP) + ((size_t)((d * 4 + h) * RW_NCH + rc) * 32) * 64 + col;
#pragma unroll
            for (int r = 0; r < 4; ++r) rp[(16 * ti + 4 * g + r) * 64] = (bf16)f2bf(acc[r]); } }
    f32x4 hn[4];
#pragma unroll
    for (int i = 0; i < 4; ++i) { f32x4 acc = isPhi ? (f32x4){0.f, 0.f, 0.f, 0.f} : ld4bf(LTb + (16 * i + 4 * g) * 2);
#pragma unroll
        for (int ks = 0; ks < 2; ++ks) acc = mfma16(ldAperm(S6, TP, 16 * i, ks, li, g), bf[ks].v, acc);
        hn[i] = acc; }
#pragma unroll
    for (int i = 0; i < 4; ++i) hs[i] = hn[i];
}
__device__ __forceinline__ void phase_rwkv1(const Ctx& C) {
    const int lane = C.lane, li = lane & 15, g = lane >> 4;
    for (int u = C.wg; u < 8 * RW_NSC; u += C.G) {
        const int s = u % RW_NSC, dh = u / RW_NSC, d = dh >> 2, h = dh & 3; const bool isPhi = C.wave >= 4; const int col = 16 * (C.wave & 3) + li;
        f32x4 hs[4];
#pragma unroll
        for (int i = 0; i < 4; ++i)
#pragma unroll
            for (int r = 0; r < 4; ++r) hs[i][r] = (isPhi && (16 * i + 4 * g + r == col)) ? 1.f : 0.f;
#pragma unroll 1
        for (int rnd = 0; rnd < (RW_SC + 2) / 3; ++rnd) {
            __syncthreads();
            { int wv = C.wave; asm volatile("" : "+s"(wv)); if (wv < 3 && 3 * rnd + wv < RW_SC) rwkv_d1(C, C.lds + wv * RW_REGION, d, h, rw_rc_of(d, s * RW_SC + 3 * rnd + wv)); }
            __syncthreads();
#pragma unroll 1
            for (int k = 0; k < 3; ++k) { const int ci = 3 * rnd + k; int ko = k * RW_REGION; asm volatile("" : "+s"(ko)); if (ci < RW_SC) rwkv_passA_step(C, C.lds + ko, hs, d, h, rw_rc_of(d, s * RW_SC + ci)); }
        }
        if (isPhi) { bf16* pf = (bf16*)(C.ws + WS_PSC) + (size_t)(dh * RW_NSC + s) * 4096;
            const int ks = col >> 5, eh = (col >> 4) & 1, gp = (col >> 2) & 3, el = col & 3;
#pragma unroll
            for (int i = 0; i < 4; ++i)
#pragma unroll
                for (int r = 0; r < 4; ++r) pf[((i * 2 + ks) * 64 + gp * 16 + 4 * g + r) * 8 + eh * 4 + el] = (bf16)f2bf(hs[i][r]); }
        else { f32x4* lf = (f32x4*)(C.ws + WS_LSC) + ((size_t)(dh * RW_NSC + s) * 4 + C.wave) * 4 * 64;
#pragma unroll
            for (int i = 0; i < 4; ++i) lf[i * 64 + lane] = hs[i]; }
    }
    __syncthreads();
}
__device__ __forceinline__ void rwkv_passB(const Ctx& C, int b) {
    if (C.wave >= 4) return;
    const int lane = C.lane, li = lane & 15, g = lane >> 4, q = C.wave;
    f32x4 hs[4];
#pragma unroll
    for (int i = 0; i < 4; ++i) hs[i] = (f32x4){0.f, 0.f, 0.f, 0.f};
    const bf16x8* pfb = (const bf16x8*)((const bf16*)(C.ws + WS_PSC) + (size_t)b * RW_NSC * 4096);
    const f32x4* lfb = (const f32x4*)(C.ws + WS_LSC) + ((size_t)b * RW_NSC * 4 + q) * 4 * 64;
    bf16x8 pa[8]; f32x4 la[4];
#pragma unroll
    for (int k = 0; k < 8; ++k) pa[k] = pfb[k * 64 + lane];
#pragma unroll
    for (int i = 0; i < 4; ++i) la[i] = lfb[i * 64 + lane];
#pragma unroll 1
    for (int s = 0; s < RW_NSC; ++s) {
        bf16* hp = (bf16*)(C.ws + WS_HSC) + ((size_t)(b * RW_NSC + s) * 64 + 16 * q + li) * 64;
#pragma unroll
        for (int i = 0; i < 4; ++i) { u32x2 w; w.x = pk2(hs[i][0], hs[i][1]); w.y = pk2(hs[i][2], hs[i][3]); *(u32x2*)(hp + 16 * i + 4 * g) = w; }
        bf16x8 pn[8]; f32x4 ln[4]; const int sn = (s + 1 < RW_NSC) ? s + 1 : s;
#pragma unroll
        for (int k = 0; k < 8; ++k) pn[k] = pfb[(size_t)sn * 512 + k * 64 + lane];
#pragma unroll
        for (int i = 0; i < 4; ++i) ln[i] = lfb[(size_t)sn * 4 * 4 * 64 + i * 64 + lane];
        union { bf16x8 v; unsigned u[4]; } bf[2];
#pragma unroll
        for (int ks = 0; ks < 2; ++ks) { bf[ks].u[0] = pk2(hs[2 * ks][0], hs[2 * ks][1]); bf[ks].u[1] = pk2(hs[2 * ks][2], hs[2 * ks][3]); bf[ks].u[2] = pk2(hs[2 * ks + 1][0], hs[2 * ks + 1][1]); bf[ks].u[3] = pk2(hs[2 * ks + 1][2], hs[2 * ks + 1][3]); }
#pragma unroll
        for (int i = 0; i < 4; ++i) { f32x4 acc = la[i];
#pragma unroll
            for (int ks = 0; ks < 2; ++ks) acc = mfma16(pa[i * 2 + ks], bf[ks].v, acc);
            hs[i] = acc; }
#pragma unroll
        for (int k = 0; k < 8; ++k) pa[k] = pn[k];
#pragma unroll
        for (int i = 0; i < 4; ++i) la[i] = ln[i];
    }
}
__device__ __forceinline__ void phase_mix3(const Ctx& C, const DArgs& a, int l) {
    const bf16* P = (const bf16*)(C.ws + WS_P); const float* SC = (const float*)(C.ws + WS_SC); const float* YS = (const float*)(C.ws + WS_YS); bf16* MIX = (bf16*)(C.ws + WS_MIX);
    LAS float* yt = (LAS float*)(C.lds);
    constexpr int GSP = 168;
    LAS unsigned char* gsig = C.lds + 32768;
    LAS float* gm = (LAS float*)(C.lds + 40960);
    const bf16* g2t = (const bf16*)(C.ws + WS_G2T) + (size_t)l * 256 * 160;
    const float* rk = a.in[I_DRK] + (size_t)l * 256; const float* lnw = a.in[I_DLNW] + (size_t)l * 256; const float* lnb = a.in[I_DLNB] + (size_t)l * 256;
    const int lane = C.lane, li = lane & 15, g = lane >> 4, h = C.wave & 3, d = C.wave >> 2;
    const int half = C.tid >> 8, c = C.tid & 255;
    const int u_lo = (l == DEPTH - 1) ? NCTX / 16 : 0;
    bf16 glv[5];
#define GL_FETCH(uu) do { _Pragma("unroll") for (int k = 0; k < 5; ++k) { const int i = C.tid + NTHR * k, t = i / 160, ii = i % 160; glv[k] = P[(size_t)(16 * (uu) + t) * INWP + C_GL + ii]; } } while (0)
    const float lnwc = lnw[c], lnbc = lnb[c], rkc = rk[c];
    bf16x8 g2f[2][5];
#pragma unroll
    for (int c2 = 0; c2 < 2; ++c2)
#pragma unroll
        for (int ks = 0; ks < 5; ++ks) g2f[c2][ks] = ldg8(g2t + (size_t)(16 * (2 * C.wave + c2) + li) * 160 + 32 * ks + 8 * g);
    bf16x8 caf[2], cbf[4][2]; float cys[4][4];
#define CORR_FETCH(uu) do { const int rc_ = (uu) >> 1, th_ = (uu) & 1, ct_ = (d == 0) ? rc_ : (rc_ < 8 ? 7 - rc_ : 527 - rc_), s_ = ct_ / RW_SC, ti_ = (d == 0) ? th_ : 1 - th_; \
        const bf16* rp_ = (const bf16*)(C.ws + WS_RPP) + (size_t)((d * 4 + h) * RW_NCH + rc_) * 32 * 64; const bf16* hp_ = (const bf16*)(C.ws + WS_HSC) + (size_t)((d * 4 + h) * RW_NSC + s_) * 64 * 64; \
        _Pragma("unroll") for (int ks = 0; ks < 2; ++ks) caf[ks] = ldg8(rp_ + (16 * ti_ + li) * 64 + 32 * ks + 8 * g); \
        _Pragma("unroll") for (int vi = 0; vi < 4; ++vi) { _Pragma("unroll") for (int ks = 0; ks < 2; ++ks) cbf[vi][ks] = ldg8(hp_ + (16 * vi + li) * 64 + 32 * ks + 8 * g); \
            _Pragma("unroll") for (int r = 0; r < 4; ++r) { const int t_ = 16 * ti_ + 4 * g + r, rl_ = ((d == 0) ? t_ : 31 - t_) - 16 * th_; cys[vi][r] = YS[((size_t)d * ROWS + 16 * (uu) + rl_) * 256 + h * 64 + 16 * vi + li]; } } } while (0)
    if (u_lo + C.wg < ROWS / 16) { GL_FETCH(u_lo + C.wg); CORR_FETCH(u_lo + C.wg); }
    for (int u = u_lo + C.wg; u < ROWS / 16; u += C.G) {
        const int rc = u >> 1, th = u & 1, rowb = 16 * u;
        __syncthreads();
#pragma unroll
        for (int k = 0; k < 5; ++k) { const int i = C.tid + NTHR * k, t = i / 160, ii = i % 160; *(LAS bf16*)(gsig + (t * GSP + ii) * 2) = (bf16)f2bf(sigmoidf_(bf2f(glv[k]))); }
        {
          const int ti = (d == 0) ? th : 1 - th;
#pragma unroll
          for (int vi = 0; vi < 4; ++vi) { f32x4 acc = {0.f, 0.f, 0.f, 0.f};
#pragma unroll
              for (int ks = 0; ks < 2; ++ks) acc = mfma16(caf[ks], cbf[vi][ks], acc);
#pragma unroll
              for (int r = 0; r < 4; ++r) { const int t = 16 * ti + 4 * g + r, rl = ((d == 0) ? t : 31 - t) - 16 * th;
                  yt[(d * 16 + rl) * 256 + h * 64 + 16 * vi + li] = acc[r] + cys[vi][r]; } } }
        __syncthreads();
#pragma unroll
        for (int c2 = 0; c2 < 2; ++c2) { const int ci = 2 * C.wave + c2; f32x4 a0 = {0.f, 0.f, 0.f, 0.f};
#pragma unroll
            for (int ks = 0; ks < 5; ++ks) a0 = mfma16(ldA(gsig, GSP, 0, 32 * ks, li, g), g2f[c2][ks], a0);
#pragma unroll
            for (int r = 0; r < 4; ++r) gm[(4 * g + r) * 256 + 16 * ci + li] = a0[r]; }
        __syncthreads();
        if (u + C.G < ROWS / 16) { GL_FETCH(u + C.G); CORR_FETCH(u + C.G); }
        float qr[8], qv[8], qk0[8], qk1[8];
#pragma unroll
        for (int it = 0; it < 8; ++it) { const float* sc = SC + (size_t)(rowb + 2 * it + half) * 9 * 256; qr[it] = sc[c]; qv[it] = sc[256 + c]; qk0[it] = sc[4 * 256 + c]; qk1[it] = sc[7 * 256 + c]; }
#pragma unroll
        for (int it = 0; it < 8; ++it) { const int rl = 2 * it + half, row = rowb + rl;
            const float y = yt[rl * 256 + c] + yt[(16 + rl) * 256 + c];
            const float mu = wave_sum(y, lane) * (1.f / 64.f), dy = y - mu, var = wave_sum(dy * dy, lane) * (1.f / 64.f);
            const float yn = dy * rsqrtf(var + 64e-5f) * lnwc + lnbc;
            const float coef = wave_sum(qr[it] * (qk0[it] + qk1[it]) * rkc, lane);
            MIX[(size_t)row * DM + 768 + c] = (bf16)f2bf((yn + coef * qv[it]) * gm[rl * 256 + c]); }
    }
#undef GL_FETCH
#undef CORR_FETCH
    __syncthreads();
}
__device__ __forceinline__ void outproj_ctx(const Ctx& C, int l, const float* gate) {
    const bf16* A = (const bf16*)(C.ws + WS_MIX); const bf16* B = (const bf16*)(C.ws + WS_WOUT) + (size_t)l * DM * DM; float* XS = (float*)(C.ws + WS_XS);
    const int lane = C.lane, li = lane & 15, g = lane >> 4;
    for (int u = C.gw; u < (NCTX / 16) * (DM / 16); u += C.NGW) { const int rt = u >> 6, ct = u & 63;
        const bf16* ap = A + (size_t)(16 * rt + li) * DM + 8 * g; const bf16* bp = B + (size_t)(16 * ct + li) * DM + 8 * g;
        f32x4 acc0 = {0.f, 0.f, 0.f, 0.f}, acc1 = {0.f, 0.f, 0.f, 0.f};
#pragma unroll 4
        for (int ks = 0; ks < 32; ks += 2) { acc0 = mfma16(ldg8(ap + 32 * ks), ldg8(bp + 32 * ks), acc0); acc1 = mfma16(ldg8(ap + 32 * ks + 32), ldg8(bp + 32 * ks + 32), acc1); }
        const float gv = gate[16 * ct + li];
#pragma unroll
        for (int r = 0; r < 4; ++r) { float* p = XS + (size_t)(16 * rt + 4 * g + r) * DM + 16 * ct + li; *p = *p + gv * (acc0[r] + acc1[r]); } }
}

#ifndef MK_SINGLE
#define MK_SINGLE 1
#endif
template <int ONLYP> __global__ void __launch_bounds__(NTHR, 2) mega(Args a) {
    extern __shared__ __attribute__((aligned(16))) unsigned char lds_raw[];
    Ctx C;
#define MKCTX() do { int t_ = threadIdx.x; asm volatile("" : "+v"(t_)); unsigned char* w_ = a.ws; asm volatile("" : "+s"(w_)); unsigned l_ = 0u; asm volatile("" : "+s"(l_)); \
        C.lds = (LAS unsigned char*)lds_raw + l_; C.tid = t_; C.lane = t_ & 63; C.wave = __builtin_amdgcn_readfirstlane(t_ >> 6); \
        C.wg = blockIdx.x; C.G = gridDim.x; C.gw = C.wg * NWAVES + C.wave; C.NGW = C.G * NWAVES; C.ws = w_; } while (0)
    MKCTX();
    if (C.tid == 0) {
#pragma unroll
        for (int i = 0; i < 31; ++i) ((LAS unsigned long long*)(C.lds + MISC_OFF + 2048))[i] = (unsigned long long)a.in[i]; }
    DArgs da; da.in.tab = (const LAS unsigned*)(C.lds + MISC_OFF + 2048); da.out = a.out;
    if (C.tid < 4) ((LAS unsigned*)(C.lds + MISC_OFF))[C.tid] = 0u;
    __syncthreads();
    XcdBarrier bar; bar.bar = (unsigned*)(C.ws + WS_CTL) + CW_BAR; bar.x = 0; bar.st = (volatile LAS unsigned*)(C.lds + MISC_OFF);
    if (a.use_bar) bar = xcd_barrier_post((unsigned*)(C.ws + WS_CTL) + CW_BAR, (volatile LAS unsigned*)(C.lds + MISC_OFF));
#ifndef PHMASK
#define PHMASK 0x1fff
#endif
#define INP(o, k) ((ONLYP < 0 || ONLYP == (o)) && ((PHMASK >> ((o) == 99 ? 12 : (o))) & 1) && a.ph_lo <= (k) && (k) < a.ph_hi)
#ifndef REPMASK
#define REPMASK 0
#endif
#define NREP(o) ((((REPMASK) >> ((o) == 99 ? 12 : (o))) & 1) ? 2 : 1)
#define IN(k) (a.ph_lo <= (k) && (k) < a.ph_hi)
#define SEAM(k) do { if (a.use_bar && IN(k) && IN((k) + 1)) { xcd_barrier(bar); if ((REPMASK >> 20) & 1) xcd_barrier(bar); } } while (0)
    if (INP(0, 0)) for (int rep = 0; rep < NREP(0); ++rep) { MKCTX(); phase_prologue(C, da); }
    SEAM(0);
    for (int l = 0; l < DEPTH; ++l) {
        const int b = 1 + l * NPL;
        const float* mod_lat = (const float*)(C.ws + WS_MOD) + (size_t)(l * 2 + 0) * 6144; const float* mod_ctx = mod_lat + 6144;
        if (INP(1, b + 0)) { MKCTX(); phase_norm1(C, da, l); }
        SEAM(b + 0);
        if (INP(2, b + 1)) for (int rep = 0; rep < NREP(2); ++rep) { MKCTX();
            pg8::StaticOrder S; S.init(WS_H, WS_WIN + (size_t)l * INWP * DM * 2, ROWS, INWP, DM, C.G, C.wg);
            pg8::EpiStoreBf16 E{(bf16*)(C.ws + WS_P), INWP, nullptr, 0, 1.0f, 1.0f};
            pg8::gemm_phase<pg8::EpiStoreBf16, pg8::StaticOrder, true, true>(C.lds, C.tid, DM, S, E, C.ws);
        }
        SEAM(b + 1);
        if (INP(3, b + 2)) { MKCTX(); for (int rep = 0; rep < NREP(3); ++rep) { mix1_rwkv_prep(C, da, l); mix1_fourier1(C); } }
        SEAM(b + 2);
        if (INP(11, b + 3)) for (int rep = 0; rep < NREP(11); ++rep) { MKCTX(); phase_rwkv1(C);
            if (C.wg >= 8 * RW_NSC) {
                Ctx C2 = C; C2.wg = C.wg - 8 * RW_NSC; C2.G = C.G - 8 * RW_NSC; C2.gw = C2.wg * NWAVES + C.wave; C2.NGW = C2.G * NWAVES;
                mix1_rope(C2); mix1_vt(C2); } }
        SEAM(b + 3);
        if (INP(4, b + 4)) for (int rep = 0; rep < NREP(4); ++rep) { MKCTX(); phase_mix2(C, da, l); }
        SEAM(b + 4);
        if (INP(5, b + 5)) for (int rep = 0; rep < NREP(5); ++rep) { MKCTX(); phase_mix3(C, da, l); }
        SEAM(b + 5);
        if (INP(6, b + 6)) { MKCTX();
            if (l < DEPTH - 1) outproj_ctx(C, l, mod_ctx + 2 * DM);
            pg8::StaticOrder S; S.init(WS_MIX + (size_t)NCTX * DM * 2, WS_WOUT + (size_t)l * DM * DM * 2, SEQ, DM, DM, C.G, C.wg);
            pg8::EpiResidual E{(float*)(C.ws + WS_XS) + (size_t)NCTX * DM, DM, mod_lat + 2 * DM, mod_lat + 2 * DM};
            pg8::gemm_phase<pg8::EpiResidual, pg8::StaticOrder, true, true>(C.lds, C.tid, DM, S, E, C.ws);
        }
        SEAM(b + 6);
        if (INP(7, b + 7)) for (int rep = 0; rep < NREP(7); ++rep) { MKCTX(); phase_norm2(C, da, l); }
        SEAM(b + 7);
        if (INP(8, b + 8)) for (int rep = 0; rep < NREP(8); ++rep) { MKCTX(); phase_gather(C, da, l); }
        SEAM(b + 8);
        if (INP(9, b + 9)) for (int rep = 0; rep < NREP(9); ++rep) { MKCTX();
            const int nblk = moe_tables(C);
            pg8::MoeOrder S{(unsigned)WS_XG8, (unsigned)(WS_WGU + (size_t)l * 32 * 2048 * DM), 256u * DM, 2048u * DM,
                            (const LAS unsigned char*)(C.lds + MISC_OFF + 1024), nblk, 8, C.G, C.wg};
            pg8::EpiSwiglu E{(bf16*)(C.ws + WS_ACT8), DM, da.in[I_BGU] + (size_t)l * 32 * 2048, 2048, pg8::X8_S * pg8::W8_S, 1.0f / (pg8::X8_S * pg8::W8_S)};
            pg8::gemm_phase<pg8::EpiSwiglu, pg8::MoeOrder, true, true, 1>(C.lds, C.tid, DM, S, E, C.ws);
        }
        SEAM(b + 9);
        if (INP(10, b + 10)) for (int rep = 0; rep < NREP(10); ++rep) { MKCTX();
            const int nblk = moe_tables(C);
            pg8::MoeOrder S{(unsigned)WS_ACT8, (unsigned)(WS_WDN + (size_t)l * 32 * DM * DM), 256u * DM, (unsigned)(DM * DM),
                            (const LAS unsigned char*)(C.lds + MISC_OFF + 1024), nblk, 4, C.G, C.wg};
            pg8::EpiStoreBf16 E{(bf16*)(C.ws + WS_XG), DM, da.in[I_BDN] + (size_t)l * 32 * DM, DM, pg8::ACT_S * pg8::W8_S, 1.0f / (pg8::ACT_S * pg8::W8_S)};
            pg8::gemm_phase<pg8::EpiStoreBf16, pg8::MoeOrder, true, true, 1>(C.lds, C.tid, DM, S, E, C.ws);
        }
        SEAM(b + 10);
    }
    if (INP(99, PH_TOTAL - 1)) for (int rep = 0; rep < NREP(99); ++rep) { MKCTX(); phase_final(C, da); }
#undef IN
#undef INP
#undef SEAM
}

typedef void (*kern_t)(Args);
static kern_t kern_of(int o) {
#if MK_SINGLE
    (void)o; return mega<-1>;
#else
    switch (o) { case 0: return mega<0>; case 1: return mega<1>; case 2: return mega<2>; case 3: return mega<3>; case 4: return mega<4>; case 5: return mega<5>; case 6: return mega<6>;
                 case 7: return mega<7>; case 8: return mega<8>; case 9: return mega<9>; case 10: return mega<10>; case 11: return mega<11>; case 99: return mega<99>;
                 default: return mega<0>;
    }
#endif
}
extern "C" void kernel_launch(void* const* d_in, const int* in_sizes, int n_in, void* d_out, int out_size, void* d_ws, size_t ws_size, hipStream_t stream) {
    static int ready = 0;
    if (ready == 0) {
        if (n_in != 31 || out_size != SEQ * DM || ws_size < WS_END) { fprintf(stderr, "kernel_launch: unexpected shapes (n_in %d, out %d, ws %zu)\n", n_in, out_size, ws_size); ready = -1; return; }
        const int ids[14] = {0, 1, 2, 3, 4, 5, 6, 7, 8, 9, 10, 11, 99, -1};
        for (int i = 0; i < (MK_SINGLE ? 14 : 13); ++i) { if (MK_SINGLE && ids[i] != -1) continue;
            if (hipFuncSetAttribute((const void*)kern_of(ids[i]), hipFuncAttributeMaxDynamicSharedMemorySize, LDS_BYTES) != hipSuccess) { fprintf(stderr, "kernel_launch: hipFuncSetAttribute failed (%d)\n", ids[i]); ready = -1; return; } }
        ready = 1;
    }
    if (ready < 0) return;
    (void)hipMemsetAsync((char*)d_ws + WS_CTL, 0, CTL_ZERO_BYTES, stream);
    Args a{};
    for (int i = 0; i < 31; ++i) a.in[i] = (const float*)d_in[i];
    a.out = (float*)d_out; a.ws = (unsigned char*)d_ws; a.pad = 0;
#if MK_SINGLE
    a.ph_lo = 0; a.ph_hi = PH_TOTAL; a.use_bar = 1;
    hipLaunchKernelGGL(kern_of(-1), dim3(NWG), dim3(NTHR), LDS_BYTES, stream, a);
#else
    for (int p = 0; p < PH_TOTAL; ++p) { a.ph_lo = p; a.ph_hi = p + 1; a.use_bar = 0;
        const int j = (p - 1) % NPL; const int o = (p == 0) ? 0 : (p == PH_TOTAL - 1) ? 99 : (j < 3 ? 1 + j : j == 3 ? 11 : j);
        hipLaunchKernelGGL(kern_of(o), dim3(NWG), dim3(NTHR), LDS_BYTES, stream, a); }
#endif
}
```

```cpp
#include <hip/hip_runtime.h>
#include <cstdio>
#include <cstdint>

#define LAS __attribute__((address_space(3)))
typedef unsigned short bf16;
typedef float f32x4 __attribute__((ext_vector_type(4)));
typedef float f32x2 __attribute__((ext_vector_type(2)));
typedef short bf16x8 __attribute__((ext_vector_type(8)));
typedef unsigned u32x4 __attribute__((ext_vector_type(4)));
typedef unsigned u32x2 __attribute__((ext_vector_type(2)));

constexpr int DM = 1024, SEQ = 16384, NCTX = 256, ROWS = SEQ + NCTX, DEPTH = 4, GRIDW = 64;
constexpr int INW = 2720, INWP = 2816;
constexpr int C_AQ = 0, C_AK = 256, C_AV = 384, C_BU = 512, C_CQ = 768, C_CK = 1024, C_CV = 1280, C_DR = 1536, C_DK = 1792, C_DV = 2048, C_WL = 2304, C_AL = 2432, C_GL = 2560;
constexpr int NEXP = 32, TOPK = 4;
constexpr int MOE_MAXBLK = 296;
constexpr int MOE_ROWS = MOE_MAXBLK * 256;
constexpr int NWG = 256, NTHR = 512, NWAVES = 8;
constexpr int VTP = ROWS + 256;

constexpr size_t MiB = 1u << 20;
constexpr size_t WS_CTL = 0, CTL_ZERO_BYTES = 1 * MiB;
constexpr size_t WS_MOD = 1 * MiB;
constexpr size_t WS_TW = 2 * MiB;
constexpr size_t WS_MTAB = 3 * MiB;
constexpr size_t WS_XS = 4 * MiB;
constexpr size_t WS_H = 70 * MiB;
constexpr size_t WS_P = 104 * MiB;
constexpr size_t WS_MIX = 194 * MiB;
constexpr size_t WS_FYR = 228 * MiB, WS_FYI = 244 * MiB;
constexpr size_t WS_VTA = 1544 * MiB, WS_VTC = 1550 * MiB;
constexpr size_t WS_SC = 260 * MiB;
constexpr size_t WS_YS = 408 * MiB;
constexpr size_t WS_ROUTE = 442 * MiB;
constexpr size_t WS_CNT = 444 * MiB;
constexpr size_t WS_XG = 446 * MiB;
constexpr size_t WS_ACT = 596 * MiB;
constexpr size_t WS_XG8 = WS_ACT, WS_ACT8 = WS_ACT + 75 * MiB;
constexpr size_t WS_WIN = 746 * MiB;
constexpr size_t WS_WOUT = 768 * MiB;
constexpr size_t WS_WGU = 776 * MiB;
constexpr size_t WS_WDN = 1288 * MiB;
constexpr size_t WS_RPP = 1560 * MiB, WS_PSC = 1578 * MiB, WS_LSC = 1580 * MiB, WS_HSC = 1584 * MiB;
constexpr size_t WS_FTAB = 1586 * MiB;
constexpr size_t WS_G2T = 1588 * MiB, WS_RWT = 1589 * MiB;
constexpr size_t WS_LORAT = 1590 * MiB;
constexpr size_t WS_F256 = 1591 * MiB;

constexpr size_t WS_END = 1592 * MiB;
static_assert(WS_XS + (size_t)ROWS * DM * 4 <= WS_H && WS_H + (size_t)ROWS * DM * 2 <= WS_P && WS_P + (size_t)ROWS * INWP * 2 <= WS_MIX && WS_MIX + (size_t)ROWS * DM * 2 <= WS_FYR, "ws map 1");
static_assert(WS_SC + (size_t)ROWS * 9 * 256 * 4 <= WS_YS && WS_YS + (size_t)2 * ROWS * 256 * 4 <= WS_ROUTE && WS_XG + (size_t)MOE_ROWS * DM * 2 <= WS_ACT && WS_ACT + (size_t)MOE_ROWS * DM * 2 <= WS_WIN, "ws map 2");
static_assert(WS_WIN + (size_t)4 * INWP * DM * 2 <= WS_WOUT && WS_WGU + (size_t)4 * 32 * 2048 * 1024 * 2 <= WS_WDN && WS_WDN + (size_t)4 * 32 * 1024 * 1024 * 2 <= WS_END, "ws map 3");
constexpr int CW_BAR = 4096;
constexpr int CW_WQ = 16384;

constexpr int RING_BYTES = 131072;
constexpr int MISC_OFF = 143360;
constexpr int LDS_BYTES = 147456;

__device__ __forceinline__ unsigned f2bf(float f) { unsigned u = __builtin_bit_cast(unsigned, f); return (u + 0x7fffu + ((u >> 16) & 1u)) >> 16; }
__device__ __forceinline__ unsigned pk2(float lo, float hi) { return f2bf(lo) | (f2bf(hi) << 16); }
__device__ __forceinline__ float bf2f(unsigned short b) { return __builtin_bit_cast(float, (unsigned)b << 16); }
__device__ __forceinline__ float bflo(unsigned w) { return __builtin_bit_cast(float, w << 16); }
__device__ __forceinline__ float bfhi(unsigned w) { return __builtin_bit_cast(float, w & 0xffff0000u); }
__device__ __forceinline__ float shx(float v, int o, int lane) { return __builtin_bit_cast(float, __builtin_amdgcn_ds_bpermute((lane ^ o) << 2, __builtin_bit_cast(int, v))); }
__device__ __forceinline__ int shxi(int v, int o, int lane) { return __builtin_amdgcn_ds_bpermute((lane ^ o) << 2, v); }
__device__ __forceinline__ float dpp_ror(float v, int ctrl_unused);
#define DPP_ROR_ADD(v, n) v += __builtin_bit_cast(float, __builtin_amdgcn_update_dpp(0, __builtin_bit_cast(int, v), 0x120 + (n), 0xf, 0xf, false))
__device__ __forceinline__ float wave_sum(float v, int lane) {
    DPP_ROR_ADD(v, 8); DPP_ROR_ADD(v, 4); DPP_ROR_ADD(v, 2); DPP_ROR_ADD(v, 1);
    v += shx(v, 16, lane); v += shx(v, 32, lane);
    return v;
}
__device__ __forceinline__ float sigmoidf_(float x) { return 1.f / (1.f + __expf(-x)); }
#define LDS_WAIT() asm volatile("s_waitcnt lgkmcnt(0)" ::: "memory")
#define VM_WAIT() asm volatile("s_waitcnt vmcnt(0)" ::: "memory")

namespace pg8 {
#define PG8_LAS __attribute__((address_space(3)))
typedef unsigned short bf16_t;
constexpr int BM = 256, BK = 64, HALF = 128, HTB = HALF * BK * 2, STAGE_BYTES = 8 * HTB, NXCD = 8, WGM = 8;
__host__ __device__ __forceinline__ int lds_byte(int r, int c) { const int st = (r >> 4) * 2 + (c >> 5), rr = r & 15, cc = c & 31, ob = rr * 64 + cc * 2; return st * 1024 + (ob ^ (((ob >> 9) & 1) << 5)); }
__host__ __device__ __forceinline__ void stage_rc(int b, int& R, int& C) { const int st = b / 1024, sb = b % 1024, swz = sb ^ (((sb >> 9) & 1) << 5); R = (st >> 1) * 16 + swz / 64; C = (st & 1) * 32 + (swz % 64) / 2; }
__host__ __device__ __forceinline__ int perm32(int rho) { const int n = rho >> 4, i = rho & 15; return 8 * (i >> 2) + 4 * n + (i & 3); }
struct Unit { int pm, pn, e; };
typedef int v8i __attribute__((ext_vector_type(8))); typedef int v4i __attribute__((ext_vector_type(4)));
__device__ __forceinline__ v8i cat8(bf16x8 a, bf16x8 b) { const v4i x = __builtin_bit_cast(v4i, a), y = __builtin_bit_cast(v4i, b); return __builtin_shufflevector(x, y, 0, 1, 2, 3, 4, 5, 6, 7); }
__device__ __forceinline__ unsigned cvt_pk_bf16(float lo, float hi) { unsigned r; asm volatile("v_cvt_pk_bf16_f32 %0, %1, %2" : "=v"(r) : "v"(lo), "v"(hi)); return r; }

struct StaticOrder {
    unsigned A, Bt, tstep;
    int nM, nN, nwg, G, c;
    __device__ void init(size_t A_, size_t Bt_, int M, int N, int K, int G_, int c_) { A = (unsigned)A_; Bt = (unsigned)Bt_; tstep = (unsigned)(BM * K * 2); nM = M / BM; nN = N / BM; nwg = nM * nN; G = G_; c = c_; }
    __device__ bool next(int i, Unit& u) const {
        const long L = (long)i * G + c; if (L >= nwg) return false;
        int wgid = (int)L; { const int q = nwg / NXCD, r = nwg % NXCD, xcd = wgid % NXCD, off = wgid / NXCD; wgid = (xcd < r ? xcd * (q + 1) : r * (q + 1) + (xcd - r) * q) + off; }
        const int nig = WGM * nN, gid = wgid / nig, fm = gid * WGM, gsz = (nM - fm) < WGM ? (nM - fm) : WGM;
        u.pm = fm + ((wgid % nig) % gsz); u.pn = (wgid % nig) / gsz; u.e = 0; return true;
    }
    __device__ __forceinline__ unsigned pa(const Unit& u) const { return A + (unsigned)u.pm * tstep; }
    __device__ __forceinline__ unsigned pb(const Unit& u) const { return Bt + (unsigned)u.pn * tstep; }
};
struct MoeOrder {
    unsigned A, Bt, tstep, estep;
    const LAS unsigned char* blk_e; int nblk, nN, G, c;
    __device__ bool next(int i, Unit& u) const {
        const int L = i * G + c; if (L >= nblk * nN) return false;
        u.pm = L / nN; u.pn = L % nN; u.e = __builtin_amdgcn_readfirstlane((int)blk_e[u.pm]); return true;
    }
    __device__ __forceinline__ unsigned pa(const Unit& u) const { return A + (unsigned)u.pm * tstep; }
    __device__ __forceinline__ unsigned pb(const Unit& u) const { return Bt + (unsigned)u.e * estep + (unsigned)u.pn * tstep; }
};

struct EpiStoreBf16 {
    static constexpr bool PERM = true;
    bf16_t* O; int ldc; const float* bias; int bias_estride; float bias_scale, acc_scale;
    __device__ __forceinline__ void init(f32x4 (&acc)[2][2][4][2], const Unit& u, int wc, int fq) const {
        const int col0 = u.pn * BM + wc * 32 + 8 * fq;
#pragma unroll
        for (int b = 0; b < 2; ++b)
#pragma unroll
            for (int n = 0; n < 2; ++n) { const f32x4 bv = bias ? *(const f32x4*)(bias + (size_t)u.e * bias_estride + col0 + b * HALF + 4 * n) * bias_scale : (f32x4){0.f, 0.f, 0.f, 0.f};
#pragma unroll
                for (int a = 0; a < 2; ++a)
#pragma unroll
                    for (int m = 0; m < 4; ++m) { f32x4 t = bv; asm volatile("" : "+v"(t)); acc[a][b][m][n] = t; } }
    }
    __device__ __forceinline__ void operator()(const f32x4 (&acc)[2][2][4][2], const Unit& u, int wr, int wc, int fr, int fq) const {
        const int row0 = u.pm * BM + wr * 64 + fr, col0 = u.pn * BM + wc * 32 + 8 * fq;
#pragma unroll
        for (int ai = 0; ai < 2; ++ai)
#pragma unroll
            for (int m = 0; m < 4; ++m) { bf16_t* rowp = O + (size_t)(row0 + ai * HALF + m * 16) * ldc + col0;
#pragma unroll
                for (int bj = 0; bj < 2; ++bj) { const f32x4 v0 = acc[ai][bj][m][0] * acc_scale, v1 = acc[ai][bj][m][1] * acc_scale;
                    u32x4 w; w.x = cvt_pk_bf16(v0[0], v0[1]); w.y = cvt_pk_bf16(v0[2], v0[3]); w.z = cvt_pk_bf16(v1[0], v1[1]); w.w = cvt_pk_bf16(v1[2], v1[3]);
                    *(u32x4*)(rowp + bj * HALF) = w; }
                asm volatile("" ::: "memory"); }
    }
};
__device__ __forceinline__ float swiglu1(float g, float up) {
    g = fminf(g, 7.0f); up = fminf(fmaxf(up, -7.0f), 7.0f);
    return g * (1.f / (1.f + __expf(-1.702f * g))) * (up + 1.0f);
}
constexpr float X8_S = 8.0f, W8_S = 256.0f, ACT_S = 4.0f;
struct EpiSwiglu {
    static constexpr bool PERM = true;
    bf16_t* O; int ldc; const float* bias; int bias_estride; float bias_scale, acc_scale;
    __device__ __forceinline__ void init(f32x4 (&acc)[2][2][4][2], const Unit& u, int wc, int fq) const {
        const int col0 = u.pn * BM + wc * 32 + 8 * fq;
#pragma unroll
        for (int b = 0; b < 2; ++b)
#pragma unroll
            for (int n = 0; n < 2; ++n) { const f32x4 bv = bias ? *(const f32x4*)(bias + (size_t)u.e * bias_estride + col0 + b * HALF + 4 * n) * bias_scale : (f32x4){0.f, 0.f, 0.f, 0.f};
#pragma unroll
                for (int a = 0; a < 2; ++a)
#pragma unroll
                    for (int m = 0; m < 4; ++m) { f32x4 t = bv; asm volatile("" : "+v"(t)); acc[a][b][m][n] = t; } }
    }
    __device__ __forceinline__ void operator()(const f32x4 (&acc)[2][2][4][2], const Unit& u, int wr, int wc, int fr, int fq) const {
        const int row0 = u.pm * BM + wr * 64 + fr, col0 = u.pn * BM + wc * 32 + 8 * fq;
#pragma unroll
        for (int ai = 0; ai < 2; ++ai)
#pragma unroll
            for (int m = 0; m < 4; ++m) { unsigned char* rowp = (unsigned char*)O + (size_t)(row0 + ai * HALF + m * 16) * ldc + (col0 >> 1);
#pragma unroll
                for (int bj = 0; bj < 2; ++bj) { const f32x4 v0 = acc[ai][bj][m][0] * acc_scale, v1 = acc[ai][bj][m][1] * acc_scale;
                    unsigned w = 0; w = __builtin_amdgcn_cvt_pk_fp8_f32(swiglu1(v0[0], v0[1]) * ACT_S, swiglu1(v0[2], v0[3]) * ACT_S, w, false); w = __builtin_amdgcn_cvt_pk_fp8_f32(swiglu1(v1[0], v1[1]) * ACT_S, swiglu1(v1[2], v1[3]) * ACT_S, w, true);
                    *(unsigned*)(rowp + bj * (HALF / 2)) = w; }
                asm volatile("" ::: "memory"); }
    }
};
struct EpiResidual {
    static constexpr bool PERM = false;
    float* X; int ldc; const float* gate_lat; const float* gate_ctx;
    __device__ __forceinline__ void init(f32x4 (&acc)[2][2][4][2], const Unit& u, int wc, int fq) const {
#pragma unroll
        for (int a = 0; a < 2; ++a)
#pragma unroll
            for (int b = 0; b < 2; ++b)
#pragma unroll
                for (int m = 0; m < 4; ++m)
#pragma unroll
                    for (int n = 0; n < 2; ++n) acc[a][b][m][n] = (f32x4){0.f, 0.f, 0.f, 0.f};
    }
    __device__ __forceinline__ void operator()(const f32x4 (&acc)[2][2][4][2], const Unit& u, int wr, int wc, int fr, int fq) const {
        const int row0 = u.pm * BM + wr * 64 + fr, col0 = u.pn * BM + wc * 32 + 4 * fq;
        const float* gp = (u.pm == 0) ? gate_ctx : gate_lat;
        f32x4 gv[2][2];
#pragma unroll
        for (int bj = 0; bj < 2; ++bj)
#pragma unroll
            for (int n = 0; n < 2; ++n) gv[bj][n] = *(const f32x4*)(gp + col0 + bj * HALF + n * 16);
#pragma unroll
        for (int ai = 0; ai < 2; ++ai)
#pragma unroll
            for (int m = 0; m < 4; ++m) { float* rowp = X + (size_t)(row0 + ai * HALF + m * 16) * ldc + col0;
#pragma unroll
                for (int bj = 0; bj < 2; ++bj)
#pragma unroll
                    for (int n = 0; n < 2; ++n) { f32x4* p = (f32x4*)(rowp + bj * HALF + n * 16); *p = *p + gv[bj][n] * acc[ai][bj][m][n]; }
                asm volatile("" ::: "memory"); }
    }
};
template <class Epi, class Sched, bool ALIGN_EPI = false, bool SP2 = false, int ES = 2>
__device__ __forceinline__ void gemm_phase(PG8_LAS unsigned char* lds, const int tid, const int K, const Sched& S, const Epi& E, const void* wsbase) {
    const __amdgpu_buffer_rsrc_t rsrc = __builtin_amdgcn_make_buffer_rsrc((void*)wsbase, 0, 0x7fffffff, 0x00020000);
    const int wid = __builtin_amdgcn_readfirstlane(tid >> 6), lane = tid & 63, wr = wid >> 2, wc = wid & 3, fr = lane & 15, fq = lane >> 4;
    const int nt = (K * ES) / 128;
    unsigned voffA[2], voffB[2];
#pragma unroll
    for (int i = 0; i < 2; ++i) { int R, C; stage_rc(tid * 16 + i * 8192, R, C); const int Rb = Epi::PERM ? ((R & ~31) + perm32(R & 31)) : R;
        voffA[i] = (unsigned)(R * K * ES + C * 2); voffB[i] = (unsigned)(Rb * K * ES + C * 2); }
    const unsigned kstep = (unsigned)(BK * 2);
    const unsigned hstep = (unsigned)(HALF * K * ES);
        const unsigned ldsw = (unsigned)wid * 1024u;
    const int aoff = lds_byte(wr * 64 + fr, ES == 2 ? fq * 8 : fq * 16), boff = lds_byte(wc * 32 + fr, ES == 2 ? fq * 8 : fq * 16); constexpr int KOFF = (ES == 2) ? 1024 : 16;
#define PG8_SA(b, h) (((b) * 2 + (h)) * HTB)
#define PG8_SB(b, h) ((4 + (b) * 2 + (h)) * HTB)
#define PG8_STAGE(bufoff, gbase, voff) do { _Pragma("unroll") for (int _i = 0; _i < 2; ++_i) \
        __builtin_amdgcn_raw_ptr_buffer_load_lds(rsrc, (PG8_LAS unsigned*)(lds + (bufoff) + ldsw + _i * 8192), 16, (voff)[_i], (gbase), 0, 0); } while (0)
#define PG8_LDA(dst, b, h) do { _Pragma("unroll") for (int m = 0; m < 4; ++m) _Pragma("unroll") for (int k = 0; k < 2; ++k) dst[m][k] = *(const PG8_LAS bf16x8*)(lds + PG8_SA(b, h) + aoff + m * 2048 + k * KOFF); } while (0)
#define PG8_LDA8(dst, b, h) do { _Pragma("unroll") for (int m = 0; m < 4; ++m) { const PG8_LAS v4i* p_ = (const PG8_LAS v4i*)(lds + PG8_SA(b, h) + aoff + m * 2048); const v4i x_ = p_[0], y_ = p_[1]; dst[m] = __builtin_shufflevector(x_, y_, 0, 1, 2, 3, 4, 5, 6, 7); } } while (0)
#define PG8_LDB(dst, b, h) do { _Pragma("unroll") for (int n = 0; n < 2; ++n) _Pragma("unroll") for (int k = 0; k < 2; ++k) dst[n][k] = *(const PG8_LAS bf16x8*)(lds + PG8_SB(b, h) + boff + n * 2048 + k * KOFF); } while (0)
#define PG8_LDB8(dst, b, h) do { _Pragma("unroll") for (int n = 0; n < 2; ++n) { const PG8_LAS v4i* p_ = (const PG8_LAS v4i*)(lds + PG8_SB(b, h) + boff + n * 2048); const v4i x_ = p_[0], y_ = p_[1]; dst[n] = __builtin_shufflevector(x_, y_, 0, 1, 2, 3, 4, 5, 6, 7); } } while (0)
#define PG8_MMA(ai, bj, At, Bt) do { __builtin_amdgcn_s_setprio(1); _Pragma("unroll") for (int m = 0; m < 4; ++m) _Pragma("unroll") for (int n = 0; n < 2; ++n) { \
        if constexpr (ES == 2) { _Pragma("unroll") for (int k = 0; k < 2; ++k) acc[ai][bj][m][n] = __builtin_amdgcn_mfma_f32_16x16x32_bf16(Bt[n][k], At[m][k], acc[ai][bj][m][n], 0, 0, 0); } \
        else asm volatile("v_mfma_f32_16x16x128_f8f6f4 %0, %1, %2, %0" : "+v"(acc[ai][bj][m][n]) : "v"(Bt##8[n]), "v"(At##8[m])); } \
        __builtin_amdgcn_s_setprio(0); } while (0)
#define PG8_LDAX(b, h) do { if constexpr (ES == 2) PG8_LDA(At, b, h); else PG8_LDA8(At8, b, h); } while (0)
#define PG8_LDBX(B, b, h) do { if constexpr (ES == 2) PG8_LDB(B, b, h); else PG8_LDB8(B##8, b, h); } while (0)
#define PG8_WAIT_V(n) asm volatile("s_waitcnt vmcnt(" #n ")" ::: "memory")
#define PG8_WAIT_L(n) asm volatile("s_waitcnt lgkmcnt(" #n ")" ::: "memory")
#define PG8_BAR __builtin_amdgcn_s_barrier()
#define PG8_SCHED __builtin_amdgcn_sched_barrier(0)
    Unit cur, nxt; int ui = 0;
    if (!S.next(0, cur)) return;
    f32x4 acc[2][2][4][2];
    E.init(acc, cur, wc, fq);
    bf16x8 At[4][2], B0[2][2], B1[2][2]; v8i At8[4], B08[2], B18[2];
    unsigned cA = S.pa(cur), cB = S.pb(cur);
    if constexpr (SP2) {
        PG8_STAGE(PG8_SB(0, 0), cB, voffB); PG8_STAGE(PG8_SB(0, 1), cB + hstep, voffB); PG8_STAGE(PG8_SA(0, 0), cA, voffA); PG8_STAGE(PG8_SA(0, 1), cA + hstep, voffA);
        if (wr == 1) PG8_BAR;
        PG8_WAIT_V(2); PG8_BAR;
        PG8_STAGE(PG8_SB(1, 0), cB + kstep, voffB); PG8_STAGE(PG8_SA(1, 0), cA + kstep, voffA); PG8_STAGE(PG8_SB(1, 1), cB + hstep + kstep, voffB);
        PG8_WAIT_V(6); PG8_BAR;
    } else {
        PG8_STAGE(PG8_SB(0, 0), cB, voffB); PG8_STAGE(PG8_SA(0, 0), cA, voffA); PG8_STAGE(PG8_SB(0, 1), cB + hstep, voffB); PG8_STAGE(PG8_SA(0, 1), cA + hstep, voffA);
        if (wr == 1) PG8_BAR;
        PG8_WAIT_V(4); PG8_BAR;
        PG8_STAGE(PG8_SB(1, 0), cB + kstep, voffB); PG8_STAGE(PG8_SA(1, 0), cA + kstep, voffA); PG8_STAGE(PG8_SB(1, 1), cB + hstep + kstep, voffB);
        PG8_WAIT_V(6); PG8_BAR;
    }
    for (;;) {
        const bool has_next = S.next(ui + 1, nxt);
        const unsigned nA = has_next ? S.pa(nxt) : cA, nB = has_next ? S.pb(nxt) : cB;
        for (int t = 0; t < nt; t += 2) {
            const bool last = (t == nt - 2);
            const unsigned a1 = cA + (unsigned)(t + 1) * kstep;
            const unsigned a2 = last ? nA : cA + (unsigned)(t + 2) * kstep, b2 = last ? nB : cB + (unsigned)(t + 2) * kstep;
            const unsigned a3 = a2 + kstep, b3 = b2 + kstep;
            if constexpr (SP2) {
            PG8_LDBX(B0, 0, 0); PG8_LDBX(B1, 0, 1); PG8_SCHED; PG8_LDAX(0, 0); PG8_STAGE(PG8_SA(1, 1), a1 + hstep, voffA);
            PG8_WAIT_V(8); PG8_WAIT_L(0); PG8_BAR; PG8_MMA(0, 0, At, B0); PG8_MMA(0, 1, At, B1); PG8_BAR; PG8_SCHED;
            PG8_LDAX(0, 1); PG8_STAGE(PG8_SB(0, 0), b2, voffB); PG8_STAGE(PG8_SB(0, 1), b2 + hstep, voffB); PG8_STAGE(PG8_SA(0, 0), a2, voffA);
            PG8_WAIT_V(8); PG8_WAIT_L(0); PG8_BAR; PG8_MMA(1, 0, At, B0); PG8_MMA(1, 1, At, B1); PG8_BAR; PG8_SCHED;
            PG8_LDBX(B0, 1, 0); PG8_LDBX(B1, 1, 1); PG8_SCHED; PG8_LDAX(1, 0); PG8_STAGE(PG8_SA(0, 1), a2 + hstep, voffA);
            PG8_WAIT_V(8); PG8_WAIT_L(0); PG8_BAR; PG8_MMA(0, 0, At, B0); PG8_MMA(0, 1, At, B1); PG8_BAR; PG8_SCHED;
            PG8_LDAX(1, 1); PG8_STAGE(PG8_SB(1, 0), b3, voffB); PG8_STAGE(PG8_SB(1, 1), b3 + hstep, voffB); PG8_STAGE(PG8_SA(1, 0), a3, voffA);
            PG8_WAIT_V(8); PG8_WAIT_L(0); PG8_BAR; PG8_MMA(1, 0, At, B0); PG8_MMA(1, 1, At, B1); PG8_BAR; PG8_SCHED;
            } else {
            PG8_LDBX(B0, 0, 0); PG8_SCHED; PG8_LDAX(0, 0); PG8_STAGE(PG8_SA(1, 1), a1 + hstep, voffA);
            PG8_WAIT_L(8); PG8_BAR; PG8_WAIT_L(0); PG8_MMA(0, 0, At, B0); PG8_BAR; PG8_SCHED;
            PG8_LDBX(B1, 0, 1); PG8_STAGE(PG8_SB(0, 0), b2, voffB);
            PG8_BAR; PG8_WAIT_L(0); PG8_MMA(0, 1, At, B1); PG8_BAR;
            PG8_LDAX(0, 1); PG8_STAGE(PG8_SA(0, 0), a2, voffA);
            PG8_BAR; PG8_WAIT_L(0); PG8_MMA(1, 0, At, B0); PG8_BAR; PG8_SCHED;
            PG8_STAGE(PG8_SB(0, 1), b2 + hstep, voffB);
            PG8_WAIT_V(6); PG8_BAR; PG8_MMA(1, 1, At, B1); PG8_BAR;
            PG8_LDBX(B0, 1, 0); PG8_SCHED; PG8_LDAX(1, 0); PG8_STAGE(PG8_SA(0, 1), a2 + hstep, voffA);
            PG8_WAIT_L(8); PG8_BAR; PG8_WAIT_L(0); PG8_MMA(0, 0, At, B0); PG8_BAR; PG8_SCHED;
            PG8_LDBX(B1, 1, 1); PG8_STAGE(PG8_SB(1, 0), b3, voffB);
            PG8_BAR; PG8_WAIT_L(0); PG8_MMA(0, 1, At, B1); PG8_BAR;
            PG8_LDAX(1, 1); PG8_STAGE(PG8_SA(1, 0), a3, voffA);
            PG8_BAR; PG8_WAIT_L(0); PG8_MMA(1, 0, At, B0); PG8_BAR; PG8_SCHED;
            PG8_STAGE(PG8_SB(1, 1), b3 + hstep, voffB);
            PG8_WAIT_V(6); PG8_BAR; PG8_MMA(1, 1, At, B1); PG8_BAR;
            }
        }
        if constexpr (ALIGN_EPI) { if (wr == 0) PG8_BAR; }
        if constexpr (ES == 1) asm volatile("s_nop 15\n\ts_nop 15" ::: "memory");
        E(acc, cur, wr, wc, fr, fq);
        if (!has_next) break;
        E.init(acc, nxt, wc, fq);
        cur = nxt; cA = nA; cB = nB; ++ui;
        if constexpr (ALIGN_EPI) { if (wr == 1) PG8_BAR; }
    }
    PG8_WAIT_V(0);
    if constexpr (!ALIGN_EPI) { if (wr == 0) PG8_BAR; }
    PG8_BAR;
#undef PG8_SA
#undef PG8_SB
#undef PG8_STAGE
#undef PG8_LDA
#undef PG8_LDA8
#undef PG8_LDB8
#undef PG8_LDAX
#undef PG8_LDBX
#undef PG8_LDB
#undef PG8_MMA
#undef PG8_WAIT_V
#undef PG8_WAIT_L
#undef PG8_BAR
#undef PG8_SCHED
}
}

#define XB_TMO      128
#define XB_XCNT(j)  (256  + 64 * (j))
#define XB_XSUB(j)  (1280 + 64 * (j))
#define XB_XGEN(j)  (2304 + 64 * (j))
#define XB_TOP      3328
#define XB_TOPGEN   3392
#define XCD_BAR_WORDS 3456
#define XB_SPIN_CAP (1u << 18)
__device__ __forceinline__ unsigned xb_ld(unsigned* p)              { return __hip_atomic_load(p, __ATOMIC_RELAXED, __HIP_MEMORY_SCOPE_AGENT); }
__device__ __forceinline__ unsigned xb_add(unsigned* p, unsigned v) { return __hip_atomic_fetch_add(p, v, __ATOMIC_RELAXED, __HIP_MEMORY_SCOPE_AGENT); }
__device__ __forceinline__ unsigned xb_xcc_id() { return (unsigned)__builtin_amdgcn_s_getreg((3 << 11) | 20) & 0xFu; }
#define XB_SPIN(cond, bar) do { unsigned _sp = 0; while (cond) { __builtin_amdgcn_s_sleep(1); \
    if ((++_sp & 255u) == 0u) { if (xb_ld(&(bar)[XB_TMO])) break; if (_sp > XB_SPIN_CAP) { atomicAdd(&(bar)[XB_TMO], 1u); break; } } } } while (0)

struct XcdBarrier {
    unsigned* bar; unsigned x;
    volatile LAS unsigned* st;
};

__device__ __forceinline__ XcdBarrier xcd_barrier_post(unsigned* bar, volatile LAS unsigned* st) {
    XcdBarrier b; b.bar = bar; b.x = xb_xcc_id(); b.st = st;
    if (threadIdx.x == 0) (void)xb_add(&bar[XB_XCNT(b.x)], 1u);
    return b;
}
__device__ __forceinline__ void xcd_barrier_complete(unsigned* bar, unsigned x, unsigned& nloc, unsigned& nx) {
    const unsigned G = gridDim.x * gridDim.y * gridDim.z;
    unsigned sum, cnt, mine, sp = 0u;
    for (;;) {
        sum = 0u; cnt = 0u; mine = 0u;
#pragma unroll
        for (unsigned j = 0; j < 16; ++j) { const unsigned c = xb_ld(&bar[XB_XCNT(j)]); sum += c; cnt += (c > 0u) ? 1u : 0u; mine = (j == x) ? c : mine; }
        if (sum == G) break;
        __builtin_amdgcn_s_sleep(1);
        if ((++sp & 255u) == 0u) { if (xb_ld(&bar[XB_TMO])) break; if (sp > XB_SPIN_CAP) { atomicAdd(&bar[XB_TMO], 1u); break; } }
    }
    nloc = mine > 0u ? mine : 1u; nx = cnt > 0u ? cnt : 1u;
}

__device__ __forceinline__ void xcd_barrier(const XcdBarrier& b) {
    asm volatile("s_waitcnt vmcnt(0)" ::: "memory");
    __syncthreads();
    if (threadIdx.x == 0) {
        unsigned* bar = b.bar;
        __builtin_amdgcn_s_waitcnt(0);
        unsigned nloc = b.st[0], nx = b.st[1];
        if (nloc == 0u) { xcd_barrier_complete(bar, b.x, nloc, nx); b.st[0] = nloc; b.st[1] = nx; }
        const unsigned old = xb_add(&bar[XB_XSUB(b.x)], 1u);
        const unsigned gen = old / nloc;
        if (old + 1u == (gen + 1u) * nloc) {
            __builtin_amdgcn_fence(__ATOMIC_RELEASE, "agent");
            asm volatile("s_waitcnt vmcnt(0)" ::: "memory");
            const unsigned og = xb_add(&bar[XB_TOP], 1u);
            const unsigned tg = og / nx;
            if (og + 1u == (tg + 1u) * nx) xb_add(&bar[XB_TOPGEN], 1u);
            else XB_SPIN(xb_ld(&bar[XB_TOPGEN]) == tg, bar);
            __builtin_amdgcn_fence(__ATOMIC_ACQUIRE, "agent");
            xb_add(&bar[XB_XGEN(b.x)], 1u);
            asm volatile("s_waitcnt vmcnt(0)" ::: "memory");
        } else {
            XB_SPIN(xb_ld(&bar[XB_XGEN(b.x)]) == gen, bar);
            __builtin_amdgcn_fence(__ATOMIC_ACQUIRE, "agent");
            asm volatile("s_waitcnt vmcnt(0)" ::: "memory");
        }
    }
    __syncthreads();
}

typedef short s4v __attribute__((ext_vector_type(4)));
__device__ __forceinline__ bf16x8 ldg8(const bf16* p) { return *(const bf16x8*)p; }
__device__ __forceinline__ f32x4 mfma16(bf16x8 a, bf16x8 b, f32x4 c) { return __builtin_amdgcn_mfma_f32_16x16x32_bf16(a, b, c, 0, 0, 0); }
__device__ __forceinline__ bf16x8 ldA(const LAS unsigned char* base, int pitch, int row0, int k0, int li, int g) { return *(const LAS bf16x8*)(base + ((row0 + li) * pitch + k0 + 8 * g) * 2); }
__device__ __forceinline__ bf16x8 ldT(const LAS unsigned char* base, int pitch, int k0, int n0, int li, int g) {
    const LAS unsigned char* p = base + ((k0 + 8 * g + (li >> 2)) * pitch + n0 + 4 * (li & 3)) * 2;
    const s4v a = __builtin_amdgcn_ds_read_tr16_b64_v4i16((LAS s4v*)p), b = __builtin_amdgcn_ds_read_tr16_b64_v4i16((LAS s4v*)(p + 8 * pitch));
    return (bf16x8){a[0], a[1], a[2], a[3], b[0], b[1], b[2], b[3]};
}
__device__ __forceinline__ bf16x8 ldAperm(const LAS unsigned char* base, int pitch, int row0, int ks, int li, int g) {
    const LAS unsigned char* p = base + ((row0 + li) * pitch + 32 * ks + 4 * g) * 2;
    const s4v a = *(const LAS s4v*)p, b = *(const LAS s4v*)(p + 32);
    return (bf16x8){a[0], a[1], a[2], a[3], b[0], b[1], b[2], b[3]};
}
__device__ __forceinline__ void stT(LAS unsigned char* base, int pitch, int n, int m0, const f32x4 v) {
    u32x2 w; w.x = pk2(v[0], v[1]); w.y = pk2(v[2], v[3]); *(LAS u32x2*)(base + (n * pitch + m0) * 2) = w;
}
__device__ __forceinline__ f32x4 ld4bf(const LAS unsigned char* p) { const u32x2 w = *(const LAS u32x2*)p; return (f32x4){bflo(w.x), bfhi(w.x), bflo(w.y), bfhi(w.y)}; }

struct Args {
    const float* in[31];
    float* out; unsigned char* ws;
    int ph_lo, ph_hi, use_bar, pad;
};
enum InIdx { I_X = 0, I_C, I_CTX, I_CCTX, I_ADAW, I_ADAB, I_N1G, I_N2G, I_WIN, I_WOUT, I_ASINK, I_BMIX, I_CREL, I_DCONV, I_DW0, I_DW2, I_DA0, I_DA2, I_DG2, I_DKK, I_DKA, I_DRK, I_DLNW, I_DLNB,
             I_RW, I_RB, I_WGU, I_BGU, I_WDN, I_BDN, I_FNG };
constexpr int NPL = 11;
constexpr int PH_TOTAL = 1 + DEPTH * NPL + 1;

struct DevIn {
    const LAS unsigned* tab;
    __device__ __forceinline__ const float* operator[](int i) const {
        const unsigned lo = __builtin_amdgcn_readfirstlane(((const volatile LAS unsigned*)tab)[2 * i]), hi = __builtin_amdgcn_readfirstlane(((const volatile LAS unsigned*)tab)[2 * i + 1]);
        return (const float*)(((unsigned long long)hi << 32) | lo);
    }
};
struct DArgs { DevIn in; float* out; };
struct Ctx {
    LAS unsigned char* lds;
    int tid, lane, wave, wg, G, gw, NGW;
    unsigned char* ws;
};

template <int NW>
__device__ __forceinline__ void transpose_item(const float* W, int K, int N, bf16* WT, int item, int lane) {
    constexpr int NQ = NW / 4, NC = 64 / NQ, PASSES = 8 / NC;
    const int nblk = N / NW, kb = item / nblk, nb = item % nblk, k0 = 64 * kb, n0 = NW * nb, nq = lane % NQ, cq = lane / NQ;
    f32x4 v[PASSES][8];
#pragma unroll
    for (int ps = 0; ps < PASSES; ++ps)
#pragma unroll
        for (int i = 0; i < 8; ++i) v[ps][i] = *(const f32x4*)(W + (size_t)(k0 + 8 * (cq + NC * ps) + i) * N + n0 + 4 * nq);
#pragma unroll
    for (int ps = 0; ps < PASSES; ++ps)
#pragma unroll
        for (int j = 0; j < 4; ++j) { u32x4 o; o.x = pk2(v[ps][0][j], v[ps][1][j]); o.y = pk2(v[ps][2][j], v[ps][3][j]); o.z = pk2(v[ps][4][j], v[ps][5][j]); o.w = pk2(v[ps][6][j], v[ps][7][j]);
            *(u32x4*)(WT + (size_t)(n0 + 4 * nq + j) * K + k0 + 8 * (cq + NC * ps)) = o; }
}
template <int NW>
__device__ __forceinline__ void transpose_item8(const float* W, int K, int N, unsigned char* WT, int item, int lane) {
    constexpr int NQ = NW / 4, NC = 64 / NQ, PASSES = 8 / NC;
    const int nblk = N / NW, kb = item / nblk, nb = item % nblk, k0 = 64 * kb, n0 = NW * nb, nq = lane % NQ, cq = lane / NQ;
    f32x4 v[PASSES][8];
#pragma unroll
    for (int ps = 0; ps < PASSES; ++ps)
#pragma unroll
        for (int i = 0; i < 8; ++i) v[ps][i] = __builtin_nontemporal_load((const f32x4*)(W + (size_t)(k0 + 8 * (cq + NC * ps) + i) * N + n0 + 4 * nq)) * pg8::W8_S;
#pragma unroll
    for (int ps = 0; ps < PASSES; ++ps)
#pragma unroll
        for (int j = 0; j < 4; ++j) { unsigned w0 = 0, w1 = 0;
            w0 = __builtin_amdgcn_cvt_pk_fp8_f32(v[ps][0][j], v[ps][1][j], w0, false); w0 = __builtin_amdgcn_cvt_pk_fp8_f32(v[ps][2][j], v[ps][3][j], w0, true);
            w1 = __builtin_amdgcn_cvt_pk_fp8_f32(v[ps][4][j], v[ps][5][j], w1, false); w1 = __builtin_amdgcn_cvt_pk_fp8_f32(v[ps][6][j], v[ps][7][j], w1, true);
            __builtin_nontemporal_store((u32x2){w0, w1}, (u32x2*)(WT + (size_t)(n0 + 4 * nq + j) * K + k0 + 8 * (cq + NC * ps))); }
}
constexpr int CV_IT_GU = 16 * 64, CV_IT_DN = 16 * 32, CV_N_GU = 32 * CV_IT_GU, CV_N_DN = 32 * CV_IT_DN, CV_ITEMS = CV_N_GU + CV_N_DN, CV_CHUNK = 16, CV_NCHUNK = CV_ITEMS / CV_CHUNK;
__device__ __forceinline__ void convert_moe_items(const Ctx& C, const DArgs& a, int l, int it0, int it1) {
    const float* pwgu = a.in[I_WGU] + (size_t)l * 32 * DM * 2048; const float* pwdn = a.in[I_WDN] + (size_t)l * 32 * DM * DM;
    unsigned char* ogu = C.ws + WS_WGU + (size_t)l * 32 * 2048 * DM; unsigned char* odn = C.ws + WS_WDN + (size_t)l * 32 * DM * DM;
#pragma unroll 1
    for (int it = it0; it < it1; ++it) {
        if (it < CV_N_GU) { const int e = it / CV_IT_GU; transpose_item8<32>(pwgu + (size_t)e * DM * 2048, DM, 2048, ogu + (size_t)e * 2048 * DM, it % CV_IT_GU, C.lane); }
        else { const int r = it - CV_N_GU, e = r / CV_IT_DN; transpose_item8<32>(pwdn + (size_t)e * DM * DM, DM, DM, odn + (size_t)e * DM * DM, r % CV_IT_DN, C.lane); }
    }
}
__device__ __forceinline__ void phase_prologue(const Ctx& C, const DArgs& a) {
    constexpr int IT_IN = 16 * (INW / 32), IT_OUT = 16 * 16;
    constexpr int N_IN = 4 * IT_IN, N_OUT = 4 * IT_OUT;
    const float* pwin = a.in[I_WIN]; const float* pwout = a.in[I_WOUT];
    for (int it = C.gw; it < N_IN + N_OUT; it += C.NGW) {
        if (it < N_IN) { const int l = it / IT_IN; transpose_item<32>(pwin + (size_t)l * DM * INW, DM, INW, (bf16*)(C.ws + WS_WIN) + (size_t)l * INWP * DM, it % IT_IN, C.lane); }
        else { const int r = it - N_IN, l = r / IT_OUT; transpose_item<64>(pwout + (size_t)l * DM * DM, DM, DM, (bf16*)(C.ws + WS_WOUT) + (size_t)l * DM * DM, r % IT_OUT, C.lane); }
    }
    for (int ch = C.gw; ch < CV_NCHUNK; ch += C.NGW) convert_moe_items(C, a, 0, ch * CV_CHUNK, ch * CV_CHUNK + CV_CHUNK);
    { const int gt = C.wg * NTHR + C.tid; constexpr int PADN = (INWP - INW) * DM / 8;
      for (int i = gt; i < 4 * PADN; i += C.G * NTHR) { const int l = i / PADN, r = i % PADN; *((u32x4*)((bf16*)(C.ws + WS_WIN) + ((size_t)l * INWP + INW) * DM) + r) = (u32x4){0u, 0u, 0u, 0u}; } }
    { float* tw = (float*)(C.ws + WS_TW); const int gt = C.wg * NTHR + C.tid;
      for (int i = gt; i < 16384; i += C.G * NTHR) { const float x = (float)i * (1.0f / 8192.0f); tw[i] = cospif(x); tw[16384 + i] = sinpif(x); } }
    { float* mt = (float*)(C.ws + WS_MTAB); const int gt = C.wg * NTHR + C.tid; const float* pbmix = a.in[I_BMIX];
      for (int i = gt; i < 4 * 4 * 64 * 64; i += C.G * NTHR) { const int e = i & 63, c = (i >> 6) & 63, g = (i >> 12) & 3, l = i >> 14;
          const float* w = pbmix + ((size_t)(l * 4 + g) * 64) * 64 + e; float sc = 0.f, ss = 0.f;
          for (int cp = 0; cp < 64; ++cp) { const float x = (float)((c * cp) & 63) * (1.0f / 32.0f); const float wv = w[cp * 64]; sc += cospif(x) * wv; ss += sinpif(x) * wv; }
          mt[((size_t)(l * 2 + 0) * 4 + g) * 4096 + c * 64 + e] = sc; mt[((size_t)(l * 2 + 1) * 4 + g) * 4096 + c * 64 + e] = ss; } }
    { bf16* ft = (bf16*)(C.ws + WS_FTAB); const int gt = C.wg * NTHR + C.tid; const float* pbmix = a.in[I_BMIX];
      for (int i = gt; i < 128 * 128; i += C.G * NTHR) { const int k = i >> 7, t = i & 127; const float x = (float)((k * t) & 127) * (1.0f / 64.0f); ft[i] = (bf16)f2bf(cospif(x)); ft[16384 + i] = (bf16)f2bf(sinpif(x)); }
      bf16* mf = ft + 32768;
      for (int i = gt; i < 4 * 4 * 16 * 64 * 8; i += C.G * NTHR) { const int j8 = i & 7, ln = (i >> 3) & 63, fr = (i >> 9) & 15, gq = (i >> 13) & 3, l = i >> 15;
          const int ei = fr >> 2, ks2 = fr & 3, e = 16 * ei + (ln & 15), g = ln >> 4, c = 32 * (ks2 & 1) + 16 * (j8 >> 2) + 4 * g + (j8 & 3), part = ks2 >> 1;
          const float* w = pbmix + ((size_t)(l * 4 + gq) * 64) * 64 + e; float s = 0.f;
          for (int cp = 0; cp < 64; ++cp) { const float x = (float)((c * cp) & 63) * (1.0f / 32.0f); s += (part ? sinpif(x) : cospif(x)) * w[cp * 64]; }
          mf[i] = (bf16)f2bf(s * (1.0f / 1024.0f)); } }
    { const int gt = C.wg * NTHR + C.tid; const float* pg2 = a.in[I_DG2]; const float* prw = a.in[I_RW]; bf16* g2t = (bf16*)(C.ws + WS_G2T); bf16* rwt = (bf16*)(C.ws + WS_RWT);
      for (int i = gt; i < 4 * 256 * 160; i += C.G * NTHR) { const int ii = i % 160, c = (i / 160) & 255, l = i / (160 * 256); g2t[i] = (bf16)f2bf(pg2[((size_t)l * 160 + ii) * 256 + c]); }
      for (int i = gt; i < 4 * 32 * 1024; i += C.G * NTHR) { const int k = i & 1023, e = (i >> 10) & 31, l = i >> 15; rwt[i] = (bf16)f2bf(prw[((size_t)l * 1024 + k) * 32 + e]); } }
    { const int gt = C.wg * NTHR + C.tid; const float* pw2 = a.in[I_DW2]; const float* pa2 = a.in[I_DA2]; bf16* lt = (bf16*)(C.ws + WS_LORAT);
      for (int i = gt; i < 4 * 4 * 256 * 64; i += C.G * NTHR) { const int ii = i & 63, c = (i >> 6) & 255, q = (i >> 14) & 3, l = i >> 16;
          const float* src = (q < 2) ? pw2 : pa2; lt[i] = (bf16)f2bf(src[(((size_t)l * 2 + (q & 1)) * 64 + ii) * 256 + c]); } }
    { bf16* f2 = (bf16*)(C.ws + WS_F256); const int gt = C.wg * NTHR + C.tid;
      for (int i = gt; i < 256 * 256; i += C.G * NTHR) { const int k = i >> 8, t = i & 255; const float x = (float)((k * t) & 255) * (1.0f / 128.0f); f2[i] = (bf16)f2bf(cospif(x)); f2[65536 + i] = (bf16)f2bf(sinpif(x)); } }
    { LAS float* sl = (LAS float*)(C.lds);
      LAS float* red = (LAS float*)(C.lds + 8192);
      __syncthreads();
      const float* pc = a.in[I_C]; const float* pcc = a.in[I_CCTX]; const float* padaw = a.in[I_ADAW]; const float* padab = a.in[I_ADAB];
      for (int i = C.tid; i < 2048; i += NTHR) { const float x = (i < 1024) ? pc[i] : pcc[i - 1024]; sl[i] = x * sigmoidf_(x); }
      __syncthreads();
      float* mod = (float*)(C.ws + WS_MOD);
      for (int u = C.wg; u < 4 * 96; u += C.G) { const int l = u / 96, jb = u % 96, j0 = jb * 64 + C.lane;
          float s0 = 0.f, s1 = 0.f; const float* w = padaw + (size_t)l * DM * 6144 + j0; const int k0 = C.wave * 128;
#pragma unroll 16
          for (int k = 0; k < 128; ++k) { const float wv = w[(size_t)(k0 + k) * 6144]; s0 += wv * sl[k0 + k]; s1 += wv * sl[1024 + k0 + k]; }
          red[(C.wave * 2 + 0) * 64 + C.lane] = s0; red[(C.wave * 2 + 1) * 64 + C.lane] = s1;
          __syncthreads();
          if (C.tid < 128) { const int v = C.tid >> 6, j = C.tid & 63; float s = 0.f;
#pragma unroll
              for (int wv = 0; wv < 8; ++wv) s += red[(wv * 2 + v) * 64 + j];
              mod[(size_t)(l * 2 + v) * 6144 + jb * 64 + j] = s + padab[(size_t)l * 6144 + jb * 64 + j]; }
          __syncthreads(); } }
}

__device__ __forceinline__ void load_row(const float* p, int lane, f32x4 (&v)[4]) {
#pragma unroll
    for (int j = 0; j < 4; ++j) v[j] = *((const f32x4*)p + lane + 64 * j);
}
__device__ __forceinline__ void moe_combine_row(const Ctx& C, int row, f32x4 (&v)[4], const f32x4 (&gt2q)[4]) {
    const int* dest = (const int*)(C.ws + WS_ROUTE) + (size_t)3 * ROWS * 4; const float* gate = (const float*)(C.ws + WS_ROUTE) + (size_t)1 * ROWS * 4;
    const bf16* YB = (const bf16*)(C.ws + WS_XG);
    f32x4 s[4];
#pragma unroll
    for (int j = 0; j < 4; ++j) s[j] = (f32x4){0.f, 0.f, 0.f, 0.f};
#pragma unroll
    for (int k = 0; k < 4; ++k) { const int d = dest[row * 4 + k]; const float g = gate[row * 4 + k]; const u32x2* yp = (const u32x2*)(YB + (size_t)d * DM) + C.lane;
#pragma unroll
        for (int j = 0; j < 4; ++j) { const u32x2 w = yp[64 * j]; s[j] += (f32x4){bflo(w.x), bfhi(w.x), bflo(w.y), bfhi(w.y)} * g; } }
#pragma unroll
    for (int j = 0; j < 4; ++j) v[j] += gt2q[j] * s[j];
}
__device__ __forceinline__ float row_rstd(const f32x4 (&v)[4], int lane) {
    float s = 0.f;
#pragma unroll
    for (int j = 0; j < 4; ++j) s += (v[j].x * v[j].x + v[j].y * v[j].y) + (v[j].z * v[j].z + v[j].w * v[j].w);
    return rsqrtf(wave_sum(s, lane) * (1.f / DM) + 1e-6f);
}
__device__ __forceinline__ void norm1_fetch(const Ctx& C, const float* src_row, int row, bool combine, const f32x4 (&gt2q)[4], f32x4 (&v)[4]) {
    load_row(src_row, C.lane, v);
    if (combine) moe_combine_row(C, row, v, gt2q);
}
__device__ __forceinline__ void phase_norm1(const Ctx& C, const DArgs& a, int l) {
    float* XS = (float*)(C.ws + WS_XS); bf16* H = (bf16*)(C.ws + WS_H); const float* mod = (const float*)(C.ws + WS_MOD);
    const float* g1 = a.in[I_N1G] + (size_t)l * DM;
    const float* pctx = a.in[I_CTX]; const float* px = a.in[I_X];
    f32x4 gq[4], shq[4], scq[4], gt2q[4];
#pragma unroll
    for (int j = 0; j < 4; ++j) gt2q[j] = *((const f32x4*)(mod + (size_t)((l > 0 ? l - 1 : 0) * 2) * 6144 + 5 * DM) + C.lane + 64 * j);
#pragma unroll
    for (int j = 0; j < 4; ++j) { gq[j] = *((const f32x4*)g1 + C.lane + 64 * j); shq[j] = *((const f32x4*)(mod + (size_t)(l * 2) * 6144) + C.lane + 64 * j); scq[j] = *((const f32x4*)(mod + (size_t)(l * 2) * 6144 + DM) + C.lane + 64 * j) + 1.0f; }
    for (int row0 = C.gw; row0 < ROWS; row0 += 2 * C.NGW) {
        f32x4 v[2][4]; const int rows[2] = {row0, row0 + C.NGW};
#pragma unroll
        for (int q = 0; q < 2; ++q) if (rows[q] < ROWS) { const int row = rows[q]; const bool isctx = row < NCTX;
            const float* src = (l == 0) ? (isctx ? pctx + (size_t)row * DM : px + (size_t)(row - NCTX) * DM) : XS + (size_t)row * DM;
            if (isctx && l > 0) { f32x4 gc4[4];
#pragma unroll
                for (int j = 0; j < 4; ++j) gc4[j] = *((const f32x4*)(mod + (size_t)((l - 1) * 2 + 1) * 6144 + 5 * DM) + C.lane + 64 * j);
                norm1_fetch(C, src, row, true, gc4, v[q]); }
            else norm1_fetch(C, src, row, l > 0, gt2q, v[q]); }
#pragma unroll
        for (int q = 0; q < 2; ++q) if (rows[q] < ROWS) { const int row = rows[q]; const bool isctx = row < NCTX;
#pragma unroll
            for (int j = 0; j < 4; ++j) *((f32x4*)(XS + (size_t)row * DM) + C.lane + 64 * j) = v[q][j];
            const float rstd = row_rstd(v[q], C.lane);
            const float* md = mod + (size_t)(l * 2 + (isctx ? 1 : 0)) * 6144;
            u32x2* o = (u32x2*)(H + (size_t)row * DM) + C.lane;
#pragma unroll
            for (int j = 0; j < 4; ++j) { f32x4 sh = shq[j], sc1 = scq[j]; if (isctx) { sh = *((const f32x4*)md + C.lane + 64 * j); sc1 = *((const f32x4*)(md + DM) + C.lane + 64 * j) + 1.0f; }
                const f32x4 y = v[q][j] * rstd * gq[j] * sc1 + sh; u32x2 w; w.x = pk2(y.x, y.y); w.y = pk2(y.z, y.w); o[64 * j] = w; } }
    }
}
__device__ __forceinline__ void phase_final(const Ctx& C, const DArgs& a) {
    const float* XS = (const float*)(C.ws + WS_XS); const float* mod = (const float*)(C.ws + WS_MOD); const float* g = a.in[I_FNG];
    const float* gt2 = mod + (size_t)((DEPTH - 1) * 2 + 0) * 6144 + 5 * DM;
    f32x4 gq[4], gt2q[4];
#pragma unroll
    for (int j = 0; j < 4; ++j) { gq[j] = *((const f32x4*)g + C.lane + 64 * j); gt2q[j] = *((const f32x4*)gt2 + C.lane + 64 * j); }
    for (int row0 = NCTX + C.gw; row0 < ROWS; row0 += 2 * C.NGW) {
        f32x4 v[2][4]; const int rows[2] = {row0, row0 + C.NGW};
#pragma unroll
        for (int q = 0; q < 2; ++q) if (rows[q] < ROWS) norm1_fetch(C, XS + (size_t)rows[q] * DM, rows[q], true, gt2q, v[q]);
#pragma unroll
        for (int q = 0; q < 2; ++q) if (rows[q] < ROWS) { const float rstd = row_rstd(v[q], C.lane); float* o = a.out + (size_t)(rows[q] - NCTX) * DM;
#pragma unroll
            for (int j = 0; j < 4; ++j) *((f32x4*)o + C.lane + 64 * j) = v[q][j] * rstd * gq[j]; }
    }
}
constexpr int NR2 = 9;
__device__ __forceinline__ void phase_norm2(const Ctx& C, const DArgs& a, int l) {
    const float* XS = (const float*)(C.ws + WS_XS); bf16* H = (bf16*)(C.ws + WS_H); const float* mod = (const float*)(C.ws + WS_MOD);
    const float* g2 = a.in[I_N2G] + (size_t)l * DM; const float* rb = a.in[I_RB] + (size_t)l * NEXP; const bf16* rwt = (const bf16*)(C.ws + WS_RWT) + (size_t)l * NEXP * DM;
    int* tok_e = (int*)(C.ws + WS_ROUTE); float* gate = (float*)(C.ws + WS_ROUTE) + (size_t)1 * ROWS * 4; int* slot = (int*)(C.ws + WS_ROUTE) + (size_t)2 * ROWS * 4;
    LAS float* lg = (LAS float*)(C.lds + C.wave * 4096);
    LAS int* hist = (LAS int*)(C.lds + MISC_OFF + 64);
    const int lane = C.lane, li = lane & 15, g = lane >> 4;
    if (C.tid < NEXP) hist[C.tid] = 0;
    constexpr int RWP = 1032;
    LAS unsigned char* rwl = C.lds + 32768;
    for (int i = C.tid; i < NEXP * 128; i += NTHR) { const int e2 = i >> 7, c8 = i & 127; *(LAS u32x4*)(rwl + (e2 * RWP + 8 * c8) * 2) = *(const u32x4*)(rwt + (size_t)e2 * DM + 8 * c8); }
    __syncthreads();
    const int row_base = (l == DEPTH - 1) ? NCTX : 0, ntile = (ROWS - row_base + NR2 - 1) / NR2;
    f32x4 gq[4], shq[4], scq[4];
#pragma unroll
    for (int j = 0; j < 4; ++j) { gq[j] = *((const f32x4*)g2 + lane + 64 * j); shq[j] = *((const f32x4*)(mod + (size_t)(l * 2) * 6144 + 3 * DM) + lane + 64 * j); scq[j] = *((const f32x4*)(mod + (size_t)(l * 2) * 6144 + 4 * DM) + lane + 64 * j) + 1.0f; }
    for (int tl = C.gw; tl < ntile; tl += C.NGW) {
        const int trow0 = row_base + NR2 * tl, nrow = (ROWS - trow0 < NR2) ? ROWS - trow0 : NR2;
#pragma unroll 1
        for (int rr = 0; rr < nrow; ++rr) { const int row = trow0 + rr; const bool isctx = row < NCTX; f32x4 v[4]; load_row(XS + (size_t)row * DM, lane, v);
            const float rstd = row_rstd(v, lane);
            const float* md = mod + (size_t)(l * 2 + (isctx ? 1 : 0)) * 6144 + 3 * DM;
            u32x2* o = (u32x2*)(H + (size_t)row * DM) + lane;
#pragma unroll
            for (int j = 0; j < 4; ++j) { f32x4 sh = shq[j], sc1 = scq[j]; if (isctx) { sh = *((const f32x4*)md + lane + 64 * j); sc1 = *((const f32x4*)(md + DM) + lane + 64 * j) + 1.0f; }
                const f32x4 y = v[j] * rstd * gq[j] * sc1 + sh; u32x2 w; w.x = pk2(y.x, y.y); w.y = pk2(y.z, y.w); o[64 * j] = w; } }
        asm volatile("s_waitcnt vmcnt(0)" ::: "memory");
        f32x4 acc0 = {0.f, 0.f, 0.f, 0.f}, acc1 = {0.f, 0.f, 0.f, 0.f};
        const int arow = (trow0 + li < ROWS) ? trow0 + li : ROWS - 1;
        const bf16* ap = H + (size_t)arow * DM + 8 * g;
#pragma unroll 8
        for (int ks = 0; ks < 32; ++ks) { const bf16x8 af = *(const bf16x8*)(ap + 32 * ks); acc0 = mfma16(af, ldA(rwl, RWP, 0, 32 * ks, li, g), acc0); acc1 = mfma16(af, ldA(rwl, RWP, 16, 32 * ks, li, g), acc1); }
#pragma unroll
        for (int r = 0; r < 4; ++r) { lg[(4 * g + r) * 33 + li] = acc0[r]; lg[(4 * g + r) * 33 + 16 + li] = acc1[r]; }
        LDS_WAIT(); asm volatile("" ::: "memory");
        const int e = lane & 31; const float rbe = rb[e];
        float val[NR2]; int te[NR2][4]; float tv[NR2][4];
#pragma unroll
        for (int rr = 0; rr < NR2; ++rr) val[rr] = lg[rr * 33 + e] + rbe;
#pragma unroll
        for (int k = 0; k < 4; ++k) {
            float bv[NR2]; int bi[NR2];
#pragma unroll
            for (int rr = 0; rr < NR2; ++rr) { bv[rr] = val[rr]; bi[rr] = e; }
#define AMAX_ROR(n) _Pragma("unroll") for (int rr = 0; rr < NR2; ++rr) { const float ov = __builtin_bit_cast(float, __builtin_amdgcn_update_dpp(0, __builtin_bit_cast(int, bv[rr]), 0x120 + (n), 0xf, 0xf, false)); const int oi = __builtin_amdgcn_update_dpp(0, bi[rr], 0x120 + (n), 0xf, 0xf, false); \
                if (ov > bv[rr] || (ov == bv[rr] && oi < bi[rr])) { bv[rr] = ov; bi[rr] = oi; } }
            AMAX_ROR(8) AMAX_ROR(4) AMAX_ROR(2) AMAX_ROR(1)
#undef AMAX_ROR
#pragma unroll
            for (int rr = 0; rr < NR2; ++rr) { const float ov = shx(bv[rr], 16, lane); const int oi = shxi(bi[rr], 16, lane); if (ov > bv[rr] || (ov == bv[rr] && oi < bi[rr])) { bv[rr] = ov; bi[rr] = oi; }
                te[rr][k] = bi[rr]; tv[rr][k] = bv[rr]; if (e == bi[rr]) val[rr] = -3.0e38f; } }
        if (lane == 0) {
#pragma unroll
            for (int rr = 0; rr < NR2; ++rr) if (rr < nrow) { const int row = trow0 + rr; const float m = tv[rr][0]; float p[4], ps = 0.f;
#pragma unroll
                for (int k = 0; k < 4; ++k) { p[k] = __expf(tv[rr][k] - m); ps += p[k]; }
#pragma unroll
                for (int k = 0; k < 4; ++k) { tok_e[row * 4 + k] = te[rr][k]; gate[row * 4 + k] = p[k] / ps; slot[row * 4 + k] = __hip_atomic_fetch_add(&hist[te[rr][k]], 1, __ATOMIC_RELAXED, __HIP_MEMORY_SCOPE_WORKGROUP); } } }
        asm volatile("" ::: "memory");
    }
    __syncthreads();
    if (C.tid < NEXP) ((int*)(C.ws + WS_CNT))[C.wg * NEXP + C.tid] = hist[C.tid];
}
__device__ __forceinline__ int moe_tables(const Ctx& C) {
    const int* cnt = (const int*)(C.ws + WS_CNT);
    LAS int* part = (LAS int*)(C.lds);
    LAS int* pstart = (LAS int*)(C.lds + MISC_OFF + 256); LAS int* wgbase = pstart + 40; LAS int* tot = wgbase + 32; LAS int* nblk_s = tot + 32;
    LAS unsigned char* blk_e = (LAS unsigned char*)(C.lds + MISC_OFF + 1024);
    __syncthreads();
    { const int e = C.tid & 31, p = C.tid >> 5; int t = 0, pre = 0;
#pragma unroll 1
      for (int w = p * 16; w < p * 16 + 16; ++w) { const int c = cnt[w * NEXP + e]; t += c; if (w < C.wg) pre += c; }
      part[(p * 32 + e) * 2] = t; part[(p * 32 + e) * 2 + 1] = pre; }
    __syncthreads();
    if (C.tid < NEXP) { int t = 0, pre = 0;
#pragma unroll 1
        for (int p = 0; p < 16; ++p) { t += part[(p * 32 + C.tid) * 2]; pre += part[(p * 32 + C.tid) * 2 + 1]; }
        tot[C.tid] = t; wgbase[C.tid] = pre; }
    __syncthreads();
    if (C.tid == 0) { int b = 0;
#pragma unroll 1
        for (int e = 0; e < NEXP; ++e) { pstart[e] = b * 256; b += (tot[e] + 255) >> 8; }
        pstart[NEXP] = b * 256; nblk_s[0] = b; }
    __syncthreads();
    if (C.tid < NEXP) wgbase[C.tid] += pstart[C.tid];
    if (C.tid < MOE_MAXBLK) { int e = 0;
#pragma unroll 1
        for (int k = 1; k < NEXP; ++k) if (pstart[k] <= C.tid * 256) e = k;
        blk_e[C.tid] = (unsigned char)e; }
    __syncthreads();
    return __builtin_amdgcn_readfirstlane(nblk_s[0]);
}
__device__ __forceinline__ int moe_tables_load(const Ctx& C) {
    const unsigned* src = (const unsigned*)(C.ws + WS_CNT + 65536);
    LAS unsigned* dst = (LAS unsigned*)(C.lds + MISC_OFF + 1024);
    __syncthreads();
    if (C.tid < MOE_MAXBLK / 4) dst[C.tid] = src[C.tid];
    const int nblk = __builtin_amdgcn_readfirstlane((int)src[MOE_MAXBLK / 4]);
    __syncthreads();
    return nblk;
}
__device__ __forceinline__ void phase_gather(const Ctx& C, const DArgs& a, int l) {
    const int nblk_all = moe_tables(C);
    if (C.wg == 0) { unsigned* dstg = (unsigned*)(C.ws + WS_CNT + 65536); const LAS unsigned* srcl = (const LAS unsigned*)(C.lds + MISC_OFF + 1024);
        if (C.tid < MOE_MAXBLK / 4) dstg[C.tid] = srcl[C.tid]; if (C.tid == 0) dstg[MOE_MAXBLK / 4] = (unsigned)nblk_all; }
    const LAS int* wgbase = (const LAS int*)(C.lds + MISC_OFF + 256) + 40;
    const int* tok_e = (const int*)(C.ws + WS_ROUTE); const int* slot = (const int*)(C.ws + WS_ROUTE) + (size_t)2 * ROWS * 4; int* dest = (int*)(C.ws + WS_ROUTE) + (size_t)3 * ROWS * 4;
    const bf16* H = (const bf16*)(C.ws + WS_H); unsigned char* XG = C.ws + WS_XG8;
    const int row_base = (l == DEPTH - 1) ? NCTX : 0, ntile = (ROWS - row_base + NR2 - 1) / NR2;
    for (int tl = C.gw; tl < ntile; tl += C.NGW)
    for (int row = row_base + NR2 * tl; row < row_base + NR2 * tl + NR2 && row < ROWS; ++row) {
        const u32x4* src = (const u32x4*)(H + (size_t)row * DM) + C.lane; const u32x4 v0 = src[0], v1 = src[64];
        u32x2 q0, q1;
        { unsigned w = 0; w = __builtin_amdgcn_cvt_pk_fp8_f32(bflo(v0.x) * pg8::X8_S, bfhi(v0.x) * pg8::X8_S, w, false); w = __builtin_amdgcn_cvt_pk_fp8_f32(bflo(v0.y) * pg8::X8_S, bfhi(v0.y) * pg8::X8_S, w, true); q0.x = w;
          w = 0; w = __builtin_amdgcn_cvt_pk_fp8_f32(bflo(v0.z) * pg8::X8_S, bfhi(v0.z) * pg8::X8_S, w, false); w = __builtin_amdgcn_cvt_pk_fp8_f32(bflo(v0.w) * pg8::X8_S, bfhi(v0.w) * pg8::X8_S, w, true); q0.y = w;
          w = 0; w = __builtin_amdgcn_cvt_pk_fp8_f32(bflo(v1.x) * pg8::X8_S, bfhi(v1.x) * pg8::X8_S, w, false); w = __builtin_amdgcn_cvt_pk_fp8_f32(bflo(v1.y) * pg8::X8_S, bfhi(v1.y) * pg8::X8_S, w, true); q1.x = w;
          w = 0; w = __builtin_amdgcn_cvt_pk_fp8_f32(bflo(v1.z) * pg8::X8_S, bfhi(v1.z) * pg8::X8_S, w, false); w = __builtin_amdgcn_cvt_pk_fp8_f32(bflo(v1.w) * pg8::X8_S, bfhi(v1.w) * pg8::X8_S, w, true); q1.y = w; }
#pragma unroll
        for (int k = 0; k < 4; ++k) { const int d = wgbase[tok_e[row * 4 + k]] + slot[row * 4 + k]; if (C.lane == 0) dest[row * 4 + k] = d;
            u32x2* dp = (u32x2*)(XG + (size_t)d * DM) + C.lane; dp[0] = q0; dp[64] = q1; }
    }
}

__device__ __forceinline__ void mix1_rope(const Ctx& C) {
    bf16* P = (bf16*)(C.ws + WS_P);
    const long total = (long)SEQ * 192;
    for (long i = (long)C.wg * NTHR + C.tid; i < total; i += (long)C.G * NTHR) {
        const int j = (int)(i & 31), hh = (int)((i >> 5) % 6), t = (int)(i / 192);
        const int col = (hh < 4) ? (C_AQ + hh * 64) : (C_AK + (hh - 4) * 64);
        const float pos = (j < 16) ? (float)(t >> 6) : (float)(t & 63);
        const float inv = __powf(10000.0f, -(float)(j & 15) * (1.0f / 16.0f));
        const float ang = pos * inv * 0.31830988618379067f;
        const float cs = cospif(ang), sn = sinpif(ang);
        bf16* p = P + (size_t)(NCTX + t) * INWP + col;
        const float x1 = bf2f(p[j]), x2 = bf2f(p[j + 32]);
        p[j] = (bf16)f2bf(x1 * cs - x2 * sn); p[j + 32] = (bf16)f2bf(x2 * cs + x1 * sn);
    }
}
__device__ __forceinline__ void mix1_vt(const Ctx& C) {
    const bf16* P = (const bf16*)(C.ws + WS_P);
    LAS unsigned short* scr = (LAS unsigned short*)(C.lds + C.wave * 16384);
    for (int u = C.gw; u < (ROWS / 64) * 6; u += C.NGW) {
        const int hd = u % 6, tb = u / 6; const int vcol = (hd < 2) ? (C_AV + hd * 64) : (C_CV + (hd - 2) * 64);
        bf16* VT = ((hd < 2) ? (bf16*)(C.ws + WS_VTA) + (size_t)hd * 64 * VTP : (bf16*)(C.ws + WS_VTC) + (size_t)(hd - 2) * 64 * VTP);
#pragma unroll
        for (int i = 0; i < 8; ++i) { const int tk = (C.lane >> 3) + 8 * i, ch = C.lane & 7; const u32x4 w = *(const u32x4*)(P + (size_t)(tb * 64 + tk) * INWP + vcol + 8 * ch);
            LAS unsigned* d = (LAS unsigned*)(scr + tk * 66 + 8 * ch); d[0] = w.x; d[1] = w.y; d[2] = w.z; d[3] = w.w; }
        LDS_WAIT(); asm volatile("" ::: "memory");
#pragma unroll
        for (int k8 = 0; k8 < 8; ++k8) { unsigned w[4];
#pragma unroll
            for (int e2 = 0; e2 < 4; ++e2) { const unsigned lo = scr[(8 * k8 + 2 * e2) * 66 + C.lane], hi = scr[(8 * k8 + 2 * e2 + 1) * 66 + C.lane]; w[e2] = lo | (hi << 16); }
            *(u32x4*)(VT + (size_t)C.lane * VTP + tb * 64 + 8 * k8) = (u32x4){w[0], w[1], w[2], w[3]}; }
        LDS_WAIT(); asm volatile("" ::: "memory");
    }
    for (int i = C.wg * NTHR + C.tid; i < 6 * 64 * 32; i += C.G * NTHR) { const int rowi = i >> 5, pc = i & 31; const int hd = rowi >> 6, d = rowi & 63;
        bf16* VT = ((hd < 2) ? (bf16*)(C.ws + WS_VTA) + (size_t)hd * 64 * VTP : (bf16*)(C.ws + WS_VTC) + (size_t)(hd - 2) * 64 * VTP);
        *(u32x4*)(VT + (size_t)d * VTP + ROWS + 8 * pc) = (u32x4){0u, 0u, 0u, 0u}; }
}
__device__ __forceinline__ float conv3(const bf16* P, int row, int col, const float* cw, int cc) {
    const bool first = (row == 0) || (row == NCTX), last = (row == NCTX - 1) || (row == ROWS - 1);
    float s = cw[768 + cc] * bf2f(P[(size_t)row * INWP + col]);
    if (!first) s += cw[cc] * bf2f(P[(size_t)(row - 1) * INWP + col]);
    if (!last) s += cw[2 * 768 + cc] * bf2f(P[(size_t)(row + 1) * INWP + col]);
    return s;
}
__device__ __forceinline__ void mix1_rwkv_prep(const Ctx& C, const DArgs& a, int l) {
    const bf16* P = (const bf16*)(C.ws + WS_P); float* SC = (float*)(C.ws + WS_SC);
    constexpr int LBP = 264;
    LAS unsigned char* lob = C.lds;
    LAS float* pre = (LAS float*)(C.lds + 16384);
    const bf16* lorat = (const bf16*)(C.ws + WS_LORAT) + (size_t)l * 4 * 256 * 64;
    const float* cw = a.in[I_DCONV] + (size_t)l * 3 * 768;
    const float* w0 = a.in[I_DW0] + (size_t)l * 512; const float* a0 = a.in[I_DA0] + (size_t)l * 512;
    const float* kkw = a.in[I_DKK] + (size_t)l * 256; const float* kaw = a.in[I_DKA] + (size_t)l * 256;
    const int half = C.tid >> 8, c = C.tid & 255, lane = C.lane, li = lane & 15, g = lane >> 4;
    const float kkc = kkw[c], kac = kaw[c];
    bf16x8 lrf[4][2][2];
#pragma unroll
    for (int q = 0; q < 4; ++q)
#pragma unroll
        for (int c2 = 0; c2 < 2; ++c2) { const bf16* bp = lorat + ((size_t)q * 256 + 16 * (2 * C.wave + c2) + li) * 64 + 8 * g; lrf[q][c2][0] = ldg8(bp); lrf[q][c2][1] = ldg8(bp + 32); }
    const float w0c[2] = {w0[c], w0[256 + c]}, a0c[2] = {a0[c], a0[256 + c]};
    const float cr0 = cw[c], cr1 = cw[768 + c], cr2 = cw[1536 + c], ck0 = cw[256 + c], ck1 = cw[768 + 256 + c], ck2 = cw[1536 + 256 + c], cv0 = cw[512 + c], cv1 = cw[768 + 512 + c], cv2 = cw[1536 + 512 + c];
    bf16 lin[7];
#define LIN_FETCH(gg) do { const int r0_ = 13 * (gg) + 7 * half; _Pragma("unroll") for (int j = 0; j < 7; ++j) if (j < 7 - half) lin[j] = P[(size_t)(r0_ + j) * INWP + C_WL + c]; } while (0)
    if (C.wg < ROWS / 13) LIN_FETCH(C.wg);
    for (int grp = C.wg; grp < ROWS / 13; grp += C.G) {
        const int row0 = 13 * grp + 7 * half, nj = 7 - half;
        __syncthreads();
#pragma unroll
        for (int j = 0; j < 7; ++j) if (j < nj) { const float x = bf2f(lin[j]); *(LAS bf16*)(lob + ((7 * half + j) * LBP + c) * 2) = (bf16)f2bf((c < 128) ? tanhf(x) : x); }
        __syncthreads();
        float xr[9], xk[9], xv[9];
#pragma unroll
        for (int q = 0; q < 9; ++q) { const int rw = row0 - 1 + q; const bool in = (rw >= 0) && (rw < ROWS) && (q <= nj + 1);
            const bf16* pp = P + (size_t)(in ? rw : row0) * INWP; xr[q] = in ? bf2f(pp[C_DR + c]) : 0.f; xk[q] = in ? bf2f(pp[C_DK + c]) : 0.f; xv[q] = in ? bf2f(pp[C_DV + c]) : 0.f; }
#pragma unroll
        for (int q = 0; q < 4; ++q) { const bf16x8 a0f = ldA(lob, LBP, 0, 64 * q, li, g), a1f = ldA(lob, LBP, 0, 64 * q + 32, li, g);
#pragma unroll
            for (int c2 = 0; c2 < 2; ++c2) { const int ci = 2 * C.wave + c2;
                f32x4 acc = {0.f, 0.f, 0.f, 0.f}; acc = mfma16(a0f, lrf[q][c2][0], acc); acc = mfma16(a1f, lrf[q][c2][1], acc);
#pragma unroll
                for (int r = 0; r < 4; ++r) pre[(q * 16 + 4 * g + r) * 256 + 16 * ci + li] = acc[r]; } }
        __syncthreads();
        if (grp + C.G < ROWS / 13) LIN_FETCH(grp + C.G);
#pragma unroll
        for (int j = 0; j < 7; ++j) if (j < nj) { const int row = row0 + j, rl = 7 * half + j;
            const bool first = (row == 0) || (row == NCTX), last = (row == NCTX - 1) || (row == ROWS - 1);
            const float m0 = first ? 0.f : 1.f, m2 = last ? 0.f : 1.f;
            const float r = cr1 * xr[j + 1] + m0 * cr0 * xr[j] + m2 * cr2 * xr[j + 2], k = ck1 * xk[j + 1] + m0 * ck0 * xk[j] + m2 * ck2 * xk[j + 2], v = cv1 * xv[j + 1] + m0 * cv0 * xv[j] + m2 * cv2 * xv[j + 2];
            float kk = k * kkc; const float n2 = wave_sum(kk * kk, lane); kk *= rsqrtf(fmaxf(n2, 1e-24f));
            float* sc = SC + (size_t)row * 9 * 256; sc[c] = r; sc[256 + c] = v; sc[512 + c] = -kk;
#pragma unroll
            for (int d = 0; d < 2; ++d) { const float wp = w0c[d] + pre[(d * 16 + rl) * 256 + c], ap = a0c[d] + pre[((2 + d) * 16 + rl) * 256 + c];
                const float nw = -wp, sp = fmaxf(nw, 0.f) + log1pf(__expf(-fabsf(nw)));
                const float lw = -__expf(-sp - 0.5f);
                const float as = sigmoidf_(ap);
                sc[(3 + 3 * d) * 256 + c] = lw; sc[(4 + 3 * d) * 256 + c] = k * (1.0f + (as - 1.0f) * kac); sc[(5 + 3 * d) * 256 + c] = kk * as; } }
    }
#undef LIN_FETCH
    __syncthreads();
}
constexpr int FP = 136;
constexpr int F_TABC = 0, F_TABS = 128 * FP * 2, F_TILE = 2 * 128 * FP * 2;
__device__ __forceinline__ void fourier_load_tables(const Ctx& C) {
    const bf16* ft = (const bf16*)(C.ws + WS_FTAB);
    for (int i = C.tid; i < 2 * 128 * 16; i += NTHR) { const int tb = i >> 11, r = (i >> 4) & 127, c8 = i & 15;
        *(LAS u32x4*)(C.lds + tb * F_TABS + (r * FP + 8 * c8) * 2) = *(const u32x4*)(ft + tb * 16384 + r * 128 + 8 * c8); }
}
__device__ __forceinline__ void mix1_fourier1(const Ctx& C) {
    const bf16* P = (const bf16*)(C.ws + WS_P); const float* tw = (const float*)(C.ws + WS_TW);
    bf16* FYR = (bf16*)(C.ws + WS_FYR); bf16* FYI = (bf16*)(C.ws + WS_FYI);
    const int lane = C.lane, li = lane & 15, g = lane >> 4, w = C.wave;
    __syncthreads();
    fourier_load_tables(C);
    for (int u = C.wg; u < 256; u += C.G) {
        const int t2 = u >> 1, ch0 = (u & 1) * 128;
        __syncthreads();
        for (int i = C.tid; i < 128 * 16; i += NTHR) { const int t1 = i >> 4, c8 = i & 15;
            *(LAS u32x4*)(C.lds + F_TILE + (t1 * FP + 8 * c8) * 2) = *(const u32x4*)(P + (size_t)(NCTX + 128 * t1 + t2) * INWP + C_BU + ch0 + 8 * c8); }
        __syncthreads();
        bf16x8 af[4];
#pragma unroll
        for (int ks = 0; ks < 4; ++ks) af[ks] = ldT(C.lds + F_TILE, FP, 32 * ks, 16 * w, li, g);
#pragma unroll 1
        for (int ni = 0; ni < 8; ++ni) { f32x4 dc = {0.f, 0.f, 0.f, 0.f}, ds = {0.f, 0.f, 0.f, 0.f};
#pragma unroll
            for (int ks = 0; ks < 4; ++ks) { dc = mfma16(af[ks], ldA(C.lds + F_TABC, FP, 16 * ni, 32 * ks, li, g), dc); ds = mfma16(af[ks], ldA(C.lds + F_TABS, FP, 16 * ni, 32 * ks, li, g), ds); }
            const int k1 = 16 * ni + li; const float cp = tw[t2 * k1], sp = tw[16384 + t2 * k1];
            const f32x4 yr = dc * cp - ds * sp, yi = -(ds * cp) - dc * sp;
            const size_t o = ((size_t)k1 * 128 + t2) * 256 + ch0 + 16 * w + 4 * g;
            u32x2 wr; wr.x = pk2(yr[0], yr[1]); wr.y = pk2(yr[2], yr[3]); *(u32x2*)(FYR + o) = wr;
            u32x2 wi; wi.x = pk2(yi[0], yi[1]); wi.y = pk2(yi[2], yi[3]); *(u32x2*)(FYI + o) = wi; }
    }
    __syncthreads();
}
__device__ __forceinline__ void fourier2_mfma(const Ctx& C, int l, int wg0) {
    const bf16* FYR = (const bf16*)(C.ws + WS_FYR); const bf16* FYI = (const bf16*)(C.ws + WS_FYI); bf16* MIX = (bf16*)(C.ws + WS_MIX);
    const int lane = C.lane, li = lane & 15, g = lane >> 4, w = C.wave;
    constexpr int YP = 72, F_YR = F_TILE, F_YI = F_TILE + 128 * YP * 2;
    __syncthreads();
    fourier_load_tables(C);
    bf16x8 mff[16];
    { const bf16x8* mf = (const bf16x8*)((const bf16*)(C.ws + WS_FTAB) + 32768) + (size_t)(l * 4 + ((C.wg - wg0) & 3)) * 16 * 64;
#pragma unroll
      for (int k = 0; k < 16; ++k) mff[k] = mf[k * 64 + lane]; }
    for (int u = C.wg - wg0; u < 512; u += C.G - wg0) {
        const int k1 = u >> 2, gq = u & 3;
        __syncthreads();
        for (int i = C.tid; i < 2 * 128 * 8; i += NTHR) { const int im = i >> 10, t2 = (i >> 3) & 127, c8 = i & 7;
            *(LAS u32x4*)(C.lds + (im ? F_YI : F_YR) + (t2 * YP + 8 * c8) * 2) = *(const u32x4*)((im ? FYI : FYR) + ((size_t)k1 * 128 + t2) * 256 + gq * 64 + 8 * c8); }
        __syncthreads();
        bf16x8 bc[4], bs[4];
#pragma unroll
        for (int ks = 0; ks < 4; ++ks) { bc[ks] = ldA(C.lds + F_TABC, FP, 16 * w, 32 * ks, li, g); bs[ks] = ldA(C.lds + F_TABS, FP, 16 * w, 32 * ks, li, g); }
        f32x4 xr[4], xi[4];
#pragma unroll
        for (int ci = 0; ci < 4; ++ci) { xr[ci] = (f32x4){0.f, 0.f, 0.f, 0.f}; f32x4 xs = {0.f, 0.f, 0.f, 0.f}; xi[ci] = xs;
#pragma unroll
            for (int ks = 0; ks < 4; ++ks) { const bf16x8 ar = ldT(C.lds + F_YR, YP, 32 * ks, 16 * ci, li, g), ai = ldT(C.lds + F_YI, YP, 32 * ks, 16 * ci, li, g);
                xr[ci] = mfma16(ar, bc[ks], xr[ci]); xr[ci] = mfma16(ai, bs[ks], xr[ci]);
                xi[ci] = mfma16(ai, bc[ks], xi[ci]); xs = mfma16(ar, bs[ks], xs); }
            xi[ci] = xi[ci] - xs; }
        union { bf16x8 v; unsigned q[4]; } xb[4];
#pragma unroll
        for (int q2 = 0; q2 < 2; ++q2) { xb[q2].q[0] = pk2(xr[2 * q2][0], xr[2 * q2][1]); xb[q2].q[1] = pk2(xr[2 * q2][2], xr[2 * q2][3]); xb[q2].q[2] = pk2(xr[2 * q2 + 1][0], xr[2 * q2 + 1][1]); xb[q2].q[3] = pk2(xr[2 * q2 + 1][2], xr[2 * q2 + 1][3]);
            xb[2 + q2].q[0] = pk2(xi[2 * q2][0], xi[2 * q2][1]); xb[2 + q2].q[1] = pk2(xi[2 * q2][2], xi[2 * q2][3]); xb[2 + q2].q[2] = pk2(xi[2 * q2 + 1][0], xi[2 * q2 + 1][1]); xb[2 + q2].q[3] = pk2(xi[2 * q2 + 1][2], xi[2 * q2 + 1][3]); }
#pragma unroll
        for (int ei = 0; ei < 4; ++ei) { f32x4 o = {0.f, 0.f, 0.f, 0.f};
#pragma unroll
            for (int ks2 = 0; ks2 < 4; ++ks2) o = mfma16(mff[ei * 4 + ks2], xb[ks2].v, o);
            const int tp = k1 + 128 * (16 * w + li);
            u32x2 wo; wo.x = pk2(o[0], o[1]); wo.y = pk2(o[2], o[3]); *(u32x2*)(MIX + (size_t)(NCTX + tp) * DM + 256 + gq * 64 + 16 * ei + 4 * g) = wo; }
    }
    __syncthreads();
}

constexpr float LOG2E = 1.4426950408889634f;
typedef short bf16x4 __attribute__((ext_vector_type(4)));
__device__ __forceinline__ void attn_load(const bf16* P, const bf16* VT, int krow, int kcol, int li, int g, bf16x8 (&kf)[2][2], bf16x8 (&vf)[4]) {
#pragma unroll
    for (int t = 0; t < 2; ++t)
#pragma unroll
        for (int ks = 0; ks < 2; ++ks) kf[t][ks] = ldg8(P + (size_t)(krow + 16 * t + li) * INWP + kcol + 32 * ks + 8 * g);
#pragma unroll
    for (int dt = 0; dt < 4; ++dt) { const bf16* vp = VT + (size_t)(dt * 16 + li) * VTP + krow + 4 * g;
        const bf16x4 a = *(const bf16x4*)vp, b = *(const bf16x4*)(vp + 16); vf[dt] = (bf16x8){a[0], a[1], a[2], a[3], b[0], b[1], b[2], b[3]}; }
}
template <int NS, int NT>
__device__ __forceinline__ void attn_compute(const bf16x8 (&kf)[2][2], const bf16x8 (&vf)[4], const bf16x8 (&qf)[NS][2], f32x4 (&o)[NS][4], float (&m)[NS], float (&ls)[NS],
                                             const float (&add)[NT][2][4], int li, int g) {
#pragma unroll
    for (int hh = 0; hh < NS; ++hh) {
        f32x4 st[2];
#pragma unroll
        for (int t = 0; t < 2; ++t) { st[t] = (f32x4){0.f, 0.f, 0.f, 0.f};
#pragma unroll
            for (int ks = 0; ks < 2; ++ks) st[t] = __builtin_amdgcn_mfma_f32_16x16x32_bf16(kf[t][ks], qf[hh][ks], st[t], 0, 0, 0); }
        float s[8]; float bm = -INFINITY;
#pragma unroll
        for (int t = 0; t < 2; ++t)
#pragma unroll
            for (int r = 0; r < 4; ++r) { const float ad = add[hh / (NS / NT)][t][r]; s[4 * t + r] = (ad == -INFINITY) ? -INFINITY : st[t][r] * (0.125f * LOG2E) + ad; bm = fmaxf(bm, s[4 * t + r]); }
        bm = fmaxf(bm, shx(bm, 16, 16 * g + li)); bm = fmaxf(bm, shx(bm, 32, 16 * g + li));
        const float mn = fmaxf(m[hh], bm), corr = __builtin_amdgcn_exp2f(m[hh] - mn); m[hh] = mn;
        float ps = 0.f; float pe[8];
#pragma unroll
        for (int e = 0; e < 8; ++e) { pe[e] = __builtin_amdgcn_exp2f(s[e] - mn); ps += pe[e]; }
        ls[hh] = ls[hh] * corr + ps;
        union { bf16x8 v; unsigned u[4]; } pf;
#pragma unroll
        for (int e2 = 0; e2 < 4; ++e2) pf.u[e2] = pk2(pe[2 * e2], pe[2 * e2 + 1]);
#pragma unroll
        for (int dt = 0; dt < 4; ++dt) { o[hh][dt] = o[hh][dt] * corr; o[hh][dt] = __builtin_amdgcn_mfma_f32_16x16x32_bf16(vf[dt], pf.v, o[hh][dt], 0, 0, 0); }
    }
}
__device__ __forceinline__ void attn_finish1(bf16* MIX, int qrow0, int ocol, f32x4 (&o)[4], float m, float ls, bool has_sink, float sink2, int li, int g) {
    float l = ls; l += shx(l, 16, 16 * g + li); l += shx(l, 32, 16 * g + li);
    float corr = 1.f;
    if (has_sink) { const float mn = fmaxf(m, sink2); corr = __builtin_amdgcn_exp2f(m - mn); l = l * corr + __builtin_amdgcn_exp2f(sink2 - mn); }
    const float inv = corr / l;
#pragma unroll
    for (int dt = 0; dt < 4; ++dt) { const f32x4 v = o[dt] * inv; u32x2 w; w.x = pk2(v[0], v[1]); w.y = pk2(v[2], v[3]);
        *(u32x2*)(MIX + (size_t)(qrow0 + li) * DM + ocol + dt * 16 + 4 * g) = w; }
}
__device__ __forceinline__ void attnA_unit(const Ctx& C, const float* asink_l, int unit, bool lat) {
    const bf16* P = (const bf16*)(C.ws + WS_P); bf16* MIX = (bf16*)(C.ws + WS_MIX);
    const int li = C.lane & 15, g = C.lane >> 4;
    const int nqp = lat ? SEQ / 32 : NCTX / 32, kvh = unit / nqp, qp = unit % nqp, t0 = qp * 32, qrow0 = (lat ? NCTX : 0) + t0;
    const bf16* VT = (const bf16*)(C.ws + WS_VTA) + (size_t)kvh * 64 * VTP; const int kcol = C_AK + kvh * 64;
    bf16x8 qf[4][2];
#pragma unroll
    for (int s = 0; s < 4; ++s)
#pragma unroll
        for (int ks = 0; ks < 2; ++ks) qf[s][ks] = ldg8(P + (size_t)(qrow0 + 16 * (s >> 1) + li) * INWP + C_AQ + (kvh * 2 + (s & 1)) * 64 + 32 * ks + 8 * g);
    f32x4 o[4][4]; float m[4], ls[4];
#pragma unroll
    for (int s = 0; s < 4; ++s) { m[s] = -1.0e30f; ls[s] = 0.f;
#pragma unroll
        for (int dt = 0; dt < 4; ++dt) o[s][dt] = (f32x4){0.f, 0.f, 0.f, 0.f}; }
    const int b_lo = lat ? 0 : 9;
#pragma unroll 1
    for (int bb = b_lo; bb < 17; ++bb) { float add[2][2][4]; bf16x8 kf[2][2], vf[4];
        const int krow = (bb < 9) ? NCTX + t0 - 128 + 32 * bb : 32 * (bb - 9);
        attn_load(P, VT, krow, kcol, li, g, kf, vf);
#pragma unroll
        for (int tl = 0; tl < 2; ++tl)
#pragma unroll
            for (int tt = 0; tt < 2; ++tt)
#pragma unroll
                for (int r = 0; r < 4; ++r) { const int j = t0 - 128 + 32 * bb + 16 * tt + 4 * g + r, t = t0 + 16 * tl + li;
                    const bool ok = (bb >= 9) || ((j >= 0) && (j < SEQ) && (j - t <= 128) && (t - j <= 128)); add[tl][tt][r] = ok ? 0.f : -INFINITY; }
        attn_compute<4, 2>(kf, vf, qf, o, m, ls, add, li, g); }
#pragma unroll
    for (int s = 0; s < 4; ++s) attn_finish1(MIX, qrow0 + 16 * (s >> 1), (kvh * 2 + (s & 1)) * 64, o[s], m[s], ls[s], true, asink_l[kvh * 2 + (s & 1)] * LOG2E, li, g);
}
__device__ __forceinline__ void attnC_unit(const Ctx& C, const LAS float* relb, int h, int up, bool lat) {
    const bf16* P = (const bf16*)(C.ws + WS_P); bf16* MIX = (bf16*)(C.ws + WS_MIX);
    const int li = C.lane & 15, g = C.lane >> 4;
    const int rp = up >> 2, cj = up & 3;
    const int t0a = lat ? (2 * rp) * 64 + 16 * cj : 32 * up, tstep = lat ? 64 : 16, qbase = lat ? NCTX : 0;
    const bf16* VT = (const bf16*)(C.ws + WS_VTC) + (size_t)h * 64 * VTP; const int kcol = C_CK + h * 64;
    bf16x8 qf[2][2];
#pragma unroll
    for (int s = 0; s < 2; ++s)
#pragma unroll
        for (int ks = 0; ks < 2; ++ks) qf[s][ks] = ldg8(P + (size_t)(qbase + t0a + tstep * s + li) * INWP + C_CQ + h * 64 + 32 * ks + 8 * g);
    f32x4 o[2][4]; float m[2] = {-1.0e30f, -1.0e30f}, ls[2] = {0.f, 0.f};
#pragma unroll
    for (int s = 0; s < 2; ++s)
#pragma unroll
        for (int dt = 0; dt < 4; ++dt) o[s][dt] = (f32x4){0.f, 0.f, 0.f, 0.f};
    const int r = 2 * rp, cq = cj * 16 + li;
    int r0a = r - 4; r0a = r0a < 0 ? 0 : (r0a > 248 ? 248 : r0a); int r0b = r - 3; r0b = r0b < 0 ? 0 : (r0b > 248 ? 248 : r0b);
    int c0 = cq - 8; c0 = c0 < 0 ? 0 : (c0 > 48 ? 48 : c0);
    const int cw0 = (cj == 0) ? 0 : (cj == 1) ? 8 : (cj == 2) ? 24 : 32;
    const int b_lo = lat ? 0 : 9;
#pragma unroll 1
    for (int bb = b_lo; bb < 17; ++bb) { float add[2][2][4]; bf16x8 kf[2][2], vf[4];
        const int kr = r0a + bb;
        if (bb < 9 && kr >= r0b + 8) continue;
        const int krow = (bb < 9) ? NCTX + kr * 64 + cw0 : 32 * (bb - 9);
        attn_load(P, VT, krow, kcol, li, g, kf, vf);
#pragma unroll
        for (int tl = 0; tl < 2; ++tl) { const int r0t = tl ? r0b : r0a, rt = r + tl; const bool rowok = (bb >= 9) || (kr >= r0t && kr < r0t + 8);
            int bi = kr - rt + 7; bi = bi < 0 ? 0 : (bi > 14 ? 14 : bi); const LAS float* rbp = relb + bi * 31;
#pragma unroll
            for (int tt = 0; tt < 2; ++tt)
#pragma unroll
                for (int rr = 0; rr < 4; ++rr) { const int kc = cw0 + 16 * tt + 4 * g + rr; int ci = kc - cq + 15; ci = ci < 0 ? 0 : (ci > 30 ? 30 : ci); const float bv = rbp[ci];
                    add[tl][tt][rr] = (bb >= 9) ? 0.f : ((rowok && kc >= c0 && kc < c0 + 16) ? bv : -INFINITY); } }
        attn_compute<2, 2>(kf, vf, qf, o, m, ls, add, li, g); }
#pragma unroll
    for (int s = 0; s < 2; ++s) attn_finish1(MIX, qbase + t0a + tstep * s, 512 + h * 64, o[s], m[s], ls[s], false, 0.f, li, g);
}
__device__ __forceinline__ void fourier_ctx_mfma(const Ctx& C, int l, int wg0) {
    const bf16* P = (const bf16*)(C.ws + WS_P); bf16* MIX = (bf16*)(C.ws + WS_MIX); const bf16* f2 = (const bf16*)(C.ws + WS_F256);
    const int lane = C.lane, li = lane & 15, g = lane >> 4, w = C.wave;
    constexpr int UP = 72;
    for (int u = C.wg - wg0; u < 8; u += C.G - wg0) {
        const int tb = u >> 2, gq = u & 3;
        __syncthreads();
        for (int i = C.tid; i < 256 * 8; i += NTHR) { const int t = i >> 3, c8 = i & 7; *(LAS u32x4*)(C.lds + (t * UP + 8 * c8) * 2) = *(const u32x4*)(P + (size_t)t * INWP + C_BU + gq * 64 + 8 * c8); }
        __syncthreads();
        const int tp0 = 128 * tb + 16 * w;
        f32x4 xr[4], xi[4];
#pragma unroll
        for (int ci = 0; ci < 4; ++ci) { xr[ci] = (f32x4){0.f, 0.f, 0.f, 0.f}; xi[ci] = (f32x4){0.f, 0.f, 0.f, 0.f}; }
#pragma unroll 2
        for (int ks = 0; ks < 8; ++ks) { const bf16x8 bc = ldg8(f2 + (size_t)(tp0 + li) * 256 + 32 * ks + 8 * g), bs = ldg8(f2 + 65536 + (size_t)(tp0 + li) * 256 + 32 * ks + 8 * g);
#pragma unroll
            for (int ci = 0; ci < 4; ++ci) { const bf16x8 au = ldT(C.lds, UP, 32 * ks, 16 * ci, li, g); xr[ci] = mfma16(au, bc, xr[ci]); xi[ci] = mfma16(au, bs, xi[ci]); } }
        union { bf16x8 v; unsigned q[4]; } xb[4];
#pragma unroll
        for (int q2 = 0; q2 < 2; ++q2) { xb[q2].q[0] = pk2(xr[2 * q2][0], xr[2 * q2][1]); xb[q2].q[1] = pk2(xr[2 * q2][2], xr[2 * q2][3]); xb[q2].q[2] = pk2(xr[2 * q2 + 1][0], xr[2 * q2 + 1][1]); xb[q2].q[3] = pk2(xr[2 * q2 + 1][2], xr[2 * q2 + 1][3]);
            xb[2 + q2].q[0] = pk2(-xi[2 * q2][0], -xi[2 * q2][1]); xb[2 + q2].q[1] = pk2(-xi[2 * q2][2], -xi[2 * q2][3]); xb[2 + q2].q[2] = pk2(-xi[2 * q2 + 1][0], -xi[2 * q2 + 1][1]); xb[2 + q2].q[3] = pk2(-xi[2 * q2 + 1][2], -xi[2 * q2 + 1][3]); }
        const bf16x8* mf = (const bf16x8*)((const bf16*)(C.ws + WS_FTAB) + 32768) + (size_t)(l * 4 + gq) * 16 * 64;
#pragma unroll
        for (int ei = 0; ei < 4; ++ei) { f32x4 o = {0.f, 0.f, 0.f, 0.f};
#pragma unroll
            for (int ks2 = 0; ks2 < 4; ++ks2) o = mfma16(mf[(ei * 4 + ks2) * 64 + lane], xb[ks2].v, o);
            o = o * 8.0f;
            u32x2 wo; wo.x = pk2(o[0], o[1]); wo.y = pk2(o[2], o[3]); *(u32x2*)(MIX + (size_t)(tp0 + li) * DM + 256 + gq * 64 + 16 * ei + 4 * g) = wo; }
    }
    __syncthreads();
}
__device__ __forceinline__ void fourier2_unit(const Ctx& C, int l, int u, bool ctx) {
    const bf16* P = (const bf16*)(C.ws + WS_P); const float* tw = (const float*)(C.ws + WS_TW); bf16* MIX = (bf16*)(C.ws + WS_MIX);
    const float* FYR = (const float*)(C.ws + WS_FYR); const float* FYI = (const float*)(C.ws + WS_FYI);
    const float* mt = (const float*)(C.ws + WS_MTAB) + (size_t)l * 2 * 4 * 4096;
    LAS float* xr = (LAS float*)(C.lds + 8192); LAS float* xi = xr + 512;
    const int tl = C.tid >> 8, ch = C.tid & 255, tp = 2 * u + tl;
    float sr = 0.f, si = 0.f;
    if (!ctx) { const int k1 = tp & 127, k2 = tp >> 7; const float* yr = FYR + (size_t)k1 * 128 * 256 + ch; const float* yi = FYI + (size_t)k1 * 128 * 256 + ch;
#pragma unroll 8
        for (int t2 = 0; t2 < 128; ++t2) { const int m = ((t2 * k2) & 127) * 128; const float c = tw[m], s = tw[16384 + m]; const float a = yr[t2 * 256], b = yi[t2 * 256]; sr += a * c + b * s; si += b * c - a * s; } }
    else {
#pragma unroll 8
        for (int t = 0; t < NCTX; ++t) { const int m = ((t * tp) & 255) * 64; const float x = bf2f(P[(size_t)t * INWP + C_BU + ch]); sr += x * tw[m]; si -= x * tw[16384 + m]; } }
    __syncthreads();
    xr[tl * 256 + ch] = sr; xi[tl * 256 + ch] = si;
    __syncthreads();
    const int g = ch >> 6, e = ch & 63; const float* mc = mt + (size_t)(0 * 4 + g) * 4096 + e; const float* ms = mt + (size_t)(1 * 4 + g) * 4096 + e;
    const LAS float* xrp = xr + tl * 256 + g * 64; const LAS float* xip = xi + tl * 256 + g * 64; float o = 0.f;
#pragma unroll 8
    for (int c = 0; c < 64; ++c) o += xrp[c] * mc[c * 64] + xip[c] * ms[c * 64];
    o *= ctx ? (1.0f / 128.0f) : (1.0f / 1024.0f);
    MIX[(size_t)((ctx ? 0 : NCTX) + tp) * DM + 256 + ch] = (bf16)f2bf(o);
}
__device__ __forceinline__ void rwkv_passB(const Ctx& C, int b);
__device__ __forceinline__ void phase_mix2(const Ctx& C, const DArgs& a, int l) {
    const bool emit_ctx = l < DEPTH - 1;
#ifndef REPMASK
#define REPMASK 0
#endif
#define NREP2(o) ((((REPMASK) >> (o)) & 1) ? 2 : 1)
    if (C.wg < 8) { for (int r2 = 0; r2 < NREP2(16); ++r2) rwkv_passB(C, C.wg); }
    else if (emit_ctx) fourier_ctx_mfma(C, l, 8);
    { const float* asink_l = a.in[I_ASINK] + l * 4; const float* crel = a.in[I_CREL] + (size_t)l * 4 * 465;
      LAS float* relb = (LAS float*)(C.lds + 110592 + C.wave * 2048);
      for (int r2 = 0; r2 < NREP2(17); ++r2) {
      unsigned* qhead = (unsigned*)(C.ws + WS_CTL) + CW_WQ + 64 * l + 16 * r2;
      const int nA = 2 * (SEQ / 32), nC = 4 * (SEQ / 32), nAc = emit_ctx ? 2 * (NCTX / 32) : 0, nCc = emit_ctx ? 4 * (NCTX / 32) : 0, nAll = nA + nAc + nC + nCc;
      int hcur = -1;
      const int nCv = emit_ctx ? CV_NCHUNK : 0;
      for (;;) { unsigned uq = 0; if (C.lane == 0) uq = __hip_atomic_fetch_add(qhead, 1u, __ATOMIC_RELAXED, __HIP_MEMORY_SCOPE_AGENT);
          const int uraw = __builtin_amdgcn_readfirstlane((int)uq); if (uraw >= nAll + nCv) break;
          int u;
          if (uraw < 2 * nCv) { if (uraw & 1) { const int ch = uraw >> 1; convert_moe_items(C, a, l + 1, ch * CV_CHUNK, ch * CV_CHUNK + CV_CHUNK); continue; } u = uraw >> 1; }
          else u = uraw - nCv;
          if (u < nA) attnA_unit(C, asink_l, u, true);
          else if (u < nA + nAc) attnA_unit(C, asink_l, u - nA, false);
          else { const int uc = u - nA - nAc; const bool lat = uc < nC; const int uu = lat ? uc : uc - nC, nqt = lat ? SEQ / 32 : NCTX / 32, h = uu / nqt, qt = uu % nqt;
              if (h != hcur) { for (int i = C.lane; i < 465; i += 64) relb[i] = crel[h * 465 + i] * LOG2E; hcur = h; LDS_WAIT(); asm volatile("" ::: "memory"); }
              attnC_unit(C, relb, h, qt, lat); } } } }
    __syncthreads();
    for (int r2 = 0; r2 < NREP2(19); ++r2) fourier2_mfma(C, l, 0);
}

constexpr int RW_C = 32, RW_NCH = ROWS / RW_C, RW_SC = 20, RW_NSC = RW_NCH / RW_SC;
constexpr int RW_SLOT = 5120, RW_REGION = 9 * RW_SLOT + 1024;
constexpr int TP = 72, HP = 40;
static_assert(3 * RW_REGION <= MISC_OFF, "RWKV D1 regions below the misc area");
__device__ __forceinline__ int rw_rc_of(int d, int c) { return d == 0 ? c : (c < 8 ? 7 - c : 527 - c); }
__device__ __forceinline__ int rw_row_of(int d, int rc, int t) { return 32 * rc + (d == 0 ? t : 31 - t); }

__device__ __forceinline__ void rwkv_d1(const Ctx& C, LAS unsigned char* rb, int d, int h, int rc) {
    int lane_ = C.lane; asm volatile("" : "+v"(lane_));
    const int lane = lane_, li = lane & 15, g = lane >> 4;
    const float* SC = (const float*)(C.ws + WS_SC);
    LAS unsigned char* S0 = rb; LAS unsigned char* S1 = rb + RW_SLOT; LAS unsigned char* S2 = rb + 2 * RW_SLOT; LAS unsigned char* S3 = rb + 3 * RW_SLOT; LAS unsigned char* S4 = rb + 4 * RW_SLOT;
    LAS unsigned char* S5 = rb + 5 * RW_SLOT; LAS unsigned char* S6 = rb + 6 * RW_SLOT; LAS unsigned char* S7 = rb + 7 * RW_SLOT; LAS unsigned char* S8 = rb + 8 * RW_SLOT;
    LAS unsigned char* S6b = S6 + 2560; LAS unsigned char* S7b = S7 + 2560;
    LAS float* gc = (LAS float*)(rb + 9 * RW_SLOT);
    { float cum = 0.f; const int j = lane; const int qw = (3 + 3 * d) * 256;
      float rv[2][4], vv[2][4], av[2][4], lw[2][4], kd[2][4], bb[2][4];
#define RW_LD(buf, t0) do { _Pragma("unroll") for (int u = 0; u < 4; ++u) { const float* sc = SC + (size_t)rw_row_of(d, rc, (t0) + u) * 9 * 256 + h * 64 + j; \
          rv[buf][u] = sc[0]; vv[buf][u] = sc[256]; av[buf][u] = sc[512]; lw[buf][u] = sc[qw]; kd[buf][u] = sc[qw + 256]; bb[buf][u] = sc[qw + 512]; } } while (0)
#define RW_CP(buf, t0) do { _Pragma("unroll") for (int u = 0; u < 4; ++u) { const float cp = cum; cum += lw[buf][u]; const float Gt = __expf(cum), Gm = __expf(cp), iG = __expf(-cum); const int off = (((t0) + u) * TP + j) * 2; \
          *(LAS bf16*)(S0 + off) = (bf16)f2bf(av[buf][u] * Gm); *(LAS bf16*)(S1 + off) = (bf16)f2bf(rv[buf][u] * Gt); *(LAS bf16*)(S2 + off) = (bf16)f2bf(bb[buf][u] * iG); \
          *(LAS bf16*)(S3 + off) = (bf16)f2bf(kd[buf][u] * iG); *(LAS bf16*)(S4 + off) = (bf16)f2bf(vv[buf][u]); } } while (0)
      RW_LD(0, 0);
#pragma unroll
      for (int b2 = 0; b2 < 4; ++b2) { RW_LD(1, 8 * b2 + 4); __builtin_amdgcn_sched_barrier(0); RW_CP(0, 8 * b2); if (b2 < 3) RW_LD(0, 8 * b2 + 8); __builtin_amdgcn_sched_barrier(0); RW_CP(1, 8 * b2 + 4); }
#undef RW_LD
#undef RW_CP
      gc[j] = __expf(cum); }
    const f32x4 z4 = {0.f, 0.f, 0.f, 0.f};
#pragma unroll 1
    for (int ti = 0; ti < 2; ++ti)
#pragma unroll
        for (int si = 0; si < 2; ++si) {
            f32x4 n = z4, nt = z4, mk = z4, qb = z4, qk = z4;
#pragma unroll
            for (int ks = 0; ks < 2; ++ks) { const bf16x8 at = ldA(S0, TP, 16 * ti, 32 * ks, li, g), rt = ldA(S1, TP, 16 * ti, 32 * ks, li, g), bs = ldA(S2, TP, 16 * si, 32 * ks, li, g), kss = ldA(S3, TP, 16 * si, 32 * ks, li, g);
                n = mfma16(at, bs, n);
                nt = mfma16(bs, at, nt);
                mk = mfma16(kss, at, mk);
                qb = mfma16(bs, rt, qb);
                qk = mfma16(kss, rt, qk); }
#pragma unroll
            for (int r = 0; r < 4; ++r) { const int trow = 16 * ti + 4 * g + r, scol = 16 * si + li; if (!(scol < trow)) n[r] = 0.f;
                const int srow = 16 * si + 4 * g + r, tcol = 16 * ti + li; if (!(srow < tcol)) { mk[r] = 0.f; nt[r] = 0.f; } if (!(srow <= tcol)) { qb[r] = 0.f; qk[r] = 0.f; } }
            *(LAS f32x4*)(S5 + ((16 * si + li) * 32 + 16 * ti + 4 * g) * 4) = n;
            stT(S6, HP, 16 * ti + li, 16 * si + 4 * g, mk);
            stT(S8, HP, 16 * ti + li, 16 * si + 4 * g, nt);
            stT(S6b, HP, 16 * ti + li, 16 * si + 4 * g, qb);
            stT(S7, HP, 16 * ti + li, 16 * si + 4 * g, qk); }
    { const int rr = lane & 31, bq = rr >> 4, lr = rr & 15; float Tr[16];
#pragma unroll
      for (int s = 15; s >= 0; --s) { float acc = (lr == s) ? 1.f : 0.f;
#pragma unroll
          for (int c4 = 0; c4 < 4; ++c4) { if (4 * c4 + 3 > s) { const f32x4 nv = *(const LAS f32x4*)(S5 + ((16 * bq + s) * 32 + 16 * bq + 4 * c4) * 4);
#pragma unroll
              for (int e = 0; e < 4; ++e) if (4 * c4 + e > s) acc += Tr[4 * c4 + e] * nv[e]; } }
          Tr[s] = acc; }
      if (lane < 32) { u32x4 w0, w1; w0.x = pk2(Tr[0], Tr[1]); w0.y = pk2(Tr[2], Tr[3]); w0.z = pk2(Tr[4], Tr[5]); w0.w = pk2(Tr[6], Tr[7]); w1.x = pk2(Tr[8], Tr[9]); w1.y = pk2(Tr[10], Tr[11]); w1.z = pk2(Tr[12], Tr[13]); w1.w = pk2(Tr[14], Tr[15]);
          const u32x4 zz = {0u, 0u, 0u, 0u}; LAS u32x4* trow = (LAS u32x4*)(S7b + rr * HP * 2);
          trow[0] = bq ? zz : w0; trow[1] = bq ? zz : w1; trow[2] = bq ? w0 : zz; trow[3] = bq ? w1 : zz; }
      f32x4 x = mfma16(ldA(S8, HP, 16, 0, li, g), ldT(S7b, HP, 0, 0, li, g), z4);
      LAS unsigned char* XT = S8 + 2560;
      *(LAS u32x2*)(XT + (li * HP + 4 * g) * 2) = (u32x2){0u, 0u}; stT(XT, HP, li, 16 + 4 * g, x);
      const f32x4 t21 = mfma16(ldA(S7b, HP, 16, 0, li, g), ldA(XT, HP, 0, 0, li, g), z4);
#pragma unroll
      for (int r = 0; r < 4; ++r) *(LAS bf16*)(S7b + ((16 + 4 * g + r) * HP + li) * 2) = (bf16)f2bf(t21[r]); }
#pragma unroll
    for (int ti = 0; ti < 2; ++ti) { const bf16x8 tf = ldA(S7b, HP, 16 * ti, 0, li, g), mf = ldA(S6, HP, 16 * ti, 0, li, g);
#pragma unroll
        for (int ji = 0; ji < 4; ++ji) { const f32x4 ap = mfma16(tf, ldT(S0, TP, 0, 16 * ji, li, g), z4); stT(S8, HP, 16 * ji + li, 16 * ti + 4 * g, ap);
            const f32x4 mv = mfma16(mf, ldT(S4, TP, 0, 16 * ji, li, g), z4); stT(S5, HP, 16 * ji + li, 16 * ti + 4 * g, mv); } }
#pragma unroll
    for (int ti = 0; ti < 2; ++ti) { const bf16x8 tf = ldA(S7b, HP, 16 * ti, 0, li, g);
#pragma unroll
        for (int vi = 0; vi < 4; ++vi) { const f32x4 ul = mfma16(tf, ldA(S5, HP, 16 * vi, 0, li, g), z4); stT(S0, HP, 16 * vi + li, 16 * ti + 4 * g, ul); } }
#pragma unroll
    for (int ti = 0; ti < 2; ++ti) { const bf16x8 qbf = ldA(S6b, HP, 16 * ti, 0, li, g), qkf = ldA(S7, HP, 16 * ti, 0, li, g);
#pragma unroll
        for (int ji = 0; ji < 4; ++ji) { f32x4 rp = mfma16(ldA(S8, HP, 16 * ji, 0, li, g), qbf, z4);
            LAS unsigned char* p = S1 + ((16 * ti + li) * TP + 16 * ji + 4 * g) * 2; rp = rp + ld4bf(p); u32x2 w; w.x = pk2(rp[0], rp[1]); w.y = pk2(rp[2], rp[3]); *(LAS u32x2*)p = w;
            f32x4 yl = mfma16(qbf, ldA(S0, HP, 16 * ji, 0, li, g), z4); yl = mfma16(qkf, ldT(S4, TP, 0, 16 * ji, li, g), yl);
            stT(S5, HP, 16 * ji + li, 16 * ti + 4 * g, yl); } }
#pragma unroll 2
    for (int ji = 0; ji < 4; ++ji) { const bf16x8 bt = ldT(S2, TP, 0, 16 * ji, li, g); const float gj = gc[16 * ji + li];
#pragma unroll
        for (int jp = 0; jp < 4; ++jp) { f32x4 pt = mfma16(ldA(S8, HP, 16 * jp, 0, li, g), bt, z4);
#pragma unroll
            for (int r = 0; r < 4; ++r) pt[r] = pt[r] * gj + ((16 * jp + 4 * g + r == 16 * ji + li) ? gj : 0.f);
            stT(S6, TP, 16 * ji + li, 16 * jp + 4 * g, pt); } }
#pragma unroll 1
    for (int vh = 0; vh < 2; ++vh) { f32x4 lt[4][2];
#pragma unroll
      for (int ji = 0; ji < 4; ++ji) { const bf16x8 ba = ldT(S2, TP, 0, 16 * ji, li, g), ka = ldT(S3, TP, 0, 16 * ji, li, g); const f32x4 gv = *(const LAS f32x4*)(gc + 16 * ji + 4 * g);
#pragma unroll
          for (int v2 = 0; v2 < 2; ++v2) { const int vi = 2 * vh + v2; f32x4 x = mfma16(ba, ldA(S0, HP, 16 * vi, 0, li, g), z4); x = mfma16(ka, ldT(S4, TP, 0, 16 * vi, li, g), x); lt[ji][v2] = x * gv; } }
      asm volatile("s_waitcnt lgkmcnt(0)" ::: "memory");
      LAS unsigned char* dst = vh ? S2 : S8;
#pragma unroll
      for (int ji = 0; ji < 4; ++ji)
#pragma unroll
          for (int v2 = 0; v2 < 2; ++v2) stT(dst, TP, 16 * v2 + li, 16 * ji + 4 * g, lt[ji][v2]); }
}
__device__ __forceinline__ void rwkv_passA_step(const Ctx& C, const LAS unsigned char* rb, f32x4 (&hs)[4], int d, int h, int rc) {
    int lane_ = C.lane; asm volatile("" : "+v"(lane_));
    const int lane = lane_, li = lane & 15, g = lane >> 4; const bool isPhi = C.wave >= 4; const int col = 16 * (C.wave & 3) + li;
    const LAS unsigned char* S1 = rb + RW_SLOT; const LAS unsigned char* S2 = rb + 2 * RW_SLOT; const LAS unsigned char* S5 = rb + 5 * RW_SLOT; const LAS unsigned char* S6 = rb + 6 * RW_SLOT;
    const LAS unsigned char* LTb = (col < 32) ? rb + 8 * RW_SLOT + col * TP * 2 : S2 + (col - 32) * TP * 2;
    union { bf16x8 v; unsigned u[4]; } bf[2];
#pragma unroll
    for (int ks = 0; ks < 2; ++ks) { bf[ks].u[0] = pk2(hs[2 * ks][0], hs[2 * ks][1]); bf[ks].u[1] = pk2(hs[2 * ks][2], hs[2 * ks][3]); bf[ks].u[2] = pk2(hs[2 * ks + 1][0], hs[2 * ks + 1][1]); bf[ks].u[3] = pk2(hs[2 * ks + 1][2], hs[2 * ks + 1][3]); }
#pragma unroll
    for (int ti = 0; ti < 2; ++ti) { f32x4 acc = isPhi ? (f32x4){0.f, 0.f, 0.f, 0.f} : ld4bf(S5 + (col * HP + 16 * ti + 4 * g) * 2);
#pragma unroll
        for (int ks = 0; ks < 2; ++ks) acc = mfma16(ldAperm(S1, TP, 16 * ti, ks, li, g), bf[ks].v, acc);
        if (!isPhi) { float* ys = (float*)(C.ws + WS_YS) + (size_t)d * ROWS * 256 + h * 64 + col;
#pragma unroll
            for (int r = 0; r < 4; ++r) ys[(size_t)rw_row_of(d, rc, 16 * ti + 4 * g + r) * 256] = acc[r]; }
        else { bf16* rp = (bf16*)(C.ws + WS_RPP) + ((size_t)((d * 4 + h) * RW_NCH + rc) * 32) * 64 + col;
#pragma unroll
            for (int r = 0; r < 4; ++r) rp[(16 * ti + 4 * g + r) * 64] = (bf16)f2bf(acc[r]); } }
    f32x4 hn[4];
#pragma unroll
    for (int i = 0; i < 4; ++i) { f32x4 acc = isPhi ? (f32x4){0.f, 0.f, 0.f, 0.f} : ld4bf(LTb + (16 * i + 4 * g) * 2);
#pragma unroll
        for (int ks = 0; ks < 2; ++ks) acc = mfma16(ldAperm(S6, TP, 16 * i, ks, li, g), bf[ks].v, acc);
        hn[i] = acc; }
#pragma unroll
    for (int i = 0; i < 4; ++i) hs[i] = hn[i];
}
__device__ __forceinline__ void phase_rwkv1(const Ctx& C) {
    const int lane = C.lane, li = lane & 15, g = lane >> 4;
    for (int u = C.wg; u < 8 * RW_NSC; u += C.G) {
        const int s = u % RW_NSC, dh = u / RW_NSC, d = dh >> 2, h = dh & 3; const bool isPhi = C.wave >= 4; const int col = 16 * (C.wave & 3) + li;
        f32x4 hs[4];
#pragma unroll
        for (int i = 0; i < 4; ++i)
#pragma unroll
            for (int r = 0; r < 4; ++r) hs[i][r] = (isPhi && (16 * i + 4 * g + r == col)) ? 1.f : 0.f;
#pragma unroll 1
        for (int rnd = 0; rnd < (RW_SC + 2) / 3; ++rnd) {
            __syncthreads();
            { int wv = C.wave; asm volatile("" : "+s"(wv)); if (wv < 3 && 3 * rnd + wv < RW_SC) rwkv_d1(C, C.lds + wv * RW_REGION, d, h, rw_rc_of(d, s * RW_SC + 3 * rnd + wv)); }
            __syncthreads();
#pragma unroll 1
            for (int k = 0; k < 3; ++k) { const int ci = 3 * rnd + k; int ko = k * RW_REGION; asm volatile("" : "+s"(ko)); if (ci < RW_SC) rwkv_passA_step(C, C.lds + ko, hs, d, h, rw_rc_of(d, s * RW_SC + ci)); }
        }
        if (isPhi) { bf16* pf = (bf16*)(C.ws + WS_PSC) + (size_t)(dh * RW_NSC + s) * 4096;
            const int ks = col >> 5, eh = (col >> 4) & 1, gp = (col >> 2) & 3, el = col & 3;
#pragma unroll
            for (int i = 0; i < 4; ++i)
#pragma unroll
                for (int r = 0; r < 4; ++r) pf[((i * 2 + ks) * 64 + gp * 16 + 4 * g + r) * 8 + eh * 4 + el] = (bf16)f2bf(hs[i][r]); }
        else { f32x4* lf = (f32x4*)(C.ws + WS_LSC) + ((size_t)(dh * RW_NSC + s) * 4 + C.wave) * 4 * 64;
#pragma unroll
            for (int i = 0; i < 4; ++i) lf[i * 64 + lane] = hs[i]; }
    }
    __syncthreads();
}
__device__ __forceinline__ void rwkv_passB(const Ctx& C, int b) {
    if (C.wave >= 4) return;
    const int lane = C.lane, li = lane & 15, g = lane >> 4, q = C.wave;
    f32x4 hs[4];
#pragma unroll
    for (int i = 0; i < 4; ++i) hs[i] = (f32x4){0.f, 0.f, 0.f, 0.f};
    const bf16x8* pfb = (const bf16x8*)((const bf16*)(C.ws + WS_PSC) + (size_t)b * RW_NSC * 4096);
    const f32x4* lfb = (const f32x4*)(C.ws + WS_LSC) + ((size_t)b * RW_NSC * 4 + q) * 4 * 64;
    bf16x8 pa[8]; f32x4 la[4];
#pragma unroll
    for (int k = 0; k < 8; ++k) pa[k] = pfb[k * 64 + lane];
#pragma unroll
    for (int i = 0; i < 4; ++i) la[i] = lfb[i * 64 + lane];
#pragma unroll 1
    for (int s = 0; s < RW_NSC; ++s) {
        bf16* hp = (bf16*)(C.ws + WS_HSC) + ((size_t)(b * RW_NSC + s) * 64 + 16 * q + li) * 64;
#pragma unroll
        for (int i = 0; i < 4; ++i) { u32x2 w; w.x = pk2(hs[i][0], hs[i][1]); w.y = pk2(hs[i][2], hs[i][3]); *(u32x2*)(hp + 16 * i + 4 * g) = w; }
        bf16x8 pn[8]; f32x4 ln[4]; const int sn = (s + 1 < RW_NSC) ? s + 1 : s;
#pragma unroll
        for (int k = 0; k < 8; ++k) pn[k] = pfb[(size_t)sn * 512 + k * 64 + lane];
#pragma unroll
        for (int i = 0; i < 4; ++i) ln[i] = lfb[(size_t)sn * 4 * 4 * 64 + i * 64 + lane];
        union { bf16x8 v; unsigned u[4]; } bf[2];
#pragma unroll
        for (int ks = 0; ks < 2; ++ks) { bf[ks].u[0] = pk2(hs[2 * ks][0], hs[2 * ks][1]); bf[ks].u[1] = pk2(hs[2 * ks][2], hs[2 * ks][3]); bf[ks].u[2] = pk2(hs[2 * ks + 1][0], hs[2 * ks + 1][1]); bf[ks].u[3] = pk2(hs[2 * ks + 1][2], hs[2 * ks + 1][3]); }
#pragma unroll
        for (int i = 0; i < 4; ++i) { f32x4 acc = la[i];
#pragma unroll
            for (int ks = 0; ks < 2; ++ks) acc = mfma16(pa[i * 2 + ks], bf[ks].v, acc);
            hs[i] = acc; }
#pragma unroll
        for (int k = 0; k < 8; ++k) pa[k] = pn[k];
#pragma unroll
        for (int i = 0; i < 4; ++i) la[i] = ln[i];
    }
}
__device__ __forceinline__ void phase_mix3(const Ctx& C, const DArgs& a, int l) {
    const bf16* P = (const bf16*)(C.ws + WS_P); const float* SC = (const float*)(C.ws + WS_SC); const float* YS = (const float*)(C.ws + WS_YS); bf16* MIX = (bf16*)(C.ws + WS_MIX);
    LAS float* yt = (LAS float*)(C.lds);
    constexpr int GSP = 168;
    LAS unsigned char* gsig = C.lds + 32768;
    LAS float* gm = (LAS float*)(C.lds + 40960);
    const bf16* g2t = (const bf16*)(C.ws + WS_G2T) + (size_t)l * 256 * 160;
    const float* rk = a.in[I_DRK] + (size_t)l * 256; const float* lnw = a.in[I_DLNW] + (size_t)l * 256; const float* lnb = a.in[I_DLNB] + (size_t)l * 256;
    const int lane = C.lane, li = lane & 15, g = lane >> 4, h = C.wave & 3, d = C.wave >> 2;
    const int half = C.tid >> 8, c = C.tid & 255;
    const int u_lo = (l == DEPTH - 1) ? NCTX / 16 : 0;
    bf16 glv[5];
#define GL_FETCH(uu) do { _Pragma("unroll") for (int k = 0; k < 5; ++k) { const int i = C.tid + NTHR * k, t = i / 160, ii = i % 160; glv[k] = P[(size_t)(16 * (uu) + t) * INWP + C_GL + ii]; } } while (0)
    const float lnwc = lnw[c], lnbc = lnb[c], rkc = rk[c];
    bf16x8 g2f[2][5];
#pragma unroll
    for (int c2 = 0; c2 < 2; ++c2)
#pragma unroll
        for (int ks = 0; ks < 5; ++ks) g2f[c2][ks] = ldg8(g2t + (size_t)(16 * (2 * C.wave + c2) + li) * 160 + 32 * ks + 8 * g);
    bf16x8 caf[2], cbf[4][2]; float cys[4][4];
#define CORR_FETCH(uu) do { const int rc_ = (uu) >> 1, th_ = (uu) & 1, ct_ = (d == 0) ? rc_ : (rc_ < 8 ? 7 - rc_ : 527 - rc_), s_ = ct_ / RW_SC, ti_ = (d == 0) ? th_ : 1 - th_; \
        const bf16* rp_ = (const bf16*)(C.ws + WS_RPP) + (size_t)((d * 4 + h) * RW_NCH + rc_) * 32 * 64; const bf16* hp_ = (const bf16*)(C.ws + WS_HSC) + (size_t)((d * 4 + h) * RW_NSC + s_) * 64 * 64; \
        _Pragma("unroll") for (int ks = 0; ks < 2; ++ks) caf[ks] = ldg8(rp_ + (16 * ti_ + li) * 64 + 32 * ks + 8 * g); \
        _Pragma("unroll") for (int vi = 0; vi < 4; ++vi) { _Pragma("unroll") for (int ks = 0; ks < 2; ++ks) cbf[vi][ks] = ldg8(hp_ + (16 * vi + li) * 64 + 32 * ks + 8 * g); \
            _Pragma("unroll") for (int r = 0; r < 4; ++r) { const int t_ = 16 * ti_ + 4 * g + r, rl_ = ((d == 0) ? t_ : 31 - t_) - 16 * th_; cys[vi][r] = YS[((size_t)d * ROWS + 16 * (uu) + rl_) * 256 + h * 64 + 16 * vi + li]; } } } while (0)
    if (u_lo + C.wg < ROWS / 16) { GL_FETCH(u_lo + C.wg); CORR_FETCH(u_lo + C.wg); }
    for (int u = u_lo + C.wg; u < ROWS / 16; u += C.G) {
        const int rc = u >> 1, th = u & 1, rowb = 16 * u;
        __syncthreads();
#pragma unroll
        for (int k = 0; k < 5; ++k) { const int i = C.tid + NTHR * k, t = i / 160, ii = i % 160; *(LAS bf16*)(gsig + (t * GSP + ii) * 2) = (bf16)f2bf(sigmoidf_(bf2f(glv[k]))); }
        {
          const int ti = (d == 0) ? th : 1 - th;
#pragma unroll
          for (int vi = 0; vi < 4; ++vi) { f32x4 acc = {0.f, 0.f, 0.f, 0.f};
#pragma unroll
              for (int ks = 0; ks < 2; ++ks) acc = mfma16(caf[ks], cbf[vi][ks], acc);
#pragma unroll
              for (int r = 0; r < 4; ++r) { const int t = 16 * ti + 4 * g + r, rl = ((d == 0) ? t : 31 - t) - 16 * th;
                  yt[(d * 16 + rl) * 256 + h * 64 + 16 * vi + li] = acc[r] + cys[vi][r]; } } }
        __syncthreads();
#pragma unroll
        for (int c2 = 0; c2 < 2; ++c2) { const int ci = 2 * C.wave + c2; f32x4 a0 = {0.f, 0.f, 0.f, 0.f};
#pragma unroll
            for (int ks = 0; ks < 5; ++ks) a0 = mfma16(ldA(gsig, GSP, 0, 32 * ks, li, g), g2f[c2][ks], a0);
#pragma unroll
            for (int r = 0; r < 4; ++r) gm[(4 * g + r) * 256 + 16 * ci + li] = a0[r]; }
        __syncthreads();
        if (u + C.G < ROWS / 16) { GL_FETCH(u + C.G); CORR_FETCH(u + C.G); }
        float qr[8], qv[8], qk0[8], qk1[8];
#pragma unroll
        for (int it = 0; it < 8; ++it) { const float* sc = SC + (size_t)(rowb + 2 * it + half) * 9 * 256; qr[it] = sc[c]; qv[it] = sc[256 + c]; qk0[it] = sc[4 * 256 + c]; qk1[it] = sc[7 * 256 + c]; }
#pragma unroll
        for (int it = 0; it < 8; ++it) { const int rl = 2 * it + half, row = rowb + rl;
            const float y = yt[rl * 256 + c] + yt[(16 + rl) * 256 + c];
            const float mu = wave_sum(y, lane) * (1.f / 64.f), dy = y - mu, var = wave_sum(dy * dy, lane) * (1.f / 64.f);
            const float yn = dy * rsqrtf(var + 64e-5f) * lnwc + lnbc;
            const float coef = wave_sum(qr[it] * (qk0[it] + qk1[it]) * rkc, lane);
            MIX[(size_t)row * DM + 768 + c] = (bf16)f2bf((yn + coef * qv[it]) * gm[rl * 256 + c]); }
    }
#undef GL_FETCH
#undef CORR_FETCH
    __syncthreads();
}
__device__ __forceinline__ void outproj_ctx(const Ctx& C, int l, const float* gate) {
    const bf16* A = (const bf16*)(C.ws + WS_MIX); const bf16* B = (const bf16*)(C.ws + WS_WOUT) + (size_t)l * DM * DM; float* XS = (float*)(C.ws + WS_XS);
    const int lane = C.lane, li = lane & 15, g = lane >> 4;
    for (int u = C.gw; u < (NCTX / 16) * (DM / 16); u += C.NGW) { const int rt = u >> 6, ct = u & 63;
        const bf16* ap = A + (size_t)(16 * rt + li) * DM + 8 * g; const bf16* bp = B + (size_t)(16 * ct + li) * DM + 8 * g;
        f32x4 acc0 = {0.f, 0.f, 0.f, 0.f}, acc1 = {0.f, 0.f, 0.f, 0.f};
#pragma unroll 4
        for (int ks = 0; ks < 32; ks += 2) { acc0 = mfma16(ldg8(ap + 32 * ks), ldg8(bp + 32 * ks), acc0); acc1 = mfma16(ldg8(ap + 32 * ks + 32), ldg8(bp + 32 * ks + 32), acc1); }
        const float gv = gate[16 * ct + li];
#pragma unroll
        for (int r = 0; r < 4; ++r) { float* p = XS + (size_t)(16 * rt + 4 * g + r) * DM + 16 * ct + li; *p = *p + gv * (acc0[r] + acc1[r]); } }
}

#ifndef MK_SINGLE
#define MK_SINGLE 1
#endif
template <int ONLYP> __global__ void __launch_bounds__(NTHR, 2) mega(Args a) {
    extern __shared__ __attribute__((aligned(16))) unsigned char lds_raw[];
    Ctx C;
#define MKCTX() do { int t_ = threadIdx.x; asm volatile("" : "+v"(t_)); unsigned char* w_ = a.ws; asm volatile("" : "+s"(w_)); unsigned l_ = 0u; asm volatile("" : "+s"(l_)); \
        C.lds = (LAS unsigned char*)lds_raw + l_; C.tid = t_; C.lane = t_ & 63; C.wave = __builtin_amdgcn_readfirstlane(t_ >> 6); \
        C.wg = blockIdx.x; C.G = gridDim.x; C.gw = C.wg * NWAVES + C.wave; C.NGW = C.G * NWAVES; C.ws = w_; } while (0)
    MKCTX();
    if (C.tid == 0) {
#pragma unroll
        for (int i = 0; i < 31; ++i) ((LAS unsigned long long*)(C.lds + MISC_OFF + 2048))[i] = (unsigned long long)a.in[i]; }
    DArgs da; da.in.tab = (const LAS unsigned*)(C.lds + MISC_OFF + 2048); da.out = a.out;
    if (C.tid < 4) ((LAS unsigned*)(C.lds + MISC_OFF))[C.tid] = 0u;
    __syncthreads();
    XcdBarrier bar; bar.bar = (unsigned*)(C.ws + WS_CTL) + CW_BAR; bar.x = 0; bar.st = (volatile LAS unsigned*)(C.lds + MISC_OFF);
    if (a.use_bar) bar = xcd_barrier_post((unsigned*)(C.ws + WS_CTL) + CW_BAR, (volatile LAS unsigned*)(C.lds + MISC_OFF));
#ifndef PHMASK
#define PHMASK 0x1fff
#endif
#define INP(o, k) ((ONLYP < 0 || ONLYP == (o)) && ((PHMASK >> ((o) == 99 ? 12 : (o))) & 1) && a.ph_lo <= (k) && (k) < a.ph_hi)
#ifndef REPMASK
#define REPMASK 0
#endif
#define NREP(o) ((((REPMASK) >> ((o) == 99 ? 12 : (o))) & 1) ? 2 : 1)
#define IN(k) (a.ph_lo <= (k) && (k) < a.ph_hi)
#define SEAM(k) do { if (a.use_bar && IN(k) && IN((k) + 1)) { xcd_barrier(bar); if ((REPMASK >> 20) & 1) xcd_barrier(bar); } } while (0)
    if (INP(0, 0)) for (int rep = 0; rep < NREP(0); ++rep) { MKCTX(); phase_prologue(C, da); }
    SEAM(0);
    for (int l = 0; l < DEPTH; ++l) {
        const int b = 1 + l * NPL;
        const float* mod_lat = (const float*)(C.ws + WS_MOD) + (size_t)(l * 2 + 0) * 6144; const float* mod_ctx = mod_lat + 6144;
        if (INP(1, b + 0)) { MKCTX(); phase_norm1(C, da, l); }
        SEAM(b + 0);
        if (INP(2, b + 1)) for (int rep = 0; rep < NREP(2); ++rep) { MKCTX();
            pg8::StaticOrder S; S.init(WS_H, WS_WIN + (size_t)l * INWP * DM * 2, ROWS, INWP, DM, C.G, C.wg);
            pg8::EpiStoreBf16 E{(bf16*)(C.ws + WS_P), INWP, nullptr, 0, 1.0f, 1.0f};
            pg8::gemm_phase<pg8::EpiStoreBf16, pg8::StaticOrder, true, true>(C.lds, C.tid, DM, S, E, C.ws);
        }
        SEAM(b + 1);
        if (INP(3, b + 2)) { MKCTX(); for (int rep = 0; rep < NREP(3); ++rep) { mix1_rwkv_prep(C, da, l); mix1_fourier1(C); } }
        SEAM(b + 2);
        if (INP(11, b + 3)) for (int rep = 0; rep < NREP(11); ++rep) { MKCTX(); phase_rwkv1(C);
            if (C.wg >= 8 * RW_NSC) {
                Ctx C2 = C; C2.wg = C.wg - 8 * RW_NSC; C2.G = C.G - 8 * RW_NSC; C2.gw = C2.wg * NWAVES + C.wave; C2.NGW = C2.G * NWAVES;
                mix1_rope(C2); mix1_vt(C2); } }
        SEAM(b + 3);
        if (INP(4, b + 4)) for (int rep = 0; rep < NREP(4); ++rep) { MKCTX(); phase_mix2(C, da, l); }
        SEAM(b + 4);
        if (INP(5, b + 5)) for (int rep = 0; rep < NREP(5); ++rep) { MKCTX(); phase_mix3(C, da, l); }
        SEAM(b + 5);
        if (INP(6, b + 6)) { MKCTX();
            if (l < DEPTH - 1) outproj_ctx(C, l, mod_ctx + 2 * DM);
            pg8::StaticOrder S; S.init(WS_MIX + (size_t)NCTX * DM * 2, WS_WOUT + (size_t)l * DM * DM * 2, SEQ, DM, DM, C.G, C.wg);
            pg8::EpiResidual E{(float*)(C.ws + WS_XS) + (size_t)NCTX * DM, DM, mod_lat + 2 * DM, mod_lat + 2 * DM};
            pg8::gemm_phase<pg8::EpiResidual, pg8::StaticOrder, true, true>(C.lds, C.tid, DM, S, E, C.ws);
        }
        SEAM(b + 6);
        if (INP(7, b + 7)) for (int rep = 0; rep < NREP(7); ++rep) { MKCTX(); phase_norm2(C, da, l); }
        SEAM(b + 7);
        if (INP(8, b + 8)) for (int rep = 0; rep < NREP(8); ++rep) { MKCTX(); phase_gather(C, da, l); }
        SEAM(b + 8);
        if (INP(9, b + 9)) for (int rep = 0; rep < NREP(9); ++rep) { MKCTX();
            const int nblk = moe_tables_load(C);
            pg8::MoeOrder S{(unsigned)WS_XG8, (unsigned)(WS_WGU + (size_t)l * 32 * 2048 * DM), 256u * DM, 2048u * DM,
                            (const LAS unsigned char*)(C.lds + MISC_OFF + 1024), nblk, 8, C.G, C.wg};
            pg8::EpiSwiglu E{(bf16*)(C.ws + WS_ACT8), DM, da.in[I_BGU] + (size_t)l * 32 * 2048, 2048, pg8::X8_S * pg8::W8_S, 1.0f / (pg8::X8_S * pg8::W8_S)};
            pg8::gemm_phase<pg8::EpiSwiglu, pg8::MoeOrder, true, true, 1>(C.lds, C.tid, DM, S, E, C.ws);
        }
        SEAM(b + 9);
        if (INP(10, b + 10)) for (int rep = 0; rep < NREP(10); ++rep) { MKCTX();
            const int nblk = moe_tables_load(C);
            pg8::MoeOrder S{(unsigned)WS_ACT8, (unsigned)(WS_WDN + (size_t)l * 32 * DM * DM), 256u * DM, (unsigned)(DM * DM),
                            (const LAS unsigned char*)(C.lds + MISC_OFF + 1024), nblk, 4, C.G, C.wg};
            pg8::EpiStoreBf16 E{(bf16*)(C.ws + WS_XG), DM, da.in[I_BDN] + (size_t)l * 32 * DM, DM, pg8::ACT_S * pg8::W8_S, 1.0f / (pg8::ACT_S * pg8::W8_S)};
            pg8::gemm_phase<pg8::EpiStoreBf16, pg8::MoeOrder, true, true, 1>(C.lds, C.tid, DM, S, E, C.ws);
        }
        SEAM(b + 10);
    }
    if (INP(99, PH_TOTAL - 1)) for (int rep = 0; rep < NREP(99); ++rep) { MKCTX(); phase_final(C, da); }
#undef IN
#undef INP
#undef SEAM
}

typedef void (*kern_t)(Args);
static kern_t kern_of(int o) {
#if MK_SINGLE
    (void)o; return mega<-1>;
#else
    switch (o) { case 0: return mega<0>; case 1: return mega<1>; case 2: return mega<2>; case 3: return mega<3>; case 4: return mega<4>; case 5: return mega<5>; case 6: return mega<6>;
                 case 7: return mega<7>; case 8: return mega<8>; case 9: return mega<9>; case 10: return mega<10>; case 11: return mega<11>; case 99: return mega<99>;
                 default: return mega<0>;
    }
#endif
}
extern "C" void kernel_launch(void* const* d_in, const int* in_sizes, int n_in, void* d_out, int out_size, void* d_ws, size_t ws_size, hipStream_t stream) {
    static int ready = 0;
    if (ready == 0) {
        if (n_in != 31 || out_size != SEQ * DM || ws_size < WS_END) { fprintf(stderr, "kernel_launch: unexpected shapes (n_in %d, out %d, ws %zu)\n", n_in, out_size, ws_size); ready = -1; return; }
        const int ids[14] = {0, 1, 2, 3, 4, 5, 6, 7, 8, 9, 10, 11, 99, -1};
        for (int i = 0; i < (MK_SINGLE ? 14 : 13); ++i) { if (MK_SINGLE && ids[i] != -1) continue;
            if (hipFuncSetAttribute((const void*)kern_of(ids[i]), hipFuncAttributeMaxDynamicSharedMemorySize, LDS_BYTES) != hipSuccess) { fprintf(stderr, "kernel_launch: hipFuncSetAttribute failed (%d)\n", ids[i]); ready = -1; return; } }
        ready = 1;
    }
    if (ready < 0) return;
    (void)hipMemsetAsync((char*)d_ws + WS_CTL, 0, CTL_ZERO_BYTES, stream);
    Args a{};
    for (int i = 0; i < 31; ++i) a.in[i] = (const float*)d_in[i];
    a.out = (float*)d_out; a.ws = (unsigned char*)d_ws; a.pad = 0;
#if MK_SINGLE
    a.ph_lo = 0; a.ph_hi = PH_TOTAL; a.use_bar = 1;
    hipLaunchKernelGGL(kern_of(-1), dim3(NWG), dim3(NTHR), LDS_BYTES, stream, a);
#else
    for (int p = 0; p < PH_TOTAL; ++p) { a.ph_lo = p; a.ph_hi = p + 1; a.use_bar = 0;
        const int j = (p - 1) % NPL; const int o = (p == 0) ? 0 : (p == PH_TOTAL - 1) ? 99 : (j < 3 ? 1 + j : j == 3 ? 11 : j);
        hipLaunchKernelGGL(kern_of(o), dim3(NWG), dim3(NTHR), LDS_BYTES, stream, a); }
#endif
}
```

```cpp
#include <hip/hip_runtime.h>
#include <cstdio>
#include <cstdint>

#define LAS __attribute__((address_space(3)))
typedef unsigned short bf16;
typedef float f32x4 __attribute__((ext_vector_type(4)));
typedef float f32x2 __attribute__((ext_vector_type(2)));
typedef short bf16x8 __attribute__((ext_vector_type(8)));
typedef unsigned u32x4 __attribute__((ext_vector_type(4)));
typedef unsigned u32x2 __attribute__((ext_vector_type(2)));

constexpr int DM = 1024, SEQ = 16384, NCTX = 256, ROWS = SEQ + NCTX, DEPTH = 4, GRIDW = 64;
constexpr int INW = 2720, INWP = 2816;
constexpr int C_AQ = 0, C_AK = 256, C_AV = 384, C_BU = 512, C_CQ = 768, C_CK = 1024, C_CV = 1280, C_DR = 1536, C_DK = 1792, C_DV = 2048, C_WL = 2304, C_AL = 2432, C_GL = 2560;
constexpr int NEXP = 32, TOPK = 4;
constexpr int MOE_MAXBLK = 296;
constexpr int MOE_ROWS = MOE_MAXBLK * 256;
constexpr int NWG = 256, NTHR = 512, NWAVES = 8;
constexpr int VTP = ROWS + 256;

constexpr size_t MiB = 1u << 20;
constexpr size_t WS_CTL = 0, CTL_ZERO_BYTES = 1 * MiB;
constexpr size_t WS_MOD = 1 * MiB;
constexpr size_t WS_TW = 2 * MiB;
constexpr size_t WS_MTAB = 3 * MiB;
constexpr size_t WS_XS = 4 * MiB;
constexpr size_t WS_H = 70 * MiB;
constexpr size_t WS_P = 104 * MiB;
constexpr size_t WS_MIX = 194 * MiB;
constexpr size_t WS_FYR = 228 * MiB, WS_FYI = 244 * MiB;
constexpr size_t WS_VTA = 1544 * MiB, WS_VTC = 1550 * MiB;
constexpr size_t WS_SC = 260 * MiB;
constexpr size_t WS_YS = 408 * MiB;
constexpr size_t WS_ROUTE = 442 * MiB;
constexpr size_t WS_CNT = 444 * MiB;
constexpr size_t WS_XG = 446 * MiB;
constexpr size_t WS_ACT = 596 * MiB;
constexpr size_t WS_XG8 = WS_ACT, WS_ACT8 = WS_ACT + 75 * MiB;
constexpr size_t WS_WIN = 746 * MiB;
constexpr size_t WS_WOUT = 768 * MiB;
constexpr size_t WS_WGU = 776 * MiB;
constexpr size_t WS_WDN = 1288 * MiB;
constexpr size_t WS_RPP = 1560 * MiB, WS_PSC = 1578 * MiB, WS_LSC = 1580 * MiB, WS_HSC = 1584 * MiB;
constexpr size_t WS_FTAB = 1586 * MiB;
constexpr size_t WS_G2T = 1588 * MiB, WS_RWT = 1589 * MiB;
constexpr size_t WS_LORAT = 1590 * MiB;
constexpr size_t WS_F256 = 1591 * MiB;

constexpr size_t WS_END = 1592 * MiB;
static_assert(WS_XS + (size_t)ROWS * DM * 4 <= WS_H && WS_H + (size_t)ROWS * DM * 2 <= WS_P && WS_P + (size_t)ROWS * INWP * 2 <= WS_MIX && WS_MIX + (size_t)ROWS * DM * 2 <= WS_FYR, "ws map 1");
static_assert(WS_SC + (size_t)ROWS * 9 * 256 * 4 <= WS_YS && WS_YS + (size_t)2 * ROWS * 256 * 4 <= WS_ROUTE && WS_XG + (size_t)MOE_ROWS * DM * 2 <= WS_ACT && WS_ACT + (size_t)MOE_ROWS * DM * 2 <= WS_WIN, "ws map 2");
static_assert(WS_WIN + (size_t)4 * INWP * DM * 2 <= WS_WOUT && WS_WGU + (size_t)4 * 32 * 2048 * 1024 * 2 <= WS_WDN && WS_WDN + (size_t)4 * 32 * 1024 * 1024 * 2 <= WS_END, "ws map 3");
constexpr int CW_BAR = 4096;
constexpr int CW_WQ = 16384;

constexpr int RING_BYTES = 131072;
constexpr int MISC_OFF = 143360;
constexpr int LDS_BYTES = 147456;

__device__ __forceinline__ unsigned f2bf(float f) { unsigned u = __builtin_bit_cast(unsigned, f); return (u + 0x7fffu + ((u >> 16) & 1u)) >> 16; }
__device__ __forceinline__ unsigned pk2(float lo, float hi) { return f2bf(lo) | (f2bf(hi) << 16); }
__device__ __forceinline__ float bf2f(unsigned short b) { return __builtin_bit_cast(float, (unsigned)b << 16); }
__device__ __forceinline__ float bflo(unsigned w) { return __builtin_bit_cast(float, w << 16); }
__device__ __forceinline__ float bfhi(unsigned w) { return __builtin_bit_cast(float, w & 0xffff0000u); }
__device__ __forceinline__ float shx(float v, int o, int lane) { return __builtin_bit_cast(float, __builtin_amdgcn_ds_bpermute((lane ^ o) << 2, __builtin_bit_cast(int, v))); }
__device__ __forceinline__ int shxi(int v, int o, int lane) { return __builtin_amdgcn_ds_bpermute((lane ^ o) << 2, v); }
__device__ __forceinline__ float dpp_ror(float v, int ctrl_unused);
#define DPP_ROR_ADD(v, n) v += __builtin_bit_cast(float, __builtin_amdgcn_update_dpp(0, __builtin_bit_cast(int, v), 0x120 + (n), 0xf, 0xf, false))
__device__ __forceinline__ float wave_sum(float v, int lane) {
    DPP_ROR_ADD(v, 8); DPP_ROR_ADD(v, 4); DPP_ROR_ADD(v, 2); DPP_ROR_ADD(v, 1);
    v += shx(v, 16, lane); v += shx(v, 32, lane);
    return v;
}
__device__ __forceinline__ float sigmoidf_(float x) { return 1.f / (1.f + __expf(-x)); }
#define LDS_WAIT() asm volatile("s_waitcnt lgkmcnt(0)" ::: "memory")
#define VM_WAIT() asm volatile("s_waitcnt vmcnt(0)" ::: "memory")

namespace pg8 {
#define PG8_LAS __attribute__((address_space(3)))
typedef unsigned short bf16_t;
constexpr int BM = 256, BK = 64, HALF = 128, HTB = HALF * BK * 2, STAGE_BYTES = 8 * HTB, NXCD = 8, WGM = 8;
__host__ __device__ __forceinline__ int lds_byte(int r, int c) { const int st = (r >> 4) * 2 + (c >> 5), rr = r & 15, cc = c & 31, ob = rr * 64 + cc * 2; return st * 1024 + (ob ^ (((ob >> 9) & 1) << 5)); }
__host__ __device__ __forceinline__ void stage_rc(int b, int& R, int& C) { const int st = b / 1024, sb = b % 1024, swz = sb ^ (((sb >> 9) & 1) << 5); R = (st >> 1) * 16 + swz / 64; C = (st & 1) * 32 + (swz % 64) / 2; }
__host__ __device__ __forceinline__ int perm32(int rho) { const int n = rho >> 4, i = rho & 15; return 8 * (i >> 2) + 4 * n + (i & 3); }
struct Unit { int pm, pn, e; };
typedef int v8i __attribute__((ext_vector_type(8))); typedef int v4i __attribute__((ext_vector_type(4)));
__device__ __forceinline__ v8i cat8(bf16x8 a, bf16x8 b) { const v4i x = __builtin_bit_cast(v4i, a), y = __builtin_bit_cast(v4i, b); return __builtin_shufflevector(x, y, 0, 1, 2, 3, 4, 5, 6, 7); }
__device__ __forceinline__ unsigned cvt_pk_bf16(float lo, float hi) { unsigned r; asm volatile("v_cvt_pk_bf16_f32 %0, %1, %2" : "=v"(r) : "v"(lo), "v"(hi)); return r; }

struct StaticOrder {
    unsigned A, Bt, tstep;
    int nM, nN, nwg, G, c;
    __device__ void init(size_t A_, size_t Bt_, int M, int N, int K, int G_, int c_) { A = (unsigned)A_; Bt = (unsigned)Bt_; tstep = (unsigned)(BM * K * 2); nM = M / BM; nN = N / BM; nwg = nM * nN; G = G_; c = c_; }
    __device__ bool next(int i, Unit& u) const {
        const long L = (long)i * G + c; if (L >= nwg) return false;
        int wgid = (int)L; { const int q = nwg / NXCD, r = nwg % NXCD, xcd = wgid % NXCD, off = wgid / NXCD; wgid = (xcd < r ? xcd * (q + 1) : r * (q + 1) + (xcd - r) * q) + off; }
        const int nig = WGM * nN, gid = wgid / nig, fm = gid * WGM, gsz = (nM - fm) < WGM ? (nM - fm) : WGM;
        u.pm = fm + ((wgid % nig) % gsz); u.pn = (wgid % nig) / gsz; u.e = 0; return true;
    }
    __device__ __forceinline__ unsigned pa(const Unit& u) const { return A + (unsigned)u.pm * tstep; }
    __device__ __forceinline__ unsigned pb(const Unit& u) const { return Bt + (unsigned)u.pn * tstep; }
};
struct MoeOrder {
    unsigned A, Bt, tstep, estep;
    const LAS unsigned char* blk_e; int nblk, nN, G, c;
    __device__ bool next(int i, Unit& u) const {
        const int L = i * G + c; if (L >= nblk * nN) return false;
        u.pm = L / nN; u.pn = L % nN; u.e = __builtin_amdgcn_readfirstlane((int)blk_e[u.pm]); return true;
    }
    __device__ __forceinline__ unsigned pa(const Unit& u) const { return A + (unsigned)u.pm * tstep; }
    __device__ __forceinline__ unsigned pb(const Unit& u) const { return Bt + (unsigned)u.e * estep + (unsigned)u.pn * tstep; }
};

struct EpiStoreBf16 {
    static constexpr bool PERM = true;
    bf16_t* O; int ldc; const float* bias; int bias_estride; float bias_scale, acc_scale;
    __device__ __forceinline__ void init(f32x4 (&acc)[2][2][4][2], const Unit& u, int wc, int fq) const {
        const int col0 = u.pn * BM + wc * 32 + 8 * fq;
#pragma unroll
        for (int b = 0; b < 2; ++b)
#pragma unroll
            for (int n = 0; n < 2; ++n) { const f32x4 bv = bias ? *(const f32x4*)(bias + (size_t)u.e * bias_estride + col0 + b * HALF + 4 * n) * bias_scale : (f32x4){0.f, 0.f, 0.f, 0.f};
#pragma unroll
                for (int a = 0; a < 2; ++a)
#pragma unroll
                    for (int m = 0; m < 4; ++m) { f32x4 t = bv; asm volatile("" : "+v"(t)); acc[a][b][m][n] = t; } }
    }
    __device__ __forceinline__ void operator()(const f32x4 (&acc)[2][2][4][2], const Unit& u, int wr, int wc, int fr, int fq) const {
        const int row0 = u.pm * BM + wr * 64 + fr, col0 = u.pn * BM + wc * 32 + 8 * fq;
#pragma unroll
        for (int ai = 0; ai < 2; ++ai)
#pragma unroll
            for (int m = 0; m < 4; ++m) { bf16_t* rowp = O + (size_t)(row0 + ai * HALF + m * 16) * ldc + col0;
#pragma unroll
                for (int bj = 0; bj < 2; ++bj) { const f32x4 v0 = acc[ai][bj][m][0] * acc_scale, v1 = acc[ai][bj][m][1] * acc_scale;
                    u32x4 w; w.x = cvt_pk_bf16(v0[0], v0[1]); w.y = cvt_pk_bf16(v0[2], v0[3]); w.z = cvt_pk_bf16(v1[0], v1[1]); w.w = cvt_pk_bf16(v1[2], v1[3]);
                    *(u32x4*)(rowp + bj * HALF) = w; }
                asm volatile("" ::: "memory"); }
    }
};
__device__ __forceinline__ float swiglu1(float g, float up) {
    g = fminf(g, 7.0f); up = fminf(fmaxf(up, -7.0f), 7.0f);
    return g * (1.f / (1.f + __expf(-1.702f * g))) * (up + 1.0f);
}
constexpr float X8_S = 8.0f, W8_S = 256.0f, ACT_S = 4.0f;
struct EpiSwiglu {
    static constexpr bool PERM = true;
    bf16_t* O; int ldc; const float* bias; int bias_estride; float bias_scale, acc_scale;
    __device__ __forceinline__ void init(f32x4 (&acc)[2][2][4][2], const Unit& u, int wc, int fq) const {
        const int col0 = u.pn * BM + wc * 32 + 8 * fq;
#pragma unroll
        for (int b = 0; b < 2; ++b)
#pragma unroll
            for (int n = 0; n < 2; ++n) { const f32x4 bv = bias ? *(const f32x4*)(bias + (size_t)u.e * bias_estride + col0 + b * HALF + 4 * n) * bias_scale : (f32x4){0.f, 0.f, 0.f, 0.f};
#pragma unroll
                for (int a = 0; a < 2; ++a)
#pragma unroll
                    for (int m = 0; m < 4; ++m) { f32x4 t = bv; asm volatile("" : "+v"(t)); acc[a][b][m][n] = t; } }
    }
    __device__ __forceinline__ void operator()(const f32x4 (&acc)[2][2][4][2], const Unit& u, int wr, int wc, int fr, int fq) const {
        const int row0 = u.pm * BM + wr * 64 + fr, col0 = u.pn * BM + wc * 32 + 8 * fq;
#pragma unroll
        for (int ai = 0; ai < 2; ++ai)
#pragma unroll
            for (int m = 0; m < 4; ++m) { unsigned char* rowp = (unsigned char*)O + (size_t)(row0 + ai * HALF + m * 16) * ldc + (col0 >> 1);
#pragma unroll
                for (int bj = 0; bj < 2; ++bj) { const f32x4 v0 = acc[ai][bj][m][0] * acc_scale, v1 = acc[ai][bj][m][1] * acc_scale;
                    unsigned w = 0; w = __builtin_amdgcn_cvt_pk_fp8_f32(swiglu1(v0[0], v0[1]) * ACT_S, swiglu1(v0[2], v0[3]) * ACT_S, w, false); w = __builtin_amdgcn_cvt_pk_fp8_f32(swiglu1(v1[0], v1[1]) * ACT_S, swiglu1(v1[2], v1[3]) * ACT_S, w, true);
                    *(unsigned*)(rowp + bj * (HALF / 2)) = w; }
                asm volatile("" ::: "memory"); }
    }
};
struct EpiResidual {
    static constexpr bool PERM = false;
    float* X; int ldc; const float* gate_lat; const float* gate_ctx;
    __device__ __forceinline__ void init(f32x4 (&acc)[2][2][4][2], const Unit& u, int wc, int fq) const {
#pragma unroll
        for (int a = 0; a < 2; ++a)
#pragma unroll
            for (int b = 0; b < 2; ++b)
#pragma unroll
                for (int m = 0; m < 4; ++m)
#pragma unroll
                    for (int n = 0; n < 2; ++n) acc[a][b][m][n] = (f32x4){0.f, 0.f, 0.f, 0.f};
    }
    __device__ __forceinline__ void operator()(const f32x4 (&acc)[2][2][4][2], const Unit& u, int wr, int wc, int fr, int fq) const {
        const int row0 = u.pm * BM + wr * 64 + fr, col0 = u.pn * BM + wc * 32 + 4 * fq;
        const float* gp = (u.pm == 0) ? gate_ctx : gate_lat;
        f32x4 gv[2][2];
#pragma unroll
        for (int bj = 0; bj < 2; ++bj)
#pragma unroll
            for (int n = 0; n < 2; ++n) gv[bj][n] = *(const f32x4*)(gp + col0 + bj * HALF + n * 16);
#pragma unroll
        for (int ai = 0; ai < 2; ++ai)
#pragma unroll
            for (int m = 0; m < 4; ++m) { float* rowp = X + (size_t)(row0 + ai * HALF + m * 16) * ldc + col0;
#pragma unroll
                for (int bj = 0; bj < 2; ++bj)
#pragma unroll
                    for (int n = 0; n < 2; ++n) { f32x4* p = (f32x4*)(rowp + bj * HALF + n * 16); *p = *p + gv[bj][n] * acc[ai][bj][m][n]; }
                asm volatile("" ::: "memory"); }
    }
};
template <class Epi, class Sched, bool ALIGN_EPI = false, bool SP2 = false, int ES = 2>
__device__ __forceinline__ void gemm_phase(PG8_LAS unsigned char* lds, const int tid, const int K, const Sched& S, const Epi& E, const void* wsbase) {
    const __amdgpu_buffer_rsrc_t rsrc = __builtin_amdgcn_make_buffer_rsrc((void*)wsbase, 0, 0x7fffffff, 0x00020000);
    const int wid = __builtin_amdgcn_readfirstlane(tid >> 6), lane = tid & 63, wr = wid >> 2, wc = wid & 3, fr = lane & 15, fq = lane >> 4;
    const int nt = (K * ES) / 128;
    unsigned voffA[2], voffB[2];
#pragma unroll
    for (int i = 0; i < 2; ++i) { int R, C; stage_rc(tid * 16 + i * 8192, R, C); const int Rb = Epi::PERM ? ((R & ~31) + perm32(R & 31)) : R;
        voffA[i] = (unsigned)(R * K * ES + C * 2); voffB[i] = (unsigned)(Rb * K * ES + C * 2); }
    const unsigned kstep = (unsigned)(BK * 2);
    const unsigned hstep = (unsigned)(HALF * K * ES);
        const unsigned ldsw = (unsigned)wid * 1024u;
    const int aoff = lds_byte(wr * 64 + fr, ES == 2 ? fq * 8 : fq * 16), boff = lds_byte(wc * 32 + fr, ES == 2 ? fq * 8 : fq * 16); constexpr int KOFF = (ES == 2) ? 1024 : 16;
#define PG8_SA(b, h) (((b) * 2 + (h)) * HTB)
#define PG8_SB(b, h) ((4 + (b) * 2 + (h)) * HTB)
#define PG8_STAGE(bufoff, gbase, voff) do { _Pragma("unroll") for (int _i = 0; _i < 2; ++_i) \
        __builtin_amdgcn_raw_ptr_buffer_load_lds(rsrc, (PG8_LAS unsigned*)(lds + (bufoff) + ldsw + _i * 8192), 16, (voff)[_i], (gbase), 0, 0); } while (0)
#define PG8_LDA(dst, b, h) do { _Pragma("unroll") for (int m = 0; m < 4; ++m) _Pragma("unroll") for (int k = 0; k < 2; ++k) dst[m][k] = *(const PG8_LAS bf16x8*)(lds + PG8_SA(b, h) + aoff + m * 2048 + k * KOFF); } while (0)
#define PG8_LDA8(dst, b, h) do { _Pragma("unroll") for (int m = 0; m < 4; ++m) { const PG8_LAS v4i* p_ = (const PG8_LAS v4i*)(lds + PG8_SA(b, h) + aoff + m * 2048); const v4i x_ = p_[0], y_ = p_[1]; dst[m] = __builtin_shufflevector(x_, y_, 0, 1, 2, 3, 4, 5, 6, 7); } } while (0)
#define PG8_LDB(dst, b, h) do { _Pragma("unroll") for (int n = 0; n < 2; ++n) _Pragma("unroll") for (int k = 0; k < 2; ++k) dst[n][k] = *(const PG8_LAS bf16x8*)(lds + PG8_SB(b, h) + boff + n * 2048 + k * KOFF); } while (0)
#define PG8_LDB8(dst, b, h) do { _Pragma("unroll") for (int n = 0; n < 2; ++n) { const PG8_LAS v4i* p_ = (const PG8_LAS v4i*)(lds + PG8_SB(b, h) + boff + n * 2048); const v4i x_ = p_[0], y_ = p_[1]; dst[n] = __builtin_shufflevector(x_, y_, 0, 1, 2, 3, 4, 5, 6, 7); } } while (0)
#define PG8_MMA(ai, bj, At, Bt) do { __builtin_amdgcn_s_setprio(1); _Pragma("unroll") for (int m = 0; m < 4; ++m) _Pragma("unroll") for (int n = 0; n < 2; ++n) { \
        if constexpr (ES == 2) { _Pragma("unroll") for (int k = 0; k < 2; ++k) acc[ai][bj][m][n] = __builtin_amdgcn_mfma_f32_16x16x32_bf16(Bt[n][k], At[m][k], acc[ai][bj][m][n], 0, 0, 0); } \
        else asm volatile("v_mfma_f32_16x16x128_f8f6f4 %0, %1, %2, %0" : "+v"(acc[ai][bj][m][n]) : "v"(Bt##8[n]), "v"(At##8[m])); } \
        __builtin_amdgcn_s_setprio(0); } while (0)
#define PG8_LDAX(b, h) do { if constexpr (ES == 2) PG8_LDA(At, b, h); else PG8_LDA8(At8, b, h); } while (0)
#define PG8_LDBX(B, b, h) do { if constexpr (ES == 2) PG8_LDB(B, b, h); else PG8_LDB8(B##8, b, h); } while (0)
#define PG8_WAIT_V(n) asm volatile("s_waitcnt vmcnt(" #n ")" ::: "memory")
#define PG8_WAIT_L(n) asm volatile("s_waitcnt lgkmcnt(" #n ")" ::: "memory")
#define PG8_BAR __builtin_amdgcn_s_barrier()
#define PG8_SCHED __builtin_amdgcn_sched_barrier(0)
    Unit cur, nxt; int ui = 0;
    if (!S.next(0, cur)) return;
    f32x4 acc[2][2][4][2];
    E.init(acc, cur, wc, fq);
    bf16x8 At[4][2], B0[2][2], B1[2][2]; v8i At8[4], B08[2], B18[2];
    unsigned cA = S.pa(cur), cB = S.pb(cur);
    if constexpr (SP2) {
        PG8_STAGE(PG8_SB(0, 0), cB, voffB); PG8_STAGE(PG8_SB(0, 1), cB + hstep, voffB); PG8_STAGE(PG8_SA(0, 0), cA, voffA); PG8_STAGE(PG8_SA(0, 1), cA + hstep, voffA);
        if (wr == 1) PG8_BAR;
        PG8_WAIT_V(2); PG8_BAR;
        PG8_STAGE(PG8_SB(1, 0), cB + kstep, voffB); PG8_STAGE(PG8_SA(1, 0), cA + kstep, voffA); PG8_STAGE(PG8_SB(1, 1), cB + hstep + kstep, voffB);
        PG8_WAIT_V(6); PG8_BAR;
    } else {
        PG8_STAGE(PG8_SB(0, 0), cB, voffB); PG8_STAGE(PG8_SA(0, 0), cA, voffA); PG8_STAGE(PG8_SB(0, 1), cB + hstep, voffB); PG8_STAGE(PG8_SA(0, 1), cA + hstep, voffA);
        if (wr == 1) PG8_BAR;
        PG8_WAIT_V(4); PG8_BAR;
        PG8_STAGE(PG8_SB(1, 0), cB + kstep, voffB); PG8_STAGE(PG8_SA(1, 0), cA + kstep, voffA); PG8_STAGE(PG8_SB(1, 1), cB + hstep + kstep, voffB);
        PG8_WAIT_V(6); PG8_BAR;
    }
    for (;;) {
        const bool has_next = S.next(ui + 1, nxt);
        const unsigned nA = has_next ? S.pa(nxt) : cA, nB = has_next ? S.pb(nxt) : cB;
        for (int t = 0; t < nt; t += 2) {
            const bool last = (t == nt - 2);
            const unsigned a1 = cA + (unsigned)(t + 1) * kstep;
            const unsigned a2 = last ? nA : cA + (unsigned)(t + 2) * kstep, b2 = last ? nB : cB + (unsigned)(t + 2) * kstep;
            const unsigned a3 = a2 + kstep, b3 = b2 + kstep;
            if constexpr (SP2) {
            PG8_LDBX(B0, 0, 0); PG8_LDBX(B1, 0, 1); PG8_SCHED; PG8_LDAX(0, 0); PG8_STAGE(PG8_SA(1, 1), a1 + hstep, voffA);
            PG8_WAIT_V(8); PG8_WAIT_L(0); PG8_BAR; PG8_MMA(0, 0, At, B0); PG8_MMA(0, 1, At, B1); PG8_BAR; PG8_SCHED;
            PG8_LDAX(0, 1); PG8_STAGE(PG8_SB(0, 0), b2, voffB); PG8_STAGE(PG8_SB(0, 1), b2 + hstep, voffB); PG8_STAGE(PG8_SA(0, 0), a2, voffA);
            PG8_WAIT_V(8); PG8_WAIT_L(0); PG8_BAR; PG8_MMA(1, 0, At, B0); PG8_MMA(1, 1, At, B1); PG8_BAR; PG8_SCHED;
            PG8_LDBX(B0, 1, 0); PG8_LDBX(B1, 1, 1); PG8_SCHED; PG8_LDAX(1, 0); PG8_STAGE(PG8_SA(0, 1), a2 + hstep, voffA);
            PG8_WAIT_V(8); PG8_WAIT_L(0); PG8_BAR; PG8_MMA(0, 0, At, B0); PG8_MMA(0, 1, At, B1); PG8_BAR; PG8_SCHED;
            PG8_LDAX(1, 1); PG8_STAGE(PG8_SB(1, 0), b3, voffB); PG8_STAGE(PG8_SB(1, 1), b3 + hstep, voffB); PG8_STAGE(PG8_SA(1, 0), a3, voffA);
            PG8_WAIT_V(8); PG8_WAIT_L(0); PG8_BAR; PG8_MMA(1, 0, At, B0); PG8_MMA(1, 1, At, B1); PG8_BAR; PG8_SCHED;
            } else {
            PG8_LDBX(B0, 0, 0); PG8_SCHED; PG8_LDAX(0, 0); PG8_STAGE(PG8_SA(1, 1), a1 + hstep, voffA);
            PG8_WAIT_L(8); PG8_BAR; PG8_WAIT_L(0); PG8_MMA(0, 0, At, B0); PG8_BAR; PG8_SCHED;
            PG8_LDBX(B1, 0, 1); PG8_STAGE(PG8_SB(0, 0), b2, voffB);
            PG8_BAR; PG8_WAIT_L(0); PG8_MMA(0, 1, At, B1); PG8_BAR;
            PG8_LDAX(0, 1); PG8_STAGE(PG8_SA(0, 0), a2, voffA);
            PG8_BAR; PG8_WAIT_L(0); PG8_MMA(1, 0, At, B0); PG8_BAR; PG8_SCHED;
            PG8_STAGE(PG8_SB(0, 1), b2 + hstep, voffB);
            PG8_WAIT_V(6); PG8_BAR; PG8_MMA(1, 1, At, B1); PG8_BAR;
            PG8_LDBX(B0, 1, 0); PG8_SCHED; PG8_LDAX(1, 0); PG8_STAGE(PG8_SA(0, 1), a2 + hstep, voffA);
            PG8_WAIT_L(8); PG8_BAR; PG8_WAIT_L(0); PG8_MMA(0, 0, At, B0); PG8_BAR; PG8_SCHED;
            PG8_LDBX(B1, 1, 1); PG8_STAGE(PG8_SB(1, 0), b3, voffB);
            PG8_BAR; PG8_WAIT_L(0); PG8_MMA(0, 1, At, B1); PG8_BAR;
            PG8_LDAX(1, 1); PG8_STAGE(PG8_SA(1, 0), a3, voffA);
            PG8_BAR; PG8_WAIT_L(0); PG8_MMA(1, 0, At, B0); PG8_BAR; PG8_SCHED;
            PG8_STAGE(PG8_SB(1, 1), b3 + hstep, voffB);
            PG8_WAIT_V(6); PG8_BAR; PG8_MMA(1, 1, At, B1); PG8_BAR;
            }
        }
        if constexpr (ALIGN_EPI) { if (wr == 0) PG8_BAR; }
        if constexpr (ES == 1) asm volatile("s_nop 15\n\ts_nop 15" ::: "memory");
        E(acc, cur, wr, wc, fr, fq);
        if (!has_next) break;
        E.init(acc, nxt, wc, fq);
        cur = nxt; cA = nA; cB = nB; ++ui;
        if constexpr (ALIGN_EPI) { if (wr == 1) PG8_BAR; }
    }
    PG8_WAIT_V(0);
    if constexpr (!ALIGN_EPI) { if (wr == 0) PG8_BAR; }
    PG8_BAR;
#undef PG8_SA
#undef PG8_SB
#undef PG8_STAGE
#undef PG8_LDA
#undef PG8_LDA8
#undef PG8_LDB8
#undef PG8_LDAX
#undef PG8_LDBX
#undef PG8_LDB
#undef PG8_MMA
#undef PG8_WAIT_V
#undef PG8_WAIT_L
#undef PG8_BAR
#undef PG8_SCHED
}
}

#define XB_TMO      128
#define XB_XCNT(j)  (256  + 64 * (j))
#define XB_XSUB(j)  (1280 + 64 * (j))
#define XB_XGEN(j)  (2304 + 64 * (j))
#define XB_TOP      3328
#define XB_TOPGEN   3392
#define XCD_BAR_WORDS 3456
#define XB_SPIN_CAP (1u << 18)
__device__ __forceinline__ unsigned xb_ld(unsigned* p)              { return __hip_atomic_load(p, __ATOMIC_RELAXED, __HIP_MEMORY_SCOPE_AGENT); }
__device__ __forceinline__ unsigned xb_add(unsigned* p, unsigned v) { return __hip_atomic_fetch_add(p, v, __ATOMIC_RELAXED, __HIP_MEMORY_SCOPE_AGENT); }
__device__ __forceinline__ unsigned xb_xcc_id() { return (unsigned)__builtin_amdgcn_s_getreg((3 << 11) | 20) & 0xFu; }
#define XB_SPIN(cond, bar) do { unsigned _sp = 0; while (cond) { __builtin_amdgcn_s_sleep(1); \
    if ((++_sp & 255u) == 0u) { if (xb_ld(&(bar)[XB_TMO])) break; if (_sp > XB_SPIN_CAP) { atomicAdd(&(bar)[XB_TMO], 1u); break; } } } } while (0)

struct XcdBarrier {
    unsigned* bar; unsigned x;
    volatile LAS unsigned* st;
};

__device__ __forceinline__ XcdBarrier xcd_barrier_post(unsigned* bar, volatile LAS unsigned* st) {
    XcdBarrier b; b.bar = bar; b.x = xb_xcc_id(); b.st = st;
    if (threadIdx.x == 0) (void)xb_add(&bar[XB_XCNT(b.x)], 1u);
    return b;
}
__device__ __forceinline__ void xcd_barrier_complete(unsigned* bar, unsigned x, unsigned& nloc, unsigned& nx) {
    const unsigned G = gridDim.x * gridDim.y * gridDim.z;
    unsigned sum, cnt, mine, sp = 0u;
    for (;;) {
        sum = 0u; cnt = 0u; mine = 0u;
#pragma unroll
        for (unsigned j = 0; j < 16; ++j) { const unsigned c = xb_ld(&bar[XB_XCNT(j)]); sum += c; cnt += (c > 0u) ? 1u : 0u; mine = (j == x) ? c : mine; }
        if (sum == G) break;
        __builtin_amdgcn_s_sleep(1);
        if ((++sp & 255u) == 0u) { if (xb_ld(&bar[XB_TMO])) break; if (sp > XB_SPIN_CAP) { atomicAdd(&bar[XB_TMO], 1u); break; } }
    }
    nloc = mine > 0u ? mine : 1u; nx = cnt > 0u ? cnt : 1u;
}

__device__ __forceinline__ void xcd_barrier(const XcdBarrier& b) {
    asm volatile("s_waitcnt vmcnt(0)" ::: "memory");
    __syncthreads();
    if (threadIdx.x == 0) {
        unsigned* bar = b.bar;
        __builtin_amdgcn_s_waitcnt(0);
        unsigned nloc = b.st[0], nx = b.st[1];
        if (nloc == 0u) { xcd_barrier_complete(bar, b.x, nloc, nx); b.st[0] = nloc; b.st[1] = nx; }
        const unsigned old = xb_add(&bar[XB_XSUB(b.x)], 1u);
        const unsigned gen = old / nloc;
        if (old + 1u == (gen + 1u) * nloc) {
            __builtin_amdgcn_fence(__ATOMIC_RELEASE, "agent");
            asm volatile("s_waitcnt vmcnt(0)" ::: "memory");
            const unsigned og = xb_add(&bar[XB_TOP], 1u);
            const unsigned tg = og / nx;
            if (og + 1u == (tg + 1u) * nx) xb_add(&bar[XB_TOPGEN], 1u);
            else XB_SPIN(xb_ld(&bar[XB_TOPGEN]) == tg, bar);
            __builtin_amdgcn_fence(__ATOMIC_ACQUIRE, "agent");
            xb_add(&bar[XB_XGEN(b.x)], 1u);
            asm volatile("s_waitcnt vmcnt(0)" ::: "memory");
        } else {
            XB_SPIN(xb_ld(&bar[XB_XGEN(b.x)]) == gen, bar);
            __builtin_amdgcn_fence(__ATOMIC_ACQUIRE, "agent");
            asm volatile("s_waitcnt vmcnt(0)" ::: "memory");
        }
    }
    __syncthreads();
}

typedef short s4v __attribute__((ext_vector_type(4)));
__device__ __forceinline__ bf16x8 ldg8(const bf16* p) { return *(const bf16x8*)p; }
__device__ __forceinline__ f32x4 mfma16(bf16x8 a, bf16x8 b, f32x4 c) { return __builtin_amdgcn_mfma_f32_16x16x32_bf16(a, b, c, 0, 0, 0); }
__device__ __forceinline__ bf16x8 ldA(const LAS unsigned char* base, int pitch, int row0, int k0, int li, int g) { return *(const LAS bf16x8*)(base + ((row0 + li) * pitch + k0 + 8 * g) * 2); }
__device__ __forceinline__ bf16x8 ldT(const LAS unsigned char* base, int pitch, int k0, int n0, int li, int g) {
    const LAS unsigned char* p = base + ((k0 + 8 * g + (li >> 2)) * pitch + n0 + 4 * (li & 3)) * 2;
    const s4v a = __builtin_amdgcn_ds_read_tr16_b64_v4i16((LAS s4v*)p), b = __builtin_amdgcn_ds_read_tr16_b64_v4i16((LAS s4v*)(p + 8 * pitch));
    return (bf16x8){a[0], a[1], a[2], a[3], b[0], b[1], b[2], b[3]};
}
__device__ __forceinline__ bf16x8 ldAperm(const LAS unsigned char* base, int pitch, int row0, int ks, int li, int g) {
    const LAS unsigned char* p = base + ((row0 + li) * pitch + 32 * ks + 4 * g) * 2;
    const s4v a = *(const LAS s4v*)p, b = *(const LAS s4v*)(p + 32);
    return (bf16x8){a[0], a[1], a[2], a[3], b[0], b[1], b[2], b[3]};
}
__device__ __forceinline__ void stT(LAS unsigned char* base, int pitch, int n, int m0, const f32x4 v) {
    u32x2 w; w.x = pk2(v[0], v[1]); w.y = pk2(v[2], v[3]); *(LAS u32x2*)(base + (n * pitch + m0) * 2) = w;
}
__device__ __forceinline__ f32x4 ld4bf(const LAS unsigned char* p) { const u32x2 w = *(const LAS u32x2*)p; return (f32x4){bflo(w.x), bfhi(w.x), bflo(w.y), bfhi(w.y)}; }

struct Args {
    const float* in[31];
    float* out; unsigned char* ws;
    int ph_lo, ph_hi, use_bar, pad;
};
enum InIdx { I_X = 0, I_C, I_CTX, I_CCTX, I_ADAW, I_ADAB, I_N1G, I_N2G, I_WIN, I_WOUT, I_ASINK, I_BMIX, I_CREL, I_DCONV, I_DW0, I_DW2, I_DA0, I_DA2, I_DG2, I_DKK, I_DKA, I_DRK, I_DLNW, I_DLNB,
             I_RW, I_RB, I_WGU, I_BGU, I_WDN, I_BDN, I_FNG };
constexpr int NPL = 11;
constexpr int PH_TOTAL = 1 + DEPTH * NPL + 1;

struct DevIn {
    const LAS unsigned* tab;
    __device__ __forceinline__ const float* operator[](int i) const {
        const unsigned lo = __builtin_amdgcn_readfirstlane(((const volatile LAS unsigned*)tab)[2 * i]), hi = __builtin_amdgcn_readfirstlane(((const volatile LAS unsigned*)tab)[2 * i + 1]);
        return (const float*)(((unsigned long long)hi << 32) | lo);
    }
};
struct DArgs { DevIn in; float* out; };
struct Ctx {
    LAS unsigned char* lds;
    int tid, lane, wave, wg, G, gw, NGW;
    unsigned char* ws;
};

template <int NW>
__device__ __forceinline__ void transpose_item(const float* W, int K, int N, bf16* WT, int item, int lane) {
    constexpr int NQ = NW / 4, NC = 64 / NQ, PASSES = 8 / NC;
    const int nblk = N / NW, kb = item / nblk, nb = item % nblk, k0 = 64 * kb, n0 = NW * nb, nq = lane % NQ, cq = lane / NQ;
    f32x4 v[PASSES][8];
#pragma unroll
    for (int ps = 0; ps < PASSES; ++ps)
#pragma unroll
        for (int i = 0; i < 8; ++i) v[ps][i] = *(const f32x4*)(W + (size_t)(k0 + 8 * (cq + NC * ps) + i) * N + n0 + 4 * nq);
#pragma unroll
    for (int ps = 0; ps < PASSES; ++ps)
#pragma unroll
        for (int j = 0; j < 4; ++j) { u32x4 o; o.x = pk2(v[ps][0][j], v[ps][1][j]); o.y = pk2(v[ps][2][j], v[ps][3][j]); o.z = pk2(v[ps][4][j], v[ps][5][j]); o.w = pk2(v[ps][6][j], v[ps][7][j]);
            *(u32x4*)(WT + (size_t)(n0 + 4 * nq + j) * K + k0 + 8 * (cq + NC * ps)) = o; }
}
template <int NW>
__device__ __forceinline__ void transpose_item8(const float* W, int K, int N, unsigned char* WT, int item, int lane) {
    constexpr int NQ = NW / 4, NC = 64 / NQ, PASSES = 8 / NC;
    const int nblk = N / NW, kb = item / nblk, nb = item % nblk, k0 = 64 * kb, n0 = NW * nb, nq = lane % NQ, cq = lane / NQ;
    f32x4 v[PASSES][8];
#pragma unroll
    for (int ps = 0; ps < PASSES; ++ps)
#pragma unroll
        for (int i = 0; i < 8; ++i) v[ps][i] = __builtin_nontemporal_load((const f32x4*)(W + (size_t)(k0 + 8 * (cq + NC * ps) + i) * N + n0 + 4 * nq)) * pg8::W8_S;
#pragma unroll
    for (int ps = 0; ps < PASSES; ++ps)
#pragma unroll
        for (int j = 0; j < 4; ++j) { unsigned w0 = 0, w1 = 0;
            w0 = __builtin_amdgcn_cvt_pk_fp8_f32(v[ps][0][j], v[ps][1][j], w0, false); w0 = __builtin_amdgcn_cvt_pk_fp8_f32(v[ps][2][j], v[ps][3][j], w0, true);
            w1 = __builtin_amdgcn_cvt_pk_fp8_f32(v[ps][4][j], v[ps][5][j], w1, false); w1 = __builtin_amdgcn_cvt_pk_fp8_f32(v[ps][6][j], v[ps][7][j], w1, true);
            __builtin_nontemporal_store((u32x2){w0, w1}, (u32x2*)(WT + (size_t)(n0 + 4 * nq + j) * K + k0 + 8 * (cq + NC * ps))); }
}
constexpr int CV_IT_GU = 16 * 64, CV_IT_DN = 16 * 32, CV_N_GU = 32 * CV_IT_GU, CV_N_DN = 32 * CV_IT_DN, CV_ITEMS = CV_N_GU + CV_N_DN, CV_CHUNK = 16, CV_NCHUNK = CV_ITEMS / CV_CHUNK;
__device__ __forceinline__ void convert_moe_items(const Ctx& C, const DArgs& a, int l, int it0, int it1) {
    const float* pwgu = a.in[I_WGU] + (size_t)l * 32 * DM * 2048; const float* pwdn = a.in[I_WDN] + (size_t)l * 32 * DM * DM;
    unsigned char* ogu = C.ws + WS_WGU + (size_t)l * 32 * 2048 * DM; unsigned char* odn = C.ws + WS_WDN + (size_t)l * 32 * DM * DM;
#pragma unroll 1
    for (int it = it0; it < it1; ++it) {
        if (it < CV_N_GU) { const int e = it / CV_IT_GU; transpose_item8<32>(pwgu + (size_t)e * DM * 2048, DM, 2048, ogu + (size_t)e * 2048 * DM, it % CV_IT_GU, C.lane); }
        else { const int r = it - CV_N_GU, e = r / CV_IT_DN; transpose_item8<32>(pwdn + (size_t)e * DM * DM, DM, DM, odn + (size_t)e * DM * DM, r % CV_IT_DN, C.lane); }
    }
}
__device__ __forceinline__ void phase_prologue(const Ctx& C, const DArgs& a) {
    constexpr int IT_IN = 16 * (INW / 32), IT_OUT = 16 * 16;
    constexpr int N_IN = 4 * IT_IN, N_OUT = 4 * IT_OUT;
    const float* pwin = a.in[I_WIN]; const float* pwout = a.in[I_WOUT];
    for (int it = C.gw; it < N_IN + N_OUT; it += C.NGW) {
        if (it < N_IN) { const int l = it / IT_IN; transpose_item<32>(pwin + (size_t)l * DM * INW, DM, INW, (bf16*)(C.ws + WS_WIN) + (size_t)l * INWP * DM, it % IT_IN, C.lane); }
        else { const int r = it - N_IN, l = r / IT_OUT; transpose_item<64>(pwout + (size_t)l * DM * DM, DM, DM, (bf16*)(C.ws + WS_WOUT) + (size_t)l * DM * DM, r % IT_OUT, C.lane); }
    }
    for (int ch = C.gw; ch < CV_NCHUNK; ch += C.NGW) convert_moe_items(C, a, 0, ch * CV_CHUNK, ch * CV_CHUNK + CV_CHUNK);
    { const int gt = C.wg * NTHR + C.tid; constexpr int PADN = (INWP - INW) * DM / 8;
      for (int i = gt; i < 4 * PADN; i += C.G * NTHR) { const int l = i / PADN, r = i % PADN; *((u32x4*)((bf16*)(C.ws + WS_WIN) + ((size_t)l * INWP + INW) * DM) + r) = (u32x4){0u, 0u, 0u, 0u}; } }
    { float* tw = (float*)(C.ws + WS_TW); const int gt = C.wg * NTHR + C.tid;
      for (int i = gt; i < 16384; i += C.G * NTHR) { const float x = (float)i * (1.0f / 8192.0f); tw[i] = cospif(x); tw[16384 + i] = sinpif(x); } }
    { float* mt = (float*)(C.ws + WS_MTAB); const int gt = C.wg * NTHR + C.tid; const float* pbmix = a.in[I_BMIX];
      for (int i = gt; i < 4 * 4 * 64 * 64; i += C.G * NTHR) { const int e = i & 63, c = (i >> 6) & 63, g = (i >> 12) & 3, l = i >> 14;
          const float* w = pbmix + ((size_t)(l * 4 + g) * 64) * 64 + e; float sc = 0.f, ss = 0.f;
          for (int cp = 0; cp < 64; ++cp) { const float x = (float)((c * cp) & 63) * (1.0f / 32.0f); const float wv = w[cp * 64]; sc += cospif(x) * wv; ss += sinpif(x) * wv; }
          mt[((size_t)(l * 2 + 0) * 4 + g) * 4096 + c * 64 + e] = sc; mt[((size_t)(l * 2 + 1) * 4 + g) * 4096 + c * 64 + e] = ss; } }
    { bf16* ft = (bf16*)(C.ws + WS_FTAB); const int gt = C.wg * NTHR + C.tid; const float* pbmix = a.in[I_BMIX];
      for (int i = gt; i < 128 * 128; i += C.G * NTHR) { const int k = i >> 7, t = i & 127; const float x = (float)((k * t) & 127) * (1.0f / 64.0f); ft[i] = (bf16)f2bf(cospif(x)); ft[16384 + i] = (bf16)f2bf(sinpif(x)); }
      bf16* mf = ft + 32768;
      for (int i = gt; i < 4 * 4 * 16 * 64 * 8; i += C.G * NTHR) { const int j8 = i & 7, ln = (i >> 3) & 63, fr = (i >> 9) & 15, gq = (i >> 13) & 3, l = i >> 15;
          const int ei = fr >> 2, ks2 = fr & 3, e = 16 * ei + (ln & 15), g = ln >> 4, c = 32 * (ks2 & 1) + 16 * (j8 >> 2) + 4 * g + (j8 & 3), part = ks2 >> 1;
          const float* w = pbmix + ((size_t)(l * 4 + gq) * 64) * 64 + e; float s = 0.f;
          for (int cp = 0; cp < 64; ++cp) { const float x = (float)((c * cp) & 63) * (1.0f / 32.0f); s += (part ? sinpif(x) : cospif(x)) * w[cp * 64]; }
          mf[i] = (bf16)f2bf(s * (1.0f / 1024.0f)); } }
    { const int gt = C.wg * NTHR + C.tid; const float* pg2 = a.in[I_DG2]; const float* prw = a.in[I_RW]; bf16* g2t = (bf16*)(C.ws + WS_G2T); bf16* rwt = (bf16*)(C.ws + WS_RWT);
      for (int i = gt; i < 4 * 256 * 160; i += C.G * NTHR) { const int ii = i % 160, c = (i / 160) & 255, l = i / (160 * 256); g2t[i] = (bf16)f2bf(pg2[((size_t)l * 160 + ii) * 256 + c]); }
      for (int i = gt; i < 4 * 32 * 1024; i += C.G * NTHR) { const int k = i & 1023, e = (i >> 10) & 31, l = i >> 15; rwt[i] = (bf16)f2bf(prw[((size_t)l * 1024 + k) * 32 + e]); } }
    { const int gt = C.wg * NTHR + C.tid; const float* pw2 = a.in[I_DW2]; const float* pa2 = a.in[I_DA2]; bf16* lt = (bf16*)(C.ws + WS_LORAT);
      for (int i = gt; i < 4 * 4 * 256 * 64; i += C.G * NTHR) { const int ii = i & 63, c = (i >> 6) & 255, q = (i >> 14) & 3, l = i >> 16;
          const float* src = (q < 2) ? pw2 : pa2; lt[i] = (bf16)f2bf(src[(((size_t)l * 2 + (q & 1)) * 64 + ii) * 256 + c]); } }
    { bf16* f2 = (bf16*)(C.ws + WS_F256); const int gt = C.wg * NTHR + C.tid;
      for (int i = gt; i < 256 * 256; i += C.G * NTHR) { const int k = i >> 8, t = i & 255; const float x = (float)((k * t) & 255) * (1.0f / 128.0f); f2[i] = (bf16)f2bf(cospif(x)); f2[65536 + i] = (bf16)f2bf(sinpif(x)); } }
    { LAS float* sl = (LAS float*)(C.lds);
      LAS float* red = (LAS float*)(C.lds + 8192);
      __syncthreads();
      const float* pc = a.in[I_C]; const float* pcc = a.in[I_CCTX]; const float* padaw = a.in[I_ADAW]; const float* padab = a.in[I_ADAB];
      for (int i = C.tid; i < 2048; i += NTHR) { const float x = (i < 1024) ? pc[i] : pcc[i - 1024]; sl[i] = x * sigmoidf_(x); }
      __syncthreads();
      float* mod = (float*)(C.ws + WS_MOD);
      for (int u = C.wg; u < 4 * 96; u += C.G) { const int l = u / 96, jb = u % 96, j0 = jb * 64 + C.lane;
          float s0 = 0.f, s1 = 0.f; const float* w = padaw + (size_t)l * DM * 6144 + j0; const int k0 = C.wave * 128;
#pragma unroll 16
          for (int k = 0; k < 128; ++k) { const float wv = w[(size_t)(k0 + k) * 6144]; s0 += wv * sl[k0 + k]; s1 += wv * sl[1024 + k0 + k]; }
          red[(C.wave * 2 + 0) * 64 + C.lane] = s0; red[(C.wave * 2 + 1) * 64 + C.lane] = s1;
          __syncthreads();
          if (C.tid < 128) { const int v = C.tid >> 6, j = C.tid & 63; float s = 0.f;
#pragma unroll
              for (int wv = 0; wv < 8; ++wv) s += red[(wv * 2 + v) * 64 + j];
              mod[(size_t)(l * 2 + v) * 6144 + jb * 64 + j] = s + padab[(size_t)l * 6144 + jb * 64 + j]; }
          __syncthreads(); } }
}

__device__ __forceinline__ void load_row(const float* p, int lane, f32x4 (&v)[4]) {
#pragma unroll
    for (int j = 0; j < 4; ++j) v[j] = *((const f32x4*)p + lane + 64 * j);
}
__device__ __forceinline__ void moe_combine_row(const Ctx& C, int row, f32x4 (&v)[4], const f32x4 (&gt2q)[4]) {
    const int* dest = (const int*)(C.ws + WS_ROUTE) + (size_t)3 * ROWS * 4; const float* gate = (const float*)(C.ws + WS_ROUTE) + (size_t)1 * ROWS * 4;
    const bf16* YB = (const bf16*)(C.ws + WS_XG);
    f32x4 s[4];
#pragma unroll
    for (int j = 0; j < 4; ++j) s[j] = (f32x4){0.f, 0.f, 0.f, 0.f};
#pragma unroll
    for (int k = 0; k < 4; ++k) { const int d = dest[row * 4 + k]; const float g = gate[row * 4 + k]; const u32x2* yp = (const u32x2*)(YB + (size_t)d * DM) + C.lane;
#pragma unroll
        for (int j = 0; j < 4; ++j) { const u32x2 w = yp[64 * j]; s[j] += (f32x4){bflo(w.x), bfhi(w.x), bflo(w.y), bfhi(w.y)} * g; } }
#pragma unroll
    for (int j = 0; j < 4; ++j) v[j] += gt2q[j] * s[j];
}
__device__ __forceinline__ float row_rstd(const f32x4 (&v)[4], int lane) {
    float s = 0.f;
#pragma unroll
    for (int j = 0; j < 4; ++j) s += (v[j].x * v[j].x + v[j].y * v[j].y) + (v[j].z * v[j].z + v[j].w * v[j].w);
    return rsqrtf(wave_sum(s, lane) * (1.f / DM) + 1e-6f);
}
__device__ __forceinline__ void norm1_fetch(const Ctx& C, const float* src_row, int row, bool combine, const f32x4 (&gt2q)[4], f32x4 (&v)[4]) {
    load_row(src_row, C.lane, v);
    if (combine) moe_combine_row(C, row, v, gt2q);
}
__device__ __forceinline__ void phase_norm1(const Ctx& C, const DArgs& a, int l) {
    float* XS = (float*)(C.ws + WS_XS); bf16* H = (bf16*)(C.ws + WS_H); const float* mod = (const float*)(C.ws + WS_MOD);
    const float* g1 = a.in[I_N1G] + (size_t)l * DM;
    const float* pctx = a.in[I_CTX]; const float* px = a.in[I_X];
    f32x4 gq[4], shq[4], scq[4], gt2q[4];
#pragma unroll
    for (int j = 0; j < 4; ++j) gt2q[j] = *((const f32x4*)(mod + (size_t)((l > 0 ? l - 1 : 0) * 2) * 6144 + 5 * DM) + C.lane + 64 * j);
#pragma unroll
    for (int j = 0; j < 4; ++j) { gq[j] = *((const f32x4*)g1 + C.lane + 64 * j); shq[j] = *((const f32x4*)(mod + (size_t)(l * 2) * 6144) + C.lane + 64 * j); scq[j] = *((const f32x4*)(mod + (size_t)(l * 2) * 6144 + DM) + C.lane + 64 * j) + 1.0f; }
    for (int row0 = C.gw; row0 < ROWS; row0 += 2 * C.NGW) {
        f32x4 v[2][4]; const int rows[2] = {row0, row0 + C.NGW};
#pragma unroll
        for (int q = 0; q < 2; ++q) if (rows[q] < ROWS) { const int row = rows[q]; const bool isctx = row < NCTX;
            const float* src = (l == 0) ? (isctx ? pctx + (size_t)row * DM : px + (size_t)(row - NCTX) * DM) : XS + (size_t)row * DM;
            if (isctx && l > 0) { f32x4 gc4[4];
#pragma unroll
                for (int j = 0; j < 4; ++j) gc4[j] = *((const f32x4*)(mod + (size_t)((l - 1) * 2 + 1) * 6144 + 5 * DM) + C.lane + 64 * j);
                norm1_fetch(C, src, row, true, gc4, v[q]); }
            else norm1_fetch(C, src, row, l > 0, gt2q, v[q]); }
#pragma unroll
        for (int q = 0; q < 2; ++q) if (rows[q] < ROWS) { const int row = rows[q]; const bool isctx = row < NCTX;
#pragma unroll
            for (int j = 0; j < 4; ++j) *((f32x4*)(XS + (size_t)row * DM) + C.lane + 64 * j) = v[q][j];
            const float rstd = row_rstd(v[q], C.lane);
            const float* md = mod + (size_t)(l * 2 + (isctx ? 1 : 0)) * 6144;
            u32x2* o = (u32x2*)(H + (size_t)row * DM) + C.lane;
#pragma unroll
            for (int j = 0; j < 4; ++j) { f32x4 sh = shq[j], sc1 = scq[j]; if (isctx) { sh = *((const f32x4*)md + C.lane + 64 * j); sc1 = *((const f32x4*)(md + DM) + C.lane + 64 * j) + 1.0f; }
                const f32x4 y = v[q][j] * rstd * gq[j] * sc1 + sh; u32x2 w; w.x = pk2(y.x, y.y); w.y = pk2(y.z, y.w); o[64 * j] = w; } }
    }
}
__device__ __forceinline__ void phase_final(const Ctx& C, const DArgs& a) {
    const float* XS = (const float*)(C.ws + WS_XS); const float* mod = (const float*)(C.ws + WS_MOD); const float* g = a.in[I_FNG];
    const float* gt2 = mod + (size_t)((DEPTH - 1) * 2 + 0) * 6144 + 5 * DM;
    f32x4 gq[4], gt2q[4];
#pragma unroll
    for (int j = 0; j < 4; ++j) { gq[j] = *((const f32x4*)g + C.lane + 64 * j); gt2q[j] = *((const f32x4*)gt2 + C.lane + 64 * j); }
    for (int row0 = NCTX + C.gw; row0 < ROWS; row0 += 2 * C.NGW) {
        f32x4 v[2][4]; const int rows[2] = {row0, row0 + C.NGW};
#pragma unroll
        for (int q = 0; q < 2; ++q) if (rows[q] < ROWS) norm1_fetch(C, XS + (size_t)rows[q] * DM, rows[q], true, gt2q, v[q]);
#pragma unroll
        for (int q = 0; q < 2; ++q) if (rows[q] < ROWS) { const float rstd = row_rstd(v[q], C.lane); float* o = a.out + (size_t)(rows[q] - NCTX) * DM;
#pragma unroll
            for (int j = 0; j < 4; ++j) *((f32x4*)o + C.lane + 64 * j) = v[q][j] * rstd * gq[j]; }
    }
}
constexpr int NR2 = 9;
__device__ __forceinline__ void phase_norm2(const Ctx& C, const DArgs& a, int l) {
    const float* XS = (const float*)(C.ws + WS_XS); bf16* H = (bf16*)(C.ws + WS_H); const float* mod = (const float*)(C.ws + WS_MOD);
    const float* g2 = a.in[I_N2G] + (size_t)l * DM; const float* rb = a.in[I_RB] + (size_t)l * NEXP; const bf16* rwt = (const bf16*)(C.ws + WS_RWT) + (size_t)l * NEXP * DM;
    int* tok_e = (int*)(C.ws + WS_ROUTE); float* gate = (float*)(C.ws + WS_ROUTE) + (size_t)1 * ROWS * 4; int* slot = (int*)(C.ws + WS_ROUTE) + (size_t)2 * ROWS * 4;
    LAS float* lg = (LAS float*)(C.lds + C.wave * 4096);
    LAS int* hist = (LAS int*)(C.lds + MISC_OFF + 64);
    const int lane = C.lane, li = lane & 15, g = lane >> 4;
    if (C.tid < NEXP) hist[C.tid] = 0;
    constexpr int RWP = 1032;
    LAS unsigned char* rwl = C.lds + 32768;
    for (int i = C.tid; i < NEXP * 128; i += NTHR) { const int e2 = i >> 7, c8 = i & 127; *(LAS u32x4*)(rwl + (e2 * RWP + 8 * c8) * 2) = *(const u32x4*)(rwt + (size_t)e2 * DM + 8 * c8); }
    __syncthreads();
    const int row_base = (l == DEPTH - 1) ? NCTX : 0, ntile = (ROWS - row_base + NR2 - 1) / NR2;
    f32x4 gq[4], shq[4], scq[4];
#pragma unroll
    for (int j = 0; j < 4; ++j) { gq[j] = *((const f32x4*)g2 + lane + 64 * j); shq[j] = *((const f32x4*)(mod + (size_t)(l * 2) * 6144 + 3 * DM) + lane + 64 * j); scq[j] = *((const f32x4*)(mod + (size_t)(l * 2) * 6144 + 4 * DM) + lane + 64 * j) + 1.0f; }
    for (int tl = C.gw; tl < ntile; tl += C.NGW) {
        const int trow0 = row_base + NR2 * tl, nrow = (ROWS - trow0 < NR2) ? ROWS - trow0 : NR2;
#pragma unroll 1
        for (int rr = 0; rr < nrow; ++rr) { const int row = trow0 + rr; const bool isctx = row < NCTX; f32x4 v[4]; load_row(XS + (size_t)row * DM, lane, v);
            const float rstd = row_rstd(v, lane);
            const float* md = mod + (size_t)(l * 2 + (isctx ? 1 : 0)) * 6144 + 3 * DM;
            u32x2* o = (u32x2*)(H + (size_t)row * DM) + lane;
#pragma unroll
            for (int j = 0; j < 4; ++j) { f32x4 sh = shq[j], sc1 = scq[j]; if (isctx) { sh = *((const f32x4*)md + lane + 64 * j); sc1 = *((const f32x4*)(md + DM) + lane + 64 * j) + 1.0f; }
                const f32x4 y = v[j] * rstd * gq[j] * sc1 + sh; u32x2 w; w.x = pk2(y.x, y.y); w.y = pk2(y.z, y.w); o[64 * j] = w; } }
        asm volatile("s_waitcnt vmcnt(0)" ::: "memory");
        f32x4 acc0 = {0.f, 0.f, 0.f, 0.f}, acc1 = {0.f, 0.f, 0.f, 0.f};
        const int arow = (trow0 + li < ROWS) ? trow0 + li : ROWS - 1;
        const bf16* ap = H + (size_t)arow * DM + 8 * g;
#pragma unroll 8
        for (int ks = 0; ks < 32; ++ks) { const bf16x8 af = *(const bf16x8*)(ap + 32 * ks); acc0 = mfma16(af, ldA(rwl, RWP, 0, 32 * ks, li, g), acc0); acc1 = mfma16(af, ldA(rwl, RWP, 16, 32 * ks, li, g), acc1); }
#pragma unroll
        for (int r = 0; r < 4; ++r) { lg[(4 * g + r) * 33 + li] = acc0[r]; lg[(4 * g + r) * 33 + 16 + li] = acc1[r]; }
        LDS_WAIT(); asm volatile("" ::: "memory");
        const int e = lane & 31; const float rbe = rb[e];
        float val[NR2]; int te[NR2][4]; float tv[NR2][4];
#pragma unroll
        for (int rr = 0; rr < NR2; ++rr) val[rr] = lg[rr * 33 + e] + rbe;
#pragma unroll
        for (int k = 0; k < 4; ++k) {
            float bv[NR2]; int bi[NR2];
#pragma unroll
            for (int rr = 0; rr < NR2; ++rr) { bv[rr] = val[rr]; bi[rr] = e; }
#define AMAX_ROR(n) _Pragma("unroll") for (int rr = 0; rr < NR2; ++rr) { const float ov = __builtin_bit_cast(float, __builtin_amdgcn_update_dpp(0, __builtin_bit_cast(int, bv[rr]), 0x120 + (n), 0xf, 0xf, false)); const int oi = __builtin_amdgcn_update_dpp(0, bi[rr], 0x120 + (n), 0xf, 0xf, false); \
                if (ov > bv[rr] || (ov == bv[rr] && oi < bi[rr])) { bv[rr] = ov; bi[rr] = oi; } }
            AMAX_ROR(8) AMAX_ROR(4) AMAX_ROR(2) AMAX_ROR(1)
#undef AMAX_ROR
#pragma unroll
            for (int rr = 0; rr < NR2; ++rr) { const float ov = shx(bv[rr], 16, lane); const int oi = shxi(bi[rr], 16, lane); if (ov > bv[rr] || (ov == bv[rr] && oi < bi[rr])) { bv[rr] = ov; bi[rr] = oi; }
                te[rr][k] = bi[rr]; tv[rr][k] = bv[rr]; if (e == bi[rr]) val[rr] = -3.0e38f; } }
        if (lane == 0) {
#pragma unroll
            for (int rr = 0; rr < NR2; ++rr) if (rr < nrow) { const int row = trow0 + rr; const float m = tv[rr][0]; float p[4], ps = 0.f;
#pragma unroll
                for (int k = 0; k < 4; ++k) { p[k] = __expf(tv[rr][k] - m); ps += p[k]; }
#pragma unroll
                for (int k = 0; k < 4; ++k) { tok_e[row * 4 + k] = te[rr][k]; gate[row * 4 + k] = p[k] / ps; slot[row * 4 + k] = __hip_atomic_fetch_add(&hist[te[rr][k]], 1, __ATOMIC_RELAXED, __HIP_MEMORY_SCOPE_WORKGROUP); } } }
        asm volatile("" ::: "memory");
    }
    __syncthreads();
    if (C.tid < NEXP) ((int*)(C.ws + WS_CNT))[C.wg * NEXP + C.tid] = hist[C.tid];
}
__device__ __forceinline__ int moe_tables(const Ctx& C) {
    const int* cnt = (const int*)(C.ws + WS_CNT);
    LAS int* part = (LAS int*)(C.lds);
    LAS int* pstart = (LAS int*)(C.lds + MISC_OFF + 256); LAS int* wgbase = pstart + 40; LAS int* tot = wgbase + 32; LAS int* nblk_s = tot + 32;
    LAS unsigned char* blk_e = (LAS unsigned char*)(C.lds + MISC_OFF + 1024);
    __syncthreads();
    { const int e = C.tid & 31, p = C.tid >> 5; int t = 0, pre = 0;
#pragma unroll 1
      for (int w = p * 16; w < p * 16 + 16; ++w) { const int c = cnt[w * NEXP + e]; t += c; if (w < C.wg) pre += c; }
      part[(p * 32 + e) * 2] = t; part[(p * 32 + e) * 2 + 1] = pre; }
    __syncthreads();
    if (C.tid < NEXP) { int t = 0, pre = 0;
#pragma unroll 1
        for (int p = 0; p < 16; ++p) { t += part[(p * 32 + C.tid) * 2]; pre += part[(p * 32 + C.tid) * 2 + 1]; }
        tot[C.tid] = t; wgbase[C.tid] = pre; }
    __syncthreads();
    if (C.tid == 0) { int b = 0;
#pragma unroll 1
        for (int e = 0; e < NEXP; ++e) { pstart[e] = b * 256; b += (tot[e] + 255) >> 8; }
        pstart[NEXP] = b * 256; nblk_s[0] = b; }
    __syncthreads();
    if (C.tid < NEXP) wgbase[C.tid] += pstart[C.tid];
    if (C.tid < MOE_MAXBLK) { int e = 0;
#pragma unroll 1
        for (int k = 1; k < NEXP; ++k) if (pstart[k] <= C.tid * 256) e = k;
        blk_e[C.tid] = (unsigned char)e; }
    __syncthreads();
    return __builtin_amdgcn_readfirstlane(nblk_s[0]);
}
__device__ __forceinline__ int moe_tables_load(const Ctx& C) {
    const unsigned* src = (const unsigned*)(C.ws + WS_CNT + 65536);
    LAS unsigned* dst = (LAS unsigned*)(C.lds + MISC_OFF + 1024);
    __syncthreads();
    if (C.tid < MOE_MAXBLK / 4) dst[C.tid] = src[C.tid];
    const int nblk = __builtin_amdgcn_readfirstlane((int)src[MOE_MAXBLK / 4]);
    __syncthreads();
    return nblk;
}
__device__ __forceinline__ void phase_gather(const Ctx& C, const DArgs& a, int l) {
    const int nblk_all = moe_tables(C);
    if (C.wg == 0) { unsigned* dstg = (unsigned*)(C.ws + WS_CNT + 65536); const LAS unsigned* srcl = (const LAS unsigned*)(C.lds + MISC_OFF + 1024);
        if (C.tid < MOE_MAXBLK / 4) dstg[C.tid] = srcl[C.tid]; if (C.tid == 0) dstg[MOE_MAXBLK / 4] = (unsigned)nblk_all; }
    const LAS int* wgbase = (const LAS int*)(C.lds + MISC_OFF + 256) + 40;
    const int* tok_e = (const int*)(C.ws + WS_ROUTE); const int* slot = (const int*)(C.ws + WS_ROUTE) + (size_t)2 * ROWS * 4; int* dest = (int*)(C.ws + WS_ROUTE) + (size_t)3 * ROWS * 4;
    const bf16* H = (const bf16*)(C.ws + WS_H); unsigned char* XG = C.ws + WS_XG8;
    const int row_base = (l == DEPTH - 1) ? NCTX : 0, ntile = (ROWS - row_base + NR2 - 1) / NR2;
    for (int tl = C.gw; tl < ntile; tl += C.NGW)
    for (int row = row_base + NR2 * tl; row < row_base + NR2 * tl + NR2 && row < ROWS; ++row) {
        const u32x4* src = (const u32x4*)(H + (size_t)row * DM) + C.lane; const u32x4 v0 = src[0], v1 = src[64];
        u32x2 q0, q1;
        { unsigned w = 0; w = __builtin_amdgcn_cvt_pk_fp8_f32(bflo(v0.x) * pg8::X8_S, bfhi(v0.x) * pg8::X8_S, w, false); w = __builtin_amdgcn_cvt_pk_fp8_f32(bflo(v0.y) * pg8::X8_S, bfhi(v0.y) * pg8::X8_S, w, true); q0.x = w;
          w = 0; w = __builtin_amdgcn_cvt_pk_fp8_f32(bflo(v0.z) * pg8::X8_S, bfhi(v0.z) * pg8::X8_S, w, false); w = __builtin_amdgcn_cvt_pk_fp8_f32(bflo(v0.w) * pg8::X8_S, bfhi(v0.w) * pg8::X8_S, w, true); q0.y = w;
          w = 0; w = __builtin_amdgcn_cvt_pk_fp8_f32(bflo(v1.x) * pg8::X8_S, bfhi(v1.x) * pg8::X8_S, w, false); w = __builtin_amdgcn_cvt_pk_fp8_f32(bflo(v1.y) * pg8::X8_S, bfhi(v1.y) * pg8::X8_S, w, true); q1.x = w;
          w = 0; w = __builtin_amdgcn_cvt_pk_fp8_f32(bflo(v1.z) * pg8::X8_S, bfhi(v1.z) * pg8::X8_S, w, false); w = __builtin_amdgcn_cvt_pk_fp8_f32(bflo(v1.w) * pg8::X8_S, bfhi(v1.w) * pg8::X8_S, w, true); q1.y = w; }
#pragma unroll
        for (int k = 0; k < 4; ++k) { const int d = wgbase[tok_e[row * 4 + k]] + slot[row * 4 + k]; if (C.lane == 0) dest[row * 4 + k] = d;
            u32x2* dp = (u32x2*)(XG + (size_t)d * DM) + C.lane; dp[0] = q0; dp[64] = q1; }
    }
}

__device__ __forceinline__ void mix1_rope(const Ctx& C) {
    bf16* P = (bf16*)(C.ws + WS_P);
    const long total = (long)SEQ * 192;
    for (long i = (long)C.wg * NTHR + C.tid; i < total; i += (long)C.G * NTHR) {
        const int j = (int)(i & 31), hh = (int)((i >> 5) % 6), t = (int)(i / 192);
        const int col = (hh < 4) ? (C_AQ + hh * 64) : (C_AK + (hh - 4) * 64);
        const float pos = (j < 16) ? (float)(t >> 6) : (float)(t & 63);
        const float inv = __powf(10000.0f, -(float)(j & 15) * (1.0f / 16.0f));
        const float ang = pos * inv * 0.31830988618379067f;
        const float cs = cospif(ang), sn = sinpif(ang);
        bf16* p = P + (size_t)(NCTX + t) * INWP + col;
        const float x1 = bf2f(p[j]), x2 = bf2f(p[j + 32]);
        p[j] = (bf16)f2bf(x1 * cs - x2 * sn); p[j + 32] = (bf16)f2bf(x2 * cs + x1 * sn);
    }
}
__device__ __forceinline__ void mix1_vt(const Ctx& C) {
    const bf16* P = (const bf16*)(C.ws + WS_P);
    LAS unsigned short* scr = (LAS unsigned short*)(C.lds + C.wave * 16384);
    for (int u = C.gw; u < (ROWS / 64) * 6; u += C.NGW) {
        const int hd = u % 6, tb = u / 6; const int vcol = (hd < 2) ? (C_AV + hd * 64) : (C_CV + (hd - 2) * 64);
        bf16* VT = ((hd < 2) ? (bf16*)(C.ws + WS_VTA) + (size_t)hd * 64 * VTP : (bf16*)(C.ws + WS_VTC) + (size_t)(hd - 2) * 64 * VTP);
#pragma unroll
        for (int i = 0; i < 8; ++i) { const int tk = (C.lane >> 3) + 8 * i, ch = C.lane & 7; const u32x4 w = *(const u32x4*)(P + (size_t)(tb * 64 + tk) * INWP + vcol + 8 * ch);
            LAS unsigned* d = (LAS unsigned*)(scr + tk * 66 + 8 * ch); d[0] = w.x; d[1] = w.y; d[2] = w.z; d[3] = w.w; }
        LDS_WAIT(); asm volatile("" ::: "memory");
#pragma unroll
        for (int k8 = 0; k8 < 8; ++k8) { unsigned w[4];
#pragma unroll
            for (int e2 = 0; e2 < 4; ++e2) { const unsigned lo = scr[(8 * k8 + 2 * e2) * 66 + C.lane], hi = scr[(8 * k8 + 2 * e2 + 1) * 66 + C.lane]; w[e2] = lo | (hi << 16); }
            *(u32x4*)(VT + (size_t)C.lane * VTP + tb * 64 + 8 * k8) = (u32x4){w[0], w[1], w[2], w[3]}; }
        LDS_WAIT(); asm volatile("" ::: "memory");
    }
    for (int i = C.wg * NTHR + C.tid; i < 6 * 64 * 32; i += C.G * NTHR) { const int rowi = i >> 5, pc = i & 31; const int hd = rowi >> 6, d = rowi & 63;
        bf16* VT = ((hd < 2) ? (bf16*)(C.ws + WS_VTA) + (size_t)hd * 64 * VTP : (bf16*)(C.ws + WS_VTC) + (size_t)(hd - 2) * 64 * VTP);
        *(u32x4*)(VT + (size_t)d * VTP + ROWS + 8 * pc) = (u32x4){0u, 0u, 0u, 0u}; }
}
__device__ __forceinline__ float conv3(const bf16* P, int row, int col, const float* cw, int cc) {
    const bool first = (row == 0) || (row == NCTX), last = (row == NCTX - 1) || (row == ROWS - 1);
    float s = cw[768 + cc] * bf2f(P[(size_t)row * INWP + col]);
    if (!first) s += cw[cc] * bf2f(P[(size_t)(row - 1) * INWP + col]);
    if (!last) s += cw[2 * 768 + cc] * bf2f(P[(size_t)(row + 1) * INWP + col]);
    return s;
}
__device__ __forceinline__ void mix1_rwkv_prep(const Ctx& C, const DArgs& a, int l) {
    const bf16* P = (const bf16*)(C.ws + WS_P); float* SC = (float*)(C.ws + WS_SC);
    constexpr int LBP = 264;
    LAS unsigned char* lob = C.lds;
    LAS float* pre = (LAS float*)(C.lds + 16384);
    const bf16* lorat = (const bf16*)(C.ws + WS_LORAT) + (size_t)l * 4 * 256 * 64;
    const float* cw = a.in[I_DCONV] + (size_t)l * 3 * 768;
    const float* w0 = a.in[I_DW0] + (size_t)l * 512; const float* a0 = a.in[I_DA0] + (size_t)l * 512;
    const float* kkw = a.in[I_DKK] + (size_t)l * 256; const float* kaw = a.in[I_DKA] + (size_t)l * 256;
    const int half = C.tid >> 8, c = C.tid & 255, lane = C.lane, li = lane & 15, g = lane >> 4;
    const float kkc = kkw[c], kac = kaw[c];
    bf16x8 lrf[4][2][2];
#pragma unroll
    for (int q = 0; q < 4; ++q)
#pragma unroll
        for (int c2 = 0; c2 < 2; ++c2) { const bf16* bp = lorat + ((size_t)q * 256 + 16 * (2 * C.wave + c2) + li) * 64 + 8 * g; lrf[q][c2][0] = ldg8(bp); lrf[q][c2][1] = ldg8(bp + 32); }
    const float w0c[2] = {w0[c], w0[256 + c]}, a0c[2] = {a0[c], a0[256 + c]};
    const float cr0 = cw[c], cr1 = cw[768 + c], cr2 = cw[1536 + c], ck0 = cw[256 + c], ck1 = cw[768 + 256 + c], ck2 = cw[1536 + 256 + c], cv0 = cw[512 + c], cv1 = cw[768 + 512 + c], cv2 = cw[1536 + 512 + c];
    bf16 lin[7];
#define LIN_FETCH(gg) do { const int r0_ = 13 * (gg) + 7 * half; _Pragma("unroll") for (int j = 0; j < 7; ++j) if (j < 7 - half) lin[j] = P[(size_t)(r0_ + j) * INWP + C_WL + c]; } while (0)
    if (C.wg < ROWS / 13) LIN_FETCH(C.wg);
    for (int grp = C.wg; grp < ROWS / 13; grp += C.G) {
        const int row0 = 13 * grp + 7 * half, nj = 7 - half;
        __syncthreads();
#pragma unroll
        for (int j = 0; j < 7; ++j) if (j < nj) { const float x = bf2f(lin[j]); *(LAS bf16*)(lob + ((7 * half + j) * LBP + c) * 2) = (bf16)f2bf((c < 128) ? tanhf(x) : x); }
        __syncthreads();
        float xr[9], xk[9], xv[9];
#pragma unroll
        for (int q = 0; q < 9; ++q) { const int rw = row0 - 1 + q; const bool in = (rw >= 0) && (rw < ROWS) && (q <= nj + 1);
            const bf16* pp = P + (size_t)(in ? rw : row0) * INWP; xr[q] = in ? bf2f(pp[C_DR + c]) : 0.f; xk[q] = in ? bf2f(pp[C_DK + c]) : 0.f; xv[q] = in ? bf2f(pp[C_DV + c]) : 0.f; }
#pragma unroll
        for (int q = 0; q < 4; ++q) { const bf16x8 a0f = ldA(lob, LBP, 0, 64 * q, li, g), a1f = ldA(lob, LBP, 0, 64 * q + 32, li, g);
#pragma unroll
            for (int c2 = 0; c2 < 2; ++c2) { const int ci = 2 * C.wave + c2;
                f32x4 acc = {0.f, 0.f, 0.f, 0.f}; acc = mfma16(a0f, lrf[q][c2][0], acc); acc = mfma16(a1f, lrf[q][c2][1], acc);
#pragma unroll
                for (int r = 0; r < 4; ++r) pre[(q * 16 + 4 * g + r) * 256 + 16 * ci + li] = acc[r]; } }
        __syncthreads();
        if (grp + C.G < ROWS / 13) LIN_FETCH(grp + C.G);
#pragma unroll
        for (int j = 0; j < 7; ++j) if (j < nj) { const int row = row0 + j, rl = 7 * half + j;
            const bool first = (row == 0) || (row == NCTX), last = (row == NCTX - 1) || (row == ROWS - 1);
            const float m0 = first ? 0.f : 1.f, m2 = last ? 0.f : 1.f;
            const float r = cr1 * xr[j + 1] + m0 * cr0 * xr[j] + m2 * cr2 * xr[j + 2], k = ck1 * xk[j + 1] + m0 * ck0 * xk[j] + m2 * ck2 * xk[j + 2], v = cv1 * xv[j + 1] + m0 * cv0 * xv[j] + m2 * cv2 * xv[j + 2];
            float kk = k * kkc; const float n2 = wave_sum(kk * kk, lane); kk *= rsqrtf(fmaxf(n2, 1e-24f));
            float* sc = SC + (size_t)row * 9 * 256; sc[c] = r; sc[256 + c] = v; sc[512 + c] = -kk;
#pragma unroll
            for (int d = 0; d < 2; ++d) { const float wp = w0c[d] + pre[(d * 16 + rl) * 256 + c], ap = a0c[d] + pre[((2 + d) * 16 + rl) * 256 + c];
                const float nw = -wp, sp = fmaxf(nw, 0.f) + log1pf(__expf(-fabsf(nw)));
                const float lw = -__expf(-sp - 0.5f);
                const float as = sigmoidf_(ap);
                sc[(3 + 3 * d) * 256 + c] = lw; sc[(4 + 3 * d) * 256 + c] = k * (1.0f + (as - 1.0f) * kac); sc[(5 + 3 * d) * 256 + c] = kk * as; } }
    }
#undef LIN_FETCH
    __syncthreads();
}
constexpr int FP = 136;
constexpr int F_TABC = 0, F_TABS = 128 * FP * 2, F_TILE = 2 * 128 * FP * 2;
__device__ __forceinline__ void fourier_load_tables(const Ctx& C) {
    const bf16* ft = (const bf16*)(C.ws + WS_FTAB);
    for (int i = C.tid; i < 2 * 128 * 16; i += NTHR) { const int tb = i >> 11, r = (i >> 4) & 127, c8 = i & 15;
        *(LAS u32x4*)(C.lds + tb * F_TABS + (r * FP + 8 * c8) * 2) = *(const u32x4*)(ft + tb * 16384 + r * 128 + 8 * c8); }
}
__device__ __forceinline__ void mix1_fourier1(const Ctx& C) {
    const bf16* P = (const bf16*)(C.ws + WS_P); const float* tw = (const float*)(C.ws + WS_TW);
    bf16* FYR = (bf16*)(C.ws + WS_FYR); bf16* FYI = (bf16*)(C.ws + WS_FYI);
    const int lane = C.lane, li = lane & 15, g = lane >> 4, w = C.wave;
    __syncthreads();
    fourier_load_tables(C);
    for (int u = C.wg; u < 256; u += C.G) {
        const int t2 = u >> 1, ch0 = (u & 1) * 128;
        __syncthreads();
        for (int i = C.tid; i < 128 * 16; i += NTHR) { const int t1 = i >> 4, c8 = i & 15;
            *(LAS u32x4*)(C.lds + F_TILE + (t1 * FP + 8 * c8) * 2) = *(const u32x4*)(P + (size_t)(NCTX + 128 * t1 + t2) * INWP + C_BU + ch0 + 8 * c8); }
        __syncthreads();
        bf16x8 af[4];
#pragma unroll
        for (int ks = 0; ks < 4; ++ks) af[ks] = ldT(C.lds + F_TILE, FP, 32 * ks, 16 * w, li, g);
#pragma unroll 1
        for (int ni = 0; ni < 8; ++ni) { f32x4 dc = {0.f, 0.f, 0.f, 0.f}, ds = {0.f, 0.f, 0.f, 0.f};
#pragma unroll
            for (int ks = 0; ks < 4; ++ks) { dc = mfma16(af[ks], ldA(C.lds + F_TABC, FP, 16 * ni, 32 * ks, li, g), dc); ds = mfma16(af[ks], ldA(C.lds + F_TABS, FP, 16 * ni, 32 * ks, li, g), ds); }
            const int k1 = 16 * ni + li; const float cp = tw[t2 * k1], sp = tw[16384 + t2 * k1];
            const f32x4 yr = dc * cp - ds * sp, yi = -(ds * cp) - dc * sp;
            const size_t o = ((size_t)k1 * 128 + t2) * 256 + ch0 + 16 * w + 4 * g;
            u32x2 wr; wr.x = pk2(yr[0], yr[1]); wr.y = pk2(yr[2], yr[3]); *(u32x2*)(FYR + o) = wr;
            u32x2 wi; wi.x = pk2(yi[0], yi[1]); wi.y = pk2(yi[2], yi[3]); *(u32x2*)(FYI + o) = wi; }
    }
    __syncthreads();
}
__device__ __forceinline__ void fourier2_mfma(const Ctx& C, int l, int wg0) {
    const bf16* FYR = (const bf16*)(C.ws + WS_FYR); const bf16* FYI = (const bf16*)(C.ws + WS_FYI); bf16* MIX = (bf16*)(C.ws + WS_MIX);
    const int lane = C.lane, li = lane & 15, g = lane >> 4, w = C.wave;
    constexpr int YP = 72, F_YR = F_TILE, F_YI = F_TILE + 128 * YP * 2;
    __syncthreads();
    fourier_load_tables(C);
    bf16x8 mff[16];
    { const bf16x8* mf = (const bf16x8*)((const bf16*)(C.ws + WS_FTAB) + 32768) + (size_t)(l * 4 + ((C.wg - wg0) & 3)) * 16 * 64;
#pragma unroll
      for (int k = 0; k < 16; ++k) mff[k] = mf[k * 64 + lane]; }
    for (int u = C.wg - wg0; u < 512; u += C.G - wg0) {
        const int k1 = u >> 2, gq = u & 3;
        __syncthreads();
        for (int i = C.tid; i < 2 * 128 * 8; i += NTHR) { const int im = i >> 10, t2 = (i >> 3) & 127, c8 = i & 7;
            *(LAS u32x4*)(C.lds + (im ? F_YI : F_YR) + (t2 * YP + 8 * c8) * 2) = *(const u32x4*)((im ? FYI : FYR) + ((size_t)k1 * 128 + t2) * 256 + gq * 64 + 8 * c8); }
        __syncthreads();
        bf16x8 bc[4], bs[4];
#pragma unroll
        for (int ks = 0; ks < 4; ++ks) { bc[ks] = ldA(C.lds + F_TABC, FP, 16 * w, 32 * ks, li, g); bs[ks] = ldA(C.lds + F_TABS, FP, 16 * w, 32 * ks, li, g); }
        f32x4 xr[4], xi[4];
#pragma unroll
        for (int ci = 0; ci < 4; ++ci) { xr[ci] = (f32x4){0.f, 0.f, 0.f, 0.f}; f32x4 xs = {0.f, 0.f, 0.f, 0.f}; xi[ci] = xs;
#pragma unroll
            for (int ks = 0; ks < 4; ++ks) { const bf16x8 ar = ldT(C.lds + F_YR, YP, 32 * ks, 16 * ci, li, g), ai = ldT(C.lds + F_YI, YP, 32 * ks, 16 * ci, li, g);
                xr[ci] = mfma16(ar, bc[ks], xr[ci]); xr[ci] = mfma16(ai, bs[ks], xr[ci]);
                xi[ci] = mfma16(ai, bc[ks], xi[ci]); xs = mfma16(ar, bs[ks], xs); }
            xi[ci] = xi[ci] - xs; }
        union { bf16x8 v; unsigned q[4]; } xb[4];
#pragma unroll
        for (int q2 = 0; q2 < 2; ++q2) { xb[q2].q[0] = pk2(xr[2 * q2][0], xr[2 * q2][1]); xb[q2].q[1] = pk2(xr[2 * q2][2], xr[2 * q2][3]); xb[q2].q[2] = pk2(xr[2 * q2 + 1][0], xr[2 * q2 + 1][1]); xb[q2].q[3] = pk2(xr[2 * q2 + 1][2], xr[2 * q2 + 1][3]);
            xb[2 + q2].q[0] = pk2(xi[2 * q2][0], xi[2 * q2][1]); xb[2 + q2].q[1] = pk2(xi[2 * q2][2], xi[2 * q2][3]); xb[2 + q2].q[2] = pk2(xi[2 * q2 + 1][0], xi[2 * q2 + 1][1]); xb[2 + q2].q[3] = pk2(xi[2 * q2 + 1][2], xi[2 * q2 + 1][3]); }
#pragma unroll
        for (int ei = 0; ei < 4; ++ei) { f32x4 o = {0.f, 0.f, 0.f, 0.f};
#pragma unroll
            for (int ks2 = 0; ks2 < 4; ++ks2) o = mfma16(mff[ei * 4 + ks2], xb[ks2].v, o);
            const int tp = k1 + 128 * (16 * w + li);
            u32x2 wo; wo.x = pk2(o[0], o[1]); wo.y = pk2(o[2], o[3]); *(u32x2*)(MIX + (size_t)(NCTX + tp) * DM + 256 + gq * 64 + 16 * ei + 4 * g) = wo; }
    }
    __syncthreads();
}

constexpr float LOG2E = 1.4426950408889634f;
typedef short bf16x4 __attribute__((ext_vector_type(4)));
__device__ __forceinline__ void attn_load(const bf16* P, const bf16* VT, int krow, int kcol, int li, int g, bf16x8 (&kf)[2][2], bf16x8 (&vf)[4]) {
#pragma unroll
    for (int t = 0; t < 2; ++t)
#pragma unroll
        for (int ks = 0; ks < 2; ++ks) kf[t][ks] = ldg8(P + (size_t)(krow + 16 * t + li) * INWP + kcol + 32 * ks + 8 * g);
#pragma unroll
    for (int dt = 0; dt < 4; ++dt) { const bf16* vp = VT + (size_t)(dt * 16 + li) * VTP + krow + 4 * g;
        const bf16x4 a = *(const bf16x4*)vp, b = *(const bf16x4*)(vp + 16); vf[dt] = (bf16x8){a[0], a[1], a[2], a[3], b[0], b[1], b[2], b[3]}; }
}
template <int NS, int NT>
__device__ __forceinline__ void attn_compute(const bf16x8 (&kf)[2][2], const bf16x8 (&vf)[4], const bf16x8 (&qf)[NS][2], f32x4 (&o)[NS][4], float (&m)[NS], float (&ls)[NS],
                                             const float (&add)[NT][2][4], int li, int g) {
#pragma unroll
    for (int hh = 0; hh < NS; ++hh) {
        f32x4 st[2];
#pragma unroll
        for (int t = 0; t < 2; ++t) { st[t] = (f32x4){0.f, 0.f, 0.f, 0.f};
#pragma unroll
            for (int ks = 0; ks < 2; ++ks) st[t] = __builtin_amdgcn_mfma_f32_16x16x32_bf16(kf[t][ks], qf[hh][ks], st[t], 0, 0, 0); }
        float s[8]; float bm = -INFINITY;
#pragma unroll
        for (int t = 0; t < 2; ++t)
#pragma unroll
            for (int r = 0; r < 4; ++r) { const float ad = add[hh / (NS / NT)][t][r]; s[4 * t + r] = (ad == -INFINITY) ? -INFINITY : st[t][r] * (0.125f * LOG2E) + ad; bm = fmaxf(bm, s[4 * t + r]); }
        bm = fmaxf(bm, shx(bm, 16, 16 * g + li)); bm = fmaxf(bm, shx(bm, 32, 16 * g + li));
        const float mn = fmaxf(m[hh], bm), corr = __builtin_amdgcn_exp2f(m[hh] - mn); m[hh] = mn;
        float ps = 0.f; float pe[8];
#pragma unroll
        for (int e = 0; e < 8; ++e) { pe[e] = __builtin_amdgcn_exp2f(s[e] - mn); ps += pe[e]; }
        ls[hh] = ls[hh] * corr + ps;
        union { bf16x8 v; unsigned u[4]; } pf;
#pragma unroll
        for (int e2 = 0; e2 < 4; ++e2) pf.u[e2] = pk2(pe[2 * e2], pe[2 * e2 + 1]);
#pragma unroll
        for (int dt = 0; dt < 4; ++dt) { o[hh][dt] = o[hh][dt] * corr; o[hh][dt] = __builtin_amdgcn_mfma_f32_16x16x32_bf16(vf[dt], pf.v, o[hh][dt], 0, 0, 0); }
    }
}
__device__ __forceinline__ void attn_finish1(bf16* MIX, int qrow0, int ocol, f32x4 (&o)[4], float m, float ls, bool has_sink, float sink2, int li, int g) {
    float l = ls; l += shx(l, 16, 16 * g + li); l += shx(l, 32, 16 * g + li);
    float corr = 1.f;
    if (has_sink) { const float mn = fmaxf(m, sink2); corr = __builtin_amdgcn_exp2f(m - mn); l = l * corr + __builtin_amdgcn_exp2f(sink2 - mn); }
    const float inv = corr / l;
#pragma unroll
    for (int dt = 0; dt < 4; ++dt) { const f32x4 v = o[dt] * inv; u32x2 w; w.x = pk2(v[0], v[1]); w.y = pk2(v[2], v[3]);
        *(u32x2*)(MIX + (size_t)(qrow0 + li) * DM + ocol + dt * 16 + 4 * g) = w; }
}
__device__ __forceinline__ void attnA_unit(const Ctx& C, const float* asink_l, int unit, bool lat) {
    const bf16* P = (const bf16*)(C.ws + WS_P); bf16* MIX = (bf16*)(C.ws + WS_MIX);
    const int li = C.lane & 15, g = C.lane >> 4;
    const int nqp = lat ? SEQ / 32 : NCTX / 32, kvh = unit / nqp, qp = unit % nqp, t0 = qp * 32, qrow0 = (lat ? NCTX : 0) + t0;
    const bf16* VT = (const bf16*)(C.ws + WS_VTA) + (size_t)kvh * 64 * VTP; const int kcol = C_AK + kvh * 64;
    bf16x8 qf[4][2];
#pragma unroll
    for (int s = 0; s < 4; ++s)
#pragma unroll
        for (int ks = 0; ks < 2; ++ks) qf[s][ks] = ldg8(P + (size_t)(qrow0 + 16 * (s >> 1) + li) * INWP + C_AQ + (kvh * 2 + (s & 1)) * 64 + 32 * ks + 8 * g);
    f32x4 o[4][4]; float m[4], ls[4];
#pragma unroll
    for (int s = 0; s < 4; ++s) { m[s] = -1.0e30f; ls[s] = 0.f;
#pragma unroll
        for (int dt = 0; dt < 4; ++dt) o[s][dt] = (f32x4){0.f, 0.f, 0.f, 0.f}; }
    const int b_lo = lat ? 0 : 9;
#pragma unroll 1
    for (int bb = b_lo; bb < 17; ++bb) { float add[2][2][4]; bf16x8 kf[2][2], vf[4];
        const int krow = (bb < 9) ? NCTX + t0 - 128 + 32 * bb : 32 * (bb - 9);
        attn_load(P, VT, krow, kcol, li, g, kf, vf);
#pragma unroll
        for (int tl = 0; tl < 2; ++tl)
#pragma unroll
            for (int tt = 0; tt < 2; ++tt)
#pragma unroll
                for (int r = 0; r < 4; ++r) { const int j = t0 - 128 + 32 * bb + 16 * tt + 4 * g + r, t = t0 + 16 * tl + li;
                    const bool ok = (bb >= 9) || ((j >= 0) && (j < SEQ) && (j - t <= 128) && (t - j <= 128)); add[tl][tt][r] = ok ? 0.f : -INFINITY; }
        attn_compute<4, 2>(kf, vf, qf, o, m, ls, add, li, g); }
#pragma unroll
    for (int s = 0; s < 4; ++s) attn_finish1(MIX, qrow0 + 16 * (s >> 1), (kvh * 2 + (s & 1)) * 64, o[s], m[s], ls[s], true, asink_l[kvh * 2 + (s & 1)] * LOG2E, li, g);
}
__device__ __forceinline__ void attnC_unit(const Ctx& C, const LAS float* relb, int h, int up, bool lat) {
    const bf16* P = (const bf16*)(C.ws + WS_P); bf16* MIX = (bf16*)(C.ws + WS_MIX);
    const int li = C.lane & 15, g = C.lane >> 4;
    const int rp = up >> 2, cj = up & 3;
    const int t0a = lat ? (2 * rp) * 64 + 16 * cj : 32 * up, tstep = lat ? 64 : 16, qbase = lat ? NCTX : 0;
    const bf16* VT = (const bf16*)(C.ws + WS_VTC) + (size_t)h * 64 * VTP; const int kcol = C_CK + h * 64;
    bf16x8 qf[2][2];
#pragma unroll
    for (int s = 0; s < 2; ++s)
#pragma unroll
        for (int ks = 0; ks < 2; ++ks) qf[s][ks] = ldg8(P + (size_t)(qbase + t0a + tstep * s + li) * INWP + C_CQ + h * 64 + 32 * ks + 8 * g);
    f32x4 o[2][4]; float m[2] = {-1.0e30f, -1.0e30f}, ls[2] = {0.f, 0.f};
#pragma unroll
    for (int s = 0; s < 2; ++s)
#pragma unroll
        for (int dt = 0; dt < 4; ++dt) o[s][dt] = (f32x4){0.f, 0.f, 0.f, 0.f};
    const int r = 2 * rp, cq = cj * 16 + li;
    int r0a = r - 4; r0a = r0a < 0 ? 0 : (r0a > 248 ? 248 : r0a); int r0b = r - 3; r0b = r0b < 0 ? 0 : (r0b > 248 ? 248 : r0b);
    int c0 = cq - 8; c0 = c0 < 0 ? 0 : (c0 > 48 ? 48 : c0);
    const int cw0 = (cj == 0) ? 0 : (cj == 1) ? 8 : (cj == 2) ? 24 : 32;
    const int b_lo = lat ? 0 : 9;
#pragma unroll 1
    for (int bb = b_lo; bb < 17; ++bb) { float add[2][2][4]; bf16x8 kf[2][2], vf[4];
        const int kr = r0a + bb;
        if (bb < 9 && kr >= r0b + 8) continue;
        const int krow = (bb < 9) ? NCTX + kr * 64 + cw0 : 32 * (bb - 9);
        attn_load(P, VT, krow, kcol, li, g, kf, vf);
#pragma unroll
        for (int tl = 0; tl < 2; ++tl) { const int r0t = tl ? r0b : r0a, rt = r + tl; const bool rowok = (bb >= 9) || (kr >= r0t && kr < r0t + 8);
            int bi = kr - rt + 7; bi = bi < 0 ? 0 : (bi > 14 ? 14 : bi); const LAS float* rbp = relb + bi * 31;
#pragma unroll
            for (int tt = 0; tt < 2; ++tt)
#pragma unroll
                for (int rr = 0; rr < 4; ++rr) { const int kc = cw0 + 16 * tt + 4 * g + rr; int ci = kc - cq + 15; ci = ci < 0 ? 0 : (ci > 30 ? 30 : ci); const float bv = rbp[ci];
                    add[tl][tt][rr] = (bb >= 9) ? 0.f : ((rowok && kc >= c0 && kc < c0 + 16) ? bv : -INFINITY); } }
        attn_compute<2, 2>(kf, vf, qf, o, m, ls, add, li, g); }
#pragma unroll
    for (int s = 0; s < 2; ++s) attn_finish1(MIX, qbase + t0a + tstep * s, 512 + h * 64, o[s], m[s], ls[s], false, 0.f, li, g);
}
__device__ __forceinline__ void fourier_ctx_mfma(const Ctx& C, int l, int wg0) {
    const bf16* P = (const bf16*)(C.ws + WS_P); bf16* MIX = (bf16*)(C.ws + WS_MIX); const bf16* f2 = (const bf16*)(C.ws + WS_F256);
    const int lane = C.lane, li = lane & 15, g = lane >> 4, w = C.wave;
    constexpr int UP = 72;
    for (int u = C.wg - wg0; u < 8; u += C.G - wg0) {
        const int tb = u >> 2, gq = u & 3;
        __syncthreads();
        for (int i = C.tid; i < 256 * 8; i += NTHR) { const int t = i >> 3, c8 = i & 7; *(LAS u32x4*)(C.lds + (t * UP + 8 * c8) * 2) = *(const u32x4*)(P + (size_t)t * INWP + C_BU + gq * 64 + 8 * c8); }
        __syncthreads();
        const int tp0 = 128 * tb + 16 * w;
        f32x4 xr[4], xi[4];
#pragma unroll
        for (int ci = 0; ci < 4; ++ci) { xr[ci] = (f32x4){0.f, 0.f, 0.f, 0.f}; xi[ci] = (f32x4){0.f, 0.f, 0.f, 0.f}; }
#pragma unroll 2
        for (int ks = 0; ks < 8; ++ks) { const bf16x8 bc = ldg8(f2 + (size_t)(tp0 + li) * 256 + 32 * ks + 8 * g), bs = ldg8(f2 + 65536 + (size_t)(tp0 + li) * 256 + 32 * ks + 8 * g);
#pragma unroll
            for (int ci = 0; ci < 4; ++ci) { const bf16x8 au = ldT(C.lds, UP, 32 * ks, 16 * ci, li, g); xr[ci] = mfma16(au, bc, xr[ci]); xi[ci] = mfma16(au, bs, xi[ci]); } }
        union { bf16x8 v; unsigned q[4]; } xb[4];
#pragma unroll
        for (int q2 = 0; q2 < 2; ++q2) { xb[q2].q[0] = pk2(xr[2 * q2][0], xr[2 * q2][1]); xb[q2].q[1] = pk2(xr[2 * q2][2], xr[2 * q2][3]); xb[q2].q[2] = pk2(xr[2 * q2 + 1][0], xr[2 * q2 + 1][1]); xb[q2].q[3] = pk2(xr[2 * q2 + 1][2], xr[2 * q2 + 1][3]);
            xb[2 + q2].q[0] = pk2(-xi[2 * q2][0], -xi[2 * q2][1]); xb[2 + q2].q[1] = pk2(-xi[2 * q2][2], -xi[2 * q2][3]); xb[2 + q2].q[2] = pk2(-xi[2 * q2 + 1][0], -xi[2 * q2 + 1][1]); xb[2 + q2].q[3] = pk2(-xi[2 * q2 + 1][2], -xi[2 * q2 + 1][3]); }
        const bf16x8* mf = (const bf16x8*)((const bf16*)(C.ws + WS_FTAB) + 32768) + (size_t)(l * 4 + gq) * 16 * 64;
#pragma unroll
        for (int ei = 0; ei < 4; ++ei) { f32x4 o = {0.f, 0.f, 0.f, 0.f};
#pragma unroll
            for (int ks2 = 0; ks2 < 4; ++ks2) o = mfma16(mf[(ei * 4 + ks2) * 64 + lane], xb[ks2].v, o);
            o = o * 8.0f;
            u32x2 wo; wo.x = pk2(o[0], o[1]); wo.y = pk2(o[2], o[3]); *(u32x2*)(MIX + (size_t)(tp0 + li) * DM + 256 + gq * 64 + 16 * ei + 4 * g) = wo; }
    }
    __syncthreads();
}
__device__ __forceinline__ void fourier2_unit(const Ctx& C, int l, int u, bool ctx) {
    const bf16* P = (const bf16*)(C.ws + WS_P); const float* tw = (const float*)(C.ws + WS_TW); bf16* MIX = (bf16*)(C.ws + WS_MIX);
    const float* FYR = (const float*)(C.ws + WS_FYR); const float* FYI = (const float*)(C.ws + WS_FYI);
    const float* mt = (const float*)(C.ws + WS_MTAB) + (size_t)l * 2 * 4 * 4096;
    LAS float* xr = (LAS float*)(C.lds + 8192); LAS float* xi = xr + 512;
    const int tl = C.tid >> 8, ch = C.tid & 255, tp = 2 * u + tl;
    float sr = 0.f, si = 0.f;
    if (!ctx) { const int k1 = tp & 127, k2 = tp >> 7; const float* yr = FYR + (size_t)k1 * 128 * 256 + ch; const float* yi = FYI + (size_t)k1 * 128 * 256 + ch;
#pragma unroll 8
        for (int t2 = 0; t2 < 128; ++t2) { const int m = ((t2 * k2) & 127) * 128; const float c = tw[m], s = tw[16384 + m]; const float a = yr[t2 * 256], b = yi[t2 * 256]; sr += a * c + b * s; si += b * c - a * s; } }
    else {
#pragma unroll 8
        for (int t = 0; t < NCTX; ++t) { const int m = ((t * tp) & 255) * 64; const float x = bf2f(P[(size_t)t * INWP + C_BU + ch]); sr += x * tw[m]; si -= x * tw[16384 + m]; } }
    __syncthreads();
    xr[tl * 256 + ch] = sr; xi[tl * 256 + ch] = si;
    __syncthreads();
    const int g = ch >> 6, e = ch & 63; const float* mc = mt + (size_t)(0 * 4 + g) * 4096 + e; const float* ms = mt + (size_t)(1 * 4 + g) * 4096 + e;
    const LAS float* xrp = xr + tl * 256 + g * 64; const LAS float* xip = xi + tl * 256 + g * 64; float o = 0.f;
#pragma unroll 8
    for (int c = 0; c < 64; ++c) o += xrp[c] * mc[c * 64] + xip[c] * ms[c * 64];
    o *= ctx ? (1.0f / 128.0f) : (1.0f / 1024.0f);
    MIX[(size_t)((ctx ? 0 : NCTX) + tp) * DM + 256 + ch] = (bf16)f2bf(o);
}
__device__ __forceinline__ void rwkv_passB(const Ctx& C, int b);
__device__ __forceinline__ void phase_mix2(const Ctx& C, const DArgs& a, int l) {
    const bool emit_ctx = l < DEPTH - 1;
#ifndef REPMASK
#define REPMASK 0
#endif
#define NREP2(o) ((((REPMASK) >> (o)) & 1) ? 2 : 1)
    if (C.wg < 8) { for (int r2 = 0; r2 < NREP2(16); ++r2) rwkv_passB(C, C.wg); }
    else if (emit_ctx) fourier_ctx_mfma(C, l, 8);
    { const float* asink_l = a.in[I_ASINK] + l * 4; const float* crel = a.in[I_CREL] + (size_t)l * 4 * 465;
      LAS float* relb = (LAS float*)(C.lds + 110592 + C.wave * 2048);
      for (int r2 = 0; r2 < NREP2(17); ++r2) {
      unsigned* qhead = (unsigned*)(C.ws + WS_CTL) + CW_WQ + 64 * l + 16 * r2;
      const int nA = 2 * (SEQ / 32), nC = 4 * (SEQ / 32), nAc = emit_ctx ? 2 * (NCTX / 32) : 0, nCc = emit_ctx ? 4 * (NCTX / 32) : 0, nAll = nA + nAc + nC + nCc;
      int hcur = -1;
      const int nCv = emit_ctx ? CV_NCHUNK : 0;
      for (;;) { unsigned uq = 0; if (C.lane == 0) uq = __hip_atomic_fetch_add(qhead, 1u, __ATOMIC_RELAXED, __HIP_MEMORY_SCOPE_AGENT);
          const int uraw = __builtin_amdgcn_readfirstlane((int)uq); if (uraw >= nAll + nCv) break;
          int u;
          if (uraw < 2 * nCv) { if (uraw & 1) { const int ch = uraw >> 1; convert_moe_items(C, a, l + 1, ch * CV_CHUNK, ch * CV_CHUNK + CV_CHUNK); continue; } u = uraw >> 1; }
          else u = uraw - nCv;
          if (u < nA) attnA_unit(C, asink_l, u, true);
          else if (u < nA + nAc) attnA_unit(C, asink_l, u - nA, false);
          else { const int uc = u - nA - nAc; const bool lat = uc < nC; const int uu = lat ? uc : uc - nC, nqt = lat ? SEQ / 32 : NCTX / 32, h = uu / nqt, qt = uu % nqt;
              if (h != hcur) { for (int i = C.lane; i < 465; i += 64) relb[i] = crel[h * 465 + i] * LOG2E; hcur = h; LDS_WAIT(); asm volatile("" ::: "memory"); }
              attnC_unit(C, relb, h, qt, lat); } } } }
    __syncthreads();
    for (int r2 = 0; r2 < NREP2(19); ++r2) fourier2_mfma(C, l, 0);
}

constexpr int RW_C = 32, RW_NCH = ROWS / RW_C, RW_NSC = 32;
__device__ __forceinline__ int rw_sc_len(int s) { return s < 8 ? 17 : 16; }
__device__ __forceinline__ int rw_sc_start(int s) { return s < 8 ? 17 * s : 136 + 16 * (s - 8); }
__device__ __forceinline__ int rw_sc_of(int ct) { return ct < 136 ? ct / 17 : 8 + ((ct - 136) >> 4); }
constexpr int RW_SLOT = 5120, RW_REGION = 9 * RW_SLOT + 1024;
constexpr int TP = 72, HP = 40;
static_assert(3 * RW_REGION <= MISC_OFF, "RWKV D1 regions below the misc area");
__device__ __forceinline__ int rw_rc_of(int d, int c) { return d == 0 ? c : (c < 8 ? 7 - c : 527 - c); }
__device__ __forceinline__ int rw_row_of(int d, int rc, int t) { return 32 * rc + (d == 0 ? t : 31 - t); }

__device__ __forceinline__ void rwkv_d1(const Ctx& C, LAS unsigned char* rb, int d, int h, int rc) {
    int lane_ = C.lane; asm volatile("" : "+v"(lane_));
    const int lane = lane_, li = lane & 15, g = lane >> 4;
    const float* SC = (const float*)(C.ws + WS_SC);
    LAS unsigned char* S0 = rb; LAS unsigned char* S1 = rb + RW_SLOT; LAS unsigned char* S2 = rb + 2 * RW_SLOT; LAS unsigned char* S3 = rb + 3 * RW_SLOT; LAS unsigned char* S4 = rb + 4 * RW_SLOT;
    LAS unsigned char* S5 = rb + 5 * RW_SLOT; LAS unsigned char* S6 = rb + 6 * RW_SLOT; LAS unsigned char* S7 = rb + 7 * RW_SLOT; LAS unsigned char* S8 = rb + 8 * RW_SLOT;
    LAS unsigned char* S6b = S6 + 2560; LAS unsigned char* S7b = S7 + 2560;
    LAS float* gc = (LAS float*)(rb + 9 * RW_SLOT);
    { float cum = 0.f; const int j = lane; const int qw = (3 + 3 * d) * 256;
      float rv[2][4], vv[2][4], av[2][4], lw[2][4], kd[2][4], bb[2][4];
#define RW_LD(buf, t0) do { _Pragma("unroll") for (int u = 0; u < 4; ++u) { const float* sc = SC + (size_t)rw_row_of(d, rc, (t0) + u) * 9 * 256 + h * 64 + j; \
          rv[buf][u] = sc[0]; vv[buf][u] = sc[256]; av[buf][u] = sc[512]; lw[buf][u] = sc[qw]; kd[buf][u] = sc[qw + 256]; bb[buf][u] = sc[qw + 512]; } } while (0)
#define RW_CP(buf, t0) do { _Pragma("unroll") for (int u = 0; u < 4; ++u) { const float cp = cum; cum += lw[buf][u]; const float Gt = __expf(cum), Gm = __expf(cp), iG = __expf(-cum); const int off = (((t0) + u) * TP + j) * 2; \
          *(LAS bf16*)(S0 + off) = (bf16)f2bf(av[buf][u] * Gm); *(LAS bf16*)(S1 + off) = (bf16)f2bf(rv[buf][u] * Gt); *(LAS bf16*)(S2 + off) = (bf16)f2bf(bb[buf][u] * iG); \
          *(LAS bf16*)(S3 + off) = (bf16)f2bf(kd[buf][u] * iG); *(LAS bf16*)(S4 + off) = (bf16)f2bf(vv[buf][u]); } } while (0)
      RW_LD(0, 0);
#pragma unroll
      for (int b2 = 0; b2 < 4; ++b2) { RW_LD(1, 8 * b2 + 4); __builtin_amdgcn_sched_barrier(0); RW_CP(0, 8 * b2); if (b2 < 3) RW_LD(0, 8 * b2 + 8); __builtin_amdgcn_sched_barrier(0); RW_CP(1, 8 * b2 + 4); }
#undef RW_LD
#undef RW_CP
      gc[j] = __expf(cum); }
    const f32x4 z4 = {0.f, 0.f, 0.f, 0.f};
#pragma unroll 1
    for (int ti = 0; ti < 2; ++ti)
#pragma unroll
        for (int si = 0; si < 2; ++si) {
            f32x4 n = z4, nt = z4, mk = z4, qb = z4, qk = z4;
#pragma unroll
            for (int ks = 0; ks < 2; ++ks) { const bf16x8 at = ldA(S0, TP, 16 * ti, 32 * ks, li, g), rt = ldA(S1, TP, 16 * ti, 32 * ks, li, g), bs = ldA(S2, TP, 16 * si, 32 * ks, li, g), kss = ldA(S3, TP, 16 * si, 32 * ks, li, g);
                n = mfma16(at, bs, n);
                nt = mfma16(bs, at, nt);
                mk = mfma16(kss, at, mk);
                qb = mfma16(bs, rt, qb);
                qk = mfma16(kss, rt, qk); }
#pragma unroll
            for (int r = 0; r < 4; ++r) { const int trow = 16 * ti + 4 * g + r, scol = 16 * si + li; if (!(scol < trow)) n[r] = 0.f;
                const int srow = 16 * si + 4 * g + r, tcol = 16 * ti + li; if (!(srow < tcol)) { mk[r] = 0.f; nt[r] = 0.f; } if (!(srow <= tcol)) { qb[r] = 0.f; qk[r] = 0.f; } }
            *(LAS f32x4*)(S5 + ((16 * si + li) * 32 + 16 * ti + 4 * g) * 4) = n;
            stT(S6, HP, 16 * ti + li, 16 * si + 4 * g, mk);
            stT(S8, HP, 16 * ti + li, 16 * si + 4 * g, nt);
            stT(S6b, HP, 16 * ti + li, 16 * si + 4 * g, qb);
            stT(S7, HP, 16 * ti + li, 16 * si + 4 * g, qk); }
    { const int rr = lane & 31, bq = rr >> 4, lr = rr & 15; float Tr[16];
#pragma unroll
      for (int s = 15; s >= 0; --s) { float acc = (lr == s) ? 1.f : 0.f;
#pragma unroll
          for (int c4 = 0; c4 < 4; ++c4) { if (4 * c4 + 3 > s) { const f32x4 nv = *(const LAS f32x4*)(S5 + ((16 * bq + s) * 32 + 16 * bq + 4 * c4) * 4);
#pragma unroll
              for (int e = 0; e < 4; ++e) if (4 * c4 + e > s) acc += Tr[4 * c4 + e] * nv[e]; } }
          Tr[s] = acc; }
      if (lane < 32) { u32x4 w0, w1; w0.x = pk2(Tr[0], Tr[1]); w0.y = pk2(Tr[2], Tr[3]); w0.z = pk2(Tr[4], Tr[5]); w0.w = pk2(Tr[6], Tr[7]); w1.x = pk2(Tr[8], Tr[9]); w1.y = pk2(Tr[10], Tr[11]); w1.z = pk2(Tr[12], Tr[13]); w1.w = pk2(Tr[14], Tr[15]);
          const u32x4 zz = {0u, 0u, 0u, 0u}; LAS u32x4* trow = (LAS u32x4*)(S7b + rr * HP * 2);
          trow[0] = bq ? zz : w0; trow[1] = bq ? zz : w1; trow[2] = bq ? w0 : zz; trow[3] = bq ? w1 : zz; }
      f32x4 x = mfma16(ldA(S8, HP, 16, 0, li, g), ldT(S7b, HP, 0, 0, li, g), z4);
      LAS unsigned char* XT = S8 + 2560;
      *(LAS u32x2*)(XT + (li * HP + 4 * g) * 2) = (u32x2){0u, 0u}; stT(XT, HP, li, 16 + 4 * g, x);
      const f32x4 t21 = mfma16(ldA(S7b, HP, 16, 0, li, g), ldA(XT, HP, 0, 0, li, g), z4);
#pragma unroll
      for (int r = 0; r < 4; ++r) *(LAS bf16*)(S7b + ((16 + 4 * g + r) * HP + li) * 2) = (bf16)f2bf(t21[r]); }
#pragma unroll
    for (int ti = 0; ti < 2; ++ti) { const bf16x8 tf = ldA(S7b, HP, 16 * ti, 0, li, g), mf = ldA(S6, HP, 16 * ti, 0, li, g);
#pragma unroll
        for (int ji = 0; ji < 4; ++ji) { const f32x4 ap = mfma16(tf, ldT(S0, TP, 0, 16 * ji, li, g), z4); stT(S8, HP, 16 * ji + li, 16 * ti + 4 * g, ap);
            const f32x4 mv = mfma16(mf, ldT(S4, TP, 0, 16 * ji, li, g), z4); stT(S5, HP, 16 * ji + li, 16 * ti + 4 * g, mv); } }
#pragma unroll
    for (int ti = 0; ti < 2; ++ti) { const bf16x8 tf = ldA(S7b, HP, 16 * ti, 0, li, g);
#pragma unroll
        for (int vi = 0; vi < 4; ++vi) { const f32x4 ul = mfma16(tf, ldA(S5, HP, 16 * vi, 0, li, g), z4); stT(S0, HP, 16 * vi + li, 16 * ti + 4 * g, ul); } }
#pragma unroll
    for (int ti = 0; ti < 2; ++ti) { const bf16x8 qbf = ldA(S6b, HP, 16 * ti, 0, li, g), qkf = ldA(S7, HP, 16 * ti, 0, li, g);
#pragma unroll
        for (int ji = 0; ji < 4; ++ji) { f32x4 rp = mfma16(ldA(S8, HP, 16 * ji, 0, li, g), qbf, z4);
            LAS unsigned char* p = S1 + ((16 * ti + li) * TP + 16 * ji + 4 * g) * 2; rp = rp + ld4bf(p); u32x2 w; w.x = pk2(rp[0], rp[1]); w.y = pk2(rp[2], rp[3]); *(LAS u32x2*)p = w;
            f32x4 yl = mfma16(qbf, ldA(S0, HP, 16 * ji, 0, li, g), z4); yl = mfma16(qkf, ldT(S4, TP, 0, 16 * ji, li, g), yl);
            stT(S5, HP, 16 * ji + li, 16 * ti + 4 * g, yl); } }
#pragma unroll 2
    for (int ji = 0; ji < 4; ++ji) { const bf16x8 bt = ldT(S2, TP, 0, 16 * ji, li, g); const float gj = gc[16 * ji + li];
#pragma unroll
        for (int jp = 0; jp < 4; ++jp) { f32x4 pt = mfma16(ldA(S8, HP, 16 * jp, 0, li, g), bt, z4);
#pragma unroll
            for (int r = 0; r < 4; ++r) pt[r] = pt[r] * gj + ((16 * jp + 4 * g + r == 16 * ji + li) ? gj : 0.f);
            stT(S6, TP, 16 * ji + li, 16 * jp + 4 * g, pt); } }
#pragma unroll 1
    for (int vh = 0; vh < 2; ++vh) { f32x4 lt[4][2];
#pragma unroll
      for (int ji = 0; ji < 4; ++ji) { const bf16x8 ba = ldT(S2, TP, 0, 16 * ji, li, g), ka = ldT(S3, TP, 0, 16 * ji, li, g); const f32x4 gv = *(const LAS f32x4*)(gc + 16 * ji + 4 * g);
#pragma unroll
          for (int v2 = 0; v2 < 2; ++v2) { const int vi = 2 * vh + v2; f32x4 x = mfma16(ba, ldA(S0, HP, 16 * vi, 0, li, g), z4); x = mfma16(ka, ldT(S4, TP, 0, 16 * vi, li, g), x); lt[ji][v2] = x * gv; } }
      asm volatile("s_waitcnt lgkmcnt(0)" ::: "memory");
      LAS unsigned char* dst = vh ? S2 : S8;
#pragma unroll
      for (int ji = 0; ji < 4; ++ji)
#pragma unroll
          for (int v2 = 0; v2 < 2; ++v2) stT(dst, TP, 16 * v2 + li, 16 * ji + 4 * g, lt[ji][v2]); }
}
__device__ __forceinline__ void rwkv_passA_step(const Ctx& C, const LAS unsigned char* rb, f32x4 (&hs)[4], int d, int h, int rc) {
    int lane_ = C.lane; asm volatile("" : "+v"(lane_));
    const int lane = lane_, li = lane & 15, g = lane >> 4; const bool isPhi = C.wave >= 4; const int col = 16 * (C.wave & 3) + li;
    const LAS unsigned char* S1 = rb + RW_SLOT; const LAS unsigned char* S2 = rb + 2 * RW_SLOT; const LAS unsigned char* S5 = rb + 5 * RW_SLOT; const LAS unsigned char* S6 = rb + 6 * RW_SLOT;
    const LAS unsigned char* LTb = (col < 32) ? rb + 8 * RW_SLOT + col * TP * 2 : S2 + (col - 32) * TP * 2;
    union { bf16x8 v; unsigned u[4]; } bf[2];
#pragma unroll
    for (int ks = 0; ks < 2; ++ks) { bf[ks].u[0] = pk2(hs[2 * ks][0], hs[2 * ks][1]); bf[ks].u[1] = pk2(hs[2 * ks][2], hs[2 * ks][3]); bf[ks].u[2] = pk2(hs[2 * ks + 1][0], hs[2 * ks + 1][1]); bf[ks].u[3] = pk2(hs[2 * ks + 1][2], hs[2 * ks + 1][3]); }
#pragma unroll
    for (int ti = 0; ti < 2; ++ti) { f32x4 acc = isPhi ? (f32x4){0.f, 0.f, 0.f, 0.f} : ld4bf(S5 + (col * HP + 16 * ti + 4 * g) * 2);
#pragma unroll
        for (int ks = 0; ks < 2; ++ks) acc = mfma16(ldAperm(S1, TP, 16 * ti, ks, li, g), bf[ks].v, acc);
        if (!isPhi) { float* ys = (float*)(C.ws + WS_YS) + (size_t)d * ROWS * 256 + h * 64 + col;
#pragma unroll
            for (int r = 0; r < 4; ++r) ys[(size_t)rw_row_of(d, rc, 16 * ti + 4 * g + r) * 256] = acc[r]; }
        else { bf16* rp = (bf16*)(C.ws + WS_RPP) + ((size_t)((d * 4 + h) * RW_NCH + rc) * 32) * 64 + col;
#pragma unroll
            for (int r = 0; r < 4; ++r) rp[(16 * ti + 4 * g + r) * 64] = (bf16)f2bf(acc[r]); } }
    f32x4 hn[4];
#pragma unroll
    for (int i = 0; i < 4; ++i) { f32x4 acc = isPhi ? (f32x4){0.f, 0.f, 0.f, 0.f} : ld4bf(LTb + (16 * i + 4 * g) * 2);
#pragma unroll
        for (int ks = 0; ks < 2; ++ks) acc = mfma16(ldAperm(S6, TP, 16 * i, ks, li, g), bf[ks].v, acc);
        hn[i] = acc; }
#pragma unroll
    for (int i = 0; i < 4; ++i) hs[i] = hn[i];
}
__device__ __forceinline__ void phase_rwkv1(const Ctx& C) {
    const int lane = C.lane, li = lane & 15, g = lane >> 4;
    for (int u = C.wg; u < 8 * RW_NSC; u += C.G) {
        const int s = u % RW_NSC, dh = u / RW_NSC, d = dh >> 2, h = dh & 3; const bool isPhi = C.wave >= 4; const int col = 16 * (C.wave & 3) + li;
        f32x4 hs[4];
#pragma unroll
        for (int i = 0; i < 4; ++i)
#pragma unroll
            for (int r = 0; r < 4; ++r) hs[i][r] = (isPhi && (16 * i + 4 * g + r == col)) ? 1.f : 0.f;
        const int nch = rw_sc_len(s), c0 = rw_sc_start(s);
#pragma unroll 1
        for (int rnd = 0; rnd < 6; ++rnd) {
            __syncthreads();
            { int wv = C.wave; asm volatile("" : "+s"(wv)); if (wv < 3 && 3 * rnd + wv < nch) rwkv_d1(C, C.lds + wv * RW_REGION, d, h, rw_rc_of(d, c0 + 3 * rnd + wv)); }
            __syncthreads();
#pragma unroll 1
            for (int k = 0; k < 3; ++k) { const int ci = 3 * rnd + k; int ko = k * RW_REGION; asm volatile("" : "+s"(ko)); if (ci < nch) rwkv_passA_step(C, C.lds + ko, hs, d, h, rw_rc_of(d, c0 + ci)); }
        }
        if (isPhi) { bf16* pf = (bf16*)(C.ws + WS_PSC) + (size_t)(dh * RW_NSC + s) * 4096;
            const int ks = col >> 5, eh = (col >> 4) & 1, gp = (col >> 2) & 3, el = col & 3;
#pragma unroll
            for (int i = 0; i < 4; ++i)
#pragma unroll
                for (int r = 0; r < 4; ++r) pf[((i * 2 + ks) * 64 + gp * 16 + 4 * g + r) * 8 + eh * 4 + el] = (bf16)f2bf(hs[i][r]); }
        else { f32x4* lf = (f32x4*)(C.ws + WS_LSC) + ((size_t)(dh * RW_NSC + s) * 4 + C.wave) * 4 * 64;
#pragma unroll
            for (int i = 0; i < 4; ++i) lf[i * 64 + lane] = hs[i]; }
    }
    __syncthreads();
}
__device__ __forceinline__ void rwkv_passB(const Ctx& C, int b) {
    if (C.wave >= 4) return;
    const int lane = C.lane, li = lane & 15, g = lane >> 4, q = C.wave;
    f32x4 hs[4];
#pragma unroll
    for (int i = 0; i < 4; ++i) hs[i] = (f32x4){0.f, 0.f, 0.f, 0.f};
    const bf16x8* pfb = (const bf16x8*)((const bf16*)(C.ws + WS_PSC) + (size_t)b * RW_NSC * 4096);
    const f32x4* lfb = (const f32x4*)(C.ws + WS_LSC) + ((size_t)b * RW_NSC * 4 + q) * 4 * 64;
    bf16x8 pa[8]; f32x4 la[4];
#pragma unroll
    for (int k = 0; k < 8; ++k) pa[k] = pfb[k * 64 + lane];
#pragma unroll
    for (int i = 0; i < 4; ++i) la[i] = lfb[i * 64 + lane];
#pragma unroll 1
    for (int s = 0; s < RW_NSC; ++s) {
        bf16* hp = (bf16*)(C.ws + WS_HSC) + ((size_t)(b * RW_NSC + s) * 64 + 16 * q + li) * 64;
#pragma unroll
        for (int i = 0; i < 4; ++i) { u32x2 w; w.x = pk2(hs[i][0], hs[i][1]); w.y = pk2(hs[i][2], hs[i][3]); *(u32x2*)(hp + 16 * i + 4 * g) = w; }
        bf16x8 pn[8]; f32x4 ln[4]; const int sn = (s + 1 < RW_NSC) ? s + 1 : s;
#pragma unroll
        for (int k = 0; k < 8; ++k) pn[k] = pfb[(size_t)sn * 512 + k * 64 + lane];
#pragma unroll
        for (int i = 0; i < 4; ++i) ln[i] = lfb[(size_t)sn * 4 * 4 * 64 + i * 64 + lane];
        union { bf16x8 v; unsigned u[4]; } bf[2];
#pragma unroll
        for (int ks = 0; ks < 2; ++ks) { bf[ks].u[0] = pk2(hs[2 * ks][0], hs[2 * ks][1]); bf[ks].u[1] = pk2(hs[2 * ks][2], hs[2 * ks][3]); bf[ks].u[2] = pk2(hs[2 * ks + 1][0], hs[2 * ks + 1][1]); bf[ks].u[3] = pk2(hs[2 * ks + 1][2], hs[2 * ks + 1][3]); }
#pragma unroll
        for (int i = 0; i < 4; ++i) { f32x4 acc = la[i];
#pragma unroll
            for (int ks = 0; ks < 2; ++ks) acc = mfma16(pa[i * 2 + ks], bf[ks].v, acc);
            hs[i] = acc; }
#pragma unroll
        for (int k = 0; k < 8; ++k) pa[k] = pn[k];
#pragma unroll
        for (int i = 0; i < 4; ++i) la[i] = ln[i];
    }
}
__device__ __forceinline__ void phase_mix3(const Ctx& C, const DArgs& a, int l) {
    const bf16* P = (const bf16*)(C.ws + WS_P); const float* SC = (const float*)(C.ws + WS_SC); const float* YS = (const float*)(C.ws + WS_YS); bf16* MIX = (bf16*)(C.ws + WS_MIX);
    LAS float* yt = (LAS float*)(C.lds);
    constexpr int GSP = 168;
    LAS unsigned char* gsig = C.lds + 32768;
    LAS float* gm = (LAS float*)(C.lds + 40960);
    const bf16* g2t = (const bf16*)(C.ws + WS_G2T) + (size_t)l * 256 * 160;
    const float* rk = a.in[I_DRK] + (size_t)l * 256; const float* lnw = a.in[I_DLNW] + (size_t)l * 256; const float* lnb = a.in[I_DLNB] + (size_t)l * 256;
    const int lane = C.lane, li = lane & 15, g = lane >> 4, h = C.wave & 3, d = C.wave >> 2;
    const int half = C.tid >> 8, c = C.tid & 255;
    const int u_lo = (l == DEPTH - 1) ? NCTX / 16 : 0;
    bf16 glv[5];
#define GL_FETCH(uu) do { _Pragma("unroll") for (int k = 0; k < 5; ++k) { const int i = C.tid + NTHR * k, t = i / 160, ii = i % 160; glv[k] = P[(size_t)(16 * (uu) + t) * INWP + C_GL + ii]; } } while (0)
    const float lnwc = lnw[c], lnbc = lnb[c], rkc = rk[c];
    bf16x8 g2f[2][5];
#pragma unroll
    for (int c2 = 0; c2 < 2; ++c2)
#pragma unroll
        for (int ks = 0; ks < 5; ++ks) g2f[c2][ks] = ldg8(g2t + (size_t)(16 * (2 * C.wave + c2) + li) * 160 + 32 * ks + 8 * g);
    bf16x8 caf[2], cbf[4][2]; float cys[4][4];
#define CORR_FETCH(uu) do { const int rc_ = (uu) >> 1, th_ = (uu) & 1, ct_ = (d == 0) ? rc_ : (rc_ < 8 ? 7 - rc_ : 527 - rc_), s_ = rw_sc_of(ct_), ti_ = (d == 0) ? th_ : 1 - th_; \
        const bf16* rp_ = (const bf16*)(C.ws + WS_RPP) + (size_t)((d * 4 + h) * RW_NCH + rc_) * 32 * 64; const bf16* hp_ = (const bf16*)(C.ws + WS_HSC) + (size_t)((d * 4 + h) * RW_NSC + s_) * 64 * 64; \
        _Pragma("unroll") for (int ks = 0; ks < 2; ++ks) caf[ks] = ldg8(rp_ + (16 * ti_ + li) * 64 + 32 * ks + 8 * g); \
        _Pragma("unroll") for (int vi = 0; vi < 4; ++vi) { _Pragma("unroll") for (int ks = 0; ks < 2; ++ks) cbf[vi][ks] = ldg8(hp_ + (16 * vi + li) * 64 + 32 * ks + 8 * g); \
            _Pragma("unroll") for (int r = 0; r < 4; ++r) { const int t_ = 16 * ti_ + 4 * g + r, rl_ = ((d == 0) ? t_ : 31 - t_) - 16 * th_; cys[vi][r] = YS[((size_t)d * ROWS + 16 * (uu) + rl_) * 256 + h * 64 + 16 * vi + li]; } } } while (0)
    if (u_lo + C.wg < ROWS / 16) { GL_FETCH(u_lo + C.wg); CORR_FETCH(u_lo + C.wg); }
    for (int u = u_lo + C.wg; u < ROWS / 16; u += C.G) {
        const int rc = u >> 1, th = u & 1, rowb = 16 * u;
        __syncthreads();
#pragma unroll
        for (int k = 0; k < 5; ++k) { const int i = C.tid + NTHR * k, t = i / 160, ii = i % 160; *(LAS bf16*)(gsig + (t * GSP + ii) * 2) = (bf16)f2bf(sigmoidf_(bf2f(glv[k]))); }
        {
          const int ti = (d == 0) ? th : 1 - th;
#pragma unroll
          for (int vi = 0; vi < 4; ++vi) { f32x4 acc = {0.f, 0.f, 0.f, 0.f};
#pragma unroll
              for (int ks = 0; ks < 2; ++ks) acc = mfma16(caf[ks], cbf[vi][ks], acc);
#pragma unroll
              for (int r = 0; r < 4; ++r) { const int t = 16 * ti + 4 * g + r, rl = ((d == 0) ? t : 31 - t) - 16 * th;
                  yt[(d * 16 + rl) * 256 + h * 64 + 16 * vi + li] = acc[r] + cys[vi][r]; } } }
        __syncthreads();
#pragma unroll
        for (int c2 = 0; c2 < 2; ++c2) { const int ci = 2 * C.wave + c2; f32x4 a0 = {0.f, 0.f, 0.f, 0.f};
#pragma unroll
            for (int ks = 0; ks < 5; ++ks) a0 = mfma16(ldA(gsig, GSP, 0, 32 * ks, li, g), g2f[c2][ks], a0);
#pragma unroll
            for (int r = 0; r < 4; ++r) gm[(4 * g + r) * 256 + 16 * ci + li] = a0[r]; }
        __syncthreads();
        if (u + C.G < ROWS / 16) { GL_FETCH(u + C.G); CORR_FETCH(u + C.G); }
        float qr[8], qv[8], qk0[8], qk1[8];
#pragma unroll
        for (int it = 0; it < 8; ++it) { const float* sc = SC + (size_t)(rowb + 2 * it + half) * 9 * 256; qr[it] = sc[c]; qv[it] = sc[256 + c]; qk0[it] = sc[4 * 256 + c]; qk1[it] = sc[7 * 256 + c]; }
#pragma unroll
        for (int it = 0; it < 8; ++it) { const int rl = 2 * it + half, row = rowb + rl;
            const float y = yt[rl * 256 + c] + yt[(16 + rl) * 256 + c];
            const float mu = wave_sum(y, lane) * (1.f / 64.f), dy = y - mu, var = wave_sum(dy * dy, lane) * (1.f / 64.f);
            const float yn = dy * rsqrtf(var + 64e-5f) * lnwc + lnbc;
            const float coef = wave_sum(qr[it] * (qk0[it] + qk1[it]) * rkc, lane);
            MIX[(size_t)row * DM + 768 + c] = (bf16)f2bf((yn + coef * qv[it]) * gm[rl * 256 + c]); }
    }
#undef GL_FETCH
#undef CORR_FETCH
    __syncthreads();
}
__device__ __forceinline__ void outproj_ctx(const Ctx& C, int l, const float* gate) {
    const bf16* A = (const bf16*)(C.ws + WS_MIX); const bf16* B = (const bf16*)(C.ws + WS_WOUT) + (size_t)l * DM * DM; float* XS = (float*)(C.ws + WS_XS);
    const int lane = C.lane, li = lane & 15, g = lane >> 4;
    for (int u = C.gw; u < (NCTX / 16) * (DM / 16); u += C.NGW) { const int rt = u >> 6, ct = u & 63;
        const bf16* ap = A + (size_t)(16 * rt + li) * DM + 8 * g; const bf16* bp = B + (size_t)(16 * ct + li) * DM + 8 * g;
        f32x4 acc0 = {0.f, 0.f, 0.f, 0.f}, acc1 = {0.f, 0.f, 0.f, 0.f};
#pragma unroll 4
        for (int ks = 0; ks < 32; ks += 2) { acc0 = mfma16(ldg8(ap + 32 * ks), ldg8(bp + 32 * ks), acc0); acc1 = mfma16(ldg8(ap + 32 * ks + 32), ldg8(bp + 32 * ks + 32), acc1); }
        const float gv = gate[16 * ct + li];
#pragma unroll
        for (int r = 0; r < 4; ++r) { float* p = XS + (size_t)(16 * rt + 4 * g + r) * DM + 16 * ct + li; *p = *p + gv * (acc0[r] + acc1[r]); } }
}

#ifndef MK_SINGLE
#define MK_SINGLE 1
#endif
template <int ONLYP> __global__ void __launch_bounds__(NTHR, 2) mega(Args a) {
    extern __shared__ __attribute__((aligned(16))) unsigned char lds_raw[];
    Ctx C;
#define MKCTX() do { int t_ = threadIdx.x; asm volatile("" : "+v"(t_)); unsigned char* w_ = a.ws; asm volatile("" : "+s"(w_)); unsigned l_ = 0u; asm volatile("" : "+s"(l_)); \
        C.lds = (LAS unsigned char*)lds_raw + l_; C.tid = t_; C.lane = t_ & 63; C.wave = __builtin_amdgcn_readfirstlane(t_ >> 6); \
        C.wg = blockIdx.x; C.G = gridDim.x; C.gw = C.wg * NWAVES + C.wave; C.NGW = C.G * NWAVES; C.ws = w_; } while (0)
    MKCTX();
    if (C.tid == 0) {
#pragma unroll
        for (int i = 0; i < 31; ++i) ((LAS unsigned long long*)(C.lds + MISC_OFF + 2048))[i] = (unsigned long long)a.in[i]; }
    DArgs da; da.in.tab = (const LAS unsigned*)(C.lds + MISC_OFF + 2048); da.out = a.out;
    if (C.tid < 4) ((LAS unsigned*)(C.lds + MISC_OFF))[C.tid] = 0u;
    __syncthreads();
    XcdBarrier bar; bar.bar = (unsigned*)(C.ws + WS_CTL) + CW_BAR; bar.x = 0; bar.st = (volatile LAS unsigned*)(C.lds + MISC_OFF);
    if (a.use_bar) bar = xcd_barrier_post((unsigned*)(C.ws + WS_CTL) + CW_BAR, (volatile LAS unsigned*)(C.lds + MISC_OFF));
#ifndef PHMASK
#define PHMASK 0x1fff
#endif
#define INP(o, k) ((ONLYP < 0 || ONLYP == (o)) && ((PHMASK >> ((o) == 99 ? 12 : (o))) & 1) && a.ph_lo <= (k) && (k) < a.ph_hi)
#ifndef REPMASK
#define REPMASK 0
#endif
#define NREP(o) ((((REPMASK) >> ((o) == 99 ? 12 : (o))) & 1) ? 2 : 1)
#define IN(k) (a.ph_lo <= (k) && (k) < a.ph_hi)
#define SEAM(k) do { if (a.use_bar && IN(k) && IN((k) + 1)) { xcd_barrier(bar); if ((REPMASK >> 20) & 1) xcd_barrier(bar); } } while (0)
    if (INP(0, 0)) for (int rep = 0; rep < NREP(0); ++rep) { MKCTX(); phase_prologue(C, da); }
    SEAM(0);
    for (int l = 0; l < DEPTH; ++l) {
        const int b = 1 + l * NPL;
        const float* mod_lat = (const float*)(C.ws + WS_MOD) + (size_t)(l * 2 + 0) * 6144; const float* mod_ctx = mod_lat + 6144;
        if (INP(1, b + 0)) { MKCTX(); phase_norm1(C, da, l); }
        SEAM(b + 0);
        if (INP(2, b + 1)) for (int rep = 0; rep < NREP(2); ++rep) { MKCTX();
            pg8::StaticOrder S; S.init(WS_H, WS_WIN + (size_t)l * INWP * DM * 2, ROWS, INWP, DM, C.G, C.wg);
            pg8::EpiStoreBf16 E{(bf16*)(C.ws + WS_P), INWP, nullptr, 0, 1.0f, 1.0f};
            pg8::gemm_phase<pg8::EpiStoreBf16, pg8::StaticOrder, true, true>(C.lds, C.tid, DM, S, E, C.ws);
        }
        SEAM(b + 1);
        if (INP(3, b + 2)) { MKCTX(); mix1_rope(C); for (int rep = 0; rep < NREP(3); ++rep) { mix1_vt(C); mix1_rwkv_prep(C, da, l); mix1_fourier1(C); } }
        SEAM(b + 2);
        if (INP(11, b + 3)) for (int rep = 0; rep < NREP(11); ++rep) { MKCTX(); phase_rwkv1(C); }
        SEAM(b + 3);
        if (INP(4, b + 4)) for (int rep = 0; rep < NREP(4); ++rep) { MKCTX(); phase_mix2(C, da, l); }
        SEAM(b + 4);
        if (INP(5, b + 5)) for (int rep = 0; rep < NREP(5); ++rep) { MKCTX(); phase_mix3(C, da, l); }
        SEAM(b + 5);
        if (INP(6, b + 6)) { MKCTX();
            if (l < DEPTH - 1) outproj_ctx(C, l, mod_ctx + 2 * DM);
            pg8::StaticOrder S; S.init(WS_MIX + (size_t)NCTX * DM * 2, WS_WOUT + (size_t)l * DM * DM * 2, SEQ, DM, DM, C.G, C.wg);
            pg8::EpiResidual E{(float*)(C.ws + WS_XS) + (size_t)NCTX * DM, DM, mod_lat + 2 * DM, mod_lat + 2 * DM};
            pg8::gemm_phase<pg8::EpiResidual, pg8::StaticOrder, true, true>(C.lds, C.tid, DM, S, E, C.ws);
        }
        SEAM(b + 6);
        if (INP(7, b + 7)) for (int rep = 0; rep < NREP(7); ++rep) { MKCTX(); phase_norm2(C, da, l); }
        SEAM(b + 7);
        if (INP(8, b + 8)) for (int rep = 0; rep < NREP(8); ++rep) { MKCTX(); phase_gather(C, da, l); }
        SEAM(b + 8);
        if (INP(9, b + 9)) for (int rep = 0; rep < NREP(9); ++rep) { MKCTX();
            const int nblk = moe_tables_load(C);
            pg8::MoeOrder S{(unsigned)WS_XG8, (unsigned)(WS_WGU + (size_t)l * 32 * 2048 * DM), 256u * DM, 2048u * DM,
                            (const LAS unsigned char*)(C.lds + MISC_OFF + 1024), nblk, 8, C.G, C.wg};
            pg8::EpiSwiglu E{(bf16*)(C.ws + WS_ACT8), DM, da.in[I_BGU] + (size_t)l * 32 * 2048, 2048, pg8::X8_S * pg8::W8_S, 1.0f / (pg8::X8_S * pg8::W8_S)};
            pg8::gemm_phase<pg8::EpiSwiglu, pg8::MoeOrder, true, true, 1>(C.lds, C.tid, DM, S, E, C.ws);
        }
        SEAM(b + 9);
        if (INP(10, b + 10)) for (int rep = 0; rep < NREP(10); ++rep) { MKCTX();
            const int nblk = moe_tables_load(C);
            pg8::MoeOrder S{(unsigned)WS_ACT8, (unsigned)(WS_WDN + (size_t)l * 32 * DM * DM), 256u * DM, (unsigned)(DM * DM),
                            (const LAS unsigned char*)(C.lds + MISC_OFF + 1024), nblk, 4, C.G, C.wg};
            pg8::EpiStoreBf16 E{(bf16*)(C.ws + WS_XG), DM, da.in[I_BDN] + (size_t)l * 32 * DM, DM, pg8::ACT_S * pg8::W8_S, 1.0f / (pg8::ACT_S * pg8::W8_S)};
            pg8::gemm_phase<pg8::EpiStoreBf16, pg8::MoeOrder, true, true, 1>(C.lds, C.tid, DM, S, E, C.ws);
        }
        SEAM(b + 10);
    }
    if (INP(99, PH_TOTAL - 1)) for (int rep = 0; rep < NREP(99); ++rep) { MKCTX(); phase_final(C, da); }
#undef IN
#undef INP
#undef SEAM
}

typedef void (*kern_t)(Args);
static kern_t kern_of(int o) {
#if MK_SINGLE
    (void)o; return mega<-1>;
#else
    switch (o) { case 0: return mega<0>; case 1: return mega<1>; case 2: return mega<2>; case 3: return mega<3>; case 4: return mega<4>; case 5: return mega<5>; case 6: return mega<6>;
                 case 7: return mega<7>; case 8: return mega<8>; case 9: return mega<9>; case 10: return mega<10>; case 11: return mega<11>; case 99: return mega<99>;
                 default: return mega<0>;
    }
#endif
}
extern "C" void kernel_launch(void* const* d_in, const int* in_sizes, int n_in, void* d_out, int out_size, void* d_ws, size_t ws_size, hipStream_t stream) {
    static int ready = 0;
    if (ready == 0) {
        if (n_in != 31 || out_size != SEQ * DM || ws_size < WS_END) { fprintf(stderr, "kernel_launch: unexpected shapes (n_in %d, out %d, ws %zu)\n", n_in, out_size, ws_size); ready = -1; return; }
        const int ids[14] = {0, 1, 2, 3, 4, 5, 6, 7, 8, 9, 10, 11, 99, -1};
        for (int i = 0; i < (MK_SINGLE ? 14 : 13); ++i) { if (MK_SINGLE && ids[i] != -1) continue;
            if (hipFuncSetAttribute((const void*)kern_of(ids[i]), hipFuncAttributeMaxDynamicSharedMemorySize, LDS_BYTES) != hipSuccess) { fprintf(stderr, "kernel_launch: hipFuncSetAttribute failed (%d)\n", ids[i]); ready = -1; return; } }
        ready = 1;
    }
    if (ready < 0) return;
    (void)hipMemsetAsync((char*)d_ws + WS_CTL, 0, CTL_ZERO_BYTES, stream);
    Args a{};
    for (int i = 0; i < 31; ++i) a.in[i] = (const float*)d_in[i];
    a.out = (float*)d_out; a.ws = (unsigned char*)d_ws; a.pad = 0;
#if MK_SINGLE
    a.ph_lo = 0; a.ph_hi = PH_TOTAL; a.use_bar = 1;
    hipLaunchKernelGGL(kern_of(-1), dim3(NWG), dim3(NTHR), LDS_BYTES, stream, a);
#else
    for (int p = 0; p < PH_TOTAL; ++p) { a.ph_lo = p; a.ph_hi = p + 1; a.use_bar = 0;
        const int j = (p - 1) % NPL; const int o = (p == 0) ? 0 : (p == PH_TOTAL - 1) ? 99 : (j < 3 ? 1 + j : j == 3 ? 11 : j);
        hipLaunchKernelGGL(kern_of(o), dim3(NWG), dim3(NTHR), LDS_BYTES, stream, a); }
#endif
}
```

```cpp
#include <hip/hip_runtime.h>
#include <cstdio>
#include <cstdint>

#define LAS __attribute__((address_space(3)))
typedef unsigned short bf16;
typedef float f32x4 __attribute__((ext_vector_type(4)));
typedef float f32x2 __attribute__((ext_vector_type(2)));
typedef short bf16x8 __attribute__((ext_vector_type(8)));
typedef unsigned u32x4 __attribute__((ext_vector_type(4)));
typedef unsigned u32x2 __attribute__((ext_vector_type(2)));

constexpr int DM = 1024, SEQ = 16384, NCTX = 256, ROWS = SEQ + NCTX, DEPTH = 4, GRIDW = 64;
constexpr int INW = 2720, INWP = 2816;
constexpr int C_AQ = 0, C_AK = 256, C_AV = 384, C_BU = 512, C_CQ = 768, C_CK = 1024, C_CV = 1280, C_DR = 1536, C_DK = 1792, C_DV = 2048, C_WL = 2304, C_AL = 2432, C_GL = 2560;
constexpr int NEXP = 32, TOPK = 4;
constexpr int MOE_MAXBLK = 296;
constexpr int MOE_ROWS = MOE_MAXBLK * 256;
constexpr int NWG = 256, NTHR = 512, NWAVES = 8;
constexpr int VTP = ROWS + 256;

constexpr size_t MiB = 1u << 20;
constexpr size_t WS_CTL = 0, CTL_ZERO_BYTES = 1 * MiB;
constexpr size_t WS_MOD = 1 * MiB;
constexpr size_t WS_TW = 2 * MiB;
constexpr size_t WS_MTAB = 3 * MiB;
constexpr size_t WS_XS = 4 * MiB;
constexpr size_t WS_H = 70 * MiB;
constexpr size_t WS_P = 104 * MiB;
constexpr size_t WS_MIX = 194 * MiB;
constexpr size_t WS_FYR = 228 * MiB, WS_FYI = 244 * MiB;
constexpr size_t WS_VTA = 1544 * MiB, WS_VTC = 1550 * MiB;
constexpr size_t WS_SC = 260 * MiB;
constexpr size_t WS_YS = 408 * MiB;
constexpr size_t WS_ROUTE = 442 * MiB;
constexpr size_t WS_CNT = 444 * MiB;
constexpr size_t WS_XG = 446 * MiB;
constexpr size_t WS_ACT = 596 * MiB;
constexpr size_t WS_XG8 = WS_ACT, WS_ACT8 = WS_ACT + 75 * MiB;
constexpr size_t WS_WIN = 746 * MiB;
constexpr size_t WS_WOUT = 768 * MiB;
constexpr size_t WS_WGU = 776 * MiB;
constexpr size_t WS_WDN = 1288 * MiB;
constexpr size_t WS_RPP = 1560 * MiB, WS_PSC = 1578 * MiB, WS_LSC = 1580 * MiB, WS_HSC = 1584 * MiB;
constexpr size_t WS_FTAB = 1586 * MiB;
constexpr size_t WS_G2T = 1588 * MiB, WS_RWT = 1589 * MiB;
constexpr size_t WS_LORAT = 1590 * MiB;
constexpr size_t WS_F256 = 1591 * MiB;

constexpr size_t WS_END = 1592 * MiB;
static_assert(WS_XS + (size_t)ROWS * DM * 4 <= WS_H && WS_H + (size_t)ROWS * DM * 2 <= WS_P && WS_P + (size_t)ROWS * INWP * 2 <= WS_MIX && WS_MIX + (size_t)ROWS * DM * 2 <= WS_FYR, "ws map 1");
static_assert(WS_SC + (size_t)ROWS * 9 * 256 * 4 <= WS_YS && WS_YS + (size_t)2 * ROWS * 256 * 4 <= WS_ROUTE && WS_XG + (size_t)MOE_ROWS * DM * 2 <= WS_ACT && WS_ACT + (size_t)MOE_ROWS * DM * 2 <= WS_WIN, "ws map 2");
static_assert(WS_WIN + (size_t)4 * INWP * DM * 2 <= WS_WOUT && WS_WGU + (size_t)4 * 32 * 2048 * 1024 * 2 <= WS_WDN && WS_WDN + (size_t)4 * 32 * 1024 * 1024 * 2 <= WS_END, "ws map 3");
constexpr int CW_BAR = 4096;
constexpr int CW_WQ = 16384;

constexpr int RING_BYTES = 131072;
constexpr int MISC_OFF = 143360;
constexpr int LDS_BYTES = 147456;

typedef __bf16 hbf16x2 __attribute__((ext_vector_type(2)));
__device__ __forceinline__ unsigned pk2(float lo, float hi) { const f32x2 v = {lo, hi}; return __builtin_bit_cast(unsigned, __builtin_convertvector(v, hbf16x2)); }
__device__ __forceinline__ unsigned f2bf(float f) { return (unsigned)__builtin_bit_cast(unsigned short, (__bf16)f); }
__device__ __forceinline__ float bf2f(unsigned short b) { return __builtin_bit_cast(float, (unsigned)b << 16); }
__device__ __forceinline__ float bflo(unsigned w) { return __builtin_bit_cast(float, w << 16); }
__device__ __forceinline__ float bfhi(unsigned w) { return __builtin_bit_cast(float, w & 0xffff0000u); }
__device__ __forceinline__ float shx(float v, int o, int lane) { return __builtin_bit_cast(float, __builtin_amdgcn_ds_bpermute((lane ^ o) << 2, __builtin_bit_cast(int, v))); }
__device__ __forceinline__ int shxi(int v, int o, int lane) { return __builtin_amdgcn_ds_bpermute((lane ^ o) << 2, v); }
__device__ __forceinline__ float dpp_ror(float v, int ctrl_unused);
__device__ __forceinline__ float dpp_swap1(float v) { return __builtin_bit_cast(float, __builtin_amdgcn_update_dpp(0, __builtin_bit_cast(int, v), 0xB1, 0xf, 0xf, false)); }
#define DPP_ROR_ADD(v, n) v += __builtin_bit_cast(float, __builtin_amdgcn_update_dpp(0, __builtin_bit_cast(int, v), 0x120 + (n), 0xf, 0xf, false))
__device__ __forceinline__ float wave_sum(float v, int lane) {
    DPP_ROR_ADD(v, 8); DPP_ROR_ADD(v, 4); DPP_ROR_ADD(v, 2); DPP_ROR_ADD(v, 1);
    v += shx(v, 16, lane); v += shx(v, 32, lane);
    return v;
}
__device__ __forceinline__ float sigmoidf_(float x) { return __builtin_amdgcn_rcpf(1.f + __expf(-x)); }
#define LDS_WAIT() asm volatile("s_waitcnt lgkmcnt(0)" ::: "memory")
#define VM_WAIT() asm volatile("s_waitcnt vmcnt(0)" ::: "memory")

namespace pg8 {
#define PG8_LAS __attribute__((address_space(3)))
typedef unsigned short bf16_t;
constexpr int BM = 256, BK = 64, HALF = 128, HTB = HALF * BK * 2, STAGE_BYTES = 8 * HTB, NXCD = 8, WGM = 8;
__host__ __device__ __forceinline__ int lds_byte(int r, int c) { const int st = (r >> 4) * 2 + (c >> 5), rr = r & 15, cc = c & 31, ob = rr * 64 + cc * 2; return st * 1024 + (ob ^ (((ob >> 9) & 1) << 5)); }
__host__ __device__ __forceinline__ void stage_rc(int b, int& R, int& C) { const int st = b / 1024, sb = b % 1024, swz = sb ^ (((sb >> 9) & 1) << 5); R = (st >> 1) * 16 + swz / 64; C = (st & 1) * 32 + (swz % 64) / 2; }
__host__ __device__ __forceinline__ int perm32(int rho) { const int n = rho >> 4, i = rho & 15; return 8 * (i >> 2) + 4 * n + (i & 3); }
struct Unit { int pm, pn, e; };
typedef int v8i __attribute__((ext_vector_type(8))); typedef int v4i __attribute__((ext_vector_type(4)));
__device__ __forceinline__ v8i cat8(bf16x8 a, bf16x8 b) { const v4i x = __builtin_bit_cast(v4i, a), y = __builtin_bit_cast(v4i, b); return __builtin_shufflevector(x, y, 0, 1, 2, 3, 4, 5, 6, 7); }
__device__ __forceinline__ unsigned cvt_pk_bf16(float lo, float hi) { unsigned r; asm volatile("v_cvt_pk_bf16_f32 %0, %1, %2" : "=v"(r) : "v"(lo), "v"(hi)); return r; }

struct StaticOrder {
    unsigned A, Bt, tstep;
    int nM, nN, nwg, G, c;
    __device__ void init(size_t A_, size_t Bt_, int M, int N, int K, int G_, int c_) { A = (unsigned)A_; Bt = (unsigned)Bt_; tstep = (unsigned)(BM * K * 2); nM = M / BM; nN = N / BM; nwg = nM * nN; G = G_; c = c_; }
    __device__ bool next(int i, Unit& u) const {
        const long L = (long)i * G + c; if (L >= nwg) return false;
        int wgid = (int)L; { const int q = nwg / NXCD, r = nwg % NXCD, xcd = wgid % NXCD, off = wgid / NXCD; wgid = (xcd < r ? xcd * (q + 1) : r * (q + 1) + (xcd - r) * q) + off; }
        const int nig = WGM * nN, gid = wgid / nig, fm = gid * WGM, gsz = (nM - fm) < WGM ? (nM - fm) : WGM;
        u.pm = fm + ((wgid % nig) % gsz); u.pn = (wgid % nig) / gsz; u.e = 0; return true;
    }
    __device__ __forceinline__ unsigned pa(const Unit& u) const { return A + (unsigned)u.pm * tstep; }
    __device__ __forceinline__ unsigned pb(const Unit& u) const { return Bt + (unsigned)u.pn * tstep; }
};
struct MoeOrder {
    unsigned A, Bt, tstep, estep;
    const LAS unsigned char* blk_e; int nblk, nN, G, c;
    int lo, hi;
    __device__ void split() {
        const int U = nblk * nN, q = U >> 3, r = U & 7, x = c & 7; lo = x * q + (x < r ? x : r); hi = lo + q + (x < r ? 1 : 0); c = c >> 3; G = G >> 3; }
    __device__ bool next(int i, Unit& u) const {
        const int L = lo + i * G + c; if (L >= hi) return false;
        u.pm = L / nN; u.pn = L % nN; u.e = __builtin_amdgcn_readfirstlane((int)blk_e[u.pm]); return true;
    }
    __device__ __forceinline__ unsigned pa(const Unit& u) const { return A + (unsigned)u.pm * tstep; }
    __device__ __forceinline__ unsigned pb(const Unit& u) const { return Bt + (unsigned)u.e * estep + (unsigned)u.pn * tstep; }
};

struct EpiStoreBf16 {
    static constexpr bool PERM = true;
    bf16_t* O; int ldc; const float* bias; int bias_estride; float bias_scale, acc_scale;
    __device__ __forceinline__ void init(f32x4 (&acc)[2][2][4][2], const Unit& u, int wc, int fq) const {
        const int col0 = u.pn * BM + wc * 32 + 8 * fq;
#pragma unroll
        for (int b = 0; b < 2; ++b)
#pragma unroll
            for (int n = 0; n < 2; ++n) { const f32x4 bv = bias ? *(const f32x4*)(bias + (size_t)u.e * bias_estride + col0 + b * HALF + 4 * n) * bias_scale : (f32x4){0.f, 0.f, 0.f, 0.f};
#pragma unroll
                for (int a = 0; a < 2; ++a)
#pragma unroll
                    for (int m = 0; m < 4; ++m) { f32x4 t = bv; asm volatile("" : "+v"(t)); acc[a][b][m][n] = t; } }
    }
    __device__ __forceinline__ void operator()(const f32x4 (&acc)[2][2][4][2], const Unit& u, int wr, int wc, int fr, int fq) const {
        const int row0 = u.pm * BM + wr * 64 + fr, col0 = u.pn * BM + wc * 32 + 8 * fq;
#pragma unroll
        for (int ai = 0; ai < 2; ++ai)
#pragma unroll
            for (int m = 0; m < 4; ++m) { bf16_t* rowp = O + (size_t)(row0 + ai * HALF + m * 16) * ldc + col0;
#pragma unroll
                for (int bj = 0; bj < 2; ++bj) { const f32x4 v0 = acc[ai][bj][m][0] * acc_scale, v1 = acc[ai][bj][m][1] * acc_scale;
                    u32x4 w; w.x = cvt_pk_bf16(v0[0], v0[1]); w.y = cvt_pk_bf16(v0[2], v0[3]); w.z = cvt_pk_bf16(v1[0], v1[1]); w.w = cvt_pk_bf16(v1[2], v1[3]);
                    *(u32x4*)(rowp + bj * HALF) = w; }
                asm volatile("" ::: "memory"); }
    }
};
__device__ __forceinline__ float swiglu1(float g, float up) {
    g = fminf(g, 7.0f); up = fminf(fmaxf(up, -7.0f), 7.0f);
    return g * __builtin_amdgcn_rcpf(1.f + __expf(-1.702f * g)) * (up + 1.0f);
}
constexpr float X8_S = 8.0f, W8_S = 256.0f, ACT_S = 4.0f;
struct EpiSwiglu {
    static constexpr bool PERM = true;
    bf16_t* O; int ldc; const float* bias; int bias_estride; float bias_scale, acc_scale;
    __device__ __forceinline__ void init(f32x4 (&acc)[2][2][4][2], const Unit& u, int wc, int fq) const {
        const int col0 = u.pn * BM + wc * 32 + 8 * fq;
#pragma unroll
        for (int b = 0; b < 2; ++b)
#pragma unroll
            for (int n = 0; n < 2; ++n) { const f32x4 bv = bias ? *(const f32x4*)(bias + (size_t)u.e * bias_estride + col0 + b * HALF + 4 * n) * bias_scale : (f32x4){0.f, 0.f, 0.f, 0.f};
#pragma unroll
                for (int a = 0; a < 2; ++a)
#pragma unroll
                    for (int m = 0; m < 4; ++m) { f32x4 t = bv; asm volatile("" : "+v"(t)); acc[a][b][m][n] = t; } }
    }
    __device__ __forceinline__ void operator()(const f32x4 (&acc)[2][2][4][2], const Unit& u, int wr, int wc, int fr, int fq) const {
        const int row0 = u.pm * BM + wr * 64 + fr, col0 = u.pn * BM + wc * 32 + 8 * fq;
#pragma unroll
        for (int ai = 0; ai < 2; ++ai)
#pragma unroll
            for (int m = 0; m < 4; ++m) { unsigned char* rowp = (unsigned char*)O + (size_t)(row0 + ai * HALF + m * 16) * ldc + (col0 >> 1);
#pragma unroll
                for (int bj = 0; bj < 2; ++bj) { const f32x4 v0 = acc[ai][bj][m][0] * acc_scale, v1 = acc[ai][bj][m][1] * acc_scale;
                    unsigned w = 0; w = __builtin_amdgcn_cvt_pk_fp8_f32(swiglu1(v0[0], v0[1]) * ACT_S, swiglu1(v0[2], v0[3]) * ACT_S, w, false); w = __builtin_amdgcn_cvt_pk_fp8_f32(swiglu1(v1[0], v1[1]) * ACT_S, swiglu1(v1[2], v1[3]) * ACT_S, w, true);
                    *(unsigned*)(rowp + bj * (HALF / 2)) = w; }
                asm volatile("" ::: "memory"); }
    }
};
struct EpiResidual {
    static constexpr bool PERM = false;
    bf16* X; int ldc; const float* gate_lat; const float* gate_ctx;
    __device__ __forceinline__ void init(f32x4 (&acc)[2][2][4][2], const Unit& u, int wc, int fq) const {
#pragma unroll
        for (int a = 0; a < 2; ++a)
#pragma unroll
            for (int b = 0; b < 2; ++b)
#pragma unroll
                for (int m = 0; m < 4; ++m)
#pragma unroll
                    for (int n = 0; n < 2; ++n) acc[a][b][m][n] = (f32x4){0.f, 0.f, 0.f, 0.f};
    }
    __device__ __forceinline__ void operator()(const f32x4 (&acc)[2][2][4][2], const Unit& u, int wr, int wc, int fr, int fq) const {
        const int row0 = u.pm * BM + wr * 64 + fr, col0 = u.pn * BM + wc * 32 + 4 * fq;
        const float* gp = (u.pm == 0) ? gate_ctx : gate_lat;
        f32x4 gv[2][2];
#pragma unroll
        for (int bj = 0; bj < 2; ++bj)
#pragma unroll
            for (int n = 0; n < 2; ++n) gv[bj][n] = *(const f32x4*)(gp + col0 + bj * HALF + n * 16);
#pragma unroll
        for (int ai = 0; ai < 2; ++ai)
#pragma unroll
            for (int m = 0; m < 4; ++m) { bf16* rowp = X + (size_t)(row0 + ai * HALF + m * 16) * ldc + col0;
#pragma unroll
                for (int bj = 0; bj < 2; ++bj)
#pragma unroll
                    for (int n = 0; n < 2; ++n) { u32x2* p = (u32x2*)(rowp + bj * HALF + n * 16); const u32x2 w = *p; const f32x4 y = (f32x4){bflo(w.x), bfhi(w.x), bflo(w.y), bfhi(w.y)} + gv[bj][n] * acc[ai][bj][m][n]; u32x2 o; o.x = pk2(y.x, y.y); o.y = pk2(y.z, y.w); *p = o; }
                asm volatile("" ::: "memory"); }
    }
};
template <class Epi, class Sched, bool ALIGN_EPI = false, bool SP2 = false, int ES = 2>
__device__ __forceinline__ void gemm_phase(PG8_LAS unsigned char* lds, const int tid, const int K, const Sched& S, const Epi& E, const void* wsbase) {
    const __amdgpu_buffer_rsrc_t rsrc = __builtin_amdgcn_make_buffer_rsrc((void*)wsbase, 0, 0x7fffffff, 0x00020000);
    const int wid = __builtin_amdgcn_readfirstlane(tid >> 6), lane = tid & 63, wr = wid >> 2, wc = wid & 3, fr = lane & 15, fq = lane >> 4;
    const int nt = (K * ES) / 128;
    unsigned voffA[2], voffB[2];
#pragma unroll
    for (int i = 0; i < 2; ++i) { int R, C; stage_rc(tid * 16 + i * 8192, R, C); const int Rb = Epi::PERM ? ((R & ~31) + perm32(R & 31)) : R;
        voffA[i] = (unsigned)(R * K * ES + C * 2); voffB[i] = (unsigned)(Rb * K * ES + C * 2); }
    const unsigned kstep = (unsigned)(BK * 2);
    const unsigned hstep = (unsigned)(HALF * K * ES);
        const unsigned ldsw = (unsigned)wid * 1024u;
    const int aoff = lds_byte(wr * 64 + fr, ES == 2 ? fq * 8 : fq * 16), boff = lds_byte(wc * 32 + fr, ES == 2 ? fq * 8 : fq * 16); constexpr int KOFF = (ES == 2) ? 1024 : 16;
#define PG8_SA(b, h) (((b) * 2 + (h)) * HTB)
#define PG8_SB(b, h) ((4 + (b) * 2 + (h)) * HTB)
#define PG8_STAGE(bufoff, gbase, voff) do { _Pragma("unroll") for (int _i = 0; _i < 2; ++_i) \
        __builtin_amdgcn_raw_ptr_buffer_load_lds(rsrc, (PG8_LAS unsigned*)(lds + (bufoff) + ldsw + _i * 8192), 16, (voff)[_i], (gbase), 0, 0); } while (0)
#define PG8_LDA(dst, b, h) do { _Pragma("unroll") for (int m = 0; m < 4; ++m) _Pragma("unroll") for (int k = 0; k < 2; ++k) dst[m][k] = *(const PG8_LAS bf16x8*)(lds + PG8_SA(b, h) + aoff + m * 2048 + k * KOFF); } while (0)
#define PG8_LDA8(dst, b, h) do { _Pragma("unroll") for (int m = 0; m < 4; ++m) { const PG8_LAS v4i* p_ = (const PG8_LAS v4i*)(lds + PG8_SA(b, h) + aoff + m * 2048); const v4i x_ = p_[0], y_ = p_[1]; dst[m] = __builtin_shufflevector(x_, y_, 0, 1, 2, 3, 4, 5, 6, 7); } } while (0)
#define PG8_LDB(dst, b, h) do { _Pragma("unroll") for (int n = 0; n < 2; ++n) _Pragma("unroll") for (int k = 0; k < 2; ++k) dst[n][k] = *(const PG8_LAS bf16x8*)(lds + PG8_SB(b, h) + boff + n * 2048 + k * KOFF); } while (0)
#define PG8_LDB8(dst, b, h) do { _Pragma("unroll") for (int n = 0; n < 2; ++n) { const PG8_LAS v4i* p_ = (const PG8_LAS v4i*)(lds + PG8_SB(b, h) + boff + n * 2048); const v4i x_ = p_[0], y_ = p_[1]; dst[n] = __builtin_shufflevector(x_, y_, 0, 1, 2, 3, 4, 5, 6, 7); } } while (0)
#define PG8_MMA(ai, bj, At, Bt) do { __builtin_amdgcn_s_setprio(1); _Pragma("unroll") for (int m = 0; m < 4; ++m) _Pragma("unroll") for (int n = 0; n < 2; ++n) { \
        if constexpr (ES == 2) { _Pragma("unroll") for (int k = 0; k < 2; ++k) acc[ai][bj][m][n] = __builtin_amdgcn_mfma_f32_16x16x32_bf16(Bt[n][k], At[m][k], acc[ai][bj][m][n], 0, 0, 0); } \
        else asm volatile("v_mfma_f32_16x16x128_f8f6f4 %0, %1, %2, %0" : "+v"(acc[ai][bj][m][n]) : "v"(Bt##8[n]), "v"(At##8[m])); } \
        __builtin_amdgcn_s_setprio(0); } while (0)
#define PG8_LDAX(b, h) do { if constexpr (ES == 2) PG8_LDA(At, b, h); else PG8_LDA8(At8, b, h); } while (0)
#define PG8_LDBX(B, b, h) do { if constexpr (ES == 2) PG8_LDB(B, b, h); else PG8_LDB8(B##8, b, h); } while (0)
#define PG8_WAIT_V(n) asm volatile("s_waitcnt vmcnt(" #n ")" ::: "memory")
#define PG8_WAIT_L(n) asm volatile("s_waitcnt lgkmcnt(" #n ")" ::: "memory")
#define PG8_BAR __builtin_amdgcn_s_barrier()
#define PG8_SCHED __builtin_amdgcn_sched_barrier(0)
    Unit cur, nxt; int ui = 0;
    if (!S.next(0, cur)) return;
    f32x4 acc[2][2][4][2];
    E.init(acc, cur, wc, fq);
    bf16x8 At[4][2], B0[2][2], B1[2][2]; v8i At8[4], B08[2], B18[2];
    unsigned cA = S.pa(cur), cB = S.pb(cur);
    if constexpr (SP2) {
        PG8_STAGE(PG8_SB(0, 0), cB, voffB); PG8_STAGE(PG8_SB(0, 1), cB + hstep, voffB); PG8_STAGE(PG8_SA(0, 0), cA, voffA); PG8_STAGE(PG8_SA(0, 1), cA + hstep, voffA);
        if (wr == 1) PG8_BAR;
        PG8_WAIT_V(2); PG8_BAR;
        PG8_STAGE(PG8_SB(1, 0), cB + kstep, voffB); PG8_STAGE(PG8_SA(1, 0), cA + kstep, voffA); PG8_STAGE(PG8_SB(1, 1), cB + hstep + kstep, voffB);
        PG8_WAIT_V(6); PG8_BAR;
    } else {
        PG8_STAGE(PG8_SB(0, 0), cB, voffB); PG8_STAGE(PG8_SA(0, 0), cA, voffA); PG8_STAGE(PG8_SB(0, 1), cB + hstep, voffB); PG8_STAGE(PG8_SA(0, 1), cA + hstep, voffA);
        if (wr == 1) PG8_BAR;
        PG8_WAIT_V(4); PG8_BAR;
        PG8_STAGE(PG8_SB(1, 0), cB + kstep, voffB); PG8_STAGE(PG8_SA(1, 0), cA + kstep, voffA); PG8_STAGE(PG8_SB(1, 1), cB + hstep + kstep, voffB);
        PG8_WAIT_V(6); PG8_BAR;
    }
    for (;;) {
        const bool has_next = S.next(ui + 1, nxt);
        const unsigned nA = has_next ? S.pa(nxt) : cA, nB = has_next ? S.pb(nxt) : cB;
        for (int t = 0; t < nt; t += 2) {
            const bool last = (t == nt - 2);
            const unsigned a1 = cA + (unsigned)(t + 1) * kstep;
            const unsigned a2 = last ? nA : cA + (unsigned)(t + 2) * kstep, b2 = last ? nB : cB + (unsigned)(t + 2) * kstep;
            const unsigned a3 = a2 + kstep, b3 = b2 + kstep;
            if constexpr (SP2) {
            PG8_LDBX(B0, 0, 0); PG8_LDBX(B1, 0, 1); PG8_SCHED; PG8_LDAX(0, 0); PG8_STAGE(PG8_SA(1, 1), a1 + hstep, voffA);
            PG8_WAIT_V(8); PG8_WAIT_L(0); PG8_BAR; PG8_MMA(0, 0, At, B0); PG8_MMA(0, 1, At, B1); PG8_BAR; PG8_SCHED;
            PG8_LDAX(0, 1); PG8_STAGE(PG8_SB(0, 0), b2, voffB); PG8_STAGE(PG8_SB(0, 1), b2 + hstep, voffB); PG8_STAGE(PG8_SA(0, 0), a2, voffA);
            PG8_WAIT_V(8); PG8_WAIT_L(0); PG8_BAR; PG8_MMA(1, 0, At, B0); PG8_MMA(1, 1, At, B1); PG8_BAR; PG8_SCHED;
            PG8_LDBX(B0, 1, 0); PG8_LDBX(B1, 1, 1); PG8_SCHED; PG8_LDAX(1, 0); PG8_STAGE(PG8_SA(0, 1), a2 + hstep, voffA);
            PG8_WAIT_V(8); PG8_WAIT_L(0); PG8_BAR; PG8_MMA(0, 0, At, B0); PG8_MMA(0, 1, At, B1); PG8_BAR; PG8_SCHED;
            PG8_LDAX(1, 1); PG8_STAGE(PG8_SB(1, 0), b3, voffB); PG8_STAGE(PG8_SB(1, 1), b3 + hstep, voffB); PG8_STAGE(PG8_SA(1, 0), a3, voffA);
            PG8_WAIT_V(8); PG8_WAIT_L(0); PG8_BAR; PG8_MMA(1, 0, At, B0); PG8_MMA(1, 1, At, B1); PG8_BAR; PG8_SCHED;
            } else {
            PG8_LDBX(B0, 0, 0); PG8_SCHED; PG8_LDAX(0, 0); PG8_STAGE(PG8_SA(1, 1), a1 + hstep, voffA);
            PG8_WAIT_L(8); PG8_BAR; PG8_WAIT_L(0); PG8_MMA(0, 0, At, B0); PG8_BAR; PG8_SCHED;
            PG8_LDBX(B1, 0, 1); PG8_STAGE(PG8_SB(0, 0), b2, voffB);
            PG8_BAR; PG8_WAIT_L(0); PG8_MMA(0, 1, At, B1); PG8_BAR;
            PG8_LDAX(0, 1); PG8_STAGE(PG8_SA(0, 0), a2, voffA);
            PG8_BAR; PG8_WAIT_L(0); PG8_MMA(1, 0, At, B0); PG8_BAR; PG8_SCHED;
            PG8_STAGE(PG8_SB(0, 1), b2 + hstep, voffB);
            PG8_WAIT_V(6); PG8_BAR; PG8_MMA(1, 1, At, B1); PG8_BAR;
            PG8_LDBX(B0, 1, 0); PG8_SCHED; PG8_LDAX(1, 0); PG8_STAGE(PG8_SA(0, 1), a2 + hstep, voffA);
            PG8_WAIT_L(8); PG8_BAR; PG8_WAIT_L(0); PG8_MMA(0, 0, At, B0); PG8_BAR; PG8_SCHED;
            PG8_LDBX(B1, 1, 1); PG8_STAGE(PG8_SB(1, 0), b3, voffB);
            PG8_BAR; PG8_WAIT_L(0); PG8_MMA(0, 1, At, B1); PG8_BAR;
            PG8_LDAX(1, 1); PG8_STAGE(PG8_SA(1, 0), a3, voffA);
            PG8_BAR; PG8_WAIT_L(0); PG8_MMA(1, 0, At, B0); PG8_BAR; PG8_SCHED;
            PG8_STAGE(PG8_SB(1, 1), b3 + hstep, voffB);
            PG8_WAIT_V(6); PG8_BAR; PG8_MMA(1, 1, At, B1); PG8_BAR;
            }
        }
        if constexpr (ALIGN_EPI) { if (wr == 0) PG8_BAR; }
        if constexpr (ES == 1) asm volatile("s_nop 15\n\ts_nop 15" ::: "memory");
        E(acc, cur, wr, wc, fr, fq);
        if (!has_next) break;
        E.init(acc, nxt, wc, fq);
        cur = nxt; cA = nA; cB = nB; ++ui;
        if constexpr (ALIGN_EPI) { if (wr == 1) PG8_BAR; }
    }
    PG8_WAIT_V(0);
    if constexpr (!ALIGN_EPI) { if (wr == 0) PG8_BAR; }
    PG8_BAR;
#undef PG8_SA
#undef PG8_SB
#undef PG8_STAGE
#undef PG8_LDA
#undef PG8_LDA8
#undef PG8_LDB8
#undef PG8_LDAX
#undef PG8_LDBX
#undef PG8_LDB
#undef PG8_MMA
#undef PG8_WAIT_V
#undef PG8_WAIT_L
#undef PG8_BAR
#undef PG8_SCHED
}
}

#define XB_TMO      128
#define XB_XCNT(j)  (256  + 64 * (j))
#define XB_XSUB(j)  (1280 + 64 * (j))
#define XB_XGEN(j)  (2304 + 64 * (j))
#define XB_TOP      3328
#define XB_TOPGEN   3392
#define XCD_BAR_WORDS 3456
#define XB_SPIN_CAP (1u << 18)
__device__ __forceinline__ unsigned xb_ld(unsigned* p)              { return __hip_atomic_load(p, __ATOMIC_RELAXED, __HIP_MEMORY_SCOPE_AGENT); }
__device__ __forceinline__ unsigned xb_add(unsigned* p, unsigned v) { return __hip_atomic_fetch_add(p, v, __ATOMIC_RELAXED, __HIP_MEMORY_SCOPE_AGENT); }
__device__ __forceinline__ unsigned xb_xcc_id() { return (unsigned)__builtin_amdgcn_s_getreg((3 << 11) | 20) & 0xFu; }
#define XB_SPIN(cond, bar) do { unsigned _sp = 0; while (cond) { __builtin_amdgcn_s_sleep(1); \
    if ((++_sp & 255u) == 0u) { if (xb_ld(&(bar)[XB_TMO])) break; if (_sp > XB_SPIN_CAP) { atomicAdd(&(bar)[XB_TMO], 1u); break; } } } } while (0)

struct XcdBarrier {
    unsigned* bar; unsigned x;
    volatile LAS unsigned* st;
};

__device__ __forceinline__ XcdBarrier xcd_barrier_post(unsigned* bar, volatile LAS unsigned* st) {
    XcdBarrier b; b.bar = bar; b.x = xb_xcc_id(); b.st = st;
    if (threadIdx.x == 0) (void)xb_add(&bar[XB_XCNT(b.x)], 1u);
    return b;
}
__device__ __forceinline__ void xcd_barrier_complete(unsigned* bar, unsigned x, unsigned& nloc, unsigned& nx) {
    const unsigned G = gridDim.x * gridDim.y * gridDim.z;
    unsigned sum, cnt, mine, sp = 0u;
    for (;;) {
        sum = 0u; cnt = 0u; mine = 0u;
#pragma unroll
        for (unsigned j = 0; j < 16; ++j) { const unsigned c = xb_ld(&bar[XB_XCNT(j)]); sum += c; cnt += (c > 0u) ? 1u : 0u; mine = (j == x) ? c : mine; }
        if (sum == G) break;
        __builtin_amdgcn_s_sleep(1);
        if ((++sp & 255u) == 0u) { if (xb_ld(&bar[XB_TMO])) break; if (sp > XB_SPIN_CAP) { atomicAdd(&bar[XB_TMO], 1u); break; } }
    }
    nloc = mine > 0u ? mine : 1u; nx = cnt > 0u ? cnt : 1u;
}

__device__ __forceinline__ void xcd_barrier(const XcdBarrier& b) {
    asm volatile("s_waitcnt vmcnt(0)" ::: "memory");
    __syncthreads();
    if (threadIdx.x == 0) {
        unsigned* bar = b.bar;
        __builtin_amdgcn_s_waitcnt(0);
        unsigned nloc = b.st[0], nx = b.st[1];
        if (nloc == 0u) { xcd_barrier_complete(bar, b.x, nloc, nx); b.st[0] = nloc; b.st[1] = nx; }
        const unsigned old = xb_add(&bar[XB_XSUB(b.x)], 1u);
        const unsigned gen = old / nloc;
        if (old + 1u == (gen + 1u) * nloc) {
            __builtin_amdgcn_fence(__ATOMIC_RELEASE, "agent");
            asm volatile("s_waitcnt vmcnt(0)" ::: "memory");
            const unsigned og = xb_add(&bar[XB_TOP], 1u);
            const unsigned tg = og / nx;
            if (og + 1u == (tg + 1u) * nx) xb_add(&bar[XB_TOPGEN], 1u);
            else XB_SPIN(xb_ld(&bar[XB_TOPGEN]) == tg, bar);
            __builtin_amdgcn_fence(__ATOMIC_ACQUIRE, "agent");
            xb_add(&bar[XB_XGEN(b.x)], 1u);
            asm volatile("s_waitcnt vmcnt(0)" ::: "memory");
        } else {
            XB_SPIN(xb_ld(&bar[XB_XGEN(b.x)]) == gen, bar);
            __builtin_amdgcn_fence(__ATOMIC_ACQUIRE, "agent");
            asm volatile("s_waitcnt vmcnt(0)" ::: "memory");
        }
    }
    __syncthreads();
}

typedef short s4v __attribute__((ext_vector_type(4)));
__device__ __forceinline__ bf16x8 ldg8(const bf16* p) { return *(const bf16x8*)p; }
__device__ __forceinline__ f32x4 mfma16(bf16x8 a, bf16x8 b, f32x4 c) { return __builtin_amdgcn_mfma_f32_16x16x32_bf16(a, b, c, 0, 0, 0); }
__device__ __forceinline__ bf16x8 ldA(const LAS unsigned char* base, int pitch, int row0, int k0, int li, int g) { return *(const LAS bf16x8*)(base + ((row0 + li) * pitch + k0 + 8 * g) * 2); }
__device__ __forceinline__ bf16x8 ldT(const LAS unsigned char* base, int pitch, int k0, int n0, int li, int g) {
    const LAS unsigned char* p = base + ((k0 + 8 * g + (li >> 2)) * pitch + n0 + 4 * (li & 3)) * 2;
    const s4v a = __builtin_amdgcn_ds_read_tr16_b64_v4i16((LAS s4v*)p), b = __builtin_amdgcn_ds_read_tr16_b64_v4i16((LAS s4v*)(p + 8 * pitch));
    return (bf16x8){a[0], a[1], a[2], a[3], b[0], b[1], b[2], b[3]};
}
__device__ __forceinline__ bf16x8 ldAperm(const LAS unsigned char* base, int pitch, int row0, int ks, int li, int g) {
    const LAS unsigned char* p = base + ((row0 + li) * pitch + 32 * ks + 4 * g) * 2;
    const s4v a = *(const LAS s4v*)p, b = *(const LAS s4v*)(p + 32);
    return (bf16x8){a[0], a[1], a[2], a[3], b[0], b[1], b[2], b[3]};
}
__device__ __forceinline__ void stT(LAS unsigned char* base, int pitch, int n, int m0, const f32x4 v) {
    u32x2 w; w.x = pk2(v[0], v[1]); w.y = pk2(v[2], v[3]); *(LAS u32x2*)(base + (n * pitch + m0) * 2) = w;
}
__device__ __forceinline__ f32x4 ld4bf(const LAS unsigned char* p) { const u32x2 w = *(const LAS u32x2*)p; return (f32x4){bflo(w.x), bfhi(w.x), bflo(w.y), bfhi(w.y)}; }

struct Args {
    const float* in[31];
    float* out; unsigned char* ws;
    int ph_lo, ph_hi, use_bar, pad;
};
enum InIdx { I_X = 0, I_C, I_CTX, I_CCTX, I_ADAW, I_ADAB, I_N1G, I_N2G, I_WIN, I_WOUT, I_ASINK, I_BMIX, I_CREL, I_DCONV, I_DW0, I_DW2, I_DA0, I_DA2, I_DG2, I_DKK, I_DKA, I_DRK, I_DLNW, I_DLNB,
             I_RW, I_RB, I_WGU, I_BGU, I_WDN, I_BDN, I_FNG };
constexpr int NPL = 11;
constexpr int PH_TOTAL = 1 + DEPTH * NPL + 1;

struct DevIn {
    const LAS unsigned* tab;
    __device__ __forceinline__ const float* operator[](int i) const {
        const unsigned lo = __builtin_amdgcn_readfirstlane(((const volatile LAS unsigned*)tab)[2 * i]), hi = __builtin_amdgcn_readfirstlane(((const volatile LAS unsigned*)tab)[2 * i + 1]);
        return (const float*)(((unsigned long long)hi << 32) | lo);
    }
};
struct DArgs { DevIn in; float* out; };
struct Ctx {
    LAS unsigned char* lds;
    int tid, lane, wave, wg, G, gw, NGW;
    unsigned char* ws;
};

template <int NW>
__device__ __forceinline__ void transpose_item(const float* W, int K, int N, bf16* WT, int item, int lane) {
    constexpr int NQ = NW / 4, NC = 64 / NQ, PASSES = 8 / NC;
    const int nblk = N / NW, kb = item / nblk, nb = item % nblk, k0 = 64 * kb, n0 = NW * nb, nq = lane % NQ, cq = lane / NQ;
    f32x4 v[PASSES][8];
#pragma unroll
    for (int ps = 0; ps < PASSES; ++ps)
#pragma unroll
        for (int i = 0; i < 8; ++i) v[ps][i] = *(const f32x4*)(W + (size_t)(k0 + 8 * (cq + NC * ps) + i) * N + n0 + 4 * nq);
#pragma unroll
    for (int ps = 0; ps < PASSES; ++ps)
#pragma unroll
        for (int j = 0; j < 4; ++j) { u32x4 o; o.x = pk2(v[ps][0][j], v[ps][1][j]); o.y = pk2(v[ps][2][j], v[ps][3][j]); o.z = pk2(v[ps][4][j], v[ps][5][j]); o.w = pk2(v[ps][6][j], v[ps][7][j]);
            *(u32x4*)(WT + (size_t)(n0 + 4 * nq + j) * K + k0 + 8 * (cq + NC * ps)) = o; }
}
template <int NW>
__device__ __forceinline__ void transpose_item8(const float* W, int K, int N, unsigned char* WT, int item, int lane) {
    constexpr int NQ = NW / 4, NC = 64 / NQ, PASSES = 8 / NC;
    const int nblk = N / NW, kb = item / nblk, nb = item % nblk, k0 = 64 * kb, n0 = NW * nb, nq = lane % NQ, cq = lane / NQ;
    f32x4 v[PASSES][8];
#pragma unroll
    for (int ps = 0; ps < PASSES; ++ps)
#pragma unroll
        for (int i = 0; i < 8; ++i) v[ps][i] = __builtin_nontemporal_load((const f32x4*)(W + (size_t)(k0 + 8 * (cq + NC * ps) + i) * N + n0 + 4 * nq)) * pg8::W8_S;
#pragma unroll
    for (int ps = 0; ps < PASSES; ++ps)
#pragma unroll
        for (int j = 0; j < 4; ++j) { unsigned w0 = 0, w1 = 0;
            w0 = __builtin_amdgcn_cvt_pk_fp8_f32(v[ps][0][j], v[ps][1][j], w0, false); w0 = __builtin_amdgcn_cvt_pk_fp8_f32(v[ps][2][j], v[ps][3][j], w0, true);
            w1 = __builtin_amdgcn_cvt_pk_fp8_f32(v[ps][4][j], v[ps][5][j], w1, false); w1 = __builtin_amdgcn_cvt_pk_fp8_f32(v[ps][6][j], v[ps][7][j], w1, true);
            __builtin_nontemporal_store((u32x2){w0, w1}, (u32x2*)(WT + (size_t)(n0 + 4 * nq + j) * K + k0 + 8 * (cq + NC * ps))); }
}
constexpr int CV_IT_GU = 16 * 64, CV_IT_DN = 16 * 32, CV_N_GU = 32 * CV_IT_GU, CV_N_DN = 32 * CV_IT_DN, CV_ITEMS = CV_N_GU + CV_N_DN, CV_CHUNK = 16, CV_NCHUNK = CV_ITEMS / CV_CHUNK;
__device__ __forceinline__ void cv8_load(const float* W, int N, int item, int lane, f32x4 (&v)[8]) {
    const int nblk = N / 32, kb = item / nblk, nb = item % nblk, k0 = 64 * kb, n0 = 32 * nb, nq = lane & 7, cq = lane >> 3;
#pragma unroll
    for (int i = 0; i < 8; ++i) v[i] = __builtin_nontemporal_load((const f32x4*)(W + (size_t)(k0 + 8 * cq + i) * N + n0 + 4 * nq));
}
__device__ __forceinline__ void cv8_store(const f32x4 (&v)[8], int K, int N, unsigned char* WT, int item, int lane) {
    const int nblk = N / 32, kb = item / nblk, nb = item % nblk, k0 = 64 * kb, n0 = 32 * nb, nq = lane & 7, cq = lane >> 3;
#pragma unroll
    for (int j = 0; j < 4; ++j) { unsigned w0 = 0, w1 = 0;
        w0 = __builtin_amdgcn_cvt_pk_fp8_f32(v[0][j] * pg8::W8_S, v[1][j] * pg8::W8_S, w0, false); w0 = __builtin_amdgcn_cvt_pk_fp8_f32(v[2][j] * pg8::W8_S, v[3][j] * pg8::W8_S, w0, true);
        w1 = __builtin_amdgcn_cvt_pk_fp8_f32(v[4][j] * pg8::W8_S, v[5][j] * pg8::W8_S, w1, false); w1 = __builtin_amdgcn_cvt_pk_fp8_f32(v[6][j] * pg8::W8_S, v[7][j] * pg8::W8_S, w1, true);
        __builtin_nontemporal_store((u32x2){w0, w1}, (u32x2*)(WT + (size_t)(n0 + 4 * nq + j) * K + k0 + 8 * cq)); }
}
__device__ __forceinline__ void convert_moe_items(const Ctx& C, const DArgs& a, int l, int it0, int it1) {
    const bool gu = it0 < CV_N_GU; const int r0 = gu ? it0 : it0 - CV_N_GU, IT = gu ? CV_IT_GU : CV_IT_DN, e = r0 / IT, N = gu ? 2048 : DM, idx0 = r0 % IT, n = it1 - it0;
    const float* W = gu ? a.in[I_WGU] + ((size_t)l * 32 + e) * DM * 2048 : a.in[I_WDN] + ((size_t)l * 32 + e) * DM * DM;
    unsigned char* WT = gu ? C.ws + WS_WGU + ((size_t)l * 32 + e) * 2048 * DM : C.ws + WS_WDN + ((size_t)l * 32 + e) * DM * DM;
    f32x4 b0[8], b1[8], b2[8]; cv8_load(W, N, idx0, C.lane, b0); if (n > 1) cv8_load(W, N, idx0 + 1, C.lane, b1);
    int i = 0;
#pragma unroll 1
    for (; i + 3 <= n; i += 3) {
        if (i + 2 < n) cv8_load(W, N, idx0 + i + 2, C.lane, b2); cv8_store(b0, DM, N, WT, idx0 + i, C.lane);
        if (i + 3 < n) cv8_load(W, N, idx0 + i + 3, C.lane, b0); cv8_store(b1, DM, N, WT, idx0 + i + 1, C.lane);
        if (i + 4 < n) cv8_load(W, N, idx0 + i + 4, C.lane, b1); cv8_store(b2, DM, N, WT, idx0 + i + 2, C.lane); }
    if (i < n) { cv8_store(b0, DM, N, WT, idx0 + i, C.lane); if (i + 1 < n) cv8_store(b1, DM, N, WT, idx0 + i + 1, C.lane); }
}
__device__ __forceinline__ void phase_prologue(const Ctx& C, const DArgs& a) {
    constexpr int IT_IN = 16 * (INW / 32), IT_OUT = 16 * 16;
    constexpr int N_IN = 4 * IT_IN, N_OUT = 4 * IT_OUT;
    const float* pwin = a.in[I_WIN]; const float* pwout = a.in[I_WOUT];
    for (int it = C.gw; it < N_IN + N_OUT; it += C.NGW) {
        if (it < N_IN) { const int l = it / IT_IN; transpose_item<32>(pwin + (size_t)l * DM * INW, DM, INW, (bf16*)(C.ws + WS_WIN) + (size_t)l * INWP * DM, it % IT_IN, C.lane); }
        else { const int r = it - N_IN, l = r / IT_OUT; transpose_item<64>(pwout + (size_t)l * DM * DM, DM, DM, (bf16*)(C.ws + WS_WOUT) + (size_t)l * DM * DM, r % IT_OUT, C.lane); }
    }
    { const int gt = C.wg * NTHR + C.tid; constexpr int PADN = (INWP - INW) * DM / 8;
      for (int i = gt; i < 4 * PADN; i += C.G * NTHR) { const int l = i / PADN, r = i % PADN; *((u32x4*)((bf16*)(C.ws + WS_WIN) + ((size_t)l * INWP + INW) * DM) + r) = (u32x4){0u, 0u, 0u, 0u}; } }
    { float* tw = (float*)(C.ws + WS_TW); const int gt = C.wg * NTHR + C.tid;
      for (int i = gt; i < 16384; i += C.G * NTHR) { const float x = (float)i * (1.0f / 8192.0f); tw[i] = cospif(x); tw[16384 + i] = sinpif(x); } }
    { float* mt = (float*)(C.ws + WS_MTAB); const int gt = C.wg * NTHR + C.tid; const float* pbmix = a.in[I_BMIX];
      for (int i = gt; i < 4 * 4 * 64 * 64; i += C.G * NTHR) { const int e = i & 63, c = (i >> 6) & 63, g = (i >> 12) & 3, l = i >> 14;
          const float* w = pbmix + ((size_t)(l * 4 + g) * 64) * 64 + e; float sc = 0.f, ss = 0.f;
          for (int cp = 0; cp < 64; ++cp) { const float x = (float)((c * cp) & 63) * (1.0f / 32.0f); const float wv = w[cp * 64]; sc += cospif(x) * wv; ss += sinpif(x) * wv; }
          mt[((size_t)(l * 2 + 0) * 4 + g) * 4096 + c * 64 + e] = sc; mt[((size_t)(l * 2 + 1) * 4 + g) * 4096 + c * 64 + e] = ss; } }
    { bf16* ft = (bf16*)(C.ws + WS_FTAB); const int gt = C.wg * NTHR + C.tid; const float* pbmix = a.in[I_BMIX];
      for (int i = gt; i < 128 * 128; i += C.G * NTHR) { const int k = i >> 7, t = i & 127; const float x = (float)((k * t) & 127) * (1.0f / 64.0f); ft[i] = (bf16)f2bf(cospif(x)); ft[16384 + i] = (bf16)f2bf(sinpif(x)); }
      bf16* mf = ft + 32768;
      for (int i = gt; i < 4 * 4 * 16 * 64 * 8; i += C.G * NTHR) { const int j8 = i & 7, ln = (i >> 3) & 63, fr = (i >> 9) & 15, gq = (i >> 13) & 3, l = i >> 15;
          const int ei = fr >> 2, ks2 = fr & 3, e = 16 * ei + (ln & 15), g = ln >> 4, c = 32 * (ks2 & 1) + 16 * (j8 >> 2) + 4 * g + (j8 & 3), part = ks2 >> 1;
          const float* w = pbmix + ((size_t)(l * 4 + gq) * 64) * 64 + e; float s = 0.f;
          for (int cp = 0; cp < 64; ++cp) { const float x = (float)((c * cp) & 63) * (1.0f / 32.0f); s += (part ? sinpif(x) : cospif(x)) * w[cp * 64]; }
          mf[i] = (bf16)f2bf(s * (1.0f / 1024.0f)); } }
    { const int gt = C.wg * NTHR + C.tid; const float* pg2 = a.in[I_DG2]; const float* prw = a.in[I_RW]; bf16* g2t = (bf16*)(C.ws + WS_G2T); bf16* rwt = (bf16*)(C.ws + WS_RWT);
      for (int i = gt; i < 4 * 256 * 160; i += C.G * NTHR) { const int ii = i % 160, c = (i / 160) & 255, l = i / (160 * 256); g2t[i] = (bf16)f2bf(pg2[((size_t)l * 160 + ii) * 256 + c]); }
      for (int i = gt; i < 4 * 32 * 1024; i += C.G * NTHR) { const int k = i & 1023, e = (i >> 10) & 31, l = i >> 15; rwt[i] = (bf16)f2bf(prw[((size_t)l * 1024 + k) * 32 + e]); } }
    { const int gt = C.wg * NTHR + C.tid; const float* pw2 = a.in[I_DW2]; const float* pa2 = a.in[I_DA2]; bf16* lt = (bf16*)(C.ws + WS_LORAT);
      for (int i = gt; i < 4 * 4 * 256 * 64; i += C.G * NTHR) { const int ii = i & 63, c = (i >> 6) & 255, q = (i >> 14) & 3, l = i >> 16;
          const float* src = (q < 2) ? pw2 : pa2; lt[i] = (bf16)f2bf(src[(((size_t)l * 2 + (q & 1)) * 64 + ii) * 256 + c]); } }
    { bf16* f2 = (bf16*)(C.ws + WS_F256); const int gt = C.wg * NTHR + C.tid;
      for (int i = gt; i < 256 * 256; i += C.G * NTHR) { const int k = i >> 8, t = i & 255; const float x = (float)((k * t) & 255) * (1.0f / 128.0f); f2[i] = (bf16)f2bf(cospif(x)); f2[65536 + i] = (bf16)f2bf(sinpif(x)); } }
    { LAS float* sl = (LAS float*)(C.lds);
      LAS float* red = (LAS float*)(C.lds + 8192);
      __syncthreads();
      const float* pc = a.in[I_C]; const float* pcc = a.in[I_CCTX]; const float* padaw = a.in[I_ADAW]; const float* padab = a.in[I_ADAB];
      for (int i = C.tid; i < 2048; i += NTHR) { const float x = (i < 1024) ? pc[i] : pcc[i - 1024]; sl[i] = x * sigmoidf_(x); }
      __syncthreads();
      float* mod = (float*)(C.ws + WS_MOD);
      for (int u = C.wg; u < 4 * 96; u += C.G) { const int l = u / 96, jb = u % 96, j0 = jb * 64 + C.lane;
          float s0 = 0.f, s1 = 0.f; const float* w = padaw + (size_t)l * DM * 6144 + j0; const int k0 = C.wave * 128;
#pragma unroll 16
          for (int k = 0; k < 128; ++k) { const float wv = w[(size_t)(k0 + k) * 6144]; s0 += wv * sl[k0 + k]; s1 += wv * sl[1024 + k0 + k]; }
          red[(C.wave * 2 + 0) * 64 + C.lane] = s0; red[(C.wave * 2 + 1) * 64 + C.lane] = s1;
          __syncthreads();
          if (C.tid < 128) { const int v = C.tid >> 6, j = C.tid & 63; float s = 0.f;
#pragma unroll
              for (int wv = 0; wv < 8; ++wv) s += red[(wv * 2 + v) * 64 + j];
              mod[(size_t)(l * 2 + v) * 6144 + jb * 64 + j] = s + padab[(size_t)l * 6144 + jb * 64 + j]; }
          __syncthreads(); } }
}

__device__ __forceinline__ void load_row(const float* p, int lane, f32x4 (&v)[4]) {
#pragma unroll
    for (int j = 0; j < 4; ++j) v[j] = *((const f32x4*)p + lane + 64 * j);
}
__device__ __forceinline__ void load_row_bf(const bf16* p, int lane, f32x4 (&v)[4]) {
#pragma unroll
    for (int j = 0; j < 4; ++j) { const u32x2 w = *((const u32x2*)p + lane + 64 * j); v[j] = (f32x4){bflo(w.x), bfhi(w.x), bflo(w.y), bfhi(w.y)}; }
}
struct RouteIdx { u32x4 d; f32x4 g; };
__device__ __forceinline__ RouteIdx route_fetch(const Ctx& C, int row) {
    RouteIdx r; r.d = *((const u32x4*)(C.ws + WS_ROUTE + (size_t)3 * ROWS * 16) + row); r.g = *((const f32x4*)(C.ws + WS_ROUTE + (size_t)1 * ROWS * 16) + row); return r; }
__device__ __forceinline__ void moe_combine_row(const Ctx& C, const RouteIdx& ri, f32x4 (&v)[4], const f32x4 (&gt2q)[4]) {
    const bf16* YB = (const bf16*)(C.ws + WS_XG);
    f32x4 s[4];
#pragma unroll
    for (int j = 0; j < 4; ++j) s[j] = (f32x4){0.f, 0.f, 0.f, 0.f};
#pragma unroll
    for (int k = 0; k < 4; ++k) { const int d = (int)ri.d[k]; const float g = ri.g[k]; const u32x2* yp = (const u32x2*)(YB + (size_t)d * DM) + C.lane;
#pragma unroll
        for (int j = 0; j < 4; ++j) { const u32x2 w = yp[64 * j]; s[j] += (f32x4){bflo(w.x), bfhi(w.x), bflo(w.y), bfhi(w.y)} * g; } }
#pragma unroll
    for (int j = 0; j < 4; ++j) v[j] += gt2q[j] * s[j];
}
__device__ __forceinline__ float row_rstd(const f32x4 (&v)[4], int lane) {
    float s = 0.f;
#pragma unroll
    for (int j = 0; j < 4; ++j) s += (v[j].x * v[j].x + v[j].y * v[j].y) + (v[j].z * v[j].z + v[j].w * v[j].w);
    return rsqrtf(wave_sum(s, lane) * (1.f / DM) + 1e-6f);
}
__device__ __forceinline__ void norm1_fetch(const Ctx& C, const float* src_f32, const bf16* src_bf, const RouteIdx& ri, bool combine, const f32x4 (&gt2q)[4], f32x4 (&v)[4]) {
    if (src_f32) load_row(src_f32, C.lane, v); else load_row_bf(src_bf, C.lane, v);
    if (combine) moe_combine_row(C, ri, v, gt2q);
}
struct RowPf { u32x2 xs[4]; u32x2 yb[4][4]; f32x4 g; };
__device__ __forceinline__ void rowpf_issue(const Ctx& C, const bf16* XS, int row, const RouteIdx& ri, RowPf& p) {
    const bf16* YB = (const bf16*)(C.ws + WS_XG);
#pragma unroll
    for (int j = 0; j < 4; ++j) p.xs[j] = *((const u32x2*)(XS + (size_t)row * DM) + C.lane + 64 * j);
#pragma unroll
    for (int k = 0; k < 4; ++k) { const u32x2* yp = (const u32x2*)(YB + (size_t)ri.d[k] * DM) + C.lane;
#pragma unroll
        for (int j = 0; j < 4; ++j) p.yb[k][j] = yp[64 * j]; }
    p.g = ri.g;
}
__device__ __forceinline__ void rowpf_combine(const RowPf& p, const f32x4 (&gt2q)[4], f32x4 (&v)[4]) {
#pragma unroll
    for (int j = 0; j < 4; ++j) { f32x4 s = {0.f, 0.f, 0.f, 0.f};
#pragma unroll
        for (int k = 0; k < 4; ++k) { const u32x2 w = p.yb[k][j]; s += (f32x4){bflo(w.x), bfhi(w.x), bflo(w.y), bfhi(w.y)} * p.g[k]; }
        const u32x2 x = p.xs[j]; v[j] = (f32x4){bflo(x.x), bfhi(x.x), bflo(x.y), bfhi(x.y)} + gt2q[j] * s; }
}
__device__ __forceinline__ void phase_norm1(const Ctx& C, const DArgs& a, int l) {
    bf16* XS = (bf16*)(C.ws + WS_XS); bf16* H = (bf16*)(C.ws + WS_H); const float* mod = (const float*)(C.ws + WS_MOD);
    const float* g1 = a.in[I_N1G] + (size_t)l * DM;
    const float* pctx = a.in[I_CTX]; const float* px = a.in[I_X];
    f32x4 gq[4], shq[4], scq[4], gt2q[4];
#pragma unroll
    for (int j = 0; j < 4; ++j) gt2q[j] = *((const f32x4*)(mod + (size_t)((l > 0 ? l - 1 : 0) * 2) * 6144 + 5 * DM) + C.lane + 64 * j);
#pragma unroll
    for (int j = 0; j < 4; ++j) { gq[j] = *((const f32x4*)g1 + C.lane + 64 * j); shq[j] = *((const f32x4*)(mod + (size_t)(l * 2) * 6144) + C.lane + 64 * j); scq[j] = *((const f32x4*)(mod + (size_t)(l * 2) * 6144 + DM) + C.lane + 64 * j) + 1.0f; }
    if (l > 0) {
        RowPf pf; RouteIdx rin;
        { const int row = C.gw; if (row < ROWS) { const RouteIdx r0 = route_fetch(C, row); if (row + C.NGW < ROWS) rin = route_fetch(C, row + C.NGW); rowpf_issue(C, XS, row, r0, pf); } }
#pragma unroll 1
        for (int row = C.gw; row < ROWS; row += C.NGW) { const bool isctx = row < NCTX;
            const RowPf cur = pf;
            if (row + C.NGW < ROWS) { rowpf_issue(C, XS, row + C.NGW, rin, pf); if (row + 2 * C.NGW < ROWS) rin = route_fetch(C, row + 2 * C.NGW); }
            f32x4 v[4];
            if (isctx) { f32x4 gc4[4];
#pragma unroll
                for (int j = 0; j < 4; ++j) gc4[j] = *((const f32x4*)(mod + (size_t)((l - 1) * 2 + 1) * 6144 + 5 * DM) + C.lane + 64 * j);
                rowpf_combine(cur, gc4, v); }
            else rowpf_combine(cur, gt2q, v);
#pragma unroll
            for (int j = 0; j < 4; ++j) { u32x2 w; w.x = pk2(v[j].x, v[j].y); w.y = pk2(v[j].z, v[j].w); *((u32x2*)(XS + (size_t)row * DM) + C.lane + 64 * j) = w; }
            const float rstd = row_rstd(v, C.lane);
            const float* md = mod + (size_t)(l * 2 + (isctx ? 1 : 0)) * 6144;
            u32x2* o = (u32x2*)(H + (size_t)row * DM) + C.lane;
#pragma unroll
            for (int j = 0; j < 4; ++j) { f32x4 sh = shq[j], sc1 = scq[j]; if (isctx) { sh = *((const f32x4*)md + C.lane + 64 * j); sc1 = *((const f32x4*)(md + DM) + C.lane + 64 * j) + 1.0f; }
                const f32x4 y = v[j] * rstd * gq[j] * sc1 + sh; u32x2 w; w.x = pk2(y.x, y.y); w.y = pk2(y.z, y.w); o[64 * j] = w; } }
        return;
    }
    RouteIdx rn[2];
    for (int row0 = C.gw; row0 < ROWS; row0 += 2 * C.NGW) {
        f32x4 v[2][4]; const int rows[2] = {row0, row0 + C.NGW};
        const RouteIdx rc[2] = {rn[0], rn[1]};
        if (l > 0) {
#pragma unroll
            for (int q = 0; q < 2; ++q) if (rows[q] + 2 * C.NGW < ROWS) rn[q] = route_fetch(C, rows[q] + 2 * C.NGW); }
#pragma unroll
        for (int q = 0; q < 2; ++q) if (rows[q] < ROWS) { const int row = rows[q]; const bool isctx = row < NCTX;
            const float* src = (l == 0) ? (isctx ? pctx + (size_t)row * DM : px + (size_t)(row - NCTX) * DM) : nullptr; const bf16* srcb = XS + (size_t)row * DM;
            if (isctx && l > 0) { f32x4 gc4[4];
#pragma unroll
                for (int j = 0; j < 4; ++j) gc4[j] = *((const f32x4*)(mod + (size_t)((l - 1) * 2 + 1) * 6144 + 5 * DM) + C.lane + 64 * j);
                norm1_fetch(C, src, srcb, rc[q], true, gc4, v[q]); }
            else norm1_fetch(C, src, srcb, rc[q], l > 0, gt2q, v[q]); }
#pragma unroll
        for (int q = 0; q < 2; ++q) if (rows[q] < ROWS) { const int row = rows[q]; const bool isctx = row < NCTX;
#pragma unroll
            for (int j = 0; j < 4; ++j) { u32x2 w; w.x = pk2(v[q][j].x, v[q][j].y); w.y = pk2(v[q][j].z, v[q][j].w); *((u32x2*)(XS + (size_t)row * DM) + C.lane + 64 * j) = w; }
            const float rstd = row_rstd(v[q], C.lane);
            const float* md = mod + (size_t)(l * 2 + (isctx ? 1 : 0)) * 6144;
            u32x2* o = (u32x2*)(H + (size_t)row * DM) + C.lane;
#pragma unroll
            for (int j = 0; j < 4; ++j) { f32x4 sh = shq[j], sc1 = scq[j]; if (isctx) { sh = *((const f32x4*)md + C.lane + 64 * j); sc1 = *((const f32x4*)(md + DM) + C.lane + 64 * j) + 1.0f; }
                const f32x4 y = v[q][j] * rstd * gq[j] * sc1 + sh; u32x2 w; w.x = pk2(y.x, y.y); w.y = pk2(y.z, y.w); o[64 * j] = w; } }
    }
}
__device__ __forceinline__ void phase_final(const Ctx& C, const DArgs& a) {
    const bf16* XS = (const bf16*)(C.ws + WS_XS); const float* mod = (const float*)(C.ws + WS_MOD); const float* g = a.in[I_FNG];
    const float* gt2 = mod + (size_t)((DEPTH - 1) * 2 + 0) * 6144 + 5 * DM;
    f32x4 gq[4], gt2q[4];
#pragma unroll
    for (int j = 0; j < 4; ++j) { gq[j] = *((const f32x4*)g + C.lane + 64 * j); gt2q[j] = *((const f32x4*)gt2 + C.lane + 64 * j); }
    RowPf pf; RouteIdx rin;
    { const int row = NCTX + C.gw; if (row < ROWS) { const RouteIdx r0 = route_fetch(C, row); if (row + C.NGW < ROWS) rin = route_fetch(C, row + C.NGW); rowpf_issue(C, XS, row, r0, pf); } }
#pragma unroll 1
    for (int row = NCTX + C.gw; row < ROWS; row += C.NGW) {
        const RowPf cur = pf;
        if (row + C.NGW < ROWS) { rowpf_issue(C, XS, row + C.NGW, rin, pf); if (row + 2 * C.NGW < ROWS) rin = route_fetch(C, row + 2 * C.NGW); }
        f32x4 v[4]; rowpf_combine(cur, gt2q, v);
        const float rstd = row_rstd(v, C.lane); float* o = a.out + (size_t)(row - NCTX) * DM;
#pragma unroll
        for (int j = 0; j < 4; ++j) *((f32x4*)o + C.lane + 64 * j) = v[j] * rstd * gq[j];
    }
}
constexpr int NR2 = 9;
__device__ __forceinline__ void phase_norm2(const Ctx& C, const DArgs& a, int l) {
    const bf16* XS = (const bf16*)(C.ws + WS_XS); bf16* H = (bf16*)(C.ws + WS_H); const float* mod = (const float*)(C.ws + WS_MOD);
    const float* g2 = a.in[I_N2G] + (size_t)l * DM; const float* rb = a.in[I_RB] + (size_t)l * NEXP; const bf16* rwt = (const bf16*)(C.ws + WS_RWT) + (size_t)l * NEXP * DM;
    int* tok_e = (int*)(C.ws + WS_ROUTE); float* gate = (float*)(C.ws + WS_ROUTE) + (size_t)1 * ROWS * 4; int* slot = (int*)(C.ws + WS_ROUTE) + (size_t)2 * ROWS * 4;
    LAS float* lg = (LAS float*)(C.lds + C.wave * 4096);
    LAS int* hist = (LAS int*)(C.lds + MISC_OFF + 64);
    const int lane = C.lane, li = lane & 15, g = lane >> 4;
    if (C.tid < NEXP) hist[C.tid] = 0;
    constexpr int RWP = 1032;
    LAS unsigned char* rwl = C.lds + 32768;
    for (int i = C.tid; i < NEXP * 128; i += NTHR) { const int e2 = i >> 7, c8 = i & 127; *(LAS u32x4*)(rwl + (e2 * RWP + 8 * c8) * 2) = *(const u32x4*)(rwt + (size_t)e2 * DM + 8 * c8); }
    __syncthreads();
    const int row_base = (l == DEPTH - 1) ? NCTX : 0, ntile = (ROWS - row_base + NR2 - 1) / NR2;
    f32x4 gq[4], shq[4], scq[4];
#pragma unroll
    for (int j = 0; j < 4; ++j) { gq[j] = *((const f32x4*)g2 + lane + 64 * j); shq[j] = *((const f32x4*)(mod + (size_t)(l * 2) * 6144 + 3 * DM) + lane + 64 * j); scq[j] = *((const f32x4*)(mod + (size_t)(l * 2) * 6144 + 4 * DM) + lane + 64 * j) + 1.0f; }
    for (int tl = C.gw; tl < ntile; tl += C.NGW) {
        const int trow0 = row_base + NR2 * tl, nrow = (ROWS - trow0 < NR2) ? ROWS - trow0 : NR2;
        u32x2 nxw[4];
#pragma unroll 1
        for (int rr = 0; rr < nrow; ++rr) { const int row = trow0 + rr; const bool isctx = row < NCTX; f32x4 v[4];
            if (rr == 0) {
#pragma unroll
                for (int j = 0; j < 4; ++j) nxw[j] = *((const u32x2*)(XS + (size_t)row * DM) + lane + 64 * j); }
#pragma unroll
            for (int j = 0; j < 4; ++j) v[j] = (f32x4){bflo(nxw[j].x), bfhi(nxw[j].x), bflo(nxw[j].y), bfhi(nxw[j].y)};
            if (rr + 1 < nrow) {
#pragma unroll
                for (int j = 0; j < 4; ++j) nxw[j] = *((const u32x2*)(XS + (size_t)(row + 1) * DM) + lane + 64 * j); }
            const float rstd = row_rstd(v, lane);
            const float* md = mod + (size_t)(l * 2 + (isctx ? 1 : 0)) * 6144 + 3 * DM;
            u32x2* o = (u32x2*)(H + (size_t)row * DM) + lane;
#pragma unroll
            for (int j = 0; j < 4; ++j) { f32x4 sh = shq[j], sc1 = scq[j]; if (isctx) { sh = *((const f32x4*)md + lane + 64 * j); sc1 = *((const f32x4*)(md + DM) + lane + 64 * j) + 1.0f; }
                const f32x4 y = v[j] * rstd * gq[j] * sc1 + sh; u32x2 w; w.x = pk2(y.x, y.y); w.y = pk2(y.z, y.w); o[64 * j] = w; } }
        asm volatile("s_waitcnt vmcnt(0)" ::: "memory");
        f32x4 acc0 = {0.f, 0.f, 0.f, 0.f}, acc1 = {0.f, 0.f, 0.f, 0.f};
        const int arow = (trow0 + li < ROWS) ? trow0 + li : ROWS - 1;
        const bf16* ap = H + (size_t)arow * DM + 8 * g;
#pragma unroll 16
        for (int ks = 0; ks < 32; ++ks) { const bf16x8 af = *(const bf16x8*)(ap + 32 * ks); acc0 = mfma16(af, ldA(rwl, RWP, 0, 32 * ks, li, g), acc0); acc1 = mfma16(af, ldA(rwl, RWP, 16, 32 * ks, li, g), acc1); }
#pragma unroll
        for (int r = 0; r < 4; ++r) { lg[(4 * g + r) * 33 + li] = acc0[r]; lg[(4 * g + r) * 33 + 16 + li] = acc1[r]; }
        LDS_WAIT(); asm volatile("" ::: "memory");
        const int e = lane & 31; const float rbe = rb[e];
        float val[NR2]; int te[NR2][4]; float tv[NR2][4];
#pragma unroll
        for (int rr = 0; rr < NR2; ++rr) val[rr] = lg[rr * 33 + e] + rbe;
#pragma unroll
        for (int k = 0; k < 4; ++k) {
            float bv[NR2]; int bi[NR2];
#pragma unroll
            for (int rr = 0; rr < NR2; ++rr) { bv[rr] = val[rr]; bi[rr] = e; }
#define AMAX_ROR(n) _Pragma("unroll") for (int rr = 0; rr < NR2; ++rr) { const float ov = __builtin_bit_cast(float, __builtin_amdgcn_update_dpp(0, __builtin_bit_cast(int, bv[rr]), 0x120 + (n), 0xf, 0xf, false)); const int oi = __builtin_amdgcn_update_dpp(0, bi[rr], 0x120 + (n), 0xf, 0xf, false); \
                if (ov > bv[rr] || (ov == bv[rr] && oi < bi[rr])) { bv[rr] = ov; bi[rr] = oi; } }
            AMAX_ROR(8) AMAX_ROR(4) AMAX_ROR(2) AMAX_ROR(1)
#undef AMAX_ROR
#pragma unroll
            for (int rr = 0; rr < NR2; ++rr) { const float ov = shx(bv[rr], 16, lane); const int oi = shxi(bi[rr], 16, lane); if (ov > bv[rr] || (ov == bv[rr] && oi < bi[rr])) { bv[rr] = ov; bi[rr] = oi; }
                te[rr][k] = bi[rr]; tv[rr][k] = bv[rr]; if (e == bi[rr]) val[rr] = -3.0e38f; } }
        if (lane == 0) {
#pragma unroll
            for (int rr = 0; rr < NR2; ++rr) if (rr < nrow) { const int row = trow0 + rr; const float m = tv[rr][0]; float p[4], ps = 0.f;
#pragma unroll
                for (int k = 0; k < 4; ++k) { p[k] = __expf(tv[rr][k] - m); ps += p[k]; }
#pragma unroll
                for (int k = 0; k < 4; ++k) { tok_e[row * 4 + k] = te[rr][k]; gate[row * 4 + k] = p[k] / ps; slot[row * 4 + k] = __hip_atomic_fetch_add(&hist[te[rr][k]], 1, __ATOMIC_RELAXED, __HIP_MEMORY_SCOPE_WORKGROUP); } } }
        asm volatile("" ::: "memory");
    }
    __syncthreads();
    if (C.tid < NEXP) ((int*)(C.ws + WS_CNT))[C.wg * NEXP + C.tid] = hist[C.tid];
}
__device__ __forceinline__ int moe_tables(const Ctx& C) {
    const int* cnt = (const int*)(C.ws + WS_CNT);
    LAS int* part = (LAS int*)(C.lds);
    LAS int* pstart = (LAS int*)(C.lds + MISC_OFF + 256); LAS int* wgbase = pstart + 40; LAS int* tot = wgbase + 32; LAS int* nblk_s = tot + 32;
    LAS unsigned char* blk_e = (LAS unsigned char*)(C.lds + MISC_OFF + 1024);
    __syncthreads();
    { const int e = C.tid & 31, p = C.tid >> 5; int t = 0, pre = 0;
#pragma unroll 1
      for (int w = p * 16; w < p * 16 + 16; ++w) { const int c = cnt[w * NEXP + e]; t += c; if (w < C.wg) pre += c; }
      part[(p * 32 + e) * 2] = t; part[(p * 32 + e) * 2 + 1] = pre; }
    __syncthreads();
    if (C.tid < NEXP) { int t = 0, pre = 0;
#pragma unroll 1
        for (int p = 0; p < 16; ++p) { t += part[(p * 32 + C.tid) * 2]; pre += part[(p * 32 + C.tid) * 2 + 1]; }
        tot[C.tid] = t; wgbase[C.tid] = pre; }
    __syncthreads();
    if (C.tid == 0) { int b = 0;
#pragma unroll 1
        for (int e = 0; e < NEXP; ++e) { pstart[e] = b * 256; b += (tot[e] + 255) >> 8; }
        pstart[NEXP] = b * 256; nblk_s[0] = b; }
    __syncthreads();
    if (C.tid < NEXP) wgbase[C.tid] += pstart[C.tid];
    if (C.tid < MOE_MAXBLK) { int e = 0;
#pragma unroll 1
        for (int k = 1; k < NEXP; ++k) if (pstart[k] <= C.tid * 256) e = k;
        blk_e[C.tid] = (unsigned char)e; }
    __syncthreads();
    return __builtin_amdgcn_readfirstlane(nblk_s[0]);
}
__device__ __forceinline__ int moe_tables_load(const Ctx& C) {
    const unsigned* src = (const unsigned*)(C.ws + WS_CNT + 65536);
    LAS unsigned* dst = (LAS unsigned*)(C.lds + MISC_OFF + 1024);
    __syncthreads();
    if (C.tid < MOE_MAXBLK / 4) dst[C.tid] = src[C.tid];
    const int nblk = __builtin_amdgcn_readfirstlane((int)src[MOE_MAXBLK / 4]);
    __syncthreads();
    return nblk;
}
__device__ __forceinline__ void phase_gather(const Ctx& C, const DArgs& a, int l) {
    const int nblk_all = moe_tables(C);
    if (C.wg == 0) { unsigned* dstg = (unsigned*)(C.ws + WS_CNT + 65536); const LAS unsigned* srcl = (const LAS unsigned*)(C.lds + MISC_OFF + 1024);
        if (C.tid < MOE_MAXBLK / 4) dstg[C.tid] = srcl[C.tid]; if (C.tid == 0) dstg[MOE_MAXBLK / 4] = (unsigned)nblk_all; }
    const LAS int* wgbase = (const LAS int*)(C.lds + MISC_OFF + 256) + 40;
    const int* tok_e = (const int*)(C.ws + WS_ROUTE); const int* slot = (const int*)(C.ws + WS_ROUTE) + (size_t)2 * ROWS * 4; int* dest = (int*)(C.ws + WS_ROUTE) + (size_t)3 * ROWS * 4;
    const bf16* H = (const bf16*)(C.ws + WS_H); unsigned char* XG = C.ws + WS_XG8;
    const int row_base = (l == DEPTH - 1) ? NCTX : 0, ntile = (ROWS - row_base + NR2 - 1) / NR2;
    for (int tl = C.gw; tl < ntile; tl += C.NGW) {
    const int rbeg = row_base + NR2 * tl, rend = (rbeg + NR2 < ROWS) ? rbeg + NR2 : ROWS;
    u32x4 nv0, nv1, nte, nsl;
    { const u32x4* src = (const u32x4*)(H + (size_t)rbeg * DM) + C.lane; nv0 = src[0]; nv1 = src[64]; nte = *((const u32x4*)tok_e + rbeg); nsl = *((const u32x4*)slot + rbeg); }
#pragma unroll 1
    for (int row = rbeg; row < rend; ++row) {
        const u32x4 v0 = nv0, v1 = nv1, te = nte, sl = nsl;
        if (row + 1 < rend) { const u32x4* src = (const u32x4*)(H + (size_t)(row + 1) * DM) + C.lane; nv0 = src[0]; nv1 = src[64]; nte = *((const u32x4*)tok_e + row + 1); nsl = *((const u32x4*)slot + row + 1); }
        u32x2 q0, q1;
        { unsigned w = 0; w = __builtin_amdgcn_cvt_pk_fp8_f32(bflo(v0.x) * pg8::X8_S, bfhi(v0.x) * pg8::X8_S, w, false); w = __builtin_amdgcn_cvt_pk_fp8_f32(bflo(v0.y) * pg8::X8_S, bfhi(v0.y) * pg8::X8_S, w, true); q0.x = w;
          w = 0; w = __builtin_amdgcn_cvt_pk_fp8_f32(bflo(v0.z) * pg8::X8_S, bfhi(v0.z) * pg8::X8_S, w, false); w = __builtin_amdgcn_cvt_pk_fp8_f32(bflo(v0.w) * pg8::X8_S, bfhi(v0.w) * pg8::X8_S, w, true); q0.y = w;
          w = 0; w = __builtin_amdgcn_cvt_pk_fp8_f32(bflo(v1.x) * pg8::X8_S, bfhi(v1.x) * pg8::X8_S, w, false); w = __builtin_amdgcn_cvt_pk_fp8_f32(bflo(v1.y) * pg8::X8_S, bfhi(v1.y) * pg8::X8_S, w, true); q1.x = w;
          w = 0; w = __builtin_amdgcn_cvt_pk_fp8_f32(bflo(v1.z) * pg8::X8_S, bfhi(v1.z) * pg8::X8_S, w, false); w = __builtin_amdgcn_cvt_pk_fp8_f32(bflo(v1.w) * pg8::X8_S, bfhi(v1.w) * pg8::X8_S, w, true); q1.y = w; }
        u32x4 dd;
#pragma unroll
        for (int k = 0; k < 4; ++k) { const int d = wgbase[te[k]] + (int)sl[k]; dd[k] = (unsigned)d;
            u32x2* dp = (u32x2*)(XG + (size_t)d * DM) + C.lane; dp[0] = q0; dp[64] = q1; }
        if (C.lane == 0) *((u32x4*)dest + row) = dd;
    } }
}

__device__ __forceinline__ void mix1_rope(const Ctx& C) {
    bf16* P = (bf16*)(C.ws + WS_P);
    const long total = (long)SEQ * 96, stride = (long)C.G * NTHR;
    for (long i0 = (long)C.wg * NTHR + C.tid; i0 < total; i0 += 4 * stride) {
        unsigned w1[4], w2[4];
#pragma unroll
        for (int q = 0; q < 4; ++q) { const long i = i0 + q * stride; if (i < total) { const int jp = (int)(i & 15), hh = (int)((i >> 4) % 6), t = (int)(i / 96);
            const int col = (hh < 4) ? (C_AQ + hh * 64) : (C_AK + (hh - 4) * 64);
            const unsigned* p = (const unsigned*)(P + (size_t)(NCTX + t) * INWP + col) + jp; w1[q] = p[0]; w2[q] = p[16]; } }
#pragma unroll
        for (int q = 0; q < 4; ++q) { const long i = i0 + q * stride; if (i < total) { const int jp = (int)(i & 15), hh = (int)((i >> 4) % 6), t = (int)(i / 96), j0 = 2 * jp;
            const int col = (hh < 4) ? (C_AQ + hh * 64) : (C_AK + (hh - 4) * 64);
            const float pos = (j0 < 16) ? (float)(t >> 6) : (float)(t & 63);
            float cs[2], sn[2];
#pragma unroll
            for (int e = 0; e < 2; ++e) { const float inv = __powf(10000.0f, -(float)((j0 + e) & 15) * (1.0f / 16.0f)); const float ang = pos * inv * 0.31830988618379067f;
                cs[e] = cospif(ang); sn[e] = sinpif(ang); }
            unsigned* p = (unsigned*)(P + (size_t)(NCTX + t) * INWP + col) + jp;
            const float x1a = bflo(w1[q]), x1b = bfhi(w1[q]), x2a = bflo(w2[q]), x2b = bfhi(w2[q]);
            p[0] = pk2(x1a * cs[0] - x2a * sn[0], x1b * cs[1] - x2b * sn[1]); p[16] = pk2(x2a * cs[0] + x1a * sn[0], x2b * cs[1] + x1b * sn[1]); } }
    }
}
__device__ __forceinline__ void mix1_vt(const Ctx& C) {
    const bf16* P = (const bf16*)(C.ws + WS_P);
    LAS unsigned short* scr = (LAS unsigned short*)(C.lds + C.wave * 16384);
    for (int u = C.gw; u < (ROWS / 64) * 6; u += C.NGW) {
        const int hd = u % 6, tb = u / 6; const int vcol = (hd < 2) ? (C_AV + hd * 64) : (C_CV + (hd - 2) * 64);
        bf16* VT = ((hd < 2) ? (bf16*)(C.ws + WS_VTA) + (size_t)hd * 64 * VTP : (bf16*)(C.ws + WS_VTC) + (size_t)(hd - 2) * 64 * VTP);
#pragma unroll
        for (int i = 0; i < 8; ++i) { const int tk = (C.lane >> 3) + 8 * i, ch = C.lane & 7; const u32x4 w = *(const u32x4*)(P + (size_t)(tb * 64 + tk) * INWP + vcol + 8 * ch);
            LAS unsigned* d = (LAS unsigned*)(scr + tk * 66 + 8 * ch); d[0] = w.x; d[1] = w.y; d[2] = w.z; d[3] = w.w; }
        LDS_WAIT(); asm volatile("" ::: "memory");
#pragma unroll
        for (int k8 = 0; k8 < 8; ++k8) { unsigned w[4];
#pragma unroll
            for (int e2 = 0; e2 < 4; ++e2) { const unsigned lo = scr[(8 * k8 + 2 * e2) * 66 + C.lane], hi = scr[(8 * k8 + 2 * e2 + 1) * 66 + C.lane]; w[e2] = lo | (hi << 16); }
            *(u32x4*)(VT + (size_t)C.lane * VTP + tb * 64 + 8 * k8) = (u32x4){w[0], w[1], w[2], w[3]}; }
        LDS_WAIT(); asm volatile("" ::: "memory");
    }
    for (int i = C.wg * NTHR + C.tid; i < 6 * 64 * 32; i += C.G * NTHR) { const int rowi = i >> 5, pc = i & 31; const int hd = rowi >> 6, d = rowi & 63;
        bf16* VT = ((hd < 2) ? (bf16*)(C.ws + WS_VTA) + (size_t)hd * 64 * VTP : (bf16*)(C.ws + WS_VTC) + (size_t)(hd - 2) * 64 * VTP);
        *(u32x4*)(VT + (size_t)d * VTP + ROWS + 8 * pc) = (u32x4){0u, 0u, 0u, 0u}; }
}
__device__ __forceinline__ float conv3(const bf16* P, int row, int col, const float* cw, int cc) {
    const bool first = (row == 0) || (row == NCTX), last = (row == NCTX - 1) || (row == ROWS - 1);
    float s = cw[768 + cc] * bf2f(P[(size_t)row * INWP + col]);
    if (!first) s += cw[cc] * bf2f(P[(size_t)(row - 1) * INWP + col]);
    if (!last) s += cw[2 * 768 + cc] * bf2f(P[(size_t)(row + 1) * INWP + col]);
    return s;
}
__device__ __forceinline__ void mix1_rwkv_prep(const Ctx& C, const DArgs& a, int l) {
    const bf16* P = (const bf16*)(C.ws + WS_P); float* SC = (float*)(C.ws + WS_SC);
    constexpr int LBP = 264;
    LAS unsigned char* lob = C.lds;
    LAS float* pre = (LAS float*)(C.lds + 16384);
    const bf16* lorat = (const bf16*)(C.ws + WS_LORAT) + (size_t)l * 4 * 256 * 64;
    const float* cw = a.in[I_DCONV] + (size_t)l * 3 * 768;
    const float* w0 = a.in[I_DW0] + (size_t)l * 512; const float* a0 = a.in[I_DA0] + (size_t)l * 512;
    const float* kkw = a.in[I_DKK] + (size_t)l * 256; const float* kaw = a.in[I_DKA] + (size_t)l * 256;
    const int half = C.tid >> 8, c = C.tid & 255, lane = C.lane, li = lane & 15, g = lane >> 4;
    const float kkc = kkw[c], kac = kaw[c];
    bf16x8 lrf[4][2][2];
#pragma unroll
    for (int q = 0; q < 4; ++q)
#pragma unroll
        for (int c2 = 0; c2 < 2; ++c2) { const bf16* bp = lorat + ((size_t)q * 256 + 16 * (2 * C.wave + c2) + li) * 64 + 8 * g; lrf[q][c2][0] = ldg8(bp); lrf[q][c2][1] = ldg8(bp + 32); }
    const float w0c[2] = {w0[c], w0[256 + c]}, a0c[2] = {a0[c], a0[256 + c]};
    const float cr0 = cw[c], cr1 = cw[768 + c], cr2 = cw[1536 + c], ck0 = cw[256 + c], ck1 = cw[768 + 256 + c], ck2 = cw[1536 + 256 + c], cv0 = cw[512 + c], cv1 = cw[768 + 512 + c], cv2 = cw[1536 + 512 + c];
    unsigned lin[4];
#define LIN_FETCH(gg) do { _Pragma("unroll") for (int k = 0; k < 4; ++k) { const int ix_ = C.tid + NTHR * k; if (ix_ < 13 * 128) lin[k] = *((const unsigned*)(P + (size_t)(13 * (gg) + (ix_ >> 7)) * INWP + C_WL) + (ix_ & 127)); } } while (0)
    unsigned xin[27];
#define XIN_FETCH(gg) do { const int r0_ = 13 * (gg) + 7 * half; _Pragma("unroll") for (int q = 0; q < 9; ++q) { const int rw_ = r0_ - 1 + q; const bool in_ = (rw_ >= 0) && (rw_ < ROWS) && (q <= (7 - half) + 1); \
        const unsigned* pp_ = (const unsigned*)(P + (size_t)(in_ ? rw_ : r0_) * INWP) + (c >> 1); xin[3 * q] = pp_[C_DR / 2]; xin[3 * q + 1] = pp_[C_DK / 2]; xin[3 * q + 2] = pp_[C_DV / 2]; } } while (0)
#define LOB_WRITE(dst) do { _Pragma("unroll") for (int k = 0; k < 4; ++k) { const int ix = C.tid + NTHR * k; if (ix < 13 * 128) { const int rl = ix >> 7, cp = ix & 127; const float x0 = bflo(lin[k]), x1 = bfhi(lin[k]); \
            *(LAS unsigned*)((dst) + (rl * LBP + 2 * cp) * 2) = (cp < 64) ? pk2(tanhf(x0), tanhf(x1)) : lin[k]; } } } while (0)
    LAS unsigned char* lob2 = C.lds + 81920;
    if (C.wg < ROWS / 13) { LIN_FETCH(C.wg); XIN_FETCH(C.wg); }
    __syncthreads();
    if (C.wg < ROWS / 13) { LOB_WRITE(lob); if (C.wg + C.G < ROWS / 13) LIN_FETCH(C.wg + C.G); }
    int pb = 0;
    for (int grp = C.wg; grp < ROWS / 13; grp += C.G) {
        const int row0 = 13 * grp + 7 * half, nj = 7 - half;
        LAS unsigned char* lobc = pb ? lob2 : lob; LAS unsigned char* lobn = pb ? lob : lob2; pb ^= 1;
        __syncthreads();
        float xr[9], xk[9], xv[9];
#pragma unroll
        for (int q = 0; q < 9; ++q) { const int rw = row0 - 1 + q; const bool in = (rw >= 0) && (rw < ROWS) && (q <= nj + 1); const unsigned wr_ = xin[3 * q], wk_ = xin[3 * q + 1], wv_ = xin[3 * q + 2];
            xr[q] = in ? ((c & 1) ? bfhi(wr_) : bflo(wr_)) : 0.f; xk[q] = in ? ((c & 1) ? bfhi(wk_) : bflo(wk_)) : 0.f; xv[q] = in ? ((c & 1) ? bfhi(wv_) : bflo(wv_)) : 0.f; }
#pragma unroll
        for (int q = 0; q < 4; ++q) { const bf16x8 a0f = ldA(lobc, LBP, 0, 64 * q, li, g), a1f = ldA(lobc, LBP, 0, 64 * q + 32, li, g);
#pragma unroll
            for (int c2 = 0; c2 < 2; ++c2) { const int ci = 2 * C.wave + c2;
                f32x4 acc = {0.f, 0.f, 0.f, 0.f}; acc = mfma16(a0f, lrf[q][c2][0], acc); acc = mfma16(a1f, lrf[q][c2][1], acc);
#pragma unroll
                for (int r = 0; r < 4; ++r) pre[(q * 16 + 4 * g + r) * 256 + 16 * ci + li] = acc[r]; } }
        __syncthreads();
        if (grp + C.G < ROWS / 13) { XIN_FETCH(grp + C.G); LOB_WRITE(lobn); if (grp + 2 * C.G < ROWS / 13) LIN_FETCH(grp + 2 * C.G); }
#pragma unroll
        for (int j = 0; j < 7; ++j) if (j < nj) { const int row = row0 + j, rl = 7 * half + j;
            const bool first = (row == 0) || (row == NCTX), last = (row == NCTX - 1) || (row == ROWS - 1);
            const float m0 = first ? 0.f : 1.f, m2 = last ? 0.f : 1.f;
            const float r = cr1 * xr[j + 1] + m0 * cr0 * xr[j] + m2 * cr2 * xr[j + 2], k = ck1 * xk[j + 1] + m0 * ck0 * xk[j] + m2 * ck2 * xk[j + 2], v = cv1 * xv[j + 1] + m0 * cv0 * xv[j] + m2 * cv2 * xv[j + 2];
            float kk = k * kkc; const float n2 = wave_sum(kk * kk, lane); kk *= rsqrtf(fmaxf(n2, 1e-24f));
            float* sc = SC + (size_t)row * 9 * 256; sc[c] = r; sc[256 + c] = v; sc[512 + c] = -kk;
#pragma unroll
            for (int d = 0; d < 2; ++d) { const float wp = w0c[d] + pre[(d * 16 + rl) * 256 + c], ap = a0c[d] + pre[((2 + d) * 16 + rl) * 256 + c];
                const float lw = -0.6065306597126334f * sigmoidf_(wp);
                const float as = sigmoidf_(ap);
                sc[(3 + 3 * d) * 256 + c] = lw; sc[(4 + 3 * d) * 256 + c] = k * (1.0f + (as - 1.0f) * kac); sc[(5 + 3 * d) * 256 + c] = kk * as; } }
    }
#undef LIN_FETCH
#undef XIN_FETCH
#undef LOB_WRITE
    __syncthreads();
}
constexpr int FP = 136;
constexpr int F_TABC = 0, F_TABS = 128 * FP * 2, F_TILE = 2 * 128 * FP * 2;
__device__ __forceinline__ void fourier_load_tables(const Ctx& C) {
    const bf16* ft = (const bf16*)(C.ws + WS_FTAB);
    for (int i = C.tid; i < 2 * 128 * 16; i += NTHR) { const int tb = i >> 11, r = (i >> 4) & 127, c8 = i & 15;
        *(LAS u32x4*)(C.lds + tb * F_TABS + (r * FP + 8 * c8) * 2) = *(const u32x4*)(ft + tb * 16384 + r * 128 + 8 * c8); }
}
__device__ __forceinline__ void mix1_fourier1(const Ctx& C) {
    const bf16* P = (const bf16*)(C.ws + WS_P); const float* tw = (const float*)(C.ws + WS_TW);
    bf16* FYR = (bf16*)(C.ws + WS_FYR); bf16* FYI = (bf16*)(C.ws + WS_FYI);
    const int lane = C.lane, li = lane & 15, g = lane >> 4, w = C.wave;
    __syncthreads();
    fourier_load_tables(C);
    for (int u = C.wg; u < 256; u += C.G) {
        const int t2 = u >> 1, ch0 = (u & 1) * 128;
        __syncthreads();
        for (int i = C.tid; i < 128 * 16; i += NTHR) { const int t1 = i >> 4, c8 = i & 15;
            *(LAS u32x4*)(C.lds + F_TILE + (t1 * FP + 8 * c8) * 2) = *(const u32x4*)(P + (size_t)(NCTX + 128 * t1 + t2) * INWP + C_BU + ch0 + 8 * c8); }
        float cpv[8], spv[8];
#pragma unroll
        for (int ni = 0; ni < 8; ++ni) { const int k1 = 16 * ni + li; cpv[ni] = tw[t2 * k1]; spv[ni] = tw[16384 + t2 * k1]; }
        __syncthreads();
        bf16x8 af[4];
#pragma unroll
        for (int ks = 0; ks < 4; ++ks) af[ks] = ldT(C.lds + F_TILE, FP, 32 * ks, 16 * w, li, g);
#pragma unroll
        for (int ni = 0; ni < 8; ++ni) { f32x4 dc = {0.f, 0.f, 0.f, 0.f}, ds = {0.f, 0.f, 0.f, 0.f};
#pragma unroll
            for (int ks = 0; ks < 4; ++ks) { dc = mfma16(af[ks], ldA(C.lds + F_TABC, FP, 16 * ni, 32 * ks, li, g), dc); ds = mfma16(af[ks], ldA(C.lds + F_TABS, FP, 16 * ni, 32 * ks, li, g), ds); }
            const int k1 = 16 * ni + li; const float cp = cpv[ni], sp = spv[ni];
            const f32x4 yr = dc * cp - ds * sp, yi = -(ds * cp) - dc * sp;
            const size_t o = ((size_t)k1 * 128 + t2) * 256 + ch0 + 16 * w + 4 * g;
            u32x2 wr; wr.x = pk2(yr[0], yr[1]); wr.y = pk2(yr[2], yr[3]); *(u32x2*)(FYR + o) = wr;
            u32x2 wi; wi.x = pk2(yi[0], yi[1]); wi.y = pk2(yi[2], yi[3]); *(u32x2*)(FYI + o) = wi; }
    }
    __syncthreads();
}
__device__ __forceinline__ void fourier2_mfma(const Ctx& C, int l, int wg0) {
    const bf16* FYR = (const bf16*)(C.ws + WS_FYR); const bf16* FYI = (const bf16*)(C.ws + WS_FYI); bf16* MIX = (bf16*)(C.ws + WS_MIX);
    const int lane = C.lane, li = lane & 15, g = lane >> 4, w = C.wave;
    constexpr int YP = 72, F_YR = F_TILE, F_YI = F_TILE + 128 * YP * 2;
    __syncthreads();
    fourier_load_tables(C);
    bf16x8 mff[16];
    { const bf16x8* mf = (const bf16x8*)((const bf16*)(C.ws + WS_FTAB) + 32768) + (size_t)(l * 4 + ((C.wg - wg0) & 3)) * 16 * 64;
#pragma unroll
      for (int k = 0; k < 16; ++k) mff[k] = mf[k * 64 + lane]; }
    u32x4 ytl[4];
#define F2_FETCH(uu) do { const int k1_ = (uu) >> 2, gq_ = (uu) & 3; _Pragma("unroll") for (int q = 0; q < 4; ++q) { const int i = C.tid + NTHR * q, im = i >> 10, t2 = (i >> 3) & 127, c8 = i & 7; \
        ytl[q] = *(const u32x4*)((im ? FYI : FYR) + ((size_t)k1_ * 128 + t2) * 256 + gq_ * 64 + 8 * c8); } } while (0)
    if (C.wg - wg0 < 512) F2_FETCH(C.wg - wg0);
    for (int u = C.wg - wg0; u < 512; u += C.G - wg0) {
        const int k1 = u >> 2, gq = u & 3;
        __syncthreads();
#pragma unroll
        for (int q = 0; q < 4; ++q) { const int i = C.tid + NTHR * q, im = i >> 10, t2 = (i >> 3) & 127, c8 = i & 7; *(LAS u32x4*)(C.lds + (im ? F_YI : F_YR) + (t2 * YP + 8 * c8) * 2) = ytl[q]; }
        __syncthreads();
        if (u + C.G - wg0 < 512) F2_FETCH(u + C.G - wg0);
        bf16x8 bc[4], bs[4];
#pragma unroll
        for (int ks = 0; ks < 4; ++ks) { bc[ks] = ldA(C.lds + F_TABC, FP, 16 * w, 32 * ks, li, g); bs[ks] = ldA(C.lds + F_TABS, FP, 16 * w, 32 * ks, li, g); }
        f32x4 xr[4], xi[4];
#pragma unroll
        for (int ci = 0; ci < 4; ++ci) { xr[ci] = (f32x4){0.f, 0.f, 0.f, 0.f}; f32x4 xs = {0.f, 0.f, 0.f, 0.f}; xi[ci] = xs;
#pragma unroll
            for (int ks = 0; ks < 4; ++ks) { const bf16x8 ar = ldT(C.lds + F_YR, YP, 32 * ks, 16 * ci, li, g), ai = ldT(C.lds + F_YI, YP, 32 * ks, 16 * ci, li, g);
                xr[ci] = mfma16(ar, bc[ks], xr[ci]); xr[ci] = mfma16(ai, bs[ks], xr[ci]);
                xi[ci] = mfma16(ai, bc[ks], xi[ci]); xs = mfma16(ar, bs[ks], xs); }
            xi[ci] = xi[ci] - xs; }
        union { bf16x8 v; unsigned q[4]; } xb[4];
#pragma unroll
        for (int q2 = 0; q2 < 2; ++q2) { xb[q2].q[0] = pk2(xr[2 * q2][0], xr[2 * q2][1]); xb[q2].q[1] = pk2(xr[2 * q2][2], xr[2 * q2][3]); xb[q2].q[2] = pk2(xr[2 * q2 + 1][0], xr[2 * q2 + 1][1]); xb[q2].q[3] = pk2(xr[2 * q2 + 1][2], xr[2 * q2 + 1][3]);
            xb[2 + q2].q[0] = pk2(xi[2 * q2][0], xi[2 * q2][1]); xb[2 + q2].q[1] = pk2(xi[2 * q2][2], xi[2 * q2][3]); xb[2 + q2].q[2] = pk2(xi[2 * q2 + 1][0], xi[2 * q2 + 1][1]); xb[2 + q2].q[3] = pk2(xi[2 * q2 + 1][2], xi[2 * q2 + 1][3]); }
#pragma unroll
        for (int ei = 0; ei < 4; ++ei) { f32x4 o = {0.f, 0.f, 0.f, 0.f};
#pragma unroll
            for (int ks2 = 0; ks2 < 4; ++ks2) o = mfma16(mff[ei * 4 + ks2], xb[ks2].v, o);
            const int tp = k1 + 128 * (16 * w + li);
            u32x2 wo; wo.x = pk2(o[0], o[1]); wo.y = pk2(o[2], o[3]); *(u32x2*)(MIX + (size_t)(NCTX + tp) * DM + 256 + gq * 64 + 16 * ei + 4 * g) = wo; }
    }
#undef F2_FETCH
    __syncthreads();
}

constexpr float LOG2E = 1.4426950408889634f;
typedef short bf16x4 __attribute__((ext_vector_type(4)));
__device__ __forceinline__ void attn_load(const bf16* P, const bf16* VT, int krow, int kcol, int li, int g, bf16x8 (&kf)[2][2], bf16x8 (&vf)[4]) {
#pragma unroll
    for (int t = 0; t < 2; ++t)
#pragma unroll
        for (int ks = 0; ks < 2; ++ks) kf[t][ks] = ldg8(P + (size_t)(krow + 16 * t + li) * INWP + kcol + 32 * ks + 8 * g);
#pragma unroll
    for (int dt = 0; dt < 4; ++dt) { const bf16* vp = VT + (size_t)(dt * 16 + li) * VTP + krow + 4 * g;
        const bf16x4 a = *(const bf16x4*)vp, b = *(const bf16x4*)(vp + 16); vf[dt] = (bf16x8){a[0], a[1], a[2], a[3], b[0], b[1], b[2], b[3]}; }
}
template <int NS, int NT>
__device__ __forceinline__ void attn_compute(const bf16x8 (&kf)[2][2], const bf16x8 (&vf)[4], const bf16x8 (&qf)[NS][2], f32x4 (&o)[NS][4], float (&m)[NS], float (&ls)[NS],
                                             const float (&add)[NT][2][4], int li, int g) {
#pragma unroll
    for (int hh = 0; hh < NS; ++hh) {
        f32x4 st[2];
#pragma unroll
        for (int t = 0; t < 2; ++t) { st[t] = (f32x4){0.f, 0.f, 0.f, 0.f};
#pragma unroll
            for (int ks = 0; ks < 2; ++ks) st[t] = __builtin_amdgcn_mfma_f32_16x16x32_bf16(kf[t][ks], qf[hh][ks], st[t], 0, 0, 0); }
        float s[8]; float bm = -INFINITY;
#pragma unroll
        for (int t = 0; t < 2; ++t)
#pragma unroll
            for (int r = 0; r < 4; ++r) { const float ad = add[hh / (NS / NT)][t][r]; s[4 * t + r] = st[t][r] * (0.125f * LOG2E) + ad;   bm = fmaxf(bm, s[4 * t + r]); }
        bm = fmaxf(bm, shx(bm, 16, 16 * g + li)); bm = fmaxf(bm, shx(bm, 32, 16 * g + li));
        const float mn = fmaxf(m[hh], bm), corr = __builtin_amdgcn_exp2f(m[hh] - mn); m[hh] = mn;
        float ps = 0.f; float pe[8];
#pragma unroll
        for (int e = 0; e < 8; ++e) { pe[e] = __builtin_amdgcn_exp2f(s[e] - mn); ps += pe[e]; }
        ls[hh] = ls[hh] * corr + ps;
        union { bf16x8 v; unsigned u[4]; } pf;
#pragma unroll
        for (int e2 = 0; e2 < 4; ++e2) pf.u[e2] = pk2(pe[2 * e2], pe[2 * e2 + 1]);
#pragma unroll
        for (int dt = 0; dt < 4; ++dt) { o[hh][dt] = o[hh][dt] * corr; o[hh][dt] = __builtin_amdgcn_mfma_f32_16x16x32_bf16(vf[dt], pf.v, o[hh][dt], 0, 0, 0); }
    }
}
__device__ __forceinline__ void attn_finish1(bf16* MIX, int qrow0, int ocol, f32x4 (&o)[4], float m, float ls, bool has_sink, float sink2, int li, int g) {
    float l = ls; l += shx(l, 16, 16 * g + li); l += shx(l, 32, 16 * g + li);
    float corr = 1.f;
    if (has_sink) { const float mn = fmaxf(m, sink2); corr = __builtin_amdgcn_exp2f(m - mn); l = l * corr + __builtin_amdgcn_exp2f(sink2 - mn); }
    const float inv = corr / l;
#pragma unroll
    for (int dt = 0; dt < 4; ++dt) { const f32x4 v = o[dt] * inv; u32x2 w; w.x = pk2(v[0], v[1]); w.y = pk2(v[2], v[3]);
        *(u32x2*)(MIX + (size_t)(qrow0 + li) * DM + ocol + dt * 16 + 4 * g) = w; }
}
__device__ __forceinline__ void attnA_unit(const Ctx& C, const float* asink_l, int unit, bool lat) {
    const bf16* P = (const bf16*)(C.ws + WS_P); bf16* MIX = (bf16*)(C.ws + WS_MIX);
    const int li = C.lane & 15, g = C.lane >> 4;
    const int nqp = lat ? SEQ / 32 : NCTX / 32, kvh = unit / nqp, qp = unit % nqp, t0 = qp * 32, qrow0 = (lat ? NCTX : 0) + t0;
    const bf16* VT = (const bf16*)(C.ws + WS_VTA) + (size_t)kvh * 64 * VTP; const int kcol = C_AK + kvh * 64;
    bf16x8 qf[4][2];
#pragma unroll
    for (int s = 0; s < 4; ++s)
#pragma unroll
        for (int ks = 0; ks < 2; ++ks) qf[s][ks] = ldg8(P + (size_t)(qrow0 + 16 * (s >> 1) + li) * INWP + C_AQ + (kvh * 2 + (s & 1)) * 64 + 32 * ks + 8 * g);
    f32x4 o[4][4]; float m[4], ls[4];
#pragma unroll
    for (int s = 0; s < 4; ++s) { m[s] = -1.0e30f; ls[s] = 0.f;
#pragma unroll
        for (int dt = 0; dt < 4; ++dt) o[s][dt] = (f32x4){0.f, 0.f, 0.f, 0.f}; }
    const int b_lo = lat ? 0 : 9;
#pragma unroll 1
    for (int bb = b_lo; bb < 17; ++bb) { float add[2][2][4]; bf16x8 kf[2][2], vf[4];
        const int krow = (bb < 9) ? NCTX + t0 - 128 + 32 * bb : 32 * (bb - 9);
        attn_load(P, VT, krow, kcol, li, g, kf, vf);
#pragma unroll
        for (int tl = 0; tl < 2; ++tl)
#pragma unroll
            for (int tt = 0; tt < 2; ++tt)
#pragma unroll
                for (int r = 0; r < 4; ++r) { const int j = t0 - 128 + 32 * bb + 16 * tt + 4 * g + r, t = t0 + 16 * tl + li;
                    const bool ok = (bb >= 9) || ((j >= 0) && (j < SEQ) && (j - t <= 128) && (t - j <= 128)); add[tl][tt][r] = ok ? 0.f : -INFINITY; }
        attn_compute<4, 2>(kf, vf, qf, o, m, ls, add, li, g); }
#pragma unroll
    for (int s = 0; s < 4; ++s) attn_finish1(MIX, qrow0 + 16 * (s >> 1), (kvh * 2 + (s & 1)) * 64, o[s], m[s], ls[s], true, asink_l[kvh * 2 + (s & 1)] * LOG2E, li, g);
}
__device__ __forceinline__ void attnC_unit(const Ctx& C, const LAS float* relb, int h, int up, bool lat) {
    const bf16* P = (const bf16*)(C.ws + WS_P); bf16* MIX = (bf16*)(C.ws + WS_MIX);
    const int li = C.lane & 15, g = C.lane >> 4;
    const int rp = up >> 2, cj = up & 3;
    const int t0a = lat ? (2 * rp) * 64 + 16 * cj : 32 * up, tstep = lat ? 64 : 16, qbase = lat ? NCTX : 0;
    const bf16* VT = (const bf16*)(C.ws + WS_VTC) + (size_t)h * 64 * VTP; const int kcol = C_CK + h * 64;
    bf16x8 qf[2][2];
#pragma unroll
    for (int s = 0; s < 2; ++s)
#pragma unroll
        for (int ks = 0; ks < 2; ++ks) qf[s][ks] = ldg8(P + (size_t)(qbase + t0a + tstep * s + li) * INWP + C_CQ + h * 64 + 32 * ks + 8 * g);
    f32x4 o[2][4]; float m[2] = {-1.0e30f, -1.0e30f}, ls[2] = {0.f, 0.f};
#pragma unroll
    for (int s = 0; s < 2; ++s)
#pragma unroll
        for (int dt = 0; dt < 4; ++dt) o[s][dt] = (f32x4){0.f, 0.f, 0.f, 0.f};
    const int r = 2 * rp, cq = cj * 16 + li;
    int r0a = r - 4; r0a = r0a < 0 ? 0 : (r0a > 248 ? 248 : r0a); int r0b = r - 3; r0b = r0b < 0 ? 0 : (r0b > 248 ? 248 : r0b);
    int c0 = cq - 8; c0 = c0 < 0 ? 0 : (c0 > 48 ? 48 : c0);
    const int cw0 = (cj == 0) ? 0 : (cj == 1) ? 8 : (cj == 2) ? 24 : 32;
    const int b_lo = lat ? 0 : 9;
#pragma unroll 1
    for (int bb = b_lo; bb < 17; ++bb) { float add[2][2][4]; bf16x8 kf[2][2], vf[4];
        const int kr = r0a + bb;
        if (bb < 9 && kr >= r0b + 8) continue;
        const int krow = (bb < 9) ? NCTX + kr * 64 + cw0 : 32 * (bb - 9);
        attn_load(P, VT, krow, kcol, li, g, kf, vf);
#pragma unroll
        for (int tl = 0; tl < 2; ++tl) { const int r0t = tl ? r0b : r0a, rt = r + tl; const bool rowok = (bb >= 9) || (kr >= r0t && kr < r0t + 8);
            int bi = kr - rt + 7; bi = bi < 0 ? 0 : (bi > 14 ? 14 : bi); const LAS float* rbp = relb + bi * 31;
#pragma unroll
            for (int tt = 0; tt < 2; ++tt)
#pragma unroll
                for (int rr = 0; rr < 4; ++rr) { const int kc = cw0 + 16 * tt + 4 * g + rr; int ci = kc - cq + 15; ci = ci < 0 ? 0 : (ci > 30 ? 30 : ci); const float bv = rbp[ci];
                    add[tl][tt][rr] = (bb >= 9) ? 0.f : ((rowok && kc >= c0 && kc < c0 + 16) ? bv : -INFINITY); } }
        attn_compute<2, 2>(kf, vf, qf, o, m, ls, add, li, g); }
#pragma unroll
    for (int s = 0; s < 2; ++s) attn_finish1(MIX, qbase + t0a + tstep * s, 512 + h * 64, o[s], m[s], ls[s], false, 0.f, li, g);
}
__device__ __forceinline__ void fourier_ctx_mfma(const Ctx& C, int l, int wg0) {
    const bf16* P = (const bf16*)(C.ws + WS_P); bf16* MIX = (bf16*)(C.ws + WS_MIX); const bf16* f2 = (const bf16*)(C.ws + WS_F256);
    const int lane = C.lane, li = lane & 15, g = lane >> 4, w = C.wave;
    constexpr int UP = 72;
    for (int u = C.wg - wg0; u < 8; u += C.G - wg0) {
        const int tb = u >> 2, gq = u & 3;
        __syncthreads();
        for (int i = C.tid; i < 256 * 8; i += NTHR) { const int t = i >> 3, c8 = i & 7; *(LAS u32x4*)(C.lds + (t * UP + 8 * c8) * 2) = *(const u32x4*)(P + (size_t)t * INWP + C_BU + gq * 64 + 8 * c8); }
        __syncthreads();
        const int tp0 = 128 * tb + 16 * w;
        f32x4 xr[4], xi[4];
#pragma unroll
        for (int ci = 0; ci < 4; ++ci) { xr[ci] = (f32x4){0.f, 0.f, 0.f, 0.f}; xi[ci] = (f32x4){0.f, 0.f, 0.f, 0.f}; }
#pragma unroll 2
        for (int ks = 0; ks < 8; ++ks) { const bf16x8 bc = ldg8(f2 + (size_t)(tp0 + li) * 256 + 32 * ks + 8 * g), bs = ldg8(f2 + 65536 + (size_t)(tp0 + li) * 256 + 32 * ks + 8 * g);
#pragma unroll
            for (int ci = 0; ci < 4; ++ci) { const bf16x8 au = ldT(C.lds, UP, 32 * ks, 16 * ci, li, g); xr[ci] = mfma16(au, bc, xr[ci]); xi[ci] = mfma16(au, bs, xi[ci]); } }
        union { bf16x8 v; unsigned q[4]; } xb[4];
#pragma unroll
        for (int q2 = 0; q2 < 2; ++q2) { xb[q2].q[0] = pk2(xr[2 * q2][0], xr[2 * q2][1]); xb[q2].q[1] = pk2(xr[2 * q2][2], xr[2 * q2][3]); xb[q2].q[2] = pk2(xr[2 * q2 + 1][0], xr[2 * q2 + 1][1]); xb[q2].q[3] = pk2(xr[2 * q2 + 1][2], xr[2 * q2 + 1][3]);
            xb[2 + q2].q[0] = pk2(-xi[2 * q2][0], -xi[2 * q2][1]); xb[2 + q2].q[1] = pk2(-xi[2 * q2][2], -xi[2 * q2][3]); xb[2 + q2].q[2] = pk2(-xi[2 * q2 + 1][0], -xi[2 * q2 + 1][1]); xb[2 + q2].q[3] = pk2(-xi[2 * q2 + 1][2], -xi[2 * q2 + 1][3]); }
        const bf16x8* mf = (const bf16x8*)((const bf16*)(C.ws + WS_FTAB) + 32768) + (size_t)(l * 4 + gq) * 16 * 64;
#pragma unroll
        for (int ei = 0; ei < 4; ++ei) { f32x4 o = {0.f, 0.f, 0.f, 0.f};
#pragma unroll
            for (int ks2 = 0; ks2 < 4; ++ks2) o = mfma16(mf[(ei * 4 + ks2) * 64 + lane], xb[ks2].v, o);
            o = o * 8.0f;
            u32x2 wo; wo.x = pk2(o[0], o[1]); wo.y = pk2(o[2], o[3]); *(u32x2*)(MIX + (size_t)(tp0 + li) * DM + 256 + gq * 64 + 16 * ei + 4 * g) = wo; }
    }
    __syncthreads();
}
__device__ __forceinline__ void fourier2_unit(const Ctx& C, int l, int u, bool ctx) {
    const bf16* P = (const bf16*)(C.ws + WS_P); const float* tw = (const float*)(C.ws + WS_TW); bf16* MIX = (bf16*)(C.ws + WS_MIX);
    const float* FYR = (const float*)(C.ws + WS_FYR); const float* FYI = (const float*)(C.ws + WS_FYI);
    const float* mt = (const float*)(C.ws + WS_MTAB) + (size_t)l * 2 * 4 * 4096;
    LAS float* xr = (LAS float*)(C.lds + 8192); LAS float* xi = xr + 512;
    const int tl = C.tid >> 8, ch = C.tid & 255, tp = 2 * u + tl;
    float sr = 0.f, si = 0.f;
    if (!ctx) { const int k1 = tp & 127, k2 = tp >> 7; const float* yr = FYR + (size_t)k1 * 128 * 256 + ch; const float* yi = FYI + (size_t)k1 * 128 * 256 + ch;
#pragma unroll 8
        for (int t2 = 0; t2 < 128; ++t2) { const int m = ((t2 * k2) & 127) * 128; const float c = tw[m], s = tw[16384 + m]; const float a = yr[t2 * 256], b = yi[t2 * 256]; sr += a * c + b * s; si += b * c - a * s; } }
    else {
#pragma unroll 8
        for (int t = 0; t < NCTX; ++t) { const int m = ((t * tp) & 255) * 64; const float x = bf2f(P[(size_t)t * INWP + C_BU + ch]); sr += x * tw[m]; si -= x * tw[16384 + m]; } }
    __syncthreads();
    xr[tl * 256 + ch] = sr; xi[tl * 256 + ch] = si;
    __syncthreads();
    const int g = ch >> 6, e = ch & 63; const float* mc = mt + (size_t)(0 * 4 + g) * 4096 + e; const float* ms = mt + (size_t)(1 * 4 + g) * 4096 + e;
    const LAS float* xrp = xr + tl * 256 + g * 64; const LAS float* xip = xi + tl * 256 + g * 64; float o = 0.f;
#pragma unroll 8
    for (int c = 0; c < 64; ++c) o += xrp[c] * mc[c * 64] + xip[c] * ms[c * 64];
    o *= ctx ? (1.0f / 128.0f) : (1.0f / 1024.0f);
    MIX[(size_t)((ctx ? 0 : NCTX) + tp) * DM + 256 + ch] = (bf16)f2bf(o);
}
__device__ __forceinline__ void rwkv_passB(const Ctx& C, int b);
__device__ __forceinline__ void phase_mix2(const Ctx& C, const DArgs& a, int l) {
    const bool emit_ctx = l < DEPTH - 1;
#ifndef REPMASK
#define REPMASK 0
#endif
#define NREP2(o) ((((REPMASK) >> (o)) & 1) ? 2 : 1)
    if (C.wg < 8) { for (int r2 = 0; r2 < NREP2(16); ++r2) rwkv_passB(C, C.wg); }
    else if (emit_ctx) fourier_ctx_mfma(C, l, 8);
    { const float* asink_l = a.in[I_ASINK] + l * 4; const float* crel = a.in[I_CREL] + (size_t)l * 4 * 465;
      LAS float* relb = (LAS float*)(C.lds + 110592 + C.wave * 2048);
      for (int r2 = 0; r2 < NREP2(17); ++r2) {
      unsigned* qhead = (unsigned*)(C.ws + WS_CTL) + CW_WQ + 64 * l + 16 * r2;
      const int nA = 2 * (SEQ / 32), nC = 4 * (SEQ / 32), nAc = emit_ctx ? 2 * (NCTX / 32) : 0, nCc = emit_ctx ? 4 * (NCTX / 32) : 0, nAll = nA + nAc + nC + nCc;
      int hcur = -1;
      const int nCv = CV_NCHUNK;
      for (;;) { unsigned uq = 0; if (C.lane == 0) uq = __hip_atomic_fetch_add(qhead, 1u, __ATOMIC_RELAXED, __HIP_MEMORY_SCOPE_AGENT);
          const int uraw = __builtin_amdgcn_readfirstlane((int)uq); if (uraw >= nAll + nCv) break;
          int u;
          if (uraw < 2 * nCv) { if (uraw & 1) { const int ch = uraw >> 1; convert_moe_items(C, a, l, ch * CV_CHUNK, ch * CV_CHUNK + CV_CHUNK); continue; } u = uraw >> 1; }
          else u = uraw - nCv;
          if (u < nA) attnA_unit(C, asink_l, u, true);
          else if (u < nA + nAc) attnA_unit(C, asink_l, u - nA, false);
          else { const int uc = u - nA - nAc; const bool lat = uc < nC; const int uu = lat ? uc : uc - nC, nqt = lat ? SEQ / 32 : NCTX / 32, h = uu / nqt, qt = uu % nqt;
              if (h != hcur) { for (int i = C.lane; i < 465; i += 64) relb[i] = crel[h * 465 + i] * LOG2E; hcur = h; LDS_WAIT(); asm volatile("" ::: "memory"); }
              attnC_unit(C, relb, h, qt, lat); } } } }
    __syncthreads();
    for (int r2 = 0; r2 < NREP2(19); ++r2) fourier2_mfma(C, l, 0);
}

constexpr int RW_C = 32, RW_NCH = ROWS / RW_C, RW_NSC = 32;
__device__ __forceinline__ int rw_sc_len(int s) { return s < 8 ? 17 : 16; }
__device__ __forceinline__ int rw_sc_start(int s) { return s < 8 ? 17 * s : 136 + 16 * (s - 8); }
__device__ __forceinline__ int rw_sc_of(int ct) { return ct < 136 ? ct / 17 : 8 + ((ct - 136) >> 4); }
constexpr int RW_SLOT = 5120, RW_REGION = 9 * RW_SLOT + 1024;
constexpr int TP = 72, HP = 40;
static_assert(3 * RW_REGION <= MISC_OFF, "RWKV D1 regions below the misc area");
__device__ __forceinline__ int rw_rc_of(int d, int c) { return d == 0 ? c : (c < 8 ? 7 - c : 527 - c); }
__device__ __forceinline__ int rw_row_of(int d, int rc, int t) { return 32 * rc + (d == 0 ? t : 31 - t); }

__device__ __forceinline__ void rwkv_d1(const Ctx& C, LAS unsigned char* rb, int d, int h, int rc) {
    int lane_ = C.lane; asm volatile("" : "+v"(lane_));
    const int lane = lane_, li = lane & 15, g = lane >> 4;
    const float* SC = (const float*)(C.ws + WS_SC);
    LAS unsigned char* S0 = rb; LAS unsigned char* S1 = rb + RW_SLOT; LAS unsigned char* S2 = rb + 2 * RW_SLOT; LAS unsigned char* S3 = rb + 3 * RW_SLOT; LAS unsigned char* S4 = rb + 4 * RW_SLOT;
    LAS unsigned char* S5 = rb + 5 * RW_SLOT; LAS unsigned char* S6 = rb + 6 * RW_SLOT; LAS unsigned char* S7 = rb + 7 * RW_SLOT; LAS unsigned char* S8 = rb + 8 * RW_SLOT;
    LAS unsigned char* S6b = S6 + 2560; LAS unsigned char* S7b = S7 + 2560;
    LAS float* gc = (LAS float*)(rb + 9 * RW_SLOT);
    { float cum = 0.f; const int j = lane; const int qw = (3 + 3 * d) * 256;
      float rv[2][4], vv[2][4], av[2][4], lw[2][4], kd[2][4], bb[2][4];
#define RW_LD(buf, t0) do { _Pragma("unroll") for (int u = 0; u < 4; ++u) { const float* sc = SC + (size_t)rw_row_of(d, rc, (t0) + u) * 9 * 256 + h * 64 + j; \
          rv[buf][u] = sc[0]; vv[buf][u] = sc[256]; av[buf][u] = sc[512]; lw[buf][u] = sc[qw]; kd[buf][u] = sc[qw + 256]; bb[buf][u] = sc[qw + 512]; } } while (0)
#define RW_CP(buf, t0) do { _Pragma("unroll") for (int u = 0; u < 4; ++u) { const float cp = cum; cum += lw[buf][u]; const float Gt = __expf(cum), Gm = __expf(cp), iG = __expf(-cum); const int off = (((t0) + u) * TP + j) * 2; \
          *(LAS bf16*)(S0 + off) = (bf16)f2bf(av[buf][u] * Gm); *(LAS bf16*)(S1 + off) = (bf16)f2bf(rv[buf][u] * Gt); *(LAS bf16*)(S2 + off) = (bf16)f2bf(bb[buf][u] * iG); \
          *(LAS bf16*)(S3 + off) = (bf16)f2bf(kd[buf][u] * iG); *(LAS bf16*)(S4 + off) = (bf16)f2bf(vv[buf][u]); } } while (0)
      RW_LD(0, 0);
#pragma unroll
      for (int b2 = 0; b2 < 4; ++b2) { RW_LD(1, 8 * b2 + 4); __builtin_amdgcn_sched_barrier(0); RW_CP(0, 8 * b2); if (b2 < 3) RW_LD(0, 8 * b2 + 8); __builtin_amdgcn_sched_barrier(0); RW_CP(1, 8 * b2 + 4); }
#undef RW_LD
#undef RW_CP
      gc[j] = __expf(cum); }
    const f32x4 z4 = {0.f, 0.f, 0.f, 0.f};
#pragma unroll 1
    for (int ti = 0; ti < 2; ++ti)
#pragma unroll
        for (int si = 0; si < 2; ++si) {
            f32x4 n = z4, nt = z4, mk = z4, qb = z4, qk = z4;
#pragma unroll
            for (int ks = 0; ks < 2; ++ks) { const bf16x8 at = ldA(S0, TP, 16 * ti, 32 * ks, li, g), rt = ldA(S1, TP, 16 * ti, 32 * ks, li, g), bs = ldA(S2, TP, 16 * si, 32 * ks, li, g), kss = ldA(S3, TP, 16 * si, 32 * ks, li, g);
                n = mfma16(at, bs, n);
                nt = mfma16(bs, at, nt);
                mk = mfma16(kss, at, mk);
                qb = mfma16(bs, rt, qb);
                qk = mfma16(kss, rt, qk); }
#pragma unroll
            for (int r = 0; r < 4; ++r) { const int trow = 16 * ti + 4 * g + r, scol = 16 * si + li; if (!(scol < trow)) n[r] = 0.f;
                const int srow = 16 * si + 4 * g + r, tcol = 16 * ti + li; if (!(srow < tcol)) { mk[r] = 0.f; nt[r] = 0.f; } if (!(srow <= tcol)) { qb[r] = 0.f; qk[r] = 0.f; } }
            *(LAS f32x4*)(S5 + ((16 * si + li) * 32 + 16 * ti + 4 * g) * 4) = n;
            stT(S6, HP, 16 * ti + li, 16 * si + 4 * g, mk);
            stT(S8, HP, 16 * ti + li, 16 * si + 4 * g, nt);
            stT(S6b, HP, 16 * ti + li, 16 * si + 4 * g, qb);
            stT(S7, HP, 16 * ti + li, 16 * si + 4 * g, qk); }
    { const int rr = lane & 31, bq = rr >> 4, lr = rr & 15; float Tr[16];
#pragma unroll
      for (int s = 15; s >= 0; --s) { float acc = (lr == s) ? 1.f : 0.f;
#pragma unroll
          for (int c4 = 0; c4 < 4; ++c4) { if (4 * c4 + 3 > s) { const f32x4 nv = *(const LAS f32x4*)(S5 + ((16 * bq + s) * 32 + 16 * bq + 4 * c4) * 4);
#pragma unroll
              for (int e = 0; e < 4; ++e) if (4 * c4 + e > s) acc += Tr[4 * c4 + e] * nv[e]; } }
          Tr[s] = acc; }
      if (lane < 32) { u32x4 w0, w1; w0.x = pk2(Tr[0], Tr[1]); w0.y = pk2(Tr[2], Tr[3]); w0.z = pk2(Tr[4], Tr[5]); w0.w = pk2(Tr[6], Tr[7]); w1.x = pk2(Tr[8], Tr[9]); w1.y = pk2(Tr[10], Tr[11]); w1.z = pk2(Tr[12], Tr[13]); w1.w = pk2(Tr[14], Tr[15]);
          const u32x4 zz = {0u, 0u, 0u, 0u}; LAS u32x4* trow = (LAS u32x4*)(S7b + rr * HP * 2);
          trow[0] = bq ? zz : w0; trow[1] = bq ? zz : w1; trow[2] = bq ? w0 : zz; trow[3] = bq ? w1 : zz; }
      f32x4 x = mfma16(ldA(S8, HP, 16, 0, li, g), ldT(S7b, HP, 0, 0, li, g), z4);
      LAS unsigned char* XT = S8 + 2560;
      *(LAS u32x2*)(XT + (li * HP + 4 * g) * 2) = (u32x2){0u, 0u}; stT(XT, HP, li, 16 + 4 * g, x);
      const f32x4 t21 = mfma16(ldA(S7b, HP, 16, 0, li, g), ldA(XT, HP, 0, 0, li, g), z4);
#pragma unroll
      for (int r = 0; r < 4; ++r) *(LAS bf16*)(S7b + ((16 + 4 * g + r) * HP + li) * 2) = (bf16)f2bf(t21[r]); }
#pragma unroll
    for (int ti = 0; ti < 2; ++ti) { const bf16x8 tf = ldA(S7b, HP, 16 * ti, 0, li, g), mf = ldA(S6, HP, 16 * ti, 0, li, g);
#pragma unroll
        for (int ji = 0; ji < 4; ++ji) { const f32x4 ap = mfma16(tf, ldT(S0, TP, 0, 16 * ji, li, g), z4); stT(S8, HP, 16 * ji + li, 16 * ti + 4 * g, ap);
            const f32x4 mv = mfma16(mf, ldT(S4, TP, 0, 16 * ji, li, g), z4); stT(S5, HP, 16 * ji + li, 16 * ti + 4 * g, mv); } }
#pragma unroll
    for (int ti = 0; ti < 2; ++ti) { const bf16x8 tf = ldA(S7b, HP, 16 * ti, 0, li, g);
#pragma unroll
        for (int vi = 0; vi < 4; ++vi) { const f32x4 ul = mfma16(tf, ldA(S5, HP, 16 * vi, 0, li, g), z4); stT(S0, HP, 16 * vi + li, 16 * ti + 4 * g, ul); } }
#pragma unroll
    for (int ti = 0; ti < 2; ++ti) { const bf16x8 qbf = ldA(S6b, HP, 16 * ti, 0, li, g), qkf = ldA(S7, HP, 16 * ti, 0, li, g);
#pragma unroll
        for (int ji = 0; ji < 4; ++ji) { f32x4 rp = mfma16(ldA(S8, HP, 16 * ji, 0, li, g), qbf, z4);
            LAS unsigned char* p = S1 + ((16 * ti + li) * TP + 16 * ji + 4 * g) * 2; rp = rp + ld4bf(p); u32x2 w; w.x = pk2(rp[0], rp[1]); w.y = pk2(rp[2], rp[3]); *(LAS u32x2*)p = w;
            f32x4 yl = mfma16(qbf, ldA(S0, HP, 16 * ji, 0, li, g), z4); yl = mfma16(qkf, ldT(S4, TP, 0, 16 * ji, li, g), yl);
            stT(S5, HP, 16 * ji + li, 16 * ti + 4 * g, yl); } }
#pragma unroll 2
    for (int ji = 0; ji < 4; ++ji) { const bf16x8 bt = ldT(S2, TP, 0, 16 * ji, li, g); const float gj = gc[16 * ji + li];
#pragma unroll
        for (int jp = 0; jp < 4; ++jp) { f32x4 pt = mfma16(ldA(S8, HP, 16 * jp, 0, li, g), bt, z4);
#pragma unroll
            for (int r = 0; r < 4; ++r) pt[r] = pt[r] * gj + ((16 * jp + 4 * g + r == 16 * ji + li) ? gj : 0.f);
            stT(S6, TP, 16 * ji + li, 16 * jp + 4 * g, pt); } }
#pragma unroll 1
    for (int vh = 0; vh < 2; ++vh) { f32x4 lt[4][2];
#pragma unroll
      for (int ji = 0; ji < 4; ++ji) { const bf16x8 ba = ldT(S2, TP, 0, 16 * ji, li, g), ka = ldT(S3, TP, 0, 16 * ji, li, g); const f32x4 gv = *(const LAS f32x4*)(gc + 16 * ji + 4 * g);
#pragma unroll
          for (int v2 = 0; v2 < 2; ++v2) { const int vi = 2 * vh + v2; f32x4 x = mfma16(ba, ldA(S0, HP, 16 * vi, 0, li, g), z4); x = mfma16(ka, ldT(S4, TP, 0, 16 * vi, li, g), x); lt[ji][v2] = x * gv; } }
      asm volatile("s_waitcnt lgkmcnt(0)" ::: "memory");
      LAS unsigned char* dst = vh ? S2 : S8;
#pragma unroll
      for (int ji = 0; ji < 4; ++ji)
#pragma unroll
          for (int v2 = 0; v2 < 2; ++v2) stT(dst, TP, 16 * v2 + li, 16 * ji + 4 * g, lt[ji][v2]); }
}
__device__ __forceinline__ void rwkv_passA_step(const Ctx& C, const LAS unsigned char* rb, f32x4 (&hs)[4], int d, int h, int rc) {
    int lane_ = C.lane; asm volatile("" : "+v"(lane_));
    const int lane = lane_, li = lane & 15, g = lane >> 4; const bool isPhi = C.wave >= 4; const int col = 16 * (C.wave & 3) + li;
    const LAS unsigned char* S1 = rb + RW_SLOT; const LAS unsigned char* S2 = rb + 2 * RW_SLOT; const LAS unsigned char* S5 = rb + 5 * RW_SLOT; const LAS unsigned char* S6 = rb + 6 * RW_SLOT;
    const LAS unsigned char* LTb = (col < 32) ? rb + 8 * RW_SLOT + col * TP * 2 : S2 + (col - 32) * TP * 2;
    union { bf16x8 v; unsigned u[4]; } bf[2];
#pragma unroll
    for (int ks = 0; ks < 2; ++ks) { bf[ks].u[0] = pk2(hs[2 * ks][0], hs[2 * ks][1]); bf[ks].u[1] = pk2(hs[2 * ks][2], hs[2 * ks][3]); bf[ks].u[2] = pk2(hs[2 * ks + 1][0], hs[2 * ks + 1][1]); bf[ks].u[3] = pk2(hs[2 * ks + 1][2], hs[2 * ks + 1][3]); }
#pragma unroll
    for (int ti = 0; ti < 2; ++ti) { f32x4 acc = isPhi ? (f32x4){0.f, 0.f, 0.f, 0.f} : ld4bf(S5 + (col * HP + 16 * ti + 4 * g) * 2);
#pragma unroll
        for (int ks = 0; ks < 2; ++ks) acc = mfma16(ldAperm(S1, TP, 16 * ti, ks, li, g), bf[ks].v, acc);
        if (!isPhi) { float* ys = (float*)(C.ws + WS_YS) + (size_t)d * ROWS * 256 + h * 64 + col;
#pragma unroll
            for (int r = 0; r < 4; ++r) ys[(size_t)rw_row_of(d, rc, 16 * ti + 4 * g + r) * 256] = acc[r]; }
        else { bf16* rp = (bf16*)(C.ws + WS_RPP) + ((size_t)((d * 4 + h) * RW_NCH + rc) * 32) * 64 + col;
#pragma unroll
            for (int r = 0; r < 4; ++r) { const float nb = dpp_swap1(acc[r]); if (!(li & 1)) *(unsigned*)(rp + (16 * ti + 4 * g + r) * 64) = pk2(acc[r], nb); } } }
    f32x4 hn[4];
#pragma unroll
    for (int i = 0; i < 4; ++i) { f32x4 acc = isPhi ? (f32x4){0.f, 0.f, 0.f, 0.f} : ld4bf(LTb + (16 * i + 4 * g) * 2);
#pragma unroll
        for (int ks = 0; ks < 2; ++ks) acc = mfma16(ldAperm(S6, TP, 16 * i, ks, li, g), bf[ks].v, acc);
        hn[i] = acc; }
#pragma unroll
    for (int i = 0; i < 4; ++i) hs[i] = hn[i];
}
__device__ __forceinline__ void phase_rwkv1(const Ctx& C) {
    const int lane = C.lane, li = lane & 15, g = lane >> 4;
    for (int u = C.wg; u < 8 * RW_NSC; u += C.G) {
        const int s = u % RW_NSC, dh = u / RW_NSC, d = dh >> 2, h = dh & 3; const bool isPhi = C.wave >= 4; const int col = 16 * (C.wave & 3) + li;
        f32x4 hs[4];
#pragma unroll
        for (int i = 0; i < 4; ++i)
#pragma unroll
            for (int r = 0; r < 4; ++r) hs[i][r] = (isPhi && (16 * i + 4 * g + r == col)) ? 1.f : 0.f;
        const int nch = rw_sc_len(s), c0 = rw_sc_start(s);
#pragma unroll 1
        for (int rnd = 0; rnd < 6; ++rnd) {
            __syncthreads();
            { int wv = C.wave; asm volatile("" : "+s"(wv)); if (wv < 3 && 3 * rnd + wv < nch) rwkv_d1(C, C.lds + wv * RW_REGION, d, h, rw_rc_of(d, c0 + 3 * rnd + wv)); }
            __syncthreads();
#pragma unroll 1
            for (int k = 0; k < 3; ++k) { const int ci = 3 * rnd + k; int ko = k * RW_REGION; asm volatile("" : "+s"(ko)); if (ci < nch) rwkv_passA_step(C, C.lds + ko, hs, d, h, rw_rc_of(d, c0 + ci)); }
        }
        if (isPhi) { bf16* pf = (bf16*)(C.ws + WS_PSC) + (size_t)(dh * RW_NSC + s) * 4096;
            const int ks = col >> 5, eh = (col >> 4) & 1, gp = (col >> 2) & 3, el = col & 3;
#pragma unroll
            for (int i = 0; i < 4; ++i)
#pragma unroll
                for (int r = 0; r < 4; ++r) pf[((i * 2 + ks) * 64 + gp * 16 + 4 * g + r) * 8 + eh * 4 + el] = (bf16)f2bf(hs[i][r]); }
        else { f32x4* lf = (f32x4*)(C.ws + WS_LSC) + ((size_t)(dh * RW_NSC + s) * 4 + C.wave) * 4 * 64;
#pragma unroll
            for (int i = 0; i < 4; ++i) lf[i * 64 + lane] = hs[i]; }
    }
    __syncthreads();
}
__device__ __forceinline__ void rwkv_passB(const Ctx& C, int b) {
    if (C.wave >= 4) return;
    const int lane = C.lane, li = lane & 15, g = lane >> 4, q = C.wave;
    f32x4 hs[4];
#pragma unroll
    for (int i = 0; i < 4; ++i) hs[i] = (f32x4){0.f, 0.f, 0.f, 0.f};
    const bf16x8* pfb = (const bf16x8*)((const bf16*)(C.ws + WS_PSC) + (size_t)b * RW_NSC * 4096);
    const f32x4* lfb = (const f32x4*)(C.ws + WS_LSC) + ((size_t)b * RW_NSC * 4 + q) * 4 * 64;
    bf16x8 pa[8]; f32x4 la[4];
#pragma unroll
    for (int k = 0; k < 8; ++k) pa[k] = pfb[k * 64 + lane];
#pragma unroll
    for (int i = 0; i < 4; ++i) la[i] = lfb[i * 64 + lane];
#pragma unroll 1
    for (int s = 0; s < RW_NSC; ++s) {
        bf16* hp = (bf16*)(C.ws + WS_HSC) + ((size_t)(b * RW_NSC + s) * 64 + 16 * q + li) * 64;
#pragma unroll
        for (int i = 0; i < 4; ++i) { u32x2 w; w.x = pk2(hs[i][0], hs[i][1]); w.y = pk2(hs[i][2], hs[i][3]); *(u32x2*)(hp + 16 * i + 4 * g) = w; }
        bf16x8 pn[8]; f32x4 ln[4]; const int sn = (s + 1 < RW_NSC) ? s + 1 : s;
#pragma unroll
        for (int k = 0; k < 8; ++k) pn[k] = pfb[(size_t)sn * 512 + k * 64 + lane];
#pragma unroll
        for (int i = 0; i < 4; ++i) ln[i] = lfb[(size_t)sn * 4 * 4 * 64 + i * 64 + lane];
        union { bf16x8 v; unsigned u[4]; } bf[2];
#pragma unroll
        for (int ks = 0; ks < 2; ++ks) { bf[ks].u[0] = pk2(hs[2 * ks][0], hs[2 * ks][1]); bf[ks].u[1] = pk2(hs[2 * ks][2], hs[2 * ks][3]); bf[ks].u[2] = pk2(hs[2 * ks + 1][0], hs[2 * ks + 1][1]); bf[ks].u[3] = pk2(hs[2 * ks + 1][2], hs[2 * ks + 1][3]); }
#pragma unroll
        for (int i = 0; i < 4; ++i) { f32x4 acc = la[i];
#pragma unroll
            for (int ks = 0; ks < 2; ++ks) acc = mfma16(pa[i * 2 + ks], bf[ks].v, acc);
            hs[i] = acc; }
#pragma unroll
        for (int k = 0; k < 8; ++k) pa[k] = pn[k];
#pragma unroll
        for (int i = 0; i < 4; ++i) la[i] = ln[i];
    }
}
__device__ __forceinline__ void phase_mix3(const Ctx& C, const DArgs& a, int l) {
    const bf16* P = (const bf16*)(C.ws + WS_P); const float* SC = (const float*)(C.ws + WS_SC); const float* YS = (const float*)(C.ws + WS_YS); bf16* MIX = (bf16*)(C.ws + WS_MIX);
    LAS float* yt = (LAS float*)(C.lds);
    constexpr int GSP = 168;
    LAS unsigned char* gsig = C.lds + 32768;
    LAS float* gm = (LAS float*)(C.lds + 40960);
    const bf16* g2t = (const bf16*)(C.ws + WS_G2T) + (size_t)l * 256 * 160;
    const float* rk = a.in[I_DRK] + (size_t)l * 256; const float* lnw = a.in[I_DLNW] + (size_t)l * 256; const float* lnb = a.in[I_DLNB] + (size_t)l * 256;
    const int lane = C.lane, li = lane & 15, g = lane >> 4, h = C.wave & 3, d = C.wave >> 2;
    const int half = C.tid >> 8, c = C.tid & 255;
    const int u_lo = (l == DEPTH - 1) ? NCTX / 16 : 0;
    unsigned glv[3];
#define GL_FETCH(uu) do { _Pragma("unroll") for (int k = 0; k < 3; ++k) { const int i = C.tid + NTHR * k; if (i < 16 * 80) { const int t = i / 80, ip = i % 80; glv[k] = *((const unsigned*)(P + (size_t)(16 * (uu) + t) * INWP + C_GL) + ip); } } } while (0)
    const float lnwc = lnw[c], lnbc = lnb[c], rkc = rk[c];
    bf16x8 g2f[2][5];
#pragma unroll
    for (int c2 = 0; c2 < 2; ++c2)
#pragma unroll
        for (int ks = 0; ks < 5; ++ks) g2f[c2][ks] = ldg8(g2t + (size_t)(16 * (2 * C.wave + c2) + li) * 160 + 32 * ks + 8 * g);
    bf16x8 caf[2], cbf[4][2]; float cys[4][4];
#define CORR_FETCH(uu) do { const int rc_ = (uu) >> 1, th_ = (uu) & 1, ct_ = (d == 0) ? rc_ : (rc_ < 8 ? 7 - rc_ : 527 - rc_), s_ = rw_sc_of(ct_), ti_ = (d == 0) ? th_ : 1 - th_; \
        const bf16* rp_ = (const bf16*)(C.ws + WS_RPP) + (size_t)((d * 4 + h) * RW_NCH + rc_) * 32 * 64; const bf16* hp_ = (const bf16*)(C.ws + WS_HSC) + (size_t)((d * 4 + h) * RW_NSC + s_) * 64 * 64; \
        _Pragma("unroll") for (int ks = 0; ks < 2; ++ks) caf[ks] = ldg8(rp_ + (16 * ti_ + li) * 64 + 32 * ks + 8 * g); \
        _Pragma("unroll") for (int vi = 0; vi < 4; ++vi) { _Pragma("unroll") for (int ks = 0; ks < 2; ++ks) cbf[vi][ks] = ldg8(hp_ + (16 * vi + li) * 64 + 32 * ks + 8 * g); \
            _Pragma("unroll") for (int r = 0; r < 4; ++r) { const int t_ = 16 * ti_ + 4 * g + r, rl_ = ((d == 0) ? t_ : 31 - t_) - 16 * th_; cys[vi][r] = YS[((size_t)d * ROWS + 16 * (uu) + rl_) * 256 + h * 64 + 16 * vi + li]; } } } while (0)
    float qr[8], qv[8], qk0[8], qk1[8];
#define SCQ_FETCH(uu) do { _Pragma("unroll") for (int it = 0; it < 8; ++it) { const float* sc = SC + (size_t)(16 * (uu) + 2 * it + half) * 9 * 256; qr[it] = sc[c]; qv[it] = sc[256 + c]; qk0[it] = sc[4 * 256 + c]; qk1[it] = sc[7 * 256 + c]; } } while (0)
    if (u_lo + C.wg < ROWS / 16) { GL_FETCH(u_lo + C.wg); CORR_FETCH(u_lo + C.wg); SCQ_FETCH(u_lo + C.wg); }
    for (int u = u_lo + C.wg; u < ROWS / 16; u += C.G) {
        const int rc = u >> 1, th = u & 1, rowb = 16 * u;
        __syncthreads();
#pragma unroll
        for (int k = 0; k < 3; ++k) { const int i = C.tid + NTHR * k; if (i < 16 * 80) { const int t = i / 80, ip = i % 80; *(LAS unsigned*)(gsig + (t * GSP + 2 * ip) * 2) = pk2(sigmoidf_(bflo(glv[k])), sigmoidf_(bfhi(glv[k]))); } }
        {
          const int ti = (d == 0) ? th : 1 - th;
#pragma unroll
          for (int vi = 0; vi < 4; ++vi) { f32x4 acc = {0.f, 0.f, 0.f, 0.f};
#pragma unroll
              for (int ks = 0; ks < 2; ++ks) acc = mfma16(caf[ks], cbf[vi][ks], acc);
#pragma unroll
              for (int r = 0; r < 4; ++r) { const int t = 16 * ti + 4 * g + r, rl = ((d == 0) ? t : 31 - t) - 16 * th;
                  yt[(d * 16 + rl) * 256 + h * 64 + 16 * vi + li] = acc[r] + cys[vi][r]; } } }
        __syncthreads();
#pragma unroll
        for (int c2 = 0; c2 < 2; ++c2) { const int ci = 2 * C.wave + c2; f32x4 a0 = {0.f, 0.f, 0.f, 0.f};
#pragma unroll
            for (int ks = 0; ks < 5; ++ks) a0 = mfma16(ldA(gsig, GSP, 0, 32 * ks, li, g), g2f[c2][ks], a0);
#pragma unroll
            for (int r = 0; r < 4; ++r) gm[(4 * g + r) * 256 + 16 * ci + li] = a0[r]; }
        __syncthreads();
        float cr[8], cv[8], ck[8];
#pragma unroll
        for (int it = 0; it < 8; ++it) { cr[it] = qr[it]; cv[it] = qv[it]; ck[it] = qk0[it] + qk1[it]; }
        if (u + C.G < ROWS / 16) { GL_FETCH(u + C.G); CORR_FETCH(u + C.G); SCQ_FETCH(u + C.G); }
#pragma unroll
        for (int it = 0; it < 8; ++it) { const int rl = 2 * it + half, row = rowb + rl;
            const float y = yt[rl * 256 + c] + yt[(16 + rl) * 256 + c];
            const float mu = wave_sum(y, lane) * (1.f / 64.f), dy = y - mu, var = wave_sum(dy * dy, lane) * (1.f / 64.f);
            const float yn = dy * rsqrtf(var + 64e-5f) * lnwc + lnbc;
            const float coef = wave_sum(cr[it] * ck[it] * rkc, lane);
            const float ov = (yn + coef * cv[it]) * gm[rl * 256 + c], onb = dpp_swap1(ov);
            if (!(c & 1)) *(unsigned*)(MIX + (size_t)row * DM + 768 + c) = pk2(ov, onb); }
    }
#undef GL_FETCH
#undef CORR_FETCH
#undef SCQ_FETCH
    __syncthreads();
}
__device__ __forceinline__ void outproj_ctx(const Ctx& C, int l, const float* gate) {
    const bf16* A = (const bf16*)(C.ws + WS_MIX); const bf16* B = (const bf16*)(C.ws + WS_WOUT) + (size_t)l * DM * DM; bf16* XS = (bf16*)(C.ws + WS_XS);
    const int lane = C.lane, li = lane & 15, g = lane >> 4;
    for (int u = C.gw; u < (NCTX / 16) * (DM / 16); u += C.NGW) { const int rt = u >> 6, ct = u & 63;
        const bf16* ap = A + (size_t)(16 * rt + li) * DM + 8 * g; const bf16* bp = B + (size_t)(16 * ct + li) * DM + 8 * g;
        f32x4 acc0 = {0.f, 0.f, 0.f, 0.f}, acc1 = {0.f, 0.f, 0.f, 0.f};
#pragma unroll 8
        for (int ks = 0; ks < 32; ks += 2) { acc0 = mfma16(ldg8(ap + 32 * ks), ldg8(bp + 32 * ks), acc0); acc1 = mfma16(ldg8(ap + 32 * ks + 32), ldg8(bp + 32 * ks + 32), acc1); }
        const float gv = gate[16 * ct + li];
#pragma unroll
        for (int r = 0; r < 4; ++r) { const float dv = gv * (acc0[r] + acc1[r]), dnb = dpp_swap1(dv);
            if (!(li & 1)) { unsigned* p = (unsigned*)(XS + (size_t)(16 * rt + 4 * g + r) * DM + 16 * ct + li); const unsigned w = *p; *p = pk2(bflo(w) + dv, bfhi(w) + dnb); } } }
}

#ifndef MK_SINGLE
#define MK_SINGLE 1
#endif
template <int ONLYP> __global__ void __launch_bounds__(NTHR, 2) mega(Args a) {
    extern __shared__ __attribute__((aligned(16))) unsigned char lds_raw[];
    Ctx C;
#define MKCTX() do { int t_ = threadIdx.x; asm volatile("" : "+v"(t_)); unsigned char* w_ = a.ws; asm volatile("" : "+s"(w_)); unsigned l_ = 0u; asm volatile("" : "+s"(l_)); \
        C.lds = (LAS unsigned char*)lds_raw + l_; C.tid = t_; C.lane = t_ & 63; C.wave = __builtin_amdgcn_readfirstlane(t_ >> 6); \
        C.wg = blockIdx.x; C.G = gridDim.x; C.gw = C.wg * NWAVES + C.wave; C.NGW = C.G * NWAVES; C.ws = w_; } while (0)
    MKCTX();
    if (C.tid == 0) {
#pragma unroll
        for (int i = 0; i < 31; ++i) ((LAS unsigned long long*)(C.lds + MISC_OFF + 2048))[i] = (unsigned long long)a.in[i]; }
    DArgs da; da.in.tab = (const LAS unsigned*)(C.lds + MISC_OFF + 2048); da.out = a.out;
    if (C.tid < 4) ((LAS unsigned*)(C.lds + MISC_OFF))[C.tid] = 0u;
    __syncthreads();
    XcdBarrier bar; bar.bar = (unsigned*)(C.ws + WS_CTL) + CW_BAR; bar.x = 0; bar.st = (volatile LAS unsigned*)(C.lds + MISC_OFF);
    if (a.use_bar) bar = xcd_barrier_post((unsigned*)(C.ws + WS_CTL) + CW_BAR, (volatile LAS unsigned*)(C.lds + MISC_OFF));
#ifndef PHMASK
#define PHMASK 0x1fff
#endif
#define INP(o, k) ((ONLYP < 0 || ONLYP == (o)) && ((PHMASK >> ((o) == 99 ? 12 : (o))) & 1) && a.ph_lo <= (k) && (k) < a.ph_hi)
#ifndef REPMASK
#define REPMASK 0
#endif
#define NREP(o) ((((REPMASK) >> ((o) == 99 ? 12 : (o))) & 1) ? 2 : 1)
#define IN(k) (a.ph_lo <= (k) && (k) < a.ph_hi)
#define SEAM(k) do { if (a.use_bar && IN(k) && IN((k) + 1)) { xcd_barrier(bar); if ((REPMASK >> 20) & 1) xcd_barrier(bar); } } while (0)
    if (INP(0, 0)) for (int rep = 0; rep < NREP(0); ++rep) { MKCTX(); phase_prologue(C, da); }
    SEAM(0);
    for (int l = 0; l < DEPTH; ++l) {
        const int b = 1 + l * NPL;
        const float* mod_lat = (const float*)(C.ws + WS_MOD) + (size_t)(l * 2 + 0) * 6144; const float* mod_ctx = mod_lat + 6144;
        if (INP(1, b + 0)) { MKCTX(); phase_norm1(C, da, l); }
        SEAM(b + 0);
        if (INP(2, b + 1)) for (int rep = 0; rep < NREP(2); ++rep) { MKCTX();
            pg8::StaticOrder S; S.init(WS_H, WS_WIN + (size_t)l * INWP * DM * 2, ROWS, INWP, DM, C.G, C.wg);
            pg8::EpiStoreBf16 E{(bf16*)(C.ws + WS_P), INWP, nullptr, 0, 1.0f, 1.0f};
            pg8::gemm_phase<pg8::EpiStoreBf16, pg8::StaticOrder, true, true>(C.lds, C.tid, DM, S, E, C.ws);
        }
        SEAM(b + 1);
        if (INP(3, b + 2)) { MKCTX(); mix1_rope(C); for (int rep = 0; rep < NREP(3); ++rep) { mix1_vt(C); mix1_rwkv_prep(C, da, l); mix1_fourier1(C); } }
        SEAM(b + 2);
        if (INP(11, b + 3)) for (int rep = 0; rep < NREP(11); ++rep) { MKCTX(); phase_rwkv1(C); }
        SEAM(b + 3);
        if (INP(4, b + 4)) for (int rep = 0; rep < NREP(4); ++rep) { MKCTX(); phase_mix2(C, da, l); }
        SEAM(b + 4);
        if (INP(5, b + 5)) for (int rep = 0; rep < NREP(5); ++rep) { MKCTX(); phase_mix3(C, da, l); }
        SEAM(b + 5);
        if (INP(6, b + 6)) { MKCTX();
            if (l < DEPTH - 1) outproj_ctx(C, l, mod_ctx + 2 * DM);
            pg8::StaticOrder S; S.init(WS_MIX + (size_t)NCTX * DM * 2, WS_WOUT + (size_t)l * DM * DM * 2, SEQ, DM, DM, C.G, C.wg);
            pg8::EpiResidual E{(bf16*)(C.ws + WS_XS) + (size_t)NCTX * DM, DM, mod_lat + 2 * DM, mod_lat + 2 * DM};
            pg8::gemm_phase<pg8::EpiResidual, pg8::StaticOrder, true, true>(C.lds, C.tid, DM, S, E, C.ws);
        }
        SEAM(b + 6);
        if (INP(7, b + 7)) for (int rep = 0; rep < NREP(7); ++rep) { MKCTX(); phase_norm2(C, da, l); }
        SEAM(b + 7);
        if (INP(8, b + 8)) for (int rep = 0; rep < NREP(8); ++rep) { MKCTX(); phase_gather(C, da, l); }
        SEAM(b + 8);
        if (INP(9, b + 9)) for (int rep = 0; rep < NREP(9); ++rep) { MKCTX();
            const int nblk = moe_tables_load(C);
            pg8::MoeOrder S{(unsigned)WS_XG8, (unsigned)(WS_WGU + (size_t)l * 32 * 2048 * DM), 256u * DM, 2048u * DM,
                            (const LAS unsigned char*)(C.lds + MISC_OFF + 1024), nblk, 8, C.G, C.wg, 0, 0}; S.split();
            pg8::EpiSwiglu E{(bf16*)(C.ws + WS_ACT8), DM, da.in[I_BGU] + (size_t)l * 32 * 2048, 2048, pg8::X8_S * pg8::W8_S, 1.0f / (pg8::X8_S * pg8::W8_S)};
            pg8::gemm_phase<pg8::EpiSwiglu, pg8::MoeOrder, true, true, 1>(C.lds, C.tid, DM, S, E, C.ws);
        }
        SEAM(b + 9);
        if (INP(10, b + 10)) for (int rep = 0; rep < NREP(10); ++rep) { MKCTX();
            const int nblk = moe_tables_load(C);
            pg8::MoeOrder S{(unsigned)WS_ACT8, (unsigned)(WS_WDN + (size_t)l * 32 * DM * DM), 256u * DM, (unsigned)(DM * DM),
                            (const LAS unsigned char*)(C.lds + MISC_OFF + 1024), nblk, 4, C.G, C.wg, 0, 0}; S.split();
            pg8::EpiStoreBf16 E{(bf16*)(C.ws + WS_XG), DM, da.in[I_BDN] + (size_t)l * 32 * DM, DM, pg8::ACT_S * pg8::W8_S, 1.0f / (pg8::ACT_S * pg8::W8_S)};
            pg8::gemm_phase<pg8::EpiStoreBf16, pg8::MoeOrder, true, true, 1>(C.lds, C.tid, DM, S, E, C.ws);
        }
        SEAM(b + 10);
    }
    if (INP(99, PH_TOTAL - 1)) for (int rep = 0; rep < NREP(99); ++rep) { MKCTX(); phase_final(C, da); }
#undef IN
#undef INP
#undef SEAM
}

typedef void (*kern_t)(Args);
static kern_t kern_of(int o) {
#if MK_SINGLE
    (void)o; return mega<-1>;
#else
    switch (o) { case 0: return mega<0>; case 1: return mega<1>; case 2: return mega<2>; case 3: return mega<3>; case 4: return mega<4>; case 5: return mega<5>; case 6: return mega<6>;
                 case 7: return mega<7>; case 8: return mega<8>; case 9: return mega<9>; case 10: return mega<10>; case 11: return mega<11>; case 99: return mega<99>;
                 default: return mega<0>;
    }
#endif
}
extern "C" void kernel_launch(void* const* d_in, const int* in_sizes, int n_in, void* d_out, int out_size, void* d_ws, size_t ws_size, hipStream_t stream) {
    static int ready = 0;
    if (ready == 0) {
        if (n_in != 31 || out_size != SEQ * DM || ws_size < WS_END) { fprintf(stderr, "kernel_launch: unexpected shapes (n_in %d, out %d, ws %zu)\n", n_in, out_size, ws_size); ready = -1; return; }
        const int ids[14] = {0, 1, 2, 3, 4, 5, 6, 7, 8, 9, 10, 11, 99, -1};
        for (int i = 0; i < (MK_SINGLE ? 14 : 13); ++i) { if (MK_SINGLE && ids[i] != -1) continue;
            if (hipFuncSetAttribute((const void*)kern_of(ids[i]), hipFuncAttributeMaxDynamicSharedMemorySize, LDS_BYTES) != hipSuccess) { fprintf(stderr, "kernel_launch: hipFuncSetAttribute failed (%d)\n", ids[i]); ready = -1; return; } }
        ready = 1;
    }
    if (ready < 0) return;
    (void)hipMemsetAsync((char*)d_ws + WS_CTL, 0, CTL_ZERO_BYTES, stream);
    Args a{};
    for (int i = 0; i < 31; ++i) a.in[i] = (const float*)d_in[i];
    a.out = (float*)d_out; a.ws = (unsigned char*)d_ws; a.pad = 0;
#if MK_SINGLE
    a.ph_lo = 0; a.ph_hi = PH_TOTAL; a.use_bar = 1;
    hipLaunchKernelGGL(kern_of(-1), dim3(NWG), dim3(NTHR), LDS_BYTES, stream, a);
#else
    for (int p = 0; p < PH_TOTAL; ++p) { a.ph_lo = p; a.ph_hi = p + 1; a.use_bar = 0;
        const int j = (p - 1) % NPL; const int o = (p == 0) ? 0 : (p == PH_TOTAL - 1) ? 99 : (j < 3 ? 1 + j : j == 3 ? 11 : j);
        hipLaunchKernelGGL(kern_of(o), dim3(NWG), dim3(NTHR), LDS_BYTES, stream, a); }
#endif
}
```
